# Optimizing an MI355X kernel written in HIP

```python
import math
import jax, jax.numpy as jnp
from jax import lax
import numpy as np

D_MODEL = 2048
BATCH = 1
SEQ = 16384
DEPTH = 1

D_SSM = D_MODEL // 2
D_ATTN = D_MODEL // 2
D_MIX = D_SSM + D_ATTN
SSM_GROUP = 16
N_SSM_GROUPS = D_SSM // SSM_GROUP
SSM_STATE = 64
DT_MIN = 1e-3
DT_MAX = 1e-1

HEAD_DIM = 128
N_HEADS = D_ATTN // HEAD_DIM
N_KV = 2
HPG = N_HEADS // N_KV
CMP_LEN = 32
CMP_STRIDE = 16
CMP_HIDDEN = 256
SLC_LEN = 64
SLC_TOPK = 16
WINDOW = 512
Q_BLOCK = 128
N_BRANCH = 3

N_BUCKETS = 32
MAX_DISTANCE = 1024

PEER_HEADS = 8
PEER_NKEYS = 128
PEER_EXPERTS = PEER_NKEYS * PEER_NKEYS
PEER_DKEY = 256
PEER_TOPK = 16
PEER_CHUNK = 128

KV_COLS = N_BRANCH * 2 * N_KV * HEAD_DIM
GATE_COLS = N_BRANCH * N_HEADS
D_IN = D_SSM + D_ATTN + KV_COLS + GATE_COLS
N_ADA = 6
EPS = 1e-6
NEG = -1e30
FORCED = 1e6

kernel_name = 'hybrid_s5_nsa_peer_block'


def rmsnorm(x, g):
    xf = x.astype(jnp.float32)
    return xf * lax.rsqrt(jnp.mean(xf * xf, axis=-1, keepdims=True) + EPS) * g


def t5_bucket(dist):
    n = jnp.maximum(dist, 0)
    max_exact = N_BUCKETS // 2
    scaled = jnp.log(jnp.maximum(n, max_exact).astype(jnp.float32) / max_exact) / math.log(MAX_DISTANCE / max_exact)
    large = max_exact + (scaled * (N_BUCKETS - max_exact)).astype(jnp.int32)
    return jnp.where(n < max_exact, n, jnp.minimum(large, N_BUCKETS - 1))


def s5_mixer(u, lam_re, lam_im, log_dt, b_re, b_im, c_re, c_im, d_skip, w_glu, b_glu):
    B, L, _ = u.shape
    f32 = jnp.float32
    uf = u.astype(f32).reshape(B, L, N_SSM_GROUPS, SSM_GROUP)
    dt = jnp.exp(log_dt.astype(f32))[:, None]
    lr = lam_re.astype(f32)
    li = lam_im.astype(f32)
    mag = jnp.exp(lr * dt)
    ab_re = mag * jnp.cos(li * dt)
    ab_im = mag * jnp.sin(li * dt)
    den = lr * lr + li * li
    nr = ab_re - 1.0
    ni = ab_im
    w_re = (nr * lr + ni * li) / den
    w_im = (ni * lr - nr * li) / den
    br = b_re.astype(f32)
    bi = b_im.astype(f32)
    bb_re = w_re[..., None] * br - w_im[..., None] * bi
    bb_im = w_re[..., None] * bi + w_im[..., None] * br
    xr = jnp.einsum('gph,blgh->blgp', bb_re, uf)
    xi = jnp.einsum('gph,blgh->blgp', bb_im, uf)
    ar = jnp.broadcast_to(ab_re, xr.shape)
    ai = jnp.broadcast_to(ab_im, xi.shape)

    def combine(e1, e2):
        a1r, a1i, b1r, b1i = e1
        a2r, a2i, b2r, b2i = e2
        return (a1r * a2r - a1i * a2i, a1r * a2i + a1i * a2r,
                a2r * b1r - a2i * b1i + b2r, a2r * b1i + a2i * b1r + b2i)

    _, _, sr, si = lax.associative_scan(combine, (ar, ai, xr, xi), axis=1)
    y = (jnp.einsum('ghp,blgp->blgh', c_re.astype(f32), sr)
         - jnp.einsum('ghp,blgp->blgh', c_im.astype(f32), si)
         + d_skip.astype(f32) * uf)
    z = jax.nn.gelu(y.reshape(B, L, D_SSM))
    return z * jax.nn.sigmoid(z @ w_glu + b_glu)


def compress(kv, pe, w1, w2):
    B, L, G, dh = kv.shape
    ch = kv.reshape(B, L // CMP_STRIDE, CMP_STRIDE, G, dh)
    blocks = jnp.concatenate([ch[:, :-1], ch[:, 1:]], axis=2)
    blocks = blocks + pe[None, None, :, None, :]
    n_cmp = blocks.shape[1]
    flat = blocks.transpose(0, 1, 3, 2, 4).reshape(B, n_cmp, G, CMP_LEN * dh)
    return jax.nn.gelu(flat @ w1) @ w2


def nsa_attention(q, k_cmp, v_cmp, k_slc, v_slc, k_win, v_win, gates, rel_bias,
                  pe_k, w1_k, w2_k, pe_v, w1_v, w2_v):
    B, L = q.shape[:2]
    f32 = jnp.float32
    scale = HEAD_DIM ** -0.5
    kc = compress(k_cmp, pe_k, w1_k, w2_k)
    vc = compress(v_cmp, pe_v, w1_v, w2_v)
    n_cmp = kc.shape[1]
    n_slc = L // SLC_LEN
    topk = min(SLC_TOPK, n_slc)
    cmp_start = jnp.arange(n_cmp) * CMP_STRIDE
    cmp_end = cmp_start + CMP_LEN - 1
    slc_start = jnp.arange(n_slc) * SLC_LEN
    ov = (jnp.minimum(cmp_start[:, None] + CMP_LEN, slc_start[None, :] + SLC_LEN)
          - jnp.maximum(cmp_start[:, None], slc_start[None, :]))
    overlap = jnp.maximum(ov, 0).astype(f32) / CMP_STRIDE
    ks_blk = k_slc.reshape(B, n_slc, SLC_LEN, N_KV, HEAD_DIM).transpose(0, 3, 1, 2, 4)
    vs_blk = v_slc.reshape(B, n_slc, SLC_LEN, N_KV, HEAD_DIM).transpose(0, 3, 1, 2, 4)
    pad = ((0, 0), (WINDOW, 0), (0, 0), (0, 0))
    kw = jnp.pad(k_win, pad)
    vw = jnp.pad(v_win, pad)
    n_qb = L // Q_BLOCK
    qb = q.reshape(B, n_qb, Q_BLOCK, N_KV, HPG, HEAD_DIM).transpose(1, 0, 2, 3, 4, 5)
    gb = gates.reshape(B, n_qb, Q_BLOCK, N_BRANCH, N_KV, HPG).transpose(1, 0, 2, 3, 4, 5)
    bias_g = rel_bias.reshape(N_BUCKETS, N_KV, HPG)
    bidx = jnp.arange(B)[:, None, None, None]
    gidx = jnp.arange(N_KV)[None, None, :, None]
    gidx5 = jnp.arange(N_KV)[None, None, :, None, None]
    jblk = jnp.arange(n_slc)

    def block_fn(args):
        qi, gi, bi = args
        t = bi * Q_BLOCK + jnp.arange(Q_BLOCK)
        lc = jnp.einsum('bqgpd,bngd->bgpqn', qi, kc).astype(f32) * scale
        dist_c = t[:, None] - cmp_end[None, :]
        valid_c = dist_c >= 0
        lc = lc + bias_g[t5_bucket(dist_c)].transpose(2, 3, 0, 1)[None]
        lc = jnp.where(valid_c, lc, NEG)
        pc = jax.nn.softmax(lc, axis=-1) * valid_c
        oc = jnp.einsum('bgpqn,bngd->bqgpd', pc.astype(vc.dtype), vc)
        imp = jnp.einsum('bgqn,nj->bgqj', pc.sum(axis=2), overlap)
        qblk = t // SLC_LEN
        forced = ((jblk[None, :] == 0) | (jblk[None, :] == qblk[:, None])
                  | (jblk[None, :] == qblk[:, None] - 1))
        causal_s = slc_start[None, :] <= t[:, None]
        score = jnp.where(causal_s, jnp.where(forced, FORCED, imp), NEG)
        sel_val, sel_idx = lax.top_k(score, topk)
        idx = sel_idx.transpose(0, 2, 1, 3)
        ok = (sel_val > NEG * 0.5).transpose(0, 2, 1, 3)
        ks = ks_blk[bidx, gidx, idx]
        vs = vs_blk[bidx, gidx, idx]
        pos = idx[..., None] * SLC_LEN + jnp.arange(SLC_LEN)
        dist_s = t[None, :, None, None, None] - pos
        valid_s = ok[..., None] & (dist_s >= 0)
        ls = jnp.einsum('bqgpd,bqgskd->bqgskp', qi, ks).astype(f32) * scale
        ls = ls + bias_g[t5_bucket(dist_s), gidx5]
        ls = jnp.where(valid_s[..., None], ls, NEG)
        ps = jax.nn.softmax(ls, axis=(3, 4))
        osl = jnp.einsum('bqgskp,bqgskd->bqgpd', ps.astype(vs.dtype), vs)
        q0 = bi * Q_BLOCK
        kwin = lax.dynamic_slice_in_dim(kw, q0, WINDOW + Q_BLOCK, axis=1)
        vwin = lax.dynamic_slice_in_dim(vw, q0, WINDOW + Q_BLOCK, axis=1)
        spos = q0 - WINDOW + jnp.arange(WINDOW + Q_BLOCK)
        dist_w = t[:, None] - spos[None, :]
        valid_w = (dist_w >= 0) & (dist_w < WINDOW) & (spos[None, :] >= 0)
        lw = jnp.einsum('bqgpd,bkgd->bgpqk', qi, kwin).astype(f32) * scale
        lw = lw + bias_g[t5_bucket(dist_w)].transpose(2, 3, 0, 1)[None]
        lw = jnp.where(valid_w, lw, NEG)
        pw = jax.nn.softmax(lw, axis=-1)
        ow = jnp.einsum('bgpqk,bkgd->bqgpd', pw.astype(vwin.dtype), vwin)
        return (gi[:, :, 0, :, :, None] * oc + gi[:, :, 1, :, :, None] * osl
                + gi[:, :, 2, :, :, None] * ow)

    out = lax.map(block_fn, (qb, gb, jnp.arange(n_qb)))
    return out.transpose(1, 0, 2, 3, 4, 5).reshape(B, L, D_ATTN)


def peer(h, w_q, sub_k1, sub_k2, exp_u, exp_v):
    B, L, D = h.shape
    T = B * L
    hf = h.reshape(T, D)
    q = (hf @ w_q).reshape(T, PEER_HEADS, 2, PEER_DKEY // 2)
    s1 = jnp.einsum('thd,nd->thn', q[:, :, 0], sub_k1).astype(jnp.float32)
    s2 = jnp.einsum('thd,nd->thn', q[:, :, 1], sub_k2).astype(jnp.float32)
    v1, i1 = lax.top_k(s1, PEER_TOPK)
    v2, i2 = lax.top_k(s2, PEER_TOPK)
    cand = (v1[..., :, None] + v2[..., None, :]).reshape(T, PEER_HEADS, PEER_TOPK * PEER_TOPK)
    sv, si = lax.top_k(cand, PEER_TOPK)
    e1 = jnp.take_along_axis(i1, si // PEER_TOPK, axis=-1)
    e2 = jnp.take_along_axis(i2, si % PEER_TOPK, axis=-1)
    expert = e1 * PEER_NKEYS + e2
    gate = jax.nn.softmax(sv, axis=-1)
    n_chunks = T // PEER_CHUNK

    def chunk_fn(args):
        xc, ec, gc = args
        u = exp_u[ec]
        a = jax.nn.gelu(jnp.einsum('cd,chkd->chk', xc, u).astype(jnp.float32))
        w = (gc * a).astype(exp_v.dtype)
        return jnp.einsum('chk,chkd->cd', w, exp_v[ec])

    out = lax.map(chunk_fn, (hf.reshape(n_chunks, PEER_CHUNK, D),
                             expert.reshape(n_chunks, PEER_CHUNK, PEER_HEADS, PEER_TOPK),
                             gate.reshape(n_chunks, PEER_CHUNK, PEER_HEADS, PEER_TOPK)))
    return out.reshape(B, L, D)


def setup_inputs(seed: int = 0) -> dict:
    key = jax.random.key(seed)
    ks = jax.random.split(key, 33)
    f32 = jnp.float32
    D = D_MODEL
    G, P, H = N_SSM_GROUPS, SSM_STATE, SSM_GROUP

    def nrm(k, shape, s):
        return jax.random.normal(k, shape, f32) * s

    lam_im_base = jnp.pi * jnp.arange(P, dtype=f32)
    return {
        'x': nrm(ks[0], (BATCH, SEQ, D), 1.0),
        'c': nrm(ks[1], (BATCH, D), 1.0),
        'w_ada': nrm(ks[2], (DEPTH, D, N_ADA * D), 0.5 * D ** -0.5),
        'b_ada': nrm(ks[3], (DEPTH, N_ADA * D), 0.02),
        'norm1_g': 1.0 + nrm(ks[4], (DEPTH, D), 0.02),
        'norm2_g': 1.0 + nrm(ks[5], (DEPTH, D), 0.02),
        'w_in': nrm(ks[6], (DEPTH, D, D_IN), D ** -0.5),
        'w_out': nrm(ks[7], (DEPTH, D_MIX, D), D_MIX ** -0.5),
        'beta_ssm': 1.0 + nrm(ks[8], (DEPTH, D_SSM), 0.02),
        'beta_attn': 1.0 + nrm(ks[9], (DEPTH, D_ATTN), 0.02),
        'ssm_lam_re': -0.5 + nrm(ks[10], (DEPTH, G, P), 0.01),
        'ssm_lam_im': lam_im_base + nrm(ks[11], (DEPTH, G, P), 0.01),
        'ssm_log_dt': jax.random.uniform(ks[12], (DEPTH, G), f32, math.log(DT_MIN), math.log(DT_MAX)),
        'ssm_b_re': nrm(ks[13], (DEPTH, G, P, H), (2 * H) ** -0.5),
        'ssm_b_im': nrm(ks[14], (DEPTH, G, P, H), (2 * H) ** -0.5),
        'ssm_c_re': nrm(ks[15], (DEPTH, G, H, P), (2 * P) ** -0.5 * 4.0),
        'ssm_c_im': nrm(ks[16], (DEPTH, G, H, P), (2 * P) ** -0.5 * 4.0),
        'ssm_d': nrm(ks[17], (DEPTH, G, H), 1.0),
        'ssm_w_glu': nrm(ks[18], (DEPTH, D_SSM, D_SSM), D_SSM ** -0.5),
        'ssm_b_glu': nrm(ks[19], (DEPTH, D_SSM), 0.02),
        'cmp_pe_k': nrm(ks[20], (DEPTH, CMP_LEN, HEAD_DIM), 0.02),
        'cmp_w1_k': nrm(ks[21], (DEPTH, CMP_LEN * HEAD_DIM, CMP_HIDDEN), (CMP_LEN * HEAD_DIM) ** -0.5),
        'cmp_w2_k': nrm(ks[22], (DEPTH, CMP_HIDDEN, HEAD_DIM), CMP_HIDDEN ** -0.5 * 2.0),
        'cmp_pe_v': nrm(ks[23], (DEPTH, CMP_LEN, HEAD_DIM), 0.02),
        'cmp_w1_v': nrm(ks[24], (DEPTH, CMP_LEN * HEAD_DIM, CMP_HIDDEN), (CMP_LEN * HEAD_DIM) ** -0.5),
        'cmp_w2_v': nrm(ks[25], (DEPTH, CMP_HIDDEN, HEAD_DIM), CMP_HIDDEN ** -0.5 * 2.0),
        'rel_bias': nrm(ks[26], (N_BUCKETS, N_HEADS), 0.1),
        'peer_w_q': nrm(ks[27], (DEPTH, D, PEER_HEADS * PEER_DKEY), D ** -0.5),
        'peer_k1': nrm(ks[28], (DEPTH, PEER_NKEYS, PEER_DKEY // 2), (PEER_DKEY // 2) ** -0.5),
        'peer_k2': nrm(ks[29], (DEPTH, PEER_NKEYS, PEER_DKEY // 2), (PEER_DKEY // 2) ** -0.5),
        'peer_u': nrm(ks[30], (DEPTH, PEER_EXPERTS, D), D ** -0.5),
        'peer_v': nrm(ks[31], (DEPTH, PEER_EXPERTS, D), PEER_HEADS ** -0.5),
        'final_g': 1.0 + nrm(ks[32], (D,), 0.02),
    }


def reference(x, c, w_ada, b_ada, norm1_g, norm2_g, w_in, w_out, beta_ssm, beta_attn,
              ssm_lam_re, ssm_lam_im, ssm_log_dt, ssm_b_re, ssm_b_im, ssm_c_re, ssm_c_im,
              ssm_d, ssm_w_glu, ssm_b_glu, cmp_pe_k, cmp_w1_k, cmp_w2_k, cmp_pe_v, cmp_w1_v,
              cmp_w2_v, rel_bias, peer_w_q, peer_k1, peer_k2, peer_u, peer_v, final_g):
    B, L, _ = x.shape
    for l in range(DEPTH):
        cond = jax.nn.silu(c) @ w_ada[l] + b_ada[l]
        sh1, sc1, g1, sh2, sc2, g2 = [m[:, None, :] for m in jnp.split(cond, N_ADA, axis=-1)]
        h = rmsnorm(x, norm1_g[l]) * (1.0 + sc1) + sh1
        proj = h @ w_in[l]
        u_ssm, q, kv, gate_logits = jnp.split(
            proj, [D_SSM, D_SSM + D_ATTN, D_SSM + D_ATTN + KV_COLS], axis=-1)
        q = q.reshape(B, L, N_HEADS, HEAD_DIM)
        kv = kv.reshape(B, L, N_BRANCH, 2, N_KV, HEAD_DIM)
        gates = jax.nn.sigmoid(gate_logits.reshape(B, L, N_BRANCH, N_HEADS))
        y_ssm = s5_mixer(u_ssm, ssm_lam_re[l], ssm_lam_im[l], ssm_log_dt[l], ssm_b_re[l], ssm_b_im[l],
                         ssm_c_re[l], ssm_c_im[l], ssm_d[l], ssm_w_glu[l], ssm_b_glu[l])
        y_att = nsa_attention(q, kv[:, :, 0, 0], kv[:, :, 0, 1], kv[:, :, 1, 0], kv[:, :, 1, 1],
                              kv[:, :, 2, 0], kv[:, :, 2, 1], gates, rel_bias,
                              cmp_pe_k[l], cmp_w1_k[l], cmp_w2_k[l], cmp_pe_v[l], cmp_w1_v[l], cmp_w2_v[l])
        mixed = jnp.concatenate([rmsnorm(y_ssm, beta_ssm[l]), rmsnorm(y_att, beta_attn[l])], axis=-1)
        x = x + g1 * (mixed @ w_out[l])
        h2 = rmsnorm(x, norm2_g[l]) * (1.0 + sc2) + sh2
        x = x + g2 * peer(h2, peer_w_q[l], peer_k1[l], peer_k2[l], peer_u[l], peer_v[l])
    return rmsnorm(x, final_g)
```

```cpp
#include <hip/hip_runtime.h>
#include <stdint.h>
#include <stdio.h>

#define LAS __attribute__((address_space(3)))
typedef unsigned short bf16_t;
typedef short bf16x8 __attribute__((ext_vector_type(8)));
typedef float f32x2 __attribute__((ext_vector_type(2)));
typedef float f32x4 __attribute__((ext_vector_type(4)));
typedef float f32x16 __attribute__((ext_vector_type(16)));
typedef unsigned u32x2 __attribute__((ext_vector_type(2)));
typedef unsigned u32x4 __attribute__((ext_vector_type(4)));
typedef __bf16 bfv2 __attribute__((ext_vector_type(2)));

constexpr int L_ = 16384, D_ = 2048, DSSM = 1024, DATT = 1024, DIN = 3608, DIN_PAD = 3840;
constexpr int NADA = 12288;
constexpr float LOG2E = 1.4426950408889634f;
constexpr float QSCALE = 0.08838834764831845f * 1.4426950408889634f;
constexpr int TBN = 800;
constexpr int NTHREADS = 512;
constexpr int LDS_BYTES = 163840;

constexpr size_t al256(size_t x) { return (x + 255) & ~(size_t)255; }
constexpr size_t WS_CTL   = 0;                                  constexpr size_t CTL_BYTES = 65536;
constexpr size_t WS_CONDP = WS_CTL + CTL_BYTES;
constexpr size_t WS_COND  = WS_CONDP + 32 * 12288 * 4;
constexpr size_t WS_TB    = WS_COND + 12288 * 4;
constexpr size_t WS_BPE   = al256(WS_TB + 8 * TBN * 4);
constexpr size_t WS_S5P   = al256(WS_BPE + 2 * 256 * 4);
constexpr size_t WS_S5F   = WS_S5P + 2 * 64 * 64 * 2 * 4;
constexpr size_t WS_S5MT  = WS_S5F + 64 * 4 * 128 * 4;
constexpr size_t WS_S5WE  = WS_S5MT + (size_t)64 * 256 * 256 * 2;
constexpr size_t WS_S5WC  = WS_S5WE + (size_t)64 * 128 * 256 * 2;
constexpr size_t WS_WIN   = WS_S5WC + (size_t)64 * 256 * 128 * 2;
constexpr size_t WS_WGLU  = WS_WIN + (size_t)DIN_PAD * 2048 * 2;
constexpr size_t WS_WOUT  = WS_WGLU + (size_t)1024 * 1024 * 2;
constexpr size_t WS_WQ    = WS_WOUT + (size_t)2048 * 2048 * 2;
constexpr size_t WS_W1    = WS_WQ + (size_t)2048 * 2048 * 2;
constexpr size_t WS_W2    = WS_W1 + (size_t)2 * 256 * 4096 * 2;
constexpr size_t WS_PK    = WS_W2 + (size_t)2 * 128 * 256 * 2;
constexpr size_t WS_PU    = WS_PK + (size_t)2 * 128 * 128 * 2;
constexpr size_t WS_PV    = WS_PU + (size_t)16384 * 2048 * 2;
constexpr size_t WS_H     = WS_PV + (size_t)16384 * 2048 * 2;
constexpr size_t WS_US    = WS_H + (size_t)16384 * 2048 * 2;
constexpr size_t WS_Q     = WS_US + (size_t)16384 * 1024 * 2;
constexpr size_t WS_QP    = WS_US;
constexpr size_t WS_KROW  = WS_Q + (size_t)16384 * 1024 * 2;
constexpr size_t WS_VROW  = WS_KROW + (size_t)6 * 16384 * 128 * 2;
constexpr size_t WS_VT    = WS_VROW + (size_t)2 * 16384 * 128 * 2 + 8192;
constexpr size_t WS_GATE  = WS_VT + (size_t)4 * 128 * 16384 * 2;
constexpr size_t WS_SLAB  = WS_GATE + (size_t)16384 * 24 * 4;
constexpr size_t WS_KC    = WS_SLAB + (size_t)2 * 4 * 2048 * 256 * 4;
constexpr size_t WS_VCT   = WS_KC + (size_t)2 * 1024 * 128 * 2;
constexpr size_t WS_Z     = WS_VCT + (size_t)2 * 128 * 1024 * 2;
constexpr size_t WS_YSSM  = WS_Z + (size_t)16384 * 1024 * 2;
constexpr size_t WS_YATT  = WS_YSSM + (size_t)16384 * 1024 * 2;
constexpr size_t WS_END   = WS_YATT + (size_t)16384 * 1024 * 2;
static_assert(WS_END < (size_t)530 * 1024 * 1024, "workspace map too large");

struct Args { const float* in[33]; float* out; unsigned char* ws; int ph_lo, ph_hi; };

__device__ __forceinline__ unsigned cvt_pk_bf16(float lo, float hi) { bfv2 v; v[0] = (__bf16)lo; v[1] = (__bf16)hi; return __builtin_bit_cast(unsigned, v); }
__device__ __forceinline__ bf16_t f2bf(float f) { return (bf16_t)(cvt_pk_bf16(f, 0.f) & 0xffffu); }
__device__ __forceinline__ float bf2f(unsigned b) { return __uint_as_float(b << 16); }
__device__ __forceinline__ float bflo(unsigned w) { return __uint_as_float(w << 16); }
__device__ __forceinline__ float bfhi(unsigned w) { return __uint_as_float(w & 0xffff0000u); }
__device__ __forceinline__ float fexp2(float x) { return __builtin_amdgcn_exp2f(x); }
__device__ __forceinline__ float frcp(float x) { return __builtin_amdgcn_rcpf(x); }
__device__ __forceinline__ float sigmoidf_(float x) { return frcp(1.f + fexp2(-LOG2E * x)); }
__device__ __forceinline__ float gelu_tanh(float x) {
    const float u = x * (1.f + 0.044715f * x * x);
    return x * frcp(1.f + fexp2(-2.f * 0.7978845608028654f * LOG2E * u));
}
__device__ __forceinline__ float shfl_xor_f(float v, int m) { return __shfl_xor(v, m, 64); }
__device__ __forceinline__ float wave_sum(float v) {
#pragma unroll
    for (int m = 32; m >= 1; m >>= 1) v += __shfl_xor(v, m, 64);
    return v;
}
__device__ __forceinline__ float wave_max(float v) {
#pragma unroll
    for (int m = 32; m >= 1; m >>= 1) v = fmaxf(v, __shfl_xor(v, m, 64));
    return v;
}
template <int CTRL> __device__ __forceinline__ float dpp_f(float x) { return __int_as_float(__builtin_amdgcn_update_dpp(0, __float_as_int(x), CTRL, 0xf, 0xf, false)); }
__device__ __forceinline__ float quad_sum(float x) { x += dpp_f<0xB1>(x); x += dpp_f<0x4E>(x); return x; }
__device__ __forceinline__ f32x4 mfma16(bf16x8 a, bf16x8 b, f32x4 c) { return __builtin_amdgcn_mfma_f32_16x16x32_bf16(a, b, c, 0, 0, 0); }
__device__ __forceinline__ f32x16 mfma32(bf16x8 a, bf16x8 b, f32x16 c) { return __builtin_amdgcn_mfma_f32_32x32x16_bf16(a, b, c, 0, 0, 0); }
#define XB_TMO      128
#define XB_XCNT(j)  (256  + 64 * (j))
#define XB_XSUB(j)  (1280 + 64 * (j))
#define XB_XGEN(j)  (2304 + 64 * (j))
#define XB_TOP      3328
#define XB_TOPGEN   3392
#define XCD_BAR_WORDS 3456
#define XB_SPIN_CAP (1u << 18)

__device__ __forceinline__ unsigned xb_ld(unsigned* p)              { return __hip_atomic_load(p, __ATOMIC_RELAXED, __HIP_MEMORY_SCOPE_AGENT); }
__device__ __forceinline__ unsigned xb_add(unsigned* p, unsigned v) { return __hip_atomic_fetch_add(p, v, __ATOMIC_RELAXED, __HIP_MEMORY_SCOPE_AGENT); }
__device__ __forceinline__ unsigned xb_xcc_id() { return (unsigned)__builtin_amdgcn_s_getreg((3 << 11) | 20) & 0xFu; }
#define XB_SPIN(cond, bar) do { unsigned _sp = 0; while (cond) { __builtin_amdgcn_s_sleep(1); \
    if ((++_sp & 255u) == 0u) { if (xb_ld(&(bar)[XB_TMO])) break; if (_sp > XB_SPIN_CAP) { atomicAdd(&(bar)[XB_TMO], 1u); break; } } } } while (0)

struct XcdBarrier {
    unsigned* bar; unsigned x;
    volatile LAS unsigned* st;
};
__device__ __forceinline__ XcdBarrier xcd_barrier_post(unsigned* bar, volatile LAS unsigned* st) {
    XcdBarrier b; b.bar = bar; b.x = xb_xcc_id(); b.st = st;
    if (threadIdx.x == 0) (void)xb_add(&bar[XB_XCNT(b.x)], 1u);
    return b;
}
__device__ __forceinline__ void xcd_barrier_complete(unsigned* bar, unsigned x, unsigned& nloc, unsigned& nx) {
    const unsigned G = gridDim.x * gridDim.y * gridDim.z;
    unsigned sum, cnt, mine, sp = 0u;
    for (;;) {
        sum = 0u; cnt = 0u; mine = 0u;
#pragma unroll
        for (unsigned j = 0; j < 16; ++j) { const unsigned c = xb_ld(&bar[XB_XCNT(j)]); sum += c; cnt += (c > 0u) ? 1u : 0u; mine = (j == x) ? c : mine; }
        if (sum == G) break;
        __builtin_amdgcn_s_sleep(1);
        if ((++sp & 255u) == 0u) { if (xb_ld(&bar[XB_TMO])) break; if (sp > XB_SPIN_CAP) { atomicAdd(&bar[XB_TMO], 1u); break; } }
    }
    nloc = mine > 0u ? mine : 1u; nx = cnt > 0u ? cnt : 1u;
}
__device__ __forceinline__ void xcd_barrier(const XcdBarrier& b) {
    asm volatile("s_waitcnt vmcnt(0)" ::: "memory");
    __syncthreads();
    if (threadIdx.x == 0) {
        unsigned* bar = b.bar;
        __builtin_amdgcn_s_waitcnt(0);
        unsigned nloc = b.st[0], nx = b.st[1];
        if (nloc == 0u) { xcd_barrier_complete(bar, b.x, nloc, nx); b.st[0] = nloc; b.st[1] = nx; }
        const unsigned old = xb_add(&bar[XB_XSUB(b.x)], 1u);
        const unsigned gen = old / nloc;
        if (old + 1u == (gen + 1u) * nloc) {
            __builtin_amdgcn_fence(__ATOMIC_RELEASE, "agent");
            asm volatile("s_waitcnt vmcnt(0)" ::: "memory");
            const unsigned og = xb_add(&bar[XB_TOP], 1u);
            const unsigned tg = og / nx;
            if (og + 1u == (tg + 1u) * nx) xb_add(&bar[XB_TOPGEN], 1u);
            else XB_SPIN(xb_ld(&bar[XB_TOPGEN]) == tg, bar);
            __builtin_amdgcn_fence(__ATOMIC_ACQUIRE, "agent");
            xb_add(&bar[XB_XGEN(b.x)], 1u);
            asm volatile("s_waitcnt vmcnt(0)" ::: "memory");
        } else {
            XB_SPIN(xb_ld(&bar[XB_XGEN(b.x)]) == gen, bar);
            __builtin_amdgcn_fence(__ATOMIC_ACQUIRE, "agent");
            asm volatile("s_waitcnt vmcnt(0)" ::: "memory");
        }
    }
    __syncthreads();
}

namespace pg8 {
constexpr int BM = 256, BK = 64, HALF = 128, HTB = HALF * BK * 2, STAGE_BYTES = 8 * HTB, NXCD = 8, WGM = 8;
__host__ __device__ __forceinline__ int lds_byte(int r, int c) { const int st = (r >> 4) * 2 + (c >> 5), rr = r & 15, cc = c & 31, ob = rr * 64 + cc * 2; return st * 1024 + (ob ^ (((ob >> 9) & 1) << 5)); }
__host__ __device__ __forceinline__ void stage_rc(int b, int& R, int& C) { const int st = b / 1024, sb = b % 1024, swz = sb ^ (((sb >> 9) & 1) << 5); R = (st >> 1) * 16 + swz / 64; C = (st & 1) * 32 + (swz % 64) / 2; }
__host__ __device__ __forceinline__ int perm32(int rho) { const int n = rho >> 4, i = rho & 15; return 8 * (i >> 2) + 4 * n + (i & 3); }

struct Unit { int pm, pn, z; };
struct StaticOrder {
    const bf16_t* A; const bf16_t* Bt; int lda, ldb, K;
    int nM, nN, nwg, G, c;
    __device__ void init(const bf16_t* A_, const bf16_t* Bt_, int lda_, int ldb_, int K_, int M, int N, int G_, int c_) { A = A_; Bt = Bt_; lda = lda_; ldb = ldb_; K = K_; nM = M / BM; nN = N / BM; nwg = nM * nN; G = G_; c = c_; }
    __device__ bool next(int i, Unit& u) const {
        const long Lx = (long)i * G + c; if (Lx >= nwg) return false;
        int wgid = (int)Lx; { const int q = nwg / NXCD, r = nwg % NXCD, xcd = wgid % NXCD, off = wgid / NXCD; wgid = (xcd < r ? xcd * (q + 1) : r * (q + 1) + (xcd - r) * q) + off; }
        const int nig = WGM * nN, gid = wgid / nig, fm = gid * WGM, gsz = (nM - fm) < WGM ? (nM - fm) : WGM;
        u.pm = fm + ((wgid % nig) % gsz); u.pn = (wgid % nig) / gsz; u.z = 0; return true;
    }
    __device__ __forceinline__ const char* a_base(const Unit& u) const { return (const char*)(A + (size_t)u.pm * BM * lda); }
    __device__ __forceinline__ const char* b_base(const Unit& u) const { return (const char*)(Bt + (size_t)u.pn * BM * ldb); }
};

template <class Epi, class Sched>
__device__ __forceinline__ void gemm_phase(LAS unsigned char* lds, const Sched& S, const Epi& E) {
    const int tid = threadIdx.x, wid = __builtin_amdgcn_readfirstlane(tid >> 6), lane = tid & 63, wr = wid >> 2, wc = wid & 3, fr = lane & 15, fq = lane >> 4;
    const int K = S.K, nt = K / BK, lda = S.lda, ldb = S.ldb;
    unsigned voffA[2], voffB[2];
#pragma unroll
    for (int i = 0; i < 2; ++i) { int R, C; stage_rc(tid * 16 + i * 8192, R, C); const int Rb = Epi::PERM ? ((R & ~31) + perm32(R & 31)) : R;
        voffA[i] = (unsigned)(R * lda + C) * 2u; voffB[i] = (unsigned)(Rb * ldb + C) * 2u; }
    const size_t kstep = (size_t)(BK * 2);
    const size_t hstepA = (size_t)HALF * lda * 2, hstepB = (size_t)HALF * ldb * 2;
    const unsigned ldsw = (unsigned)wid * 1024u;
    const int aoff = lds_byte(wr * 64 + fr, fq * 8), boff = lds_byte(wc * 32 + fr, fq * 8);
#define PG8_SA(b, h) (((b) * 2 + (h)) * HTB)
#define PG8_SB(b, h) ((4 + (b) * 2 + (h)) * HTB)
#define PG8_STAGE(bufoff, gbase, voff) do { _Pragma("unroll") for (int _i = 0; _i < 2; ++_i) \
        __builtin_amdgcn_global_load_lds((const unsigned*)((const char*)(gbase) + (voff)[_i]), (LAS unsigned*)(lds + (bufoff) + ldsw + _i * 8192), 16, 0, 0); } while (0)
#define PG8_LDA(dst, b, h) do { _Pragma("unroll") for (int m = 0; m < 4; ++m) _Pragma("unroll") for (int k = 0; k < 2; ++k) dst[m][k] = *(const LAS bf16x8*)(lds + PG8_SA(b, h) + aoff + m * 2048 + k * 1024); } while (0)
#define PG8_LDB(dst, b, h) do { _Pragma("unroll") for (int n = 0; n < 2; ++n) _Pragma("unroll") for (int k = 0; k < 2; ++k) dst[n][k] = *(const LAS bf16x8*)(lds + PG8_SB(b, h) + boff + n * 2048 + k * 1024); } while (0)
#define PG8_MMA(ai, bj, At, Bt) do { __builtin_amdgcn_s_setprio(1); _Pragma("unroll") for (int m = 0; m < 4; ++m) _Pragma("unroll") for (int n = 0; n < 2; ++n) _Pragma("unroll") for (int k = 0; k < 2; ++k) \
        acc[ai][bj][m][n] = __builtin_amdgcn_mfma_f32_16x16x32_bf16(Bt[n][k], At[m][k], acc[ai][bj][m][n], 0, 0, 0); __builtin_amdgcn_s_setprio(0); } while (0)
#define PG8_WAIT_V(n) asm volatile("s_waitcnt vmcnt(" #n ")" ::: "memory")
#define PG8_WAIT_L(n) asm volatile("s_waitcnt lgkmcnt(" #n ")" ::: "memory")
#define PG8_BAR __builtin_amdgcn_s_barrier()
#define PG8_SCHED __builtin_amdgcn_sched_barrier(0)
    Unit cur, nxt; int ui = 0;
    if (!S.next(0, cur)) return;
    f32x4 acc[2][2][4][2];
#pragma unroll
    for (int a = 0; a < 2; ++a)
#pragma unroll
        for (int b = 0; b < 2; ++b)
#pragma unroll
            for (int m = 0; m < 4; ++m)
#pragma unroll
                for (int n = 0; n < 2; ++n) acc[a][b][m][n] = (f32x4){0.f, 0.f, 0.f, 0.f};
    bf16x8 At[4][2], B0[2][2], B1[2][2];
    const char* cA = S.a_base(cur); const char* cB = S.b_base(cur);
    PG8_STAGE(PG8_SB(0, 0), cB, voffB); PG8_STAGE(PG8_SA(0, 0), cA, voffA); PG8_STAGE(PG8_SB(0, 1), cB + hstepB, voffB); PG8_STAGE(PG8_SA(0, 1), cA + hstepA, voffA);
    if (wr == 1) PG8_BAR;
    PG8_WAIT_V(4); PG8_BAR;
    PG8_STAGE(PG8_SB(1, 0), cB + kstep, voffB); PG8_STAGE(PG8_SA(1, 0), cA + kstep, voffA); PG8_STAGE(PG8_SB(1, 1), cB + hstepB + kstep, voffB);
    PG8_WAIT_V(6); PG8_BAR;
    for (;;) {
        const bool has_next = S.next(ui + 1, nxt);
        const char* nA = has_next ? S.a_base(nxt) : cA; const char* nB = has_next ? S.b_base(nxt) : cB;
        for (int t = 0; t < nt; t += 2) {
            const bool last = (t == nt - 2);
            const char* a1 = cA + (size_t)(t + 1) * kstep;
            const char* a2 = last ? nA : cA + (size_t)(t + 2) * kstep; const char* b2 = last ? nB : cB + (size_t)(t + 2) * kstep;
            const char* a3 = a2 + kstep; const char* b3 = b2 + kstep;
            PG8_LDB(B0, 0, 0); PG8_SCHED; PG8_LDA(At, 0, 0); PG8_STAGE(PG8_SA(1, 1), a1 + hstepA, voffA);
            PG8_WAIT_L(8); PG8_BAR; PG8_WAIT_L(0); PG8_MMA(0, 0, At, B0); PG8_BAR; PG8_SCHED;
            PG8_LDB(B1, 0, 1); PG8_STAGE(PG8_SB(0, 0), b2, voffB);
            PG8_BAR; PG8_WAIT_L(0); PG8_MMA(0, 1, At, B1); PG8_BAR;
            PG8_LDA(At, 0, 1); PG8_STAGE(PG8_SA(0, 0), a2, voffA);
            PG8_BAR; PG8_WAIT_L(0); PG8_MMA(1, 0, At, B0); PG8_BAR; PG8_SCHED;
            PG8_STAGE(PG8_SB(0, 1), b2 + hstepB, voffB);
            PG8_WAIT_V(6); PG8_BAR; PG8_MMA(1, 1, At, B1); PG8_BAR;
            PG8_LDB(B0, 1, 0); PG8_SCHED; PG8_LDA(At, 1, 0); PG8_STAGE(PG8_SA(0, 1), a2 + hstepA, voffA);
            PG8_WAIT_L(8); PG8_BAR; PG8_WAIT_L(0); PG8_MMA(0, 0, At, B0); PG8_BAR; PG8_SCHED;
            PG8_LDB(B1, 1, 1); PG8_STAGE(PG8_SB(1, 0), b3, voffB);
            PG8_BAR; PG8_WAIT_L(0); PG8_MMA(0, 1, At, B1); PG8_BAR;
            PG8_LDA(At, 1, 1); PG8_STAGE(PG8_SA(1, 0), a3, voffA);
            PG8_BAR; PG8_WAIT_L(0); PG8_MMA(1, 0, At, B0); PG8_BAR; PG8_SCHED;
            PG8_STAGE(PG8_SB(1, 1), b3 + hstepB, voffB);
            PG8_WAIT_V(6); PG8_BAR; PG8_MMA(1, 1, At, B1); PG8_BAR;
        }
        E(acc, cur, wr, wc, fr, fq);
        if (!has_next) break;
#pragma unroll
        for (int a = 0; a < 2; ++a)
#pragma unroll
            for (int b = 0; b < 2; ++b)
#pragma unroll
                for (int m = 0; m < 4; ++m)
#pragma unroll
                    for (int n = 0; n < 2; ++n) acc[a][b][m][n] = (f32x4){0.f, 0.f, 0.f, 0.f};
        cur = nxt; cA = nA; cB = nB; ++ui;
    }
    PG8_WAIT_V(0);
    if (wr == 0) PG8_BAR;
    PG8_BAR;
#undef PG8_SA
#undef PG8_SB
#undef PG8_STAGE
#undef PG8_LDA
#undef PG8_LDB
#undef PG8_MMA
#undef PG8_WAIT_V
#undef PG8_WAIT_L
#undef PG8_BAR
#undef PG8_SCHED
}
}
using pg8::Unit;
__device__ __forceinline__ u32x4 pack8(const f32x4& v0, const f32x4& v1) {
    u32x4 o; o[0] = cvt_pk_bf16(v0[0], v0[1]); o[1] = cvt_pk_bf16(v0[2], v0[3]); o[2] = cvt_pk_bf16(v1[0], v1[1]); o[3] = cvt_pk_bf16(v1[2], v1[3]); return o;
}
struct EpiWin {
    static constexpr bool PERM = true;
    bf16_t* US; bf16_t* Q; bf16_t* KROW; bf16_t* VROW; bf16_t* VT; float* GATE;
    __device__ __forceinline__ void operator()(const f32x4 (&acc)[2][2][4][2], const Unit& u, int wr, int wc, int fr, int fq) const {
        const int row0 = u.pm * 256 + wr * 64 + fr; const int pn = u.pn;
#pragma unroll
        for (int ai = 0; ai < 2; ++ai)
#pragma unroll
            for (int m = 0; m < 4; ++m) {
                const int row = row0 + ai * 128 + m * 16;
#pragma unroll
                for (int bj = 0; bj < 2; ++bj) {
                    const f32x4 v0 = acc[ai][bj][m][0], v1 = acc[ai][bj][m][1];
                    const int cin = bj * 128 + wc * 32 + 8 * fq;
                    if (pn < 4) { *(u32x4*)(US + (size_t)row * 1024 + pn * 256 + cin) = pack8(v0, v1); }
                    else if (pn < 8) { *(u32x4*)(Q + (size_t)row * 1024 + (pn - 4) * 256 + cin) = pack8(v0 * QSCALE, v1 * QSCALE); }
                    else if (pn < 14) {
                        const int kvi = pn - 8, branch = kvi >> 1, kvsel = kvi & 1, g = bj, d0 = wc * 32 + 8 * fq;
                        if (kvsel == 0) { *(u32x4*)(KROW + ((size_t)(branch * 2 + g) * L_ + row) * 128 + d0) = pack8(v0, v1); }
                        else if (branch == 0) { *(u32x4*)(VROW + ((size_t)g * L_ + row) * 128 + d0) = pack8(v0, v1); }
                        else {
                            bf16_t* vt = VT + ((size_t)((branch - 1) * 2 + g) * 128 + d0) * L_ + row;
#pragma unroll
                            for (int e = 0; e < 4; ++e) { vt[(size_t)e * L_] = f2bf(v0[e]); vt[(size_t)(e + 4) * L_] = f2bf(v1[e]); }
                        }
                    } else {
                        if (cin < 24) {
                            float* gp = GATE + (size_t)row * 24 + cin;
                            f32x4 s0, s1;
#pragma unroll
                            for (int e = 0; e < 4; ++e) { s0[e] = sigmoidf_(v0[e]); s1[e] = sigmoidf_(v1[e]); }
                            *(f32x4*)gp = s0; *(f32x4*)(gp + 4) = s1;
                        }
                    }
                }
            }
    }
};
struct EpiGlu {
    static constexpr bool PERM = true;
    const bf16_t* Z; const float* bglu; bf16_t* Y;
    __device__ __forceinline__ void operator()(const f32x4 (&acc)[2][2][4][2], const Unit& u, int wr, int wc, int fr, int fq) const {
        const int row0 = u.pm * 256 + wr * 64 + fr;
#pragma unroll
        for (int bj = 0; bj < 2; ++bj) {
            const int col = u.pn * 256 + bj * 128 + wc * 32 + 8 * fq;
            const f32x4 b0 = *(const f32x4*)(bglu + col), b1 = *(const f32x4*)(bglu + col + 4);
#pragma unroll
            for (int ai = 0; ai < 2; ++ai)
#pragma unroll
                for (int m = 0; m < 4; ++m) {
                    const int row = row0 + ai * 128 + m * 16;
                    const u32x4 zz = *(const u32x4*)(Z + (size_t)row * 1024 + col);
                    const f32x4 v0 = acc[ai][bj][m][0] + b0, v1 = acc[ai][bj][m][1] + b1;
                    f32x4 o0, o1;
                    o0[0] = bflo(zz[0]) * sigmoidf_(v0[0]); o0[1] = bfhi(zz[0]) * sigmoidf_(v0[1]); o0[2] = bflo(zz[1]) * sigmoidf_(v0[2]); o0[3] = bfhi(zz[1]) * sigmoidf_(v0[3]);
                    o1[0] = bflo(zz[2]) * sigmoidf_(v1[0]); o1[1] = bfhi(zz[2]) * sigmoidf_(v1[1]); o1[2] = bflo(zz[3]) * sigmoidf_(v1[2]); o1[3] = bfhi(zz[3]) * sigmoidf_(v1[3]);
                    *(u32x4*)(Y + (size_t)row * 1024 + col) = pack8(o0, o1);
                }
        }
    }
};
struct EpiWout {
    static constexpr bool PERM = false;
    const float* X; const float* g1; float* X1;
    __device__ __forceinline__ void operator()(const f32x4 (&acc)[2][2][4][2], const Unit& u, int wr, int wc, int fr, int fq) const {
        const int row0 = u.pm * 256 + wr * 64 + fr, col0 = u.pn * 256 + wc * 32 + 4 * fq;
#pragma unroll
        for (int bj = 0; bj < 2; ++bj)
#pragma unroll
            for (int n = 0; n < 2; ++n) {
                const int col = col0 + bj * 128 + n * 16;
                const f32x4 gv = *(const f32x4*)(g1 + col);
#pragma unroll
                for (int ai = 0; ai < 2; ++ai)
#pragma unroll
                    for (int m = 0; m < 4; ++m) {
                        const size_t off = (size_t)(row0 + ai * 128 + m * 16) * 2048 + col;
                        *(f32x4*)(X1 + off) = *(const f32x4*)(X + off) + gv * acc[ai][bj][m][n];
                    }
            }
    }
};
struct EpiBf16 {
    static constexpr bool PERM = true;
    bf16_t* O; int ldc;
    __device__ __forceinline__ void operator()(const f32x4 (&acc)[2][2][4][2], const Unit& u, int wr, int wc, int fr, int fq) const {
        const int row0 = u.pm * 256 + wr * 64 + fr, col0 = u.pn * 256 + wc * 32 + 8 * fq;
#pragma unroll
        for (int ai = 0; ai < 2; ++ai)
#pragma unroll
            for (int m = 0; m < 4; ++m)
#pragma unroll
                for (int bj = 0; bj < 2; ++bj)
                    *(u32x4*)(O + (size_t)(row0 + ai * 128 + m * 16) * ldc + col0 + bj * 128) = pack8(acc[ai][bj][m][0], acc[ai][bj][m][1]);
    }
};
struct EpiSlab {
    static constexpr bool PERM = false;
    float* SL;
    __device__ __forceinline__ void operator()(const f32x4 (&acc)[2][2][4][2], const Unit& u, int wr, int wc, int fr, int fq) const {
        float* base = SL + (size_t)u.z * 2048 * 256;
        const int row0 = u.pm * 256 + wr * 64 + fr, col0 = wc * 32 + 4 * fq;
#pragma unroll
        for (int ai = 0; ai < 2; ++ai)
#pragma unroll
            for (int m = 0; m < 4; ++m)
#pragma unroll
                for (int bj = 0; bj < 2; ++bj)
#pragma unroll
                    for (int n = 0; n < 2; ++n)
                        *(f32x4*)(base + (size_t)(row0 + ai * 128 + m * 16) * 256 + col0 + bj * 128 + n * 16) = acc[ai][bj][m][n];
    }
};
struct CmpOrder {
    const bf16_t* KROW; const bf16_t* VROW; const bf16_t* W1; int lda, ldb, K; int G, c;
    __device__ bool next(int i, Unit& u) const {
        const int x = i * G + c; if (x >= 64) return false;
        const int kvsel = x >> 5, pm = (x & 31) >> 2, ks = x & 3; u.pm = pm; u.pn = 0; u.z = kvsel * 4 + ks; return true;
    }
    __device__ __forceinline__ const char* a_base(const Unit& u) const { return (const char*)(((u.z >> 2) ? VROW : KROW) + (size_t)u.pm * 256 * 2048 + (u.z & 3) * 1024); }
    __device__ __forceinline__ const char* b_base(const Unit& u) const { return (const char*)(W1 + (size_t)(u.z >> 2) * 256 * 4096 + (u.z & 3) * 1024); }
};
struct Ctx { int bid, nb, tid, wave, lane; LAS unsigned char* lds; };

__device__ __forceinline__ void p0_cond(const Args& a, const Ctx& c) {
    const float* cv = a.in[1]; const float* w = a.in[2]; float* condp = (float*)(a.ws + WS_CONDP);
    for (int u = c.bid * 8 + c.wave; u < 1536; u += c.nb * 8) {
        const int cc = u % 48, kc = u / 48;
        const float* wp = w + (size_t)(kc * 64) * NADA + cc * 256 + c.lane * 4;
        f32x4 acc = {0.f, 0.f, 0.f, 0.f};
#pragma unroll 16
        for (int k = 0; k < 64; ++k) { const float x = cv[kc * 64 + k]; const float s = x / (1.f + __expf(-x)); acc += s * *(const f32x4*)(wp + (size_t)k * NADA); }
        *(f32x4*)(condp + (size_t)kc * NADA + cc * 256 + c.lane * 4) = acc;
    }
}
__device__ __forceinline__ void conv_T(const float* src, int K, int N, bf16_t* dst, int Npad, const Ctx& c) {
    LAS float* tile = (LAS float*)c.lds;
    const int nkt = K / 64, ntiles = nkt * (Npad / 64);
    for (int tix = c.bid; tix < ntiles; tix += c.nb) {
        const int nt = tix / nkt, kt = tix % nkt;
        { const int r = c.tid >> 4, c4 = c.tid & 15, n = nt * 64 + 4 * c4;
#pragma unroll
          for (int i = 0; i < 2; ++i) { const int k = kt * 64 + r + 32 * i; f32x4 v = {0.f, 0.f, 0.f, 0.f}; if (n < N) v = *(const f32x4*)(src + (size_t)k * N + n);
              LAS float* tp = tile + (r + 32 * i) * 65 + 4 * c4; tp[0] = v[0]; tp[1] = v[1]; tp[2] = v[2]; tp[3] = v[3]; } }
        __syncthreads();
        { const int n = c.tid >> 3, kq = c.tid & 7; float v[8];
#pragma unroll
          for (int j = 0; j < 8; ++j) v[j] = tile[(kq * 8 + j) * 65 + n];
          u32x4 o; o[0] = cvt_pk_bf16(v[0], v[1]); o[1] = cvt_pk_bf16(v[2], v[3]); o[2] = cvt_pk_bf16(v[4], v[5]); o[3] = cvt_pk_bf16(v[6], v[7]);
          *(u32x4*)(dst + (size_t)(nt * 64 + n) * K + kt * 64 + kq * 8) = o; }
        __syncthreads();
    }
}
__device__ __forceinline__ void conv_E(const float* src, bf16_t* dst, size_t n8, const Ctx& c) {
    const size_t stride = (size_t)c.nb * NTHREADS;
    for (size_t i = (size_t)c.bid * NTHREADS + c.tid; i < n8; i += stride) {
        const f32x4 x = *(const f32x4*)(src + i * 8), y = *(const f32x4*)(src + i * 8 + 4);
        *(u32x4*)(dst + i * 8) = pack8(x, y);
    }
}
__device__ __forceinline__ int t5_bucket(int n) {
    if (n < 16) return n;
    const float scaled = logf((float)n / 16.f) / logf(64.f);
    const int large = 16 + (int)(scaled * 16.f);
    return large < 31 ? large : 31;
}
__device__ __forceinline__ void p0_tb(const Args& a, const Ctx& c) {
    float* tb = (float*)(a.ws + WS_TB); const float* rb = a.in[26];
    for (int i = c.bid * NTHREADS + c.tid; i < 8 * TBN; i += c.nb * NTHREADS) { const int head = i / TBN, dist = i % TBN; tb[i] = rb[t5_bucket(dist) * 8 + head] * LOG2E; }
}
__device__ __forceinline__ void p0_bpe(const Args& a, const Ctx& c, int kv) {
    const float* pe = a.in[kv ? 23 : 20]; const float* w1 = a.in[kv ? 24 : 21]; float* bpe = (float*)(a.ws + WS_BPE) + kv * 256;
    LAS float* red = (LAS float*)c.lds;
    const int n = c.tid & 255, half = c.tid >> 8; float s = 0.f;
#pragma unroll 8
    for (int k = half * 2048; k < half * 2048 + 2048; ++k) s += pe[k] * w1[(size_t)k * 256 + n];
    red[c.tid] = s; __syncthreads();
    if (c.tid < 256) bpe[n] = red[c.tid] + red[c.tid + 256];
    __syncthreads();
}
__device__ __forceinline__ void p0_s5(const Args& a, const Ctx& c, int g) {
    LAS float* ar = (LAS float*)c.lds;
    LAS float* ai = ar + 17 * 64;
    LAS float* bbr = ai + 17 * 64;
    LAS float* bbi = bbr + 1024;
    LAS float* cr = bbi + 1024;
    LAS float* ci = cr + 1024;
    LAS float* kd = ci + 1024;
    const int tid = c.tid;
    if (tid < 64) {
        const int p = tid; const float dt = expf(a.in[12][g]); const float lr = a.in[10][g * 64 + p], li = a.in[11][g * 64 + p];
        for (int d = 0; d <= 16; ++d) { const float mag = expf(lr * dt * (float)d), ang = li * dt * (float)d; ar[d * 64 + p] = mag * cosf(ang); ai[d * 64 + p] = mag * sinf(ang); }
        const float nr = ar[64 + p] - 1.f, ni = ai[64 + p], den = lr * lr + li * li;
        const float wre = (nr * lr + ni * li) / den, wim = (ni * lr - nr * li) / den;
        for (int h = 0; h < 16; ++h) { const float br = a.in[13][(g * 64 + p) * 16 + h], bi = a.in[14][(g * 64 + p) * 16 + h]; bbr[p * 16 + h] = wre * br - wim * bi; bbi[p * 16 + h] = wre * bi + wim * br; }
        float* s5p = (float*)(a.ws + WS_S5P);
        float xr = ar[16 * 64 + p], xi = ai[16 * 64 + p];
        s5p[(g * 64 + p) * 2] = xr; s5p[(g * 64 + p) * 2 + 1] = xi;
        for (int s = 0; s < 8; ++s) { const float tr = xr * xr - xi * xi, ti = 2.f * xr * xi; xr = tr; xi = ti; }
        s5p[64 * 64 * 2 + (g * 64 + p) * 2] = xr; s5p[64 * 64 * 2 + (g * 64 + p) * 2 + 1] = xi;
    }
    for (int e = tid; e < 1024; e += NTHREADS) { cr[e] = a.in[15][g * 1024 + e]; ci[e] = a.in[16][g * 1024 + e]; }
    __syncthreads();
    for (int e = tid; e < 4096; e += NTHREADS) {
        const int d = e >> 8, h1 = (e >> 4) & 15, h = e & 15; float s = 0.f;
        for (int p = 0; p < 64; ++p) { const float Cr = cr[h1 * 64 + p], Ci = ci[h1 * 64 + p], Ar = ar[d * 64 + p], Ai = ai[d * 64 + p];
            const float Gr = Cr * Ar - Ci * Ai, Gi = Cr * Ai + Ci * Ar; s += Gr * bbr[p * 16 + h] - Gi * bbi[p * 16 + h]; }
        if (d == 0 && h1 == h) s += a.in[17][g * 16 + h];
        kd[e] = s;
    }
    __syncthreads();
    bf16_t* MT = (bf16_t*)(a.ws + WS_S5MT) + (size_t)g * 65536;
    bf16_t* WE = (bf16_t*)(a.ws + WS_S5WE) + (size_t)g * 32768;
    bf16_t* WC = (bf16_t*)(a.ws + WS_S5WC) + (size_t)g * 32768;
    for (int e = tid; e < 65536; e += NTHREADS) { const int n = e >> 8, k = e & 255, j = n >> 4, h1 = n & 15, i = k >> 4, h = k & 15;
        MT[e] = f2bf(i <= j ? kd[(j - i) * 256 + h1 * 16 + h] : 0.f); }
    for (int e = tid; e < 32768; e += NTHREADS) { const int n = e >> 8, k = e & 255, cc = n >> 6, p = n & 63, i = k >> 4, h = k & 15;
        const float Ar = ar[(15 - i) * 64 + p], Ai = ai[(15 - i) * 64 + p], Br = bbr[p * 16 + h], Bi = bbi[p * 16 + h];
        WE[e] = f2bf(cc ? (Ar * Bi + Ai * Br) : (Ar * Br - Ai * Bi)); }
    for (int e = tid; e < 32768; e += NTHREADS) { const int n = e >> 7, k = e & 127, j = n >> 4, h1 = n & 15, cc = k >> 6, p = k & 63;
        const float Cr = cr[h1 * 64 + p], Ci = ci[h1 * 64 + p], Ar = ar[(j + 1) * 64 + p], Ai = ai[(j + 1) * 64 + p];
        WC[e] = f2bf(cc ? -(Cr * Ai + Ci * Ar) : (Cr * Ar - Ci * Ai)); }
    __syncthreads();
}
__device__ __forceinline__ void p0_prologue(const Args& a, const Ctx& c) {
    for (int g = c.bid; g < 64; g += c.nb) p0_s5(a, c, g);
    for (int u = 0; u < 2; ++u) if (c.bid == (64 + u) % c.nb) p0_bpe(a, c, u);
    p0_tb(a, c);
    p0_cond(a, c);
    conv_T(a.in[6], 2048, DIN, (bf16_t*)(a.ws + WS_WIN), DIN_PAD, c);
    conv_T(a.in[18], 1024, 1024, (bf16_t*)(a.ws + WS_WGLU), 1024, c);
    conv_T(a.in[7], 2048, 2048, (bf16_t*)(a.ws + WS_WOUT), 2048, c);
    conv_T(a.in[27], 2048, 2048, (bf16_t*)(a.ws + WS_WQ), 2048, c);
    conv_T(a.in[21], 4096, 256, (bf16_t*)(a.ws + WS_W1), 256, c);
    conv_T(a.in[24], 4096, 256, (bf16_t*)(a.ws + WS_W1) + 256 * 4096, 256, c);
    conv_T(a.in[22], 256, 128, (bf16_t*)(a.ws + WS_W2), 128, c);
    conv_T(a.in[25], 256, 128, (bf16_t*)(a.ws + WS_W2) + 128 * 256, 128, c);
    conv_E(a.in[28], (bf16_t*)(a.ws + WS_PK), 128 * 128 / 8, c);
    conv_E(a.in[29], (bf16_t*)(a.ws + WS_PK) + 128 * 128, 128 * 128 / 8, c);
    conv_E(a.in[30], (bf16_t*)(a.ws + WS_PU), (size_t)16384 * 2048 / 8, c);
    conv_E(a.in[31], (bf16_t*)(a.ws + WS_PV), (size_t)16384 * 2048 / 8, c);
}

__device__ __forceinline__ void norm_rows(const float* X, bf16_t* O, LAS const float* Ab, LAS const float* Bb, const Ctx& c) {
    for (int t = c.bid * 8 + c.wave; t < L_; t += c.nb * 8) {
        const float* xr = X + (size_t)t * 2048 + c.lane * 4;
        f32x4 v[8]; float ss = 0.f;
#pragma unroll
        for (int j = 0; j < 8; ++j) { v[j] = *(const f32x4*)(xr + j * 256); ss += v[j][0] * v[j][0] + v[j][1] * v[j][1] + v[j][2] * v[j][2] + v[j][3] * v[j][3]; }
        ss = wave_sum(ss);
        const float rstd = rsqrtf(ss * (1.f / 2048.f) + 1e-6f);
#pragma unroll
        for (int j = 0; j < 8; ++j) {
            const int col = j * 256 + c.lane * 4;
            const f32x4 A = *(const LAS f32x4*)(Ab + col), B = *(const LAS f32x4*)(Bb + col);
            const f32x4 o = v[j] * rstd * A + B;
            u32x2 w; w[0] = cvt_pk_bf16(o[0], o[1]); w[1] = cvt_pk_bf16(o[2], o[3]);
            *(u32x2*)(O + (size_t)t * 2048 + col) = w;
        }
    }
}
__device__ __forceinline__ float cond_from_partials(const float* condp, const float* b_ada, int j) {
    float s = b_ada[j];
#pragma unroll 8
    for (int k = 0; k < 32; ++k) s += condp[(size_t)k * NADA + j];
    return s;
}
__device__ __forceinline__ void p1_hnorm(const Args& a, const Ctx& c) {
    const float* condp = (const float*)(a.ws + WS_CONDP); float* cond = (float*)(a.ws + WS_COND);
    for (int j = c.bid * NTHREADS + c.tid; j < NADA; j += c.nb * NTHREADS) cond[j] = cond_from_partials(condp, a.in[3], j);
    LAS float* Ab = (LAS float*)c.lds; LAS float* Bb = Ab + 2048;
    for (int col = c.tid; col < 2048; col += NTHREADS) {
        Ab[col] = a.in[4][col] * (1.f + cond_from_partials(condp, a.in[3], 2048 + col)); Bb[col] = cond_from_partials(condp, a.in[3], col); }
    __syncthreads();
    norm_rows(a.in[0], (bf16_t*)(a.ws + WS_H), Ab, Bb, c);
}
__device__ __forceinline__ void p8_h2norm(const Args& a, const Ctx& c) {
    const float* cond = (const float*)(a.ws + WS_COND);
    LAS float* Ab = (LAS float*)c.lds; LAS float* Bb = Ab + 2048;
    for (int col = c.tid; col < 2048; col += NTHREADS) { Ab[col] = a.in[5][col] * (1.f + cond[4 * 2048 + col]); Bb[col] = cond[3 * 2048 + col]; }
    __syncthreads();
    norm_rows(a.out, (bf16_t*)(a.ws + WS_H), Ab, Bb, c);
}
__device__ __forceinline__ void p6_mixnorm(const Args& a, const Ctx& c) {
    const bf16_t* YS = (const bf16_t*)(a.ws + WS_YSSM); const bf16_t* YA = (const bf16_t*)(a.ws + WS_YATT); bf16_t* O = (bf16_t*)(a.ws + WS_H);
    for (int t = c.bid * 8 + c.wave; t < L_; t += c.nb * 8) {
#pragma unroll
        for (int part = 0; part < 2; ++part) {
            const bf16_t* src = (part ? YA : YS) + (size_t)t * 1024 + c.lane * 8; const float* beta = a.in[part ? 9 : 8];
            u32x4 w[2]; float f[16]; float ss = 0.f;
#pragma unroll
            for (int j = 0; j < 2; ++j) { w[j] = *(const u32x4*)(src + j * 512);
#pragma unroll
                for (int e = 0; e < 4; ++e) { f[j * 8 + 2 * e] = bflo(w[j][e]); f[j * 8 + 2 * e + 1] = bfhi(w[j][e]); } }
#pragma unroll
            for (int e = 0; e < 16; ++e) ss += f[e] * f[e];
            ss = wave_sum(ss);
            const float rstd = rsqrtf(ss * (1.f / 1024.f) + 1e-6f);
#pragma unroll
            for (int j = 0; j < 2; ++j) { const int col = j * 512 + c.lane * 8; const f32x4 b0 = *(const f32x4*)(beta + col), b1 = *(const f32x4*)(beta + col + 4);
                f32x4 o0, o1;
#pragma unroll
                for (int e = 0; e < 4; ++e) { o0[e] = f[j * 8 + e] * rstd * b0[e]; o1[e] = f[j * 8 + 4 + e] * rstd * b1[e]; }
                *(u32x4*)(O + (size_t)t * 2048 + part * 1024 + col) = pack8(o0, o1); }
        }
    }
}
constexpr int S5_US = 0, S5_ES = 33792, S5_SS = 67584;
template <int PASS>
__device__ __forceinline__ void s5_item(const Args& a, const Ctx& c, int g, int seg) {
    LAS unsigned char* lds = c.lds;
    const int tid = c.tid, wave = c.wave, lane = c.lane, r = lane & 15, q = lane >> 4;
    const bf16_t* U = (const bf16_t*)(a.ws + WS_US);
    const bf16_t* MT = (const bf16_t*)(a.ws + WS_S5MT) + (size_t)g * 65536;
    const bf16_t* WE = (const bf16_t*)(a.ws + WS_S5WE) + (size_t)g * 32768;
    const bf16_t* WC = (const bf16_t*)(a.ws + WS_S5WC) + (size_t)g * 32768;
    const float* s5p = (const float*)(a.ws + WS_S5P);
    float* F = (float*)(a.ws + WS_S5F) + (size_t)g * 4 * 128;
    bf16_t* Z = (bf16_t*)(a.ws + WS_Z);
    bf16x8 bE[8];
#pragma unroll
    for (int ks = 0; ks < 8; ++ks) bE[ks] = *(const bf16x8*)(WE + (size_t)(16 * wave + r) * 256 + 32 * ks + 8 * q);
    float sr = 0.f, si = 0.f, a16r = 0.f, a16i = 0.f;
    if (wave == 0) {
        a16r = s5p[(g * 64 + lane) * 2]; a16i = s5p[(g * 64 + lane) * 2 + 1];
        if (PASS == 1) { const float br = s5p[8192 + (g * 64 + lane) * 2], bi = s5p[8192 + (g * 64 + lane) * 2 + 1];
            for (int s = 0; s < seg; ++s) { const float fr_ = F[s * 128 + lane], fi_ = F[s * 128 + 64 + lane]; const float nr = br * sr - bi * si + fr_, ni = br * si + bi * sr + fi_; sr = nr; si = ni; } }
    }
    for (int sb = 0; sb < 4; ++sb) {
        const int tok0 = seg * 4096 + sb * 1024;
#pragma unroll
        for (int i = 0; i < 4; ++i) { const int ch = tid + NTHREADS * i, token = ch >> 1, half = ch & 1;
            const u32x4 v = *(const u32x4*)(U + (size_t)(tok0 + token) * 1024 + g * 16 + half * 8);
            *(LAS u32x4*)(lds + S5_US + (token >> 4) * 528 + ((token & 15) * 16 + half * 8) * 2) = v; }
        __syncthreads();
#pragma unroll
        for (int m = 0; m < 4; ++m) {
            f32x4 acc = {0.f, 0.f, 0.f, 0.f};
#pragma unroll
            for (int ks = 0; ks < 8; ++ks) { const bf16x8 A = *(const LAS bf16x8*)(lds + S5_US + (16 * m + r) * 528 + (32 * ks + 8 * q) * 2); acc = mfma16(A, bE[ks], acc); }
#pragma unroll
            for (int i = 0; i < 4; ++i) *(LAS float*)(lds + S5_ES + ((16 * m + 4 * q + i) * 132 + 16 * wave + r) * 4) = acc[i];
        }
        __syncthreads();
        if (wave == 0) {
            for (int ch = 0; ch < 64; ++ch) {
                const float er = *(const LAS float*)(lds + S5_ES + (ch * 132 + lane) * 4), ei = *(const LAS float*)(lds + S5_ES + (ch * 132 + 64 + lane) * 4);
                if (PASS == 1) { *(LAS bf16_t*)(lds + S5_SS + (ch * 136 + lane) * 2) = f2bf(sr); *(LAS bf16_t*)(lds + S5_SS + (ch * 136 + 64 + lane) * 2) = f2bf(si); }
                const float nr = a16r * sr - a16i * si + er, ni = a16r * si + a16i * sr + ei; sr = nr; si = ni;
            }
        }
        __syncthreads();
        if (PASS == 1) {
#pragma unroll
            for (int nt = 0; nt < 2; ++nt) {
                const int j = 2 * wave + nt;
                f32x4 acc[4];
#pragma unroll
                for (int m = 0; m < 4; ++m) acc[m] = (f32x4){0.f, 0.f, 0.f, 0.f};
                for (int ks = 0; ks <= (j >> 1); ++ks) {
                    const bf16x8 B = *(const bf16x8*)(MT + (size_t)(16 * j + r) * 256 + 32 * ks + 8 * q);
#pragma unroll
                    for (int m = 0; m < 4; ++m) { const bf16x8 A = *(const LAS bf16x8*)(lds + S5_US + (16 * m + r) * 528 + (32 * ks + 8 * q) * 2); acc[m] = mfma16(A, B, acc[m]); }
                }
#pragma unroll
                for (int ks = 0; ks < 4; ++ks) {
                    const bf16x8 B = *(const bf16x8*)(WC + (size_t)(16 * j + r) * 128 + 32 * ks + 8 * q);
#pragma unroll
                    for (int m = 0; m < 4; ++m) { const bf16x8 A = *(const LAS bf16x8*)(lds + S5_SS + (16 * m + r) * 272 + (32 * ks + 8 * q) * 2); acc[m] = mfma16(A, B, acc[m]); }
                }
#pragma unroll
                for (int m = 0; m < 4; ++m)
#pragma unroll
                    for (int i = 0; i < 4; ++i) { const int ch = 16 * m + 4 * q + i; Z[(size_t)(tok0 + 16 * ch + j) * 1024 + g * 16 + r] = f2bf(gelu_tanh(acc[m][i])); }
            }
            __syncthreads();
        }
    }
    if (PASS == 0 && wave == 0) { F[seg * 128 + lane] = sr; F[seg * 128 + 64 + lane] = si; }
}

__device__ __forceinline__ void cmp_finish_item(const Args& a, const Ctx& c, int kvsel, int rt) {
    LAS unsigned char* lds = c.lds;
    const int tid = c.tid, wave = c.wave, lane = c.lane, r = lane & 15, q = lane >> 4;
    const float* SL = (const float*)(a.ws + WS_SLAB) + (size_t)kvsel * 4 * 2048 * 256;
    const float* bpe = (const float*)(a.ws + WS_BPE) + kvsel * 256;
    const bf16_t* W2 = (const bf16_t*)(a.ws + WS_W2) + kvsel * 128 * 256;
    for (int e = tid; e < 64 * 64; e += NTHREADS) {
        const int row = e >> 6, c4 = (e & 63) * 4;
        f32x4 s = *(const f32x4*)(bpe + c4);
#pragma unroll
        for (int ks = 0; ks < 4; ++ks) s += *(const f32x4*)(SL + ((size_t)ks * 2048 + rt * 64 + row) * 256 + c4);
        u32x2 w; w[0] = cvt_pk_bf16(gelu_tanh(s[0]), gelu_tanh(s[1])); w[1] = cvt_pk_bf16(gelu_tanh(s[2]), gelu_tanh(s[3]));
        *(LAS u32x2*)(lds + row * 528 + c4 * 2) = w;
    }
    __syncthreads();
    bf16x8 B[8];
#pragma unroll
    for (int ks = 0; ks < 8; ++ks) B[ks] = *(const bf16x8*)(W2 + (size_t)(16 * wave + r) * 256 + 32 * ks + 8 * q);
#pragma unroll
    for (int m = 0; m < 4; ++m) {
        f32x4 acc = {0.f, 0.f, 0.f, 0.f};
#pragma unroll
        for (int ks = 0; ks < 8; ++ks) { const bf16x8 A = *(const LAS bf16x8*)(lds + (16 * m + r) * 528 + (32 * ks + 8 * q) * 2); acc = mfma16(A, B[ks], acc); }
#pragma unroll
        for (int i = 0; i < 4; ++i) {
            const int row = rt * 64 + 16 * m + 4 * q + i, gi = row >> 10, ci = row & 1023, n = 16 * wave + r;
            const bf16_t v = (ci == 1023) ? (bf16_t)0 : f2bf(acc[i]);
            if (kvsel == 0) ((bf16_t*)(a.ws + WS_KC))[((size_t)gi * 1024 + ci) * 128 + n] = v;
            else ((bf16_t*)(a.ws + WS_VCT))[((size_t)gi * 128 + n) * 1024 + ci] = v;
        }
    }
    __syncthreads();
}
constexpr int AT_KB = 0, AT_VB = 34816, AT_IMP = 69632, AT_TB = 135168, AT_BM = 147968, AT_WU = 150016, AT_END = 150272;
constexpr int AT_KBUF = 64 * 272, AT_VBUF = 128 * 136;
struct TileRegs { u32x4 k[2]; u32x4 v[2]; };
template <bool NEEDV>
__device__ __forceinline__ void tile_load(TileRegs& R, const bf16_t* Kt, const bf16_t* Vt, int ldv, int tid) {
#pragma unroll
    for (int i = 0; i < 2; ++i) { const int ch = tid + NTHREADS * i; R.k[i] = *(const u32x4*)(Kt + (ch >> 4) * 128 + (ch & 15) * 8); }
    if (NEEDV) {
#pragma unroll
        for (int i = 0; i < 2; ++i) { const int ch = tid + NTHREADS * i; R.v[i] = *(const u32x4*)(Vt + (size_t)(ch >> 3) * ldv + (ch & 7) * 8); }
    }
}
template <bool NEEDV>
__device__ __forceinline__ void tile_store(const TileRegs& R, LAS unsigned char* kb, LAS unsigned char* vb, int tid) {
#pragma unroll
    for (int i = 0; i < 2; ++i) { const int ch = tid + NTHREADS * i; *(LAS u32x4*)(kb + (ch >> 4) * 272 + (ch & 15) * 16) = R.k[i]; }
    if (NEEDV) {
#pragma unroll
        for (int i = 0; i < 2; ++i) { const int ch = tid + NTHREADS * i; LAS unsigned char* p = vb + (ch >> 3) * 136 + (ch & 7) * 16;
            *(LAS u32x2*)p = (u32x2){R.v[i][0], R.v[i][1]}; *(LAS u32x2*)(p + 8) = (u32x2){R.v[i][2], R.v[i][3]}; }
    }
}
template <int BR>
__device__ __forceinline__ void attn_tile(LAS const unsigned char* kb, LAS const unsigned char* vb, LAS const float* tb, int key0, int t, int lane,
                                          const bf16x8 (&qf)[8], f32x16 (&O)[4], float& m, float& l, float inv_l, bool selbit, LAS float* imp_row) {
    const int r31 = lane & 31, h = lane >> 5;
#pragma unroll
    for (int sub = 0; sub < 2; ++sub) {
        f32x16 S;
#pragma unroll
        for (int r = 0; r < 16; ++r) S[r] = 0.f;
#pragma unroll
        for (int ks = 0; ks < 8; ++ks) { const bf16x8 A = *(const LAS bf16x8*)(kb + (sub * 32 + r31) * 272 + ks * 32 + h * 16); S = mfma32(A, qf[ks], S); }
        float mx = -INFINITY;
#pragma unroll
        for (int r = 0; r < 16; ++r) {
            const int kk = key0 + sub * 32 + (r & 3) + 8 * (r >> 2) + 4 * h;
            int dist; bool valid;
            if (BR <= 1) { dist = t - (16 * kk + 31); valid = dist >= 0; }
            else if (BR == 2) { dist = t - kk; valid = selbit && dist >= 0; }
            else { dist = t - kk; valid = dist >= 0 && dist < 512; }
            const int idx = min(max(dist, 0), TBN - 1);
            const float v = valid ? S[r] + tb[idx] : -INFINITY;
            S[r] = v; mx = fmaxf(mx, v);
        }
        if (BR != 1) {
            mx = fmaxf(mx, shfl_xor_f(mx, 32));
            const float mn = fmaxf(m, mx), mu = (mn == -INFINITY) ? 0.f : mn;
            float ps = 0.f;
#pragma unroll
            for (int r = 0; r < 16; ++r) { const float p = fexp2(S[r] - mu); S[r] = p; ps += p; }
            if (__any(mn > m)) {
                const float alpha = fexp2(m - mu);
                l *= alpha;
                if (BR >= 2) {
#pragma unroll
                    for (int dt = 0; dt < 4; ++dt)
#pragma unroll
                        for (int r = 0; r < 16; ++r) O[dt][r] *= alpha;
                }
            }
            l += ps; m = mn;
        } else {
            const float mu = (m == -INFINITY) ? 0.f : m;
#pragma unroll
            for (int r = 0; r < 16; ++r) S[r] = fexp2(S[r] - mu) * inv_l;
#pragma unroll
            for (int rg = 0; rg < 4; ++rg) {
                float A = 2.f * (S[4 * rg] + S[4 * rg + 1] + S[4 * rg + 2]) + S[4 * rg + 3], B = S[4 * rg + 3];
                A = quad_sum(A); B = quad_sum(B);
                const int jj = ((key0 + sub * 32) >> 2) + 2 * rg + h;
                if ((lane & 3) == 0) {
                    __hip_atomic_fetch_add(imp_row + jj, A, __ATOMIC_RELAXED, __HIP_MEMORY_SCOPE_WORKGROUP);
                    if (jj + 1 < 256) __hip_atomic_fetch_add(imp_row + jj + 1, B, __ATOMIC_RELAXED, __HIP_MEMORY_SCOPE_WORKGROUP);
                }
            }
        }
        if (BR >= 1) {
#pragma unroll
            for (int s1 = 0; s1 < 2; ++s1) {
                const int s = 2 * sub + s1;
                u32x4 pk;
#pragma unroll
                for (int e = 0; e < 4; ++e) pk[e] = cvt_pk_bf16(S[8 * s1 + 2 * e], S[8 * s1 + 2 * e + 1]);
                const bf16x8 pf = __builtin_bit_cast(bf16x8, pk);
#pragma unroll
                for (int dt = 0; dt < 4; ++dt) {
                    LAS const unsigned char* vp = vb + (32 * dt + r31) * 136 + (16 * s + 4 * h) * 2;
                    const u32x2 lo = *(const LAS u32x2*)vp, hi = *(const LAS u32x2*)(vp + 16);
                    const u32x4 av = {lo[0], lo[1], hi[0], hi[1]};
                    O[dt] = mfma32(__builtin_bit_cast(bf16x8, av), pf, O[dt]);
                }
            }
        }
    }
}
template <int BR>
__device__ __forceinline__ void run_branch(const Ctx& c, const bf16_t* Kb, const bf16_t* Vtb, int ldv, int lo, int hi, LAS const float* tb, int t,
                                           const bf16x8 (&qf)[8], f32x16 (&O)[4], float& m, float& l, float inv_l, int tl, LAS float* imp_row) {
    constexpr bool NEEDV = (BR != 0);
    LAS unsigned char* lds = c.lds;
    TileRegs R;
    int tidz = c.tid; asm volatile("" : "+v"(tidz));
    tile_load<NEEDV>(R, Kb + (size_t)lo * 64 * 128, Vtb + (size_t)lo * 64, ldv, tidz);
    tile_store<NEEDV>(R, lds + AT_KB, lds + AT_VB, tidz);
    __syncthreads();
    for (int j = lo; j < hi; ++j) {
        const int buf = (j - lo) & 1;
        if (j + 1 < hi) tile_load<NEEDV>(R, Kb + (size_t)(j + 1) * 64 * 128, Vtb + (size_t)(j + 1) * 64, ldv, tidz);
        bool selbit = true, wave_on = true;
        if (BR == 2) {
            const unsigned w = *(const LAS unsigned*)(lds + AT_BM + (tl * 8 + (j >> 5)) * 4);
            selbit = (w >> (j & 31)) & 1u;
            const unsigned wu = *(const LAS unsigned*)(lds + AT_WU + (c.wave * 8 + (j >> 5)) * 4);
            wave_on = (wu >> (j & 31)) & 1u;
        }
        if (wave_on) attn_tile<BR>(lds + AT_KB + buf * AT_KBUF, lds + AT_VB + buf * AT_VBUF, tb, j * 64, t, c.lane, qf, O, m, l, inv_l, selbit, imp_row);
        if (j + 1 < hi) tile_store<NEEDV>(R, lds + AT_KB + (buf ^ 1) * AT_KBUF, lds + AT_VB + (buf ^ 1) * AT_VBUF, tidz);
        __syncthreads();
    }
}
__device__ __forceinline__ void attn_item(const Args& a, const Ctx& c, int qt, int g) {
    LAS unsigned char* lds = c.lds;
    const int tid = c.tid, wave = c.wave, lane = c.lane, r31 = lane & 31, h = lane >> 5, hl = lane & 3;
    const int t0 = qt * 64, tl = 8 * wave + (r31 >> 2), t = t0 + tl, head = g * 4 + hl;
    const bf16_t* Qb = (const bf16_t*)(a.ws + WS_Q);
    const bf16_t* KROW = (const bf16_t*)(a.ws + WS_KROW);
    const bf16_t* VT = (const bf16_t*)(a.ws + WS_VT);
    const float* GATE = (const float*)(a.ws + WS_GATE);
    { const float* tbg = (const float*)(a.ws + WS_TB) + g * 4 * TBN;
      for (int i = tid; i < 4 * TBN; i += NTHREADS) *(LAS float*)(lds + AT_TB + i * 4) = tbg[i];
      for (int i = tid; i < 64 * 256; i += NTHREADS) *(LAS float*)(lds + AT_IMP + i * 4) = 0.f; }
    bf16x8 qf[8];
#pragma unroll
    for (int ks = 0; ks < 8; ++ks) qf[ks] = *(const bf16x8*)(Qb + (size_t)t * 1024 + head * 128 + 16 * ks + 8 * h);
    LAS const float* tb = (LAS const float*)(lds + AT_TB) + hl * TBN;
    LAS float* imp_row = (LAS float*)(lds + AT_IMP) + tl * 256;
    f32x16 O[4]; unsigned Otp[4][8];
#pragma unroll
    for (int dt = 0; dt < 4; ++dt)
#pragma unroll
        for (int r = 0; r < 16; ++r) O[dt][r] = 0.f;
    __syncthreads();
    { const int ntile = (t0 / 16 + 3 + 63) / 64;
      const bf16_t* KC = (const bf16_t*)(a.ws + WS_KC) + (size_t)g * 1024 * 128; const bf16_t* VCT = (const bf16_t*)(a.ws + WS_VCT) + (size_t)g * 128 * 1024;
      float m = -INFINITY, l = 0.f;
      run_branch<0>(c, KC, VCT, 1024, 0, ntile, tb, t, qf, O, m, l, 0.f, tl, imp_row);
      const float lt = l + shfl_xor_f(l, 32), inv = lt > 0.f ? 1.f / lt : 0.f;
      run_branch<1>(c, KC, VCT, 1024, 0, ntile, tb, t, qf, O, m, l, inv, tl, imp_row);
      const float gc = GATE[(size_t)t * 24 + head];
#pragma unroll
      for (int dt = 0; dt < 4; ++dt)
#pragma unroll
          for (int r = 0; r < 8; ++r) { Otp[dt][r] = cvt_pk_bf16(gc * O[dt][2 * r], gc * O[dt][2 * r + 1]); O[dt][2 * r] = 0.f; O[dt][2 * r + 1] = 0.f; }
    }
    {
        unsigned wu[8];
#pragma unroll
        for (int k = 0; k < 8; ++k) wu[k] = 0u;
        const int ncand = qt - 2 > 0 ? qt - 2 : 0;
        for (int i = 0; i < 8; ++i) {
            LAS const float* row = (LAS const float*)(lds + AT_IMP) + (8 * wave + i) * 256;
            float v[4]; bool sel[4];
#pragma unroll
            for (int k = 0; k < 4; ++k) { const int j = lane + 64 * k; const bool cand = (j >= 1 && j <= qt - 2); v[k] = cand ? row[j] : -1.f; sel[k] = false; }
            if (ncand <= 13) {
#pragma unroll
                for (int k = 0; k < 4; ++k) sel[k] = v[k] >= 0.f;
            } else {
                for (int it = 0; it < 13; ++it) {
                    float mx = fmaxf(fmaxf(v[0], v[1]), fmaxf(v[2], v[3])); mx = wave_max(mx);
                    int wk = -1, wl = 0;
#pragma unroll
                    for (int k = 0; k < 4; ++k) { const unsigned long long mk = __ballot(v[k] == mx); if (wk < 0 && mk != 0ull) { wk = k; wl = __ffsll((long long)mk) - 1; } }
#pragma unroll
                    for (int k = 0; k < 4; ++k) if (k == wk && lane == wl) { v[k] = -1.f; sel[k] = true; }
                }
            }
#pragma unroll
            for (int k = 0; k < 4; ++k) {
                const int j = lane + 64 * k; const bool forced = (j == 0) || (j == qt) || (j == qt - 1);
                const unsigned long long mk = __ballot(sel[k] || forced);
                const unsigned lo = (unsigned)mk, hi = (unsigned)(mk >> 32);
                if (lane == 0) { *(LAS unsigned*)(lds + AT_BM + ((8 * wave + i) * 8 + 2 * k) * 4) = lo; *(LAS unsigned*)(lds + AT_BM + ((8 * wave + i) * 8 + 2 * k + 1) * 4) = hi; }
                wu[2 * k] |= lo; wu[2 * k + 1] |= hi;
            }
        }
        if (lane == 0) {
#pragma unroll
            for (int k = 0; k < 8; ++k) *(LAS unsigned*)(lds + AT_WU + (wave * 8 + k) * 4) = wu[k];
        }
    }
    LAS unsigned* park = (LAS unsigned*)(lds + AT_IMP + wave * 8192) + lane;
#pragma unroll
    for (int dt = 0; dt < 4; ++dt)
#pragma unroll
        for (int r = 0; r < 8; ++r) park[(dt * 8 + r) * 64] = Otp[dt][r];
    __syncthreads();
    { float m = -INFINITY, l = 0.f;
      run_branch<2>(c, KROW + (size_t)(2 + g) * L_ * 128, VT + (size_t)g * 128 * L_, L_, 0, qt + 1, tb, t, qf, O, m, l, 0.f, tl, imp_row);
      const float gs = GATE[(size_t)t * 24 + 8 + head];
      const float lt = l + shfl_xor_f(l, 32), sc = gs * (lt > 0.f ? 1.f / lt : 0.f);
#pragma unroll
      for (int dt = 0; dt < 4; ++dt)
#pragma unroll
          for (int r = 0; r < 8; ++r) { const unsigned w = park[(dt * 8 + r) * 64]; park[(dt * 8 + r) * 64] = cvt_pk_bf16(bflo(w) + sc * O[dt][2 * r], bfhi(w) + sc * O[dt][2 * r + 1]); O[dt][2 * r] = 0.f; O[dt][2 * r + 1] = 0.f; }
    }
    { float m = -INFINITY, l = 0.f;
      const int lo = qt - 8 > 0 ? qt - 8 : 0;
      run_branch<3>(c, KROW + (size_t)(4 + g) * L_ * 128, VT + (size_t)(2 + g) * 128 * L_, L_, lo, qt + 1, tb, t, qf, O, m, l, 0.f, tl, imp_row);
      const float gw = GATE[(size_t)t * 24 + 16 + head];
      const float lt = l + shfl_xor_f(l, 32), sc = gw * (lt > 0.f ? 1.f / lt : 0.f);
#pragma unroll
      for (int dt = 0; dt < 4; ++dt)
#pragma unroll
          for (int r = 0; r < 8; ++r) { const unsigned w = park[(dt * 8 + r) * 64]; Otp[dt][r] = cvt_pk_bf16(bflo(w) + sc * O[dt][2 * r], bfhi(w) + sc * O[dt][2 * r + 1]); }
    }
    bf16_t* Y = (bf16_t*)(a.ws + WS_YATT) + (size_t)t * 1024 + head * 128;
#pragma unroll
    for (int dt = 0; dt < 4; ++dt)
#pragma unroll
        for (int rg = 0; rg < 4; ++rg) {
            u32x2 w; w[0] = Otp[dt][2 * rg]; w[1] = Otp[dt][2 * rg + 1];
            *(u32x2*)(Y + 32 * dt + 8 * rg + 4 * h) = w;
        }
    __syncthreads();
}
#ifndef PEER_ALPHA
#define PEER_ALPHA 1.0f
#endif
constexpr int PE_SC = 0, PE_LV = 66048, PE_LI = 74240, PE_EX = 82432, PE_GT = 86528, PE_END = 90624;
__device__ __forceinline__ float wave_sum_bcast(float v) {
    v += dpp_f<0xB1>(v); v += dpp_f<0x4E>(v); v += dpp_f<0x141>(v); v += dpp_f<0x140>(v);
    v += __int_as_float(__builtin_amdgcn_update_dpp(0, __float_as_int(v), 0x142, 0xa, 0xf, false));
    v += __int_as_float(__builtin_amdgcn_update_dpp(0, __float_as_int(v), 0x143, 0xc, 0xf, false));
    return __int_as_float(__builtin_amdgcn_readlane(__float_as_int(v), 63));
}
__device__ __forceinline__ unsigned mono_key(float v) { const unsigned b = __float_as_uint(v); return b ^ ((b >> 31) ? 0xFFFFFFFFu : 0x80000000u); }
__device__ __forceinline__ float dot8(const u32x4& u, const u32x4& hv, float acc) {
#pragma unroll
    for (int e = 0; e < 4; ++e) { acc += bflo(u[e]) * bflo(hv[e]); acc += bfhi(u[e]) * bfhi(hv[e]); }
    return acc;
}
struct RowRegs { u32x4 u[4]; u32x4 v[4]; };
__device__ __forceinline__ void row_load(RowRegs& R, const bf16_t* PU, const bf16_t* PV, int e, int lane) {
    const bf16_t* up = PU + (size_t)e * 2048 + lane * 8; const bf16_t* vp = PV + (size_t)e * 2048 + lane * 8;
#pragma unroll
    for (int j = 0; j < 4; ++j) { R.u[j] = *(const u32x4*)(up + j * 512); R.v[j] = *(const u32x4*)(vp + j * 512); }
}
__device__ __forceinline__ void row_apply(const RowRegs& R, const u32x4 (&hp)[4], float gate, float (&acc)[32]) {
    float d = 0.f;
#pragma unroll
    for (int j = 0; j < 4; ++j) d = dot8(R.u[j], hp[j], d);
    d = wave_sum(d);
    const float w = gate * gelu_tanh(d);
#pragma unroll
    for (int j = 0; j < 4; ++j)
#pragma unroll
        for (int e = 0; e < 4; ++e) { acc[j * 8 + 2 * e] += w * bflo(R.v[j][e]); acc[j * 8 + 2 * e + 1] += w * bfhi(R.v[j][e]); }
}
__device__ __forceinline__ void peer_step(const Args& a, const Ctx& c, int t0) {
    LAS unsigned char* lds = c.lds;
    const int tid = c.tid, wave = c.wave, lane = c.lane, r = lane & 15, q = lane >> 4;
    const bf16_t* QP = (const bf16_t*)(a.ws + WS_QP); const bf16_t* PK = (const bf16_t*)(a.ws + WS_PK);
    const bf16_t* PU = (const bf16_t*)(a.ws + WS_PU); const bf16_t* PV = (const bf16_t*)(a.ws + WS_PV);
    const bf16_t* HB = (const bf16_t*)(a.ws + WS_H);
    {
        const int hh = wave;
#pragma unroll
        for (int cc = 0; cc < 2; ++cc) {
            bf16x8 aF[4];
#pragma unroll
            for (int ks = 0; ks < 4; ++ks) aF[ks] = *(const bf16x8*)(QP + (size_t)(t0 + (r & 7)) * 2048 + hh * 256 + cc * 128 + 32 * ks + 8 * q);
#pragma unroll 2
            for (int nt = 0; nt < 8; ++nt) {
                f32x4 acc = {0.f, 0.f, 0.f, 0.f};
#pragma unroll
                for (int ks = 0; ks < 4; ++ks) { const bf16x8 B = *(const bf16x8*)(PK + (size_t)(cc * 128 + 16 * nt + r) * 128 + 32 * ks + 8 * q); acc = mfma16(aF[ks], B, acc); }
                if (q < 2) {
#pragma unroll
                    for (int i = 0; i < 4; ++i) { const int tok = 4 * q + i; *(LAS float*)(lds + PE_SC + ((tok * 16 + hh * 2 + cc) * 129 + 16 * nt + r) * 4) = acc[i]; }
                }
            }
        }
    }
    __syncthreads();
    if (tid < 128) {
        LAS const float* sc = (LAS const float*)(lds + PE_SC) + tid * 129;
        unsigned top[16];
#pragma unroll
        for (int e = 0; e < 16; ++e) top[e] = 0u;
#pragma unroll 2
        for (int k = 0; k < 128; ++k) {
            unsigned key = (mono_key(sc[k]) & ~0x7Fu) | (unsigned)(127 - k);
#pragma unroll
            for (int e = 0; e < 16; ++e) { const unsigned hi = max(top[e], key); key = min(top[e], key); top[e] = hi; }
        }
#pragma unroll
        for (int e = 0; e < 16; ++e) { const int idx = 127 - (int)(top[e] & 0x7Fu); *(LAS float*)(lds + PE_LV + (tid * 16 + e) * 4) = sc[idx]; *(LAS int*)(lds + PE_LI + (tid * 16 + e) * 4) = idx; }
    }
    __syncthreads();
    if (tid < 64) {
        const int tok = tid >> 3, hh = tid & 7, t1 = tok * 16 + hh * 2, t2 = t1 + 1;
        float v1[16], v2[16];
#pragma unroll
        for (int e = 0; e < 16; ++e) { v1[e] = *(const LAS float*)(lds + PE_LV + (t1 * 16 + e) * 4); v2[e] = *(const LAS float*)(lds + PE_LV + (t2 * 16 + e) * 4); }
        unsigned top[16];
#pragma unroll
        for (int e = 0; e < 16; ++e) top[e] = 0u;
#pragma unroll
        for (int aa = 0; aa < 16; ++aa)
#pragma unroll
            for (int bb = 0; bb < 16; ++bb)
                if ((aa + 1) * (bb + 1) <= 16) {
                    unsigned key = (mono_key(v1[aa] + v2[bb]) & ~0xFFu) | (unsigned)(255 - (aa * 16 + bb));
#pragma unroll
                    for (int e = 0; e < 16; ++e) { const unsigned hi = max(top[e], key); key = min(top[e], key); top[e] = hi; }
                }
        float sv[16]; int ex[16]; float mx = -INFINITY;
#pragma unroll
        for (int e = 0; e < 16; ++e) {
            const int id = 255 - (int)(top[e] & 0xFFu), aa = id >> 4, bb = id & 15;
            sv[e] = *(const LAS float*)(lds + PE_LV + (t1 * 16 + aa) * 4) + *(const LAS float*)(lds + PE_LV + (t2 * 16 + bb) * 4);
            ex[e] = *(const LAS int*)(lds + PE_LI + (t1 * 16 + aa) * 4) * 128 + *(const LAS int*)(lds + PE_LI + (t2 * 16 + bb) * 4);
            mx = fmaxf(mx, sv[e]);
        }
        float sum = 0.f;
#pragma unroll
        for (int e = 0; e < 16; ++e) { sv[e] = fexp2((sv[e] - mx) * LOG2E); sum += sv[e]; }
        const float inv = 1.f / sum;
#pragma unroll
        for (int e = 0; e < 16; ++e) { *(LAS int*)(lds + PE_EX + (tok * 128 + hh * 16 + e) * 4) = ex[e]; *(LAS float*)(lds + PE_GT + (tok * 128 + hh * 16 + e) * 4) = sv[e] * inv; }
    }
    __syncthreads();
    const int t = t0 + wave;
    u32x4 hp[4];
#pragma unroll
    for (int j = 0; j < 4; ++j) hp[j] = *(const u32x4*)(HB + (size_t)t * 2048 + j * 512 + lane * 8);
    float acc[32];
#pragma unroll
    for (int e = 0; e < 32; ++e) acc[e] = 0.f;
    {
        LAS const int* exl = (LAS const int*)(lds + PE_EX) + wave * 128; LAS const float* gtl = (LAS const float*)(lds + PE_GT) + wave * 128;
        RowRegs RA, RB;
        row_load(RA, PU, PV, __builtin_amdgcn_readfirstlane(exl[0]), lane);
#pragma unroll 1
        for (int e = 0; e < 128; e += 2) {
            row_load(RB, PU, PV, __builtin_amdgcn_readfirstlane(exl[e + 1]), lane);
            row_apply(RA, hp, gtl[e], acc);
            if (e + 2 < 128) row_load(RA, PU, PV, __builtin_amdgcn_readfirstlane(exl[e + 2]), lane);
            row_apply(RB, hp, gtl[e + 1], acc);
        }
    }
    {
        float* xo = a.out + (size_t)t * 2048; const float* g2 = (const float*)(a.ws + WS_COND) + 5 * 2048; const float* fg = a.in[32];
        float ss = 0.f;
#pragma unroll
        for (int j = 0; j < 4; ++j)
#pragma unroll
            for (int hf = 0; hf < 2; ++hf) {
                const int col = j * 512 + lane * 8 + hf * 4;
                const f32x4 x1 = *(const f32x4*)(xo + col), gv = *(const f32x4*)(g2 + col);
#pragma unroll
                for (int e = 0; e < 4; ++e) { const float x2 = x1[e] + PEER_ALPHA * gv[e] * acc[j * 8 + hf * 4 + e]; acc[j * 8 + hf * 4 + e] = x2; ss += x2 * x2; }
            }
        ss = wave_sum(ss);
        const float rstd = rsqrtf(ss * (1.f / 2048.f) + 1e-6f);
#pragma unroll
        for (int j = 0; j < 4; ++j)
#pragma unroll
            for (int hf = 0; hf < 2; ++hf) {
                const int col = j * 512 + lane * 8 + hf * 4;
                const f32x4 fv = *(const f32x4*)(fg + col);
                f32x4 o;
#pragma unroll
                for (int e = 0; e < 4; ++e) o[e] = acc[j * 8 + hf * 4 + e] * rstd * fv[e];
                *(f32x4*)(xo + col) = o;
            }
    }
    __syncthreads();
}
constexpr int NPHASE = 11;
#ifndef DBG
#define DBG 0
#endif
__device__ __forceinline__ void dbg_final_norm(const Args& a, const Ctx& c, const float* src) {
    for (int t = c.bid * 8 + c.wave; t < L_; t += c.nb * 8) {
        const float* xr = src + (size_t)t * 2048 + c.lane * 4; float* o = a.out + (size_t)t * 2048 + c.lane * 4;
        f32x4 v[8]; float ss = 0.f;
#pragma unroll
        for (int j = 0; j < 8; ++j) { v[j] = *(const f32x4*)(xr + j * 256); ss += v[j][0] * v[j][0] + v[j][1] * v[j][1] + v[j][2] * v[j][2] + v[j][3] * v[j][3]; }
        ss = wave_sum(ss);
        const float rstd = rsqrtf(ss * (1.f / 2048.f) + 1e-6f);
#pragma unroll
        for (int j = 0; j < 8; ++j) { const f32x4 g = *(const f32x4*)(a.in[32] + j * 256 + c.lane * 4); *(f32x4*)(o + j * 256) = v[j] * rstd * g; }
    }
}

extern __shared__ __attribute__((aligned(16))) unsigned char smem[];

__global__ void __launch_bounds__(512, 2) fwd(Args a) {
    LAS unsigned char* lds = (LAS unsigned char*)smem;
    Ctx c; c.bid = blockIdx.x; c.nb = gridDim.x; c.tid = threadIdx.x; c.wave = __builtin_amdgcn_readfirstlane(threadIdx.x >> 6); c.lane = threadIdx.x & 63; c.lds = lds;
    volatile LAS unsigned* xbw = (volatile LAS unsigned*)(lds + LDS_BYTES - 16);
    if (c.tid < 4) xbw[c.tid] = 0u;
    __syncthreads();
    const int lo = a.ph_lo, hi = a.ph_hi;
    const bool multi = (hi - lo) > 1;
    XcdBarrier bar; bar.bar = (unsigned*)(a.ws + WS_CTL); bar.x = 0; bar.st = xbw;
    if (multi) bar = xcd_barrier_post((unsigned*)(a.ws + WS_CTL), xbw);
#ifndef PHASE_MASK
#define PHASE_MASK 0xFFFF
#endif
#if DBG == 1
#undef PHASE_MASK
#define PHASE_MASK 0x403
#elif DBG == 2 || DBG == 4 || DBG == 5
#undef PHASE_MASK
#define PHASE_MASK 0x4FF
#endif
#define IN(k) (((PHASE_MASK >> (k)) & 1) && lo <= (k) && (k) < hi)
#define SEAM(k) do { if (IN(k) && IN((k) + 1)) xcd_barrier(bar); } while (0)

    if (IN(0)) { p0_prologue(a, c); }
    SEAM(0);
    if (IN(1)) { p1_hnorm(a, c); }
    SEAM(1);
    if (IN(2)) {
        pg8::StaticOrder S; S.init((const bf16_t*)(a.ws + WS_H), (const bf16_t*)(a.ws + WS_WIN), 2048, 2048, 2048, L_, DIN_PAD, c.nb, c.bid);
        EpiWin E{(bf16_t*)(a.ws + WS_US), (bf16_t*)(a.ws + WS_Q), (bf16_t*)(a.ws + WS_KROW), (bf16_t*)(a.ws + WS_VROW), (bf16_t*)(a.ws + WS_VT), (float*)(a.ws + WS_GATE)};
        pg8::gemm_phase<EpiWin, pg8::StaticOrder>(lds, S, E);
    }
    SEAM(2);
    if (IN(3)) {
        for (int it = c.bid; it < 256; it += c.nb) s5_item<0>(a, c, it >> 2, it & 3);
        __syncthreads();
        CmpOrder S{(const bf16_t*)(a.ws + WS_KROW), (const bf16_t*)(a.ws + WS_VROW), (const bf16_t*)(a.ws + WS_W1), 2048, 4096, 1024, c.nb, c.bid};
        EpiSlab E{(float*)(a.ws + WS_SLAB)};
        pg8::gemm_phase<EpiSlab, CmpOrder>(lds, S, E);
    }
    SEAM(3);
    if (IN(4)) {
        for (int it = c.bid; it < 64; it += c.nb) cmp_finish_item(a, c, it >> 5, it & 31);
        for (int it = c.bid; it < 256; it += c.nb) s5_item<1>(a, c, it >> 2, it & 3);
    }
    SEAM(4);
    if (IN(5)) {
#if DBG == 5
        for (size_t i = (size_t)c.bid * NTHREADS + c.tid; i < (size_t)L_ * 1024 / 8; i += (size_t)c.nb * NTHREADS) *(u32x4*)((bf16_t*)(a.ws + WS_YSSM) + i * 8) = (u32x4){0u, 0u, 0u, 0u};
#else
        {
            pg8::StaticOrder S; S.init((const bf16_t*)(a.ws + WS_Z), (const bf16_t*)(a.ws + WS_WGLU), 1024, 1024, 1024, L_, 1024, c.nb, c.bid);
            EpiGlu E{(const bf16_t*)(a.ws + WS_Z), a.in[19], (bf16_t*)(a.ws + WS_YSSM)};
            pg8::gemm_phase<EpiGlu, pg8::StaticOrder>(lds, S, E);
        }
#endif
        __syncthreads();
#if DBG == 4
        for (size_t i = (size_t)c.bid * NTHREADS + c.tid; i < (size_t)L_ * 1024 / 8; i += (size_t)c.nb * NTHREADS) *(u32x4*)((bf16_t*)(a.ws + WS_YATT) + i * 8) = (u32x4){0u, 0u, 0u, 0u};
#else
        for (int it = c.bid; it < 512; it += c.nb) {
            const int rnd = it / c.nb;
            const int qt = (rnd & 1) ? 255 - (it % 256) : (it % 256), g = (it >> 8) & 1;
            attn_item(a, c, qt, g);
        }
#endif
    }
    SEAM(5);
    if (IN(6)) { p6_mixnorm(a, c); }
    SEAM(6);
    if (IN(7)) {
        pg8::StaticOrder S; S.init((const bf16_t*)(a.ws + WS_H), (const bf16_t*)(a.ws + WS_WOUT), 2048, 2048, 2048, L_, 2048, c.nb, c.bid);
        EpiWout E{a.in[0], (const float*)(a.ws + WS_COND) + 2 * 2048, a.out};
        pg8::gemm_phase<EpiWout, pg8::StaticOrder>(lds, S, E);
    }
    SEAM(7);
    if (IN(8)) { p8_h2norm(a, c); }
    SEAM(8);
    if (IN(9)) {
        pg8::StaticOrder S; S.init((const bf16_t*)(a.ws + WS_H), (const bf16_t*)(a.ws + WS_WQ), 2048, 2048, 2048, L_, 2048, c.nb, c.bid);
        EpiBf16 E{(bf16_t*)(a.ws + WS_QP), 2048};
        pg8::gemm_phase<EpiBf16, pg8::StaticOrder>(lds, S, E);
    }
    SEAM(9);
    if (IN(10)) {
#if DBG == 1
        dbg_final_norm(a, c, a.in[0]);
#elif DBG == 2 || DBG == 4 || DBG == 5
        dbg_final_norm(a, c, a.out);
#else
        for (int s = c.bid; s < L_ / 8; s += c.nb) peer_step(a, c, s * 8);
#endif
    }
#undef IN
#undef SEAM
}

#ifndef N_LAUNCHES
#define N_LAUNCHES 1
#endif
extern "C" void kernel_launch(void* const* d_in, const int* in_sizes, int n_in, void* d_out, int out_size, void* d_ws, size_t ws_size, hipStream_t stream) {
    static int grid = 0;
    if (grid == 0) {
        if (n_in != 33 || out_size != L_ * D_ || ws_size < WS_END) { fprintf(stderr, "kernel_launch: unexpected shapes (n_in %d, out %d, ws %zu < %zu); nothing launched\n", n_in, out_size, ws_size, (size_t)WS_END); grid = -1; return; }
        int dev = 0, cus = 0, per_cu = 0;
        if (hipGetDevice(&dev) != hipSuccess || hipDeviceGetAttribute(&cus, hipDeviceAttributeMultiprocessorCount, dev) != hipSuccess) { grid = -1; return; }
        if (hipFuncSetAttribute((const void*)fwd, hipFuncAttributeMaxDynamicSharedMemorySize, LDS_BYTES) != hipSuccess) { fprintf(stderr, "kernel_launch: hipFuncSetAttribute failed\n"); grid = -1; return; }
        if (hipOccupancyMaxActiveBlocksPerMultiprocessor(&per_cu, (const void*)fwd, NTHREADS, LDS_BYTES) != hipSuccess || per_cu < 1) { fprintf(stderr, "kernel_launch: occupancy query says %d\n", per_cu); (void)hipGetLastError(); grid = -1; return; }
        grid = cus;
    }
    if (grid < 0) return;
    (void)hipMemsetAsync((char*)d_ws + WS_CTL, 0, CTL_BYTES, stream);
    Args a{};
    for (int i = 0; i < 33; ++i) a.in[i] = (const float*)d_in[i];
    a.out = (float*)d_out; a.ws = (unsigned char*)d_ws;
    if (N_LAUNCHES == 1) { a.ph_lo = 0; a.ph_hi = NPHASE; hipLaunchKernelGGL(fwd, dim3(grid), dim3(NTHREADS), LDS_BYTES, stream, a); }
    else for (int p = 0; p < NPHASE; ++p) { a.ph_lo = p; a.ph_hi = p + 1; hipLaunchKernelGGL(fwd, dim3(grid), dim3(NTHREADS), LDS_BYTES, stream, a); }
}
```

```cpp
#include <hip/hip_runtime.h>
#include <stdint.h>
#include <stdio.h>

#define LAS __attribute__((address_space(3)))
typedef unsigned short bf16_t;
typedef short bf16x8 __attribute__((ext_vector_type(8)));
typedef float f32x2 __attribute__((ext_vector_type(2)));
typedef float f32x4 __attribute__((ext_vector_type(4)));
typedef float f32x16 __attribute__((ext_vector_type(16)));
typedef unsigned u32x2 __attribute__((ext_vector_type(2)));
typedef unsigned u32x4 __attribute__((ext_vector_type(4)));
typedef __bf16 bfv2 __attribute__((ext_vector_type(2)));

constexpr int L_ = 16384, D_ = 2048, DSSM = 1024, DATT = 1024, DIN = 3608, DIN_PAD = 3840;
constexpr int NADA = 12288;
constexpr float LOG2E = 1.4426950408889634f;
constexpr float QSCALE = 0.08838834764831845f * 1.4426950408889634f;
constexpr int TBN = 800;
constexpr int NTHREADS = 512;
constexpr int LDS_BYTES = 163840;

constexpr size_t al256(size_t x) { return (x + 255) & ~(size_t)255; }
constexpr size_t WS_CTL   = 0;                                  constexpr size_t CTL_BYTES = 65536;
constexpr size_t WS_CONDP = WS_CTL + CTL_BYTES;
constexpr size_t WS_COND  = WS_CONDP + 32 * 12288 * 4;
constexpr size_t WS_TB    = WS_COND + 12288 * 4;
constexpr size_t WS_BPE   = al256(WS_TB + 8 * TBN * 4);
constexpr size_t WS_S5P   = al256(WS_BPE + 2 * 256 * 4);
constexpr size_t WS_S5F   = WS_S5P + 2 * 64 * 64 * 2 * 4;
constexpr size_t WS_S5MT  = WS_S5F + 64 * 4 * 128 * 4;
constexpr size_t WS_S5WE  = WS_S5MT + (size_t)64 * 256 * 256 * 2;
constexpr size_t WS_S5WC  = WS_S5WE + (size_t)64 * 128 * 256 * 2;
constexpr size_t WS_WIN   = WS_S5WC + (size_t)64 * 256 * 128 * 2;
constexpr size_t WS_WGLU  = WS_WIN + (size_t)DIN_PAD * 2048 * 2;
constexpr size_t WS_WOUT  = WS_WGLU + (size_t)1024 * 1024 * 2;
constexpr size_t WS_WQ    = WS_WOUT + (size_t)2048 * 2048 * 2;
constexpr size_t WS_W1    = WS_WQ + (size_t)2048 * 2048 * 2;
constexpr size_t WS_W2    = WS_W1 + (size_t)2 * 256 * 4096 * 2;
constexpr size_t WS_PK    = WS_W2 + (size_t)2 * 128 * 256 * 2;
constexpr size_t WS_PU    = WS_PK + (size_t)2 * 128 * 128 * 2;
constexpr size_t WS_PV    = WS_PU + (size_t)16384 * 2048;
constexpr size_t WS_PSC   = WS_PV + (size_t)16384 * 2048;
constexpr size_t WS_BPEP  = WS_PSC + (size_t)2 * 16384 * 4;
constexpr size_t WS_H     = WS_BPEP + (size_t)32 * 2 * 256 * 4;
constexpr size_t WS_US    = WS_H + (size_t)16384 * 2048 * 2;
constexpr size_t WS_Q     = WS_US + (size_t)16384 * 1024 * 2;
constexpr size_t WS_QP    = WS_US;
constexpr size_t WS_KROW  = WS_Q + (size_t)16384 * 1024 * 2;
constexpr size_t WS_VROW  = WS_KROW + (size_t)6 * 16384 * 128 * 2;
constexpr size_t WS_VT    = WS_VROW + (size_t)2 * 16384 * 128 * 2 + 8192;
constexpr size_t WS_GATE  = WS_VT + (size_t)4 * 128 * 16384 * 2;
constexpr size_t WS_SLAB  = WS_GATE + (size_t)16384 * 24 * 4;
constexpr size_t WS_KC    = WS_SLAB + (size_t)2 * 4 * 2048 * 256 * 4;
constexpr size_t WS_VCT   = WS_KC + (size_t)2 * 1024 * 128 * 2;
constexpr size_t WS_Z     = WS_VCT + (size_t)2 * 128 * 1024 * 2;
constexpr size_t WS_YSSM  = WS_Z + (size_t)16384 * 1024 * 2;
constexpr size_t WS_YATT  = WS_YSSM + (size_t)16384 * 1024 * 2;
constexpr size_t WS_END   = WS_YATT + (size_t)16384 * 1024 * 2;
static_assert(WS_END < (size_t)530 * 1024 * 1024, "workspace map too large");

struct Args { const float* in[33]; float* out; unsigned char* ws; int ph_lo, ph_hi; };

__device__ __forceinline__ unsigned cvt_pk_bf16(float lo, float hi) { bfv2 v; v[0] = (__bf16)lo; v[1] = (__bf16)hi; return __builtin_bit_cast(unsigned, v); }
__device__ __forceinline__ bf16_t f2bf(float f) { return (bf16_t)(cvt_pk_bf16(f, 0.f) & 0xffffu); }
__device__ __forceinline__ float bf2f(unsigned b) { return __uint_as_float(b << 16); }
__device__ __forceinline__ float bflo(unsigned w) { return __uint_as_float(w << 16); }
__device__ __forceinline__ float bfhi(unsigned w) { return __uint_as_float(w & 0xffff0000u); }
__device__ __forceinline__ float fexp2(float x) { return __builtin_amdgcn_exp2f(x); }
__device__ __forceinline__ float frcp(float x) { return __builtin_amdgcn_rcpf(x); }
__device__ __forceinline__ float sigmoidf_(float x) { return frcp(1.f + fexp2(-LOG2E * x)); }
__device__ __forceinline__ float gelu_tanh(float x) {
    const float u = x * (1.f + 0.044715f * x * x);
    return x * frcp(1.f + fexp2(-2.f * 0.7978845608028654f * LOG2E * u));
}
__device__ __forceinline__ float shfl_xor_f(float v, int m) { return __shfl_xor(v, m, 64); }
__device__ __forceinline__ float wave_sum(float v) {
#pragma unroll
    for (int m = 32; m >= 1; m >>= 1) v += __shfl_xor(v, m, 64);
    return v;
}
__device__ __forceinline__ float wave_max(float v) {
#pragma unroll
    for (int m = 32; m >= 1; m >>= 1) v = fmaxf(v, __shfl_xor(v, m, 64));
    return v;
}
template <int CTRL> __device__ __forceinline__ float dpp_f(float x) { return __int_as_float(__builtin_amdgcn_update_dpp(0, __float_as_int(x), CTRL, 0xf, 0xf, false)); }
__device__ __forceinline__ float quad_sum(float x) { x += dpp_f<0xB1>(x); x += dpp_f<0x4E>(x); return x; }
__device__ __forceinline__ f32x4 mfma16(bf16x8 a, bf16x8 b, f32x4 c) { return __builtin_amdgcn_mfma_f32_16x16x32_bf16(a, b, c, 0, 0, 0); }
__device__ __forceinline__ f32x16 mfma32(bf16x8 a, bf16x8 b, f32x16 c) { return __builtin_amdgcn_mfma_f32_32x32x16_bf16(a, b, c, 0, 0, 0); }
#define XB_TMO      128
#define XB_XCNT(j)  (256  + 64 * (j))
#define XB_XSUB(j)  (1280 + 64 * (j))
#define XB_XGEN(j)  (2304 + 64 * (j))
#define XB_TOP      3328
#define XB_TOPGEN   3392
#define XCD_BAR_WORDS 3456
#define XB_SPIN_CAP (1u << 18)

__device__ __forceinline__ unsigned xb_ld(unsigned* p)              { return __hip_atomic_load(p, __ATOMIC_RELAXED, __HIP_MEMORY_SCOPE_AGENT); }
__device__ __forceinline__ unsigned xb_add(unsigned* p, unsigned v) { return __hip_atomic_fetch_add(p, v, __ATOMIC_RELAXED, __HIP_MEMORY_SCOPE_AGENT); }
__device__ __forceinline__ unsigned xb_xcc_id() { return (unsigned)__builtin_amdgcn_s_getreg((3 << 11) | 20) & 0xFu; }
#define XB_SPIN(cond, bar) do { unsigned _sp = 0; while (cond) { __builtin_amdgcn_s_sleep(1); \
    if ((++_sp & 255u) == 0u) { if (xb_ld(&(bar)[XB_TMO])) break; if (_sp > XB_SPIN_CAP) { atomicAdd(&(bar)[XB_TMO], 1u); break; } } } } while (0)

struct XcdBarrier {
    unsigned* bar; unsigned x;
    volatile LAS unsigned* st;
};
__device__ __forceinline__ XcdBarrier xcd_barrier_post(unsigned* bar, volatile LAS unsigned* st) {
    XcdBarrier b; b.bar = bar; b.x = xb_xcc_id(); b.st = st;
    if (threadIdx.x == 0) (void)xb_add(&bar[XB_XCNT(b.x)], 1u);
    return b;
}
__device__ __forceinline__ void xcd_barrier_complete(unsigned* bar, unsigned x, unsigned& nloc, unsigned& nx) {
    const unsigned G = gridDim.x * gridDim.y * gridDim.z;
    unsigned sum, cnt, mine, sp = 0u;
    for (;;) {
        sum = 0u; cnt = 0u; mine = 0u;
#pragma unroll
        for (unsigned j = 0; j < 16; ++j) { const unsigned c = xb_ld(&bar[XB_XCNT(j)]); sum += c; cnt += (c > 0u) ? 1u : 0u; mine = (j == x) ? c : mine; }
        if (sum == G) break;
        __builtin_amdgcn_s_sleep(1);
        if ((++sp & 255u) == 0u) { if (xb_ld(&bar[XB_TMO])) break; if (sp > XB_SPIN_CAP) { atomicAdd(&bar[XB_TMO], 1u); break; } }
    }
    nloc = mine > 0u ? mine : 1u; nx = cnt > 0u ? cnt : 1u;
}
__device__ __forceinline__ void xcd_barrier(const XcdBarrier& b) {
    asm volatile("s_waitcnt vmcnt(0)" ::: "memory");
    __syncthreads();
    if (threadIdx.x == 0) {
        unsigned* bar = b.bar;
        __builtin_amdgcn_s_waitcnt(0);
        unsigned nloc = b.st[0], nx = b.st[1];
        if (nloc == 0u) { xcd_barrier_complete(bar, b.x, nloc, nx); b.st[0] = nloc; b.st[1] = nx; }
        const unsigned old = xb_add(&bar[XB_XSUB(b.x)], 1u);
        const unsigned gen = old / nloc;
        if (old + 1u == (gen + 1u) * nloc) {
            __builtin_amdgcn_fence(__ATOMIC_RELEASE, "agent");
            asm volatile("s_waitcnt vmcnt(0)" ::: "memory");
            const unsigned og = xb_add(&bar[XB_TOP], 1u);
            const unsigned tg = og / nx;
            if (og + 1u == (tg + 1u) * nx) xb_add(&bar[XB_TOPGEN], 1u);
            else XB_SPIN(xb_ld(&bar[XB_TOPGEN]) == tg, bar);
            __builtin_amdgcn_fence(__ATOMIC_ACQUIRE, "agent");
            xb_add(&bar[XB_XGEN(b.x)], 1u);
            asm volatile("s_waitcnt vmcnt(0)" ::: "memory");
        } else {
            XB_SPIN(xb_ld(&bar[XB_XGEN(b.x)]) == gen, bar);
            __builtin_amdgcn_fence(__ATOMIC_ACQUIRE, "agent");
            asm volatile("s_waitcnt vmcnt(0)" ::: "memory");
        }
    }
    __syncthreads();
}

namespace pg8 {
constexpr int BM = 256, BK = 64, HALF = 128, HTB = HALF * BK * 2, STAGE_BYTES = 8 * HTB, NXCD = 8, WGM = 8;
__host__ __device__ __forceinline__ int lds_byte(int r, int c) { const int st = (r >> 4) * 2 + (c >> 5), rr = r & 15, cc = c & 31, ob = rr * 64 + cc * 2; return st * 1024 + (ob ^ (((ob >> 9) & 1) << 5)); }
__host__ __device__ __forceinline__ void stage_rc(int b, int& R, int& C) { const int st = b / 1024, sb = b % 1024, swz = sb ^ (((sb >> 9) & 1) << 5); R = (st >> 1) * 16 + swz / 64; C = (st & 1) * 32 + (swz % 64) / 2; }
__host__ __device__ __forceinline__ int perm32(int rho) { const int n = rho >> 4, i = rho & 15; return 8 * (i >> 2) + 4 * n + (i & 3); }

struct Unit { int pm, pn, z; };
struct StaticOrder {
    const bf16_t* A; const bf16_t* Bt; int lda, ldb, K;
    int nM, nN, nwg, G, c;
    __device__ void init(const bf16_t* A_, const bf16_t* Bt_, int lda_, int ldb_, int K_, int M, int N, int G_, int c_) { A = A_; Bt = Bt_; lda = lda_; ldb = ldb_; K = K_; nM = M / BM; nN = N / BM; nwg = nM * nN; G = G_; c = c_; }
    __device__ bool next(int i, Unit& u) const {
        const long Lx = (long)i * G + c; if (Lx >= nwg) return false;
        int wgid = (int)Lx; { const int q = nwg / NXCD, r = nwg % NXCD, xcd = wgid % NXCD, off = wgid / NXCD; wgid = (xcd < r ? xcd * (q + 1) : r * (q + 1) + (xcd - r) * q) + off; }
        const int nig = WGM * nN, gid = wgid / nig, fm = gid * WGM, gsz = (nM - fm) < WGM ? (nM - fm) : WGM;
        u.pm = fm + ((wgid % nig) % gsz); u.pn = (wgid % nig) / gsz; u.z = 0; return true;
    }
    __device__ __forceinline__ const char* a_base(const Unit& u) const { return (const char*)(A + (size_t)u.pm * BM * lda); }
    __device__ __forceinline__ const char* b_base(const Unit& u) const { return (const char*)(Bt + (size_t)u.pn * BM * ldb); }
};

template <class Epi, class Sched>
__device__ __forceinline__ void gemm_phase(LAS unsigned char* lds, const Sched& S, const Epi& E) {
    const int tid = threadIdx.x, wid = __builtin_amdgcn_readfirstlane(tid >> 6), lane = tid & 63, wr = wid >> 2, wc = wid & 3, fr = lane & 15, fq = lane >> 4;
    const int K = S.K, nt = K / BK, lda = S.lda, ldb = S.ldb;
    unsigned voffA[2], voffB[2];
#pragma unroll
    for (int i = 0; i < 2; ++i) { int R, C; stage_rc(tid * 16 + i * 8192, R, C); const int Rb = Epi::PERM ? ((R & ~31) + perm32(R & 31)) : R;
        voffA[i] = (unsigned)(R * lda + C) * 2u; voffB[i] = (unsigned)(Rb * ldb + C) * 2u; }
    const size_t kstep = (size_t)(BK * 2);
    const size_t hstepA = (size_t)HALF * lda * 2, hstepB = (size_t)HALF * ldb * 2;
    const unsigned ldsw = (unsigned)wid * 1024u;
    const int aoff = lds_byte(wr * 64 + fr, fq * 8), boff = lds_byte(wc * 32 + fr, fq * 8);
#define PG8_SA(b, h) (((b) * 2 + (h)) * HTB)
#define PG8_SB(b, h) ((4 + (b) * 2 + (h)) * HTB)
#define PG8_STAGE(bufoff, gbase, voff) do { _Pragma("unroll") for (int _i = 0; _i < 2; ++_i) \
        __builtin_amdgcn_global_load_lds((const unsigned*)((const char*)(gbase) + (voff)[_i]), (LAS unsigned*)(lds + (bufoff) + ldsw + _i * 8192), 16, 0, 0); } while (0)
#define PG8_LDA(dst, b, h) do { _Pragma("unroll") for (int m = 0; m < 4; ++m) _Pragma("unroll") for (int k = 0; k < 2; ++k) dst[m][k] = *(const LAS bf16x8*)(lds + PG8_SA(b, h) + aoff + m * 2048 + k * 1024); } while (0)
#define PG8_LDB(dst, b, h) do { _Pragma("unroll") for (int n = 0; n < 2; ++n) _Pragma("unroll") for (int k = 0; k < 2; ++k) dst[n][k] = *(const LAS bf16x8*)(lds + PG8_SB(b, h) + boff + n * 2048 + k * 1024); } while (0)
#define PG8_MMA(ai, bj, At, Bt) do { __builtin_amdgcn_s_setprio(1); _Pragma("unroll") for (int m = 0; m < 4; ++m) _Pragma("unroll") for (int n = 0; n < 2; ++n) _Pragma("unroll") for (int k = 0; k < 2; ++k) \
        acc[ai][bj][m][n] = __builtin_amdgcn_mfma_f32_16x16x32_bf16(Bt[n][k], At[m][k], acc[ai][bj][m][n], 0, 0, 0); __builtin_amdgcn_s_setprio(0); } while (0)
#define PG8_WAIT_V(n) asm volatile("s_waitcnt vmcnt(" #n ")" ::: "memory")
#define PG8_WAIT_L(n) asm volatile("s_waitcnt lgkmcnt(" #n ")" ::: "memory")
#define PG8_BAR __builtin_amdgcn_s_barrier()
#define PG8_SCHED __builtin_amdgcn_sched_barrier(0)
    Unit cur, nxt; int ui = 0;
    if (!S.next(0, cur)) return;
    f32x4 acc[2][2][4][2];
#pragma unroll
    for (int a = 0; a < 2; ++a)
#pragma unroll
        for (int b = 0; b < 2; ++b)
#pragma unroll
            for (int m = 0; m < 4; ++m)
#pragma unroll
                for (int n = 0; n < 2; ++n) acc[a][b][m][n] = (f32x4){0.f, 0.f, 0.f, 0.f};
    bf16x8 At[4][2], B0[2][2], B1[2][2];
    const char* cA = S.a_base(cur); const char* cB = S.b_base(cur);
    PG8_STAGE(PG8_SB(0, 0), cB, voffB); PG8_STAGE(PG8_SA(0, 0), cA, voffA); PG8_STAGE(PG8_SB(0, 1), cB + hstepB, voffB); PG8_STAGE(PG8_SA(0, 1), cA + hstepA, voffA);
    if (wr == 1) PG8_BAR;
    PG8_WAIT_V(4); PG8_BAR;
    PG8_STAGE(PG8_SB(1, 0), cB + kstep, voffB); PG8_STAGE(PG8_SA(1, 0), cA + kstep, voffA); PG8_STAGE(PG8_SB(1, 1), cB + hstepB + kstep, voffB);
    PG8_WAIT_V(6); PG8_BAR;
    for (;;) {
        const bool has_next = S.next(ui + 1, nxt);
        const char* nA = has_next ? S.a_base(nxt) : cA; const char* nB = has_next ? S.b_base(nxt) : cB;
        for (int t = 0; t < nt; t += 2) {
            const bool last = (t == nt - 2);
            const char* a1 = cA + (size_t)(t + 1) * kstep;
            const char* a2 = last ? nA : cA + (size_t)(t + 2) * kstep; const char* b2 = last ? nB : cB + (size_t)(t + 2) * kstep;
            const char* a3 = a2 + kstep; const char* b3 = b2 + kstep;
            PG8_LDB(B0, 0, 0); PG8_SCHED; PG8_LDA(At, 0, 0); PG8_STAGE(PG8_SA(1, 1), a1 + hstepA, voffA);
            PG8_WAIT_L(8); PG8_BAR; PG8_WAIT_L(0); PG8_MMA(0, 0, At, B0); PG8_BAR; PG8_SCHED;
            PG8_LDB(B1, 0, 1); PG8_STAGE(PG8_SB(0, 0), b2, voffB);
            PG8_BAR; PG8_WAIT_L(0); PG8_MMA(0, 1, At, B1); PG8_BAR;
            PG8_LDA(At, 0, 1); PG8_STAGE(PG8_SA(0, 0), a2, voffA);
            PG8_BAR; PG8_WAIT_L(0); PG8_MMA(1, 0, At, B0); PG8_BAR; PG8_SCHED;
            PG8_STAGE(PG8_SB(0, 1), b2 + hstepB, voffB);
            PG8_WAIT_V(6); PG8_BAR; PG8_MMA(1, 1, At, B1); PG8_BAR;
            PG8_LDB(B0, 1, 0); PG8_SCHED; PG8_LDA(At, 1, 0); PG8_STAGE(PG8_SA(0, 1), a2 + hstepA, voffA);
            PG8_WAIT_L(8); PG8_BAR; PG8_WAIT_L(0); PG8_MMA(0, 0, At, B0); PG8_BAR; PG8_SCHED;
            PG8_LDB(B1, 1, 1); PG8_STAGE(PG8_SB(1, 0), b3, voffB);
            PG8_BAR; PG8_WAIT_L(0); PG8_MMA(0, 1, At, B1); PG8_BAR;
            PG8_LDA(At, 1, 1); PG8_STAGE(PG8_SA(1, 0), a3, voffA);
            PG8_BAR; PG8_WAIT_L(0); PG8_MMA(1, 0, At, B0); PG8_BAR; PG8_SCHED;
            PG8_STAGE(PG8_SB(1, 1), b3 + hstepB, voffB);
            PG8_WAIT_V(6); PG8_BAR; PG8_MMA(1, 1, At, B1); PG8_BAR;
        }
        E(acc, cur, wr, wc, fr, fq);
        if (!has_next) break;
#pragma unroll
        for (int a = 0; a < 2; ++a)
#pragma unroll
            for (int b = 0; b < 2; ++b)
#pragma unroll
                for (int m = 0; m < 4; ++m)
#pragma unroll
                    for (int n = 0; n < 2; ++n) acc[a][b][m][n] = (f32x4){0.f, 0.f, 0.f, 0.f};
        cur = nxt; cA = nA; cB = nB; ++ui;
    }
    PG8_WAIT_V(0);
    if (wr == 0) PG8_BAR;
    PG8_BAR;
#undef PG8_SA
#undef PG8_SB
#undef PG8_STAGE
#undef PG8_LDA
#undef PG8_LDB
#undef PG8_MMA
#undef PG8_WAIT_V
#undef PG8_WAIT_L
#undef PG8_BAR
#undef PG8_SCHED
}
}
using pg8::Unit;
__device__ __forceinline__ u32x4 pack8(const f32x4& v0, const f32x4& v1) {
    u32x4 o; o[0] = cvt_pk_bf16(v0[0], v0[1]); o[1] = cvt_pk_bf16(v0[2], v0[3]); o[2] = cvt_pk_bf16(v1[0], v1[1]); o[3] = cvt_pk_bf16(v1[2], v1[3]); return o;
}
struct EpiWin {
    static constexpr bool PERM = true;
    bf16_t* US; bf16_t* Q; bf16_t* KROW; bf16_t* VROW; bf16_t* VT; float* GATE;
    __device__ __forceinline__ void operator()(const f32x4 (&acc)[2][2][4][2], const Unit& u, int wr, int wc, int fr, int fq) const {
        const int row0 = u.pm * 256 + wr * 64 + fr; const int pn = u.pn;
#pragma unroll
        for (int ai = 0; ai < 2; ++ai)
#pragma unroll
            for (int m = 0; m < 4; ++m) {
                const int row = row0 + ai * 128 + m * 16;
#pragma unroll
                for (int bj = 0; bj < 2; ++bj) {
                    const f32x4 v0 = acc[ai][bj][m][0], v1 = acc[ai][bj][m][1];
                    const int cin = bj * 128 + wc * 32 + 8 * fq;
                    if (pn < 4) { *(u32x4*)(US + (size_t)row * 1024 + pn * 256 + cin) = pack8(v0, v1); }
                    else if (pn < 8) { *(u32x4*)(Q + (size_t)row * 1024 + (pn - 4) * 256 + cin) = pack8(v0 * QSCALE, v1 * QSCALE); }
                    else if (pn < 14) {
                        const int kvi = pn - 8, branch = kvi >> 1, kvsel = kvi & 1, g = bj, d0 = wc * 32 + 8 * fq;
                        if (kvsel == 0) { *(u32x4*)(KROW + ((size_t)(branch * 2 + g) * L_ + row) * 128 + d0) = pack8(v0, v1); }
                        else if (branch == 0) { *(u32x4*)(VROW + ((size_t)g * L_ + row) * 128 + d0) = pack8(v0, v1); }
                        else {
                            bf16_t* vt = VT + ((size_t)((branch - 1) * 2 + g) * 128 + d0) * L_ + row;
#pragma unroll
                            for (int e = 0; e < 4; ++e) { vt[(size_t)e * L_] = f2bf(v0[e]); vt[(size_t)(e + 4) * L_] = f2bf(v1[e]); }
                        }
                    } else {
                        if (cin < 24) {
                            float* gp = GATE + (size_t)row * 24 + cin;
                            f32x4 s0, s1;
#pragma unroll
                            for (int e = 0; e < 4; ++e) { s0[e] = sigmoidf_(v0[e]); s1[e] = sigmoidf_(v1[e]); }
                            *(f32x4*)gp = s0; *(f32x4*)(gp + 4) = s1;
                        }
                    }
                }
            }
    }
};
struct EpiGlu {
    static constexpr bool PERM = true;
    const bf16_t* Z; const float* bglu; bf16_t* Y;
    __device__ __forceinline__ void operator()(const f32x4 (&acc)[2][2][4][2], const Unit& u, int wr, int wc, int fr, int fq) const {
        const int row0 = u.pm * 256 + wr * 64 + fr;
#pragma unroll
        for (int bj = 0; bj < 2; ++bj) {
            const int col = u.pn * 256 + bj * 128 + wc * 32 + 8 * fq;
            const f32x4 b0 = *(const f32x4*)(bglu + col), b1 = *(const f32x4*)(bglu + col + 4);
#pragma unroll
            for (int ai = 0; ai < 2; ++ai)
#pragma unroll
                for (int m = 0; m < 4; ++m) {
                    const int row = row0 + ai * 128 + m * 16;
                    const u32x4 zz = *(const u32x4*)(Z + (size_t)row * 1024 + col);
                    const f32x4 v0 = acc[ai][bj][m][0] + b0, v1 = acc[ai][bj][m][1] + b1;
                    f32x4 o0, o1;
                    o0[0] = bflo(zz[0]) * sigmoidf_(v0[0]); o0[1] = bfhi(zz[0]) * sigmoidf_(v0[1]); o0[2] = bflo(zz[1]) * sigmoidf_(v0[2]); o0[3] = bfhi(zz[1]) * sigmoidf_(v0[3]);
                    o1[0] = bflo(zz[2]) * sigmoidf_(v1[0]); o1[1] = bfhi(zz[2]) * sigmoidf_(v1[1]); o1[2] = bflo(zz[3]) * sigmoidf_(v1[2]); o1[3] = bfhi(zz[3]) * sigmoidf_(v1[3]);
                    *(u32x4*)(Y + (size_t)row * 1024 + col) = pack8(o0, o1);
                }
        }
    }
};
struct EpiWout {
    static constexpr bool PERM = false;
    const float* X; const float* g1; float* X1;
    __device__ __forceinline__ void operator()(const f32x4 (&acc)[2][2][4][2], const Unit& u, int wr, int wc, int fr, int fq) const {
        const int row0 = u.pm * 256 + wr * 64 + fr, col0 = u.pn * 256 + wc * 32 + 4 * fq;
#pragma unroll
        for (int bj = 0; bj < 2; ++bj)
#pragma unroll
            for (int n = 0; n < 2; ++n) {
                const int col = col0 + bj * 128 + n * 16;
                const f32x4 gv = *(const f32x4*)(g1 + col);
#pragma unroll
                for (int ai = 0; ai < 2; ++ai)
#pragma unroll
                    for (int m = 0; m < 4; ++m) {
                        const size_t off = (size_t)(row0 + ai * 128 + m * 16) * 2048 + col;
                        *(f32x4*)(X1 + off) = *(const f32x4*)(X + off) + gv * acc[ai][bj][m][n];
                    }
            }
    }
};
struct EpiBf16 {
    static constexpr bool PERM = true;
    bf16_t* O; int ldc;
    __device__ __forceinline__ void operator()(const f32x4 (&acc)[2][2][4][2], const Unit& u, int wr, int wc, int fr, int fq) const {
        const int row0 = u.pm * 256 + wr * 64 + fr, col0 = u.pn * 256 + wc * 32 + 8 * fq;
#pragma unroll
        for (int ai = 0; ai < 2; ++ai)
#pragma unroll
            for (int m = 0; m < 4; ++m)
#pragma unroll
                for (int bj = 0; bj < 2; ++bj)
                    *(u32x4*)(O + (size_t)(row0 + ai * 128 + m * 16) * ldc + col0 + bj * 128) = pack8(acc[ai][bj][m][0], acc[ai][bj][m][1]);
    }
};
struct EpiSlab {
    static constexpr bool PERM = false;
    float* SL;
    __device__ __forceinline__ void operator()(const f32x4 (&acc)[2][2][4][2], const Unit& u, int wr, int wc, int fr, int fq) const {
        float* base = SL + (size_t)u.z * 2048 * 256;
        const int row0 = u.pm * 256 + wr * 64 + fr, col0 = wc * 32 + 4 * fq;
#pragma unroll
        for (int ai = 0; ai < 2; ++ai)
#pragma unroll
            for (int m = 0; m < 4; ++m)
#pragma unroll
                for (int bj = 0; bj < 2; ++bj)
#pragma unroll
                    for (int n = 0; n < 2; ++n)
                        *(f32x4*)(base + (size_t)(row0 + ai * 128 + m * 16) * 256 + col0 + bj * 128 + n * 16) = acc[ai][bj][m][n];
    }
};
struct CmpOrder {
    const bf16_t* KROW; const bf16_t* VROW; const bf16_t* W1; int lda, ldb, K; int G, c;
    __device__ bool next(int i, Unit& u) const {
        const int x = i * G + c; if (x >= 64) return false;
        const int kvsel = x >> 5, pm = (x & 31) >> 2, ks = x & 3; u.pm = pm; u.pn = 0; u.z = kvsel * 4 + ks; return true;
    }
    __device__ __forceinline__ const char* a_base(const Unit& u) const { return (const char*)(((u.z >> 2) ? VROW : KROW) + (size_t)u.pm * 256 * 2048 + (u.z & 3) * 1024); }
    __device__ __forceinline__ const char* b_base(const Unit& u) const { return (const char*)(W1 + (size_t)(u.z >> 2) * 256 * 4096 + (u.z & 3) * 1024); }
};
struct Ctx { int bid, nb, tid, wave, lane; LAS unsigned char* lds; };

__device__ __forceinline__ void p0_cond(const Args& a, const Ctx& c) {
    const float* cv = a.in[1]; const float* w = a.in[2]; float* condp = (float*)(a.ws + WS_CONDP);
    for (int u = c.bid * 8 + c.wave; u < 1536; u += c.nb * 8) {
        const int cc = u % 48, kc = u / 48;
        const float* wp = w + (size_t)(kc * 64) * NADA + cc * 256 + c.lane * 4;
        f32x4 acc = {0.f, 0.f, 0.f, 0.f};
#pragma unroll 16
        for (int k = 0; k < 64; ++k) { const float x = cv[kc * 64 + k]; const float s = x / (1.f + __expf(-x)); acc += s * *(const f32x4*)(wp + (size_t)k * NADA); }
        *(f32x4*)(condp + (size_t)kc * NADA + cc * 256 + c.lane * 4) = acc;
    }
}
__device__ __forceinline__ void conv_T(const float* src, int K, int N, bf16_t* dst, int Npad, const Ctx& c) {
    LAS float* tile = (LAS float*)c.lds;
    const int nkt = K / 64, ntiles = nkt * (Npad / 64);
    const int r = c.tid >> 4, c4 = c.tid & 15;
    f32x4 v[2];
#define CONVT_LD(tix_) do { const int nt_ = (tix_) / nkt, kt_ = (tix_) % nkt, n_ = nt_ * 64 + 4 * c4; _Pragma("unroll") for (int i = 0; i < 2; ++i) { const int k_ = kt_ * 64 + r + 32 * i; v[i] = (f32x4){0.f, 0.f, 0.f, 0.f}; if (n_ < N) v[i] = *(const f32x4*)(src + (size_t)k_ * N + n_); } } while (0)
    if (c.bid < ntiles) CONVT_LD(c.bid);
    for (int tix = c.bid; tix < ntiles; tix += c.nb) {
        const int nt = tix / nkt, kt = tix % nkt;
#pragma unroll
        for (int i = 0; i < 2; ++i) { LAS float* tp = tile + (r + 32 * i) * 65 + 4 * c4; tp[0] = v[i][0]; tp[1] = v[i][1]; tp[2] = v[i][2]; tp[3] = v[i][3]; }
        __syncthreads();
        if (tix + c.nb < ntiles) CONVT_LD(tix + c.nb);
        { const int n = c.tid >> 3, kq = c.tid & 7; float w[8];
#pragma unroll
          for (int j = 0; j < 8; ++j) w[j] = tile[(kq * 8 + j) * 65 + n];
          u32x4 o; o[0] = cvt_pk_bf16(w[0], w[1]); o[1] = cvt_pk_bf16(w[2], w[3]); o[2] = cvt_pk_bf16(w[4], w[5]); o[3] = cvt_pk_bf16(w[6], w[7]);
          *(u32x4*)(dst + (size_t)(nt * 64 + n) * K + kt * 64 + kq * 8) = o; }
        __syncthreads();
    }
#undef CONVT_LD
}
__device__ __forceinline__ void conv_fp8rows(const float* src, unsigned char* dst8, float* scl, int rows, const Ctx& c) {
    for (int row = c.bid * 8 + c.wave; row < rows; row += c.nb * 8) {
        const float* sp = src + (size_t)row * 2048 + c.lane * 4;
        f32x4 v[8]; float mx = 0.f;
#pragma unroll
        for (int j = 0; j < 8; ++j) { v[j] = *(const f32x4*)(sp + j * 256); mx = fmaxf(mx, fmaxf(fmaxf(fabsf(v[j][0]), fabsf(v[j][1])), fmaxf(fabsf(v[j][2]), fabsf(v[j][3])))); }
        mx = wave_max(mx);
        const float s = mx > 0.f ? 448.f / mx : 1.f;
        if (c.lane == 0) scl[row] = mx > 0.f ? mx * (1.f / 448.f) : 1.f;
#pragma unroll
        for (int j = 0; j < 8; ++j) {
            int w = 0;
            w = __builtin_amdgcn_cvt_pk_fp8_f32(v[j][0] * s, v[j][1] * s, w, false);
            w = __builtin_amdgcn_cvt_pk_fp8_f32(v[j][2] * s, v[j][3] * s, w, true);
            *(int*)(dst8 + (size_t)row * 2048 + j * 256 + c.lane * 4) = w;
        }
    }
}
__device__ __forceinline__ void conv_E(const float* src, bf16_t* dst, size_t n8, const Ctx& c) {
    const size_t stride = (size_t)c.nb * NTHREADS;
    for (size_t i = (size_t)c.bid * NTHREADS + c.tid; i < n8; i += stride) {
        const f32x4 x = *(const f32x4*)(src + i * 8), y = *(const f32x4*)(src + i * 8 + 4);
        *(u32x4*)(dst + i * 8) = pack8(x, y);
    }
}
__device__ __forceinline__ int t5_bucket(int n) {
    if (n < 16) return n;
    const float scaled = logf((float)n / 16.f) / logf(64.f);
    const int large = 16 + (int)(scaled * 16.f);
    return large < 31 ? large : 31;
}
__device__ __forceinline__ void p0_tb(const Args& a, const Ctx& c) {
    float* tb = (float*)(a.ws + WS_TB); const float* rb = a.in[26];
    for (int i = c.bid * NTHREADS + c.tid; i < 8 * TBN; i += c.nb * NTHREADS) { const int head = i / TBN, dist = i % TBN; tb[i] = rb[t5_bucket(dist) * 8 + head] * LOG2E; }
}
__device__ __forceinline__ void p0_bpe(const Args& a, const Ctx& c, int part) {
    const int n = c.tid & 255, kv = c.tid >> 8;
    const float* pe = a.in[kv ? 23 : 20]; const float* w1 = a.in[kv ? 24 : 21]; float* bpep = (float*)(a.ws + WS_BPEP);
    float s = 0.f;
#pragma unroll 16
    for (int k = part * 128; k < part * 128 + 128; ++k) s += pe[k] * w1[(size_t)k * 256 + n];
    bpep[(part * 2 + kv) * 256 + n] = s;
}
__device__ __forceinline__ void p0_s5(const Args& a, const Ctx& c, int g) {
    LAS float* ar = (LAS float*)c.lds;
    LAS float* ai = ar + 17 * 64;
    LAS float* bbr = ai + 17 * 64;
    LAS float* bbi = bbr + 1024;
    LAS float* cr = bbi + 1024;
    LAS float* ci = cr + 1024;
    LAS float* kd = ci + 1024;
    const int tid = c.tid;
    if (tid < 64) {
        const int p = tid; const float dt = expf(a.in[12][g]); const float lr = a.in[10][g * 64 + p], li = a.in[11][g * 64 + p];
        for (int d = 0; d <= 16; ++d) { const float mag = expf(lr * dt * (float)d), ang = li * dt * (float)d; ar[d * 64 + p] = mag * cosf(ang); ai[d * 64 + p] = mag * sinf(ang); }
        const float nr = ar[64 + p] - 1.f, ni = ai[64 + p], den = lr * lr + li * li;
        const float wre = (nr * lr + ni * li) / den, wim = (ni * lr - nr * li) / den;
        for (int h = 0; h < 16; ++h) { const float br = a.in[13][(g * 64 + p) * 16 + h], bi = a.in[14][(g * 64 + p) * 16 + h]; bbr[p * 16 + h] = wre * br - wim * bi; bbi[p * 16 + h] = wre * bi + wim * br; }
        float* s5p = (float*)(a.ws + WS_S5P);
        float xr = ar[16 * 64 + p], xi = ai[16 * 64 + p];
        s5p[(g * 64 + p) * 2] = xr; s5p[(g * 64 + p) * 2 + 1] = xi;
        for (int s = 0; s < 8; ++s) { const float tr = xr * xr - xi * xi, ti = 2.f * xr * xi; xr = tr; xi = ti; }
        s5p[64 * 64 * 2 + (g * 64 + p) * 2] = xr; s5p[64 * 64 * 2 + (g * 64 + p) * 2 + 1] = xi;
    }
    for (int e = tid; e < 1024; e += NTHREADS) { cr[e] = a.in[15][g * 1024 + e]; ci[e] = a.in[16][g * 1024 + e]; }
    __syncthreads();
    for (int e = tid; e < 4096; e += NTHREADS) {
        const int d = e >> 8, h1 = (e >> 4) & 15, h = e & 15; float s = 0.f;
        for (int p = 0; p < 64; ++p) { const float Cr = cr[h1 * 64 + p], Ci = ci[h1 * 64 + p], Ar = ar[d * 64 + p], Ai = ai[d * 64 + p];
            const float Gr = Cr * Ar - Ci * Ai, Gi = Cr * Ai + Ci * Ar; s += Gr * bbr[p * 16 + h] - Gi * bbi[p * 16 + h]; }
        if (d == 0 && h1 == h) s += a.in[17][g * 16 + h];
        kd[e] = s;
    }
    __syncthreads();
    bf16_t* MT = (bf16_t*)(a.ws + WS_S5MT) + (size_t)g * 65536;
    bf16_t* WE = (bf16_t*)(a.ws + WS_S5WE) + (size_t)g * 32768;
    bf16_t* WC = (bf16_t*)(a.ws + WS_S5WC) + (size_t)g * 32768;
    for (int e = tid; e < 65536; e += NTHREADS) { const int n = e >> 8, k = e & 255, j = n >> 4, h1 = n & 15, i = k >> 4, h = k & 15;
        MT[e] = f2bf(i <= j ? kd[(j - i) * 256 + h1 * 16 + h] : 0.f); }
    for (int e = tid; e < 32768; e += NTHREADS) { const int n = e >> 8, k = e & 255, cc = n >> 6, p = n & 63, i = k >> 4, h = k & 15;
        const float Ar = ar[(15 - i) * 64 + p], Ai = ai[(15 - i) * 64 + p], Br = bbr[p * 16 + h], Bi = bbi[p * 16 + h];
        WE[e] = f2bf(cc ? (Ar * Bi + Ai * Br) : (Ar * Br - Ai * Bi)); }
    for (int e = tid; e < 32768; e += NTHREADS) { const int n = e >> 7, k = e & 127, j = n >> 4, h1 = n & 15, cc = k >> 6, p = k & 63;
        const float Cr = cr[h1 * 64 + p], Ci = ci[h1 * 64 + p], Ar = ar[(j + 1) * 64 + p], Ai = ai[(j + 1) * 64 + p];
        WC[e] = f2bf(cc ? -(Cr * Ai + Ci * Ar) : (Cr * Ar - Ci * Ai)); }
    __syncthreads();
}
__device__ __forceinline__ void p0_prologue(const Args& a, const Ctx& c) {
    for (int g = c.bid; g < 64; g += c.nb) p0_s5(a, c, g);
    for (int u = 0; u < 32; ++u) if (c.bid == (64 + u) % c.nb) p0_bpe(a, c, u);
    p0_tb(a, c);
    p0_cond(a, c);
    conv_T(a.in[6], 2048, DIN, (bf16_t*)(a.ws + WS_WIN), DIN_PAD, c);
    conv_T(a.in[18], 1024, 1024, (bf16_t*)(a.ws + WS_WGLU), 1024, c);
    conv_T(a.in[7], 2048, 2048, (bf16_t*)(a.ws + WS_WOUT), 2048, c);
    conv_T(a.in[27], 2048, 2048, (bf16_t*)(a.ws + WS_WQ), 2048, c);
    conv_T(a.in[21], 4096, 256, (bf16_t*)(a.ws + WS_W1), 256, c);
    conv_T(a.in[24], 4096, 256, (bf16_t*)(a.ws + WS_W1) + 256 * 4096, 256, c);
    conv_T(a.in[22], 256, 128, (bf16_t*)(a.ws + WS_W2), 128, c);
    conv_T(a.in[25], 256, 128, (bf16_t*)(a.ws + WS_W2) + 128 * 256, 128, c);
    conv_E(a.in[28], (bf16_t*)(a.ws + WS_PK), 128 * 128 / 8, c);
    conv_E(a.in[29], (bf16_t*)(a.ws + WS_PK) + 128 * 128, 128 * 128 / 8, c);
    conv_fp8rows(a.in[30], a.ws + WS_PU, (float*)(a.ws + WS_PSC), 16384, c);
    conv_fp8rows(a.in[31], a.ws + WS_PV, (float*)(a.ws + WS_PSC) + 16384, 16384, c);
}

__device__ __forceinline__ void norm_rows(const float* X, bf16_t* O, LAS const float* Ab, LAS const float* Bb, const Ctx& c) {
    for (int t = c.bid * 8 + c.wave; t < L_; t += c.nb * 8) {
        const float* xr = X + (size_t)t * 2048 + c.lane * 4;
        f32x4 v[8]; float ss = 0.f;
#pragma unroll
        for (int j = 0; j < 8; ++j) { v[j] = *(const f32x4*)(xr + j * 256); ss += v[j][0] * v[j][0] + v[j][1] * v[j][1] + v[j][2] * v[j][2] + v[j][3] * v[j][3]; }
        ss = wave_sum(ss);
        const float rstd = rsqrtf(ss * (1.f / 2048.f) + 1e-6f);
#pragma unroll
        for (int j = 0; j < 8; ++j) {
            const int col = j * 256 + c.lane * 4;
            const f32x4 A = *(const LAS f32x4*)(Ab + col), B = *(const LAS f32x4*)(Bb + col);
            const f32x4 o = v[j] * rstd * A + B;
            u32x2 w; w[0] = cvt_pk_bf16(o[0], o[1]); w[1] = cvt_pk_bf16(o[2], o[3]);
            *(u32x2*)(O + (size_t)t * 2048 + col) = w;
        }
    }
}
__device__ __forceinline__ float cond_from_partials(const float* condp, const float* b_ada, int j) {
    float s = b_ada[j];
#pragma unroll 8
    for (int k = 0; k < 32; ++k) s += condp[(size_t)k * NADA + j];
    return s;
}
__device__ __forceinline__ void p1_hnorm(const Args& a, const Ctx& c) {
    const float* condp = (const float*)(a.ws + WS_CONDP); float* cond = (float*)(a.ws + WS_COND);
    for (int j = c.bid * NTHREADS + c.tid; j < NADA; j += c.nb * NTHREADS) cond[j] = cond_from_partials(condp, a.in[3], j);
    LAS float* Ab = (LAS float*)c.lds; LAS float* Bb = Ab + 2048;
    for (int col = c.tid; col < 2048; col += NTHREADS) {
        Ab[col] = a.in[4][col] * (1.f + cond_from_partials(condp, a.in[3], 2048 + col)); Bb[col] = cond_from_partials(condp, a.in[3], col); }
    __syncthreads();
    norm_rows(a.in[0], (bf16_t*)(a.ws + WS_H), Ab, Bb, c);
}
__device__ __forceinline__ void p8_h2norm(const Args& a, const Ctx& c) {
    const float* cond = (const float*)(a.ws + WS_COND);
    LAS float* Ab = (LAS float*)c.lds; LAS float* Bb = Ab + 2048;
    for (int col = c.tid; col < 2048; col += NTHREADS) { Ab[col] = a.in[5][col] * (1.f + cond[4 * 2048 + col]); Bb[col] = cond[3 * 2048 + col]; }
    __syncthreads();
    norm_rows(a.out, (bf16_t*)(a.ws + WS_H), Ab, Bb, c);
}
__device__ __forceinline__ void p6_mixnorm(const Args& a, const Ctx& c) {
    const bf16_t* YS = (const bf16_t*)(a.ws + WS_YSSM); const bf16_t* YA = (const bf16_t*)(a.ws + WS_YATT); bf16_t* O = (bf16_t*)(a.ws + WS_H);
    for (int t = c.bid * 8 + c.wave; t < L_; t += c.nb * 8) {
#pragma unroll
        for (int part = 0; part < 2; ++part) {
            const bf16_t* src = (part ? YA : YS) + (size_t)t * 1024 + c.lane * 8; const float* beta = a.in[part ? 9 : 8];
            u32x4 w[2]; float f[16]; float ss = 0.f;
#pragma unroll
            for (int j = 0; j < 2; ++j) { w[j] = *(const u32x4*)(src + j * 512);
#pragma unroll
                for (int e = 0; e < 4; ++e) { f[j * 8 + 2 * e] = bflo(w[j][e]); f[j * 8 + 2 * e + 1] = bfhi(w[j][e]); } }
#pragma unroll
            for (int e = 0; e < 16; ++e) ss += f[e] * f[e];
            ss = wave_sum(ss);
            const float rstd = rsqrtf(ss * (1.f / 1024.f) + 1e-6f);
#pragma unroll
            for (int j = 0; j < 2; ++j) { const int col = j * 512 + c.lane * 8; const f32x4 b0 = *(const f32x4*)(beta + col), b1 = *(const f32x4*)(beta + col + 4);
                f32x4 o0, o1;
#pragma unroll
                for (int e = 0; e < 4; ++e) { o0[e] = f[j * 8 + e] * rstd * b0[e]; o1[e] = f[j * 8 + 4 + e] * rstd * b1[e]; }
                *(u32x4*)(O + (size_t)t * 2048 + part * 1024 + col) = pack8(o0, o1); }
        }
    }
}
constexpr int S5_US = 0, S5_ES = 33792, S5_SS = 67584;
template <int PASS>
__device__ __forceinline__ void s5_item(const Args& a, const Ctx& c, int g, int seg) {
    LAS unsigned char* lds = c.lds;
    const int tid = c.tid, wave = c.wave, lane = c.lane, r = lane & 15, q = lane >> 4;
    const bf16_t* U = (const bf16_t*)(a.ws + WS_US);
    const bf16_t* MT = (const bf16_t*)(a.ws + WS_S5MT) + (size_t)g * 65536;
    const bf16_t* WE = (const bf16_t*)(a.ws + WS_S5WE) + (size_t)g * 32768;
    const bf16_t* WC = (const bf16_t*)(a.ws + WS_S5WC) + (size_t)g * 32768;
    const float* s5p = (const float*)(a.ws + WS_S5P);
    float* F = (float*)(a.ws + WS_S5F) + (size_t)g * 4 * 128;
    bf16_t* Z = (bf16_t*)(a.ws + WS_Z);
    bf16x8 bE[8];
#pragma unroll
    for (int ks = 0; ks < 8; ++ks) bE[ks] = *(const bf16x8*)(WE + (size_t)(16 * wave + r) * 256 + 32 * ks + 8 * q);
    float sr = 0.f, si = 0.f, a16r = 0.f, a16i = 0.f;
    if (wave == 0) {
        a16r = s5p[(g * 64 + lane) * 2]; a16i = s5p[(g * 64 + lane) * 2 + 1];
        if (PASS == 1) { const float br = s5p[8192 + (g * 64 + lane) * 2], bi = s5p[8192 + (g * 64 + lane) * 2 + 1];
            for (int s = 0; s < seg; ++s) { const float fr_ = F[s * 128 + lane], fi_ = F[s * 128 + 64 + lane]; const float nr = br * sr - bi * si + fr_, ni = br * si + bi * sr + fi_; sr = nr; si = ni; } }
    }
    for (int sb = 0; sb < 4; ++sb) {
        const int tok0 = seg * 4096 + sb * 1024;
#pragma unroll
        for (int i = 0; i < 4; ++i) { const int ch = tid + NTHREADS * i, token = ch >> 1, half = ch & 1;
            const u32x4 v = *(const u32x4*)(U + (size_t)(tok0 + token) * 1024 + g * 16 + half * 8);
            *(LAS u32x4*)(lds + S5_US + (token >> 4) * 528 + ((token & 15) * 16 + half * 8) * 2) = v; }
        __syncthreads();
#pragma unroll
        for (int m = 0; m < 4; ++m) {
            f32x4 acc = {0.f, 0.f, 0.f, 0.f};
#pragma unroll
            for (int ks = 0; ks < 8; ++ks) { const bf16x8 A = *(const LAS bf16x8*)(lds + S5_US + (16 * m + r) * 528 + (32 * ks + 8 * q) * 2); acc = mfma16(A, bE[ks], acc); }
#pragma unroll
            for (int i = 0; i < 4; ++i) *(LAS float*)(lds + S5_ES + ((16 * m + 4 * q + i) * 132 + 16 * wave + r) * 4) = acc[i];
        }
        __syncthreads();
        if (wave == 0) {
            for (int ch = 0; ch < 64; ++ch) {
                const float er = *(const LAS float*)(lds + S5_ES + (ch * 132 + lane) * 4), ei = *(const LAS float*)(lds + S5_ES + (ch * 132 + 64 + lane) * 4);
                if (PASS == 1) { *(LAS bf16_t*)(lds + S5_SS + (ch * 136 + lane) * 2) = f2bf(sr); *(LAS bf16_t*)(lds + S5_SS + (ch * 136 + 64 + lane) * 2) = f2bf(si); }
                const float nr = a16r * sr - a16i * si + er, ni = a16r * si + a16i * sr + ei; sr = nr; si = ni;
            }
        }
        __syncthreads();
        if (PASS == 1) {
#pragma unroll
            for (int nt = 0; nt < 2; ++nt) {
                const int j = 2 * wave + nt;
                f32x4 acc[4];
#pragma unroll
                for (int m = 0; m < 4; ++m) acc[m] = (f32x4){0.f, 0.f, 0.f, 0.f};
                for (int ks = 0; ks <= (j >> 1); ++ks) {
                    const bf16x8 B = *(const bf16x8*)(MT + (size_t)(16 * j + r) * 256 + 32 * ks + 8 * q);
#pragma unroll
                    for (int m = 0; m < 4; ++m) { const bf16x8 A = *(const LAS bf16x8*)(lds + S5_US + (16 * m + r) * 528 + (32 * ks + 8 * q) * 2); acc[m] = mfma16(A, B, acc[m]); }
                }
#pragma unroll
                for (int ks = 0; ks < 4; ++ks) {
                    const bf16x8 B = *(const bf16x8*)(WC + (size_t)(16 * j + r) * 128 + 32 * ks + 8 * q);
#pragma unroll
                    for (int m = 0; m < 4; ++m) { const bf16x8 A = *(const LAS bf16x8*)(lds + S5_SS + (16 * m + r) * 272 + (32 * ks + 8 * q) * 2); acc[m] = mfma16(A, B, acc[m]); }
                }
#pragma unroll
                for (int m = 0; m < 4; ++m)
#pragma unroll
                    for (int i = 0; i < 4; ++i) { const int ch = 16 * m + 4 * q + i; Z[(size_t)(tok0 + 16 * ch + j) * 1024 + g * 16 + r] = f2bf(gelu_tanh(acc[m][i])); }
            }
            __syncthreads();
        }
    }
    if (PASS == 0 && wave == 0) { F[seg * 128 + lane] = sr; F[seg * 128 + 64 + lane] = si; }
}

__device__ __forceinline__ void cmp_finish_item(const Args& a, const Ctx& c, int kvsel, int rt) {
    LAS unsigned char* lds = c.lds;
    const int tid = c.tid, wave = c.wave, lane = c.lane, r = lane & 15, q = lane >> 4;
    const float* SL = (const float*)(a.ws + WS_SLAB) + (size_t)kvsel * 4 * 2048 * 256;
    const float* bpep = (const float*)(a.ws + WS_BPEP) + kvsel * 256;
    const bf16_t* W2 = (const bf16_t*)(a.ws + WS_W2) + kvsel * 128 * 256;
    for (int e = tid; e < 64 * 64; e += NTHREADS) {
        const int row = e >> 6, c4 = (e & 63) * 4;
        f32x4 s = {0.f, 0.f, 0.f, 0.f};
#pragma unroll 8
        for (int pt = 0; pt < 32; ++pt) s += *(const f32x4*)(bpep + pt * 512 + c4);
#pragma unroll
        for (int ks = 0; ks < 4; ++ks) s += *(const f32x4*)(SL + ((size_t)ks * 2048 + rt * 64 + row) * 256 + c4);
        u32x2 w; w[0] = cvt_pk_bf16(gelu_tanh(s[0]), gelu_tanh(s[1])); w[1] = cvt_pk_bf16(gelu_tanh(s[2]), gelu_tanh(s[3]));
        *(LAS u32x2*)(lds + row * 528 + c4 * 2) = w;
    }
    __syncthreads();
    bf16x8 B[8];
#pragma unroll
    for (int ks = 0; ks < 8; ++ks) B[ks] = *(const bf16x8*)(W2 + (size_t)(16 * wave + r) * 256 + 32 * ks + 8 * q);
#pragma unroll
    for (int m = 0; m < 4; ++m) {
        f32x4 acc = {0.f, 0.f, 0.f, 0.f};
#pragma unroll
        for (int ks = 0; ks < 8; ++ks) { const bf16x8 A = *(const LAS bf16x8*)(lds + (16 * m + r) * 528 + (32 * ks + 8 * q) * 2); acc = mfma16(A, B[ks], acc); }
#pragma unroll
        for (int i = 0; i < 4; ++i) {
            const int row = rt * 64 + 16 * m + 4 * q + i, gi = row >> 10, ci = row & 1023, n = 16 * wave + r;
            const bf16_t v = (ci == 1023) ? (bf16_t)0 : f2bf(acc[i]);
            if (kvsel == 0) ((bf16_t*)(a.ws + WS_KC))[((size_t)gi * 1024 + ci) * 128 + n] = v;
            else ((bf16_t*)(a.ws + WS_VCT))[((size_t)gi * 128 + n) * 1024 + ci] = v;
        }
    }
    __syncthreads();
}
constexpr int AT_KB = 0, AT_VB = 34816, AT_IMP = 69632, AT_TB = 135168, AT_BM = 147968, AT_WU = 150016, AT_END = 150272;
constexpr int AT_KBUF = 64 * 272, AT_VBUF = 128 * 136;
struct TileRegs { u32x4 k[2]; u32x4 v[2]; };
template <bool NEEDV>
__device__ __forceinline__ void tile_load(TileRegs& R, const bf16_t* Kt, const bf16_t* Vt, int ldv, int tid) {
#pragma unroll
    for (int i = 0; i < 2; ++i) { const int ch = tid + NTHREADS * i; R.k[i] = *(const u32x4*)(Kt + (ch >> 4) * 128 + (ch & 15) * 8); }
    if (NEEDV) {
#pragma unroll
        for (int i = 0; i < 2; ++i) { const int ch = tid + NTHREADS * i; R.v[i] = *(const u32x4*)(Vt + (size_t)(ch >> 3) * ldv + (ch & 7) * 8); }
    }
}
template <bool NEEDV>
__device__ __forceinline__ void tile_store(const TileRegs& R, LAS unsigned char* kb, LAS unsigned char* vb, int tid) {
#pragma unroll
    for (int i = 0; i < 2; ++i) { const int ch = tid + NTHREADS * i; *(LAS u32x4*)(kb + (ch >> 4) * 272 + (ch & 15) * 16) = R.k[i]; }
    if (NEEDV) {
#pragma unroll
        for (int i = 0; i < 2; ++i) { const int ch = tid + NTHREADS * i; LAS unsigned char* p = vb + (ch >> 3) * 136 + (ch & 7) * 16;
            *(LAS u32x2*)p = (u32x2){R.v[i][0], R.v[i][1]}; *(LAS u32x2*)(p + 8) = (u32x2){R.v[i][2], R.v[i][3]}; }
    }
}
template <int BR>
__device__ __forceinline__ void attn_tile(LAS const unsigned char* kb, LAS const unsigned char* vb, LAS const float* tb, int key0, int t, int lane,
                                          const bf16x8 (&qf)[8], f32x16 (&O)[4], float& m, float& l, float inv_l, bool selbit, LAS float* imp_row) {
    const int r31 = lane & 31, h = lane >> 5;
#pragma unroll
    for (int sub = 0; sub < 2; ++sub) {
        f32x16 S;
#pragma unroll
        for (int r = 0; r < 16; ++r) S[r] = 0.f;
#pragma unroll
        for (int ks = 0; ks < 8; ++ks) { const bf16x8 A = *(const LAS bf16x8*)(kb + (sub * 32 + r31) * 272 + ks * 32 + h * 16); S = mfma32(A, qf[ks], S); }
        float mx = -INFINITY;
#pragma unroll
        for (int r = 0; r < 16; ++r) {
            const int kk = key0 + sub * 32 + (r & 3) + 8 * (r >> 2) + 4 * h;
            int dist; bool valid;
            if (BR <= 1) { dist = t - (16 * kk + 31); valid = dist >= 0; }
            else if (BR == 2) { dist = t - kk; valid = selbit && dist >= 0; }
            else { dist = t - kk; valid = dist >= 0 && dist < 512; }
            const int idx = min(max(dist, 0), TBN - 1);
            const float v = valid ? S[r] + tb[idx] : -INFINITY;
            S[r] = v; mx = fmaxf(mx, v);
        }
        if (BR != 1) {
            mx = fmaxf(mx, shfl_xor_f(mx, 32));
            const float mn = fmaxf(m, mx), mu = (mn == -INFINITY) ? 0.f : mn;
            float ps = 0.f;
#pragma unroll
            for (int r = 0; r < 16; ++r) { const float p = fexp2(S[r] - mu); S[r] = p; ps += p; }
            if (__any(mn > m)) {
                const float alpha = fexp2(m - mu);
                l *= alpha;
                if (BR >= 2) {
#pragma unroll
                    for (int dt = 0; dt < 4; ++dt)
#pragma unroll
                        for (int r = 0; r < 16; ++r) O[dt][r] *= alpha;
                }
            }
            l += ps; m = mn;
        } else {
            const float mu = (m == -INFINITY) ? 0.f : m;
#pragma unroll
            for (int r = 0; r < 16; ++r) S[r] = fexp2(S[r] - mu) * inv_l;
#pragma unroll
            for (int rg = 0; rg < 4; ++rg) {
                float A = 2.f * (S[4 * rg] + S[4 * rg + 1] + S[4 * rg + 2]) + S[4 * rg + 3], B = S[4 * rg + 3];
                A = quad_sum(A); B = quad_sum(B);
                const int jj = ((key0 + sub * 32) >> 2) + 2 * rg + h;
                if ((lane & 3) == 0) {
                    __hip_atomic_fetch_add(imp_row + jj, A, __ATOMIC_RELAXED, __HIP_MEMORY_SCOPE_WORKGROUP);
                    if (jj + 1 < 256) __hip_atomic_fetch_add(imp_row + jj + 1, B, __ATOMIC_RELAXED, __HIP_MEMORY_SCOPE_WORKGROUP);
                }
            }
        }
        if (BR >= 1) {
#pragma unroll
            for (int s1 = 0; s1 < 2; ++s1) {
                const int s = 2 * sub + s1;
                u32x4 pk;
#pragma unroll
                for (int e = 0; e < 4; ++e) pk[e] = cvt_pk_bf16(S[8 * s1 + 2 * e], S[8 * s1 + 2 * e + 1]);
                const bf16x8 pf = __builtin_bit_cast(bf16x8, pk);
#pragma unroll
                for (int dt = 0; dt < 4; ++dt) {
                    LAS const unsigned char* vp = vb + (32 * dt + r31) * 136 + (16 * s + 4 * h) * 2;
                    const u32x2 lo = *(const LAS u32x2*)vp, hi = *(const LAS u32x2*)(vp + 16);
                    const u32x4 av = {lo[0], lo[1], hi[0], hi[1]};
                    O[dt] = mfma32(__builtin_bit_cast(bf16x8, av), pf, O[dt]);
                }
            }
        }
    }
}
template <int BR>
__device__ __forceinline__ void run_branch(const Ctx& c, const bf16_t* Kb, const bf16_t* Vtb, int ldv, int lo, int hi, LAS const float* tb, int t,
                                           const bf16x8 (&qf)[8], f32x16 (&O)[4], float& m, float& l, float inv_l, int tl, LAS float* imp_row) {
    constexpr bool NEEDV = (BR != 0);
    LAS unsigned char* lds = c.lds;
    TileRegs R;
    int tidz = c.tid; asm volatile("" : "+v"(tidz));
    tile_load<NEEDV>(R, Kb + (size_t)lo * 64 * 128, Vtb + (size_t)lo * 64, ldv, tidz);
    tile_store<NEEDV>(R, lds + AT_KB, lds + AT_VB, tidz);
    __syncthreads();
    for (int j = lo; j < hi; ++j) {
        const int buf = (j - lo) & 1;
        if (j + 1 < hi) tile_load<NEEDV>(R, Kb + (size_t)(j + 1) * 64 * 128, Vtb + (size_t)(j + 1) * 64, ldv, tidz);
        bool selbit = true, wave_on = true;
        if (BR == 2) {
            const unsigned w = *(const LAS unsigned*)(lds + AT_BM + (tl * 8 + (j >> 5)) * 4);
            selbit = (w >> (j & 31)) & 1u;
            const unsigned wu = *(const LAS unsigned*)(lds + AT_WU + (c.wave * 8 + (j >> 5)) * 4);
            wave_on = (wu >> (j & 31)) & 1u;
        }
        if (wave_on) attn_tile<BR>(lds + AT_KB + buf * AT_KBUF, lds + AT_VB + buf * AT_VBUF, tb, j * 64, t, c.lane, qf, O, m, l, inv_l, selbit, imp_row);
        if (j + 1 < hi) tile_store<NEEDV>(R, lds + AT_KB + (buf ^ 1) * AT_KBUF, lds + AT_VB + (buf ^ 1) * AT_VBUF, tidz);
        __syncthreads();
    }
}
__device__ __forceinline__ void attn_item(const Args& a, const Ctx& c, int qt, int g) {
    LAS unsigned char* lds = c.lds;
    const int tid = c.tid, wave = c.wave, lane = c.lane, r31 = lane & 31, h = lane >> 5, hl = lane & 3;
    const int t0 = qt * 64, tl = 8 * wave + (r31 >> 2), t = t0 + tl, head = g * 4 + hl;
    const bf16_t* Qb = (const bf16_t*)(a.ws + WS_Q);
    const bf16_t* KROW = (const bf16_t*)(a.ws + WS_KROW);
    const bf16_t* VT = (const bf16_t*)(a.ws + WS_VT);
    const float* GATE = (const float*)(a.ws + WS_GATE);
    { const float* tbg = (const float*)(a.ws + WS_TB) + g * 4 * TBN;
      for (int i = tid; i < 4 * TBN; i += NTHREADS) *(LAS float*)(lds + AT_TB + i * 4) = tbg[i];
      for (int i = tid; i < 64 * 256; i += NTHREADS) *(LAS float*)(lds + AT_IMP + i * 4) = 0.f; }
    bf16x8 qf[8];
#pragma unroll
    for (int ks = 0; ks < 8; ++ks) qf[ks] = *(const bf16x8*)(Qb + (size_t)t * 1024 + head * 128 + 16 * ks + 8 * h);
    LAS const float* tb = (LAS const float*)(lds + AT_TB) + hl * TBN;
    LAS float* imp_row = (LAS float*)(lds + AT_IMP) + tl * 256;
    f32x16 O[4]; unsigned Otp[4][8];
#pragma unroll
    for (int dt = 0; dt < 4; ++dt)
#pragma unroll
        for (int r = 0; r < 16; ++r) O[dt][r] = 0.f;
    __syncthreads();
    { const int ntile = (t0 / 16 + 3 + 63) / 64;
      const bf16_t* KC = (const bf16_t*)(a.ws + WS_KC) + (size_t)g * 1024 * 128; const bf16_t* VCT = (const bf16_t*)(a.ws + WS_VCT) + (size_t)g * 128 * 1024;
      float m = -INFINITY, l = 0.f;
      run_branch<0>(c, KC, VCT, 1024, 0, ntile, tb, t, qf, O, m, l, 0.f, tl, imp_row);
      const float lt = l + shfl_xor_f(l, 32), inv = lt > 0.f ? 1.f / lt : 0.f;
      run_branch<1>(c, KC, VCT, 1024, 0, ntile, tb, t, qf, O, m, l, inv, tl, imp_row);
      const float gc = GATE[(size_t)t * 24 + head];
#pragma unroll
      for (int dt = 0; dt < 4; ++dt)
#pragma unroll
          for (int r = 0; r < 8; ++r) { Otp[dt][r] = cvt_pk_bf16(gc * O[dt][2 * r], gc * O[dt][2 * r + 1]); O[dt][2 * r] = 0.f; O[dt][2 * r + 1] = 0.f; }
    }
    {
        unsigned wu[8];
#pragma unroll
        for (int k = 0; k < 8; ++k) wu[k] = 0u;
        const int ncand = qt - 2 > 0 ? qt - 2 : 0;
        for (int i = 0; i < 8; ++i) {
            LAS const float* row = (LAS const float*)(lds + AT_IMP) + (8 * wave + i) * 256;
            float v[4]; bool sel[4];
#pragma unroll
            for (int k = 0; k < 4; ++k) { const int j = lane + 64 * k; const bool cand = (j >= 1 && j <= qt - 2); v[k] = cand ? row[j] : -1.f; sel[k] = false; }
            if (ncand <= 13) {
#pragma unroll
                for (int k = 0; k < 4; ++k) sel[k] = v[k] >= 0.f;
            } else {
                for (int it = 0; it < 13; ++it) {
                    float mx = fmaxf(fmaxf(v[0], v[1]), fmaxf(v[2], v[3])); mx = wave_max(mx);
                    int wk = -1, wl = 0;
#pragma unroll
                    for (int k = 0; k < 4; ++k) { const unsigned long long mk = __ballot(v[k] == mx); if (wk < 0 && mk != 0ull) { wk = k; wl = __ffsll((long long)mk) - 1; } }
#pragma unroll
                    for (int k = 0; k < 4; ++k) if (k == wk && lane == wl) { v[k] = -1.f; sel[k] = true; }
                }
            }
#pragma unroll
            for (int k = 0; k < 4; ++k) {
                const int j = lane + 64 * k; const bool forced = (j == 0) || (j == qt) || (j == qt - 1);
                const unsigned long long mk = __ballot(sel[k] || forced);
                const unsigned lo = (unsigned)mk, hi = (unsigned)(mk >> 32);
                if (lane == 0) { *(LAS unsigned*)(lds + AT_BM + ((8 * wave + i) * 8 + 2 * k) * 4) = lo; *(LAS unsigned*)(lds + AT_BM + ((8 * wave + i) * 8 + 2 * k + 1) * 4) = hi; }
                wu[2 * k] |= lo; wu[2 * k + 1] |= hi;
            }
        }
        if (lane == 0) {
#pragma unroll
            for (int k = 0; k < 8; ++k) *(LAS unsigned*)(lds + AT_WU + (wave * 8 + k) * 4) = wu[k];
        }
    }
    LAS unsigned* park = (LAS unsigned*)(lds + AT_IMP + wave * 8192) + lane;
#pragma unroll
    for (int dt = 0; dt < 4; ++dt)
#pragma unroll
        for (int r = 0; r < 8; ++r) park[(dt * 8 + r) * 64] = Otp[dt][r];
    __syncthreads();
    { float m = -INFINITY, l = 0.f;
      run_branch<2>(c, KROW + (size_t)(2 + g) * L_ * 128, VT + (size_t)g * 128 * L_, L_, 0, qt + 1, tb, t, qf, O, m, l, 0.f, tl, imp_row);
      const float gs = GATE[(size_t)t * 24 + 8 + head];
      const float lt = l + shfl_xor_f(l, 32), sc = gs * (lt > 0.f ? 1.f / lt : 0.f);
#pragma unroll
      for (int dt = 0; dt < 4; ++dt)
#pragma unroll
          for (int r = 0; r < 8; ++r) { const unsigned w = park[(dt * 8 + r) * 64]; park[(dt * 8 + r) * 64] = cvt_pk_bf16(bflo(w) + sc * O[dt][2 * r], bfhi(w) + sc * O[dt][2 * r + 1]); O[dt][2 * r] = 0.f; O[dt][2 * r + 1] = 0.f; }
    }
    { float m = -INFINITY, l = 0.f;
      const int lo = qt - 8 > 0 ? qt - 8 : 0;
      run_branch<3>(c, KROW + (size_t)(4 + g) * L_ * 128, VT + (size_t)(2 + g) * 128 * L_, L_, lo, qt + 1, tb, t, qf, O, m, l, 0.f, tl, imp_row);
      const float gw = GATE[(size_t)t * 24 + 16 + head];
      const float lt = l + shfl_xor_f(l, 32), sc = gw * (lt > 0.f ? 1.f / lt : 0.f);
#pragma unroll
      for (int dt = 0; dt < 4; ++dt)
#pragma unroll
          for (int r = 0; r < 8; ++r) { const unsigned w = park[(dt * 8 + r) * 64]; Otp[dt][r] = cvt_pk_bf16(bflo(w) + sc * O[dt][2 * r], bfhi(w) + sc * O[dt][2 * r + 1]); }
    }
    bf16_t* Y = (bf16_t*)(a.ws + WS_YATT) + (size_t)t * 1024 + head * 128;
#pragma unroll
    for (int dt = 0; dt < 4; ++dt)
#pragma unroll
        for (int rg = 0; rg < 4; ++rg) {
            u32x2 w; w[0] = Otp[dt][2 * rg]; w[1] = Otp[dt][2 * rg + 1];
            *(u32x2*)(Y + 32 * dt + 8 * rg + 4 * h) = w;
        }
    __syncthreads();
}
#ifndef PEER_ALPHA
#define PEER_ALPHA 1.0f
#endif
constexpr int PE_SC = 0, PE_LV = 66048, PE_LI = 74240, PE_EX = 82432, PE_GT = 86528, PE_END = 90624;
__device__ __forceinline__ float wave_sum_bcast(float v) {
    v += dpp_f<0xB1>(v); v += dpp_f<0x4E>(v); v += dpp_f<0x141>(v); v += dpp_f<0x140>(v);
    v += __int_as_float(__builtin_amdgcn_update_dpp(0, __float_as_int(v), 0x142, 0xa, 0xf, false));
    v += __int_as_float(__builtin_amdgcn_update_dpp(0, __float_as_int(v), 0x143, 0xc, 0xf, false));
    return __int_as_float(__builtin_amdgcn_readlane(__float_as_int(v), 63));
}
__device__ __forceinline__ unsigned mono_key(float v) { const unsigned b = __float_as_uint(v); return b ^ ((b >> 31) ? 0xFFFFFFFFu : 0x80000000u); }
struct RowRegs { u32x4 u[2]; u32x4 v[2]; float su, sv; };
__device__ __forceinline__ void row_load(RowRegs& R, const unsigned char* PU, const unsigned char* PV, const float* psc, int e, int lane) {
    const unsigned char* up = PU + (size_t)e * 2048 + lane * 16; const unsigned char* vp = PV + (size_t)e * 2048 + lane * 16;
#pragma unroll
    for (int j = 0; j < 2; ++j) { R.u[j] = *(const u32x4*)(up + j * 1024); R.v[j] = *(const u32x4*)(vp + j * 1024); }
    R.su = psc[e]; R.sv = psc[16384 + e];
}
__device__ __forceinline__ void row_apply(const RowRegs& R, const float (&hp)[32], float gate, float (&acc)[32]) {
    float d0 = 0.f, d1 = 0.f;
#pragma unroll
    for (int j = 0; j < 2; ++j)
#pragma unroll
        for (int w = 0; w < 4; ++w) {
            const f32x2 lo = __builtin_amdgcn_cvt_pk_f32_fp8((int)R.u[j][w], false), hi = __builtin_amdgcn_cvt_pk_f32_fp8((int)R.u[j][w], true);
            d0 += lo[0] * hp[j * 16 + 4 * w] + hi[0] * hp[j * 16 + 4 * w + 2];
            d1 += lo[1] * hp[j * 16 + 4 * w + 1] + hi[1] * hp[j * 16 + 4 * w + 3];
        }
    const float d = wave_sum_bcast(d0 + d1) * R.su;
    const float wgt = gate * gelu_tanh(d) * R.sv;
#pragma unroll
    for (int j = 0; j < 2; ++j)
#pragma unroll
        for (int w = 0; w < 4; ++w) {
            const f32x2 lo = __builtin_amdgcn_cvt_pk_f32_fp8((int)R.v[j][w], false), hi = __builtin_amdgcn_cvt_pk_f32_fp8((int)R.v[j][w], true);
            acc[j * 16 + 4 * w] += wgt * lo[0]; acc[j * 16 + 4 * w + 1] += wgt * lo[1]; acc[j * 16 + 4 * w + 2] += wgt * hi[0]; acc[j * 16 + 4 * w + 3] += wgt * hi[1];
        }
}
template <bool DRY>
__device__ __forceinline__ void peer_step(const Args& a, const Ctx& c, int t0) {
    LAS unsigned char* lds = c.lds;
    const int tid = c.tid, wave = c.wave, lane = c.lane, r = lane & 15, q = lane >> 4;
    const bf16_t* QP = (const bf16_t*)(a.ws + WS_QP); const bf16_t* PK = (const bf16_t*)(a.ws + WS_PK);
    const unsigned char* PU = a.ws + WS_PU; const unsigned char* PV = a.ws + WS_PV; const float* psc = (const float*)(a.ws + WS_PSC);
    const bf16_t* HB = (const bf16_t*)(a.ws + WS_H);
    {
        const int hh = wave;
#pragma unroll
        for (int cc = 0; cc < 2; ++cc) {
            bf16x8 aF[4];
#pragma unroll
            for (int ks = 0; ks < 4; ++ks) aF[ks] = *(const bf16x8*)(QP + (size_t)(t0 + (r & 7)) * 2048 + hh * 256 + cc * 128 + 32 * ks + 8 * q);
#pragma unroll 2
            for (int nt = 0; nt < 8; ++nt) {
                f32x4 acc = {0.f, 0.f, 0.f, 0.f};
#pragma unroll
                for (int ks = 0; ks < 4; ++ks) { const bf16x8 B = *(const bf16x8*)(PK + (size_t)(cc * 128 + 16 * nt + r) * 128 + 32 * ks + 8 * q); acc = mfma16(aF[ks], B, acc); }
                if (q < 2) {
#pragma unroll
                    for (int i = 0; i < 4; ++i) { const int tok = 4 * q + i; *(LAS float*)(lds + PE_SC + ((tok * 16 + hh * 2 + cc) * 129 + 16 * nt + r) * 4) = acc[i]; }
                }
            }
        }
    }
    __syncthreads();
    if (tid < 128) {
        LAS const float* sc = (LAS const float*)(lds + PE_SC) + tid * 129;
        unsigned top[16];
#pragma unroll
        for (int e = 0; e < 16; ++e) top[e] = 0u;
#pragma unroll 2
        for (int k = 0; k < 128; ++k) {
            unsigned key = (mono_key(sc[k]) & ~0x7Fu) | (unsigned)(127 - k);
#pragma unroll
            for (int e = 0; e < 16; ++e) { const unsigned hi = max(top[e], key); key = min(top[e], key); top[e] = hi; }
        }
#pragma unroll
        for (int e = 0; e < 16; ++e) { const int idx = 127 - (int)(top[e] & 0x7Fu); *(LAS float*)(lds + PE_LV + (tid * 16 + e) * 4) = sc[idx]; *(LAS int*)(lds + PE_LI + (tid * 16 + e) * 4) = idx; }
    }
    __syncthreads();
    if (tid < 64) {
        const int tok = tid >> 3, hh = tid & 7, t1 = tok * 16 + hh * 2, t2 = t1 + 1;
        float v1[16], v2[16];
#pragma unroll
        for (int e = 0; e < 16; ++e) { v1[e] = *(const LAS float*)(lds + PE_LV + (t1 * 16 + e) * 4); v2[e] = *(const LAS float*)(lds + PE_LV + (t2 * 16 + e) * 4); }
        unsigned top[16];
#pragma unroll
        for (int e = 0; e < 16; ++e) top[e] = 0u;
#pragma unroll
        for (int aa = 0; aa < 16; ++aa)
#pragma unroll
            for (int bb = 0; bb < 16; ++bb)
                if ((aa + 1) * (bb + 1) <= 16) {
                    unsigned key = (mono_key(v1[aa] + v2[bb]) & ~0xFFu) | (unsigned)(255 - (aa * 16 + bb));
#pragma unroll
                    for (int e = 0; e < 16; ++e) { const unsigned hi = max(top[e], key); key = min(top[e], key); top[e] = hi; }
                }
        float sv[16]; int ex[16]; float mx = -INFINITY;
#pragma unroll
        for (int e = 0; e < 16; ++e) {
            const int id = 255 - (int)(top[e] & 0xFFu), aa = id >> 4, bb = id & 15;
            sv[e] = *(const LAS float*)(lds + PE_LV + (t1 * 16 + aa) * 4) + *(const LAS float*)(lds + PE_LV + (t2 * 16 + bb) * 4);
            ex[e] = *(const LAS int*)(lds + PE_LI + (t1 * 16 + aa) * 4) * 128 + *(const LAS int*)(lds + PE_LI + (t2 * 16 + bb) * 4);
            mx = fmaxf(mx, sv[e]);
        }
        float sum = 0.f;
#pragma unroll
        for (int e = 0; e < 16; ++e) { sv[e] = fexp2((sv[e] - mx) * LOG2E); sum += sv[e]; }
        const float inv = 1.f / sum;
#pragma unroll
        for (int e = 0; e < 16; ++e) { *(LAS int*)(lds + PE_EX + (tok * 128 + hh * 16 + e) * 4) = ex[e]; *(LAS float*)(lds + PE_GT + (tok * 128 + hh * 16 + e) * 4) = sv[e] * inv; }
    }
    __syncthreads();
    const int t = t0 + wave;
    float hp[32];
#pragma unroll
    for (int j = 0; j < 2; ++j)
#pragma unroll
        for (int k = 0; k < 2; ++k) { const u32x4 w = *(const u32x4*)(HB + (size_t)t * 2048 + j * 1024 + lane * 16 + k * 8);
#pragma unroll
            for (int e = 0; e < 4; ++e) { hp[j * 16 + k * 8 + 2 * e] = bflo(w[e]); hp[j * 16 + k * 8 + 2 * e + 1] = bfhi(w[e]); } }
    float acc[32];
#pragma unroll
    for (int e = 0; e < 32; ++e) acc[e] = 0.f;
    {
        LAS const int* exl = (LAS const int*)(lds + PE_EX) + wave * 128; LAS const float* gtl = (LAS const float*)(lds + PE_GT) + wave * 128;
        RowRegs R0, R1, R2, R3;
        row_load(R0, PU, PV, psc, __builtin_amdgcn_readfirstlane(exl[0]), lane);
        row_load(R1, PU, PV, psc, __builtin_amdgcn_readfirstlane(exl[1]), lane);
        row_load(R2, PU, PV, psc, __builtin_amdgcn_readfirstlane(exl[2]), lane);
        row_load(R3, PU, PV, psc, __builtin_amdgcn_readfirstlane(exl[3]), lane);
#pragma unroll 1
        for (int e = 0; e < 128; e += 4) {
            const bool more = e + 4 < 128;
            row_apply(R0, hp, gtl[e], acc);     if (more) row_load(R0, PU, PV, psc, __builtin_amdgcn_readfirstlane(exl[e + 4]), lane);
            row_apply(R1, hp, gtl[e + 1], acc); if (more) row_load(R1, PU, PV, psc, __builtin_amdgcn_readfirstlane(exl[e + 5]), lane);
            row_apply(R2, hp, gtl[e + 2], acc); if (more) row_load(R2, PU, PV, psc, __builtin_amdgcn_readfirstlane(exl[e + 6]), lane);
            row_apply(R3, hp, gtl[e + 3], acc); if (more) row_load(R3, PU, PV, psc, __builtin_amdgcn_readfirstlane(exl[e + 7]), lane);
        }
    }
    {
        float* xo = a.out + (size_t)t * 2048; const float* g2 = (const float*)(a.ws + WS_COND) + 5 * 2048; const float* fg = a.in[32];
        float ss = 0.f;
#pragma unroll
        for (int j = 0; j < 2; ++j)
#pragma unroll
            for (int k = 0; k < 4; ++k) {
                const int col = j * 1024 + lane * 16 + k * 4;
                const f32x4 x1 = *(const f32x4*)(xo + col), gv = *(const f32x4*)(g2 + col);
#pragma unroll
                for (int e = 0; e < 4; ++e) { const float x2 = x1[e] + PEER_ALPHA * gv[e] * acc[j * 16 + k * 4 + e]; acc[j * 16 + k * 4 + e] = x2; ss += x2 * x2; }
            }
        ss = wave_sum_bcast(ss);
        const float rstd = rsqrtf(ss * (1.f / 2048.f) + 1e-6f);
#pragma unroll
        for (int j = 0; j < 2; ++j)
#pragma unroll
            for (int k = 0; k < 4; ++k) {
                const int col = j * 1024 + lane * 16 + k * 4;
                const f32x4 fv = *(const f32x4*)(fg + col);
                f32x4 o;
#pragma unroll
                for (int e = 0; e < 4; ++e) o[e] = acc[j * 16 + k * 4 + e] * rstd * fv[e];
                if (!DRY || rstd == 123.456f) *(f32x4*)(xo + col) = o;
            }
    }
    __syncthreads();
}
constexpr int NPHASE = 11;
#ifndef DBG
#define DBG 0
#endif
__device__ __forceinline__ void dbg_final_norm(const Args& a, const Ctx& c, const float* src) {
    for (int t = c.bid * 8 + c.wave; t < L_; t += c.nb * 8) {
        const float* xr = src + (size_t)t * 2048 + c.lane * 4; float* o = a.out + (size_t)t * 2048 + c.lane * 4;
        f32x4 v[8]; float ss = 0.f;
#pragma unroll
        for (int j = 0; j < 8; ++j) { v[j] = *(const f32x4*)(xr + j * 256); ss += v[j][0] * v[j][0] + v[j][1] * v[j][1] + v[j][2] * v[j][2] + v[j][3] * v[j][3]; }
        ss = wave_sum(ss);
        const float rstd = rsqrtf(ss * (1.f / 2048.f) + 1e-6f);
#pragma unroll
        for (int j = 0; j < 8; ++j) { const f32x4 g = *(const f32x4*)(a.in[32] + j * 256 + c.lane * 4); *(f32x4*)(o + j * 256) = v[j] * rstd * g; }
    }
}

extern __shared__ __attribute__((aligned(16))) unsigned char smem[];

__global__ void __launch_bounds__(512, 2) fwd(Args a) {
    LAS unsigned char* lds = (LAS unsigned char*)smem;
    Ctx c; c.bid = blockIdx.x; c.nb = gridDim.x; c.tid = threadIdx.x; c.wave = __builtin_amdgcn_readfirstlane(threadIdx.x >> 6); c.lane = threadIdx.x & 63; c.lds = lds;
    volatile LAS unsigned* xbw = (volatile LAS unsigned*)(lds + LDS_BYTES - 16);
    if (c.tid < 4) xbw[c.tid] = 0u;
    __syncthreads();
    const int lo = a.ph_lo, hi = a.ph_hi;
    const bool multi = (hi - lo) > 1;
    XcdBarrier bar; bar.bar = (unsigned*)(a.ws + WS_CTL); bar.x = 0; bar.st = xbw;
    if (multi) bar = xcd_barrier_post((unsigned*)(a.ws + WS_CTL), xbw);
#ifndef PHASE_MASK
#define PHASE_MASK 0xFFFF
#endif
#if DBG == 1
#undef PHASE_MASK
#define PHASE_MASK 0x403
#elif DBG == 2 || DBG == 4 || DBG == 5
#undef PHASE_MASK
#define PHASE_MASK 0x4FF
#endif
#define IN(k) (((PHASE_MASK >> (k)) & 1) && lo <= (k) && (k) < hi)
#define SEAM(k) do { if (IN(k) && IN((k) + 1)) xcd_barrier(bar); } while (0)
#ifndef DUP
#define DUP -1
#endif
#define REP(k) for (int rep_ = 0; rep_ < ((DUP == (k)) ? 2 : 1); ++rep_)

    if (IN(0)) REP(0) { p0_prologue(a, c); }
    SEAM(0);
    if (IN(1)) { p1_hnorm(a, c); }
    SEAM(1);
    if (IN(2)) REP(2) {
        pg8::StaticOrder S; S.init((const bf16_t*)(a.ws + WS_H), (const bf16_t*)(a.ws + WS_WIN), 2048, 2048, 2048, L_, DIN_PAD, c.nb, c.bid);
        EpiWin E{(bf16_t*)(a.ws + WS_US), (bf16_t*)(a.ws + WS_Q), (bf16_t*)(a.ws + WS_KROW), (bf16_t*)(a.ws + WS_VROW), (bf16_t*)(a.ws + WS_VT), (float*)(a.ws + WS_GATE)};
        pg8::gemm_phase<EpiWin, pg8::StaticOrder>(lds, S, E);
    }
    SEAM(2);
    if (IN(3)) REP(3) {
        for (int it = c.bid; it < 256; it += c.nb) s5_item<0>(a, c, it >> 2, it & 3);
        __syncthreads();
        CmpOrder S{(const bf16_t*)(a.ws + WS_KROW), (const bf16_t*)(a.ws + WS_VROW), (const bf16_t*)(a.ws + WS_W1), 2048, 4096, 1024, c.nb, c.bid};
        EpiSlab E{(float*)(a.ws + WS_SLAB)};
        pg8::gemm_phase<EpiSlab, CmpOrder>(lds, S, E);
    }
    SEAM(3);
    if (IN(4)) REP(4) {
        for (int it = c.bid; it < 64; it += c.nb) cmp_finish_item(a, c, it >> 5, it & 31);
        for (int it = c.bid; it < 256; it += c.nb) s5_item<1>(a, c, it >> 2, it & 3);
    }
    SEAM(4);
    if (IN(5)) {
#if DBG == 5
        for (size_t i = (size_t)c.bid * NTHREADS + c.tid; i < (size_t)L_ * 1024 / 8; i += (size_t)c.nb * NTHREADS) *(u32x4*)((bf16_t*)(a.ws + WS_YSSM) + i * 8) = (u32x4){0u, 0u, 0u, 0u};
#else
        {
            pg8::StaticOrder S; S.init((const bf16_t*)(a.ws + WS_Z), (const bf16_t*)(a.ws + WS_WGLU), 1024, 1024, 1024, L_, 1024, c.nb, c.bid);
            EpiGlu E{(const bf16_t*)(a.ws + WS_Z), a.in[19], (bf16_t*)(a.ws + WS_YSSM)};
            pg8::gemm_phase<EpiGlu, pg8::StaticOrder>(lds, S, E);
        }
#endif
        __syncthreads();
        REP(5)
#if DBG == 4
        for (size_t i = (size_t)c.bid * NTHREADS + c.tid; i < (size_t)L_ * 1024 / 8; i += (size_t)c.nb * NTHREADS) *(u32x4*)((bf16_t*)(a.ws + WS_YATT) + i * 8) = (u32x4){0u, 0u, 0u, 0u};
#else
        for (int it = c.bid; it < 512; it += c.nb) {
            const int rnd = it / c.nb;
            const int qt = (rnd & 1) ? 255 - (it % 256) : (it % 256), g = (it >> 8) & 1;
            attn_item(a, c, qt, g);
        }
#endif
    }
    SEAM(5);
    if (IN(6)) { p6_mixnorm(a, c); }
    SEAM(6);
    if (IN(7)) {
        pg8::StaticOrder S; S.init((const bf16_t*)(a.ws + WS_H), (const bf16_t*)(a.ws + WS_WOUT), 2048, 2048, 2048, L_, 2048, c.nb, c.bid);
        EpiWout E{a.in[0], (const float*)(a.ws + WS_COND) + 2 * 2048, a.out};
        pg8::gemm_phase<EpiWout, pg8::StaticOrder>(lds, S, E);
    }
    SEAM(7);
    if (IN(8)) { p8_h2norm(a, c); }
    SEAM(8);
    if (IN(9)) {
        pg8::StaticOrder S; S.init((const bf16_t*)(a.ws + WS_H), (const bf16_t*)(a.ws + WS_WQ), 2048, 2048, 2048, L_, 2048, c.nb, c.bid);
        EpiBf16 E{(bf16_t*)(a.ws + WS_QP), 2048};
        pg8::gemm_phase<EpiBf16, pg8::StaticOrder>(lds, S, E);
    }
    SEAM(9);
    if (IN(10)) {
#if DBG == 1
        dbg_final_norm(a, c, a.in[0]);
#elif DBG == 2 || DBG == 4 || DBG == 5
        dbg_final_norm(a, c, a.out);
#else
        if (DUP == 10) { for (int s = c.bid; s < L_ / 8; s += c.nb) peer_step<true>(a, c, s * 8); }
        for (int s = c.bid; s < L_ / 8; s += c.nb) peer_step<false>(a, c, s * 8);
#endif
    }
#undef IN
#undef SEAM
}

#ifndef N_LAUNCHES
#define N_LAUNCHES 1
#endif
extern "C" void kernel_launch(void* const* d_in, const int* in_sizes, int n_in, void* d_out, int out_size, void* d_ws, size_t ws_size, hipStream_t stream) {
    static int grid = 0;
    if (grid == 0) {
        if (n_in != 33 || out_size != L_ * D_ || ws_size < WS_END) { fprintf(stderr, "kernel_launch: unexpected shapes (n_in %d, out %d, ws %zu < %zu); nothing launched\n", n_in, out_size, ws_size, (size_t)WS_END); grid = -1; return; }
        int dev = 0, cus = 0, per_cu = 0;
        if (hipGetDevice(&dev) != hipSuccess || hipDeviceGetAttribute(&cus, hipDeviceAttributeMultiprocessorCount, dev) != hipSuccess) { grid = -1; return; }
        if (hipFuncSetAttribute((const void*)fwd, hipFuncAttributeMaxDynamicSharedMemorySize, LDS_BYTES) != hipSuccess) { fprintf(stderr, "kernel_launch: hipFuncSetAttribute failed\n"); grid = -1; return; }
        if (hipOccupancyMaxActiveBlocksPerMultiprocessor(&per_cu, (const void*)fwd, NTHREADS, LDS_BYTES) != hipSuccess || per_cu < 1) { fprintf(stderr, "kernel_launch: occupancy query says %d\n", per_cu); (void)hipGetLastError(); grid = -1; return; }
        grid = cus;
    }
    if (grid < 0) return;
    (void)hipMemsetAsync((char*)d_ws + WS_CTL, 0, CTL_BYTES, stream);
    Args a{};
    for (int i = 0; i < 33; ++i) a.in[i] = (const float*)d_in[i];
    a.out = (float*)d_out; a.ws = (unsigned char*)d_ws;
    if (N_LAUNCHES == 1) { a.ph_lo = 0; a.ph_hi = NPHASE; hipLaunchKernelGGL(fwd, dim3(grid), dim3(NTHREADS), LDS_BYTES, stream, a); }
    else for (int p = 0; p < NPHASE; ++p) { a.ph_lo = p; a.ph_hi = p + 1; hipLaunchKernelGGL(fwd, dim3(grid), dim3(NTHREADS), LDS_BYTES, stream, a); }
}
```

```cpp
#include <hip/hip_runtime.h>
#include <stdint.h>
#include <stdio.h>

#define LAS __attribute__((address_space(3)))
typedef unsigned short bf16_t;
typedef short bf16x8 __attribute__((ext_vector_type(8)));
typedef float f32x2 __attribute__((ext_vector_type(2)));
typedef float f32x4 __attribute__((ext_vector_type(4)));
typedef float f32x16 __attribute__((ext_vector_type(16)));
typedef unsigned u32x2 __attribute__((ext_vector_type(2)));
typedef unsigned u32x4 __attribute__((ext_vector_type(4)));
typedef __bf16 bfv2 __attribute__((ext_vector_type(2)));

constexpr int L_ = 16384, D_ = 2048, DSSM = 1024, DATT = 1024, DIN = 3608, DIN_PAD = 3840;
constexpr int NADA = 12288;
constexpr float LOG2E = 1.4426950408889634f;
constexpr float QSCALE = 0.08838834764831845f * 1.4426950408889634f;
constexpr int TBN = 800;
constexpr int NTHREADS = 512;
constexpr int LDS_BYTES = 163840;

constexpr size_t al256(size_t x) { return (x + 255) & ~(size_t)255; }
constexpr size_t WS_CTL   = 0;                                  constexpr size_t CTL_BYTES = 65536;
constexpr size_t WS_CONDP = WS_CTL + CTL_BYTES;
constexpr size_t WS_COND  = WS_CONDP + 32 * 12288 * 4;
constexpr size_t WS_TB    = WS_COND + 12288 * 4;
constexpr size_t WS_BPE   = al256(WS_TB + 8 * TBN * 4);
constexpr size_t WS_S5P   = al256(WS_BPE + 2 * 256 * 4);
constexpr size_t WS_S5F   = WS_S5P + 2 * 64 * 64 * 2 * 4;
constexpr size_t WS_S5MT  = WS_S5F + 64 * 4 * 128 * 4;
constexpr size_t WS_S5WE  = WS_S5MT + (size_t)64 * 256 * 256 * 2;
constexpr size_t WS_S5WC  = WS_S5WE + (size_t)64 * 128 * 256 * 2;
constexpr size_t WS_WIN   = WS_S5WC + (size_t)64 * 256 * 128 * 2;
constexpr size_t WS_WGLU  = WS_WIN + (size_t)DIN_PAD * 2048 * 2;
constexpr size_t WS_WOUT  = WS_WGLU + (size_t)1024 * 1024 * 2;
constexpr size_t WS_WQ    = WS_WOUT + (size_t)2048 * 2048 * 2;
constexpr size_t WS_W1    = WS_WQ + (size_t)2048 * 2048 * 2;
constexpr size_t WS_W2    = WS_W1 + (size_t)2 * 256 * 4096 * 2;
constexpr size_t WS_PK    = WS_W2 + (size_t)2 * 128 * 256 * 2;
constexpr size_t WS_PU    = WS_PK + (size_t)2 * 128 * 128 * 2;
constexpr size_t WS_PV    = WS_PU + (size_t)16384 * 2048;
constexpr size_t WS_PSC   = WS_PV + (size_t)16384 * 2048;
constexpr size_t WS_BPEP  = WS_PSC + (size_t)2 * 16384 * 4;
constexpr size_t WS_H     = WS_BPEP + (size_t)32 * 2 * 256 * 4;
constexpr size_t WS_US    = WS_H + (size_t)16384 * 2048 * 2;
constexpr size_t WS_Q     = WS_US + (size_t)16384 * 1024 * 2;
constexpr size_t WS_QP    = WS_US;
constexpr size_t WS_KROW  = WS_Q + (size_t)16384 * 1024 * 2;
constexpr size_t WS_VROW  = WS_KROW + (size_t)6 * 16384 * 128 * 2;
constexpr size_t WS_VT    = WS_VROW + (size_t)2 * 16384 * 128 * 2 + 8192;
constexpr size_t WS_GATE  = WS_VT + (size_t)4 * 128 * 16384 * 2;
constexpr size_t WS_SLAB  = WS_GATE + (size_t)16384 * 24 * 4;
constexpr size_t WS_KC    = WS_SLAB + (size_t)2 * 4 * 2048 * 256 * 4;
constexpr size_t WS_VCT   = WS_KC + (size_t)2 * 1024 * 128 * 2;
constexpr size_t WS_Z     = WS_VCT + (size_t)2 * 128 * 1024 * 2;
constexpr size_t WS_YSSM  = WS_Z + (size_t)16384 * 1024 * 2;
constexpr size_t WS_YATT  = WS_YSSM + (size_t)16384 * 1024 * 2;
constexpr size_t WS_END   = WS_YATT + (size_t)16384 * 1024 * 2;
static_assert(WS_END < (size_t)530 * 1024 * 1024, "workspace map too large");

struct Args { const float* in[33]; float* out; unsigned char* ws; int ph_lo, ph_hi; };

__device__ __forceinline__ unsigned cvt_pk_bf16(float lo, float hi) { bfv2 v; v[0] = (__bf16)lo; v[1] = (__bf16)hi; return __builtin_bit_cast(unsigned, v); }
__device__ __forceinline__ bf16_t f2bf(float f) { return (bf16_t)(cvt_pk_bf16(f, 0.f) & 0xffffu); }
__device__ __forceinline__ float bf2f(unsigned b) { return __uint_as_float(b << 16); }
__device__ __forceinline__ float bflo(unsigned w) { return __uint_as_float(w << 16); }
__device__ __forceinline__ float bfhi(unsigned w) { return __uint_as_float(w & 0xffff0000u); }
__device__ __forceinline__ float fexp2(float x) { return __builtin_amdgcn_exp2f(x); }
__device__ __forceinline__ float frcp(float x) { return __builtin_amdgcn_rcpf(x); }
__device__ __forceinline__ float sigmoidf_(float x) { return frcp(1.f + fexp2(-LOG2E * x)); }
__device__ __forceinline__ float gelu_tanh(float x) {
    const float u = x * (1.f + 0.044715f * x * x);
    return x * frcp(1.f + fexp2(-2.f * 0.7978845608028654f * LOG2E * u));
}
__device__ __forceinline__ float shfl_xor_f(float v, int m) { return __shfl_xor(v, m, 64); }
__device__ __forceinline__ float wave_sum(float v) {
#pragma unroll
    for (int m = 32; m >= 1; m >>= 1) v += __shfl_xor(v, m, 64);
    return v;
}
__device__ __forceinline__ float wave_max(float v) {
#pragma unroll
    for (int m = 32; m >= 1; m >>= 1) v = fmaxf(v, __shfl_xor(v, m, 64));
    return v;
}
template <int CTRL> __device__ __forceinline__ float dpp_f(float x) { return __int_as_float(__builtin_amdgcn_update_dpp(0, __float_as_int(x), CTRL, 0xf, 0xf, false)); }
__device__ __forceinline__ float quad_sum(float x) { x += dpp_f<0xB1>(x); x += dpp_f<0x4E>(x); return x; }
__device__ __forceinline__ f32x4 mfma16(bf16x8 a, bf16x8 b, f32x4 c) { return __builtin_amdgcn_mfma_f32_16x16x32_bf16(a, b, c, 0, 0, 0); }
__device__ __forceinline__ f32x16 mfma32(bf16x8 a, bf16x8 b, f32x16 c) { return __builtin_amdgcn_mfma_f32_32x32x16_bf16(a, b, c, 0, 0, 0); }
#define XB_TMO      128
#define XB_XCNT(j)  (256  + 64 * (j))
#define XB_XSUB(j)  (1280 + 64 * (j))
#define XB_XGEN(j)  (2304 + 64 * (j))
#define XB_TOP      3328
#define XB_TOPGEN   3392
#define XCD_BAR_WORDS 3456
#define XB_SPIN_CAP (1u << 18)

__device__ __forceinline__ unsigned xb_ld(unsigned* p)              { return __hip_atomic_load(p, __ATOMIC_RELAXED, __HIP_MEMORY_SCOPE_AGENT); }
__device__ __forceinline__ unsigned xb_add(unsigned* p, unsigned v) { return __hip_atomic_fetch_add(p, v, __ATOMIC_RELAXED, __HIP_MEMORY_SCOPE_AGENT); }
__device__ __forceinline__ unsigned xb_xcc_id() { return (unsigned)__builtin_amdgcn_s_getreg((3 << 11) | 20) & 0xFu; }
#define XB_SPIN(cond, bar) do { unsigned _sp = 0; while (cond) { __builtin_amdgcn_s_sleep(1); \
    if ((++_sp & 255u) == 0u) { if (xb_ld(&(bar)[XB_TMO])) break; if (_sp > XB_SPIN_CAP) { atomicAdd(&(bar)[XB_TMO], 1u); break; } } } } while (0)

struct XcdBarrier {
    unsigned* bar; unsigned x;
    volatile LAS unsigned* st;
};
__device__ __forceinline__ XcdBarrier xcd_barrier_post(unsigned* bar, volatile LAS unsigned* st) {
    XcdBarrier b; b.bar = bar; b.x = xb_xcc_id(); b.st = st;
    if (threadIdx.x == 0) (void)xb_add(&bar[XB_XCNT(b.x)], 1u);
    return b;
}
__device__ __forceinline__ void xcd_barrier_complete(unsigned* bar, unsigned x, unsigned& nloc, unsigned& nx) {
    const unsigned G = gridDim.x * gridDim.y * gridDim.z;
    unsigned sum, cnt, mine, sp = 0u;
    for (;;) {
        sum = 0u; cnt = 0u; mine = 0u;
#pragma unroll
        for (unsigned j = 0; j < 16; ++j) { const unsigned c = xb_ld(&bar[XB_XCNT(j)]); sum += c; cnt += (c > 0u) ? 1u : 0u; mine = (j == x) ? c : mine; }
        if (sum == G) break;
        __builtin_amdgcn_s_sleep(1);
        if ((++sp & 255u) == 0u) { if (xb_ld(&bar[XB_TMO])) break; if (sp > XB_SPIN_CAP) { atomicAdd(&bar[XB_TMO], 1u); break; } }
    }
    nloc = mine > 0u ? mine : 1u; nx = cnt > 0u ? cnt : 1u;
}
__device__ __forceinline__ void xcd_barrier(const XcdBarrier& b) {
    asm volatile("s_waitcnt vmcnt(0)" ::: "memory");
    __syncthreads();
    if (threadIdx.x == 0) {
        unsigned* bar = b.bar;
        __builtin_amdgcn_s_waitcnt(0);
        unsigned nloc = b.st[0], nx = b.st[1];
        if (nloc == 0u) { xcd_barrier_complete(bar, b.x, nloc, nx); b.st[0] = nloc; b.st[1] = nx; }
        const unsigned old = xb_add(&bar[XB_XSUB(b.x)], 1u);
        const unsigned gen = old / nloc;
        if (old + 1u == (gen + 1u) * nloc) {
            __builtin_amdgcn_fence(__ATOMIC_RELEASE, "agent");
            asm volatile("s_waitcnt vmcnt(0)" ::: "memory");
            const unsigned og = xb_add(&bar[XB_TOP], 1u);
            const unsigned tg = og / nx;
            if (og + 1u == (tg + 1u) * nx) xb_add(&bar[XB_TOPGEN], 1u);
            else XB_SPIN(xb_ld(&bar[XB_TOPGEN]) == tg, bar);
            __builtin_amdgcn_fence(__ATOMIC_ACQUIRE, "agent");
            xb_add(&bar[XB_XGEN(b.x)], 1u);
            asm volatile("s_waitcnt vmcnt(0)" ::: "memory");
        } else {
            XB_SPIN(xb_ld(&bar[XB_XGEN(b.x)]) == gen, bar);
            __builtin_amdgcn_fence(__ATOMIC_ACQUIRE, "agent");
            asm volatile("s_waitcnt vmcnt(0)" ::: "memory");
        }
    }
    __syncthreads();
}

namespace pg8 {
constexpr int BM = 256, BK = 64, HALF = 128, HTB = HALF * BK * 2, STAGE_BYTES = 8 * HTB, NXCD = 8, WGM = 8;
__host__ __device__ __forceinline__ int lds_byte(int r, int c) { const int st = (r >> 4) * 2 + (c >> 5), rr = r & 15, cc = c & 31, ob = rr * 64 + cc * 2; return st * 1024 + (ob ^ (((ob >> 9) & 1) << 5)); }
__host__ __device__ __forceinline__ void stage_rc(int b, int& R, int& C) { const int st = b / 1024, sb = b % 1024, swz = sb ^ (((sb >> 9) & 1) << 5); R = (st >> 1) * 16 + swz / 64; C = (st & 1) * 32 + (swz % 64) / 2; }
__host__ __device__ __forceinline__ int perm32(int rho) { const int n = rho >> 4, i = rho & 15; return 8 * (i >> 2) + 4 * n + (i & 3); }

struct Unit { int pm, pn, z; };
struct StaticOrder {
    const bf16_t* A; const bf16_t* Bt; int lda, ldb, K;
    int nM, nN, nwg, G, c;
    __device__ void init(const bf16_t* A_, const bf16_t* Bt_, int lda_, int ldb_, int K_, int M, int N, int G_, int c_) { A = A_; Bt = Bt_; lda = lda_; ldb = ldb_; K = K_; nM = M / BM; nN = N / BM; nwg = nM * nN; G = G_; c = c_; }
    __device__ bool next(int i, Unit& u) const {
        const long Lx = (long)i * G + c; if (Lx >= nwg) return false;
        int wgid = (int)Lx; { const int q = nwg / NXCD, r = nwg % NXCD, xcd = wgid % NXCD, off = wgid / NXCD; wgid = (xcd < r ? xcd * (q + 1) : r * (q + 1) + (xcd - r) * q) + off; }
        const int nig = WGM * nN, gid = wgid / nig, fm = gid * WGM, gsz = (nM - fm) < WGM ? (nM - fm) : WGM;
        u.pm = fm + ((wgid % nig) % gsz); u.pn = (wgid % nig) / gsz; u.z = 0; return true;
    }
    __device__ __forceinline__ const char* a_base(const Unit& u) const { return (const char*)(A + (size_t)u.pm * BM * lda); }
    __device__ __forceinline__ const char* b_base(const Unit& u) const { return (const char*)(Bt + (size_t)u.pn * BM * ldb); }
};

template <class Epi, class Sched>
__device__ __forceinline__ void gemm_phase(LAS unsigned char* lds, const Sched& S, const Epi& E) {
    const int tid = threadIdx.x, wid = __builtin_amdgcn_readfirstlane(tid >> 6), lane = tid & 63, wr = wid >> 2, wc = wid & 3, fr = lane & 15, fq = lane >> 4;
    const int K = S.K, nt = K / BK, lda = S.lda, ldb = S.ldb;
    unsigned voffA[2], voffB[2];
#pragma unroll
    for (int i = 0; i < 2; ++i) { int R, C; stage_rc(tid * 16 + i * 8192, R, C); const int Rb = Epi::PERM ? ((R & ~31) + perm32(R & 31)) : R;
        voffA[i] = (unsigned)(R * lda + C) * 2u; voffB[i] = (unsigned)(Rb * ldb + C) * 2u; }
    const size_t kstep = (size_t)(BK * 2);
    const size_t hstepA = (size_t)HALF * lda * 2, hstepB = (size_t)HALF * ldb * 2;
    const unsigned ldsw = (unsigned)wid * 1024u;
    const int aoff = lds_byte(wr * 64 + fr, fq * 8), boff = lds_byte(wc * 32 + fr, fq * 8);
#define PG8_SA(b, h) (((b) * 2 + (h)) * HTB)
#define PG8_SB(b, h) ((4 + (b) * 2 + (h)) * HTB)
#define PG8_STAGE(bufoff, gbase, voff) do { _Pragma("unroll") for (int _i = 0; _i < 2; ++_i) \
        __builtin_amdgcn_global_load_lds((const unsigned*)((const char*)(gbase) + (voff)[_i]), (LAS unsigned*)(lds + (bufoff) + ldsw + _i * 8192), 16, 0, 0); } while (0)
#define PG8_LDA(dst, b, h) do { _Pragma("unroll") for (int m = 0; m < 4; ++m) _Pragma("unroll") for (int k = 0; k < 2; ++k) dst[m][k] = *(const LAS bf16x8*)(lds + PG8_SA(b, h) + aoff + m * 2048 + k * 1024); } while (0)
#define PG8_LDB(dst, b, h) do { _Pragma("unroll") for (int n = 0; n < 2; ++n) _Pragma("unroll") for (int k = 0; k < 2; ++k) dst[n][k] = *(const LAS bf16x8*)(lds + PG8_SB(b, h) + boff + n * 2048 + k * 1024); } while (0)
#define PG8_MMA(ai, bj, At, Bt) do { __builtin_amdgcn_s_setprio(1); _Pragma("unroll") for (int m = 0; m < 4; ++m) _Pragma("unroll") for (int n = 0; n < 2; ++n) _Pragma("unroll") for (int k = 0; k < 2; ++k) \
        acc[ai][bj][m][n] = __builtin_amdgcn_mfma_f32_16x16x32_bf16(Bt[n][k], At[m][k], acc[ai][bj][m][n], 0, 0, 0); __builtin_amdgcn_s_setprio(0); } while (0)
#define PG8_WAIT_V(n) asm volatile("s_waitcnt vmcnt(" #n ")" ::: "memory")
#define PG8_WAIT_L(n) asm volatile("s_waitcnt lgkmcnt(" #n ")" ::: "memory")
#define PG8_BAR __builtin_amdgcn_s_barrier()
#define PG8_SCHED __builtin_amdgcn_sched_barrier(0)
    Unit cur, nxt; int ui = 0;
    if (!S.next(0, cur)) return;
    f32x4 acc[2][2][4][2];
#pragma unroll
    for (int a = 0; a < 2; ++a)
#pragma unroll
        for (int b = 0; b < 2; ++b)
#pragma unroll
            for (int m = 0; m < 4; ++m)
#pragma unroll
                for (int n = 0; n < 2; ++n) acc[a][b][m][n] = (f32x4){0.f, 0.f, 0.f, 0.f};
    bf16x8 At[4][2], B0[2][2], B1[2][2];
    const char* cA = S.a_base(cur); const char* cB = S.b_base(cur);
    PG8_STAGE(PG8_SB(0, 0), cB, voffB); PG8_STAGE(PG8_SA(0, 0), cA, voffA); PG8_STAGE(PG8_SB(0, 1), cB + hstepB, voffB); PG8_STAGE(PG8_SA(0, 1), cA + hstepA, voffA);
    if (wr == 1) PG8_BAR;
    PG8_WAIT_V(4); PG8_BAR;
    PG8_STAGE(PG8_SB(1, 0), cB + kstep, voffB); PG8_STAGE(PG8_SA(1, 0), cA + kstep, voffA); PG8_STAGE(PG8_SB(1, 1), cB + hstepB + kstep, voffB);
    PG8_WAIT_V(6); PG8_BAR;
    for (;;) {
        const bool has_next = S.next(ui + 1, nxt);
        const char* nA = has_next ? S.a_base(nxt) : cA; const char* nB = has_next ? S.b_base(nxt) : cB;
        for (int t = 0; t < nt; t += 2) {
            const bool last = (t == nt - 2);
            const char* a1 = cA + (size_t)(t + 1) * kstep;
            const char* a2 = last ? nA : cA + (size_t)(t + 2) * kstep; const char* b2 = last ? nB : cB + (size_t)(t + 2) * kstep;
            const char* a3 = a2 + kstep; const char* b3 = b2 + kstep;
            PG8_LDB(B0, 0, 0); PG8_SCHED; PG8_LDA(At, 0, 0); PG8_STAGE(PG8_SA(1, 1), a1 + hstepA, voffA);
            PG8_WAIT_L(8); PG8_BAR; PG8_WAIT_L(0); PG8_MMA(0, 0, At, B0); PG8_BAR; PG8_SCHED;
            PG8_LDB(B1, 0, 1); PG8_STAGE(PG8_SB(0, 0), b2, voffB);
            PG8_BAR; PG8_WAIT_L(0); PG8_MMA(0, 1, At, B1); PG8_BAR;
            PG8_LDA(At, 0, 1); PG8_STAGE(PG8_SA(0, 0), a2, voffA);
            PG8_BAR; PG8_WAIT_L(0); PG8_MMA(1, 0, At, B0); PG8_BAR; PG8_SCHED;
            PG8_STAGE(PG8_SB(0, 1), b2 + hstepB, voffB);
            PG8_WAIT_V(6); PG8_BAR; PG8_MMA(1, 1, At, B1); PG8_BAR;
            PG8_LDB(B0, 1, 0); PG8_SCHED; PG8_LDA(At, 1, 0); PG8_STAGE(PG8_SA(0, 1), a2 + hstepA, voffA);
            PG8_WAIT_L(8); PG8_BAR; PG8_WAIT_L(0); PG8_MMA(0, 0, At, B0); PG8_BAR; PG8_SCHED;
            PG8_LDB(B1, 1, 1); PG8_STAGE(PG8_SB(1, 0), b3, voffB);
            PG8_BAR; PG8_WAIT_L(0); PG8_MMA(0, 1, At, B1); PG8_BAR;
            PG8_LDA(At, 1, 1); PG8_STAGE(PG8_SA(1, 0), a3, voffA);
            PG8_BAR; PG8_WAIT_L(0); PG8_MMA(1, 0, At, B0); PG8_BAR; PG8_SCHED;
            PG8_STAGE(PG8_SB(1, 1), b3 + hstepB, voffB);
            PG8_WAIT_V(6); PG8_BAR; PG8_MMA(1, 1, At, B1); PG8_BAR;
        }
        E(acc, cur, wr, wc, fr, fq);
        if (!has_next) break;
#pragma unroll
        for (int a = 0; a < 2; ++a)
#pragma unroll
            for (int b = 0; b < 2; ++b)
#pragma unroll
                for (int m = 0; m < 4; ++m)
#pragma unroll
                    for (int n = 0; n < 2; ++n) acc[a][b][m][n] = (f32x4){0.f, 0.f, 0.f, 0.f};
        cur = nxt; cA = nA; cB = nB; ++ui;
    }
    PG8_WAIT_V(0);
    if (wr == 0) PG8_BAR;
    PG8_BAR;
#undef PG8_SA
#undef PG8_SB
#undef PG8_STAGE
#undef PG8_LDA
#undef PG8_LDB
#undef PG8_MMA
#undef PG8_WAIT_V
#undef PG8_WAIT_L
#undef PG8_BAR
#undef PG8_SCHED
}
}
using pg8::Unit;
__device__ __forceinline__ u32x4 pack8(const f32x4& v0, const f32x4& v1) {
    u32x4 o; o[0] = cvt_pk_bf16(v0[0], v0[1]); o[1] = cvt_pk_bf16(v0[2], v0[3]); o[2] = cvt_pk_bf16(v1[0], v1[1]); o[3] = cvt_pk_bf16(v1[2], v1[3]); return o;
}
struct EpiWin {
    static constexpr bool PERM = true;
    bf16_t* US; bf16_t* Q; bf16_t* KROW; bf16_t* VROW; bf16_t* VT; float* GATE;
    __device__ __forceinline__ void operator()(const f32x4 (&acc)[2][2][4][2], const Unit& u, int wr, int wc, int fr, int fq) const {
        const int row0 = u.pm * 256 + wr * 64 + fr; const int pn = u.pn;
#pragma unroll
        for (int ai = 0; ai < 2; ++ai)
#pragma unroll
            for (int m = 0; m < 4; ++m) {
                const int row = row0 + ai * 128 + m * 16;
#pragma unroll
                for (int bj = 0; bj < 2; ++bj) {
                    const f32x4 v0 = acc[ai][bj][m][0], v1 = acc[ai][bj][m][1];
                    const int cin = bj * 128 + wc * 32 + 8 * fq;
                    if (pn < 4) { *(u32x4*)(US + (size_t)row * 1024 + pn * 256 + cin) = pack8(v0, v1); }
                    else if (pn < 8) { *(u32x4*)(Q + (size_t)row * 1024 + (pn - 4) * 256 + cin) = pack8(v0 * QSCALE, v1 * QSCALE); }
                    else if (pn < 14) {
                        const int kvi = pn - 8, branch = kvi >> 1, kvsel = kvi & 1, g = bj, d0 = wc * 32 + 8 * fq;
                        if (kvsel == 0) { *(u32x4*)(KROW + ((size_t)(branch * 2 + g) * L_ + row) * 128 + d0) = pack8(v0, v1); }
                        else if (branch == 0) { *(u32x4*)(VROW + ((size_t)g * L_ + row) * 128 + d0) = pack8(v0, v1); }
                        else {
                            bf16_t* vt = VT + ((size_t)((branch - 1) * 2 + g) * 128 + d0) * L_ + row;
#pragma unroll
                            for (int e = 0; e < 4; ++e) { vt[(size_t)e * L_] = f2bf(v0[e]); vt[(size_t)(e + 4) * L_] = f2bf(v1[e]); }
                        }
                    } else {
                        if (cin < 24) {
                            float* gp = GATE + (size_t)row * 24 + cin;
                            f32x4 s0, s1;
#pragma unroll
                            for (int e = 0; e < 4; ++e) { s0[e] = sigmoidf_(v0[e]); s1[e] = sigmoidf_(v1[e]); }
                            *(f32x4*)gp = s0; *(f32x4*)(gp + 4) = s1;
                        }
                    }
                }
            }
    }
};
struct EpiGlu {
    static constexpr bool PERM = true;
    const bf16_t* Z; const float* bglu; bf16_t* Y;
    __device__ __forceinline__ void operator()(const f32x4 (&acc)[2][2][4][2], const Unit& u, int wr, int wc, int fr, int fq) const {
        const int row0 = u.pm * 256 + wr * 64 + fr;
#pragma unroll
        for (int bj = 0; bj < 2; ++bj) {
            const int col = u.pn * 256 + bj * 128 + wc * 32 + 8 * fq;
            const f32x4 b0 = *(const f32x4*)(bglu + col), b1 = *(const f32x4*)(bglu + col + 4);
#pragma unroll
            for (int ai = 0; ai < 2; ++ai)
#pragma unroll
                for (int m = 0; m < 4; ++m) {
                    const int row = row0 + ai * 128 + m * 16;
                    const u32x4 zz = *(const u32x4*)(Z + (size_t)row * 1024 + col);
                    const f32x4 v0 = acc[ai][bj][m][0] + b0, v1 = acc[ai][bj][m][1] + b1;
                    f32x4 o0, o1;
                    o0[0] = bflo(zz[0]) * sigmoidf_(v0[0]); o0[1] = bfhi(zz[0]) * sigmoidf_(v0[1]); o0[2] = bflo(zz[1]) * sigmoidf_(v0[2]); o0[3] = bfhi(zz[1]) * sigmoidf_(v0[3]);
                    o1[0] = bflo(zz[2]) * sigmoidf_(v1[0]); o1[1] = bfhi(zz[2]) * sigmoidf_(v1[1]); o1[2] = bflo(zz[3]) * sigmoidf_(v1[2]); o1[3] = bfhi(zz[3]) * sigmoidf_(v1[3]);
                    *(u32x4*)(Y + (size_t)row * 1024 + col) = pack8(o0, o1);
                }
        }
    }
};
struct EpiWout {
    static constexpr bool PERM = false;
    const float* X; const float* g1; float* X1;
    __device__ __forceinline__ void operator()(const f32x4 (&acc)[2][2][4][2], const Unit& u, int wr, int wc, int fr, int fq) const {
        const int row0 = u.pm * 256 + wr * 64 + fr, col0 = u.pn * 256 + wc * 32 + 4 * fq;
#pragma unroll
        for (int bj = 0; bj < 2; ++bj)
#pragma unroll
            for (int n = 0; n < 2; ++n) {
                const int col = col0 + bj * 128 + n * 16;
                const f32x4 gv = *(const f32x4*)(g1 + col);
#pragma unroll
                for (int ai = 0; ai < 2; ++ai)
#pragma unroll
                    for (int m = 0; m < 4; ++m) {
                        const size_t off = (size_t)(row0 + ai * 128 + m * 16) * 2048 + col;
                        *(f32x4*)(X1 + off) = *(const f32x4*)(X + off) + gv * acc[ai][bj][m][n];
                    }
            }
    }
};
struct EpiBf16 {
    static constexpr bool PERM = true;
    bf16_t* O; int ldc;
    __device__ __forceinline__ void operator()(const f32x4 (&acc)[2][2][4][2], const Unit& u, int wr, int wc, int fr, int fq) const {
        const int row0 = u.pm * 256 + wr * 64 + fr, col0 = u.pn * 256 + wc * 32 + 8 * fq;
#pragma unroll
        for (int ai = 0; ai < 2; ++ai)
#pragma unroll
            for (int m = 0; m < 4; ++m)
#pragma unroll
                for (int bj = 0; bj < 2; ++bj)
                    *(u32x4*)(O + (size_t)(row0 + ai * 128 + m * 16) * ldc + col0 + bj * 128) = pack8(acc[ai][bj][m][0], acc[ai][bj][m][1]);
    }
};
struct EpiSlab {
    static constexpr bool PERM = false;
    float* SL;
    __device__ __forceinline__ void operator()(const f32x4 (&acc)[2][2][4][2], const Unit& u, int wr, int wc, int fr, int fq) const {
        float* base = SL + (size_t)u.z * 2048 * 256;
        const int row0 = u.pm * 256 + wr * 64 + fr, col0 = wc * 32 + 4 * fq;
#pragma unroll
        for (int ai = 0; ai < 2; ++ai)
#pragma unroll
            for (int m = 0; m < 4; ++m)
#pragma unroll
                for (int bj = 0; bj < 2; ++bj)
#pragma unroll
                    for (int n = 0; n < 2; ++n)
                        *(f32x4*)(base + (size_t)(row0 + ai * 128 + m * 16) * 256 + col0 + bj * 128 + n * 16) = acc[ai][bj][m][n];
    }
};
struct CmpOrder {
    const bf16_t* KROW; const bf16_t* VROW; const bf16_t* W1; int lda, ldb, K; int G, c;
    __device__ bool next(int i, Unit& u) const {
        const int x = i * G + c; if (x >= 64) return false;
        const int kvsel = x >> 5, pm = (x & 31) >> 2, ks = x & 3; u.pm = pm; u.pn = 0; u.z = kvsel * 4 + ks; return true;
    }
    __device__ __forceinline__ const char* a_base(const Unit& u) const { return (const char*)(((u.z >> 2) ? VROW : KROW) + (size_t)u.pm * 256 * 2048 + (u.z & 3) * 1024); }
    __device__ __forceinline__ const char* b_base(const Unit& u) const { return (const char*)(W1 + (size_t)(u.z >> 2) * 256 * 4096 + (u.z & 3) * 1024); }
};
struct Ctx { int bid, nb, tid, wave, lane; LAS unsigned char* lds; };

__device__ __forceinline__ void p0_cond(const Args& a, const Ctx& c) {
    const float* cv = a.in[1]; const float* w = a.in[2]; float* condp = (float*)(a.ws + WS_CONDP);
    for (int u = c.bid * 8 + c.wave; u < 1536; u += c.nb * 8) {
        const int cc = u % 48, kc = u / 48;
        const float* wp = w + (size_t)(kc * 64) * NADA + cc * 256 + c.lane * 4;
        f32x4 acc = {0.f, 0.f, 0.f, 0.f};
#pragma unroll 16
        for (int k = 0; k < 64; ++k) { const float x = cv[kc * 64 + k]; const float s = x / (1.f + __expf(-x)); acc += s * *(const f32x4*)(wp + (size_t)k * NADA); }
        *(f32x4*)(condp + (size_t)kc * NADA + cc * 256 + c.lane * 4) = acc;
    }
}
__device__ __forceinline__ void conv_T(const float* src, int K, int N, bf16_t* dst, int Npad, const Ctx& c) {
    LAS float* tile = (LAS float*)c.lds;
    const int nkt = K / 64, ntiles = nkt * (Npad / 64);
    const int r = c.tid >> 4, c4 = c.tid & 15;
    f32x4 v[2];
#define CONVT_LD(tix_) do { const int nt_ = (tix_) / nkt, kt_ = (tix_) % nkt, n_ = nt_ * 64 + 4 * c4; _Pragma("unroll") for (int i = 0; i < 2; ++i) { const int k_ = kt_ * 64 + r + 32 * i; v[i] = (f32x4){0.f, 0.f, 0.f, 0.f}; if (n_ < N) v[i] = *(const f32x4*)(src + (size_t)k_ * N + n_); } } while (0)
    if (c.bid < ntiles) CONVT_LD(c.bid);
    for (int tix = c.bid; tix < ntiles; tix += c.nb) {
        const int nt = tix / nkt, kt = tix % nkt;
#pragma unroll
        for (int i = 0; i < 2; ++i) { LAS float* tp = tile + (r + 32 * i) * 65 + 4 * c4; tp[0] = v[i][0]; tp[1] = v[i][1]; tp[2] = v[i][2]; tp[3] = v[i][3]; }
        __syncthreads();
        if (tix + c.nb < ntiles) CONVT_LD(tix + c.nb);
        { const int n = c.tid >> 3, kq = c.tid & 7; float w[8];
#pragma unroll
          for (int j = 0; j < 8; ++j) w[j] = tile[(kq * 8 + j) * 65 + n];
          u32x4 o; o[0] = cvt_pk_bf16(w[0], w[1]); o[1] = cvt_pk_bf16(w[2], w[3]); o[2] = cvt_pk_bf16(w[4], w[5]); o[3] = cvt_pk_bf16(w[6], w[7]);
          *(u32x4*)(dst + (size_t)(nt * 64 + n) * K + kt * 64 + kq * 8) = o; }
        __syncthreads();
    }
#undef CONVT_LD
}
__device__ __forceinline__ void conv_fp8rows(const float* src, unsigned char* dst8, float* scl, int rows, const Ctx& c) {
    for (int row = c.bid * 8 + c.wave; row < rows; row += c.nb * 8) {
        const float* sp = src + (size_t)row * 2048 + c.lane * 4;
        f32x4 v[8]; float mx = 0.f;
#pragma unroll
        for (int j = 0; j < 8; ++j) { v[j] = *(const f32x4*)(sp + j * 256); mx = fmaxf(mx, fmaxf(fmaxf(fabsf(v[j][0]), fabsf(v[j][1])), fmaxf(fabsf(v[j][2]), fabsf(v[j][3])))); }
        mx = wave_max(mx);
        const float s = mx > 0.f ? 448.f / mx : 1.f;
        if (c.lane == 0) scl[row] = mx > 0.f ? mx * (1.f / 448.f) : 1.f;
#pragma unroll
        for (int j = 0; j < 8; ++j) {
            int w = 0;
            w = __builtin_amdgcn_cvt_pk_fp8_f32(v[j][0] * s, v[j][1] * s, w, false);
            w = __builtin_amdgcn_cvt_pk_fp8_f32(v[j][2] * s, v[j][3] * s, w, true);
            *(int*)(dst8 + (size_t)row * 2048 + j * 256 + c.lane * 4) = w;
        }
    }
}
__device__ __forceinline__ void conv_E(const float* src, bf16_t* dst, size_t n8, const Ctx& c) {
    const size_t stride = (size_t)c.nb * NTHREADS;
    for (size_t i = (size_t)c.bid * NTHREADS + c.tid; i < n8; i += stride) {
        const f32x4 x = *(const f32x4*)(src + i * 8), y = *(const f32x4*)(src + i * 8 + 4);
        *(u32x4*)(dst + i * 8) = pack8(x, y);
    }
}
__device__ __forceinline__ int t5_bucket(int n) {
    if (n < 16) return n;
    const float scaled = logf((float)n / 16.f) / logf(64.f);
    const int large = 16 + (int)(scaled * 16.f);
    return large < 31 ? large : 31;
}
__device__ __forceinline__ void p0_tb(const Args& a, const Ctx& c) {
    float* tb = (float*)(a.ws + WS_TB); const float* rb = a.in[26];
    for (int i = c.bid * NTHREADS + c.tid; i < 8 * TBN; i += c.nb * NTHREADS) { const int head = i / TBN, dist = i % TBN; tb[i] = rb[t5_bucket(dist) * 8 + head] * LOG2E; }
}
__device__ __forceinline__ void p0_bpe(const Args& a, const Ctx& c, int part) {
    const int n = c.tid & 255, kv = c.tid >> 8;
    const float* pe = a.in[kv ? 23 : 20]; const float* w1 = a.in[kv ? 24 : 21]; float* bpep = (float*)(a.ws + WS_BPEP);
    float s = 0.f;
#pragma unroll 16
    for (int k = part * 128; k < part * 128 + 128; ++k) s += pe[k] * w1[(size_t)k * 256 + n];
    bpep[(part * 2 + kv) * 256 + n] = s;
}
__device__ __forceinline__ void p0_s5(const Args& a, const Ctx& c, int g) {
    LAS float* ar = (LAS float*)c.lds;
    LAS float* ai = ar + 17 * 64;
    LAS float* bbr = ai + 17 * 64;
    LAS float* bbi = bbr + 1024;
    LAS float* cr = bbi + 1024;
    LAS float* ci = cr + 1024;
    LAS float* kd = ci + 1024;
    const int tid = c.tid;
    if (tid < 64) {
        const int p = tid; const float dt = expf(a.in[12][g]); const float lr = a.in[10][g * 64 + p], li = a.in[11][g * 64 + p];
        for (int d = 0; d <= 16; ++d) { const float mag = expf(lr * dt * (float)d), ang = li * dt * (float)d; ar[d * 64 + p] = mag * cosf(ang); ai[d * 64 + p] = mag * sinf(ang); }
        const float nr = ar[64 + p] - 1.f, ni = ai[64 + p], den = lr * lr + li * li;
        const float wre = (nr * lr + ni * li) / den, wim = (ni * lr - nr * li) / den;
        for (int h = 0; h < 16; ++h) { const float br = a.in[13][(g * 64 + p) * 16 + h], bi = a.in[14][(g * 64 + p) * 16 + h]; bbr[p * 16 + h] = wre * br - wim * bi; bbi[p * 16 + h] = wre * bi + wim * br; }
        float* s5p = (float*)(a.ws + WS_S5P);
        float xr = ar[16 * 64 + p], xi = ai[16 * 64 + p];
        s5p[(g * 64 + p) * 2] = xr; s5p[(g * 64 + p) * 2 + 1] = xi;
        for (int s = 0; s < 8; ++s) { const float tr = xr * xr - xi * xi, ti = 2.f * xr * xi; xr = tr; xi = ti; }
        s5p[64 * 64 * 2 + (g * 64 + p) * 2] = xr; s5p[64 * 64 * 2 + (g * 64 + p) * 2 + 1] = xi;
    }
    for (int e = tid; e < 1024; e += NTHREADS) { cr[e] = a.in[15][g * 1024 + e]; ci[e] = a.in[16][g * 1024 + e]; }
    __syncthreads();
    for (int e = tid; e < 4096; e += NTHREADS) {
        const int d = e >> 8, h1 = (e >> 4) & 15, h = e & 15; float s = 0.f;
        for (int p = 0; p < 64; ++p) { const float Cr = cr[h1 * 64 + p], Ci = ci[h1 * 64 + p], Ar = ar[d * 64 + p], Ai = ai[d * 64 + p];
            const float Gr = Cr * Ar - Ci * Ai, Gi = Cr * Ai + Ci * Ar; s += Gr * bbr[p * 16 + h] - Gi * bbi[p * 16 + h]; }
        if (d == 0 && h1 == h) s += a.in[17][g * 16 + h];
        kd[e] = s;
    }
    __syncthreads();
    bf16_t* MT = (bf16_t*)(a.ws + WS_S5MT) + (size_t)g * 65536;
    bf16_t* WE = (bf16_t*)(a.ws + WS_S5WE) + (size_t)g * 32768;
    bf16_t* WC = (bf16_t*)(a.ws + WS_S5WC) + (size_t)g * 32768;
    for (int e = tid; e < 65536; e += NTHREADS) { const int n = e >> 8, k = e & 255, j = n >> 4, h1 = n & 15, i = k >> 4, h = k & 15;
        MT[e] = f2bf(i <= j ? kd[(j - i) * 256 + h1 * 16 + h] : 0.f); }
    for (int e = tid; e < 32768; e += NTHREADS) { const int n = e >> 8, k = e & 255, cc = n >> 6, p = n & 63, i = k >> 4, h = k & 15;
        const float Ar = ar[(15 - i) * 64 + p], Ai = ai[(15 - i) * 64 + p], Br = bbr[p * 16 + h], Bi = bbi[p * 16 + h];
        WE[e] = f2bf(cc ? (Ar * Bi + Ai * Br) : (Ar * Br - Ai * Bi)); }
    for (int e = tid; e < 32768; e += NTHREADS) { const int n = e >> 7, k = e & 127, j = n >> 4, h1 = n & 15, cc = k >> 6, p = k & 63;
        const float Cr = cr[h1 * 64 + p], Ci = ci[h1 * 64 + p], Ar = ar[(j + 1) * 64 + p], Ai = ai[(j + 1) * 64 + p];
        WC[e] = f2bf(cc ? -(Cr * Ai + Ci * Ar) : (Cr * Ar - Ci * Ai)); }
    __syncthreads();
}
__device__ __forceinline__ void p0_prologue(const Args& a, const Ctx& c) {
    for (int g = c.bid; g < 64; g += c.nb) p0_s5(a, c, g);
    for (int u = 0; u < 32; ++u) if (c.bid == (64 + u) % c.nb) p0_bpe(a, c, u);
    p0_tb(a, c);
    p0_cond(a, c);
    conv_T(a.in[6], 2048, DIN, (bf16_t*)(a.ws + WS_WIN), DIN_PAD, c);
    conv_T(a.in[18], 1024, 1024, (bf16_t*)(a.ws + WS_WGLU), 1024, c);
    conv_T(a.in[7], 2048, 2048, (bf16_t*)(a.ws + WS_WOUT), 2048, c);
    conv_T(a.in[27], 2048, 2048, (bf16_t*)(a.ws + WS_WQ), 2048, c);
    conv_T(a.in[21], 4096, 256, (bf16_t*)(a.ws + WS_W1), 256, c);
    conv_T(a.in[24], 4096, 256, (bf16_t*)(a.ws + WS_W1) + 256 * 4096, 256, c);
    conv_T(a.in[22], 256, 128, (bf16_t*)(a.ws + WS_W2), 128, c);
    conv_T(a.in[25], 256, 128, (bf16_t*)(a.ws + WS_W2) + 128 * 256, 128, c);
    conv_E(a.in[28], (bf16_t*)(a.ws + WS_PK), 128 * 128 / 8, c);
    conv_E(a.in[29], (bf16_t*)(a.ws + WS_PK) + 128 * 128, 128 * 128 / 8, c);
    conv_fp8rows(a.in[30], a.ws + WS_PU, (float*)(a.ws + WS_PSC), 16384, c);
    conv_fp8rows(a.in[31], a.ws + WS_PV, (float*)(a.ws + WS_PSC) + 16384, 16384, c);
}

__device__ __forceinline__ void norm_rows(const float* X, bf16_t* O, LAS const float* Ab, LAS const float* Bb, const Ctx& c) {
    for (int t = c.bid * 8 + c.wave; t < L_; t += c.nb * 8) {
        const float* xr = X + (size_t)t * 2048 + c.lane * 4;
        f32x4 v[8]; float ss = 0.f;
#pragma unroll
        for (int j = 0; j < 8; ++j) { v[j] = *(const f32x4*)(xr + j * 256); ss += v[j][0] * v[j][0] + v[j][1] * v[j][1] + v[j][2] * v[j][2] + v[j][3] * v[j][3]; }
        ss = wave_sum(ss);
        const float rstd = rsqrtf(ss * (1.f / 2048.f) + 1e-6f);
#pragma unroll
        for (int j = 0; j < 8; ++j) {
            const int col = j * 256 + c.lane * 4;
            const f32x4 A = *(const LAS f32x4*)(Ab + col), B = *(const LAS f32x4*)(Bb + col);
            const f32x4 o = v[j] * rstd * A + B;
            u32x2 w; w[0] = cvt_pk_bf16(o[0], o[1]); w[1] = cvt_pk_bf16(o[2], o[3]);
            *(u32x2*)(O + (size_t)t * 2048 + col) = w;
        }
    }
}
__device__ __forceinline__ float cond_from_partials(const float* condp, const float* b_ada, int j) {
    float s = b_ada[j];
#pragma unroll 8
    for (int k = 0; k < 32; ++k) s += condp[(size_t)k * NADA + j];
    return s;
}
__device__ __forceinline__ void p1_hnorm(const Args& a, const Ctx& c) {
    const float* condp = (const float*)(a.ws + WS_CONDP); float* cond = (float*)(a.ws + WS_COND);
    for (int j = c.bid * NTHREADS + c.tid; j < NADA; j += c.nb * NTHREADS) cond[j] = cond_from_partials(condp, a.in[3], j);
    LAS float* Ab = (LAS float*)c.lds; LAS float* Bb = Ab + 2048;
    for (int col = c.tid; col < 2048; col += NTHREADS) {
        Ab[col] = a.in[4][col] * (1.f + cond_from_partials(condp, a.in[3], 2048 + col)); Bb[col] = cond_from_partials(condp, a.in[3], col); }
    __syncthreads();
    norm_rows(a.in[0], (bf16_t*)(a.ws + WS_H), Ab, Bb, c);
}
__device__ __forceinline__ void p8_h2norm(const Args& a, const Ctx& c) {
    const float* cond = (const float*)(a.ws + WS_COND);
    LAS float* Ab = (LAS float*)c.lds; LAS float* Bb = Ab + 2048;
    for (int col = c.tid; col < 2048; col += NTHREADS) { Ab[col] = a.in[5][col] * (1.f + cond[4 * 2048 + col]); Bb[col] = cond[3 * 2048 + col]; }
    __syncthreads();
    norm_rows(a.out, (bf16_t*)(a.ws + WS_H), Ab, Bb, c);
}
__device__ __forceinline__ void p6_mixnorm(const Args& a, const Ctx& c) {
    const bf16_t* YS = (const bf16_t*)(a.ws + WS_YSSM); const bf16_t* YA = (const bf16_t*)(a.ws + WS_YATT); bf16_t* O = (bf16_t*)(a.ws + WS_H);
    for (int t = c.bid * 8 + c.wave; t < L_; t += c.nb * 8) {
#pragma unroll
        for (int part = 0; part < 2; ++part) {
            const bf16_t* src = (part ? YA : YS) + (size_t)t * 1024 + c.lane * 8; const float* beta = a.in[part ? 9 : 8];
            u32x4 w[2]; float f[16]; float ss = 0.f;
#pragma unroll
            for (int j = 0; j < 2; ++j) { w[j] = *(const u32x4*)(src + j * 512);
#pragma unroll
                for (int e = 0; e < 4; ++e) { f[j * 8 + 2 * e] = bflo(w[j][e]); f[j * 8 + 2 * e + 1] = bfhi(w[j][e]); } }
#pragma unroll
            for (int e = 0; e < 16; ++e) ss += f[e] * f[e];
            ss = wave_sum(ss);
            const float rstd = rsqrtf(ss * (1.f / 1024.f) + 1e-6f);
#pragma unroll
            for (int j = 0; j < 2; ++j) { const int col = j * 512 + c.lane * 8; const f32x4 b0 = *(const f32x4*)(beta + col), b1 = *(const f32x4*)(beta + col + 4);
                f32x4 o0, o1;
#pragma unroll
                for (int e = 0; e < 4; ++e) { o0[e] = f[j * 8 + e] * rstd * b0[e]; o1[e] = f[j * 8 + 4 + e] * rstd * b1[e]; }
                *(u32x4*)(O + (size_t)t * 2048 + part * 1024 + col) = pack8(o0, o1); }
        }
    }
}
constexpr int S5_US = 0, S5_ES = 33792, S5_SS = 67584;
template <int PASS>
__device__ __forceinline__ void s5_item(const Args& a, const Ctx& c, int g, int seg) {
    LAS unsigned char* lds = c.lds;
    const int tid = c.tid, wave = c.wave, lane = c.lane, r = lane & 15, q = lane >> 4;
    const bf16_t* U = (const bf16_t*)(a.ws + WS_US);
    const bf16_t* MT = (const bf16_t*)(a.ws + WS_S5MT) + (size_t)g * 65536;
    const bf16_t* WE = (const bf16_t*)(a.ws + WS_S5WE) + (size_t)g * 32768;
    const bf16_t* WC = (const bf16_t*)(a.ws + WS_S5WC) + (size_t)g * 32768;
    const float* s5p = (const float*)(a.ws + WS_S5P);
    float* F = (float*)(a.ws + WS_S5F) + (size_t)g * 4 * 128;
    bf16_t* Z = (bf16_t*)(a.ws + WS_Z);
    bf16x8 bE[8];
#pragma unroll
    for (int ks = 0; ks < 8; ++ks) bE[ks] = *(const bf16x8*)(WE + (size_t)(16 * wave + r) * 256 + 32 * ks + 8 * q);
    float sr = 0.f, si = 0.f, a16r = 0.f, a16i = 0.f;
    if (wave == 0) {
        a16r = s5p[(g * 64 + lane) * 2]; a16i = s5p[(g * 64 + lane) * 2 + 1];
        if (PASS == 1) { const float br = s5p[8192 + (g * 64 + lane) * 2], bi = s5p[8192 + (g * 64 + lane) * 2 + 1];
            for (int s = 0; s < seg; ++s) { const float fr_ = F[s * 128 + lane], fi_ = F[s * 128 + 64 + lane]; const float nr = br * sr - bi * si + fr_, ni = br * si + bi * sr + fi_; sr = nr; si = ni; } }
    }
    for (int sb = 0; sb < 4; ++sb) {
        const int tok0 = seg * 4096 + sb * 1024;
#pragma unroll
        for (int i = 0; i < 4; ++i) { const int ch = tid + NTHREADS * i, token = ch >> 1, half = ch & 1;
            const u32x4 v = *(const u32x4*)(U + (size_t)(tok0 + token) * 1024 + g * 16 + half * 8);
            *(LAS u32x4*)(lds + S5_US + (token >> 4) * 528 + ((token & 15) * 16 + half * 8) * 2) = v; }
        __syncthreads();
#pragma unroll
        for (int m = 0; m < 4; ++m) {
            f32x4 acc = {0.f, 0.f, 0.f, 0.f};
#pragma unroll
            for (int ks = 0; ks < 8; ++ks) { const bf16x8 A = *(const LAS bf16x8*)(lds + S5_US + (16 * m + r) * 528 + (32 * ks + 8 * q) * 2); acc = mfma16(A, bE[ks], acc); }
#pragma unroll
            for (int i = 0; i < 4; ++i) *(LAS float*)(lds + S5_ES + ((16 * m + 4 * q + i) * 132 + 16 * wave + r) * 4) = acc[i];
        }
        __syncthreads();
        if (wave == 0) {
            for (int ch = 0; ch < 64; ++ch) {
                const float er = *(const LAS float*)(lds + S5_ES + (ch * 132 + lane) * 4), ei = *(const LAS float*)(lds + S5_ES + (ch * 132 + 64 + lane) * 4);
                if (PASS == 1) { *(LAS bf16_t*)(lds + S5_SS + (ch * 136 + lane) * 2) = f2bf(sr); *(LAS bf16_t*)(lds + S5_SS + (ch * 136 + 64 + lane) * 2) = f2bf(si); }
                const float nr = a16r * sr - a16i * si + er, ni = a16r * si + a16i * sr + ei; sr = nr; si = ni;
            }
        }
        __syncthreads();
        if (PASS == 1) {
#pragma unroll
            for (int nt = 0; nt < 2; ++nt) {
                const int j = 2 * wave + nt;
                f32x4 acc[4];
#pragma unroll
                for (int m = 0; m < 4; ++m) acc[m] = (f32x4){0.f, 0.f, 0.f, 0.f};
                for (int ks = 0; ks <= (j >> 1); ++ks) {
                    const bf16x8 B = *(const bf16x8*)(MT + (size_t)(16 * j + r) * 256 + 32 * ks + 8 * q);
#pragma unroll
                    for (int m = 0; m < 4; ++m) { const bf16x8 A = *(const LAS bf16x8*)(lds + S5_US + (16 * m + r) * 528 + (32 * ks + 8 * q) * 2); acc[m] = mfma16(A, B, acc[m]); }
                }
#pragma unroll
                for (int ks = 0; ks < 4; ++ks) {
                    const bf16x8 B = *(const bf16x8*)(WC + (size_t)(16 * j + r) * 128 + 32 * ks + 8 * q);
#pragma unroll
                    for (int m = 0; m < 4; ++m) { const bf16x8 A = *(const LAS bf16x8*)(lds + S5_SS + (16 * m + r) * 272 + (32 * ks + 8 * q) * 2); acc[m] = mfma16(A, B, acc[m]); }
                }
#pragma unroll
                for (int m = 0; m < 4; ++m)
#pragma unroll
                    for (int i = 0; i < 4; ++i) { const int ch = 16 * m + 4 * q + i; Z[(size_t)(tok0 + 16 * ch + j) * 1024 + g * 16 + r] = f2bf(gelu_tanh(acc[m][i])); }
            }
            __syncthreads();
        }
    }
    if (PASS == 0 && wave == 0) { F[seg * 128 + lane] = sr; F[seg * 128 + 64 + lane] = si; }
}

__device__ __forceinline__ void cmp_finish_item(const Args& a, const Ctx& c, int kvsel, int rt) {
    LAS unsigned char* lds = c.lds;
    const int tid = c.tid, wave = c.wave, lane = c.lane, r = lane & 15, q = lane >> 4;
    const float* SL = (const float*)(a.ws + WS_SLAB) + (size_t)kvsel * 4 * 2048 * 256;
    const float* bpep = (const float*)(a.ws + WS_BPEP) + kvsel * 256;
    const bf16_t* W2 = (const bf16_t*)(a.ws + WS_W2) + kvsel * 128 * 256;
    for (int e = tid; e < 64 * 64; e += NTHREADS) {
        const int row = e >> 6, c4 = (e & 63) * 4;
        f32x4 s = {0.f, 0.f, 0.f, 0.f};
#pragma unroll 8
        for (int pt = 0; pt < 32; ++pt) s += *(const f32x4*)(bpep + pt * 512 + c4);
#pragma unroll
        for (int ks = 0; ks < 4; ++ks) s += *(const f32x4*)(SL + ((size_t)ks * 2048 + rt * 64 + row) * 256 + c4);
        u32x2 w; w[0] = cvt_pk_bf16(gelu_tanh(s[0]), gelu_tanh(s[1])); w[1] = cvt_pk_bf16(gelu_tanh(s[2]), gelu_tanh(s[3]));
        *(LAS u32x2*)(lds + row * 528 + c4 * 2) = w;
    }
    __syncthreads();
    bf16x8 B[8];
#pragma unroll
    for (int ks = 0; ks < 8; ++ks) B[ks] = *(const bf16x8*)(W2 + (size_t)(16 * wave + r) * 256 + 32 * ks + 8 * q);
#pragma unroll
    for (int m = 0; m < 4; ++m) {
        f32x4 acc = {0.f, 0.f, 0.f, 0.f};
#pragma unroll
        for (int ks = 0; ks < 8; ++ks) { const bf16x8 A = *(const LAS bf16x8*)(lds + (16 * m + r) * 528 + (32 * ks + 8 * q) * 2); acc = mfma16(A, B[ks], acc); }
#pragma unroll
        for (int i = 0; i < 4; ++i) {
            const int row = rt * 64 + 16 * m + 4 * q + i, gi = row >> 10, ci = row & 1023, n = 16 * wave + r;
            const bf16_t v = (ci == 1023) ? (bf16_t)0 : f2bf(acc[i]);
            if (kvsel == 0) ((bf16_t*)(a.ws + WS_KC))[((size_t)gi * 1024 + ci) * 128 + n] = v;
            else ((bf16_t*)(a.ws + WS_VCT))[((size_t)gi * 128 + n) * 1024 + ci] = v;
        }
    }
    __syncthreads();
}
constexpr int AT_KB = 0, AT_VB = 34816, AT_IMP = 69632, AT_TB = 135168, AT_BM = 147968, AT_WU = 150016, AT_END = 150272;
constexpr int AT_KBUF = 64 * 272, AT_VBUF = 128 * 136;
struct TileRegs { u32x4 k[2]; u32x4 v[2]; };
template <bool NEEDV>
__device__ __forceinline__ void tile_load(TileRegs& R, const bf16_t* Kt, const bf16_t* Vt, int ldv, int tid) {
#pragma unroll
    for (int i = 0; i < 2; ++i) { const int ch = tid + NTHREADS * i; R.k[i] = *(const u32x4*)(Kt + (ch >> 4) * 128 + (ch & 15) * 8); }
    if (NEEDV) {
#pragma unroll
        for (int i = 0; i < 2; ++i) { const int ch = tid + NTHREADS * i; R.v[i] = *(const u32x4*)(Vt + (size_t)(ch >> 3) * ldv + (ch & 7) * 8); }
    }
}
template <bool NEEDV>
__device__ __forceinline__ void tile_store(const TileRegs& R, LAS unsigned char* kb, LAS unsigned char* vb, int tid) {
#pragma unroll
    for (int i = 0; i < 2; ++i) { const int ch = tid + NTHREADS * i; *(LAS u32x4*)(kb + (ch >> 4) * 272 + (ch & 15) * 16) = R.k[i]; }
    if (NEEDV) {
#pragma unroll
        for (int i = 0; i < 2; ++i) { const int ch = tid + NTHREADS * i; LAS unsigned char* p = vb + (ch >> 3) * 136 + (ch & 7) * 16;
            *(LAS u32x2*)p = (u32x2){R.v[i][0], R.v[i][1]}; *(LAS u32x2*)(p + 8) = (u32x2){R.v[i][2], R.v[i][3]}; }
    }
}
__device__ __forceinline__ float xhalf_max(float x) { auto rr = __builtin_amdgcn_permlane32_swap(__float_as_uint(x), __float_as_uint(x), false, false); return fmaxf(__uint_as_float(rr[0]), __uint_as_float(rr[1])); }
__device__ __forceinline__ float xhalf_sum(float x) { auto rr = __builtin_amdgcn_permlane32_swap(__float_as_uint(x), __float_as_uint(x), false, false); return __uint_as_float(rr[0]) + __uint_as_float(rr[1]); }
template <int BR>
__device__ __forceinline__ void attn_tile(int MODE, LAS const unsigned char* kb, LAS const unsigned char* vb, LAS const float* tb, float cb, int key0, int t, int lane,
                                          const bf16x8 (&qf)[8], f32x16 (&O)[4], float& m, float& l, float inv_l, bool selbit, LAS float* imp_row) {
    const int r31 = lane & 31, h = lane >> 5;
    if (MODE == 1) cb = tb[TBN - 1];
#pragma unroll
    for (int sub = 0; sub < 2; ++sub) {
        f32x16 S;
#pragma unroll
        for (int r = 0; r < 16; ++r) S[r] = 0.f;
#pragma unroll
        for (int ks = 0; ks < 8; ++ks) { const bf16x8 A = *(const LAS bf16x8*)(kb + (sub * 32 + r31) * 272 + ks * 32 + h * 16); S = mfma32(A, qf[ks], S); }
        float mx = -INFINITY;
        if (MODE == 1) {
#pragma unroll
            for (int r = 0; r < 16; ++r) mx = fmaxf(mx, S[r]);
            mx = (BR == 2 && !selbit) ? -INFINITY : mx + cb;
        } else {
            const int base = (BR <= 1) ? t - 31 - 16 * (key0 + sub * 32 + 4 * h) : t - (key0 + sub * 32 + 4 * h);
            const bool nomask = (MODE == 2);
#pragma unroll
            for (int r = 0; r < 16; ++r) {
                const int cr = (r & 3) + 8 * (r >> 2);
                const int dist = (BR <= 1) ? base - 16 * cr : base - cr;
                const int idx = min(max(dist, 0), TBN - 1);
                float v = S[r] + tb[idx];
                {
                    bool valid;
                    if (BR <= 1) valid = dist >= 0; else if (BR == 2) valid = selbit && dist >= 0; else valid = nomask || (unsigned)dist < 512u;
                    v = valid ? v : -INFINITY;
                }
                S[r] = v; mx = fmaxf(mx, v);
            }
        }
        if (BR != 1) {
            mx = xhalf_max(mx);
            const float mn = fmaxf(m, mx), mu = (mn == -INFINITY) ? 0.f : mn;
            float me = mu;
            if (MODE == 1) me = (BR == 2 && !selbit) ? INFINITY : mu - cb;
            float ps = 0.f;
#pragma unroll
            for (int r = 0; r < 16; ++r) { const float p = fexp2(S[r] - me); S[r] = p; ps += p; }
            if (__any(mn > m)) {
                const float alpha = fexp2(m - mu);
                l *= alpha;
                if (BR >= 2) {
#pragma unroll
                    for (int dt = 0; dt < 4; ++dt)
#pragma unroll
                        for (int r = 0; r < 16; ++r) O[dt][r] *= alpha;
                }
            }
            l += ps; m = mn;
        } else {
            const float mu = (m == -INFINITY) ? 0.f : m;
            const float me = (MODE == 1) ? mu - cb : mu;
#pragma unroll
            for (int r = 0; r < 16; ++r) S[r] = fexp2(S[r] - me) * inv_l;
#pragma unroll
            for (int rg = 0; rg < 4; ++rg) {
                float A = 2.f * (S[4 * rg] + S[4 * rg + 1] + S[4 * rg + 2]) + S[4 * rg + 3], B = S[4 * rg + 3];
                A = quad_sum(A); B = quad_sum(B);
                const int jj = ((key0 + sub * 32) >> 2) + 2 * rg + h;
                if ((lane & 3) == 0) {
                    __hip_atomic_fetch_add(imp_row + jj, A, __ATOMIC_RELAXED, __HIP_MEMORY_SCOPE_WORKGROUP);
                    if (jj + 1 < 256) __hip_atomic_fetch_add(imp_row + jj + 1, B, __ATOMIC_RELAXED, __HIP_MEMORY_SCOPE_WORKGROUP);
                }
            }
        }
        if (BR >= 1) {
#pragma unroll
            for (int s1 = 0; s1 < 2; ++s1) {
                const int s = 2 * sub + s1;
                u32x4 pk;
#pragma unroll
                for (int e = 0; e < 4; ++e) pk[e] = cvt_pk_bf16(S[8 * s1 + 2 * e], S[8 * s1 + 2 * e + 1]);
                const bf16x8 pf = __builtin_bit_cast(bf16x8, pk);
#pragma unroll
                for (int dt = 0; dt < 4; ++dt) {
                    LAS const unsigned char* vp = vb + (32 * dt + r31) * 136 + (16 * s + 4 * h) * 2;
                    const u32x2 lo = *(const LAS u32x2*)vp, hi = *(const LAS u32x2*)(vp + 16);
                    const u32x4 av = {lo[0], lo[1], hi[0], hi[1]};
                    O[dt] = mfma32(__builtin_bit_cast(bf16x8, av), pf, O[dt]);
                }
            }
        }
    }
}
template <int BR>
__device__ __forceinline__ void run_branch(const Ctx& c, const bf16_t* Kb, const bf16_t* Vtb, int ldv, int lo, int hi, LAS const float* tb, float cb, int t, int t0,
                                           const bf16x8 (&qf)[8], f32x16 (&O)[4], float& m, float& l, float inv_l, int tl, LAS float* imp_row) {
    constexpr bool NEEDV = (BR != 0);
    LAS unsigned char* lds = c.lds;
    TileRegs R;
    int tidz = c.tid; asm volatile("" : "+v"(tidz));
    tile_load<NEEDV>(R, Kb + (size_t)lo * 64 * 128, Vtb + (size_t)lo * 64, ldv, tidz);
    tile_store<NEEDV>(R, lds + AT_KB, lds + AT_VB, tidz);
    __syncthreads();
    const int qt = t0 >> 6;
    for (int j = lo; j < hi; ++j) {
        const int buf = (j - lo) & 1;
        if (j + 1 < hi) tile_load<NEEDV>(R, Kb + (size_t)(j + 1) * 64 * 128, Vtb + (size_t)(j + 1) * 64, ldv, tidz);
        bool selbit = true, wave_on = true;
        if (BR == 2) {
            const unsigned w = *(const LAS unsigned*)(lds + AT_BM + (tl * 8 + (j >> 5)) * 4);
            selbit = (w >> (j & 31)) & 1u;
            const unsigned wu = *(const LAS unsigned*)(lds + AT_WU + (c.wave * 8 + (j >> 5)) * 4);
            wave_on = (wu >> (j & 31)) & 1u;
        }
        LAS const unsigned char* kb = lds + AT_KB + buf * AT_KBUF; LAS const unsigned char* vb = lds + AT_VB + buf * AT_VBUF;
        if (wave_on) {
            int mode = 0;
            if (BR <= 1) mode = (1024 * j + 1829 <= t0) ? 1 : 0;
            else if (BR == 2) mode = (64 * j + 853 <= t0) ? 1 : 0;
            else mode = (j >= qt - 7 && j <= qt - 1) ? 2 : 0;
            attn_tile<BR>(mode, kb, vb, tb, cb, j * 64, t, c.lane, qf, O, m, l, inv_l, selbit, imp_row);
        }
        if (j + 1 < hi) tile_store<NEEDV>(R, lds + AT_KB + (buf ^ 1) * AT_KBUF, lds + AT_VB + (buf ^ 1) * AT_VBUF, tidz);
        __syncthreads();
    }
}
__device__ __forceinline__ void attn_item(const Args& a, const Ctx& c_, int qt, int g) {
    Ctx c = c_; { int tz = c_.tid; asm volatile("" : "+v"(tz)); c.tid = tz; c.lane = tz & 63; }
    LAS unsigned char* lds = c.lds;
    const int tid = c.tid, wave = c.wave, lane = c.lane, r31 = lane & 31, h = lane >> 5, hl = lane & 3;
    const int t0 = qt * 64, tl = 8 * wave + (r31 >> 2), t = t0 + tl, head = g * 4 + hl;
    const bf16_t* Qb = (const bf16_t*)(a.ws + WS_Q);
    const bf16_t* KROW = (const bf16_t*)(a.ws + WS_KROW);
    const bf16_t* VT = (const bf16_t*)(a.ws + WS_VT);
    const float* GATE = (const float*)(a.ws + WS_GATE);
    { const float* tbg = (const float*)(a.ws + WS_TB) + g * 4 * TBN;
      for (int i = tid; i < 4 * TBN; i += NTHREADS) *(LAS float*)(lds + AT_TB + i * 4) = tbg[i];
      for (int i = tid; i < 64 * 256; i += NTHREADS) *(LAS float*)(lds + AT_IMP + i * 4) = 0.f; }
    bf16x8 qf[8];
#pragma unroll
    for (int ks = 0; ks < 8; ++ks) qf[ks] = *(const bf16x8*)(Qb + (size_t)t * 1024 + head * 128 + 16 * ks + 8 * h);
    LAS const float* tb = (LAS const float*)(lds + AT_TB) + hl * TBN;
    LAS float* imp_row = (LAS float*)(lds + AT_IMP) + tl * 256;
    const float cb = 0.f;
    f32x16 O[4]; unsigned Otp[4][8];
#pragma unroll
    for (int dt = 0; dt < 4; ++dt)
#pragma unroll
        for (int r = 0; r < 16; ++r) O[dt][r] = 0.f;
    __syncthreads();
    { const int ntile = (t0 / 16 + 3 + 63) / 64;
      const bf16_t* KC = (const bf16_t*)(a.ws + WS_KC) + (size_t)g * 1024 * 128; const bf16_t* VCT = (const bf16_t*)(a.ws + WS_VCT) + (size_t)g * 128 * 1024;
      float m = -INFINITY, l = 0.f;
      run_branch<0>(c, KC, VCT, 1024, 0, ntile, tb, cb, t, t0, qf, O, m, l, 0.f, tl, imp_row);
      const float lt = xhalf_sum(l), inv = lt > 0.f ? 1.f / lt : 0.f;
      run_branch<1>(c, KC, VCT, 1024, 0, ntile, tb, cb, t, t0, qf, O, m, l, inv, tl, imp_row);
      const float gc = GATE[(size_t)t * 24 + head];
#pragma unroll
      for (int dt = 0; dt < 4; ++dt)
#pragma unroll
          for (int r = 0; r < 8; ++r) { Otp[dt][r] = cvt_pk_bf16(gc * O[dt][2 * r], gc * O[dt][2 * r + 1]); O[dt][2 * r] = 0.f; O[dt][2 * r + 1] = 0.f; }
    }
    {
        unsigned wu[8];
#pragma unroll
        for (int k = 0; k < 8; ++k) wu[k] = 0u;
        const int ncand = qt - 2 > 0 ? qt - 2 : 0;
        for (int i = 0; i < 8; ++i) {
            LAS const float* row = (LAS const float*)(lds + AT_IMP) + (8 * wave + i) * 256;
            float v[4]; bool sel[4];
#pragma unroll
            for (int k = 0; k < 4; ++k) { const int j = lane + 64 * k; const bool cand = (j >= 1 && j <= qt - 2); v[k] = cand ? row[j] : -1.f; sel[k] = false; }
            if (ncand <= 13) {
#pragma unroll
                for (int k = 0; k < 4; ++k) sel[k] = v[k] >= 0.f;
            } else {
                for (int it = 0; it < 13; ++it) {
                    float mx = fmaxf(fmaxf(v[0], v[1]), fmaxf(v[2], v[3])); mx = wave_max(mx);
                    int wk = -1, wl = 0;
#pragma unroll
                    for (int k = 0; k < 4; ++k) { const unsigned long long mk = __ballot(v[k] == mx); if (wk < 0 && mk != 0ull) { wk = k; wl = __ffsll((long long)mk) - 1; } }
#pragma unroll
                    for (int k = 0; k < 4; ++k) if (k == wk && lane == wl) { v[k] = -1.f; sel[k] = true; }
                }
            }
#pragma unroll
            for (int k = 0; k < 4; ++k) {
                const int j = lane + 64 * k; const bool forced = (j == 0) || (j == qt) || (j == qt - 1);
                const unsigned long long mk = __ballot(sel[k] || forced);
                const unsigned lo = (unsigned)mk, hi = (unsigned)(mk >> 32);
                if (lane == 0) { *(LAS unsigned*)(lds + AT_BM + ((8 * wave + i) * 8 + 2 * k) * 4) = lo; *(LAS unsigned*)(lds + AT_BM + ((8 * wave + i) * 8 + 2 * k + 1) * 4) = hi; }
                wu[2 * k] |= lo; wu[2 * k + 1] |= hi;
            }
        }
        if (lane == 0) {
#pragma unroll
            for (int k = 0; k < 8; ++k) *(LAS unsigned*)(lds + AT_WU + (wave * 8 + k) * 4) = wu[k];
        }
    }
    LAS unsigned* park = (LAS unsigned*)(lds + AT_IMP + wave * 8192) + lane;
#pragma unroll
    for (int dt = 0; dt < 4; ++dt)
#pragma unroll
        for (int r = 0; r < 8; ++r) park[(dt * 8 + r) * 64] = Otp[dt][r];
    __syncthreads();
    { float m = -INFINITY, l = 0.f;
      run_branch<2>(c, KROW + (size_t)(2 + g) * L_ * 128, VT + (size_t)g * 128 * L_, L_, 0, qt + 1, tb, cb, t, t0, qf, O, m, l, 0.f, tl, imp_row);
      const float gs = GATE[(size_t)t * 24 + 8 + head];
      const float lt = xhalf_sum(l), sc = gs * (lt > 0.f ? 1.f / lt : 0.f);
#pragma unroll
      for (int dt = 0; dt < 4; ++dt)
#pragma unroll
          for (int r = 0; r < 8; ++r) { const unsigned w = park[(dt * 8 + r) * 64]; park[(dt * 8 + r) * 64] = cvt_pk_bf16(bflo(w) + sc * O[dt][2 * r], bfhi(w) + sc * O[dt][2 * r + 1]); O[dt][2 * r] = 0.f; O[dt][2 * r + 1] = 0.f; }
    }
    { float m = -INFINITY, l = 0.f;
      const int lo = qt - 8 > 0 ? qt - 8 : 0;
      run_branch<3>(c, KROW + (size_t)(4 + g) * L_ * 128, VT + (size_t)(2 + g) * 128 * L_, L_, lo, qt + 1, tb, cb, t, t0, qf, O, m, l, 0.f, tl, imp_row);
      const float gw = GATE[(size_t)t * 24 + 16 + head];
      const float lt = xhalf_sum(l), sc = gw * (lt > 0.f ? 1.f / lt : 0.f);
#pragma unroll
      for (int dt = 0; dt < 4; ++dt)
#pragma unroll
          for (int r = 0; r < 8; ++r) { const unsigned w = park[(dt * 8 + r) * 64]; Otp[dt][r] = cvt_pk_bf16(bflo(w) + sc * O[dt][2 * r], bfhi(w) + sc * O[dt][2 * r + 1]); }
    }
    bf16_t* Y = (bf16_t*)(a.ws + WS_YATT) + (size_t)t * 1024 + head * 128;
#pragma unroll
    for (int dt = 0; dt < 4; ++dt)
#pragma unroll
        for (int rg = 0; rg < 4; ++rg) {
            u32x2 w; w[0] = Otp[dt][2 * rg]; w[1] = Otp[dt][2 * rg + 1];
            *(u32x2*)(Y + 32 * dt + 8 * rg + 4 * h) = w;
        }
    __syncthreads();
}
#ifndef PEER_ALPHA
#define PEER_ALPHA 1.0f
#endif
constexpr int PE_SC = 0, PE_LV = 66048, PE_LI = 74240, PE_EX = 82432, PE_GT = 86528, PE_END = 90624;
__device__ __forceinline__ float wave_sum_bcast(float v) {
    v += dpp_f<0xB1>(v); v += dpp_f<0x4E>(v); v += dpp_f<0x141>(v); v += dpp_f<0x140>(v);
    v += __int_as_float(__builtin_amdgcn_update_dpp(0, __float_as_int(v), 0x142, 0xa, 0xf, false));
    v += __int_as_float(__builtin_amdgcn_update_dpp(0, __float_as_int(v), 0x143, 0xc, 0xf, false));
    return __int_as_float(__builtin_amdgcn_readlane(__float_as_int(v), 63));
}
__device__ __forceinline__ unsigned mono_key(float v) { const unsigned b = __float_as_uint(v); return b ^ ((b >> 31) ? 0xFFFFFFFFu : 0x80000000u); }
struct RowRegs { u32x4 u[2]; u32x4 v[2]; float su, sv; };
__device__ __forceinline__ void row_load(RowRegs& R, const unsigned char* PU, const unsigned char* PV, const float* psc, int e, int lane) {
    const unsigned char* up = PU + (size_t)e * 2048 + lane * 16; const unsigned char* vp = PV + (size_t)e * 2048 + lane * 16;
#pragma unroll
    for (int j = 0; j < 2; ++j) { R.u[j] = *(const u32x4*)(up + j * 1024); R.v[j] = *(const u32x4*)(vp + j * 1024); }
    R.su = psc[e]; R.sv = psc[16384 + e];
}
__device__ __forceinline__ void row_apply(const RowRegs& R, const float (&hp)[32], float gate, float (&acc)[32]) {
    float d0 = 0.f, d1 = 0.f;
#pragma unroll
    for (int j = 0; j < 2; ++j)
#pragma unroll
        for (int w = 0; w < 4; ++w) {
            const f32x2 lo = __builtin_amdgcn_cvt_pk_f32_fp8((int)R.u[j][w], false), hi = __builtin_amdgcn_cvt_pk_f32_fp8((int)R.u[j][w], true);
            d0 += lo[0] * hp[j * 16 + 4 * w] + hi[0] * hp[j * 16 + 4 * w + 2];
            d1 += lo[1] * hp[j * 16 + 4 * w + 1] + hi[1] * hp[j * 16 + 4 * w + 3];
        }
    const float d = wave_sum_bcast(d0 + d1) * R.su;
    const float wgt = gate * gelu_tanh(d) * R.sv;
#pragma unroll
    for (int j = 0; j < 2; ++j)
#pragma unroll
        for (int w = 0; w < 4; ++w) {
            const f32x2 lo = __builtin_amdgcn_cvt_pk_f32_fp8((int)R.v[j][w], false), hi = __builtin_amdgcn_cvt_pk_f32_fp8((int)R.v[j][w], true);
            acc[j * 16 + 4 * w] += wgt * lo[0]; acc[j * 16 + 4 * w + 1] += wgt * lo[1]; acc[j * 16 + 4 * w + 2] += wgt * hi[0]; acc[j * 16 + 4 * w + 3] += wgt * hi[1];
        }
}
template <bool DRY>
__device__ __forceinline__ void peer_step(const Args& a, const Ctx& c, int t0) {
    LAS unsigned char* lds = c.lds;
    const int tid = c.tid, wave = c.wave, lane = c.lane, r = lane & 15, q = lane >> 4;
    const bf16_t* QP = (const bf16_t*)(a.ws + WS_QP); const bf16_t* PK = (const bf16_t*)(a.ws + WS_PK);
    const unsigned char* PU = a.ws + WS_PU; const unsigned char* PV = a.ws + WS_PV; const float* psc = (const float*)(a.ws + WS_PSC);
    const bf16_t* HB = (const bf16_t*)(a.ws + WS_H);
    {
        const int hh = wave;
#pragma unroll
        for (int cc = 0; cc < 2; ++cc) {
            bf16x8 aF[4];
#pragma unroll
            for (int ks = 0; ks < 4; ++ks) aF[ks] = *(const bf16x8*)(QP + (size_t)(t0 + (r & 7)) * 2048 + hh * 256 + cc * 128 + 32 * ks + 8 * q);
#pragma unroll 2
            for (int nt = 0; nt < 8; ++nt) {
                f32x4 acc = {0.f, 0.f, 0.f, 0.f};
#pragma unroll
                for (int ks = 0; ks < 4; ++ks) { const bf16x8 B = *(const bf16x8*)(PK + (size_t)(cc * 128 + 16 * nt + r) * 128 + 32 * ks + 8 * q); acc = mfma16(aF[ks], B, acc); }
                if (q < 2) {
#pragma unroll
                    for (int i = 0; i < 4; ++i) { const int tok = 4 * q + i; *(LAS float*)(lds + PE_SC + ((tok * 16 + hh * 2 + cc) * 129 + 16 * nt + r) * 4) = acc[i]; }
                }
            }
        }
    }
    __syncthreads();
    if (tid < 128) {
        LAS const float* sc = (LAS const float*)(lds + PE_SC) + tid * 129;
        unsigned top[16];
#pragma unroll
        for (int e = 0; e < 16; ++e) top[e] = 0u;
#pragma unroll 2
        for (int k = 0; k < 128; ++k) {
            unsigned key = (mono_key(sc[k]) & ~0x7Fu) | (unsigned)(127 - k);
#pragma unroll
            for (int e = 0; e < 16; ++e) { const unsigned hi = max(top[e], key); key = min(top[e], key); top[e] = hi; }
        }
#pragma unroll
        for (int e = 0; e < 16; ++e) { const int idx = 127 - (int)(top[e] & 0x7Fu); *(LAS float*)(lds + PE_LV + (tid * 16 + e) * 4) = sc[idx]; *(LAS int*)(lds + PE_LI + (tid * 16 + e) * 4) = idx; }
    }
    __syncthreads();
    if (tid < 64) {
        const int tok = tid >> 3, hh = tid & 7, t1 = tok * 16 + hh * 2, t2 = t1 + 1;
        float v1[16], v2[16];
#pragma unroll
        for (int e = 0; e < 16; ++e) { v1[e] = *(const LAS float*)(lds + PE_LV + (t1 * 16 + e) * 4); v2[e] = *(const LAS float*)(lds + PE_LV + (t2 * 16 + e) * 4); }
        unsigned top[16];
#pragma unroll
        for (int e = 0; e < 16; ++e) top[e] = 0u;
#pragma unroll
        for (int aa = 0; aa < 16; ++aa)
#pragma unroll
            for (int bb = 0; bb < 16; ++bb)
                if ((aa + 1) * (bb + 1) <= 16) {
                    unsigned key = (mono_key(v1[aa] + v2[bb]) & ~0xFFu) | (unsigned)(255 - (aa * 16 + bb));
#pragma unroll
                    for (int e = 0; e < 16; ++e) { const unsigned hi = max(top[e], key); key = min(top[e], key); top[e] = hi; }
                }
        float sv[16]; int ex[16]; float mx = -INFINITY;
#pragma unroll
        for (int e = 0; e < 16; ++e) {
            const int id = 255 - (int)(top[e] & 0xFFu), aa = id >> 4, bb = id & 15;
            sv[e] = *(const LAS float*)(lds + PE_LV + (t1 * 16 + aa) * 4) + *(const LAS float*)(lds + PE_LV + (t2 * 16 + bb) * 4);
            ex[e] = *(const LAS int*)(lds + PE_LI + (t1 * 16 + aa) * 4) * 128 + *(const LAS int*)(lds + PE_LI + (t2 * 16 + bb) * 4);
            mx = fmaxf(mx, sv[e]);
        }
        float sum = 0.f;
#pragma unroll
        for (int e = 0; e < 16; ++e) { sv[e] = fexp2((sv[e] - mx) * LOG2E); sum += sv[e]; }
        const float inv = 1.f / sum;
#pragma unroll
        for (int e = 0; e < 16; ++e) { *(LAS int*)(lds + PE_EX + (tok * 128 + hh * 16 + e) * 4) = ex[e]; *(LAS float*)(lds + PE_GT + (tok * 128 + hh * 16 + e) * 4) = sv[e] * inv; }
    }
    __syncthreads();
    const int t = t0 + wave;
    float hp[32];
#pragma unroll
    for (int j = 0; j < 2; ++j)
#pragma unroll
        for (int k = 0; k < 2; ++k) { const u32x4 w = *(const u32x4*)(HB + (size_t)t * 2048 + j * 1024 + lane * 16 + k * 8);
#pragma unroll
            for (int e = 0; e < 4; ++e) { hp[j * 16 + k * 8 + 2 * e] = bflo(w[e]); hp[j * 16 + k * 8 + 2 * e + 1] = bfhi(w[e]); } }
    float acc[32];
#pragma unroll
    for (int e = 0; e < 32; ++e) acc[e] = 0.f;
    {
        LAS const int* exl = (LAS const int*)(lds + PE_EX) + wave * 128; LAS const float* gtl = (LAS const float*)(lds + PE_GT) + wave * 128;
        RowRegs R0, R1, R2, R3;
        row_load(R0, PU, PV, psc, __builtin_amdgcn_readfirstlane(exl[0]), lane);
        row_load(R1, PU, PV, psc, __builtin_amdgcn_readfirstlane(exl[1]), lane);
        row_load(R2, PU, PV, psc, __builtin_amdgcn_readfirstlane(exl[2]), lane);
        row_load(R3, PU, PV, psc, __builtin_amdgcn_readfirstlane(exl[3]), lane);
#pragma unroll 1
        for (int e = 0; e < 128; e += 4) {
            const bool more = e + 4 < 128;
            row_apply(R0, hp, gtl[e], acc);     if (more) row_load(R0, PU, PV, psc, __builtin_amdgcn_readfirstlane(exl[e + 4]), lane);
            row_apply(R1, hp, gtl[e + 1], acc); if (more) row_load(R1, PU, PV, psc, __builtin_amdgcn_readfirstlane(exl[e + 5]), lane);
            row_apply(R2, hp, gtl[e + 2], acc); if (more) row_load(R2, PU, PV, psc, __builtin_amdgcn_readfirstlane(exl[e + 6]), lane);
            row_apply(R3, hp, gtl[e + 3], acc); if (more) row_load(R3, PU, PV, psc, __builtin_amdgcn_readfirstlane(exl[e + 7]), lane);
        }
    }
    {
        float* xo = a.out + (size_t)t * 2048; const float* g2 = (const float*)(a.ws + WS_COND) + 5 * 2048; const float* fg = a.in[32];
        float ss = 0.f;
#pragma unroll
        for (int j = 0; j < 2; ++j)
#pragma unroll
            for (int k = 0; k < 4; ++k) {
                const int col = j * 1024 + lane * 16 + k * 4;
                const f32x4 x1 = *(const f32x4*)(xo + col), gv = *(const f32x4*)(g2 + col);
#pragma unroll
                for (int e = 0; e < 4; ++e) { const float x2 = x1[e] + PEER_ALPHA * gv[e] * acc[j * 16 + k * 4 + e]; acc[j * 16 + k * 4 + e] = x2; ss += x2 * x2; }
            }
        ss = wave_sum_bcast(ss);
        const float rstd = rsqrtf(ss * (1.f / 2048.f) + 1e-6f);
#pragma unroll
        for (int j = 0; j < 2; ++j)
#pragma unroll
            for (int k = 0; k < 4; ++k) {
                const int col = j * 1024 + lane * 16 + k * 4;
                const f32x4 fv = *(const f32x4*)(fg + col);
                f32x4 o;
#pragma unroll
                for (int e = 0; e < 4; ++e) o[e] = acc[j * 16 + k * 4 + e] * rstd * fv[e];
                if (!DRY || rstd == 123.456f) *(f32x4*)(xo + col) = o;
            }
    }
    __syncthreads();
}
constexpr int NPHASE = 11;
#ifndef DBG
#define DBG 0
#endif
__device__ __forceinline__ void dbg_final_norm(const Args& a, const Ctx& c, const float* src) {
    for (int t = c.bid * 8 + c.wave; t < L_; t += c.nb * 8) {
        const float* xr = src + (size_t)t * 2048 + c.lane * 4; float* o = a.out + (size_t)t * 2048 + c.lane * 4;
        f32x4 v[8]; float ss = 0.f;
#pragma unroll
        for (int j = 0; j < 8; ++j) { v[j] = *(const f32x4*)(xr + j * 256); ss += v[j][0] * v[j][0] + v[j][1] * v[j][1] + v[j][2] * v[j][2] + v[j][3] * v[j][3]; }
        ss = wave_sum(ss);
        const float rstd = rsqrtf(ss * (1.f / 2048.f) + 1e-6f);
#pragma unroll
        for (int j = 0; j < 8; ++j) { const f32x4 g = *(const f32x4*)(a.in[32] + j * 256 + c.lane * 4); *(f32x4*)(o + j * 256) = v[j] * rstd * g; }
    }
}

extern __shared__ __attribute__((aligned(16))) unsigned char smem[];

__global__ void __launch_bounds__(512, 2) fwd(Args a) {
    LAS unsigned char* lds = (LAS unsigned char*)smem;
    Ctx c; c.bid = blockIdx.x; c.nb = gridDim.x; c.tid = threadIdx.x; c.wave = __builtin_amdgcn_readfirstlane(threadIdx.x >> 6); c.lane = threadIdx.x & 63; c.lds = lds;
    volatile LAS unsigned* xbw = (volatile LAS unsigned*)(lds + LDS_BYTES - 16);
    if (c.tid < 4) xbw[c.tid] = 0u;
    __syncthreads();
    const int lo = a.ph_lo, hi = a.ph_hi;
    const bool multi = (hi - lo) > 1;
    XcdBarrier bar; bar.bar = (unsigned*)(a.ws + WS_CTL); bar.x = 0; bar.st = xbw;
    if (multi) bar = xcd_barrier_post((unsigned*)(a.ws + WS_CTL), xbw);
#ifndef PHASE_MASK
#define PHASE_MASK 0xFFFF
#endif
#if DBG == 1
#undef PHASE_MASK
#define PHASE_MASK 0x403
#elif DBG == 2 || DBG == 4 || DBG == 5
#undef PHASE_MASK
#define PHASE_MASK 0x4FF
#endif
#define IN(k) (((PHASE_MASK >> (k)) & 1) && lo <= (k) && (k) < hi)
#define REFRESH() do { int tz_ = threadIdx.x; asm volatile("" : "+v"(tz_)); c.tid = tz_; c.lane = tz_ & 63; c.wave = __builtin_amdgcn_readfirstlane(tz_ >> 6); } while (0)
#define SEAM(k) do { if (IN(k) && IN((k) + 1)) xcd_barrier(bar); } while (0)
#ifndef DUP
#define DUP -1
#endif
#define REP(k) for (int rep_ = 0; rep_ < ((DUP == (k)) ? 2 : 1); ++rep_)

    if (IN(0)) REP(0) { REFRESH(); p0_prologue(a, c); }
    SEAM(0);
    if (IN(1)) { REFRESH(); p1_hnorm(a, c); }
    SEAM(1);
    if (IN(2)) REP(2) { REFRESH();
        pg8::StaticOrder S; S.init((const bf16_t*)(a.ws + WS_H), (const bf16_t*)(a.ws + WS_WIN), 2048, 2048, 2048, L_, DIN_PAD, c.nb, c.bid);
        EpiWin E{(bf16_t*)(a.ws + WS_US), (bf16_t*)(a.ws + WS_Q), (bf16_t*)(a.ws + WS_KROW), (bf16_t*)(a.ws + WS_VROW), (bf16_t*)(a.ws + WS_VT), (float*)(a.ws + WS_GATE)};
        pg8::gemm_phase<EpiWin, pg8::StaticOrder>(lds, S, E);
    }
    SEAM(2);
    if (IN(3)) REP(3) { REFRESH();
        for (int it = c.bid; it < 256; it += c.nb) s5_item<0>(a, c, it >> 2, it & 3);
        __syncthreads();
        CmpOrder S{(const bf16_t*)(a.ws + WS_KROW), (const bf16_t*)(a.ws + WS_VROW), (const bf16_t*)(a.ws + WS_W1), 2048, 4096, 1024, c.nb, c.bid};
        EpiSlab E{(float*)(a.ws + WS_SLAB)};
        pg8::gemm_phase<EpiSlab, CmpOrder>(lds, S, E);
    }
    SEAM(3);
    if (IN(4)) REP(4) { REFRESH();
        for (int it = c.bid; it < 64; it += c.nb) cmp_finish_item(a, c, it >> 5, it & 31);
        for (int it = c.bid; it < 256; it += c.nb) s5_item<1>(a, c, it >> 2, it & 3);
    }
    SEAM(4);
    if (IN(5)) { REFRESH();
#if DBG == 5
        for (size_t i = (size_t)c.bid * NTHREADS + c.tid; i < (size_t)L_ * 1024 / 8; i += (size_t)c.nb * NTHREADS) *(u32x4*)((bf16_t*)(a.ws + WS_YSSM) + i * 8) = (u32x4){0u, 0u, 0u, 0u};
#else
        {
            pg8::StaticOrder S; S.init((const bf16_t*)(a.ws + WS_Z), (const bf16_t*)(a.ws + WS_WGLU), 1024, 1024, 1024, L_, 1024, c.nb, c.bid);
            EpiGlu E{(const bf16_t*)(a.ws + WS_Z), a.in[19], (bf16_t*)(a.ws + WS_YSSM)};
            pg8::gemm_phase<EpiGlu, pg8::StaticOrder>(lds, S, E);
        }
#endif
        __syncthreads();
        REP(5)
#if DBG == 4
        for (size_t i = (size_t)c.bid * NTHREADS + c.tid; i < (size_t)L_ * 1024 / 8; i += (size_t)c.nb * NTHREADS) *(u32x4*)((bf16_t*)(a.ws + WS_YATT) + i * 8) = (u32x4){0u, 0u, 0u, 0u};
#else
        for (int it = c.bid; it < 512; it += c.nb) {
            const int rnd = it / c.nb;
            const int qt = (rnd & 1) ? 255 - (it % 256) : (it % 256), g = (it >> 8) & 1;
            attn_item(a, c, qt, g);
        }
#endif
    }
    SEAM(5);
    if (IN(6)) { REFRESH(); p6_mixnorm(a, c); }
    SEAM(6);
    if (IN(7)) { REFRESH();
        pg8::StaticOrder S; S.init((const bf16_t*)(a.ws + WS_H), (const bf16_t*)(a.ws + WS_WOUT), 2048, 2048, 2048, L_, 2048, c.nb, c.bid);
        EpiWout E{a.in[0], (const float*)(a.ws + WS_COND) + 2 * 2048, a.out};
        pg8::gemm_phase<EpiWout, pg8::StaticOrder>(lds, S, E);
    }
    SEAM(7);
    if (IN(8)) { REFRESH(); p8_h2norm(a, c); }
    SEAM(8);
    if (IN(9)) { REFRESH();
        pg8::StaticOrder S; S.init((const bf16_t*)(a.ws + WS_H), (const bf16_t*)(a.ws + WS_WQ), 2048, 2048, 2048, L_, 2048, c.nb, c.bid);
        EpiBf16 E{(bf16_t*)(a.ws + WS_QP), 2048};
        pg8::gemm_phase<EpiBf16, pg8::StaticOrder>(lds, S, E);
    }
    SEAM(9);
    if (IN(10)) { REFRESH();
#if DBG == 1
        dbg_final_norm(a, c, a.in[0]);
#elif DBG == 2 || DBG == 4 || DBG == 5
        dbg_final_norm(a, c, a.out);
#else
        if (DUP == 10) { for (int s = c.bid; s < L_ / 8; s += c.nb) peer_step<true>(a, c, s * 8); }
        for (int s = c.bid; s < L_ / 8; s += c.nb) peer_step<false>(a, c, s * 8);
#endif
    }
#undef IN
#undef SEAM
}

#ifndef N_LAUNCHES
#define N_LAUNCHES 1
#endif
extern "C" void kernel_launch(void* const* d_in, const int* in_sizes, int n_in, void* d_out, int out_size, void* d_ws, size_t ws_size, hipStream_t stream) {
    static int grid = 0;
    if (grid == 0) {
        if (n_in != 33 || out_size != L_ * D_ || ws_size < WS_END) { fprintf(stderr, "kernel_launch: unexpected shapes (n_in %d, out %d, ws %zu < %zu); nothing launched\n", n_in, out_size, ws_size, (size_t)WS_END); grid = -1; return; }
        int dev = 0, cus = 0, per_cu = 0;
        if (hipGetDevice(&dev) != hipSuccess || hipDeviceGetAttribute(&cus, hipDeviceAttributeMultiprocessorCount, dev) != hipSuccess) { grid = -1; return; }
        if (hipFuncSetAttribute((const void*)fwd, hipFuncAttributeMaxDynamicSharedMemorySize, LDS_BYTES) != hipSuccess) { fprintf(stderr, "kernel_launch: hipFuncSetAttribute failed\n"); grid = -1; return; }
        if (hipOccupancyMaxActiveBlocksPerMultiprocessor(&per_cu, (const void*)fwd, NTHREADS, LDS_BYTES) != hipSuccess || per_cu < 1) { fprintf(stderr, "kernel_launch: occupancy query says %d\n", per_cu); (void)hipGetLastError(); grid = -1; return; }
        grid = cus;
    }
    if (grid < 0) return;
    (void)hipMemsetAsync((char*)d_ws + WS_CTL, 0, CTL_BYTES, stream);
    Args a{};
    for (int i = 0; i < 33; ++i) a.in[i] = (const float*)d_in[i];
    a.out = (float*)d_out; a.ws = (unsigned char*)d_ws;
    if (N_LAUNCHES == 1) { a.ph_lo = 0; a.ph_hi = NPHASE; hipLaunchKernelGGL(fwd, dim3(grid), dim3(NTHREADS), LDS_BYTES, stream, a); }
    else for (int p = 0; p < NPHASE; ++p) { a.ph_lo = p; a.ph_hi = p + 1; hipLaunchKernelGGL(fwd, dim3(grid), dim3(NTHREADS), LDS_BYTES, stream, a); }
}
```

```cpp
#include <hip/hip_runtime.h>
#include <stdint.h>
#include <stdio.h>

#define LAS __attribute__((address_space(3)))
typedef unsigned short bf16_t;
typedef short bf16x8 __attribute__((ext_vector_type(8)));
typedef float f32x2 __attribute__((ext_vector_type(2)));
typedef float f32x4 __attribute__((ext_vector_type(4)));
typedef float f32x16 __attribute__((ext_vector_type(16)));
typedef unsigned u32x2 __attribute__((ext_vector_type(2)));
typedef unsigned u32x4 __attribute__((ext_vector_type(4)));
typedef __bf16 bfv2 __attribute__((ext_vector_type(2)));
typedef unsigned u32x6 __attribute__((ext_vector_type(6)));
typedef float f32x32 __attribute__((ext_vector_type(32)));

constexpr int L_ = 16384, D_ = 2048, DSSM = 1024, DATT = 1024, DIN = 3608, DIN_PAD = 3840;
constexpr int NADA = 12288;
constexpr float LOG2E = 1.4426950408889634f;
constexpr float QSCALE = 0.08838834764831845f * 1.4426950408889634f;
constexpr int TBN = 800;
constexpr int NTHREADS = 512;
constexpr int LDS_BYTES = 163840;

constexpr size_t al256(size_t x) { return (x + 255) & ~(size_t)255; }
constexpr size_t WS_CTL   = 0;                                  constexpr size_t CTL_BYTES = 65536;
constexpr size_t WS_CONDP = WS_CTL + CTL_BYTES;
constexpr size_t WS_COND  = WS_CONDP + 32 * 12288 * 4;
constexpr size_t WS_TB    = WS_COND + 12288 * 4;
constexpr size_t WS_BPE   = al256(WS_TB + 8 * TBN * 4);
constexpr size_t WS_S5P   = al256(WS_BPE + 2 * 256 * 4);
constexpr size_t WS_S5F   = WS_S5P + 2 * 64 * 64 * 2 * 4;
constexpr size_t WS_S5MT  = WS_S5F + 64 * 4 * 128 * 4;
constexpr size_t WS_S5WE  = WS_S5MT + (size_t)64 * 256 * 256 * 2;
constexpr size_t WS_S5WC  = WS_S5WE + (size_t)64 * 128 * 256 * 2;
constexpr size_t WS_WIN   = WS_S5WC + (size_t)64 * 256 * 128 * 2;
constexpr size_t WS_WGLU  = WS_WIN + (size_t)DIN_PAD * 2048 * 2;
constexpr size_t WS_WOUT  = WS_WGLU + (size_t)1024 * 1024 * 2;
constexpr size_t WS_WQ    = WS_WOUT + (size_t)2048 * 2048 * 2;
constexpr size_t WS_W1    = WS_WQ + (size_t)2048 * 2048 * 2;
constexpr size_t WS_W2    = WS_W1 + (size_t)2 * 256 * 4096 * 2;
constexpr size_t WS_PK    = WS_W2 + (size_t)2 * 128 * 256 * 2;
constexpr size_t WS_PU    = WS_PK + (size_t)2 * 128 * 128 * 2;
constexpr size_t WS_PV    = WS_PU + (size_t)16384 * 1536;
constexpr size_t WS_PSC   = WS_PV + (size_t)16384 * 1536;
constexpr size_t WS_BPEP  = WS_PSC + (size_t)2 * 16384 * 4;
constexpr size_t WS_H     = WS_BPEP + (size_t)32 * 2 * 256 * 4;
constexpr size_t WS_US    = WS_H + (size_t)16384 * 2048 * 2;
constexpr size_t WS_Q     = WS_US + (size_t)16384 * 1024 * 2;
constexpr size_t WS_QP    = WS_US;
constexpr size_t WS_KROW  = WS_Q + (size_t)16384 * 1024 * 2;
constexpr size_t WS_VROW  = WS_KROW + (size_t)6 * 16384 * 128 * 2;
constexpr size_t WS_VT    = WS_VROW + (size_t)2 * 16384 * 128 * 2 + 8192;
constexpr size_t WS_GATE  = WS_VT + (size_t)4 * 128 * 16384 * 2;
constexpr size_t WS_SLAB  = WS_GATE + (size_t)16384 * 24 * 4;
constexpr size_t WS_KC    = WS_SLAB + (size_t)2 * 4 * 2048 * 256 * 4;
constexpr size_t WS_VCT   = WS_KC + (size_t)2 * 1024 * 128 * 2;
constexpr size_t WS_Z     = WS_VCT + (size_t)2 * 128 * 1024 * 2;
constexpr size_t WS_YSSM  = WS_Z + (size_t)16384 * 1024 * 2;
constexpr size_t WS_YATT  = WS_YSSM + (size_t)16384 * 1024 * 2;
constexpr size_t WS_END   = WS_YATT + (size_t)16384 * 1024 * 2;
static_assert(WS_END < (size_t)530 * 1024 * 1024, "workspace map too large");

struct Args { const float* in[33]; float* out; unsigned char* ws; int ph_lo, ph_hi; };

__device__ __forceinline__ unsigned cvt_pk_bf16(float lo, float hi) { bfv2 v; v[0] = (__bf16)lo; v[1] = (__bf16)hi; return __builtin_bit_cast(unsigned, v); }
__device__ __forceinline__ bf16_t f2bf(float f) { return (bf16_t)(cvt_pk_bf16(f, 0.f) & 0xffffu); }
__device__ __forceinline__ float bf2f(unsigned b) { return __uint_as_float(b << 16); }
__device__ __forceinline__ float bflo(unsigned w) { return __uint_as_float(w << 16); }
__device__ __forceinline__ float bfhi(unsigned w) { return __uint_as_float(w & 0xffff0000u); }
__device__ __forceinline__ float fexp2(float x) { return __builtin_amdgcn_exp2f(x); }
__device__ __forceinline__ float frcp(float x) { return __builtin_amdgcn_rcpf(x); }
__device__ __forceinline__ float sigmoidf_(float x) { return frcp(1.f + fexp2(-LOG2E * x)); }
__device__ __forceinline__ float gelu_tanh(float x) {
    const float u = x * (1.f + 0.044715f * x * x);
    return x * frcp(1.f + fexp2(-2.f * 0.7978845608028654f * LOG2E * u));
}
__device__ __forceinline__ float shfl_xor_f(float v, int m) { return __shfl_xor(v, m, 64); }
__device__ __forceinline__ float wave_sum(float v) {
#pragma unroll
    for (int m = 32; m >= 1; m >>= 1) v += __shfl_xor(v, m, 64);
    return v;
}
__device__ __forceinline__ float wave_max(float v) {
#pragma unroll
    for (int m = 32; m >= 1; m >>= 1) v = fmaxf(v, __shfl_xor(v, m, 64));
    return v;
}
template <int CTRL> __device__ __forceinline__ float dpp_f(float x) { return __int_as_float(__builtin_amdgcn_update_dpp(0, __float_as_int(x), CTRL, 0xf, 0xf, false)); }
__device__ __forceinline__ float quad_sum(float x) { x += dpp_f<0xB1>(x); x += dpp_f<0x4E>(x); return x; }
__device__ __forceinline__ f32x4 mfma16(bf16x8 a, bf16x8 b, f32x4 c) { return __builtin_amdgcn_mfma_f32_16x16x32_bf16(a, b, c, 0, 0, 0); }
__device__ __forceinline__ f32x16 mfma32(bf16x8 a, bf16x8 b, f32x16 c) { return __builtin_amdgcn_mfma_f32_32x32x16_bf16(a, b, c, 0, 0, 0); }
#define XB_TMO      128
#define XB_XCNT(j)  (256  + 64 * (j))
#define XB_XSUB(j)  (1280 + 64 * (j))
#define XB_XGEN(j)  (2304 + 64 * (j))
#define XB_TOP      3328
#define XB_TOPGEN   3392
#define XCD_BAR_WORDS 3456
#define XB_SPIN_CAP (1u << 18)

__device__ __forceinline__ unsigned xb_ld(unsigned* p)              { return __hip_atomic_load(p, __ATOMIC_RELAXED, __HIP_MEMORY_SCOPE_AGENT); }
__device__ __forceinline__ unsigned xb_add(unsigned* p, unsigned v) { return __hip_atomic_fetch_add(p, v, __ATOMIC_RELAXED, __HIP_MEMORY_SCOPE_AGENT); }
__device__ __forceinline__ unsigned xb_xcc_id() { return (unsigned)__builtin_amdgcn_s_getreg((3 << 11) | 20) & 0xFu; }
#define XB_SPIN(cond, bar) do { unsigned _sp = 0; while (cond) { __builtin_amdgcn_s_sleep(1); \
    if ((++_sp & 255u) == 0u) { if (xb_ld(&(bar)[XB_TMO])) break; if (_sp > XB_SPIN_CAP) { atomicAdd(&(bar)[XB_TMO], 1u); break; } } } } while (0)

struct XcdBarrier {
    unsigned* bar; unsigned x;
    volatile LAS unsigned* st;
};
__device__ __forceinline__ XcdBarrier xcd_barrier_post(unsigned* bar, volatile LAS unsigned* st) {
    XcdBarrier b; b.bar = bar; b.x = xb_xcc_id(); b.st = st;
    if (threadIdx.x == 0) (void)xb_add(&bar[XB_XCNT(b.x)], 1u);
    return b;
}
__device__ __forceinline__ void xcd_barrier_complete(unsigned* bar, unsigned x, unsigned& nloc, unsigned& nx) {
    const unsigned G = gridDim.x * gridDim.y * gridDim.z;
    unsigned sum, cnt, mine, sp = 0u;
    for (;;) {
        sum = 0u; cnt = 0u; mine = 0u;
#pragma unroll
        for (unsigned j = 0; j < 16; ++j) { const unsigned c = xb_ld(&bar[XB_XCNT(j)]); sum += c; cnt += (c > 0u) ? 1u : 0u; mine = (j == x) ? c : mine; }
        if (sum == G) break;
        __builtin_amdgcn_s_sleep(1);
        if ((++sp & 255u) == 0u) { if (xb_ld(&bar[XB_TMO])) break; if (sp > XB_SPIN_CAP) { atomicAdd(&bar[XB_TMO], 1u); break; } }
    }
    nloc = mine > 0u ? mine : 1u; nx = cnt > 0u ? cnt : 1u;
}
__device__ __forceinline__ void xcd_barrier(const XcdBarrier& b) {
    asm volatile("s_waitcnt vmcnt(0)" ::: "memory");
    __syncthreads();
    if (threadIdx.x == 0) {
        unsigned* bar = b.bar;
        __builtin_amdgcn_s_waitcnt(0);
        unsigned nloc = b.st[0], nx = b.st[1];
        if (nloc == 0u) { xcd_barrier_complete(bar, b.x, nloc, nx); b.st[0] = nloc; b.st[1] = nx; }
        const unsigned old = xb_add(&bar[XB_XSUB(b.x)], 1u);
        const unsigned gen = old / nloc;
        if (old + 1u == (gen + 1u) * nloc) {
            __builtin_amdgcn_fence(__ATOMIC_RELEASE, "agent");
            asm volatile("s_waitcnt vmcnt(0)" ::: "memory");
            const unsigned og = xb_add(&bar[XB_TOP], 1u);
            const unsigned tg = og / nx;
            if (og + 1u == (tg + 1u) * nx) xb_add(&bar[XB_TOPGEN], 1u);
            else XB_SPIN(xb_ld(&bar[XB_TOPGEN]) == tg, bar);
            __builtin_amdgcn_fence(__ATOMIC_ACQUIRE, "agent");
            xb_add(&bar[XB_XGEN(b.x)], 1u);
            asm volatile("s_waitcnt vmcnt(0)" ::: "memory");
        } else {
            XB_SPIN(xb_ld(&bar[XB_XGEN(b.x)]) == gen, bar);
            __builtin_amdgcn_fence(__ATOMIC_ACQUIRE, "agent");
            asm volatile("s_waitcnt vmcnt(0)" ::: "memory");
        }
    }
    __syncthreads();
}

namespace pg8 {
constexpr int BM = 256, BK = 64, HALF = 128, HTB = HALF * BK * 2, STAGE_BYTES = 8 * HTB, NXCD = 8, WGM = 8;
__host__ __device__ __forceinline__ int lds_byte(int r, int c) { const int st = (r >> 4) * 2 + (c >> 5), rr = r & 15, cc = c & 31, ob = rr * 64 + cc * 2; return st * 1024 + (ob ^ (((ob >> 9) & 1) << 5)); }
__host__ __device__ __forceinline__ void stage_rc(int b, int& R, int& C) { const int st = b / 1024, sb = b % 1024, swz = sb ^ (((sb >> 9) & 1) << 5); R = (st >> 1) * 16 + swz / 64; C = (st & 1) * 32 + (swz % 64) / 2; }
__host__ __device__ __forceinline__ int perm32(int rho) { const int n = rho >> 4, i = rho & 15; return 8 * (i >> 2) + 4 * n + (i & 3); }

struct Unit { int pm, pn, z; };
struct StaticOrder {
    const bf16_t* A; const bf16_t* Bt; int lda, ldb, K;
    int nM, nN, nwg, G, c;
    __device__ void init(const bf16_t* A_, const bf16_t* Bt_, int lda_, int ldb_, int K_, int M, int N, int G_, int c_) { A = A_; Bt = Bt_; lda = lda_; ldb = ldb_; K = K_; nM = M / BM; nN = N / BM; nwg = nM * nN; G = G_; c = c_; }
    __device__ bool next(int i, Unit& u) const {
        const long Lx = (long)i * G + c; if (Lx >= nwg) return false;
        int wgid = (int)Lx; { const int q = nwg / NXCD, r = nwg % NXCD, xcd = wgid % NXCD, off = wgid / NXCD; wgid = (xcd < r ? xcd * (q + 1) : r * (q + 1) + (xcd - r) * q) + off; }
        const int nig = WGM * nN, gid = wgid / nig, fm = gid * WGM, gsz = (nM - fm) < WGM ? (nM - fm) : WGM;
        u.pm = fm + ((wgid % nig) % gsz); u.pn = (wgid % nig) / gsz; u.z = 0; return true;
    }
    __device__ __forceinline__ const char* a_base(const Unit& u) const { return (const char*)(A + (size_t)u.pm * BM * lda); }
    __device__ __forceinline__ const char* b_base(const Unit& u) const { return (const char*)(Bt + (size_t)u.pn * BM * ldb); }
};

template <class Epi, class Sched>
__device__ __forceinline__ void gemm_phase(LAS unsigned char* lds, const Sched& S, const Epi& E) {
    const int tid = threadIdx.x, wid = __builtin_amdgcn_readfirstlane(tid >> 6), lane = tid & 63, wr = wid >> 2, wc = wid & 3, fr = lane & 15, fq = lane >> 4;
    const int K = S.K, nt = K / BK, lda = S.lda, ldb = S.ldb;
    unsigned voffA[2], voffB[2];
#pragma unroll
    for (int i = 0; i < 2; ++i) { int R, C; stage_rc(tid * 16 + i * 8192, R, C); const int Rb = Epi::PERM ? ((R & ~31) + perm32(R & 31)) : R;
        voffA[i] = (unsigned)(R * lda + C) * 2u; voffB[i] = (unsigned)(Rb * ldb + C) * 2u; }
    const size_t kstep = (size_t)(BK * 2);
    const size_t hstepA = (size_t)HALF * lda * 2, hstepB = (size_t)HALF * ldb * 2;
    const unsigned ldsw = (unsigned)wid * 1024u;
    const int aoff = lds_byte(wr * 64 + fr, fq * 8), boff = lds_byte(wc * 32 + fr, fq * 8);
#define PG8_SA(b, h) (((b) * 2 + (h)) * HTB)
#define PG8_SB(b, h) ((4 + (b) * 2 + (h)) * HTB)
#define PG8_STAGE(bufoff, gbase, voff) do { _Pragma("unroll") for (int _i = 0; _i < 2; ++_i) \
        __builtin_amdgcn_global_load_lds((const unsigned*)((const char*)(gbase) + (voff)[_i]), (LAS unsigned*)(lds + (bufoff) + ldsw + _i * 8192), 16, 0, 0); } while (0)
#define PG8_LDA(dst, b, h) do { _Pragma("unroll") for (int m = 0; m < 4; ++m) _Pragma("unroll") for (int k = 0; k < 2; ++k) dst[m][k] = *(const LAS bf16x8*)(lds + PG8_SA(b, h) + aoff + m * 2048 + k * 1024); } while (0)
#define PG8_LDB(dst, b, h) do { _Pragma("unroll") for (int n = 0; n < 2; ++n) _Pragma("unroll") for (int k = 0; k < 2; ++k) dst[n][k] = *(const LAS bf16x8*)(lds + PG8_SB(b, h) + boff + n * 2048 + k * 1024); } while (0)
#define PG8_MMA(ai, bj, At, Bt) do { __builtin_amdgcn_s_setprio(1); _Pragma("unroll") for (int m = 0; m < 4; ++m) _Pragma("unroll") for (int n = 0; n < 2; ++n) _Pragma("unroll") for (int k = 0; k < 2; ++k) \
        acc[ai][bj][m][n] = __builtin_amdgcn_mfma_f32_16x16x32_bf16(Bt[n][k], At[m][k], acc[ai][bj][m][n], 0, 0, 0); __builtin_amdgcn_s_setprio(0); } while (0)
#define PG8_WAIT_V(n) asm volatile("s_waitcnt vmcnt(" #n ")" ::: "memory")
#define PG8_WAIT_L(n) asm volatile("s_waitcnt lgkmcnt(" #n ")" ::: "memory")
#define PG8_BAR __builtin_amdgcn_s_barrier()
#define PG8_SCHED __builtin_amdgcn_sched_barrier(0)
    Unit cur, nxt; int ui = 0;
    if (!S.next(0, cur)) return;
    f32x4 acc[2][2][4][2];
#pragma unroll
    for (int a = 0; a < 2; ++a)
#pragma unroll
        for (int b = 0; b < 2; ++b)
#pragma unroll
            for (int m = 0; m < 4; ++m)
#pragma unroll
                for (int n = 0; n < 2; ++n) acc[a][b][m][n] = (f32x4){0.f, 0.f, 0.f, 0.f};
    bf16x8 At[4][2], B0[2][2], B1[2][2];
    const char* cA = S.a_base(cur); const char* cB = S.b_base(cur);
    PG8_STAGE(PG8_SB(0, 0), cB, voffB); PG8_STAGE(PG8_SA(0, 0), cA, voffA); PG8_STAGE(PG8_SB(0, 1), cB + hstepB, voffB); PG8_STAGE(PG8_SA(0, 1), cA + hstepA, voffA);
    if (wr == 1) PG8_BAR;
    PG8_WAIT_V(4); PG8_BAR;
    PG8_STAGE(PG8_SB(1, 0), cB + kstep, voffB); PG8_STAGE(PG8_SA(1, 0), cA + kstep, voffA); PG8_STAGE(PG8_SB(1, 1), cB + hstepB + kstep, voffB);
    PG8_WAIT_V(6); PG8_BAR;
    for (;;) {
        const bool has_next = S.next(ui + 1, nxt);
        const char* nA = has_next ? S.a_base(nxt) : cA; const char* nB = has_next ? S.b_base(nxt) : cB;
        for (int t = 0; t < nt; t += 2) {
            const bool last = (t == nt - 2);
            const char* a1 = cA + (size_t)(t + 1) * kstep;
            const char* a2 = last ? nA : cA + (size_t)(t + 2) * kstep; const char* b2 = last ? nB : cB + (size_t)(t + 2) * kstep;
            const char* a3 = a2 + kstep; const char* b3 = b2 + kstep;
            PG8_LDB(B0, 0, 0); PG8_SCHED; PG8_LDA(At, 0, 0); PG8_STAGE(PG8_SA(1, 1), a1 + hstepA, voffA);
            PG8_WAIT_L(8); PG8_BAR; PG8_WAIT_L(0); PG8_MMA(0, 0, At, B0); PG8_BAR; PG8_SCHED;
            PG8_LDB(B1, 0, 1); PG8_STAGE(PG8_SB(0, 0), b2, voffB);
            PG8_BAR; PG8_WAIT_L(0); PG8_MMA(0, 1, At, B1); PG8_BAR;
            PG8_LDA(At, 0, 1); PG8_STAGE(PG8_SA(0, 0), a2, voffA);
            PG8_BAR; PG8_WAIT_L(0); PG8_MMA(1, 0, At, B0); PG8_BAR; PG8_SCHED;
            PG8_STAGE(PG8_SB(0, 1), b2 + hstepB, voffB);
            PG8_WAIT_V(6); PG8_BAR; PG8_MMA(1, 1, At, B1); PG8_BAR;
            PG8_LDB(B0, 1, 0); PG8_SCHED; PG8_LDA(At, 1, 0); PG8_STAGE(PG8_SA(0, 1), a2 + hstepA, voffA);
            PG8_WAIT_L(8); PG8_BAR; PG8_WAIT_L(0); PG8_MMA(0, 0, At, B0); PG8_BAR; PG8_SCHED;
            PG8_LDB(B1, 1, 1); PG8_STAGE(PG8_SB(1, 0), b3, voffB);
            PG8_BAR; PG8_WAIT_L(0); PG8_MMA(0, 1, At, B1); PG8_BAR;
            PG8_LDA(At, 1, 1); PG8_STAGE(PG8_SA(1, 0), a3, voffA);
            PG8_BAR; PG8_WAIT_L(0); PG8_MMA(1, 0, At, B0); PG8_BAR; PG8_SCHED;
            PG8_STAGE(PG8_SB(1, 1), b3 + hstepB, voffB);
            PG8_WAIT_V(6); PG8_BAR; PG8_MMA(1, 1, At, B1); PG8_BAR;
        }
        E(acc, cur, wr, wc, fr, fq);
        if (!has_next) break;
#pragma unroll
        for (int a = 0; a < 2; ++a)
#pragma unroll
            for (int b = 0; b < 2; ++b)
#pragma unroll
                for (int m = 0; m < 4; ++m)
#pragma unroll
                    for (int n = 0; n < 2; ++n) acc[a][b][m][n] = (f32x4){0.f, 0.f, 0.f, 0.f};
        cur = nxt; cA = nA; cB = nB; ++ui;
    }
    PG8_WAIT_V(0);
    if (wr == 0) PG8_BAR;
    PG8_BAR;
#undef PG8_SA
#undef PG8_SB
#undef PG8_STAGE
#undef PG8_LDA
#undef PG8_LDB
#undef PG8_MMA
#undef PG8_WAIT_V
#undef PG8_WAIT_L
#undef PG8_BAR
#undef PG8_SCHED
}
}
using pg8::Unit;
__device__ __forceinline__ u32x4 pack8(const f32x4& v0, const f32x4& v1) {
    u32x4 o; o[0] = cvt_pk_bf16(v0[0], v0[1]); o[1] = cvt_pk_bf16(v0[2], v0[3]); o[2] = cvt_pk_bf16(v1[0], v1[1]); o[3] = cvt_pk_bf16(v1[2], v1[3]); return o;
}
struct EpiWin {
    static constexpr bool PERM = true;
    bf16_t* US; bf16_t* Q; bf16_t* KROW; bf16_t* VROW; bf16_t* VT; float* GATE;
    __device__ __forceinline__ void operator()(const f32x4 (&acc)[2][2][4][2], const Unit& u, int wr, int wc, int fr, int fq) const {
        const int row0 = u.pm * 256 + wr * 64 + fr; const int pn = u.pn;
#pragma unroll
        for (int ai = 0; ai < 2; ++ai)
#pragma unroll
            for (int m = 0; m < 4; ++m) {
                const int row = row0 + ai * 128 + m * 16;
#pragma unroll
                for (int bj = 0; bj < 2; ++bj) {
                    const f32x4 v0 = acc[ai][bj][m][0], v1 = acc[ai][bj][m][1];
                    const int cin = bj * 128 + wc * 32 + 8 * fq;
                    if (pn < 4) { *(u32x4*)(US + (size_t)row * 1024 + pn * 256 + cin) = pack8(v0, v1); }
                    else if (pn < 8) { *(u32x4*)(Q + (size_t)row * 1024 + (pn - 4) * 256 + cin) = pack8(v0 * QSCALE, v1 * QSCALE); }
                    else if (pn < 14) {
                        const int kvi = pn - 8, branch = kvi >> 1, kvsel = kvi & 1, g = bj, d0 = wc * 32 + 8 * fq;
                        if (kvsel == 0) { *(u32x4*)(KROW + ((size_t)(branch * 2 + g) * L_ + row) * 128 + d0) = pack8(v0, v1); }
                        else if (branch == 0) { *(u32x4*)(VROW + ((size_t)g * L_ + row) * 128 + d0) = pack8(v0, v1); }
                        else {
                            bf16_t* vt = VT + ((size_t)((branch - 1) * 2 + g) * 128 + d0) * L_ + row;
#pragma unroll
                            for (int e = 0; e < 4; ++e) { vt[(size_t)e * L_] = f2bf(v0[e]); vt[(size_t)(e + 4) * L_] = f2bf(v1[e]); }
                        }
                    } else {
                        if (cin < 24) {
                            float* gp = GATE + (size_t)row * 24 + cin;
                            f32x4 s0, s1;
#pragma unroll
                            for (int e = 0; e < 4; ++e) { s0[e] = sigmoidf_(v0[e]); s1[e] = sigmoidf_(v1[e]); }
                            *(f32x4*)gp = s0; *(f32x4*)(gp + 4) = s1;
                        }
                    }
                }
            }
    }
};
struct EpiGlu {
    static constexpr bool PERM = true;
    const bf16_t* Z; const float* bglu; bf16_t* Y;
    __device__ __forceinline__ void operator()(const f32x4 (&acc)[2][2][4][2], const Unit& u, int wr, int wc, int fr, int fq) const {
        const int row0 = u.pm * 256 + wr * 64 + fr;
#pragma unroll
        for (int bj = 0; bj < 2; ++bj) {
            const int col = u.pn * 256 + bj * 128 + wc * 32 + 8 * fq;
            const f32x4 b0 = *(const f32x4*)(bglu + col), b1 = *(const f32x4*)(bglu + col + 4);
#pragma unroll
            for (int ai = 0; ai < 2; ++ai)
#pragma unroll
                for (int m = 0; m < 4; ++m) {
                    const int row = row0 + ai * 128 + m * 16;
                    const u32x4 zz = *(const u32x4*)(Z + (size_t)row * 1024 + col);
                    const f32x4 v0 = acc[ai][bj][m][0] + b0, v1 = acc[ai][bj][m][1] + b1;
                    f32x4 o0, o1;
                    o0[0] = bflo(zz[0]) * sigmoidf_(v0[0]); o0[1] = bfhi(zz[0]) * sigmoidf_(v0[1]); o0[2] = bflo(zz[1]) * sigmoidf_(v0[2]); o0[3] = bfhi(zz[1]) * sigmoidf_(v0[3]);
                    o1[0] = bflo(zz[2]) * sigmoidf_(v1[0]); o1[1] = bfhi(zz[2]) * sigmoidf_(v1[1]); o1[2] = bflo(zz[3]) * sigmoidf_(v1[2]); o1[3] = bfhi(zz[3]) * sigmoidf_(v1[3]);
                    *(u32x4*)(Y + (size_t)row * 1024 + col) = pack8(o0, o1);
                }
        }
    }
};
struct EpiWout {
    static constexpr bool PERM = false;
    const float* X; const float* g1; float* X1;
    __device__ __forceinline__ void operator()(const f32x4 (&acc)[2][2][4][2], const Unit& u, int wr, int wc, int fr, int fq) const {
        const int row0 = u.pm * 256 + wr * 64 + fr, col0 = u.pn * 256 + wc * 32 + 4 * fq;
#pragma unroll
        for (int bj = 0; bj < 2; ++bj)
#pragma unroll
            for (int n = 0; n < 2; ++n) {
                const int col = col0 + bj * 128 + n * 16;
                const f32x4 gv = *(const f32x4*)(g1 + col);
#pragma unroll
                for (int ai = 0; ai < 2; ++ai)
#pragma unroll
                    for (int m = 0; m < 4; ++m) {
                        const size_t off = (size_t)(row0 + ai * 128 + m * 16) * 2048 + col;
                        *(f32x4*)(X1 + off) = *(const f32x4*)(X + off) + gv * acc[ai][bj][m][n];
                    }
            }
    }
};
struct EpiBf16 {
    static constexpr bool PERM = true;
    bf16_t* O; int ldc;
    __device__ __forceinline__ void operator()(const f32x4 (&acc)[2][2][4][2], const Unit& u, int wr, int wc, int fr, int fq) const {
        const int row0 = u.pm * 256 + wr * 64 + fr, col0 = u.pn * 256 + wc * 32 + 8 * fq;
#pragma unroll
        for (int ai = 0; ai < 2; ++ai)
#pragma unroll
            for (int m = 0; m < 4; ++m)
#pragma unroll
                for (int bj = 0; bj < 2; ++bj)
                    *(u32x4*)(O + (size_t)(row0 + ai * 128 + m * 16) * ldc + col0 + bj * 128) = pack8(acc[ai][bj][m][0], acc[ai][bj][m][1]);
    }
};
struct EpiSlab {
    static constexpr bool PERM = false;
    float* SL;
    __device__ __forceinline__ void operator()(const f32x4 (&acc)[2][2][4][2], const Unit& u, int wr, int wc, int fr, int fq) const {
        float* base = SL + (size_t)u.z * 2048 * 256;
        const int row0 = u.pm * 256 + wr * 64 + fr, col0 = wc * 32 + 4 * fq;
#pragma unroll
        for (int ai = 0; ai < 2; ++ai)
#pragma unroll
            for (int m = 0; m < 4; ++m)
#pragma unroll
                for (int bj = 0; bj < 2; ++bj)
#pragma unroll
                    for (int n = 0; n < 2; ++n)
                        *(f32x4*)(base + (size_t)(row0 + ai * 128 + m * 16) * 256 + col0 + bj * 128 + n * 16) = acc[ai][bj][m][n];
    }
};
struct CmpOrder {
    const bf16_t* KROW; const bf16_t* VROW; const bf16_t* W1; int lda, ldb, K; int G, c;
    __device__ bool next(int i, Unit& u) const {
        const int x = i * G + c; if (x >= 64) return false;
        const int kvsel = x >> 5, pm = (x & 31) >> 2, ks = x & 3; u.pm = pm; u.pn = 0; u.z = kvsel * 4 + ks; return true;
    }
    __device__ __forceinline__ const char* a_base(const Unit& u) const { return (const char*)(((u.z >> 2) ? VROW : KROW) + (size_t)u.pm * 256 * 2048 + (u.z & 3) * 1024); }
    __device__ __forceinline__ const char* b_base(const Unit& u) const { return (const char*)(W1 + (size_t)(u.z >> 2) * 256 * 4096 + (u.z & 3) * 1024); }
};
struct Ctx { int bid, nb, tid, wave, lane; LAS unsigned char* lds; };

__device__ __forceinline__ void p0_cond(const Args& a, const Ctx& c) {
    const float* cv = a.in[1]; const float* w = a.in[2]; float* condp = (float*)(a.ws + WS_CONDP);
    for (int u = c.bid * 8 + c.wave; u < 1536; u += c.nb * 8) {
        const int cc = u % 48, kc = u / 48;
        const float* wp = w + (size_t)(kc * 64) * NADA + cc * 256 + c.lane * 4;
        f32x4 acc = {0.f, 0.f, 0.f, 0.f};
#pragma unroll 16
        for (int k = 0; k < 64; ++k) { const float x = cv[kc * 64 + k]; const float s = x / (1.f + __expf(-x)); acc += s * *(const f32x4*)(wp + (size_t)k * NADA); }
        *(f32x4*)(condp + (size_t)kc * NADA + cc * 256 + c.lane * 4) = acc;
    }
}
__device__ __forceinline__ void conv_T(const float* src, int K, int N, bf16_t* dst, int Npad, const Ctx& c) {
    LAS float* tile = (LAS float*)c.lds;
    const int nkt = K / 64, ntiles = nkt * (Npad / 64);
    const int r = c.tid >> 4, c4 = c.tid & 15;
    f32x4 v[2];
#define CONVT_LD(tix_) do { const int nt_ = (tix_) / nkt, kt_ = (tix_) % nkt, n_ = nt_ * 64 + 4 * c4; _Pragma("unroll") for (int i = 0; i < 2; ++i) { const int k_ = kt_ * 64 + r + 32 * i; v[i] = (f32x4){0.f, 0.f, 0.f, 0.f}; if (n_ < N) v[i] = *(const f32x4*)(src + (size_t)k_ * N + n_); } } while (0)
    if (c.bid < ntiles) CONVT_LD(c.bid);
    for (int tix = c.bid; tix < ntiles; tix += c.nb) {
        const int nt = tix / nkt, kt = tix % nkt;
#pragma unroll
        for (int i = 0; i < 2; ++i) { LAS float* tp = tile + (r + 32 * i) * 65 + 4 * c4; tp[0] = v[i][0]; tp[1] = v[i][1]; tp[2] = v[i][2]; tp[3] = v[i][3]; }
        __syncthreads();
        if (tix + c.nb < ntiles) CONVT_LD(tix + c.nb);
        { const int n = c.tid >> 3, kq = c.tid & 7; float w[8];
#pragma unroll
          for (int j = 0; j < 8; ++j) w[j] = tile[(kq * 8 + j) * 65 + n];
          u32x4 o; o[0] = cvt_pk_bf16(w[0], w[1]); o[1] = cvt_pk_bf16(w[2], w[3]); o[2] = cvt_pk_bf16(w[4], w[5]); o[3] = cvt_pk_bf16(w[6], w[7]);
          *(u32x4*)(dst + (size_t)(nt * 64 + n) * K + kt * 64 + kq * 8) = o; }
        __syncthreads();
    }
#undef CONVT_LD
}
__device__ __forceinline__ void conv_fp6rows(const float* src, unsigned char* dst6, float* scl, int rows, const Ctx& c) {
    for (int row = c.bid * 8 + c.wave; row < rows; row += c.nb * 8) {
        const float* sp = src + (size_t)row * 2048 + c.lane * 32;
        f32x4 v[8]; float mx = 0.f;
#pragma unroll
        for (int j = 0; j < 8; ++j) { v[j] = *(const f32x4*)(sp + j * 4); mx = fmaxf(mx, fmaxf(fmaxf(fabsf(v[j][0]), fabsf(v[j][1])), fmaxf(fabsf(v[j][2]), fabsf(v[j][3])))); }
        mx = wave_max(mx);
        const float s = mx > 0.f ? 7.5f / mx : 1.f;
        if (c.lane == 0) scl[row] = mx > 0.f ? mx * (1.f / 7.5f) : 1.f;
        f32x16 x, y;
#pragma unroll
        for (int j = 0; j < 4; ++j)
#pragma unroll
            for (int e = 0; e < 4; ++e) { const int i = j * 4 + e;
                x[i] = v[(2 * i) >> 2][(2 * i) & 3] * s; y[i] = v[(2 * i + 1) >> 2][(2 * i + 1) & 3] * s; }
        const u32x6 pk = __builtin_amdgcn_cvt_scalef32_2xpk16_fp6_f32(x, y, 1.0f);
        unsigned char* dp = dst6 + (size_t)row * 1536 + c.lane * 24;
        *(u32x2*)dp = (u32x2){pk[0], pk[1]}; *(u32x2*)(dp + 8) = (u32x2){pk[2], pk[3]}; *(u32x2*)(dp + 16) = (u32x2){pk[4], pk[5]};
    }
}
__device__ __forceinline__ void conv_E(const float* src, bf16_t* dst, size_t n8, const Ctx& c) {
    const size_t stride = (size_t)c.nb * NTHREADS;
    for (size_t i = (size_t)c.bid * NTHREADS + c.tid; i < n8; i += stride) {
        const f32x4 x = *(const f32x4*)(src + i * 8), y = *(const f32x4*)(src + i * 8 + 4);
        *(u32x4*)(dst + i * 8) = pack8(x, y);
    }
}
__device__ __forceinline__ int t5_bucket(int n) {
    if (n < 16) return n;
    const float scaled = logf((float)n / 16.f) / logf(64.f);
    const int large = 16 + (int)(scaled * 16.f);
    return large < 31 ? large : 31;
}
__device__ __forceinline__ void p0_tb(const Args& a, const Ctx& c) {
    float* tb = (float*)(a.ws + WS_TB); const float* rb = a.in[26];
    for (int i = c.bid * NTHREADS + c.tid; i < 8 * TBN; i += c.nb * NTHREADS) { const int head = i / TBN, dist = i % TBN; tb[i] = rb[t5_bucket(dist) * 8 + head] * LOG2E; }
}
__device__ __forceinline__ void p0_bpe(const Args& a, const Ctx& c, int part) {
    const int n = c.tid & 255, kv = c.tid >> 8;
    const float* pe = a.in[kv ? 23 : 20]; const float* w1 = a.in[kv ? 24 : 21]; float* bpep = (float*)(a.ws + WS_BPEP);
    float s = 0.f;
#pragma unroll 16
    for (int k = part * 128; k < part * 128 + 128; ++k) s += pe[k] * w1[(size_t)k * 256 + n];
    bpep[(part * 2 + kv) * 256 + n] = s;
}
__device__ __forceinline__ void p0_s5(const Args& a, const Ctx& c, int g) {
    LAS float* ar = (LAS float*)c.lds;
    LAS float* ai = ar + 17 * 64;
    LAS float* bbr = ai + 17 * 64;
    LAS float* bbi = bbr + 1024;
    LAS float* cr = bbi + 1024;
    LAS float* ci = cr + 1024;
    LAS float* kd = ci + 1024;
    const int tid = c.tid;
    if (tid < 64) {
        const int p = tid; const float dt = expf(a.in[12][g]); const float lr = a.in[10][g * 64 + p], li = a.in[11][g * 64 + p];
        for (int d = 0; d <= 16; ++d) { const float mag = expf(lr * dt * (float)d), ang = li * dt * (float)d; ar[d * 64 + p] = mag * cosf(ang); ai[d * 64 + p] = mag * sinf(ang); }
        const float nr = ar[64 + p] - 1.f, ni = ai[64 + p], den = lr * lr + li * li;
        const float wre = (nr * lr + ni * li) / den, wim = (ni * lr - nr * li) / den;
        for (int h = 0; h < 16; ++h) { const float br = a.in[13][(g * 64 + p) * 16 + h], bi = a.in[14][(g * 64 + p) * 16 + h]; bbr[p * 16 + h] = wre * br - wim * bi; bbi[p * 16 + h] = wre * bi + wim * br; }
        float* s5p = (float*)(a.ws + WS_S5P);
        float xr = ar[16 * 64 + p], xi = ai[16 * 64 + p];
        s5p[(g * 64 + p) * 2] = xr; s5p[(g * 64 + p) * 2 + 1] = xi;
        for (int s = 0; s < 8; ++s) { const float tr = xr * xr - xi * xi, ti = 2.f * xr * xi; xr = tr; xi = ti; }
        s5p[64 * 64 * 2 + (g * 64 + p) * 2] = xr; s5p[64 * 64 * 2 + (g * 64 + p) * 2 + 1] = xi;
    }
    for (int e = tid; e < 1024; e += NTHREADS) { cr[e] = a.in[15][g * 1024 + e]; ci[e] = a.in[16][g * 1024 + e]; }
    __syncthreads();
    for (int e = tid; e < 4096; e += NTHREADS) {
        const int d = e >> 8, h1 = (e >> 4) & 15, h = e & 15; float s = 0.f;
        for (int p = 0; p < 64; ++p) { const float Cr = cr[h1 * 64 + p], Ci = ci[h1 * 64 + p], Ar = ar[d * 64 + p], Ai = ai[d * 64 + p];
            const float Gr = Cr * Ar - Ci * Ai, Gi = Cr * Ai + Ci * Ar; s += Gr * bbr[p * 16 + h] - Gi * bbi[p * 16 + h]; }
        if (d == 0 && h1 == h) s += a.in[17][g * 16 + h];
        kd[e] = s;
    }
    __syncthreads();
    bf16_t* MT = (bf16_t*)(a.ws + WS_S5MT) + (size_t)g * 65536;
    bf16_t* WE = (bf16_t*)(a.ws + WS_S5WE) + (size_t)g * 32768;
    bf16_t* WC = (bf16_t*)(a.ws + WS_S5WC) + (size_t)g * 32768;
    for (int e = tid; e < 65536; e += NTHREADS) { const int n = e >> 8, k = e & 255, j = n >> 4, h1 = n & 15, i = k >> 4, h = k & 15;
        MT[e] = f2bf(i <= j ? kd[(j - i) * 256 + h1 * 16 + h] : 0.f); }
    for (int e = tid; e < 32768; e += NTHREADS) { const int n = e >> 8, k = e & 255, cc = n >> 6, p = n & 63, i = k >> 4, h = k & 15;
        const float Ar = ar[(15 - i) * 64 + p], Ai = ai[(15 - i) * 64 + p], Br = bbr[p * 16 + h], Bi = bbi[p * 16 + h];
        WE[e] = f2bf(cc ? (Ar * Bi + Ai * Br) : (Ar * Br - Ai * Bi)); }
    for (int e = tid; e < 32768; e += NTHREADS) { const int n = e >> 7, k = e & 127, j = n >> 4, h1 = n & 15, cc = k >> 6, p = k & 63;
        const float Cr = cr[h1 * 64 + p], Ci = ci[h1 * 64 + p], Ar = ar[(j + 1) * 64 + p], Ai = ai[(j + 1) * 64 + p];
        WC[e] = f2bf(cc ? -(Cr * Ai + Ci * Ar) : (Cr * Ar - Ci * Ai)); }
    __syncthreads();
}
__device__ __forceinline__ void p0_prologue(const Args& a, const Ctx& c) {
    for (int g = c.bid; g < 64; g += c.nb) p0_s5(a, c, g);
    for (int u = 0; u < 32; ++u) if (c.bid == (64 + u) % c.nb) p0_bpe(a, c, u);
    p0_tb(a, c);
    p0_cond(a, c);
    conv_T(a.in[6], 2048, DIN, (bf16_t*)(a.ws + WS_WIN), DIN_PAD, c);
    conv_T(a.in[18], 1024, 1024, (bf16_t*)(a.ws + WS_WGLU), 1024, c);
    conv_T(a.in[7], 2048, 2048, (bf16_t*)(a.ws + WS_WOUT), 2048, c);
    conv_T(a.in[27], 2048, 2048, (bf16_t*)(a.ws + WS_WQ), 2048, c);
    conv_T(a.in[21], 4096, 256, (bf16_t*)(a.ws + WS_W1), 256, c);
    conv_T(a.in[24], 4096, 256, (bf16_t*)(a.ws + WS_W1) + 256 * 4096, 256, c);
    conv_T(a.in[22], 256, 128, (bf16_t*)(a.ws + WS_W2), 128, c);
    conv_T(a.in[25], 256, 128, (bf16_t*)(a.ws + WS_W2) + 128 * 256, 128, c);
    conv_E(a.in[28], (bf16_t*)(a.ws + WS_PK), 128 * 128 / 8, c);
    conv_E(a.in[29], (bf16_t*)(a.ws + WS_PK) + 128 * 128, 128 * 128 / 8, c);
    conv_fp6rows(a.in[30], a.ws + WS_PU, (float*)(a.ws + WS_PSC), 16384, c);
    conv_fp6rows(a.in[31], a.ws + WS_PV, (float*)(a.ws + WS_PSC) + 16384, 16384, c);
}

__device__ __forceinline__ void norm_rows(const float* X, bf16_t* O, LAS const float* Ab, LAS const float* Bb, const Ctx& c) {
    for (int t = c.bid * 8 + c.wave; t < L_; t += c.nb * 8) {
        const float* xr = X + (size_t)t * 2048 + c.lane * 4;
        f32x4 v[8]; float ss = 0.f;
#pragma unroll
        for (int j = 0; j < 8; ++j) { v[j] = *(const f32x4*)(xr + j * 256); ss += v[j][0] * v[j][0] + v[j][1] * v[j][1] + v[j][2] * v[j][2] + v[j][3] * v[j][3]; }
        ss = wave_sum(ss);
        const float rstd = rsqrtf(ss * (1.f / 2048.f) + 1e-6f);
#pragma unroll
        for (int j = 0; j < 8; ++j) {
            const int col = j * 256 + c.lane * 4;
            const f32x4 A = *(const LAS f32x4*)(Ab + col), B = *(const LAS f32x4*)(Bb + col);
            const f32x4 o = v[j] * rstd * A + B;
            u32x2 w; w[0] = cvt_pk_bf16(o[0], o[1]); w[1] = cvt_pk_bf16(o[2], o[3]);
            *(u32x2*)(O + (size_t)t * 2048 + col) = w;
        }
    }
}
__device__ __forceinline__ float cond_from_partials(const float* condp, const float* b_ada, int j) {
    float s = b_ada[j];
#pragma unroll 8
    for (int k = 0; k < 32; ++k) s += condp[(size_t)k * NADA + j];
    return s;
}
__device__ __forceinline__ void p1_hnorm(const Args& a, const Ctx& c) {
    const float* condp = (const float*)(a.ws + WS_CONDP); float* cond = (float*)(a.ws + WS_COND);
    for (int j = c.bid * NTHREADS + c.tid; j < NADA; j += c.nb * NTHREADS) cond[j] = cond_from_partials(condp, a.in[3], j);
    LAS float* Ab = (LAS float*)c.lds; LAS float* Bb = Ab + 2048;
    for (int col = c.tid; col < 2048; col += NTHREADS) {
        Ab[col] = a.in[4][col] * (1.f + cond_from_partials(condp, a.in[3], 2048 + col)); Bb[col] = cond_from_partials(condp, a.in[3], col); }
    __syncthreads();
    norm_rows(a.in[0], (bf16_t*)(a.ws + WS_H), Ab, Bb, c);
}
__device__ __forceinline__ void p8_h2norm(const Args& a, const Ctx& c) {
    const float* cond = (const float*)(a.ws + WS_COND);
    LAS float* Ab = (LAS float*)c.lds; LAS float* Bb = Ab + 2048;
    for (int col = c.tid; col < 2048; col += NTHREADS) { Ab[col] = a.in[5][col] * (1.f + cond[4 * 2048 + col]); Bb[col] = cond[3 * 2048 + col]; }
    __syncthreads();
    norm_rows(a.out, (bf16_t*)(a.ws + WS_H), Ab, Bb, c);
}
__device__ __forceinline__ void p6_mixnorm(const Args& a, const Ctx& c) {
    const bf16_t* YS = (const bf16_t*)(a.ws + WS_YSSM); const bf16_t* YA = (const bf16_t*)(a.ws + WS_YATT); bf16_t* O = (bf16_t*)(a.ws + WS_H);
    for (int t = c.bid * 8 + c.wave; t < L_; t += c.nb * 8) {
#pragma unroll
        for (int part = 0; part < 2; ++part) {
            const bf16_t* src = (part ? YA : YS) + (size_t)t * 1024 + c.lane * 8; const float* beta = a.in[part ? 9 : 8];
            u32x4 w[2]; float f[16]; float ss = 0.f;
#pragma unroll
            for (int j = 0; j < 2; ++j) { w[j] = *(const u32x4*)(src + j * 512);
#pragma unroll
                for (int e = 0; e < 4; ++e) { f[j * 8 + 2 * e] = bflo(w[j][e]); f[j * 8 + 2 * e + 1] = bfhi(w[j][e]); } }
#pragma unroll
            for (int e = 0; e < 16; ++e) ss += f[e] * f[e];
            ss = wave_sum(ss);
            const float rstd = rsqrtf(ss * (1.f / 1024.f) + 1e-6f);
#pragma unroll
            for (int j = 0; j < 2; ++j) { const int col = j * 512 + c.lane * 8; const f32x4 b0 = *(const f32x4*)(beta + col), b1 = *(const f32x4*)(beta + col + 4);
                f32x4 o0, o1;
#pragma unroll
                for (int e = 0; e < 4; ++e) { o0[e] = f[j * 8 + e] * rstd * b0[e]; o1[e] = f[j * 8 + 4 + e] * rstd * b1[e]; }
                *(u32x4*)(O + (size_t)t * 2048 + part * 1024 + col) = pack8(o0, o1); }
        }
    }
}
constexpr int S5_US = 0, S5_ES = 33792, S5_SS = 67584;
template <int PASS>
__device__ __forceinline__ void s5_item(const Args& a, const Ctx& c, int g, int seg) {
    LAS unsigned char* lds = c.lds;
    const int tid = c.tid, wave = c.wave, lane = c.lane, r = lane & 15, q = lane >> 4;
    const bf16_t* U = (const bf16_t*)(a.ws + WS_US);
    const bf16_t* MT = (const bf16_t*)(a.ws + WS_S5MT) + (size_t)g * 65536;
    const bf16_t* WE = (const bf16_t*)(a.ws + WS_S5WE) + (size_t)g * 32768;
    const bf16_t* WC = (const bf16_t*)(a.ws + WS_S5WC) + (size_t)g * 32768;
    const float* s5p = (const float*)(a.ws + WS_S5P);
    float* F = (float*)(a.ws + WS_S5F) + (size_t)g * 4 * 128;
    bf16_t* Z = (bf16_t*)(a.ws + WS_Z);
    bf16x8 bE[8];
#pragma unroll
    for (int ks = 0; ks < 8; ++ks) bE[ks] = *(const bf16x8*)(WE + (size_t)(16 * wave + r) * 256 + 32 * ks + 8 * q);
    float sr = 0.f, si = 0.f, a16r = 0.f, a16i = 0.f;
    if (wave == 0) {
        a16r = s5p[(g * 64 + lane) * 2]; a16i = s5p[(g * 64 + lane) * 2 + 1];
        if (PASS == 1) { const float br = s5p[8192 + (g * 64 + lane) * 2], bi = s5p[8192 + (g * 64 + lane) * 2 + 1];
            for (int s = 0; s < seg; ++s) { const float fr_ = F[s * 128 + lane], fi_ = F[s * 128 + 64 + lane]; const float nr = br * sr - bi * si + fr_, ni = br * si + bi * sr + fi_; sr = nr; si = ni; } }
    }
    for (int sb = 0; sb < 4; ++sb) {
        const int tok0 = seg * 4096 + sb * 1024;
#pragma unroll
        for (int i = 0; i < 4; ++i) { const int ch = tid + NTHREADS * i, token = ch >> 1, half = ch & 1;
            const u32x4 v = *(const u32x4*)(U + (size_t)(tok0 + token) * 1024 + g * 16 + half * 8);
            *(LAS u32x4*)(lds + S5_US + (token >> 4) * 528 + ((token & 15) * 16 + half * 8) * 2) = v; }
        __syncthreads();
#pragma unroll
        for (int m = 0; m < 4; ++m) {
            f32x4 acc = {0.f, 0.f, 0.f, 0.f};
#pragma unroll
            for (int ks = 0; ks < 8; ++ks) { const bf16x8 A = *(const LAS bf16x8*)(lds + S5_US + (16 * m + r) * 528 + (32 * ks + 8 * q) * 2); acc = mfma16(A, bE[ks], acc); }
#pragma unroll
            for (int i = 0; i < 4; ++i) *(LAS float*)(lds + S5_ES + ((16 * m + 4 * q + i) * 132 + 16 * wave + r) * 4) = acc[i];
        }
        __syncthreads();
        if (wave == 0) {
            for (int ch = 0; ch < 64; ++ch) {
                const float er = *(const LAS float*)(lds + S5_ES + (ch * 132 + lane) * 4), ei = *(const LAS float*)(lds + S5_ES + (ch * 132 + 64 + lane) * 4);
                if (PASS == 1) { *(LAS bf16_t*)(lds + S5_SS + (ch * 136 + lane) * 2) = f2bf(sr); *(LAS bf16_t*)(lds + S5_SS + (ch * 136 + 64 + lane) * 2) = f2bf(si); }
                const float nr = a16r * sr - a16i * si + er, ni = a16r * si + a16i * sr + ei; sr = nr; si = ni;
            }
        }
        __syncthreads();
        if (PASS == 1) {
#pragma unroll
            for (int nt = 0; nt < 2; ++nt) {
                const int j = 2 * wave + nt;
                f32x4 acc[4];
#pragma unroll
                for (int m = 0; m < 4; ++m) acc[m] = (f32x4){0.f, 0.f, 0.f, 0.f};
                for (int ks = 0; ks <= (j >> 1); ++ks) {
                    const bf16x8 B = *(const bf16x8*)(MT + (size_t)(16 * j + r) * 256 + 32 * ks + 8 * q);
#pragma unroll
                    for (int m = 0; m < 4; ++m) { const bf16x8 A = *(const LAS bf16x8*)(lds + S5_US + (16 * m + r) * 528 + (32 * ks + 8 * q) * 2); acc[m] = mfma16(A, B, acc[m]); }
                }
#pragma unroll
                for (int ks = 0; ks < 4; ++ks) {
                    const bf16x8 B = *(const bf16x8*)(WC + (size_t)(16 * j + r) * 128 + 32 * ks + 8 * q);
#pragma unroll
                    for (int m = 0; m < 4; ++m) { const bf16x8 A = *(const LAS bf16x8*)(lds + S5_SS + (16 * m + r) * 272 + (32 * ks + 8 * q) * 2); acc[m] = mfma16(A, B, acc[m]); }
                }
#pragma unroll
                for (int m = 0; m < 4; ++m)
#pragma unroll
                    for (int i = 0; i < 4; ++i) { const int ch = 16 * m + 4 * q + i; Z[(size_t)(tok0 + 16 * ch + j) * 1024 + g * 16 + r] = f2bf(gelu_tanh(acc[m][i])); }
            }
            __syncthreads();
        }
    }
    if (PASS == 0 && wave == 0) { F[seg * 128 + lane] = sr; F[seg * 128 + 64 + lane] = si; }
}

__device__ __forceinline__ void cmp_finish_item(const Args& a, const Ctx& c, int kvsel, int rt) {
    LAS unsigned char* lds = c.lds;
    const int tid = c.tid, wave = c.wave, lane = c.lane, r = lane & 15, q = lane >> 4;
    const float* SL = (const float*)(a.ws + WS_SLAB) + (size_t)kvsel * 4 * 2048 * 256;
    const float* bpep = (const float*)(a.ws + WS_BPEP) + kvsel * 256;
    const bf16_t* W2 = (const bf16_t*)(a.ws + WS_W2) + kvsel * 128 * 256;
    for (int e = tid; e < 64 * 64; e += NTHREADS) {
        const int row = e >> 6, c4 = (e & 63) * 4;
        f32x4 s = {0.f, 0.f, 0.f, 0.f};
#pragma unroll 8
        for (int pt = 0; pt < 32; ++pt) s += *(const f32x4*)(bpep + pt * 512 + c4);
#pragma unroll
        for (int ks = 0; ks < 4; ++ks) s += *(const f32x4*)(SL + ((size_t)ks * 2048 + rt * 64 + row) * 256 + c4);
        u32x2 w; w[0] = cvt_pk_bf16(gelu_tanh(s[0]), gelu_tanh(s[1])); w[1] = cvt_pk_bf16(gelu_tanh(s[2]), gelu_tanh(s[3]));
        *(LAS u32x2*)(lds + row * 528 + c4 * 2) = w;
    }
    __syncthreads();
    bf16x8 B[8];
#pragma unroll
    for (int ks = 0; ks < 8; ++ks) B[ks] = *(const bf16x8*)(W2 + (size_t)(16 * wave + r) * 256 + 32 * ks + 8 * q);
#pragma unroll
    for (int m = 0; m < 4; ++m) {
        f32x4 acc = {0.f, 0.f, 0.f, 0.f};
#pragma unroll
        for (int ks = 0; ks < 8; ++ks) { const bf16x8 A = *(const LAS bf16x8*)(lds + (16 * m + r) * 528 + (32 * ks + 8 * q) * 2); acc = mfma16(A, B[ks], acc); }
#pragma unroll
        for (int i = 0; i < 4; ++i) {
            const int row = rt * 64 + 16 * m + 4 * q + i, gi = row >> 10, ci = row & 1023, n = 16 * wave + r;
            const bf16_t v = (ci == 1023) ? (bf16_t)0 : f2bf(acc[i]);
            if (kvsel == 0) ((bf16_t*)(a.ws + WS_KC))[((size_t)gi * 1024 + ci) * 128 + n] = v;
            else ((bf16_t*)(a.ws + WS_VCT))[((size_t)gi * 128 + n) * 1024 + ci] = v;
        }
    }
    __syncthreads();
}
constexpr int AT_KB = 0, AT_VB = 34816, AT_IMP = 69632, AT_TB = 135168, AT_BM = 147968, AT_WU = 150016, AT_END = 150272;
constexpr int AT_KBUF = 64 * 272, AT_VBUF = 128 * 136;
struct TileRegs { u32x4 k[2]; u32x4 v[2]; };
template <bool NEEDV>
__device__ __forceinline__ void tile_load(TileRegs& R, const bf16_t* Kt, const bf16_t* Vt, int ldv, int tid) {
#pragma unroll
    for (int i = 0; i < 2; ++i) { const int ch = tid + NTHREADS * i; R.k[i] = *(const u32x4*)(Kt + (ch >> 4) * 128 + (ch & 15) * 8); }
    if (NEEDV) {
#pragma unroll
        for (int i = 0; i < 2; ++i) { const int ch = tid + NTHREADS * i; R.v[i] = *(const u32x4*)(Vt + (size_t)(ch >> 3) * ldv + (ch & 7) * 8); }
    }
}
template <bool NEEDV>
__device__ __forceinline__ void tile_store(const TileRegs& R, LAS unsigned char* kb, LAS unsigned char* vb, int tid) {
#pragma unroll
    for (int i = 0; i < 2; ++i) { const int ch = tid + NTHREADS * i; *(LAS u32x4*)(kb + (ch >> 4) * 272 + (ch & 15) * 16) = R.k[i]; }
    if (NEEDV) {
#pragma unroll
        for (int i = 0; i < 2; ++i) { const int ch = tid + NTHREADS * i; LAS unsigned char* p = vb + (ch >> 3) * 136 + (ch & 7) * 16;
            *(LAS u32x2*)p = (u32x2){R.v[i][0], R.v[i][1]}; *(LAS u32x2*)(p + 8) = (u32x2){R.v[i][2], R.v[i][3]}; }
    }
}
__device__ __forceinline__ float xhalf_max(float x) { auto rr = __builtin_amdgcn_permlane32_swap(__float_as_uint(x), __float_as_uint(x), false, false); return fmaxf(__uint_as_float(rr[0]), __uint_as_float(rr[1])); }
__device__ __forceinline__ float xhalf_sum(float x) { auto rr = __builtin_amdgcn_permlane32_swap(__float_as_uint(x), __float_as_uint(x), false, false); return __uint_as_float(rr[0]) + __uint_as_float(rr[1]); }
template <int BR>
__device__ __forceinline__ void attn_tile(int MODE, LAS const unsigned char* kb, LAS const unsigned char* vb, LAS const float* tb, float cb, int key0, int t, int lane,
                                          const bf16x8 (&qf)[8], f32x16 (&O)[4], float& m, float& l, float inv_l, bool selbit, LAS float* imp_row) {
    const int r31 = lane & 31, h = lane >> 5;
    if (MODE == 1) cb = tb[TBN - 1];
#pragma unroll
    for (int sub = 0; sub < 2; ++sub) {
        f32x16 S;
#pragma unroll
        for (int r = 0; r < 16; ++r) S[r] = 0.f;
#pragma unroll
        for (int ks = 0; ks < 8; ++ks) { const bf16x8 A = *(const LAS bf16x8*)(kb + (sub * 32 + r31) * 272 + ks * 32 + h * 16); S = mfma32(A, qf[ks], S); }
        float mx = -INFINITY;
        if (MODE == 1) {
#pragma unroll
            for (int r = 0; r < 16; ++r) mx = fmaxf(mx, S[r]);
            mx = (BR == 2 && !selbit) ? -INFINITY : mx + cb;
        } else {
            const int base = (BR <= 1) ? t - 31 - 16 * (key0 + sub * 32 + 4 * h) : t - (key0 + sub * 32 + 4 * h);
            const bool nomask = (MODE == 2);
#pragma unroll
            for (int r = 0; r < 16; ++r) {
                const int cr = (r & 3) + 8 * (r >> 2);
                const int dist = (BR <= 1) ? base - 16 * cr : base - cr;
                const int idx = min(max(dist, 0), TBN - 1);
                float v = S[r] + tb[idx];
                {
                    bool valid;
                    if (BR <= 1) valid = dist >= 0; else if (BR == 2) valid = selbit && dist >= 0; else valid = nomask || (unsigned)dist < 512u;
                    v = valid ? v : -INFINITY;
                }
                S[r] = v; mx = fmaxf(mx, v);
            }
        }
        if (BR != 1) {
            mx = xhalf_max(mx);
            const float mn = fmaxf(m, mx), mu = (mn == -INFINITY) ? 0.f : mn;
            float me = mu;
            if (MODE == 1) me = (BR == 2 && !selbit) ? INFINITY : mu - cb;
            float ps = 0.f;
#pragma unroll
            for (int r = 0; r < 16; ++r) { const float p = fexp2(S[r] - me); S[r] = p; ps += p; }
            if (__any(mn > m)) {
                const float alpha = fexp2(m - mu);
                l *= alpha;
                if (BR >= 2) {
#pragma unroll
                    for (int dt = 0; dt < 4; ++dt)
#pragma unroll
                        for (int r = 0; r < 16; ++r) O[dt][r] *= alpha;
                }
            }
            l += ps; m = mn;
        } else {
            const float mu = (m == -INFINITY) ? 0.f : m;
            const float me = (MODE == 1) ? mu - cb : mu;
#pragma unroll
            for (int r = 0; r < 16; ++r) S[r] = fexp2(S[r] - me) * inv_l;
#pragma unroll
            for (int rg = 0; rg < 4; ++rg) {
                float A = 2.f * (S[4 * rg] + S[4 * rg + 1] + S[4 * rg + 2]) + S[4 * rg + 3], B = S[4 * rg + 3];
                A = quad_sum(A); B = quad_sum(B);
                const int jj = ((key0 + sub * 32) >> 2) + 2 * rg + h;
                if ((lane & 3) == 0) {
                    __hip_atomic_fetch_add(imp_row + jj, A, __ATOMIC_RELAXED, __HIP_MEMORY_SCOPE_WORKGROUP);
                    if (jj + 1 < 256) __hip_atomic_fetch_add(imp_row + jj + 1, B, __ATOMIC_RELAXED, __HIP_MEMORY_SCOPE_WORKGROUP);
                }
            }
        }
        if (BR >= 1) {
#pragma unroll
            for (int s1 = 0; s1 < 2; ++s1) {
                const int s = 2 * sub + s1;
                u32x4 pk;
#pragma unroll
                for (int e = 0; e < 4; ++e) pk[e] = cvt_pk_bf16(S[8 * s1 + 2 * e], S[8 * s1 + 2 * e + 1]);
                const bf16x8 pf = __builtin_bit_cast(bf16x8, pk);
#pragma unroll
                for (int dt = 0; dt < 4; ++dt) {
                    LAS const unsigned char* vp = vb + (32 * dt + r31) * 136 + (16 * s + 4 * h) * 2;
                    const u32x2 lo = *(const LAS u32x2*)vp, hi = *(const LAS u32x2*)(vp + 16);
                    const u32x4 av = {lo[0], lo[1], hi[0], hi[1]};
                    O[dt] = mfma32(__builtin_bit_cast(bf16x8, av), pf, O[dt]);
                }
            }
        }
    }
}
template <int BR>
__device__ __forceinline__ void run_branch(const Ctx& c, const bf16_t* Kb, const bf16_t* Vtb, int ldv, int lo, int hi, LAS const float* tb, float cb, int t, int t0,
                                           const bf16x8 (&qf)[8], f32x16 (&O)[4], float& m, float& l, float inv_l, int tl, LAS float* imp_row) {
    constexpr bool NEEDV = (BR != 0);
    LAS unsigned char* lds = c.lds;
    TileRegs R;
    int tidz = c.tid; asm volatile("" : "+v"(tidz));
    tile_load<NEEDV>(R, Kb + (size_t)lo * 64 * 128, Vtb + (size_t)lo * 64, ldv, tidz);
    tile_store<NEEDV>(R, lds + AT_KB, lds + AT_VB, tidz);
    __syncthreads();
    const int qt = t0 >> 6;
    for (int j = lo; j < hi; ++j) {
        const int buf = (j - lo) & 1;
        if (j + 1 < hi) tile_load<NEEDV>(R, Kb + (size_t)(j + 1) * 64 * 128, Vtb + (size_t)(j + 1) * 64, ldv, tidz);
        bool selbit = true, wave_on = true;
        if (BR == 2) {
            const unsigned w = *(const LAS unsigned*)(lds + AT_BM + (tl * 8 + (j >> 5)) * 4);
            selbit = (w >> (j & 31)) & 1u;
            const unsigned wu = *(const LAS unsigned*)(lds + AT_WU + (c.wave * 8 + (j >> 5)) * 4);
            wave_on = (wu >> (j & 31)) & 1u;
        }
        LAS const unsigned char* kb = lds + AT_KB + buf * AT_KBUF; LAS const unsigned char* vb = lds + AT_VB + buf * AT_VBUF;
        if (wave_on) {
            int mode = 0;
            if (BR <= 1) mode = (1024 * j + 1829 <= t0) ? 1 : 0;
            else if (BR == 2) mode = (64 * j + 853 <= t0) ? 1 : 0;
            else mode = (j >= qt - 7 && j <= qt - 1) ? 2 : 0;
            attn_tile<BR>(mode, kb, vb, tb, cb, j * 64, t, c.lane, qf, O, m, l, inv_l, selbit, imp_row);
        }
        if (j + 1 < hi) tile_store<NEEDV>(R, lds + AT_KB + (buf ^ 1) * AT_KBUF, lds + AT_VB + (buf ^ 1) * AT_VBUF, tidz);
        __syncthreads();
    }
}
__device__ __forceinline__ void attn_item(const Args& a, const Ctx& c_, int qt, int g) {
    Ctx c = c_; { int tz = c_.tid; asm volatile("" : "+v"(tz)); c.tid = tz; c.lane = tz & 63; }
    LAS unsigned char* lds = c.lds;
    const int tid = c.tid, wave = c.wave, lane = c.lane, r31 = lane & 31, h = lane >> 5, hl = lane & 3;
    const int t0 = qt * 64, tl = 8 * wave + (r31 >> 2), t = t0 + tl, head = g * 4 + hl;
    const bf16_t* Qb = (const bf16_t*)(a.ws + WS_Q);
    const bf16_t* KROW = (const bf16_t*)(a.ws + WS_KROW);
    const bf16_t* VT = (const bf16_t*)(a.ws + WS_VT);
    const float* GATE = (const float*)(a.ws + WS_GATE);
    { const float* tbg = (const float*)(a.ws + WS_TB) + g * 4 * TBN;
      for (int i = tid; i < 4 * TBN; i += NTHREADS) *(LAS float*)(lds + AT_TB + i * 4) = tbg[i];
      for (int i = tid; i < 64 * 256; i += NTHREADS) *(LAS float*)(lds + AT_IMP + i * 4) = 0.f; }
    bf16x8 qf[8];
#pragma unroll
    for (int ks = 0; ks < 8; ++ks) qf[ks] = *(const bf16x8*)(Qb + (size_t)t * 1024 + head * 128 + 16 * ks + 8 * h);
    LAS const float* tb = (LAS const float*)(lds + AT_TB) + hl * TBN;
    LAS float* imp_row = (LAS float*)(lds + AT_IMP) + tl * 256;
    const float cb = 0.f;
    f32x16 O[4]; unsigned Otp[4][8];
#pragma unroll
    for (int dt = 0; dt < 4; ++dt)
#pragma unroll
        for (int r = 0; r < 16; ++r) O[dt][r] = 0.f;
    __syncthreads();
    { const int ntile = (t0 / 16 + 3 + 63) / 64;
      const bf16_t* KC = (const bf16_t*)(a.ws + WS_KC) + (size_t)g * 1024 * 128; const bf16_t* VCT = (const bf16_t*)(a.ws + WS_VCT) + (size_t)g * 128 * 1024;
      float m = -INFINITY, l = 0.f;
      run_branch<0>(c, KC, VCT, 1024, 0, ntile, tb, cb, t, t0, qf, O, m, l, 0.f, tl, imp_row);
      const float lt = xhalf_sum(l), inv = lt > 0.f ? 1.f / lt : 0.f;
      run_branch<1>(c, KC, VCT, 1024, 0, ntile, tb, cb, t, t0, qf, O, m, l, inv, tl, imp_row);
      const float gc = GATE[(size_t)t * 24 + head];
#pragma unroll
      for (int dt = 0; dt < 4; ++dt)
#pragma unroll
          for (int r = 0; r < 8; ++r) { Otp[dt][r] = cvt_pk_bf16(gc * O[dt][2 * r], gc * O[dt][2 * r + 1]); O[dt][2 * r] = 0.f; O[dt][2 * r + 1] = 0.f; }
    }
    {
        unsigned wu[8];
#pragma unroll
        for (int k = 0; k < 8; ++k) wu[k] = 0u;
        const int ncand = qt - 2 > 0 ? qt - 2 : 0;
        for (int i = 0; i < 8; ++i) {
            LAS const float* row = (LAS const float*)(lds + AT_IMP) + (8 * wave + i) * 256;
            float v[4]; bool sel[4];
#pragma unroll
            for (int k = 0; k < 4; ++k) { const int j = lane + 64 * k; const bool cand = (j >= 1 && j <= qt - 2); v[k] = cand ? row[j] : -1.f; sel[k] = false; }
            if (ncand <= 13) {
#pragma unroll
                for (int k = 0; k < 4; ++k) sel[k] = v[k] >= 0.f;
            } else {
                for (int it = 0; it < 13; ++it) {
                    float mx = fmaxf(fmaxf(v[0], v[1]), fmaxf(v[2], v[3])); mx = wave_max(mx);
                    int wk = -1, wl = 0;
#pragma unroll
                    for (int k = 0; k < 4; ++k) { const unsigned long long mk = __ballot(v[k] == mx); if (wk < 0 && mk != 0ull) { wk = k; wl = __ffsll((long long)mk) - 1; } }
#pragma unroll
                    for (int k = 0; k < 4; ++k) if (k == wk && lane == wl) { v[k] = -1.f; sel[k] = true; }
                }
            }
#pragma unroll
            for (int k = 0; k < 4; ++k) {
                const int j = lane + 64 * k; const bool forced = (j == 0) || (j == qt) || (j == qt - 1);
                const unsigned long long mk = __ballot(sel[k] || forced);
                const unsigned lo = (unsigned)mk, hi = (unsigned)(mk >> 32);
                if (lane == 0) { *(LAS unsigned*)(lds + AT_BM + ((8 * wave + i) * 8 + 2 * k) * 4) = lo; *(LAS unsigned*)(lds + AT_BM + ((8 * wave + i) * 8 + 2 * k + 1) * 4) = hi; }
                wu[2 * k] |= lo; wu[2 * k + 1] |= hi;
            }
        }
        if (lane == 0) {
#pragma unroll
            for (int k = 0; k < 8; ++k) *(LAS unsigned*)(lds + AT_WU + (wave * 8 + k) * 4) = wu[k];
        }
    }
    LAS unsigned* park = (LAS unsigned*)(lds + AT_IMP + wave * 8192) + lane;
#pragma unroll
    for (int dt = 0; dt < 4; ++dt)
#pragma unroll
        for (int r = 0; r < 8; ++r) park[(dt * 8 + r) * 64] = Otp[dt][r];
    __syncthreads();
    { float m = -INFINITY, l = 0.f;
      run_branch<2>(c, KROW + (size_t)(2 + g) * L_ * 128, VT + (size_t)g * 128 * L_, L_, 0, qt + 1, tb, cb, t, t0, qf, O, m, l, 0.f, tl, imp_row);
      const float gs = GATE[(size_t)t * 24 + 8 + head];
      const float lt = xhalf_sum(l), sc = gs * (lt > 0.f ? 1.f / lt : 0.f);
#pragma unroll
      for (int dt = 0; dt < 4; ++dt)
#pragma unroll
          for (int r = 0; r < 8; ++r) { const unsigned w = park[(dt * 8 + r) * 64]; park[(dt * 8 + r) * 64] = cvt_pk_bf16(bflo(w) + sc * O[dt][2 * r], bfhi(w) + sc * O[dt][2 * r + 1]); O[dt][2 * r] = 0.f; O[dt][2 * r + 1] = 0.f; }
    }
    { float m = -INFINITY, l = 0.f;
      const int lo = qt - 8 > 0 ? qt - 8 : 0;
      run_branch<3>(c, KROW + (size_t)(4 + g) * L_ * 128, VT + (size_t)(2 + g) * 128 * L_, L_, lo, qt + 1, tb, cb, t, t0, qf, O, m, l, 0.f, tl, imp_row);
      const float gw = GATE[(size_t)t * 24 + 16 + head];
      const float lt = xhalf_sum(l), sc = gw * (lt > 0.f ? 1.f / lt : 0.f);
#pragma unroll
      for (int dt = 0; dt < 4; ++dt)
#pragma unroll
          for (int r = 0; r < 8; ++r) { const unsigned w = park[(dt * 8 + r) * 64]; Otp[dt][r] = cvt_pk_bf16(bflo(w) + sc * O[dt][2 * r], bfhi(w) + sc * O[dt][2 * r + 1]); }
    }
    bf16_t* Y = (bf16_t*)(a.ws + WS_YATT) + (size_t)t * 1024 + head * 128;
#pragma unroll
    for (int dt = 0; dt < 4; ++dt)
#pragma unroll
        for (int rg = 0; rg < 4; ++rg) {
            u32x2 w; w[0] = Otp[dt][2 * rg]; w[1] = Otp[dt][2 * rg + 1];
            *(u32x2*)(Y + 32 * dt + 8 * rg + 4 * h) = w;
        }
    __syncthreads();
}
#ifndef PEER_ALPHA
#define PEER_ALPHA 1.0f
#endif
constexpr int PE_SC = 0, PE_LV = 66048, PE_LI = 74240, PE_EX = 147456, PE_GT = 151552, PE_SU = 155648, PE_END = 159744;
constexpr int PE_SLOT = 3072, PE_NSLOT = 6, PE_RINGW = PE_SLOT * PE_NSLOT;
static_assert(8 * PE_RINGW <= PE_EX && PE_END <= LDS_BYTES - 16, "PEER LDS map");
__device__ __forceinline__ float wave_sum_bcast(float v) {
    v += dpp_f<0xB1>(v); v += dpp_f<0x4E>(v); v += dpp_f<0x141>(v); v += dpp_f<0x140>(v);
    v += __int_as_float(__builtin_amdgcn_update_dpp(0, __float_as_int(v), 0x142, 0xa, 0xf, false));
    v += __int_as_float(__builtin_amdgcn_update_dpp(0, __float_as_int(v), 0x143, 0xc, 0xf, false));
    return __int_as_float(__builtin_amdgcn_readlane(__float_as_int(v), 63));
}
__device__ __forceinline__ unsigned mono_key(float v) { const unsigned b = __float_as_uint(v); return b ^ ((b >> 31) ? 0xFFFFFFFFu : 0x80000000u); }
template <bool DRY>
__device__ __forceinline__ void peer_step(const Args& a, const Ctx& c_, int t0) {
    Ctx c = c_; { int tz = c_.tid; asm volatile("" : "+v"(tz)); c.tid = tz; c.lane = tz & 63; }
    LAS unsigned char* lds = c.lds;
    const int tid = c.tid, wave = c.wave, lane = c.lane, r = lane & 15, q = lane >> 4;
    const bf16_t* QP = (const bf16_t*)(a.ws + WS_QP); const bf16_t* PK = (const bf16_t*)(a.ws + WS_PK);
    const unsigned char* PU = a.ws + WS_PU; const unsigned char* PV = a.ws + WS_PV; const float* psc = (const float*)(a.ws + WS_PSC);
    const bf16_t* HB = (const bf16_t*)(a.ws + WS_H);
    {
        const int hh = wave;
#pragma unroll
        for (int cc = 0; cc < 2; ++cc) {
            bf16x8 aF[4];
#pragma unroll
            for (int ks = 0; ks < 4; ++ks) aF[ks] = *(const bf16x8*)(QP + (size_t)(t0 + (r & 7)) * 2048 + hh * 256 + cc * 128 + 32 * ks + 8 * q);
#pragma unroll 2
            for (int nt = 0; nt < 8; ++nt) {
                f32x4 acc = {0.f, 0.f, 0.f, 0.f};
#pragma unroll
                for (int ks = 0; ks < 4; ++ks) { const bf16x8 B = *(const bf16x8*)(PK + (size_t)(cc * 128 + 16 * nt + r) * 128 + 32 * ks + 8 * q); acc = mfma16(aF[ks], B, acc); }
                if (q < 2) {
#pragma unroll
                    for (int i = 0; i < 4; ++i) { const int tok = 4 * q + i; *(LAS float*)(lds + PE_SC + ((tok * 16 + hh * 2 + cc) * 129 + 16 * nt + r) * 4) = acc[i]; }
                }
            }
        }
    }
    __syncthreads();
    if (tid < 128) {
        LAS const float* sc = (LAS const float*)(lds + PE_SC) + tid * 129;
        unsigned top[16];
#pragma unroll
        for (int e = 0; e < 16; ++e) top[e] = 0u;
#pragma unroll 2
        for (int k = 0; k < 128; ++k) {
            unsigned key = (mono_key(sc[k]) & ~0x7Fu) | (unsigned)(127 - k);
#pragma unroll
            for (int e = 0; e < 16; ++e) { const unsigned hi = max(top[e], key); key = min(top[e], key); top[e] = hi; }
        }
#pragma unroll
        for (int e = 0; e < 16; ++e) { const int idx = 127 - (int)(top[e] & 0x7Fu); *(LAS float*)(lds + PE_LV + (tid * 16 + e) * 4) = sc[idx]; *(LAS int*)(lds + PE_LI + (tid * 16 + e) * 4) = idx; }
    }
    __syncthreads();
    if (tid < 64) {
        const int tok = tid >> 3, hh = tid & 7, t1 = tok * 16 + hh * 2, t2 = t1 + 1;
        float v1[16], v2[16];
#pragma unroll
        for (int e = 0; e < 16; ++e) { v1[e] = *(const LAS float*)(lds + PE_LV + (t1 * 16 + e) * 4); v2[e] = *(const LAS float*)(lds + PE_LV + (t2 * 16 + e) * 4); }
        unsigned top[16];
#pragma unroll
        for (int e = 0; e < 16; ++e) top[e] = 0u;
#pragma unroll
        for (int aa = 0; aa < 16; ++aa)
#pragma unroll
            for (int bb = 0; bb < 16; ++bb)
                if ((aa + 1) * (bb + 1) <= 16) {
                    unsigned key = (mono_key(v1[aa] + v2[bb]) & ~0xFFu) | (unsigned)(255 - (aa * 16 + bb));
#pragma unroll
                    for (int e = 0; e < 16; ++e) { const unsigned hi = max(top[e], key); key = min(top[e], key); top[e] = hi; }
                }
        float sv[16]; int ex[16]; float mx = -INFINITY;
#pragma unroll
        for (int e = 0; e < 16; ++e) {
            const int id = 255 - (int)(top[e] & 0xFFu), aa = id >> 4, bb = id & 15;
            sv[e] = *(const LAS float*)(lds + PE_LV + (t1 * 16 + aa) * 4) + *(const LAS float*)(lds + PE_LV + (t2 * 16 + bb) * 4);
            ex[e] = *(const LAS int*)(lds + PE_LI + (t1 * 16 + aa) * 4) * 128 + *(const LAS int*)(lds + PE_LI + (t2 * 16 + bb) * 4);
            mx = fmaxf(mx, sv[e]);
        }
        float sum = 0.f;
#pragma unroll
        for (int e = 0; e < 16; ++e) { sv[e] = fexp2((sv[e] - mx) * LOG2E); sum += sv[e]; }
        const float inv = 1.f / sum;
#pragma unroll
        for (int e = 0; e < 16; ++e) { *(LAS int*)(lds + PE_EX + (tok * 128 + hh * 16 + e) * 4) = ex[e];
            *(LAS float*)(lds + PE_GT + (tok * 128 + hh * 16 + e) * 4) = sv[e] * inv * psc[16384 + ex[e]];
            *(LAS float*)(lds + PE_SU + (tok * 128 + hh * 16 + e) * 4) = psc[ex[e]]; }
    }
    __syncthreads();
    const int t = t0 + wave;
    float hp[32];
#pragma unroll
    for (int k = 0; k < 4; ++k) { const u32x4 w = *(const u32x4*)(HB + (size_t)t * 2048 + lane * 32 + k * 8);
#pragma unroll
        for (int e = 0; e < 4; ++e) { hp[k * 8 + 2 * e] = bflo(w[e]); hp[k * 8 + 2 * e + 1] = bfhi(w[e]); } }
    float acc[32];
#pragma unroll
    for (int e = 0; e < 32; ++e) acc[e] = 0.f;
    asm volatile("s_waitcnt vmcnt(0)" ::: "memory");
    {
        LAS const int* exl = (LAS const int*)(lds + PE_EX) + wave * 128; LAS const float* gtl = (LAS const float*)(lds + PE_GT) + wave * 128;
        LAS unsigned char* ring = lds + wave * PE_RINGW;
        LAS const float* sul = (LAS const float*)(lds + PE_SU) + wave * 128;
#define ROW_ISSUE(SL, IDX) do { const int ex_ = __builtin_amdgcn_readfirstlane(exl[IDX]); \
            const unsigned char* gu_ = PU + (size_t)ex_ * 1536; const unsigned char* gv_ = PV + (size_t)ex_ * 1536; \
            LAS unsigned char* sl_ = ring + (SL) * PE_SLOT;                   \
            __builtin_amdgcn_global_load_lds((const unsigned*)(gu_ + lane * 16), (LAS unsigned*)sl_, 16, 0, 0); \
            __builtin_amdgcn_global_load_lds((const unsigned*)((lane < 32 ? gu_ + 1024 : gv_ - 512) + lane * 16), (LAS unsigned*)(sl_ + 1024), 16, 0, 0); \
            __builtin_amdgcn_global_load_lds((const unsigned*)(gv_ + 512 + lane * 16), (LAS unsigned*)(sl_ + 2048), 16, 0, 0); \
            } while (0)
#define ROW_APPLY(SL, IDX) do { LAS const unsigned char* sl_ = ring + (SL) * PE_SLOT + lane * 24; \
            const u32x2 a0_ = *(const LAS u32x2*)sl_, a1_ = *(const LAS u32x2*)(sl_ + 8), a2_ = *(const LAS u32x2*)(sl_ + 16); \
            const f32x32 uf_ = __builtin_amdgcn_cvt_scalef32_pk32_f32_fp6((u32x6){a0_[0], a0_[1], a1_[0], a1_[1], a2_[0], a2_[1]}, 1.0f); \
            float d0_ = 0.f, d1_ = 0.f; \
            _Pragma("unroll") for (int i = 0; i < 32; i += 2) { d0_ += uf_[i] * hp[i]; d1_ += uf_[i + 1] * hp[i + 1]; } \
            const float d_ = wave_sum_bcast(d0_ + d1_) * sul[IDX]; \
            const float wgt_ = gtl[IDX] * gelu_tanh(d_); \
            const u32x2 b0_ = *(const LAS u32x2*)(sl_ + 1536), b1_ = *(const LAS u32x2*)(sl_ + 1544), b2_ = *(const LAS u32x2*)(sl_ + 1552); \
            const f32x32 vf_ = __builtin_amdgcn_cvt_scalef32_pk32_f32_fp6((u32x6){b0_[0], b0_[1], b1_[0], b1_[1], b2_[0], b2_[1]}, 1.0f); \
            _Pragma("unroll") for (int i = 0; i < 32; ++i) acc[i] += wgt_ * vf_[i]; \
            asm volatile("s_waitcnt lgkmcnt(0)" ::: "memory"); } while (0)
#define DMA_WAIT(N) asm volatile("s_waitcnt vmcnt(" #N ")" ::: "memory")
        ROW_ISSUE(0, 0); ROW_ISSUE(1, 1); ROW_ISSUE(2, 2); ROW_ISSUE(3, 3); ROW_ISSUE(4, 4); ROW_ISSUE(5, 5);
#pragma unroll 1
        for (int e = 0; e < 126; e += 6) {
            const bool last = (e == 120);
            DMA_WAIT(15); ROW_APPLY(0, e);     ROW_ISSUE(0, e + 6);
            DMA_WAIT(15); ROW_APPLY(1, e + 1); ROW_ISSUE(1, e + 7);
            DMA_WAIT(15); ROW_APPLY(2, e + 2); if (!last) ROW_ISSUE(2, e + 8);
            if (last) DMA_WAIT(0); else DMA_WAIT(15);
            ROW_APPLY(3, e + 3); if (!last) ROW_ISSUE(3, e + 9);
            if (!last) DMA_WAIT(15);
            ROW_APPLY(4, e + 4); if (!last) ROW_ISSUE(4, e + 10);
            if (!last) DMA_WAIT(15);
            ROW_APPLY(5, e + 5); if (!last) ROW_ISSUE(5, e + 11);
        }
        ROW_APPLY(0, 126);
        ROW_APPLY(1, 127);
#undef ROW_ISSUE
#undef ROW_APPLY
#undef DMA_WAIT
    }
    {
        float* xo = a.out + (size_t)t * 2048; const float* g2 = (const float*)(a.ws + WS_COND) + 5 * 2048; const float* fg = a.in[32];
        float ss = 0.f;
#pragma unroll
        for (int k = 0; k < 8; ++k) {
            const int col = lane * 32 + k * 4;
            const f32x4 x1 = *(const f32x4*)(xo + col), gv = *(const f32x4*)(g2 + col);
#pragma unroll
            for (int e = 0; e < 4; ++e) { const float x2 = x1[e] + PEER_ALPHA * gv[e] * acc[k * 4 + e]; acc[k * 4 + e] = x2; ss += x2 * x2; }
        }
        ss = wave_sum_bcast(ss);
        const float rstd = rsqrtf(ss * (1.f / 2048.f) + 1e-6f);
#pragma unroll
        for (int k = 0; k < 8; ++k) {
            const int col = lane * 32 + k * 4;
            const f32x4 fv = *(const f32x4*)(fg + col);
            f32x4 o;
#pragma unroll
            for (int e = 0; e < 4; ++e) o[e] = acc[k * 4 + e] * rstd * fv[e];
            if (!DRY || rstd == 123.456f) *(f32x4*)(xo + col) = o;
        }
    }
    __syncthreads();
}
constexpr int NPHASE = 11;
#ifndef DBG
#define DBG 0
#endif
__device__ __forceinline__ void dbg_final_norm(const Args& a, const Ctx& c, const float* src) {
    for (int t = c.bid * 8 + c.wave; t < L_; t += c.nb * 8) {
        const float* xr = src + (size_t)t * 2048 + c.lane * 4; float* o = a.out + (size_t)t * 2048 + c.lane * 4;
        f32x4 v[8]; float ss = 0.f;
#pragma unroll
        for (int j = 0; j < 8; ++j) { v[j] = *(const f32x4*)(xr + j * 256); ss += v[j][0] * v[j][0] + v[j][1] * v[j][1] + v[j][2] * v[j][2] + v[j][3] * v[j][3]; }
        ss = wave_sum(ss);
        const float rstd = rsqrtf(ss * (1.f / 2048.f) + 1e-6f);
#pragma unroll
        for (int j = 0; j < 8; ++j) { const f32x4 g = *(const f32x4*)(a.in[32] + j * 256 + c.lane * 4); *(f32x4*)(o + j * 256) = v[j] * rstd * g; }
    }
}

extern __shared__ __attribute__((aligned(16))) unsigned char smem[];

__global__ void __launch_bounds__(512, 2) fwd(Args a) {
    LAS unsigned char* lds = (LAS unsigned char*)smem;
    Ctx c; c.bid = blockIdx.x; c.nb = gridDim.x; c.tid = threadIdx.x; c.wave = __builtin_amdgcn_readfirstlane(threadIdx.x >> 6); c.lane = threadIdx.x & 63; c.lds = lds;
    volatile LAS unsigned* xbw = (volatile LAS unsigned*)(lds + LDS_BYTES - 16);
    if (c.tid < 4) xbw[c.tid] = 0u;
    __syncthreads();
    const int lo = a.ph_lo, hi = a.ph_hi;
    const bool multi = (hi - lo) > 1;
    XcdBarrier bar; bar.bar = (unsigned*)(a.ws + WS_CTL); bar.x = 0; bar.st = xbw;
    if (multi) bar = xcd_barrier_post((unsigned*)(a.ws + WS_CTL), xbw);
#ifndef PHASE_MASK
#define PHASE_MASK 0xFFFF
#endif
#if DBG == 1
#undef PHASE_MASK
#define PHASE_MASK 0x403
#elif DBG == 2 || DBG == 4 || DBG == 5
#undef PHASE_MASK
#define PHASE_MASK 0x4FF
#endif
#define IN(k) (((PHASE_MASK >> (k)) & 1) && lo <= (k) && (k) < hi)
#define REFRESH() do { int tz_ = threadIdx.x; asm volatile("" : "+v"(tz_)); c.tid = tz_; c.lane = tz_ & 63; c.wave = __builtin_amdgcn_readfirstlane(tz_ >> 6); } while (0)
#define SEAM(k) do { if (IN(k) && IN((k) + 1)) xcd_barrier(bar); } while (0)
#ifndef DUP
#define DUP -1
#endif
#define REP(k) for (int rep_ = 0; rep_ < ((DUP == (k)) ? 2 : 1); ++rep_)

    if (IN(0)) REP(0) { REFRESH(); p0_prologue(a, c); }
    SEAM(0);
    if (IN(1)) { REFRESH(); p1_hnorm(a, c); }
    SEAM(1);
    if (IN(2)) REP(2) { REFRESH();
        pg8::StaticOrder S; S.init((const bf16_t*)(a.ws + WS_H), (const bf16_t*)(a.ws + WS_WIN), 2048, 2048, 2048, L_, DIN_PAD, c.nb, c.bid);
        EpiWin E{(bf16_t*)(a.ws + WS_US), (bf16_t*)(a.ws + WS_Q), (bf16_t*)(a.ws + WS_KROW), (bf16_t*)(a.ws + WS_VROW), (bf16_t*)(a.ws + WS_VT), (float*)(a.ws + WS_GATE)};
        pg8::gemm_phase<EpiWin, pg8::StaticOrder>(lds, S, E);
    }
    SEAM(2);
    if (IN(3)) REP(3) { REFRESH();
        for (int it = c.bid; it < 256; it += c.nb) s5_item<0>(a, c, it >> 2, it & 3);
        __syncthreads();
        CmpOrder S{(const bf16_t*)(a.ws + WS_KROW), (const bf16_t*)(a.ws + WS_VROW), (const bf16_t*)(a.ws + WS_W1), 2048, 4096, 1024, c.nb, c.bid};
        EpiSlab E{(float*)(a.ws + WS_SLAB)};
        pg8::gemm_phase<EpiSlab, CmpOrder>(lds, S, E);
    }
    SEAM(3);
    if (IN(4)) REP(4) { REFRESH();
        for (int it = c.bid; it < 64; it += c.nb) cmp_finish_item(a, c, it >> 5, it & 31);
        for (int it = c.bid; it < 256; it += c.nb) s5_item<1>(a, c, it >> 2, it & 3);
    }
    SEAM(4);
    if (IN(5)) { REFRESH();
#if DBG == 5
        for (size_t i = (size_t)c.bid * NTHREADS + c.tid; i < (size_t)L_ * 1024 / 8; i += (size_t)c.nb * NTHREADS) *(u32x4*)((bf16_t*)(a.ws + WS_YSSM) + i * 8) = (u32x4){0u, 0u, 0u, 0u};
#else
        {
            pg8::StaticOrder S; S.init((const bf16_t*)(a.ws + WS_Z), (const bf16_t*)(a.ws + WS_WGLU), 1024, 1024, 1024, L_, 1024, c.nb, c.bid);
            EpiGlu E{(const bf16_t*)(a.ws + WS_Z), a.in[19], (bf16_t*)(a.ws + WS_YSSM)};
            pg8::gemm_phase<EpiGlu, pg8::StaticOrder>(lds, S, E);
        }
#endif
        __syncthreads();
        REP(5)
#if DBG == 4
        for (size_t i = (size_t)c.bid * NTHREADS + c.tid; i < (size_t)L_ * 1024 / 8; i += (size_t)c.nb * NTHREADS) *(u32x4*)((bf16_t*)(a.ws + WS_YATT) + i * 8) = (u32x4){0u, 0u, 0u, 0u};
#else
        for (int it = c.bid; it < 512; it += c.nb) {
            const int rnd = it / c.nb;
            const int qt = (rnd & 1) ? 255 - (it % 256) : (it % 256), g = (it >> 8) & 1;
            attn_item(a, c, qt, g);
        }
#endif
    }
    SEAM(5);
    if (IN(6)) { REFRESH(); p6_mixnorm(a, c); }
    SEAM(6);
    if (IN(7)) { REFRESH();
        pg8::StaticOrder S; S.init((const bf16_t*)(a.ws + WS_H), (const bf16_t*)(a.ws + WS_WOUT), 2048, 2048, 2048, L_, 2048, c.nb, c.bid);
        EpiWout E{a.in[0], (const float*)(a.ws + WS_COND) + 2 * 2048, a.out};
        pg8::gemm_phase<EpiWout, pg8::StaticOrder>(lds, S, E);
    }
    SEAM(7);
    if (IN(8)) { REFRESH(); p8_h2norm(a, c); }
    SEAM(8);
    if (IN(9)) { REFRESH();
        pg8::StaticOrder S; S.init((const bf16_t*)(a.ws + WS_H), (const bf16_t*)(a.ws + WS_WQ), 2048, 2048, 2048, L_, 2048, c.nb, c.bid);
        EpiBf16 E{(bf16_t*)(a.ws + WS_QP), 2048};
        pg8::gemm_phase<EpiBf16, pg8::StaticOrder>(lds, S, E);
    }
    SEAM(9);
    if (IN(10)) { REFRESH();
#if DBG == 1
        dbg_final_norm(a, c, a.in[0]);
#elif DBG == 2 || DBG == 4 || DBG == 5
        dbg_final_norm(a, c, a.out);
#else
        if (DUP == 10) { for (int s = c.bid; s < L_ / 8; s += c.nb) peer_step<true>(a, c, s * 8); }
        for (int s = c.bid; s < L_ / 8; s += c.nb) peer_step<false>(a, c, s * 8);
#endif
    }
#undef IN
#undef SEAM
}

#ifndef N_LAUNCHES
#define N_LAUNCHES 1
#endif
extern "C" void kernel_launch(void* const* d_in, const int* in_sizes, int n_in, void* d_out, int out_size, void* d_ws, size_t ws_size, hipStream_t stream) {
    static int grid = 0;
    if (grid == 0) {
        if (n_in != 33 || out_size != L_ * D_ || ws_size < WS_END) { fprintf(stderr, "kernel_launch: unexpected shapes (n_in %d, out %d, ws %zu < %zu); nothing launched\n", n_in, out_size, ws_size, (size_t)WS_END); grid = -1; return; }
        int dev = 0, cus = 0, per_cu = 0;
        if (hipGetDevice(&dev) != hipSuccess || hipDeviceGetAttribute(&cus, hipDeviceAttributeMultiprocessorCount, dev) != hipSuccess) { grid = -1; return; }
        if (hipFuncSetAttribute((const void*)fwd, hipFuncAttributeMaxDynamicSharedMemorySize, LDS_BYTES) != hipSuccess) { fprintf(stderr, "kernel_launch: hipFuncSetAttribute failed\n"); grid = -1; return; }
        if (hipOccupancyMaxActiveBlocksPerMultiprocessor(&per_cu, (const void*)fwd, NTHREADS, LDS_BYTES) != hipSuccess || per_cu < 1) { fprintf(stderr, "kernel_launch: occupancy query says %d\n", per_cu); (void)hipGetLastError(); grid = -1; return; }
        grid = cus;
    }
    if (grid < 0) return;
    (void)hipMemsetAsync((char*)d_ws + WS_CTL, 0, CTL_BYTES, stream);
    Args a{};
    for (int i = 0; i < 33; ++i) a.in[i] = (const float*)d_in[i];
    a.out = (float*)d_out; a.ws = (unsigned char*)d_ws;
    if (N_LAUNCHES == 1) { a.ph_lo = 0; a.ph_hi = NPHASE; hipLaunchKernelGGL(fwd, dim3(grid), dim3(NTHREADS), LDS_BYTES, stream, a); }
    else for (int p = 0; p < NPHASE; ++p) { a.ph_lo = p; a.ph_hi = p + 1; hipLaunchKernelGGL(fwd, dim3(grid), dim3(NTHREADS), LDS_BYTES, stream, a); }
}
```

```cpp
#include <hip/hip_runtime.h>
#include <stdint.h>
#include <stdio.h>

#define LAS __attribute__((address_space(3)))
typedef unsigned short bf16_t;
typedef short bf16x8 __attribute__((ext_vector_type(8)));
typedef float f32x2 __attribute__((ext_vector_type(2)));
typedef float f32x4 __attribute__((ext_vector_type(4)));
typedef float f32x16 __attribute__((ext_vector_type(16)));
typedef unsigned u32x2 __attribute__((ext_vector_type(2)));
typedef unsigned u32x4 __attribute__((ext_vector_type(4)));
typedef __bf16 bfv2 __attribute__((ext_vector_type(2)));
typedef unsigned u32x6 __attribute__((ext_vector_type(6)));
typedef float f32x32 __attribute__((ext_vector_type(32)));

constexpr int L_ = 16384, D_ = 2048, DSSM = 1024, DATT = 1024, DIN = 3608, DIN_PAD = 3840;
constexpr int NADA = 12288;
constexpr float LOG2E = 1.4426950408889634f;
constexpr float QSCALE = 0.08838834764831845f * 1.4426950408889634f;
constexpr int TBN = 800;
constexpr int NTHREADS = 512;
constexpr int LDS_BYTES = 163840;

constexpr size_t al256(size_t x) { return (x + 255) & ~(size_t)255; }
constexpr size_t WS_CTL   = 0;                                  constexpr size_t CTL_BYTES = 65536;
constexpr size_t WS_CONDP = WS_CTL + CTL_BYTES;
constexpr size_t WS_COND  = WS_CONDP + 32 * 12288 * 4;
constexpr size_t WS_TB    = WS_COND + 12288 * 4;
constexpr size_t WS_BPE   = al256(WS_TB + 8 * TBN * 4);
constexpr size_t WS_S5P   = al256(WS_BPE + 2 * 256 * 4);
constexpr size_t WS_S5F   = WS_S5P + 2 * 64 * 64 * 2 * 4;
constexpr size_t WS_S5MT  = WS_S5F + 64 * 4 * 128 * 4;
constexpr size_t WS_S5WE  = WS_S5MT + (size_t)64 * 256 * 256 * 2;
constexpr size_t WS_S5WC  = WS_S5WE + (size_t)64 * 128 * 256 * 2;
constexpr size_t WS_WIN   = WS_S5WC + (size_t)64 * 256 * 128 * 2;
constexpr size_t WS_WGLU  = WS_WIN + (size_t)DIN_PAD * 2048 * 2;
constexpr size_t WS_WOUT  = WS_WGLU + (size_t)1024 * 1024 * 2;
constexpr size_t WS_WQ    = WS_WOUT + (size_t)2048 * 2048 * 2;
constexpr size_t WS_W1    = WS_WQ + (size_t)2048 * 2048 * 2;
constexpr size_t WS_W2    = WS_W1 + (size_t)2 * 256 * 4096 * 2;
constexpr size_t WS_PK    = WS_W2 + (size_t)2 * 128 * 256 * 2;
constexpr size_t WS_PU    = WS_PK + (size_t)2 * 128 * 128 * 2;
constexpr size_t WS_PV    = WS_PU + (size_t)16384 * 1536;
constexpr size_t WS_PSC   = WS_PV + (size_t)16384 * 1536;
constexpr size_t WS_BPEP  = WS_PSC + (size_t)2 * 16384 * 4;
constexpr size_t WS_H     = WS_BPEP + (size_t)32 * 2 * 256 * 4;
constexpr size_t WS_US    = WS_H + (size_t)16384 * 2048 * 2;
constexpr size_t WS_Q     = WS_US + (size_t)16384 * 1024 * 2;
constexpr size_t WS_QP    = WS_US;
constexpr size_t WS_KROW  = WS_Q + (size_t)16384 * 1024 * 2;
constexpr size_t WS_VROW  = WS_KROW + (size_t)6 * 16384 * 128 * 2;
constexpr size_t WS_VT    = WS_VROW + (size_t)2 * 16384 * 128 * 2 + 8192;
constexpr size_t WS_GATE  = WS_VT + (size_t)4 * 128 * 16384 * 2;
constexpr size_t WS_SLAB  = WS_GATE + (size_t)16384 * 24 * 4;
constexpr size_t WS_KC    = WS_SLAB + (size_t)2 * 4 * 2048 * 256 * 4;
constexpr size_t WS_VCT   = WS_KC + (size_t)2 * 1024 * 128 * 2;
constexpr size_t WS_Z     = WS_VCT + (size_t)2 * 128 * 1024 * 2;
constexpr size_t WS_YSSM  = WS_Z + (size_t)16384 * 1024 * 2;
constexpr size_t WS_YATT  = WS_YSSM + (size_t)16384 * 1024 * 2;
constexpr size_t WS_END   = WS_YATT + (size_t)16384 * 1024 * 2;
static_assert(WS_END < (size_t)530 * 1024 * 1024, "workspace map too large");

struct Args { const float* in[33]; float* out; unsigned char* ws; int ph_lo, ph_hi; };

__device__ __forceinline__ unsigned cvt_pk_bf16(float lo, float hi) { bfv2 v; v[0] = (__bf16)lo; v[1] = (__bf16)hi; return __builtin_bit_cast(unsigned, v); }
__device__ __forceinline__ bf16_t f2bf(float f) { return (bf16_t)(cvt_pk_bf16(f, 0.f) & 0xffffu); }
__device__ __forceinline__ float bf2f(unsigned b) { return __uint_as_float(b << 16); }
__device__ __forceinline__ float bflo(unsigned w) { return __uint_as_float(w << 16); }
__device__ __forceinline__ float bfhi(unsigned w) { return __uint_as_float(w & 0xffff0000u); }
__device__ __forceinline__ float fexp2(float x) { return __builtin_amdgcn_exp2f(x); }
__device__ __forceinline__ float frcp(float x) { return __builtin_amdgcn_rcpf(x); }
__device__ __forceinline__ float sigmoidf_(float x) { return frcp(1.f + fexp2(-LOG2E * x)); }
__device__ __forceinline__ float gelu_tanh(float x) {
    const float u = x * (1.f + 0.044715f * x * x);
    return x * frcp(1.f + fexp2(-2.f * 0.7978845608028654f * LOG2E * u));
}
__device__ __forceinline__ float shfl_xor_f(float v, int m) { return __shfl_xor(v, m, 64); }
__device__ __forceinline__ float wave_sum(float v) {
#pragma unroll
    for (int m = 32; m >= 1; m >>= 1) v += __shfl_xor(v, m, 64);
    return v;
}
__device__ __forceinline__ float wave_max(float v) {
#pragma unroll
    for (int m = 32; m >= 1; m >>= 1) v = fmaxf(v, __shfl_xor(v, m, 64));
    return v;
}
template <int CTRL> __device__ __forceinline__ float dpp_f(float x) { return __int_as_float(__builtin_amdgcn_update_dpp(0, __float_as_int(x), CTRL, 0xf, 0xf, false)); }
__device__ __forceinline__ float wave_max_bcast(float v) {
    v = fmaxf(v, dpp_f<0xB1>(v)); v = fmaxf(v, dpp_f<0x4E>(v)); v = fmaxf(v, dpp_f<0x141>(v)); v = fmaxf(v, dpp_f<0x140>(v));
    v = fmaxf(v, __int_as_float(__builtin_amdgcn_update_dpp(__float_as_int(v), __float_as_int(v), 0x142, 0xa, 0xf, false)));
    v = fmaxf(v, __int_as_float(__builtin_amdgcn_update_dpp(__float_as_int(v), __float_as_int(v), 0x143, 0xc, 0xf, false)));
    return __int_as_float(__builtin_amdgcn_readlane(__float_as_int(v), 63));
}
__device__ __forceinline__ float quad_sum(float x) { x += dpp_f<0xB1>(x); x += dpp_f<0x4E>(x); return x; }
__device__ __forceinline__ f32x4 mfma16(bf16x8 a, bf16x8 b, f32x4 c) { return __builtin_amdgcn_mfma_f32_16x16x32_bf16(a, b, c, 0, 0, 0); }
__device__ __forceinline__ f32x16 mfma32(bf16x8 a, bf16x8 b, f32x16 c) { return __builtin_amdgcn_mfma_f32_32x32x16_bf16(a, b, c, 0, 0, 0); }
#define XB_TMO      128
#define XB_XCNT(j)  (256  + 64 * (j))
#define XB_XSUB(j)  (1280 + 64 * (j))
#define XB_XGEN(j)  (2304 + 64 * (j))
#define XB_TOP      3328
#define XB_TOPGEN   3392
#define XCD_BAR_WORDS 3456
#define XB_SPIN_CAP (1u << 18)

__device__ __forceinline__ unsigned xb_ld(unsigned* p)              { return __hip_atomic_load(p, __ATOMIC_RELAXED, __HIP_MEMORY_SCOPE_AGENT); }
__device__ __forceinline__ unsigned xb_add(unsigned* p, unsigned v) { return __hip_atomic_fetch_add(p, v, __ATOMIC_RELAXED, __HIP_MEMORY_SCOPE_AGENT); }
__device__ __forceinline__ unsigned xb_xcc_id() { return (unsigned)__builtin_amdgcn_s_getreg((3 << 11) | 20) & 0xFu; }
#define XB_SPIN(cond, bar) do { unsigned _sp = 0; while (cond) { __builtin_amdgcn_s_sleep(1); \
    if ((++_sp & 255u) == 0u) { if (xb_ld(&(bar)[XB_TMO])) break; if (_sp > XB_SPIN_CAP) { atomicAdd(&(bar)[XB_TMO], 1u); break; } } } } while (0)

struct XcdBarrier {
    unsigned* bar; unsigned x;
    volatile LAS unsigned* st;
};
__device__ __forceinline__ XcdBarrier xcd_barrier_post(unsigned* bar, volatile LAS unsigned* st) {
    XcdBarrier b; b.bar = bar; b.x = xb_xcc_id(); b.st = st;
    if (threadIdx.x == 0) (void)xb_add(&bar[XB_XCNT(b.x)], 1u);
    return b;
}
__device__ __forceinline__ void xcd_barrier_complete(unsigned* bar, unsigned x, unsigned& nloc, unsigned& nx) {
    const unsigned G = gridDim.x * gridDim.y * gridDim.z;
    unsigned sum, cnt, mine, sp = 0u;
    for (;;) {
        sum = 0u; cnt = 0u; mine = 0u;
#pragma unroll
        for (unsigned j = 0; j < 16; ++j) { const unsigned c = xb_ld(&bar[XB_XCNT(j)]); sum += c; cnt += (c > 0u) ? 1u : 0u; mine = (j == x) ? c : mine; }
        if (sum == G) break;
        __builtin_amdgcn_s_sleep(1);
        if ((++sp & 255u) == 0u) { if (xb_ld(&bar[XB_TMO])) break; if (sp > XB_SPIN_CAP) { atomicAdd(&bar[XB_TMO], 1u); break; } }
    }
    nloc = mine > 0u ? mine : 1u; nx = cnt > 0u ? cnt : 1u;
}
__device__ __forceinline__ void xcd_barrier(const XcdBarrier& b) {
    asm volatile("s_waitcnt vmcnt(0)" ::: "memory");
    __syncthreads();
    if (threadIdx.x == 0) {
        unsigned* bar = b.bar;
        __builtin_amdgcn_s_waitcnt(0);
        unsigned nloc = b.st[0], nx = b.st[1];
        if (nloc == 0u) { xcd_barrier_complete(bar, b.x, nloc, nx); b.st[0] = nloc; b.st[1] = nx; }
        const unsigned old = xb_add(&bar[XB_XSUB(b.x)], 1u);
        const unsigned gen = old / nloc;
        if (old + 1u == (gen + 1u) * nloc) {
            __builtin_amdgcn_fence(__ATOMIC_RELEASE, "agent");
            asm volatile("s_waitcnt vmcnt(0)" ::: "memory");
            const unsigned og = xb_add(&bar[XB_TOP], 1u);
            const unsigned tg = og / nx;
            if (og + 1u == (tg + 1u) * nx) xb_add(&bar[XB_TOPGEN], 1u);
            else XB_SPIN(xb_ld(&bar[XB_TOPGEN]) == tg, bar);
            __builtin_amdgcn_fence(__ATOMIC_ACQUIRE, "agent");
            xb_add(&bar[XB_XGEN(b.x)], 1u);
            asm volatile("s_waitcnt vmcnt(0)" ::: "memory");
        } else {
            XB_SPIN(xb_ld(&bar[XB_XGEN(b.x)]) == gen, bar);
            __builtin_amdgcn_fence(__ATOMIC_ACQUIRE, "agent");
            asm volatile("s_waitcnt vmcnt(0)" ::: "memory");
        }
    }
    __syncthreads();
}

namespace pg8 {
constexpr int BM = 256, BK = 64, HALF = 128, HTB = HALF * BK * 2, STAGE_BYTES = 8 * HTB, NXCD = 8, WGM = 8;
__host__ __device__ __forceinline__ int lds_byte(int r, int c) { const int st = (r >> 4) * 2 + (c >> 5), rr = r & 15, cc = c & 31, ob = rr * 64 + cc * 2; return st * 1024 + (ob ^ (((ob >> 9) & 1) << 5)); }
__host__ __device__ __forceinline__ void stage_rc(int b, int& R, int& C) { const int st = b / 1024, sb = b % 1024, swz = sb ^ (((sb >> 9) & 1) << 5); R = (st >> 1) * 16 + swz / 64; C = (st & 1) * 32 + (swz % 64) / 2; }
__host__ __device__ __forceinline__ int perm32(int rho) { const int n = rho >> 4, i = rho & 15; return 8 * (i >> 2) + 4 * n + (i & 3); }

struct Unit { int pm, pn, z; };
struct StaticOrder {
    const bf16_t* A; const bf16_t* Bt; int lda, ldb, K;
    int nM, nN, nwg, G, c;
    __device__ void init(const bf16_t* A_, const bf16_t* Bt_, int lda_, int ldb_, int K_, int M, int N, int G_, int c_) { A = A_; Bt = Bt_; lda = lda_; ldb = ldb_; K = K_; nM = M / BM; nN = N / BM; nwg = nM * nN; G = G_; c = c_; }
    __device__ bool next(int i, Unit& u) const {
        const long Lx = (long)i * G + c; if (Lx >= nwg) return false;
        int wgid = (int)Lx; { const int q = nwg / NXCD, r = nwg % NXCD, xcd = wgid % NXCD, off = wgid / NXCD; wgid = (xcd < r ? xcd * (q + 1) : r * (q + 1) + (xcd - r) * q) + off; }
        const int nig = WGM * nN, gid = wgid / nig, fm = gid * WGM, gsz = (nM - fm) < WGM ? (nM - fm) : WGM;
        u.pm = fm + ((wgid % nig) % gsz); u.pn = (wgid % nig) / gsz; u.z = 0; return true;
    }
    __device__ __forceinline__ const char* a_base(const Unit& u) const { return (const char*)(A + (size_t)u.pm * BM * lda); }
    __device__ __forceinline__ const char* b_base(const Unit& u) const { return (const char*)(Bt + (size_t)u.pn * BM * ldb); }
};

template <class Epi, class Sched>
__device__ __forceinline__ void gemm_phase(LAS unsigned char* lds, const Sched& S, const Epi& E) {
    const int tid = threadIdx.x, wid = __builtin_amdgcn_readfirstlane(tid >> 6), lane = tid & 63, wr = wid >> 2, wc = wid & 3, fr = lane & 15, fq = lane >> 4;
    const int K = S.K, nt = K / BK, lda = S.lda, ldb = S.ldb;
    unsigned voffA[2], voffB[2];
#pragma unroll
    for (int i = 0; i < 2; ++i) { int R, C; stage_rc(tid * 16 + i * 8192, R, C); const int Rb = Epi::PERM ? ((R & ~31) + perm32(R & 31)) : R;
        voffA[i] = (unsigned)(R * lda + C) * 2u; voffB[i] = (unsigned)(Rb * ldb + C) * 2u; }
    const size_t kstep = (size_t)(BK * 2);
    const size_t hstepA = (size_t)HALF * lda * 2, hstepB = (size_t)HALF * ldb * 2;
    const unsigned ldsw = (unsigned)wid * 1024u;
    const int aoff = lds_byte(wr * 64 + fr, fq * 8), boff = lds_byte(wc * 32 + fr, fq * 8);
#define PG8_SA(b, h) (((b) * 2 + (h)) * HTB)
#define PG8_SB(b, h) ((4 + (b) * 2 + (h)) * HTB)
#define PG8_STAGE(bufoff, gbase, voff) do { _Pragma("unroll") for (int _i = 0; _i < 2; ++_i) \
        __builtin_amdgcn_global_load_lds((const unsigned*)((const char*)(gbase) + (voff)[_i]), (LAS unsigned*)(lds + (bufoff) + ldsw + _i * 8192), 16, 0, 0); } while (0)
#define PG8_LDA(dst, b, h) do { _Pragma("unroll") for (int m = 0; m < 4; ++m) _Pragma("unroll") for (int k = 0; k < 2; ++k) dst[m][k] = *(const LAS bf16x8*)(lds + PG8_SA(b, h) + aoff + m * 2048 + k * 1024); } while (0)
#define PG8_LDB(dst, b, h) do { _Pragma("unroll") for (int n = 0; n < 2; ++n) _Pragma("unroll") for (int k = 0; k < 2; ++k) dst[n][k] = *(const LAS bf16x8*)(lds + PG8_SB(b, h) + boff + n * 2048 + k * 1024); } while (0)
#define PG8_MMA(ai, bj, At, Bt) do { __builtin_amdgcn_s_setprio(1); _Pragma("unroll") for (int m = 0; m < 4; ++m) _Pragma("unroll") for (int n = 0; n < 2; ++n) _Pragma("unroll") for (int k = 0; k < 2; ++k) \
        acc[ai][bj][m][n] = __builtin_amdgcn_mfma_f32_16x16x32_bf16(Bt[n][k], At[m][k], acc[ai][bj][m][n], 0, 0, 0); __builtin_amdgcn_s_setprio(0); } while (0)
#define PG8_WAIT_V(n) asm volatile("s_waitcnt vmcnt(" #n ")" ::: "memory")
#define PG8_WAIT_L(n) asm volatile("s_waitcnt lgkmcnt(" #n ")" ::: "memory")
#define PG8_BAR __builtin_amdgcn_s_barrier()
#define PG8_SCHED __builtin_amdgcn_sched_barrier(0)
    Unit cur, nxt; int ui = 0;
    if (!S.next(0, cur)) return;
    f32x4 acc[2][2][4][2];
#pragma unroll
    for (int a = 0; a < 2; ++a)
#pragma unroll
        for (int b = 0; b < 2; ++b)
#pragma unroll
            for (int m = 0; m < 4; ++m)
#pragma unroll
                for (int n = 0; n < 2; ++n) acc[a][b][m][n] = (f32x4){0.f, 0.f, 0.f, 0.f};
    bf16x8 At[4][2], B0[2][2], B1[2][2];
    const char* cA = S.a_base(cur); const char* cB = S.b_base(cur);
    PG8_STAGE(PG8_SB(0, 0), cB, voffB); PG8_STAGE(PG8_SA(0, 0), cA, voffA); PG8_STAGE(PG8_SB(0, 1), cB + hstepB, voffB); PG8_STAGE(PG8_SA(0, 1), cA + hstepA, voffA);
    if (wr == 1) PG8_BAR;
    PG8_WAIT_V(4); PG8_BAR;
    PG8_STAGE(PG8_SB(1, 0), cB + kstep, voffB); PG8_STAGE(PG8_SA(1, 0), cA + kstep, voffA); PG8_STAGE(PG8_SB(1, 1), cB + hstepB + kstep, voffB);
    PG8_WAIT_V(6); PG8_BAR;
    for (;;) {
        const bool has_next = S.next(ui + 1, nxt);
        const char* nA = has_next ? S.a_base(nxt) : cA; const char* nB = has_next ? S.b_base(nxt) : cB;
        for (int t = 0; t < nt; t += 2) {
            const bool last = (t == nt - 2);
            const char* a1 = cA + (size_t)(t + 1) * kstep;
            const char* a2 = last ? nA : cA + (size_t)(t + 2) * kstep; const char* b2 = last ? nB : cB + (size_t)(t + 2) * kstep;
            const char* a3 = a2 + kstep; const char* b3 = b2 + kstep;
            PG8_LDB(B0, 0, 0); PG8_SCHED; PG8_LDA(At, 0, 0); PG8_STAGE(PG8_SA(1, 1), a1 + hstepA, voffA);
            PG8_WAIT_L(8); PG8_BAR; PG8_WAIT_L(0); PG8_MMA(0, 0, At, B0); PG8_BAR; PG8_SCHED;
            PG8_LDB(B1, 0, 1); PG8_STAGE(PG8_SB(0, 0), b2, voffB);
            PG8_BAR; PG8_WAIT_L(0); PG8_MMA(0, 1, At, B1); PG8_BAR;
            PG8_LDA(At, 0, 1); PG8_STAGE(PG8_SA(0, 0), a2, voffA);
            PG8_BAR; PG8_WAIT_L(0); PG8_MMA(1, 0, At, B0); PG8_BAR; PG8_SCHED;
            PG8_STAGE(PG8_SB(0, 1), b2 + hstepB, voffB);
            PG8_WAIT_V(6); PG8_BAR; PG8_MMA(1, 1, At, B1); PG8_BAR;
            PG8_LDB(B0, 1, 0); PG8_SCHED; PG8_LDA(At, 1, 0); PG8_STAGE(PG8_SA(0, 1), a2 + hstepA, voffA);
            PG8_WAIT_L(8); PG8_BAR; PG8_WAIT_L(0); PG8_MMA(0, 0, At, B0); PG8_BAR; PG8_SCHED;
            PG8_LDB(B1, 1, 1); PG8_STAGE(PG8_SB(1, 0), b3, voffB);
            PG8_BAR; PG8_WAIT_L(0); PG8_MMA(0, 1, At, B1); PG8_BAR;
            PG8_LDA(At, 1, 1); PG8_STAGE(PG8_SA(1, 0), a3, voffA);
            PG8_BAR; PG8_WAIT_L(0); PG8_MMA(1, 0, At, B0); PG8_BAR; PG8_SCHED;
            PG8_STAGE(PG8_SB(1, 1), b3 + hstepB, voffB);
            PG8_WAIT_V(6); PG8_BAR; PG8_MMA(1, 1, At, B1); PG8_BAR;
        }
        E(acc, cur, wr, wc, fr, fq);
        if (!has_next) break;
#pragma unroll
        for (int a = 0; a < 2; ++a)
#pragma unroll
            for (int b = 0; b < 2; ++b)
#pragma unroll
                for (int m = 0; m < 4; ++m)
#pragma unroll
                    for (int n = 0; n < 2; ++n) acc[a][b][m][n] = (f32x4){0.f, 0.f, 0.f, 0.f};
        cur = nxt; cA = nA; cB = nB; ++ui;
    }
    PG8_WAIT_V(0);
    if (wr == 0) PG8_BAR;
    PG8_BAR;
#undef PG8_SA
#undef PG8_SB
#undef PG8_STAGE
#undef PG8_LDA
#undef PG8_LDB
#undef PG8_MMA
#undef PG8_WAIT_V
#undef PG8_WAIT_L
#undef PG8_BAR
#undef PG8_SCHED
}
}
using pg8::Unit;
__device__ __forceinline__ u32x4 pack8(const f32x4& v0, const f32x4& v1) {
    u32x4 o; o[0] = cvt_pk_bf16(v0[0], v0[1]); o[1] = cvt_pk_bf16(v0[2], v0[3]); o[2] = cvt_pk_bf16(v1[0], v1[1]); o[3] = cvt_pk_bf16(v1[2], v1[3]); return o;
}
struct EpiWin {
    static constexpr bool PERM = true;
    bf16_t* US; bf16_t* Q; bf16_t* KROW; bf16_t* VROW; bf16_t* VT; float* GATE;
    __device__ __forceinline__ void operator()(const f32x4 (&acc)[2][2][4][2], const Unit& u, int wr, int wc, int fr, int fq) const {
        const int row0 = u.pm * 256 + wr * 64 + fr; const int pn = u.pn;
#pragma unroll
        for (int ai = 0; ai < 2; ++ai)
#pragma unroll
            for (int m = 0; m < 4; ++m) {
                const int row = row0 + ai * 128 + m * 16;
#pragma unroll
                for (int bj = 0; bj < 2; ++bj) {
                    const f32x4 v0 = acc[ai][bj][m][0], v1 = acc[ai][bj][m][1];
                    const int cin = bj * 128 + wc * 32 + 8 * fq;
                    if (pn < 4) { *(u32x4*)(US + (size_t)row * 1024 + pn * 256 + cin) = pack8(v0, v1); }
                    else if (pn < 8) { *(u32x4*)(Q + (size_t)row * 1024 + (pn - 4) * 256 + cin) = pack8(v0 * QSCALE, v1 * QSCALE); }
                    else if (pn < 14) {
                        const int kvi = pn - 8, branch = kvi >> 1, kvsel = kvi & 1, g = bj, d0 = wc * 32 + 8 * fq;
                        if (kvsel == 0) { *(u32x4*)(KROW + ((size_t)(branch * 2 + g) * L_ + row) * 128 + d0) = pack8(v0, v1); }
                        else if (branch == 0) { *(u32x4*)(VROW + ((size_t)g * L_ + row) * 128 + d0) = pack8(v0, v1); }
                        else {
                            bf16_t* vt = VT + ((size_t)((branch - 1) * 2 + g) * 128 + d0) * L_ + ((row & ~12) | ((row & 4) << 1) | ((row & 8) >> 1));
#pragma unroll
                            for (int e = 0; e < 4; ++e) { vt[(size_t)e * L_] = f2bf(v0[e]); vt[(size_t)(e + 4) * L_] = f2bf(v1[e]); }
                        }
                    } else {
                        if (cin < 24) {
                            float* gp = GATE + (size_t)row * 24 + cin;
                            f32x4 s0, s1;
#pragma unroll
                            for (int e = 0; e < 4; ++e) { s0[e] = sigmoidf_(v0[e]); s1[e] = sigmoidf_(v1[e]); }
                            *(f32x4*)gp = s0; *(f32x4*)(gp + 4) = s1;
                        }
                    }
                }
            }
    }
};
struct EpiGlu {
    static constexpr bool PERM = true;
    const bf16_t* Z; const float* bglu; bf16_t* Y;
    __device__ __forceinline__ void operator()(const f32x4 (&acc)[2][2][4][2], const Unit& u, int wr, int wc, int fr, int fq) const {
        const int row0 = u.pm * 256 + wr * 64 + fr;
#pragma unroll
        for (int bj = 0; bj < 2; ++bj) {
            const int col = u.pn * 256 + bj * 128 + wc * 32 + 8 * fq;
            const f32x4 b0 = *(const f32x4*)(bglu + col), b1 = *(const f32x4*)(bglu + col + 4);
#pragma unroll
            for (int ai = 0; ai < 2; ++ai)
#pragma unroll
                for (int m = 0; m < 4; ++m) {
                    const int row = row0 + ai * 128 + m * 16;
                    const u32x4 zz = *(const u32x4*)(Z + (size_t)row * 1024 + col);
                    const f32x4 v0 = acc[ai][bj][m][0] + b0, v1 = acc[ai][bj][m][1] + b1;
                    f32x4 o0, o1;
                    o0[0] = bflo(zz[0]) * sigmoidf_(v0[0]); o0[1] = bfhi(zz[0]) * sigmoidf_(v0[1]); o0[2] = bflo(zz[1]) * sigmoidf_(v0[2]); o0[3] = bfhi(zz[1]) * sigmoidf_(v0[3]);
                    o1[0] = bflo(zz[2]) * sigmoidf_(v1[0]); o1[1] = bfhi(zz[2]) * sigmoidf_(v1[1]); o1[2] = bflo(zz[3]) * sigmoidf_(v1[2]); o1[3] = bfhi(zz[3]) * sigmoidf_(v1[3]);
                    *(u32x4*)(Y + (size_t)row * 1024 + col) = pack8(o0, o1);
                }
        }
    }
};
struct EpiWout {
    static constexpr bool PERM = false;
    const float* X; const float* g1; float* X1;
    __device__ __forceinline__ void operator()(const f32x4 (&acc)[2][2][4][2], const Unit& u, int wr, int wc, int fr, int fq) const {
        const int row0 = u.pm * 256 + wr * 64 + fr, col0 = u.pn * 256 + wc * 32 + 4 * fq;
#pragma unroll
        for (int bj = 0; bj < 2; ++bj)
#pragma unroll
            for (int n = 0; n < 2; ++n) {
                const int col = col0 + bj * 128 + n * 16;
                const f32x4 gv = *(const f32x4*)(g1 + col);
#pragma unroll
                for (int ai = 0; ai < 2; ++ai)
#pragma unroll
                    for (int m = 0; m < 4; ++m) {
                        const size_t off = (size_t)(row0 + ai * 128 + m * 16) * 2048 + col;
                        *(f32x4*)(X1 + off) = *(const f32x4*)(X + off) + gv * acc[ai][bj][m][n];
                    }
            }
    }
};
struct EpiBf16 {
    static constexpr bool PERM = true;
    bf16_t* O; int ldc;
    __device__ __forceinline__ void operator()(const f32x4 (&acc)[2][2][4][2], const Unit& u, int wr, int wc, int fr, int fq) const {
        const int row0 = u.pm * 256 + wr * 64 + fr, col0 = u.pn * 256 + wc * 32 + 8 * fq;
#pragma unroll
        for (int ai = 0; ai < 2; ++ai)
#pragma unroll
            for (int m = 0; m < 4; ++m)
#pragma unroll
                for (int bj = 0; bj < 2; ++bj)
                    *(u32x4*)(O + (size_t)(row0 + ai * 128 + m * 16) * ldc + col0 + bj * 128) = pack8(acc[ai][bj][m][0], acc[ai][bj][m][1]);
    }
};
struct EpiSlab {
    static constexpr bool PERM = false;
    float* SL;
    __device__ __forceinline__ void operator()(const f32x4 (&acc)[2][2][4][2], const Unit& u, int wr, int wc, int fr, int fq) const {
        float* base = SL + (size_t)u.z * 2048 * 256;
        const int row0 = u.pm * 256 + wr * 64 + fr, col0 = wc * 32 + 4 * fq;
#pragma unroll
        for (int ai = 0; ai < 2; ++ai)
#pragma unroll
            for (int m = 0; m < 4; ++m)
#pragma unroll
                for (int bj = 0; bj < 2; ++bj)
#pragma unroll
                    for (int n = 0; n < 2; ++n)
                        *(f32x4*)(base + (size_t)(row0 + ai * 128 + m * 16) * 256 + col0 + bj * 128 + n * 16) = acc[ai][bj][m][n];
    }
};
struct CmpOrder {
    const bf16_t* KROW; const bf16_t* VROW; const bf16_t* W1; int lda, ldb, K; int G, c;
    __device__ bool next(int i, Unit& u) const {
        const int x = i * G + c; if (x >= 64) return false;
        const int kvsel = x >> 5, pm = (x & 31) >> 2, ks = x & 3; u.pm = pm; u.pn = 0; u.z = kvsel * 4 + ks; return true;
    }
    __device__ __forceinline__ const char* a_base(const Unit& u) const { return (const char*)(((u.z >> 2) ? VROW : KROW) + (size_t)u.pm * 256 * 2048 + (u.z & 3) * 1024); }
    __device__ __forceinline__ const char* b_base(const Unit& u) const { return (const char*)(W1 + (size_t)(u.z >> 2) * 256 * 4096 + (u.z & 3) * 1024); }
};
struct Ctx { int bid, nb, tid, wave, lane; LAS unsigned char* lds; };

__device__ __forceinline__ void p0_cond(const Args& a, const Ctx& c) {
    const float* cv = a.in[1]; const float* w = a.in[2]; float* condp = (float*)(a.ws + WS_CONDP);
    for (int u = c.bid * 8 + c.wave; u < 1536; u += c.nb * 8) {
        const int cc = u % 48, kc = u / 48;
        const float* wp = w + (size_t)(kc * 64) * NADA + cc * 256 + c.lane * 4;
        f32x4 acc = {0.f, 0.f, 0.f, 0.f};
#pragma unroll 16
        for (int k = 0; k < 64; ++k) { const float x = cv[kc * 64 + k]; const float s = x / (1.f + __expf(-x)); acc += s * *(const f32x4*)(wp + (size_t)k * NADA); }
        *(f32x4*)(condp + (size_t)kc * NADA + cc * 256 + c.lane * 4) = acc;
    }
}
__device__ __forceinline__ void conv_T(const float* src, int K, int N, bf16_t* dst, int Npad, const Ctx& c) {
    LAS float* tile = (LAS float*)c.lds;
    const int nkt = K / 64, ntiles = nkt * (Npad / 64);
    const int r = c.tid >> 4, c4 = c.tid & 15;
    f32x4 v[2];
#define CONVT_LD(tix_) do { const int nt_ = (tix_) / nkt, kt_ = (tix_) % nkt, n_ = nt_ * 64 + 4 * c4; _Pragma("unroll") for (int i = 0; i < 2; ++i) { const int k_ = kt_ * 64 + r + 32 * i; v[i] = (f32x4){0.f, 0.f, 0.f, 0.f}; if (n_ < N) v[i] = *(const f32x4*)(src + (size_t)k_ * N + n_); } } while (0)
    if (c.bid < ntiles) CONVT_LD(c.bid);
    for (int tix = c.bid; tix < ntiles; tix += c.nb) {
        const int nt = tix / nkt, kt = tix % nkt;
#pragma unroll
        for (int i = 0; i < 2; ++i) { LAS float* tp = tile + (r + 32 * i) * 65 + 4 * c4; tp[0] = v[i][0]; tp[1] = v[i][1]; tp[2] = v[i][2]; tp[3] = v[i][3]; }
        __syncthreads();
        if (tix + c.nb < ntiles) CONVT_LD(tix + c.nb);
        { const int n = c.tid >> 3, kq = c.tid & 7; float w[8];
#pragma unroll
          for (int j = 0; j < 8; ++j) w[j] = tile[(kq * 8 + j) * 65 + n];
          u32x4 o; o[0] = cvt_pk_bf16(w[0], w[1]); o[1] = cvt_pk_bf16(w[2], w[3]); o[2] = cvt_pk_bf16(w[4], w[5]); o[3] = cvt_pk_bf16(w[6], w[7]);
          *(u32x4*)(dst + (size_t)(nt * 64 + n) * K + kt * 64 + kq * 8) = o; }
        __syncthreads();
    }
#undef CONVT_LD
}
__device__ __forceinline__ void conv_fp6rows(const float* src, unsigned char* dst6, float* scl, int rows, const Ctx& c) {
    for (int row = c.bid * 8 + c.wave; row < rows; row += c.nb * 8) {
        const float* sp = src + (size_t)row * 2048 + c.lane * 32;
        f32x4 v[8]; float mx = 0.f;
#pragma unroll
        for (int j = 0; j < 8; ++j) { v[j] = *(const f32x4*)(sp + j * 4); mx = fmaxf(mx, fmaxf(fmaxf(fabsf(v[j][0]), fabsf(v[j][1])), fmaxf(fabsf(v[j][2]), fabsf(v[j][3])))); }
        mx = wave_max(mx);
        const float s = mx > 0.f ? 7.5f / mx : 1.f;
        if (c.lane == 0) scl[row] = mx > 0.f ? mx * (1.f / 7.5f) : 1.f;
        f32x16 x, y;
#pragma unroll
        for (int j = 0; j < 4; ++j)
#pragma unroll
            for (int e = 0; e < 4; ++e) { const int i = j * 4 + e;
                x[i] = v[(2 * i) >> 2][(2 * i) & 3] * s; y[i] = v[(2 * i + 1) >> 2][(2 * i + 1) & 3] * s; }
        const u32x6 pk = __builtin_amdgcn_cvt_scalef32_2xpk16_fp6_f32(x, y, 1.0f);
        unsigned char* dp = dst6 + (size_t)row * 1536 + c.lane * 24;
        *(u32x2*)dp = (u32x2){pk[0], pk[1]}; *(u32x2*)(dp + 8) = (u32x2){pk[2], pk[3]}; *(u32x2*)(dp + 16) = (u32x2){pk[4], pk[5]};
    }
}
__device__ __forceinline__ void conv_E(const float* src, bf16_t* dst, size_t n8, const Ctx& c) {
    const size_t stride = (size_t)c.nb * NTHREADS;
    for (size_t i = (size_t)c.bid * NTHREADS + c.tid; i < n8; i += stride) {
        const f32x4 x = *(const f32x4*)(src + i * 8), y = *(const f32x4*)(src + i * 8 + 4);
        *(u32x4*)(dst + i * 8) = pack8(x, y);
    }
}
__device__ __forceinline__ int t5_bucket(int n) {
    if (n < 16) return n;
    const float scaled = logf((float)n / 16.f) / logf(64.f);
    const int large = 16 + (int)(scaled * 16.f);
    return large < 31 ? large : 31;
}
__device__ __forceinline__ void p0_tb(const Args& a, const Ctx& c) {
    float* tb = (float*)(a.ws + WS_TB); const float* rb = a.in[26];
    for (int i = c.bid * NTHREADS + c.tid; i < 8 * TBN; i += c.nb * NTHREADS) { const int head = i / TBN, dist = i % TBN; tb[i] = rb[t5_bucket(dist) * 8 + head] * LOG2E; }
}
__device__ __forceinline__ void p0_bpe(const Args& a, const Ctx& c, int part) {
    const int n = c.tid & 255, kv = c.tid >> 8;
    const float* pe = a.in[kv ? 23 : 20]; const float* w1 = a.in[kv ? 24 : 21]; float* bpep = (float*)(a.ws + WS_BPEP);
    float s = 0.f;
#pragma unroll 16
    for (int k = part * 128; k < part * 128 + 128; ++k) s += pe[k] * w1[(size_t)k * 256 + n];
    bpep[(part * 2 + kv) * 256 + n] = s;
}
__device__ __forceinline__ void p0_s5(const Args& a, const Ctx& c, int g) {
    LAS float* ar = (LAS float*)c.lds;
    LAS float* ai = ar + 17 * 64;
    LAS float* bbr = ai + 17 * 64;
    LAS float* bbi = bbr + 1024;
    LAS float* cr = bbi + 1024;
    LAS float* ci = cr + 1024;
    LAS float* kd = ci + 1024;
    const int tid = c.tid;
    if (tid < 64) {
        const int p = tid; const float dt = expf(a.in[12][g]); const float lr = a.in[10][g * 64 + p], li = a.in[11][g * 64 + p];
        for (int d = 0; d <= 16; ++d) { const float mag = expf(lr * dt * (float)d), ang = li * dt * (float)d; ar[d * 64 + p] = mag * cosf(ang); ai[d * 64 + p] = mag * sinf(ang); }
        const float nr = ar[64 + p] - 1.f, ni = ai[64 + p], den = lr * lr + li * li;
        const float wre = (nr * lr + ni * li) / den, wim = (ni * lr - nr * li) / den;
        for (int h = 0; h < 16; ++h) { const float br = a.in[13][(g * 64 + p) * 16 + h], bi = a.in[14][(g * 64 + p) * 16 + h]; bbr[p * 16 + h] = wre * br - wim * bi; bbi[p * 16 + h] = wre * bi + wim * br; }
        float* s5p = (float*)(a.ws + WS_S5P);
        float xr = ar[16 * 64 + p], xi = ai[16 * 64 + p];
        s5p[(g * 64 + p) * 2] = xr; s5p[(g * 64 + p) * 2 + 1] = xi;
        for (int s = 0; s < 8; ++s) { const float tr = xr * xr - xi * xi, ti = 2.f * xr * xi; xr = tr; xi = ti; }
        s5p[64 * 64 * 2 + (g * 64 + p) * 2] = xr; s5p[64 * 64 * 2 + (g * 64 + p) * 2 + 1] = xi;
    }
    for (int e = tid; e < 1024; e += NTHREADS) { cr[e] = a.in[15][g * 1024 + e]; ci[e] = a.in[16][g * 1024 + e]; }
    __syncthreads();
    for (int e = tid; e < 4096; e += NTHREADS) {
        const int d = e >> 8, h1 = (e >> 4) & 15, h = e & 15; float s = 0.f;
        for (int p = 0; p < 64; ++p) { const float Cr = cr[h1 * 64 + p], Ci = ci[h1 * 64 + p], Ar = ar[d * 64 + p], Ai = ai[d * 64 + p];
            const float Gr = Cr * Ar - Ci * Ai, Gi = Cr * Ai + Ci * Ar; s += Gr * bbr[p * 16 + h] - Gi * bbi[p * 16 + h]; }
        if (d == 0 && h1 == h) s += a.in[17][g * 16 + h];
        kd[e] = s;
    }
    __syncthreads();
    bf16_t* MT = (bf16_t*)(a.ws + WS_S5MT) + (size_t)g * 65536;
    bf16_t* WE = (bf16_t*)(a.ws + WS_S5WE) + (size_t)g * 32768;
    bf16_t* WC = (bf16_t*)(a.ws + WS_S5WC) + (size_t)g * 32768;
    for (int e = tid; e < 65536; e += NTHREADS) { const int n = e >> 8, k = e & 255, j = n >> 4, h1 = n & 15, i = k >> 4, h = k & 15;
        MT[e] = f2bf(i <= j ? kd[(j - i) * 256 + h1 * 16 + h] : 0.f); }
    for (int e = tid; e < 32768; e += NTHREADS) { const int n = e >> 8, k = e & 255, cc = n >> 6, p = n & 63, i = k >> 4, h = k & 15;
        const float Ar = ar[(15 - i) * 64 + p], Ai = ai[(15 - i) * 64 + p], Br = bbr[p * 16 + h], Bi = bbi[p * 16 + h];
        WE[e] = f2bf(cc ? (Ar * Bi + Ai * Br) : (Ar * Br - Ai * Bi)); }
    for (int e = tid; e < 32768; e += NTHREADS) { const int n = e >> 7, k = e & 127, j = n >> 4, h1 = n & 15, cc = k >> 6, p = k & 63;
        const float Cr = cr[h1 * 64 + p], Ci = ci[h1 * 64 + p], Ar = ar[(j + 1) * 64 + p], Ai = ai[(j + 1) * 64 + p];
        WC[e] = f2bf(cc ? -(Cr * Ai + Ci * Ar) : (Cr * Ar - Ci * Ai)); }
    __syncthreads();
}
__device__ __forceinline__ void p0_prologue(const Args& a, const Ctx& c) {
    for (int g = c.bid; g < 64; g += c.nb) p0_s5(a, c, g);
    for (int u = 0; u < 32; ++u) if (c.bid == (64 + u) % c.nb) p0_bpe(a, c, u);
    p0_tb(a, c);
    p0_cond(a, c);
    conv_T(a.in[6], 2048, DIN, (bf16_t*)(a.ws + WS_WIN), DIN_PAD, c);
    conv_T(a.in[18], 1024, 1024, (bf16_t*)(a.ws + WS_WGLU), 1024, c);
    conv_T(a.in[7], 2048, 2048, (bf16_t*)(a.ws + WS_WOUT), 2048, c);
    conv_T(a.in[27], 2048, 2048, (bf16_t*)(a.ws + WS_WQ), 2048, c);
    conv_T(a.in[21], 4096, 256, (bf16_t*)(a.ws + WS_W1), 256, c);
    conv_T(a.in[24], 4096, 256, (bf16_t*)(a.ws + WS_W1) + 256 * 4096, 256, c);
    conv_T(a.in[22], 256, 128, (bf16_t*)(a.ws + WS_W2), 128, c);
    conv_T(a.in[25], 256, 128, (bf16_t*)(a.ws + WS_W2) + 128 * 256, 128, c);
    conv_E(a.in[28], (bf16_t*)(a.ws + WS_PK), 128 * 128 / 8, c);
    conv_E(a.in[29], (bf16_t*)(a.ws + WS_PK) + 128 * 128, 128 * 128 / 8, c);
    conv_fp6rows(a.in[30], a.ws + WS_PU, (float*)(a.ws + WS_PSC), 16384, c);
    conv_fp6rows(a.in[31], a.ws + WS_PV, (float*)(a.ws + WS_PSC) + 16384, 16384, c);
}

__device__ __forceinline__ void norm_rows(const float* X, bf16_t* O, LAS const float* Ab, LAS const float* Bb, const Ctx& c) {
    for (int t = c.bid * 8 + c.wave; t < L_; t += c.nb * 8) {
        const float* xr = X + (size_t)t * 2048 + c.lane * 4;
        f32x4 v[8]; float ss = 0.f;
#pragma unroll
        for (int j = 0; j < 8; ++j) { v[j] = *(const f32x4*)(xr + j * 256); ss += v[j][0] * v[j][0] + v[j][1] * v[j][1] + v[j][2] * v[j][2] + v[j][3] * v[j][3]; }
        ss = wave_sum(ss);
        const float rstd = rsqrtf(ss * (1.f / 2048.f) + 1e-6f);
#pragma unroll
        for (int j = 0; j < 8; ++j) {
            const int col = j * 256 + c.lane * 4;
            const f32x4 A = *(const LAS f32x4*)(Ab + col), B = *(const LAS f32x4*)(Bb + col);
            const f32x4 o = v[j] * rstd * A + B;
            u32x2 w; w[0] = cvt_pk_bf16(o[0], o[1]); w[1] = cvt_pk_bf16(o[2], o[3]);
            *(u32x2*)(O + (size_t)t * 2048 + col) = w;
        }
    }
}
__device__ __forceinline__ float cond_from_partials(const float* condp, const float* b_ada, int j) {
    float s = b_ada[j];
#pragma unroll 8
    for (int k = 0; k < 32; ++k) s += condp[(size_t)k * NADA + j];
    return s;
}
__device__ __forceinline__ void p1_hnorm(const Args& a, const Ctx& c) {
    const float* condp = (const float*)(a.ws + WS_CONDP); float* cond = (float*)(a.ws + WS_COND);
    for (int j = c.bid * NTHREADS + c.tid; j < NADA; j += c.nb * NTHREADS) cond[j] = cond_from_partials(condp, a.in[3], j);
    LAS float* Ab = (LAS float*)c.lds; LAS float* Bb = Ab + 2048;
    for (int col = c.tid; col < 2048; col += NTHREADS) {
        Ab[col] = a.in[4][col] * (1.f + cond_from_partials(condp, a.in[3], 2048 + col)); Bb[col] = cond_from_partials(condp, a.in[3], col); }
    __syncthreads();
    norm_rows(a.in[0], (bf16_t*)(a.ws + WS_H), Ab, Bb, c);
}
__device__ __forceinline__ void p8_h2norm(const Args& a, const Ctx& c) {
    const float* cond = (const float*)(a.ws + WS_COND);
    LAS float* Ab = (LAS float*)c.lds; LAS float* Bb = Ab + 2048;
    for (int col = c.tid; col < 2048; col += NTHREADS) { Ab[col] = a.in[5][col] * (1.f + cond[4 * 2048 + col]); Bb[col] = cond[3 * 2048 + col]; }
    __syncthreads();
    norm_rows(a.out, (bf16_t*)(a.ws + WS_H), Ab, Bb, c);
}
__device__ __forceinline__ void p6_mixnorm(const Args& a, const Ctx& c) {
    const bf16_t* YS = (const bf16_t*)(a.ws + WS_YSSM); const bf16_t* YA = (const bf16_t*)(a.ws + WS_YATT); bf16_t* O = (bf16_t*)(a.ws + WS_H);
    for (int t = c.bid * 8 + c.wave; t < L_; t += c.nb * 8) {
#pragma unroll
        for (int part = 0; part < 2; ++part) {
            const bf16_t* src = (part ? YA : YS) + (size_t)t * 1024 + c.lane * 8; const float* beta = a.in[part ? 9 : 8];
            u32x4 w[2]; float f[16]; float ss = 0.f;
#pragma unroll
            for (int j = 0; j < 2; ++j) { w[j] = *(const u32x4*)(src + j * 512);
#pragma unroll
                for (int e = 0; e < 4; ++e) { f[j * 8 + 2 * e] = bflo(w[j][e]); f[j * 8 + 2 * e + 1] = bfhi(w[j][e]); } }
#pragma unroll
            for (int e = 0; e < 16; ++e) ss += f[e] * f[e];
            ss = wave_sum(ss);
            const float rstd = rsqrtf(ss * (1.f / 1024.f) + 1e-6f);
#pragma unroll
            for (int j = 0; j < 2; ++j) { const int col = j * 512 + c.lane * 8; const f32x4 b0 = *(const f32x4*)(beta + col), b1 = *(const f32x4*)(beta + col + 4);
                f32x4 o0, o1;
#pragma unroll
                for (int e = 0; e < 4; ++e) { o0[e] = f[j * 8 + e] * rstd * b0[e]; o1[e] = f[j * 8 + 4 + e] * rstd * b1[e]; }
                *(u32x4*)(O + (size_t)t * 2048 + part * 1024 + col) = pack8(o0, o1); }
        }
    }
}
constexpr int S5_US = 0, S5_ES = 33792, S5_SS = 67584;
template <int PASS>
__device__ __forceinline__ void s5_item(const Args& a, const Ctx& c, int g, int seg) {
    LAS unsigned char* lds = c.lds;
    const int tid = c.tid, wave = c.wave, lane = c.lane, r = lane & 15, q = lane >> 4;
    const bf16_t* U = (const bf16_t*)(a.ws + WS_US);
    const bf16_t* MT = (const bf16_t*)(a.ws + WS_S5MT) + (size_t)g * 65536;
    const bf16_t* WE = (const bf16_t*)(a.ws + WS_S5WE) + (size_t)g * 32768;
    const bf16_t* WC = (const bf16_t*)(a.ws + WS_S5WC) + (size_t)g * 32768;
    const float* s5p = (const float*)(a.ws + WS_S5P);
    float* F = (float*)(a.ws + WS_S5F) + (size_t)g * 4 * 128;
    bf16_t* Z = (bf16_t*)(a.ws + WS_Z);
    bf16x8 bE[8];
#pragma unroll
    for (int ks = 0; ks < 8; ++ks) bE[ks] = *(const bf16x8*)(WE + (size_t)(16 * wave + r) * 256 + 32 * ks + 8 * q);
    float sr = 0.f, si = 0.f, a16r = 0.f, a16i = 0.f;
    if (wave == 0) {
        a16r = s5p[(g * 64 + lane) * 2]; a16i = s5p[(g * 64 + lane) * 2 + 1];
        if (PASS == 1) { const float br = s5p[8192 + (g * 64 + lane) * 2], bi = s5p[8192 + (g * 64 + lane) * 2 + 1];
            for (int s = 0; s < seg; ++s) { const float fr_ = F[s * 128 + lane], fi_ = F[s * 128 + 64 + lane]; const float nr = br * sr - bi * si + fr_, ni = br * si + bi * sr + fi_; sr = nr; si = ni; } }
    }
    for (int sb = 0; sb < 4; ++sb) {
        const int tok0 = seg * 4096 + sb * 1024;
#pragma unroll
        for (int i = 0; i < 4; ++i) { const int ch = tid + NTHREADS * i, token = ch >> 1, half = ch & 1;
            const u32x4 v = *(const u32x4*)(U + (size_t)(tok0 + token) * 1024 + g * 16 + half * 8);
            *(LAS u32x4*)(lds + S5_US + (token >> 4) * 528 + ((token & 15) * 16 + half * 8) * 2) = v; }
        __syncthreads();
#pragma unroll
        for (int m = 0; m < 4; ++m) {
            f32x4 acc = {0.f, 0.f, 0.f, 0.f};
#pragma unroll
            for (int ks = 0; ks < 8; ++ks) { const bf16x8 A = *(const LAS bf16x8*)(lds + S5_US + (16 * m + r) * 528 + (32 * ks + 8 * q) * 2); acc = mfma16(A, bE[ks], acc); }
#pragma unroll
            for (int i = 0; i < 4; ++i) *(LAS float*)(lds + S5_ES + ((16 * m + 4 * q + i) * 132 + 16 * wave + r) * 4) = acc[i];
        }
        __syncthreads();
        if (wave == 0) {
            for (int ch = 0; ch < 64; ++ch) {
                const float er = *(const LAS float*)(lds + S5_ES + (ch * 132 + lane) * 4), ei = *(const LAS float*)(lds + S5_ES + (ch * 132 + 64 + lane) * 4);
                if (PASS == 1) { *(LAS bf16_t*)(lds + S5_SS + (ch * 136 + lane) * 2) = f2bf(sr); *(LAS bf16_t*)(lds + S5_SS + (ch * 136 + 64 + lane) * 2) = f2bf(si); }
                const float nr = a16r * sr - a16i * si + er, ni = a16r * si + a16i * sr + ei; sr = nr; si = ni;
            }
        }
        __syncthreads();
        if (PASS == 1) {
#pragma unroll
            for (int nt = 0; nt < 2; ++nt) {
                const int j = 2 * wave + nt;
                f32x4 acc[4];
#pragma unroll
                for (int m = 0; m < 4; ++m) acc[m] = (f32x4){0.f, 0.f, 0.f, 0.f};
                for (int ks = 0; ks <= (j >> 1); ++ks) {
                    const bf16x8 B = *(const bf16x8*)(MT + (size_t)(16 * j + r) * 256 + 32 * ks + 8 * q);
#pragma unroll
                    for (int m = 0; m < 4; ++m) { const bf16x8 A = *(const LAS bf16x8*)(lds + S5_US + (16 * m + r) * 528 + (32 * ks + 8 * q) * 2); acc[m] = mfma16(A, B, acc[m]); }
                }
#pragma unroll
                for (int ks = 0; ks < 4; ++ks) {
                    const bf16x8 B = *(const bf16x8*)(WC + (size_t)(16 * j + r) * 128 + 32 * ks + 8 * q);
#pragma unroll
                    for (int m = 0; m < 4; ++m) { const bf16x8 A = *(const LAS bf16x8*)(lds + S5_SS + (16 * m + r) * 272 + (32 * ks + 8 * q) * 2); acc[m] = mfma16(A, B, acc[m]); }
                }
#pragma unroll
                for (int m = 0; m < 4; ++m)
#pragma unroll
                    for (int i = 0; i < 4; ++i) { const int ch = 16 * m + 4 * q + i; Z[(size_t)(tok0 + 16 * ch + j) * 1024 + g * 16 + r] = f2bf(gelu_tanh(acc[m][i])); }
            }
            __syncthreads();
        }
    }
    if (PASS == 0 && wave == 0) { F[seg * 128 + lane] = sr; F[seg * 128 + 64 + lane] = si; }
}

__device__ __forceinline__ void cmp_finish_item(const Args& a, const Ctx& c, int kvsel, int rt) {
    LAS unsigned char* lds = c.lds;
    const int tid = c.tid, wave = c.wave, lane = c.lane, r = lane & 15, q = lane >> 4;
    const float* SL = (const float*)(a.ws + WS_SLAB) + (size_t)kvsel * 4 * 2048 * 256;
    const float* bpep = (const float*)(a.ws + WS_BPEP) + kvsel * 256;
    const bf16_t* W2 = (const bf16_t*)(a.ws + WS_W2) + kvsel * 128 * 256;
    for (int e = tid; e < 64 * 64; e += NTHREADS) {
        const int row = e >> 6, c4 = (e & 63) * 4;
        f32x4 s = {0.f, 0.f, 0.f, 0.f};
#pragma unroll 8
        for (int pt = 0; pt < 32; ++pt) s += *(const f32x4*)(bpep + pt * 512 + c4);
#pragma unroll
        for (int ks = 0; ks < 4; ++ks) s += *(const f32x4*)(SL + ((size_t)ks * 2048 + rt * 64 + row) * 256 + c4);
        u32x2 w; w[0] = cvt_pk_bf16(gelu_tanh(s[0]), gelu_tanh(s[1])); w[1] = cvt_pk_bf16(gelu_tanh(s[2]), gelu_tanh(s[3]));
        *(LAS u32x2*)(lds + row * 528 + c4 * 2) = w;
    }
    __syncthreads();
    bf16x8 B[8];
#pragma unroll
    for (int ks = 0; ks < 8; ++ks) B[ks] = *(const bf16x8*)(W2 + (size_t)(16 * wave + r) * 256 + 32 * ks + 8 * q);
#pragma unroll
    for (int m = 0; m < 4; ++m) {
        f32x4 acc = {0.f, 0.f, 0.f, 0.f};
#pragma unroll
        for (int ks = 0; ks < 8; ++ks) { const bf16x8 A = *(const LAS bf16x8*)(lds + (16 * m + r) * 528 + (32 * ks + 8 * q) * 2); acc = mfma16(A, B[ks], acc); }
#pragma unroll
        for (int i = 0; i < 4; ++i) {
            const int row = rt * 64 + 16 * m + 4 * q + i, gi = row >> 10, ci = row & 1023, n = 16 * wave + r;
            const bf16_t v = (ci == 1023) ? (bf16_t)0 : f2bf(acc[i]);
            if (kvsel == 0) ((bf16_t*)(a.ws + WS_KC))[((size_t)gi * 1024 + ci) * 128 + n] = v;
            else ((bf16_t*)(a.ws + WS_VCT))[((size_t)gi * 128 + n) * 1024 + ((ci & ~12) | ((ci & 4) << 1) | ((ci & 8) >> 1))] = v;
        }
    }
    __syncthreads();
}
constexpr int AT_IMP = 65536, AT_TB = 131072, AT_BM = 143872, AT_WU = 145920, AT_END = 146176;
__device__ __forceinline__ int kswz(int r) { return ((r & 3) << 2) | ((r >> 2) & 3); }
__host__ __device__ __forceinline__ int vperm(int t) { return (t & ~12) | ((t & 4) << 1) | ((t & 8) >> 1); }
template <int KEYS> __device__ __forceinline__ int vsw(int d) { return KEYS == 128 ? kswz(d) : ((d >> 1) & 7); }
template <int KEYS, bool NEEDV>
__device__ __forceinline__ void stage_dma(const bf16_t* Kt, const bf16_t* Vt, int ldv, LAS unsigned char* kb, LAS unsigned char* vb, int wave, int lane) {
    constexpr int NP = KEYS / 32;
#pragma unroll
    for (int i = 0; i < NP; ++i) { const int pc = NP * wave + i, row = 4 * pc + (lane >> 4), ch = (lane & 15) ^ kswz(row);
        __builtin_amdgcn_global_load_lds((const unsigned*)(Kt + row * 128 + ch * 8), (LAS unsigned*)(kb + pc * 1024), 16, 0, 0); }
    if (NEEDV) {
#pragma unroll
        for (int i = 0; i < NP; ++i) {
            const int pc = NP * wave + i;
            if (KEYS == 128) { const int d = 4 * pc + (lane >> 4), ch = (lane & 15) ^ kswz(d);
                __builtin_amdgcn_global_load_lds((const unsigned*)(Vt + (size_t)d * ldv + 8 * ch), (LAS unsigned*)(vb + pc * 1024), 16, 0, 0); }
            else { const int d = 8 * pc + (lane >> 3), ch = (lane & 7) ^ ((d >> 1) & 7);
                __builtin_amdgcn_global_load_lds((const unsigned*)(Vt + (size_t)d * ldv + 8 * ch), (LAS unsigned*)(vb + pc * 1024), 16, 0, 0); }
        }
    }
}
__device__ __forceinline__ float xhalf_max(float x) { auto rr = __builtin_amdgcn_permlane32_swap(__float_as_uint(x), __float_as_uint(x), false, false); return fmaxf(__uint_as_float(rr[0]), __uint_as_float(rr[1])); }
__device__ __forceinline__ float xhalf_sum(float x) { auto rr = __builtin_amdgcn_permlane32_swap(__float_as_uint(x), __float_as_uint(x), false, false); return __uint_as_float(rr[0]) + __uint_as_float(rr[1]); }
template <int BR>
__device__ __forceinline__ float tile_prep(int MODE, f32x16& S, LAS const float* tb, float cb, int base, bool selbit) {
    float mx = -INFINITY;
    if (MODE == 1) {
#pragma unroll
        for (int r = 0; r < 16; ++r) mx = fmaxf(mx, S[r]);
        mx = (BR == 2 && !selbit) ? -INFINITY : mx + cb;
    } else {
        const bool nomask = (MODE == 2);
        float bv[16];
#pragma unroll
        for (int r = 0; r < 16; ++r) { const int cr = (r & 3) + 8 * (r >> 2); const int dist = (BR <= 1) ? base - 16 * cr : base - cr; bv[r] = tb[min(max(dist, 0), TBN - 1)]; }
        __builtin_amdgcn_sched_barrier(0);
#pragma unroll
        for (int r = 0; r < 16; ++r) {
            const int cr = (r & 3) + 8 * (r >> 2);
            const int dist = (BR <= 1) ? base - 16 * cr : base - cr;
            float v = S[r] + bv[r];
            bool valid;
            if (BR <= 1) valid = dist >= 0; else if (BR == 2) valid = selbit && dist >= 0; else valid = nomask || (unsigned)dist < 512u;
            v = valid ? v : -INFINITY;
            S[r] = v; mx = fmaxf(mx, v);
        }
    }
    return mx;
}
template <int BR, bool PEND>
__device__ __forceinline__ float tile_decide(int MODE, float mx, float cb, bool selbit, f32x16 (&O)[4], float& m, float& l, u32x4& pa, u32x4& pb) {
    if (BR == 1) { const float mu = (m == -INFINITY) ? 0.f : m; return (MODE == 1) ? mu - cb : mu; }
    mx = xhalf_max(mx);
    const float mn = fmaxf(m, mx), mu = (mn == -INFINITY) ? 0.f : mn;
    if (__any(mn > m)) {
        const float alpha = fexp2(m - mu);
        l *= alpha;
        if (BR >= 2) {
#pragma unroll
            for (int dt = 0; dt < 4; ++dt)
#pragma unroll
                for (int r = 0; r < 16; ++r) O[dt][r] *= alpha;
            if (PEND) {
#pragma unroll
                for (int e = 0; e < 4; ++e) { pa[e] = cvt_pk_bf16(bflo(pa[e]) * alpha, bfhi(pa[e]) * alpha); pb[e] = cvt_pk_bf16(bflo(pb[e]) * alpha, bfhi(pb[e]) * alpha); }
            }
        }
    }
    m = mn;
    if (MODE == 1) return (BR == 2 && !selbit) ? INFINITY : mu - cb;
    return mu;
}
template <int BR, int KEYS>
__device__ __forceinline__ void attn_tile(int MODE, LAS const unsigned char* kb, LAS const unsigned char* vb, int cb0, LAS const float* tb, int key0, int t, int lane,
                                          const bf16x8 (&qf)[8], f32x16 (&O)[4], float& m, float& l, float inv_l, bool selbit, LAS float* imp_row) {
    asm volatile("" : "+v"(lane));
    constexpr int ROWB = 2 * KEYS;
    const int r31 = lane & 31, h = lane >> 5;
    const int gh = kswz(r31) ^ h, vh = vsw<KEYS>(r31) ^ h;
    float cb = 0.f;
    if (MODE == 1) cb = tb[TBN - 1];
    const int base0 = (BR <= 1) ? t - 31 - 16 * (key0 + 4 * h) : t - (key0 + 4 * h);
    const int base1 = (BR <= 1) ? base0 - 16 * 32 : base0 - 32;
    LAS const unsigned char* k0 = kb + r31 * 256;
    f32x16 S0, S1;
    bf16x8 kf[8];
#pragma unroll
    for (int ks = 0; ks < 8; ++ks) kf[ks] = *(const LAS bf16x8*)(k0 + 16 * ((2 * ks) ^ gh));
#pragma unroll
    for (int r = 0; r < 16; ++r) { S0[r] = 0.f; S1[r] = 0.f; }
    __builtin_amdgcn_sched_barrier(0);
#pragma unroll
    for (int ks = 0; ks < 8; ++ks) S0 = mfma32(kf[ks], qf[ks], S0);
    __builtin_amdgcn_sched_barrier(0);
#pragma unroll
    for (int ks = 0; ks < 8; ++ks) kf[ks] = *(const LAS bf16x8*)(k0 + 8192 + 16 * ((2 * ks) ^ gh));
    const float mx0 = tile_prep<BR>(MODE, S0, tb, cb, base0, selbit);
    u32x4 pk0a = {0u, 0u, 0u, 0u}, pk0b = {0u, 0u, 0u, 0u}, pk1a, pk1b;
    const float me0 = tile_decide<BR, false>(MODE, mx0, cb, selbit, O, m, l, pk0a, pk0b);
    __builtin_amdgcn_sched_barrier(0);
    {
#pragma unroll
        for (int ks = 0; ks < 8; ++ks) S1 = mfma32(kf[ks], qf[ks], S1);
        float ps = 0.f;
#pragma unroll
        for (int r = 0; r < 16; ++r) { float p = fexp2(S0[r] - me0); if (BR == 1) p *= inv_l; S0[r] = p; ps += p; }
        if (BR != 1) l += ps;
        if (BR >= 1) {
#pragma unroll
            for (int e = 0; e < 4; ++e) { pk0a[e] = cvt_pk_bf16(S0[2 * e], S0[2 * e + 1]); pk0b[e] = cvt_pk_bf16(S0[8 + 2 * e], S0[8 + 2 * e + 1]); }
        }
#pragma unroll
        for (int i = 0; i < 8; ++i) { __builtin_amdgcn_sched_group_barrier(0x008, 1, 0); __builtin_amdgcn_sched_group_barrier(0x002, 8, 0); }
    }
    __builtin_amdgcn_sched_barrier(0);
    if (BR == 1) {
#pragma unroll
        for (int rg = 0; rg < 4; ++rg) {
            float A = 2.f * (S0[4 * rg] + S0[4 * rg + 1] + S0[4 * rg + 2]) + S0[4 * rg + 3], B = S0[4 * rg + 3];
            A = quad_sum(A); B = quad_sum(B);
            const int jj = (key0 >> 2) + 2 * rg + h;
            if ((lane & 3) == 0) { __hip_atomic_fetch_add(imp_row + jj, A, __ATOMIC_RELAXED, __HIP_MEMORY_SCOPE_WORKGROUP);
                if (jj + 1 < 256) __hip_atomic_fetch_add(imp_row + jj + 1, B, __ATOMIC_RELAXED, __HIP_MEMORY_SCOPE_WORKGROUP); }
        }
    }
    bf16x8 av[8];
    if (BR >= 1) {
#pragma unroll
        for (int s = 0; s < 2; ++s)
#pragma unroll
            for (int dt = 0; dt < 4; ++dt) av[s * 4 + dt] = *(const LAS bf16x8*)(vb + (32 * dt + r31) * ROWB + 16 * ((cb0 + 2 * s) ^ vh));
    }
    const float mx1 = tile_prep<BR>(MODE, S1, tb, cb, base1, selbit);
    const float me1 = tile_decide<BR, true>(MODE, mx1, cb, selbit, O, m, l, pk0a, pk0b);
    __builtin_amdgcn_sched_barrier(0);
    {
        if (BR >= 1) {
#pragma unroll
            for (int dt = 0; dt < 4; ++dt) O[dt] = mfma32(av[dt], __builtin_bit_cast(bf16x8, pk0a), O[dt]);
#pragma unroll
            for (int dt = 0; dt < 4; ++dt) O[dt] = mfma32(av[4 + dt], __builtin_bit_cast(bf16x8, pk0b), O[dt]);
        }
        float ps = 0.f;
#pragma unroll
        for (int r = 0; r < 16; ++r) { float p = fexp2(S1[r] - me1); if (BR == 1) p *= inv_l; S1[r] = p; ps += p; }
        if (BR != 1) l += ps;
        if (BR >= 1) {
#pragma unroll
            for (int e = 0; e < 4; ++e) { pk1a[e] = cvt_pk_bf16(S1[2 * e], S1[2 * e + 1]); pk1b[e] = cvt_pk_bf16(S1[8 + 2 * e], S1[8 + 2 * e + 1]); }
#pragma unroll
            for (int i = 0; i < 8; ++i) { __builtin_amdgcn_sched_group_barrier(0x008, 1, 0); __builtin_amdgcn_sched_group_barrier(0x002, 8, 0); }
        }
    }
    __builtin_amdgcn_sched_barrier(0);
    if (BR == 1) {
#pragma unroll
        for (int rg = 0; rg < 4; ++rg) {
            float A = 2.f * (S1[4 * rg] + S1[4 * rg + 1] + S1[4 * rg + 2]) + S1[4 * rg + 3], B = S1[4 * rg + 3];
            A = quad_sum(A); B = quad_sum(B);
            const int jj = ((key0 + 32) >> 2) + 2 * rg + h;
            if ((lane & 3) == 0) { __hip_atomic_fetch_add(imp_row + jj, A, __ATOMIC_RELAXED, __HIP_MEMORY_SCOPE_WORKGROUP);
                if (jj + 1 < 256) __hip_atomic_fetch_add(imp_row + jj + 1, B, __ATOMIC_RELAXED, __HIP_MEMORY_SCOPE_WORKGROUP); }
        }
    }
    if (BR >= 1) {
#pragma unroll
        for (int s = 0; s < 2; ++s)
#pragma unroll
            for (int dt = 0; dt < 4; ++dt) av[s * 4 + dt] = *(const LAS bf16x8*)(vb + (32 * dt + r31) * ROWB + 16 * ((cb0 + 4 + 2 * s) ^ vh));
        __builtin_amdgcn_sched_barrier(0);
#pragma unroll
        for (int dt = 0; dt < 4; ++dt) O[dt] = mfma32(av[dt], __builtin_bit_cast(bf16x8, pk1a), O[dt]);
#pragma unroll
        for (int dt = 0; dt < 4; ++dt) O[dt] = mfma32(av[4 + dt], __builtin_bit_cast(bf16x8, pk1b), O[dt]);
    }
}
template <int BR, int KEYS>
__device__ __forceinline__ void run_branch(const Ctx& c, const bf16_t* Kb, const bf16_t* Vtb, int ldv, int lo, int hi, LAS const float* tb, int t, int t0,
                                           const bf16x8 (&qf)[8], f32x16 (&O)[4], float& m, float& l, float inv_l, int tl, LAS float* imp_row) {
    constexpr bool NEEDV = (BR != 0);
    constexpr int BPS = KEYS / 64, KSTG = KEYS * 256, VSTG = 128 * 2 * KEYS, VB0 = 2 * KSTG;
    LAS unsigned char* lds = c.lds;
    int lz = c.lane; asm volatile("" : "+v"(lz));
    const int nst = (hi - lo + BPS - 1) / BPS;
#define STG_BLK(i) ((lo + BPS * (i) + BPS - 1 < hi) ? lo + BPS * (i) : hi - BPS)
    asm volatile("s_waitcnt vmcnt(0)" ::: "memory");
    { const int b0 = (BPS == 2 && hi - lo < 2) ? lo : STG_BLK(0);
      stage_dma<KEYS, NEEDV>(Kb + (size_t)b0 * 64 * 128, Vtb + (size_t)b0 * 64, ldv, lds, lds + VB0, c.wave, lz); }
    asm volatile("s_waitcnt vmcnt(0)" ::: "memory");
    __syncthreads();
    const int qt = t0 >> 6;
    for (int i = 0; i < nst; ++i) {
        const int buf = i & 1;
        if (i + 1 < nst) { int lz2 = lz; asm volatile("" : "+v"(lz2));
            const int b1 = STG_BLK(i + 1);
            stage_dma<KEYS, NEEDV>(Kb + (size_t)b1 * 64 * 128, Vtb + (size_t)b1 * 64, ldv, lds + (buf ^ 1) * KSTG, lds + VB0 + (buf ^ 1) * VSTG, c.wave, lz2); }
        const int sb = (BPS == 2 && hi - lo < 2) ? lo : STG_BLK(i);
#pragma unroll
        for (int q = 0; q < BPS; ++q) {
            const int j = lo + BPS * i + q;
            if (j < hi) {
                bool selbit = true, wave_on = true;
                if (BR == 2) {
                    const unsigned w = *(const LAS unsigned*)(lds + AT_BM + (tl * 8 + (j >> 5)) * 4);
                    selbit = (w >> (j & 31)) & 1u;
                    const unsigned wu = *(const LAS unsigned*)(lds + AT_WU + (c.wave * 8 + (j >> 5)) * 4);
                    wave_on = (wu >> (j & 31)) & 1u;
                }
                if (wave_on) {
                    int mode = 0;
                    if (BR <= 1) mode = (1024 * j + 1829 <= t0) ? 1 : 0;
                    else if (BR == 2) mode = (64 * j + 853 <= t0) ? 1 : 0;
                    else mode = (j >= qt - 7 && j <= qt - 1) ? 2 : 0;
                    const int slot = j - sb;
                    attn_tile<BR, KEYS>(mode, lds + buf * KSTG + slot * 16384, lds + VB0 + buf * VSTG, 8 * slot, tb, j * 64, t, c.lane, qf, O, m, l, inv_l, selbit, imp_row);
                }
            }
        }
        asm volatile("s_waitcnt vmcnt(0)" ::: "memory");
        __syncthreads();
    }
#undef STG_BLK
}
__device__ __forceinline__ void attn_item(const Args& a, const Ctx& c_, int qt, int g) {
    Ctx c = c_; { int tz = c_.tid; asm volatile("" : "+v"(tz)); c.tid = tz; c.lane = tz & 63; }
    LAS unsigned char* lds = c.lds;
    const int tid = c.tid, wave = c.wave, lane = c.lane, r31 = lane & 31, h = lane >> 5, hl = lane & 3;
    const int t0 = qt * 64, tl = 8 * wave + (r31 >> 2), t = t0 + tl, head = g * 4 + hl;
    const bf16_t* Qb = (const bf16_t*)(a.ws + WS_Q);
    const bf16_t* KROW = (const bf16_t*)(a.ws + WS_KROW);
    const bf16_t* VT = (const bf16_t*)(a.ws + WS_VT);
    const float* GATE = (const float*)(a.ws + WS_GATE);
    { const float* tbg = (const float*)(a.ws + WS_TB) + g * 4 * TBN;
      for (int i = tid; i < 4 * TBN; i += NTHREADS) *(LAS float*)(lds + AT_TB + i * 4) = tbg[i];
      for (int i = tid; i < 64 * 256; i += NTHREADS) *(LAS float*)(lds + AT_IMP + i * 4) = 0.f; }
    bf16x8 qf[8];
#pragma unroll
    for (int ks = 0; ks < 8; ++ks) qf[ks] = *(const bf16x8*)(Qb + (size_t)t * 1024 + head * 128 + 16 * ks + 8 * h);
    LAS const float* tb = (LAS const float*)(lds + AT_TB) + hl * TBN;
    LAS float* imp_row = (LAS float*)(lds + AT_IMP) + tl * 256;
    bf16_t* Y = (bf16_t*)(a.ws + WS_YATT) + (size_t)t * 1024 + head * 128 + 4 * h;
    f32x16 O[4];
#pragma unroll
    for (int dt = 0; dt < 4; ++dt)
#pragma unroll
        for (int r = 0; r < 16; ++r) O[dt][r] = 0.f;
    __syncthreads();
    { const int ntile = (t0 / 16 + 3 + 63) / 64;
      const bf16_t* KC = (const bf16_t*)(a.ws + WS_KC) + (size_t)g * 1024 * 128; const bf16_t* VCT = (const bf16_t*)(a.ws + WS_VCT) + (size_t)g * 128 * 1024;
      float m = -INFINITY, l = 0.f;
#if defined(PROBE_CMP)
      run_branch<0, 64>(c, KC, VCT, 1024, 0, ntile, tb, t, t0, qf, O, m, l, 0.f, tl, imp_row);
      asm volatile("" :: "v"(m), "v"(l));
      m = -INFINITY; l = 0.f;
#endif
      run_branch<0, 64>(c, KC, VCT, 1024, 0, ntile, tb, t, t0, qf, O, m, l, 0.f, tl, imp_row);
      const float lt = xhalf_sum(l), inv = lt > 0.f ? 1.f / lt : 0.f;
      run_branch<1, 64>(c, KC, VCT, 1024, 0, ntile, tb, t, t0, qf, O, m, l, inv, tl, imp_row);
      const float gc = GATE[(size_t)t * 24 + head];
#pragma unroll
      for (int dt = 0; dt < 4; ++dt)
#pragma unroll
          for (int rg = 0; rg < 4; ++rg) {
              u32x2 w; w[0] = cvt_pk_bf16(gc * O[dt][4 * rg], gc * O[dt][4 * rg + 1]); w[1] = cvt_pk_bf16(gc * O[dt][4 * rg + 2], gc * O[dt][4 * rg + 3]);
              *(u32x2*)(Y + 32 * dt + 8 * rg) = w;
#pragma unroll
              for (int e = 0; e < 4; ++e) O[dt][4 * rg + e] = 0.f;
          }
    }
    {
        unsigned wu[8];
#pragma unroll
        for (int k = 0; k < 8; ++k) wu[k] = 0u;
        const int ncand = qt - 2 > 0 ? qt - 2 : 0;
        for (int i = 0; i < 8; ++i) {
            LAS const float* row = (LAS const float*)(lds + AT_IMP) + (8 * wave + i) * 256;
            float v[4]; bool sel[4];
#pragma unroll
            for (int k = 0; k < 4; ++k) { const int j = lane + 64 * k; const bool cand = (j >= 1 && j <= qt - 2); v[k] = cand ? row[j] : -1.f; sel[k] = false; }
            if (ncand <= 13) {
#pragma unroll
                for (int k = 0; k < 4; ++k) sel[k] = v[k] >= 0.f;
            } else {
                for (int it = 0; it < 13; ++it) {
                    float mx = fmaxf(fmaxf(v[0], v[1]), fmaxf(v[2], v[3])); mx = wave_max_bcast(mx);
                    int wk = -1, wl = 0;
#pragma unroll
                    for (int k = 0; k < 4; ++k) { const unsigned long long mk = __ballot(v[k] == mx); if (wk < 0 && mk != 0ull) { wk = k; wl = __ffsll((long long)mk) - 1; } }
#pragma unroll
                    for (int k = 0; k < 4; ++k) if (k == wk && lane == wl) { v[k] = -1.f; sel[k] = true; }
                }
            }
#pragma unroll
            for (int k = 0; k < 4; ++k) {
                const int j = lane + 64 * k; const bool forced = (j == 0) || (j == qt) || (j == qt - 1);
                const unsigned long long mk = __ballot(sel[k] || forced);
                const unsigned lo = (unsigned)mk, hi = (unsigned)(mk >> 32);
                if (lane == 0) { *(LAS unsigned*)(lds + AT_BM + ((8 * wave + i) * 8 + 2 * k) * 4) = lo; *(LAS unsigned*)(lds + AT_BM + ((8 * wave + i) * 8 + 2 * k + 1) * 4) = hi; }
                wu[2 * k] |= lo; wu[2 * k + 1] |= hi;
            }
        }
        if (lane == 0) {
#pragma unroll
            for (int k = 0; k < 8; ++k) *(LAS unsigned*)(lds + AT_WU + (wave * 8 + k) * 4) = wu[k];
        }
    }
    __syncthreads();
#if defined(PROBE_SEL)
    { float m = -INFINITY, l = 0.f;
      run_branch<2, 128>(c, KROW + (size_t)(2 + g) * L_ * 128, VT + (size_t)g * 128 * L_, L_, 0, qt + 1, tb, t, t0, qf, O, m, l, 0.f, tl, imp_row);
      asm volatile("" :: "v"(O[0]), "v"(O[1]), "v"(O[2]), "v"(O[3]), "v"(m), "v"(l));
#pragma unroll
      for (int dt = 0; dt < 4; ++dt)
#pragma unroll
          for (int r = 0; r < 16; ++r) O[dt][r] = 0.f; }
#endif
    { float m = -INFINITY, l = 0.f;
      run_branch<2, 128>(c, KROW + (size_t)(2 + g) * L_ * 128, VT + (size_t)g * 128 * L_, L_, 0, qt + 1, tb, t, t0, qf, O, m, l, 0.f, tl, imp_row);
      const float gs = GATE[(size_t)t * 24 + 8 + head];
      const float lt = xhalf_sum(l), sc = gs * (lt > 0.f ? 1.f / lt : 0.f);
#pragma unroll
      for (int dt = 0; dt < 4; ++dt)
#pragma unroll
          for (int rg = 0; rg < 4; ++rg) {
              const u32x2 w0 = *(const u32x2*)(Y + 32 * dt + 8 * rg);
              u32x2 w; w[0] = cvt_pk_bf16(bflo(w0[0]) + sc * O[dt][4 * rg], bfhi(w0[0]) + sc * O[dt][4 * rg + 1]); w[1] = cvt_pk_bf16(bflo(w0[1]) + sc * O[dt][4 * rg + 2], bfhi(w0[1]) + sc * O[dt][4 * rg + 3]);
              *(u32x2*)(Y + 32 * dt + 8 * rg) = w;
#pragma unroll
              for (int e = 0; e < 4; ++e) O[dt][4 * rg + e] = 0.f;
          }
    }
#if defined(PROBE_WIN)
    { float m = -INFINITY, l = 0.f;
      const int lo = qt - 8 > 0 ? qt - 8 : 0;
      run_branch<3, 128>(c, KROW + (size_t)(4 + g) * L_ * 128, VT + (size_t)(2 + g) * 128 * L_, L_, lo, qt + 1, tb, t, t0, qf, O, m, l, 0.f, tl, imp_row);
      asm volatile("" :: "v"(O[0]), "v"(O[1]), "v"(O[2]), "v"(O[3]), "v"(m), "v"(l));
#pragma unroll
      for (int dt = 0; dt < 4; ++dt)
#pragma unroll
          for (int r = 0; r < 16; ++r) O[dt][r] = 0.f; }
#endif
    { float m = -INFINITY, l = 0.f;
      const int lo = qt - 8 > 0 ? qt - 8 : 0;
      run_branch<3, 128>(c, KROW + (size_t)(4 + g) * L_ * 128, VT + (size_t)(2 + g) * 128 * L_, L_, lo, qt + 1, tb, t, t0, qf, O, m, l, 0.f, tl, imp_row);
      const float gw = GATE[(size_t)t * 24 + 16 + head];
      const float lt = xhalf_sum(l), sc = gw * (lt > 0.f ? 1.f / lt : 0.f);
#pragma unroll
      for (int dt = 0; dt < 4; ++dt)
#pragma unroll
          for (int rg = 0; rg < 4; ++rg) {
              const u32x2 w0 = *(const u32x2*)(Y + 32 * dt + 8 * rg);
              u32x2 w; w[0] = cvt_pk_bf16(bflo(w0[0]) + sc * O[dt][4 * rg], bfhi(w0[0]) + sc * O[dt][4 * rg + 1]); w[1] = cvt_pk_bf16(bflo(w0[1]) + sc * O[dt][4 * rg + 2], bfhi(w0[1]) + sc * O[dt][4 * rg + 3]);
              *(u32x2*)(Y + 32 * dt + 8 * rg) = w;
          }
    }
    __syncthreads();
}
#ifndef PEER_ALPHA
#define PEER_ALPHA 1.0f
#endif
constexpr int PE_SC = 0, PE_LV = 66048, PE_LI = 74240, PE_EX = 147456, PE_GT = 151552, PE_SU = 155648, PE_END = 159744;
constexpr int PE_SLOT = 3072, PE_NSLOT = 6, PE_RINGW = PE_SLOT * PE_NSLOT;
static_assert(8 * PE_RINGW <= PE_EX && PE_END <= LDS_BYTES - 16, "PEER LDS map");
__device__ __forceinline__ float wave_sum_bcast(float v) {
    v += dpp_f<0xB1>(v); v += dpp_f<0x4E>(v); v += dpp_f<0x141>(v); v += dpp_f<0x140>(v);
    v += __int_as_float(__builtin_amdgcn_update_dpp(0, __float_as_int(v), 0x142, 0xa, 0xf, false));
    v += __int_as_float(__builtin_amdgcn_update_dpp(0, __float_as_int(v), 0x143, 0xc, 0xf, false));
    return __int_as_float(__builtin_amdgcn_readlane(__float_as_int(v), 63));
}
__device__ __forceinline__ unsigned mono_key(float v) { const unsigned b = __float_as_uint(v); return b ^ ((b >> 31) ? 0xFFFFFFFFu : 0x80000000u); }
template <bool DRY>
__device__ __forceinline__ void peer_step(const Args& a, const Ctx& c_, int t0) {
    Ctx c = c_; { int tz = c_.tid; asm volatile("" : "+v"(tz)); c.tid = tz; c.lane = tz & 63; }
    LAS unsigned char* lds = c.lds;
    const int tid = c.tid, wave = c.wave, lane = c.lane, r = lane & 15, q = lane >> 4;
    const bf16_t* QP = (const bf16_t*)(a.ws + WS_QP); const bf16_t* PK = (const bf16_t*)(a.ws + WS_PK);
    const unsigned char* PU = a.ws + WS_PU; const unsigned char* PV = a.ws + WS_PV; const float* psc = (const float*)(a.ws + WS_PSC);
    const bf16_t* HB = (const bf16_t*)(a.ws + WS_H);
    {
        const int hh = wave;
#pragma unroll
        for (int cc = 0; cc < 2; ++cc) {
            bf16x8 aF[4];
#pragma unroll
            for (int ks = 0; ks < 4; ++ks) aF[ks] = *(const bf16x8*)(QP + (size_t)(t0 + (r & 7)) * 2048 + hh * 256 + cc * 128 + 32 * ks + 8 * q);
#pragma unroll 2
            for (int nt = 0; nt < 8; ++nt) {
                f32x4 acc = {0.f, 0.f, 0.f, 0.f};
#pragma unroll
                for (int ks = 0; ks < 4; ++ks) { const bf16x8 B = *(const bf16x8*)(PK + (size_t)(cc * 128 + 16 * nt + r) * 128 + 32 * ks + 8 * q); acc = mfma16(aF[ks], B, acc); }
                if (q < 2) {
#pragma unroll
                    for (int i = 0; i < 4; ++i) { const int tok = 4 * q + i; *(LAS float*)(lds + PE_SC + ((tok * 16 + hh * 2 + cc) * 129 + 16 * nt + r) * 4) = acc[i]; }
                }
            }
        }
    }
    __syncthreads();
    if (tid < 128) {
        LAS const float* sc = (LAS const float*)(lds + PE_SC) + tid * 129;
        unsigned top[16];
#pragma unroll
        for (int e = 0; e < 16; ++e) top[e] = 0u;
#pragma unroll 2
        for (int k = 0; k < 128; ++k) {
            unsigned key = (mono_key(sc[k]) & ~0x7Fu) | (unsigned)(127 - k);
#pragma unroll
            for (int e = 0; e < 16; ++e) { const unsigned hi = max(top[e], key); key = min(top[e], key); top[e] = hi; }
        }
#pragma unroll
        for (int e = 0; e < 16; ++e) { const int idx = 127 - (int)(top[e] & 0x7Fu); *(LAS float*)(lds + PE_LV + (tid * 16 + e) * 4) = sc[idx]; *(LAS int*)(lds + PE_LI + (tid * 16 + e) * 4) = idx; }
    }
    __syncthreads();
    if (tid < 64) {
        const int tok = tid >> 3, hh = tid & 7, t1 = tok * 16 + hh * 2, t2 = t1 + 1;
        float v1[16], v2[16];
#pragma unroll
        for (int e = 0; e < 16; ++e) { v1[e] = *(const LAS float*)(lds + PE_LV + (t1 * 16 + e) * 4); v2[e] = *(const LAS float*)(lds + PE_LV + (t2 * 16 + e) * 4); }
        unsigned top[16];
#pragma unroll
        for (int e = 0; e < 16; ++e) top[e] = 0u;
#pragma unroll
        for (int aa = 0; aa < 16; ++aa)
#pragma unroll
            for (int bb = 0; bb < 16; ++bb)
                if ((aa + 1) * (bb + 1) <= 16) {
                    unsigned key = (mono_key(v1[aa] + v2[bb]) & ~0xFFu) | (unsigned)(255 - (aa * 16 + bb));
#pragma unroll
                    for (int e = 0; e < 16; ++e) { const unsigned hi = max(top[e], key); key = min(top[e], key); top[e] = hi; }
                }
        float sv[16]; int ex[16]; float mx = -INFINITY;
#pragma unroll
        for (int e = 0; e < 16; ++e) {
            const int id = 255 - (int)(top[e] & 0xFFu), aa = id >> 4, bb = id & 15;
            sv[e] = *(const LAS float*)(lds + PE_LV + (t1 * 16 + aa) * 4) + *(const LAS float*)(lds + PE_LV + (t2 * 16 + bb) * 4);
            ex[e] = *(const LAS int*)(lds + PE_LI + (t1 * 16 + aa) * 4) * 128 + *(const LAS int*)(lds + PE_LI + (t2 * 16 + bb) * 4);
            mx = fmaxf(mx, sv[e]);
        }
        float sum = 0.f;
#pragma unroll
        for (int e = 0; e < 16; ++e) { sv[e] = fexp2((sv[e] - mx) * LOG2E); sum += sv[e]; }
        const float inv = 1.f / sum;
#pragma unroll
        for (int e = 0; e < 16; ++e) { *(LAS int*)(lds + PE_EX + (tok * 128 + hh * 16 + e) * 4) = ex[e];
            *(LAS float*)(lds + PE_GT + (tok * 128 + hh * 16 + e) * 4) = sv[e] * inv * psc[16384 + ex[e]];
            *(LAS float*)(lds + PE_SU + (tok * 128 + hh * 16 + e) * 4) = psc[ex[e]]; }
    }
    __syncthreads();
    const int t = t0 + wave;
    float hp[32];
#pragma unroll
    for (int k = 0; k < 4; ++k) { const u32x4 w = *(const u32x4*)(HB + (size_t)t * 2048 + lane * 32 + k * 8);
#pragma unroll
        for (int e = 0; e < 4; ++e) { hp[k * 8 + 2 * e] = bflo(w[e]); hp[k * 8 + 2 * e + 1] = bfhi(w[e]); } }
    float acc[32];
#pragma unroll
    for (int e = 0; e < 32; ++e) acc[e] = 0.f;
    asm volatile("s_waitcnt vmcnt(0)" ::: "memory");
    {
        LAS const int* exl = (LAS const int*)(lds + PE_EX) + wave * 128; LAS const float* gtl = (LAS const float*)(lds + PE_GT) + wave * 128;
        LAS unsigned char* ring = lds + wave * PE_RINGW;
        LAS const float* sul = (LAS const float*)(lds + PE_SU) + wave * 128;
#define ROW_ISSUE(SL, IDX) do { const int ex_ = __builtin_amdgcn_readfirstlane(exl[IDX]); \
            const unsigned char* gu_ = PU + (size_t)ex_ * 1536; const unsigned char* gv_ = PV + (size_t)ex_ * 1536; \
            LAS unsigned char* sl_ = ring + (SL) * PE_SLOT;                   \
            __builtin_amdgcn_global_load_lds((const unsigned*)(gu_ + lane * 16), (LAS unsigned*)sl_, 16, 0, 0); \
            __builtin_amdgcn_global_load_lds((const unsigned*)((lane < 32 ? gu_ + 1024 : gv_ - 512) + lane * 16), (LAS unsigned*)(sl_ + 1024), 16, 0, 0); \
            __builtin_amdgcn_global_load_lds((const unsigned*)(gv_ + 512 + lane * 16), (LAS unsigned*)(sl_ + 2048), 16, 0, 0); \
            } while (0)
#define ROW_APPLY(SL, IDX) do { LAS const unsigned char* sl_ = ring + (SL) * PE_SLOT + lane * 24; \
            const u32x2 a0_ = *(const LAS u32x2*)sl_, a1_ = *(const LAS u32x2*)(sl_ + 8), a2_ = *(const LAS u32x2*)(sl_ + 16); \
            const f32x32 uf_ = __builtin_amdgcn_cvt_scalef32_pk32_f32_fp6((u32x6){a0_[0], a0_[1], a1_[0], a1_[1], a2_[0], a2_[1]}, 1.0f); \
            float d0_ = 0.f, d1_ = 0.f; \
            _Pragma("unroll") for (int i = 0; i < 32; i += 2) { d0_ += uf_[i] * hp[i]; d1_ += uf_[i + 1] * hp[i + 1]; } \
            const float d_ = wave_sum_bcast(d0_ + d1_) * sul[IDX]; \
            const float wgt_ = gtl[IDX] * gelu_tanh(d_); \
            const u32x2 b0_ = *(const LAS u32x2*)(sl_ + 1536), b1_ = *(const LAS u32x2*)(sl_ + 1544), b2_ = *(const LAS u32x2*)(sl_ + 1552); \
            const f32x32 vf_ = __builtin_amdgcn_cvt_scalef32_pk32_f32_fp6((u32x6){b0_[0], b0_[1], b1_[0], b1_[1], b2_[0], b2_[1]}, 1.0f); \
            _Pragma("unroll") for (int i = 0; i < 32; ++i) acc[i] += wgt_ * vf_[i]; \
            asm volatile("s_waitcnt lgkmcnt(0)" ::: "memory"); } while (0)
#define DMA_WAIT(N) asm volatile("s_waitcnt vmcnt(" #N ")" ::: "memory")
        ROW_ISSUE(0, 0); ROW_ISSUE(1, 1); ROW_ISSUE(2, 2); ROW_ISSUE(3, 3); ROW_ISSUE(4, 4); ROW_ISSUE(5, 5);
#pragma unroll 1
        for (int e = 0; e < 126; e += 6) {
            const bool last = (e == 120);
            DMA_WAIT(15); ROW_APPLY(0, e);     ROW_ISSUE(0, e + 6);
            DMA_WAIT(15); ROW_APPLY(1, e + 1); ROW_ISSUE(1, e + 7);
            DMA_WAIT(15); ROW_APPLY(2, e + 2); if (!last) ROW_ISSUE(2, e + 8);
            if (last) DMA_WAIT(0); else DMA_WAIT(15);
            ROW_APPLY(3, e + 3); if (!last) ROW_ISSUE(3, e + 9);
            if (!last) DMA_WAIT(15);
            ROW_APPLY(4, e + 4); if (!last) ROW_ISSUE(4, e + 10);
            if (!last) DMA_WAIT(15);
            ROW_APPLY(5, e + 5); if (!last) ROW_ISSUE(5, e + 11);
        }
        ROW_APPLY(0, 126);
        ROW_APPLY(1, 127);
#undef ROW_ISSUE
#undef ROW_APPLY
#undef DMA_WAIT
    }
    {
        float* xo = a.out + (size_t)t * 2048; const float* g2 = (const float*)(a.ws + WS_COND) + 5 * 2048; const float* fg = a.in[32];
        float ss = 0.f;
#pragma unroll
        for (int k = 0; k < 8; ++k) {
            const int col = lane * 32 + k * 4;
            const f32x4 x1 = *(const f32x4*)(xo + col), gv = *(const f32x4*)(g2 + col);
#pragma unroll
            for (int e = 0; e < 4; ++e) { const float x2 = x1[e] + PEER_ALPHA * gv[e] * acc[k * 4 + e]; acc[k * 4 + e] = x2; ss += x2 * x2; }
        }
        ss = wave_sum_bcast(ss);
        const float rstd = rsqrtf(ss * (1.f / 2048.f) + 1e-6f);
#pragma unroll
        for (int k = 0; k < 8; ++k) {
            const int col = lane * 32 + k * 4;
            const f32x4 fv = *(const f32x4*)(fg + col);
            f32x4 o;
#pragma unroll
            for (int e = 0; e < 4; ++e) o[e] = acc[k * 4 + e] * rstd * fv[e];
            if (!DRY || rstd == 123.456f) *(f32x4*)(xo + col) = o;
        }
    }
    __syncthreads();
}
constexpr int NPHASE = 11;
#ifndef DBG
#define DBG 0
#endif
__device__ __forceinline__ void dbg_final_norm(const Args& a, const Ctx& c, const float* src) {
    for (int t = c.bid * 8 + c.wave; t < L_; t += c.nb * 8) {
        const float* xr = src + (size_t)t * 2048 + c.lane * 4; float* o = a.out + (size_t)t * 2048 + c.lane * 4;
        f32x4 v[8]; float ss = 0.f;
#pragma unroll
        for (int j = 0; j < 8; ++j) { v[j] = *(const f32x4*)(xr + j * 256); ss += v[j][0] * v[j][0] + v[j][1] * v[j][1] + v[j][2] * v[j][2] + v[j][3] * v[j][3]; }
        ss = wave_sum(ss);
        const float rstd = rsqrtf(ss * (1.f / 2048.f) + 1e-6f);
#pragma unroll
        for (int j = 0; j < 8; ++j) { const f32x4 g = *(const f32x4*)(a.in[32] + j * 256 + c.lane * 4); *(f32x4*)(o + j * 256) = v[j] * rstd * g; }
    }
}

extern __shared__ __attribute__((aligned(16))) unsigned char smem[];

__global__ void __launch_bounds__(512, 2) fwd(Args a) {
    LAS unsigned char* lds = (LAS unsigned char*)smem;
    Ctx c; c.bid = blockIdx.x; c.nb = gridDim.x; c.tid = threadIdx.x; c.wave = __builtin_amdgcn_readfirstlane(threadIdx.x >> 6); c.lane = threadIdx.x & 63; c.lds = lds;
    volatile LAS unsigned* xbw = (volatile LAS unsigned*)(lds + LDS_BYTES - 16);
    if (c.tid < 4) xbw[c.tid] = 0u;
    __syncthreads();
    const int lo = a.ph_lo, hi = a.ph_hi;
    const bool multi = (hi - lo) > 1;
    XcdBarrier bar; bar.bar = (unsigned*)(a.ws + WS_CTL); bar.x = 0; bar.st = xbw;
    if (multi) bar = xcd_barrier_post((unsigned*)(a.ws + WS_CTL), xbw);
#ifndef PHASE_MASK
#define PHASE_MASK 0xFFFF
#endif
#if DBG == 1
#undef PHASE_MASK
#define PHASE_MASK 0x403
#elif DBG == 2 || DBG == 4 || DBG == 5
#undef PHASE_MASK
#define PHASE_MASK 0x4FF
#endif
#define IN(k) (((PHASE_MASK >> (k)) & 1) && lo <= (k) && (k) < hi)
#define REFRESH() do { int tz_ = threadIdx.x; asm volatile("" : "+v"(tz_)); c.tid = tz_; c.lane = tz_ & 63; c.wave = __builtin_amdgcn_readfirstlane(tz_ >> 6); } while (0)
#define SEAM(k) do { if (IN(k) && IN((k) + 1)) xcd_barrier(bar); } while (0)
#ifndef DUP
#define DUP -1
#endif
#define REP(k) for (int rep_ = 0; rep_ < ((DUP == (k)) ? 2 : 1); ++rep_)
#define DUP2(k, ...) do { __VA_ARGS__; if (DUP == (k)) { __syncthreads(); __VA_ARGS__; } } while (0)

    if (IN(0)) REP(0) { REFRESH(); p0_prologue(a, c); }
    SEAM(0);
    if (IN(1)) { REFRESH(); DUP2(1, p1_hnorm(a, c)); }
    SEAM(1);
    if (IN(2)) { REFRESH();
        pg8::StaticOrder S; S.init((const bf16_t*)(a.ws + WS_H), (const bf16_t*)(a.ws + WS_WIN), 2048, 2048, 2048, L_, DIN_PAD, c.nb, c.bid);
        EpiWin E{(bf16_t*)(a.ws + WS_US), (bf16_t*)(a.ws + WS_Q), (bf16_t*)(a.ws + WS_KROW), (bf16_t*)(a.ws + WS_VROW), (bf16_t*)(a.ws + WS_VT), (float*)(a.ws + WS_GATE)};
        DUP2(2, pg8::gemm_phase<EpiWin, pg8::StaticOrder>(lds, S, E));
    }
    SEAM(2);
    if (IN(3)) REP(3) { REFRESH();
        for (int it = c.bid; it < 256; it += c.nb) s5_item<0>(a, c, it >> 2, it & 3);
        __syncthreads();
        CmpOrder S{(const bf16_t*)(a.ws + WS_KROW), (const bf16_t*)(a.ws + WS_VROW), (const bf16_t*)(a.ws + WS_W1), 2048, 4096, 1024, c.nb, c.bid};
        EpiSlab E{(float*)(a.ws + WS_SLAB)};
        pg8::gemm_phase<EpiSlab, CmpOrder>(lds, S, E);
    }
    SEAM(3);
    if (IN(4)) REP(4) { REFRESH();
        for (int it = c.bid; it < 64; it += c.nb) cmp_finish_item(a, c, it >> 5, it & 31);
        for (int it = c.bid; it < 256; it += c.nb) s5_item<1>(a, c, it >> 2, it & 3);
    }
    SEAM(4);
    if (IN(5)) { REFRESH();
#if DBG == 5
        for (size_t i = (size_t)c.bid * NTHREADS + c.tid; i < (size_t)L_ * 1024 / 8; i += (size_t)c.nb * NTHREADS) *(u32x4*)((bf16_t*)(a.ws + WS_YSSM) + i * 8) = (u32x4){0u, 0u, 0u, 0u};
#else
        {
            pg8::StaticOrder S; S.init((const bf16_t*)(a.ws + WS_Z), (const bf16_t*)(a.ws + WS_WGLU), 1024, 1024, 1024, L_, 1024, c.nb, c.bid);
            EpiGlu E{(const bf16_t*)(a.ws + WS_Z), a.in[19], (bf16_t*)(a.ws + WS_YSSM)};
            DUP2(55, pg8::gemm_phase<EpiGlu, pg8::StaticOrder>(lds, S, E));
        }
#endif
        __syncthreads();
        REP(5)
#if DBG == 4
        for (size_t i = (size_t)c.bid * NTHREADS + c.tid; i < (size_t)L_ * 1024 / 8; i += (size_t)c.nb * NTHREADS) *(u32x4*)((bf16_t*)(a.ws + WS_YATT) + i * 8) = (u32x4){0u, 0u, 0u, 0u};
#else
        for (int it = c.bid; it < 512; it += c.nb) {
            const int rnd = it / c.nb;
            const int qt = (rnd & 1) ? 255 - (it % 256) : (it % 256), g = (it >> 8) & 1;
            attn_item(a, c, qt, g);
        }
#endif
    }
    SEAM(5);
    if (IN(6)) { REFRESH(); DUP2(6, p6_mixnorm(a, c)); }
    SEAM(6);
    if (IN(7)) { REFRESH();
        pg8::StaticOrder S; S.init((const bf16_t*)(a.ws + WS_H), (const bf16_t*)(a.ws + WS_WOUT), 2048, 2048, 2048, L_, 2048, c.nb, c.bid);
        EpiWout E{a.in[0], (const float*)(a.ws + WS_COND) + 2 * 2048, a.out};
        DUP2(7, pg8::gemm_phase<EpiWout, pg8::StaticOrder>(lds, S, E));
    }
    SEAM(7);
    if (IN(8)) { REFRESH(); DUP2(8, p8_h2norm(a, c)); }
    SEAM(8);
    if (IN(9)) { REFRESH();
        pg8::StaticOrder S; S.init((const bf16_t*)(a.ws + WS_H), (const bf16_t*)(a.ws + WS_WQ), 2048, 2048, 2048, L_, 2048, c.nb, c.bid);
        EpiBf16 E{(bf16_t*)(a.ws + WS_QP), 2048};
        DUP2(9, pg8::gemm_phase<EpiBf16, pg8::StaticOrder>(lds, S, E));
    }
    SEAM(9);
    if (IN(10)) { REFRESH();
#if DBG == 1
        dbg_final_norm(a, c, a.in[0]);
#elif DBG == 2 || DBG == 4 || DBG == 5
        dbg_final_norm(a, c, a.out);
#else
        if (DUP == 10) { for (int s = c.bid; s < L_ / 8; s += c.nb) peer_step<true>(a, c, s * 8); }
        for (int s = c.bid; s < L_ / 8; s += c.nb) peer_step<false>(a, c, s * 8);
#endif
    }
#undef IN
#undef SEAM
}

#ifndef N_LAUNCHES
#define N_LAUNCHES 1
#endif
extern "C" void kernel_launch(void* const* d_in, const int* in_sizes, int n_in, void* d_out, int out_size, void* d_ws, size_t ws_size, hipStream_t stream) {
    static int grid = 0;
    if (grid == 0) {
        if (n_in != 33 || out_size != L_ * D_ || ws_size < WS_END) { fprintf(stderr, "kernel_launch: unexpected shapes (n_in %d, out %d, ws %zu < %zu); nothing launched\n", n_in, out_size, ws_size, (size_t)WS_END); grid = -1; return; }
        int dev = 0, cus = 0, per_cu = 0;
        if (hipGetDevice(&dev) != hipSuccess || hipDeviceGetAttribute(&cus, hipDeviceAttributeMultiprocessorCount, dev) != hipSuccess) { grid = -1; return; }
        if (hipFuncSetAttribute((const void*)fwd, hipFuncAttributeMaxDynamicSharedMemorySize, LDS_BYTES) != hipSuccess) { fprintf(stderr, "kernel_launch: hipFuncSetAttribute failed\n"); grid = -1; return; }
        if (hipOccupancyMaxActiveBlocksPerMultiprocessor(&per_cu, (const void*)fwd, NTHREADS, LDS_BYTES) != hipSuccess || per_cu < 1) { fprintf(stderr, "kernel_launch: occupancy query says %d\n", per_cu); (void)hipGetLastError(); grid = -1; return; }
        grid = cus;
    }
    if (grid < 0) return;
    (void)hipMemsetAsync((char*)d_ws + WS_CTL, 0, CTL_BYTES, stream);
    Args a{};
    for (int i = 0; i < 33; ++i) a.in[i] = (const float*)d_in[i];
    a.out = (float*)d_out; a.ws = (unsigned char*)d_ws;
    if (N_LAUNCHES == 1) { a.ph_lo = 0; a.ph_hi = NPHASE; hipLaunchKernelGGL(fwd, dim3(grid), dim3(NTHREADS), LDS_BYTES, stream, a); }
    else for (int p = 0; p < NPHASE; ++p) { a.ph_lo = p; a.ph_hi = p + 1; hipLaunchKernelGGL(fwd, dim3(grid), dim3(NTHREADS), LDS_BYTES, stream, a); }
}
```

```cpp
#include <hip/hip_runtime.h>
#include <stdint.h>
#include <stdio.h>

#define LAS __attribute__((address_space(3)))
typedef unsigned short bf16_t;
typedef short bf16x8 __attribute__((ext_vector_type(8)));
typedef float f32x2 __attribute__((ext_vector_type(2)));
typedef float f32x4 __attribute__((ext_vector_type(4)));
typedef float f32x16 __attribute__((ext_vector_type(16)));
typedef unsigned u32x2 __attribute__((ext_vector_type(2)));
typedef unsigned u32x4 __attribute__((ext_vector_type(4)));
typedef __bf16 bfv2 __attribute__((ext_vector_type(2)));
typedef unsigned u32x6 __attribute__((ext_vector_type(6)));
typedef float f32x32 __attribute__((ext_vector_type(32)));

constexpr int L_ = 16384, D_ = 2048, DSSM = 1024, DATT = 1024, DIN = 3608, DIN_PAD = 3840;
constexpr int NADA = 12288;
constexpr float LOG2E = 1.4426950408889634f;
constexpr float QSCALE = 0.08838834764831845f * 1.4426950408889634f;
constexpr int TBN = 800;
constexpr int NTHREADS = 512;
constexpr int LDS_BYTES = 163840;

constexpr size_t al256(size_t x) { return (x + 255) & ~(size_t)255; }
constexpr size_t WS_CTL   = 0;                                  constexpr size_t CTL_BYTES = 65536;
constexpr size_t WS_CONDP = WS_CTL + CTL_BYTES;
constexpr size_t WS_COND  = WS_CONDP + 32 * 12288 * 4;
constexpr size_t WS_TB    = WS_COND + 12288 * 4;
constexpr size_t WS_BPE   = al256(WS_TB + 8 * TBN * 4);
constexpr size_t WS_S5P   = al256(WS_BPE + 2 * 256 * 4);
constexpr size_t WS_S5F   = WS_S5P + 2 * 64 * 64 * 2 * 4;
constexpr size_t WS_S5MT  = WS_S5F + 64 * 4 * 128 * 4;
constexpr size_t WS_S5WE  = WS_S5MT + (size_t)64 * 256 * 256 * 2;
constexpr size_t WS_S5WC  = WS_S5WE + (size_t)64 * 128 * 256 * 2;
constexpr size_t WS_WIN   = WS_S5WC + (size_t)64 * 256 * 128 * 2;
constexpr size_t WS_WGLU  = WS_WIN + (size_t)DIN_PAD * 2048 * 2;
constexpr size_t WS_WOUT  = WS_WGLU + (size_t)1024 * 1024 * 2;
constexpr size_t WS_WQ    = WS_WOUT + (size_t)2048 * 2048 * 2;
constexpr size_t WS_W1    = WS_WQ + (size_t)2048 * 2048 * 2;
constexpr size_t WS_W2    = WS_W1 + (size_t)2 * 256 * 4096 * 2;
constexpr size_t WS_PK    = WS_W2 + (size_t)2 * 128 * 256 * 2;
constexpr size_t WS_PU    = WS_PK + (size_t)2 * 128 * 128 * 2;
constexpr size_t WS_PV    = WS_PU + (size_t)16384 * 1536;
constexpr size_t WS_PSC   = WS_PV + (size_t)16384 * 1536;
constexpr size_t WS_BPEP  = WS_PSC + (size_t)2 * 16384 * 4;
constexpr size_t WS_H     = WS_BPEP + (size_t)32 * 2 * 256 * 4;
constexpr size_t WS_US    = WS_H + (size_t)16384 * 2048 * 2;
constexpr size_t WS_Q     = WS_US + (size_t)16384 * 1024 * 2;
constexpr size_t WS_QP    = WS_US;
constexpr size_t WS_KROW  = WS_Q + (size_t)16384 * 1024 * 2;
constexpr size_t WS_VROW  = WS_KROW + (size_t)6 * 16384 * 128 * 2;
constexpr size_t WS_VT    = WS_VROW + (size_t)2 * 16384 * 128 * 2 + 8192;
constexpr size_t WS_GATE  = WS_VT + (size_t)4 * 128 * 16384 * 2;
constexpr size_t WS_SLAB  = WS_GATE + (size_t)16384 * 24 * 4;
constexpr size_t WS_KC    = WS_SLAB + (size_t)2 * 4 * 2048 * 256 * 4;
constexpr size_t WS_VCT   = WS_KC + (size_t)2 * 1024 * 128 * 2;
constexpr size_t WS_Z     = WS_VCT + (size_t)2 * 128 * 1024 * 2;
constexpr size_t WS_YSSM  = WS_Z + (size_t)16384 * 1024 * 2;
constexpr size_t WS_YATT  = WS_YSSM + (size_t)16384 * 1024 * 2;
constexpr size_t WS_END   = WS_YATT + (size_t)16384 * 1024 * 2;
static_assert(WS_END < (size_t)530 * 1024 * 1024, "workspace map too large");

struct Args { const float* in[33]; float* out; unsigned char* ws; int ph_lo, ph_hi; };

__device__ __forceinline__ unsigned cvt_pk_bf16(float lo, float hi) { bfv2 v; v[0] = (__bf16)lo; v[1] = (__bf16)hi; return __builtin_bit_cast(unsigned, v); }
__device__ __forceinline__ bf16_t f2bf(float f) { return (bf16_t)(cvt_pk_bf16(f, 0.f) & 0xffffu); }
__device__ __forceinline__ float bf2f(unsigned b) { return __uint_as_float(b << 16); }
__device__ __forceinline__ float bflo(unsigned w) { return __uint_as_float(w << 16); }
__device__ __forceinline__ float bfhi(unsigned w) { return __uint_as_float(w & 0xffff0000u); }
__device__ __forceinline__ float fexp2(float x) { return __builtin_amdgcn_exp2f(x); }
__device__ __forceinline__ float frcp(float x) { return __builtin_amdgcn_rcpf(x); }
__device__ __forceinline__ float sigmoidf_(float x) { return frcp(1.f + fexp2(-LOG2E * x)); }
__device__ __forceinline__ float gelu_tanh(float x) {
    const float u = x * (1.f + 0.044715f * x * x);
    return x * frcp(1.f + fexp2(-2.f * 0.7978845608028654f * LOG2E * u));
}
__device__ __forceinline__ float shfl_xor_f(float v, int m) { return __shfl_xor(v, m, 64); }
__device__ __forceinline__ float wave_sum(float v) {
#pragma unroll
    for (int m = 32; m >= 1; m >>= 1) v += __shfl_xor(v, m, 64);
    return v;
}
__device__ __forceinline__ float wave_max(float v) {
#pragma unroll
    for (int m = 32; m >= 1; m >>= 1) v = fmaxf(v, __shfl_xor(v, m, 64));
    return v;
}
template <int CTRL> __device__ __forceinline__ float dpp_f(float x) { return __int_as_float(__builtin_amdgcn_update_dpp(0, __float_as_int(x), CTRL, 0xf, 0xf, false)); }
__device__ __forceinline__ float wave_max_bcast(float v) {
    v = fmaxf(v, dpp_f<0xB1>(v)); v = fmaxf(v, dpp_f<0x4E>(v)); v = fmaxf(v, dpp_f<0x141>(v)); v = fmaxf(v, dpp_f<0x140>(v));
    v = fmaxf(v, __int_as_float(__builtin_amdgcn_update_dpp(__float_as_int(v), __float_as_int(v), 0x142, 0xa, 0xf, false)));
    v = fmaxf(v, __int_as_float(__builtin_amdgcn_update_dpp(__float_as_int(v), __float_as_int(v), 0x143, 0xc, 0xf, false)));
    return __int_as_float(__builtin_amdgcn_readlane(__float_as_int(v), 63));
}
__device__ __forceinline__ float quad_sum(float x) { x += dpp_f<0xB1>(x); x += dpp_f<0x4E>(x); return x; }
__device__ __forceinline__ f32x4 mfma16(bf16x8 a, bf16x8 b, f32x4 c) { return __builtin_amdgcn_mfma_f32_16x16x32_bf16(a, b, c, 0, 0, 0); }
__device__ __forceinline__ f32x16 mfma32(bf16x8 a, bf16x8 b, f32x16 c) { return __builtin_amdgcn_mfma_f32_32x32x16_bf16(a, b, c, 0, 0, 0); }
#define XB_TMO      128
#define XB_XCNT(j)  (256  + 64 * (j))
#define XB_XSUB(j)  (1280 + 64 * (j))
#define XB_XGEN(j)  (2304 + 64 * (j))
#define XB_TOP      3328
#define XB_TOPGEN   3392
#define XCD_BAR_WORDS 3456
#define XB_SPIN_CAP (1u << 18)

__device__ __forceinline__ unsigned xb_ld(unsigned* p)              { return __hip_atomic_load(p, __ATOMIC_RELAXED, __HIP_MEMORY_SCOPE_AGENT); }
__device__ __forceinline__ unsigned xb_add(unsigned* p, unsigned v) { return __hip_atomic_fetch_add(p, v, __ATOMIC_RELAXED, __HIP_MEMORY_SCOPE_AGENT); }
__device__ __forceinline__ unsigned xb_xcc_id() { return (unsigned)__builtin_amdgcn_s_getreg((3 << 11) | 20) & 0xFu; }
#define XB_SPIN(cond, bar) do { unsigned _sp = 0; while (cond) { __builtin_amdgcn_s_sleep(1); \
    if ((++_sp & 255u) == 0u) { if (xb_ld(&(bar)[XB_TMO])) break; if (_sp > XB_SPIN_CAP) { atomicAdd(&(bar)[XB_TMO], 1u); break; } } } } while (0)

struct XcdBarrier {
    unsigned* bar; unsigned x;
    volatile LAS unsigned* st;
};
__device__ __forceinline__ XcdBarrier xcd_barrier_post(unsigned* bar, volatile LAS unsigned* st) {
    XcdBarrier b; b.bar = bar; b.x = xb_xcc_id(); b.st = st;
    if (threadIdx.x == 0) (void)xb_add(&bar[XB_XCNT(b.x)], 1u);
    return b;
}
__device__ __forceinline__ void xcd_barrier_complete(unsigned* bar, unsigned x, unsigned& nloc, unsigned& nx) {
    const unsigned G = gridDim.x * gridDim.y * gridDim.z;
    unsigned sum, cnt, mine, sp = 0u;
    for (;;) {
        sum = 0u; cnt = 0u; mine = 0u;
#pragma unroll
        for (unsigned j = 0; j < 16; ++j) { const unsigned c = xb_ld(&bar[XB_XCNT(j)]); sum += c; cnt += (c > 0u) ? 1u : 0u; mine = (j == x) ? c : mine; }
        if (sum == G) break;
        __builtin_amdgcn_s_sleep(1);
        if ((++sp & 255u) == 0u) { if (xb_ld(&bar[XB_TMO])) break; if (sp > XB_SPIN_CAP) { atomicAdd(&bar[XB_TMO], 1u); break; } }
    }
    nloc = mine > 0u ? mine : 1u; nx = cnt > 0u ? cnt : 1u;
}
__device__ __forceinline__ void xcd_barrier(const XcdBarrier& b) {
    asm volatile("s_waitcnt vmcnt(0)" ::: "memory");
    __syncthreads();
    if (threadIdx.x == 0) {
        unsigned* bar = b.bar;
        __builtin_amdgcn_s_waitcnt(0);
        unsigned nloc = b.st[0], nx = b.st[1];
        if (nloc == 0u) { xcd_barrier_complete(bar, b.x, nloc, nx); b.st[0] = nloc; b.st[1] = nx; }
        const unsigned old = xb_add(&bar[XB_XSUB(b.x)], 1u);
        const unsigned gen = old / nloc;
        if (old + 1u == (gen + 1u) * nloc) {
            __builtin_amdgcn_fence(__ATOMIC_RELEASE, "agent");
            asm volatile("s_waitcnt vmcnt(0)" ::: "memory");
            const unsigned og = xb_add(&bar[XB_TOP], 1u);
            const unsigned tg = og / nx;
            if (og + 1u == (tg + 1u) * nx) xb_add(&bar[XB_TOPGEN], 1u);
            else XB_SPIN(xb_ld(&bar[XB_TOPGEN]) == tg, bar);
            __builtin_amdgcn_fence(__ATOMIC_ACQUIRE, "agent");
            xb_add(&bar[XB_XGEN(b.x)], 1u);
            asm volatile("s_waitcnt vmcnt(0)" ::: "memory");
        } else {
            XB_SPIN(xb_ld(&bar[XB_XGEN(b.x)]) == gen, bar);
            __builtin_amdgcn_fence(__ATOMIC_ACQUIRE, "agent");
            asm volatile("s_waitcnt vmcnt(0)" ::: "memory");
        }
    }
    __syncthreads();
}

namespace pg8 {
constexpr int BM = 256, BK = 64, HALF = 128, HTB = HALF * BK * 2, STAGE_BYTES = 8 * HTB, NXCD = 8, WGM = 8;
__host__ __device__ __forceinline__ int lds_byte(int r, int c) { const int st = (r >> 4) * 2 + (c >> 5), rr = r & 15, cc = c & 31, ob = rr * 64 + cc * 2; return st * 1024 + (ob ^ (((ob >> 9) & 1) << 5)); }
__host__ __device__ __forceinline__ void stage_rc(int b, int& R, int& C) { const int st = b / 1024, sb = b % 1024, swz = sb ^ (((sb >> 9) & 1) << 5); R = (st >> 1) * 16 + swz / 64; C = (st & 1) * 32 + (swz % 64) / 2; }
__host__ __device__ __forceinline__ int perm32(int rho) { const int n = rho >> 4, i = rho & 15; return 8 * (i >> 2) + 4 * n + (i & 3); }

struct Unit { int pm, pn, z; };
struct StaticOrder {
    const bf16_t* A; const bf16_t* Bt; int lda, ldb, K;
    int nM, nN, nwg, G, c;
    __device__ void init(const bf16_t* A_, const bf16_t* Bt_, int lda_, int ldb_, int K_, int M, int N, int G_, int c_) { A = A_; Bt = Bt_; lda = lda_; ldb = ldb_; K = K_; nM = M / BM; nN = N / BM; nwg = nM * nN; G = G_; c = c_; }
    __device__ bool next(int i, Unit& u) const {
        const long Lx = (long)i * G + c; if (Lx >= nwg) return false;
        int wgid = (int)Lx; { const int q = nwg / NXCD, r = nwg % NXCD, xcd = wgid % NXCD, off = wgid / NXCD; wgid = (xcd < r ? xcd * (q + 1) : r * (q + 1) + (xcd - r) * q) + off; }
        const int nig = WGM * nN, gid = wgid / nig, fm = gid * WGM, gsz = (nM - fm) < WGM ? (nM - fm) : WGM;
        u.pm = fm + ((wgid % nig) % gsz); u.pn = (wgid % nig) / gsz; u.z = 0; return true;
    }
    __device__ __forceinline__ const char* a_base(const Unit& u) const { return (const char*)(A + (size_t)u.pm * BM * lda); }
    __device__ __forceinline__ const char* b_base(const Unit& u) const { return (const char*)(Bt + (size_t)u.pn * BM * ldb); }
};

template <class Epi, class Sched>
__device__ __forceinline__ void gemm_phase(LAS unsigned char* lds, const Sched& S, const Epi& E) {
    const int tid = threadIdx.x, wid = __builtin_amdgcn_readfirstlane(tid >> 6), lane = tid & 63, wr = wid >> 2, wc = wid & 3, fr = lane & 15, fq = lane >> 4;
    const int K = S.K, nt = K / BK, lda = S.lda, ldb = S.ldb;
    unsigned voffA[2], voffB[2];
#pragma unroll
    for (int i = 0; i < 2; ++i) { int R, C; stage_rc(tid * 16 + i * 8192, R, C); const int Rb = Epi::PERM ? ((R & ~31) + perm32(R & 31)) : R;
        voffA[i] = (unsigned)(R * lda + C) * 2u; voffB[i] = (unsigned)(Rb * ldb + C) * 2u; }
    const size_t kstep = (size_t)(BK * 2);
    const size_t hstepA = (size_t)HALF * lda * 2, hstepB = (size_t)HALF * ldb * 2;
    const unsigned ldsw = (unsigned)wid * 1024u;
    const int aoff = lds_byte(wr * 64 + fr, fq * 8), boff = lds_byte(wc * 32 + fr, fq * 8);
#define PG8_SA(b, h) (((b) * 2 + (h)) * HTB)
#define PG8_SB(b, h) ((4 + (b) * 2 + (h)) * HTB)
#define PG8_STAGE(bufoff, gbase, voff) do { _Pragma("unroll") for (int _i = 0; _i < 2; ++_i) \
        __builtin_amdgcn_global_load_lds((const unsigned*)((const char*)(gbase) + (voff)[_i]), (LAS unsigned*)(lds + (bufoff) + ldsw + _i * 8192), 16, 0, 0); } while (0)
#define PG8_LDA(dst, b, h) do { _Pragma("unroll") for (int m = 0; m < 4; ++m) _Pragma("unroll") for (int k = 0; k < 2; ++k) dst[m][k] = *(const LAS bf16x8*)(lds + PG8_SA(b, h) + aoff + m * 2048 + k * 1024); } while (0)
#define PG8_LDB(dst, b, h) do { _Pragma("unroll") for (int n = 0; n < 2; ++n) _Pragma("unroll") for (int k = 0; k < 2; ++k) dst[n][k] = *(const LAS bf16x8*)(lds + PG8_SB(b, h) + boff + n * 2048 + k * 1024); } while (0)
#define PG8_MMA(ai, bj, At, Bt) do { __builtin_amdgcn_s_setprio(1); _Pragma("unroll") for (int m = 0; m < 4; ++m) _Pragma("unroll") for (int n = 0; n < 2; ++n) _Pragma("unroll") for (int k = 0; k < 2; ++k) \
        acc[ai][bj][m][n] = __builtin_amdgcn_mfma_f32_16x16x32_bf16(Bt[n][k], At[m][k], acc[ai][bj][m][n], 0, 0, 0); __builtin_amdgcn_s_setprio(0); } while (0)
#define PG8_WAIT_V(n) asm volatile("s_waitcnt vmcnt(" #n ")" ::: "memory")
#define PG8_WAIT_L(n) asm volatile("s_waitcnt lgkmcnt(" #n ")" ::: "memory")
#define PG8_BAR __builtin_amdgcn_s_barrier()
#define PG8_SCHED __builtin_amdgcn_sched_barrier(0)
    Unit cur, nxt; int ui = 0;
    if (!S.next(0, cur)) return;
    f32x4 acc[2][2][4][2];
#pragma unroll
    for (int a = 0; a < 2; ++a)
#pragma unroll
        for (int b = 0; b < 2; ++b)
#pragma unroll
            for (int m = 0; m < 4; ++m)
#pragma unroll
                for (int n = 0; n < 2; ++n) acc[a][b][m][n] = (f32x4){0.f, 0.f, 0.f, 0.f};
    bf16x8 At[4][2], B0[2][2], B1[2][2];
    const char* cA = S.a_base(cur); const char* cB = S.b_base(cur);
    PG8_STAGE(PG8_SB(0, 0), cB, voffB); PG8_STAGE(PG8_SA(0, 0), cA, voffA); PG8_STAGE(PG8_SB(0, 1), cB + hstepB, voffB); PG8_STAGE(PG8_SA(0, 1), cA + hstepA, voffA);
    if (wr == 1) PG8_BAR;
    PG8_WAIT_V(4); PG8_BAR;
    PG8_STAGE(PG8_SB(1, 0), cB + kstep, voffB); PG8_STAGE(PG8_SA(1, 0), cA + kstep, voffA); PG8_STAGE(PG8_SB(1, 1), cB + hstepB + kstep, voffB);
    PG8_WAIT_V(6); PG8_BAR;
    for (;;) {
        const bool has_next = S.next(ui + 1, nxt);
        const char* nA = has_next ? S.a_base(nxt) : cA; const char* nB = has_next ? S.b_base(nxt) : cB;
        for (int t = 0; t < nt; t += 2) {
            const bool last = (t == nt - 2);
            const char* a1 = cA + (size_t)(t + 1) * kstep;
            const char* a2 = last ? nA : cA + (size_t)(t + 2) * kstep; const char* b2 = last ? nB : cB + (size_t)(t + 2) * kstep;
            const char* a3 = a2 + kstep; const char* b3 = b2 + kstep;
            PG8_LDB(B0, 0, 0); PG8_SCHED; PG8_LDA(At, 0, 0); PG8_STAGE(PG8_SA(1, 1), a1 + hstepA, voffA);
            PG8_WAIT_L(8); PG8_BAR; PG8_WAIT_L(0); PG8_MMA(0, 0, At, B0); PG8_BAR; PG8_SCHED;
            PG8_LDB(B1, 0, 1); PG8_STAGE(PG8_SB(0, 0), b2, voffB);
            PG8_BAR; PG8_WAIT_L(0); PG8_MMA(0, 1, At, B1); PG8_BAR;
            PG8_LDA(At, 0, 1); PG8_STAGE(PG8_SA(0, 0), a2, voffA);
            PG8_BAR; PG8_WAIT_L(0); PG8_MMA(1, 0, At, B0); PG8_BAR; PG8_SCHED;
            PG8_STAGE(PG8_SB(0, 1), b2 + hstepB, voffB);
            PG8_WAIT_V(6); PG8_BAR; PG8_MMA(1, 1, At, B1); PG8_BAR;
            PG8_LDB(B0, 1, 0); PG8_SCHED; PG8_LDA(At, 1, 0); PG8_STAGE(PG8_SA(0, 1), a2 + hstepA, voffA);
            PG8_WAIT_L(8); PG8_BAR; PG8_WAIT_L(0); PG8_MMA(0, 0, At, B0); PG8_BAR; PG8_SCHED;
            PG8_LDB(B1, 1, 1); PG8_STAGE(PG8_SB(1, 0), b3, voffB);
            PG8_BAR; PG8_WAIT_L(0); PG8_MMA(0, 1, At, B1); PG8_BAR;
            PG8_LDA(At, 1, 1); PG8_STAGE(PG8_SA(1, 0), a3, voffA);
            PG8_BAR; PG8_WAIT_L(0); PG8_MMA(1, 0, At, B0); PG8_BAR; PG8_SCHED;
            PG8_STAGE(PG8_SB(1, 1), b3 + hstepB, voffB);
            PG8_WAIT_V(6); PG8_BAR; PG8_MMA(1, 1, At, B1); PG8_BAR;
        }
        E(acc, cur, wr, wc, fr, fq);
        if (!has_next) break;
#pragma unroll
        for (int a = 0; a < 2; ++a)
#pragma unroll
            for (int b = 0; b < 2; ++b)
#pragma unroll
                for (int m = 0; m < 4; ++m)
#pragma unroll
                    for (int n = 0; n < 2; ++n) acc[a][b][m][n] = (f32x4){0.f, 0.f, 0.f, 0.f};
        cur = nxt; cA = nA; cB = nB; ++ui;
    }
    PG8_WAIT_V(0);
    if (wr == 0) PG8_BAR;
    PG8_BAR;
#undef PG8_SA
#undef PG8_SB
#undef PG8_STAGE
#undef PG8_LDA
#undef PG8_LDB
#undef PG8_MMA
#undef PG8_WAIT_V
#undef PG8_WAIT_L
#undef PG8_BAR
#undef PG8_SCHED
}
}
using pg8::Unit;
__device__ __forceinline__ u32x4 pack8(const f32x4& v0, const f32x4& v1) {
    u32x4 o; o[0] = cvt_pk_bf16(v0[0], v0[1]); o[1] = cvt_pk_bf16(v0[2], v0[3]); o[2] = cvt_pk_bf16(v1[0], v1[1]); o[3] = cvt_pk_bf16(v1[2], v1[3]); return o;
}
struct EpiWin {
    static constexpr bool PERM = true;
    bf16_t* US; bf16_t* Q; bf16_t* KROW; bf16_t* VROW; bf16_t* VT; float* GATE;
    __device__ __forceinline__ void operator()(const f32x4 (&acc)[2][2][4][2], const Unit& u, int wr, int wc, int fr, int fq) const {
        const int row0 = u.pm * 256 + wr * 64 + fr; const int pn = u.pn;
#pragma unroll
        for (int ai = 0; ai < 2; ++ai)
#pragma unroll
            for (int m = 0; m < 4; ++m) {
                const int row = row0 + ai * 128 + m * 16;
#pragma unroll
                for (int bj = 0; bj < 2; ++bj) {
                    const f32x4 v0 = acc[ai][bj][m][0], v1 = acc[ai][bj][m][1];
                    const int cin = bj * 128 + wc * 32 + 8 * fq;
                    if (pn < 4) { *(u32x4*)(US + (size_t)row * 1024 + pn * 256 + cin) = pack8(v0, v1); }
                    else if (pn < 8) { *(u32x4*)(Q + (size_t)row * 1024 + (pn - 4) * 256 + cin) = pack8(v0 * QSCALE, v1 * QSCALE); }
                    else if (pn < 14) {
                        const int kvi = pn - 8, branch = kvi >> 1, kvsel = kvi & 1, g = bj, d0 = wc * 32 + 8 * fq;
                        if (kvsel == 0) { *(u32x4*)(KROW + ((size_t)(branch * 2 + g) * L_ + row) * 128 + d0) = pack8(v0, v1); }
                        else if (branch == 0) { *(u32x4*)(VROW + ((size_t)g * L_ + row) * 128 + d0) = pack8(v0, v1); }
                        else {
                            bf16_t* vt = VT + ((size_t)((branch - 1) * 2 + g) * 128 + d0) * L_ + ((row & ~12) | ((row & 4) << 1) | ((row & 8) >> 1));
#pragma unroll
                            for (int e = 0; e < 4; ++e) { vt[(size_t)e * L_] = f2bf(v0[e]); vt[(size_t)(e + 4) * L_] = f2bf(v1[e]); }
                        }
                    } else {
                        if (cin < 24) {
                            float* gp = GATE + (size_t)row * 24 + cin;
                            f32x4 s0, s1;
#pragma unroll
                            for (int e = 0; e < 4; ++e) { s0[e] = sigmoidf_(v0[e]); s1[e] = sigmoidf_(v1[e]); }
                            *(f32x4*)gp = s0; *(f32x4*)(gp + 4) = s1;
                        }
                    }
                }
            }
    }
};
struct EpiGlu {
    static constexpr bool PERM = true;
    const bf16_t* Z; const float* bglu; bf16_t* Y;
    __device__ __forceinline__ void operator()(const f32x4 (&acc)[2][2][4][2], const Unit& u, int wr, int wc, int fr, int fq) const {
        const int row0 = u.pm * 256 + wr * 64 + fr;
#pragma unroll
        for (int bj = 0; bj < 2; ++bj) {
            const int col = u.pn * 256 + bj * 128 + wc * 32 + 8 * fq;
            const f32x4 b0 = *(const f32x4*)(bglu + col), b1 = *(const f32x4*)(bglu + col + 4);
#pragma unroll
            for (int ai = 0; ai < 2; ++ai)
#pragma unroll
                for (int m = 0; m < 4; ++m) {
                    const int row = row0 + ai * 128 + m * 16;
                    const u32x4 zz = *(const u32x4*)(Z + (size_t)row * 1024 + col);
                    const f32x4 v0 = acc[ai][bj][m][0] + b0, v1 = acc[ai][bj][m][1] + b1;
                    f32x4 o0, o1;
                    o0[0] = bflo(zz[0]) * sigmoidf_(v0[0]); o0[1] = bfhi(zz[0]) * sigmoidf_(v0[1]); o0[2] = bflo(zz[1]) * sigmoidf_(v0[2]); o0[3] = bfhi(zz[1]) * sigmoidf_(v0[3]);
                    o1[0] = bflo(zz[2]) * sigmoidf_(v1[0]); o1[1] = bfhi(zz[2]) * sigmoidf_(v1[1]); o1[2] = bflo(zz[3]) * sigmoidf_(v1[2]); o1[3] = bfhi(zz[3]) * sigmoidf_(v1[3]);
                    *(u32x4*)(Y + (size_t)row * 1024 + col) = pack8(o0, o1);
                }
        }
    }
};
struct EpiWout {
    static constexpr bool PERM = false;
    const float* X; const float* g1; float* X1;
    __device__ __forceinline__ void operator()(const f32x4 (&acc)[2][2][4][2], const Unit& u, int wr, int wc, int fr, int fq) const {
        const int row0 = u.pm * 256 + wr * 64 + fr, col0 = u.pn * 256 + wc * 32 + 4 * fq;
#pragma unroll
        for (int bj = 0; bj < 2; ++bj)
#pragma unroll
            for (int n = 0; n < 2; ++n) {
                const int col = col0 + bj * 128 + n * 16;
                const f32x4 gv = *(const f32x4*)(g1 + col);
#pragma unroll
                for (int ai = 0; ai < 2; ++ai)
#pragma unroll
                    for (int m = 0; m < 4; ++m) {
                        const size_t off = (size_t)(row0 + ai * 128 + m * 16) * 2048 + col;
                        *(f32x4*)(X1 + off) = *(const f32x4*)(X + off) + gv * acc[ai][bj][m][n];
                    }
            }
    }
};
struct EpiBf16 {
    static constexpr bool PERM = true;
    bf16_t* O; int ldc;
    __device__ __forceinline__ void operator()(const f32x4 (&acc)[2][2][4][2], const Unit& u, int wr, int wc, int fr, int fq) const {
        const int row0 = u.pm * 256 + wr * 64 + fr, col0 = u.pn * 256 + wc * 32 + 8 * fq;
#pragma unroll
        for (int ai = 0; ai < 2; ++ai)
#pragma unroll
            for (int m = 0; m < 4; ++m)
#pragma unroll
                for (int bj = 0; bj < 2; ++bj)
                    *(u32x4*)(O + (size_t)(row0 + ai * 128 + m * 16) * ldc + col0 + bj * 128) = pack8(acc[ai][bj][m][0], acc[ai][bj][m][1]);
    }
};
struct EpiSlab {
    static constexpr bool PERM = false;
    float* SL;
    __device__ __forceinline__ void operator()(const f32x4 (&acc)[2][2][4][2], const Unit& u, int wr, int wc, int fr, int fq) const {
        float* base = SL + (size_t)u.z * 2048 * 256;
        const int row0 = u.pm * 256 + wr * 64 + fr, col0 = wc * 32 + 4 * fq;
#pragma unroll
        for (int ai = 0; ai < 2; ++ai)
#pragma unroll
            for (int m = 0; m < 4; ++m)
#pragma unroll
                for (int bj = 0; bj < 2; ++bj)
#pragma unroll
                    for (int n = 0; n < 2; ++n)
                        *(f32x4*)(base + (size_t)(row0 + ai * 128 + m * 16) * 256 + col0 + bj * 128 + n * 16) = acc[ai][bj][m][n];
    }
};
struct CmpOrder {
    const bf16_t* KROW; const bf16_t* VROW; const bf16_t* W1; int lda, ldb, K; int G, c;
    __device__ bool next(int i, Unit& u) const {
        const int x = i * G + c; if (x >= 64) return false;
        const int kvsel = x >> 5, pm = (x & 31) >> 2, ks = x & 3; u.pm = pm; u.pn = 0; u.z = kvsel * 4 + ks; return true;
    }
    __device__ __forceinline__ const char* a_base(const Unit& u) const { return (const char*)(((u.z >> 2) ? VROW : KROW) + (size_t)u.pm * 256 * 2048 + (u.z & 3) * 1024); }
    __device__ __forceinline__ const char* b_base(const Unit& u) const { return (const char*)(W1 + (size_t)(u.z >> 2) * 256 * 4096 + (u.z & 3) * 1024); }
};
struct Ctx { int bid, nb, tid, wave, lane; LAS unsigned char* lds; };

__device__ __forceinline__ void p0_cond(const Args& a, const Ctx& c) {
    const float* cv = a.in[1]; const float* w = a.in[2]; float* condp = (float*)(a.ws + WS_CONDP);
    for (int u = c.bid * 8 + c.wave; u < 1536; u += c.nb * 8) {
        const int cc = u % 48, kc = u / 48;
        const float* wp = w + (size_t)(kc * 64) * NADA + cc * 256 + c.lane * 4;
        f32x4 acc = {0.f, 0.f, 0.f, 0.f};
#pragma unroll 16
        for (int k = 0; k < 64; ++k) { const float x = cv[kc * 64 + k]; const float s = x / (1.f + __expf(-x)); acc += s * *(const f32x4*)(wp + (size_t)k * NADA); }
        *(f32x4*)(condp + (size_t)kc * NADA + cc * 256 + c.lane * 4) = acc;
    }
}
__device__ __forceinline__ void conv_T(const float* src, int K, int N, bf16_t* dst, int Npad, const Ctx& c) {
    LAS float* tile = (LAS float*)c.lds;
    const int nkt = K / 64, ntiles = nkt * (Npad / 64);
    const int r = c.tid >> 4, c4 = c.tid & 15;
    f32x4 v[2];
#define CONVT_LD(tix_) do { const int nt_ = (tix_) / nkt, kt_ = (tix_) % nkt, n_ = nt_ * 64 + 4 * c4; _Pragma("unroll") for (int i = 0; i < 2; ++i) { const int k_ = kt_ * 64 + r + 32 * i; v[i] = (f32x4){0.f, 0.f, 0.f, 0.f}; if (n_ < N) v[i] = *(const f32x4*)(src + (size_t)k_ * N + n_); } } while (0)
    if (c.bid < ntiles) CONVT_LD(c.bid);
    for (int tix = c.bid; tix < ntiles; tix += c.nb) {
        const int nt = tix / nkt, kt = tix % nkt;
#pragma unroll
        for (int i = 0; i < 2; ++i) { LAS float* tp = tile + (r + 32 * i) * 65 + 4 * c4; tp[0] = v[i][0]; tp[1] = v[i][1]; tp[2] = v[i][2]; tp[3] = v[i][3]; }
        __syncthreads();
        if (tix + c.nb < ntiles) CONVT_LD(tix + c.nb);
        { const int n = c.tid >> 3, kq = c.tid & 7; float w[8];
#pragma unroll
          for (int j = 0; j < 8; ++j) w[j] = tile[(kq * 8 + j) * 65 + n];
          u32x4 o; o[0] = cvt_pk_bf16(w[0], w[1]); o[1] = cvt_pk_bf16(w[2], w[3]); o[2] = cvt_pk_bf16(w[4], w[5]); o[3] = cvt_pk_bf16(w[6], w[7]);
          *(u32x4*)(dst + (size_t)(nt * 64 + n) * K + kt * 64 + kq * 8) = o; }
        __syncthreads();
    }
#undef CONVT_LD
}
__device__ __forceinline__ void conv_fp6rows(const float* src, unsigned char* dst6, float* scl, int rows, const Ctx& c) {
    for (int row = c.bid * 8 + c.wave; row < rows; row += c.nb * 8) {
        const float* sp = src + (size_t)row * 2048 + c.lane * 32;
        f32x4 v[8]; float mx = 0.f;
#pragma unroll
        for (int j = 0; j < 8; ++j) { v[j] = *(const f32x4*)(sp + j * 4); mx = fmaxf(mx, fmaxf(fmaxf(fabsf(v[j][0]), fabsf(v[j][1])), fmaxf(fabsf(v[j][2]), fabsf(v[j][3])))); }
        mx = wave_max(mx);
        const float s = mx > 0.f ? 7.5f / mx : 1.f;
        if (c.lane == 0) scl[row] = mx > 0.f ? mx * (1.f / 7.5f) : 1.f;
        f32x16 x, y;
#pragma unroll
        for (int j = 0; j < 4; ++j)
#pragma unroll
            for (int e = 0; e < 4; ++e) { const int i = j * 4 + e;
                x[i] = v[(2 * i) >> 2][(2 * i) & 3] * s; y[i] = v[(2 * i + 1) >> 2][(2 * i + 1) & 3] * s; }
        const u32x6 pk = __builtin_amdgcn_cvt_scalef32_2xpk16_fp6_f32(x, y, 1.0f);
        unsigned char* dp = dst6 + (size_t)row * 1536 + c.lane * 24;
        *(u32x2*)dp = (u32x2){pk[0], pk[1]}; *(u32x2*)(dp + 8) = (u32x2){pk[2], pk[3]}; *(u32x2*)(dp + 16) = (u32x2){pk[4], pk[5]};
    }
}
__device__ __forceinline__ void conv_E(const float* src, bf16_t* dst, size_t n8, const Ctx& c) {
    const size_t stride = (size_t)c.nb * NTHREADS;
    for (size_t i = (size_t)c.bid * NTHREADS + c.tid; i < n8; i += stride) {
        const f32x4 x = *(const f32x4*)(src + i * 8), y = *(const f32x4*)(src + i * 8 + 4);
        *(u32x4*)(dst + i * 8) = pack8(x, y);
    }
}
__device__ __forceinline__ int t5_bucket(int n) {
    if (n < 16) return n;
    const float scaled = logf((float)n / 16.f) / logf(64.f);
    const int large = 16 + (int)(scaled * 16.f);
    return large < 31 ? large : 31;
}
__device__ __forceinline__ void p0_tb(const Args& a, const Ctx& c) {
    float* tb = (float*)(a.ws + WS_TB); const float* rb = a.in[26];
    for (int i = c.bid * NTHREADS + c.tid; i < 8 * TBN; i += c.nb * NTHREADS) { const int head = i / TBN, dist = i % TBN; tb[i] = rb[t5_bucket(dist) * 8 + head] * LOG2E; }
}
__device__ __forceinline__ void p0_bpe(const Args& a, const Ctx& c, int part) {
    const int n = c.tid & 255, kv = c.tid >> 8;
    const float* pe = a.in[kv ? 23 : 20]; const float* w1 = a.in[kv ? 24 : 21]; float* bpep = (float*)(a.ws + WS_BPEP);
    float s = 0.f;
#pragma unroll 16
    for (int k = part * 128; k < part * 128 + 128; ++k) s += pe[k] * w1[(size_t)k * 256 + n];
    bpep[(part * 2 + kv) * 256 + n] = s;
}
__device__ __forceinline__ void p0_s5(const Args& a, const Ctx& c, int g) {
    LAS float* ar = (LAS float*)c.lds;
    LAS float* ai = ar + 17 * 64;
    LAS float* bbr = ai + 17 * 64;
    LAS float* bbi = bbr + 1024;
    LAS float* cr = bbi + 1024;
    LAS float* ci = cr + 1024;
    LAS float* kd = ci + 1024;
    const int tid = c.tid;
    if (tid < 64) {
        const int p = tid; const float dt = expf(a.in[12][g]); const float lr = a.in[10][g * 64 + p], li = a.in[11][g * 64 + p];
        for (int d = 0; d <= 16; ++d) { const float mag = expf(lr * dt * (float)d), ang = li * dt * (float)d; ar[d * 64 + p] = mag * cosf(ang); ai[d * 64 + p] = mag * sinf(ang); }
        const float nr = ar[64 + p] - 1.f, ni = ai[64 + p], den = lr * lr + li * li;
        const float wre = (nr * lr + ni * li) / den, wim = (ni * lr - nr * li) / den;
        for (int h = 0; h < 16; ++h) { const float br = a.in[13][(g * 64 + p) * 16 + h], bi = a.in[14][(g * 64 + p) * 16 + h]; bbr[p * 16 + h] = wre * br - wim * bi; bbi[p * 16 + h] = wre * bi + wim * br; }
        float* s5p = (float*)(a.ws + WS_S5P);
        float xr = ar[16 * 64 + p], xi = ai[16 * 64 + p];
        s5p[(g * 64 + p) * 2] = xr; s5p[(g * 64 + p) * 2 + 1] = xi;
        for (int s = 0; s < 8; ++s) { const float tr = xr * xr - xi * xi, ti = 2.f * xr * xi; xr = tr; xi = ti; }
        s5p[64 * 64 * 2 + (g * 64 + p) * 2] = xr; s5p[64 * 64 * 2 + (g * 64 + p) * 2 + 1] = xi;
    }
    for (int e = tid; e < 1024; e += NTHREADS) { cr[e] = a.in[15][g * 1024 + e]; ci[e] = a.in[16][g * 1024 + e]; }
    __syncthreads();
    for (int e = tid; e < 4096; e += NTHREADS) {
        const int d = e >> 8, h1 = (e >> 4) & 15, h = e & 15; float s = 0.f;
        for (int p = 0; p < 64; ++p) { const float Cr = cr[h1 * 64 + p], Ci = ci[h1 * 64 + p], Ar = ar[d * 64 + p], Ai = ai[d * 64 + p];
            const float Gr = Cr * Ar - Ci * Ai, Gi = Cr * Ai + Ci * Ar; s += Gr * bbr[p * 16 + h] - Gi * bbi[p * 16 + h]; }
        if (d == 0 && h1 == h) s += a.in[17][g * 16 + h];
        kd[e] = s;
    }
    __syncthreads();
    bf16_t* MT = (bf16_t*)(a.ws + WS_S5MT) + (size_t)g * 65536;
    bf16_t* WE = (bf16_t*)(a.ws + WS_S5WE) + (size_t)g * 32768;
    bf16_t* WC = (bf16_t*)(a.ws + WS_S5WC) + (size_t)g * 32768;
    for (int e = tid; e < 65536; e += NTHREADS) { const int n = e >> 8, k = e & 255, j = n >> 4, h1 = n & 15, i = k >> 4, h = k & 15;
        MT[e] = f2bf(i <= j ? kd[(j - i) * 256 + h1 * 16 + h] : 0.f); }
    for (int e = tid; e < 32768; e += NTHREADS) { const int n = e >> 8, k = e & 255, cc = n >> 6, p = n & 63, i = k >> 4, h = k & 15;
        const float Ar = ar[(15 - i) * 64 + p], Ai = ai[(15 - i) * 64 + p], Br = bbr[p * 16 + h], Bi = bbi[p * 16 + h];
        WE[e] = f2bf(cc ? (Ar * Bi + Ai * Br) : (Ar * Br - Ai * Bi)); }
    for (int e = tid; e < 32768; e += NTHREADS) { const int n = e >> 7, k = e & 127, j = n >> 4, h1 = n & 15, cc = k >> 6, p = k & 63;
        const float Cr = cr[h1 * 64 + p], Ci = ci[h1 * 64 + p], Ar = ar[(j + 1) * 64 + p], Ai = ai[(j + 1) * 64 + p];
        WC[e] = f2bf(cc ? -(Cr * Ai + Ci * Ar) : (Cr * Ar - Ci * Ai)); }
    __syncthreads();
}
__device__ __forceinline__ void p0_prologue(const Args& a, const Ctx& c) {
    for (int g = c.bid; g < 64; g += c.nb) p0_s5(a, c, g);
    for (int u = 0; u < 32; ++u) if (c.bid == (64 + u) % c.nb) p0_bpe(a, c, u);
    p0_tb(a, c);
    p0_cond(a, c);
    conv_T(a.in[6], 2048, DIN, (bf16_t*)(a.ws + WS_WIN), DIN_PAD, c);
    conv_T(a.in[18], 1024, 1024, (bf16_t*)(a.ws + WS_WGLU), 1024, c);
    conv_T(a.in[7], 2048, 2048, (bf16_t*)(a.ws + WS_WOUT), 2048, c);
    conv_T(a.in[27], 2048, 2048, (bf16_t*)(a.ws + WS_WQ), 2048, c);
    conv_T(a.in[21], 4096, 256, (bf16_t*)(a.ws + WS_W1), 256, c);
    conv_T(a.in[24], 4096, 256, (bf16_t*)(a.ws + WS_W1) + 256 * 4096, 256, c);
    conv_T(a.in[22], 256, 128, (bf16_t*)(a.ws + WS_W2), 128, c);
    conv_T(a.in[25], 256, 128, (bf16_t*)(a.ws + WS_W2) + 128 * 256, 128, c);
    conv_E(a.in[28], (bf16_t*)(a.ws + WS_PK), 128 * 128 / 8, c);
    conv_E(a.in[29], (bf16_t*)(a.ws + WS_PK) + 128 * 128, 128 * 128 / 8, c);
    conv_fp6rows(a.in[30], a.ws + WS_PU, (float*)(a.ws + WS_PSC), 16384, c);
    conv_fp6rows(a.in[31], a.ws + WS_PV, (float*)(a.ws + WS_PSC) + 16384, 16384, c);
}

__device__ __forceinline__ void norm_rows(const float* X, bf16_t* O, LAS const float* Ab, LAS const float* Bb, const Ctx& c) {
    for (int t = c.bid * 8 + c.wave; t < L_; t += c.nb * 8) {
        const float* xr = X + (size_t)t * 2048 + c.lane * 4;
        f32x4 v[8]; float ss = 0.f;
#pragma unroll
        for (int j = 0; j < 8; ++j) { v[j] = *(const f32x4*)(xr + j * 256); ss += v[j][0] * v[j][0] + v[j][1] * v[j][1] + v[j][2] * v[j][2] + v[j][3] * v[j][3]; }
        ss = wave_sum(ss);
        const float rstd = rsqrtf(ss * (1.f / 2048.f) + 1e-6f);
#pragma unroll
        for (int j = 0; j < 8; ++j) {
            const int col = j * 256 + c.lane * 4;
            const f32x4 A = *(const LAS f32x4*)(Ab + col), B = *(const LAS f32x4*)(Bb + col);
            const f32x4 o = v[j] * rstd * A + B;
            u32x2 w; w[0] = cvt_pk_bf16(o[0], o[1]); w[1] = cvt_pk_bf16(o[2], o[3]);
            *(u32x2*)(O + (size_t)t * 2048 + col) = w;
        }
    }
}
__device__ __forceinline__ float cond_from_partials(const float* condp, const float* b_ada, int j) {
    float s = b_ada[j];
#pragma unroll 8
    for (int k = 0; k < 32; ++k) s += condp[(size_t)k * NADA + j];
    return s;
}
__device__ __forceinline__ void p1_hnorm(const Args& a, const Ctx& c) {
    const float* condp = (const float*)(a.ws + WS_CONDP); float* cond = (float*)(a.ws + WS_COND);
    for (int j = c.bid * NTHREADS + c.tid; j < NADA; j += c.nb * NTHREADS) cond[j] = cond_from_partials(condp, a.in[3], j);
    LAS float* Ab = (LAS float*)c.lds; LAS float* Bb = Ab + 2048;
    for (int col = c.tid; col < 2048; col += NTHREADS) {
        Ab[col] = a.in[4][col] * (1.f + cond_from_partials(condp, a.in[3], 2048 + col)); Bb[col] = cond_from_partials(condp, a.in[3], col); }
    __syncthreads();
    norm_rows(a.in[0], (bf16_t*)(a.ws + WS_H), Ab, Bb, c);
}
__device__ __forceinline__ void p8_h2norm(const Args& a, const Ctx& c) {
    const float* cond = (const float*)(a.ws + WS_COND);
    LAS float* Ab = (LAS float*)c.lds; LAS float* Bb = Ab + 2048;
    for (int col = c.tid; col < 2048; col += NTHREADS) { Ab[col] = a.in[5][col] * (1.f + cond[4 * 2048 + col]); Bb[col] = cond[3 * 2048 + col]; }
    __syncthreads();
    norm_rows(a.out, (bf16_t*)(a.ws + WS_H), Ab, Bb, c);
}
__device__ __forceinline__ void p6_mixnorm(const Args& a, const Ctx& c) {
    const bf16_t* YS = (const bf16_t*)(a.ws + WS_YSSM); const bf16_t* YA = (const bf16_t*)(a.ws + WS_YATT); bf16_t* O = (bf16_t*)(a.ws + WS_H);
    for (int t = c.bid * 8 + c.wave; t < L_; t += c.nb * 8) {
#pragma unroll
        for (int part = 0; part < 2; ++part) {
            const bf16_t* src = (part ? YA : YS) + (size_t)t * 1024 + c.lane * 8; const float* beta = a.in[part ? 9 : 8];
            u32x4 w[2]; float f[16]; float ss = 0.f;
#pragma unroll
            for (int j = 0; j < 2; ++j) { w[j] = *(const u32x4*)(src + j * 512);
#pragma unroll
                for (int e = 0; e < 4; ++e) { f[j * 8 + 2 * e] = bflo(w[j][e]); f[j * 8 + 2 * e + 1] = bfhi(w[j][e]); } }
#pragma unroll
            for (int e = 0; e < 16; ++e) ss += f[e] * f[e];
            ss = wave_sum(ss);
            const float rstd = rsqrtf(ss * (1.f / 1024.f) + 1e-6f);
#pragma unroll
            for (int j = 0; j < 2; ++j) { const int col = j * 512 + c.lane * 8; const f32x4 b0 = *(const f32x4*)(beta + col), b1 = *(const f32x4*)(beta + col + 4);
                f32x4 o0, o1;
#pragma unroll
                for (int e = 0; e < 4; ++e) { o0[e] = f[j * 8 + e] * rstd * b0[e]; o1[e] = f[j * 8 + 4 + e] * rstd * b1[e]; }
                *(u32x4*)(O + (size_t)t * 2048 + part * 1024 + col) = pack8(o0, o1); }
        }
    }
}
constexpr int S5_US = 0, S5_ES = 33792, S5_SS = 67584;
template <int PASS>
__device__ __forceinline__ void s5_item(const Args& a, const Ctx& c, int g, int seg) {
    LAS unsigned char* lds = c.lds;
    const int tid = c.tid, wave = c.wave, lane = c.lane, r = lane & 15, q = lane >> 4;
    const bf16_t* U = (const bf16_t*)(a.ws + WS_US);
    const bf16_t* MT = (const bf16_t*)(a.ws + WS_S5MT) + (size_t)g * 65536;
    const bf16_t* WE = (const bf16_t*)(a.ws + WS_S5WE) + (size_t)g * 32768;
    const bf16_t* WC = (const bf16_t*)(a.ws + WS_S5WC) + (size_t)g * 32768;
    const float* s5p = (const float*)(a.ws + WS_S5P);
    float* F = (float*)(a.ws + WS_S5F) + (size_t)g * 4 * 128;
    bf16_t* Z = (bf16_t*)(a.ws + WS_Z);
    bf16x8 bE[8];
#pragma unroll
    for (int ks = 0; ks < 8; ++ks) bE[ks] = *(const bf16x8*)(WE + (size_t)(16 * wave + r) * 256 + 32 * ks + 8 * q);
    float sr = 0.f, si = 0.f, a16r = 0.f, a16i = 0.f;
    if (wave == 0) {
        a16r = s5p[(g * 64 + lane) * 2]; a16i = s5p[(g * 64 + lane) * 2 + 1];
        if (PASS == 1) { const float br = s5p[8192 + (g * 64 + lane) * 2], bi = s5p[8192 + (g * 64 + lane) * 2 + 1];
            for (int s = 0; s < seg; ++s) { const float fr_ = F[s * 128 + lane], fi_ = F[s * 128 + 64 + lane]; const float nr = br * sr - bi * si + fr_, ni = br * si + bi * sr + fi_; sr = nr; si = ni; } }
    }
    for (int sb = 0; sb < 4; ++sb) {
        const int tok0 = seg * 4096 + sb * 1024;
#pragma unroll
        for (int i = 0; i < 4; ++i) { const int ch = tid + NTHREADS * i, token = ch >> 1, half = ch & 1;
            const u32x4 v = *(const u32x4*)(U + (size_t)(tok0 + token) * 1024 + g * 16 + half * 8);
            *(LAS u32x4*)(lds + S5_US + (token >> 4) * 528 + ((token & 15) * 16 + half * 8) * 2) = v; }
        __syncthreads();
#pragma unroll
        for (int m = 0; m < 4; ++m) {
            f32x4 acc = {0.f, 0.f, 0.f, 0.f};
#pragma unroll
            for (int ks = 0; ks < 8; ++ks) { const bf16x8 A = *(const LAS bf16x8*)(lds + S5_US + (16 * m + r) * 528 + (32 * ks + 8 * q) * 2); acc = mfma16(A, bE[ks], acc); }
#pragma unroll
            for (int i = 0; i < 4; ++i) *(LAS float*)(lds + S5_ES + ((16 * m + 4 * q + i) * 132 + 16 * wave + r) * 4) = acc[i];
        }
        __syncthreads();
        if (wave == 0) {
            for (int ch = 0; ch < 64; ++ch) {
                const float er = *(const LAS float*)(lds + S5_ES + (ch * 132 + lane) * 4), ei = *(const LAS float*)(lds + S5_ES + (ch * 132 + 64 + lane) * 4);
                if (PASS == 1) { *(LAS bf16_t*)(lds + S5_SS + (ch * 136 + lane) * 2) = f2bf(sr); *(LAS bf16_t*)(lds + S5_SS + (ch * 136 + 64 + lane) * 2) = f2bf(si); }
                const float nr = a16r * sr - a16i * si + er, ni = a16r * si + a16i * sr + ei; sr = nr; si = ni;
            }
        }
        __syncthreads();
        if (PASS == 1) {
#pragma unroll
            for (int nt = 0; nt < 2; ++nt) {
                const int j = 2 * wave + nt;
                f32x4 acc[4];
#pragma unroll
                for (int m = 0; m < 4; ++m) acc[m] = (f32x4){0.f, 0.f, 0.f, 0.f};
                for (int ks = 0; ks <= (j >> 1); ++ks) {
                    const bf16x8 B = *(const bf16x8*)(MT + (size_t)(16 * j + r) * 256 + 32 * ks + 8 * q);
#pragma unroll
                    for (int m = 0; m < 4; ++m) { const bf16x8 A = *(const LAS bf16x8*)(lds + S5_US + (16 * m + r) * 528 + (32 * ks + 8 * q) * 2); acc[m] = mfma16(A, B, acc[m]); }
                }
#pragma unroll
                for (int ks = 0; ks < 4; ++ks) {
                    const bf16x8 B = *(const bf16x8*)(WC + (size_t)(16 * j + r) * 128 + 32 * ks + 8 * q);
#pragma unroll
                    for (int m = 0; m < 4; ++m) { const bf16x8 A = *(const LAS bf16x8*)(lds + S5_SS + (16 * m + r) * 272 + (32 * ks + 8 * q) * 2); acc[m] = mfma16(A, B, acc[m]); }
                }
#pragma unroll
                for (int m = 0; m < 4; ++m)
#pragma unroll
                    for (int i = 0; i < 4; ++i) { const int ch = 16 * m + 4 * q + i; Z[(size_t)(tok0 + 16 * ch + j) * 1024 + g * 16 + r] = f2bf(gelu_tanh(acc[m][i])); }
            }
            __syncthreads();
        }
    }
    if (PASS == 0 && wave == 0) { F[seg * 128 + lane] = sr; F[seg * 128 + 64 + lane] = si; }
}

__device__ __forceinline__ void cmp_finish_item(const Args& a, const Ctx& c, int kvsel, int rt) {
    LAS unsigned char* lds = c.lds;
    const int tid = c.tid, wave = c.wave, lane = c.lane, r = lane & 15, q = lane >> 4;
    const float* SL = (const float*)(a.ws + WS_SLAB) + (size_t)kvsel * 4 * 2048 * 256;
    const float* bpep = (const float*)(a.ws + WS_BPEP) + kvsel * 256;
    const bf16_t* W2 = (const bf16_t*)(a.ws + WS_W2) + kvsel * 128 * 256;
    for (int e = tid; e < 64 * 64; e += NTHREADS) {
        const int row = e >> 6, c4 = (e & 63) * 4;
        f32x4 s = {0.f, 0.f, 0.f, 0.f};
#pragma unroll 8
        for (int pt = 0; pt < 32; ++pt) s += *(const f32x4*)(bpep + pt * 512 + c4);
#pragma unroll
        for (int ks = 0; ks < 4; ++ks) s += *(const f32x4*)(SL + ((size_t)ks * 2048 + rt * 64 + row) * 256 + c4);
        u32x2 w; w[0] = cvt_pk_bf16(gelu_tanh(s[0]), gelu_tanh(s[1])); w[1] = cvt_pk_bf16(gelu_tanh(s[2]), gelu_tanh(s[3]));
        *(LAS u32x2*)(lds + row * 528 + c4 * 2) = w;
    }
    __syncthreads();
    bf16x8 B[8];
#pragma unroll
    for (int ks = 0; ks < 8; ++ks) B[ks] = *(const bf16x8*)(W2 + (size_t)(16 * wave + r) * 256 + 32 * ks + 8 * q);
#pragma unroll
    for (int m = 0; m < 4; ++m) {
        f32x4 acc = {0.f, 0.f, 0.f, 0.f};
#pragma unroll
        for (int ks = 0; ks < 8; ++ks) { const bf16x8 A = *(const LAS bf16x8*)(lds + (16 * m + r) * 528 + (32 * ks + 8 * q) * 2); acc = mfma16(A, B[ks], acc); }
#pragma unroll
        for (int i = 0; i < 4; ++i) {
            const int row = rt * 64 + 16 * m + 4 * q + i, gi = row >> 10, ci = row & 1023, n = 16 * wave + r;
            const bf16_t v = (ci == 1023) ? (bf16_t)0 : f2bf(acc[i]);
            if (kvsel == 0) ((bf16_t*)(a.ws + WS_KC))[((size_t)gi * 1024 + ci) * 128 + n] = v;
            else ((bf16_t*)(a.ws + WS_VCT))[((size_t)gi * 128 + n) * 1024 + ((ci & ~12) | ((ci & 4) << 1) | ((ci & 8) >> 1))] = v;
        }
    }
    __syncthreads();
}
constexpr int AT_IMP = 65536, AT_TB = 131072, AT_BM = 143872, AT_WU = 145920, AT_END = 146176;
__device__ __forceinline__ int kswz(int r) { return ((r & 3) << 2) | ((r >> 2) & 3); }
__host__ __device__ __forceinline__ int vperm(int t) { return (t & ~12) | ((t & 4) << 1) | ((t & 8) >> 1); }
template <int KEYS> __device__ __forceinline__ int vsw(int d) { return KEYS == 128 ? kswz(d) : ((d >> 1) & 7); }
template <int KEYS, bool NEEDV>
__device__ __forceinline__ void stage_dma(const bf16_t* Kt, const bf16_t* Vt, int ldv, LAS unsigned char* kb, LAS unsigned char* vb, int wave, int lane) {
    constexpr int NP = KEYS / 32;
#pragma unroll
    for (int i = 0; i < NP; ++i) { const int pc = NP * wave + i, row = 4 * pc + (lane >> 4), ch = (lane & 15) ^ kswz(row);
        __builtin_amdgcn_global_load_lds((const unsigned*)(Kt + row * 128 + ch * 8), (LAS unsigned*)(kb + pc * 1024), 16, 0, 0); }
    if (NEEDV) {
#pragma unroll
        for (int i = 0; i < NP; ++i) {
            const int pc = NP * wave + i;
            if (KEYS == 128) { const int d = 4 * pc + (lane >> 4), ch = (lane & 15) ^ kswz(d);
                __builtin_amdgcn_global_load_lds((const unsigned*)(Vt + (size_t)d * ldv + 8 * ch), (LAS unsigned*)(vb + pc * 1024), 16, 0, 0); }
            else { const int d = 8 * pc + (lane >> 3), ch = (lane & 7) ^ ((d >> 1) & 7);
                __builtin_amdgcn_global_load_lds((const unsigned*)(Vt + (size_t)d * ldv + 8 * ch), (LAS unsigned*)(vb + pc * 1024), 16, 0, 0); }
        }
    }
}
__device__ __forceinline__ float xhalf_max(float x) { auto rr = __builtin_amdgcn_permlane32_swap(__float_as_uint(x), __float_as_uint(x), false, false); return fmaxf(__uint_as_float(rr[0]), __uint_as_float(rr[1])); }
__device__ __forceinline__ float xhalf_sum(float x) { auto rr = __builtin_amdgcn_permlane32_swap(__float_as_uint(x), __float_as_uint(x), false, false); return __uint_as_float(rr[0]) + __uint_as_float(rr[1]); }
template <int BR>
__device__ __forceinline__ float tile_prep(int MODE, f32x16& S, LAS const float* tb, float cb, int base, bool selbit) {
    float mx = -INFINITY;
    if (MODE == 1) {
#pragma unroll
        for (int r = 0; r < 16; ++r) mx = fmaxf(mx, S[r]);
        mx = (BR == 2 && !selbit) ? -INFINITY : mx + cb;
    } else {
        const bool nomask = (MODE == 2);
        float bv[16];
#pragma unroll
        for (int r = 0; r < 16; ++r) { const int cr = (r & 3) + 8 * (r >> 2); const int dist = (BR <= 1) ? base - 16 * cr : base - cr; bv[r] = tb[min(max(dist, 0), TBN - 1)]; }
        __builtin_amdgcn_sched_barrier(0);
#pragma unroll
        for (int r = 0; r < 16; ++r) {
            const int cr = (r & 3) + 8 * (r >> 2);
            const int dist = (BR <= 1) ? base - 16 * cr : base - cr;
            float v = S[r] + bv[r];
            bool valid;
            if (BR <= 1) valid = dist >= 0; else if (BR == 2) valid = selbit && dist >= 0; else valid = nomask || (unsigned)dist < 512u;
            v = valid ? v : -INFINITY;
            S[r] = v; mx = fmaxf(mx, v);
        }
    }
    return mx;
}
template <int BR, bool PEND>
__device__ __forceinline__ float tile_decide(int MODE, float mx, float cb, bool selbit, f32x16 (&O)[4], float& m, float& l, u32x4& pa, u32x4& pb) {
    if (BR == 1) { const float mu = (m == -INFINITY) ? 0.f : m; return (MODE == 1) ? mu - cb : mu; }
    mx = xhalf_max(mx);
    const float mn = fmaxf(m, mx), mu = (mn == -INFINITY) ? 0.f : mn;
    if (__any(mn > m)) {
        const float alpha = fexp2(m - mu);
        l *= alpha;
        if (BR >= 2) {
#pragma unroll
            for (int dt = 0; dt < 4; ++dt)
#pragma unroll
                for (int r = 0; r < 16; ++r) O[dt][r] *= alpha;
            if (PEND) {
#pragma unroll
                for (int e = 0; e < 4; ++e) { pa[e] = cvt_pk_bf16(bflo(pa[e]) * alpha, bfhi(pa[e]) * alpha); pb[e] = cvt_pk_bf16(bflo(pb[e]) * alpha, bfhi(pb[e]) * alpha); }
            }
        }
    }
    m = mn;
    if (MODE == 1) return (BR == 2 && !selbit) ? INFINITY : mu - cb;
    return mu;
}
template <int BR, int KEYS>
__device__ __forceinline__ void attn_tile(int MODE, LAS const unsigned char* kb, LAS const unsigned char* vb, int cb0, LAS const float* tb, int key0, int t, int lane,
                                          const bf16x8 (&qf)[8], f32x16 (&O)[4], float& m, float& l, float inv_l, bool selbit, LAS float* imp_row) {
    asm volatile("" : "+v"(lane));
    constexpr int ROWB = 2 * KEYS;
    const int r31 = lane & 31, h = lane >> 5;
    const int gh = kswz(r31) ^ h, vh = vsw<KEYS>(r31) ^ h;
    float cb = 0.f;
    if (MODE == 1) cb = tb[TBN - 1];
    const int base0 = (BR <= 1) ? t - 31 - 16 * (key0 + 4 * h) : t - (key0 + 4 * h);
    const int base1 = (BR <= 1) ? base0 - 16 * 32 : base0 - 32;
    LAS const unsigned char* k0 = kb + r31 * 256;
    f32x16 S0, S1;
    bf16x8 kf[8];
#pragma unroll
    for (int ks = 0; ks < 8; ++ks) kf[ks] = *(const LAS bf16x8*)(k0 + 16 * ((2 * ks) ^ gh));
#pragma unroll
    for (int r = 0; r < 16; ++r) { S0[r] = 0.f; S1[r] = 0.f; }
    __builtin_amdgcn_sched_barrier(0);
#pragma unroll
    for (int ks = 0; ks < 8; ++ks) S0 = mfma32(kf[ks], qf[ks], S0);
    __builtin_amdgcn_sched_barrier(0);
#pragma unroll
    for (int ks = 0; ks < 8; ++ks) kf[ks] = *(const LAS bf16x8*)(k0 + 8192 + 16 * ((2 * ks) ^ gh));
    const float mx0 = tile_prep<BR>(MODE, S0, tb, cb, base0, selbit);
    u32x4 pk0a = {0u, 0u, 0u, 0u}, pk0b = {0u, 0u, 0u, 0u}, pk1a, pk1b;
    const float me0 = tile_decide<BR, false>(MODE, mx0, cb, selbit, O, m, l, pk0a, pk0b);
    __builtin_amdgcn_sched_barrier(0);
    {
#pragma unroll
        for (int ks = 0; ks < 8; ++ks) S1 = mfma32(kf[ks], qf[ks], S1);
        float ps = 0.f;
#pragma unroll
        for (int r = 0; r < 16; ++r) { float p = fexp2(S0[r] - me0); if (BR == 1) p *= inv_l; S0[r] = p; ps += p; }
        if (BR != 1) l += ps;
        if (BR >= 1) {
#pragma unroll
            for (int e = 0; e < 4; ++e) { pk0a[e] = cvt_pk_bf16(S0[2 * e], S0[2 * e + 1]); pk0b[e] = cvt_pk_bf16(S0[8 + 2 * e], S0[8 + 2 * e + 1]); }
        }
#pragma unroll
        for (int i = 0; i < 8; ++i) { __builtin_amdgcn_sched_group_barrier(0x008, 1, 0); __builtin_amdgcn_sched_group_barrier(0x002, 8, 0); }
    }
    __builtin_amdgcn_sched_barrier(0);
    if (BR == 1) {
#pragma unroll
        for (int rg = 0; rg < 4; ++rg) {
            float A = 2.f * (S0[4 * rg] + S0[4 * rg + 1] + S0[4 * rg + 2]) + S0[4 * rg + 3], B = S0[4 * rg + 3];
            A = quad_sum(A); B = quad_sum(B);
            const int jj = (key0 >> 2) + 2 * rg + h;
            if ((lane & 3) == 0) { __hip_atomic_fetch_add(imp_row + jj, A, __ATOMIC_RELAXED, __HIP_MEMORY_SCOPE_WORKGROUP);
                if (jj + 1 < 256) __hip_atomic_fetch_add(imp_row + jj + 1, B, __ATOMIC_RELAXED, __HIP_MEMORY_SCOPE_WORKGROUP); }
        }
    }
    bf16x8 av[8];
    if (BR >= 1) {
#pragma unroll
        for (int s = 0; s < 2; ++s)
#pragma unroll
            for (int dt = 0; dt < 4; ++dt) av[s * 4 + dt] = *(const LAS bf16x8*)(vb + (32 * dt + r31) * ROWB + 16 * ((cb0 + 2 * s) ^ vh));
    }
    const float mx1 = tile_prep<BR>(MODE, S1, tb, cb, base1, selbit);
    const float me1 = tile_decide<BR, true>(MODE, mx1, cb, selbit, O, m, l, pk0a, pk0b);
    __builtin_amdgcn_sched_barrier(0);
    {
        if (BR >= 1) {
#pragma unroll
            for (int dt = 0; dt < 4; ++dt) O[dt] = mfma32(av[dt], __builtin_bit_cast(bf16x8, pk0a), O[dt]);
#pragma unroll
            for (int dt = 0; dt < 4; ++dt) O[dt] = mfma32(av[4 + dt], __builtin_bit_cast(bf16x8, pk0b), O[dt]);
        }
        float ps = 0.f;
#pragma unroll
        for (int r = 0; r < 16; ++r) { float p = fexp2(S1[r] - me1); if (BR == 1) p *= inv_l; S1[r] = p; ps += p; }
        if (BR != 1) l += ps;
        if (BR >= 1) {
#pragma unroll
            for (int e = 0; e < 4; ++e) { pk1a[e] = cvt_pk_bf16(S1[2 * e], S1[2 * e + 1]); pk1b[e] = cvt_pk_bf16(S1[8 + 2 * e], S1[8 + 2 * e + 1]); }
#pragma unroll
            for (int i = 0; i < 8; ++i) { __builtin_amdgcn_sched_group_barrier(0x008, 1, 0); __builtin_amdgcn_sched_group_barrier(0x002, 8, 0); }
        }
    }
    __builtin_amdgcn_sched_barrier(0);
    if (BR == 1) {
#pragma unroll
        for (int rg = 0; rg < 4; ++rg) {
            float A = 2.f * (S1[4 * rg] + S1[4 * rg + 1] + S1[4 * rg + 2]) + S1[4 * rg + 3], B = S1[4 * rg + 3];
            A = quad_sum(A); B = quad_sum(B);
            const int jj = ((key0 + 32) >> 2) + 2 * rg + h;
            if ((lane & 3) == 0) { __hip_atomic_fetch_add(imp_row + jj, A, __ATOMIC_RELAXED, __HIP_MEMORY_SCOPE_WORKGROUP);
                if (jj + 1 < 256) __hip_atomic_fetch_add(imp_row + jj + 1, B, __ATOMIC_RELAXED, __HIP_MEMORY_SCOPE_WORKGROUP); }
        }
    }
    if (BR >= 1) {
#pragma unroll
        for (int s = 0; s < 2; ++s)
#pragma unroll
            for (int dt = 0; dt < 4; ++dt) av[s * 4 + dt] = *(const LAS bf16x8*)(vb + (32 * dt + r31) * ROWB + 16 * ((cb0 + 4 + 2 * s) ^ vh));
        __builtin_amdgcn_sched_barrier(0);
#pragma unroll
        for (int dt = 0; dt < 4; ++dt) O[dt] = mfma32(av[dt], __builtin_bit_cast(bf16x8, pk1a), O[dt]);
#pragma unroll
        for (int dt = 0; dt < 4; ++dt) O[dt] = mfma32(av[4 + dt], __builtin_bit_cast(bf16x8, pk1b), O[dt]);
    }
}
template <int BR, int KEYS>
__device__ __forceinline__ void run_branch(const Ctx& c, const bf16_t* Kb, const bf16_t* Vtb, int ldv, int lo, int hi, LAS const float* tb, int t, int t0,
                                           const bf16x8 (&qf)[8], f32x16 (&O)[4], float& m, float& l, float inv_l, int tl, LAS float* imp_row) {
    constexpr bool NEEDV = (BR != 0);
    constexpr int BPS = KEYS / 64, KSTG = KEYS * 256, VSTG = 128 * 2 * KEYS, VB0 = 2 * KSTG;
    LAS unsigned char* lds = c.lds;
    int lz = c.lane; asm volatile("" : "+v"(lz));
    const int nst = (hi - lo + BPS - 1) / BPS;
#define STG_BLK(i) ((lo + BPS * (i) + BPS - 1 < hi) ? lo + BPS * (i) : hi - BPS)
    asm volatile("s_waitcnt vmcnt(0)" ::: "memory");
    { const int b0 = (BPS == 2 && hi - lo < 2) ? lo : STG_BLK(0);
      stage_dma<KEYS, NEEDV>(Kb + (size_t)b0 * 64 * 128, Vtb + (size_t)b0 * 64, ldv, lds, lds + VB0, c.wave, lz); }
    asm volatile("s_waitcnt vmcnt(0)" ::: "memory");
    __syncthreads();
    const int qt = t0 >> 6;
    for (int i = 0; i < nst; ++i) {
        const int buf = i & 1;
        if (i + 1 < nst) { int lz2 = lz; asm volatile("" : "+v"(lz2));
            const int b1 = STG_BLK(i + 1);
            stage_dma<KEYS, NEEDV>(Kb + (size_t)b1 * 64 * 128, Vtb + (size_t)b1 * 64, ldv, lds + (buf ^ 1) * KSTG, lds + VB0 + (buf ^ 1) * VSTG, c.wave, lz2); }
        const int sb = (BPS == 2 && hi - lo < 2) ? lo : STG_BLK(i);
#pragma unroll
        for (int q = 0; q < BPS; ++q) {
            const int j = lo + BPS * i + q;
            if (j < hi) {
                bool selbit = true, wave_on = true;
                if (BR == 2) {
                    const unsigned w = *(const LAS unsigned*)(lds + AT_BM + (tl * 8 + (j >> 5)) * 4);
                    selbit = (w >> (j & 31)) & 1u;
                    const unsigned wu = *(const LAS unsigned*)(lds + AT_WU + (c.wave * 8 + (j >> 5)) * 4);
                    wave_on = (wu >> (j & 31)) & 1u;
                }
                if (wave_on) {
                    int mode = 0;
                    if (BR <= 1) mode = (1024 * j + 1829 <= t0) ? 1 : 0;
                    else if (BR == 2) mode = (64 * j + 853 <= t0) ? 1 : 0;
                    else mode = (j >= qt - 7 && j <= qt - 1) ? 2 : 0;
                    const int slot = j - sb;
                    attn_tile<BR, KEYS>(mode, lds + buf * KSTG + slot * 16384, lds + VB0 + buf * VSTG, 8 * slot, tb, j * 64, t, c.lane, qf, O, m, l, inv_l, selbit, imp_row);
                }
            }
        }
        asm volatile("s_waitcnt vmcnt(0)" ::: "memory");
        __syncthreads();
    }
#undef STG_BLK
}
__device__ __forceinline__ void attn_item(const Args& a, const Ctx& c_, int qt, int g) {
    Ctx c = c_; { int tz = c_.tid; asm volatile("" : "+v"(tz)); c.tid = tz; c.lane = tz & 63; }
    LAS unsigned char* lds = c.lds;
    const int tid = c.tid, wave = c.wave, lane = c.lane, r31 = lane & 31, h = lane >> 5, hl = lane & 3;
    const int t0 = qt * 64, tl = 8 * wave + (r31 >> 2), t = t0 + tl, head = g * 4 + hl;
    const bf16_t* Qb = (const bf16_t*)(a.ws + WS_Q);
    const bf16_t* KROW = (const bf16_t*)(a.ws + WS_KROW);
    const bf16_t* VT = (const bf16_t*)(a.ws + WS_VT);
    const float* GATE = (const float*)(a.ws + WS_GATE);
    { const float* tbg = (const float*)(a.ws + WS_TB) + g * 4 * TBN;
      for (int i = tid; i < 4 * TBN; i += NTHREADS) *(LAS float*)(lds + AT_TB + i * 4) = tbg[i];
      for (int i = tid; i < 64 * 256; i += NTHREADS) *(LAS float*)(lds + AT_IMP + i * 4) = 0.f; }
    bf16x8 qf[8];
#pragma unroll
    for (int ks = 0; ks < 8; ++ks) qf[ks] = *(const bf16x8*)(Qb + (size_t)t * 1024 + head * 128 + 16 * ks + 8 * h);
    LAS const float* tb = (LAS const float*)(lds + AT_TB) + hl * TBN;
    LAS float* imp_row = (LAS float*)(lds + AT_IMP) + tl * 256;
    bf16_t* Y = (bf16_t*)(a.ws + WS_YATT) + (size_t)t * 1024 + head * 128 + 4 * h;
    f32x16 O[4];
#pragma unroll
    for (int dt = 0; dt < 4; ++dt)
#pragma unroll
        for (int r = 0; r < 16; ++r) O[dt][r] = 0.f;
    __syncthreads();
    { const int ntile = (t0 / 16 + 3 + 63) / 64;
      const bf16_t* KC = (const bf16_t*)(a.ws + WS_KC) + (size_t)g * 1024 * 128; const bf16_t* VCT = (const bf16_t*)(a.ws + WS_VCT) + (size_t)g * 128 * 1024;
      float m = -INFINITY, l = 0.f;
#if defined(PROBE_CMP)
      run_branch<0, 64>(c, KC, VCT, 1024, 0, ntile, tb, t, t0, qf, O, m, l, 0.f, tl, imp_row);
      asm volatile("" :: "v"(m), "v"(l));
      m = -INFINITY; l = 0.f;
#endif
      run_branch<0, 64>(c, KC, VCT, 1024, 0, ntile, tb, t, t0, qf, O, m, l, 0.f, tl, imp_row);
      const float lt = xhalf_sum(l), inv = lt > 0.f ? 1.f / lt : 0.f;
      run_branch<1, 64>(c, KC, VCT, 1024, 0, ntile, tb, t, t0, qf, O, m, l, inv, tl, imp_row);
      const float gc = GATE[(size_t)t * 24 + head];
#pragma unroll
      for (int dt = 0; dt < 4; ++dt)
#pragma unroll
          for (int rg = 0; rg < 4; ++rg) {
              u32x2 w; w[0] = cvt_pk_bf16(gc * O[dt][4 * rg], gc * O[dt][4 * rg + 1]); w[1] = cvt_pk_bf16(gc * O[dt][4 * rg + 2], gc * O[dt][4 * rg + 3]);
              *(u32x2*)(Y + 32 * dt + 8 * rg) = w;
#pragma unroll
              for (int e = 0; e < 4; ++e) O[dt][4 * rg + e] = 0.f;
          }
    }
    {
        unsigned wu[8];
#pragma unroll
        for (int k = 0; k < 8; ++k) wu[k] = 0u;
        const int ncand = qt - 2 > 0 ? qt - 2 : 0;
        for (int i = 0; i < 8; ++i) {
            LAS const float* row = (LAS const float*)(lds + AT_IMP) + (8 * wave + i) * 256;
            float v[4]; bool sel[4];
#pragma unroll
            for (int k = 0; k < 4; ++k) { const int j = lane + 64 * k; const bool cand = (j >= 1 && j <= qt - 2); v[k] = cand ? row[j] : -1.f; sel[k] = false; }
            if (ncand <= 13) {
#pragma unroll
                for (int k = 0; k < 4; ++k) sel[k] = v[k] >= 0.f;
            } else {
                for (int it = 0; it < 13; ++it) {
                    float mx = fmaxf(fmaxf(v[0], v[1]), fmaxf(v[2], v[3])); mx = wave_max_bcast(mx);
                    int wk = -1, wl = 0;
#pragma unroll
                    for (int k = 0; k < 4; ++k) { const unsigned long long mk = __ballot(v[k] == mx); if (wk < 0 && mk != 0ull) { wk = k; wl = __ffsll((long long)mk) - 1; } }
#pragma unroll
                    for (int k = 0; k < 4; ++k) if (k == wk && lane == wl) { v[k] = -1.f; sel[k] = true; }
                }
            }
#pragma unroll
            for (int k = 0; k < 4; ++k) {
                const int j = lane + 64 * k; const bool forced = (j == 0) || (j == qt) || (j == qt - 1);
                const unsigned long long mk = __ballot(sel[k] || forced);
                const unsigned lo = (unsigned)mk, hi = (unsigned)(mk >> 32);
                if (lane == 0) { *(LAS unsigned*)(lds + AT_BM + ((8 * wave + i) * 8 + 2 * k) * 4) = lo; *(LAS unsigned*)(lds + AT_BM + ((8 * wave + i) * 8 + 2 * k + 1) * 4) = hi; }
                wu[2 * k] |= lo; wu[2 * k + 1] |= hi;
            }
        }
        if (lane == 0) {
#pragma unroll
            for (int k = 0; k < 8; ++k) *(LAS unsigned*)(lds + AT_WU + (wave * 8 + k) * 4) = wu[k];
        }
    }
    __syncthreads();
#if defined(PROBE_SEL)
    { float m = -INFINITY, l = 0.f;
      run_branch<2, 128>(c, KROW + (size_t)(2 + g) * L_ * 128, VT + (size_t)g * 128 * L_, L_, 0, qt + 1, tb, t, t0, qf, O, m, l, 0.f, tl, imp_row);
      asm volatile("" :: "v"(O[0]), "v"(O[1]), "v"(O[2]), "v"(O[3]), "v"(m), "v"(l));
#pragma unroll
      for (int dt = 0; dt < 4; ++dt)
#pragma unroll
          for (int r = 0; r < 16; ++r) O[dt][r] = 0.f; }
#endif
    { float m = -INFINITY, l = 0.f;
      run_branch<2, 128>(c, KROW + (size_t)(2 + g) * L_ * 128, VT + (size_t)g * 128 * L_, L_, 0, qt + 1, tb, t, t0, qf, O, m, l, 0.f, tl, imp_row);
      const float gs = GATE[(size_t)t * 24 + 8 + head];
      const float lt = xhalf_sum(l), sc = gs * (lt > 0.f ? 1.f / lt : 0.f);
#pragma unroll
      for (int dt = 0; dt < 4; ++dt)
#pragma unroll
          for (int rg = 0; rg < 4; ++rg) {
              const u32x2 w0 = *(const u32x2*)(Y + 32 * dt + 8 * rg);
              u32x2 w; w[0] = cvt_pk_bf16(bflo(w0[0]) + sc * O[dt][4 * rg], bfhi(w0[0]) + sc * O[dt][4 * rg + 1]); w[1] = cvt_pk_bf16(bflo(w0[1]) + sc * O[dt][4 * rg + 2], bfhi(w0[1]) + sc * O[dt][4 * rg + 3]);
              *(u32x2*)(Y + 32 * dt + 8 * rg) = w;
#pragma unroll
              for (int e = 0; e < 4; ++e) O[dt][4 * rg + e] = 0.f;
          }
    }
#if defined(PROBE_WIN)
    { float m = -INFINITY, l = 0.f;
      const int lo = qt - 8 > 0 ? qt - 8 : 0;
      run_branch<3, 128>(c, KROW + (size_t)(4 + g) * L_ * 128, VT + (size_t)(2 + g) * 128 * L_, L_, lo, qt + 1, tb, t, t0, qf, O, m, l, 0.f, tl, imp_row);
      asm volatile("" :: "v"(O[0]), "v"(O[1]), "v"(O[2]), "v"(O[3]), "v"(m), "v"(l));
#pragma unroll
      for (int dt = 0; dt < 4; ++dt)
#pragma unroll
          for (int r = 0; r < 16; ++r) O[dt][r] = 0.f; }
#endif
    { float m = -INFINITY, l = 0.f;
      const int lo = qt - 8 > 0 ? qt - 8 : 0;
      run_branch<3, 128>(c, KROW + (size_t)(4 + g) * L_ * 128, VT + (size_t)(2 + g) * 128 * L_, L_, lo, qt + 1, tb, t, t0, qf, O, m, l, 0.f, tl, imp_row);
      const float gw = GATE[(size_t)t * 24 + 16 + head];
      const float lt = xhalf_sum(l), sc = gw * (lt > 0.f ? 1.f / lt : 0.f);
#pragma unroll
      for (int dt = 0; dt < 4; ++dt)
#pragma unroll
          for (int rg = 0; rg < 4; ++rg) {
              const u32x2 w0 = *(const u32x2*)(Y + 32 * dt + 8 * rg);
              u32x2 w; w[0] = cvt_pk_bf16(bflo(w0[0]) + sc * O[dt][4 * rg], bfhi(w0[0]) + sc * O[dt][4 * rg + 1]); w[1] = cvt_pk_bf16(bflo(w0[1]) + sc * O[dt][4 * rg + 2], bfhi(w0[1]) + sc * O[dt][4 * rg + 3]);
              *(u32x2*)(Y + 32 * dt + 8 * rg) = w;
          }
    }
    __syncthreads();
}
#ifndef PEER_ALPHA
#define PEER_ALPHA 1.0f
#endif
constexpr int PE_SC = 0, PE_LV = 66048, PE_LI = 74240, PE_EX = 147456, PE_GT = 151552, PE_SU = 155648, PE_END = 159744;
constexpr int PE_SLOT = 3072, PE_NSLOT = 6, PE_RINGW = PE_SLOT * PE_NSLOT;
static_assert(8 * PE_RINGW <= PE_EX && PE_END <= LDS_BYTES - 16, "PEER LDS map");
__device__ __forceinline__ float wave_sum_bcast(float v) {
    v += dpp_f<0xB1>(v); v += dpp_f<0x4E>(v); v += dpp_f<0x141>(v); v += dpp_f<0x140>(v);
    v += __int_as_float(__builtin_amdgcn_update_dpp(0, __float_as_int(v), 0x142, 0xa, 0xf, false));
    v += __int_as_float(__builtin_amdgcn_update_dpp(0, __float_as_int(v), 0x143, 0xc, 0xf, false));
    return __int_as_float(__builtin_amdgcn_readlane(__float_as_int(v), 63));
}
__device__ __forceinline__ unsigned mono_key(float v) { const unsigned b = __float_as_uint(v); return b ^ ((b >> 31) ? 0xFFFFFFFFu : 0x80000000u); }
template <int CTRL>
__device__ __forceinline__ void quad_merge16(unsigned (&t)[16]) {
    unsigned o[16];
#pragma unroll
    for (int i = 0; i < 16; ++i) o[i] = (unsigned)__builtin_amdgcn_update_dpp(0, (int)t[15 - i], CTRL, 0xf, 0xf, false);
#pragma unroll
    for (int i = 0; i < 16; ++i) t[i] = max(t[i], o[i]);
#pragma unroll
    for (int st = 8; st >= 1; st >>= 1)
#pragma unroll
        for (int i = 0; i < 16; ++i) if ((i & st) == 0) { const unsigned hi = max(t[i], t[i + st]), lo = min(t[i], t[i + st]); t[i] = hi; t[i + st] = lo; }
}
__device__ __forceinline__ int pair_a(int p) { return p < 16 ? 0 : p < 24 ? 1 : p < 29 ? 2 : p < 33 ? 3 : p < 36 ? 4 : p < 38 ? 5 : p < 40 ? 6 : p < 42 ? 7 : p - 34; }
__device__ __forceinline__ int pair_b(int p) { return p < 16 ? p : p < 24 ? p - 16 : p < 29 ? p - 24 : p < 33 ? p - 29 : p < 36 ? p - 33 : p < 38 ? p - 36 : p < 40 ? p - 38 : p < 42 ? p - 40 : 0; }
template <bool DRY>
__device__ __forceinline__ void peer_step(const Args& a, const Ctx& c_, int t0) {
    Ctx c = c_; { int tz = c_.tid; asm volatile("" : "+v"(tz)); c.tid = tz; c.lane = tz & 63; }
    LAS unsigned char* lds = c.lds;
    const int tid = c.tid, wave = c.wave, lane = c.lane, r = lane & 15, q = lane >> 4;
    const bf16_t* QP = (const bf16_t*)(a.ws + WS_QP); const bf16_t* PK = (const bf16_t*)(a.ws + WS_PK);
    const unsigned char* PU = a.ws + WS_PU; const unsigned char* PV = a.ws + WS_PV; const float* psc = (const float*)(a.ws + WS_PSC);
    const bf16_t* HB = (const bf16_t*)(a.ws + WS_H);
    {
        const int hh = wave;
#pragma unroll
        for (int cc = 0; cc < 2; ++cc) {
            bf16x8 aF[4];
#pragma unroll
            for (int ks = 0; ks < 4; ++ks) aF[ks] = *(const bf16x8*)(QP + (size_t)(t0 + (r & 7)) * 2048 + hh * 256 + cc * 128 + 32 * ks + 8 * q);
#pragma unroll 2
            for (int nt = 0; nt < 8; ++nt) {
                f32x4 acc = {0.f, 0.f, 0.f, 0.f};
#pragma unroll
                for (int ks = 0; ks < 4; ++ks) { const bf16x8 B = *(const bf16x8*)(PK + (size_t)(cc * 128 + 16 * nt + r) * 128 + 32 * ks + 8 * q); acc = mfma16(aF[ks], B, acc); }
                if (q < 2) {
#pragma unroll
                    for (int i = 0; i < 4; ++i) { const int tok = 4 * q + i; *(LAS float*)(lds + PE_SC + ((tok * 16 + hh * 2 + cc) * 129 + 16 * nt + r) * 4) = acc[i]; }
                }
            }
        }
    }
    __syncthreads();
    {
        const int task = tid >> 2, part = tid & 3;
        LAS const float* sc = (LAS const float*)(lds + PE_SC) + task * 129;
        float vals[32];
#pragma unroll
        for (int k = 0; k < 32; ++k) vals[k] = sc[32 * part + k];
        unsigned top[16];
#pragma unroll
        for (int e = 0; e < 16; ++e) top[e] = 0u;
#pragma unroll
        for (int k = 0; k < 32; ++k) {
            unsigned key = (mono_key(vals[k]) & ~0x7Fu) | (unsigned)(127 - (32 * part + k));
#pragma unroll
            for (int e = 0; e < 16; ++e) { const unsigned hi = max(top[e], key); key = min(top[e], key); top[e] = hi; }
        }
        quad_merge16<0xB1>(top);
        quad_merge16<0x4E>(top);
        if (part == 0) {
#pragma unroll
            for (int e = 0; e < 16; ++e) { const int idx = 127 - (int)(top[e] & 0x7Fu); *(LAS float*)(lds + PE_LV + (task * 16 + e) * 4) = sc[idx]; *(LAS int*)(lds + PE_LI + (task * 16 + e) * 4) = idx; }
        }
    }
    __syncthreads();
    if (tid < 256) {
        const int task = tid >> 2, part = tid & 3, tok = task >> 3, hh = task & 7, t1 = tok * 16 + hh * 2, t2 = t1 + 1;
        LAS const float* lv1 = (LAS const float*)(lds + PE_LV) + t1 * 16; LAS const float* lv2 = (LAS const float*)(lds + PE_LV) + t2 * 16;
        unsigned top[16];
#pragma unroll
        for (int e = 0; e < 16; ++e) top[e] = 0u;
        for (int p = part; p < 50; p += 4) {
            const int aa = pair_a(p), bb = pair_b(p);
            unsigned key = (mono_key(lv1[aa] + lv2[bb]) & ~0xFFu) | (unsigned)(255 - (aa * 16 + bb));
#pragma unroll
            for (int e = 0; e < 16; ++e) { const unsigned hi = max(top[e], key); key = min(top[e], key); top[e] = hi; }
        }
        quad_merge16<0xB1>(top);
        quad_merge16<0x4E>(top);
        if (part == 0) {
            LAS const int* li1 = (LAS const int*)(lds + PE_LI) + t1 * 16; LAS const int* li2 = (LAS const int*)(lds + PE_LI) + t2 * 16;
            float sv[16]; int ex[16]; float mx = -INFINITY;
#pragma unroll
            for (int e = 0; e < 16; ++e) {
                const int id = 255 - (int)(top[e] & 0xFFu), aa = id >> 4, bb = id & 15;
                sv[e] = lv1[aa] + lv2[bb]; ex[e] = li1[aa] * 128 + li2[bb]; mx = fmaxf(mx, sv[e]);
            }
            float sum = 0.f;
#pragma unroll
            for (int e = 0; e < 16; ++e) { sv[e] = fexp2((sv[e] - mx) * LOG2E); sum += sv[e]; }
            const float inv = 1.f / sum;
#pragma unroll
            for (int e = 0; e < 16; ++e) { *(LAS int*)(lds + PE_EX + (tok * 128 + hh * 16 + e) * 4) = ex[e];
                *(LAS float*)(lds + PE_GT + (tok * 128 + hh * 16 + e) * 4) = sv[e] * inv * psc[16384 + ex[e]];
                *(LAS float*)(lds + PE_SU + (tok * 128 + hh * 16 + e) * 4) = psc[ex[e]]; }
        }
    }
    __syncthreads();
    const int t = t0 + wave;
    float hp[32];
#pragma unroll
    for (int k = 0; k < 4; ++k) { const u32x4 w = *(const u32x4*)(HB + (size_t)t * 2048 + lane * 32 + k * 8);
#pragma unroll
        for (int e = 0; e < 4; ++e) { hp[k * 8 + 2 * e] = bflo(w[e]); hp[k * 8 + 2 * e + 1] = bfhi(w[e]); } }
    float acc[32];
#pragma unroll
    for (int e = 0; e < 32; ++e) acc[e] = 0.f;
    asm volatile("s_waitcnt vmcnt(0)" ::: "memory");
    {
        LAS const int* exl = (LAS const int*)(lds + PE_EX) + wave * 128; LAS const float* gtl = (LAS const float*)(lds + PE_GT) + wave * 128;
        LAS unsigned char* ring = lds + wave * PE_RINGW;
        LAS const float* sul = (LAS const float*)(lds + PE_SU) + wave * 128;
#define ROW_ISSUE(SL, IDX) do { const int ex_ = __builtin_amdgcn_readfirstlane(exl[IDX]); \
            const unsigned char* gu_ = PU + (size_t)ex_ * 1536; const unsigned char* gv_ = PV + (size_t)ex_ * 1536; \
            LAS unsigned char* sl_ = ring + (SL) * PE_SLOT;                   \
            __builtin_amdgcn_global_load_lds((const unsigned*)(gu_ + lane * 16), (LAS unsigned*)sl_, 16, 0, 0); \
            __builtin_amdgcn_global_load_lds((const unsigned*)((lane < 32 ? gu_ + 1024 : gv_ - 512) + lane * 16), (LAS unsigned*)(sl_ + 1024), 16, 0, 0); \
            __builtin_amdgcn_global_load_lds((const unsigned*)(gv_ + 512 + lane * 16), (LAS unsigned*)(sl_ + 2048), 16, 0, 0); \
            } while (0)
#define ROW_APPLY(SL, IDX) do { LAS const unsigned char* sl_ = ring + (SL) * PE_SLOT + lane * 24; \
            const u32x2 a0_ = *(const LAS u32x2*)sl_, a1_ = *(const LAS u32x2*)(sl_ + 8), a2_ = *(const LAS u32x2*)(sl_ + 16); \
            const f32x32 uf_ = __builtin_amdgcn_cvt_scalef32_pk32_f32_fp6((u32x6){a0_[0], a0_[1], a1_[0], a1_[1], a2_[0], a2_[1]}, 1.0f); \
            float d0_ = 0.f, d1_ = 0.f; \
            _Pragma("unroll") for (int i = 0; i < 32; i += 2) { d0_ += uf_[i] * hp[i]; d1_ += uf_[i + 1] * hp[i + 1]; } \
            const float d_ = wave_sum_bcast(d0_ + d1_) * sul[IDX]; \
            const float wgt_ = gtl[IDX] * gelu_tanh(d_); \
            const u32x2 b0_ = *(const LAS u32x2*)(sl_ + 1536), b1_ = *(const LAS u32x2*)(sl_ + 1544), b2_ = *(const LAS u32x2*)(sl_ + 1552); \
            const f32x32 vf_ = __builtin_amdgcn_cvt_scalef32_pk32_f32_fp6((u32x6){b0_[0], b0_[1], b1_[0], b1_[1], b2_[0], b2_[1]}, 1.0f); \
            _Pragma("unroll") for (int i = 0; i < 32; ++i) acc[i] += wgt_ * vf_[i]; \
            asm volatile("s_waitcnt lgkmcnt(0)" ::: "memory"); } while (0)
#define DMA_WAIT(N) asm volatile("s_waitcnt vmcnt(" #N ")" ::: "memory")
        ROW_ISSUE(0, 0); ROW_ISSUE(1, 1); ROW_ISSUE(2, 2); ROW_ISSUE(3, 3); ROW_ISSUE(4, 4); ROW_ISSUE(5, 5);
#pragma unroll 1
        for (int e = 0; e < 126; e += 6) {
            const bool last = (e == 120);
            DMA_WAIT(15); ROW_APPLY(0, e);     ROW_ISSUE(0, e + 6);
            DMA_WAIT(15); ROW_APPLY(1, e + 1); ROW_ISSUE(1, e + 7);
            DMA_WAIT(15); ROW_APPLY(2, e + 2); if (!last) ROW_ISSUE(2, e + 8);
            if (last) DMA_WAIT(0); else DMA_WAIT(15);
            ROW_APPLY(3, e + 3); if (!last) ROW_ISSUE(3, e + 9);
            if (!last) DMA_WAIT(15);
            ROW_APPLY(4, e + 4); if (!last) ROW_ISSUE(4, e + 10);
            if (!last) DMA_WAIT(15);
            ROW_APPLY(5, e + 5); if (!last) ROW_ISSUE(5, e + 11);
        }
        ROW_APPLY(0, 126);
        ROW_APPLY(1, 127);
#undef ROW_ISSUE
#undef ROW_APPLY
#undef DMA_WAIT
    }
    {
        float* xo = a.out + (size_t)t * 2048; const float* g2 = (const float*)(a.ws + WS_COND) + 5 * 2048; const float* fg = a.in[32];
        float ss = 0.f;
#pragma unroll
        for (int k = 0; k < 8; ++k) {
            const int col = lane * 32 + k * 4;
            const f32x4 x1 = *(const f32x4*)(xo + col), gv = *(const f32x4*)(g2 + col);
#pragma unroll
            for (int e = 0; e < 4; ++e) { const float x2 = x1[e] + PEER_ALPHA * gv[e] * acc[k * 4 + e]; acc[k * 4 + e] = x2; ss += x2 * x2; }
        }
        ss = wave_sum_bcast(ss);
        const float rstd = rsqrtf(ss * (1.f / 2048.f) + 1e-6f);
#pragma unroll
        for (int k = 0; k < 8; ++k) {
            const int col = lane * 32 + k * 4;
            const f32x4 fv = *(const f32x4*)(fg + col);
            f32x4 o;
#pragma unroll
            for (int e = 0; e < 4; ++e) o[e] = acc[k * 4 + e] * rstd * fv[e];
            if (!DRY || rstd == 123.456f) *(f32x4*)(xo + col) = o;
        }
    }
    __syncthreads();
}
constexpr int NPHASE = 11;
#ifndef DBG
#define DBG 0
#endif
__device__ __forceinline__ void dbg_final_norm(const Args& a, const Ctx& c, const float* src) {
    for (int t = c.bid * 8 + c.wave; t < L_; t += c.nb * 8) {
        const float* xr = src + (size_t)t * 2048 + c.lane * 4; float* o = a.out + (size_t)t * 2048 + c.lane * 4;
        f32x4 v[8]; float ss = 0.f;
#pragma unroll
        for (int j = 0; j < 8; ++j) { v[j] = *(const f32x4*)(xr + j * 256); ss += v[j][0] * v[j][0] + v[j][1] * v[j][1] + v[j][2] * v[j][2] + v[j][3] * v[j][3]; }
        ss = wave_sum(ss);
        const float rstd = rsqrtf(ss * (1.f / 2048.f) + 1e-6f);
#pragma unroll
        for (int j = 0; j < 8; ++j) { const f32x4 g = *(const f32x4*)(a.in[32] + j * 256 + c.lane * 4); *(f32x4*)(o + j * 256) = v[j] * rstd * g; }
    }
}

extern __shared__ __attribute__((aligned(16))) unsigned char smem[];

__global__ void __launch_bounds__(512, 2) fwd(Args a) {
    LAS unsigned char* lds = (LAS unsigned char*)smem;
    Ctx c; c.bid = blockIdx.x; c.nb = gridDim.x; c.tid = threadIdx.x; c.wave = __builtin_amdgcn_readfirstlane(threadIdx.x >> 6); c.lane = threadIdx.x & 63; c.lds = lds;
    volatile LAS unsigned* xbw = (volatile LAS unsigned*)(lds + LDS_BYTES - 16);
    if (c.tid < 4) xbw[c.tid] = 0u;
    __syncthreads();
    const int lo = a.ph_lo, hi = a.ph_hi;
    const bool multi = (hi - lo) > 1;
    XcdBarrier bar; bar.bar = (unsigned*)(a.ws + WS_CTL); bar.x = 0; bar.st = xbw;
    if (multi) bar = xcd_barrier_post((unsigned*)(a.ws + WS_CTL), xbw);
#ifndef PHASE_MASK
#define PHASE_MASK 0xFFFF
#endif
#if DBG == 1
#undef PHASE_MASK
#define PHASE_MASK 0x403
#elif DBG == 2 || DBG == 4 || DBG == 5
#undef PHASE_MASK
#define PHASE_MASK 0x4FF
#endif
#define IN(k) (((PHASE_MASK >> (k)) & 1) && lo <= (k) && (k) < hi)
#define REFRESH() do { int tz_ = threadIdx.x; asm volatile("" : "+v"(tz_)); c.tid = tz_; c.lane = tz_ & 63; c.wave = __builtin_amdgcn_readfirstlane(tz_ >> 6); } while (0)
#define SEAM(k) do { if (IN(k) && IN((k) + 1)) xcd_barrier(bar); } while (0)
#ifndef DUP
#define DUP -1
#endif
#define REP(k) for (int rep_ = 0; rep_ < ((DUP == (k)) ? 2 : 1); ++rep_)
#define DUP2(k, ...) do { __VA_ARGS__; if (DUP == (k)) { __syncthreads(); __VA_ARGS__; } } while (0)

    if (IN(0)) REP(0) { REFRESH(); p0_prologue(a, c); }
    SEAM(0);
    if (IN(1)) { REFRESH(); DUP2(1, p1_hnorm(a, c)); }
    SEAM(1);
    if (IN(2)) { REFRESH();
        pg8::StaticOrder S; S.init((const bf16_t*)(a.ws + WS_H), (const bf16_t*)(a.ws + WS_WIN), 2048, 2048, 2048, L_, DIN_PAD, c.nb, c.bid);
        EpiWin E{(bf16_t*)(a.ws + WS_US), (bf16_t*)(a.ws + WS_Q), (bf16_t*)(a.ws + WS_KROW), (bf16_t*)(a.ws + WS_VROW), (bf16_t*)(a.ws + WS_VT), (float*)(a.ws + WS_GATE)};
        DUP2(2, pg8::gemm_phase<EpiWin, pg8::StaticOrder>(lds, S, E));
    }
    SEAM(2);
    if (IN(3)) REP(3) { REFRESH();
        for (int it = c.bid; it < 256; it += c.nb) s5_item<0>(a, c, it >> 2, it & 3);
        __syncthreads();
        CmpOrder S{(const bf16_t*)(a.ws + WS_KROW), (const bf16_t*)(a.ws + WS_VROW), (const bf16_t*)(a.ws + WS_W1), 2048, 4096, 1024, c.nb, c.bid};
        EpiSlab E{(float*)(a.ws + WS_SLAB)};
        pg8::gemm_phase<EpiSlab, CmpOrder>(lds, S, E);
    }
    SEAM(3);
    if (IN(4)) REP(4) { REFRESH();
        for (int it = c.bid; it < 64; it += c.nb) cmp_finish_item(a, c, it >> 5, it & 31);
        for (int it = c.bid; it < 256; it += c.nb) s5_item<1>(a, c, it >> 2, it & 3);
    }
    SEAM(4);
    if (IN(5)) { REFRESH();
#if DBG == 5
        for (size_t i = (size_t)c.bid * NTHREADS + c.tid; i < (size_t)L_ * 1024 / 8; i += (size_t)c.nb * NTHREADS) *(u32x4*)((bf16_t*)(a.ws + WS_YSSM) + i * 8) = (u32x4){0u, 0u, 0u, 0u};
#else
        {
            pg8::StaticOrder S; S.init((const bf16_t*)(a.ws + WS_Z), (const bf16_t*)(a.ws + WS_WGLU), 1024, 1024, 1024, L_, 1024, c.nb, c.bid);
            EpiGlu E{(const bf16_t*)(a.ws + WS_Z), a.in[19], (bf16_t*)(a.ws + WS_YSSM)};
            DUP2(55, pg8::gemm_phase<EpiGlu, pg8::StaticOrder>(lds, S, E));
        }
#endif
        __syncthreads();
        REP(5)
#if DBG == 4
        for (size_t i = (size_t)c.bid * NTHREADS + c.tid; i < (size_t)L_ * 1024 / 8; i += (size_t)c.nb * NTHREADS) *(u32x4*)((bf16_t*)(a.ws + WS_YATT) + i * 8) = (u32x4){0u, 0u, 0u, 0u};
#else
        for (int it = c.bid; it < 512; it += c.nb) {
            const int rnd = it / c.nb;
            const int qt = (rnd & 1) ? 255 - (it % 256) : (it % 256), g = (it >> 8) & 1;
            attn_item(a, c, qt, g);
        }
#endif
    }
    SEAM(5);
    if (IN(6)) { REFRESH(); DUP2(6, p6_mixnorm(a, c)); }
    SEAM(6);
    if (IN(7)) { REFRESH();
        pg8::StaticOrder S; S.init((const bf16_t*)(a.ws + WS_H), (const bf16_t*)(a.ws + WS_WOUT), 2048, 2048, 2048, L_, 2048, c.nb, c.bid);
        EpiWout E{a.in[0], (const float*)(a.ws + WS_COND) + 2 * 2048, a.out};
        DUP2(7, pg8::gemm_phase<EpiWout, pg8::StaticOrder>(lds, S, E));
    }
    SEAM(7);
    if (IN(8)) { REFRESH(); DUP2(8, p8_h2norm(a, c)); }
    SEAM(8);
    if (IN(9)) { REFRESH();
        pg8::StaticOrder S; S.init((const bf16_t*)(a.ws + WS_H), (const bf16_t*)(a.ws + WS_WQ), 2048, 2048, 2048, L_, 2048, c.nb, c.bid);
        EpiBf16 E{(bf16_t*)(a.ws + WS_QP), 2048};
        DUP2(9, pg8::gemm_phase<EpiBf16, pg8::StaticOrder>(lds, S, E));
    }
    SEAM(9);
    if (IN(10)) { REFRESH();
#if DBG == 1
        dbg_final_norm(a, c, a.in[0]);
#elif DBG == 2 || DBG == 4 || DBG == 5
        dbg_final_norm(a, c, a.out);
#else
        if (DUP == 10) { for (int s = c.bid; s < L_ / 8; s += c.nb) peer_step<true>(a, c, s * 8); }
        for (int s = c.bid; s < L_ / 8; s += c.nb) peer_step<false>(a, c, s * 8);
#endif
    }
#undef IN
#undef SEAM
}

#ifndef N_LAUNCHES
#define N_LAUNCHES 1
#endif
extern "C" void kernel_launch(void* const* d_in, const int* in_sizes, int n_in, void* d_out, int out_size, void* d_ws, size_t ws_size, hipStream_t stream) {
    static int grid = 0;
    if (grid == 0) {
        if (n_in != 33 || out_size != L_ * D_ || ws_size < WS_END) { fprintf(stderr, "kernel_launch: unexpected shapes (n_in %d, out %d, ws %zu < %zu); nothing launched\n", n_in, out_size, ws_size, (size_t)WS_END); grid = -1; return; }
        int dev = 0, cus = 0, per_cu = 0;
        if (hipGetDevice(&dev) != hipSuccess || hipDeviceGetAttribute(&cus, hipDeviceAttributeMultiprocessorCount, dev) != hipSuccess) { grid = -1; return; }
        if (hipFuncSetAttribute((const void*)fwd, hipFuncAttributeMaxDynamicSharedMemorySize, LDS_BYTES) != hipSuccess) { fprintf(stderr, "kernel_launch: hipFuncSetAttribute failed\n"); grid = -1; return; }
        if (hipOccupancyMaxActiveBlocksPerMultiprocessor(&per_cu, (const void*)fwd, NTHREADS, LDS_BYTES) != hipSuccess || per_cu < 1) { fprintf(stderr, "kernel_launch: occupancy query says %d\n", per_cu); (void)hipGetLastError(); grid = -1; return; }
        grid = cus;
    }
    if (grid < 0) return;
    (void)hipMemsetAsync((char*)d_ws + WS_CTL, 0, CTL_BYTES, stream);
    Args a{};
    for (int i = 0; i < 33; ++i) a.in[i] = (const float*)d_in[i];
    a.out = (float*)d_out; a.ws = (unsigned char*)d_ws;
    if (N_LAUNCHES == 1) { a.ph_lo = 0; a.ph_hi = NPHASE; hipLaunchKernelGGL(fwd, dim3(grid), dim3(NTHREADS), LDS_BYTES, stream, a); }
    else for (int p = 0; p < NPHASE; ++p) { a.ph_lo = p; a.ph_hi = p + 1; hipLaunchKernelGGL(fwd, dim3(grid), dim3(NTHREADS), LDS_BYTES, stream, a); }
}
```

```cpp
#include <hip/hip_runtime.h>
#include <stdint.h>
#include <stdio.h>

#define LAS __attribute__((address_space(3)))
typedef unsigned short bf16_t;
typedef short bf16x8 __attribute__((ext_vector_type(8)));
typedef float f32x2 __attribute__((ext_vector_type(2)));
typedef float f32x4 __attribute__((ext_vector_type(4)));
typedef float f32x16 __attribute__((ext_vector_type(16)));
typedef unsigned u32x2 __attribute__((ext_vector_type(2)));
typedef unsigned u32x4 __attribute__((ext_vector_type(4)));
typedef __bf16 bfv2 __attribute__((ext_vector_type(2)));
typedef unsigned u32x6 __attribute__((ext_vector_type(6)));
typedef float f32x32 __attribute__((ext_vector_type(32)));

constexpr int L_ = 16384, D_ = 2048, DSSM = 1024, DATT = 1024, DIN = 3608, DIN_PAD = 3840;
constexpr int NADA = 12288;
constexpr float LOG2E = 1.4426950408889634f;
constexpr float QSCALE = 0.08838834764831845f * 1.4426950408889634f;
constexpr int TBN = 800;
constexpr int NTHREADS = 512;
constexpr int LDS_BYTES = 163840;

constexpr size_t al256(size_t x) { return (x + 255) & ~(size_t)255; }
constexpr size_t WS_CTL   = 0;                                  constexpr size_t CTL_BYTES = 65536;
constexpr size_t WS_CONDP = WS_CTL + CTL_BYTES;
constexpr size_t WS_COND  = WS_CONDP + 32 * 12288 * 4;
constexpr size_t WS_TB    = WS_COND + 12288 * 4;
constexpr size_t WS_BPE   = al256(WS_TB + 8 * TBN * 4);
constexpr size_t WS_S5P   = al256(WS_BPE + 2 * 256 * 4);
constexpr size_t WS_S5F   = WS_S5P + 2 * 64 * 64 * 2 * 4;
constexpr size_t WS_S5MT  = WS_S5F + 64 * 4 * 128 * 4;
constexpr size_t WS_S5WE  = WS_S5MT + (size_t)64 * 256 * 256 * 2;
constexpr size_t WS_S5WC  = WS_S5WE + (size_t)64 * 128 * 256 * 2;
constexpr size_t WS_WIN   = WS_S5WC + (size_t)64 * 256 * 128 * 2;
constexpr size_t WS_WGLU  = WS_WIN + (size_t)DIN_PAD * 2048 * 2;
constexpr size_t WS_WOUT  = WS_WGLU + (size_t)1024 * 1024 * 2;
constexpr size_t WS_WQ    = WS_WOUT + (size_t)2048 * 2048 * 2;
constexpr size_t WS_W1    = WS_WQ + (size_t)2048 * 2048 * 2;
constexpr size_t WS_W2    = WS_W1 + (size_t)2 * 256 * 4096 * 2;
constexpr size_t WS_PK    = WS_W2 + (size_t)2 * 128 * 256 * 2;
constexpr size_t WS_PU    = WS_PK + (size_t)2 * 128 * 128 * 2;
constexpr size_t WS_PV    = WS_PU + (size_t)16384 * 1536;
constexpr size_t WS_PSC   = WS_PV + (size_t)16384 * 1536;
constexpr size_t WS_BPEP  = WS_PSC + (size_t)2 * 16384 * 4;
constexpr size_t WS_H     = WS_BPEP + (size_t)32 * 2 * 256 * 4;
constexpr size_t WS_US    = WS_H + (size_t)16384 * 2048 * 2;
constexpr size_t WS_Q     = WS_US + (size_t)16384 * 1024 * 2;
constexpr size_t WS_QP    = WS_US;
constexpr size_t WS_KROW  = WS_Q + (size_t)16384 * 1024 * 2;
constexpr size_t WS_VROW  = WS_KROW + (size_t)6 * 16384 * 128 * 2;
constexpr size_t WS_VT    = WS_VROW + (size_t)2 * 16384 * 128 * 2 + 8192;
constexpr size_t WS_GATE  = WS_VT + (size_t)4 * 128 * 16384 * 2;
constexpr size_t WS_SLAB  = WS_GATE + (size_t)16384 * 24 * 4;
constexpr size_t WS_KC    = WS_SLAB + (size_t)2 * 4 * 2048 * 256 * 4;
constexpr size_t WS_VCT   = WS_KC + (size_t)2 * 1024 * 128 * 2;
constexpr size_t WS_Z     = WS_VCT + (size_t)2 * 128 * 1024 * 2;
constexpr size_t WS_YSSM  = WS_Z + (size_t)16384 * 1024 * 2;
constexpr size_t WS_YATT  = WS_YSSM + (size_t)16384 * 1024 * 2;
constexpr size_t WS_END   = WS_YATT + (size_t)16384 * 1024 * 2;
static_assert(WS_END < (size_t)530 * 1024 * 1024, "workspace map too large");

struct Args { const float* in[33]; float* out; unsigned char* ws; int ph_lo, ph_hi; };

__device__ __forceinline__ unsigned cvt_pk_bf16(float lo, float hi) { bfv2 v; v[0] = (__bf16)lo; v[1] = (__bf16)hi; return __builtin_bit_cast(unsigned, v); }
__device__ __forceinline__ bf16_t f2bf(float f) { return (bf16_t)(cvt_pk_bf16(f, 0.f) & 0xffffu); }
__device__ __forceinline__ float bf2f(unsigned b) { return __uint_as_float(b << 16); }
__device__ __forceinline__ float bflo(unsigned w) { return __uint_as_float(w << 16); }
__device__ __forceinline__ float bfhi(unsigned w) { return __uint_as_float(w & 0xffff0000u); }
__device__ __forceinline__ float fexp2(float x) { return __builtin_amdgcn_exp2f(x); }
__device__ __forceinline__ float frcp(float x) { return __builtin_amdgcn_rcpf(x); }
__device__ __forceinline__ float sigmoidf_(float x) { return frcp(1.f + fexp2(-LOG2E * x)); }
__device__ __forceinline__ float gelu_tanh(float x) {
    const float u = x * (1.f + 0.044715f * x * x);
    return x * frcp(1.f + fexp2(-2.f * 0.7978845608028654f * LOG2E * u));
}
__device__ __forceinline__ float shfl_xor_f(float v, int m) { return __shfl_xor(v, m, 64); }
__device__ __forceinline__ float wave_sum(float v) {
#pragma unroll
    for (int m = 32; m >= 1; m >>= 1) v += __shfl_xor(v, m, 64);
    return v;
}
__device__ __forceinline__ float wave_max(float v) {
#pragma unroll
    for (int m = 32; m >= 1; m >>= 1) v = fmaxf(v, __shfl_xor(v, m, 64));
    return v;
}
template <int CTRL> __device__ __forceinline__ float dpp_f(float x) { return __int_as_float(__builtin_amdgcn_update_dpp(0, __float_as_int(x), CTRL, 0xf, 0xf, false)); }
__device__ __forceinline__ float wave_max_bcast(float v) {
    v = fmaxf(v, dpp_f<0xB1>(v)); v = fmaxf(v, dpp_f<0x4E>(v)); v = fmaxf(v, dpp_f<0x141>(v)); v = fmaxf(v, dpp_f<0x140>(v));
    v = fmaxf(v, __int_as_float(__builtin_amdgcn_update_dpp(__float_as_int(v), __float_as_int(v), 0x142, 0xa, 0xf, false)));
    v = fmaxf(v, __int_as_float(__builtin_amdgcn_update_dpp(__float_as_int(v), __float_as_int(v), 0x143, 0xc, 0xf, false)));
    return __int_as_float(__builtin_amdgcn_readlane(__float_as_int(v), 63));
}
__device__ __forceinline__ unsigned wave_umax_bcast(unsigned v) {
#define UDPP_(x, ctrl, rm) (unsigned)__builtin_amdgcn_update_dpp((int)(x), (int)(x), ctrl, rm, 0xf, false)
    v = max(v, UDPP_(v, 0xB1, 0xf)); v = max(v, UDPP_(v, 0x4E, 0xf)); v = max(v, UDPP_(v, 0x141, 0xf)); v = max(v, UDPP_(v, 0x140, 0xf));
    v = max(v, UDPP_(v, 0x142, 0xa)); v = max(v, UDPP_(v, 0x143, 0xc));
#undef UDPP_
    return (unsigned)__builtin_amdgcn_readlane((int)v, 63);
}
__device__ __forceinline__ float quad_sum(float x) { x += dpp_f<0xB1>(x); x += dpp_f<0x4E>(x); return x; }
__device__ __forceinline__ f32x4 mfma16(bf16x8 a, bf16x8 b, f32x4 c) { return __builtin_amdgcn_mfma_f32_16x16x32_bf16(a, b, c, 0, 0, 0); }
__device__ __forceinline__ f32x16 mfma32(bf16x8 a, bf16x8 b, f32x16 c) { return __builtin_amdgcn_mfma_f32_32x32x16_bf16(a, b, c, 0, 0, 0); }
#define XB_TMO      128
#define XB_XCNT(j)  (256  + 64 * (j))
#define XB_XSUB(j)  (1280 + 64 * (j))
#define XB_XGEN(j)  (2304 + 64 * (j))
#define XB_TOP      3328
#define XB_TOPGEN   3392
#define XCD_BAR_WORDS 3456
#define XB_SPIN_CAP (1u << 18)

__device__ __forceinline__ unsigned xb_ld(unsigned* p)              { return __hip_atomic_load(p, __ATOMIC_RELAXED, __HIP_MEMORY_SCOPE_AGENT); }
__device__ __forceinline__ unsigned xb_add(unsigned* p, unsigned v) { return __hip_atomic_fetch_add(p, v, __ATOMIC_RELAXED, __HIP_MEMORY_SCOPE_AGENT); }
__device__ __forceinline__ unsigned xb_xcc_id() { return (unsigned)__builtin_amdgcn_s_getreg((3 << 11) | 20) & 0xFu; }
#define XB_SPIN(cond, bar) do { unsigned _sp = 0; while (cond) { __builtin_amdgcn_s_sleep(1); \
    if ((++_sp & 255u) == 0u) { if (xb_ld(&(bar)[XB_TMO])) break; if (_sp > XB_SPIN_CAP) { atomicAdd(&(bar)[XB_TMO], 1u); break; } } } } while (0)

struct XcdBarrier {
    unsigned* bar; unsigned x;
    volatile LAS unsigned* st;
};
__device__ __forceinline__ XcdBarrier xcd_barrier_post(unsigned* bar, volatile LAS unsigned* st) {
    XcdBarrier b; b.bar = bar; b.x = xb_xcc_id(); b.st = st;
    if (threadIdx.x == 0) (void)xb_add(&bar[XB_XCNT(b.x)], 1u);
    return b;
}
__device__ __forceinline__ void xcd_barrier_complete(unsigned* bar, unsigned x, unsigned& nloc, unsigned& nx) {
    const unsigned G = gridDim.x * gridDim.y * gridDim.z;
    unsigned sum, cnt, mine, sp = 0u;
    for (;;) {
        sum = 0u; cnt = 0u; mine = 0u;
#pragma unroll
        for (unsigned j = 0; j < 16; ++j) { const unsigned c = xb_ld(&bar[XB_XCNT(j)]); sum += c; cnt += (c > 0u) ? 1u : 0u; mine = (j == x) ? c : mine; }
        if (sum == G) break;
        __builtin_amdgcn_s_sleep(1);
        if ((++sp & 255u) == 0u) { if (xb_ld(&bar[XB_TMO])) break; if (sp > XB_SPIN_CAP) { atomicAdd(&bar[XB_TMO], 1u); break; } }
    }
    nloc = mine > 0u ? mine : 1u; nx = cnt > 0u ? cnt : 1u;
}
__device__ __forceinline__ void xcd_barrier(const XcdBarrier& b) {
    asm volatile("s_waitcnt vmcnt(0)" ::: "memory");
    __syncthreads();
    if (threadIdx.x == 0) {
        unsigned* bar = b.bar;
        __builtin_amdgcn_s_waitcnt(0);
        unsigned nloc = b.st[0], nx = b.st[1];
        if (nloc == 0u) { xcd_barrier_complete(bar, b.x, nloc, nx); b.st[0] = nloc; b.st[1] = nx; }
        const unsigned old = xb_add(&bar[XB_XSUB(b.x)], 1u);
        const unsigned gen = old / nloc;
        if (old + 1u == (gen + 1u) * nloc) {
            __builtin_amdgcn_fence(__ATOMIC_RELEASE, "agent");
            asm volatile("s_waitcnt vmcnt(0)" ::: "memory");
            const unsigned og = xb_add(&bar[XB_TOP], 1u);
            const unsigned tg = og / nx;
            if (og + 1u == (tg + 1u) * nx) xb_add(&bar[XB_TOPGEN], 1u);
            else XB_SPIN(xb_ld(&bar[XB_TOPGEN]) == tg, bar);
            __builtin_amdgcn_fence(__ATOMIC_ACQUIRE, "agent");
            xb_add(&bar[XB_XGEN(b.x)], 1u);
            asm volatile("s_waitcnt vmcnt(0)" ::: "memory");
        } else {
            XB_SPIN(xb_ld(&bar[XB_XGEN(b.x)]) == gen, bar);
            __builtin_amdgcn_fence(__ATOMIC_ACQUIRE, "agent");
            asm volatile("s_waitcnt vmcnt(0)" ::: "memory");
        }
    }
    __syncthreads();
}

namespace pg8 {
constexpr int BM = 256, BK = 64, HALF = 128, HTB = HALF * BK * 2, STAGE_BYTES = 8 * HTB, NXCD = 8, WGM = 8;
__host__ __device__ __forceinline__ int lds_byte(int r, int c) { const int st = (r >> 4) * 2 + (c >> 5), rr = r & 15, cc = c & 31, ob = rr * 64 + cc * 2; return st * 1024 + (ob ^ (((ob >> 9) & 1) << 5)); }
__host__ __device__ __forceinline__ void stage_rc(int b, int& R, int& C) { const int st = b / 1024, sb = b % 1024, swz = sb ^ (((sb >> 9) & 1) << 5); R = (st >> 1) * 16 + swz / 64; C = (st & 1) * 32 + (swz % 64) / 2; }
__host__ __device__ __forceinline__ int perm32(int rho) { const int n = rho >> 4, i = rho & 15; return 8 * (i >> 2) + 4 * n + (i & 3); }

struct Unit { int pm, pn, z; };
struct StaticOrder {
    const bf16_t* A; const bf16_t* Bt; int lda, ldb, K;
    int nM, nN, nwg, G, c, pm0;
    __device__ void init(const bf16_t* A_, const bf16_t* Bt_, int lda_, int ldb_, int K_, int M, int N, int G_, int c_, int pm0_ = 0) { A = A_; Bt = Bt_; lda = lda_; ldb = ldb_; K = K_; nM = M / BM; nN = N / BM; nwg = nM * nN; G = G_; c = c_; pm0 = pm0_; }
    __device__ bool next(int i, Unit& u) const {
        const long Lx = (long)i * G + c; if (Lx >= nwg) return false;
        int wgid = (int)Lx; { const int q = nwg / NXCD, r = nwg % NXCD, xcd = wgid % NXCD, off = wgid / NXCD; wgid = (xcd < r ? xcd * (q + 1) : r * (q + 1) + (xcd - r) * q) + off; }
        const int nig = WGM * nN, gid = wgid / nig, fm = gid * WGM, gsz = (nM - fm) < WGM ? (nM - fm) : WGM;
        u.pm = pm0 + fm + ((wgid % nig) % gsz); u.pn = (wgid % nig) / gsz; u.z = 0; return true;
    }
    __device__ __forceinline__ const char* a_base(const Unit& u) const { return (const char*)(A + (size_t)u.pm * BM * lda); }
    __device__ __forceinline__ const char* b_base(const Unit& u) const { return (const char*)(Bt + (size_t)u.pn * BM * ldb); }
};

template <class Epi, class Sched>
__device__ __forceinline__ void gemm_phase(LAS unsigned char* lds, const Sched& S, const Epi& E) {
    const int tid = threadIdx.x, wid = __builtin_amdgcn_readfirstlane(tid >> 6), lane = tid & 63, wr = wid >> 2, wc = wid & 3, fr = lane & 15, fq = lane >> 4;
    const int K = S.K, nt = K / BK, lda = S.lda, ldb = S.ldb;
    unsigned voffA[2], voffB[2];
#pragma unroll
    for (int i = 0; i < 2; ++i) { int R, C; stage_rc(tid * 16 + i * 8192, R, C); const int Rb = Epi::PERM ? ((R & ~31) + perm32(R & 31)) : R;
        voffA[i] = (unsigned)(R * lda + C) * 2u; voffB[i] = (unsigned)(Rb * ldb + C) * 2u; }
    const size_t kstep = (size_t)(BK * 2);
    const size_t hstepA = (size_t)HALF * lda * 2, hstepB = (size_t)HALF * ldb * 2;
    const unsigned ldsw = (unsigned)wid * 1024u;
    const int aoff = lds_byte(wr * 64 + fr, fq * 8), boff = lds_byte(wc * 32 + fr, fq * 8);
#define PG8_SA(b, h) (((b) * 2 + (h)) * HTB)
#define PG8_SB(b, h) ((4 + (b) * 2 + (h)) * HTB)
#define PG8_STAGE(bufoff, gbase, voff) do { _Pragma("unroll") for (int _i = 0; _i < 2; ++_i) \
        __builtin_amdgcn_global_load_lds((const unsigned*)((const char*)(gbase) + (voff)[_i]), (LAS unsigned*)(lds + (bufoff) + ldsw + _i * 8192), 16, 0, 0); } while (0)
#define PG8_LDA(dst, b, h) do { _Pragma("unroll") for (int m = 0; m < 4; ++m) _Pragma("unroll") for (int k = 0; k < 2; ++k) dst[m][k] = *(const LAS bf16x8*)(lds + PG8_SA(b, h) + aoff + m * 2048 + k * 1024); } while (0)
#define PG8_LDB(dst, b, h) do { _Pragma("unroll") for (int n = 0; n < 2; ++n) _Pragma("unroll") for (int k = 0; k < 2; ++k) dst[n][k] = *(const LAS bf16x8*)(lds + PG8_SB(b, h) + boff + n * 2048 + k * 1024); } while (0)
#define PG8_MMA(ai, bj, At, Bt) do { __builtin_amdgcn_s_setprio(1); _Pragma("unroll") for (int m = 0; m < 4; ++m) _Pragma("unroll") for (int n = 0; n < 2; ++n) _Pragma("unroll") for (int k = 0; k < 2; ++k) \
        acc[ai][bj][m][n] = __builtin_amdgcn_mfma_f32_16x16x32_bf16(Bt[n][k], At[m][k], acc[ai][bj][m][n], 0, 0, 0); __builtin_amdgcn_s_setprio(0); } while (0)
#define PG8_WAIT_V(n) asm volatile("s_waitcnt vmcnt(" #n ")" ::: "memory")
#define PG8_WAIT_L(n) asm volatile("s_waitcnt lgkmcnt(" #n ")" ::: "memory")
#define PG8_BAR __builtin_amdgcn_s_barrier()
#define PG8_SCHED __builtin_amdgcn_sched_barrier(0)
    Unit cur, nxt; int ui = 0;
    if (!S.next(0, cur)) return;
    f32x4 acc[2][2][4][2];
#pragma unroll
    for (int a = 0; a < 2; ++a)
#pragma unroll
        for (int b = 0; b < 2; ++b)
#pragma unroll
            for (int m = 0; m < 4; ++m)
#pragma unroll
                for (int n = 0; n < 2; ++n) acc[a][b][m][n] = (f32x4){0.f, 0.f, 0.f, 0.f};
    bf16x8 At[4][2], B0[2][2], B1[2][2];
    const char* cA = S.a_base(cur); const char* cB = S.b_base(cur);
    PG8_STAGE(PG8_SB(0, 0), cB, voffB); PG8_STAGE(PG8_SA(0, 0), cA, voffA); PG8_STAGE(PG8_SB(0, 1), cB + hstepB, voffB); PG8_STAGE(PG8_SA(0, 1), cA + hstepA, voffA);
    if (wr == 1) PG8_BAR;
    PG8_WAIT_V(4); PG8_BAR;
    PG8_STAGE(PG8_SB(1, 0), cB + kstep, voffB); PG8_STAGE(PG8_SA(1, 0), cA + kstep, voffA); PG8_STAGE(PG8_SB(1, 1), cB + hstepB + kstep, voffB);
    PG8_WAIT_V(6); PG8_BAR;
    for (;;) {
        const bool has_next = S.next(ui + 1, nxt);
        const char* nA = has_next ? S.a_base(nxt) : cA; const char* nB = has_next ? S.b_base(nxt) : cB;
        for (int t = 0; t < nt; t += 2) {
            const bool last = (t == nt - 2);
            const char* a1 = cA + (size_t)(t + 1) * kstep;
            const char* a2 = last ? nA : cA + (size_t)(t + 2) * kstep; const char* b2 = last ? nB : cB + (size_t)(t + 2) * kstep;
            const char* a3 = a2 + kstep; const char* b3 = b2 + kstep;
            PG8_LDB(B0, 0, 0); PG8_SCHED; PG8_LDA(At, 0, 0); PG8_STAGE(PG8_SA(1, 1), a1 + hstepA, voffA);
            PG8_WAIT_L(8); PG8_BAR; PG8_WAIT_L(0); PG8_MMA(0, 0, At, B0); PG8_BAR; PG8_SCHED;
            PG8_LDB(B1, 0, 1); PG8_STAGE(PG8_SB(0, 0), b2, voffB);
            PG8_BAR; PG8_WAIT_L(0); PG8_MMA(0, 1, At, B1); PG8_BAR;
            PG8_LDA(At, 0, 1); PG8_STAGE(PG8_SA(0, 0), a2, voffA);
            PG8_BAR; PG8_WAIT_L(0); PG8_MMA(1, 0, At, B0); PG8_BAR; PG8_SCHED;
            PG8_STAGE(PG8_SB(0, 1), b2 + hstepB, voffB);
            PG8_WAIT_V(6); PG8_BAR; PG8_MMA(1, 1, At, B1); PG8_BAR;
            PG8_LDB(B0, 1, 0); PG8_SCHED; PG8_LDA(At, 1, 0); PG8_STAGE(PG8_SA(0, 1), a2 + hstepA, voffA);
            PG8_WAIT_L(8); PG8_BAR; PG8_WAIT_L(0); PG8_MMA(0, 0, At, B0); PG8_BAR; PG8_SCHED;
            PG8_LDB(B1, 1, 1); PG8_STAGE(PG8_SB(1, 0), b3, voffB);
            PG8_BAR; PG8_WAIT_L(0); PG8_MMA(0, 1, At, B1); PG8_BAR;
            PG8_LDA(At, 1, 1); PG8_STAGE(PG8_SA(1, 0), a3, voffA);
            PG8_BAR; PG8_WAIT_L(0); PG8_MMA(1, 0, At, B0); PG8_BAR; PG8_SCHED;
            PG8_STAGE(PG8_SB(1, 1), b3 + hstepB, voffB);
            PG8_WAIT_V(6); PG8_BAR; PG8_MMA(1, 1, At, B1); PG8_BAR;
        }
        E(acc, cur, wr, wc, fr, fq);
        if (!has_next) break;
#pragma unroll
        for (int a = 0; a < 2; ++a)
#pragma unroll
            for (int b = 0; b < 2; ++b)
#pragma unroll
                for (int m = 0; m < 4; ++m)
#pragma unroll
                    for (int n = 0; n < 2; ++n) acc[a][b][m][n] = (f32x4){0.f, 0.f, 0.f, 0.f};
        cur = nxt; cA = nA; cB = nB; ++ui;
    }
    PG8_WAIT_V(0);
    if (wr == 0) PG8_BAR;
    PG8_BAR;
#undef PG8_SA
#undef PG8_SB
#undef PG8_STAGE
#undef PG8_LDA
#undef PG8_LDB
#undef PG8_MMA
#undef PG8_WAIT_V
#undef PG8_WAIT_L
#undef PG8_BAR
#undef PG8_SCHED
}
}
using pg8::Unit;
__device__ __forceinline__ u32x4 pack8(const f32x4& v0, const f32x4& v1) {
    u32x4 o; o[0] = cvt_pk_bf16(v0[0], v0[1]); o[1] = cvt_pk_bf16(v0[2], v0[3]); o[2] = cvt_pk_bf16(v1[0], v1[1]); o[3] = cvt_pk_bf16(v1[2], v1[3]); return o;
}
struct EpiWin {
    static constexpr bool PERM = true;
    bf16_t* US; bf16_t* Q; bf16_t* KROW; bf16_t* VROW; bf16_t* VT; float* GATE;
    __device__ __forceinline__ void operator()(const f32x4 (&acc)[2][2][4][2], const Unit& u, int wr, int wc, int fr, int fq) const {
        const int row0 = u.pm * 256 + wr * 64 + fr; const int pn = u.pn;
#pragma unroll
        for (int ai = 0; ai < 2; ++ai)
#pragma unroll
            for (int m = 0; m < 4; ++m) {
                const int row = row0 + ai * 128 + m * 16;
#pragma unroll
                for (int bj = 0; bj < 2; ++bj) {
                    const f32x4 v0 = acc[ai][bj][m][0], v1 = acc[ai][bj][m][1];
                    const int cin = bj * 128 + wc * 32 + 8 * fq;
                    if (pn < 4) { *(u32x4*)(US + (size_t)row * 1024 + pn * 256 + cin) = pack8(v0, v1); }
                    else if (pn < 8) { *(u32x4*)(Q + (size_t)row * 1024 + (pn - 4) * 256 + cin) = pack8(v0 * QSCALE, v1 * QSCALE); }
                    else if (pn < 14) {
                        const int kvi = pn - 8, branch = kvi >> 1, kvsel = kvi & 1, g = bj, d0 = wc * 32 + 8 * fq;
                        if (kvsel == 0) { *(u32x4*)(KROW + ((size_t)(branch * 2 + g) * L_ + row) * 128 + d0) = pack8(v0, v1); }
                        else if (branch == 0) { *(u32x4*)(VROW + ((size_t)g * L_ + row) * 128 + d0) = pack8(v0, v1); }
                        else {
                            bf16_t* vt = VT + ((size_t)((branch - 1) * 2 + g) * 128 + d0) * L_ + ((row & ~12) | ((row & 4) << 1) | ((row & 8) >> 1));
#pragma unroll
                            for (int e = 0; e < 4; ++e) { vt[(size_t)e * L_] = f2bf(v0[e]); vt[(size_t)(e + 4) * L_] = f2bf(v1[e]); }
                        }
                    } else {
                        if (cin < 24) {
                            float* gp = GATE + (size_t)row * 24 + cin;
                            f32x4 s0, s1;
#pragma unroll
                            for (int e = 0; e < 4; ++e) { s0[e] = sigmoidf_(v0[e]); s1[e] = sigmoidf_(v1[e]); }
                            *(f32x4*)gp = s0; *(f32x4*)(gp + 4) = s1;
                        }
                    }
                }
            }
    }
};
struct EpiGlu {
    static constexpr bool PERM = true;
    const bf16_t* Z; const float* bglu; bf16_t* Y;
    __device__ __forceinline__ void operator()(const f32x4 (&acc)[2][2][4][2], const Unit& u, int wr, int wc, int fr, int fq) const {
        const int row0 = u.pm * 256 + wr * 64 + fr;
#pragma unroll
        for (int bj = 0; bj < 2; ++bj) {
            const int col = u.pn * 256 + bj * 128 + wc * 32 + 8 * fq;
            const f32x4 b0 = *(const f32x4*)(bglu + col), b1 = *(const f32x4*)(bglu + col + 4);
#pragma unroll
            for (int ai = 0; ai < 2; ++ai)
#pragma unroll
                for (int m = 0; m < 4; ++m) {
                    const int row = row0 + ai * 128 + m * 16;
                    const u32x4 zz = *(const u32x4*)(Z + (size_t)row * 1024 + col);
                    const f32x4 v0 = acc[ai][bj][m][0] + b0, v1 = acc[ai][bj][m][1] + b1;
                    f32x4 o0, o1;
                    o0[0] = bflo(zz[0]) * sigmoidf_(v0[0]); o0[1] = bfhi(zz[0]) * sigmoidf_(v0[1]); o0[2] = bflo(zz[1]) * sigmoidf_(v0[2]); o0[3] = bfhi(zz[1]) * sigmoidf_(v0[3]);
                    o1[0] = bflo(zz[2]) * sigmoidf_(v1[0]); o1[1] = bfhi(zz[2]) * sigmoidf_(v1[1]); o1[2] = bflo(zz[3]) * sigmoidf_(v1[2]); o1[3] = bfhi(zz[3]) * sigmoidf_(v1[3]);
                    *(u32x4*)(Y + (size_t)row * 1024 + col) = pack8(o0, o1);
                }
        }
    }
};
struct EpiWout {
    static constexpr bool PERM = false;
    const float* X; const float* g1; float* X1;
    __device__ __forceinline__ void operator()(const f32x4 (&acc)[2][2][4][2], const Unit& u, int wr, int wc, int fr, int fq) const {
        const int row0 = u.pm * 256 + wr * 64 + fr, col0 = u.pn * 256 + wc * 32 + 4 * fq;
#pragma unroll
        for (int bj = 0; bj < 2; ++bj)
#pragma unroll
            for (int n = 0; n < 2; ++n) {
                const int col = col0 + bj * 128 + n * 16;
                const f32x4 gv = *(const f32x4*)(g1 + col);
#pragma unroll
                for (int ai = 0; ai < 2; ++ai)
#pragma unroll
                    for (int m = 0; m < 4; ++m) {
                        const size_t off = (size_t)(row0 + ai * 128 + m * 16) * 2048 + col;
                        *(f32x4*)(X1 + off) = *(const f32x4*)(X + off) + gv * acc[ai][bj][m][n];
                    }
            }
    }
};
struct EpiBf16 {
    static constexpr bool PERM = true;
    bf16_t* O; int ldc;
    __device__ __forceinline__ void operator()(const f32x4 (&acc)[2][2][4][2], const Unit& u, int wr, int wc, int fr, int fq) const {
        const int row0 = u.pm * 256 + wr * 64 + fr, col0 = u.pn * 256 + wc * 32 + 8 * fq;
#pragma unroll
        for (int ai = 0; ai < 2; ++ai)
#pragma unroll
            for (int m = 0; m < 4; ++m)
#pragma unroll
                for (int bj = 0; bj < 2; ++bj)
                    *(u32x4*)(O + (size_t)(row0 + ai * 128 + m * 16) * ldc + col0 + bj * 128) = pack8(acc[ai][bj][m][0], acc[ai][bj][m][1]);
    }
};
struct EpiSlab {
    static constexpr bool PERM = false;
    float* SL;
    __device__ __forceinline__ void operator()(const f32x4 (&acc)[2][2][4][2], const Unit& u, int wr, int wc, int fr, int fq) const {
        float* base = SL + (size_t)u.z * 2048 * 256;
        const int row0 = u.pm * 256 + wr * 64 + fr, col0 = wc * 32 + 4 * fq;
#pragma unroll
        for (int ai = 0; ai < 2; ++ai)
#pragma unroll
            for (int m = 0; m < 4; ++m)
#pragma unroll
                for (int bj = 0; bj < 2; ++bj)
#pragma unroll
                    for (int n = 0; n < 2; ++n)
                        *(f32x4*)(base + (size_t)(row0 + ai * 128 + m * 16) * 256 + col0 + bj * 128 + n * 16) = acc[ai][bj][m][n];
    }
};
struct CmpOrder {
    const bf16_t* KROW; const bf16_t* VROW; const bf16_t* W1; int lda, ldb, K; int G, c;
    __device__ bool next(int i, Unit& u) const {
        const int x = i * G + c; if (x >= 64) return false;
        const int kvsel = x >> 5, pm = (x & 31) >> 2, ks = x & 3; u.pm = pm; u.pn = 0; u.z = kvsel * 4 + ks; return true;
    }
    __device__ __forceinline__ const char* a_base(const Unit& u) const { return (const char*)(((u.z >> 2) ? VROW : KROW) + (size_t)u.pm * 256 * 2048 + (u.z & 3) * 1024); }
    __device__ __forceinline__ const char* b_base(const Unit& u) const { return (const char*)(W1 + (size_t)(u.z >> 2) * 256 * 4096 + (u.z & 3) * 1024); }
};
struct Ctx { int bid, nb, tid, wave, lane; LAS unsigned char* lds; };

__device__ __forceinline__ void p0_cond(const Args& a, const Ctx& c) {
    const float* cv = a.in[1]; const float* w = a.in[2]; float* condp = (float*)(a.ws + WS_CONDP);
    for (int u = c.bid * 8 + c.wave; u < 1536; u += c.nb * 8) {
        const int cc = u % 48, kc = u / 48;
        const float* wp = w + (size_t)(kc * 64) * NADA + cc * 256 + c.lane * 4;
        f32x4 acc = {0.f, 0.f, 0.f, 0.f};
#pragma unroll 16
        for (int k = 0; k < 64; ++k) { const float x = cv[kc * 64 + k]; const float s = x / (1.f + __expf(-x)); acc += s * *(const f32x4*)(wp + (size_t)k * NADA); }
        *(f32x4*)(condp + (size_t)kc * NADA + cc * 256 + c.lane * 4) = acc;
    }
}
__device__ __forceinline__ void conv_T(const float* src, int K, int N, bf16_t* dst, int Npad, const Ctx& c) {
    LAS float* tile = (LAS float*)c.lds;
    const int nkt = K / 64, ntiles = nkt * (Npad / 64);
    const int r = c.tid >> 4, c4 = c.tid & 15;
    f32x4 v[2];
#define CONVT_LD(tix_) do { const int nt_ = (tix_) / nkt, kt_ = (tix_) % nkt, n_ = nt_ * 64 + 4 * c4; _Pragma("unroll") for (int i = 0; i < 2; ++i) { const int k_ = kt_ * 64 + r + 32 * i; v[i] = (f32x4){0.f, 0.f, 0.f, 0.f}; if (n_ < N) v[i] = *(const f32x4*)(src + (size_t)k_ * N + n_); } } while (0)
    if (c.bid < ntiles) CONVT_LD(c.bid);
    for (int tix = c.bid; tix < ntiles; tix += c.nb) {
        const int nt = tix / nkt, kt = tix % nkt;
#pragma unroll
        for (int i = 0; i < 2; ++i) { LAS float* tp = tile + (r + 32 * i) * 65 + 4 * c4; tp[0] = v[i][0]; tp[1] = v[i][1]; tp[2] = v[i][2]; tp[3] = v[i][3]; }
        __syncthreads();
        if (tix + c.nb < ntiles) CONVT_LD(tix + c.nb);
        { const int n = c.tid >> 3, kq = c.tid & 7; float w[8];
#pragma unroll
          for (int j = 0; j < 8; ++j) w[j] = tile[(kq * 8 + j) * 65 + n];
          u32x4 o; o[0] = cvt_pk_bf16(w[0], w[1]); o[1] = cvt_pk_bf16(w[2], w[3]); o[2] = cvt_pk_bf16(w[4], w[5]); o[3] = cvt_pk_bf16(w[6], w[7]);
          *(u32x4*)(dst + (size_t)(nt * 64 + n) * K + kt * 64 + kq * 8) = o; }
        __syncthreads();
    }
#undef CONVT_LD
}
__device__ __forceinline__ void conv_fp6rows(const float* src, unsigned char* dst6, float* scl, int rows, const Ctx& c) {
    for (int row = c.bid * 8 + c.wave; row < rows; row += c.nb * 8) {
        const float* sp = src + (size_t)row * 2048 + c.lane * 32;
        f32x4 v[8]; float mx = 0.f;
#pragma unroll
        for (int j = 0; j < 8; ++j) { v[j] = *(const f32x4*)(sp + j * 4); mx = fmaxf(mx, fmaxf(fmaxf(fabsf(v[j][0]), fabsf(v[j][1])), fmaxf(fabsf(v[j][2]), fabsf(v[j][3])))); }
        mx = wave_max(mx);
        const float s = mx > 0.f ? 7.5f / mx : 1.f;
        if (c.lane == 0) scl[row] = mx > 0.f ? mx * (1.f / 7.5f) : 1.f;
        f32x16 x, y;
#pragma unroll
        for (int j = 0; j < 4; ++j)
#pragma unroll
            for (int e = 0; e < 4; ++e) { const int i = j * 4 + e;
                x[i] = v[(2 * i) >> 2][(2 * i) & 3] * s; y[i] = v[(2 * i + 1) >> 2][(2 * i + 1) & 3] * s; }
        const u32x6 pk = __builtin_amdgcn_cvt_scalef32_2xpk16_fp6_f32(x, y, 1.0f);
        unsigned char* dp = dst6 + (size_t)row * 1536 + c.lane * 24;
        *(u32x2*)dp = (u32x2){pk[0], pk[1]}; *(u32x2*)(dp + 8) = (u32x2){pk[2], pk[3]}; *(u32x2*)(dp + 16) = (u32x2){pk[4], pk[5]};
    }
}
__device__ __forceinline__ void conv_E(const float* src, bf16_t* dst, size_t n8, const Ctx& c) {
    const size_t stride = (size_t)c.nb * NTHREADS;
    for (size_t i = (size_t)c.bid * NTHREADS + c.tid; i < n8; i += stride) {
        const f32x4 x = *(const f32x4*)(src + i * 8), y = *(const f32x4*)(src + i * 8 + 4);
        *(u32x4*)(dst + i * 8) = pack8(x, y);
    }
}
__device__ __forceinline__ int t5_bucket(int n) {
    if (n < 16) return n;
    const float scaled = logf((float)n / 16.f) / logf(64.f);
    const int large = 16 + (int)(scaled * 16.f);
    return large < 31 ? large : 31;
}
__device__ __forceinline__ void p0_tb(const Args& a, const Ctx& c) {
    float* tb = (float*)(a.ws + WS_TB); const float* rb = a.in[26];
    for (int i = c.bid * NTHREADS + c.tid; i < 8 * TBN; i += c.nb * NTHREADS) { const int head = i / TBN, dist = i % TBN; tb[i] = rb[t5_bucket(dist) * 8 + head] * LOG2E; }
}
__device__ __forceinline__ void p0_bpe(const Args& a, const Ctx& c, int part) {
    const int n = c.tid & 255, kv = c.tid >> 8;
    const float* pe = a.in[kv ? 23 : 20]; const float* w1 = a.in[kv ? 24 : 21]; float* bpep = (float*)(a.ws + WS_BPEP);
    float s = 0.f;
#pragma unroll 16
    for (int k = part * 128; k < part * 128 + 128; ++k) s += pe[k] * w1[(size_t)k * 256 + n];
    bpep[(part * 2 + kv) * 256 + n] = s;
}
__device__ __forceinline__ void p0_s5(const Args& a, const Ctx& c, int g) {
    LAS float* ar = (LAS float*)c.lds;
    LAS float* ai = ar + 17 * 64;
    LAS float* bbr = ai + 17 * 64;
    LAS float* bbi = bbr + 1024;
    LAS float* cr = bbi + 1024;
    LAS float* ci = cr + 1024;
    LAS float* kd = ci + 1024;
    const int tid = c.tid;
    if (tid < 64) {
        const int p = tid; const float dt = expf(a.in[12][g]); const float lr = a.in[10][g * 64 + p], li = a.in[11][g * 64 + p];
        for (int d = 0; d <= 16; ++d) { const float mag = expf(lr * dt * (float)d), ang = li * dt * (float)d; ar[d * 64 + p] = mag * cosf(ang); ai[d * 64 + p] = mag * sinf(ang); }
        const float nr = ar[64 + p] - 1.f, ni = ai[64 + p], den = lr * lr + li * li;
        const float wre = (nr * lr + ni * li) / den, wim = (ni * lr - nr * li) / den;
        for (int h = 0; h < 16; ++h) { const float br = a.in[13][(g * 64 + p) * 16 + h], bi = a.in[14][(g * 64 + p) * 16 + h]; bbr[p * 16 + h] = wre * br - wim * bi; bbi[p * 16 + h] = wre * bi + wim * br; }
        float* s5p = (float*)(a.ws + WS_S5P);
        float xr = ar[16 * 64 + p], xi = ai[16 * 64 + p];
        s5p[(g * 64 + p) * 2] = xr; s5p[(g * 64 + p) * 2 + 1] = xi;
        for (int s = 0; s < 8; ++s) { const float tr = xr * xr - xi * xi, ti = 2.f * xr * xi; xr = tr; xi = ti; }
        s5p[64 * 64 * 2 + (g * 64 + p) * 2] = xr; s5p[64 * 64 * 2 + (g * 64 + p) * 2 + 1] = xi;
    }
    for (int e = tid; e < 1024; e += NTHREADS) { cr[e] = a.in[15][g * 1024 + e]; ci[e] = a.in[16][g * 1024 + e]; }
    __syncthreads();
    for (int e = tid; e < 4096; e += NTHREADS) {
        const int d = e >> 8, h1 = (e >> 4) & 15, h = e & 15; float s = 0.f;
        for (int p = 0; p < 64; ++p) { const float Cr = cr[h1 * 64 + p], Ci = ci[h1 * 64 + p], Ar = ar[d * 64 + p], Ai = ai[d * 64 + p];
            const float Gr = Cr * Ar - Ci * Ai, Gi = Cr * Ai + Ci * Ar; s += Gr * bbr[p * 16 + h] - Gi * bbi[p * 16 + h]; }
        if (d == 0 && h1 == h) s += a.in[17][g * 16 + h];
        kd[e] = s;
    }
    __syncthreads();
    bf16_t* MT = (bf16_t*)(a.ws + WS_S5MT) + (size_t)g * 65536;
    bf16_t* WE = (bf16_t*)(a.ws + WS_S5WE) + (size_t)g * 32768;
    bf16_t* WC = (bf16_t*)(a.ws + WS_S5WC) + (size_t)g * 32768;
    for (int e = tid; e < 65536; e += NTHREADS) { const int n = e >> 8, k = e & 255, j = n >> 4, h1 = n & 15, i = k >> 4, h = k & 15;
        MT[e] = f2bf(i <= j ? kd[(j - i) * 256 + h1 * 16 + h] : 0.f); }
    for (int e = tid; e < 32768; e += NTHREADS) { const int n = e >> 8, k = e & 255, cc = n >> 6, p = n & 63, i = k >> 4, h = k & 15;
        const float Ar = ar[(15 - i) * 64 + p], Ai = ai[(15 - i) * 64 + p], Br = bbr[p * 16 + h], Bi = bbi[p * 16 + h];
        WE[e] = f2bf(cc ? (Ar * Bi + Ai * Br) : (Ar * Br - Ai * Bi)); }
    for (int e = tid; e < 32768; e += NTHREADS) { const int n = e >> 7, k = e & 127, j = n >> 4, h1 = n & 15, cc = k >> 6, p = k & 63;
        const float Cr = cr[h1 * 64 + p], Ci = ci[h1 * 64 + p], Ar = ar[(j + 1) * 64 + p], Ai = ai[(j + 1) * 64 + p];
        WC[e] = f2bf(cc ? -(Cr * Ai + Ci * Ar) : (Cr * Ar - Ci * Ai)); }
    __syncthreads();
}
__device__ __forceinline__ void p0_prologue(const Args& a, const Ctx& c) {
    for (int g = c.bid; g < 64; g += c.nb) p0_s5(a, c, g);
    for (int u = 0; u < 32; ++u) if (c.bid == (64 + u) % c.nb) p0_bpe(a, c, u);
    p0_tb(a, c);
    p0_cond(a, c);
    conv_T(a.in[6], 2048, DIN, (bf16_t*)(a.ws + WS_WIN), DIN_PAD, c);
    conv_T(a.in[18], 1024, 1024, (bf16_t*)(a.ws + WS_WGLU), 1024, c);
    conv_T(a.in[7], 2048, 2048, (bf16_t*)(a.ws + WS_WOUT), 2048, c);
    conv_T(a.in[27], 2048, 2048, (bf16_t*)(a.ws + WS_WQ), 2048, c);
    conv_T(a.in[21], 4096, 256, (bf16_t*)(a.ws + WS_W1), 256, c);
    conv_T(a.in[24], 4096, 256, (bf16_t*)(a.ws + WS_W1) + 256 * 4096, 256, c);
    conv_T(a.in[22], 256, 128, (bf16_t*)(a.ws + WS_W2), 128, c);
    conv_T(a.in[25], 256, 128, (bf16_t*)(a.ws + WS_W2) + 128 * 256, 128, c);
    conv_E(a.in[28], (bf16_t*)(a.ws + WS_PK), 128 * 128 / 8, c);
    conv_E(a.in[29], (bf16_t*)(a.ws + WS_PK) + 128 * 128, 128 * 128 / 8, c);
    conv_fp6rows(a.in[30], a.ws + WS_PU, (float*)(a.ws + WS_PSC), 16384, c);
    conv_fp6rows(a.in[31], a.ws + WS_PV, (float*)(a.ws + WS_PSC) + 16384, 16384, c);
}

__device__ __forceinline__ void norm_rows(const float* X, bf16_t* O, LAS const float* Ab, LAS const float* Bb, const Ctx& c, int row0 = 0, int nrows = L_) {
    for (int t = row0 + c.bid * 8 + c.wave; t < row0 + nrows; t += c.nb * 8) {
        const float* xr = X + (size_t)t * 2048 + c.lane * 4;
        f32x4 v[8]; float ss = 0.f;
#pragma unroll
        for (int j = 0; j < 8; ++j) { v[j] = *(const f32x4*)(xr + j * 256); ss += v[j][0] * v[j][0] + v[j][1] * v[j][1] + v[j][2] * v[j][2] + v[j][3] * v[j][3]; }
        ss = wave_sum(ss);
        const float rstd = rsqrtf(ss * (1.f / 2048.f) + 1e-6f);
#pragma unroll
        for (int j = 0; j < 8; ++j) {
            const int col = j * 256 + c.lane * 4;
            const f32x4 A = *(const LAS f32x4*)(Ab + col), B = *(const LAS f32x4*)(Bb + col);
            const f32x4 o = v[j] * rstd * A + B;
            u32x2 w; w[0] = cvt_pk_bf16(o[0], o[1]); w[1] = cvt_pk_bf16(o[2], o[3]);
            *(u32x2*)(O + (size_t)t * 2048 + col) = w;
        }
    }
}
__device__ __forceinline__ float cond_from_partials(const float* condp, const float* b_ada, int j) {
    float s = b_ada[j];
#pragma unroll 8
    for (int k = 0; k < 32; ++k) s += condp[(size_t)k * NADA + j];
    return s;
}
__device__ __forceinline__ void p1_hnorm(const Args& a, const Ctx& c) {
    const float* condp = (const float*)(a.ws + WS_CONDP); float* cond = (float*)(a.ws + WS_COND);
    for (int j = c.bid * NTHREADS + c.tid; j < NADA; j += c.nb * NTHREADS) cond[j] = cond_from_partials(condp, a.in[3], j);
    LAS float* Ab = (LAS float*)c.lds; LAS float* Bb = Ab + 2048;
    for (int col = c.tid; col < 2048; col += NTHREADS) {
        Ab[col] = a.in[4][col] * (1.f + cond_from_partials(condp, a.in[3], 2048 + col)); Bb[col] = cond_from_partials(condp, a.in[3], col); }
    __syncthreads();
    norm_rows(a.in[0], (bf16_t*)(a.ws + WS_H), Ab, Bb, c);
}
__device__ __forceinline__ void p8_h2norm(const Args& a, const Ctx& c, int row0, int nrows) {
    const float* cond = (const float*)(a.ws + WS_COND);
    LAS float* Ab = (LAS float*)c.lds; LAS float* Bb = Ab + 2048;
    for (int col = c.tid; col < 2048; col += NTHREADS) { Ab[col] = a.in[5][col] * (1.f + cond[4 * 2048 + col]); Bb[col] = cond[3 * 2048 + col]; }
    __syncthreads();
    norm_rows(a.out, (bf16_t*)(a.ws + WS_H), Ab, Bb, c, row0, nrows);
}
__device__ __forceinline__ void p6_mixnorm(const Args& a, const Ctx& c) {
    const bf16_t* YS = (const bf16_t*)(a.ws + WS_YSSM); const bf16_t* YA = (const bf16_t*)(a.ws + WS_YATT); bf16_t* O = (bf16_t*)(a.ws + WS_H);
    for (int t = c.bid * 8 + c.wave; t < L_; t += c.nb * 8) {
#pragma unroll
        for (int part = 0; part < 2; ++part) {
            const bf16_t* src = (part ? YA : YS) + (size_t)t * 1024 + c.lane * 8; const float* beta = a.in[part ? 9 : 8];
            u32x4 w[2]; float f[16]; float ss = 0.f;
#pragma unroll
            for (int j = 0; j < 2; ++j) { w[j] = *(const u32x4*)(src + j * 512);
#pragma unroll
                for (int e = 0; e < 4; ++e) { f[j * 8 + 2 * e] = bflo(w[j][e]); f[j * 8 + 2 * e + 1] = bfhi(w[j][e]); } }
#pragma unroll
            for (int e = 0; e < 16; ++e) ss += f[e] * f[e];
            ss = wave_sum(ss);
            const float rstd = rsqrtf(ss * (1.f / 1024.f) + 1e-6f);
#pragma unroll
            for (int j = 0; j < 2; ++j) { const int col = j * 512 + c.lane * 8; const f32x4 b0 = *(const f32x4*)(beta + col), b1 = *(const f32x4*)(beta + col + 4);
                f32x4 o0, o1;
#pragma unroll
                for (int e = 0; e < 4; ++e) { o0[e] = f[j * 8 + e] * rstd * b0[e]; o1[e] = f[j * 8 + 4 + e] * rstd * b1[e]; }
                *(u32x4*)(O + (size_t)t * 2048 + part * 1024 + col) = pack8(o0, o1); }
        }
    }
}
constexpr int S5_US = 0, S5_ES = 33792, S5_SS = 67584;
template <int PASS>
__device__ __forceinline__ void s5_item(const Args& a, const Ctx& c, int g, int seg) {
    LAS unsigned char* lds = c.lds;
    const int tid = c.tid, wave = c.wave, lane = c.lane, r = lane & 15, q = lane >> 4;
    const bf16_t* U = (const bf16_t*)(a.ws + WS_US);
    const bf16_t* MT = (const bf16_t*)(a.ws + WS_S5MT) + (size_t)g * 65536;
    const bf16_t* WE = (const bf16_t*)(a.ws + WS_S5WE) + (size_t)g * 32768;
    const bf16_t* WC = (const bf16_t*)(a.ws + WS_S5WC) + (size_t)g * 32768;
    const float* s5p = (const float*)(a.ws + WS_S5P);
    float* F = (float*)(a.ws + WS_S5F) + (size_t)g * 4 * 128;
    bf16_t* Z = (bf16_t*)(a.ws + WS_Z);
    bf16x8 bE[8];
#pragma unroll
    for (int ks = 0; ks < 8; ++ks) bE[ks] = *(const bf16x8*)(WE + (size_t)(16 * wave + r) * 256 + 32 * ks + 8 * q);
    float sr = 0.f, si = 0.f, a16r = 0.f, a16i = 0.f;
    if (wave == 0) {
        a16r = s5p[(g * 64 + lane) * 2]; a16i = s5p[(g * 64 + lane) * 2 + 1];
        if (PASS == 1) { const float br = s5p[8192 + (g * 64 + lane) * 2], bi = s5p[8192 + (g * 64 + lane) * 2 + 1];
            for (int s = 0; s < seg; ++s) { const float fr_ = F[s * 128 + lane], fi_ = F[s * 128 + 64 + lane]; const float nr = br * sr - bi * si + fr_, ni = br * si + bi * sr + fi_; sr = nr; si = ni; } }
    }
    for (int sb = 0; sb < 4; ++sb) {
        const int tok0 = seg * 4096 + sb * 1024;
#pragma unroll
        for (int i = 0; i < 4; ++i) { const int ch = tid + NTHREADS * i, token = ch >> 1, half = ch & 1;
            const u32x4 v = *(const u32x4*)(U + (size_t)(tok0 + token) * 1024 + g * 16 + half * 8);
            *(LAS u32x4*)(lds + S5_US + (token >> 4) * 528 + ((token & 15) * 16 + half * 8) * 2) = v; }
        __syncthreads();
#pragma unroll
        for (int m = 0; m < 4; ++m) {
            f32x4 acc = {0.f, 0.f, 0.f, 0.f};
#pragma unroll
            for (int ks = 0; ks < 8; ++ks) { const bf16x8 A = *(const LAS bf16x8*)(lds + S5_US + (16 * m + r) * 528 + (32 * ks + 8 * q) * 2); acc = mfma16(A, bE[ks], acc); }
#pragma unroll
            for (int i = 0; i < 4; ++i) *(LAS float*)(lds + S5_ES + ((16 * m + 4 * q + i) * 132 + 16 * wave + r) * 4) = acc[i];
        }
        __syncthreads();
        if (wave == 0) {
            for (int ch = 0; ch < 64; ++ch) {
                const float er = *(const LAS float*)(lds + S5_ES + (ch * 132 + lane) * 4), ei = *(const LAS float*)(lds + S5_ES + (ch * 132 + 64 + lane) * 4);
                if (PASS == 1) { *(LAS bf16_t*)(lds + S5_SS + (ch * 136 + lane) * 2) = f2bf(sr); *(LAS bf16_t*)(lds + S5_SS + (ch * 136 + 64 + lane) * 2) = f2bf(si); }
                const float nr = a16r * sr - a16i * si + er, ni = a16r * si + a16i * sr + ei; sr = nr; si = ni;
            }
        }
        __syncthreads();
        if (PASS == 1) {
#pragma unroll
            for (int nt = 0; nt < 2; ++nt) {
                const int j = 2 * wave + nt;
                f32x4 acc[4];
#pragma unroll
                for (int m = 0; m < 4; ++m) acc[m] = (f32x4){0.f, 0.f, 0.f, 0.f};
                for (int ks = 0; ks <= (j >> 1); ++ks) {
                    const bf16x8 B = *(const bf16x8*)(MT + (size_t)(16 * j + r) * 256 + 32 * ks + 8 * q);
#pragma unroll
                    for (int m = 0; m < 4; ++m) { const bf16x8 A = *(const LAS bf16x8*)(lds + S5_US + (16 * m + r) * 528 + (32 * ks + 8 * q) * 2); acc[m] = mfma16(A, B, acc[m]); }
                }
#pragma unroll
                for (int ks = 0; ks < 4; ++ks) {
                    const bf16x8 B = *(const bf16x8*)(WC + (size_t)(16 * j + r) * 128 + 32 * ks + 8 * q);
#pragma unroll
                    for (int m = 0; m < 4; ++m) { const bf16x8 A = *(const LAS bf16x8*)(lds + S5_SS + (16 * m + r) * 272 + (32 * ks + 8 * q) * 2); acc[m] = mfma16(A, B, acc[m]); }
                }
#pragma unroll
                for (int m = 0; m < 4; ++m)
#pragma unroll
                    for (int i = 0; i < 4; ++i) { const int ch = 16 * m + 4 * q + i; Z[(size_t)(tok0 + 16 * ch + j) * 1024 + g * 16 + r] = f2bf(gelu_tanh(acc[m][i])); }
            }
            __syncthreads();
        }
    }
    if (PASS == 0 && wave == 0) { F[seg * 128 + lane] = sr; F[seg * 128 + 64 + lane] = si; }
}

__device__ __forceinline__ void cmp_finish_item(const Args& a, const Ctx& c, int kvsel, int rt) {
    LAS unsigned char* lds = c.lds;
    const int tid = c.tid, wave = c.wave, lane = c.lane, r = lane & 15, q = lane >> 4;
    const float* SL = (const float*)(a.ws + WS_SLAB) + (size_t)kvsel * 4 * 2048 * 256;
    const float* bpep = (const float*)(a.ws + WS_BPEP) + kvsel * 256;
    const bf16_t* W2 = (const bf16_t*)(a.ws + WS_W2) + kvsel * 128 * 256;
    for (int e = tid; e < 64 * 64; e += NTHREADS) {
        const int row = e >> 6, c4 = (e & 63) * 4;
        f32x4 s = {0.f, 0.f, 0.f, 0.f};
#pragma unroll 8
        for (int pt = 0; pt < 32; ++pt) s += *(const f32x4*)(bpep + pt * 512 + c4);
#pragma unroll
        for (int ks = 0; ks < 4; ++ks) s += *(const f32x4*)(SL + ((size_t)ks * 2048 + rt * 64 + row) * 256 + c4);
        u32x2 w; w[0] = cvt_pk_bf16(gelu_tanh(s[0]), gelu_tanh(s[1])); w[1] = cvt_pk_bf16(gelu_tanh(s[2]), gelu_tanh(s[3]));
        *(LAS u32x2*)(lds + row * 528 + c4 * 2) = w;
    }
    __syncthreads();
    bf16x8 B[8];
#pragma unroll
    for (int ks = 0; ks < 8; ++ks) B[ks] = *(const bf16x8*)(W2 + (size_t)(16 * wave + r) * 256 + 32 * ks + 8 * q);
#pragma unroll
    for (int m = 0; m < 4; ++m) {
        f32x4 acc = {0.f, 0.f, 0.f, 0.f};
#pragma unroll
        for (int ks = 0; ks < 8; ++ks) { const bf16x8 A = *(const LAS bf16x8*)(lds + (16 * m + r) * 528 + (32 * ks + 8 * q) * 2); acc = mfma16(A, B[ks], acc); }
#pragma unroll
        for (int i = 0; i < 4; ++i) {
            const int row = rt * 64 + 16 * m + 4 * q + i, gi = row >> 10, ci = row & 1023, n = 16 * wave + r;
            const bf16_t v = (ci == 1023) ? (bf16_t)0 : f2bf(acc[i]);
            if (kvsel == 0) ((bf16_t*)(a.ws + WS_KC))[((size_t)gi * 1024 + ci) * 128 + n] = v;
            else ((bf16_t*)(a.ws + WS_VCT))[((size_t)gi * 128 + n) * 1024 + ((ci & ~12) | ((ci & 4) << 1) | ((ci & 8) >> 1))] = v;
        }
    }
    __syncthreads();
}
constexpr int AT_IMP = 65536, AT_TB = 131072, AT_BM = 143872, AT_WU = 145920, AT_END = 146176;
__device__ __forceinline__ int kswz(int r) { return ((r & 3) << 2) | ((r >> 2) & 3); }
__host__ __device__ __forceinline__ int vperm(int t) { return (t & ~12) | ((t & 4) << 1) | ((t & 8) >> 1); }
template <int KEYS> __device__ __forceinline__ int vsw(int d) { return KEYS == 128 ? kswz(d) : ((d >> 1) & 7); }
template <int KEYS, bool NEEDV>
__device__ __forceinline__ void stage_dma(const bf16_t* Kt, const bf16_t* Vt, int ldv, LAS unsigned char* kb, LAS unsigned char* vb, int wave, int lane) {
    constexpr int NP = KEYS / 32;
#pragma unroll
    for (int i = 0; i < NP; ++i) { const int pc = NP * wave + i, row = 4 * pc + (lane >> 4), ch = (lane & 15) ^ kswz(row);
        __builtin_amdgcn_global_load_lds((const unsigned*)(Kt + row * 128 + ch * 8), (LAS unsigned*)(kb + pc * 1024), 16, 0, 0); }
    if (NEEDV) {
#pragma unroll
        for (int i = 0; i < NP; ++i) {
            const int pc = NP * wave + i;
            if (KEYS == 128) { const int d = 4 * pc + (lane >> 4), ch = (lane & 15) ^ kswz(d);
                __builtin_amdgcn_global_load_lds((const unsigned*)(Vt + (size_t)d * ldv + 8 * ch), (LAS unsigned*)(vb + pc * 1024), 16, 0, 0); }
            else { const int d = 8 * pc + (lane >> 3), ch = (lane & 7) ^ ((d >> 1) & 7);
                __builtin_amdgcn_global_load_lds((const unsigned*)(Vt + (size_t)d * ldv + 8 * ch), (LAS unsigned*)(vb + pc * 1024), 16, 0, 0); }
        }
    }
}
__device__ __forceinline__ float xhalf_max(float x) { auto rr = __builtin_amdgcn_permlane32_swap(__float_as_uint(x), __float_as_uint(x), false, false); return fmaxf(__uint_as_float(rr[0]), __uint_as_float(rr[1])); }
__device__ __forceinline__ float xhalf_sum(float x) { auto rr = __builtin_amdgcn_permlane32_swap(__float_as_uint(x), __float_as_uint(x), false, false); return __uint_as_float(rr[0]) + __uint_as_float(rr[1]); }
template <int BR>
__device__ __forceinline__ float tile_prep(int MODE, f32x16& S, LAS const float* tb, float cb, int base, bool selbit) {
    float mx = -INFINITY;
    if (MODE == 1) {
#pragma unroll
        for (int r = 0; r < 16; ++r) mx = fmaxf(mx, S[r]);
        mx = (BR == 2 && !selbit) ? -INFINITY : mx + cb;
    } else {
        const bool nomask = (MODE == 2);
        float bv[16];
#pragma unroll
        for (int r = 0; r < 16; ++r) { const int cr = (r & 3) + 8 * (r >> 2); const int dist = (BR <= 1) ? base - 16 * cr : base - cr; bv[r] = tb[min(max(dist, 0), TBN - 1)]; }
        __builtin_amdgcn_sched_barrier(0);
#pragma unroll
        for (int r = 0; r < 16; ++r) {
            const int cr = (r & 3) + 8 * (r >> 2);
            const int dist = (BR <= 1) ? base - 16 * cr : base - cr;
            float v = S[r] + bv[r];
            bool valid;
            if (BR <= 1) valid = dist >= 0; else if (BR == 2) valid = selbit && dist >= 0; else valid = nomask || (unsigned)dist < 512u;
            v = valid ? v : -INFINITY;
            S[r] = v; mx = fmaxf(mx, v);
        }
    }
    return mx;
}
template <int BR, bool PEND>
__device__ __forceinline__ float tile_decide(int MODE, float mx, float cb, bool selbit, f32x16 (&O)[4], float& m, float& l, u32x4& pa, u32x4& pb) {
    if (BR == 1) { const float mu = (m == -INFINITY) ? 0.f : m; return (MODE == 1) ? mu - cb : mu; }
    mx = xhalf_max(mx);
    const float mn = fmaxf(m, mx), mu = (mn == -INFINITY) ? 0.f : mn;
    if (__any(mn > m)) {
        const float alpha = fexp2(m - mu);
        l *= alpha;
        if (BR >= 2) {
#pragma unroll
            for (int dt = 0; dt < 4; ++dt)
#pragma unroll
                for (int r = 0; r < 16; ++r) O[dt][r] *= alpha;
            if (PEND) {
#pragma unroll
                for (int e = 0; e < 4; ++e) { pa[e] = cvt_pk_bf16(bflo(pa[e]) * alpha, bfhi(pa[e]) * alpha); pb[e] = cvt_pk_bf16(bflo(pb[e]) * alpha, bfhi(pb[e]) * alpha); }
            }
        }
    }
    m = mn;
    if (MODE == 1) return (BR == 2 && !selbit) ? INFINITY : mu - cb;
    return mu;
}
template <int BR, int KEYS>
__device__ __forceinline__ void attn_tile(int MODE, LAS const unsigned char* kb, LAS const unsigned char* vb, int cb0, LAS const float* tb, int key0, int t, int lane,
                                          const bf16x8 (&qf)[8], f32x16 (&O)[4], float& m, float& l, float inv_l, bool selbit, LAS float* imp_row) {
    asm volatile("" : "+v"(lane));
    constexpr int ROWB = 2 * KEYS;
    const int r31 = lane & 31, h = lane >> 5;
    const int gh = kswz(r31) ^ h, vh = vsw<KEYS>(r31) ^ h;
    float cb = 0.f;
    if (MODE == 1) cb = tb[TBN - 1];
    const int base0 = (BR <= 1) ? t - 31 - 16 * (key0 + 4 * h) : t - (key0 + 4 * h);
    const int base1 = (BR <= 1) ? base0 - 16 * 32 : base0 - 32;
    LAS const unsigned char* k0 = kb + r31 * 256;
    f32x16 S0, S1;
    bf16x8 kf[8];
#pragma unroll
    for (int ks = 0; ks < 8; ++ks) kf[ks] = *(const LAS bf16x8*)(k0 + 16 * ((2 * ks) ^ gh));
#pragma unroll
    for (int r = 0; r < 16; ++r) { S0[r] = 0.f; S1[r] = 0.f; }
    __builtin_amdgcn_sched_barrier(0);
#pragma unroll
    for (int ks = 0; ks < 8; ++ks) S0 = mfma32(kf[ks], qf[ks], S0);
    __builtin_amdgcn_sched_barrier(0);
#pragma unroll
    for (int ks = 0; ks < 8; ++ks) kf[ks] = *(const LAS bf16x8*)(k0 + 8192 + 16 * ((2 * ks) ^ gh));
    const float mx0 = tile_prep<BR>(MODE, S0, tb, cb, base0, selbit);
    u32x4 pk0a = {0u, 0u, 0u, 0u}, pk0b = {0u, 0u, 0u, 0u}, pk1a, pk1b;
    const float me0 = tile_decide<BR, false>(MODE, mx0, cb, selbit, O, m, l, pk0a, pk0b);
    __builtin_amdgcn_sched_barrier(0);
    {
#pragma unroll
        for (int ks = 0; ks < 8; ++ks) S1 = mfma32(kf[ks], qf[ks], S1);
        float ps = 0.f;
#pragma unroll
        for (int r = 0; r < 16; ++r) { float p = fexp2(S0[r] - me0); if (BR == 1) p *= inv_l; S0[r] = p; ps += p; }
        if (BR != 1) l += ps;
        if (BR >= 1) {
#pragma unroll
            for (int e = 0; e < 4; ++e) { pk0a[e] = cvt_pk_bf16(S0[2 * e], S0[2 * e + 1]); pk0b[e] = cvt_pk_bf16(S0[8 + 2 * e], S0[8 + 2 * e + 1]); }
        }
#pragma unroll
        for (int i = 0; i < 8; ++i) { __builtin_amdgcn_sched_group_barrier(0x008, 1, 0); __builtin_amdgcn_sched_group_barrier(0x002, 8, 0); }
    }
    __builtin_amdgcn_sched_barrier(0);
    if (BR == 1) {
#pragma unroll
        for (int rg = 0; rg < 4; ++rg) {
            float A = 2.f * (S0[4 * rg] + S0[4 * rg + 1] + S0[4 * rg + 2]) + S0[4 * rg + 3], B = S0[4 * rg + 3];
            A = quad_sum(A); B = quad_sum(B);
            const int jj = (key0 >> 2) + 2 * rg + h;
            if ((lane & 3) == 0) { __hip_atomic_fetch_add(imp_row + jj, A, __ATOMIC_RELAXED, __HIP_MEMORY_SCOPE_WORKGROUP);
                if (jj + 1 < 256) __hip_atomic_fetch_add(imp_row + jj + 1, B, __ATOMIC_RELAXED, __HIP_MEMORY_SCOPE_WORKGROUP); }
        }
    }
    bf16x8 av[8];
    if (BR >= 1) {
#pragma unroll
        for (int s = 0; s < 2; ++s)
#pragma unroll
            for (int dt = 0; dt < 4; ++dt) av[s * 4 + dt] = *(const LAS bf16x8*)(vb + (32 * dt + r31) * ROWB + 16 * ((cb0 + 2 * s) ^ vh));
    }
    const float mx1 = tile_prep<BR>(MODE, S1, tb, cb, base1, selbit);
    const float me1 = tile_decide<BR, true>(MODE, mx1, cb, selbit, O, m, l, pk0a, pk0b);
    __builtin_amdgcn_sched_barrier(0);
    {
        if (BR >= 1) {
#pragma unroll
            for (int dt = 0; dt < 4; ++dt) O[dt] = mfma32(av[dt], __builtin_bit_cast(bf16x8, pk0a), O[dt]);
#pragma unroll
            for (int dt = 0; dt < 4; ++dt) O[dt] = mfma32(av[4 + dt], __builtin_bit_cast(bf16x8, pk0b), O[dt]);
        }
        float ps = 0.f;
#pragma unroll
        for (int r = 0; r < 16; ++r) { float p = fexp2(S1[r] - me1); if (BR == 1) p *= inv_l; S1[r] = p; ps += p; }
        if (BR != 1) l += ps;
        if (BR >= 1) {
#pragma unroll
            for (int e = 0; e < 4; ++e) { pk1a[e] = cvt_pk_bf16(S1[2 * e], S1[2 * e + 1]); pk1b[e] = cvt_pk_bf16(S1[8 + 2 * e], S1[8 + 2 * e + 1]); }
#pragma unroll
            for (int i = 0; i < 8; ++i) { __builtin_amdgcn_sched_group_barrier(0x008, 1, 0); __builtin_amdgcn_sched_group_barrier(0x002, 8, 0); }
        }
    }
    __builtin_amdgcn_sched_barrier(0);
    if (BR == 1) {
#pragma unroll
        for (int rg = 0; rg < 4; ++rg) {
            float A = 2.f * (S1[4 * rg] + S1[4 * rg + 1] + S1[4 * rg + 2]) + S1[4 * rg + 3], B = S1[4 * rg + 3];
            A = quad_sum(A); B = quad_sum(B);
            const int jj = ((key0 + 32) >> 2) + 2 * rg + h;
            if ((lane & 3) == 0) { __hip_atomic_fetch_add(imp_row + jj, A, __ATOMIC_RELAXED, __HIP_MEMORY_SCOPE_WORKGROUP);
                if (jj + 1 < 256) __hip_atomic_fetch_add(imp_row + jj + 1, B, __ATOMIC_RELAXED, __HIP_MEMORY_SCOPE_WORKGROUP); }
        }
    }
    if (BR >= 1) {
#pragma unroll
        for (int s = 0; s < 2; ++s)
#pragma unroll
            for (int dt = 0; dt < 4; ++dt) av[s * 4 + dt] = *(const LAS bf16x8*)(vb + (32 * dt + r31) * ROWB + 16 * ((cb0 + 4 + 2 * s) ^ vh));
        __builtin_amdgcn_sched_barrier(0);
#pragma unroll
        for (int dt = 0; dt < 4; ++dt) O[dt] = mfma32(av[dt], __builtin_bit_cast(bf16x8, pk1a), O[dt]);
#pragma unroll
        for (int dt = 0; dt < 4; ++dt) O[dt] = mfma32(av[4 + dt], __builtin_bit_cast(bf16x8, pk1b), O[dt]);
    }
}
template <int BR, int KEYS>
__device__ __forceinline__ void run_branch(const Ctx& c, const bf16_t* Kb, const bf16_t* Vtb, int ldv, int lo, int hi, LAS const float* tb, int t, int t0,
                                           const bf16x8 (&qf)[8], f32x16 (&O)[4], float& m, float& l, float inv_l, int tl, LAS float* imp_row) {
    constexpr bool NEEDV = (BR != 0);
    constexpr int BPS = KEYS / 64, KSTG = KEYS * 256, VSTG = 128 * 2 * KEYS, VB0 = 2 * KSTG;
    LAS unsigned char* lds = c.lds;
    int lz = c.lane; asm volatile("" : "+v"(lz));
    const int nst = (hi - lo + BPS - 1) / BPS;
#define STG_BLK(i) ((lo + BPS * (i) + BPS - 1 < hi) ? lo + BPS * (i) : hi - BPS)
    asm volatile("s_waitcnt vmcnt(0)" ::: "memory");
    { const int b0 = (BPS == 2 && hi - lo < 2) ? lo : STG_BLK(0);
      stage_dma<KEYS, NEEDV>(Kb + (size_t)b0 * 64 * 128, Vtb + (size_t)b0 * 64, ldv, lds, lds + VB0, c.wave, lz); }
    asm volatile("s_waitcnt vmcnt(0)" ::: "memory");
    __syncthreads();
    const int qt = t0 >> 6;
    for (int i = 0; i < nst; ++i) {
        const int buf = i & 1;
        if (i + 1 < nst) { int lz2 = lz; asm volatile("" : "+v"(lz2));
            const int b1 = STG_BLK(i + 1);
            stage_dma<KEYS, NEEDV>(Kb + (size_t)b1 * 64 * 128, Vtb + (size_t)b1 * 64, ldv, lds + (buf ^ 1) * KSTG, lds + VB0 + (buf ^ 1) * VSTG, c.wave, lz2); }
        const int sb = (BPS == 2 && hi - lo < 2) ? lo : STG_BLK(i);
#pragma unroll
        for (int q = 0; q < BPS; ++q) {
            const int j = lo + BPS * i + q;
            if (j < hi) {
                bool selbit = true, wave_on = true;
                if (BR == 2) {
                    const unsigned w = *(const LAS unsigned*)(lds + AT_BM + (tl * 8 + (j >> 5)) * 4);
                    selbit = (w >> (j & 31)) & 1u;
                    const unsigned wu = *(const LAS unsigned*)(lds + AT_WU + (c.wave * 8 + (j >> 5)) * 4);
                    wave_on = (wu >> (j & 31)) & 1u;
                }
                if (wave_on) {
                    int mode = 0;
                    if (BR <= 1) mode = (1024 * j + 1829 <= t0) ? 1 : 0;
                    else if (BR == 2) mode = (64 * j + 853 <= t0) ? 1 : 0;
                    else mode = (j >= qt - 7 && j <= qt - 1) ? 2 : 0;
                    const int slot = j - sb;
                    attn_tile<BR, KEYS>(mode, lds + buf * KSTG + slot * 16384, lds + VB0 + buf * VSTG, 8 * slot, tb, j * 64, t, c.lane, qf, O, m, l, inv_l, selbit, imp_row);
                }
            }
        }
        asm volatile("s_waitcnt vmcnt(0)" ::: "memory");
        __syncthreads();
    }
#undef STG_BLK
}
__device__ __forceinline__ void attn_item(const Args& a, const Ctx& c_, int qt, int g) {
    Ctx c = c_; { int tz = c_.tid; asm volatile("" : "+v"(tz)); c.tid = tz; c.lane = tz & 63; }
    LAS unsigned char* lds = c.lds;
    const int tid = c.tid, wave = c.wave, lane = c.lane, r31 = lane & 31, h = lane >> 5, hl = lane & 3;
    const int t0 = qt * 64, tl = 8 * wave + (r31 >> 2), t = t0 + tl, head = g * 4 + hl;
    const bf16_t* Qb = (const bf16_t*)(a.ws + WS_Q);
    const bf16_t* KROW = (const bf16_t*)(a.ws + WS_KROW);
    const bf16_t* VT = (const bf16_t*)(a.ws + WS_VT);
    const float* GATE = (const float*)(a.ws + WS_GATE);
    { const float* tbg = (const float*)(a.ws + WS_TB) + g * 4 * TBN;
      for (int i = tid; i < 4 * TBN; i += NTHREADS) *(LAS float*)(lds + AT_TB + i * 4) = tbg[i];
      for (int i = tid; i < 64 * 256; i += NTHREADS) *(LAS float*)(lds + AT_IMP + i * 4) = 0.f; }
    bf16x8 qf[8];
#pragma unroll
    for (int ks = 0; ks < 8; ++ks) qf[ks] = *(const bf16x8*)(Qb + (size_t)t * 1024 + head * 128 + 16 * ks + 8 * h);
    LAS const float* tb = (LAS const float*)(lds + AT_TB) + hl * TBN;
    LAS float* imp_row = (LAS float*)(lds + AT_IMP) + tl * 256;
    bf16_t* Y = (bf16_t*)(a.ws + WS_YATT) + (size_t)t * 1024 + head * 128 + 4 * h;
    f32x16 O[4];
#pragma unroll
    for (int dt = 0; dt < 4; ++dt)
#pragma unroll
        for (int r = 0; r < 16; ++r) O[dt][r] = 0.f;
    __syncthreads();
    { const int ntile = (t0 / 16 + 3 + 63) / 64;
      const bf16_t* KC = (const bf16_t*)(a.ws + WS_KC) + (size_t)g * 1024 * 128; const bf16_t* VCT = (const bf16_t*)(a.ws + WS_VCT) + (size_t)g * 128 * 1024;
      float m = -INFINITY, l = 0.f;
#if defined(PROBE_CMP)
      run_branch<0, 64>(c, KC, VCT, 1024, 0, ntile, tb, t, t0, qf, O, m, l, 0.f, tl, imp_row);
      asm volatile("" :: "v"(m), "v"(l));
      m = -INFINITY; l = 0.f;
#endif
      run_branch<0, 64>(c, KC, VCT, 1024, 0, ntile, tb, t, t0, qf, O, m, l, 0.f, tl, imp_row);
      const float lt = xhalf_sum(l), inv = lt > 0.f ? 1.f / lt : 0.f;
      run_branch<1, 64>(c, KC, VCT, 1024, 0, ntile, tb, t, t0, qf, O, m, l, inv, tl, imp_row);
      const float gc = GATE[(size_t)t * 24 + head];
#pragma unroll
      for (int dt = 0; dt < 4; ++dt)
#pragma unroll
          for (int rg = 0; rg < 4; ++rg) {
              u32x2 w; w[0] = cvt_pk_bf16(gc * O[dt][4 * rg], gc * O[dt][4 * rg + 1]); w[1] = cvt_pk_bf16(gc * O[dt][4 * rg + 2], gc * O[dt][4 * rg + 3]);
              *(u32x2*)(Y + 32 * dt + 8 * rg) = w;
#pragma unroll
              for (int e = 0; e < 4; ++e) O[dt][4 * rg + e] = 0.f;
          }
    }
    {
        const int ncand = qt - 2 > 0 ? qt - 2 : 0;
        unsigned v[8][4], selm[8];
#pragma unroll
        for (int i = 0; i < 8; ++i) {
            LAS const float* row = (LAS const float*)(lds + AT_IMP) + (8 * wave + i) * 256;
            selm[i] = 0u;
#pragma unroll
            for (int k = 0; k < 4; ++k) { const int j = lane + 64 * k; const bool cand = (j >= 1 && j <= qt - 2);
                v[i][k] = cand ? ((__float_as_uint(row[j]) & ~0xFFu) | (unsigned)(255 - j)) : 0u; if (ncand <= 13 && cand) selm[i] |= 1u << k; }
        }
        if (ncand > 13) {
            for (int it = 0; it < 13; ++it) {
#pragma unroll
                for (int i = 0; i < 8; ++i) {
                    const unsigned mx = wave_umax_bcast(max(max(v[i][0], v[i][1]), max(v[i][2], v[i][3])));
#pragma unroll
                    for (int k = 0; k < 4; ++k) if (v[i][k] == mx) { v[i][k] = 0u; selm[i] |= 1u << k; }
                }
            }
        }
        unsigned wu[8];
#pragma unroll
        for (int k = 0; k < 8; ++k) wu[k] = 0u;
#pragma unroll
        for (int i = 0; i < 8; ++i)
#pragma unroll
            for (int k = 0; k < 4; ++k) {
                const int j = lane + 64 * k; const bool forced = (j == 0) || (j == qt) || (j == qt - 1);
                const unsigned long long mk = __ballot(((selm[i] >> k) & 1u) || forced);
                const unsigned lo = (unsigned)mk, hi = (unsigned)(mk >> 32);
                if (lane == 0) { *(LAS unsigned*)(lds + AT_BM + ((8 * wave + i) * 8 + 2 * k) * 4) = lo; *(LAS unsigned*)(lds + AT_BM + ((8 * wave + i) * 8 + 2 * k + 1) * 4) = hi; }
                wu[2 * k] |= lo; wu[2 * k + 1] |= hi;
            }
        if (lane == 0) {
#pragma unroll
            for (int k = 0; k < 8; ++k) *(LAS unsigned*)(lds + AT_WU + (wave * 8 + k) * 4) = wu[k];
        }
    }
    __syncthreads();
#if defined(PROBE_SEL)
    { float m = -INFINITY, l = 0.f;
      run_branch<2, 128>(c, KROW + (size_t)(2 + g) * L_ * 128, VT + (size_t)g * 128 * L_, L_, 0, qt + 1, tb, t, t0, qf, O, m, l, 0.f, tl, imp_row);
      asm volatile("" :: "v"(O[0]), "v"(O[1]), "v"(O[2]), "v"(O[3]), "v"(m), "v"(l));
#pragma unroll
      for (int dt = 0; dt < 4; ++dt)
#pragma unroll
          for (int r = 0; r < 16; ++r) O[dt][r] = 0.f; }
#endif
    { float m = -INFINITY, l = 0.f;
      run_branch<2, 128>(c, KROW + (size_t)(2 + g) * L_ * 128, VT + (size_t)g * 128 * L_, L_, 0, qt + 1, tb, t, t0, qf, O, m, l, 0.f, tl, imp_row);
      const float gs = GATE[(size_t)t * 24 + 8 + head];
      const float lt = xhalf_sum(l), sc = gs * (lt > 0.f ? 1.f / lt : 0.f);
#pragma unroll
      for (int dt = 0; dt < 4; ++dt)
#pragma unroll
          for (int rg = 0; rg < 4; ++rg) {
              const u32x2 w0 = *(const u32x2*)(Y + 32 * dt + 8 * rg);
              u32x2 w; w[0] = cvt_pk_bf16(bflo(w0[0]) + sc * O[dt][4 * rg], bfhi(w0[0]) + sc * O[dt][4 * rg + 1]); w[1] = cvt_pk_bf16(bflo(w0[1]) + sc * O[dt][4 * rg + 2], bfhi(w0[1]) + sc * O[dt][4 * rg + 3]);
              *(u32x2*)(Y + 32 * dt + 8 * rg) = w;
#pragma unroll
              for (int e = 0; e < 4; ++e) O[dt][4 * rg + e] = 0.f;
          }
    }
#if defined(PROBE_WIN)
    { float m = -INFINITY, l = 0.f;
      const int lo = qt - 8 > 0 ? qt - 8 : 0;
      run_branch<3, 128>(c, KROW + (size_t)(4 + g) * L_ * 128, VT + (size_t)(2 + g) * 128 * L_, L_, lo, qt + 1, tb, t, t0, qf, O, m, l, 0.f, tl, imp_row);
      asm volatile("" :: "v"(O[0]), "v"(O[1]), "v"(O[2]), "v"(O[3]), "v"(m), "v"(l));
#pragma unroll
      for (int dt = 0; dt < 4; ++dt)
#pragma unroll
          for (int r = 0; r < 16; ++r) O[dt][r] = 0.f; }
#endif
    { float m = -INFINITY, l = 0.f;
      const int lo = qt - 8 > 0 ? qt - 8 : 0;
      run_branch<3, 128>(c, KROW + (size_t)(4 + g) * L_ * 128, VT + (size_t)(2 + g) * 128 * L_, L_, lo, qt + 1, tb, t, t0, qf, O, m, l, 0.f, tl, imp_row);
      const float gw = GATE[(size_t)t * 24 + 16 + head];
      const float lt = xhalf_sum(l), sc = gw * (lt > 0.f ? 1.f / lt : 0.f);
#pragma unroll
      for (int dt = 0; dt < 4; ++dt)
#pragma unroll
          for (int rg = 0; rg < 4; ++rg) {
              const u32x2 w0 = *(const u32x2*)(Y + 32 * dt + 8 * rg);
              u32x2 w; w[0] = cvt_pk_bf16(bflo(w0[0]) + sc * O[dt][4 * rg], bfhi(w0[0]) + sc * O[dt][4 * rg + 1]); w[1] = cvt_pk_bf16(bflo(w0[1]) + sc * O[dt][4 * rg + 2], bfhi(w0[1]) + sc * O[dt][4 * rg + 3]);
              *(u32x2*)(Y + 32 * dt + 8 * rg) = w;
          }
    }
    __syncthreads();
}
#ifndef PEER_ALPHA
#define PEER_ALPHA 1.0f
#endif
constexpr int PE_SC = 0, PE_LV = 66048, PE_LI = 74240, PE_EX = 147456, PE_GT = 151552, PE_SU = 155648, PE_END = 159744;
constexpr int PE_SLOT = 3072, PE_NSLOT = 6, PE_RINGW = PE_SLOT * PE_NSLOT;
static_assert(8 * PE_RINGW <= PE_EX && PE_END <= LDS_BYTES - 16, "PEER LDS map");
__device__ __forceinline__ float wave_sum_bcast(float v) {
    v += dpp_f<0xB1>(v); v += dpp_f<0x4E>(v); v += dpp_f<0x141>(v); v += dpp_f<0x140>(v);
    v += __int_as_float(__builtin_amdgcn_update_dpp(0, __float_as_int(v), 0x142, 0xa, 0xf, false));
    v += __int_as_float(__builtin_amdgcn_update_dpp(0, __float_as_int(v), 0x143, 0xc, 0xf, false));
    return __int_as_float(__builtin_amdgcn_readlane(__float_as_int(v), 63));
}
__device__ __forceinline__ unsigned mono_key(float v) { const unsigned b = __float_as_uint(v); return b ^ ((b >> 31) ? 0xFFFFFFFFu : 0x80000000u); }
template <int CTRL>
__device__ __forceinline__ void quad_merge16(unsigned (&t)[16]) {
    unsigned o[16];
#pragma unroll
    for (int i = 0; i < 16; ++i) o[i] = (unsigned)__builtin_amdgcn_update_dpp(0, (int)t[15 - i], CTRL, 0xf, 0xf, false);
#pragma unroll
    for (int i = 0; i < 16; ++i) t[i] = max(t[i], o[i]);
#pragma unroll
    for (int st = 8; st >= 1; st >>= 1)
#pragma unroll
        for (int i = 0; i < 16; ++i) if ((i & st) == 0) { const unsigned hi = max(t[i], t[i + st]), lo = min(t[i], t[i + st]); t[i] = hi; t[i + st] = lo; }
}
__device__ __forceinline__ int pair_a(int p) { return p < 16 ? 0 : p < 24 ? 1 : p < 29 ? 2 : p < 33 ? 3 : p < 36 ? 4 : p < 38 ? 5 : p < 40 ? 6 : p < 42 ? 7 : p - 34; }
__device__ __forceinline__ int pair_b(int p) { return p < 16 ? p : p < 24 ? p - 16 : p < 29 ? p - 24 : p < 33 ? p - 29 : p < 36 ? p - 33 : p < 38 ? p - 36 : p < 40 ? p - 38 : p < 42 ? p - 40 : 0; }
template <bool DRY>
__device__ __forceinline__ void peer_step(const Args& a, const Ctx& c_, int t0) {
    Ctx c = c_; { int tz = c_.tid; asm volatile("" : "+v"(tz)); c.tid = tz; c.lane = tz & 63; }
    LAS unsigned char* lds = c.lds;
    const int tid = c.tid, wave = c.wave, lane = c.lane, r = lane & 15, q = lane >> 4;
    const bf16_t* QP = (const bf16_t*)(a.ws + WS_QP); const bf16_t* PK = (const bf16_t*)(a.ws + WS_PK);
    const unsigned char* PU = a.ws + WS_PU; const unsigned char* PV = a.ws + WS_PV; const float* psc = (const float*)(a.ws + WS_PSC);
    const bf16_t* HB = (const bf16_t*)(a.ws + WS_H);
    {
        const int hh = wave;
#pragma unroll
        for (int cc = 0; cc < 2; ++cc) {
            bf16x8 aF[4];
#pragma unroll
            for (int ks = 0; ks < 4; ++ks) aF[ks] = *(const bf16x8*)(QP + (size_t)(t0 + (r & 7)) * 2048 + hh * 256 + cc * 128 + 32 * ks + 8 * q);
#pragma unroll 2
            for (int nt = 0; nt < 8; ++nt) {
                f32x4 acc = {0.f, 0.f, 0.f, 0.f};
#pragma unroll
                for (int ks = 0; ks < 4; ++ks) { const bf16x8 B = *(const bf16x8*)(PK + (size_t)(cc * 128 + 16 * nt + r) * 128 + 32 * ks + 8 * q); acc = mfma16(aF[ks], B, acc); }
                if (q < 2) {
#pragma unroll
                    for (int i = 0; i < 4; ++i) { const int tok = 4 * q + i; *(LAS float*)(lds + PE_SC + ((tok * 16 + hh * 2 + cc) * 129 + 16 * nt + r) * 4) = acc[i]; }
                }
            }
        }
    }
    __syncthreads();
    {
        const int task = tid >> 2, part = tid & 3;
        LAS const float* sc = (LAS const float*)(lds + PE_SC) + task * 129;
        float vals[32];
#pragma unroll
        for (int k = 0; k < 32; ++k) vals[k] = sc[32 * part + k];
        unsigned top[16];
#pragma unroll
        for (int e = 0; e < 16; ++e) top[e] = 0u;
#pragma unroll
        for (int k = 0; k < 32; ++k) {
            unsigned key = (mono_key(vals[k]) & ~0x7Fu) | (unsigned)(127 - (32 * part + k));
#pragma unroll
            for (int e = 0; e < 16; ++e) { const unsigned hi = max(top[e], key); key = min(top[e], key); top[e] = hi; }
        }
        quad_merge16<0xB1>(top);
        quad_merge16<0x4E>(top);
        if (part == 0) {
#pragma unroll
            for (int e = 0; e < 16; ++e) { const int idx = 127 - (int)(top[e] & 0x7Fu); *(LAS float*)(lds + PE_LV + (task * 16 + e) * 4) = sc[idx]; *(LAS int*)(lds + PE_LI + (task * 16 + e) * 4) = idx; }
        }
    }
    __syncthreads();
    if (tid < 256) {
        const int task = tid >> 2, part = tid & 3, tok = task >> 3, hh = task & 7, t1 = tok * 16 + hh * 2, t2 = t1 + 1;
        LAS const float* lv1 = (LAS const float*)(lds + PE_LV) + t1 * 16; LAS const float* lv2 = (LAS const float*)(lds + PE_LV) + t2 * 16;
        unsigned top[16];
#pragma unroll
        for (int e = 0; e < 16; ++e) top[e] = 0u;
        for (int p = part; p < 50; p += 4) {
            const int aa = pair_a(p), bb = pair_b(p);
            unsigned key = (mono_key(lv1[aa] + lv2[bb]) & ~0xFFu) | (unsigned)(255 - (aa * 16 + bb));
#pragma unroll
            for (int e = 0; e < 16; ++e) { const unsigned hi = max(top[e], key); key = min(top[e], key); top[e] = hi; }
        }
        quad_merge16<0xB1>(top);
        quad_merge16<0x4E>(top);
        if (part == 0) {
            LAS const int* li1 = (LAS const int*)(lds + PE_LI) + t1 * 16; LAS const int* li2 = (LAS const int*)(lds + PE_LI) + t2 * 16;
            float sv[16]; int ex[16]; float mx = -INFINITY;
#pragma unroll
            for (int e = 0; e < 16; ++e) {
                const int id = 255 - (int)(top[e] & 0xFFu), aa = id >> 4, bb = id & 15;
                sv[e] = lv1[aa] + lv2[bb]; ex[e] = li1[aa] * 128 + li2[bb]; mx = fmaxf(mx, sv[e]);
            }
            float sum = 0.f;
#pragma unroll
            for (int e = 0; e < 16; ++e) { sv[e] = fexp2((sv[e] - mx) * LOG2E); sum += sv[e]; }
            const float inv = 1.f / sum;
#pragma unroll
            for (int e = 0; e < 16; ++e) { *(LAS int*)(lds + PE_EX + (tok * 128 + hh * 16 + e) * 4) = ex[e];
                *(LAS float*)(lds + PE_GT + (tok * 128 + hh * 16 + e) * 4) = sv[e] * inv * psc[16384 + ex[e]];
                *(LAS float*)(lds + PE_SU + (tok * 128 + hh * 16 + e) * 4) = psc[ex[e]]; }
        }
    }
    __syncthreads();
    const int t = t0 + wave;
    float hp[32];
#pragma unroll
    for (int k = 0; k < 4; ++k) { const u32x4 w = *(const u32x4*)(HB + (size_t)t * 2048 + lane * 32 + k * 8);
#pragma unroll
        for (int e = 0; e < 4; ++e) { hp[k * 8 + 2 * e] = bflo(w[e]); hp[k * 8 + 2 * e + 1] = bfhi(w[e]); } }
    float acc[32];
#pragma unroll
    for (int e = 0; e < 32; ++e) acc[e] = 0.f;
    asm volatile("s_waitcnt vmcnt(0)" ::: "memory");
    {
        LAS const int* exl = (LAS const int*)(lds + PE_EX) + wave * 128; LAS const float* gtl = (LAS const float*)(lds + PE_GT) + wave * 128;
        LAS unsigned char* ring = lds + wave * PE_RINGW;
        LAS const float* sul = (LAS const float*)(lds + PE_SU) + wave * 128;
#define ROW_ISSUE(SL, IDX) do { const int ex_ = __builtin_amdgcn_readfirstlane(exl[IDX]); \
            const unsigned char* gu_ = PU + (size_t)ex_ * 1536; const unsigned char* gv_ = PV + (size_t)ex_ * 1536; \
            LAS unsigned char* sl_ = ring + (SL) * PE_SLOT;                   \
            __builtin_amdgcn_global_load_lds((const unsigned*)(gu_ + lane * 16), (LAS unsigned*)sl_, 16, 0, 0); \
            __builtin_amdgcn_global_load_lds((const unsigned*)((lane < 32 ? gu_ + 1024 : gv_ - 512) + lane * 16), (LAS unsigned*)(sl_ + 1024), 16, 0, 0); \
            __builtin_amdgcn_global_load_lds((const unsigned*)(gv_ + 512 + lane * 16), (LAS unsigned*)(sl_ + 2048), 16, 0, 0); \
            } while (0)
#define ROW_APPLY(SL, IDX) do { LAS const unsigned char* sl_ = ring + (SL) * PE_SLOT + lane * 24; \
            const u32x2 a0_ = *(const LAS u32x2*)sl_, a1_ = *(const LAS u32x2*)(sl_ + 8), a2_ = *(const LAS u32x2*)(sl_ + 16); \
            const f32x32 uf_ = __builtin_amdgcn_cvt_scalef32_pk32_f32_fp6((u32x6){a0_[0], a0_[1], a1_[0], a1_[1], a2_[0], a2_[1]}, 1.0f); \
            float d0_ = 0.f, d1_ = 0.f; \
            _Pragma("unroll") for (int i = 0; i < 32; i += 2) { d0_ += uf_[i] * hp[i]; d1_ += uf_[i + 1] * hp[i + 1]; } \
            const float d_ = wave_sum_bcast(d0_ + d1_) * sul[IDX]; \
            const float wgt_ = gtl[IDX] * gelu_tanh(d_); \
            const u32x2 b0_ = *(const LAS u32x2*)(sl_ + 1536), b1_ = *(const LAS u32x2*)(sl_ + 1544), b2_ = *(const LAS u32x2*)(sl_ + 1552); \
            const f32x32 vf_ = __builtin_amdgcn_cvt_scalef32_pk32_f32_fp6((u32x6){b0_[0], b0_[1], b1_[0], b1_[1], b2_[0], b2_[1]}, 1.0f); \
            _Pragma("unroll") for (int i = 0; i < 32; ++i) acc[i] += wgt_ * vf_[i]; \
            asm volatile("s_waitcnt lgkmcnt(0)" ::: "memory"); } while (0)
#define DMA_WAIT(N) asm volatile("s_waitcnt vmcnt(" #N ")" ::: "memory")
        ROW_ISSUE(0, 0); ROW_ISSUE(1, 1); ROW_ISSUE(2, 2); ROW_ISSUE(3, 3); ROW_ISSUE(4, 4); ROW_ISSUE(5, 5);
#pragma unroll 1
        for (int e = 0; e < 126; e += 6) {
            const bool last = (e == 120);
            DMA_WAIT(15); ROW_APPLY(0, e);     ROW_ISSUE(0, e + 6);
            DMA_WAIT(15); ROW_APPLY(1, e + 1); ROW_ISSUE(1, e + 7);
            DMA_WAIT(15); ROW_APPLY(2, e + 2); if (!last) ROW_ISSUE(2, e + 8);
            if (last) DMA_WAIT(0); else DMA_WAIT(15);
            ROW_APPLY(3, e + 3); if (!last) ROW_ISSUE(3, e + 9);
            if (!last) DMA_WAIT(15);
            ROW_APPLY(4, e + 4); if (!last) ROW_ISSUE(4, e + 10);
            if (!last) DMA_WAIT(15);
            ROW_APPLY(5, e + 5); if (!last) ROW_ISSUE(5, e + 11);
        }
        ROW_APPLY(0, 126);
        ROW_APPLY(1, 127);
#undef ROW_ISSUE
#undef ROW_APPLY
#undef DMA_WAIT
    }
    {
        float* xo = a.out + (size_t)t * 2048; const float* g2 = (const float*)(a.ws + WS_COND) + 5 * 2048; const float* fg = a.in[32];
        float ss = 0.f;
#pragma unroll
        for (int k = 0; k < 8; ++k) {
            const int col = lane * 32 + k * 4;
            const f32x4 x1 = *(const f32x4*)(xo + col), gv = *(const f32x4*)(g2 + col);
#pragma unroll
            for (int e = 0; e < 4; ++e) { const float x2 = x1[e] + PEER_ALPHA * gv[e] * acc[k * 4 + e]; acc[k * 4 + e] = x2; ss += x2 * x2; }
        }
        ss = wave_sum_bcast(ss);
        const float rstd = rsqrtf(ss * (1.f / 2048.f) + 1e-6f);
#pragma unroll
        for (int k = 0; k < 8; ++k) {
            const int col = lane * 32 + k * 4;
            const f32x4 fv = *(const f32x4*)(fg + col);
            f32x4 o;
#pragma unroll
            for (int e = 0; e < 4; ++e) o[e] = acc[k * 4 + e] * rstd * fv[e];
            if (!DRY || rstd == 123.456f) *(f32x4*)(xo + col) = o;
        }
    }
    __syncthreads();
}
constexpr int NPHASE = 14;
#ifndef DBG
#define DBG 0
#endif
__device__ __forceinline__ void dbg_final_norm(const Args& a, const Ctx& c, const float* src) {
    for (int t = c.bid * 8 + c.wave; t < L_; t += c.nb * 8) {
        const float* xr = src + (size_t)t * 2048 + c.lane * 4; float* o = a.out + (size_t)t * 2048 + c.lane * 4;
        f32x4 v[8]; float ss = 0.f;
#pragma unroll
        for (int j = 0; j < 8; ++j) { v[j] = *(const f32x4*)(xr + j * 256); ss += v[j][0] * v[j][0] + v[j][1] * v[j][1] + v[j][2] * v[j][2] + v[j][3] * v[j][3]; }
        ss = wave_sum(ss);
        const float rstd = rsqrtf(ss * (1.f / 2048.f) + 1e-6f);
#pragma unroll
        for (int j = 0; j < 8; ++j) { const f32x4 g = *(const f32x4*)(a.in[32] + j * 256 + c.lane * 4); *(f32x4*)(o + j * 256) = v[j] * rstd * g; }
    }
}

extern __shared__ __attribute__((aligned(16))) unsigned char smem[];

__global__ void __launch_bounds__(512, 2) fwd(Args a) {
    LAS unsigned char* lds = (LAS unsigned char*)smem;
    Ctx c; c.bid = blockIdx.x; c.nb = gridDim.x; c.tid = threadIdx.x; c.wave = __builtin_amdgcn_readfirstlane(threadIdx.x >> 6); c.lane = threadIdx.x & 63; c.lds = lds;
    volatile LAS unsigned* xbw = (volatile LAS unsigned*)(lds + LDS_BYTES - 16);
    if (c.tid < 4) xbw[c.tid] = 0u;
    __syncthreads();
    const int lo = a.ph_lo, hi = a.ph_hi;
    const bool multi = (hi - lo) > 1;
    XcdBarrier bar; bar.bar = (unsigned*)(a.ws + WS_CTL); bar.x = 0; bar.st = xbw;
    if (multi) bar = xcd_barrier_post((unsigned*)(a.ws + WS_CTL), xbw);
#ifndef PHASE_MASK
#define PHASE_MASK 0xFFFF
#endif
#if DBG == 1
#undef PHASE_MASK
#define PHASE_MASK 0x403
#elif DBG == 2 || DBG == 4 || DBG == 5
#undef PHASE_MASK
#define PHASE_MASK 0x4FF
#endif
#define IN(k) (((PHASE_MASK >> (k)) & 1) && lo <= (k) && (k) < hi)
#define REFRESH() do { int tz_ = threadIdx.x; asm volatile("" : "+v"(tz_)); c.tid = tz_; c.lane = tz_ & 63; c.wave = __builtin_amdgcn_readfirstlane(tz_ >> 6); } while (0)
#define SEAM(k) do { if (IN(k) && IN((k) + 1)) xcd_barrier(bar); } while (0)
#ifndef DUP
#define DUP -1
#endif
#define REP(k) for (int rep_ = 0; rep_ < ((DUP == (k)) ? 2 : 1); ++rep_)
#define DUP2(k, ...) do { __VA_ARGS__; if (DUP == (k)) { __syncthreads(); __VA_ARGS__; } } while (0)

    if (IN(0)) REP(0) { REFRESH(); p0_prologue(a, c); }
    SEAM(0);
    if (IN(1)) { REFRESH(); DUP2(1, p1_hnorm(a, c)); }
    SEAM(1);
    if (IN(2)) { REFRESH();
        pg8::StaticOrder S; S.init((const bf16_t*)(a.ws + WS_H), (const bf16_t*)(a.ws + WS_WIN), 2048, 2048, 2048, L_, DIN_PAD, c.nb, c.bid);
        EpiWin E{(bf16_t*)(a.ws + WS_US), (bf16_t*)(a.ws + WS_Q), (bf16_t*)(a.ws + WS_KROW), (bf16_t*)(a.ws + WS_VROW), (bf16_t*)(a.ws + WS_VT), (float*)(a.ws + WS_GATE)};
        DUP2(2, pg8::gemm_phase<EpiWin, pg8::StaticOrder>(lds, S, E));
    }
    SEAM(2);
    if (IN(3)) { REFRESH();
        DUP2(31, for (int it = c.bid; it < 256; it += c.nb) s5_item<0>(a, c, it >> 2, it & 3));
        __syncthreads();
        CmpOrder S{(const bf16_t*)(a.ws + WS_KROW), (const bf16_t*)(a.ws + WS_VROW), (const bf16_t*)(a.ws + WS_W1), 2048, 4096, 1024, c.nb, c.bid};
        EpiSlab E{(float*)(a.ws + WS_SLAB)};
        DUP2(32, pg8::gemm_phase<EpiSlab, CmpOrder>(lds, S, E));
    }
    SEAM(3);
    if (IN(4)) { REFRESH();
        DUP2(41, for (int it = c.bid; it < 64; it += c.nb) cmp_finish_item(a, c, it >> 5, it & 31));
        DUP2(42, for (int it = c.bid; it < 256; it += c.nb) s5_item<1>(a, c, it >> 2, it & 3));
    }
    SEAM(4);
    if (IN(5)) { REFRESH();
#if DBG == 5
        for (size_t i = (size_t)c.bid * NTHREADS + c.tid; i < (size_t)L_ * 1024 / 8; i += (size_t)c.nb * NTHREADS) *(u32x4*)((bf16_t*)(a.ws + WS_YSSM) + i * 8) = (u32x4){0u, 0u, 0u, 0u};
#else
        {
            pg8::StaticOrder S; S.init((const bf16_t*)(a.ws + WS_Z), (const bf16_t*)(a.ws + WS_WGLU), 1024, 1024, 1024, L_, 1024, c.nb, c.bid);
            EpiGlu E{(const bf16_t*)(a.ws + WS_Z), a.in[19], (bf16_t*)(a.ws + WS_YSSM)};
            DUP2(55, pg8::gemm_phase<EpiGlu, pg8::StaticOrder>(lds, S, E));
        }
#endif
        __syncthreads();
        REP(5)
#if DBG == 4
        for (size_t i = (size_t)c.bid * NTHREADS + c.tid; i < (size_t)L_ * 1024 / 8; i += (size_t)c.nb * NTHREADS) *(u32x4*)((bf16_t*)(a.ws + WS_YATT) + i * 8) = (u32x4){0u, 0u, 0u, 0u};
#else
        for (int it = c.bid; it < 512; it += c.nb) {
            const int rnd = it / c.nb;
            const int qt = (rnd & 1) ? 255 - (it % 256) : (it % 256), g = (it >> 8) & 1;
            attn_item(a, c, qt, g);
        }
#endif
    }
    SEAM(5);
    if (IN(6)) { REFRESH(); DUP2(6, p6_mixnorm(a, c)); }
    SEAM(6);
#define WOUT_GEMM(PM0) do { pg8::StaticOrder S; S.init((const bf16_t*)(a.ws + WS_H), (const bf16_t*)(a.ws + WS_WOUT), 2048, 2048, 2048, L_ / 2, 2048, c.nb, c.bid, PM0); \
        EpiWout E{a.in[0], (const float*)(a.ws + WS_COND) + 2 * 2048, a.out}; pg8::gemm_phase<EpiWout, pg8::StaticOrder>(lds, S, E); __syncthreads(); } while (0)
#define WQ_GEMM(PM0) do { pg8::StaticOrder S; S.init((const bf16_t*)(a.ws + WS_H), (const bf16_t*)(a.ws + WS_WQ), 2048, 2048, 2048, L_ / 2, 2048, c.nb, c.bid, PM0); \
        EpiBf16 E{(bf16_t*)(a.ws + WS_QP), 2048}; pg8::gemm_phase<EpiBf16, pg8::StaticOrder>(lds, S, E); __syncthreads(); } while (0)
#define PEER_STEPS(FIRST, COUNT) do { for (int s_ = (FIRST) + c.bid; s_ < (FIRST) + (COUNT); s_ += c.nb) peer_step<false>(a, c, s_ * 8); } while (0)
    if (IN(7)) { REFRESH(); WOUT_GEMM(0); }
    SEAM(7);
    if (IN(8)) { REFRESH(); p8_h2norm(a, c, 0, L_ / 2); }
    SEAM(8);
    if (IN(9)) { REFRESH(); WQ_GEMM(0); }
    SEAM(9);
    if (IN(10)) { REFRESH();
        if ((c.bid >> 3) & 1) PEER_STEPS(0, 512);
        WOUT_GEMM(32);
        if (!((c.bid >> 3) & 1)) PEER_STEPS(0, 512); }
    SEAM(10);
    if (IN(11)) { REFRESH(); p8_h2norm(a, c, L_ / 2, L_ / 2); }
    SEAM(11);
    if (IN(12)) { REFRESH();
        if ((c.bid >> 3) & 1) PEER_STEPS(512, 512);
        WQ_GEMM(32);
        if (!((c.bid >> 3) & 1)) PEER_STEPS(512, 512); }
    SEAM(12);
    if (IN(13)) { REFRESH(); PEER_STEPS(1024, 1024); }
#undef WOUT_GEMM
#undef WQ_GEMM
#undef PEER_STEPS
#undef IN
#undef SEAM
}

#ifndef N_LAUNCHES
#define N_LAUNCHES 1
#endif
extern "C" void kernel_launch(void* const* d_in, const int* in_sizes, int n_in, void* d_out, int out_size, void* d_ws, size_t ws_size, hipStream_t stream) {
    static int grid = 0;
    if (grid == 0) {
        if (n_in != 33 || out_size != L_ * D_ || ws_size < WS_END) { fprintf(stderr, "kernel_launch: unexpected shapes (n_in %d, out %d, ws %zu < %zu); nothing launched\n", n_in, out_size, ws_size, (size_t)WS_END); grid = -1; return; }
        int dev = 0, cus = 0, per_cu = 0;
        if (hipGetDevice(&dev) != hipSuccess || hipDeviceGetAttribute(&cus, hipDeviceAttributeMultiprocessorCount, dev) != hipSuccess) { grid = -1; return; }
        if (hipFuncSetAttribute((const void*)fwd, hipFuncAttributeMaxDynamicSharedMemorySize, LDS_BYTES) != hipSuccess) { fprintf(stderr, "kernel_launch: hipFuncSetAttribute failed\n"); grid = -1; return; }
        if (hipOccupancyMaxActiveBlocksPerMultiprocessor(&per_cu, (const void*)fwd, NTHREADS, LDS_BYTES) != hipSuccess || per_cu < 1) { fprintf(stderr, "kernel_launch: occupancy query says %d\n", per_cu); (void)hipGetLastError(); grid = -1; return; }
        grid = cus;
    }
    if (grid < 0) return;
    (void)hipMemsetAsync((char*)d_ws + WS_CTL, 0, CTL_BYTES, stream);
    Args a{};
    for (int i = 0; i < 33; ++i) a.in[i] = (const float*)d_in[i];
    a.out = (float*)d_out; a.ws = (unsigned char*)d_ws;
    if (N_LAUNCHES == 1) { a.ph_lo = 0; a.ph_hi = NPHASE; hipLaunchKernelGGL(fwd, dim3(grid), dim3(NTHREADS), LDS_BYTES, stream, a); }
    else for (int p = 0; p < NPHASE; ++p) { a.ph_lo = p; a.ph_hi = p + 1; hipLaunchKernelGGL(fwd, dim3(grid), dim3(NTHREADS), LDS_BYTES, stream, a); }
}
```

```cpp
#include <hip/hip_runtime.h>
#include <stdint.h>
#include <stdio.h>

#define LAS __attribute__((address_space(3)))
typedef unsigned short bf16_t;
typedef short bf16x8 __attribute__((ext_vector_type(8)));
typedef float f32x2 __attribute__((ext_vector_type(2)));
typedef float f32x4 __attribute__((ext_vector_type(4)));
typedef float f32x16 __attribute__((ext_vector_type(16)));
typedef unsigned u32x2 __attribute__((ext_vector_type(2)));
typedef unsigned u32x4 __attribute__((ext_vector_type(4)));
typedef __bf16 bfv2 __attribute__((ext_vector_type(2)));
typedef unsigned u32x6 __attribute__((ext_vector_type(6)));
typedef float f32x32 __attribute__((ext_vector_type(32)));

constexpr int L_ = 16384, D_ = 2048, DSSM = 1024, DATT = 1024, DIN = 3608, DIN_PAD = 3840;
constexpr int NADA = 12288;
constexpr float LOG2E = 1.4426950408889634f;
constexpr float QSCALE = 0.08838834764831845f * 1.4426950408889634f;
constexpr int TBN = 800;
constexpr int NTHREADS = 512;
constexpr int LDS_BYTES = 163840;

constexpr size_t al256(size_t x) { return (x + 255) & ~(size_t)255; }
constexpr size_t WS_CTL   = 0;                                  constexpr size_t CTL_BYTES = 65536;
constexpr size_t WS_CONDP = WS_CTL + CTL_BYTES;
constexpr size_t WS_COND  = WS_CONDP + 32 * 12288 * 4;
constexpr size_t WS_TB    = WS_COND + 12288 * 4;
constexpr size_t WS_BPE   = al256(WS_TB + 8 * TBN * 4);
constexpr size_t WS_S5P   = al256(WS_BPE + 2 * 256 * 4);
constexpr size_t WS_S5F   = WS_S5P + 2 * 64 * 64 * 2 * 4;
constexpr size_t WS_S5MT  = WS_S5F + 64 * 4 * 128 * 4;
constexpr size_t WS_S5WE  = WS_S5MT + (size_t)64 * 256 * 256 * 2;
constexpr size_t WS_S5WC  = WS_S5WE + (size_t)64 * 128 * 256 * 2;
constexpr size_t WS_WIN   = WS_S5WC + (size_t)64 * 256 * 128 * 2;
constexpr size_t WS_WGLU  = WS_WIN + (size_t)DIN_PAD * 2048 * 2;
constexpr size_t WS_WOUT  = WS_WGLU + (size_t)1024 * 1024 * 2;
constexpr size_t WS_WQ    = WS_WOUT + (size_t)2048 * 2048 * 2;
constexpr size_t WS_W1    = WS_WQ + (size_t)2048 * 2048 * 2;
constexpr size_t WS_W2    = WS_W1 + (size_t)2 * 256 * 4096 * 2;
constexpr size_t WS_PK    = WS_W2 + (size_t)2 * 128 * 256 * 2;
constexpr size_t WS_PU    = WS_PK + (size_t)2 * 128 * 128 * 2;
constexpr size_t WS_PV    = WS_PU + (size_t)16384 * 1536;
constexpr size_t WS_PSC   = WS_PV + (size_t)16384 * 1536;
constexpr size_t WS_BPEP  = WS_PSC + (size_t)2 * 16384 * 4;
constexpr size_t WS_H     = WS_BPEP + (size_t)32 * 2 * 256 * 4;
constexpr size_t WS_US    = WS_H + (size_t)16384 * 2048 * 2;
constexpr size_t WS_Q     = WS_US + (size_t)16384 * 1024 * 2;
constexpr size_t WS_QP    = WS_US;
constexpr size_t WS_KROW  = WS_Q + (size_t)16384 * 1024 * 2;
constexpr size_t WS_VROW  = WS_KROW + (size_t)6 * 16384 * 128 * 2;
constexpr size_t WS_VT    = WS_VROW + (size_t)2 * 16384 * 128 * 2 + 8192;
constexpr size_t WS_GATE  = WS_VT + (size_t)4 * 128 * 16384 * 2;
constexpr size_t WS_SLAB  = WS_GATE + (size_t)16384 * 24 * 4;
constexpr size_t WS_KC    = WS_SLAB + (size_t)2 * 4 * 2048 * 256 * 4;
constexpr size_t WS_VCT   = WS_KC + (size_t)2 * 1024 * 128 * 2;
constexpr size_t WS_Z     = WS_VCT + (size_t)2 * 128 * 1024 * 2;
constexpr size_t WS_YSSM  = WS_Z + (size_t)16384 * 1024 * 2;
constexpr size_t WS_YATT  = WS_YSSM + (size_t)16384 * 1024 * 2;
constexpr size_t WS_X1    = WS_Z;
constexpr size_t WS_END   = WS_YATT + (size_t)16384 * 1024 * 2;
static_assert(WS_END < (size_t)530 * 1024 * 1024, "workspace map too large");

struct Args { const float* in[33]; float* out; unsigned char* ws; int ph_lo, ph_hi; };

__device__ __forceinline__ unsigned cvt_pk_bf16(float lo, float hi) { bfv2 v; v[0] = (__bf16)lo; v[1] = (__bf16)hi; return __builtin_bit_cast(unsigned, v); }
__device__ __forceinline__ bf16_t f2bf(float f) { return (bf16_t)(cvt_pk_bf16(f, 0.f) & 0xffffu); }
__device__ __forceinline__ float bf2f(unsigned b) { return __uint_as_float(b << 16); }
__device__ __forceinline__ float bflo(unsigned w) { return __uint_as_float(w << 16); }
__device__ __forceinline__ float bfhi(unsigned w) { return __uint_as_float(w & 0xffff0000u); }
__device__ __forceinline__ float fexp2(float x) { return __builtin_amdgcn_exp2f(x); }
__device__ __forceinline__ float frcp(float x) { return __builtin_amdgcn_rcpf(x); }
__device__ __forceinline__ float sigmoidf_(float x) { return frcp(1.f + fexp2(-LOG2E * x)); }
__device__ __forceinline__ float gelu_tanh(float x) {
    const float u = x * (1.f + 0.044715f * x * x);
    return x * frcp(1.f + fexp2(-2.f * 0.7978845608028654f * LOG2E * u));
}
__device__ __forceinline__ float shfl_xor_f(float v, int m) { return __shfl_xor(v, m, 64); }
__device__ __forceinline__ float wave_sum(float v) {
#pragma unroll
    for (int m = 32; m >= 1; m >>= 1) v += __shfl_xor(v, m, 64);
    return v;
}
__device__ __forceinline__ float wave_max(float v) {
#pragma unroll
    for (int m = 32; m >= 1; m >>= 1) v = fmaxf(v, __shfl_xor(v, m, 64));
    return v;
}
template <int CTRL> __device__ __forceinline__ float dpp_f(float x) { return __int_as_float(__builtin_amdgcn_update_dpp(0, __float_as_int(x), CTRL, 0xf, 0xf, false)); }
__device__ __forceinline__ float wave_max_bcast(float v) {
    v = fmaxf(v, dpp_f<0xB1>(v)); v = fmaxf(v, dpp_f<0x4E>(v)); v = fmaxf(v, dpp_f<0x141>(v)); v = fmaxf(v, dpp_f<0x140>(v));
    v = fmaxf(v, __int_as_float(__builtin_amdgcn_update_dpp(__float_as_int(v), __float_as_int(v), 0x142, 0xa, 0xf, false)));
    v = fmaxf(v, __int_as_float(__builtin_amdgcn_update_dpp(__float_as_int(v), __float_as_int(v), 0x143, 0xc, 0xf, false)));
    return __int_as_float(__builtin_amdgcn_readlane(__float_as_int(v), 63));
}
__device__ __forceinline__ unsigned wave_umax_bcast(unsigned v) {
#define UDPP_(x, ctrl, rm) (unsigned)__builtin_amdgcn_update_dpp((int)(x), (int)(x), ctrl, rm, 0xf, false)
    v = max(v, UDPP_(v, 0xB1, 0xf)); v = max(v, UDPP_(v, 0x4E, 0xf)); v = max(v, UDPP_(v, 0x141, 0xf)); v = max(v, UDPP_(v, 0x140, 0xf));
    v = max(v, UDPP_(v, 0x142, 0xa)); v = max(v, UDPP_(v, 0x143, 0xc));
#undef UDPP_
    return (unsigned)__builtin_amdgcn_readlane((int)v, 63);
}
__device__ __forceinline__ float quad_sum(float x) { x += dpp_f<0xB1>(x); x += dpp_f<0x4E>(x); return x; }
__device__ __forceinline__ f32x4 mfma16(bf16x8 a, bf16x8 b, f32x4 c) { return __builtin_amdgcn_mfma_f32_16x16x32_bf16(a, b, c, 0, 0, 0); }
__device__ __forceinline__ f32x16 mfma32(bf16x8 a, bf16x8 b, f32x16 c) { return __builtin_amdgcn_mfma_f32_32x32x16_bf16(a, b, c, 0, 0, 0); }
#define XB_TMO      128
#define XB_XCNT(j)  (256  + 64 * (j))
#define XB_XSUB(j)  (1280 + 64 * (j))
#define XB_XGEN(j)  (2304 + 64 * (j))
#define XB_TOP      3328
#define XB_TOPGEN   3392
#define XCD_BAR_WORDS 3456
#define XB_SPIN_CAP (1u << 18)

__device__ __forceinline__ unsigned xb_ld(unsigned* p)              { return __hip_atomic_load(p, __ATOMIC_RELAXED, __HIP_MEMORY_SCOPE_AGENT); }
__device__ __forceinline__ unsigned xb_add(unsigned* p, unsigned v) { return __hip_atomic_fetch_add(p, v, __ATOMIC_RELAXED, __HIP_MEMORY_SCOPE_AGENT); }
__device__ __forceinline__ unsigned xb_xcc_id() { return (unsigned)__builtin_amdgcn_s_getreg((3 << 11) | 20) & 0xFu; }
#define XB_SPIN(cond, bar) do { unsigned _sp = 0; while (cond) { __builtin_amdgcn_s_sleep(1); \
    if ((++_sp & 255u) == 0u) { if (xb_ld(&(bar)[XB_TMO])) break; if (_sp > XB_SPIN_CAP) { atomicAdd(&(bar)[XB_TMO], 1u); break; } } } } while (0)

struct XcdBarrier {
    unsigned* bar; unsigned x;
    volatile LAS unsigned* st;
};
__device__ __forceinline__ XcdBarrier xcd_barrier_post(unsigned* bar, volatile LAS unsigned* st) {
    XcdBarrier b; b.bar = bar; b.x = xb_xcc_id(); b.st = st;
    if (threadIdx.x == 0) (void)xb_add(&bar[XB_XCNT(b.x)], 1u);
    return b;
}
__device__ __forceinline__ void xcd_barrier_complete(unsigned* bar, unsigned x, unsigned& nloc, unsigned& nx) {
    const unsigned G = gridDim.x * gridDim.y * gridDim.z;
    unsigned sum, cnt, mine, sp = 0u;
    for (;;) {
        sum = 0u; cnt = 0u; mine = 0u;
#pragma unroll
        for (unsigned j = 0; j < 16; ++j) { const unsigned c = xb_ld(&bar[XB_XCNT(j)]); sum += c; cnt += (c > 0u) ? 1u : 0u; mine = (j == x) ? c : mine; }
        if (sum == G) break;
        __builtin_amdgcn_s_sleep(1);
        if ((++sp & 255u) == 0u) { if (xb_ld(&bar[XB_TMO])) break; if (sp > XB_SPIN_CAP) { atomicAdd(&bar[XB_TMO], 1u); break; } }
    }
    nloc = mine > 0u ? mine : 1u; nx = cnt > 0u ? cnt : 1u;
}
__device__ __forceinline__ void xcd_barrier(const XcdBarrier& b) {
    asm volatile("s_waitcnt vmcnt(0)" ::: "memory");
    __syncthreads();
    if (threadIdx.x == 0) {
        unsigned* bar = b.bar;
        __builtin_amdgcn_s_waitcnt(0);
        unsigned nloc = b.st[0], nx = b.st[1];
        if (nloc == 0u) { xcd_barrier_complete(bar, b.x, nloc, nx); b.st[0] = nloc; b.st[1] = nx; }
        const unsigned old = xb_add(&bar[XB_XSUB(b.x)], 1u);
        const unsigned gen = old / nloc;
        if (old + 1u == (gen + 1u) * nloc) {
            __builtin_amdgcn_fence(__ATOMIC_RELEASE, "agent");
            asm volatile("s_waitcnt vmcnt(0)" ::: "memory");
            const unsigned og = xb_add(&bar[XB_TOP], 1u);
            const unsigned tg = og / nx;
            if (og + 1u == (tg + 1u) * nx) xb_add(&bar[XB_TOPGEN], 1u);
            else XB_SPIN(xb_ld(&bar[XB_TOPGEN]) == tg, bar);
            __builtin_amdgcn_fence(__ATOMIC_ACQUIRE, "agent");
            xb_add(&bar[XB_XGEN(b.x)], 1u);
            asm volatile("s_waitcnt vmcnt(0)" ::: "memory");
        } else {
            XB_SPIN(xb_ld(&bar[XB_XGEN(b.x)]) == gen, bar);
            __builtin_amdgcn_fence(__ATOMIC_ACQUIRE, "agent");
            asm volatile("s_waitcnt vmcnt(0)" ::: "memory");
        }
    }
    __syncthreads();
}

namespace pg8 {
constexpr int BM = 256, BK = 64, HALF = 128, HTB = HALF * BK * 2, STAGE_BYTES = 8 * HTB, NXCD = 8, WGM = 8;
__host__ __device__ __forceinline__ int lds_byte(int r, int c) { const int st = (r >> 4) * 2 + (c >> 5), rr = r & 15, cc = c & 31, ob = rr * 64 + cc * 2; return st * 1024 + (ob ^ (((ob >> 9) & 1) << 5)); }
__host__ __device__ __forceinline__ void stage_rc(int b, int& R, int& C) { const int st = b / 1024, sb = b % 1024, swz = sb ^ (((sb >> 9) & 1) << 5); R = (st >> 1) * 16 + swz / 64; C = (st & 1) * 32 + (swz % 64) / 2; }
__host__ __device__ __forceinline__ int perm32(int rho) { const int n = rho >> 4, i = rho & 15; return 8 * (i >> 2) + 4 * n + (i & 3); }

struct Unit { int pm, pn, z; };
struct StaticOrder {
    const bf16_t* A; const bf16_t* Bt; int lda, ldb, K;
    int nM, nN, nwg, G, c, pm0;
    __device__ void init(const bf16_t* A_, const bf16_t* Bt_, int lda_, int ldb_, int K_, int M, int N, int G_, int c_, int pm0_ = 0) { A = A_; Bt = Bt_; lda = lda_; ldb = ldb_; K = K_; nM = M / BM; nN = N / BM; nwg = nM * nN; G = G_; c = c_; pm0 = pm0_; }
    __device__ bool next(int i, Unit& u) const {
        const long Lx = (long)i * G + c; if (Lx >= nwg) return false;
        int wgid = (int)Lx; { const int q = nwg / NXCD, r = nwg % NXCD, xcd = wgid % NXCD, off = wgid / NXCD; wgid = (xcd < r ? xcd * (q + 1) : r * (q + 1) + (xcd - r) * q) + off; }
        const int nig = WGM * nN, gid = wgid / nig, fm = gid * WGM, gsz = (nM - fm) < WGM ? (nM - fm) : WGM;
        u.pm = pm0 + fm + ((wgid % nig) % gsz); u.pn = (wgid % nig) / gsz; u.z = 0; return true;
    }
    __device__ __forceinline__ const char* a_base(const Unit& u) const { return (const char*)(A + (size_t)u.pm * BM * lda); }
    __device__ __forceinline__ const char* b_base(const Unit& u) const { return (const char*)(Bt + (size_t)u.pn * BM * ldb); }
};

template <class Epi, class Sched>
__device__ __forceinline__ void gemm_phase(LAS unsigned char* lds, const Sched& S, const Epi& E) {
    const int tid = threadIdx.x, wid = __builtin_amdgcn_readfirstlane(tid >> 6), lane = tid & 63, wr = wid >> 2, wc = wid & 3, fr = lane & 15, fq = lane >> 4;
    const int K = S.K, nt = K / BK, lda = S.lda, ldb = S.ldb;
    unsigned voffA[2], voffB[2];
#pragma unroll
    for (int i = 0; i < 2; ++i) { int R, C; stage_rc(tid * 16 + i * 8192, R, C); const int Rb = Epi::PERM ? ((R & ~31) + perm32(R & 31)) : R;
        voffA[i] = (unsigned)(R * lda + C) * 2u; voffB[i] = (unsigned)(Rb * ldb + C) * 2u; }
    const size_t kstep = (size_t)(BK * 2);
    const size_t hstepA = (size_t)HALF * lda * 2, hstepB = (size_t)HALF * ldb * 2;
    const unsigned ldsw = (unsigned)wid * 1024u;
    const int aoff = lds_byte(wr * 64 + fr, fq * 8), boff = lds_byte(wc * 32 + fr, fq * 8);
#define PG8_SA(b, h) (((b) * 2 + (h)) * HTB)
#define PG8_SB(b, h) ((4 + (b) * 2 + (h)) * HTB)
#define PG8_STAGE(bufoff, gbase, voff) do { _Pragma("unroll") for (int _i = 0; _i < 2; ++_i) \
        __builtin_amdgcn_global_load_lds((const unsigned*)((const char*)(gbase) + (voff)[_i]), (LAS unsigned*)(lds + (bufoff) + ldsw + _i * 8192), 16, 0, 0); } while (0)
#define PG8_LDA(dst, b, h) do { _Pragma("unroll") for (int m = 0; m < 4; ++m) _Pragma("unroll") for (int k = 0; k < 2; ++k) dst[m][k] = *(const LAS bf16x8*)(lds + PG8_SA(b, h) + aoff + m * 2048 + k * 1024); } while (0)
#define PG8_LDB(dst, b, h) do { _Pragma("unroll") for (int n = 0; n < 2; ++n) _Pragma("unroll") for (int k = 0; k < 2; ++k) dst[n][k] = *(const LAS bf16x8*)(lds + PG8_SB(b, h) + boff + n * 2048 + k * 1024); } while (0)
#define PG8_MMA(ai, bj, At, Bt) do { __builtin_amdgcn_s_setprio(1); _Pragma("unroll") for (int m = 0; m < 4; ++m) _Pragma("unroll") for (int n = 0; n < 2; ++n) _Pragma("unroll") for (int k = 0; k < 2; ++k) \
        acc[ai][bj][m][n] = __builtin_amdgcn_mfma_f32_16x16x32_bf16(Bt[n][k], At[m][k], acc[ai][bj][m][n], 0, 0, 0); __builtin_amdgcn_s_setprio(0); } while (0)
#define PG8_WAIT_V(n) asm volatile("s_waitcnt vmcnt(" #n ")" ::: "memory")
#define PG8_WAIT_L(n) asm volatile("s_waitcnt lgkmcnt(" #n ")" ::: "memory")
#define PG8_BAR __builtin_amdgcn_s_barrier()
#define PG8_SCHED __builtin_amdgcn_sched_barrier(0)
    Unit cur, nxt; int ui = 0;
    if (!S.next(0, cur)) return;
    f32x4 acc[2][2][4][2];
#pragma unroll
    for (int a = 0; a < 2; ++a)
#pragma unroll
        for (int b = 0; b < 2; ++b)
#pragma unroll
            for (int m = 0; m < 4; ++m)
#pragma unroll
                for (int n = 0; n < 2; ++n) acc[a][b][m][n] = (f32x4){0.f, 0.f, 0.f, 0.f};
    bf16x8 At[4][2], B0[2][2], B1[2][2];
    const char* cA = S.a_base(cur); const char* cB = S.b_base(cur);
    PG8_STAGE(PG8_SB(0, 0), cB, voffB); PG8_STAGE(PG8_SA(0, 0), cA, voffA); PG8_STAGE(PG8_SB(0, 1), cB + hstepB, voffB); PG8_STAGE(PG8_SA(0, 1), cA + hstepA, voffA);
    if (wr == 1) PG8_BAR;
    PG8_WAIT_V(4); PG8_BAR;
    PG8_STAGE(PG8_SB(1, 0), cB + kstep, voffB); PG8_STAGE(PG8_SA(1, 0), cA + kstep, voffA); PG8_STAGE(PG8_SB(1, 1), cB + hstepB + kstep, voffB);
    PG8_WAIT_V(6); PG8_BAR;
    for (;;) {
        const bool has_next = S.next(ui + 1, nxt);
        const char* nA = has_next ? S.a_base(nxt) : cA; const char* nB = has_next ? S.b_base(nxt) : cB;
        for (int t = 0; t < nt; t += 2) {
            const bool last = (t == nt - 2);
            const char* a1 = cA + (size_t)(t + 1) * kstep;
            const char* a2 = last ? nA : cA + (size_t)(t + 2) * kstep; const char* b2 = last ? nB : cB + (size_t)(t + 2) * kstep;
            const char* a3 = a2 + kstep; const char* b3 = b2 + kstep;
            PG8_LDB(B0, 0, 0); PG8_SCHED; PG8_LDA(At, 0, 0); PG8_STAGE(PG8_SA(1, 1), a1 + hstepA, voffA);
            PG8_WAIT_L(8); PG8_BAR; PG8_WAIT_L(0); PG8_MMA(0, 0, At, B0); PG8_BAR; PG8_SCHED;
            PG8_LDB(B1, 0, 1); PG8_STAGE(PG8_SB(0, 0), b2, voffB);
            PG8_BAR; PG8_WAIT_L(0); PG8_MMA(0, 1, At, B1); PG8_BAR;
            PG8_LDA(At, 0, 1); PG8_STAGE(PG8_SA(0, 0), a2, voffA);
            PG8_BAR; PG8_WAIT_L(0); PG8_MMA(1, 0, At, B0); PG8_BAR; PG8_SCHED;
            PG8_STAGE(PG8_SB(0, 1), b2 + hstepB, voffB);
            PG8_WAIT_V(6); PG8_BAR; PG8_MMA(1, 1, At, B1); PG8_BAR;
            PG8_LDB(B0, 1, 0); PG8_SCHED; PG8_LDA(At, 1, 0); PG8_STAGE(PG8_SA(0, 1), a2 + hstepA, voffA);
            PG8_WAIT_L(8); PG8_BAR; PG8_WAIT_L(0); PG8_MMA(0, 0, At, B0); PG8_BAR; PG8_SCHED;
            PG8_LDB(B1, 1, 1); PG8_STAGE(PG8_SB(1, 0), b3, voffB);
            PG8_BAR; PG8_WAIT_L(0); PG8_MMA(0, 1, At, B1); PG8_BAR;
            PG8_LDA(At, 1, 1); PG8_STAGE(PG8_SA(1, 0), a3, voffA);
            PG8_BAR; PG8_WAIT_L(0); PG8_MMA(1, 0, At, B0); PG8_BAR; PG8_SCHED;
            PG8_STAGE(PG8_SB(1, 1), b3 + hstepB, voffB);
            PG8_WAIT_V(6); PG8_BAR; PG8_MMA(1, 1, At, B1); PG8_BAR;
        }
        E(acc, cur, wr, wc, fr, fq);
        if (!has_next) break;
#pragma unroll
        for (int a = 0; a < 2; ++a)
#pragma unroll
            for (int b = 0; b < 2; ++b)
#pragma unroll
                for (int m = 0; m < 4; ++m)
#pragma unroll
                    for (int n = 0; n < 2; ++n) acc[a][b][m][n] = (f32x4){0.f, 0.f, 0.f, 0.f};
        cur = nxt; cA = nA; cB = nB; ++ui;
    }
    PG8_WAIT_V(0);
    if (wr == 0) PG8_BAR;
    PG8_BAR;
#undef PG8_SA
#undef PG8_SB
#undef PG8_STAGE
#undef PG8_LDA
#undef PG8_LDB
#undef PG8_MMA
#undef PG8_WAIT_V
#undef PG8_WAIT_L
#undef PG8_BAR
#undef PG8_SCHED
}
}
using pg8::Unit;
__device__ __forceinline__ u32x4 pack8(const f32x4& v0, const f32x4& v1) {
    u32x4 o; o[0] = cvt_pk_bf16(v0[0], v0[1]); o[1] = cvt_pk_bf16(v0[2], v0[3]); o[2] = cvt_pk_bf16(v1[0], v1[1]); o[3] = cvt_pk_bf16(v1[2], v1[3]); return o;
}
struct EpiWin {
    static constexpr bool PERM = true;
    bf16_t* US; bf16_t* Q; bf16_t* KROW; bf16_t* VROW; bf16_t* VT; float* GATE;
    __device__ __forceinline__ void operator()(const f32x4 (&acc)[2][2][4][2], const Unit& u, int wr, int wc, int fr, int fq) const {
        const int row0 = u.pm * 256 + wr * 64 + fr; const int pn = u.pn;
#pragma unroll
        for (int ai = 0; ai < 2; ++ai)
#pragma unroll
            for (int m = 0; m < 4; ++m) {
                const int row = row0 + ai * 128 + m * 16;
#pragma unroll
                for (int bj = 0; bj < 2; ++bj) {
                    const f32x4 v0 = acc[ai][bj][m][0], v1 = acc[ai][bj][m][1];
                    const int cin = bj * 128 + wc * 32 + 8 * fq;
                    if (pn < 4) { *(u32x4*)(US + (size_t)row * 1024 + pn * 256 + cin) = pack8(v0, v1); }
                    else if (pn < 8) { *(u32x4*)(Q + (size_t)row * 1024 + (pn - 4) * 256 + cin) = pack8(v0 * QSCALE, v1 * QSCALE); }
                    else if (pn < 14) {
                        const int kvi = pn - 8, branch = kvi >> 1, kvsel = kvi & 1, g = bj, d0 = wc * 32 + 8 * fq;
                        if (kvsel == 0) { *(u32x4*)(KROW + ((size_t)(branch * 2 + g) * L_ + row) * 128 + d0) = pack8(v0, v1); }
                        else if (branch == 0) { *(u32x4*)(VROW + ((size_t)g * L_ + row) * 128 + d0) = pack8(v0, v1); }
                        else {
                            bf16_t* vt = VT + ((size_t)((branch - 1) * 2 + g) * 128 + d0) * L_ + ((row & ~12) | ((row & 4) << 1) | ((row & 8) >> 1));
#pragma unroll
                            for (int e = 0; e < 4; ++e) { vt[(size_t)e * L_] = f2bf(v0[e]); vt[(size_t)(e + 4) * L_] = f2bf(v1[e]); }
                        }
                    } else {
                        if (cin < 24) {
                            float* gp = GATE + (size_t)row * 24 + cin;
                            f32x4 s0, s1;
#pragma unroll
                            for (int e = 0; e < 4; ++e) { s0[e] = sigmoidf_(v0[e]); s1[e] = sigmoidf_(v1[e]); }
                            *(f32x4*)gp = s0; *(f32x4*)(gp + 4) = s1;
                        }
                    }
                }
            }
    }
};
struct EpiGlu {
    static constexpr bool PERM = true;
    const bf16_t* Z; const float* bglu; bf16_t* Y;
    __device__ __forceinline__ void operator()(const f32x4 (&acc)[2][2][4][2], const Unit& u, int wr, int wc, int fr, int fq) const {
        const int row0 = u.pm * 256 + wr * 64 + fr;
#pragma unroll
        for (int bj = 0; bj < 2; ++bj) {
            const int col = u.pn * 256 + bj * 128 + wc * 32 + 8 * fq;
            const f32x4 b0 = *(const f32x4*)(bglu + col), b1 = *(const f32x4*)(bglu + col + 4);
#pragma unroll
            for (int ai = 0; ai < 2; ++ai)
#pragma unroll
                for (int m = 0; m < 4; ++m) {
                    const int row = row0 + ai * 128 + m * 16;
                    const u32x4 zz = *(const u32x4*)(Z + (size_t)row * 1024 + col);
                    const f32x4 v0 = acc[ai][bj][m][0] + b0, v1 = acc[ai][bj][m][1] + b1;
                    f32x4 o0, o1;
                    o0[0] = bflo(zz[0]) * sigmoidf_(v0[0]); o0[1] = bfhi(zz[0]) * sigmoidf_(v0[1]); o0[2] = bflo(zz[1]) * sigmoidf_(v0[2]); o0[3] = bfhi(zz[1]) * sigmoidf_(v0[3]);
                    o1[0] = bflo(zz[2]) * sigmoidf_(v1[0]); o1[1] = bfhi(zz[2]) * sigmoidf_(v1[1]); o1[2] = bflo(zz[3]) * sigmoidf_(v1[2]); o1[3] = bfhi(zz[3]) * sigmoidf_(v1[3]);
                    *(u32x4*)(Y + (size_t)row * 1024 + col) = pack8(o0, o1);
                }
        }
    }
};
struct EpiWout {
    static constexpr bool PERM = true;
    const float* X; const float* g1; bf16_t* X1;
    __device__ __forceinline__ void operator()(const f32x4 (&acc)[2][2][4][2], const Unit& u, int wr, int wc, int fr, int fq) const {
        const int row0 = u.pm * 256 + wr * 64 + fr, col0 = u.pn * 256 + wc * 32 + 8 * fq;
#pragma unroll
        for (int bj = 0; bj < 2; ++bj) {
            const int col = col0 + bj * 128;
            const f32x4 g0 = *(const f32x4*)(g1 + col), g4 = *(const f32x4*)(g1 + col + 4);
#pragma unroll
            for (int ai = 0; ai < 2; ++ai)
#pragma unroll
                for (int m = 0; m < 4; ++m) {
                    const size_t off = (size_t)(row0 + ai * 128 + m * 16) * 2048 + col;
                    const f32x4 x0 = *(const f32x4*)(X + off), x4 = *(const f32x4*)(X + off + 4);
                    *(u32x4*)(X1 + off) = pack8(x0 + g0 * acc[ai][bj][m][0], x4 + g4 * acc[ai][bj][m][1]);
                }
        }
    }
};
struct EpiBf16 {
    static constexpr bool PERM = true;
    bf16_t* O; int ldc;
    __device__ __forceinline__ void operator()(const f32x4 (&acc)[2][2][4][2], const Unit& u, int wr, int wc, int fr, int fq) const {
        const int row0 = u.pm * 256 + wr * 64 + fr, col0 = u.pn * 256 + wc * 32 + 8 * fq;
#pragma unroll
        for (int ai = 0; ai < 2; ++ai)
#pragma unroll
            for (int m = 0; m < 4; ++m)
#pragma unroll
                for (int bj = 0; bj < 2; ++bj)
                    *(u32x4*)(O + (size_t)(row0 + ai * 128 + m * 16) * ldc + col0 + bj * 128) = pack8(acc[ai][bj][m][0], acc[ai][bj][m][1]);
    }
};
struct EpiSlab {
    static constexpr bool PERM = false;
    float* SL;
    __device__ __forceinline__ void operator()(const f32x4 (&acc)[2][2][4][2], const Unit& u, int wr, int wc, int fr, int fq) const {
        float* base = SL + (size_t)u.z * 2048 * 256;
        const int row0 = u.pm * 256 + wr * 64 + fr, col0 = wc * 32 + 4 * fq;
#pragma unroll
        for (int ai = 0; ai < 2; ++ai)
#pragma unroll
            for (int m = 0; m < 4; ++m)
#pragma unroll
                for (int bj = 0; bj < 2; ++bj)
#pragma unroll
                    for (int n = 0; n < 2; ++n)
                        *(f32x4*)(base + (size_t)(row0 + ai * 128 + m * 16) * 256 + col0 + bj * 128 + n * 16) = acc[ai][bj][m][n];
    }
};
struct CmpOrder {
    const bf16_t* KROW; const bf16_t* VROW; const bf16_t* W1; int lda, ldb, K; int G, c;
    __device__ bool next(int i, Unit& u) const {
        const int x = i * G + c; if (x >= 64) return false;
        const int kvsel = x >> 5, pm = (x & 31) >> 2, ks = x & 3; u.pm = pm; u.pn = 0; u.z = kvsel * 4 + ks; return true;
    }
    __device__ __forceinline__ const char* a_base(const Unit& u) const { return (const char*)(((u.z >> 2) ? VROW : KROW) + (size_t)u.pm * 256 * 2048 + (u.z & 3) * 1024); }
    __device__ __forceinline__ const char* b_base(const Unit& u) const { return (const char*)(W1 + (size_t)(u.z >> 2) * 256 * 4096 + (u.z & 3) * 1024); }
};
struct Ctx { int bid, nb, tid, wave, lane; LAS unsigned char* lds; };

__device__ __forceinline__ void p0_cond(const Args& a, const Ctx& c) {
    const float* cv = a.in[1]; const float* w = a.in[2]; float* condp = (float*)(a.ws + WS_CONDP);
    for (int u = c.bid * 8 + c.wave; u < 1536; u += c.nb * 8) {
        const int cc = u % 48, kc = u / 48;
        const float* wp = w + (size_t)(kc * 64) * NADA + cc * 256 + c.lane * 4;
        f32x4 acc = {0.f, 0.f, 0.f, 0.f};
#pragma unroll 16
        for (int k = 0; k < 64; ++k) { const float x = cv[kc * 64 + k]; const float s = x / (1.f + __expf(-x)); acc += s * *(const f32x4*)(wp + (size_t)k * NADA); }
        *(f32x4*)(condp + (size_t)kc * NADA + cc * 256 + c.lane * 4) = acc;
    }
}
__device__ __forceinline__ void conv_T(const float* src, int K, int N, bf16_t* dst, int Npad, const Ctx& c) {
    LAS float* tile = (LAS float*)c.lds;
    const int nkt = K / 64, ntiles = nkt * (Npad / 64);
    const int r = c.tid >> 4, c4 = c.tid & 15;
    f32x4 v[2];
#define CONVT_LD(tix_) do { const int nt_ = (tix_) / nkt, kt_ = (tix_) % nkt, n_ = nt_ * 64 + 4 * c4; _Pragma("unroll") for (int i = 0; i < 2; ++i) { const int k_ = kt_ * 64 + r + 32 * i; v[i] = (f32x4){0.f, 0.f, 0.f, 0.f}; if (n_ < N) v[i] = *(const f32x4*)(src + (size_t)k_ * N + n_); } } while (0)
    if (c.bid < ntiles) CONVT_LD(c.bid);
    for (int tix = c.bid; tix < ntiles; tix += c.nb) {
        const int nt = tix / nkt, kt = tix % nkt;
#pragma unroll
        for (int i = 0; i < 2; ++i) { LAS float* tp = tile + (r + 32 * i) * 65 + 4 * c4; tp[0] = v[i][0]; tp[1] = v[i][1]; tp[2] = v[i][2]; tp[3] = v[i][3]; }
        __syncthreads();
        if (tix + c.nb < ntiles) CONVT_LD(tix + c.nb);
        { const int n = c.tid >> 3, kq = c.tid & 7; float w[8];
#pragma unroll
          for (int j = 0; j < 8; ++j) w[j] = tile[(kq * 8 + j) * 65 + n];
          u32x4 o; o[0] = cvt_pk_bf16(w[0], w[1]); o[1] = cvt_pk_bf16(w[2], w[3]); o[2] = cvt_pk_bf16(w[4], w[5]); o[3] = cvt_pk_bf16(w[6], w[7]);
          *(u32x4*)(dst + (size_t)(nt * 64 + n) * K + kt * 64 + kq * 8) = o; }
        __syncthreads();
    }
#undef CONVT_LD
}
__device__ __forceinline__ void conv_fp6rows(const float* src, unsigned char* dst6, float* scl, int rows, const Ctx& c) {
    for (int row = c.bid * 8 + c.wave; row < rows; row += c.nb * 8) {
        const float* sp = src + (size_t)row * 2048 + c.lane * 32;
        f32x4 v[8]; float mx = 0.f;
#pragma unroll
        for (int j = 0; j < 8; ++j) { v[j] = *(const f32x4*)(sp + j * 4); mx = fmaxf(mx, fmaxf(fmaxf(fabsf(v[j][0]), fabsf(v[j][1])), fmaxf(fabsf(v[j][2]), fabsf(v[j][3])))); }
        mx = wave_max(mx);
        const float s = mx > 0.f ? 7.5f / mx : 1.f;
        if (c.lane == 0) scl[row] = mx > 0.f ? mx * (1.f / 7.5f) : 1.f;
        f32x16 x, y;
#pragma unroll
        for (int j = 0; j < 4; ++j)
#pragma unroll
            for (int e = 0; e < 4; ++e) { const int i = j * 4 + e;
                x[i] = v[(2 * i) >> 2][(2 * i) & 3] * s; y[i] = v[(2 * i + 1) >> 2][(2 * i + 1) & 3] * s; }
        const u32x6 pk = __builtin_amdgcn_cvt_scalef32_2xpk16_fp6_f32(x, y, 1.0f);
        unsigned char* dp = dst6 + (size_t)row * 1536 + c.lane * 24;
        *(u32x2*)dp = (u32x2){pk[0], pk[1]}; *(u32x2*)(dp + 8) = (u32x2){pk[2], pk[3]}; *(u32x2*)(dp + 16) = (u32x2){pk[4], pk[5]};
    }
}
__device__ __forceinline__ void conv_E(const float* src, bf16_t* dst, size_t n8, const Ctx& c) {
    const size_t stride = (size_t)c.nb * NTHREADS;
    for (size_t i = (size_t)c.bid * NTHREADS + c.tid; i < n8; i += stride) {
        const f32x4 x = *(const f32x4*)(src + i * 8), y = *(const f32x4*)(src + i * 8 + 4);
        *(u32x4*)(dst + i * 8) = pack8(x, y);
    }
}
__device__ __forceinline__ int t5_bucket(int n) {
    if (n < 16) return n;
    const float scaled = logf((float)n / 16.f) / logf(64.f);
    const int large = 16 + (int)(scaled * 16.f);
    return large < 31 ? large : 31;
}
__device__ __forceinline__ void p0_tb(const Args& a, const Ctx& c) {
    float* tb = (float*)(a.ws + WS_TB); const float* rb = a.in[26];
    for (int i = c.bid * NTHREADS + c.tid; i < 8 * TBN; i += c.nb * NTHREADS) { const int head = i / TBN, dist = i % TBN; tb[i] = rb[t5_bucket(dist) * 8 + head] * LOG2E; }
}
__device__ __forceinline__ void p0_bpe(const Args& a, const Ctx& c, int part) {
    const int n = c.tid & 255, kv = c.tid >> 8;
    const float* pe = a.in[kv ? 23 : 20]; const float* w1 = a.in[kv ? 24 : 21]; float* bpep = (float*)(a.ws + WS_BPEP);
    float s = 0.f;
#pragma unroll 16
    for (int k = part * 128; k < part * 128 + 128; ++k) s += pe[k] * w1[(size_t)k * 256 + n];
    bpep[(part * 2 + kv) * 256 + n] = s;
}
__device__ __forceinline__ void p0_s5(const Args& a, const Ctx& c, int g) {
    LAS float* ar = (LAS float*)c.lds;
    LAS float* ai = ar + 17 * 64;
    LAS float* bbr = ai + 17 * 64;
    LAS float* bbi = bbr + 1024;
    LAS float* cr = bbi + 1024;
    LAS float* ci = cr + 1024;
    LAS float* kd = ci + 1024;
    const int tid = c.tid;
    if (tid < 64) {
        const int p = tid; const float dt = expf(a.in[12][g]); const float lr = a.in[10][g * 64 + p], li = a.in[11][g * 64 + p];
        for (int d = 0; d <= 16; ++d) { const float mag = expf(lr * dt * (float)d), ang = li * dt * (float)d; ar[d * 64 + p] = mag * cosf(ang); ai[d * 64 + p] = mag * sinf(ang); }
        const float nr = ar[64 + p] - 1.f, ni = ai[64 + p], den = lr * lr + li * li;
        const float wre = (nr * lr + ni * li) / den, wim = (ni * lr - nr * li) / den;
        for (int h = 0; h < 16; ++h) { const float br = a.in[13][(g * 64 + p) * 16 + h], bi = a.in[14][(g * 64 + p) * 16 + h]; bbr[p * 16 + h] = wre * br - wim * bi; bbi[p * 16 + h] = wre * bi + wim * br; }
        float* s5p = (float*)(a.ws + WS_S5P);
        float xr = ar[16 * 64 + p], xi = ai[16 * 64 + p];
        s5p[(g * 64 + p) * 2] = xr; s5p[(g * 64 + p) * 2 + 1] = xi;
        for (int s = 0; s < 8; ++s) { const float tr = xr * xr - xi * xi, ti = 2.f * xr * xi; xr = tr; xi = ti; }
        s5p[64 * 64 * 2 + (g * 64 + p) * 2] = xr; s5p[64 * 64 * 2 + (g * 64 + p) * 2 + 1] = xi;
    }
    for (int e = tid; e < 1024; e += NTHREADS) { cr[e] = a.in[15][g * 1024 + e]; ci[e] = a.in[16][g * 1024 + e]; }
    __syncthreads();
    for (int e = tid; e < 4096; e += NTHREADS) {
        const int d = e >> 8, h1 = (e >> 4) & 15, h = e & 15; float s = 0.f;
        for (int p = 0; p < 64; ++p) { const float Cr = cr[h1 * 64 + p], Ci = ci[h1 * 64 + p], Ar = ar[d * 64 + p], Ai = ai[d * 64 + p];
            const float Gr = Cr * Ar - Ci * Ai, Gi = Cr * Ai + Ci * Ar; s += Gr * bbr[p * 16 + h] - Gi * bbi[p * 16 + h]; }
        if (d == 0 && h1 == h) s += a.in[17][g * 16 + h];
        kd[e] = s;
    }
    __syncthreads();
    bf16_t* MT = (bf16_t*)(a.ws + WS_S5MT) + (size_t)g * 65536;
    bf16_t* WE = (bf16_t*)(a.ws + WS_S5WE) + (size_t)g * 32768;
    bf16_t* WC = (bf16_t*)(a.ws + WS_S5WC) + (size_t)g * 32768;
    for (int e = tid; e < 65536; e += NTHREADS) { const int n = e >> 8, k = e & 255, j = n >> 4, h1 = n & 15, i = k >> 4, h = k & 15;
        MT[e] = f2bf(i <= j ? kd[(j - i) * 256 + h1 * 16 + h] : 0.f); }
    for (int e = tid; e < 32768; e += NTHREADS) { const int n = e >> 8, k = e & 255, cc = n >> 6, p = n & 63, i = k >> 4, h = k & 15;
        const float Ar = ar[(15 - i) * 64 + p], Ai = ai[(15 - i) * 64 + p], Br = bbr[p * 16 + h], Bi = bbi[p * 16 + h];
        WE[e] = f2bf(cc ? (Ar * Bi + Ai * Br) : (Ar * Br - Ai * Bi)); }
    for (int e = tid; e < 32768; e += NTHREADS) { const int n = e >> 7, k = e & 127, j = n >> 4, h1 = n & 15, cc = k >> 6, p = k & 63;
        const float Cr = cr[h1 * 64 + p], Ci = ci[h1 * 64 + p], Ar = ar[(j + 1) * 64 + p], Ai = ai[(j + 1) * 64 + p];
        WC[e] = f2bf(cc ? -(Cr * Ai + Ci * Ar) : (Cr * Ar - Ci * Ai)); }
    __syncthreads();
}
__device__ __forceinline__ void p0_prologue(const Args& a, const Ctx& c) {
    for (int g = c.bid; g < 64; g += c.nb) p0_s5(a, c, g);
    for (int u = 0; u < 32; ++u) if (c.bid == (64 + u) % c.nb) p0_bpe(a, c, u);
    p0_tb(a, c);
    p0_cond(a, c);
    conv_T(a.in[6], 2048, DIN, (bf16_t*)(a.ws + WS_WIN), DIN_PAD, c);
    conv_T(a.in[18], 1024, 1024, (bf16_t*)(a.ws + WS_WGLU), 1024, c);
    conv_T(a.in[7], 2048, 2048, (bf16_t*)(a.ws + WS_WOUT), 2048, c);
    conv_T(a.in[27], 2048, 2048, (bf16_t*)(a.ws + WS_WQ), 2048, c);
    conv_T(a.in[21], 4096, 256, (bf16_t*)(a.ws + WS_W1), 256, c);
    conv_T(a.in[24], 4096, 256, (bf16_t*)(a.ws + WS_W1) + 256 * 4096, 256, c);
    conv_T(a.in[22], 256, 128, (bf16_t*)(a.ws + WS_W2), 128, c);
    conv_T(a.in[25], 256, 128, (bf16_t*)(a.ws + WS_W2) + 128 * 256, 128, c);
    conv_E(a.in[28], (bf16_t*)(a.ws + WS_PK), 128 * 128 / 8, c);
    conv_E(a.in[29], (bf16_t*)(a.ws + WS_PK) + 128 * 128, 128 * 128 / 8, c);
    conv_fp6rows(a.in[30], a.ws + WS_PU, (float*)(a.ws + WS_PSC), 16384, c);
    conv_fp6rows(a.in[31], a.ws + WS_PV, (float*)(a.ws + WS_PSC) + 16384, 16384, c);
}

__device__ __forceinline__ void norm_rows(const float* X, bf16_t* O, LAS const float* Ab, LAS const float* Bb, const Ctx& c, int row0 = 0, int nrows = L_) {
    for (int t = row0 + c.bid * 8 + c.wave; t < row0 + nrows; t += c.nb * 8) {
        const float* xr = X + (size_t)t * 2048 + c.lane * 4;
        f32x4 v[8]; float ss = 0.f;
#pragma unroll
        for (int j = 0; j < 8; ++j) { v[j] = *(const f32x4*)(xr + j * 256); ss += v[j][0] * v[j][0] + v[j][1] * v[j][1] + v[j][2] * v[j][2] + v[j][3] * v[j][3]; }
        ss = wave_sum(ss);
        const float rstd = rsqrtf(ss * (1.f / 2048.f) + 1e-6f);
#pragma unroll
        for (int j = 0; j < 8; ++j) {
            const int col = j * 256 + c.lane * 4;
            const f32x4 A = *(const LAS f32x4*)(Ab + col), B = *(const LAS f32x4*)(Bb + col);
            const f32x4 o = v[j] * rstd * A + B;
            u32x2 w; w[0] = cvt_pk_bf16(o[0], o[1]); w[1] = cvt_pk_bf16(o[2], o[3]);
            *(u32x2*)(O + (size_t)t * 2048 + col) = w;
        }
    }
}
__device__ __forceinline__ void norm_rows_bf16(const bf16_t* X, bf16_t* O, LAS const float* Ab, LAS const float* Bb, const Ctx& c, int row0, int nrows) {
    for (int t = row0 + c.bid * 8 + c.wave; t < row0 + nrows; t += c.nb * 8) {
        const bf16_t* xr = X + (size_t)t * 2048 + c.lane * 8;
        u32x4 w[4]; float ss = 0.f;
#pragma unroll
        for (int j = 0; j < 4; ++j) { w[j] = *(const u32x4*)(xr + j * 512);
#pragma unroll
            for (int e = 0; e < 4; ++e) { const float a0 = bflo(w[j][e]), a1 = bfhi(w[j][e]); ss += a0 * a0 + a1 * a1; } }
        ss = wave_sum(ss);
        const float rstd = rsqrtf(ss * (1.f / 2048.f) + 1e-6f);
#pragma unroll
        for (int j = 0; j < 4; ++j) {
            const int col = j * 512 + c.lane * 8;
            const f32x4 A0 = *(const LAS f32x4*)(Ab + col), A1 = *(const LAS f32x4*)(Ab + col + 4), B0 = *(const LAS f32x4*)(Bb + col), B1 = *(const LAS f32x4*)(Bb + col + 4);
            f32x4 o0, o1;
#pragma unroll
            for (int e = 0; e < 2; ++e) { o0[2 * e] = bflo(w[j][e]) * rstd * A0[2 * e] + B0[2 * e]; o0[2 * e + 1] = bfhi(w[j][e]) * rstd * A0[2 * e + 1] + B0[2 * e + 1];
                o1[2 * e] = bflo(w[j][2 + e]) * rstd * A1[2 * e] + B1[2 * e]; o1[2 * e + 1] = bfhi(w[j][2 + e]) * rstd * A1[2 * e + 1] + B1[2 * e + 1]; }
            *(u32x4*)(O + (size_t)t * 2048 + col) = pack8(o0, o1);
        }
    }
}
__device__ __forceinline__ float cond_from_partials(const float* condp, const float* b_ada, int j) {
    float s = b_ada[j];
#pragma unroll 8
    for (int k = 0; k < 32; ++k) s += condp[(size_t)k * NADA + j];
    return s;
}
__device__ __forceinline__ void p1_hnorm(const Args& a, const Ctx& c) {
    const float* condp = (const float*)(a.ws + WS_CONDP); float* cond = (float*)(a.ws + WS_COND);
    for (int j = c.bid * NTHREADS + c.tid; j < NADA; j += c.nb * NTHREADS) cond[j] = cond_from_partials(condp, a.in[3], j);
    LAS float* Ab = (LAS float*)c.lds; LAS float* Bb = Ab + 2048;
    for (int col = c.tid; col < 2048; col += NTHREADS) {
        Ab[col] = a.in[4][col] * (1.f + cond_from_partials(condp, a.in[3], 2048 + col)); Bb[col] = cond_from_partials(condp, a.in[3], col); }
    __syncthreads();
    norm_rows(a.in[0], (bf16_t*)(a.ws + WS_H), Ab, Bb, c);
}
__device__ __forceinline__ void p8_h2norm(const Args& a, const Ctx& c, int row0, int nrows) {
    const float* cond = (const float*)(a.ws + WS_COND);
    LAS float* Ab = (LAS float*)c.lds; LAS float* Bb = Ab + 2048;
    for (int col = c.tid; col < 2048; col += NTHREADS) { Ab[col] = a.in[5][col] * (1.f + cond[4 * 2048 + col]); Bb[col] = cond[3 * 2048 + col]; }
    __syncthreads();
    norm_rows_bf16((const bf16_t*)(a.ws + WS_X1), (bf16_t*)(a.ws + WS_H), Ab, Bb, c, row0, nrows);
}
__device__ __forceinline__ void p6_mixnorm(const Args& a, const Ctx& c) {
    const bf16_t* YS = (const bf16_t*)(a.ws + WS_YSSM); const bf16_t* YA = (const bf16_t*)(a.ws + WS_YATT); bf16_t* O = (bf16_t*)(a.ws + WS_H);
    for (int t = c.bid * 8 + c.wave; t < L_; t += c.nb * 8) {
#pragma unroll
        for (int part = 0; part < 2; ++part) {
            const bf16_t* src = (part ? YA : YS) + (size_t)t * 1024 + c.lane * 8; const float* beta = a.in[part ? 9 : 8];
            u32x4 w[2]; float f[16]; float ss = 0.f;
#pragma unroll
            for (int j = 0; j < 2; ++j) { w[j] = *(const u32x4*)(src + j * 512);
#pragma unroll
                for (int e = 0; e < 4; ++e) { f[j * 8 + 2 * e] = bflo(w[j][e]); f[j * 8 + 2 * e + 1] = bfhi(w[j][e]); } }
#pragma unroll
            for (int e = 0; e < 16; ++e) ss += f[e] * f[e];
            ss = wave_sum(ss);
            const float rstd = rsqrtf(ss * (1.f / 1024.f) + 1e-6f);
#pragma unroll
            for (int j = 0; j < 2; ++j) { const int col = j * 512 + c.lane * 8; const f32x4 b0 = *(const f32x4*)(beta + col), b1 = *(const f32x4*)(beta + col + 4);
                f32x4 o0, o1;
#pragma unroll
                for (int e = 0; e < 4; ++e) { o0[e] = f[j * 8 + e] * rstd * b0[e]; o1[e] = f[j * 8 + 4 + e] * rstd * b1[e]; }
                *(u32x4*)(O + (size_t)t * 2048 + part * 1024 + col) = pack8(o0, o1); }
        }
    }
}
constexpr int S5_US = 0, S5_ES = 33792, S5_SS = 67584;
template <int PASS>
__device__ __forceinline__ void s5_item(const Args& a, const Ctx& c, int g, int seg) {
    LAS unsigned char* lds = c.lds;
    const int tid = c.tid, wave = c.wave, lane = c.lane, r = lane & 15, q = lane >> 4;
    const bf16_t* U = (const bf16_t*)(a.ws + WS_US);
    const bf16_t* MT = (const bf16_t*)(a.ws + WS_S5MT) + (size_t)g * 65536;
    const bf16_t* WE = (const bf16_t*)(a.ws + WS_S5WE) + (size_t)g * 32768;
    const bf16_t* WC = (const bf16_t*)(a.ws + WS_S5WC) + (size_t)g * 32768;
    const float* s5p = (const float*)(a.ws + WS_S5P);
    float* F = (float*)(a.ws + WS_S5F) + (size_t)g * 4 * 128;
    bf16_t* Z = (bf16_t*)(a.ws + WS_Z);
    bf16x8 bE[8];
#pragma unroll
    for (int ks = 0; ks < 8; ++ks) bE[ks] = *(const bf16x8*)(WE + (size_t)(16 * wave + r) * 256 + 32 * ks + 8 * q);
    float sr = 0.f, si = 0.f, a16r = 0.f, a16i = 0.f;
    if (wave == 0) {
        a16r = s5p[(g * 64 + lane) * 2]; a16i = s5p[(g * 64 + lane) * 2 + 1];
        if (PASS == 1) { const float br = s5p[8192 + (g * 64 + lane) * 2], bi = s5p[8192 + (g * 64 + lane) * 2 + 1];
            for (int s = 0; s < seg; ++s) { const float fr_ = F[s * 128 + lane], fi_ = F[s * 128 + 64 + lane]; const float nr = br * sr - bi * si + fr_, ni = br * si + bi * sr + fi_; sr = nr; si = ni; } }
    }
    for (int sb = 0; sb < 4; ++sb) {
        const int tok0 = seg * 4096 + sb * 1024;
#pragma unroll
        for (int i = 0; i < 4; ++i) { const int ch = tid + NTHREADS * i, token = ch >> 1, half = ch & 1;
            const u32x4 v = *(const u32x4*)(U + (size_t)(tok0 + token) * 1024 + g * 16 + half * 8);
            *(LAS u32x4*)(lds + S5_US + (token >> 4) * 528 + ((token & 15) * 16 + half * 8) * 2) = v; }
        __syncthreads();
#pragma unroll
        for (int m = 0; m < 4; ++m) {
            f32x4 acc = {0.f, 0.f, 0.f, 0.f};
#pragma unroll
            for (int ks = 0; ks < 8; ++ks) { const bf16x8 A = *(const LAS bf16x8*)(lds + S5_US + (16 * m + r) * 528 + (32 * ks + 8 * q) * 2); acc = mfma16(A, bE[ks], acc); }
#pragma unroll
            for (int i = 0; i < 4; ++i) *(LAS float*)(lds + S5_ES + ((16 * m + 4 * q + i) * 132 + 16 * wave + r) * 4) = acc[i];
        }
        __syncthreads();
        if (wave == 0) {
            for (int ch = 0; ch < 64; ++ch) {
                const float er = *(const LAS float*)(lds + S5_ES + (ch * 132 + lane) * 4), ei = *(const LAS float*)(lds + S5_ES + (ch * 132 + 64 + lane) * 4);
                if (PASS == 1) { *(LAS bf16_t*)(lds + S5_SS + (ch * 136 + lane) * 2) = f2bf(sr); *(LAS bf16_t*)(lds + S5_SS + (ch * 136 + 64 + lane) * 2) = f2bf(si); }
                const float nr = a16r * sr - a16i * si + er, ni = a16r * si + a16i * sr + ei; sr = nr; si = ni;
            }
        }
        __syncthreads();
        if (PASS == 1) {
#pragma unroll
            for (int nt = 0; nt < 2; ++nt) {
                const int j = 2 * wave + nt;
                f32x4 acc[4];
#pragma unroll
                for (int m = 0; m < 4; ++m) acc[m] = (f32x4){0.f, 0.f, 0.f, 0.f};
                for (int ks = 0; ks <= (j >> 1); ++ks) {
                    const bf16x8 B = *(const bf16x8*)(MT + (size_t)(16 * j + r) * 256 + 32 * ks + 8 * q);
#pragma unroll
                    for (int m = 0; m < 4; ++m) { const bf16x8 A = *(const LAS bf16x8*)(lds + S5_US + (16 * m + r) * 528 + (32 * ks + 8 * q) * 2); acc[m] = mfma16(A, B, acc[m]); }
                }
#pragma unroll
                for (int ks = 0; ks < 4; ++ks) {
                    const bf16x8 B = *(const bf16x8*)(WC + (size_t)(16 * j + r) * 128 + 32 * ks + 8 * q);
#pragma unroll
                    for (int m = 0; m < 4; ++m) { const bf16x8 A = *(const LAS bf16x8*)(lds + S5_SS + (16 * m + r) * 272 + (32 * ks + 8 * q) * 2); acc[m] = mfma16(A, B, acc[m]); }
                }
#pragma unroll
                for (int m = 0; m < 4; ++m)
#pragma unroll
                    for (int i = 0; i < 4; ++i) { const int ch = 16 * m + 4 * q + i; Z[(size_t)(tok0 + 16 * ch + j) * 1024 + g * 16 + r] = f2bf(gelu_tanh(acc[m][i])); }
            }
            __syncthreads();
        }
    }
    if (PASS == 0 && wave == 0) { F[seg * 128 + lane] = sr; F[seg * 128 + 64 + lane] = si; }
}

__device__ __forceinline__ void cmp_finish_item(const Args& a, const Ctx& c, int kvsel, int rt) {
    LAS unsigned char* lds = c.lds;
    const int tid = c.tid, wave = c.wave, lane = c.lane, r = lane & 15, q = lane >> 4;
    const float* SL = (const float*)(a.ws + WS_SLAB) + (size_t)kvsel * 4 * 2048 * 256;
    const float* bpep = (const float*)(a.ws + WS_BPEP) + kvsel * 256;
    const bf16_t* W2 = (const bf16_t*)(a.ws + WS_W2) + kvsel * 128 * 256;
    for (int e = tid; e < 64 * 64; e += NTHREADS) {
        const int row = e >> 6, c4 = (e & 63) * 4;
        f32x4 s = {0.f, 0.f, 0.f, 0.f};
#pragma unroll 8
        for (int pt = 0; pt < 32; ++pt) s += *(const f32x4*)(bpep + pt * 512 + c4);
#pragma unroll
        for (int ks = 0; ks < 4; ++ks) s += *(const f32x4*)(SL + ((size_t)ks * 2048 + rt * 64 + row) * 256 + c4);
        u32x2 w; w[0] = cvt_pk_bf16(gelu_tanh(s[0]), gelu_tanh(s[1])); w[1] = cvt_pk_bf16(gelu_tanh(s[2]), gelu_tanh(s[3]));
        *(LAS u32x2*)(lds + row * 528 + c4 * 2) = w;
    }
    __syncthreads();
    bf16x8 B[8];
#pragma unroll
    for (int ks = 0; ks < 8; ++ks) B[ks] = *(const bf16x8*)(W2 + (size_t)(16 * wave + r) * 256 + 32 * ks + 8 * q);
#pragma unroll
    for (int m = 0; m < 4; ++m) {
        f32x4 acc = {0.f, 0.f, 0.f, 0.f};
#pragma unroll
        for (int ks = 0; ks < 8; ++ks) { const bf16x8 A = *(const LAS bf16x8*)(lds + (16 * m + r) * 528 + (32 * ks + 8 * q) * 2); acc = mfma16(A, B[ks], acc); }
#pragma unroll
        for (int i = 0; i < 4; ++i) {
            const int row = rt * 64 + 16 * m + 4 * q + i, gi = row >> 10, ci = row & 1023, n = 16 * wave + r;
            const bf16_t v = (ci == 1023) ? (bf16_t)0 : f2bf(acc[i]);
            if (kvsel == 0) ((bf16_t*)(a.ws + WS_KC))[((size_t)gi * 1024 + ci) * 128 + n] = v;
            else ((bf16_t*)(a.ws + WS_VCT))[((size_t)gi * 128 + n) * 1024 + ((ci & ~12) | ((ci & 4) << 1) | ((ci & 8) >> 1))] = v;
        }
    }
    __syncthreads();
}
constexpr int AT_IMP = 65536, AT_TB = 131072, AT_BM = 143872, AT_WU = 145920, AT_END = 146176;
__device__ __forceinline__ int kswz(int r) { return ((r & 3) << 2) | ((r >> 2) & 3); }
__host__ __device__ __forceinline__ int vperm(int t) { return (t & ~12) | ((t & 4) << 1) | ((t & 8) >> 1); }
template <int KEYS> __device__ __forceinline__ int vsw(int d) { return KEYS == 128 ? kswz(d) : ((d >> 1) & 7); }
template <int KEYS, bool NEEDV>
__device__ __forceinline__ void stage_dma(const bf16_t* Kt, const bf16_t* Vt, int ldv, LAS unsigned char* kb, LAS unsigned char* vb, int wave, int lane) {
    constexpr int NP = KEYS / 32;
#pragma unroll
    for (int i = 0; i < NP; ++i) { const int pc = NP * wave + i, row = 4 * pc + (lane >> 4), ch = (lane & 15) ^ kswz(row);
        __builtin_amdgcn_global_load_lds((const unsigned*)(Kt + row * 128 + ch * 8), (LAS unsigned*)(kb + pc * 1024), 16, 0, 0); }
    if (NEEDV) {
#pragma unroll
        for (int i = 0; i < NP; ++i) {
            const int pc = NP * wave + i;
            if (KEYS == 128) { const int d = 4 * pc + (lane >> 4), ch = (lane & 15) ^ kswz(d);
                __builtin_amdgcn_global_load_lds((const unsigned*)(Vt + (size_t)d * ldv + 8 * ch), (LAS unsigned*)(vb + pc * 1024), 16, 0, 0); }
            else { const int d = 8 * pc + (lane >> 3), ch = (lane & 7) ^ ((d >> 1) & 7);
                __builtin_amdgcn_global_load_lds((const unsigned*)(Vt + (size_t)d * ldv + 8 * ch), (LAS unsigned*)(vb + pc * 1024), 16, 0, 0); }
        }
    }
}
__device__ __forceinline__ float xhalf_max(float x) { auto rr = __builtin_amdgcn_permlane32_swap(__float_as_uint(x), __float_as_uint(x), false, false); return fmaxf(__uint_as_float(rr[0]), __uint_as_float(rr[1])); }
__device__ __forceinline__ float xhalf_sum(float x) { auto rr = __builtin_amdgcn_permlane32_swap(__float_as_uint(x), __float_as_uint(x), false, false); return __uint_as_float(rr[0]) + __uint_as_float(rr[1]); }
template <int BR>
__device__ __forceinline__ float tile_prep(int MODE, f32x16& S, LAS const float* tb, float cb, int base, bool selbit) {
    float mx = -INFINITY;
    if (MODE == 1) {
#pragma unroll
        for (int r = 0; r < 16; ++r) mx = fmaxf(mx, S[r]);
        mx = (BR == 2 && !selbit) ? -INFINITY : mx + cb;
    } else {
        const bool nomask = (MODE == 2);
        float bv[16];
#pragma unroll
        for (int r = 0; r < 16; ++r) { const int cr = (r & 3) + 8 * (r >> 2); const int dist = (BR <= 1) ? base - 16 * cr : base - cr; bv[r] = tb[min(max(dist, 0), TBN - 1)]; }
        __builtin_amdgcn_sched_barrier(0);
#pragma unroll
        for (int r = 0; r < 16; ++r) {
            const int cr = (r & 3) + 8 * (r >> 2);
            const int dist = (BR <= 1) ? base - 16 * cr : base - cr;
            float v = S[r] + bv[r];
            bool valid;
            if (BR <= 1) valid = dist >= 0; else if (BR == 2) valid = selbit && dist >= 0; else valid = nomask || (unsigned)dist < 512u;
            v = valid ? v : -INFINITY;
            S[r] = v; mx = fmaxf(mx, v);
        }
    }
    return mx;
}
template <int BR, bool PEND>
__device__ __forceinline__ float tile_decide(int MODE, float mx, float cb, bool selbit, f32x16 (&O)[4], float& m, float& l, u32x4& pa, u32x4& pb) {
    if (BR == 1) { const float mu = (m == -INFINITY) ? 0.f : m; return (MODE == 1) ? mu - cb : mu; }
    mx = xhalf_max(mx);
    const float mn = fmaxf(m, mx), mu = (mn == -INFINITY) ? 0.f : mn;
    if (__any(mn > m)) {
        const float alpha = fexp2(m - mu);
        l *= alpha;
        if (BR >= 2) {
#pragma unroll
            for (int dt = 0; dt < 4; ++dt)
#pragma unroll
                for (int r = 0; r < 16; ++r) O[dt][r] *= alpha;
            if (PEND) {
#pragma unroll
                for (int e = 0; e < 4; ++e) { pa[e] = cvt_pk_bf16(bflo(pa[e]) * alpha, bfhi(pa[e]) * alpha); pb[e] = cvt_pk_bf16(bflo(pb[e]) * alpha, bfhi(pb[e]) * alpha); }
            }
        }
    }
    m = mn;
    if (MODE == 1) return (BR == 2 && !selbit) ? INFINITY : mu - cb;
    return mu;
}
template <int BR, int KEYS>
__device__ __forceinline__ void attn_tile(int MODE, LAS const unsigned char* kb, LAS const unsigned char* vb, int cb0, LAS const float* tb, int key0, int t, int lane,
                                          const bf16x8 (&qf)[8], f32x16 (&O)[4], float& m, float& l, float inv_l, bool selbit, LAS float* imp_row) {
    asm volatile("" : "+v"(lane));
    constexpr int ROWB = 2 * KEYS;
    const int r31 = lane & 31, h = lane >> 5;
    const int gh = kswz(r31) ^ h, vh = vsw<KEYS>(r31) ^ h;
    float cb = 0.f;
    if (MODE == 1) cb = tb[TBN - 1];
    const int base0 = (BR <= 1) ? t - 31 - 16 * (key0 + 4 * h) : t - (key0 + 4 * h);
    const int base1 = (BR <= 1) ? base0 - 16 * 32 : base0 - 32;
    LAS const unsigned char* k0 = kb + r31 * 256;
    f32x16 S0, S1;
    bf16x8 kf[8];
#pragma unroll
    for (int ks = 0; ks < 8; ++ks) kf[ks] = *(const LAS bf16x8*)(k0 + 16 * ((2 * ks) ^ gh));
#pragma unroll
    for (int r = 0; r < 16; ++r) { S0[r] = 0.f; S1[r] = 0.f; }
    __builtin_amdgcn_sched_barrier(0);
#pragma unroll
    for (int ks = 0; ks < 8; ++ks) S0 = mfma32(kf[ks], qf[ks], S0);
    __builtin_amdgcn_sched_barrier(0);
#pragma unroll
    for (int ks = 0; ks < 8; ++ks) kf[ks] = *(const LAS bf16x8*)(k0 + 8192 + 16 * ((2 * ks) ^ gh));
    const float mx0 = tile_prep<BR>(MODE, S0, tb, cb, base0, selbit);
    u32x4 pk0a = {0u, 0u, 0u, 0u}, pk0b = {0u, 0u, 0u, 0u}, pk1a, pk1b;
    const float me0 = tile_decide<BR, false>(MODE, mx0, cb, selbit, O, m, l, pk0a, pk0b);
    __builtin_amdgcn_sched_barrier(0);
    {
#pragma unroll
        for (int ks = 0; ks < 8; ++ks) S1 = mfma32(kf[ks], qf[ks], S1);
        float ps = 0.f;
#pragma unroll
        for (int r = 0; r < 16; ++r) { float p = fexp2(S0[r] - me0); if (BR == 1) p *= inv_l; S0[r] = p; ps += p; }
        if (BR != 1) l += ps;
        if (BR >= 1) {
#pragma unroll
            for (int e = 0; e < 4; ++e) { pk0a[e] = cvt_pk_bf16(S0[2 * e], S0[2 * e + 1]); pk0b[e] = cvt_pk_bf16(S0[8 + 2 * e], S0[8 + 2 * e + 1]); }
        }
#pragma unroll
        for (int i = 0; i < 8; ++i) { __builtin_amdgcn_sched_group_barrier(0x008, 1, 0); __builtin_amdgcn_sched_group_barrier(0x002, 8, 0); }
    }
    __builtin_amdgcn_sched_barrier(0);
    if (BR == 1) {
#pragma unroll
        for (int rg = 0; rg < 4; ++rg) {
            float A = 2.f * (S0[4 * rg] + S0[4 * rg + 1] + S0[4 * rg + 2]) + S0[4 * rg + 3], B = S0[4 * rg + 3];
            A = quad_sum(A); B = quad_sum(B);
            const int jj = (key0 >> 2) + 2 * rg + h;
            if ((lane & 3) == 0) { __hip_atomic_fetch_add(imp_row + jj, A, __ATOMIC_RELAXED, __HIP_MEMORY_SCOPE_WORKGROUP);
                if (jj + 1 < 256) __hip_atomic_fetch_add(imp_row + jj + 1, B, __ATOMIC_RELAXED, __HIP_MEMORY_SCOPE_WORKGROUP); }
        }
    }
    bf16x8 av[8];
    if (BR >= 1) {
#pragma unroll
        for (int s = 0; s < 2; ++s)
#pragma unroll
            for (int dt = 0; dt < 4; ++dt) av[s * 4 + dt] = *(const LAS bf16x8*)(vb + (32 * dt + r31) * ROWB + 16 * ((cb0 + 2 * s) ^ vh));
    }
    const float mx1 = tile_prep<BR>(MODE, S1, tb, cb, base1, selbit);
    const float me1 = tile_decide<BR, true>(MODE, mx1, cb, selbit, O, m, l, pk0a, pk0b);
    __builtin_amdgcn_sched_barrier(0);
    {
        if (BR >= 1) {
#pragma unroll
            for (int dt = 0; dt < 4; ++dt) O[dt] = mfma32(av[dt], __builtin_bit_cast(bf16x8, pk0a), O[dt]);
#pragma unroll
            for (int dt = 0; dt < 4; ++dt) O[dt] = mfma32(av[4 + dt], __builtin_bit_cast(bf16x8, pk0b), O[dt]);
        }
        float ps = 0.f;
#pragma unroll
        for (int r = 0; r < 16; ++r) { float p = fexp2(S1[r] - me1); if (BR == 1) p *= inv_l; S1[r] = p; ps += p; }
        if (BR != 1) l += ps;
        if (BR >= 1) {
#pragma unroll
            for (int e = 0; e < 4; ++e) { pk1a[e] = cvt_pk_bf16(S1[2 * e], S1[2 * e + 1]); pk1b[e] = cvt_pk_bf16(S1[8 + 2 * e], S1[8 + 2 * e + 1]); }
#pragma unroll
            for (int i = 0; i < 8; ++i) { __builtin_amdgcn_sched_group_barrier(0x008, 1, 0); __builtin_amdgcn_sched_group_barrier(0x002, 8, 0); }
        }
    }
    __builtin_amdgcn_sched_barrier(0);
    if (BR == 1) {
#pragma unroll
        for (int rg = 0; rg < 4; ++rg) {
            float A = 2.f * (S1[4 * rg] + S1[4 * rg + 1] + S1[4 * rg + 2]) + S1[4 * rg + 3], B = S1[4 * rg + 3];
            A = quad_sum(A); B = quad_sum(B);
            const int jj = ((key0 + 32) >> 2) + 2 * rg + h;
            if ((lane & 3) == 0) { __hip_atomic_fetch_add(imp_row + jj, A, __ATOMIC_RELAXED, __HIP_MEMORY_SCOPE_WORKGROUP);
                if (jj + 1 < 256) __hip_atomic_fetch_add(imp_row + jj + 1, B, __ATOMIC_RELAXED, __HIP_MEMORY_SCOPE_WORKGROUP); }
        }
    }
    if (BR >= 1) {
#pragma unroll
        for (int s = 0; s < 2; ++s)
#pragma unroll
            for (int dt = 0; dt < 4; ++dt) av[s * 4 + dt] = *(const LAS bf16x8*)(vb + (32 * dt + r31) * ROWB + 16 * ((cb0 + 4 + 2 * s) ^ vh));
        __builtin_amdgcn_sched_barrier(0);
#pragma unroll
        for (int dt = 0; dt < 4; ++dt) O[dt] = mfma32(av[dt], __builtin_bit_cast(bf16x8, pk1a), O[dt]);
#pragma unroll
        for (int dt = 0; dt < 4; ++dt) O[dt] = mfma32(av[4 + dt], __builtin_bit_cast(bf16x8, pk1b), O[dt]);
    }
}
template <int BR, int KEYS>
__device__ __forceinline__ void run_branch(const Ctx& c, const bf16_t* Kb, const bf16_t* Vtb, int ldv, int lo, int hi, LAS const float* tb, int t, int t0,
                                           const bf16x8 (&qf)[8], f32x16 (&O)[4], float& m, float& l, float inv_l, int tl, LAS float* imp_row) {
    constexpr bool NEEDV = (BR != 0);
    constexpr int BPS = KEYS / 64, KSTG = KEYS * 256, VSTG = 128 * 2 * KEYS, VB0 = 2 * KSTG;
    LAS unsigned char* lds = c.lds;
    int lz = c.lane; asm volatile("" : "+v"(lz));
    const int nst = (hi - lo + BPS - 1) / BPS;
#define STG_BLK(i) ((lo + BPS * (i) + BPS - 1 < hi) ? lo + BPS * (i) : hi - BPS)
    asm volatile("s_waitcnt vmcnt(0)" ::: "memory");
    { const int b0 = (BPS == 2 && hi - lo < 2) ? lo : STG_BLK(0);
      stage_dma<KEYS, NEEDV>(Kb + (size_t)b0 * 64 * 128, Vtb + (size_t)b0 * 64, ldv, lds, lds + VB0, c.wave, lz); }
    asm volatile("s_waitcnt vmcnt(0)" ::: "memory");
    __syncthreads();
    const int qt = t0 >> 6;
    for (int i = 0; i < nst; ++i) {
        const int buf = i & 1;
        if (i + 1 < nst) { int lz2 = lz; asm volatile("" : "+v"(lz2));
            const int b1 = STG_BLK(i + 1);
            stage_dma<KEYS, NEEDV>(Kb + (size_t)b1 * 64 * 128, Vtb + (size_t)b1 * 64, ldv, lds + (buf ^ 1) * KSTG, lds + VB0 + (buf ^ 1) * VSTG, c.wave, lz2); }
        const int sb = (BPS == 2 && hi - lo < 2) ? lo : STG_BLK(i);
#pragma unroll
        for (int q = 0; q < BPS; ++q) {
            const int j = lo + BPS * i + q;
            if (j < hi) {
                bool selbit = true, wave_on = true;
                if (BR == 2) {
                    const unsigned w = *(const LAS unsigned*)(lds + AT_BM + (tl * 8 + (j >> 5)) * 4);
                    selbit = (w >> (j & 31)) & 1u;
                    const unsigned wu = *(const LAS unsigned*)(lds + AT_WU + (c.wave * 8 + (j >> 5)) * 4);
                    wave_on = (wu >> (j & 31)) & 1u;
                }
                if (wave_on) {
                    int mode = 0;
                    if (BR <= 1) mode = (1024 * j + 1829 <= t0) ? 1 : 0;
                    else if (BR == 2) mode = (64 * j + 853 <= t0) ? 1 : 0;
                    else mode = (j >= qt - 7 && j <= qt - 1) ? 2 : 0;
                    const int slot = j - sb;
                    attn_tile<BR, KEYS>(mode, lds + buf * KSTG + slot * 16384, lds + VB0 + buf * VSTG, 8 * slot, tb, j * 64, t, c.lane, qf, O, m, l, inv_l, selbit, imp_row);
                }
            }
        }
        asm volatile("s_waitcnt vmcnt(0)" ::: "memory");
        __syncthreads();
    }
#undef STG_BLK
}
__device__ __forceinline__ void attn_item(const Args& a, const Ctx& c_, int qt, int g) {
    Ctx c = c_; { int tz = c_.tid; asm volatile("" : "+v"(tz)); c.tid = tz; c.lane = tz & 63; }
    LAS unsigned char* lds = c.lds;
    const int tid = c.tid, wave = c.wave, lane = c.lane, r31 = lane & 31, h = lane >> 5, hl = lane & 3;
    const int t0 = qt * 64, tl = 8 * wave + (r31 >> 2), t = t0 + tl, head = g * 4 + hl;
    const bf16_t* Qb = (const bf16_t*)(a.ws + WS_Q);
    const bf16_t* KROW = (const bf16_t*)(a.ws + WS_KROW);
    const bf16_t* VT = (const bf16_t*)(a.ws + WS_VT);
    const float* GATE = (const float*)(a.ws + WS_GATE);
    { const float* tbg = (const float*)(a.ws + WS_TB) + g * 4 * TBN;
      for (int i = tid; i < 4 * TBN; i += NTHREADS) *(LAS float*)(lds + AT_TB + i * 4) = tbg[i];
      for (int i = tid; i < 64 * 256; i += NTHREADS) *(LAS float*)(lds + AT_IMP + i * 4) = 0.f; }
    bf16x8 qf[8];
#pragma unroll
    for (int ks = 0; ks < 8; ++ks) qf[ks] = *(const bf16x8*)(Qb + (size_t)t * 1024 + head * 128 + 16 * ks + 8 * h);
    LAS const float* tb = (LAS const float*)(lds + AT_TB) + hl * TBN;
    LAS float* imp_row = (LAS float*)(lds + AT_IMP) + tl * 256;
    bf16_t* Y = (bf16_t*)(a.ws + WS_YATT) + (size_t)t * 1024 + head * 128 + 4 * h;
    f32x16 O[4];
#pragma unroll
    for (int dt = 0; dt < 4; ++dt)
#pragma unroll
        for (int r = 0; r < 16; ++r) O[dt][r] = 0.f;
    __syncthreads();
    { const int ntile = (t0 / 16 + 3 + 63) / 64;
      const bf16_t* KC = (const bf16_t*)(a.ws + WS_KC) + (size_t)g * 1024 * 128; const bf16_t* VCT = (const bf16_t*)(a.ws + WS_VCT) + (size_t)g * 128 * 1024;
      float m = -INFINITY, l = 0.f;
#if defined(PROBE_CMP)
      run_branch<0, 64>(c, KC, VCT, 1024, 0, ntile, tb, t, t0, qf, O, m, l, 0.f, tl, imp_row);
      asm volatile("" :: "v"(m), "v"(l));
      m = -INFINITY; l = 0.f;
#endif
      run_branch<0, 64>(c, KC, VCT, 1024, 0, ntile, tb, t, t0, qf, O, m, l, 0.f, tl, imp_row);
      const float lt = xhalf_sum(l), inv = lt > 0.f ? 1.f / lt : 0.f;
      run_branch<1, 64>(c, KC, VCT, 1024, 0, ntile, tb, t, t0, qf, O, m, l, inv, tl, imp_row);
      const float gc = GATE[(size_t)t * 24 + head];
#pragma unroll
      for (int dt = 0; dt < 4; ++dt)
#pragma unroll
          for (int rg = 0; rg < 4; ++rg) {
              u32x2 w; w[0] = cvt_pk_bf16(gc * O[dt][4 * rg], gc * O[dt][4 * rg + 1]); w[1] = cvt_pk_bf16(gc * O[dt][4 * rg + 2], gc * O[dt][4 * rg + 3]);
              *(u32x2*)(Y + 32 * dt + 8 * rg) = w;
#pragma unroll
              for (int e = 0; e < 4; ++e) O[dt][4 * rg + e] = 0.f;
          }
    }
    {
        const int ncand = qt - 2 > 0 ? qt - 2 : 0;
        unsigned v[8][4], selm[8];
#pragma unroll
        for (int i = 0; i < 8; ++i) {
            LAS const float* row = (LAS const float*)(lds + AT_IMP) + (8 * wave + i) * 256;
            selm[i] = 0u;
#pragma unroll
            for (int k = 0; k < 4; ++k) { const int j = lane + 64 * k; const bool cand = (j >= 1 && j <= qt - 2);
                v[i][k] = cand ? ((__float_as_uint(row[j]) & ~0xFFu) | (unsigned)(255 - j)) : 0u; if (ncand <= 13 && cand) selm[i] |= 1u << k; }
        }
        if (ncand > 13) {
            for (int it = 0; it < 13; ++it) {
#pragma unroll
                for (int i = 0; i < 8; ++i) {
                    const unsigned mx = wave_umax_bcast(max(max(v[i][0], v[i][1]), max(v[i][2], v[i][3])));
#pragma unroll
                    for (int k = 0; k < 4; ++k) if (v[i][k] == mx) { v[i][k] = 0u; selm[i] |= 1u << k; }
                }
            }
        }
        unsigned wu[8];
#pragma unroll
        for (int k = 0; k < 8; ++k) wu[k] = 0u;
#pragma unroll
        for (int i = 0; i < 8; ++i)
#pragma unroll
            for (int k = 0; k < 4; ++k) {
                const int j = lane + 64 * k; const bool forced = (j == 0) || (j == qt) || (j == qt - 1);
                const unsigned long long mk = __ballot(((selm[i] >> k) & 1u) || forced);
                const unsigned lo = (unsigned)mk, hi = (unsigned)(mk >> 32);
                if (lane == 0) { *(LAS unsigned*)(lds + AT_BM + ((8 * wave + i) * 8 + 2 * k) * 4) = lo; *(LAS unsigned*)(lds + AT_BM + ((8 * wave + i) * 8 + 2 * k + 1) * 4) = hi; }
                wu[2 * k] |= lo; wu[2 * k + 1] |= hi;
            }
        if (lane == 0) {
#pragma unroll
            for (int k = 0; k < 8; ++k) *(LAS unsigned*)(lds + AT_WU + (wave * 8 + k) * 4) = wu[k];
        }
    }
    __syncthreads();
#if defined(PROBE_SEL)
    { float m = -INFINITY, l = 0.f;
      run_branch<2, 128>(c, KROW + (size_t)(2 + g) * L_ * 128, VT + (size_t)g * 128 * L_, L_, 0, qt + 1, tb, t, t0, qf, O, m, l, 0.f, tl, imp_row);
      asm volatile("" :: "v"(O[0]), "v"(O[1]), "v"(O[2]), "v"(O[3]), "v"(m), "v"(l));
#pragma unroll
      for (int dt = 0; dt < 4; ++dt)
#pragma unroll
          for (int r = 0; r < 16; ++r) O[dt][r] = 0.f; }
#endif
    { float m = -INFINITY, l = 0.f;
      run_branch<2, 128>(c, KROW + (size_t)(2 + g) * L_ * 128, VT + (size_t)g * 128 * L_, L_, 0, qt + 1, tb, t, t0, qf, O, m, l, 0.f, tl, imp_row);
      const float gs = GATE[(size_t)t * 24 + 8 + head];
      const float lt = xhalf_sum(l), sc = gs * (lt > 0.f ? 1.f / lt : 0.f);
#pragma unroll
      for (int dt = 0; dt < 4; ++dt)
#pragma unroll
          for (int rg = 0; rg < 4; ++rg) {
              const u32x2 w0 = *(const u32x2*)(Y + 32 * dt + 8 * rg);
              u32x2 w; w[0] = cvt_pk_bf16(bflo(w0[0]) + sc * O[dt][4 * rg], bfhi(w0[0]) + sc * O[dt][4 * rg + 1]); w[1] = cvt_pk_bf16(bflo(w0[1]) + sc * O[dt][4 * rg + 2], bfhi(w0[1]) + sc * O[dt][4 * rg + 3]);
              *(u32x2*)(Y + 32 * dt + 8 * rg) = w;
#pragma unroll
              for (int e = 0; e < 4; ++e) O[dt][4 * rg + e] = 0.f;
          }
    }
#if defined(PROBE_WIN)
    { float m = -INFINITY, l = 0.f;
      const int lo = qt - 8 > 0 ? qt - 8 : 0;
      run_branch<3, 128>(c, KROW + (size_t)(4 + g) * L_ * 128, VT + (size_t)(2 + g) * 128 * L_, L_, lo, qt + 1, tb, t, t0, qf, O, m, l, 0.f, tl, imp_row);
      asm volatile("" :: "v"(O[0]), "v"(O[1]), "v"(O[2]), "v"(O[3]), "v"(m), "v"(l));
#pragma unroll
      for (int dt = 0; dt < 4; ++dt)
#pragma unroll
          for (int r = 0; r < 16; ++r) O[dt][r] = 0.f; }
#endif
    { float m = -INFINITY, l = 0.f;
      const int lo = qt - 8 > 0 ? qt - 8 : 0;
      run_branch<3, 128>(c, KROW + (size_t)(4 + g) * L_ * 128, VT + (size_t)(2 + g) * 128 * L_, L_, lo, qt + 1, tb, t, t0, qf, O, m, l, 0.f, tl, imp_row);
      const float gw = GATE[(size_t)t * 24 + 16 + head];
      const float lt = xhalf_sum(l), sc = gw * (lt > 0.f ? 1.f / lt : 0.f);
#pragma unroll
      for (int dt = 0; dt < 4; ++dt)
#pragma unroll
          for (int rg = 0; rg < 4; ++rg) {
              const u32x2 w0 = *(const u32x2*)(Y + 32 * dt + 8 * rg);
              u32x2 w; w[0] = cvt_pk_bf16(bflo(w0[0]) + sc * O[dt][4 * rg], bfhi(w0[0]) + sc * O[dt][4 * rg + 1]); w[1] = cvt_pk_bf16(bflo(w0[1]) + sc * O[dt][4 * rg + 2], bfhi(w0[1]) + sc * O[dt][4 * rg + 3]);
              *(u32x2*)(Y + 32 * dt + 8 * rg) = w;
          }
    }
    __syncthreads();
}
#ifndef PEER_ALPHA
#define PEER_ALPHA 1.0f
#endif
constexpr int PE_SC = 0, PE_LV = 66048, PE_LI = 74240, PE_EX = 147456, PE_GT = 151552, PE_SU = 155648, PE_END = 159744;
constexpr int PE_SLOT = 3072, PE_NSLOT = 6, PE_RINGW = PE_SLOT * PE_NSLOT;
static_assert(8 * PE_RINGW <= PE_EX && PE_END <= LDS_BYTES - 16, "PEER LDS map");
__device__ __forceinline__ float wave_sum_bcast(float v) {
    v += dpp_f<0xB1>(v); v += dpp_f<0x4E>(v); v += dpp_f<0x141>(v); v += dpp_f<0x140>(v);
    v += __int_as_float(__builtin_amdgcn_update_dpp(0, __float_as_int(v), 0x142, 0xa, 0xf, false));
    v += __int_as_float(__builtin_amdgcn_update_dpp(0, __float_as_int(v), 0x143, 0xc, 0xf, false));
    return __int_as_float(__builtin_amdgcn_readlane(__float_as_int(v), 63));
}
__device__ __forceinline__ unsigned mono_key(float v) { const unsigned b = __float_as_uint(v); return b ^ ((b >> 31) ? 0xFFFFFFFFu : 0x80000000u); }
template <int CTRL>
__device__ __forceinline__ void quad_merge16(unsigned (&t)[16]) {
    unsigned o[16];
#pragma unroll
    for (int i = 0; i < 16; ++i) o[i] = (unsigned)__builtin_amdgcn_update_dpp(0, (int)t[15 - i], CTRL, 0xf, 0xf, false);
#pragma unroll
    for (int i = 0; i < 16; ++i) t[i] = max(t[i], o[i]);
#pragma unroll
    for (int st = 8; st >= 1; st >>= 1)
#pragma unroll
        for (int i = 0; i < 16; ++i) if ((i & st) == 0) { const unsigned hi = max(t[i], t[i + st]), lo = min(t[i], t[i + st]); t[i] = hi; t[i + st] = lo; }
}
__device__ __forceinline__ int pair_a(int p) { return p < 16 ? 0 : p < 24 ? 1 : p < 29 ? 2 : p < 33 ? 3 : p < 36 ? 4 : p < 38 ? 5 : p < 40 ? 6 : p < 42 ? 7 : p - 34; }
__device__ __forceinline__ int pair_b(int p) { return p < 16 ? p : p < 24 ? p - 16 : p < 29 ? p - 24 : p < 33 ? p - 29 : p < 36 ? p - 33 : p < 38 ? p - 36 : p < 40 ? p - 38 : p < 42 ? p - 40 : 0; }
template <bool DRY>
__device__ __forceinline__ void peer_step(const Args& a, const Ctx& c_, int t0) {
    Ctx c = c_; { int tz = c_.tid; asm volatile("" : "+v"(tz)); c.tid = tz; c.lane = tz & 63; }
    LAS unsigned char* lds = c.lds;
    const int tid = c.tid, wave = c.wave, lane = c.lane, r = lane & 15, q = lane >> 4;
    const bf16_t* QP = (const bf16_t*)(a.ws + WS_QP); const bf16_t* PK = (const bf16_t*)(a.ws + WS_PK);
    const unsigned char* PU = a.ws + WS_PU; const unsigned char* PV = a.ws + WS_PV; const float* psc = (const float*)(a.ws + WS_PSC);
    const bf16_t* HB = (const bf16_t*)(a.ws + WS_H);
    {
        const int hh = wave;
#pragma unroll
        for (int cc = 0; cc < 2; ++cc) {
            bf16x8 aF[4];
#pragma unroll
            for (int ks = 0; ks < 4; ++ks) aF[ks] = *(const bf16x8*)(QP + (size_t)(t0 + (r & 7)) * 2048 + hh * 256 + cc * 128 + 32 * ks + 8 * q);
#pragma unroll 2
            for (int nt = 0; nt < 8; ++nt) {
                f32x4 acc = {0.f, 0.f, 0.f, 0.f};
#pragma unroll
                for (int ks = 0; ks < 4; ++ks) { const bf16x8 B = *(const bf16x8*)(PK + (size_t)(cc * 128 + 16 * nt + r) * 128 + 32 * ks + 8 * q); acc = mfma16(aF[ks], B, acc); }
                if (q < 2) {
#pragma unroll
                    for (int i = 0; i < 4; ++i) { const int tok = 4 * q + i; *(LAS float*)(lds + PE_SC + ((tok * 16 + hh * 2 + cc) * 129 + 16 * nt + r) * 4) = acc[i]; }
                }
            }
        }
    }
    __syncthreads();
    {
        const int task = tid >> 2, part = tid & 3;
        LAS const float* sc = (LAS const float*)(lds + PE_SC) + task * 129;
        float vals[32];
#pragma unroll
        for (int k = 0; k < 32; ++k) vals[k] = sc[32 * part + k];
        unsigned top[16];
#pragma unroll
        for (int e = 0; e < 16; ++e) top[e] = 0u;
#pragma unroll
        for (int k = 0; k < 32; ++k) {
            unsigned key = (mono_key(vals[k]) & ~0x7Fu) | (unsigned)(127 - (32 * part + k));
#pragma unroll
            for (int e = 0; e < 16; ++e) { const unsigned hi = max(top[e], key); key = min(top[e], key); top[e] = hi; }
        }
        quad_merge16<0xB1>(top);
        quad_merge16<0x4E>(top);
        if (part == 0) {
#pragma unroll
            for (int e = 0; e < 16; ++e) { const int idx = 127 - (int)(top[e] & 0x7Fu); *(LAS float*)(lds + PE_LV + (task * 16 + e) * 4) = sc[idx]; *(LAS int*)(lds + PE_LI + (task * 16 + e) * 4) = idx; }
        }
    }
    __syncthreads();
    if (tid < 256) {
        const int task = tid >> 2, part = tid & 3, tok = task >> 3, hh = task & 7, t1 = tok * 16 + hh * 2, t2 = t1 + 1;
        LAS const float* lv1 = (LAS const float*)(lds + PE_LV) + t1 * 16; LAS const float* lv2 = (LAS const float*)(lds + PE_LV) + t2 * 16;
        unsigned top[16];
#pragma unroll
        for (int e = 0; e < 16; ++e) top[e] = 0u;
        for (int p = part; p < 50; p += 4) {
            const int aa = pair_a(p), bb = pair_b(p);
            unsigned key = (mono_key(lv1[aa] + lv2[bb]) & ~0xFFu) | (unsigned)(255 - (aa * 16 + bb));
#pragma unroll
            for (int e = 0; e < 16; ++e) { const unsigned hi = max(top[e], key); key = min(top[e], key); top[e] = hi; }
        }
        quad_merge16<0xB1>(top);
        quad_merge16<0x4E>(top);
        if (part == 0) {
            LAS const int* li1 = (LAS const int*)(lds + PE_LI) + t1 * 16; LAS const int* li2 = (LAS const int*)(lds + PE_LI) + t2 * 16;
            float sv[16]; int ex[16]; float mx = -INFINITY;
#pragma unroll
            for (int e = 0; e < 16; ++e) {
                const int id = 255 - (int)(top[e] & 0xFFu), aa = id >> 4, bb = id & 15;
                sv[e] = lv1[aa] + lv2[bb]; ex[e] = li1[aa] * 128 + li2[bb]; mx = fmaxf(mx, sv[e]);
            }
            float sum = 0.f;
#pragma unroll
            for (int e = 0; e < 16; ++e) { sv[e] = fexp2((sv[e] - mx) * LOG2E); sum += sv[e]; }
            const float inv = 1.f / sum;
#pragma unroll
            for (int e = 0; e < 16; ++e) { *(LAS int*)(lds + PE_EX + (tok * 128 + hh * 16 + e) * 4) = ex[e];
                *(LAS float*)(lds + PE_GT + (tok * 128 + hh * 16 + e) * 4) = sv[e] * inv * psc[16384 + ex[e]];
                *(LAS float*)(lds + PE_SU + (tok * 128 + hh * 16 + e) * 4) = psc[ex[e]]; }
        }
    }
    __syncthreads();
    const int t = t0 + wave;
    float hp[32];
#pragma unroll
    for (int k = 0; k < 4; ++k) { const u32x4 w = *(const u32x4*)(HB + (size_t)t * 2048 + lane * 32 + k * 8);
#pragma unroll
        for (int e = 0; e < 4; ++e) { hp[k * 8 + 2 * e] = bflo(w[e]); hp[k * 8 + 2 * e + 1] = bfhi(w[e]); } }
    float acc[32];
#pragma unroll
    for (int e = 0; e < 32; ++e) acc[e] = 0.f;
    asm volatile("s_waitcnt vmcnt(0)" ::: "memory");
    {
        LAS const int* exl = (LAS const int*)(lds + PE_EX) + wave * 128; LAS const float* gtl = (LAS const float*)(lds + PE_GT) + wave * 128;
        LAS unsigned char* ring = lds + wave * PE_RINGW;
        LAS const float* sul = (LAS const float*)(lds + PE_SU) + wave * 128;
#define ROW_ISSUE(SL, IDX) do { const int ex_ = __builtin_amdgcn_readfirstlane(exl[IDX]); \
            const unsigned char* gu_ = PU + (size_t)ex_ * 1536; const unsigned char* gv_ = PV + (size_t)ex_ * 1536; \
            LAS unsigned char* sl_ = ring + (SL) * PE_SLOT;                   \
            __builtin_amdgcn_global_load_lds((const unsigned*)(gu_ + lane * 16), (LAS unsigned*)sl_, 16, 0, 0); \
            __builtin_amdgcn_global_load_lds((const unsigned*)((lane < 32 ? gu_ + 1024 : gv_ - 512) + lane * 16), (LAS unsigned*)(sl_ + 1024), 16, 0, 0); \
            __builtin_amdgcn_global_load_lds((const unsigned*)(gv_ + 512 + lane * 16), (LAS unsigned*)(sl_ + 2048), 16, 0, 0); \
            } while (0)
#define ROW_APPLY(SL, IDX) do { LAS const unsigned char* sl_ = ring + (SL) * PE_SLOT + lane * 24; \
            const u32x2 a0_ = *(const LAS u32x2*)sl_, a1_ = *(const LAS u32x2*)(sl_ + 8), a2_ = *(const LAS u32x2*)(sl_ + 16); \
            const f32x32 uf_ = __builtin_amdgcn_cvt_scalef32_pk32_f32_fp6((u32x6){a0_[0], a0_[1], a1_[0], a1_[1], a2_[0], a2_[1]}, 1.0f); \
            float d0_ = 0.f, d1_ = 0.f; \
            _Pragma("unroll") for (int i = 0; i < 32; i += 2) { d0_ += uf_[i] * hp[i]; d1_ += uf_[i + 1] * hp[i + 1]; } \
            const float d_ = wave_sum_bcast(d0_ + d1_) * sul[IDX]; \
            const float wgt_ = gtl[IDX] * gelu_tanh(d_); \
            const u32x2 b0_ = *(const LAS u32x2*)(sl_ + 1536), b1_ = *(const LAS u32x2*)(sl_ + 1544), b2_ = *(const LAS u32x2*)(sl_ + 1552); \
            const f32x32 vf_ = __builtin_amdgcn_cvt_scalef32_pk32_f32_fp6((u32x6){b0_[0], b0_[1], b1_[0], b1_[1], b2_[0], b2_[1]}, 1.0f); \
            _Pragma("unroll") for (int i = 0; i < 32; ++i) acc[i] += wgt_ * vf_[i]; \
            asm volatile("s_waitcnt lgkmcnt(0)" ::: "memory"); } while (0)
#define DMA_WAIT(N) asm volatile("s_waitcnt vmcnt(" #N ")" ::: "memory")
        ROW_ISSUE(0, 0); ROW_ISSUE(1, 1); ROW_ISSUE(2, 2); ROW_ISSUE(3, 3); ROW_ISSUE(4, 4); ROW_ISSUE(5, 5);
#pragma unroll 1
        for (int e = 0; e < 126; e += 6) {
            const bool last = (e == 120);
            DMA_WAIT(15); ROW_APPLY(0, e);     ROW_ISSUE(0, e + 6);
            DMA_WAIT(15); ROW_APPLY(1, e + 1); ROW_ISSUE(1, e + 7);
            DMA_WAIT(15); ROW_APPLY(2, e + 2); if (!last) ROW_ISSUE(2, e + 8);
            if (last) DMA_WAIT(0); else DMA_WAIT(15);
            ROW_APPLY(3, e + 3); if (!last) ROW_ISSUE(3, e + 9);
            if (!last) DMA_WAIT(15);
            ROW_APPLY(4, e + 4); if (!last) ROW_ISSUE(4, e + 10);
            if (!last) DMA_WAIT(15);
            ROW_APPLY(5, e + 5); if (!last) ROW_ISSUE(5, e + 11);
        }
        ROW_APPLY(0, 126);
        ROW_APPLY(1, 127);
#undef ROW_ISSUE
#undef ROW_APPLY
#undef DMA_WAIT
    }
    {
        float* xo = a.out + (size_t)t * 2048; const bf16_t* x1p = (const bf16_t*)(a.ws + WS_X1) + (size_t)t * 2048; const float* g2 = (const float*)(a.ws + WS_COND) + 5 * 2048; const float* fg = a.in[32];
        float ss = 0.f;
#pragma unroll
        for (int k = 0; k < 8; ++k) {
            const int col = lane * 32 + k * 4;
            const u32x2 xw = *(const u32x2*)(x1p + col); const f32x4 gv = *(const f32x4*)(g2 + col);
            const float x1[4] = {bflo(xw[0]), bfhi(xw[0]), bflo(xw[1]), bfhi(xw[1])};
#pragma unroll
            for (int e = 0; e < 4; ++e) { const float x2 = x1[e] + PEER_ALPHA * gv[e] * acc[k * 4 + e]; acc[k * 4 + e] = x2; ss += x2 * x2; }
        }
        ss = wave_sum_bcast(ss);
        const float rstd = rsqrtf(ss * (1.f / 2048.f) + 1e-6f);
#pragma unroll
        for (int k = 0; k < 8; ++k) {
            const int col = lane * 32 + k * 4;
            const f32x4 fv = *(const f32x4*)(fg + col);
            f32x4 o;
#pragma unroll
            for (int e = 0; e < 4; ++e) o[e] = acc[k * 4 + e] * rstd * fv[e];
            if (!DRY || rstd == 123.456f) *(f32x4*)(xo + col) = o;
        }
    }
    __syncthreads();
}
constexpr int NPHASE = 14;
#ifndef DBG
#define DBG 0
#endif
__device__ __forceinline__ void dbg_final_norm(const Args& a, const Ctx& c, const float* src) {
    for (int t = c.bid * 8 + c.wave; t < L_; t += c.nb * 8) {
        const float* xr = src + (size_t)t * 2048 + c.lane * 4; float* o = a.out + (size_t)t * 2048 + c.lane * 4;
        f32x4 v[8]; float ss = 0.f;
#pragma unroll
        for (int j = 0; j < 8; ++j) { v[j] = *(const f32x4*)(xr + j * 256); ss += v[j][0] * v[j][0] + v[j][1] * v[j][1] + v[j][2] * v[j][2] + v[j][3] * v[j][3]; }
        ss = wave_sum(ss);
        const float rstd = rsqrtf(ss * (1.f / 2048.f) + 1e-6f);
#pragma unroll
        for (int j = 0; j < 8; ++j) { const f32x4 g = *(const f32x4*)(a.in[32] + j * 256 + c.lane * 4); *(f32x4*)(o + j * 256) = v[j] * rstd * g; }
    }
}

extern __shared__ __attribute__((aligned(16))) unsigned char smem[];

__global__ void __launch_bounds__(512, 2) fwd(Args a) {
    LAS unsigned char* lds = (LAS unsigned char*)smem;
    Ctx c; c.bid = blockIdx.x; c.nb = gridDim.x; c.tid = threadIdx.x; c.wave = __builtin_amdgcn_readfirstlane(threadIdx.x >> 6); c.lane = threadIdx.x & 63; c.lds = lds;
    volatile LAS unsigned* xbw = (volatile LAS unsigned*)(lds + LDS_BYTES - 16);
    if (c.tid < 4) xbw[c.tid] = 0u;
    __syncthreads();
    const int lo = a.ph_lo, hi = a.ph_hi;
    const bool multi = (hi - lo) > 1;
    XcdBarrier bar; bar.bar = (unsigned*)(a.ws + WS_CTL); bar.x = 0; bar.st = xbw;
    if (multi) bar = xcd_barrier_post((unsigned*)(a.ws + WS_CTL), xbw);
#ifndef PHASE_MASK
#define PHASE_MASK 0xFFFF
#endif
#if DBG == 1
#undef PHASE_MASK
#define PHASE_MASK 0x403
#elif DBG == 2 || DBG == 4 || DBG == 5
#undef PHASE_MASK
#define PHASE_MASK 0x4FF
#endif
#define IN(k) (((PHASE_MASK >> (k)) & 1) && lo <= (k) && (k) < hi)
#define REFRESH() do { int tz_ = threadIdx.x; asm volatile("" : "+v"(tz_)); c.tid = tz_; c.lane = tz_ & 63; c.wave = __builtin_amdgcn_readfirstlane(tz_ >> 6); } while (0)
#define SEAM(k) do { if (IN(k) && IN((k) + 1)) xcd_barrier(bar); } while (0)
#ifndef DUP
#define DUP -1
#endif
#define REP(k) for (int rep_ = 0; rep_ < ((DUP == (k)) ? 2 : 1); ++rep_)
#define DUP2(k, ...) do { __VA_ARGS__; if (DUP == (k)) { __syncthreads(); __VA_ARGS__; } } while (0)

    if (IN(0)) REP(0) { REFRESH(); p0_prologue(a, c); }
    SEAM(0);
    if (IN(1)) { REFRESH(); DUP2(1, p1_hnorm(a, c)); }
    SEAM(1);
    if (IN(2)) { REFRESH();
        pg8::StaticOrder S; S.init((const bf16_t*)(a.ws + WS_H), (const bf16_t*)(a.ws + WS_WIN), 2048, 2048, 2048, L_, DIN_PAD, c.nb, c.bid);
        EpiWin E{(bf16_t*)(a.ws + WS_US), (bf16_t*)(a.ws + WS_Q), (bf16_t*)(a.ws + WS_KROW), (bf16_t*)(a.ws + WS_VROW), (bf16_t*)(a.ws + WS_VT), (float*)(a.ws + WS_GATE)};
        DUP2(2, pg8::gemm_phase<EpiWin, pg8::StaticOrder>(lds, S, E));
    }
    SEAM(2);
    if (IN(3)) { REFRESH();
        DUP2(31, for (int it = c.bid; it < 256; it += c.nb) s5_item<0>(a, c, it >> 2, it & 3));
        __syncthreads();
        CmpOrder S{(const bf16_t*)(a.ws + WS_KROW), (const bf16_t*)(a.ws + WS_VROW), (const bf16_t*)(a.ws + WS_W1), 2048, 4096, 1024, c.nb, c.bid};
        EpiSlab E{(float*)(a.ws + WS_SLAB)};
        DUP2(32, pg8::gemm_phase<EpiSlab, CmpOrder>(lds, S, E));
    }
    SEAM(3);
    if (IN(4)) { REFRESH();
        DUP2(41, for (int it = c.bid; it < 64; it += c.nb) cmp_finish_item(a, c, it >> 5, it & 31));
        DUP2(42, for (int it = c.bid; it < 256; it += c.nb) s5_item<1>(a, c, it >> 2, it & 3));
    }
    SEAM(4);
    if (IN(5)) { REFRESH();
#if DBG == 5
        for (size_t i = (size_t)c.bid * NTHREADS + c.tid; i < (size_t)L_ * 1024 / 8; i += (size_t)c.nb * NTHREADS) *(u32x4*)((bf16_t*)(a.ws + WS_YSSM) + i * 8) = (u32x4){0u, 0u, 0u, 0u};
#else
        {
            pg8::StaticOrder S; S.init((const bf16_t*)(a.ws + WS_Z), (const bf16_t*)(a.ws + WS_WGLU), 1024, 1024, 1024, L_, 1024, c.nb, c.bid);
            EpiGlu E{(const bf16_t*)(a.ws + WS_Z), a.in[19], (bf16_t*)(a.ws + WS_YSSM)};
            DUP2(55, pg8::gemm_phase<EpiGlu, pg8::StaticOrder>(lds, S, E));
        }
#endif
        __syncthreads();
        REP(5)
#if DBG == 4
        for (size_t i = (size_t)c.bid * NTHREADS + c.tid; i < (size_t)L_ * 1024 / 8; i += (size_t)c.nb * NTHREADS) *(u32x4*)((bf16_t*)(a.ws + WS_YATT) + i * 8) = (u32x4){0u, 0u, 0u, 0u};
#else
        for (int it = c.bid; it < 512; it += c.nb) {
            const int rnd = it / c.nb;
            const int qt = (rnd & 1) ? 255 - (it % 256) : (it % 256), g = (it >> 8) & 1;
            attn_item(a, c, qt, g);
        }
#endif
    }
    SEAM(5);
    if (IN(6)) { REFRESH(); DUP2(6, p6_mixnorm(a, c)); }
    SEAM(6);
#define WOUT_GEMM(PM0) do { pg8::StaticOrder S; S.init((const bf16_t*)(a.ws + WS_H), (const bf16_t*)(a.ws + WS_WOUT), 2048, 2048, 2048, L_ / 2, 2048, c.nb, c.bid, PM0); \
        EpiWout E{a.in[0], (const float*)(a.ws + WS_COND) + 2 * 2048, (bf16_t*)(a.ws + WS_X1)}; pg8::gemm_phase<EpiWout, pg8::StaticOrder>(lds, S, E); __syncthreads(); } while (0)
#define WQ_GEMM(PM0) do { pg8::StaticOrder S; S.init((const bf16_t*)(a.ws + WS_H), (const bf16_t*)(a.ws + WS_WQ), 2048, 2048, 2048, L_ / 2, 2048, c.nb, c.bid, PM0); \
        EpiBf16 E{(bf16_t*)(a.ws + WS_QP), 2048}; pg8::gemm_phase<EpiBf16, pg8::StaticOrder>(lds, S, E); __syncthreads(); } while (0)
#define PEER_STEPS(FIRST, COUNT) do { for (int s_ = (FIRST) + c.bid; s_ < (FIRST) + (COUNT); s_ += c.nb) peer_step<false>(a, c, s_ * 8); } while (0)
    if (IN(7)) { REFRESH(); WOUT_GEMM(0); }
    SEAM(7);
    if (IN(8)) { REFRESH(); p8_h2norm(a, c, 0, L_ / 2); }
    SEAM(8);
    if (IN(9)) { REFRESH(); WQ_GEMM(0); }
    SEAM(9);
    if (IN(10)) { REFRESH();
        if ((c.bid >> 3) & 1) PEER_STEPS(0, 512);
        WOUT_GEMM(32);
        if (!((c.bid >> 3) & 1)) PEER_STEPS(0, 512); }
    SEAM(10);
    if (IN(11)) { REFRESH(); p8_h2norm(a, c, L_ / 2, L_ / 2); }
    SEAM(11);
    if (IN(12)) { REFRESH();
        if ((c.bid >> 3) & 1) PEER_STEPS(512, 512);
        WQ_GEMM(32);
        if (!((c.bid >> 3) & 1)) PEER_STEPS(512, 512); }
    SEAM(12);
    if (IN(13)) { REFRESH(); PEER_STEPS(1024, 1024); }
#undef WOUT_GEMM
#undef WQ_GEMM
#undef PEER_STEPS
#undef IN
#undef SEAM
}

#ifndef N_LAUNCHES
#define N_LAUNCHES 1
#endif
extern "C" void kernel_launch(void* const* d_in, const int* in_sizes, int n_in, void* d_out, int out_size, void* d_ws, size_t ws_size, hipStream_t stream) {
    static int grid = 0;
    if (grid == 0) {
        if (n_in != 33 || out_size != L_ * D_ || ws_size < WS_END) { fprintf(stderr, "kernel_launch: unexpected shapes (n_in %d, out %d, ws %zu < %zu); nothing launched\n", n_in, out_size, ws_size, (size_t)WS_END); grid = -1; return; }
        int dev = 0, cus = 0, per_cu = 0;
        if (hipGetDevice(&dev) != hipSuccess || hipDeviceGetAttribute(&cus, hipDeviceAttributeMultiprocessorCount, dev) != hipSuccess) { grid = -1; return; }
        if (hipFuncSetAttribute((const void*)fwd, hipFuncAttributeMaxDynamicSharedMemorySize, LDS_BYTES) != hipSuccess) { fprintf(stderr, "kernel_launch: hipFuncSetAttribute failed\n"); grid = -1; return; }
        if (hipOccupancyMaxActiveBlocksPerMultiprocessor(&per_cu, (const void*)fwd, NTHREADS, LDS_BYTES) != hipSuccess || per_cu < 1) { fprintf(stderr, "kernel_launch: occupancy query says %d\n", per_cu); (void)hipGetLastError(); grid = -1; return; }
        grid = cus;
    }
    if (grid < 0) return;
    (void)hipMemsetAsync((char*)d_ws + WS_CTL, 0, CTL_BYTES, stream);
    Args a{};
    for (int i = 0; i < 33; ++i) a.in[i] = (const float*)d_in[i];
    a.out = (float*)d_out; a.ws = (unsigned char*)d_ws;
    if (N_LAUNCHES == 1) { a.ph_lo = 0; a.ph_hi = NPHASE; hipLaunchKernelGGL(fwd, dim3(grid), dim3(NTHREADS), LDS_BYTES, stream, a); }
    else for (int p = 0; p < NPHASE; ++p) { a.ph_lo = p; a.ph_hi = p + 1; hipLaunchKernelGGL(fwd, dim3(grid), dim3(NTHREADS), LDS_BYTES, stream, a); }
}
```

```cpp
#include <hip/hip_runtime.h>
#include <stdint.h>
#include <stdio.h>

#define LAS __attribute__((address_space(3)))
typedef unsigned short bf16_t;
typedef short bf16x8 __attribute__((ext_vector_type(8)));
typedef float f32x2 __attribute__((ext_vector_type(2)));
typedef float f32x4 __attribute__((ext_vector_type(4)));
typedef float f32x16 __attribute__((ext_vector_type(16)));
typedef unsigned u32x2 __attribute__((ext_vector_type(2)));
typedef unsigned u32x4 __attribute__((ext_vector_type(4)));
typedef __bf16 bfv2 __attribute__((ext_vector_type(2)));
typedef unsigned u32x6 __attribute__((ext_vector_type(6)));
typedef float f32x32 __attribute__((ext_vector_type(32)));

constexpr int L_ = 16384, D_ = 2048, DSSM = 1024, DATT = 1024, DIN = 3608, DIN_PAD = 3840;
constexpr int NADA = 12288;
constexpr float LOG2E = 1.4426950408889634f;
constexpr float QSCALE = 0.08838834764831845f * 1.4426950408889634f;
constexpr int TBN = 800;
constexpr int NTHREADS = 512;
constexpr int LDS_BYTES = 163840;

constexpr size_t al256(size_t x) { return (x + 255) & ~(size_t)255; }
constexpr size_t WS_CTL   = 0;                                  constexpr size_t CTL_BYTES = 65536;
constexpr size_t WS_CONDP = WS_CTL + CTL_BYTES;
constexpr size_t WS_COND  = WS_CONDP + 32 * 12288 * 4;
constexpr size_t WS_TB    = WS_COND + 12288 * 4;
constexpr size_t WS_BPE   = al256(WS_TB + 8 * TBN * 4);
constexpr size_t WS_S5P   = al256(WS_BPE + 2 * 256 * 4);
constexpr size_t WS_S5F   = WS_S5P + 2 * 64 * 64 * 2 * 4;
constexpr size_t WS_S5MT  = WS_S5F + 64 * 4 * 128 * 4;
constexpr size_t WS_S5WE  = WS_S5MT + (size_t)64 * 256 * 256 * 2;
constexpr size_t WS_S5WC  = WS_S5WE + (size_t)64 * 128 * 256 * 2;
constexpr size_t WS_WIN   = WS_S5WC + (size_t)64 * 256 * 128 * 2;
constexpr size_t WS_WGLU  = WS_WIN + (size_t)DIN_PAD * 2048 * 2;
constexpr size_t WS_WOUT  = WS_WGLU + (size_t)1024 * 1024 * 2;
constexpr size_t WS_WQ    = WS_WOUT + (size_t)2048 * 2048 * 2;
constexpr size_t WS_W1    = WS_WQ + (size_t)2048 * 2048 * 2;
constexpr size_t WS_W2    = WS_W1 + (size_t)2 * 256 * 4096 * 2;
constexpr size_t WS_PK    = WS_W2 + (size_t)2 * 128 * 256 * 2;
constexpr size_t WS_PU    = WS_PK + (size_t)2 * 128 * 128 * 2;
constexpr size_t WS_PV    = WS_PU + (size_t)16384 * 1536;
constexpr size_t WS_PSC   = WS_PV + (size_t)16384 * 1536;
constexpr size_t WS_BPEP  = WS_PSC + (size_t)2 * 16384 * 4;
constexpr size_t WS_H     = WS_BPEP + (size_t)32 * 2 * 256 * 4;
constexpr size_t WS_US    = WS_H + (size_t)16384 * 2048 * 2;
constexpr size_t WS_Q     = WS_US + (size_t)16384 * 1024 * 2;
constexpr size_t WS_QP    = WS_US;
constexpr size_t WS_KROW  = WS_Q + (size_t)16384 * 1024 * 2;
constexpr size_t WS_VROW  = WS_KROW + (size_t)6 * 16384 * 128 * 2;
constexpr size_t WS_VT    = WS_VROW + (size_t)2 * 16384 * 128 * 2 + 8192;
constexpr size_t WS_GATE  = WS_VT + (size_t)4 * 128 * 16384 * 2;
constexpr size_t WS_SLAB  = WS_GATE + (size_t)16384 * 24 * 4;
constexpr size_t WS_KC    = WS_SLAB + (size_t)2 * 4 * 2048 * 256 * 4;
constexpr size_t WS_VCT   = WS_KC + (size_t)2 * 1024 * 128 * 2;
constexpr size_t WS_Z     = WS_VCT + (size_t)2 * 128 * 1024 * 2;
constexpr size_t WS_YSSM  = WS_Z + (size_t)16384 * 1024 * 2;
constexpr size_t WS_YATT  = WS_YSSM + (size_t)16384 * 1024 * 2;
constexpr size_t WS_X1    = WS_Z;
constexpr size_t WS_END   = WS_YATT + (size_t)16384 * 1024 * 2;
static_assert(WS_END < (size_t)530 * 1024 * 1024, "workspace map too large");

struct Args { const float* in[33]; float* out; unsigned char* ws; int ph_lo, ph_hi; };

__device__ __forceinline__ unsigned cvt_pk_bf16(float lo, float hi) { bfv2 v; v[0] = (__bf16)lo; v[1] = (__bf16)hi; return __builtin_bit_cast(unsigned, v); }
__device__ __forceinline__ bf16_t f2bf(float f) { return (bf16_t)(cvt_pk_bf16(f, 0.f) & 0xffffu); }
__device__ __forceinline__ float bf2f(unsigned b) { return __uint_as_float(b << 16); }
__device__ __forceinline__ float bflo(unsigned w) { return __uint_as_float(w << 16); }
__device__ __forceinline__ float bfhi(unsigned w) { return __uint_as_float(w & 0xffff0000u); }
__device__ __forceinline__ float fexp2(float x) { return __builtin_amdgcn_exp2f(x); }
__device__ __forceinline__ float frcp(float x) { return __builtin_amdgcn_rcpf(x); }
__device__ __forceinline__ float sigmoidf_(float x) { return frcp(1.f + fexp2(-LOG2E * x)); }
__device__ __forceinline__ float gelu_tanh(float x) {
    const float u = x * (1.f + 0.044715f * x * x);
    return x * frcp(1.f + fexp2(-2.f * 0.7978845608028654f * LOG2E * u));
}
__device__ __forceinline__ float shfl_xor_f(float v, int m) { return __shfl_xor(v, m, 64); }
__device__ __forceinline__ float wave_sum(float v) {
#pragma unroll
    for (int m = 32; m >= 1; m >>= 1) v += __shfl_xor(v, m, 64);
    return v;
}
__device__ __forceinline__ float wave_max(float v) {
#pragma unroll
    for (int m = 32; m >= 1; m >>= 1) v = fmaxf(v, __shfl_xor(v, m, 64));
    return v;
}
template <int CTRL> __device__ __forceinline__ float dpp_f(float x) { return __int_as_float(__builtin_amdgcn_update_dpp(0, __float_as_int(x), CTRL, 0xf, 0xf, false)); }
__device__ __forceinline__ float wave_max_bcast(float v) {
    v = fmaxf(v, dpp_f<0xB1>(v)); v = fmaxf(v, dpp_f<0x4E>(v)); v = fmaxf(v, dpp_f<0x141>(v)); v = fmaxf(v, dpp_f<0x140>(v));
    v = fmaxf(v, __int_as_float(__builtin_amdgcn_update_dpp(__float_as_int(v), __float_as_int(v), 0x142, 0xa, 0xf, false)));
    v = fmaxf(v, __int_as_float(__builtin_amdgcn_update_dpp(__float_as_int(v), __float_as_int(v), 0x143, 0xc, 0xf, false)));
    return __int_as_float(__builtin_amdgcn_readlane(__float_as_int(v), 63));
}
__device__ __forceinline__ unsigned wave_umax_bcast(unsigned v) {
#define UDPP_(x, ctrl, rm) (unsigned)__builtin_amdgcn_update_dpp((int)(x), (int)(x), ctrl, rm, 0xf, false)
    v = max(v, UDPP_(v, 0xB1, 0xf)); v = max(v, UDPP_(v, 0x4E, 0xf)); v = max(v, UDPP_(v, 0x141, 0xf)); v = max(v, UDPP_(v, 0x140, 0xf));
    v = max(v, UDPP_(v, 0x142, 0xa)); v = max(v, UDPP_(v, 0x143, 0xc));
#undef UDPP_
    return (unsigned)__builtin_amdgcn_readlane((int)v, 63);
}
__device__ __forceinline__ float quad_sum(float x) { x += dpp_f<0xB1>(x); x += dpp_f<0x4E>(x); return x; }
__device__ __forceinline__ f32x4 mfma16(bf16x8 a, bf16x8 b, f32x4 c) { return __builtin_amdgcn_mfma_f32_16x16x32_bf16(a, b, c, 0, 0, 0); }
__device__ __forceinline__ f32x16 mfma32(bf16x8 a, bf16x8 b, f32x16 c) { return __builtin_amdgcn_mfma_f32_32x32x16_bf16(a, b, c, 0, 0, 0); }
#define XB_TMO      128
#define XB_XCNT(j)  (256  + 64 * (j))
#define XB_XSUB(j)  (1280 + 64 * (j))
#define XB_XGEN(j)  (2304 + 64 * (j))
#define XB_TOP      3328
#define XB_TOPGEN   3392
#define XCD_BAR_WORDS 3456
#define XB_SPIN_CAP (1u << 18)

__device__ __forceinline__ unsigned xb_ld(unsigned* p)              { return __hip_atomic_load(p, __ATOMIC_RELAXED, __HIP_MEMORY_SCOPE_AGENT); }
__device__ __forceinline__ unsigned xb_add(unsigned* p, unsigned v) { return __hip_atomic_fetch_add(p, v, __ATOMIC_RELAXED, __HIP_MEMORY_SCOPE_AGENT); }
__device__ __forceinline__ unsigned xb_xcc_id() { return (unsigned)__builtin_amdgcn_s_getreg((3 << 11) | 20) & 0xFu; }
#define XB_SPIN(cond, bar) do { unsigned _sp = 0; while (cond) { __builtin_amdgcn_s_sleep(1); \
    if ((++_sp & 255u) == 0u) { if (xb_ld(&(bar)[XB_TMO])) break; if (_sp > XB_SPIN_CAP) { atomicAdd(&(bar)[XB_TMO], 1u); break; } } } } while (0)

struct XcdBarrier {
    unsigned* bar; unsigned x;
    volatile LAS unsigned* st;
};
__device__ __forceinline__ XcdBarrier xcd_barrier_post(unsigned* bar, volatile LAS unsigned* st) {
    XcdBarrier b; b.bar = bar; b.x = xb_xcc_id(); b.st = st;
    if (threadIdx.x == 0) (void)xb_add(&bar[XB_XCNT(b.x)], 1u);
    return b;
}
__device__ __forceinline__ void xcd_barrier_complete(unsigned* bar, unsigned x, unsigned& nloc, unsigned& nx) {
    const unsigned G = gridDim.x * gridDim.y * gridDim.z;
    unsigned sum, cnt, mine, sp = 0u;
    for (;;) {
        sum = 0u; cnt = 0u; mine = 0u;
#pragma unroll
        for (unsigned j = 0; j < 16; ++j) { const unsigned c = xb_ld(&bar[XB_XCNT(j)]); sum += c; cnt += (c > 0u) ? 1u : 0u; mine = (j == x) ? c : mine; }
        if (sum == G) break;
        __builtin_amdgcn_s_sleep(1);
        if ((++sp & 255u) == 0u) { if (xb_ld(&bar[XB_TMO])) break; if (sp > XB_SPIN_CAP) { atomicAdd(&bar[XB_TMO], 1u); break; } }
    }
    nloc = mine > 0u ? mine : 1u; nx = cnt > 0u ? cnt : 1u;
}
__device__ __forceinline__ void xcd_barrier(const XcdBarrier& b) {
    asm volatile("s_waitcnt vmcnt(0)" ::: "memory");
    __syncthreads();
    if (threadIdx.x == 0) {
        unsigned* bar = b.bar;
        __builtin_amdgcn_s_waitcnt(0);
        unsigned nloc = b.st[0], nx = b.st[1];
        if (nloc == 0u) { xcd_barrier_complete(bar, b.x, nloc, nx); b.st[0] = nloc; b.st[1] = nx; }
        const unsigned old = xb_add(&bar[XB_XSUB(b.x)], 1u);
        const unsigned gen = old / nloc;
        if (old + 1u == (gen + 1u) * nloc) {
            __builtin_amdgcn_fence(__ATOMIC_RELEASE, "agent");
            asm volatile("s_waitcnt vmcnt(0)" ::: "memory");
            const unsigned og = xb_add(&bar[XB_TOP], 1u);
            const unsigned tg = og / nx;
            if (og + 1u == (tg + 1u) * nx) xb_add(&bar[XB_TOPGEN], 1u);
            else XB_SPIN(xb_ld(&bar[XB_TOPGEN]) == tg, bar);
            __builtin_amdgcn_fence(__ATOMIC_ACQUIRE, "agent");
            xb_add(&bar[XB_XGEN(b.x)], 1u);
            asm volatile("s_waitcnt vmcnt(0)" ::: "memory");
        } else {
            XB_SPIN(xb_ld(&bar[XB_XGEN(b.x)]) == gen, bar);
            __builtin_amdgcn_fence(__ATOMIC_ACQUIRE, "agent");
            asm volatile("s_waitcnt vmcnt(0)" ::: "memory");
        }
    }
    __syncthreads();
}

namespace pg8 {
constexpr int BM = 256, BK = 64, HALF = 128, HTB = HALF * BK * 2, STAGE_BYTES = 8 * HTB, NXCD = 8, WGM = 8;
__host__ __device__ __forceinline__ int lds_byte(int r, int c) { const int st = (r >> 4) * 2 + (c >> 5), rr = r & 15, cc = c & 31, ob = rr * 64 + cc * 2; return st * 1024 + (ob ^ (((ob >> 9) & 1) << 5)); }
__host__ __device__ __forceinline__ void stage_rc(int b, int& R, int& C) { const int st = b / 1024, sb = b % 1024, swz = sb ^ (((sb >> 9) & 1) << 5); R = (st >> 1) * 16 + swz / 64; C = (st & 1) * 32 + (swz % 64) / 2; }
__host__ __device__ __forceinline__ int perm32(int rho) { const int n = rho >> 4, i = rho & 15; return 8 * (i >> 2) + 4 * n + (i & 3); }

struct Unit { int pm, pn, z; };
struct StaticOrder {
    const bf16_t* A; const bf16_t* Bt; int lda, ldb, K;
    int nM, nN, nwg, G, c, pm0;
    __device__ void init(const bf16_t* A_, const bf16_t* Bt_, int lda_, int ldb_, int K_, int M, int N, int G_, int c_, int pm0_ = 0) { A = A_; Bt = Bt_; lda = lda_; ldb = ldb_; K = K_; nM = M / BM; nN = N / BM; nwg = nM * nN; G = G_; c = c_; pm0 = pm0_; }
    __device__ bool next(int i, Unit& u) const {
        const long Lx = (long)i * G + c; if (Lx >= nwg) return false;
        int wgid = (int)Lx; { const int q = nwg / NXCD, r = nwg % NXCD, xcd = wgid % NXCD, off = wgid / NXCD; wgid = (xcd < r ? xcd * (q + 1) : r * (q + 1) + (xcd - r) * q) + off; }
        const int nig = WGM * nN, gid = wgid / nig, fm = gid * WGM, gsz = (nM - fm) < WGM ? (nM - fm) : WGM;
        u.pm = pm0 + fm + ((wgid % nig) % gsz); u.pn = (wgid % nig) / gsz; u.z = 0; return true;
    }
    __device__ __forceinline__ const char* a_base(const Unit& u) const { return (const char*)(A + (size_t)u.pm * BM * lda); }
    __device__ __forceinline__ const char* b_base(const Unit& u) const { return (const char*)(Bt + (size_t)u.pn * BM * ldb); }
};

template <class Epi, class Sched>
__device__ __forceinline__ void gemm_phase(LAS unsigned char* lds, const Sched& S, const Epi& E) {
    const int tid = threadIdx.x, wid = __builtin_amdgcn_readfirstlane(tid >> 6), lane = tid & 63, wr = wid >> 2, wc = wid & 3, fr = lane & 15, fq = lane >> 4;
    const int K = S.K, nt = K / BK, lda = S.lda, ldb = S.ldb;
    unsigned voffA[2], voffB[2];
#pragma unroll
    for (int i = 0; i < 2; ++i) { int R, C; stage_rc(tid * 16 + i * 8192, R, C); const int Rb = Epi::PERM ? ((R & ~31) + perm32(R & 31)) : R;
        voffA[i] = (unsigned)(R * lda + C) * 2u; voffB[i] = (unsigned)(Rb * ldb + C) * 2u; }
    const size_t kstep = (size_t)(BK * 2);
    const size_t hstepA = (size_t)HALF * lda * 2, hstepB = (size_t)HALF * ldb * 2;
    const unsigned ldsw = (unsigned)wid * 1024u;
    const int aoff = lds_byte(wr * 64 + fr, fq * 8), boff = lds_byte(wc * 32 + fr, fq * 8);
#define PG8_SA(b, h) (((b) * 2 + (h)) * HTB)
#define PG8_SB(b, h) ((4 + (b) * 2 + (h)) * HTB)
#define PG8_STAGE(bufoff, gbase, voff) do { _Pragma("unroll") for (int _i = 0; _i < 2; ++_i) \
        __builtin_amdgcn_global_load_lds((const unsigned*)((const char*)(gbase) + (voff)[_i]), (LAS unsigned*)(lds + (bufoff) + ldsw + _i * 8192), 16, 0, 0); } while (0)
#define PG8_LDA(dst, b, h) do { _Pragma("unroll") for (int m = 0; m < 4; ++m) _Pragma("unroll") for (int k = 0; k < 2; ++k) dst[m][k] = *(const LAS bf16x8*)(lds + PG8_SA(b, h) + aoff + m * 2048 + k * 1024); } while (0)
#define PG8_LDB(dst, b, h) do { _Pragma("unroll") for (int n = 0; n < 2; ++n) _Pragma("unroll") for (int k = 0; k < 2; ++k) dst[n][k] = *(const LAS bf16x8*)(lds + PG8_SB(b, h) + boff + n * 2048 + k * 1024); } while (0)
#define PG8_MMA(ai, bj, At, Bt) do { __builtin_amdgcn_s_setprio(1); _Pragma("unroll") for (int m = 0; m < 4; ++m) _Pragma("unroll") for (int n = 0; n < 2; ++n) _Pragma("unroll") for (int k = 0; k < 2; ++k) \
        acc[ai][bj][m][n] = __builtin_amdgcn_mfma_f32_16x16x32_bf16(Bt[n][k], At[m][k], acc[ai][bj][m][n], 0, 0, 0); __builtin_amdgcn_s_setprio(0); } while (0)
#define PG8_WAIT_V(n) asm volatile("s_waitcnt vmcnt(" #n ")" ::: "memory")
#define PG8_WAIT_L(n) asm volatile("s_waitcnt lgkmcnt(" #n ")" ::: "memory")
#define PG8_BAR __builtin_amdgcn_s_barrier()
#define PG8_SCHED __builtin_amdgcn_sched_barrier(0)
    Unit cur, nxt; int ui = 0;
    if (!S.next(0, cur)) return;
    f32x4 acc[2][2][4][2];
#pragma unroll
    for (int a = 0; a < 2; ++a)
#pragma unroll
        for (int b = 0; b < 2; ++b)
#pragma unroll
            for (int m = 0; m < 4; ++m)
#pragma unroll
                for (int n = 0; n < 2; ++n) acc[a][b][m][n] = (f32x4){0.f, 0.f, 0.f, 0.f};
    bf16x8 At[4][2], B0[2][2], B1[2][2];
    const char* cA = S.a_base(cur); const char* cB = S.b_base(cur);
    PG8_STAGE(PG8_SB(0, 0), cB, voffB); PG8_STAGE(PG8_SA(0, 0), cA, voffA); PG8_STAGE(PG8_SB(0, 1), cB + hstepB, voffB); PG8_STAGE(PG8_SA(0, 1), cA + hstepA, voffA);
    if (wr == 1) PG8_BAR;
    PG8_WAIT_V(4); PG8_BAR;
    PG8_STAGE(PG8_SB(1, 0), cB + kstep, voffB); PG8_STAGE(PG8_SA(1, 0), cA + kstep, voffA); PG8_STAGE(PG8_SB(1, 1), cB + hstepB + kstep, voffB);
    PG8_WAIT_V(6); PG8_BAR;
    for (;;) {
        const bool has_next = S.next(ui + 1, nxt);
        const char* nA = has_next ? S.a_base(nxt) : cA; const char* nB = has_next ? S.b_base(nxt) : cB;
        for (int t = 0; t < nt; t += 2) {
            const bool last = (t == nt - 2);
            const char* a1 = cA + (size_t)(t + 1) * kstep;
            const char* a2 = last ? nA : cA + (size_t)(t + 2) * kstep; const char* b2 = last ? nB : cB + (size_t)(t + 2) * kstep;
            const char* a3 = a2 + kstep; const char* b3 = b2 + kstep;
            PG8_LDB(B0, 0, 0); PG8_SCHED; PG8_LDA(At, 0, 0); PG8_STAGE(PG8_SA(1, 1), a1 + hstepA, voffA);
            PG8_WAIT_L(8); PG8_BAR; PG8_WAIT_L(0); PG8_MMA(0, 0, At, B0); PG8_BAR; PG8_SCHED;
            PG8_LDB(B1, 0, 1); PG8_STAGE(PG8_SB(0, 0), b2, voffB);
            PG8_BAR; PG8_WAIT_L(0); PG8_MMA(0, 1, At, B1); PG8_BAR;
            PG8_LDA(At, 0, 1); PG8_STAGE(PG8_SA(0, 0), a2, voffA);
            PG8_BAR; PG8_WAIT_L(0); PG8_MMA(1, 0, At, B0); PG8_BAR; PG8_SCHED;
            PG8_STAGE(PG8_SB(0, 1), b2 + hstepB, voffB);
            PG8_WAIT_V(6); PG8_BAR; PG8_MMA(1, 1, At, B1); PG8_BAR;
            PG8_LDB(B0, 1, 0); PG8_SCHED; PG8_LDA(At, 1, 0); PG8_STAGE(PG8_SA(0, 1), a2 + hstepA, voffA);
            PG8_WAIT_L(8); PG8_BAR; PG8_WAIT_L(0); PG8_MMA(0, 0, At, B0); PG8_BAR; PG8_SCHED;
            PG8_LDB(B1, 1, 1); PG8_STAGE(PG8_SB(1, 0), b3, voffB);
            PG8_BAR; PG8_WAIT_L(0); PG8_MMA(0, 1, At, B1); PG8_BAR;
            PG8_LDA(At, 1, 1); PG8_STAGE(PG8_SA(1, 0), a3, voffA);
            PG8_BAR; PG8_WAIT_L(0); PG8_MMA(1, 0, At, B0); PG8_BAR; PG8_SCHED;
            PG8_STAGE(PG8_SB(1, 1), b3 + hstepB, voffB);
            PG8_WAIT_V(6); PG8_BAR; PG8_MMA(1, 1, At, B1); PG8_BAR;
        }
        E(acc, cur, wr, wc, fr, fq);
        if (!has_next) break;
#pragma unroll
        for (int a = 0; a < 2; ++a)
#pragma unroll
            for (int b = 0; b < 2; ++b)
#pragma unroll
                for (int m = 0; m < 4; ++m)
#pragma unroll
                    for (int n = 0; n < 2; ++n) acc[a][b][m][n] = (f32x4){0.f, 0.f, 0.f, 0.f};
        cur = nxt; cA = nA; cB = nB; ++ui;
    }
    PG8_WAIT_V(0);
    if (wr == 0) PG8_BAR;
    PG8_BAR;
#undef PG8_SA
#undef PG8_SB
#undef PG8_STAGE
#undef PG8_LDA
#undef PG8_LDB
#undef PG8_MMA
#undef PG8_WAIT_V
#undef PG8_WAIT_L
#undef PG8_BAR
#undef PG8_SCHED
}
}
using pg8::Unit;
__device__ __forceinline__ u32x4 pack8(const f32x4& v0, const f32x4& v1) {
    u32x4 o; o[0] = cvt_pk_bf16(v0[0], v0[1]); o[1] = cvt_pk_bf16(v0[2], v0[3]); o[2] = cvt_pk_bf16(v1[0], v1[1]); o[3] = cvt_pk_bf16(v1[2], v1[3]); return o;
}
struct EpiWin {
    static constexpr bool PERM = true;
    bf16_t* US; bf16_t* Q; bf16_t* KROW; bf16_t* VROW; bf16_t* VT; float* GATE;
    __device__ __forceinline__ void operator()(const f32x4 (&acc)[2][2][4][2], const Unit& u, int wr, int wc, int fr, int fq) const {
        const int row0 = u.pm * 256 + wr * 64 + fr; const int pn = u.pn;
#pragma unroll
        for (int ai = 0; ai < 2; ++ai)
#pragma unroll
            for (int m = 0; m < 4; ++m) {
                const int row = row0 + ai * 128 + m * 16;
#pragma unroll
                for (int bj = 0; bj < 2; ++bj) {
                    const f32x4 v0 = acc[ai][bj][m][0], v1 = acc[ai][bj][m][1];
                    const int cin = bj * 128 + wc * 32 + 8 * fq;
                    if (pn < 4) { *(u32x4*)(US + (size_t)row * 1024 + pn * 256 + cin) = pack8(v0, v1); }
                    else if (pn < 8) { *(u32x4*)(Q + (size_t)row * 1024 + (pn - 4) * 256 + cin) = pack8(v0 * QSCALE, v1 * QSCALE); }
                    else if (pn < 14) {
                        const int kvi = pn - 8, branch = kvi >> 1, kvsel = kvi & 1, g = bj, d0 = wc * 32 + 8 * fq;
                        if (kvsel == 0) { *(u32x4*)(KROW + ((size_t)(branch * 2 + g) * L_ + row) * 128 + d0) = pack8(v0, v1); }
                        else if (branch == 0) { *(u32x4*)(VROW + ((size_t)g * L_ + row) * 128 + d0) = pack8(v0, v1); }
                        else {
                            bf16_t* vt = VT + ((size_t)((branch - 1) * 2 + g) * 128 + d0) * L_ + ((row & ~12) | ((row & 4) << 1) | ((row & 8) >> 1));
#pragma unroll
                            for (int e = 0; e < 4; ++e) { vt[(size_t)e * L_] = f2bf(v0[e]); vt[(size_t)(e + 4) * L_] = f2bf(v1[e]); }
                        }
                    } else {
                        if (cin < 24) {
                            float* gp = GATE + (size_t)row * 24 + cin;
                            f32x4 s0, s1;
#pragma unroll
                            for (int e = 0; e < 4; ++e) { s0[e] = sigmoidf_(v0[e]); s1[e] = sigmoidf_(v1[e]); }
                            *(f32x4*)gp = s0; *(f32x4*)(gp + 4) = s1;
                        }
                    }
                }
            }
    }
};
struct EpiGlu {
    static constexpr bool PERM = true;
    const bf16_t* Z; const float* bglu; bf16_t* Y;
    __device__ __forceinline__ void operator()(const f32x4 (&acc)[2][2][4][2], const Unit& u, int wr, int wc, int fr, int fq) const {
        const int row0 = u.pm * 256 + wr * 64 + fr;
#pragma unroll
        for (int bj = 0; bj < 2; ++bj) {
            const int col = u.pn * 256 + bj * 128 + wc * 32 + 8 * fq;
            const f32x4 b0 = *(const f32x4*)(bglu + col), b1 = *(const f32x4*)(bglu + col + 4);
#pragma unroll
            for (int ai = 0; ai < 2; ++ai)
#pragma unroll
                for (int m = 0; m < 4; ++m) {
                    const int row = row0 + ai * 128 + m * 16;
                    const u32x4 zz = *(const u32x4*)(Z + (size_t)row * 1024 + col);
                    const f32x4 v0 = acc[ai][bj][m][0] + b0, v1 = acc[ai][bj][m][1] + b1;
                    f32x4 o0, o1;
                    o0[0] = bflo(zz[0]) * sigmoidf_(v0[0]); o0[1] = bfhi(zz[0]) * sigmoidf_(v0[1]); o0[2] = bflo(zz[1]) * sigmoidf_(v0[2]); o0[3] = bfhi(zz[1]) * sigmoidf_(v0[3]);
                    o1[0] = bflo(zz[2]) * sigmoidf_(v1[0]); o1[1] = bfhi(zz[2]) * sigmoidf_(v1[1]); o1[2] = bflo(zz[3]) * sigmoidf_(v1[2]); o1[3] = bfhi(zz[3]) * sigmoidf_(v1[3]);
                    *(u32x4*)(Y + (size_t)row * 1024 + col) = pack8(o0, o1);
                }
        }
    }
};
struct EpiWout {
    static constexpr bool PERM = true;
    const float* X; const float* g1; bf16_t* X1;
    __device__ __forceinline__ void operator()(const f32x4 (&acc)[2][2][4][2], const Unit& u, int wr, int wc, int fr, int fq) const {
        const int row0 = u.pm * 256 + wr * 64 + fr, col0 = u.pn * 256 + wc * 32 + 8 * fq;
#pragma unroll
        for (int bj = 0; bj < 2; ++bj) {
            const int col = col0 + bj * 128;
            const f32x4 g0 = *(const f32x4*)(g1 + col), g4 = *(const f32x4*)(g1 + col + 4);
#pragma unroll
            for (int ai = 0; ai < 2; ++ai)
#pragma unroll
                for (int m = 0; m < 4; ++m) {
                    const size_t off = (size_t)(row0 + ai * 128 + m * 16) * 2048 + col;
                    const f32x4 x0 = *(const f32x4*)(X + off), x4 = *(const f32x4*)(X + off + 4);
                    *(u32x4*)(X1 + off) = pack8(x0 + g0 * acc[ai][bj][m][0], x4 + g4 * acc[ai][bj][m][1]);
                }
        }
    }
};
struct EpiBf16 {
    static constexpr bool PERM = true;
    bf16_t* O; int ldc;
    __device__ __forceinline__ void operator()(const f32x4 (&acc)[2][2][4][2], const Unit& u, int wr, int wc, int fr, int fq) const {
        const int row0 = u.pm * 256 + wr * 64 + fr, col0 = u.pn * 256 + wc * 32 + 8 * fq;
#pragma unroll
        for (int ai = 0; ai < 2; ++ai)
#pragma unroll
            for (int m = 0; m < 4; ++m)
#pragma unroll
                for (int bj = 0; bj < 2; ++bj)
                    *(u32x4*)(O + (size_t)(row0 + ai * 128 + m * 16) * ldc + col0 + bj * 128) = pack8(acc[ai][bj][m][0], acc[ai][bj][m][1]);
    }
};
struct EpiSlab {
    static constexpr bool PERM = false;
    float* SL;
    __device__ __forceinline__ void operator()(const f32x4 (&acc)[2][2][4][2], const Unit& u, int wr, int wc, int fr, int fq) const {
        float* base = SL + (size_t)u.z * 2048 * 256;
        const int row0 = u.pm * 256 + wr * 64 + fr, col0 = wc * 32 + 4 * fq;
#pragma unroll
        for (int ai = 0; ai < 2; ++ai)
#pragma unroll
            for (int m = 0; m < 4; ++m)
#pragma unroll
                for (int bj = 0; bj < 2; ++bj)
#pragma unroll
                    for (int n = 0; n < 2; ++n)
                        *(f32x4*)(base + (size_t)(row0 + ai * 128 + m * 16) * 256 + col0 + bj * 128 + n * 16) = acc[ai][bj][m][n];
    }
};
struct CmpOrder {
    const bf16_t* KROW; const bf16_t* VROW; const bf16_t* W1; int lda, ldb, K; int G, c;
    __device__ bool next(int i, Unit& u) const {
        const int x = i * G + c; if (x >= 64) return false;
        const int kvsel = x >> 5, pm = (x & 31) >> 2, ks = x & 3; u.pm = pm; u.pn = 0; u.z = kvsel * 4 + ks; return true;
    }
    __device__ __forceinline__ const char* a_base(const Unit& u) const { return (const char*)(((u.z >> 2) ? VROW : KROW) + (size_t)u.pm * 256 * 2048 + (u.z & 3) * 1024); }
    __device__ __forceinline__ const char* b_base(const Unit& u) const { return (const char*)(W1 + (size_t)(u.z >> 2) * 256 * 4096 + (u.z & 3) * 1024); }
};
struct Ctx { int bid, nb, tid, wave, lane; LAS unsigned char* lds; };

__device__ __forceinline__ void p0_cond(const Args& a, const Ctx& c) {
    const float* cv = a.in[1]; const float* w = a.in[2]; float* condp = (float*)(a.ws + WS_CONDP);
    for (int u = c.bid * 8 + c.wave; u < 1536; u += c.nb * 8) {
        const int cc = u % 48, kc = u / 48;
        const float* wp = w + (size_t)(kc * 64) * NADA + cc * 256 + c.lane * 4;
        f32x4 acc = {0.f, 0.f, 0.f, 0.f};
#pragma unroll 16
        for (int k = 0; k < 64; ++k) { const float x = cv[kc * 64 + k]; const float s = x / (1.f + __expf(-x)); acc += s * *(const f32x4*)(wp + (size_t)k * NADA); }
        *(f32x4*)(condp + (size_t)kc * NADA + cc * 256 + c.lane * 4) = acc;
    }
}
__device__ __forceinline__ void conv_T(const float* src, int K, int N, bf16_t* dst, int Npad, const Ctx& c) {
    LAS float* tile = (LAS float*)c.lds;
    const int nkt = K / 64, ntiles = nkt * (Npad / 64);
    const int r = c.tid >> 4, c4 = c.tid & 15;
    f32x4 v[2];
#define CONVT_LD(tix_) do { const int nt_ = (tix_) / nkt, kt_ = (tix_) % nkt, n_ = nt_ * 64 + 4 * c4; _Pragma("unroll") for (int i = 0; i < 2; ++i) { const int k_ = kt_ * 64 + r + 32 * i; v[i] = (f32x4){0.f, 0.f, 0.f, 0.f}; if (n_ < N) v[i] = *(const f32x4*)(src + (size_t)k_ * N + n_); } } while (0)
    if (c.bid < ntiles) CONVT_LD(c.bid);
    for (int tix = c.bid; tix < ntiles; tix += c.nb) {
        const int nt = tix / nkt, kt = tix % nkt;
#pragma unroll
        for (int i = 0; i < 2; ++i) { LAS float* tp = tile + (r + 32 * i) * 65 + 4 * c4; tp[0] = v[i][0]; tp[1] = v[i][1]; tp[2] = v[i][2]; tp[3] = v[i][3]; }
        __syncthreads();
        if (tix + c.nb < ntiles) CONVT_LD(tix + c.nb);
        { const int n = c.tid >> 3, kq = c.tid & 7; float w[8];
#pragma unroll
          for (int j = 0; j < 8; ++j) w[j] = tile[(kq * 8 + j) * 65 + n];
          u32x4 o; o[0] = cvt_pk_bf16(w[0], w[1]); o[1] = cvt_pk_bf16(w[2], w[3]); o[2] = cvt_pk_bf16(w[4], w[5]); o[3] = cvt_pk_bf16(w[6], w[7]);
          *(u32x4*)(dst + (size_t)(nt * 64 + n) * K + kt * 64 + kq * 8) = o; }
        __syncthreads();
    }
#undef CONVT_LD
}
__device__ __forceinline__ void conv_fp6rows(const float* src, unsigned char* dst6, float* scl, int rows, const Ctx& c) {
    for (int row = c.bid * 8 + c.wave; row < rows; row += c.nb * 8) {
        const float* sp = src + (size_t)row * 2048 + c.lane * 32;
        f32x4 v[8]; float mx = 0.f;
#pragma unroll
        for (int j = 0; j < 8; ++j) { v[j] = *(const f32x4*)(sp + j * 4); mx = fmaxf(mx, fmaxf(fmaxf(fabsf(v[j][0]), fabsf(v[j][1])), fmaxf(fabsf(v[j][2]), fabsf(v[j][3])))); }
        mx = wave_max(mx);
        const float s = mx > 0.f ? 7.5f / mx : 1.f;
        if (c.lane == 0) scl[row] = mx > 0.f ? mx * (1.f / 7.5f) : 1.f;
        f32x16 x, y;
#pragma unroll
        for (int j = 0; j < 4; ++j)
#pragma unroll
            for (int e = 0; e < 4; ++e) { const int i = j * 4 + e;
                x[i] = v[(2 * i) >> 2][(2 * i) & 3] * s; y[i] = v[(2 * i + 1) >> 2][(2 * i + 1) & 3] * s; }
        const u32x6 pk = __builtin_amdgcn_cvt_scalef32_2xpk16_fp6_f32(x, y, 1.0f);
        unsigned char* dp = dst6 + (size_t)row * 1536 + c.lane * 24;
        *(u32x2*)dp = (u32x2){pk[0], pk[1]}; *(u32x2*)(dp + 8) = (u32x2){pk[2], pk[3]}; *(u32x2*)(dp + 16) = (u32x2){pk[4], pk[5]};
    }
}
__device__ __forceinline__ void conv_E(const float* src, bf16_t* dst, size_t n8, const Ctx& c) {
    const size_t stride = (size_t)c.nb * NTHREADS;
    for (size_t i = (size_t)c.bid * NTHREADS + c.tid; i < n8; i += stride) {
        const f32x4 x = *(const f32x4*)(src + i * 8), y = *(const f32x4*)(src + i * 8 + 4);
        *(u32x4*)(dst + i * 8) = pack8(x, y);
    }
}
__device__ __forceinline__ int t5_bucket(int n) {
    if (n < 16) return n;
    const float scaled = logf((float)n / 16.f) / logf(64.f);
    const int large = 16 + (int)(scaled * 16.f);
    return large < 31 ? large : 31;
}
__device__ __forceinline__ void p0_tb(const Args& a, const Ctx& c) {
    float* tb = (float*)(a.ws + WS_TB); const float* rb = a.in[26];
    for (int i = c.bid * NTHREADS + c.tid; i < 8 * TBN; i += c.nb * NTHREADS) { const int head = i / TBN, dist = i % TBN; tb[i] = rb[t5_bucket(dist) * 8 + head] * LOG2E; }
}
__device__ __forceinline__ void p0_bpe(const Args& a, const Ctx& c, int part) {
    const int n = c.tid & 255, kv = c.tid >> 8;
    const float* pe = a.in[kv ? 23 : 20]; const float* w1 = a.in[kv ? 24 : 21]; float* bpep = (float*)(a.ws + WS_BPEP);
    float s = 0.f;
#pragma unroll 16
    for (int k = part * 128; k < part * 128 + 128; ++k) s += pe[k] * w1[(size_t)k * 256 + n];
    bpep[(part * 2 + kv) * 256 + n] = s;
}
__device__ __forceinline__ void p0_s5(const Args& a, const Ctx& c, int g, int part) {
    LAS float* ar = (LAS float*)c.lds;
    LAS float* ai = ar + 17 * 64;
    LAS float* bbr = ai + 17 * 64;
    LAS float* bbi = bbr + 1024;
    LAS float* cr = bbi + 1024;
    LAS float* ci = cr + 1024;
    LAS float* kd = ci + 1024;
    const int tid = c.tid;
    if (tid < 64) {
        const int p = tid; const float dt = expf(a.in[12][g]); const float lr = a.in[10][g * 64 + p], li = a.in[11][g * 64 + p];
        for (int d = 0; d <= 16; ++d) { const float mag = expf(lr * dt * (float)d), ang = li * dt * (float)d; ar[d * 64 + p] = mag * cosf(ang); ai[d * 64 + p] = mag * sinf(ang); }
        const float nr = ar[64 + p] - 1.f, ni = ai[64 + p], den = lr * lr + li * li;
        const float wre = (nr * lr + ni * li) / den, wim = (ni * lr - nr * li) / den;
        for (int h = 0; h < 16; ++h) { const float br = a.in[13][(g * 64 + p) * 16 + h], bi = a.in[14][(g * 64 + p) * 16 + h]; bbr[p * 16 + h] = wre * br - wim * bi; bbi[p * 16 + h] = wre * bi + wim * br; }
        if (part == 0) {
        float* s5p = (float*)(a.ws + WS_S5P);
        float xr = ar[16 * 64 + p], xi = ai[16 * 64 + p];
        s5p[(g * 64 + p) * 2] = xr; s5p[(g * 64 + p) * 2 + 1] = xi;
        for (int s = 0; s < 8; ++s) { const float tr = xr * xr - xi * xi, ti = 2.f * xr * xi; xr = tr; xi = ti; }
        s5p[64 * 64 * 2 + (g * 64 + p) * 2] = xr; s5p[64 * 64 * 2 + (g * 64 + p) * 2 + 1] = xi;
        }
    }
    for (int e = tid; e < 1024; e += NTHREADS) { cr[e] = a.in[15][g * 1024 + e]; ci[e] = a.in[16][g * 1024 + e]; }
    __syncthreads();
    for (int e = tid; e < 1024 * (part + 1); e += NTHREADS) {
        const int d = e >> 8, h1 = (e >> 4) & 15, h = e & 15; float s = 0.f;
        for (int p = 0; p < 64; ++p) { const float Cr = cr[h1 * 64 + p], Ci = ci[h1 * 64 + p], Ar = ar[d * 64 + p], Ai = ai[d * 64 + p];
            const float Gr = Cr * Ar - Ci * Ai, Gi = Cr * Ai + Ci * Ar; s += Gr * bbr[p * 16 + h] - Gi * bbi[p * 16 + h]; }
        if (d == 0 && h1 == h) s += a.in[17][g * 16 + h];
        kd[e] = s;
    }
    __syncthreads();
    bf16_t* MT = (bf16_t*)(a.ws + WS_S5MT) + (size_t)g * 65536;
    bf16_t* WE = (bf16_t*)(a.ws + WS_S5WE) + (size_t)g * 32768;
    bf16_t* WC = (bf16_t*)(a.ws + WS_S5WC) + (size_t)g * 32768;
    for (int e = 16384 * part + tid; e < 16384 * (part + 1); e += NTHREADS) { const int n = e >> 8, k = e & 255, j = n >> 4, h1 = n & 15, i = k >> 4, h = k & 15;
        MT[e] = f2bf(i <= j ? kd[(j - i) * 256 + h1 * 16 + h] : 0.f); }
    for (int e = 8192 * part + tid; e < 8192 * (part + 1); e += NTHREADS) { const int n = e >> 8, k = e & 255, cc = n >> 6, p = n & 63, i = k >> 4, h = k & 15;
        const float Ar = ar[(15 - i) * 64 + p], Ai = ai[(15 - i) * 64 + p], Br = bbr[p * 16 + h], Bi = bbi[p * 16 + h];
        WE[e] = f2bf(cc ? (Ar * Bi + Ai * Br) : (Ar * Br - Ai * Bi)); }
    for (int e = 8192 * part + tid; e < 8192 * (part + 1); e += NTHREADS) { const int n = e >> 7, k = e & 127, j = n >> 4, h1 = n & 15, cc = k >> 6, p = k & 63;
        const float Cr = cr[h1 * 64 + p], Ci = ci[h1 * 64 + p], Ar = ar[(j + 1) * 64 + p], Ai = ai[(j + 1) * 64 + p];
        WC[e] = f2bf(cc ? -(Cr * Ai + Ci * Ar) : (Cr * Ar - Ci * Ai)); }
    __syncthreads();
}
__device__ __forceinline__ void p0_prologue(const Args& a, const Ctx& c) {
    for (int u = c.bid; u < 256; u += c.nb) p0_s5(a, c, u >> 2, u & 3);
    for (int u = 0; u < 32; ++u) if (c.bid == (8 * u + 7) % c.nb) p0_bpe(a, c, u);
    p0_tb(a, c);
    p0_cond(a, c);
    conv_T(a.in[6], 2048, DIN, (bf16_t*)(a.ws + WS_WIN), DIN_PAD, c);
    conv_T(a.in[18], 1024, 1024, (bf16_t*)(a.ws + WS_WGLU), 1024, c);
    conv_T(a.in[7], 2048, 2048, (bf16_t*)(a.ws + WS_WOUT), 2048, c);
    conv_T(a.in[27], 2048, 2048, (bf16_t*)(a.ws + WS_WQ), 2048, c);
    conv_T(a.in[21], 4096, 256, (bf16_t*)(a.ws + WS_W1), 256, c);
    conv_T(a.in[24], 4096, 256, (bf16_t*)(a.ws + WS_W1) + 256 * 4096, 256, c);
    conv_T(a.in[22], 256, 128, (bf16_t*)(a.ws + WS_W2), 128, c);
    conv_T(a.in[25], 256, 128, (bf16_t*)(a.ws + WS_W2) + 128 * 256, 128, c);
    conv_E(a.in[28], (bf16_t*)(a.ws + WS_PK), 128 * 128 / 8, c);
    conv_E(a.in[29], (bf16_t*)(a.ws + WS_PK) + 128 * 128, 128 * 128 / 8, c);
    conv_fp6rows(a.in[30], a.ws + WS_PU, (float*)(a.ws + WS_PSC), 16384, c);
    conv_fp6rows(a.in[31], a.ws + WS_PV, (float*)(a.ws + WS_PSC) + 16384, 16384, c);
}

__device__ __forceinline__ void norm_rows(const float* X, bf16_t* O, LAS const float* Ab, LAS const float* Bb, const Ctx& c, int row0 = 0, int nrows = L_) {
    for (int t = row0 + c.bid * 8 + c.wave; t < row0 + nrows; t += c.nb * 8) {
        const float* xr = X + (size_t)t * 2048 + c.lane * 4;
        f32x4 v[8]; float ss = 0.f;
#pragma unroll
        for (int j = 0; j < 8; ++j) { v[j] = *(const f32x4*)(xr + j * 256); ss += v[j][0] * v[j][0] + v[j][1] * v[j][1] + v[j][2] * v[j][2] + v[j][3] * v[j][3]; }
        ss = wave_sum(ss);
        const float rstd = rsqrtf(ss * (1.f / 2048.f) + 1e-6f);
#pragma unroll
        for (int j = 0; j < 8; ++j) {
            const int col = j * 256 + c.lane * 4;
            const f32x4 A = *(const LAS f32x4*)(Ab + col), B = *(const LAS f32x4*)(Bb + col);
            const f32x4 o = v[j] * rstd * A + B;
            u32x2 w; w[0] = cvt_pk_bf16(o[0], o[1]); w[1] = cvt_pk_bf16(o[2], o[3]);
            *(u32x2*)(O + (size_t)t * 2048 + col) = w;
        }
    }
}
__device__ __forceinline__ void norm_rows_bf16(const bf16_t* X, bf16_t* O, LAS const float* Ab, LAS const float* Bb, const Ctx& c, int row0, int nrows) {
    for (int t = row0 + c.bid * 8 + c.wave; t < row0 + nrows; t += c.nb * 8) {
        const bf16_t* xr = X + (size_t)t * 2048 + c.lane * 8;
        u32x4 w[4]; float ss = 0.f;
#pragma unroll
        for (int j = 0; j < 4; ++j) { w[j] = *(const u32x4*)(xr + j * 512);
#pragma unroll
            for (int e = 0; e < 4; ++e) { const float a0 = bflo(w[j][e]), a1 = bfhi(w[j][e]); ss += a0 * a0 + a1 * a1; } }
        ss = wave_sum(ss);
        const float rstd = rsqrtf(ss * (1.f / 2048.f) + 1e-6f);
#pragma unroll
        for (int j = 0; j < 4; ++j) {
            const int col = j * 512 + c.lane * 8;
            const f32x4 A0 = *(const LAS f32x4*)(Ab + col), A1 = *(const LAS f32x4*)(Ab + col + 4), B0 = *(const LAS f32x4*)(Bb + col), B1 = *(const LAS f32x4*)(Bb + col + 4);
            f32x4 o0, o1;
#pragma unroll
            for (int e = 0; e < 2; ++e) { o0[2 * e] = bflo(w[j][e]) * rstd * A0[2 * e] + B0[2 * e]; o0[2 * e + 1] = bfhi(w[j][e]) * rstd * A0[2 * e + 1] + B0[2 * e + 1];
                o1[2 * e] = bflo(w[j][2 + e]) * rstd * A1[2 * e] + B1[2 * e]; o1[2 * e + 1] = bfhi(w[j][2 + e]) * rstd * A1[2 * e + 1] + B1[2 * e + 1]; }
            *(u32x4*)(O + (size_t)t * 2048 + col) = pack8(o0, o1);
        }
    }
}
__device__ __forceinline__ float cond_from_partials(const float* condp, const float* b_ada, int j) {
    float s = b_ada[j];
#pragma unroll 8
    for (int k = 0; k < 32; ++k) s += condp[(size_t)k * NADA + j];
    return s;
}
__device__ __forceinline__ void p1_hnorm(const Args& a, const Ctx& c) {
    const float* condp = (const float*)(a.ws + WS_CONDP); float* cond = (float*)(a.ws + WS_COND);
    for (int j = c.bid * NTHREADS + c.tid; j < NADA; j += c.nb * NTHREADS) cond[j] = cond_from_partials(condp, a.in[3], j);
    LAS float* Ab = (LAS float*)c.lds; LAS float* Bb = Ab + 2048;
    for (int col = c.tid; col < 2048; col += NTHREADS) {
        Ab[col] = a.in[4][col] * (1.f + cond_from_partials(condp, a.in[3], 2048 + col)); Bb[col] = cond_from_partials(condp, a.in[3], col); }
    __syncthreads();
    norm_rows(a.in[0], (bf16_t*)(a.ws + WS_H), Ab, Bb, c);
}
__device__ __forceinline__ void p8_h2norm(const Args& a, const Ctx& c, int row0, int nrows) {
    const float* cond = (const float*)(a.ws + WS_COND);
    LAS float* Ab = (LAS float*)c.lds; LAS float* Bb = Ab + 2048;
    for (int col = c.tid; col < 2048; col += NTHREADS) { Ab[col] = a.in[5][col] * (1.f + cond[4 * 2048 + col]); Bb[col] = cond[3 * 2048 + col]; }
    __syncthreads();
    norm_rows_bf16((const bf16_t*)(a.ws + WS_X1), (bf16_t*)(a.ws + WS_H), Ab, Bb, c, row0, nrows);
}
__device__ __forceinline__ void p6_mixnorm(const Args& a, const Ctx& c) {
    const bf16_t* YS = (const bf16_t*)(a.ws + WS_YSSM); const bf16_t* YA = (const bf16_t*)(a.ws + WS_YATT); bf16_t* O = (bf16_t*)(a.ws + WS_H);
    for (int t = c.bid * 8 + c.wave; t < L_; t += c.nb * 8) {
#pragma unroll
        for (int part = 0; part < 2; ++part) {
            const bf16_t* src = (part ? YA : YS) + (size_t)t * 1024 + c.lane * 8; const float* beta = a.in[part ? 9 : 8];
            u32x4 w[2]; float f[16]; float ss = 0.f;
#pragma unroll
            for (int j = 0; j < 2; ++j) { w[j] = *(const u32x4*)(src + j * 512);
#pragma unroll
                for (int e = 0; e < 4; ++e) { f[j * 8 + 2 * e] = bflo(w[j][e]); f[j * 8 + 2 * e + 1] = bfhi(w[j][e]); } }
#pragma unroll
            for (int e = 0; e < 16; ++e) ss += f[e] * f[e];
            ss = wave_sum(ss);
            const float rstd = rsqrtf(ss * (1.f / 1024.f) + 1e-6f);
#pragma unroll
            for (int j = 0; j < 2; ++j) { const int col = j * 512 + c.lane * 8; const f32x4 b0 = *(const f32x4*)(beta + col), b1 = *(const f32x4*)(beta + col + 4);
                f32x4 o0, o1;
#pragma unroll
                for (int e = 0; e < 4; ++e) { o0[e] = f[j * 8 + e] * rstd * b0[e]; o1[e] = f[j * 8 + 4 + e] * rstd * b1[e]; }
                *(u32x4*)(O + (size_t)t * 2048 + part * 1024 + col) = pack8(o0, o1); }
        }
    }
}
constexpr int S5_US = 0, S5_ES = 33792, S5_SS = 67584;
template <int PASS>
__device__ __forceinline__ void s5_item(const Args& a, const Ctx& c, int g, int seg) {
    LAS unsigned char* lds = c.lds;
    const int tid = c.tid, wave = c.wave, lane = c.lane, r = lane & 15, q = lane >> 4;
    const bf16_t* U = (const bf16_t*)(a.ws + WS_US);
    const bf16_t* MT = (const bf16_t*)(a.ws + WS_S5MT) + (size_t)g * 65536;
    const bf16_t* WE = (const bf16_t*)(a.ws + WS_S5WE) + (size_t)g * 32768;
    const bf16_t* WC = (const bf16_t*)(a.ws + WS_S5WC) + (size_t)g * 32768;
    const float* s5p = (const float*)(a.ws + WS_S5P);
    float* F = (float*)(a.ws + WS_S5F) + (size_t)g * 4 * 128;
    bf16_t* Z = (bf16_t*)(a.ws + WS_Z);
    bf16x8 bE[8];
#pragma unroll
    for (int ks = 0; ks < 8; ++ks) bE[ks] = *(const bf16x8*)(WE + (size_t)(16 * wave + r) * 256 + 32 * ks + 8 * q);
    float sr = 0.f, si = 0.f, a16r = 0.f, a16i = 0.f;
    if (wave == 0) {
        a16r = s5p[(g * 64 + lane) * 2]; a16i = s5p[(g * 64 + lane) * 2 + 1];
        if (PASS == 1) { const float br = s5p[8192 + (g * 64 + lane) * 2], bi = s5p[8192 + (g * 64 + lane) * 2 + 1];
            for (int s = 0; s < seg; ++s) { const float fr_ = F[s * 128 + lane], fi_ = F[s * 128 + 64 + lane]; const float nr = br * sr - bi * si + fr_, ni = br * si + bi * sr + fi_; sr = nr; si = ni; } }
    }
    for (int sb = 0; sb < 4; ++sb) {
        const int tok0 = seg * 4096 + sb * 1024;
#pragma unroll
        for (int i = 0; i < 4; ++i) { const int ch = tid + NTHREADS * i, token = ch >> 1, half = ch & 1;
            const u32x4 v = *(const u32x4*)(U + (size_t)(tok0 + token) * 1024 + g * 16 + half * 8);
            *(LAS u32x4*)(lds + S5_US + (token >> 4) * 528 + ((token & 15) * 16 + half * 8) * 2) = v; }
        __syncthreads();
#pragma unroll
        for (int m = 0; m < 4; ++m) {
            f32x4 acc = {0.f, 0.f, 0.f, 0.f};
#pragma unroll
            for (int ks = 0; ks < 8; ++ks) { const bf16x8 A = *(const LAS bf16x8*)(lds + S5_US + (16 * m + r) * 528 + (32 * ks + 8 * q) * 2); acc = mfma16(A, bE[ks], acc); }
#pragma unroll
            for (int i = 0; i < 4; ++i) *(LAS float*)(lds + S5_ES + ((16 * m + 4 * q + i) * 132 + 16 * wave + r) * 4) = acc[i];
        }
        __syncthreads();
        if (wave == 0) {
            for (int ch = 0; ch < 64; ++ch) {
                const float er = *(const LAS float*)(lds + S5_ES + (ch * 132 + lane) * 4), ei = *(const LAS float*)(lds + S5_ES + (ch * 132 + 64 + lane) * 4);
                if (PASS == 1) { *(LAS bf16_t*)(lds + S5_SS + (ch * 136 + lane) * 2) = f2bf(sr); *(LAS bf16_t*)(lds + S5_SS + (ch * 136 + 64 + lane) * 2) = f2bf(si); }
                const float nr = a16r * sr - a16i * si + er, ni = a16r * si + a16i * sr + ei; sr = nr; si = ni;
            }
        }
        __syncthreads();
        if (PASS == 1) {
#pragma unroll
            for (int nt = 0; nt < 2; ++nt) {
                const int j = 2 * wave + nt;
                f32x4 acc[4];
#pragma unroll
                for (int m = 0; m < 4; ++m) acc[m] = (f32x4){0.f, 0.f, 0.f, 0.f};
                for (int ks = 0; ks <= (j >> 1); ++ks) {
                    const bf16x8 B = *(const bf16x8*)(MT + (size_t)(16 * j + r) * 256 + 32 * ks + 8 * q);
#pragma unroll
                    for (int m = 0; m < 4; ++m) { const bf16x8 A = *(const LAS bf16x8*)(lds + S5_US + (16 * m + r) * 528 + (32 * ks + 8 * q) * 2); acc[m] = mfma16(A, B, acc[m]); }
                }
#pragma unroll
                for (int ks = 0; ks < 4; ++ks) {
                    const bf16x8 B = *(const bf16x8*)(WC + (size_t)(16 * j + r) * 128 + 32 * ks + 8 * q);
#pragma unroll
                    for (int m = 0; m < 4; ++m) { const bf16x8 A = *(const LAS bf16x8*)(lds + S5_SS + (16 * m + r) * 272 + (32 * ks + 8 * q) * 2); acc[m] = mfma16(A, B, acc[m]); }
                }
#pragma unroll
                for (int m = 0; m < 4; ++m)
#pragma unroll
                    for (int i = 0; i < 4; ++i) { const int ch = 16 * m + 4 * q + i; Z[(size_t)(tok0 + 16 * ch + j) * 1024 + g * 16 + r] = f2bf(gelu_tanh(acc[m][i])); }
            }
            __syncthreads();
        }
    }
    if (PASS == 0 && wave == 0) { F[seg * 128 + lane] = sr; F[seg * 128 + 64 + lane] = si; }
}

__device__ __forceinline__ void cmp_finish_item(const Args& a, const Ctx& c, int kvsel, int rt) {
    LAS unsigned char* lds = c.lds;
    const int tid = c.tid, wave = c.wave, lane = c.lane, r = lane & 15, q = lane >> 4;
    const float* SL = (const float*)(a.ws + WS_SLAB) + (size_t)kvsel * 4 * 2048 * 256;
    const float* bpep = (const float*)(a.ws + WS_BPEP) + kvsel * 256;
    const bf16_t* W2 = (const bf16_t*)(a.ws + WS_W2) + kvsel * 128 * 256;
    for (int e = tid; e < 64 * 64; e += NTHREADS) {
        const int row = e >> 6, c4 = (e & 63) * 4;
        f32x4 s = {0.f, 0.f, 0.f, 0.f};
#pragma unroll 8
        for (int pt = 0; pt < 32; ++pt) s += *(const f32x4*)(bpep + pt * 512 + c4);
#pragma unroll
        for (int ks = 0; ks < 4; ++ks) s += *(const f32x4*)(SL + ((size_t)ks * 2048 + rt * 64 + row) * 256 + c4);
        u32x2 w; w[0] = cvt_pk_bf16(gelu_tanh(s[0]), gelu_tanh(s[1])); w[1] = cvt_pk_bf16(gelu_tanh(s[2]), gelu_tanh(s[3]));
        *(LAS u32x2*)(lds + row * 528 + c4 * 2) = w;
    }
    __syncthreads();
    bf16x8 B[8];
#pragma unroll
    for (int ks = 0; ks < 8; ++ks) B[ks] = *(const bf16x8*)(W2 + (size_t)(16 * wave + r) * 256 + 32 * ks + 8 * q);
#pragma unroll
    for (int m = 0; m < 4; ++m) {
        f32x4 acc = {0.f, 0.f, 0.f, 0.f};
#pragma unroll
        for (int ks = 0; ks < 8; ++ks) { const bf16x8 A = *(const LAS bf16x8*)(lds + (16 * m + r) * 528 + (32 * ks + 8 * q) * 2); acc = mfma16(A, B[ks], acc); }
#pragma unroll
        for (int i = 0; i < 4; ++i) {
            const int row = rt * 64 + 16 * m + 4 * q + i, gi = row >> 10, ci = row & 1023, n = 16 * wave + r;
            const bf16_t v = (ci == 1023) ? (bf16_t)0 : f2bf(acc[i]);
            if (kvsel == 0) ((bf16_t*)(a.ws + WS_KC))[((size_t)gi * 1024 + ci) * 128 + n] = v;
            else ((bf16_t*)(a.ws + WS_VCT))[((size_t)gi * 128 + n) * 1024 + ((ci & ~12) | ((ci & 4) << 1) | ((ci & 8) >> 1))] = v;
        }
    }
    __syncthreads();
}
constexpr int AT_IMP = 65536, AT_TB = 131072, AT_BM = 143872, AT_WU = 145920, AT_END = 146176;
__device__ __forceinline__ int kswz(int r) { return ((r & 3) << 2) | ((r >> 2) & 3); }
__host__ __device__ __forceinline__ int vperm(int t) { return (t & ~12) | ((t & 4) << 1) | ((t & 8) >> 1); }
template <int KEYS> __device__ __forceinline__ int vsw(int d) { return KEYS == 128 ? kswz(d) : ((d >> 1) & 7); }
template <int KEYS, bool NEEDV>
__device__ __forceinline__ void stage_dma(const bf16_t* Kt, const bf16_t* Vt, int ldv, LAS unsigned char* kb, LAS unsigned char* vb, int wave, int lane) {
    constexpr int NP = KEYS / 32;
#pragma unroll
    for (int i = 0; i < NP; ++i) { const int pc = NP * wave + i, row = 4 * pc + (lane >> 4), ch = (lane & 15) ^ kswz(row);
        __builtin_amdgcn_global_load_lds((const unsigned*)(Kt + row * 128 + ch * 8), (LAS unsigned*)(kb + pc * 1024), 16, 0, 0); }
    if (NEEDV) {
#pragma unroll
        for (int i = 0; i < NP; ++i) {
            const int pc = NP * wave + i;
            if (KEYS == 128) { const int d = 4 * pc + (lane >> 4), ch = (lane & 15) ^ kswz(d);
                __builtin_amdgcn_global_load_lds((const unsigned*)(Vt + (size_t)d * ldv + 8 * ch), (LAS unsigned*)(vb + pc * 1024), 16, 0, 0); }
            else { const int d = 8 * pc + (lane >> 3), ch = (lane & 7) ^ ((d >> 1) & 7);
                __builtin_amdgcn_global_load_lds((const unsigned*)(Vt + (size_t)d * ldv + 8 * ch), (LAS unsigned*)(vb + pc * 1024), 16, 0, 0); }
        }
    }
}
__device__ __forceinline__ float xhalf_max(float x) { auto rr = __builtin_amdgcn_permlane32_swap(__float_as_uint(x), __float_as_uint(x), false, false); return fmaxf(__uint_as_float(rr[0]), __uint_as_float(rr[1])); }
__device__ __forceinline__ float xhalf_sum(float x) { auto rr = __builtin_amdgcn_permlane32_swap(__float_as_uint(x), __float_as_uint(x), false, false); return __uint_as_float(rr[0]) + __uint_as_float(rr[1]); }
template <int BR>
__device__ __forceinline__ float tile_prep(int MODE, f32x16& S, LAS const float* tb, float cb, int base, bool selbit) {
    float mx = -INFINITY;
    if (MODE == 1) {
#pragma unroll
        for (int r = 0; r < 16; ++r) mx = fmaxf(mx, S[r]);
        mx = (BR == 2 && !selbit) ? -INFINITY : mx + cb;
    } else {
        const bool nomask = (MODE == 2);
        float bv[16];
#pragma unroll
        for (int r = 0; r < 16; ++r) { const int cr = (r & 3) + 8 * (r >> 2); const int dist = (BR <= 1) ? base - 16 * cr : base - cr; bv[r] = tb[min(max(dist, 0), TBN - 1)]; }
        __builtin_amdgcn_sched_barrier(0);
#pragma unroll
        for (int r = 0; r < 16; ++r) {
            const int cr = (r & 3) + 8 * (r >> 2);
            const int dist = (BR <= 1) ? base - 16 * cr : base - cr;
            float v = S[r] + bv[r];
            bool valid;
            if (BR <= 1) valid = dist >= 0; else if (BR == 2) valid = selbit && dist >= 0; else valid = nomask || (unsigned)dist < 512u;
            v = valid ? v : -INFINITY;
            S[r] = v; mx = fmaxf(mx, v);
        }
    }
    return mx;
}
template <int BR, bool PEND>
__device__ __forceinline__ float tile_decide(int MODE, float mx, float cb, bool selbit, f32x16 (&O)[4], float& m, float& l, u32x4& pa, u32x4& pb) {
    if (BR == 1) { const float mu = (m == -INFINITY) ? 0.f : m; return (MODE == 1) ? mu - cb : mu; }
    mx = xhalf_max(mx);
    const float mn = fmaxf(m, mx), mu = (mn == -INFINITY) ? 0.f : mn;
    if (__any(mn > m)) {
        const float alpha = fexp2(m - mu);
        l *= alpha;
        if (BR >= 2) {
#pragma unroll
            for (int dt = 0; dt < 4; ++dt)
#pragma unroll
                for (int r = 0; r < 16; ++r) O[dt][r] *= alpha;
            if (PEND) {
#pragma unroll
                for (int e = 0; e < 4; ++e) { pa[e] = cvt_pk_bf16(bflo(pa[e]) * alpha, bfhi(pa[e]) * alpha); pb[e] = cvt_pk_bf16(bflo(pb[e]) * alpha, bfhi(pb[e]) * alpha); }
            }
        }
    }
    m = mn;
    if (MODE == 1) return (BR == 2 && !selbit) ? INFINITY : mu - cb;
    return mu;
}
template <int BR, int KEYS>
__device__ __forceinline__ void attn_tile(int MODE, LAS const unsigned char* kb, LAS const unsigned char* vb, int cb0, LAS const float* tb, int key0, int t, int lane,
                                          const bf16x8 (&qf)[8], f32x16 (&O)[4], float& m, float& l, float inv_l, bool selbit, LAS float* imp_row) {
    asm volatile("" : "+v"(lane));
    constexpr int ROWB = 2 * KEYS;
    const int r31 = lane & 31, h = lane >> 5;
    const int gh = kswz(r31) ^ h, vh = vsw<KEYS>(r31) ^ h;
    float cb = 0.f;
    if (MODE == 1) cb = tb[TBN - 1];
    const int base0 = (BR <= 1) ? t - 31 - 16 * (key0 + 4 * h) : t - (key0 + 4 * h);
    const int base1 = (BR <= 1) ? base0 - 16 * 32 : base0 - 32;
    LAS const unsigned char* k0 = kb + r31 * 256;
    f32x16 S0, S1;
    bf16x8 kf[8];
#pragma unroll
    for (int ks = 0; ks < 8; ++ks) kf[ks] = *(const LAS bf16x8*)(k0 + 16 * ((2 * ks) ^ gh));
#pragma unroll
    for (int r = 0; r < 16; ++r) { S0[r] = 0.f; S1[r] = 0.f; }
    __builtin_amdgcn_sched_barrier(0);
#pragma unroll
    for (int ks = 0; ks < 8; ++ks) S0 = mfma32(kf[ks], qf[ks], S0);
    __builtin_amdgcn_sched_barrier(0);
#pragma unroll
    for (int ks = 0; ks < 8; ++ks) kf[ks] = *(const LAS bf16x8*)(k0 + 8192 + 16 * ((2 * ks) ^ gh));
    const float mx0 = tile_prep<BR>(MODE, S0, tb, cb, base0, selbit);
    u32x4 pk0a = {0u, 0u, 0u, 0u}, pk0b = {0u, 0u, 0u, 0u}, pk1a, pk1b;
    const float me0 = tile_decide<BR, false>(MODE, mx0, cb, selbit, O, m, l, pk0a, pk0b);
    __builtin_amdgcn_sched_barrier(0);
    {
#pragma unroll
        for (int ks = 0; ks < 8; ++ks) S1 = mfma32(kf[ks], qf[ks], S1);
        float ps = 0.f;
#pragma unroll
        for (int r = 0; r < 16; ++r) { float p = fexp2(S0[r] - me0); if (BR == 1) p *= inv_l; S0[r] = p; ps += p; }
        if (BR != 1) l += ps;
        if (BR >= 1) {
#pragma unroll
            for (int e = 0; e < 4; ++e) { pk0a[e] = cvt_pk_bf16(S0[2 * e], S0[2 * e + 1]); pk0b[e] = cvt_pk_bf16(S0[8 + 2 * e], S0[8 + 2 * e + 1]); }
        }
#pragma unroll
        for (int i = 0; i < 8; ++i) { __builtin_amdgcn_sched_group_barrier(0x008, 1, 0); __builtin_amdgcn_sched_group_barrier(0x002, 8, 0); }
    }
    __builtin_amdgcn_sched_barrier(0);
    if (BR == 1) {
#pragma unroll
        for (int rg = 0; rg < 4; ++rg) {
            float A = 2.f * (S0[4 * rg] + S0[4 * rg + 1] + S0[4 * rg + 2]) + S0[4 * rg + 3], B = S0[4 * rg + 3];
            A = quad_sum(A); B = quad_sum(B);
            const int jj = (key0 >> 2) + 2 * rg + h;
            if ((lane & 3) == 0) { __hip_atomic_fetch_add(imp_row + jj, A, __ATOMIC_RELAXED, __HIP_MEMORY_SCOPE_WORKGROUP);
                if (jj + 1 < 256) __hip_atomic_fetch_add(imp_row + jj + 1, B, __ATOMIC_RELAXED, __HIP_MEMORY_SCOPE_WORKGROUP); }
        }
    }
    bf16x8 av[8];
    if (BR >= 1) {
#pragma unroll
        for (int s = 0; s < 2; ++s)
#pragma unroll
            for (int dt = 0; dt < 4; ++dt) av[s * 4 + dt] = *(const LAS bf16x8*)(vb + (32 * dt + r31) * ROWB + 16 * ((cb0 + 2 * s) ^ vh));
    }
    const float mx1 = tile_prep<BR>(MODE, S1, tb, cb, base1, selbit);
    const float me1 = tile_decide<BR, true>(MODE, mx1, cb, selbit, O, m, l, pk0a, pk0b);
    __builtin_amdgcn_sched_barrier(0);
    {
        if (BR >= 1) {
#pragma unroll
            for (int dt = 0; dt < 4; ++dt) O[dt] = mfma32(av[dt], __builtin_bit_cast(bf16x8, pk0a), O[dt]);
#pragma unroll
            for (int dt = 0; dt < 4; ++dt) O[dt] = mfma32(av[4 + dt], __builtin_bit_cast(bf16x8, pk0b), O[dt]);
        }
        float ps = 0.f;
#pragma unroll
        for (int r = 0; r < 16; ++r) { float p = fexp2(S1[r] - me1); if (BR == 1) p *= inv_l; S1[r] = p; ps += p; }
        if (BR != 1) l += ps;
        if (BR >= 1) {
#pragma unroll
            for (int e = 0; e < 4; ++e) { pk1a[e] = cvt_pk_bf16(S1[2 * e], S1[2 * e + 1]); pk1b[e] = cvt_pk_bf16(S1[8 + 2 * e], S1[8 + 2 * e + 1]); }
#pragma unroll
            for (int i = 0; i < 8; ++i) { __builtin_amdgcn_sched_group_barrier(0x008, 1, 0); __builtin_amdgcn_sched_group_barrier(0x002, 8, 0); }
        }
    }
    __builtin_amdgcn_sched_barrier(0);
    if (BR == 1) {
#pragma unroll
        for (int rg = 0; rg < 4; ++rg) {
            float A = 2.f * (S1[4 * rg] + S1[4 * rg + 1] + S1[4 * rg + 2]) + S1[4 * rg + 3], B = S1[4 * rg + 3];
            A = quad_sum(A); B = quad_sum(B);
            const int jj = ((key0 + 32) >> 2) + 2 * rg + h;
            if ((lane & 3) == 0) { __hip_atomic_fetch_add(imp_row + jj, A, __ATOMIC_RELAXED, __HIP_MEMORY_SCOPE_WORKGROUP);
                if (jj + 1 < 256) __hip_atomic_fetch_add(imp_row + jj + 1, B, __ATOMIC_RELAXED, __HIP_MEMORY_SCOPE_WORKGROUP); }
        }
    }
    if (BR >= 1) {
#pragma unroll
        for (int s = 0; s < 2; ++s)
#pragma unroll
            for (int dt = 0; dt < 4; ++dt) av[s * 4 + dt] = *(const LAS bf16x8*)(vb + (32 * dt + r31) * ROWB + 16 * ((cb0 + 4 + 2 * s) ^ vh));
        __builtin_amdgcn_sched_barrier(0);
#pragma unroll
        for (int dt = 0; dt < 4; ++dt) O[dt] = mfma32(av[dt], __builtin_bit_cast(bf16x8, pk1a), O[dt]);
#pragma unroll
        for (int dt = 0; dt < 4; ++dt) O[dt] = mfma32(av[4 + dt], __builtin_bit_cast(bf16x8, pk1b), O[dt]);
    }
}
template <int BR, int KEYS>
__device__ __forceinline__ void run_branch(const Ctx& c, const bf16_t* Kb, const bf16_t* Vtb, int ldv, int lo, int hi, LAS const float* tb, int t, int t0,
                                           const bf16x8 (&qf)[8], f32x16 (&O)[4], float& m, float& l, float inv_l, int tl, LAS float* imp_row) {
    constexpr bool NEEDV = (BR != 0);
    constexpr int BPS = KEYS / 64, KSTG = KEYS * 256, VSTG = 128 * 2 * KEYS, VB0 = 2 * KSTG;
    LAS unsigned char* lds = c.lds;
    int lz = c.lane; asm volatile("" : "+v"(lz));
    const int nst = (hi - lo + BPS - 1) / BPS;
#define STG_BLK(i) ((lo + BPS * (i) + BPS - 1 < hi) ? lo + BPS * (i) : hi - BPS)
    asm volatile("s_waitcnt vmcnt(0)" ::: "memory");
    { const int b0 = (BPS == 2 && hi - lo < 2) ? lo : STG_BLK(0);
      stage_dma<KEYS, NEEDV>(Kb + (size_t)b0 * 64 * 128, Vtb + (size_t)b0 * 64, ldv, lds, lds + VB0, c.wave, lz); }
    asm volatile("s_waitcnt vmcnt(0)" ::: "memory");
    __syncthreads();
    const int qt = t0 >> 6;
    for (int i = 0; i < nst; ++i) {
        const int buf = i & 1;
        if (i + 1 < nst) { int lz2 = lz; asm volatile("" : "+v"(lz2));
            const int b1 = STG_BLK(i + 1);
            stage_dma<KEYS, NEEDV>(Kb + (size_t)b1 * 64 * 128, Vtb + (size_t)b1 * 64, ldv, lds + (buf ^ 1) * KSTG, lds + VB0 + (buf ^ 1) * VSTG, c.wave, lz2); }
        const int sb = (BPS == 2 && hi - lo < 2) ? lo : STG_BLK(i);
#pragma unroll
        for (int q = 0; q < BPS; ++q) {
            const int j = lo + BPS * i + q;
            if (j < hi) {
                bool selbit = true, wave_on = true;
                if (BR == 2) {
                    const unsigned w = *(const LAS unsigned*)(lds + AT_BM + (tl * 8 + (j >> 5)) * 4);
                    selbit = (w >> (j & 31)) & 1u;
                    const unsigned wu = *(const LAS unsigned*)(lds + AT_WU + (c.wave * 8 + (j >> 5)) * 4);
                    wave_on = (wu >> (j & 31)) & 1u;
                }
                if (wave_on) {
                    int mode = 0;
                    if (BR <= 1) mode = (1024 * j + 1829 <= t0) ? 1 : 0;
                    else if (BR == 2) mode = (64 * j + 853 <= t0) ? 1 : 0;
                    else mode = (j >= qt - 7 && j <= qt - 1) ? 2 : 0;
                    const int slot = j - sb;
                    attn_tile<BR, KEYS>(mode, lds + buf * KSTG + slot * 16384, lds + VB0 + buf * VSTG, 8 * slot, tb, j * 64, t, c.lane, qf, O, m, l, inv_l, selbit, imp_row);
                }
            }
        }
        asm volatile("s_waitcnt vmcnt(0)" ::: "memory");
        __syncthreads();
    }
#undef STG_BLK
}
__device__ __forceinline__ void attn_item(const Args& a, const Ctx& c_, int qt, int g) {
    Ctx c = c_; { int tz = c_.tid; asm volatile("" : "+v"(tz)); c.tid = tz; c.lane = tz & 63; }
    LAS unsigned char* lds = c.lds;
    const int tid = c.tid, wave = c.wave, lane = c.lane, r31 = lane & 31, h = lane >> 5, hl = lane & 3;
    const int t0 = qt * 64, tl = 8 * wave + (r31 >> 2), t = t0 + tl, head = g * 4 + hl;
    const bf16_t* Qb = (const bf16_t*)(a.ws + WS_Q);
    const bf16_t* KROW = (const bf16_t*)(a.ws + WS_KROW);
    const bf16_t* VT = (const bf16_t*)(a.ws + WS_VT);
    const float* GATE = (const float*)(a.ws + WS_GATE);
    { const float* tbg = (const float*)(a.ws + WS_TB) + g * 4 * TBN;
      for (int i = tid; i < 4 * TBN; i += NTHREADS) *(LAS float*)(lds + AT_TB + i * 4) = tbg[i];
      for (int i = tid; i < 64 * 256; i += NTHREADS) *(LAS float*)(lds + AT_IMP + i * 4) = 0.f; }
    bf16x8 qf[8];
#pragma unroll
    for (int ks = 0; ks < 8; ++ks) qf[ks] = *(const bf16x8*)(Qb + (size_t)t * 1024 + head * 128 + 16 * ks + 8 * h);
    LAS const float* tb = (LAS const float*)(lds + AT_TB) + hl * TBN;
    LAS float* imp_row = (LAS float*)(lds + AT_IMP) + tl * 256;
    bf16_t* Y = (bf16_t*)(a.ws + WS_YATT) + (size_t)t * 1024 + head * 128 + 4 * h;
    f32x16 O[4];
#pragma unroll
    for (int dt = 0; dt < 4; ++dt)
#pragma unroll
        for (int r = 0; r < 16; ++r) O[dt][r] = 0.f;
    __syncthreads();
    { const int ntile = (t0 / 16 + 3 + 63) / 64;
      const bf16_t* KC = (const bf16_t*)(a.ws + WS_KC) + (size_t)g * 1024 * 128; const bf16_t* VCT = (const bf16_t*)(a.ws + WS_VCT) + (size_t)g * 128 * 1024;
      float m = -INFINITY, l = 0.f;
#if defined(PROBE_CMP)
      run_branch<0, 64>(c, KC, VCT, 1024, 0, ntile, tb, t, t0, qf, O, m, l, 0.f, tl, imp_row);
      asm volatile("" :: "v"(m), "v"(l));
      m = -INFINITY; l = 0.f;
#endif
      run_branch<0, 64>(c, KC, VCT, 1024, 0, ntile, tb, t, t0, qf, O, m, l, 0.f, tl, imp_row);
      const float lt = xhalf_sum(l), inv = lt > 0.f ? 1.f / lt : 0.f;
      run_branch<1, 64>(c, KC, VCT, 1024, 0, ntile, tb, t, t0, qf, O, m, l, inv, tl, imp_row);
      const float gc = GATE[(size_t)t * 24 + head];
#pragma unroll
      for (int dt = 0; dt < 4; ++dt)
#pragma unroll
          for (int rg = 0; rg < 4; ++rg) {
              u32x2 w; w[0] = cvt_pk_bf16(gc * O[dt][4 * rg], gc * O[dt][4 * rg + 1]); w[1] = cvt_pk_bf16(gc * O[dt][4 * rg + 2], gc * O[dt][4 * rg + 3]);
              *(u32x2*)(Y + 32 * dt + 8 * rg) = w;
#pragma unroll
              for (int e = 0; e < 4; ++e) O[dt][4 * rg + e] = 0.f;
          }
    }
    {
        const int ncand = qt - 2 > 0 ? qt - 2 : 0;
        unsigned v[8][4], selm[8];
#pragma unroll
        for (int i = 0; i < 8; ++i) {
            LAS const float* row = (LAS const float*)(lds + AT_IMP) + (8 * wave + i) * 256;
            selm[i] = 0u;
#pragma unroll
            for (int k = 0; k < 4; ++k) { const int j = lane + 64 * k; const bool cand = (j >= 1 && j <= qt - 2);
                v[i][k] = cand ? ((__float_as_uint(row[j]) & ~0xFFu) | (unsigned)(255 - j)) : 0u; if (ncand <= 13 && cand) selm[i] |= 1u << k; }
        }
        if (ncand > 13) {
            for (int it = 0; it < 13; ++it) {
#pragma unroll
                for (int i = 0; i < 8; ++i) {
                    const unsigned mx = wave_umax_bcast(max(max(v[i][0], v[i][1]), max(v[i][2], v[i][3])));
#pragma unroll
                    for (int k = 0; k < 4; ++k) if (v[i][k] == mx) { v[i][k] = 0u; selm[i] |= 1u << k; }
                }
            }
        }
        unsigned wu[8];
#pragma unroll
        for (int k = 0; k < 8; ++k) wu[k] = 0u;
#pragma unroll
        for (int i = 0; i < 8; ++i)
#pragma unroll
            for (int k = 0; k < 4; ++k) {
                const int j = lane + 64 * k; const bool forced = (j == 0) || (j == qt) || (j == qt - 1);
                const unsigned long long mk = __ballot(((selm[i] >> k) & 1u) || forced);
                const unsigned lo = (unsigned)mk, hi = (unsigned)(mk >> 32);
                if (lane == 0) { *(LAS unsigned*)(lds + AT_BM + ((8 * wave + i) * 8 + 2 * k) * 4) = lo; *(LAS unsigned*)(lds + AT_BM + ((8 * wave + i) * 8 + 2 * k + 1) * 4) = hi; }
                wu[2 * k] |= lo; wu[2 * k + 1] |= hi;
            }
        if (lane == 0) {
#pragma unroll
            for (int k = 0; k < 8; ++k) *(LAS unsigned*)(lds + AT_WU + (wave * 8 + k) * 4) = wu[k];
        }
    }
    __syncthreads();
#if defined(PROBE_SEL)
    { float m = -INFINITY, l = 0.f;
      run_branch<2, 128>(c, KROW + (size_t)(2 + g) * L_ * 128, VT + (size_t)g * 128 * L_, L_, 0, qt + 1, tb, t, t0, qf, O, m, l, 0.f, tl, imp_row);
      asm volatile("" :: "v"(O[0]), "v"(O[1]), "v"(O[2]), "v"(O[3]), "v"(m), "v"(l));
#pragma unroll
      for (int dt = 0; dt < 4; ++dt)
#pragma unroll
          for (int r = 0; r < 16; ++r) O[dt][r] = 0.f; }
#endif
    { float m = -INFINITY, l = 0.f;
      run_branch<2, 128>(c, KROW + (size_t)(2 + g) * L_ * 128, VT + (size_t)g * 128 * L_, L_, 0, qt + 1, tb, t, t0, qf, O, m, l, 0.f, tl, imp_row);
      const float gs = GATE[(size_t)t * 24 + 8 + head];
      const float lt = xhalf_sum(l), sc = gs * (lt > 0.f ? 1.f / lt : 0.f);
#pragma unroll
      for (int dt = 0; dt < 4; ++dt)
#pragma unroll
          for (int rg = 0; rg < 4; ++rg) {
              const u32x2 w0 = *(const u32x2*)(Y + 32 * dt + 8 * rg);
              u32x2 w; w[0] = cvt_pk_bf16(bflo(w0[0]) + sc * O[dt][4 * rg], bfhi(w0[0]) + sc * O[dt][4 * rg + 1]); w[1] = cvt_pk_bf16(bflo(w0[1]) + sc * O[dt][4 * rg + 2], bfhi(w0[1]) + sc * O[dt][4 * rg + 3]);
              *(u32x2*)(Y + 32 * dt + 8 * rg) = w;
#pragma unroll
              for (int e = 0; e < 4; ++e) O[dt][4 * rg + e] = 0.f;
          }
    }
#if defined(PROBE_WIN)
    { float m = -INFINITY, l = 0.f;
      const int lo = qt - 8 > 0 ? qt - 8 : 0;
      run_branch<3, 128>(c, KROW + (size_t)(4 + g) * L_ * 128, VT + (size_t)(2 + g) * 128 * L_, L_, lo, qt + 1, tb, t, t0, qf, O, m, l, 0.f, tl, imp_row);
      asm volatile("" :: "v"(O[0]), "v"(O[1]), "v"(O[2]), "v"(O[3]), "v"(m), "v"(l));
#pragma unroll
      for (int dt = 0; dt < 4; ++dt)
#pragma unroll
          for (int r = 0; r < 16; ++r) O[dt][r] = 0.f; }
#endif
    { float m = -INFINITY, l = 0.f;
      const int lo = qt - 8 > 0 ? qt - 8 : 0;
      run_branch<3, 128>(c, KROW + (size_t)(4 + g) * L_ * 128, VT + (size_t)(2 + g) * 128 * L_, L_, lo, qt + 1, tb, t, t0, qf, O, m, l, 0.f, tl, imp_row);
      const float gw = GATE[(size_t)t * 24 + 16 + head];
      const float lt = xhalf_sum(l), sc = gw * (lt > 0.f ? 1.f / lt : 0.f);
#pragma unroll
      for (int dt = 0; dt < 4; ++dt)
#pragma unroll
          for (int rg = 0; rg < 4; ++rg) {
              const u32x2 w0 = *(const u32x2*)(Y + 32 * dt + 8 * rg);
              u32x2 w; w[0] = cvt_pk_bf16(bflo(w0[0]) + sc * O[dt][4 * rg], bfhi(w0[0]) + sc * O[dt][4 * rg + 1]); w[1] = cvt_pk_bf16(bflo(w0[1]) + sc * O[dt][4 * rg + 2], bfhi(w0[1]) + sc * O[dt][4 * rg + 3]);
              *(u32x2*)(Y + 32 * dt + 8 * rg) = w;
          }
    }
    __syncthreads();
}
#ifndef PEER_ALPHA
#define PEER_ALPHA 1.0f
#endif
constexpr int PE_SC = 0, PE_LV = 66048, PE_LI = 74240, PE_EX = 147456, PE_GT = 151552, PE_SU = 155648, PE_END = 159744;
constexpr int PE_SLOT = 3072, PE_NSLOT = 6, PE_RINGW = PE_SLOT * PE_NSLOT;
static_assert(8 * PE_RINGW <= PE_EX && PE_END <= LDS_BYTES - 16, "PEER LDS map");
__device__ __forceinline__ float wave_sum_bcast(float v) {
    v += dpp_f<0xB1>(v); v += dpp_f<0x4E>(v); v += dpp_f<0x141>(v); v += dpp_f<0x140>(v);
    v += __int_as_float(__builtin_amdgcn_update_dpp(0, __float_as_int(v), 0x142, 0xa, 0xf, false));
    v += __int_as_float(__builtin_amdgcn_update_dpp(0, __float_as_int(v), 0x143, 0xc, 0xf, false));
    return __int_as_float(__builtin_amdgcn_readlane(__float_as_int(v), 63));
}
__device__ __forceinline__ unsigned mono_key(float v) { const unsigned b = __float_as_uint(v); return b ^ ((b >> 31) ? 0xFFFFFFFFu : 0x80000000u); }
template <int CTRL>
__device__ __forceinline__ void quad_merge16(unsigned (&t)[16]) {
    unsigned o[16];
#pragma unroll
    for (int i = 0; i < 16; ++i) o[i] = (unsigned)__builtin_amdgcn_update_dpp(0, (int)t[15 - i], CTRL, 0xf, 0xf, false);
#pragma unroll
    for (int i = 0; i < 16; ++i) t[i] = max(t[i], o[i]);
#pragma unroll
    for (int st = 8; st >= 1; st >>= 1)
#pragma unroll
        for (int i = 0; i < 16; ++i) if ((i & st) == 0) { const unsigned hi = max(t[i], t[i + st]), lo = min(t[i], t[i + st]); t[i] = hi; t[i + st] = lo; }
}
__device__ __forceinline__ int pair_a(int p) { return p < 16 ? 0 : p < 24 ? 1 : p < 29 ? 2 : p < 33 ? 3 : p < 36 ? 4 : p < 38 ? 5 : p < 40 ? 6 : p < 42 ? 7 : p - 34; }
__device__ __forceinline__ int pair_b(int p) { return p < 16 ? p : p < 24 ? p - 16 : p < 29 ? p - 24 : p < 33 ? p - 29 : p < 36 ? p - 33 : p < 38 ? p - 36 : p < 40 ? p - 38 : p < 42 ? p - 40 : 0; }
template <bool DRY>
__device__ __forceinline__ void peer_step(const Args& a, const Ctx& c_, int t0) {
    Ctx c = c_; { int tz = c_.tid; asm volatile("" : "+v"(tz)); c.tid = tz; c.lane = tz & 63; }
    LAS unsigned char* lds = c.lds;
    const int tid = c.tid, wave = c.wave, lane = c.lane, r = lane & 15, q = lane >> 4;
    const bf16_t* QP = (const bf16_t*)(a.ws + WS_QP); const bf16_t* PK = (const bf16_t*)(a.ws + WS_PK);
    const unsigned char* PU = a.ws + WS_PU; const unsigned char* PV = a.ws + WS_PV; const float* psc = (const float*)(a.ws + WS_PSC);
    const bf16_t* HB = (const bf16_t*)(a.ws + WS_H);
    {
        const int hh = wave;
#pragma unroll
        for (int cc = 0; cc < 2; ++cc) {
            bf16x8 aF[4];
#pragma unroll
            for (int ks = 0; ks < 4; ++ks) aF[ks] = *(const bf16x8*)(QP + (size_t)(t0 + (r & 7)) * 2048 + hh * 256 + cc * 128 + 32 * ks + 8 * q);
#pragma unroll 2
            for (int nt = 0; nt < 8; ++nt) {
                f32x4 acc = {0.f, 0.f, 0.f, 0.f};
#pragma unroll
                for (int ks = 0; ks < 4; ++ks) { const bf16x8 B = *(const bf16x8*)(PK + (size_t)(cc * 128 + 16 * nt + r) * 128 + 32 * ks + 8 * q); acc = mfma16(aF[ks], B, acc); }
                if (q < 2) {
#pragma unroll
                    for (int i = 0; i < 4; ++i) { const int tok = 4 * q + i; *(LAS float*)(lds + PE_SC + ((tok * 16 + hh * 2 + cc) * 129 + 16 * nt + r) * 4) = acc[i]; }
                }
            }
        }
    }
    __syncthreads();
    {
        const int task = tid >> 2, part = tid & 3;
        LAS const float* sc = (LAS const float*)(lds + PE_SC) + task * 129;
        float vals[32];
#pragma unroll
        for (int k = 0; k < 32; ++k) vals[k] = sc[32 * part + k];
        unsigned top[16];
#pragma unroll
        for (int e = 0; e < 16; ++e) top[e] = 0u;
#pragma unroll
        for (int k = 0; k < 32; ++k) {
            unsigned key = (mono_key(vals[k]) & ~0x7Fu) | (unsigned)(127 - (32 * part + k));
#pragma unroll
            for (int e = 0; e < 16; ++e) { const unsigned hi = max(top[e], key); key = min(top[e], key); top[e] = hi; }
        }
        quad_merge16<0xB1>(top);
        quad_merge16<0x4E>(top);
        if (part == 0) {
#pragma unroll
            for (int e = 0; e < 16; ++e) { const int idx = 127 - (int)(top[e] & 0x7Fu); *(LAS float*)(lds + PE_LV + (task * 16 + e) * 4) = sc[idx]; *(LAS int*)(lds + PE_LI + (task * 16 + e) * 4) = idx; }
        }
    }
    __syncthreads();
    if (tid < 256) {
        const int task = tid >> 2, part = tid & 3, tok = task >> 3, hh = task & 7, t1 = tok * 16 + hh * 2, t2 = t1 + 1;
        LAS const float* lv1 = (LAS const float*)(lds + PE_LV) + t1 * 16; LAS const float* lv2 = (LAS const float*)(lds + PE_LV) + t2 * 16;
        unsigned top[16];
#pragma unroll
        for (int e = 0; e < 16; ++e) top[e] = 0u;
        for (int p = part; p < 50; p += 4) {
            const int aa = pair_a(p), bb = pair_b(p);
            unsigned key = (mono_key(lv1[aa] + lv2[bb]) & ~0xFFu) | (unsigned)(255 - (aa * 16 + bb));
#pragma unroll
            for (int e = 0; e < 16; ++e) { const unsigned hi = max(top[e], key); key = min(top[e], key); top[e] = hi; }
        }
        quad_merge16<0xB1>(top);
        quad_merge16<0x4E>(top);
        if (part == 0) {
            LAS const int* li1 = (LAS const int*)(lds + PE_LI) + t1 * 16; LAS const int* li2 = (LAS const int*)(lds + PE_LI) + t2 * 16;
            float sv[16]; int ex[16]; float mx = -INFINITY;
#pragma unroll
            for (int e = 0; e < 16; ++e) {
                const int id = 255 - (int)(top[e] & 0xFFu), aa = id >> 4, bb = id & 15;
                sv[e] = lv1[aa] + lv2[bb]; ex[e] = li1[aa] * 128 + li2[bb]; mx = fmaxf(mx, sv[e]);
            }
            float sum = 0.f;
#pragma unroll
            for (int e = 0; e < 16; ++e) { sv[e] = fexp2((sv[e] - mx) * LOG2E); sum += sv[e]; }
            const float inv = 1.f / sum;
#pragma unroll
            for (int e = 0; e < 16; ++e) { *(LAS int*)(lds + PE_EX + (tok * 128 + hh * 16 + e) * 4) = ex[e];
                *(LAS float*)(lds + PE_GT + (tok * 128 + hh * 16 + e) * 4) = sv[e] * inv * psc[16384 + ex[e]];
                *(LAS float*)(lds + PE_SU + (tok * 128 + hh * 16 + e) * 4) = psc[ex[e]]; }
        }
    }
    __syncthreads();
    const int t = t0 + wave;
    float hp[32];
#pragma unroll
    for (int k = 0; k < 4; ++k) { const u32x4 w = *(const u32x4*)(HB + (size_t)t * 2048 + lane * 32 + k * 8);
#pragma unroll
        for (int e = 0; e < 4; ++e) { hp[k * 8 + 2 * e] = bflo(w[e]); hp[k * 8 + 2 * e + 1] = bfhi(w[e]); } }
    float acc[32];
#pragma unroll
    for (int e = 0; e < 32; ++e) acc[e] = 0.f;
    asm volatile("s_waitcnt vmcnt(0)" ::: "memory");
    {
        LAS const int* exl = (LAS const int*)(lds + PE_EX) + wave * 128; LAS const float* gtl = (LAS const float*)(lds + PE_GT) + wave * 128;
        LAS unsigned char* ring = lds + wave * PE_RINGW;
        LAS const float* sul = (LAS const float*)(lds + PE_SU) + wave * 128;
#define ROW_ISSUE(SL, IDX) do { const int ex_ = __builtin_amdgcn_readfirstlane(exl[IDX]); \
            const unsigned char* gu_ = PU + (size_t)ex_ * 1536; const unsigned char* gv_ = PV + (size_t)ex_ * 1536; \
            LAS unsigned char* sl_ = ring + (SL) * PE_SLOT;                   \
            __builtin_amdgcn_global_load_lds((const unsigned*)(gu_ + lane * 16), (LAS unsigned*)sl_, 16, 0, 0); \
            __builtin_amdgcn_global_load_lds((const unsigned*)((lane < 32 ? gu_ + 1024 : gv_ - 512) + lane * 16), (LAS unsigned*)(sl_ + 1024), 16, 0, 0); \
            __builtin_amdgcn_global_load_lds((const unsigned*)(gv_ + 512 + lane * 16), (LAS unsigned*)(sl_ + 2048), 16, 0, 0); \
            } while (0)
#define ROW_APPLY(SL, IDX) do { LAS const unsigned char* sl_ = ring + (SL) * PE_SLOT + lane * 24; \
            const u32x2 a0_ = *(const LAS u32x2*)sl_, a1_ = *(const LAS u32x2*)(sl_ + 8), a2_ = *(const LAS u32x2*)(sl_ + 16); \
            const f32x32 uf_ = __builtin_amdgcn_cvt_scalef32_pk32_f32_fp6((u32x6){a0_[0], a0_[1], a1_[0], a1_[1], a2_[0], a2_[1]}, 1.0f); \
            float d0_ = 0.f, d1_ = 0.f; \
            _Pragma("unroll") for (int i = 0; i < 32; i += 2) { d0_ += uf_[i] * hp[i]; d1_ += uf_[i + 1] * hp[i + 1]; } \
            const float d_ = wave_sum_bcast(d0_ + d1_) * sul[IDX]; \
            const float wgt_ = gtl[IDX] * gelu_tanh(d_); \
            const u32x2 b0_ = *(const LAS u32x2*)(sl_ + 1536), b1_ = *(const LAS u32x2*)(sl_ + 1544), b2_ = *(const LAS u32x2*)(sl_ + 1552); \
            const f32x32 vf_ = __builtin_amdgcn_cvt_scalef32_pk32_f32_fp6((u32x6){b0_[0], b0_[1], b1_[0], b1_[1], b2_[0], b2_[1]}, 1.0f); \
            _Pragma("unroll") for (int i = 0; i < 32; ++i) acc[i] += wgt_ * vf_[i]; \
            asm volatile("s_waitcnt lgkmcnt(0)" ::: "memory"); } while (0)
#define DMA_WAIT(N) asm volatile("s_waitcnt vmcnt(" #N ")" ::: "memory")
        ROW_ISSUE(0, 0); ROW_ISSUE(1, 1); ROW_ISSUE(2, 2); ROW_ISSUE(3, 3); ROW_ISSUE(4, 4); ROW_ISSUE(5, 5);
#pragma unroll 1
        for (int e = 0; e < 126; e += 6) {
            const bool last = (e == 120);
            DMA_WAIT(15); ROW_APPLY(0, e);     ROW_ISSUE(0, e + 6);
            DMA_WAIT(15); ROW_APPLY(1, e + 1); ROW_ISSUE(1, e + 7);
            DMA_WAIT(15); ROW_APPLY(2, e + 2); if (!last) ROW_ISSUE(2, e + 8);
            if (last) DMA_WAIT(0); else DMA_WAIT(15);
            ROW_APPLY(3, e + 3); if (!last) ROW_ISSUE(3, e + 9);
            if (!last) DMA_WAIT(15);
            ROW_APPLY(4, e + 4); if (!last) ROW_ISSUE(4, e + 10);
            if (!last) DMA_WAIT(15);
            ROW_APPLY(5, e + 5); if (!last) ROW_ISSUE(5, e + 11);
        }
        ROW_APPLY(0, 126);
        ROW_APPLY(1, 127);
#undef ROW_ISSUE
#undef ROW_APPLY
#undef DMA_WAIT
    }
    {
        float* xo = a.out + (size_t)t * 2048; const bf16_t* x1p = (const bf16_t*)(a.ws + WS_X1) + (size_t)t * 2048; const float* g2 = (const float*)(a.ws + WS_COND) + 5 * 2048; const float* fg = a.in[32];
        float ss = 0.f;
#pragma unroll
        for (int k = 0; k < 8; ++k) {
            const int col = lane * 32 + k * 4;
            const u32x2 xw = *(const u32x2*)(x1p + col); const f32x4 gv = *(const f32x4*)(g2 + col);
            const float x1[4] = {bflo(xw[0]), bfhi(xw[0]), bflo(xw[1]), bfhi(xw[1])};
#pragma unroll
            for (int e = 0; e < 4; ++e) { const float x2 = x1[e] + PEER_ALPHA * gv[e] * acc[k * 4 + e]; acc[k * 4 + e] = x2; ss += x2 * x2; }
        }
        ss = wave_sum_bcast(ss);
        const float rstd = rsqrtf(ss * (1.f / 2048.f) + 1e-6f);
#pragma unroll
        for (int k = 0; k < 8; ++k) {
            const int col = lane * 32 + k * 4;
            const f32x4 fv = *(const f32x4*)(fg + col);
            f32x4 o;
#pragma unroll
            for (int e = 0; e < 4; ++e) o[e] = acc[k * 4 + e] * rstd * fv[e];
            if (!DRY || rstd == 123.456f) *(f32x4*)(xo + col) = o;
        }
    }
    __syncthreads();
}
constexpr int NPHASE = 14;
#ifndef DBG
#define DBG 0
#endif
__device__ __forceinline__ void dbg_final_norm(const Args& a, const Ctx& c, const float* src) {
    for (int t = c.bid * 8 + c.wave; t < L_; t += c.nb * 8) {
        const float* xr = src + (size_t)t * 2048 + c.lane * 4; float* o = a.out + (size_t)t * 2048 + c.lane * 4;
        f32x4 v[8]; float ss = 0.f;
#pragma unroll
        for (int j = 0; j < 8; ++j) { v[j] = *(const f32x4*)(xr + j * 256); ss += v[j][0] * v[j][0] + v[j][1] * v[j][1] + v[j][2] * v[j][2] + v[j][3] * v[j][3]; }
        ss = wave_sum(ss);
        const float rstd = rsqrtf(ss * (1.f / 2048.f) + 1e-6f);
#pragma unroll
        for (int j = 0; j < 8; ++j) { const f32x4 g = *(const f32x4*)(a.in[32] + j * 256 + c.lane * 4); *(f32x4*)(o + j * 256) = v[j] * rstd * g; }
    }
}

extern __shared__ __attribute__((aligned(16))) unsigned char smem[];

__global__ void __launch_bounds__(512, 2) fwd(Args a) {
    LAS unsigned char* lds = (LAS unsigned char*)smem;
    Ctx c; c.bid = blockIdx.x; c.nb = gridDim.x; c.tid = threadIdx.x; c.wave = __builtin_amdgcn_readfirstlane(threadIdx.x >> 6); c.lane = threadIdx.x & 63; c.lds = lds;
    volatile LAS unsigned* xbw = (volatile LAS unsigned*)(lds + LDS_BYTES - 16);
    if (c.tid < 4) xbw[c.tid] = 0u;
    __syncthreads();
    const int lo = a.ph_lo, hi = a.ph_hi;
    const bool multi = (hi - lo) > 1;
    XcdBarrier bar; bar.bar = (unsigned*)(a.ws + WS_CTL); bar.x = 0; bar.st = xbw;
    if (multi) bar = xcd_barrier_post((unsigned*)(a.ws + WS_CTL), xbw);
#ifndef PHASE_MASK
#define PHASE_MASK 0xFFFF
#endif
#if DBG == 1
#undef PHASE_MASK
#define PHASE_MASK 0x403
#elif DBG == 2 || DBG == 4 || DBG == 5
#undef PHASE_MASK
#define PHASE_MASK 0x4FF
#endif
#define IN(k) (((PHASE_MASK >> (k)) & 1) && lo <= (k) && (k) < hi)
#define REFRESH() do { int tz_ = threadIdx.x; asm volatile("" : "+v"(tz_)); c.tid = tz_; c.lane = tz_ & 63; c.wave = __builtin_amdgcn_readfirstlane(tz_ >> 6); } while (0)
#define SEAM(k) do { if (IN(k) && IN((k) + 1)) xcd_barrier(bar); } while (0)
#ifndef DUP
#define DUP -1
#endif
#define REP(k) for (int rep_ = 0; rep_ < ((DUP == (k)) ? 2 : 1); ++rep_)
#define DUP2(k, ...) do { __VA_ARGS__; if (DUP == (k)) { __syncthreads(); __VA_ARGS__; } } while (0)

    if (IN(0)) REP(0) { REFRESH(); p0_prologue(a, c); }
    SEAM(0);
    if (IN(1)) { REFRESH(); DUP2(1, p1_hnorm(a, c)); }
    SEAM(1);
    if (IN(2)) { REFRESH();
        pg8::StaticOrder S; S.init((const bf16_t*)(a.ws + WS_H), (const bf16_t*)(a.ws + WS_WIN), 2048, 2048, 2048, L_, DIN_PAD, c.nb, c.bid);
        EpiWin E{(bf16_t*)(a.ws + WS_US), (bf16_t*)(a.ws + WS_Q), (bf16_t*)(a.ws + WS_KROW), (bf16_t*)(a.ws + WS_VROW), (bf16_t*)(a.ws + WS_VT), (float*)(a.ws + WS_GATE)};
        DUP2(2, pg8::gemm_phase<EpiWin, pg8::StaticOrder>(lds, S, E));
    }
    SEAM(2);
    if (IN(3)) { REFRESH();
        DUP2(31, for (int it = c.bid; it < 256; it += c.nb) s5_item<0>(a, c, it >> 2, it & 3));
        __syncthreads();
        CmpOrder S{(const bf16_t*)(a.ws + WS_KROW), (const bf16_t*)(a.ws + WS_VROW), (const bf16_t*)(a.ws + WS_W1), 2048, 4096, 1024, c.nb, c.bid};
        EpiSlab E{(float*)(a.ws + WS_SLAB)};
        DUP2(32, pg8::gemm_phase<EpiSlab, CmpOrder>(lds, S, E));
    }
    SEAM(3);
    if (IN(4)) { REFRESH();
        DUP2(41, for (int it = c.bid; it < 64; it += c.nb) cmp_finish_item(a, c, it >> 5, it & 31));
        DUP2(42, for (int it = c.bid; it < 256; it += c.nb) s5_item<1>(a, c, it >> 2, it & 3));
    }
    SEAM(4);
    if (IN(5)) { REFRESH();
#if DBG == 5
        for (size_t i = (size_t)c.bid * NTHREADS + c.tid; i < (size_t)L_ * 1024 / 8; i += (size_t)c.nb * NTHREADS) *(u32x4*)((bf16_t*)(a.ws + WS_YSSM) + i * 8) = (u32x4){0u, 0u, 0u, 0u};
#else
        {
            pg8::StaticOrder S; S.init((const bf16_t*)(a.ws + WS_Z), (const bf16_t*)(a.ws + WS_WGLU), 1024, 1024, 1024, L_, 1024, c.nb, c.bid);
            EpiGlu E{(const bf16_t*)(a.ws + WS_Z), a.in[19], (bf16_t*)(a.ws + WS_YSSM)};
            DUP2(55, pg8::gemm_phase<EpiGlu, pg8::StaticOrder>(lds, S, E));
        }
#endif
        __syncthreads();
        REP(5)
#if DBG == 4
        for (size_t i = (size_t)c.bid * NTHREADS + c.tid; i < (size_t)L_ * 1024 / 8; i += (size_t)c.nb * NTHREADS) *(u32x4*)((bf16_t*)(a.ws + WS_YATT) + i * 8) = (u32x4){0u, 0u, 0u, 0u};
#else
        {
            unsigned* qhead = (unsigned*)(a.ws + WS_CTL) + 8192;
            volatile LAS unsigned* slot = (volatile LAS unsigned*)(lds + LDS_BYTES - 32);
            for (;;) {
                if (c.tid == 0) *slot = __hip_atomic_fetch_add(qhead, 1u, __ATOMIC_RELAXED, __HIP_MEMORY_SCOPE_AGENT);
                __syncthreads();
                const unsigned q = *slot;
                __syncthreads();
                if (q >= 512u) break;
                attn_item(a, c, 255 - (int)(q >> 1), (int)(q & 1));
            }
        }
#endif
    }
    SEAM(5);
    if (IN(6)) { REFRESH(); DUP2(6, p6_mixnorm(a, c)); }
    SEAM(6);
#define WOUT_GEMM(PM0) do { pg8::StaticOrder S; S.init((const bf16_t*)(a.ws + WS_H), (const bf16_t*)(a.ws + WS_WOUT), 2048, 2048, 2048, L_ / 2, 2048, c.nb, c.bid, PM0); \
        EpiWout E{a.in[0], (const float*)(a.ws + WS_COND) + 2 * 2048, (bf16_t*)(a.ws + WS_X1)}; pg8::gemm_phase<EpiWout, pg8::StaticOrder>(lds, S, E); __syncthreads(); } while (0)
#define WQ_GEMM(PM0) do { pg8::StaticOrder S; S.init((const bf16_t*)(a.ws + WS_H), (const bf16_t*)(a.ws + WS_WQ), 2048, 2048, 2048, L_ / 2, 2048, c.nb, c.bid, PM0); \
        EpiBf16 E{(bf16_t*)(a.ws + WS_QP), 2048}; pg8::gemm_phase<EpiBf16, pg8::StaticOrder>(lds, S, E); __syncthreads(); } while (0)
#define PEER_STEPS(FIRST, COUNT) do { for (int s_ = (FIRST) + c.bid; s_ < (FIRST) + (COUNT); s_ += c.nb) peer_step<false>(a, c, s_ * 8); } while (0)
    if (IN(7)) { REFRESH(); WOUT_GEMM(0); }
    SEAM(7);
    if (IN(8)) { REFRESH(); p8_h2norm(a, c, 0, L_ / 2); }
    SEAM(8);
    if (IN(9)) { REFRESH(); WQ_GEMM(0); }
    SEAM(9);
    if (IN(10)) { REFRESH();
        if ((c.bid >> 3) & 1) PEER_STEPS(0, 512);
        WOUT_GEMM(32);
        if (!((c.bid >> 3) & 1)) PEER_STEPS(0, 512); }
    SEAM(10);
    if (IN(11)) { REFRESH(); p8_h2norm(a, c, L_ / 2, L_ / 2); }
    SEAM(11);
    if (IN(12)) { REFRESH();
        if ((c.bid >> 3) & 1) PEER_STEPS(512, 512);
        WQ_GEMM(32);
        if (!((c.bid >> 3) & 1)) PEER_STEPS(512, 512); }
    SEAM(12);
    if (IN(13)) { REFRESH(); PEER_STEPS(1024, 1024); }
#undef WOUT_GEMM
#undef WQ_GEMM
#undef PEER_STEPS
#undef IN
#undef SEAM
}

#ifndef N_LAUNCHES
#define N_LAUNCHES 1
#endif
extern "C" void kernel_launch(void* const* d_in, const int* in_sizes, int n_in, void* d_out, int out_size, void* d_ws, size_t ws_size, hipStream_t stream) {
    static int grid = 0;
    if (grid == 0) {
        if (n_in != 33 || out_size != L_ * D_ || ws_size < WS_END) { fprintf(stderr, "kernel_launch: unexpected shapes (n_in %d, out %d, ws %zu < %zu); nothing launched\n", n_in, out_size, ws_size, (size_t)WS_END); grid = -1; return; }
        int dev = 0, cus = 0, per_cu = 0;
        if (hipGetDevice(&dev) != hipSuccess || hipDeviceGetAttribute(&cus, hipDeviceAttributeMultiprocessorCount, dev) != hipSuccess) { grid = -1; return; }
        if (hipFuncSetAttribute((const void*)fwd, hipFuncAttributeMaxDynamicSharedMemorySize, LDS_BYTES) != hipSuccess) { fprintf(stderr, "kernel_launch: hipFuncSetAttribute failed\n"); grid = -1; return; }
        if (hipOccupancyMaxActiveBlocksPerMultiprocessor(&per_cu, (const void*)fwd, NTHREADS, LDS_BYTES) != hipSuccess || per_cu < 1) { fprintf(stderr, "kernel_launch: occupancy query says %d\n", per_cu); (void)hipGetLastError(); grid = -1; return; }
        grid = cus;
    }
    if (grid < 0) return;
    (void)hipMemsetAsync((char*)d_ws + WS_CTL, 0, CTL_BYTES, stream);
    Args a{};
    for (int i = 0; i < 33; ++i) a.in[i] = (const float*)d_in[i];
    a.out = (float*)d_out; a.ws = (unsigned char*)d_ws;
    if (N_LAUNCHES == 1) { a.ph_lo = 0; a.ph_hi = NPHASE; hipLaunchKernelGGL(fwd, dim3(grid), dim3(NTHREADS), LDS_BYTES, stream, a); }
    else for (int p = 0; p < NPHASE; ++p) { a.ph_lo = p; a.ph_hi = p + 1; hipLaunchKernelGGL(fwd, dim3(grid), dim3(NTHREADS), LDS_BYTES, stream, a); }
}
```

```cpp
#include <hip/hip_runtime.h>
#include <stdint.h>
#include <stdio.h>

#define LAS __attribute__((address_space(3)))
typedef unsigned short bf16_t;
typedef short bf16x8 __attribute__((ext_vector_type(8)));
typedef float f32x2 __attribute__((ext_vector_type(2)));
typedef float f32x4 __attribute__((ext_vector_type(4)));
typedef float f32x16 __attribute__((ext_vector_type(16)));
typedef unsigned u32x2 __attribute__((ext_vector_type(2)));
typedef unsigned u32x4 __attribute__((ext_vector_type(4)));
typedef __bf16 bfv2 __attribute__((ext_vector_type(2)));
typedef unsigned u32x6 __attribute__((ext_vector_type(6)));
typedef float f32x32 __attribute__((ext_vector_type(32)));

constexpr int L_ = 16384, D_ = 2048, DSSM = 1024, DATT = 1024, DIN = 3608, DIN_PAD = 3840;
constexpr int NADA = 12288;
constexpr float LOG2E = 1.4426950408889634f;
constexpr float QSCALE = 0.08838834764831845f * 1.4426950408889634f;
constexpr int TBN = 800;
constexpr int NTHREADS = 512;
constexpr int LDS_BYTES = 163840;

constexpr size_t al256(size_t x) { return (x + 255) & ~(size_t)255; }
constexpr size_t WS_CTL   = 0;                                  constexpr size_t CTL_BYTES = 65536;
constexpr size_t WS_CONDP = WS_CTL + CTL_BYTES;
constexpr size_t WS_COND  = WS_CONDP + 32 * 12288 * 4;
constexpr size_t WS_TB    = WS_COND + 12288 * 4;
constexpr size_t WS_BPE   = al256(WS_TB + 8 * TBN * 4);
constexpr size_t WS_S5P   = al256(WS_BPE + 2 * 256 * 4);
constexpr size_t WS_S5F   = WS_S5P + 2 * 64 * 64 * 2 * 4;
constexpr size_t WS_S5MT  = WS_S5F + 64 * 4 * 128 * 4;
constexpr size_t WS_S5WE  = WS_S5MT + (size_t)64 * 256 * 256 * 2;
constexpr size_t WS_S5WC  = WS_S5WE + (size_t)64 * 128 * 256 * 2;
constexpr size_t WS_WIN   = WS_S5WC + (size_t)64 * 256 * 128 * 2;
constexpr size_t WS_WGLU  = WS_WIN + (size_t)DIN_PAD * 2048 * 2;
constexpr size_t WS_WOUT  = WS_WGLU + (size_t)1024 * 1024 * 2;
constexpr size_t WS_WQ    = WS_WOUT + (size_t)2048 * 2048 * 2;
constexpr size_t WS_W1    = WS_WQ + (size_t)2048 * 2048 * 2;
constexpr size_t WS_W2    = WS_W1 + (size_t)2 * 256 * 4096 * 2;
constexpr size_t WS_PK    = WS_W2 + (size_t)2 * 128 * 256 * 2;
constexpr size_t WS_PU    = WS_PK + (size_t)2 * 128 * 128 * 2;
constexpr size_t WS_PV    = WS_PU + (size_t)16384 * 1024;
constexpr size_t WS_PSC   = WS_PV + (size_t)16384 * 1024;
constexpr size_t WS_BPEP  = WS_PSC + (size_t)2 * 16384 * 4;
constexpr size_t WS_H     = WS_BPEP + (size_t)32 * 2 * 256 * 4;
constexpr size_t WS_US    = WS_H + (size_t)16384 * 2048 * 2;
constexpr size_t WS_Q     = WS_US + (size_t)16384 * 1024 * 2;
constexpr size_t WS_QP    = WS_US;
constexpr size_t WS_KROW  = WS_Q + (size_t)16384 * 1024 * 2;
constexpr size_t WS_VROW  = WS_KROW + (size_t)6 * 16384 * 128 * 2;
constexpr size_t WS_VT    = WS_VROW + (size_t)2 * 16384 * 128 * 2 + 8192;
constexpr size_t WS_GATE  = WS_VT + (size_t)4 * 128 * 16384 * 2;
constexpr size_t WS_SLAB  = WS_GATE + (size_t)16384 * 24 * 4;
constexpr size_t WS_KC    = WS_SLAB + (size_t)2 * 4 * 2048 * 256 * 4;
constexpr size_t WS_VCT   = WS_KC + (size_t)2 * 1024 * 128 * 2;
constexpr size_t WS_Z     = WS_VCT + (size_t)2 * 128 * 1024 * 2;
constexpr size_t WS_YSSM  = WS_Z + (size_t)16384 * 1024 * 2;
constexpr size_t WS_YATT  = WS_YSSM + (size_t)16384 * 1024 * 2;
constexpr size_t WS_X1    = WS_Z;
constexpr size_t WS_END   = WS_YATT + (size_t)16384 * 1024 * 2;
static_assert(WS_END < (size_t)530 * 1024 * 1024, "workspace map too large");

struct Args { const float* in[33]; float* out; unsigned char* ws; int ph_lo, ph_hi; };

__device__ __forceinline__ unsigned cvt_pk_bf16(float lo, float hi) { bfv2 v; v[0] = (__bf16)lo; v[1] = (__bf16)hi; return __builtin_bit_cast(unsigned, v); }
__device__ __forceinline__ bf16_t f2bf(float f) { return (bf16_t)(cvt_pk_bf16(f, 0.f) & 0xffffu); }
__device__ __forceinline__ float bf2f(unsigned b) { return __uint_as_float(b << 16); }
__device__ __forceinline__ float bflo(unsigned w) { return __uint_as_float(w << 16); }
__device__ __forceinline__ float bfhi(unsigned w) { return __uint_as_float(w & 0xffff0000u); }
__device__ __forceinline__ float fexp2(float x) { return __builtin_amdgcn_exp2f(x); }
__device__ __forceinline__ float frcp(float x) { return __builtin_amdgcn_rcpf(x); }
__device__ __forceinline__ float sigmoidf_(float x) { return frcp(1.f + fexp2(-LOG2E * x)); }
__device__ __forceinline__ float gelu_tanh(float x) {
    const float u = x * (1.f + 0.044715f * x * x);
    return x * frcp(1.f + fexp2(-2.f * 0.7978845608028654f * LOG2E * u));
}
__device__ __forceinline__ float shfl_xor_f(float v, int m) { return __shfl_xor(v, m, 64); }
__device__ __forceinline__ float wave_sum(float v) {
#pragma unroll
    for (int m = 32; m >= 1; m >>= 1) v += __shfl_xor(v, m, 64);
    return v;
}
__device__ __forceinline__ float wave_max(float v) {
#pragma unroll
    for (int m = 32; m >= 1; m >>= 1) v = fmaxf(v, __shfl_xor(v, m, 64));
    return v;
}
template <int CTRL> __device__ __forceinline__ float dpp_f(float x) { return __int_as_float(__builtin_amdgcn_update_dpp(0, __float_as_int(x), CTRL, 0xf, 0xf, false)); }
__device__ __forceinline__ float wave_max_bcast(float v) {
    v = fmaxf(v, dpp_f<0xB1>(v)); v = fmaxf(v, dpp_f<0x4E>(v)); v = fmaxf(v, dpp_f<0x141>(v)); v = fmaxf(v, dpp_f<0x140>(v));
    v = fmaxf(v, __int_as_float(__builtin_amdgcn_update_dpp(__float_as_int(v), __float_as_int(v), 0x142, 0xa, 0xf, false)));
    v = fmaxf(v, __int_as_float(__builtin_amdgcn_update_dpp(__float_as_int(v), __float_as_int(v), 0x143, 0xc, 0xf, false)));
    return __int_as_float(__builtin_amdgcn_readlane(__float_as_int(v), 63));
}
__device__ __forceinline__ unsigned wave_umax_bcast(unsigned v) {
#define UDPP_(x, ctrl, rm) (unsigned)__builtin_amdgcn_update_dpp((int)(x), (int)(x), ctrl, rm, 0xf, false)
    v = max(v, UDPP_(v, 0xB1, 0xf)); v = max(v, UDPP_(v, 0x4E, 0xf)); v = max(v, UDPP_(v, 0x141, 0xf)); v = max(v, UDPP_(v, 0x140, 0xf));
    v = max(v, UDPP_(v, 0x142, 0xa)); v = max(v, UDPP_(v, 0x143, 0xc));
#undef UDPP_
    return (unsigned)__builtin_amdgcn_readlane((int)v, 63);
}
__device__ __forceinline__ float quad_sum(float x) { x += dpp_f<0xB1>(x); x += dpp_f<0x4E>(x); return x; }
template <int SEL> __device__ __forceinline__ f32x2 fp4_unpk(unsigned w) { return __builtin_amdgcn_cvt_scalef32_pk_f32_fp4(w, 1.0f, SEL); }
template <int SEL> __device__ __forceinline__ unsigned fp4_pk(unsigned w, float a, float b) { return __builtin_amdgcn_cvt_scalef32_pk_fp4_f32(w, a, b, 1.0f, SEL); }
__device__ __forceinline__ f32x4 mfma16(bf16x8 a, bf16x8 b, f32x4 c) { return __builtin_amdgcn_mfma_f32_16x16x32_bf16(a, b, c, 0, 0, 0); }
__device__ __forceinline__ f32x16 mfma32(bf16x8 a, bf16x8 b, f32x16 c) { return __builtin_amdgcn_mfma_f32_32x32x16_bf16(a, b, c, 0, 0, 0); }
#define XB_TMO      128
#define XB_XCNT(j)  (256  + 64 * (j))
#define XB_XSUB(j)  (1280 + 64 * (j))
#define XB_XGEN(j)  (2304 + 64 * (j))
#define XB_TOP      3328
#define XB_TOPGEN   3392
#define XCD_BAR_WORDS 3456
#define XB_SPIN_CAP (1u << 18)

__device__ __forceinline__ unsigned xb_ld(unsigned* p)              { return __hip_atomic_load(p, __ATOMIC_RELAXED, __HIP_MEMORY_SCOPE_AGENT); }
__device__ __forceinline__ unsigned xb_add(unsigned* p, unsigned v) { return __hip_atomic_fetch_add(p, v, __ATOMIC_RELAXED, __HIP_MEMORY_SCOPE_AGENT); }
__device__ __forceinline__ unsigned xb_xcc_id() { return (unsigned)__builtin_amdgcn_s_getreg((3 << 11) | 20) & 0xFu; }
#define XB_SPIN(cond, bar) do { unsigned _sp = 0; while (cond) { __builtin_amdgcn_s_sleep(1); \
    if ((++_sp & 255u) == 0u) { if (xb_ld(&(bar)[XB_TMO])) break; if (_sp > XB_SPIN_CAP) { atomicAdd(&(bar)[XB_TMO], 1u); break; } } } } while (0)

struct XcdBarrier {
    unsigned* bar; unsigned x;
    volatile LAS unsigned* st;
};
__device__ __forceinline__ XcdBarrier xcd_barrier_post(unsigned* bar, volatile LAS unsigned* st) {
    XcdBarrier b; b.bar = bar; b.x = xb_xcc_id(); b.st = st;
    if (threadIdx.x == 0) (void)xb_add(&bar[XB_XCNT(b.x)], 1u);
    return b;
}
__device__ __forceinline__ void xcd_barrier_complete(unsigned* bar, unsigned x, unsigned& nloc, unsigned& nx) {
    const unsigned G = gridDim.x * gridDim.y * gridDim.z;
    unsigned sum, cnt, mine, sp = 0u;
    for (;;) {
        sum = 0u; cnt = 0u; mine = 0u;
#pragma unroll
        for (unsigned j = 0; j < 16; ++j) { const unsigned c = xb_ld(&bar[XB_XCNT(j)]); sum += c; cnt += (c > 0u) ? 1u : 0u; mine = (j == x) ? c : mine; }
        if (sum == G) break;
        __builtin_amdgcn_s_sleep(1);
        if ((++sp & 255u) == 0u) { if (xb_ld(&bar[XB_TMO])) break; if (sp > XB_SPIN_CAP) { atomicAdd(&bar[XB_TMO], 1u); break; } }
    }
    nloc = mine > 0u ? mine : 1u; nx = cnt > 0u ? cnt : 1u;
}
__device__ __forceinline__ void xcd_barrier(const XcdBarrier& b) {
    asm volatile("s_waitcnt vmcnt(0)" ::: "memory");
    __syncthreads();
    if (threadIdx.x == 0) {
        unsigned* bar = b.bar;
        __builtin_amdgcn_s_waitcnt(0);
        unsigned nloc = b.st[0], nx = b.st[1];
        if (nloc == 0u) { xcd_barrier_complete(bar, b.x, nloc, nx); b.st[0] = nloc; b.st[1] = nx; }
        const unsigned old = xb_add(&bar[XB_XSUB(b.x)], 1u);
        const unsigned gen = old / nloc;
        if (old + 1u == (gen + 1u) * nloc) {
            __builtin_amdgcn_fence(__ATOMIC_RELEASE, "agent");
            asm volatile("s_waitcnt vmcnt(0)" ::: "memory");
            const unsigned og = xb_add(&bar[XB_TOP], 1u);
            const unsigned tg = og / nx;
            if (og + 1u == (tg + 1u) * nx) xb_add(&bar[XB_TOPGEN], 1u);
            else XB_SPIN(xb_ld(&bar[XB_TOPGEN]) == tg, bar);
            __builtin_amdgcn_fence(__ATOMIC_ACQUIRE, "agent");
            xb_add(&bar[XB_XGEN(b.x)], 1u);
            asm volatile("s_waitcnt vmcnt(0)" ::: "memory");
        } else {
            XB_SPIN(xb_ld(&bar[XB_XGEN(b.x)]) == gen, bar);
            __builtin_amdgcn_fence(__ATOMIC_ACQUIRE, "agent");
            asm volatile("s_waitcnt vmcnt(0)" ::: "memory");
        }
    }
    __syncthreads();
}

namespace pg8 {
constexpr int BM = 256, BK = 64, HALF = 128, HTB = HALF * BK * 2, STAGE_BYTES = 8 * HTB, NXCD = 8, WGM = 8;
__host__ __device__ __forceinline__ int lds_byte(int r, int c) { const int st = (r >> 4) * 2 + (c >> 5), rr = r & 15, cc = c & 31, ob = rr * 64 + cc * 2; return st * 1024 + (ob ^ (((ob >> 9) & 1) << 5)); }
__host__ __device__ __forceinline__ void stage_rc(int b, int& R, int& C) { const int st = b / 1024, sb = b % 1024, swz = sb ^ (((sb >> 9) & 1) << 5); R = (st >> 1) * 16 + swz / 64; C = (st & 1) * 32 + (swz % 64) / 2; }
__host__ __device__ __forceinline__ int perm32(int rho) { const int n = rho >> 4, i = rho & 15; return 8 * (i >> 2) + 4 * n + (i & 3); }

struct Unit { int pm, pn, z; };
struct StaticOrder {
    const bf16_t* A; const bf16_t* Bt; int lda, ldb, K;
    int nM, nN, nwg, G, c, pm0;
    __device__ void init(const bf16_t* A_, const bf16_t* Bt_, int lda_, int ldb_, int K_, int M, int N, int G_, int c_, int pm0_ = 0) { A = A_; Bt = Bt_; lda = lda_; ldb = ldb_; K = K_; nM = M / BM; nN = N / BM; nwg = nM * nN; G = G_; c = c_; pm0 = pm0_; }
    __device__ bool next(int i, Unit& u) const {
        const long Lx = (long)i * G + c; if (Lx >= nwg) return false;
        int wgid = (int)Lx; { const int q = nwg / NXCD, r = nwg % NXCD, xcd = wgid % NXCD, off = wgid / NXCD; wgid = (xcd < r ? xcd * (q + 1) : r * (q + 1) + (xcd - r) * q) + off; }
        const int nig = WGM * nN, gid = wgid / nig, fm = gid * WGM, gsz = (nM - fm) < WGM ? (nM - fm) : WGM;
        u.pm = pm0 + fm + ((wgid % nig) % gsz); u.pn = (wgid % nig) / gsz; u.z = 0; return true;
    }
    __device__ __forceinline__ const char* a_base(const Unit& u) const { return (const char*)(A + (size_t)u.pm * BM * lda); }
    __device__ __forceinline__ const char* b_base(const Unit& u) const { return (const char*)(Bt + (size_t)u.pn * BM * ldb); }
};

template <class Epi, class Sched>
__device__ __forceinline__ void gemm_phase(LAS unsigned char* lds, const Sched& S, const Epi& E) {
    const int tid = threadIdx.x, wid = __builtin_amdgcn_readfirstlane(tid >> 6), lane = tid & 63, wr = wid >> 2, wc = wid & 3, fr = lane & 15, fq = lane >> 4;
    const int K = S.K, nt = K / BK, lda = S.lda, ldb = S.ldb;
    unsigned voffA[2], voffB[2];
#pragma unroll
    for (int i = 0; i < 2; ++i) { int R, C; stage_rc(tid * 16 + i * 8192, R, C); const int Rb = Epi::PERM ? ((R & ~31) + perm32(R & 31)) : R;
        voffA[i] = (unsigned)(R * lda + C) * 2u; voffB[i] = (unsigned)(Rb * ldb + C) * 2u; }
    const size_t kstep = (size_t)(BK * 2);
    const size_t hstepA = (size_t)HALF * lda * 2, hstepB = (size_t)HALF * ldb * 2;
    const unsigned ldsw = (unsigned)wid * 1024u;
    const int aoff = lds_byte(wr * 64 + fr, fq * 8), boff = lds_byte(wc * 32 + fr, fq * 8);
#define PG8_SA(b, h) (((b) * 2 + (h)) * HTB)
#define PG8_SB(b, h) ((4 + (b) * 2 + (h)) * HTB)
#define PG8_STAGE(bufoff, gbase, voff) do { _Pragma("unroll") for (int _i = 0; _i < 2; ++_i) \
        __builtin_amdgcn_global_load_lds((const unsigned*)((const char*)(gbase) + (voff)[_i]), (LAS unsigned*)(lds + (bufoff) + ldsw + _i * 8192), 16, 0, 0); } while (0)
#define PG8_LDA(dst, b, h) do { _Pragma("unroll") for (int m = 0; m < 4; ++m) _Pragma("unroll") for (int k = 0; k < 2; ++k) dst[m][k] = *(const LAS bf16x8*)(lds + PG8_SA(b, h) + aoff + m * 2048 + k * 1024); } while (0)
#define PG8_LDB(dst, b, h) do { _Pragma("unroll") for (int n = 0; n < 2; ++n) _Pragma("unroll") for (int k = 0; k < 2; ++k) dst[n][k] = *(const LAS bf16x8*)(lds + PG8_SB(b, h) + boff + n * 2048 + k * 1024); } while (0)
#define PG8_MMA(ai, bj, At, Bt) do { __builtin_amdgcn_s_setprio(1); _Pragma("unroll") for (int m = 0; m < 4; ++m) _Pragma("unroll") for (int n = 0; n < 2; ++n) _Pragma("unroll") for (int k = 0; k < 2; ++k) \
        acc[ai][bj][m][n] = __builtin_amdgcn_mfma_f32_16x16x32_bf16(Bt[n][k], At[m][k], acc[ai][bj][m][n], 0, 0, 0); __builtin_amdgcn_s_setprio(0); } while (0)
#define PG8_WAIT_V(n) asm volatile("s_waitcnt vmcnt(" #n ")" ::: "memory")
#define PG8_WAIT_L(n) asm volatile("s_waitcnt lgkmcnt(" #n ")" ::: "memory")
#define PG8_BAR __builtin_amdgcn_s_barrier()
#define PG8_SCHED __builtin_amdgcn_sched_barrier(0)
    Unit cur, nxt; int ui = 0;
    if (!S.next(0, cur)) return;
    f32x4 acc[2][2][4][2];
#pragma unroll
    for (int a = 0; a < 2; ++a)
#pragma unroll
        for (int b = 0; b < 2; ++b)
#pragma unroll
            for (int m = 0; m < 4; ++m)
#pragma unroll
                for (int n = 0; n < 2; ++n) acc[a][b][m][n] = (f32x4){0.f, 0.f, 0.f, 0.f};
    bf16x8 At[4][2], B0[2][2], B1[2][2];
    const char* cA = S.a_base(cur); const char* cB = S.b_base(cur);
    PG8_STAGE(PG8_SB(0, 0), cB, voffB); PG8_STAGE(PG8_SA(0, 0), cA, voffA); PG8_STAGE(PG8_SB(0, 1), cB + hstepB, voffB); PG8_STAGE(PG8_SA(0, 1), cA + hstepA, voffA);
    if (wr == 1) PG8_BAR;
    PG8_WAIT_V(4); PG8_BAR;
    PG8_STAGE(PG8_SB(1, 0), cB + kstep, voffB); PG8_STAGE(PG8_SA(1, 0), cA + kstep, voffA); PG8_STAGE(PG8_SB(1, 1), cB + hstepB + kstep, voffB);
    PG8_WAIT_V(6); PG8_BAR;
    for (;;) {
        const bool has_next = S.next(ui + 1, nxt);
        const char* nA = has_next ? S.a_base(nxt) : cA; const char* nB = has_next ? S.b_base(nxt) : cB;
        for (int t = 0; t < nt; t += 2) {
            const bool last = (t == nt - 2);
            const char* a1 = cA + (size_t)(t + 1) * kstep;
            const char* a2 = last ? nA : cA + (size_t)(t + 2) * kstep; const char* b2 = last ? nB : cB + (size_t)(t + 2) * kstep;
            const char* a3 = a2 + kstep; const char* b3 = b2 + kstep;
            PG8_LDB(B0, 0, 0); PG8_SCHED; PG8_LDA(At, 0, 0); PG8_STAGE(PG8_SA(1, 1), a1 + hstepA, voffA);
            PG8_WAIT_L(8); PG8_BAR; PG8_WAIT_L(0); PG8_MMA(0, 0, At, B0); PG8_BAR; PG8_SCHED;
            PG8_LDB(B1, 0, 1); PG8_STAGE(PG8_SB(0, 0), b2, voffB);
            PG8_BAR; PG8_WAIT_L(0); PG8_MMA(0, 1, At, B1); PG8_BAR;
            PG8_LDA(At, 0, 1); PG8_STAGE(PG8_SA(0, 0), a2, voffA);
            PG8_BAR; PG8_WAIT_L(0); PG8_MMA(1, 0, At, B0); PG8_BAR; PG8_SCHED;
            PG8_STAGE(PG8_SB(0, 1), b2 + hstepB, voffB);
            PG8_WAIT_V(6); PG8_BAR; PG8_MMA(1, 1, At, B1); PG8_BAR;
            PG8_LDB(B0, 1, 0); PG8_SCHED; PG8_LDA(At, 1, 0); PG8_STAGE(PG8_SA(0, 1), a2 + hstepA, voffA);
            PG8_WAIT_L(8); PG8_BAR; PG8_WAIT_L(0); PG8_MMA(0, 0, At, B0); PG8_BAR; PG8_SCHED;
            PG8_LDB(B1, 1, 1); PG8_STAGE(PG8_SB(1, 0), b3, voffB);
            PG8_BAR; PG8_WAIT_L(0); PG8_MMA(0, 1, At, B1); PG8_BAR;
            PG8_LDA(At, 1, 1); PG8_STAGE(PG8_SA(1, 0), a3, voffA);
            PG8_BAR; PG8_WAIT_L(0); PG8_MMA(1, 0, At, B0); PG8_BAR; PG8_SCHED;
            PG8_STAGE(PG8_SB(1, 1), b3 + hstepB, voffB);
            PG8_WAIT_V(6); PG8_BAR; PG8_MMA(1, 1, At, B1); PG8_BAR;
        }
        E(acc, cur, wr, wc, fr, fq);
        if (!has_next) break;
#pragma unroll
        for (int a = 0; a < 2; ++a)
#pragma unroll
            for (int b = 0; b < 2; ++b)
#pragma unroll
                for (int m = 0; m < 4; ++m)
#pragma unroll
                    for (int n = 0; n < 2; ++n) acc[a][b][m][n] = (f32x4){0.f, 0.f, 0.f, 0.f};
        cur = nxt; cA = nA; cB = nB; ++ui;
    }
    PG8_WAIT_V(0);
    if (wr == 0) PG8_BAR;
    PG8_BAR;
#undef PG8_SA
#undef PG8_SB
#undef PG8_STAGE
#undef PG8_LDA
#undef PG8_LDB
#undef PG8_MMA
#undef PG8_WAIT_V
#undef PG8_WAIT_L
#undef PG8_BAR
#undef PG8_SCHED
}
}
using pg8::Unit;
__device__ __forceinline__ u32x4 pack8(const f32x4& v0, const f32x4& v1) {
    u32x4 o; o[0] = cvt_pk_bf16(v0[0], v0[1]); o[1] = cvt_pk_bf16(v0[2], v0[3]); o[2] = cvt_pk_bf16(v1[0], v1[1]); o[3] = cvt_pk_bf16(v1[2], v1[3]); return o;
}
struct EpiWin {
    static constexpr bool PERM = true;
    bf16_t* US; bf16_t* Q; bf16_t* KROW; bf16_t* VROW; bf16_t* VT; float* GATE;
    __device__ __forceinline__ void operator()(const f32x4 (&acc)[2][2][4][2], const Unit& u, int wr, int wc, int fr, int fq) const {
        const int row0 = u.pm * 256 + wr * 64 + fr; const int pn = u.pn;
#pragma unroll
        for (int ai = 0; ai < 2; ++ai)
#pragma unroll
            for (int m = 0; m < 4; ++m) {
                const int row = row0 + ai * 128 + m * 16;
#pragma unroll
                for (int bj = 0; bj < 2; ++bj) {
                    const f32x4 v0 = acc[ai][bj][m][0], v1 = acc[ai][bj][m][1];
                    const int cin = bj * 128 + wc * 32 + 8 * fq;
                    if (pn < 4) { *(u32x4*)(US + (size_t)row * 1024 + pn * 256 + cin) = pack8(v0, v1); }
                    else if (pn < 8) { *(u32x4*)(Q + (size_t)row * 1024 + (pn - 4) * 256 + cin) = pack8(v0 * QSCALE, v1 * QSCALE); }
                    else if (pn < 14) {
                        const int kvi = pn - 8, branch = kvi >> 1, kvsel = kvi & 1, g = bj, d0 = wc * 32 + 8 * fq;
                        if (kvsel == 0) { *(u32x4*)(KROW + ((size_t)(branch * 2 + g) * L_ + row) * 128 + d0) = pack8(v0, v1); }
                        else if (branch == 0) { *(u32x4*)(VROW + ((size_t)g * L_ + row) * 128 + d0) = pack8(v0, v1); }
                        else {
                            const int prow = ((row & ~12) | ((row & 4) << 1) | ((row & 8) >> 1));
                            bf16_t* vt = VT + ((size_t)((branch - 1) * 2 + g) * 128 + d0) * L_ + prow;
#pragma unroll
                            for (int e = 0; e < 4; ++e) { vt[(size_t)e * L_] = f2bf(v0[e]); vt[(size_t)(e + 4) * L_] = f2bf(v1[e]); }
                        }
                    } else {
                        if (cin < 24) {
                            float* gp = GATE + (size_t)row * 24 + cin;
                            f32x4 s0, s1;
#pragma unroll
                            for (int e = 0; e < 4; ++e) { s0[e] = sigmoidf_(v0[e]); s1[e] = sigmoidf_(v1[e]); }
                            *(f32x4*)gp = s0; *(f32x4*)(gp + 4) = s1;
                        }
                    }
                }
            }
    }
};
struct EpiGlu {
    static constexpr bool PERM = true;
    const bf16_t* Z; const float* bglu; bf16_t* Y;
    __device__ __forceinline__ void operator()(const f32x4 (&acc)[2][2][4][2], const Unit& u, int wr, int wc, int fr, int fq) const {
        const int row0 = u.pm * 256 + wr * 64 + fr;
#pragma unroll
        for (int bj = 0; bj < 2; ++bj) {
            const int col = u.pn * 256 + bj * 128 + wc * 32 + 8 * fq;
            const f32x4 b0 = *(const f32x4*)(bglu + col), b1 = *(const f32x4*)(bglu + col + 4);
#pragma unroll
            for (int ai = 0; ai < 2; ++ai)
#pragma unroll
                for (int m = 0; m < 4; ++m) {
                    const int row = row0 + ai * 128 + m * 16;
                    const u32x4 zz = *(const u32x4*)(Z + (size_t)row * 1024 + col);
                    const f32x4 v0 = acc[ai][bj][m][0] + b0, v1 = acc[ai][bj][m][1] + b1;
                    f32x4 o0, o1;
                    o0[0] = bflo(zz[0]) * sigmoidf_(v0[0]); o0[1] = bfhi(zz[0]) * sigmoidf_(v0[1]); o0[2] = bflo(zz[1]) * sigmoidf_(v0[2]); o0[3] = bfhi(zz[1]) * sigmoidf_(v0[3]);
                    o1[0] = bflo(zz[2]) * sigmoidf_(v1[0]); o1[1] = bfhi(zz[2]) * sigmoidf_(v1[1]); o1[2] = bflo(zz[3]) * sigmoidf_(v1[2]); o1[3] = bfhi(zz[3]) * sigmoidf_(v1[3]);
                    *(u32x4*)(Y + (size_t)row * 1024 + col) = pack8(o0, o1);
                }
        }
    }
};
struct EpiWout {
    static constexpr bool PERM = true;
    const float* X; const float* g1; bf16_t* X1;
    __device__ __forceinline__ void operator()(const f32x4 (&acc)[2][2][4][2], const Unit& u, int wr, int wc, int fr, int fq) const {
        const int row0 = u.pm * 256 + wr * 64 + fr, col0 = u.pn * 256 + wc * 32 + 8 * fq;
#pragma unroll
        for (int bj = 0; bj < 2; ++bj) {
            const int col = col0 + bj * 128;
            const f32x4 g0 = *(const f32x4*)(g1 + col), g4 = *(const f32x4*)(g1 + col + 4);
#pragma unroll
            for (int ai = 0; ai < 2; ++ai)
#pragma unroll
                for (int m = 0; m < 4; ++m) {
                    const size_t off = (size_t)(row0 + ai * 128 + m * 16) * 2048 + col;
                    const f32x4 x0 = *(const f32x4*)(X + off), x4 = *(const f32x4*)(X + off + 4);
                    *(u32x4*)(X1 + off) = pack8(x0 + g0 * acc[ai][bj][m][0], x4 + g4 * acc[ai][bj][m][1]);
                }
        }
    }
};
struct EpiBf16 {
    static constexpr bool PERM = true;
    bf16_t* O; int ldc;
    __device__ __forceinline__ void operator()(const f32x4 (&acc)[2][2][4][2], const Unit& u, int wr, int wc, int fr, int fq) const {
        const int row0 = u.pm * 256 + wr * 64 + fr, col0 = u.pn * 256 + wc * 32 + 8 * fq;
#pragma unroll
        for (int ai = 0; ai < 2; ++ai)
#pragma unroll
            for (int m = 0; m < 4; ++m)
#pragma unroll
                for (int bj = 0; bj < 2; ++bj)
                    *(u32x4*)(O + (size_t)(row0 + ai * 128 + m * 16) * ldc + col0 + bj * 128) = pack8(acc[ai][bj][m][0], acc[ai][bj][m][1]);
    }
};
struct EpiSlab {
    static constexpr bool PERM = false;
    float* SL;
    __device__ __forceinline__ void operator()(const f32x4 (&acc)[2][2][4][2], const Unit& u, int wr, int wc, int fr, int fq) const {
        float* base = SL + (size_t)u.z * 2048 * 256;
        const int row0 = u.pm * 256 + wr * 64 + fr, col0 = wc * 32 + 4 * fq;
#pragma unroll
        for (int ai = 0; ai < 2; ++ai)
#pragma unroll
            for (int m = 0; m < 4; ++m)
#pragma unroll
                for (int bj = 0; bj < 2; ++bj)
#pragma unroll
                    for (int n = 0; n < 2; ++n)
                        *(f32x4*)(base + (size_t)(row0 + ai * 128 + m * 16) * 256 + col0 + bj * 128 + n * 16) = acc[ai][bj][m][n];
    }
};
struct CmpOrder {
    const bf16_t* KROW; const bf16_t* VROW; const bf16_t* W1; int lda, ldb, K; int G, c;
    __device__ bool next(int i, Unit& u) const {
        const int x = i * G + c; if (x >= 64) return false;
        const int kvsel = x >> 5, pm = (x & 31) >> 2, ks = x & 3; u.pm = pm; u.pn = 0; u.z = kvsel * 4 + ks; return true;
    }
    __device__ __forceinline__ const char* a_base(const Unit& u) const { return (const char*)(((u.z >> 2) ? VROW : KROW) + (size_t)u.pm * 256 * 2048 + (u.z & 3) * 1024); }
    __device__ __forceinline__ const char* b_base(const Unit& u) const { return (const char*)(W1 + (size_t)(u.z >> 2) * 256 * 4096 + (u.z & 3) * 1024); }
};
struct Ctx { int bid, nb, tid, wave, lane; LAS unsigned char* lds; };

__device__ __forceinline__ void p0_cond(const Args& a, const Ctx& c) {
    const float* cv = a.in[1]; const float* w = a.in[2]; float* condp = (float*)(a.ws + WS_CONDP);
    for (int u = c.bid * 8 + c.wave; u < 1536; u += c.nb * 8) {
        const int cc = u % 48, kc = u / 48;
        const float* wp = w + (size_t)(kc * 64) * NADA + cc * 256 + c.lane * 4;
        f32x4 acc = {0.f, 0.f, 0.f, 0.f};
#pragma unroll 16
        for (int k = 0; k < 64; ++k) { const float x = cv[kc * 64 + k]; const float s = x / (1.f + __expf(-x)); acc += s * *(const f32x4*)(wp + (size_t)k * NADA); }
        *(f32x4*)(condp + (size_t)kc * NADA + cc * 256 + c.lane * 4) = acc;
    }
}
__device__ __forceinline__ void conv_T(const float* src, int K, int N, bf16_t* dst, int Npad, const Ctx& c) {
    LAS float* tile = (LAS float*)c.lds;
    const int nkt = K / 64, ntiles = nkt * (Npad / 64);
    const int r = c.tid >> 4, c4 = c.tid & 15;
    f32x4 v[2];
#define CONVT_LD(tix_) do { const int nt_ = (tix_) / nkt, kt_ = (tix_) % nkt, n_ = nt_ * 64 + 4 * c4; _Pragma("unroll") for (int i = 0; i < 2; ++i) { const int k_ = kt_ * 64 + r + 32 * i; v[i] = (f32x4){0.f, 0.f, 0.f, 0.f}; if (n_ < N) v[i] = *(const f32x4*)(src + (size_t)k_ * N + n_); } } while (0)
    if (c.bid < ntiles) CONVT_LD(c.bid);
    for (int tix = c.bid; tix < ntiles; tix += c.nb) {
        const int nt = tix / nkt, kt = tix % nkt;
#pragma unroll
        for (int i = 0; i < 2; ++i) { LAS float* tp = tile + (r + 32 * i) * 65 + 4 * c4; tp[0] = v[i][0]; tp[1] = v[i][1]; tp[2] = v[i][2]; tp[3] = v[i][3]; }
        __syncthreads();
        if (tix + c.nb < ntiles) CONVT_LD(tix + c.nb);
        { const int n = c.tid >> 3, kq = c.tid & 7; float w[8];
#pragma unroll
          for (int j = 0; j < 8; ++j) w[j] = tile[(kq * 8 + j) * 65 + n];
          u32x4 o; o[0] = cvt_pk_bf16(w[0], w[1]); o[1] = cvt_pk_bf16(w[2], w[3]); o[2] = cvt_pk_bf16(w[4], w[5]); o[3] = cvt_pk_bf16(w[6], w[7]);
          *(u32x4*)(dst + (size_t)(nt * 64 + n) * K + kt * 64 + kq * 8) = o; }
        __syncthreads();
    }
#undef CONVT_LD
}
__device__ __forceinline__ void conv_fp4rows(const float* src, unsigned char* dst4, float* scl, int rows, const Ctx& c) {
    const int stride = c.nb * 8;
    int row = c.bid * 8 + c.wave;
    f32x4 v[8], w[8];
    if (row < rows) {
#pragma unroll
        for (int j = 0; j < 8; ++j) v[j] = *(const f32x4*)(src + (size_t)row * 2048 + c.lane * 32 + j * 4);
    }
    for (; row < rows; row += stride) {
        const int nrow = row + stride;
        if (nrow < rows) {
#pragma unroll
            for (int j = 0; j < 8; ++j) w[j] = *(const f32x4*)(src + (size_t)nrow * 2048 + c.lane * 32 + j * 4);
        }
        float mx = 0.f;
#pragma unroll
        for (int j = 0; j < 8; ++j) mx = fmaxf(mx, fmaxf(fmaxf(fabsf(v[j][0]), fabsf(v[j][1])), fmaxf(fabsf(v[j][2]), fabsf(v[j][3]))));
        mx = wave_max(mx);
        const float s = mx > 0.f ? 6.f / mx : 1.f;
        if (c.lane == 0) scl[row] = mx > 0.f ? mx * (1.f / 6.f) : 1.f;
        u32x4 pk = {0u, 0u, 0u, 0u};
#pragma unroll
        for (int d = 0; d < 4; ++d) {
            unsigned wq = 0u;
            wq = fp4_pk<0>(wq, v[2 * d][0] * s, v[2 * d][1] * s); wq = fp4_pk<1>(wq, v[2 * d][2] * s, v[2 * d][3] * s);
            wq = fp4_pk<2>(wq, v[2 * d + 1][0] * s, v[2 * d + 1][1] * s); wq = fp4_pk<3>(wq, v[2 * d + 1][2] * s, v[2 * d + 1][3] * s);
            pk[d] = wq;
        }
        *(u32x4*)(dst4 + (size_t)row * 1024 + c.lane * 16) = pk;
#pragma unroll
        for (int j = 0; j < 8; ++j) v[j] = w[j];
    }
}
__device__ __forceinline__ void conv_E(const float* src, bf16_t* dst, size_t n8, const Ctx& c) {
    const size_t stride = (size_t)c.nb * NTHREADS;
    for (size_t i = (size_t)c.bid * NTHREADS + c.tid; i < n8; i += stride) {
        const f32x4 x = *(const f32x4*)(src + i * 8), y = *(const f32x4*)(src + i * 8 + 4);
        *(u32x4*)(dst + i * 8) = pack8(x, y);
    }
}
__device__ __forceinline__ int t5_bucket(int n) {
    if (n < 16) return n;
    const float scaled = logf((float)n / 16.f) / logf(64.f);
    const int large = 16 + (int)(scaled * 16.f);
    return large < 31 ? large : 31;
}
__device__ __forceinline__ void p0_tb(const Args& a, const Ctx& c) {
    float* tb = (float*)(a.ws + WS_TB); const float* rb = a.in[26];
    for (int i = c.bid * NTHREADS + c.tid; i < 8 * TBN; i += c.nb * NTHREADS) { const int head = i / TBN, dist = i % TBN; tb[i] = rb[t5_bucket(dist) * 8 + head] * LOG2E; }
}
__device__ __forceinline__ void p0_bpe(const Args& a, const Ctx& c, int part) {
    const int n = c.tid & 255, kv = c.tid >> 8;
    const float* pe = a.in[kv ? 23 : 20]; const float* w1 = a.in[kv ? 24 : 21]; float* bpep = (float*)(a.ws + WS_BPEP);
    float s = 0.f;
#pragma unroll 16
    for (int k = part * 128; k < part * 128 + 128; ++k) s += pe[k] * w1[(size_t)k * 256 + n];
    bpep[(part * 2 + kv) * 256 + n] = s;
}
__device__ __forceinline__ void p0_s5(const Args& a, const Ctx& c, int g, int part) {
    LAS float* ar = (LAS float*)c.lds;
    LAS float* ai = ar + 17 * 64;
    LAS float* bbr = ai + 17 * 64;
    LAS float* bbi = bbr + 1024;
    LAS float* cr = bbi + 1024;
    LAS float* ci = cr + 1024;
    LAS float* kd = ci + 1024;
    const int tid = c.tid;
    if (tid < 64) {
        const int p = tid; const float dt = expf(a.in[12][g]); const float lr = a.in[10][g * 64 + p], li = a.in[11][g * 64 + p];
        for (int d = 0; d <= 16; ++d) { const float mag = expf(lr * dt * (float)d), ang = li * dt * (float)d; ar[d * 64 + p] = mag * cosf(ang); ai[d * 64 + p] = mag * sinf(ang); }
        const float nr = ar[64 + p] - 1.f, ni = ai[64 + p], den = lr * lr + li * li;
        const float wre = (nr * lr + ni * li) / den, wim = (ni * lr - nr * li) / den;
        for (int h = 0; h < 16; ++h) { const float br = a.in[13][(g * 64 + p) * 16 + h], bi = a.in[14][(g * 64 + p) * 16 + h]; bbr[p * 16 + h] = wre * br - wim * bi; bbi[p * 16 + h] = wre * bi + wim * br; }
        if (part == 0) {
        float* s5p = (float*)(a.ws + WS_S5P);
        float xr = ar[16 * 64 + p], xi = ai[16 * 64 + p];
        s5p[(g * 64 + p) * 2] = xr; s5p[(g * 64 + p) * 2 + 1] = xi;
        for (int s = 0; s < 8; ++s) { const float tr = xr * xr - xi * xi, ti = 2.f * xr * xi; xr = tr; xi = ti; }
        s5p[64 * 64 * 2 + (g * 64 + p) * 2] = xr; s5p[64 * 64 * 2 + (g * 64 + p) * 2 + 1] = xi;
        }
    }
    for (int e = tid; e < 1024; e += NTHREADS) { cr[e] = a.in[15][g * 1024 + e]; ci[e] = a.in[16][g * 1024 + e]; }
    __syncthreads();
    for (int e = tid; e < 1024 * (part + 1); e += NTHREADS) {
        const int d = e >> 8, h1 = (e >> 4) & 15, h = e & 15; float s = 0.f;
        for (int p = 0; p < 64; ++p) { const float Cr = cr[h1 * 64 + p], Ci = ci[h1 * 64 + p], Ar = ar[d * 64 + p], Ai = ai[d * 64 + p];
            const float Gr = Cr * Ar - Ci * Ai, Gi = Cr * Ai + Ci * Ar; s += Gr * bbr[p * 16 + h] - Gi * bbi[p * 16 + h]; }
        if (d == 0 && h1 == h) s += a.in[17][g * 16 + h];
        kd[e] = s;
    }
    __syncthreads();
    bf16_t* MT = (bf16_t*)(a.ws + WS_S5MT) + (size_t)g * 65536;
    bf16_t* WE = (bf16_t*)(a.ws + WS_S5WE) + (size_t)g * 32768;
    bf16_t* WC = (bf16_t*)(a.ws + WS_S5WC) + (size_t)g * 32768;
    for (int e = 16384 * part + tid; e < 16384 * (part + 1); e += NTHREADS) { const int n = e >> 8, k = e & 255, j = n >> 4, h1 = n & 15, i = k >> 4, h = k & 15;
        MT[e] = f2bf(i <= j ? kd[(j - i) * 256 + h1 * 16 + h] : 0.f); }
    for (int e = 8192 * part + tid; e < 8192 * (part + 1); e += NTHREADS) { const int n = e >> 8, k = e & 255, cc = n >> 6, p = n & 63, i = k >> 4, h = k & 15;
        const float Ar = ar[(15 - i) * 64 + p], Ai = ai[(15 - i) * 64 + p], Br = bbr[p * 16 + h], Bi = bbi[p * 16 + h];
        WE[e] = f2bf(cc ? (Ar * Bi + Ai * Br) : (Ar * Br - Ai * Bi)); }
    for (int e = 8192 * part + tid; e < 8192 * (part + 1); e += NTHREADS) { const int n = e >> 7, k = e & 127, j = n >> 4, h1 = n & 15, cc = k >> 6, p = k & 63;
        const float Cr = cr[h1 * 64 + p], Ci = ci[h1 * 64 + p], Ar = ar[(j + 1) * 64 + p], Ai = ai[(j + 1) * 64 + p];
        WC[e] = f2bf(cc ? -(Cr * Ai + Ci * Ar) : (Cr * Ar - Ci * Ai)); }
    __syncthreads();
}
__device__ __forceinline__ void p0_prologue(const Args& a, const Ctx& c) {
    for (int u = c.bid; u < 256; u += c.nb) p0_s5(a, c, u >> 2, u & 3);
    for (int u = 0; u < 32; ++u) if (c.bid == (8 * u + 7) % c.nb) p0_bpe(a, c, u);
    p0_tb(a, c);
    p0_cond(a, c);
    conv_T(a.in[6], 2048, DIN, (bf16_t*)(a.ws + WS_WIN), DIN_PAD, c);
    conv_T(a.in[18], 1024, 1024, (bf16_t*)(a.ws + WS_WGLU), 1024, c);
    conv_T(a.in[7], 2048, 2048, (bf16_t*)(a.ws + WS_WOUT), 2048, c);
    conv_T(a.in[27], 2048, 2048, (bf16_t*)(a.ws + WS_WQ), 2048, c);
    conv_T(a.in[21], 4096, 256, (bf16_t*)(a.ws + WS_W1), 256, c);
    conv_T(a.in[24], 4096, 256, (bf16_t*)(a.ws + WS_W1) + 256 * 4096, 256, c);
    conv_T(a.in[22], 256, 128, (bf16_t*)(a.ws + WS_W2), 128, c);
    conv_T(a.in[25], 256, 128, (bf16_t*)(a.ws + WS_W2) + 128 * 256, 128, c);
    conv_E(a.in[28], (bf16_t*)(a.ws + WS_PK), 128 * 128 / 8, c);
    conv_E(a.in[29], (bf16_t*)(a.ws + WS_PK) + 128 * 128, 128 * 128 / 8, c);
    conv_fp4rows(a.in[30], a.ws + WS_PU, (float*)(a.ws + WS_PSC), 16384, c);
    conv_fp4rows(a.in[31], a.ws + WS_PV, (float*)(a.ws + WS_PSC) + 16384, 16384, c);
}

__device__ __forceinline__ void norm_rows(const float* X, bf16_t* O, LAS const float* Ab, LAS const float* Bb, const Ctx& c, int row0 = 0, int nrows = L_) {
    for (int t = row0 + c.bid * 8 + c.wave; t < row0 + nrows; t += c.nb * 8) {
        const float* xr = X + (size_t)t * 2048 + c.lane * 4;
        f32x4 v[8]; float ss = 0.f;
#pragma unroll
        for (int j = 0; j < 8; ++j) { v[j] = *(const f32x4*)(xr + j * 256); ss += v[j][0] * v[j][0] + v[j][1] * v[j][1] + v[j][2] * v[j][2] + v[j][3] * v[j][3]; }
        ss = wave_sum(ss);
        const float rstd = rsqrtf(ss * (1.f / 2048.f) + 1e-6f);
#pragma unroll
        for (int j = 0; j < 8; ++j) {
            const int col = j * 256 + c.lane * 4;
            const f32x4 A = *(const LAS f32x4*)(Ab + col), B = *(const LAS f32x4*)(Bb + col);
            const f32x4 o = v[j] * rstd * A + B;
            u32x2 w; w[0] = cvt_pk_bf16(o[0], o[1]); w[1] = cvt_pk_bf16(o[2], o[3]);
            *(u32x2*)(O + (size_t)t * 2048 + col) = w;
        }
    }
}
__device__ __forceinline__ void norm_rows_bf16(const bf16_t* X, bf16_t* O, LAS const float* Ab, LAS const float* Bb, const Ctx& c, int row0, int nrows) {
    for (int t = row0 + c.bid * 8 + c.wave; t < row0 + nrows; t += c.nb * 8) {
        const bf16_t* xr = X + (size_t)t * 2048 + c.lane * 8;
        u32x4 w[4]; float ss = 0.f;
#pragma unroll
        for (int j = 0; j < 4; ++j) { w[j] = *(const u32x4*)(xr + j * 512);
#pragma unroll
            for (int e = 0; e < 4; ++e) { const float a0 = bflo(w[j][e]), a1 = bfhi(w[j][e]); ss += a0 * a0 + a1 * a1; } }
        ss = wave_sum(ss);
        const float rstd = rsqrtf(ss * (1.f / 2048.f) + 1e-6f);
#pragma unroll
        for (int j = 0; j < 4; ++j) {
            const int col = j * 512 + c.lane * 8;
            const f32x4 A0 = *(const LAS f32x4*)(Ab + col), A1 = *(const LAS f32x4*)(Ab + col + 4), B0 = *(const LAS f32x4*)(Bb + col), B1 = *(const LAS f32x4*)(Bb + col + 4);
            f32x4 o0, o1;
#pragma unroll
            for (int e = 0; e < 2; ++e) { o0[2 * e] = bflo(w[j][e]) * rstd * A0[2 * e] + B0[2 * e]; o0[2 * e + 1] = bfhi(w[j][e]) * rstd * A0[2 * e + 1] + B0[2 * e + 1];
                o1[2 * e] = bflo(w[j][2 + e]) * rstd * A1[2 * e] + B1[2 * e]; o1[2 * e + 1] = bfhi(w[j][2 + e]) * rstd * A1[2 * e + 1] + B1[2 * e + 1]; }
            *(u32x4*)(O + (size_t)t * 2048 + col) = pack8(o0, o1);
        }
    }
}
__device__ __forceinline__ float cond_from_partials(const float* condp, const float* b_ada, int j) {
    float s = b_ada[j];
#pragma unroll 8
    for (int k = 0; k < 32; ++k) s += condp[(size_t)k * NADA + j];
    return s;
}
__device__ __forceinline__ void p1_hnorm(const Args& a, const Ctx& c) {
    const float* condp = (const float*)(a.ws + WS_CONDP); float* cond = (float*)(a.ws + WS_COND);
    for (int j = c.bid * NTHREADS + c.tid; j < NADA; j += c.nb * NTHREADS) cond[j] = cond_from_partials(condp, a.in[3], j);
    LAS float* Ab = (LAS float*)c.lds; LAS float* Bb = Ab + 2048;
    for (int col = c.tid; col < 2048; col += NTHREADS) {
        Ab[col] = a.in[4][col] * (1.f + cond_from_partials(condp, a.in[3], 2048 + col)); Bb[col] = cond_from_partials(condp, a.in[3], col); }
    __syncthreads();
    norm_rows(a.in[0], (bf16_t*)(a.ws + WS_H), Ab, Bb, c);
}
__device__ __forceinline__ void p8_h2norm(const Args& a, const Ctx& c, int row0, int nrows) {
    const float* cond = (const float*)(a.ws + WS_COND);
    LAS float* Ab = (LAS float*)c.lds; LAS float* Bb = Ab + 2048;
    for (int col = c.tid; col < 2048; col += NTHREADS) { Ab[col] = a.in[5][col] * (1.f + cond[4 * 2048 + col]); Bb[col] = cond[3 * 2048 + col]; }
    __syncthreads();
    norm_rows_bf16((const bf16_t*)(a.ws + WS_X1), (bf16_t*)(a.ws + WS_H), Ab, Bb, c, row0, nrows);
}
__device__ __forceinline__ void p6_mixnorm(const Args& a, const Ctx& c) {
    const bf16_t* YS = (const bf16_t*)(a.ws + WS_YSSM); const bf16_t* YA = (const bf16_t*)(a.ws + WS_YATT); bf16_t* O = (bf16_t*)(a.ws + WS_H);
    for (int t = c.bid * 8 + c.wave; t < L_; t += c.nb * 8) {
#pragma unroll
        for (int part = 0; part < 2; ++part) {
            const bf16_t* src = (part ? YA : YS) + (size_t)t * 1024 + c.lane * 8; const float* beta = a.in[part ? 9 : 8];
            u32x4 w[2]; float f[16]; float ss = 0.f;
#pragma unroll
            for (int j = 0; j < 2; ++j) { w[j] = *(const u32x4*)(src + j * 512);
#pragma unroll
                for (int e = 0; e < 4; ++e) { f[j * 8 + 2 * e] = bflo(w[j][e]); f[j * 8 + 2 * e + 1] = bfhi(w[j][e]); } }
#pragma unroll
            for (int e = 0; e < 16; ++e) ss += f[e] * f[e];
            ss = wave_sum(ss);
            const float rstd = rsqrtf(ss * (1.f / 1024.f) + 1e-6f);
#pragma unroll
            for (int j = 0; j < 2; ++j) { const int col = j * 512 + c.lane * 8; const f32x4 b0 = *(const f32x4*)(beta + col), b1 = *(const f32x4*)(beta + col + 4);
                f32x4 o0, o1;
#pragma unroll
                for (int e = 0; e < 4; ++e) { o0[e] = f[j * 8 + e] * rstd * b0[e]; o1[e] = f[j * 8 + 4 + e] * rstd * b1[e]; }
                *(u32x4*)(O + (size_t)t * 2048 + part * 1024 + col) = pack8(o0, o1); }
        }
    }
}
constexpr int S5_US = 0, S5_ES = 33792, S5_SS = 67584;
template <int PASS>
__device__ __forceinline__ void s5_item(const Args& a, const Ctx& c, int g, int seg) {
    LAS unsigned char* lds = c.lds;
    const int tid = c.tid, wave = c.wave, lane = c.lane, r = lane & 15, q = lane >> 4;
    const bf16_t* U = (const bf16_t*)(a.ws + WS_US);
    const bf16_t* MT = (const bf16_t*)(a.ws + WS_S5MT) + (size_t)g * 65536;
    const bf16_t* WE = (const bf16_t*)(a.ws + WS_S5WE) + (size_t)g * 32768;
    const bf16_t* WC = (const bf16_t*)(a.ws + WS_S5WC) + (size_t)g * 32768;
    const float* s5p = (const float*)(a.ws + WS_S5P);
    float* F = (float*)(a.ws + WS_S5F) + (size_t)g * 4 * 128;
    bf16_t* Z = (bf16_t*)(a.ws + WS_Z);
    bf16x8 bE[8];
#pragma unroll
    for (int ks = 0; ks < 8; ++ks) bE[ks] = *(const bf16x8*)(WE + (size_t)(16 * wave + r) * 256 + 32 * ks + 8 * q);
    float sr = 0.f, si = 0.f, a16r = 0.f, a16i = 0.f;
    if (wave == 0) {
        a16r = s5p[(g * 64 + lane) * 2]; a16i = s5p[(g * 64 + lane) * 2 + 1];
        if (PASS == 1) { const float br = s5p[8192 + (g * 64 + lane) * 2], bi = s5p[8192 + (g * 64 + lane) * 2 + 1];
            for (int s = 0; s < seg; ++s) { const float fr_ = F[s * 128 + lane], fi_ = F[s * 128 + 64 + lane]; const float nr = br * sr - bi * si + fr_, ni = br * si + bi * sr + fi_; sr = nr; si = ni; } }
    }
    for (int sb = 0; sb < 4; ++sb) {
        const int tok0 = seg * 4096 + sb * 1024;
#pragma unroll
        for (int i = 0; i < 4; ++i) { const int ch = tid + NTHREADS * i, token = ch >> 1, half = ch & 1;
            const u32x4 v = *(const u32x4*)(U + (size_t)(tok0 + token) * 1024 + g * 16 + half * 8);
            *(LAS u32x4*)(lds + S5_US + (token >> 4) * 528 + ((token & 15) * 16 + half * 8) * 2) = v; }
        __syncthreads();
#pragma unroll
        for (int m = 0; m < 4; ++m) {
            f32x4 acc = {0.f, 0.f, 0.f, 0.f};
#pragma unroll
            for (int ks = 0; ks < 8; ++ks) { const bf16x8 A = *(const LAS bf16x8*)(lds + S5_US + (16 * m + r) * 528 + (32 * ks + 8 * q) * 2); acc = mfma16(A, bE[ks], acc); }
#pragma unroll
            for (int i = 0; i < 4; ++i) *(LAS float*)(lds + S5_ES + ((16 * m + 4 * q + i) * 132 + 16 * wave + r) * 4) = acc[i];
        }
        __syncthreads();
        if (wave == 0) {
            for (int ch = 0; ch < 64; ++ch) {
                const float er = *(const LAS float*)(lds + S5_ES + (ch * 132 + lane) * 4), ei = *(const LAS float*)(lds + S5_ES + (ch * 132 + 64 + lane) * 4);
                if (PASS == 1) { *(LAS bf16_t*)(lds + S5_SS + (ch * 136 + lane) * 2) = f2bf(sr); *(LAS bf16_t*)(lds + S5_SS + (ch * 136 + 64 + lane) * 2) = f2bf(si); }
                const float nr = a16r * sr - a16i * si + er, ni = a16r * si + a16i * sr + ei; sr = nr; si = ni;
            }
        }
        __syncthreads();
        if (PASS == 1) {
#pragma unroll
            for (int nt = 0; nt < 2; ++nt) {
                const int j = 2 * wave + nt;
                f32x4 acc[4];
#pragma unroll
                for (int m = 0; m < 4; ++m) acc[m] = (f32x4){0.f, 0.f, 0.f, 0.f};
                for (int ks = 0; ks <= (j >> 1); ++ks) {
                    const bf16x8 B = *(const bf16x8*)(MT + (size_t)(16 * j + r) * 256 + 32 * ks + 8 * q);
#pragma unroll
                    for (int m = 0; m < 4; ++m) { const bf16x8 A = *(const LAS bf16x8*)(lds + S5_US + (16 * m + r) * 528 + (32 * ks + 8 * q) * 2); acc[m] = mfma16(A, B, acc[m]); }
                }
#pragma unroll
                for (int ks = 0; ks < 4; ++ks) {
                    const bf16x8 B = *(const bf16x8*)(WC + (size_t)(16 * j + r) * 128 + 32 * ks + 8 * q);
#pragma unroll
                    for (int m = 0; m < 4; ++m) { const bf16x8 A = *(const LAS bf16x8*)(lds + S5_SS + (16 * m + r) * 272 + (32 * ks + 8 * q) * 2); acc[m] = mfma16(A, B, acc[m]); }
                }
#pragma unroll
                for (int m = 0; m < 4; ++m)
#pragma unroll
                    for (int i = 0; i < 4; ++i) { const int ch = 16 * m + 4 * q + i; Z[(size_t)(tok0 + 16 * ch + j) * 1024 + g * 16 + r] = f2bf(gelu_tanh(acc[m][i])); }
            }
            __syncthreads();
        }
    }
    if (PASS == 0 && wave == 0) { F[seg * 128 + lane] = sr; F[seg * 128 + 64 + lane] = si; }
}

__device__ __forceinline__ void cmp_finish_item(const Args& a, const Ctx& c, int kvsel, int rt) {
    LAS unsigned char* lds = c.lds;
    const int tid = c.tid, wave = c.wave, lane = c.lane, r = lane & 15, q = lane >> 4;
    const float* SL = (const float*)(a.ws + WS_SLAB) + (size_t)kvsel * 4 * 2048 * 256;
    const float* bpep = (const float*)(a.ws + WS_BPEP) + kvsel * 256;
    const bf16_t* W2 = (const bf16_t*)(a.ws + WS_W2) + kvsel * 128 * 256;
    for (int e = tid; e < 64 * 64; e += NTHREADS) {
        const int row = e >> 6, c4 = (e & 63) * 4;
        f32x4 s = {0.f, 0.f, 0.f, 0.f};
#pragma unroll 8
        for (int pt = 0; pt < 32; ++pt) s += *(const f32x4*)(bpep + pt * 512 + c4);
#pragma unroll
        for (int ks = 0; ks < 4; ++ks) s += *(const f32x4*)(SL + ((size_t)ks * 2048 + rt * 64 + row) * 256 + c4);
        u32x2 w; w[0] = cvt_pk_bf16(gelu_tanh(s[0]), gelu_tanh(s[1])); w[1] = cvt_pk_bf16(gelu_tanh(s[2]), gelu_tanh(s[3]));
        *(LAS u32x2*)(lds + row * 528 + c4 * 2) = w;
    }
    __syncthreads();
    bf16x8 B[8];
#pragma unroll
    for (int ks = 0; ks < 8; ++ks) B[ks] = *(const bf16x8*)(W2 + (size_t)(16 * wave + r) * 256 + 32 * ks + 8 * q);
#pragma unroll
    for (int m = 0; m < 4; ++m) {
        f32x4 acc = {0.f, 0.f, 0.f, 0.f};
#pragma unroll
        for (int ks = 0; ks < 8; ++ks) { const bf16x8 A = *(const LAS bf16x8*)(lds + (16 * m + r) * 528 + (32 * ks + 8 * q) * 2); acc = mfma16(A, B[ks], acc); }
#pragma unroll
        for (int i = 0; i < 4; ++i) {
            const int row = rt * 64 + 16 * m + 4 * q + i, gi = row >> 10, ci = row & 1023, n = 16 * wave + r;
            const bf16_t v = (ci == 1023) ? (bf16_t)0 : f2bf(acc[i]);
            if (kvsel == 0) ((bf16_t*)(a.ws + WS_KC))[((size_t)gi * 1024 + ci) * 128 + n] = v;
            else ((bf16_t*)(a.ws + WS_VCT))[((size_t)gi * 128 + n) * 1024 + ((ci & ~12) | ((ci & 4) << 1) | ((ci & 8) >> 1))] = v;
        }
    }
    __syncthreads();
}
constexpr int AT_IMP = 65536, AT_TB = 131072, AT_BM = 143872, AT_WU = 145920, AT_END = 146176;
__device__ __forceinline__ int kswz(int r) { return ((r & 3) << 2) | ((r >> 2) & 3); }
__host__ __device__ __forceinline__ int vperm(int t) { return (t & ~12) | ((t & 4) << 1) | ((t & 8) >> 1); }
template <int KEYS> __device__ __forceinline__ int vsw(int d) { return KEYS == 128 ? kswz(d) : ((d >> 1) & 7); }
template <int KEYS, bool NEEDV>
__device__ __forceinline__ void stage_dma(const bf16_t* Kt, const bf16_t* Vt, int ldv, LAS unsigned char* kb, LAS unsigned char* vb, int wave, int lane) {
    constexpr int NP = KEYS / 32;
#pragma unroll
    for (int i = 0; i < NP; ++i) { const int pc = NP * wave + i, row = 4 * pc + (lane >> 4), ch = (lane & 15) ^ kswz(row);
        __builtin_amdgcn_global_load_lds((const unsigned*)(Kt + row * 128 + ch * 8), (LAS unsigned*)(kb + pc * 1024), 16, 0, 0); }
    if (NEEDV) {
#pragma unroll
        for (int i = 0; i < NP; ++i) {
            const int pc = NP * wave + i;
            if (KEYS == 128) { const int d = 4 * pc + (lane >> 4), ch = (lane & 15) ^ kswz(d);
                __builtin_amdgcn_global_load_lds((const unsigned*)(Vt + (size_t)d * ldv + 8 * ch), (LAS unsigned*)(vb + pc * 1024), 16, 0, 0); }
            else { const int d = 8 * pc + (lane >> 3), ch = (lane & 7) ^ ((d >> 1) & 7);
                __builtin_amdgcn_global_load_lds((const unsigned*)(Vt + (size_t)d * ldv + 8 * ch), (LAS unsigned*)(vb + pc * 1024), 16, 0, 0); }
        }
    }
}
__device__ __forceinline__ float xhalf_max(float x) { auto rr = __builtin_amdgcn_permlane32_swap(__float_as_uint(x), __float_as_uint(x), false, false); return fmaxf(__uint_as_float(rr[0]), __uint_as_float(rr[1])); }
__device__ __forceinline__ float xhalf_sum(float x) { auto rr = __builtin_amdgcn_permlane32_swap(__float_as_uint(x), __float_as_uint(x), false, false); return __uint_as_float(rr[0]) + __uint_as_float(rr[1]); }
template <int BR>
__device__ __forceinline__ float tile_prep(int MODE, f32x16& S, LAS const float* tb, float cb, int base, bool selbit) {
    float mx = -INFINITY;
    if (MODE == 1) {
#pragma unroll
        for (int r = 0; r < 16; ++r) mx = fmaxf(mx, S[r]);
        mx = (BR == 2 && !selbit) ? -INFINITY : mx + cb;
    } else {
        const bool nomask = (MODE == 2);
        float bv[16];
#pragma unroll
        for (int r = 0; r < 16; ++r) { const int cr = (r & 3) + 8 * (r >> 2); const int dist = (BR <= 1) ? base - 16 * cr : base - cr; bv[r] = tb[min(max(dist, 0), TBN - 1)]; }
        __builtin_amdgcn_sched_barrier(0);
#pragma unroll
        for (int r = 0; r < 16; ++r) {
            const int cr = (r & 3) + 8 * (r >> 2);
            const int dist = (BR <= 1) ? base - 16 * cr : base - cr;
            float v = S[r] + bv[r];
            bool valid;
            if (BR <= 1) valid = dist >= 0; else if (BR == 2) valid = selbit && dist >= 0; else valid = nomask || (unsigned)dist < 512u;
            v = valid ? v : -INFINITY;
            S[r] = v; mx = fmaxf(mx, v);
        }
    }
    return mx;
}
template <int BR, bool PEND>
__device__ __forceinline__ float tile_decide(int MODE, float mx, float cb, bool selbit, f32x16 (&O)[4], float& m, float& l, u32x4& pa, u32x4& pb) {
    if (BR == 1) { const float mu = (m == -INFINITY) ? 0.f : m; return (MODE == 1) ? mu - cb : mu; }
    mx = xhalf_max(mx);
    const float mn = fmaxf(m, mx), mu = (mn == -INFINITY) ? 0.f : mn;
    if (__any(mn > m)) {
        const float alpha = fexp2(m - mu);
        l *= alpha;
        if (BR >= 2) {
#pragma unroll
            for (int dt = 0; dt < 4; ++dt)
#pragma unroll
                for (int r = 0; r < 16; ++r) O[dt][r] *= alpha;
            if (PEND) {
#pragma unroll
                for (int e = 0; e < 4; ++e) { pa[e] = cvt_pk_bf16(bflo(pa[e]) * alpha, bfhi(pa[e]) * alpha); pb[e] = cvt_pk_bf16(bflo(pb[e]) * alpha, bfhi(pb[e]) * alpha); }
            }
        }
    }
    m = mn;
    if (MODE == 1) return (BR == 2 && !selbit) ? INFINITY : mu - cb;
    return mu;
}
template <int BR, int KEYS>
__device__ __forceinline__ void attn_tile(int MODE, LAS const unsigned char* kb, LAS const unsigned char* vb, int cb0, LAS const float* tb, int key0, int t, int lane,
                                          const bf16x8 (&qf)[8], f32x16 (&O)[4], float& m, float& l, float inv_l, bool selbit, LAS float* imp_row) {
    asm volatile("" : "+v"(lane));
    constexpr int ROWB = 2 * KEYS;
    const int r31 = lane & 31, h = lane >> 5;
    const int gh = kswz(r31) ^ h, vh = vsw<KEYS>(r31) ^ h;
    float cb = 0.f;
    if (MODE == 1) cb = tb[TBN - 1];
    const int base0 = (BR <= 1) ? t - 31 - 16 * (key0 + 4 * h) : t - (key0 + 4 * h);
    const int base1 = (BR <= 1) ? base0 - 16 * 32 : base0 - 32;
    LAS const unsigned char* k0 = kb + r31 * 256;
    f32x16 S0, S1;
    bf16x8 kf[8];
#pragma unroll
    for (int ks = 0; ks < 8; ++ks) kf[ks] = *(const LAS bf16x8*)(k0 + 16 * ((2 * ks) ^ gh));
#pragma unroll
    for (int r = 0; r < 16; ++r) { S0[r] = 0.f; S1[r] = 0.f; }
    __builtin_amdgcn_sched_barrier(0);
#pragma unroll
    for (int ks = 0; ks < 8; ++ks) S0 = mfma32(kf[ks], qf[ks], S0);
    __builtin_amdgcn_sched_barrier(0);
#pragma unroll
    for (int ks = 0; ks < 8; ++ks) kf[ks] = *(const LAS bf16x8*)(k0 + 8192 + 16 * ((2 * ks) ^ gh));
    const float mx0 = tile_prep<BR>(MODE, S0, tb, cb, base0, selbit);
    u32x4 pk0a = {0u, 0u, 0u, 0u}, pk0b = {0u, 0u, 0u, 0u}, pk1a, pk1b;
    const float me0 = tile_decide<BR, false>(MODE, mx0, cb, selbit, O, m, l, pk0a, pk0b);
    __builtin_amdgcn_sched_barrier(0);
    {
#pragma unroll
        for (int ks = 0; ks < 8; ++ks) S1 = mfma32(kf[ks], qf[ks], S1);
        float ps = 0.f;
#pragma unroll
        for (int r = 0; r < 16; ++r) { float p = fexp2(S0[r] - me0); if (BR == 1) p *= inv_l; S0[r] = p; ps += p; }
        if (BR != 1) l += ps;
        if (BR >= 1) {
#pragma unroll
            for (int e = 0; e < 4; ++e) { pk0a[e] = cvt_pk_bf16(S0[2 * e], S0[2 * e + 1]); pk0b[e] = cvt_pk_bf16(S0[8 + 2 * e], S0[8 + 2 * e + 1]); }
        }
#pragma unroll
        for (int i = 0; i < 8; ++i) { __builtin_amdgcn_sched_group_barrier(0x008, 1, 0); __builtin_amdgcn_sched_group_barrier(0x002, 8, 0); }
    }
    __builtin_amdgcn_sched_barrier(0);
    if (BR == 1) {
#pragma unroll
        for (int rg = 0; rg < 4; ++rg) {
            float A = 2.f * (S0[4 * rg] + S0[4 * rg + 1] + S0[4 * rg + 2]) + S0[4 * rg + 3], B = S0[4 * rg + 3];
            A = quad_sum(A); B = quad_sum(B);
            const int jj = (key0 >> 2) + 2 * rg + h;
            if ((lane & 3) == 0) { __hip_atomic_fetch_add(imp_row + jj, A, __ATOMIC_RELAXED, __HIP_MEMORY_SCOPE_WORKGROUP);
                if (jj + 1 < 256) __hip_atomic_fetch_add(imp_row + jj + 1, B, __ATOMIC_RELAXED, __HIP_MEMORY_SCOPE_WORKGROUP); }
        }
    }
    bf16x8 av[8];
    if (BR >= 1) {
#pragma unroll
        for (int s = 0; s < 2; ++s)
#pragma unroll
            for (int dt = 0; dt < 4; ++dt) av[s * 4 + dt] = *(const LAS bf16x8*)(vb + (32 * dt + r31) * ROWB + 16 * ((cb0 + 2 * s) ^ vh));
    }
    const float mx1 = tile_prep<BR>(MODE, S1, tb, cb, base1, selbit);
    const float me1 = tile_decide<BR, true>(MODE, mx1, cb, selbit, O, m, l, pk0a, pk0b);
    __builtin_amdgcn_sched_barrier(0);
    {
        if (BR >= 1) {
#pragma unroll
            for (int dt = 0; dt < 4; ++dt) O[dt] = mfma32(av[dt], __builtin_bit_cast(bf16x8, pk0a), O[dt]);
#pragma unroll
            for (int dt = 0; dt < 4; ++dt) O[dt] = mfma32(av[4 + dt], __builtin_bit_cast(bf16x8, pk0b), O[dt]);
        }
        float ps = 0.f;
#pragma unroll
        for (int r = 0; r < 16; ++r) { float p = fexp2(S1[r] - me1); if (BR == 1) p *= inv_l; S1[r] = p; ps += p; }
        if (BR != 1) l += ps;
        if (BR >= 1) {
#pragma unroll
            for (int e = 0; e < 4; ++e) { pk1a[e] = cvt_pk_bf16(S1[2 * e], S1[2 * e + 1]); pk1b[e] = cvt_pk_bf16(S1[8 + 2 * e], S1[8 + 2 * e + 1]); }
#pragma unroll
            for (int i = 0; i < 8; ++i) { __builtin_amdgcn_sched_group_barrier(0x008, 1, 0); __builtin_amdgcn_sched_group_barrier(0x002, 8, 0); }
        }
    }
    __builtin_amdgcn_sched_barrier(0);
    if (BR == 1) {
#pragma unroll
        for (int rg = 0; rg < 4; ++rg) {
            float A = 2.f * (S1[4 * rg] + S1[4 * rg + 1] + S1[4 * rg + 2]) + S1[4 * rg + 3], B = S1[4 * rg + 3];
            A = quad_sum(A); B = quad_sum(B);
            const int jj = ((key0 + 32) >> 2) + 2 * rg + h;
            if ((lane & 3) == 0) { __hip_atomic_fetch_add(imp_row + jj, A, __ATOMIC_RELAXED, __HIP_MEMORY_SCOPE_WORKGROUP);
                if (jj + 1 < 256) __hip_atomic_fetch_add(imp_row + jj + 1, B, __ATOMIC_RELAXED, __HIP_MEMORY_SCOPE_WORKGROUP); }
        }
    }
    if (BR >= 1) {
#pragma unroll
        for (int s = 0; s < 2; ++s)
#pragma unroll
            for (int dt = 0; dt < 4; ++dt) av[s * 4 + dt] = *(const LAS bf16x8*)(vb + (32 * dt + r31) * ROWB + 16 * ((cb0 + 4 + 2 * s) ^ vh));
        __builtin_amdgcn_sched_barrier(0);
#pragma unroll
        for (int dt = 0; dt < 4; ++dt) O[dt] = mfma32(av[dt], __builtin_bit_cast(bf16x8, pk1a), O[dt]);
#pragma unroll
        for (int dt = 0; dt < 4; ++dt) O[dt] = mfma32(av[4 + dt], __builtin_bit_cast(bf16x8, pk1b), O[dt]);
    }
}
template <int BR, int KEYS>
__device__ __forceinline__ void run_branch(const Ctx& c, const bf16_t* Kb, const bf16_t* Vtb, int ldv, int lo, int hi, LAS const float* tb, int t, int t0,
                                           const bf16x8 (&qf)[8], f32x16 (&O)[4], float& m, float& l, float inv_l, int tl, LAS float* imp_row) {
    constexpr bool NEEDV = (BR != 0);
    constexpr int BPS = KEYS / 64, KSTG = KEYS * 256, VSTG = 128 * 2 * KEYS, VB0 = 2 * KSTG;
    LAS unsigned char* lds = c.lds;
    int lz = c.lane; asm volatile("" : "+v"(lz));
    const int nst = (hi - lo + BPS - 1) / BPS;
#define STG_BLK(i) ((lo + BPS * (i) + BPS - 1 < hi) ? lo + BPS * (i) : hi - BPS)
    asm volatile("s_waitcnt vmcnt(0)" ::: "memory");
    { const int b0 = (BPS == 2 && hi - lo < 2) ? lo : STG_BLK(0);
      stage_dma<KEYS, NEEDV>(Kb + (size_t)b0 * 64 * 128, Vtb + (size_t)b0 * 64, ldv, lds, lds + VB0, c.wave, lz); }
    asm volatile("s_waitcnt vmcnt(0)" ::: "memory");
    __syncthreads();
    const int qt = t0 >> 6;
    for (int i = 0; i < nst; ++i) {
        const int buf = i & 1;
        if (i + 1 < nst) { int lz2 = lz; asm volatile("" : "+v"(lz2));
            const int b1 = STG_BLK(i + 1);
            stage_dma<KEYS, NEEDV>(Kb + (size_t)b1 * 64 * 128, Vtb + (size_t)b1 * 64, ldv, lds + (buf ^ 1) * KSTG, lds + VB0 + (buf ^ 1) * VSTG, c.wave, lz2); }
        const int sb = (BPS == 2 && hi - lo < 2) ? lo : STG_BLK(i);
#pragma unroll
        for (int q = 0; q < BPS; ++q) {
            const int j = lo + BPS * i + q;
            if (j < hi) {
                bool selbit = true, wave_on = true;
                if (BR == 2) {
                    const unsigned w = *(const LAS unsigned*)(lds + AT_BM + (tl * 8 + (j >> 5)) * 4);
                    selbit = (w >> (j & 31)) & 1u;
                    const unsigned wu = *(const LAS unsigned*)(lds + AT_WU + (c.wave * 8 + (j >> 5)) * 4);
                    wave_on = (wu >> (j & 31)) & 1u;
                }
                if (wave_on) {
                    int mode = 0;
                    if (BR <= 1) mode = (1024 * j + 1829 <= t0) ? 1 : 0;
                    else if (BR == 2) mode = (64 * j + 853 <= t0) ? 1 : 0;
                    else mode = (j >= qt - 7 && j <= qt - 1) ? 2 : 0;
                    const int slot = j - sb;
                    attn_tile<BR, KEYS>(mode, lds + buf * KSTG + slot * 16384, lds + VB0 + buf * VSTG, 8 * slot, tb, j * 64, t, c.lane, qf, O, m, l, inv_l, selbit, imp_row);
                }
            }
        }
        asm volatile("s_waitcnt vmcnt(0)" ::: "memory");
        __syncthreads();
    }
#undef STG_BLK
}
__device__ __forceinline__ void attn_item(const Args& a, const Ctx& c_, int qt, int g) {
    Ctx c = c_; { int tz = c_.tid; asm volatile("" : "+v"(tz)); c.tid = tz; c.lane = tz & 63; }
    LAS unsigned char* lds = c.lds;
    const int tid = c.tid, wave = c.wave, lane = c.lane, r31 = lane & 31, h = lane >> 5, hl = lane & 3;
    const int t0 = qt * 64, tl = 8 * wave + (r31 >> 2), t = t0 + tl, head = g * 4 + hl;
    const bf16_t* Qb = (const bf16_t*)(a.ws + WS_Q);
    const bf16_t* KROW = (const bf16_t*)(a.ws + WS_KROW);
    const bf16_t* VT = (const bf16_t*)(a.ws + WS_VT);
    const float* GATE = (const float*)(a.ws + WS_GATE);
    { const float* tbg = (const float*)(a.ws + WS_TB) + g * 4 * TBN;
      for (int i = tid; i < 4 * TBN; i += NTHREADS) *(LAS float*)(lds + AT_TB + i * 4) = tbg[i];
      for (int i = tid; i < 64 * 256; i += NTHREADS) *(LAS float*)(lds + AT_IMP + i * 4) = 0.f; }
    bf16x8 qf[8];
#pragma unroll
    for (int ks = 0; ks < 8; ++ks) qf[ks] = *(const bf16x8*)(Qb + (size_t)t * 1024 + head * 128 + 16 * ks + 8 * h);
    LAS const float* tb = (LAS const float*)(lds + AT_TB) + hl * TBN;
    LAS float* imp_row = (LAS float*)(lds + AT_IMP) + tl * 256;
    bf16_t* Y = (bf16_t*)(a.ws + WS_YATT) + (size_t)t * 1024 + head * 128 + 4 * h;
    f32x16 O[4];
#pragma unroll
    for (int dt = 0; dt < 4; ++dt)
#pragma unroll
        for (int r = 0; r < 16; ++r) O[dt][r] = 0.f;
    __syncthreads();
    { const int ntile = (t0 / 16 + 3 + 63) / 64;
      const bf16_t* KC = (const bf16_t*)(a.ws + WS_KC) + (size_t)g * 1024 * 128; const bf16_t* VCT = (const bf16_t*)(a.ws + WS_VCT) + (size_t)g * 128 * 1024;
      float m = -INFINITY, l = 0.f;
#if defined(PROBE_CMP)
      run_branch<0, 64>(c, KC, VCT, 1024, 0, ntile, tb, t, t0, qf, O, m, l, 0.f, tl, imp_row);
      asm volatile("" :: "v"(m), "v"(l));
      m = -INFINITY; l = 0.f;
#endif
      run_branch<0, 64>(c, KC, VCT, 1024, 0, ntile, tb, t, t0, qf, O, m, l, 0.f, tl, imp_row);
      const float lt = xhalf_sum(l), inv = lt > 0.f ? 1.f / lt : 0.f;
      run_branch<1, 64>(c, KC, VCT, 1024, 0, ntile, tb, t, t0, qf, O, m, l, inv, tl, imp_row);
      const float gc = GATE[(size_t)t * 24 + head];
#pragma unroll
      for (int dt = 0; dt < 4; ++dt)
#pragma unroll
          for (int rg = 0; rg < 4; ++rg) {
              u32x2 w; w[0] = cvt_pk_bf16(gc * O[dt][4 * rg], gc * O[dt][4 * rg + 1]); w[1] = cvt_pk_bf16(gc * O[dt][4 * rg + 2], gc * O[dt][4 * rg + 3]);
              *(u32x2*)(Y + 32 * dt + 8 * rg) = w;
#pragma unroll
              for (int e = 0; e < 4; ++e) O[dt][4 * rg + e] = 0.f;
          }
    }
    {
        const int ncand = qt - 2 > 0 ? qt - 2 : 0;
        unsigned v[8][4], selm[8];
#pragma unroll
        for (int i = 0; i < 8; ++i) {
            LAS const float* row = (LAS const float*)(lds + AT_IMP) + (8 * wave + i) * 256;
            selm[i] = 0u;
#pragma unroll
            for (int k = 0; k < 4; ++k) { const int j = lane + 64 * k; const bool cand = (j >= 1 && j <= qt - 2);
                v[i][k] = cand ? ((__float_as_uint(row[j]) & ~0xFFu) | (unsigned)(255 - j)) : 0u; if (ncand <= 13 && cand) selm[i] |= 1u << k; }
        }
        if (ncand > 13) {
            for (int it = 0; it < 13; ++it) {
#pragma unroll
                for (int i = 0; i < 8; ++i) {
                    const unsigned mx = wave_umax_bcast(max(max(v[i][0], v[i][1]), max(v[i][2], v[i][3])));
#pragma unroll
                    for (int k = 0; k < 4; ++k) if (v[i][k] == mx) { v[i][k] = 0u; selm[i] |= 1u << k; }
                }
            }
        }
        unsigned wu[8];
#pragma unroll
        for (int k = 0; k < 8; ++k) wu[k] = 0u;
#pragma unroll
        for (int i = 0; i < 8; ++i)
#pragma unroll
            for (int k = 0; k < 4; ++k) {
                const int j = lane + 64 * k; const bool forced = (j == 0) || (j == qt) || (j == qt - 1);
                const unsigned long long mk = __ballot(((selm[i] >> k) & 1u) || forced);
                const unsigned lo = (unsigned)mk, hi = (unsigned)(mk >> 32);
                if (lane == 0) { *(LAS unsigned*)(lds + AT_BM + ((8 * wave + i) * 8 + 2 * k) * 4) = lo; *(LAS unsigned*)(lds + AT_BM + ((8 * wave + i) * 8 + 2 * k + 1) * 4) = hi; }
                wu[2 * k] |= lo; wu[2 * k + 1] |= hi;
            }
        if (lane == 0) {
#pragma unroll
            for (int k = 0; k < 8; ++k) *(LAS unsigned*)(lds + AT_WU + (wave * 8 + k) * 4) = wu[k];
        }
    }
    __syncthreads();
#if defined(PROBE_SEL)
    { float m = -INFINITY, l = 0.f;
      run_branch<2, 128>(c, KROW + (size_t)(2 + g) * L_ * 128, VT + (size_t)g * 128 * L_, L_, 0, qt + 1, tb, t, t0, qf, O, m, l, 0.f, tl, imp_row);
      asm volatile("" :: "v"(O[0]), "v"(O[1]), "v"(O[2]), "v"(O[3]), "v"(m), "v"(l));
#pragma unroll
      for (int dt = 0; dt < 4; ++dt)
#pragma unroll
          for (int r = 0; r < 16; ++r) O[dt][r] = 0.f; }
#endif
    { float m = -INFINITY, l = 0.f;
      run_branch<2, 128>(c, KROW + (size_t)(2 + g) * L_ * 128, VT + (size_t)g * 128 * L_, L_, 0, qt + 1, tb, t, t0, qf, O, m, l, 0.f, tl, imp_row);
      const float gs = GATE[(size_t)t * 24 + 8 + head];
      const float lt = xhalf_sum(l), sc = gs * (lt > 0.f ? 1.f / lt : 0.f);
#pragma unroll
      for (int dt = 0; dt < 4; ++dt)
#pragma unroll
          for (int rg = 0; rg < 4; ++rg) {
              const u32x2 w0 = *(const u32x2*)(Y + 32 * dt + 8 * rg);
              u32x2 w; w[0] = cvt_pk_bf16(bflo(w0[0]) + sc * O[dt][4 * rg], bfhi(w0[0]) + sc * O[dt][4 * rg + 1]); w[1] = cvt_pk_bf16(bflo(w0[1]) + sc * O[dt][4 * rg + 2], bfhi(w0[1]) + sc * O[dt][4 * rg + 3]);
              *(u32x2*)(Y + 32 * dt + 8 * rg) = w;
#pragma unroll
              for (int e = 0; e < 4; ++e) O[dt][4 * rg + e] = 0.f;
          }
    }
#if defined(PROBE_WIN)
    { float m = -INFINITY, l = 0.f;
      const int lo = qt - 8 > 0 ? qt - 8 : 0;
      run_branch<3, 128>(c, KROW + (size_t)(4 + g) * L_ * 128, VT + (size_t)(2 + g) * 128 * L_, L_, lo, qt + 1, tb, t, t0, qf, O, m, l, 0.f, tl, imp_row);
      asm volatile("" :: "v"(O[0]), "v"(O[1]), "v"(O[2]), "v"(O[3]), "v"(m), "v"(l));
#pragma unroll
      for (int dt = 0; dt < 4; ++dt)
#pragma unroll
          for (int r = 0; r < 16; ++r) O[dt][r] = 0.f; }
#endif
    { float m = -INFINITY, l = 0.f;
      const int lo = qt - 8 > 0 ? qt - 8 : 0;
      run_branch<3, 128>(c, KROW + (size_t)(4 + g) * L_ * 128, VT + (size_t)(2 + g) * 128 * L_, L_, lo, qt + 1, tb, t, t0, qf, O, m, l, 0.f, tl, imp_row);
      const float gw = GATE[(size_t)t * 24 + 16 + head];
      const float lt = xhalf_sum(l), sc = gw * (lt > 0.f ? 1.f / lt : 0.f);
#pragma unroll
      for (int dt = 0; dt < 4; ++dt)
#pragma unroll
          for (int rg = 0; rg < 4; ++rg) {
              const u32x2 w0 = *(const u32x2*)(Y + 32 * dt + 8 * rg);
              u32x2 w; w[0] = cvt_pk_bf16(bflo(w0[0]) + sc * O[dt][4 * rg], bfhi(w0[0]) + sc * O[dt][4 * rg + 1]); w[1] = cvt_pk_bf16(bflo(w0[1]) + sc * O[dt][4 * rg + 2], bfhi(w0[1]) + sc * O[dt][4 * rg + 3]);
              *(u32x2*)(Y + 32 * dt + 8 * rg) = w;
          }
    }
    __syncthreads();
}
#ifndef PEER_ALPHA
#define PEER_ALPHA 1.0f
#endif
constexpr int PE_SC = 0, PE_LV = 65536, PE_LI = 73728, PE_PK = 81920, PE_EX = 147456, PE_GT = 151552, PE_SU = 155648, PE_END = 159744;
constexpr int PE_SLOT = 2048, PE_NSLOT = 8, PE_RINGW = PE_SLOT * 9;
static_assert(8 * PE_RINGW <= PE_EX && PE_END <= LDS_BYTES - 16, "PEER LDS map");
__device__ __forceinline__ float wave_sum_bcast(float v) {
    v += dpp_f<0xB1>(v); v += dpp_f<0x4E>(v); v += dpp_f<0x141>(v); v += dpp_f<0x140>(v);
    v += __int_as_float(__builtin_amdgcn_update_dpp(0, __float_as_int(v), 0x142, 0xa, 0xf, false));
    v += __int_as_float(__builtin_amdgcn_update_dpp(0, __float_as_int(v), 0x143, 0xc, 0xf, false));
    return __int_as_float(__builtin_amdgcn_readlane(__float_as_int(v), 63));
}
__device__ __forceinline__ unsigned mono_key(float v) { const unsigned b = __float_as_uint(v); return b ^ ((b >> 31) ? 0xFFFFFFFFu : 0x80000000u); }
template <int CTRL>
__device__ __forceinline__ void quad_merge16(unsigned (&t)[16]) {
    unsigned o[16];
#pragma unroll
    for (int i = 0; i < 16; ++i) o[i] = (unsigned)__builtin_amdgcn_update_dpp(0, (int)t[15 - i], CTRL, 0xf, 0xf, false);
#pragma unroll
    for (int i = 0; i < 16; ++i) t[i] = max(t[i], o[i]);
#pragma unroll
    for (int st = 8; st >= 1; st >>= 1)
#pragma unroll
        for (int i = 0; i < 16; ++i) if ((i & st) == 0) { const unsigned hi = max(t[i], t[i + st]), lo = min(t[i], t[i + st]); t[i] = hi; t[i + st] = lo; }
}
__device__ __forceinline__ int pair_a(int p) { return p < 16 ? 0 : p < 24 ? 1 : p < 29 ? 2 : p < 33 ? 3 : p < 36 ? 4 : p < 38 ? 5 : p < 40 ? 6 : p < 42 ? 7 : p - 34; }
__device__ __forceinline__ int pair_b(int p) { return p < 16 ? p : p < 24 ? p - 16 : p < 29 ? p - 24 : p < 33 ? p - 29 : p < 36 ? p - 33 : p < 38 ? p - 36 : p < 40 ? p - 38 : p < 42 ? p - 40 : 0; }
template <bool DRY>
__device__ __forceinline__ void peer_step(const Args& a, const Ctx& c_, int t0) {
    Ctx c = c_; { int tz = c_.tid; asm volatile("" : "+v"(tz)); c.tid = tz; c.lane = tz & 63; }
    LAS unsigned char* lds = c.lds;
    const int tid = c.tid, wave = c.wave, lane = c.lane, r = lane & 15, q = lane >> 4;
    const bf16_t* QP = (const bf16_t*)(a.ws + WS_QP); const bf16_t* PK = (const bf16_t*)(a.ws + WS_PK);
    const unsigned char* PU = a.ws + WS_PU; const unsigned char* PV = a.ws + WS_PV; const float* psc = (const float*)(a.ws + WS_PSC);
    const bf16_t* HB = (const bf16_t*)(a.ws + WS_H);
    {
#pragma unroll
        for (int i = 0; i < 8; ++i) { const int pc = 8 * wave + i, row = 4 * pc + (lane >> 4), ch = (lane & 15) ^ kswz(row);
            __builtin_amdgcn_global_load_lds((const unsigned*)(PK + (size_t)row * 128 + ch * 8), (LAS unsigned*)(lds + PE_PK + pc * 1024), 16, 0, 0); }
        const int hh = wave;
        bf16x8 aF[2][4];
#pragma unroll
        for (int cc = 0; cc < 2; ++cc)
#pragma unroll
            for (int ks = 0; ks < 4; ++ks) aF[cc][ks] = *(const bf16x8*)(QP + (size_t)(t0 + (r & 7)) * 2048 + hh * 256 + cc * 128 + 32 * ks + 8 * q);
        asm volatile("s_waitcnt vmcnt(0)" ::: "memory");
        __syncthreads();
        const int ksw = kswz(r);
#pragma unroll
        for (int cc = 0; cc < 2; ++cc)
#pragma unroll 2
            for (int nt = 0; nt < 8; ++nt) {
                f32x4 acc = {0.f, 0.f, 0.f, 0.f};
#pragma unroll
                for (int ks = 0; ks < 4; ++ks) { const bf16x8 B = *(const LAS bf16x8*)(lds + PE_PK + (cc * 128 + 16 * nt + r) * 256 + 16 * ((4 * ks + q) ^ ksw)); acc = mfma16(aF[cc][ks], B, acc); }
                if (q < 2) {
#pragma unroll
                    for (int i = 0; i < 4; ++i) { const int task = (4 * q + i) * 16 + hh * 2 + cc; *(LAS float*)(lds + PE_SC + (task * 128 + ((16 * nt + r + task) & 127)) * 4) = acc[i]; }
                }
            }
    }
    __syncthreads();
    {
        const int task = tid >> 2, part = tid & 3;
        LAS const float* sc = (LAS const float*)(lds + PE_SC) + task * 128;
        float vals[32];
#pragma unroll
        for (int k = 0; k < 32; ++k) vals[k] = sc[(32 * part + k + task) & 127];
        unsigned top[16];
#pragma unroll
        for (int e = 0; e < 16; ++e) top[e] = 0u;
#pragma unroll
        for (int k = 0; k < 32; ++k) {
            unsigned key = (mono_key(vals[k]) & ~0x7Fu) | (unsigned)(127 - (32 * part + k));
#pragma unroll
            for (int e = 0; e < 16; ++e) { const unsigned hi = max(top[e], key); key = min(top[e], key); top[e] = hi; }
        }
        quad_merge16<0xB1>(top);
        quad_merge16<0x4E>(top);
        if (part == 0) {
#pragma unroll
            for (int e = 0; e < 16; ++e) { const int idx = 127 - (int)(top[e] & 0x7Fu); *(LAS float*)(lds + PE_LV + (task * 16 + e) * 4) = sc[(idx + task) & 127]; *(LAS int*)(lds + PE_LI + (task * 16 + e) * 4) = idx; }
        }
    }
    __syncthreads();
    if (tid < 256) {
        const int task = tid >> 2, part = tid & 3, tok = task >> 3, hh = task & 7, t1 = tok * 16 + hh * 2, t2 = t1 + 1;
        LAS const float* lv1 = (LAS const float*)(lds + PE_LV) + t1 * 16; LAS const float* lv2 = (LAS const float*)(lds + PE_LV) + t2 * 16;
        unsigned top[16];
#pragma unroll
        for (int e = 0; e < 16; ++e) top[e] = 0u;
        for (int p = part; p < 50; p += 4) {
            const int aa = pair_a(p), bb = pair_b(p);
            unsigned key = (mono_key(lv1[aa] + lv2[bb]) & ~0xFFu) | (unsigned)(255 - (aa * 16 + bb));
#pragma unroll
            for (int e = 0; e < 16; ++e) { const unsigned hi = max(top[e], key); key = min(top[e], key); top[e] = hi; }
        }
        quad_merge16<0xB1>(top);
        quad_merge16<0x4E>(top);
        if (part == 0) {
            LAS const int* li1 = (LAS const int*)(lds + PE_LI) + t1 * 16; LAS const int* li2 = (LAS const int*)(lds + PE_LI) + t2 * 16;
            float sv[16]; int ex[16]; float mx = -INFINITY;
#pragma unroll
            for (int e = 0; e < 16; ++e) {
                const int id = 255 - (int)(top[e] & 0xFFu), aa = id >> 4, bb = id & 15;
                sv[e] = lv1[aa] + lv2[bb]; ex[e] = li1[aa] * 128 + li2[bb]; mx = fmaxf(mx, sv[e]);
            }
            float sum = 0.f;
#pragma unroll
            for (int e = 0; e < 16; ++e) { sv[e] = fexp2((sv[e] - mx) * LOG2E); sum += sv[e]; }
            const float inv = 1.f / sum;
#pragma unroll
            for (int e = 0; e < 16; ++e) { *(LAS int*)(lds + PE_EX + (tok * 128 + hh * 16 + e) * 4) = ex[e];
                *(LAS float*)(lds + PE_GT + (tok * 128 + hh * 16 + e) * 4) = sv[e] * inv * psc[16384 + ex[e]];
                *(LAS float*)(lds + PE_SU + (tok * 128 + hh * 16 + e) * 4) = psc[ex[e]]; }
        }
    }
    __syncthreads();
    const int t = t0 + wave;
    float hp[32];
#pragma unroll
    for (int k = 0; k < 4; ++k) { const u32x4 w = *(const u32x4*)(HB + (size_t)t * 2048 + lane * 32 + k * 8);
#pragma unroll
        for (int e = 0; e < 4; ++e) { hp[k * 8 + 2 * e] = bflo(w[e]); hp[k * 8 + 2 * e + 1] = bfhi(w[e]); } }
    float acc[32];
#pragma unroll
    for (int e = 0; e < 32; ++e) acc[e] = 0.f;
    asm volatile("s_waitcnt vmcnt(0)" ::: "memory");
    {
        LAS const int* exl = (LAS const int*)(lds + PE_EX) + wave * 128; LAS const float* gtl = (LAS const float*)(lds + PE_GT) + wave * 128;
        LAS unsigned char* ring = lds + wave * PE_RINGW;
        LAS const float* sul = (LAS const float*)(lds + PE_SU) + wave * 128;
#define ROW_ISSUE(SL, IDX) do { const int ex_ = __builtin_amdgcn_readfirstlane(exl[IDX]); \
            LAS unsigned char* sl_ = ring + (SL) * PE_SLOT; \
            __builtin_amdgcn_global_load_lds((const unsigned*)(PU + (size_t)ex_ * 1024 + lane * 16), (LAS unsigned*)sl_, 16, 0, 0); \
            __builtin_amdgcn_global_load_lds((const unsigned*)(PV + (size_t)ex_ * 1024 + lane * 16), (LAS unsigned*)(sl_ + 1024), 16, 0, 0); \
            } while (0)
#define UDOT(UW, D0, D1) do { _Pragma("unroll") for (int dw = 0; dw < 4; ++dw) { const f32x2 f0_ = fp4_unpk<0>(UW[dw]), f1_ = fp4_unpk<1>(UW[dw]), f2_ = fp4_unpk<2>(UW[dw]), f3_ = fp4_unpk<3>(UW[dw]); \
                D0 += f0_[0] * hp[8 * dw] + f1_[0] * hp[8 * dw + 2] + f2_[0] * hp[8 * dw + 4] + f3_[0] * hp[8 * dw + 6]; \
                D1 += f0_[1] * hp[8 * dw + 1] + f1_[1] * hp[8 * dw + 3] + f2_[1] * hp[8 * dw + 5] + f3_[1] * hp[8 * dw + 7]; } } while (0)
#define VACC(VW, WG) do { _Pragma("unroll") for (int dw = 0; dw < 4; ++dw) { const f32x2 f0_ = fp4_unpk<0>(VW[dw]), f1_ = fp4_unpk<1>(VW[dw]), f2_ = fp4_unpk<2>(VW[dw]), f3_ = fp4_unpk<3>(VW[dw]); \
                acc[8 * dw] += WG * f0_[0]; acc[8 * dw + 1] += WG * f0_[1]; acc[8 * dw + 2] += WG * f1_[0]; acc[8 * dw + 3] += WG * f1_[1]; \
                acc[8 * dw + 4] += WG * f2_[0]; acc[8 * dw + 5] += WG * f2_[1]; acc[8 * dw + 6] += WG * f3_[0]; acc[8 * dw + 7] += WG * f3_[1]; } } while (0)
#define PAIR_APPLY(SA, SB, IDX) do { LAS const unsigned char* pa_ = ring + (SA) * PE_SLOT + lane * 16; LAS const unsigned char* pb_ = ring + (SB) * PE_SLOT + lane * 16; \
            const u32x4 ua_ = *(const LAS u32x4*)pa_, ub_ = *(const LAS u32x4*)pb_, va_ = *(const LAS u32x4*)(pa_ + 1024), vb_ = *(const LAS u32x4*)(pb_ + 1024); \
            float a0_ = 0.f, a1_ = 0.f, b0_ = 0.f, b1_ = 0.f; \
            UDOT(ua_, a0_, a1_); UDOT(ub_, b0_, b1_); \
            const float da_ = wave_sum_bcast(a0_ + a1_) * sul[IDX], db_ = wave_sum_bcast(b0_ + b1_) * sul[(IDX) + 1]; \
            const float wa_ = gtl[IDX] * gelu_tanh(da_), wb_ = gtl[(IDX) + 1] * gelu_tanh(db_); \
            VACC(va_, wa_); VACC(vb_, wb_); \
            asm volatile("s_waitcnt lgkmcnt(0)" ::: "memory"); } while (0)
#define DMA_WAIT(N) asm volatile("s_waitcnt vmcnt(" #N ")" ::: "memory")
        ROW_ISSUE(0, 0); ROW_ISSUE(1, 1); ROW_ISSUE(2, 2); ROW_ISSUE(3, 3); ROW_ISSUE(4, 4); ROW_ISSUE(5, 5); ROW_ISSUE(6, 6); ROW_ISSUE(7, 7);
#pragma unroll 1
        for (int e = 0; e < 128; e += 8) {
            const bool more = e + 8 < 128;
            DMA_WAIT(12); PAIR_APPLY(0, 1, e);     if (more) { ROW_ISSUE(0, e + 8);  ROW_ISSUE(1, e + 9); }
            if (more) DMA_WAIT(12); else DMA_WAIT(0);
            PAIR_APPLY(2, 3, e + 2); if (more) { ROW_ISSUE(2, e + 10); ROW_ISSUE(3, e + 11); }
            if (more) DMA_WAIT(12);
            PAIR_APPLY(4, 5, e + 4); if (more) { ROW_ISSUE(4, e + 12); ROW_ISSUE(5, e + 13); }
            if (more) DMA_WAIT(12);
            PAIR_APPLY(6, 7, e + 6); if (more) { ROW_ISSUE(6, e + 14); ROW_ISSUE(7, e + 15); }
        }
#undef ROW_ISSUE
#undef PAIR_APPLY
#undef UDOT
#undef VACC
#undef DMA_WAIT
    }
    {
        float* xo = a.out + (size_t)t * 2048; const bf16_t* x1p = (const bf16_t*)(a.ws + WS_X1) + (size_t)t * 2048; const float* g2 = (const float*)(a.ws + WS_COND) + 5 * 2048; const float* fg = a.in[32];
        u32x2 xw[8]; f32x4 gvv[8], fvv[8];
#pragma unroll
        for (int k = 0; k < 8; ++k) { const int col = lane * 32 + k * 4; xw[k] = *(const u32x2*)(x1p + col); gvv[k] = *(const f32x4*)(g2 + col); fvv[k] = *(const f32x4*)(fg + col); }
        float ss = 0.f;
#pragma unroll
        for (int k = 0; k < 8; ++k) {
            const float x1[4] = {bflo(xw[k][0]), bfhi(xw[k][0]), bflo(xw[k][1]), bfhi(xw[k][1])};
#pragma unroll
            for (int e = 0; e < 4; ++e) { const float x2 = x1[e] + PEER_ALPHA * gvv[k][e] * acc[k * 4 + e]; acc[k * 4 + e] = x2; ss += x2 * x2; }
        }
        ss = wave_sum_bcast(ss);
        const float rstd = rsqrtf(ss * (1.f / 2048.f) + 1e-6f);
#pragma unroll
        for (int k = 0; k < 8; ++k) {
            const int col = lane * 32 + k * 4;
            f32x4 o;
#pragma unroll
            for (int e = 0; e < 4; ++e) o[e] = acc[k * 4 + e] * rstd * fvv[k][e];
            if (!DRY || rstd == 123.456f) *(f32x4*)(xo + col) = o;
        }
    }
    __syncthreads();
}
constexpr int NPHASE = 14;
#ifndef DBG
#define DBG 0
#endif
__device__ __forceinline__ void dbg_final_norm(const Args& a, const Ctx& c, const float* src) {
    for (int t = c.bid * 8 + c.wave; t < L_; t += c.nb * 8) {
        const float* xr = src + (size_t)t * 2048 + c.lane * 4; float* o = a.out + (size_t)t * 2048 + c.lane * 4;
        f32x4 v[8]; float ss = 0.f;
#pragma unroll
        for (int j = 0; j < 8; ++j) { v[j] = *(const f32x4*)(xr + j * 256); ss += v[j][0] * v[j][0] + v[j][1] * v[j][1] + v[j][2] * v[j][2] + v[j][3] * v[j][3]; }
        ss = wave_sum(ss);
        const float rstd = rsqrtf(ss * (1.f / 2048.f) + 1e-6f);
#pragma unroll
        for (int j = 0; j < 8; ++j) { const f32x4 g = *(const f32x4*)(a.in[32] + j * 256 + c.lane * 4); *(f32x4*)(o + j * 256) = v[j] * rstd * g; }
    }
}

extern __shared__ __attribute__((aligned(16))) unsigned char smem[];

__global__ void __launch_bounds__(512, 2) fwd(Args a) {
    LAS unsigned char* lds = (LAS unsigned char*)smem;
    Ctx c; c.bid = blockIdx.x; c.nb = gridDim.x; c.tid = threadIdx.x; c.wave = __builtin_amdgcn_readfirstlane(threadIdx.x >> 6); c.lane = threadIdx.x & 63; c.lds = lds;
    volatile LAS unsigned* xbw = (volatile LAS unsigned*)(lds + LDS_BYTES - 16);
    if (c.tid < 4) xbw[c.tid] = 0u;
    __syncthreads();
    const int lo = a.ph_lo, hi = a.ph_hi;
    const bool multi = (hi - lo) > 1;
    XcdBarrier bar; bar.bar = (unsigned*)(a.ws + WS_CTL); bar.x = 0; bar.st = xbw;
    if (multi) bar = xcd_barrier_post((unsigned*)(a.ws + WS_CTL), xbw);
#ifndef PHASE_MASK
#define PHASE_MASK 0xFFFF
#endif
#if DBG == 1
#undef PHASE_MASK
#define PHASE_MASK 0x403
#elif DBG == 2 || DBG == 4 || DBG == 5
#undef PHASE_MASK
#define PHASE_MASK 0x4FF
#endif
#define IN(k) (((PHASE_MASK >> (k)) & 1) && lo <= (k) && (k) < hi)
#define REFRESH() do { int tz_ = threadIdx.x; asm volatile("" : "+v"(tz_)); c.tid = tz_; c.lane = tz_ & 63; c.wave = __builtin_amdgcn_readfirstlane(tz_ >> 6); } while (0)
#define SEAM(k) do { if (IN(k) && IN((k) + 1)) xcd_barrier(bar); } while (0)
#ifndef DUP
#define DUP -1
#endif
#define REP(k) for (int rep_ = 0; rep_ < ((DUP == (k)) ? 2 : 1); ++rep_)
#define DUP2(k, ...) do { __VA_ARGS__; if (DUP == (k)) { __syncthreads(); __VA_ARGS__; } } while (0)

    if (IN(0)) REP(0) { REFRESH(); p0_prologue(a, c); }
    SEAM(0);
    if (IN(1)) { REFRESH(); DUP2(1, p1_hnorm(a, c)); }
    SEAM(1);
    if (IN(2)) { REFRESH();
        pg8::StaticOrder S; S.init((const bf16_t*)(a.ws + WS_H), (const bf16_t*)(a.ws + WS_WIN), 2048, 2048, 2048, L_, DIN_PAD, c.nb, c.bid);
        EpiWin E{(bf16_t*)(a.ws + WS_US), (bf16_t*)(a.ws + WS_Q), (bf16_t*)(a.ws + WS_KROW), (bf16_t*)(a.ws + WS_VROW), (bf16_t*)(a.ws + WS_VT), (float*)(a.ws + WS_GATE)};
        DUP2(2, pg8::gemm_phase<EpiWin, pg8::StaticOrder>(lds, S, E));
    }
    SEAM(2);
    if (IN(3)) { REFRESH();
        DUP2(31, for (int it = c.bid; it < 256; it += c.nb) s5_item<0>(a, c, it >> 2, it & 3));
        __syncthreads();
        CmpOrder S{(const bf16_t*)(a.ws + WS_KROW), (const bf16_t*)(a.ws + WS_VROW), (const bf16_t*)(a.ws + WS_W1), 2048, 4096, 1024, c.nb, c.bid};
        EpiSlab E{(float*)(a.ws + WS_SLAB)};
        DUP2(32, pg8::gemm_phase<EpiSlab, CmpOrder>(lds, S, E));
    }
    SEAM(3);
    if (IN(4)) { REFRESH();
        DUP2(41, for (int it = c.bid; it < 64; it += c.nb) cmp_finish_item(a, c, it >> 5, it & 31));
        DUP2(42, for (int it = c.bid; it < 256; it += c.nb) s5_item<1>(a, c, it >> 2, it & 3));
    }
    SEAM(4);
    if (IN(5)) { REFRESH();
#if DBG == 5
        for (size_t i = (size_t)c.bid * NTHREADS + c.tid; i < (size_t)L_ * 1024 / 8; i += (size_t)c.nb * NTHREADS) *(u32x4*)((bf16_t*)(a.ws + WS_YSSM) + i * 8) = (u32x4){0u, 0u, 0u, 0u};
#else
        {
            pg8::StaticOrder S; S.init((const bf16_t*)(a.ws + WS_Z), (const bf16_t*)(a.ws + WS_WGLU), 1024, 1024, 1024, L_, 1024, c.nb, c.bid);
            EpiGlu E{(const bf16_t*)(a.ws + WS_Z), a.in[19], (bf16_t*)(a.ws + WS_YSSM)};
            DUP2(55, pg8::gemm_phase<EpiGlu, pg8::StaticOrder>(lds, S, E));
        }
#endif
        __syncthreads();
        REP(5)
#if DBG == 4
        for (size_t i = (size_t)c.bid * NTHREADS + c.tid; i < (size_t)L_ * 1024 / 8; i += (size_t)c.nb * NTHREADS) *(u32x4*)((bf16_t*)(a.ws + WS_YATT) + i * 8) = (u32x4){0u, 0u, 0u, 0u};
#else
        {
            unsigned* qhead = (unsigned*)(a.ws + WS_CTL) + 8192;
            volatile LAS unsigned* slot = (volatile LAS unsigned*)(lds + LDS_BYTES - 32);
            for (;;) {
                if (c.tid == 0) *slot = __hip_atomic_fetch_add(qhead, 1u, __ATOMIC_RELAXED, __HIP_MEMORY_SCOPE_AGENT);
                __syncthreads();
                const unsigned q = *slot;
                __syncthreads();
                if (q >= 512u) break;
                attn_item(a, c, 255 - (int)(q >> 1), (int)(q & 1));
            }
        }
#endif
    }
    SEAM(5);
    if (IN(6)) { REFRESH(); DUP2(6, p6_mixnorm(a, c)); }
    SEAM(6);
#define WOUT_GEMM(PM0) do { pg8::StaticOrder S; S.init((const bf16_t*)(a.ws + WS_H), (const bf16_t*)(a.ws + WS_WOUT), 2048, 2048, 2048, L_ / 2, 2048, c.nb, c.bid, PM0); \
        EpiWout E{a.in[0], (const float*)(a.ws + WS_COND) + 2 * 2048, (bf16_t*)(a.ws + WS_X1)}; pg8::gemm_phase<EpiWout, pg8::StaticOrder>(lds, S, E); __syncthreads(); } while (0)
#define WQ_GEMM(PM0) do { pg8::StaticOrder S; S.init((const bf16_t*)(a.ws + WS_H), (const bf16_t*)(a.ws + WS_WQ), 2048, 2048, 2048, L_ / 2, 2048, c.nb, c.bid, PM0); \
        EpiBf16 E{(bf16_t*)(a.ws + WS_QP), 2048}; pg8::gemm_phase<EpiBf16, pg8::StaticOrder>(lds, S, E); __syncthreads(); } while (0)
#define PEER_STEPS(FIRST, COUNT) do { for (int s_ = (FIRST) + c.bid; s_ < (FIRST) + (COUNT); s_ += c.nb) peer_step<false>(a, c, s_ * 8); } while (0)
    if (IN(7)) { REFRESH(); WOUT_GEMM(0); }
    SEAM(7);
    if (IN(8)) { REFRESH(); p8_h2norm(a, c, 0, L_ / 2); }
    SEAM(8);
    if (IN(9)) { REFRESH(); WQ_GEMM(0); }
    SEAM(9);
    if (IN(10)) { REFRESH();
        if ((c.bid >> 3) & 1) PEER_STEPS(0, 512);
        WOUT_GEMM(32);
        if (!((c.bid >> 3) & 1)) PEER_STEPS(0, 512); }
    SEAM(10);
    if (IN(11)) { REFRESH(); p8_h2norm(a, c, L_ / 2, L_ / 2); }
    SEAM(11);
    if (IN(12)) { REFRESH();
        if ((c.bid >> 3) & 1) PEER_STEPS(512, 512);
        WQ_GEMM(32);
        if (!((c.bid >> 3) & 1)) PEER_STEPS(512, 512); }
    SEAM(12);
    if (IN(13)) { REFRESH(); PEER_STEPS(1024, 1024); }
#undef WOUT_GEMM
#undef WQ_GEMM
#undef PEER_STEPS
#undef IN
#undef SEAM
}

#ifndef N_LAUNCHES
#define N_LAUNCHES 1
#endif
extern "C" void kernel_launch(void* const* d_in, const int* in_sizes, int n_in, void* d_out, int out_size, void* d_ws, size_t ws_size, hipStream_t stream) {
    static int grid = 0;
    if (grid == 0) {
        if (n_in != 33 || out_size != L_ * D_ || ws_size < WS_END) { fprintf(stderr, "kernel_launch: unexpected shapes (n_in %d, out %d, ws %zu < %zu); nothing launched\n", n_in, out_size, ws_size, (size_t)WS_END); grid = -1; return; }
        int dev = 0, cus = 0, per_cu = 0;
        if (hipGetDevice(&dev) != hipSuccess || hipDeviceGetAttribute(&cus, hipDeviceAttributeMultiprocessorCount, dev) != hipSuccess) { grid = -1; return; }
        if (hipFuncSetAttribute((const void*)fwd, hipFuncAttributeMaxDynamicSharedMemorySize, LDS_BYTES) != hipSuccess) { fprintf(stderr, "kernel_launch: hipFuncSetAttribute failed\n"); grid = -1; return; }
        if (hipOccupancyMaxActiveBlocksPerMultiprocessor(&per_cu, (const void*)fwd, NTHREADS, LDS_BYTES) != hipSuccess || per_cu < 1) { fprintf(stderr, "kernel_launch: occupancy query says %d\n", per_cu); (void)hipGetLastError(); grid = -1; return; }
        grid = cus;
    }
    if (grid < 0) return;
    (void)hipMemsetAsync((char*)d_ws + WS_CTL, 0, CTL_BYTES, stream);
    Args a{};
    for (int i = 0; i < 33; ++i) a.in[i] = (const float*)d_in[i];
    a.out = (float*)d_out; a.ws = (unsigned char*)d_ws;
    if (N_LAUNCHES == 1) { a.ph_lo = 0; a.ph_hi = NPHASE; hipLaunchKernelGGL(fwd, dim3(grid), dim3(NTHREADS), LDS_BYTES, stream, a); }
    else for (int p = 0; p < NPHASE; ++p) { a.ph_lo = p; a.ph_hi = p + 1; hipLaunchKernelGGL(fwd, dim3(grid), dim3(NTHREADS), LDS_BYTES, stream, a); }
}
```

```cpp
#include <hip/hip_runtime.h>
#include <stdint.h>
#include <stdio.h>

#define LAS __attribute__((address_space(3)))
typedef unsigned short bf16_t;
typedef short bf16x8 __attribute__((ext_vector_type(8)));
typedef float f32x2 __attribute__((ext_vector_type(2)));
typedef float f32x4 __attribute__((ext_vector_type(4)));
typedef float f32x16 __attribute__((ext_vector_type(16)));
typedef unsigned u32x2 __attribute__((ext_vector_type(2)));
typedef unsigned u32x4 __attribute__((ext_vector_type(4)));
typedef __bf16 bfv2 __attribute__((ext_vector_type(2)));
typedef unsigned u32x6 __attribute__((ext_vector_type(6)));
typedef float f32x32 __attribute__((ext_vector_type(32)));

constexpr int L_ = 16384, D_ = 2048, DSSM = 1024, DATT = 1024, DIN = 3608, DIN_PAD = 3840;
constexpr int NADA = 12288;
constexpr float LOG2E = 1.4426950408889634f;
constexpr float QSCALE = 0.08838834764831845f * 1.4426950408889634f;
constexpr int TBN = 800;
constexpr int NTHREADS = 512;
constexpr int LDS_BYTES = 163840;

constexpr size_t al256(size_t x) { return (x + 255) & ~(size_t)255; }
constexpr size_t WS_CTL   = 0;                                  constexpr size_t CTL_BYTES = 65536;
constexpr size_t WS_CONDP = WS_CTL + CTL_BYTES;
constexpr size_t WS_COND  = WS_CONDP + 32 * 12288 * 4;
constexpr size_t WS_TB    = WS_COND + 12288 * 4;
constexpr size_t WS_BPE   = al256(WS_TB + 8 * TBN * 4);
constexpr size_t WS_S5P   = al256(WS_BPE + 2 * 256 * 4);
constexpr size_t WS_S5F   = WS_S5P + 2 * 64 * 64 * 2 * 4;
constexpr size_t WS_S5MT  = WS_S5F + 64 * 4 * 128 * 4;
constexpr size_t WS_S5WE  = WS_S5MT + (size_t)64 * 256 * 256 * 2;
constexpr size_t WS_S5WC  = WS_S5WE + (size_t)64 * 128 * 256 * 2;
constexpr size_t WS_WIN   = WS_S5WC + (size_t)64 * 256 * 128 * 2;
constexpr size_t WS_WGLU  = WS_WIN + (size_t)DIN_PAD * 2048 * 2;
constexpr size_t WS_WOUT  = WS_WGLU + (size_t)1024 * 1024 * 2;
constexpr size_t WS_WQ    = WS_WOUT + (size_t)2048 * 2048 * 2;
constexpr size_t WS_W1    = WS_WQ + (size_t)2048 * 2048 * 2;
constexpr size_t WS_W2    = WS_W1 + (size_t)2 * 256 * 4096 * 2;
constexpr size_t WS_PK    = WS_W2 + (size_t)2 * 128 * 256 * 2;
constexpr size_t WS_PU    = WS_PK + (size_t)2 * 128 * 128 * 2;
constexpr size_t WS_PV    = WS_PU + (size_t)16384 * 1024;
constexpr size_t WS_PSC   = WS_PV + (size_t)16384 * 1024;
constexpr size_t WS_BPEP  = WS_PSC + (size_t)2 * 16384 * 4;
constexpr size_t WS_H     = WS_BPEP + (size_t)32 * 2 * 256 * 4;
constexpr size_t WS_US    = WS_H + (size_t)16384 * 2048 * 2;
constexpr size_t WS_Q     = WS_US + (size_t)16384 * 1024 * 2;
constexpr size_t WS_QP    = WS_US;
constexpr size_t WS_KROW  = WS_Q + (size_t)16384 * 1024 * 2;
constexpr size_t WS_VROW  = WS_KROW + (size_t)6 * 16384 * 128 * 2;
constexpr size_t WS_VT    = WS_VROW + (size_t)2 * 16384 * 128 * 2 + 8192;
constexpr size_t WS_GATE  = WS_VT + (size_t)4 * 128 * 16384 * 2;
constexpr size_t WS_SLAB  = WS_GATE + (size_t)16384 * 24 * 4;
constexpr size_t WS_KC    = WS_SLAB + (size_t)2 * 4 * 2048 * 256 * 4;
constexpr size_t WS_VCT   = WS_KC + (size_t)2 * 1024 * 128 * 2;
constexpr size_t WS_Z     = WS_VCT + (size_t)2 * 128 * 1024 * 2;
constexpr size_t WS_YSSM  = WS_Z + (size_t)16384 * 1024 * 2;
constexpr size_t WS_YATT  = WS_YSSM + (size_t)16384 * 1024 * 2;
constexpr size_t WS_X1    = WS_Z;
constexpr size_t WS_END   = WS_YATT + (size_t)16384 * 1024 * 2;
static_assert(WS_END < (size_t)530 * 1024 * 1024, "workspace map too large");

struct Args { const float* in[33]; float* out; unsigned char* ws; int ph_lo, ph_hi; };

__device__ __forceinline__ unsigned cvt_pk_bf16(float lo, float hi) { bfv2 v; v[0] = (__bf16)lo; v[1] = (__bf16)hi; return __builtin_bit_cast(unsigned, v); }
__device__ __forceinline__ bf16_t f2bf(float f) { return (bf16_t)(cvt_pk_bf16(f, 0.f) & 0xffffu); }
__device__ __forceinline__ float bf2f(unsigned b) { return __uint_as_float(b << 16); }
__device__ __forceinline__ float bflo(unsigned w) { return __uint_as_float(w << 16); }
__device__ __forceinline__ float bfhi(unsigned w) { return __uint_as_float(w & 0xffff0000u); }
__device__ __forceinline__ float fexp2(float x) { return __builtin_amdgcn_exp2f(x); }
__device__ __forceinline__ float frcp(float x) { return __builtin_amdgcn_rcpf(x); }
__device__ __forceinline__ float sigmoidf_(float x) { return frcp(1.f + fexp2(-LOG2E * x)); }
__device__ __forceinline__ float gelu_tanh(float x) {
    const float u = x * (1.f + 0.044715f * x * x);
    return x * frcp(1.f + fexp2(-2.f * 0.7978845608028654f * LOG2E * u));
}
__device__ __forceinline__ float shfl_xor_f(float v, int m) { return __shfl_xor(v, m, 64); }
__device__ __forceinline__ float wave_sum(float v) {
#pragma unroll
    for (int m = 32; m >= 1; m >>= 1) v += __shfl_xor(v, m, 64);
    return v;
}
__device__ __forceinline__ float wave_max(float v) {
#pragma unroll
    for (int m = 32; m >= 1; m >>= 1) v = fmaxf(v, __shfl_xor(v, m, 64));
    return v;
}
template <int CTRL> __device__ __forceinline__ float dpp_f(float x) { return __int_as_float(__builtin_amdgcn_update_dpp(0, __float_as_int(x), CTRL, 0xf, 0xf, false)); }
__device__ __forceinline__ float wave_max_bcast(float v) {
    v = fmaxf(v, dpp_f<0xB1>(v)); v = fmaxf(v, dpp_f<0x4E>(v)); v = fmaxf(v, dpp_f<0x141>(v)); v = fmaxf(v, dpp_f<0x140>(v));
    v = fmaxf(v, __int_as_float(__builtin_amdgcn_update_dpp(__float_as_int(v), __float_as_int(v), 0x142, 0xa, 0xf, false)));
    v = fmaxf(v, __int_as_float(__builtin_amdgcn_update_dpp(__float_as_int(v), __float_as_int(v), 0x143, 0xc, 0xf, false)));
    return __int_as_float(__builtin_amdgcn_readlane(__float_as_int(v), 63));
}
__device__ __forceinline__ unsigned wave_umax_bcast(unsigned v) {
#define UDPP_(x, ctrl, rm) (unsigned)__builtin_amdgcn_update_dpp((int)(x), (int)(x), ctrl, rm, 0xf, false)
    v = max(v, UDPP_(v, 0xB1, 0xf)); v = max(v, UDPP_(v, 0x4E, 0xf)); v = max(v, UDPP_(v, 0x141, 0xf)); v = max(v, UDPP_(v, 0x140, 0xf));
    v = max(v, UDPP_(v, 0x142, 0xa)); v = max(v, UDPP_(v, 0x143, 0xc));
#undef UDPP_
    return (unsigned)__builtin_amdgcn_readlane((int)v, 63);
}
__device__ __forceinline__ float quad_sum(float x) { x += dpp_f<0xB1>(x); x += dpp_f<0x4E>(x); return x; }
template <int SEL> __device__ __forceinline__ f32x2 fp4_unpk(unsigned w) { return __builtin_amdgcn_cvt_scalef32_pk_f32_fp4(w, 1.0f, SEL); }
template <int SEL> __device__ __forceinline__ unsigned fp4_pk(unsigned w, float a, float b) { return __builtin_amdgcn_cvt_scalef32_pk_fp4_f32(w, a, b, 1.0f, SEL); }
__device__ __forceinline__ f32x4 mfma16(bf16x8 a, bf16x8 b, f32x4 c) { return __builtin_amdgcn_mfma_f32_16x16x32_bf16(a, b, c, 0, 0, 0); }
__device__ __forceinline__ f32x16 mfma32(bf16x8 a, bf16x8 b, f32x16 c) { return __builtin_amdgcn_mfma_f32_32x32x16_bf16(a, b, c, 0, 0, 0); }
#define XB_TMO      128
#define XB_XCNT(j)  (256  + 64 * (j))
#define XB_XSUB(j)  (1280 + 64 * (j))
#define XB_XGEN(j)  (2304 + 64 * (j))
#define XB_TOP      3328
#define XB_TOPGEN   3392
#define XCD_BAR_WORDS 3456
#define XB_SPIN_CAP (1u << 18)

__device__ __forceinline__ unsigned xb_ld(unsigned* p)              { return __hip_atomic_load(p, __ATOMIC_RELAXED, __HIP_MEMORY_SCOPE_AGENT); }
__device__ __forceinline__ unsigned xb_add(unsigned* p, unsigned v) { return __hip_atomic_fetch_add(p, v, __ATOMIC_RELAXED, __HIP_MEMORY_SCOPE_AGENT); }
__device__ __forceinline__ unsigned xb_xcc_id() { return (unsigned)__builtin_amdgcn_s_getreg((3 << 11) | 20) & 0xFu; }
#define XB_SPIN(cond, bar) do { unsigned _sp = 0; while (cond) { __builtin_amdgcn_s_sleep(1); \
    if ((++_sp & 255u) == 0u) { if (xb_ld(&(bar)[XB_TMO])) break; if (_sp > XB_SPIN_CAP) { atomicAdd(&(bar)[XB_TMO], 1u); break; } } } } while (0)

struct XcdBarrier {
    unsigned* bar; unsigned x;
    volatile LAS unsigned* st;
};
__device__ __forceinline__ XcdBarrier xcd_barrier_post(unsigned* bar, volatile LAS unsigned* st) {
    XcdBarrier b; b.bar = bar; b.x = xb_xcc_id(); b.st = st;
    if (threadIdx.x == 0) (void)xb_add(&bar[XB_XCNT(b.x)], 1u);
    return b;
}
__device__ __forceinline__ void xcd_barrier_complete(unsigned* bar, unsigned x, unsigned& nloc, unsigned& nx) {
    const unsigned G = gridDim.x * gridDim.y * gridDim.z;
    unsigned sum, cnt, mine, sp = 0u;
    for (;;) {
        sum = 0u; cnt = 0u; mine = 0u;
#pragma unroll
        for (unsigned j = 0; j < 16; ++j) { const unsigned c = xb_ld(&bar[XB_XCNT(j)]); sum += c; cnt += (c > 0u) ? 1u : 0u; mine = (j == x) ? c : mine; }
        if (sum == G) break;
        __builtin_amdgcn_s_sleep(1);
        if ((++sp & 255u) == 0u) { if (xb_ld(&bar[XB_TMO])) break; if (sp > XB_SPIN_CAP) { atomicAdd(&bar[XB_TMO], 1u); break; } }
    }
    nloc = mine > 0u ? mine : 1u; nx = cnt > 0u ? cnt : 1u;
}
__device__ __forceinline__ void xcd_barrier(const XcdBarrier& b) {
    asm volatile("s_waitcnt vmcnt(0)" ::: "memory");
    __syncthreads();
    if (threadIdx.x == 0) {
        unsigned* bar = b.bar;
        __builtin_amdgcn_s_waitcnt(0);
        unsigned nloc = b.st[0], nx = b.st[1];
        if (nloc == 0u) { xcd_barrier_complete(bar, b.x, nloc, nx); b.st[0] = nloc; b.st[1] = nx; }
        const unsigned old = xb_add(&bar[XB_XSUB(b.x)], 1u);
        const unsigned gen = old / nloc;
        if (old + 1u == (gen + 1u) * nloc) {
            __builtin_amdgcn_fence(__ATOMIC_RELEASE, "agent");
            asm volatile("s_waitcnt vmcnt(0)" ::: "memory");
            const unsigned og = xb_add(&bar[XB_TOP], 1u);
            const unsigned tg = og / nx;
            if (og + 1u == (tg + 1u) * nx) xb_add(&bar[XB_TOPGEN], 1u);
            else XB_SPIN(xb_ld(&bar[XB_TOPGEN]) == tg, bar);
            __builtin_amdgcn_fence(__ATOMIC_ACQUIRE, "agent");
            xb_add(&bar[XB_XGEN(b.x)], 1u);
            asm volatile("s_waitcnt vmcnt(0)" ::: "memory");
        } else {
            XB_SPIN(xb_ld(&bar[XB_XGEN(b.x)]) == gen, bar);
            __builtin_amdgcn_fence(__ATOMIC_ACQUIRE, "agent");
            asm volatile("s_waitcnt vmcnt(0)" ::: "memory");
        }
    }
    __syncthreads();
}

namespace pg8 {
constexpr int BM = 256, BK = 64, HALF = 128, HTB = HALF * BK * 2, STAGE_BYTES = 8 * HTB, NXCD = 8, WGM = 8;
__host__ __device__ __forceinline__ int lds_byte(int r, int c) { const int st = (r >> 4) * 2 + (c >> 5), rr = r & 15, cc = c & 31, ob = rr * 64 + cc * 2; return st * 1024 + (ob ^ (((ob >> 9) & 1) << 5)); }
__host__ __device__ __forceinline__ void stage_rc(int b, int& R, int& C) { const int st = b / 1024, sb = b % 1024, swz = sb ^ (((sb >> 9) & 1) << 5); R = (st >> 1) * 16 + swz / 64; C = (st & 1) * 32 + (swz % 64) / 2; }
__host__ __device__ __forceinline__ int perm32(int rho) { const int n = rho >> 4, i = rho & 15; return 8 * (i >> 2) + 4 * n + (i & 3); }

struct Unit { int pm, pn, z; };
struct StaticOrder {
    const bf16_t* A; const bf16_t* Bt; int lda, ldb, K;
    int nM, nN, nwg, G, c, pm0;
    __device__ void init(const bf16_t* A_, const bf16_t* Bt_, int lda_, int ldb_, int K_, int M, int N, int G_, int c_, int pm0_ = 0) { A = A_; Bt = Bt_; lda = lda_; ldb = ldb_; K = K_; nM = M / BM; nN = N / BM; nwg = nM * nN; G = G_; c = c_; pm0 = pm0_; }
    __device__ bool next(int i, Unit& u) const {
        const long Lx = (long)i * G + c; if (Lx >= nwg) return false;
        int wgid = (int)Lx; { const int q = nwg / NXCD, r = nwg % NXCD, xcd = wgid % NXCD, off = wgid / NXCD; wgid = (xcd < r ? xcd * (q + 1) : r * (q + 1) + (xcd - r) * q) + off; }
        const int nig = WGM * nN, gid = wgid / nig, fm = gid * WGM, gsz = (nM - fm) < WGM ? (nM - fm) : WGM;
        u.pm = pm0 + fm + ((wgid % nig) % gsz); u.pn = (wgid % nig) / gsz; u.z = 0; return true;
    }
    __device__ __forceinline__ const char* a_base(const Unit& u) const { return (const char*)(A + (size_t)u.pm * BM * lda); }
    __device__ __forceinline__ const char* b_base(const Unit& u) const { return (const char*)(Bt + (size_t)u.pn * BM * ldb); }
};

template <class Epi, class Sched>
__device__ __forceinline__ void gemm_phase(LAS unsigned char* lds, const Sched& S, const Epi& E) {
    const int tid = threadIdx.x, wid = __builtin_amdgcn_readfirstlane(tid >> 6), lane = tid & 63, wr = wid >> 2, wc = wid & 3, fr = lane & 15, fq = lane >> 4;
    const int K = S.K, nt = K / BK, lda = S.lda, ldb = S.ldb;
    unsigned voffA[2], voffB[2];
#pragma unroll
    for (int i = 0; i < 2; ++i) { int R, C; stage_rc(tid * 16 + i * 8192, R, C); const int Rb = Epi::PERM ? ((R & ~31) + perm32(R & 31)) : R;
        voffA[i] = (unsigned)(R * lda + C) * 2u; voffB[i] = (unsigned)(Rb * ldb + C) * 2u; }
    const size_t kstep = (size_t)(BK * 2);
    const size_t hstepA = (size_t)HALF * lda * 2, hstepB = (size_t)HALF * ldb * 2;
    const unsigned ldsw = (unsigned)wid * 1024u;
    const int aoff = lds_byte(wr * 64 + fr, fq * 8), boff = lds_byte(wc * 32 + fr, fq * 8);
#define PG8_SA(b, h) (((b) * 2 + (h)) * HTB)
#define PG8_SB(b, h) ((4 + (b) * 2 + (h)) * HTB)
#define PG8_STAGE(bufoff, gbase, voff) do { _Pragma("unroll") for (int _i = 0; _i < 2; ++_i) \
        __builtin_amdgcn_global_load_lds((const unsigned*)((const char*)(gbase) + (voff)[_i]), (LAS unsigned*)(lds + (bufoff) + ldsw + _i * 8192), 16, 0, 0); } while (0)
#define PG8_LDA(dst, b, h) do { _Pragma("unroll") for (int m = 0; m < 4; ++m) _Pragma("unroll") for (int k = 0; k < 2; ++k) dst[m][k] = *(const LAS bf16x8*)(lds + PG8_SA(b, h) + aoff + m * 2048 + k * 1024); } while (0)
#define PG8_LDB(dst, b, h) do { _Pragma("unroll") for (int n = 0; n < 2; ++n) _Pragma("unroll") for (int k = 0; k < 2; ++k) dst[n][k] = *(const LAS bf16x8*)(lds + PG8_SB(b, h) + boff + n * 2048 + k * 1024); } while (0)
#define PG8_MMA(ai, bj, At, Bt) do { __builtin_amdgcn_s_setprio(1); _Pragma("unroll") for (int m = 0; m < 4; ++m) _Pragma("unroll") for (int n = 0; n < 2; ++n) _Pragma("unroll") for (int k = 0; k < 2; ++k) \
        acc[ai][bj][m][n] = __builtin_amdgcn_mfma_f32_16x16x32_bf16(Bt[n][k], At[m][k], acc[ai][bj][m][n], 0, 0, 0); __builtin_amdgcn_s_setprio(0); } while (0)
#define PG8_WAIT_V(n) asm volatile("s_waitcnt vmcnt(" #n ")" ::: "memory")
#define PG8_WAIT_L(n) asm volatile("s_waitcnt lgkmcnt(" #n ")" ::: "memory")
#define PG8_BAR __builtin_amdgcn_s_barrier()
#define PG8_SCHED __builtin_amdgcn_sched_barrier(0)
    Unit cur, nxt; int ui = 0;
    if (!S.next(0, cur)) return;
    f32x4 acc[2][2][4][2];
#pragma unroll
    for (int a = 0; a < 2; ++a)
#pragma unroll
        for (int b = 0; b < 2; ++b)
#pragma unroll
            for (int m = 0; m < 4; ++m)
#pragma unroll
                for (int n = 0; n < 2; ++n) acc[a][b][m][n] = (f32x4){0.f, 0.f, 0.f, 0.f};
    bf16x8 At[4][2], B0[2][2], B1[2][2];
    const char* cA = S.a_base(cur); const char* cB = S.b_base(cur);
    PG8_STAGE(PG8_SB(0, 0), cB, voffB); PG8_STAGE(PG8_SA(0, 0), cA, voffA); PG8_STAGE(PG8_SB(0, 1), cB + hstepB, voffB); PG8_STAGE(PG8_SA(0, 1), cA + hstepA, voffA);
    if (wr == 1) PG8_BAR;
    PG8_WAIT_V(4); PG8_BAR;
    PG8_STAGE(PG8_SB(1, 0), cB + kstep, voffB); PG8_STAGE(PG8_SA(1, 0), cA + kstep, voffA); PG8_STAGE(PG8_SB(1, 1), cB + hstepB + kstep, voffB);
    PG8_WAIT_V(6); PG8_BAR;
    for (;;) {
        const bool has_next = S.next(ui + 1, nxt);
        const char* nA = has_next ? S.a_base(nxt) : cA; const char* nB = has_next ? S.b_base(nxt) : cB;
        for (int t = 0; t < nt; t += 2) {
            const bool last = (t == nt - 2);
            const char* a1 = cA + (size_t)(t + 1) * kstep;
            const char* a2 = last ? nA : cA + (size_t)(t + 2) * kstep; const char* b2 = last ? nB : cB + (size_t)(t + 2) * kstep;
            const char* a3 = a2 + kstep; const char* b3 = b2 + kstep;
            PG8_LDB(B0, 0, 0); PG8_SCHED; PG8_LDA(At, 0, 0); PG8_STAGE(PG8_SA(1, 1), a1 + hstepA, voffA);
            PG8_WAIT_L(8); PG8_BAR; PG8_WAIT_L(0); PG8_MMA(0, 0, At, B0); PG8_BAR; PG8_SCHED;
            PG8_LDB(B1, 0, 1); PG8_STAGE(PG8_SB(0, 0), b2, voffB);
            PG8_BAR; PG8_WAIT_L(0); PG8_MMA(0, 1, At, B1); PG8_BAR;
            PG8_LDA(At, 0, 1); PG8_STAGE(PG8_SA(0, 0), a2, voffA);
            PG8_BAR; PG8_WAIT_L(0); PG8_MMA(1, 0, At, B0); PG8_BAR; PG8_SCHED;
            PG8_STAGE(PG8_SB(0, 1), b2 + hstepB, voffB);
            PG8_WAIT_V(6); PG8_BAR; PG8_MMA(1, 1, At, B1); PG8_BAR;
            PG8_LDB(B0, 1, 0); PG8_SCHED; PG8_LDA(At, 1, 0); PG8_STAGE(PG8_SA(0, 1), a2 + hstepA, voffA);
            PG8_WAIT_L(8); PG8_BAR; PG8_WAIT_L(0); PG8_MMA(0, 0, At, B0); PG8_BAR; PG8_SCHED;
            PG8_LDB(B1, 1, 1); PG8_STAGE(PG8_SB(1, 0), b3, voffB);
            PG8_BAR; PG8_WAIT_L(0); PG8_MMA(0, 1, At, B1); PG8_BAR;
            PG8_LDA(At, 1, 1); PG8_STAGE(PG8_SA(1, 0), a3, voffA);
            PG8_BAR; PG8_WAIT_L(0); PG8_MMA(1, 0, At, B0); PG8_BAR; PG8_SCHED;
            PG8_STAGE(PG8_SB(1, 1), b3 + hstepB, voffB);
            PG8_WAIT_V(6); PG8_BAR; PG8_MMA(1, 1, At, B1); PG8_BAR;
        }
        E(acc, cur, wr, wc, fr, fq);
        if (!has_next) break;
#pragma unroll
        for (int a = 0; a < 2; ++a)
#pragma unroll
            for (int b = 0; b < 2; ++b)
#pragma unroll
                for (int m = 0; m < 4; ++m)
#pragma unroll
                    for (int n = 0; n < 2; ++n) acc[a][b][m][n] = (f32x4){0.f, 0.f, 0.f, 0.f};
        cur = nxt; cA = nA; cB = nB; ++ui;
    }
    PG8_WAIT_V(0);
    if (wr == 0) PG8_BAR;
    PG8_BAR;
#undef PG8_SA
#undef PG8_SB
#undef PG8_STAGE
#undef PG8_LDA
#undef PG8_LDB
#undef PG8_MMA
#undef PG8_WAIT_V
#undef PG8_WAIT_L
#undef PG8_BAR
#undef PG8_SCHED
}
}
using pg8::Unit;
__device__ __forceinline__ u32x4 pack8(const f32x4& v0, const f32x4& v1) {
    u32x4 o; o[0] = cvt_pk_bf16(v0[0], v0[1]); o[1] = cvt_pk_bf16(v0[2], v0[3]); o[2] = cvt_pk_bf16(v1[0], v1[1]); o[3] = cvt_pk_bf16(v1[2], v1[3]); return o;
}
struct EpiWin {
    static constexpr bool PERM = true;
    bf16_t* US; bf16_t* Q; bf16_t* KROW; bf16_t* VROW; bf16_t* VT; float* GATE;
    __device__ __forceinline__ void operator()(const f32x4 (&acc)[2][2][4][2], const Unit& u, int wr, int wc, int fr, int fq) const {
        const int row0 = u.pm * 256 + wr * 64 + fr; const int pn = u.pn;
#pragma unroll
        for (int ai = 0; ai < 2; ++ai)
#pragma unroll
            for (int m = 0; m < 4; ++m) {
                const int row = row0 + ai * 128 + m * 16;
#pragma unroll
                for (int bj = 0; bj < 2; ++bj) {
                    const f32x4 v0 = acc[ai][bj][m][0], v1 = acc[ai][bj][m][1];
                    const int cin = bj * 128 + wc * 32 + 8 * fq;
                    if (pn < 4) { *(u32x4*)(US + (size_t)row * 1024 + pn * 256 + cin) = pack8(v0, v1); }
                    else if (pn < 8) { *(u32x4*)(Q + (size_t)row * 1024 + (pn - 4) * 256 + cin) = pack8(v0 * QSCALE, v1 * QSCALE); }
                    else if (pn < 14) {
                        const int kvi = pn - 8, branch = kvi >> 1, kvsel = kvi & 1, g = bj, d0 = wc * 32 + 8 * fq;
                        if (kvsel == 0) { *(u32x4*)(KROW + ((size_t)(branch * 2 + g) * L_ + row) * 128 + d0) = pack8(v0, v1); }
                        else if (branch == 0) { *(u32x4*)(VROW + ((size_t)g * L_ + row) * 128 + d0) = pack8(v0, v1); }
                        else {
                            const int prow = ((row & ~12) | ((row & 4) << 1) | ((row & 8) >> 1));
                            bf16_t* vt = VT + ((size_t)((branch - 1) * 2 + g) * 128 + d0) * L_ + prow;
#pragma unroll
                            for (int e = 0; e < 4; ++e) { vt[(size_t)e * L_] = f2bf(v0[e]); vt[(size_t)(e + 4) * L_] = f2bf(v1[e]); }
                        }
                    } else {
                        if (cin < 24) {
                            float* gp = GATE + (size_t)row * 24 + cin;
                            f32x4 s0, s1;
#pragma unroll
                            for (int e = 0; e < 4; ++e) { s0[e] = sigmoidf_(v0[e]); s1[e] = sigmoidf_(v1[e]); }
                            *(f32x4*)gp = s0; *(f32x4*)(gp + 4) = s1;
                        }
                    }
                }
            }
    }
};
struct EpiGlu {
    static constexpr bool PERM = true;
    const bf16_t* Z; const float* bglu; bf16_t* Y;
    __device__ __forceinline__ void operator()(const f32x4 (&acc)[2][2][4][2], const Unit& u, int wr, int wc, int fr, int fq) const {
        const int row0 = u.pm * 256 + wr * 64 + fr;
#pragma unroll
        for (int bj = 0; bj < 2; ++bj) {
            const int col = u.pn * 256 + bj * 128 + wc * 32 + 8 * fq;
            const f32x4 b0 = *(const f32x4*)(bglu + col), b1 = *(const f32x4*)(bglu + col + 4);
#pragma unroll
            for (int ai = 0; ai < 2; ++ai)
#pragma unroll
                for (int m = 0; m < 4; ++m) {
                    const int row = row0 + ai * 128 + m * 16;
                    const u32x4 zz = *(const u32x4*)(Z + (size_t)row * 1024 + col);
                    const f32x4 v0 = acc[ai][bj][m][0] + b0, v1 = acc[ai][bj][m][1] + b1;
                    f32x4 o0, o1;
                    o0[0] = bflo(zz[0]) * sigmoidf_(v0[0]); o0[1] = bfhi(zz[0]) * sigmoidf_(v0[1]); o0[2] = bflo(zz[1]) * sigmoidf_(v0[2]); o0[3] = bfhi(zz[1]) * sigmoidf_(v0[3]);
                    o1[0] = bflo(zz[2]) * sigmoidf_(v1[0]); o1[1] = bfhi(zz[2]) * sigmoidf_(v1[1]); o1[2] = bflo(zz[3]) * sigmoidf_(v1[2]); o1[3] = bfhi(zz[3]) * sigmoidf_(v1[3]);
                    *(u32x4*)(Y + (size_t)row * 1024 + col) = pack8(o0, o1);
                }
        }
    }
};
struct EpiWout {
    static constexpr bool PERM = true;
    const float* X; const float* g1; bf16_t* X1;
    __device__ __forceinline__ void operator()(const f32x4 (&acc)[2][2][4][2], const Unit& u, int wr, int wc, int fr, int fq) const {
        const int row0 = u.pm * 256 + wr * 64 + fr, col0 = u.pn * 256 + wc * 32 + 8 * fq;
#pragma unroll
        for (int bj = 0; bj < 2; ++bj) {
            const int col = col0 + bj * 128;
            const f32x4 g0 = *(const f32x4*)(g1 + col), g4 = *(const f32x4*)(g1 + col + 4);
#pragma unroll
            for (int ai = 0; ai < 2; ++ai)
#pragma unroll
                for (int m = 0; m < 4; ++m) {
                    const size_t off = (size_t)(row0 + ai * 128 + m * 16) * 2048 + col;
                    const f32x4 x0 = *(const f32x4*)(X + off), x4 = *(const f32x4*)(X + off + 4);
                    *(u32x4*)(X1 + off) = pack8(x0 + g0 * acc[ai][bj][m][0], x4 + g4 * acc[ai][bj][m][1]);
                }
        }
    }
};
struct EpiBf16 {
    static constexpr bool PERM = true;
    bf16_t* O; int ldc;
    __device__ __forceinline__ void operator()(const f32x4 (&acc)[2][2][4][2], const Unit& u, int wr, int wc, int fr, int fq) const {
        const int row0 = u.pm * 256 + wr * 64 + fr, col0 = u.pn * 256 + wc * 32 + 8 * fq;
#pragma unroll
        for (int ai = 0; ai < 2; ++ai)
#pragma unroll
            for (int m = 0; m < 4; ++m)
#pragma unroll
                for (int bj = 0; bj < 2; ++bj)
                    *(u32x4*)(O + (size_t)(row0 + ai * 128 + m * 16) * ldc + col0 + bj * 128) = pack8(acc[ai][bj][m][0], acc[ai][bj][m][1]);
    }
};
struct EpiSlab {
    static constexpr bool PERM = false;
    float* SL;
    __device__ __forceinline__ void operator()(const f32x4 (&acc)[2][2][4][2], const Unit& u, int wr, int wc, int fr, int fq) const {
        float* base = SL + (size_t)u.z * 2048 * 256;
        const int row0 = u.pm * 256 + wr * 64 + fr, col0 = wc * 32 + 4 * fq;
#pragma unroll
        for (int ai = 0; ai < 2; ++ai)
#pragma unroll
            for (int m = 0; m < 4; ++m)
#pragma unroll
                for (int bj = 0; bj < 2; ++bj)
#pragma unroll
                    for (int n = 0; n < 2; ++n)
                        *(f32x4*)(base + (size_t)(row0 + ai * 128 + m * 16) * 256 + col0 + bj * 128 + n * 16) = acc[ai][bj][m][n];
    }
};
struct CmpOrder {
    const bf16_t* KROW; const bf16_t* VROW; const bf16_t* W1; int lda, ldb, K; int G, c;
    __device__ bool next(int i, Unit& u) const {
        const int x = i * G + c; if (x >= 64) return false;
        const int kvsel = x >> 5, pm = (x & 31) >> 2, ks = x & 3; u.pm = pm; u.pn = 0; u.z = kvsel * 4 + ks; return true;
    }
    __device__ __forceinline__ const char* a_base(const Unit& u) const { return (const char*)(((u.z >> 2) ? VROW : KROW) + (size_t)u.pm * 256 * 2048 + (u.z & 3) * 1024); }
    __device__ __forceinline__ const char* b_base(const Unit& u) const { return (const char*)(W1 + (size_t)(u.z >> 2) * 256 * 4096 + (u.z & 3) * 1024); }
};
struct Ctx { int bid, nb, tid, wave, lane; LAS unsigned char* lds; };

__device__ __forceinline__ void p0_cond(const Args& a, const Ctx& c) {
    const float* cv = a.in[1]; const float* w = a.in[2]; float* condp = (float*)(a.ws + WS_CONDP);
    for (int u = c.bid * 8 + c.wave; u < 1536; u += c.nb * 8) {
        const int cc = u % 48, kc = u / 48;
        const float* wp = w + (size_t)(kc * 64) * NADA + cc * 256 + c.lane * 4;
        f32x4 acc = {0.f, 0.f, 0.f, 0.f};
#pragma unroll 16
        for (int k = 0; k < 64; ++k) { const float x = cv[kc * 64 + k]; const float s = x / (1.f + __expf(-x)); acc += s * *(const f32x4*)(wp + (size_t)k * NADA); }
        *(f32x4*)(condp + (size_t)kc * NADA + cc * 256 + c.lane * 4) = acc;
    }
}
__device__ __forceinline__ void conv_T(const float* src, int K, int N, bf16_t* dst, int Npad, const Ctx& c) {
    LAS float* tile = (LAS float*)c.lds;
    const int nkt = K / 64, ntiles = nkt * (Npad / 64);
    const int r = c.tid >> 4, c4 = c.tid & 15;
    f32x4 v[2];
#define CONVT_LD(tix_) do { const int nt_ = (tix_) / nkt, kt_ = (tix_) % nkt, n_ = nt_ * 64 + 4 * c4; _Pragma("unroll") for (int i = 0; i < 2; ++i) { const int k_ = kt_ * 64 + r + 32 * i; v[i] = (f32x4){0.f, 0.f, 0.f, 0.f}; if (n_ < N) v[i] = *(const f32x4*)(src + (size_t)k_ * N + n_); } } while (0)
    if (c.bid < ntiles) CONVT_LD(c.bid);
    for (int tix = c.bid; tix < ntiles; tix += c.nb) {
        const int nt = tix / nkt, kt = tix % nkt;
#pragma unroll
        for (int i = 0; i < 2; ++i) { LAS float* tp = tile + (r + 32 * i) * 65 + 4 * c4; tp[0] = v[i][0]; tp[1] = v[i][1]; tp[2] = v[i][2]; tp[3] = v[i][3]; }
        __syncthreads();
        if (tix + c.nb < ntiles) CONVT_LD(tix + c.nb);
        { const int n = c.tid >> 3, kq = c.tid & 7; float w[8];
#pragma unroll
          for (int j = 0; j < 8; ++j) w[j] = tile[(kq * 8 + j) * 65 + n];
          u32x4 o; o[0] = cvt_pk_bf16(w[0], w[1]); o[1] = cvt_pk_bf16(w[2], w[3]); o[2] = cvt_pk_bf16(w[4], w[5]); o[3] = cvt_pk_bf16(w[6], w[7]);
          *(u32x4*)(dst + (size_t)(nt * 64 + n) * K + kt * 64 + kq * 8) = o; }
        __syncthreads();
    }
#undef CONVT_LD
}
__device__ __forceinline__ void conv_fp4rows(const float* src, unsigned char* dst4, float* scl, int rows, const Ctx& c) {
    const int stride = c.nb * 8;
    int row = c.bid * 8 + c.wave;
    f32x4 v[8], w[8];
    if (row < rows) {
#pragma unroll
        for (int j = 0; j < 8; ++j) v[j] = *(const f32x4*)(src + (size_t)row * 2048 + c.lane * 32 + j * 4);
    }
    for (; row < rows; row += stride) {
        const int nrow = row + stride;
        if (nrow < rows) {
#pragma unroll
            for (int j = 0; j < 8; ++j) w[j] = *(const f32x4*)(src + (size_t)nrow * 2048 + c.lane * 32 + j * 4);
        }
        float mx = 0.f;
#pragma unroll
        for (int j = 0; j < 8; ++j) mx = fmaxf(mx, fmaxf(fmaxf(fabsf(v[j][0]), fabsf(v[j][1])), fmaxf(fabsf(v[j][2]), fabsf(v[j][3]))));
        mx = wave_max(mx);
        const float s = mx > 0.f ? 6.f / mx : 1.f;
        if (c.lane == 0) scl[row] = mx > 0.f ? mx * (1.f / 6.f) : 1.f;
        u32x4 pk = {0u, 0u, 0u, 0u};
#pragma unroll
        for (int d = 0; d < 4; ++d) {
            unsigned wq = 0u;
            wq = fp4_pk<0>(wq, v[2 * d][0] * s, v[2 * d][1] * s); wq = fp4_pk<1>(wq, v[2 * d][2] * s, v[2 * d][3] * s);
            wq = fp4_pk<2>(wq, v[2 * d + 1][0] * s, v[2 * d + 1][1] * s); wq = fp4_pk<3>(wq, v[2 * d + 1][2] * s, v[2 * d + 1][3] * s);
            pk[d] = wq;
        }
        *(u32x4*)(dst4 + (size_t)row * 1024 + c.lane * 16) = pk;
#pragma unroll
        for (int j = 0; j < 8; ++j) v[j] = w[j];
    }
}
__device__ __forceinline__ void conv_E(const float* src, bf16_t* dst, size_t n8, const Ctx& c) {
    const size_t stride = (size_t)c.nb * NTHREADS;
    for (size_t i = (size_t)c.bid * NTHREADS + c.tid; i < n8; i += stride) {
        const f32x4 x = *(const f32x4*)(src + i * 8), y = *(const f32x4*)(src + i * 8 + 4);
        *(u32x4*)(dst + i * 8) = pack8(x, y);
    }
}
__device__ __forceinline__ int t5_bucket(int n) {
    if (n < 16) return n;
    const float scaled = logf((float)n / 16.f) / logf(64.f);
    const int large = 16 + (int)(scaled * 16.f);
    return large < 31 ? large : 31;
}
__device__ __forceinline__ void p0_tb(const Args& a, const Ctx& c) {
    float* tb = (float*)(a.ws + WS_TB); const float* rb = a.in[26];
    for (int i = c.bid * NTHREADS + c.tid; i < 8 * TBN; i += c.nb * NTHREADS) { const int head = i / TBN, dist = i % TBN; tb[i] = rb[t5_bucket(dist) * 8 + head] * LOG2E; }
}
__device__ __forceinline__ void p0_bpe(const Args& a, const Ctx& c, int part) {
    const int n = c.tid & 255, kv = c.tid >> 8;
    const float* pe = a.in[kv ? 23 : 20]; const float* w1 = a.in[kv ? 24 : 21]; float* bpep = (float*)(a.ws + WS_BPEP);
    float s = 0.f;
#pragma unroll 16
    for (int k = part * 128; k < part * 128 + 128; ++k) s += pe[k] * w1[(size_t)k * 256 + n];
    bpep[(part * 2 + kv) * 256 + n] = s;
}
__device__ __forceinline__ void p0_s5(const Args& a, const Ctx& c, int g, int part) {
    LAS float* ar = (LAS float*)c.lds;
    LAS float* ai = ar + 17 * 64;
    LAS float* bbr = ai + 17 * 64;
    LAS float* bbi = bbr + 1024;
    LAS float* cr = bbi + 1024;
    LAS float* ci = cr + 1024;
    LAS float* kd = ci + 1024;
    const int tid = c.tid;
    if (tid < 64) {
        const int p = tid; const float dt = expf(a.in[12][g]); const float lr = a.in[10][g * 64 + p], li = a.in[11][g * 64 + p];
        for (int d = 0; d <= 16; ++d) { const float mag = expf(lr * dt * (float)d), ang = li * dt * (float)d; ar[d * 64 + p] = mag * cosf(ang); ai[d * 64 + p] = mag * sinf(ang); }
        const float nr = ar[64 + p] - 1.f, ni = ai[64 + p], den = lr * lr + li * li;
        const float wre = (nr * lr + ni * li) / den, wim = (ni * lr - nr * li) / den;
        for (int h = 0; h < 16; ++h) { const float br = a.in[13][(g * 64 + p) * 16 + h], bi = a.in[14][(g * 64 + p) * 16 + h]; bbr[p * 16 + h] = wre * br - wim * bi; bbi[p * 16 + h] = wre * bi + wim * br; }
        if (part == 0) {
        float* s5p = (float*)(a.ws + WS_S5P);
        float xr = ar[16 * 64 + p], xi = ai[16 * 64 + p];
        s5p[(g * 64 + p) * 2] = xr; s5p[(g * 64 + p) * 2 + 1] = xi;
        for (int s = 0; s < 8; ++s) { const float tr = xr * xr - xi * xi, ti = 2.f * xr * xi; xr = tr; xi = ti; }
        s5p[64 * 64 * 2 + (g * 64 + p) * 2] = xr; s5p[64 * 64 * 2 + (g * 64 + p) * 2 + 1] = xi;
        }
    }
    for (int e = tid; e < 1024; e += NTHREADS) { cr[e] = a.in[15][g * 1024 + e]; ci[e] = a.in[16][g * 1024 + e]; }
    __syncthreads();
    for (int e = tid; e < 1024 * (part + 1); e += NTHREADS) {
        const int d = e >> 8, h1 = (e >> 4) & 15, h = e & 15; float s = 0.f;
        for (int p = 0; p < 64; ++p) { const float Cr = cr[h1 * 64 + p], Ci = ci[h1 * 64 + p], Ar = ar[d * 64 + p], Ai = ai[d * 64 + p];
            const float Gr = Cr * Ar - Ci * Ai, Gi = Cr * Ai + Ci * Ar; s += Gr * bbr[p * 16 + h] - Gi * bbi[p * 16 + h]; }
        if (d == 0 && h1 == h) s += a.in[17][g * 16 + h];
        kd[e] = s;
    }
    __syncthreads();
    bf16_t* MT = (bf16_t*)(a.ws + WS_S5MT) + (size_t)g * 65536;
    bf16_t* WE = (bf16_t*)(a.ws + WS_S5WE) + (size_t)g * 32768;
    bf16_t* WC = (bf16_t*)(a.ws + WS_S5WC) + (size_t)g * 32768;
    for (int e = 16384 * part + tid; e < 16384 * (part + 1); e += NTHREADS) { const int n = e >> 8, k = e & 255, j = n >> 4, h1 = n & 15, i = k >> 4, h = k & 15;
        MT[e] = f2bf(i <= j ? kd[(j - i) * 256 + h1 * 16 + h] : 0.f); }
    for (int e = 8192 * part + tid; e < 8192 * (part + 1); e += NTHREADS) { const int n = e >> 8, k = e & 255, cc = n >> 6, p = n & 63, i = k >> 4, h = k & 15;
        const float Ar = ar[(15 - i) * 64 + p], Ai = ai[(15 - i) * 64 + p], Br = bbr[p * 16 + h], Bi = bbi[p * 16 + h];
        WE[e] = f2bf(cc ? (Ar * Bi + Ai * Br) : (Ar * Br - Ai * Bi)); }
    for (int e = 8192 * part + tid; e < 8192 * (part + 1); e += NTHREADS) { const int n = e >> 7, k = e & 127, j = n >> 4, h1 = n & 15, cc = k >> 6, p = k & 63;
        const float Cr = cr[h1 * 64 + p], Ci = ci[h1 * 64 + p], Ar = ar[(j + 1) * 64 + p], Ai = ai[(j + 1) * 64 + p];
        WC[e] = f2bf(cc ? -(Cr * Ai + Ci * Ar) : (Cr * Ar - Ci * Ai)); }
    __syncthreads();
}
__device__ __forceinline__ void p0_prologue(const Args& a, const Ctx& c) {
    for (int u = c.bid; u < 256; u += c.nb) p0_s5(a, c, u >> 2, u & 3);
    for (int u = 0; u < 32; ++u) if (c.bid == (8 * u + 7) % c.nb) p0_bpe(a, c, u);
    p0_tb(a, c);
    p0_cond(a, c);
    conv_T(a.in[6], 2048, DIN, (bf16_t*)(a.ws + WS_WIN), DIN_PAD, c);
    conv_T(a.in[18], 1024, 1024, (bf16_t*)(a.ws + WS_WGLU), 1024, c);
    conv_T(a.in[7], 2048, 2048, (bf16_t*)(a.ws + WS_WOUT), 2048, c);
    conv_T(a.in[27], 2048, 2048, (bf16_t*)(a.ws + WS_WQ), 2048, c);
    conv_T(a.in[21], 4096, 256, (bf16_t*)(a.ws + WS_W1), 256, c);
    conv_T(a.in[24], 4096, 256, (bf16_t*)(a.ws + WS_W1) + 256 * 4096, 256, c);
    conv_T(a.in[22], 256, 128, (bf16_t*)(a.ws + WS_W2), 128, c);
    conv_T(a.in[25], 256, 128, (bf16_t*)(a.ws + WS_W2) + 128 * 256, 128, c);
    conv_E(a.in[28], (bf16_t*)(a.ws + WS_PK), 128 * 128 / 8, c);
    conv_E(a.in[29], (bf16_t*)(a.ws + WS_PK) + 128 * 128, 128 * 128 / 8, c);
    conv_fp4rows(a.in[30], a.ws + WS_PU, (float*)(a.ws + WS_PSC), 16384, c);
    conv_fp4rows(a.in[31], a.ws + WS_PV, (float*)(a.ws + WS_PSC) + 16384, 16384, c);
}

__device__ __forceinline__ void norm_rows(const float* X, bf16_t* O, LAS const float* Ab, LAS const float* Bb, const Ctx& c, int row0 = 0, int nrows = L_) {
    for (int t = row0 + c.bid * 8 + c.wave; t < row0 + nrows; t += c.nb * 8) {
        const float* xr = X + (size_t)t * 2048 + c.lane * 4;
        f32x4 v[8]; float ss = 0.f;
#pragma unroll
        for (int j = 0; j < 8; ++j) { v[j] = *(const f32x4*)(xr + j * 256); ss += v[j][0] * v[j][0] + v[j][1] * v[j][1] + v[j][2] * v[j][2] + v[j][3] * v[j][3]; }
        ss = wave_sum(ss);
        const float rstd = rsqrtf(ss * (1.f / 2048.f) + 1e-6f);
#pragma unroll
        for (int j = 0; j < 8; ++j) {
            const int col = j * 256 + c.lane * 4;
            const f32x4 A = *(const LAS f32x4*)(Ab + col), B = *(const LAS f32x4*)(Bb + col);
            const f32x4 o = v[j] * rstd * A + B;
            u32x2 w; w[0] = cvt_pk_bf16(o[0], o[1]); w[1] = cvt_pk_bf16(o[2], o[3]);
            *(u32x2*)(O + (size_t)t * 2048 + col) = w;
        }
    }
}
__device__ __forceinline__ void norm_rows_bf16(const bf16_t* X, bf16_t* O, LAS const float* Ab, LAS const float* Bb, const Ctx& c, int row0, int nrows) {
    for (int t = row0 + c.bid * 8 + c.wave; t < row0 + nrows; t += c.nb * 8) {
        const bf16_t* xr = X + (size_t)t * 2048 + c.lane * 8;
        u32x4 w[4]; float ss = 0.f;
#pragma unroll
        for (int j = 0; j < 4; ++j) { w[j] = *(const u32x4*)(xr + j * 512);
#pragma unroll
            for (int e = 0; e < 4; ++e) { const float a0 = bflo(w[j][e]), a1 = bfhi(w[j][e]); ss += a0 * a0 + a1 * a1; } }
        ss = wave_sum(ss);
        const float rstd = rsqrtf(ss * (1.f / 2048.f) + 1e-6f);
#pragma unroll
        for (int j = 0; j < 4; ++j) {
            const int col = j * 512 + c.lane * 8;
            const f32x4 A0 = *(const LAS f32x4*)(Ab + col), A1 = *(const LAS f32x4*)(Ab + col + 4), B0 = *(const LAS f32x4*)(Bb + col), B1 = *(const LAS f32x4*)(Bb + col + 4);
            f32x4 o0, o1;
#pragma unroll
            for (int e = 0; e < 2; ++e) { o0[2 * e] = bflo(w[j][e]) * rstd * A0[2 * e] + B0[2 * e]; o0[2 * e + 1] = bfhi(w[j][e]) * rstd * A0[2 * e + 1] + B0[2 * e + 1];
                o1[2 * e] = bflo(w[j][2 + e]) * rstd * A1[2 * e] + B1[2 * e]; o1[2 * e + 1] = bfhi(w[j][2 + e]) * rstd * A1[2 * e + 1] + B1[2 * e + 1]; }
            *(u32x4*)(O + (size_t)t * 2048 + col) = pack8(o0, o1);
        }
    }
}
__device__ __forceinline__ float cond_from_partials(const float* condp, const float* b_ada, int j) {
    float s = b_ada[j];
#pragma unroll 8
    for (int k = 0; k < 32; ++k) s += condp[(size_t)k * NADA + j];
    return s;
}
__device__ __forceinline__ void p1_hnorm(const Args& a, const Ctx& c) {
    const float* condp = (const float*)(a.ws + WS_CONDP); float* cond = (float*)(a.ws + WS_COND);
    for (int j = c.bid * NTHREADS + c.tid; j < NADA; j += c.nb * NTHREADS) cond[j] = cond_from_partials(condp, a.in[3], j);
    LAS float* Ab = (LAS float*)c.lds; LAS float* Bb = Ab + 2048;
    for (int col = c.tid; col < 2048; col += NTHREADS) {
        Ab[col] = a.in[4][col] * (1.f + cond_from_partials(condp, a.in[3], 2048 + col)); Bb[col] = cond_from_partials(condp, a.in[3], col); }
    __syncthreads();
    norm_rows(a.in[0], (bf16_t*)(a.ws + WS_H), Ab, Bb, c);
}
__device__ __forceinline__ void p8_h2norm(const Args& a, const Ctx& c, int row0, int nrows) {
    const float* cond = (const float*)(a.ws + WS_COND);
    LAS float* Ab = (LAS float*)c.lds; LAS float* Bb = Ab + 2048;
    for (int col = c.tid; col < 2048; col += NTHREADS) { Ab[col] = a.in[5][col] * (1.f + cond[4 * 2048 + col]); Bb[col] = cond[3 * 2048 + col]; }
    __syncthreads();
    norm_rows_bf16((const bf16_t*)(a.ws + WS_X1), (bf16_t*)(a.ws + WS_H), Ab, Bb, c, row0, nrows);
}
__device__ __forceinline__ void p6_mixnorm(const Args& a, const Ctx& c) {
    const bf16_t* YS = (const bf16_t*)(a.ws + WS_YSSM); const bf16_t* YA = (const bf16_t*)(a.ws + WS_YATT); bf16_t* O = (bf16_t*)(a.ws + WS_H);
    for (int t = c.bid * 8 + c.wave; t < L_; t += c.nb * 8) {
#pragma unroll
        for (int part = 0; part < 2; ++part) {
            const bf16_t* src = (part ? YA : YS) + (size_t)t * 1024 + c.lane * 8; const float* beta = a.in[part ? 9 : 8];
            u32x4 w[2]; float f[16]; float ss = 0.f;
#pragma unroll
            for (int j = 0; j < 2; ++j) { w[j] = *(const u32x4*)(src + j * 512);
#pragma unroll
                for (int e = 0; e < 4; ++e) { f[j * 8 + 2 * e] = bflo(w[j][e]); f[j * 8 + 2 * e + 1] = bfhi(w[j][e]); } }
#pragma unroll
            for (int e = 0; e < 16; ++e) ss += f[e] * f[e];
            ss = wave_sum(ss);
            const float rstd = rsqrtf(ss * (1.f / 1024.f) + 1e-6f);
#pragma unroll
            for (int j = 0; j < 2; ++j) { const int col = j * 512 + c.lane * 8; const f32x4 b0 = *(const f32x4*)(beta + col), b1 = *(const f32x4*)(beta + col + 4);
                f32x4 o0, o1;
#pragma unroll
                for (int e = 0; e < 4; ++e) { o0[e] = f[j * 8 + e] * rstd * b0[e]; o1[e] = f[j * 8 + 4 + e] * rstd * b1[e]; }
                *(u32x4*)(O + (size_t)t * 2048 + part * 1024 + col) = pack8(o0, o1); }
        }
    }
}
constexpr int S5_US = 0, S5_ES = 33792, S5_SS = 67584;
template <int PASS>
__device__ __forceinline__ void s5_item(const Args& a, const Ctx& c, int g, int seg) {
    LAS unsigned char* lds = c.lds;
    const int tid = c.tid, wave = c.wave, lane = c.lane, r = lane & 15, q = lane >> 4;
    const bf16_t* U = (const bf16_t*)(a.ws + WS_US);
    const bf16_t* MT = (const bf16_t*)(a.ws + WS_S5MT) + (size_t)g * 65536;
    const bf16_t* WE = (const bf16_t*)(a.ws + WS_S5WE) + (size_t)g * 32768;
    const bf16_t* WC = (const bf16_t*)(a.ws + WS_S5WC) + (size_t)g * 32768;
    const float* s5p = (const float*)(a.ws + WS_S5P);
    float* F = (float*)(a.ws + WS_S5F) + (size_t)g * 4 * 128;
    bf16_t* Z = (bf16_t*)(a.ws + WS_Z);
    bf16x8 bE[8];
#pragma unroll
    for (int ks = 0; ks < 8; ++ks) bE[ks] = *(const bf16x8*)(WE + (size_t)(16 * wave + r) * 256 + 32 * ks + 8 * q);
    bf16x8 bM[2][8], bC[2][4];
    if (PASS == 1) {
#pragma unroll
        for (int nt = 0; nt < 2; ++nt) {
#pragma unroll
            for (int ks = 0; ks < 8; ++ks) bM[nt][ks] = *(const bf16x8*)(MT + (size_t)(16 * (2 * wave + nt) + r) * 256 + 32 * ks + 8 * q);
#pragma unroll
            for (int ks = 0; ks < 4; ++ks) bC[nt][ks] = *(const bf16x8*)(WC + (size_t)(16 * (2 * wave + nt) + r) * 128 + 32 * ks + 8 * q);
        }
    }
    float sr = 0.f, si = 0.f, a16r = 0.f, a16i = 0.f;
    if (wave == 0) {
        a16r = s5p[(g * 64 + lane) * 2]; a16i = s5p[(g * 64 + lane) * 2 + 1];
        if (PASS == 1) { const float br = s5p[8192 + (g * 64 + lane) * 2], bi = s5p[8192 + (g * 64 + lane) * 2 + 1];
            for (int s = 0; s < seg; ++s) { const float fr_ = F[s * 128 + lane], fi_ = F[s * 128 + 64 + lane]; const float nr = br * sr - bi * si + fr_, ni = br * si + bi * sr + fi_; sr = nr; si = ni; } }
    }
    for (int sb = 0; sb < 4; ++sb) {
        const int tok0 = seg * 4096 + sb * 1024;
#pragma unroll
        for (int i = 0; i < 4; ++i) { const int ch = tid + NTHREADS * i, token = ch >> 1, half = ch & 1;
            const u32x4 v = *(const u32x4*)(U + (size_t)(tok0 + token) * 1024 + g * 16 + half * 8);
            *(LAS u32x4*)(lds + S5_US + (token >> 4) * 528 + ((token & 15) * 16 + half * 8) * 2) = v; }
        __syncthreads();
#pragma unroll
        for (int m = 0; m < 4; ++m) {
            f32x4 acc = {0.f, 0.f, 0.f, 0.f};
#pragma unroll
            for (int ks = 0; ks < 8; ++ks) { const bf16x8 A = *(const LAS bf16x8*)(lds + S5_US + (16 * m + r) * 528 + (32 * ks + 8 * q) * 2); acc = mfma16(A, bE[ks], acc); }
#pragma unroll
            for (int i = 0; i < 4; ++i) *(LAS float*)(lds + S5_ES + ((16 * m + 4 * q + i) * 132 + 16 * wave + r) * 4) = acc[i];
        }
        __syncthreads();
        if (wave == 0) {
            for (int ch = 0; ch < 64; ++ch) {
                const float er = *(const LAS float*)(lds + S5_ES + (ch * 132 + lane) * 4), ei = *(const LAS float*)(lds + S5_ES + (ch * 132 + 64 + lane) * 4);
                if (PASS == 1) { *(LAS bf16_t*)(lds + S5_SS + (ch * 136 + lane) * 2) = f2bf(sr); *(LAS bf16_t*)(lds + S5_SS + (ch * 136 + 64 + lane) * 2) = f2bf(si); }
                const float nr = a16r * sr - a16i * si + er, ni = a16r * si + a16i * sr + ei; sr = nr; si = ni;
            }
        }
        __syncthreads();
        if (PASS == 1) {
#pragma unroll
            for (int nt = 0; nt < 2; ++nt) {
                const int j = 2 * wave + nt;
                f32x4 acc[4];
#pragma unroll
                for (int m = 0; m < 4; ++m) acc[m] = (f32x4){0.f, 0.f, 0.f, 0.f};
#pragma unroll
                for (int ks = 0; ks < 8; ++ks) {
                    __builtin_amdgcn_sched_barrier(0);
#pragma unroll
                    for (int m = 0; m < 4; ++m) { const bf16x8 A = *(const LAS bf16x8*)(lds + S5_US + (16 * m + r) * 528 + (32 * ks + 8 * q) * 2); acc[m] = mfma16(A, bM[nt][ks], acc[m]); }
                }
#pragma unroll
                for (int ks = 0; ks < 4; ++ks) {
                    __builtin_amdgcn_sched_barrier(0);
#pragma unroll
                    for (int m = 0; m < 4; ++m) { const bf16x8 A = *(const LAS bf16x8*)(lds + S5_SS + (16 * m + r) * 272 + (32 * ks + 8 * q) * 2); acc[m] = mfma16(A, bC[nt][ks], acc[m]); }
                }
#pragma unroll
                for (int m = 0; m < 4; ++m)
#pragma unroll
                    for (int i = 0; i < 4; ++i) { const int ch = 16 * m + 4 * q + i; Z[(size_t)(tok0 + 16 * ch + j) * 1024 + g * 16 + r] = f2bf(gelu_tanh(acc[m][i])); }
            }
            __syncthreads();
        }
    }
    if (PASS == 0 && wave == 0) { F[seg * 128 + lane] = sr; F[seg * 128 + 64 + lane] = si; }
}

__device__ __forceinline__ void cmp_finish_item(const Args& a, const Ctx& c, int kvsel, int rt) {
    LAS unsigned char* lds = c.lds;
    const int tid = c.tid, wave = c.wave, lane = c.lane, r = lane & 15, q = lane >> 4;
    const float* SL = (const float*)(a.ws + WS_SLAB) + (size_t)kvsel * 4 * 2048 * 256;
    const float* bpep = (const float*)(a.ws + WS_BPEP) + kvsel * 256;
    const bf16_t* W2 = (const bf16_t*)(a.ws + WS_W2) + kvsel * 128 * 256;
    for (int e = tid; e < 64 * 64; e += NTHREADS) {
        const int row = e >> 6, c4 = (e & 63) * 4;
        f32x4 s = {0.f, 0.f, 0.f, 0.f};
#pragma unroll 8
        for (int pt = 0; pt < 32; ++pt) s += *(const f32x4*)(bpep + pt * 512 + c4);
#pragma unroll
        for (int ks = 0; ks < 4; ++ks) s += *(const f32x4*)(SL + ((size_t)ks * 2048 + rt * 64 + row) * 256 + c4);
        u32x2 w; w[0] = cvt_pk_bf16(gelu_tanh(s[0]), gelu_tanh(s[1])); w[1] = cvt_pk_bf16(gelu_tanh(s[2]), gelu_tanh(s[3]));
        *(LAS u32x2*)(lds + row * 528 + c4 * 2) = w;
    }
    __syncthreads();
    bf16x8 B[8];
#pragma unroll
    for (int ks = 0; ks < 8; ++ks) B[ks] = *(const bf16x8*)(W2 + (size_t)(16 * wave + r) * 256 + 32 * ks + 8 * q);
#pragma unroll
    for (int m = 0; m < 4; ++m) {
        f32x4 acc = {0.f, 0.f, 0.f, 0.f};
#pragma unroll
        for (int ks = 0; ks < 8; ++ks) { const bf16x8 A = *(const LAS bf16x8*)(lds + (16 * m + r) * 528 + (32 * ks + 8 * q) * 2); acc = mfma16(A, B[ks], acc); }
#pragma unroll
        for (int i = 0; i < 4; ++i) {
            const int row = rt * 64 + 16 * m + 4 * q + i, gi = row >> 10, ci = row & 1023, n = 16 * wave + r;
            const bf16_t v = (ci == 1023) ? (bf16_t)0 : f2bf(acc[i]);
            if (kvsel == 0) ((bf16_t*)(a.ws + WS_KC))[((size_t)gi * 1024 + ci) * 128 + n] = v;
            else ((bf16_t*)(a.ws + WS_VCT))[((size_t)gi * 128 + n) * 1024 + ((ci & ~12) | ((ci & 4) << 1) | ((ci & 8) >> 1))] = v;
        }
    }
    __syncthreads();
}
constexpr int AT_IMP = 65536, AT_TB = 131072, AT_BM = 143872, AT_WU = 145920, AT_END = 146176;
__device__ __forceinline__ int kswz(int r) { return ((r & 3) << 2) | ((r >> 2) & 3); }
__host__ __device__ __forceinline__ int vperm(int t) { return (t & ~12) | ((t & 4) << 1) | ((t & 8) >> 1); }
template <int KEYS> __device__ __forceinline__ int vsw(int d) { return KEYS == 128 ? kswz(d) : ((d >> 1) & 7); }
template <int KEYS, bool NEEDV>
__device__ __forceinline__ void stage_dma(const bf16_t* Kt, const bf16_t* Vt, int ldv, LAS unsigned char* kb, LAS unsigned char* vb, int wave, int lane) {
    constexpr int NP = KEYS / 32;
#pragma unroll
    for (int i = 0; i < NP; ++i) { const int pc = NP * wave + i, row = 4 * pc + (lane >> 4), ch = (lane & 15) ^ kswz(row);
        __builtin_amdgcn_global_load_lds((const unsigned*)(Kt + row * 128 + ch * 8), (LAS unsigned*)(kb + pc * 1024), 16, 0, 0); }
    if (NEEDV) {
#pragma unroll
        for (int i = 0; i < NP; ++i) {
            const int pc = NP * wave + i;
            if (KEYS == 128) { const int d = 4 * pc + (lane >> 4), ch = (lane & 15) ^ kswz(d);
                __builtin_amdgcn_global_load_lds((const unsigned*)(Vt + (size_t)d * ldv + 8 * ch), (LAS unsigned*)(vb + pc * 1024), 16, 0, 0); }
            else { const int d = 8 * pc + (lane >> 3), ch = (lane & 7) ^ ((d >> 1) & 7);
                __builtin_amdgcn_global_load_lds((const unsigned*)(Vt + (size_t)d * ldv + 8 * ch), (LAS unsigned*)(vb + pc * 1024), 16, 0, 0); }
        }
    }
}
__device__ __forceinline__ float xhalf_max(float x) { auto rr = __builtin_amdgcn_permlane32_swap(__float_as_uint(x), __float_as_uint(x), false, false); return fmaxf(__uint_as_float(rr[0]), __uint_as_float(rr[1])); }
__device__ __forceinline__ float xhalf_sum(float x) { auto rr = __builtin_amdgcn_permlane32_swap(__float_as_uint(x), __float_as_uint(x), false, false); return __uint_as_float(rr[0]) + __uint_as_float(rr[1]); }
template <int BR>
__device__ __forceinline__ float tile_prep(int MODE, f32x16& S, LAS const float* tb, float cb, int base, bool selbit) {
    float mx = -INFINITY;
    if (MODE == 1) {
#pragma unroll
        for (int r = 0; r < 16; ++r) mx = fmaxf(mx, S[r]);
        mx = (BR == 2 && !selbit) ? -INFINITY : mx + cb;
    } else {
        const bool nomask = (MODE == 2);
        float bv[16];
#pragma unroll
        for (int r = 0; r < 16; ++r) { const int cr = (r & 3) + 8 * (r >> 2); const int dist = (BR <= 1) ? base - 16 * cr : base - cr; bv[r] = tb[min(max(dist, 0), TBN - 1)]; }
        __builtin_amdgcn_sched_barrier(0);
#pragma unroll
        for (int r = 0; r < 16; ++r) {
            const int cr = (r & 3) + 8 * (r >> 2);
            const int dist = (BR <= 1) ? base - 16 * cr : base - cr;
            float v = S[r] + bv[r];
            bool valid;
            if (BR <= 1) valid = dist >= 0; else if (BR == 2) valid = selbit && dist >= 0; else valid = nomask || (unsigned)dist < 512u;
            v = valid ? v : -INFINITY;
            S[r] = v; mx = fmaxf(mx, v);
        }
    }
    return mx;
}
template <int BR, bool PEND>
__device__ __forceinline__ float tile_decide(int MODE, float mx, float cb, bool selbit, f32x16 (&O)[4], float& m, float& l, u32x4& pa, u32x4& pb) {
    if (BR == 1) { const float mu = (m == -INFINITY) ? 0.f : m; return (MODE == 1) ? mu - cb : mu; }
    mx = xhalf_max(mx);
    const float mn = fmaxf(m, mx), mu = (mn == -INFINITY) ? 0.f : mn;
    if (__any(mn > m)) {
        const float alpha = fexp2(m - mu);
        l *= alpha;
        if (BR >= 2) {
#pragma unroll
            for (int dt = 0; dt < 4; ++dt)
#pragma unroll
                for (int r = 0; r < 16; ++r) O[dt][r] *= alpha;
            if (PEND) {
#pragma unroll
                for (int e = 0; e < 4; ++e) { pa[e] = cvt_pk_bf16(bflo(pa[e]) * alpha, bfhi(pa[e]) * alpha); pb[e] = cvt_pk_bf16(bflo(pb[e]) * alpha, bfhi(pb[e]) * alpha); }
            }
        }
    }
    m = mn;
    if (MODE == 1) return (BR == 2 && !selbit) ? INFINITY : mu - cb;
    return mu;
}
template <int BR, int KEYS>
__device__ __forceinline__ void attn_tile(int MODE, LAS const unsigned char* kb, LAS const unsigned char* vb, int cb0, LAS const float* tb, int key0, int t, int lane,
                                          const bf16x8 (&qf)[8], f32x16 (&O)[4], float& m, float& l, float inv_l, bool selbit, LAS float* imp_row) {
    asm volatile("" : "+v"(lane));
    constexpr int ROWB = 2 * KEYS;
    const int r31 = lane & 31, h = lane >> 5;
    const int gh = kswz(r31) ^ h, vh = vsw<KEYS>(r31) ^ h;
    float cb = 0.f;
    if (MODE == 1) cb = tb[TBN - 1];
    const int base0 = (BR <= 1) ? t - 31 - 16 * (key0 + 4 * h) : t - (key0 + 4 * h);
    const int base1 = (BR <= 1) ? base0 - 16 * 32 : base0 - 32;
    LAS const unsigned char* k0 = kb + r31 * 256;
    f32x16 S0, S1;
    bf16x8 kf[8];
#pragma unroll
    for (int ks = 0; ks < 8; ++ks) kf[ks] = *(const LAS bf16x8*)(k0 + 16 * ((2 * ks) ^ gh));
#pragma unroll
    for (int r = 0; r < 16; ++r) { S0[r] = 0.f; S1[r] = 0.f; }
    __builtin_amdgcn_sched_barrier(0);
#pragma unroll
    for (int ks = 0; ks < 8; ++ks) S0 = mfma32(kf[ks], qf[ks], S0);
    __builtin_amdgcn_sched_barrier(0);
#pragma unroll
    for (int ks = 0; ks < 8; ++ks) kf[ks] = *(const LAS bf16x8*)(k0 + 8192 + 16 * ((2 * ks) ^ gh));
    const float mx0 = tile_prep<BR>(MODE, S0, tb, cb, base0, selbit);
    u32x4 pk0a = {0u, 0u, 0u, 0u}, pk0b = {0u, 0u, 0u, 0u}, pk1a, pk1b;
    const float me0 = tile_decide<BR, false>(MODE, mx0, cb, selbit, O, m, l, pk0a, pk0b);
    __builtin_amdgcn_sched_barrier(0);
    {
#pragma unroll
        for (int ks = 0; ks < 8; ++ks) S1 = mfma32(kf[ks], qf[ks], S1);
        float ps = 0.f;
#pragma unroll
        for (int r = 0; r < 16; ++r) { float p = fexp2(S0[r] - me0); if (BR == 1) p *= inv_l; S0[r] = p; ps += p; }
        if (BR != 1) l += ps;
        if (BR >= 1) {
#pragma unroll
            for (int e = 0; e < 4; ++e) { pk0a[e] = cvt_pk_bf16(S0[2 * e], S0[2 * e + 1]); pk0b[e] = cvt_pk_bf16(S0[8 + 2 * e], S0[8 + 2 * e + 1]); }
        }
#pragma unroll
        for (int i = 0; i < 8; ++i) { __builtin_amdgcn_sched_group_barrier(0x008, 1, 0); __builtin_amdgcn_sched_group_barrier(0x002, 8, 0); }
    }
    __builtin_amdgcn_sched_barrier(0);
    if (BR == 1) {
#pragma unroll
        for (int rg = 0; rg < 4; ++rg) {
            float A = 2.f * (S0[4 * rg] + S0[4 * rg + 1] + S0[4 * rg + 2]) + S0[4 * rg + 3], B = S0[4 * rg + 3];
            A = quad_sum(A); B = quad_sum(B);
            const int jj = (key0 >> 2) + 2 * rg + h;
            if ((lane & 3) == 0) { __hip_atomic_fetch_add(imp_row + jj, A, __ATOMIC_RELAXED, __HIP_MEMORY_SCOPE_WORKGROUP);
                if (jj + 1 < 256) __hip_atomic_fetch_add(imp_row + jj + 1, B, __ATOMIC_RELAXED, __HIP_MEMORY_SCOPE_WORKGROUP); }
        }
    }
    bf16x8 av[8];
    if (BR >= 1) {
#pragma unroll
        for (int s = 0; s < 2; ++s)
#pragma unroll
            for (int dt = 0; dt < 4; ++dt) av[s * 4 + dt] = *(const LAS bf16x8*)(vb + (32 * dt + r31) * ROWB + 16 * ((cb0 + 2 * s) ^ vh));
    }
    const float mx1 = tile_prep<BR>(MODE, S1, tb, cb, base1, selbit);
    const float me1 = tile_decide<BR, true>(MODE, mx1, cb, selbit, O, m, l, pk0a, pk0b);
    __builtin_amdgcn_sched_barrier(0);
    {
        if (BR >= 1) {
#pragma unroll
            for (int dt = 0; dt < 4; ++dt) O[dt] = mfma32(av[dt], __builtin_bit_cast(bf16x8, pk0a), O[dt]);
#pragma unroll
            for (int dt = 0; dt < 4; ++dt) O[dt] = mfma32(av[4 + dt], __builtin_bit_cast(bf16x8, pk0b), O[dt]);
        }
        float ps = 0.f;
#pragma unroll
        for (int r = 0; r < 16; ++r) { float p = fexp2(S1[r] - me1); if (BR == 1) p *= inv_l; S1[r] = p; ps += p; }
        if (BR != 1) l += ps;
        if (BR >= 1) {
#pragma unroll
            for (int e = 0; e < 4; ++e) { pk1a[e] = cvt_pk_bf16(S1[2 * e], S1[2 * e + 1]); pk1b[e] = cvt_pk_bf16(S1[8 + 2 * e], S1[8 + 2 * e + 1]); }
#pragma unroll
            for (int i = 0; i < 8; ++i) { __builtin_amdgcn_sched_group_barrier(0x008, 1, 0); __builtin_amdgcn_sched_group_barrier(0x002, 8, 0); }
        }
    }
    __builtin_amdgcn_sched_barrier(0);
    if (BR == 1) {
#pragma unroll
        for (int rg = 0; rg < 4; ++rg) {
            float A = 2.f * (S1[4 * rg] + S1[4 * rg + 1] + S1[4 * rg + 2]) + S1[4 * rg + 3], B = S1[4 * rg + 3];
            A = quad_sum(A); B = quad_sum(B);
            const int jj = ((key0 + 32) >> 2) + 2 * rg + h;
            if ((lane & 3) == 0) { __hip_atomic_fetch_add(imp_row + jj, A, __ATOMIC_RELAXED, __HIP_MEMORY_SCOPE_WORKGROUP);
                if (jj + 1 < 256) __hip_atomic_fetch_add(imp_row + jj + 1, B, __ATOMIC_RELAXED, __HIP_MEMORY_SCOPE_WORKGROUP); }
        }
    }
    if (BR >= 1) {
#pragma unroll
        for (int s = 0; s < 2; ++s)
#pragma unroll
            for (int dt = 0; dt < 4; ++dt) av[s * 4 + dt] = *(const LAS bf16x8*)(vb + (32 * dt + r31) * ROWB + 16 * ((cb0 + 4 + 2 * s) ^ vh));
        __builtin_amdgcn_sched_barrier(0);
#pragma unroll
        for (int dt = 0; dt < 4; ++dt) O[dt] = mfma32(av[dt], __builtin_bit_cast(bf16x8, pk1a), O[dt]);
#pragma unroll
        for (int dt = 0; dt < 4; ++dt) O[dt] = mfma32(av[4 + dt], __builtin_bit_cast(bf16x8, pk1b), O[dt]);
    }
}
template <int BR, int KEYS>
__device__ __forceinline__ void run_branch(const Ctx& c, const bf16_t* Kb, const bf16_t* Vtb, int ldv, int lo, int hi, LAS const float* tb, int t, int t0,
                                           const bf16x8 (&qf)[8], f32x16 (&O)[4], float& m, float& l, float inv_l, int tl, LAS float* imp_row) {
    constexpr bool NEEDV = (BR != 0);
    constexpr int BPS = KEYS / 64, KSTG = KEYS * 256, VSTG = 128 * 2 * KEYS, VB0 = 2 * KSTG;
    LAS unsigned char* lds = c.lds;
    int lz = c.lane; asm volatile("" : "+v"(lz));
    const int nst = (hi - lo + BPS - 1) / BPS;
#define STG_BLK(i) ((lo + BPS * (i) + BPS - 1 < hi) ? lo + BPS * (i) : hi - BPS)
    asm volatile("s_waitcnt vmcnt(0)" ::: "memory");
    { const int b0 = (BPS == 2 && hi - lo < 2) ? lo : STG_BLK(0);
      stage_dma<KEYS, NEEDV>(Kb + (size_t)b0 * 64 * 128, Vtb + (size_t)b0 * 64, ldv, lds, lds + VB0, c.wave, lz); }
    asm volatile("s_waitcnt vmcnt(0)" ::: "memory");
    __syncthreads();
    const int qt = t0 >> 6;
    for (int i = 0; i < nst; ++i) {
        const int buf = i & 1;
        if (i + 1 < nst) { int lz2 = lz; asm volatile("" : "+v"(lz2));
            const int b1 = STG_BLK(i + 1);
            stage_dma<KEYS, NEEDV>(Kb + (size_t)b1 * 64 * 128, Vtb + (size_t)b1 * 64, ldv, lds + (buf ^ 1) * KSTG, lds + VB0 + (buf ^ 1) * VSTG, c.wave, lz2); }
        const int sb = (BPS == 2 && hi - lo < 2) ? lo : STG_BLK(i);
#pragma unroll
        for (int q = 0; q < BPS; ++q) {
            const int j = lo + BPS * i + q;
            if (j < hi) {
                bool selbit = true, wave_on = true;
                if (BR == 2) {
                    const unsigned w = *(const LAS unsigned*)(lds + AT_BM + (tl * 8 + (j >> 5)) * 4);
                    selbit = (w >> (j & 31)) & 1u;
                    const unsigned wu = *(const LAS unsigned*)(lds + AT_WU + (c.wave * 8 + (j >> 5)) * 4);
                    wave_on = (wu >> (j & 31)) & 1u;
                }
                if (wave_on) {
                    int mode = 0;
                    if (BR <= 1) mode = (1024 * j + 1829 <= t0) ? 1 : 0;
                    else if (BR == 2) mode = (64 * j + 853 <= t0) ? 1 : 0;
                    else mode = (j >= qt - 7 && j <= qt - 1) ? 2 : 0;
                    const int slot = j - sb;
                    attn_tile<BR, KEYS>(mode, lds + buf * KSTG + slot * 16384, lds + VB0 + buf * VSTG, 8 * slot, tb, j * 64, t, c.lane, qf, O, m, l, inv_l, selbit, imp_row);
                }
            }
        }
        asm volatile("s_waitcnt vmcnt(0)" ::: "memory");
        __syncthreads();
    }
#undef STG_BLK
}
__device__ __forceinline__ void attn_item(const Args& a, const Ctx& c_, int qt, int g) {
    Ctx c = c_; { int tz = c_.tid; asm volatile("" : "+v"(tz)); c.tid = tz; c.lane = tz & 63; }
    LAS unsigned char* lds = c.lds;
    const int tid = c.tid, wave = c.wave, lane = c.lane, r31 = lane & 31, h = lane >> 5, hl = lane & 3;
    const int t0 = qt * 64, tl = 8 * wave + (r31 >> 2), t = t0 + tl, head = g * 4 + hl;
    const bf16_t* Qb = (const bf16_t*)(a.ws + WS_Q);
    const bf16_t* KROW = (const bf16_t*)(a.ws + WS_KROW);
    const bf16_t* VT = (const bf16_t*)(a.ws + WS_VT);
    const float* GATE = (const float*)(a.ws + WS_GATE);
    { const float* tbg = (const float*)(a.ws + WS_TB) + g * 4 * TBN;
      for (int i = tid; i < 4 * TBN; i += NTHREADS) *(LAS float*)(lds + AT_TB + i * 4) = tbg[i];
      for (int i = tid; i < 64 * 256; i += NTHREADS) *(LAS float*)(lds + AT_IMP + i * 4) = 0.f; }
    bf16x8 qf[8];
#pragma unroll
    for (int ks = 0; ks < 8; ++ks) qf[ks] = *(const bf16x8*)(Qb + (size_t)t * 1024 + head * 128 + 16 * ks + 8 * h);
    LAS const float* tb = (LAS const float*)(lds + AT_TB) + hl * TBN;
    LAS float* imp_row = (LAS float*)(lds + AT_IMP) + tl * 256;
    bf16_t* Y = (bf16_t*)(a.ws + WS_YATT) + (size_t)t * 1024 + head * 128 + 4 * h;
    f32x16 O[4];
#pragma unroll
    for (int dt = 0; dt < 4; ++dt)
#pragma unroll
        for (int r = 0; r < 16; ++r) O[dt][r] = 0.f;
    __syncthreads();
    { const int ntile = (t0 / 16 + 3 + 63) / 64;
      const bf16_t* KC = (const bf16_t*)(a.ws + WS_KC) + (size_t)g * 1024 * 128; const bf16_t* VCT = (const bf16_t*)(a.ws + WS_VCT) + (size_t)g * 128 * 1024;
      float m = -INFINITY, l = 0.f;
#if defined(PROBE_CMP)
      run_branch<0, 64>(c, KC, VCT, 1024, 0, ntile, tb, t, t0, qf, O, m, l, 0.f, tl, imp_row);
      asm volatile("" :: "v"(m), "v"(l));
      m = -INFINITY; l = 0.f;
#endif
      run_branch<0, 64>(c, KC, VCT, 1024, 0, ntile, tb, t, t0, qf, O, m, l, 0.f, tl, imp_row);
      const float lt = xhalf_sum(l), inv = lt > 0.f ? 1.f / lt : 0.f;
      run_branch<1, 64>(c, KC, VCT, 1024, 0, ntile, tb, t, t0, qf, O, m, l, inv, tl, imp_row);
      const float gc = GATE[(size_t)t * 24 + head];
#pragma unroll
      for (int dt = 0; dt < 4; ++dt)
#pragma unroll
          for (int rg = 0; rg < 4; ++rg) {
              u32x2 w; w[0] = cvt_pk_bf16(gc * O[dt][4 * rg], gc * O[dt][4 * rg + 1]); w[1] = cvt_pk_bf16(gc * O[dt][4 * rg + 2], gc * O[dt][4 * rg + 3]);
              *(u32x2*)(Y + 32 * dt + 8 * rg) = w;
#pragma unroll
              for (int e = 0; e < 4; ++e) O[dt][4 * rg + e] = 0.f;
          }
    }
    {
        const int ncand = qt - 2 > 0 ? qt - 2 : 0;
        unsigned v[8][4], selm[8];
#pragma unroll
        for (int i = 0; i < 8; ++i) {
            LAS const float* row = (LAS const float*)(lds + AT_IMP) + (8 * wave + i) * 256;
            selm[i] = 0u;
#pragma unroll
            for (int k = 0; k < 4; ++k) { const int j = lane + 64 * k; const bool cand = (j >= 1 && j <= qt - 2);
                v[i][k] = cand ? ((__float_as_uint(row[j]) & ~0xFFu) | (unsigned)(255 - j)) : 0u; if (ncand <= 13 && cand) selm[i] |= 1u << k; }
        }
        if (ncand > 13) {
            for (int it = 0; it < 13; ++it) {
#pragma unroll
                for (int i = 0; i < 8; ++i) {
                    const unsigned mx = wave_umax_bcast(max(max(v[i][0], v[i][1]), max(v[i][2], v[i][3])));
#pragma unroll
                    for (int k = 0; k < 4; ++k) if (v[i][k] == mx) { v[i][k] = 0u; selm[i] |= 1u << k; }
                }
            }
        }
        unsigned wu[8];
#pragma unroll
        for (int k = 0; k < 8; ++k) wu[k] = 0u;
#pragma unroll
        for (int i = 0; i < 8; ++i)
#pragma unroll
            for (int k = 0; k < 4; ++k) {
                const int j = lane + 64 * k; const bool forced = (j == 0) || (j == qt) || (j == qt - 1);
                const unsigned long long mk = __ballot(((selm[i] >> k) & 1u) || forced);
                const unsigned lo = (unsigned)mk, hi = (unsigned)(mk >> 32);
                if (lane == 0) { *(LAS unsigned*)(lds + AT_BM + ((8 * wave + i) * 8 + 2 * k) * 4) = lo; *(LAS unsigned*)(lds + AT_BM + ((8 * wave + i) * 8 + 2 * k + 1) * 4) = hi; }
                wu[2 * k] |= lo; wu[2 * k + 1] |= hi;
            }
        if (lane == 0) {
#pragma unroll
            for (int k = 0; k < 8; ++k) *(LAS unsigned*)(lds + AT_WU + (wave * 8 + k) * 4) = wu[k];
        }
    }
    __syncthreads();
#if defined(PROBE_SEL)
    { float m = -INFINITY, l = 0.f;
      run_branch<2, 128>(c, KROW + (size_t)(2 + g) * L_ * 128, VT + (size_t)g * 128 * L_, L_, 0, qt + 1, tb, t, t0, qf, O, m, l, 0.f, tl, imp_row);
      asm volatile("" :: "v"(O[0]), "v"(O[1]), "v"(O[2]), "v"(O[3]), "v"(m), "v"(l));
#pragma unroll
      for (int dt = 0; dt < 4; ++dt)
#pragma unroll
          for (int r = 0; r < 16; ++r) O[dt][r] = 0.f; }
#endif
    { float m = -INFINITY, l = 0.f;
      run_branch<2, 128>(c, KROW + (size_t)(2 + g) * L_ * 128, VT + (size_t)g * 128 * L_, L_, 0, qt + 1, tb, t, t0, qf, O, m, l, 0.f, tl, imp_row);
      const float gs = GATE[(size_t)t * 24 + 8 + head];
      const float lt = xhalf_sum(l), sc = gs * (lt > 0.f ? 1.f / lt : 0.f);
#pragma unroll
      for (int dt = 0; dt < 4; ++dt)
#pragma unroll
          for (int rg = 0; rg < 4; ++rg) {
              const u32x2 w0 = *(const u32x2*)(Y + 32 * dt + 8 * rg);
              u32x2 w; w[0] = cvt_pk_bf16(bflo(w0[0]) + sc * O[dt][4 * rg], bfhi(w0[0]) + sc * O[dt][4 * rg + 1]); w[1] = cvt_pk_bf16(bflo(w0[1]) + sc * O[dt][4 * rg + 2], bfhi(w0[1]) + sc * O[dt][4 * rg + 3]);
              *(u32x2*)(Y + 32 * dt + 8 * rg) = w;
#pragma unroll
              for (int e = 0; e < 4; ++e) O[dt][4 * rg + e] = 0.f;
          }
    }
#if defined(PROBE_WIN)
    { float m = -INFINITY, l = 0.f;
      const int lo = qt - 8 > 0 ? qt - 8 : 0;
      run_branch<3, 128>(c, KROW + (size_t)(4 + g) * L_ * 128, VT + (size_t)(2 + g) * 128 * L_, L_, lo, qt + 1, tb, t, t0, qf, O, m, l, 0.f, tl, imp_row);
      asm volatile("" :: "v"(O[0]), "v"(O[1]), "v"(O[2]), "v"(O[3]), "v"(m), "v"(l));
#pragma unroll
      for (int dt = 0; dt < 4; ++dt)
#pragma unroll
          for (int r = 0; r < 16; ++r) O[dt][r] = 0.f; }
#endif
    { float m = -INFINITY, l = 0.f;
      const int lo = qt - 8 > 0 ? qt - 8 : 0;
      run_branch<3, 128>(c, KROW + (size_t)(4 + g) * L_ * 128, VT + (size_t)(2 + g) * 128 * L_, L_, lo, qt + 1, tb, t, t0, qf, O, m, l, 0.f, tl, imp_row);
      const float gw = GATE[(size_t)t * 24 + 16 + head];
      const float lt = xhalf_sum(l), sc = gw * (lt > 0.f ? 1.f / lt : 0.f);
#pragma unroll
      for (int dt = 0; dt < 4; ++dt)
#pragma unroll
          for (int rg = 0; rg < 4; ++rg) {
              const u32x2 w0 = *(const u32x2*)(Y + 32 * dt + 8 * rg);
              u32x2 w; w[0] = cvt_pk_bf16(bflo(w0[0]) + sc * O[dt][4 * rg], bfhi(w0[0]) + sc * O[dt][4 * rg + 1]); w[1] = cvt_pk_bf16(bflo(w0[1]) + sc * O[dt][4 * rg + 2], bfhi(w0[1]) + sc * O[dt][4 * rg + 3]);
              *(u32x2*)(Y + 32 * dt + 8 * rg) = w;
          }
    }
    __syncthreads();
}
#ifndef PEER_ALPHA
#define PEER_ALPHA 1.0f
#endif
constexpr int PE_SC = 0, PE_LV = 65536, PE_LI = 73728, PE_PK = 81920, PE_EX = 147456, PE_GT = 151552, PE_SU = 155648, PE_END = 159744;
constexpr int PE_SLOT = 2048, PE_NSLOT = 8, PE_RINGW = PE_SLOT * 9;
static_assert(8 * PE_RINGW <= PE_EX && PE_END <= LDS_BYTES - 16, "PEER LDS map");
__device__ __forceinline__ float wave_sum_bcast(float v) {
    v += dpp_f<0xB1>(v); v += dpp_f<0x4E>(v); v += dpp_f<0x141>(v); v += dpp_f<0x140>(v);
    v += __int_as_float(__builtin_amdgcn_update_dpp(0, __float_as_int(v), 0x142, 0xa, 0xf, false));
    v += __int_as_float(__builtin_amdgcn_update_dpp(0, __float_as_int(v), 0x143, 0xc, 0xf, false));
    return __int_as_float(__builtin_amdgcn_readlane(__float_as_int(v), 63));
}
__device__ __forceinline__ unsigned mono_key(float v) { const unsigned b = __float_as_uint(v); return b ^ ((b >> 31) ? 0xFFFFFFFFu : 0x80000000u); }
template <int CTRL>
__device__ __forceinline__ void quad_merge16(unsigned (&t)[16]) {
    unsigned o[16];
#pragma unroll
    for (int i = 0; i < 16; ++i) o[i] = (unsigned)__builtin_amdgcn_update_dpp(0, (int)t[15 - i], CTRL, 0xf, 0xf, false);
#pragma unroll
    for (int i = 0; i < 16; ++i) t[i] = max(t[i], o[i]);
#pragma unroll
    for (int st = 8; st >= 1; st >>= 1)
#pragma unroll
        for (int i = 0; i < 16; ++i) if ((i & st) == 0) { const unsigned hi = max(t[i], t[i + st]), lo = min(t[i], t[i + st]); t[i] = hi; t[i + st] = lo; }
}
__device__ __forceinline__ int pair_a(int p) { return p < 16 ? 0 : p < 24 ? 1 : p < 29 ? 2 : p < 33 ? 3 : p < 36 ? 4 : p < 38 ? 5 : p < 40 ? 6 : p < 42 ? 7 : p - 34; }
__device__ __forceinline__ int pair_b(int p) { return p < 16 ? p : p < 24 ? p - 16 : p < 29 ? p - 24 : p < 33 ? p - 29 : p < 36 ? p - 33 : p < 38 ? p - 36 : p < 40 ? p - 38 : p < 42 ? p - 40 : 0; }
template <bool DRY>
__device__ __forceinline__ void peer_step(const Args& a, const Ctx& c_, int t0) {
    Ctx c = c_; { int tz = c_.tid; asm volatile("" : "+v"(tz)); c.tid = tz; c.lane = tz & 63; }
    LAS unsigned char* lds = c.lds;
    const int tid = c.tid, wave = c.wave, lane = c.lane, r = lane & 15, q = lane >> 4;
    const bf16_t* QP = (const bf16_t*)(a.ws + WS_QP); const bf16_t* PK = (const bf16_t*)(a.ws + WS_PK);
    const unsigned char* PU = a.ws + WS_PU; const unsigned char* PV = a.ws + WS_PV; const float* psc = (const float*)(a.ws + WS_PSC);
    const bf16_t* HB = (const bf16_t*)(a.ws + WS_H);
    const int t = t0 + wave;
    u32x4 hraw[4]; u32x2 xw[8];
#pragma unroll
    for (int k = 0; k < 4; ++k) hraw[k] = *(const u32x4*)(HB + (size_t)t * 2048 + lane * 32 + k * 8);
#pragma unroll
    for (int k = 0; k < 8; ++k) xw[k] = *(const u32x2*)((const bf16_t*)(a.ws + WS_X1) + (size_t)t * 2048 + lane * 32 + k * 4);
    {
#pragma unroll
        for (int i = 0; i < 8; ++i) { const int pc = 8 * wave + i, row = 4 * pc + (lane >> 4), ch = (lane & 15) ^ kswz(row);
            __builtin_amdgcn_global_load_lds((const unsigned*)(PK + (size_t)row * 128 + ch * 8), (LAS unsigned*)(lds + PE_PK + pc * 1024), 16, 0, 0); }
        const int hh = wave;
        bf16x8 aF[2][4];
#pragma unroll
        for (int cc = 0; cc < 2; ++cc)
#pragma unroll
            for (int ks = 0; ks < 4; ++ks) aF[cc][ks] = *(const bf16x8*)(QP + (size_t)(t0 + (r & 7)) * 2048 + hh * 256 + cc * 128 + 32 * ks + 8 * q);
        asm volatile("s_waitcnt vmcnt(0)" ::: "memory");
        __syncthreads();
        const int ksw = kswz(r);
#pragma unroll
        for (int cc = 0; cc < 2; ++cc)
#pragma unroll 2
            for (int nt = 0; nt < 8; ++nt) {
                f32x4 acc = {0.f, 0.f, 0.f, 0.f};
#pragma unroll
                for (int ks = 0; ks < 4; ++ks) { const bf16x8 B = *(const LAS bf16x8*)(lds + PE_PK + (cc * 128 + 16 * nt + r) * 256 + 16 * ((4 * ks + q) ^ ksw)); acc = mfma16(aF[cc][ks], B, acc); }
                if (q < 2) {
#pragma unroll
                    for (int i = 0; i < 4; ++i) { const int task = (4 * q + i) * 16 + hh * 2 + cc; *(LAS float*)(lds + PE_SC + (task * 128 + ((16 * nt + r + task) & 127)) * 4) = acc[i]; }
                }
            }
    }
    __syncthreads();
    {
        const int task = tid >> 2, part = tid & 3;
        LAS const float* sc = (LAS const float*)(lds + PE_SC) + task * 128;
        float vals[32];
#pragma unroll
        for (int k = 0; k < 32; ++k) vals[k] = sc[(32 * part + k + task) & 127];
        unsigned top[16];
#pragma unroll
        for (int e = 0; e < 16; ++e) top[e] = 0u;
#pragma unroll
        for (int k = 0; k < 32; ++k) {
            unsigned key = (mono_key(vals[k]) & ~0x7Fu) | (unsigned)(127 - (32 * part + k));
#pragma unroll
            for (int e = 0; e < 16; ++e) { const unsigned hi = max(top[e], key); key = min(top[e], key); top[e] = hi; }
        }
        quad_merge16<0xB1>(top);
        quad_merge16<0x4E>(top);
        if (part == 0) {
#pragma unroll
            for (int e = 0; e < 16; ++e) { const int idx = 127 - (int)(top[e] & 0x7Fu); *(LAS float*)(lds + PE_LV + (task * 16 + e) * 4) = sc[(idx + task) & 127]; *(LAS int*)(lds + PE_LI + (task * 16 + e) * 4) = idx; }
        }
    }
    __syncthreads();
    if (tid < 256) {
        const int task = tid >> 2, part = tid & 3, tok = task >> 3, hh = task & 7, t1 = tok * 16 + hh * 2, t2 = t1 + 1;
        LAS const float* lv1 = (LAS const float*)(lds + PE_LV) + t1 * 16; LAS const float* lv2 = (LAS const float*)(lds + PE_LV) + t2 * 16;
        unsigned top[16];
#pragma unroll
        for (int e = 0; e < 16; ++e) top[e] = 0u;
        for (int p = part; p < 50; p += 4) {
            const int aa = pair_a(p), bb = pair_b(p);
            unsigned key = (mono_key(lv1[aa] + lv2[bb]) & ~0xFFu) | (unsigned)(255 - (aa * 16 + bb));
#pragma unroll
            for (int e = 0; e < 16; ++e) { const unsigned hi = max(top[e], key); key = min(top[e], key); top[e] = hi; }
        }
        quad_merge16<0xB1>(top);
        quad_merge16<0x4E>(top);
        if (part == 0) {
            LAS const int* li1 = (LAS const int*)(lds + PE_LI) + t1 * 16; LAS const int* li2 = (LAS const int*)(lds + PE_LI) + t2 * 16;
            float sv[16]; int ex[16]; float mx = -INFINITY;
#pragma unroll
            for (int e = 0; e < 16; ++e) {
                const int id = 255 - (int)(top[e] & 0xFFu), aa = id >> 4, bb = id & 15;
                sv[e] = lv1[aa] + lv2[bb]; ex[e] = li1[aa] * 128 + li2[bb]; mx = fmaxf(mx, sv[e]);
            }
            float sum = 0.f;
#pragma unroll
            for (int e = 0; e < 16; ++e) { sv[e] = fexp2((sv[e] - mx) * LOG2E); sum += sv[e]; }
            const float inv = 1.f / sum;
#pragma unroll
            for (int e = 0; e < 16; ++e) { *(LAS int*)(lds + PE_EX + (tok * 128 + hh * 16 + e) * 4) = ex[e];
                *(LAS float*)(lds + PE_GT + (tok * 128 + hh * 16 + e) * 4) = sv[e] * inv * psc[16384 + ex[e]];
                *(LAS float*)(lds + PE_SU + (tok * 128 + hh * 16 + e) * 4) = psc[ex[e]]; }
        }
    }
    __syncthreads();
    float hp[32];
#pragma unroll
    for (int k = 0; k < 4; ++k)
#pragma unroll
        for (int e = 0; e < 4; ++e) { hp[k * 8 + 2 * e] = bflo(hraw[k][e]); hp[k * 8 + 2 * e + 1] = bfhi(hraw[k][e]); }
    float acc[32];
#pragma unroll
    for (int e = 0; e < 32; ++e) acc[e] = 0.f;
    asm volatile("s_waitcnt vmcnt(0)" ::: "memory");
    {
        LAS const int* exl = (LAS const int*)(lds + PE_EX) + wave * 128; LAS const float* gtl = (LAS const float*)(lds + PE_GT) + wave * 128;
        LAS const float* sul = (LAS const float*)(lds + PE_SU) + wave * 128;
        LAS unsigned char* ring = lds + wave * PE_RINGW;
#define ROW_ISSUE(SL, IDX) do { const int ex_ = __builtin_amdgcn_readfirstlane(exl[IDX]); \
            LAS unsigned char* sl_ = ring + (SL) * PE_SLOT; \
            __builtin_amdgcn_global_load_lds((const unsigned*)(PU + (size_t)ex_ * 1024 + lane * 16), (LAS unsigned*)sl_, 16, 0, 0); \
            __builtin_amdgcn_global_load_lds((const unsigned*)(PV + (size_t)ex_ * 1024 + lane * 16), (LAS unsigned*)(sl_ + 1024), 16, 0, 0); \
            } while (0)
#define UDOT(UW, D0, D1) do { _Pragma("unroll") for (int dw = 0; dw < 4; ++dw) { const f32x2 f0_ = fp4_unpk<0>(UW[dw]), f1_ = fp4_unpk<1>(UW[dw]), f2_ = fp4_unpk<2>(UW[dw]), f3_ = fp4_unpk<3>(UW[dw]); \
                D0 += f0_[0] * hp[8 * dw] + f1_[0] * hp[8 * dw + 2] + f2_[0] * hp[8 * dw + 4] + f3_[0] * hp[8 * dw + 6]; \
                D1 += f0_[1] * hp[8 * dw + 1] + f1_[1] * hp[8 * dw + 3] + f2_[1] * hp[8 * dw + 5] + f3_[1] * hp[8 * dw + 7]; } } while (0)
#define VACC(VW, WG) do { _Pragma("unroll") for (int dw = 0; dw < 4; ++dw) { const f32x2 f0_ = fp4_unpk<0>(VW[dw]), f1_ = fp4_unpk<1>(VW[dw]), f2_ = fp4_unpk<2>(VW[dw]), f3_ = fp4_unpk<3>(VW[dw]); \
                acc[8 * dw] += WG * f0_[0]; acc[8 * dw + 1] += WG * f0_[1]; acc[8 * dw + 2] += WG * f1_[0]; acc[8 * dw + 3] += WG * f1_[1]; \
                acc[8 * dw + 4] += WG * f2_[0]; acc[8 * dw + 5] += WG * f2_[1]; acc[8 * dw + 6] += WG * f3_[0]; acc[8 * dw + 7] += WG * f3_[1]; } } while (0)
#define PAIR_APPLY(SA, SB, IDX) do { LAS const unsigned char* pa_ = ring + (SA) * PE_SLOT + lane * 16; LAS const unsigned char* pb_ = ring + (SB) * PE_SLOT + lane * 16; \
            const u32x4 ua_ = *(const LAS u32x4*)pa_, ub_ = *(const LAS u32x4*)pb_, va_ = *(const LAS u32x4*)(pa_ + 1024), vb_ = *(const LAS u32x4*)(pb_ + 1024); \
            float a0_ = 0.f, a1_ = 0.f, b0_ = 0.f, b1_ = 0.f; \
            UDOT(ua_, a0_, a1_); UDOT(ub_, b0_, b1_); \
            const float da_ = wave_sum_bcast(a0_ + a1_) * sul[IDX], db_ = wave_sum_bcast(b0_ + b1_) * sul[(IDX) + 1]; \
            const float wa_ = gtl[IDX] * gelu_tanh(da_), wb_ = gtl[(IDX) + 1] * gelu_tanh(db_); \
            VACC(va_, wa_); VACC(vb_, wb_); \
            asm volatile("s_waitcnt lgkmcnt(0)" ::: "memory"); } while (0)
#define DMA_WAIT(N) asm volatile("s_waitcnt vmcnt(" #N ")" ::: "memory")
        ROW_ISSUE(0, 0); ROW_ISSUE(1, 1); ROW_ISSUE(2, 2); ROW_ISSUE(3, 3); ROW_ISSUE(4, 4); ROW_ISSUE(5, 5); ROW_ISSUE(6, 6); ROW_ISSUE(7, 7);
#pragma unroll 1
        for (int e = 0; e < 128; e += 8) {
            const bool more = e + 8 < 128;
            DMA_WAIT(12); PAIR_APPLY(0, 1, e);     if (more) { ROW_ISSUE(0, e + 8);  ROW_ISSUE(1, e + 9); }
            if (more) DMA_WAIT(12); else DMA_WAIT(0);
            PAIR_APPLY(2, 3, e + 2); if (more) { ROW_ISSUE(2, e + 10); ROW_ISSUE(3, e + 11); }
            if (more) DMA_WAIT(12);
            PAIR_APPLY(4, 5, e + 4); if (more) { ROW_ISSUE(4, e + 12); ROW_ISSUE(5, e + 13); }
            if (more) DMA_WAIT(12);
            PAIR_APPLY(6, 7, e + 6); if (more) { ROW_ISSUE(6, e + 14); ROW_ISSUE(7, e + 15); }
        }
#undef ROW_ISSUE
#undef PAIR_APPLY
#undef UDOT
#undef VACC
#undef DMA_WAIT
    }
    {
        float* xo = a.out + (size_t)t * 2048; const float* g2 = (const float*)(a.ws + WS_COND) + 5 * 2048; const float* fg = a.in[32];
        f32x4 gvv[8], fvv[8];
#pragma unroll
        for (int k = 0; k < 8; ++k) { const int col = lane * 32 + k * 4; gvv[k] = *(const f32x4*)(g2 + col); fvv[k] = *(const f32x4*)(fg + col); }
        float ss = 0.f;
#pragma unroll
        for (int k = 0; k < 8; ++k) {
            const float x1[4] = {bflo(xw[k][0]), bfhi(xw[k][0]), bflo(xw[k][1]), bfhi(xw[k][1])};
#pragma unroll
            for (int e = 0; e < 4; ++e) { const float x2 = x1[e] + PEER_ALPHA * gvv[k][e] * acc[k * 4 + e]; acc[k * 4 + e] = x2; ss += x2 * x2; }
        }
        ss = wave_sum_bcast(ss);
        const float rstd = rsqrtf(ss * (1.f / 2048.f) + 1e-6f);
#pragma unroll
        for (int k = 0; k < 8; ++k) {
            const int col = lane * 32 + k * 4;
            f32x4 o;
#pragma unroll
            for (int e = 0; e < 4; ++e) o[e] = acc[k * 4 + e] * rstd * fvv[k][e];
            if (!DRY || rstd == 123.456f) *(f32x4*)(xo + col) = o;
        }
    }
    __syncthreads();
}
constexpr int NPHASE = 14;
#ifndef DBG
#define DBG 0
#endif
__device__ __forceinline__ void dbg_final_norm(const Args& a, const Ctx& c, const float* src) {
    for (int t = c.bid * 8 + c.wave; t < L_; t += c.nb * 8) {
        const float* xr = src + (size_t)t * 2048 + c.lane * 4; float* o = a.out + (size_t)t * 2048 + c.lane * 4;
        f32x4 v[8]; float ss = 0.f;
#pragma unroll
        for (int j = 0; j < 8; ++j) { v[j] = *(const f32x4*)(xr + j * 256); ss += v[j][0] * v[j][0] + v[j][1] * v[j][1] + v[j][2] * v[j][2] + v[j][3] * v[j][3]; }
        ss = wave_sum(ss);
        const float rstd = rsqrtf(ss * (1.f / 2048.f) + 1e-6f);
#pragma unroll
        for (int j = 0; j < 8; ++j) { const f32x4 g = *(const f32x4*)(a.in[32] + j * 256 + c.lane * 4); *(f32x4*)(o + j * 256) = v[j] * rstd * g; }
    }
}

extern __shared__ __attribute__((aligned(16))) unsigned char smem[];

__global__ void __launch_bounds__(512, 2) fwd(Args a) {
    LAS unsigned char* lds = (LAS unsigned char*)smem;
    Ctx c; c.bid = blockIdx.x; c.nb = gridDim.x; c.tid = threadIdx.x; c.wave = __builtin_amdgcn_readfirstlane(threadIdx.x >> 6); c.lane = threadIdx.x & 63; c.lds = lds;
    volatile LAS unsigned* xbw = (volatile LAS unsigned*)(lds + LDS_BYTES - 16);
    if (c.tid < 4) xbw[c.tid] = 0u;
    __syncthreads();
    const int lo = a.ph_lo, hi = a.ph_hi;
    const bool multi = (hi - lo) > 1;
    XcdBarrier bar; bar.bar = (unsigned*)(a.ws + WS_CTL); bar.x = 0; bar.st = xbw;
    if (multi) bar = xcd_barrier_post((unsigned*)(a.ws + WS_CTL), xbw);
#ifndef PHASE_MASK
#define PHASE_MASK 0xFFFF
#endif
#if DBG == 1
#undef PHASE_MASK
#define PHASE_MASK 0x403
#elif DBG == 2 || DBG == 4 || DBG == 5
#undef PHASE_MASK
#define PHASE_MASK 0x4FF
#endif
#define IN(k) (((PHASE_MASK >> (k)) & 1) && lo <= (k) && (k) < hi)
#define REFRESH() do { int tz_ = threadIdx.x; asm volatile("" : "+v"(tz_)); c.tid = tz_; c.lane = tz_ & 63; c.wave = __builtin_amdgcn_readfirstlane(tz_ >> 6); } while (0)
#define SEAM(k) do { if (IN(k) && IN((k) + 1)) xcd_barrier(bar); } while (0)
#ifndef DUP
#define DUP -1
#endif
#define REP(k) for (int rep_ = 0; rep_ < ((DUP == (k)) ? 2 : 1); ++rep_)
#define DUP2(k, ...) do { __VA_ARGS__; if (DUP == (k)) { __syncthreads(); __VA_ARGS__; } } while (0)

    if (IN(0)) REP(0) { REFRESH(); p0_prologue(a, c); }
    SEAM(0);
    if (IN(1)) { REFRESH(); DUP2(1, p1_hnorm(a, c)); }
    SEAM(1);
    if (IN(2)) { REFRESH();
        pg8::StaticOrder S; S.init((const bf16_t*)(a.ws + WS_H), (const bf16_t*)(a.ws + WS_WIN), 2048, 2048, 2048, L_, DIN_PAD, c.nb, c.bid);
        EpiWin E{(bf16_t*)(a.ws + WS_US), (bf16_t*)(a.ws + WS_Q), (bf16_t*)(a.ws + WS_KROW), (bf16_t*)(a.ws + WS_VROW), (bf16_t*)(a.ws + WS_VT), (float*)(a.ws + WS_GATE)};
        DUP2(2, pg8::gemm_phase<EpiWin, pg8::StaticOrder>(lds, S, E));
    }
    SEAM(2);
    if (IN(3)) { REFRESH();
        DUP2(31, for (int it = c.bid; it < 256; it += c.nb) s5_item<0>(a, c, it >> 2, it & 3));
        __syncthreads();
        CmpOrder S{(const bf16_t*)(a.ws + WS_KROW), (const bf16_t*)(a.ws + WS_VROW), (const bf16_t*)(a.ws + WS_W1), 2048, 4096, 1024, c.nb, c.bid};
        EpiSlab E{(float*)(a.ws + WS_SLAB)};
        DUP2(32, pg8::gemm_phase<EpiSlab, CmpOrder>(lds, S, E));
    }
    SEAM(3);
    if (IN(4)) { REFRESH();
        DUP2(41, for (int it = c.bid; it < 64; it += c.nb) cmp_finish_item(a, c, it >> 5, it & 31));
        DUP2(42, for (int it = c.bid; it < 256; it += c.nb) s5_item<1>(a, c, it >> 2, it & 3));
    }
    SEAM(4);
    if (IN(5)) { REFRESH();
#if DBG == 5
        for (size_t i = (size_t)c.bid * NTHREADS + c.tid; i < (size_t)L_ * 1024 / 8; i += (size_t)c.nb * NTHREADS) *(u32x4*)((bf16_t*)(a.ws + WS_YSSM) + i * 8) = (u32x4){0u, 0u, 0u, 0u};
#else
        {
            pg8::StaticOrder S; S.init((const bf16_t*)(a.ws + WS_Z), (const bf16_t*)(a.ws + WS_WGLU), 1024, 1024, 1024, L_, 1024, c.nb, c.bid);
            EpiGlu E{(const bf16_t*)(a.ws + WS_Z), a.in[19], (bf16_t*)(a.ws + WS_YSSM)};
            DUP2(55, pg8::gemm_phase<EpiGlu, pg8::StaticOrder>(lds, S, E));
        }
#endif
        __syncthreads();
        REP(5)
#if DBG == 4
        for (size_t i = (size_t)c.bid * NTHREADS + c.tid; i < (size_t)L_ * 1024 / 8; i += (size_t)c.nb * NTHREADS) *(u32x4*)((bf16_t*)(a.ws + WS_YATT) + i * 8) = (u32x4){0u, 0u, 0u, 0u};
#else
        {
            unsigned* qhead = (unsigned*)(a.ws + WS_CTL) + 8192;
            volatile LAS unsigned* slot = (volatile LAS unsigned*)(lds + LDS_BYTES - 32);
            for (;;) {
                if (c.tid == 0) *slot = __hip_atomic_fetch_add(qhead, 1u, __ATOMIC_RELAXED, __HIP_MEMORY_SCOPE_AGENT);
                __syncthreads();
                const unsigned q = *slot;
                __syncthreads();
                if (q >= 512u) break;
                attn_item(a, c, 255 - (int)(q >> 1), (int)(q & 1));
            }
        }
#endif
    }
    SEAM(5);
    if (IN(6)) { REFRESH(); DUP2(6, p6_mixnorm(a, c)); }
    SEAM(6);
#define WOUT_GEMM(PM0) do { pg8::StaticOrder S; S.init((const bf16_t*)(a.ws + WS_H), (const bf16_t*)(a.ws + WS_WOUT), 2048, 2048, 2048, L_ / 2, 2048, c.nb, c.bid, PM0); \
        EpiWout E{a.in[0], (const float*)(a.ws + WS_COND) + 2 * 2048, (bf16_t*)(a.ws + WS_X1)}; pg8::gemm_phase<EpiWout, pg8::StaticOrder>(lds, S, E); __syncthreads(); } while (0)
#define WQ_GEMM(PM0) do { pg8::StaticOrder S; S.init((const bf16_t*)(a.ws + WS_H), (const bf16_t*)(a.ws + WS_WQ), 2048, 2048, 2048, L_ / 2, 2048, c.nb, c.bid, PM0); \
        EpiBf16 E{(bf16_t*)(a.ws + WS_QP), 2048}; pg8::gemm_phase<EpiBf16, pg8::StaticOrder>(lds, S, E); __syncthreads(); } while (0)
#define PEER_STEPS(FIRST, COUNT) do { for (int s_ = (FIRST) + c.bid; s_ < (FIRST) + (COUNT); s_ += c.nb) peer_step<false>(a, c, s_ * 8); } while (0)
    if (IN(7)) { REFRESH(); WOUT_GEMM(0); }
    SEAM(7);
    if (IN(8)) { REFRESH(); p8_h2norm(a, c, 0, L_ / 2); }
    SEAM(8);
    if (IN(9)) { REFRESH(); WQ_GEMM(0); }
    SEAM(9);
    if (IN(10)) { REFRESH();
        if ((c.bid >> 3) & 1) PEER_STEPS(0, 512);
        WOUT_GEMM(32);
        if (!((c.bid >> 3) & 1)) PEER_STEPS(0, 512); }
    SEAM(10);
    if (IN(11)) { REFRESH(); p8_h2norm(a, c, L_ / 2, L_ / 2); }
    SEAM(11);
    if (IN(12)) { REFRESH();
        if ((c.bid >> 3) & 1) PEER_STEPS(512, 512);
        WQ_GEMM(32);
        if (!((c.bid >> 3) & 1)) PEER_STEPS(512, 512); }
    SEAM(12);
    if (IN(13)) { REFRESH(); PEER_STEPS(1024, 1024); }
#undef WOUT_GEMM
#undef WQ_GEMM
#undef PEER_STEPS
#undef IN
#undef SEAM
}

#ifndef N_LAUNCHES
#define N_LAUNCHES 1
#endif
extern "C" void kernel_launch(void* const* d_in, const int* in_sizes, int n_in, void* d_out, int out_size, void* d_ws, size_t ws_size, hipStream_t stream) {
    static int grid = 0;
    if (grid == 0) {
        if (n_in != 33 || out_size != L_ * D_ || ws_size < WS_END) { fprintf(stderr, "kernel_launch: unexpected shapes (n_in %d, out %d, ws %zu < %zu); nothing launched\n", n_in, out_size, ws_size, (size_t)WS_END); grid = -1; return; }
        int dev = 0, cus = 0, per_cu = 0;
        if (hipGetDevice(&dev) != hipSuccess || hipDeviceGetAttribute(&cus, hipDeviceAttributeMultiprocessorCount, dev) != hipSuccess) { grid = -1; return; }
        if (hipFuncSetAttribute((const void*)fwd, hipFuncAttributeMaxDynamicSharedMemorySize, LDS_BYTES) != hipSuccess) { fprintf(stderr, "kernel_launch: hipFuncSetAttribute failed\n"); grid = -1; return; }
        if (hipOccupancyMaxActiveBlocksPerMultiprocessor(&per_cu, (const void*)fwd, NTHREADS, LDS_BYTES) != hipSuccess || per_cu < 1) { fprintf(stderr, "kernel_launch: occupancy query says %d\n", per_cu); (void)hipGetLastError(); grid = -1; return; }
        grid = cus;
    }
    if (grid < 0) return;
    (void)hipMemsetAsync((char*)d_ws + WS_CTL, 0, CTL_BYTES, stream);
    Args a{};
    for (int i = 0; i < 33; ++i) a.in[i] = (const float*)d_in[i];
    a.out = (float*)d_out; a.ws = (unsigned char*)d_ws;
    if (N_LAUNCHES == 1) { a.ph_lo = 0; a.ph_hi = NPHASE; hipLaunchKernelGGL(fwd, dim3(grid), dim3(NTHREADS), LDS_BYTES, stream, a); }
    else for (int p = 0; p < NPHASE; ++p) { a.ph_lo = p; a.ph_hi = p + 1; hipLaunchKernelGGL(fwd, dim3(grid), dim3(NTHREADS), LDS_BYTES, stream, a); }
}
```

```cpp
#include <hip/hip_runtime.h>
#include <stdint.h>
#include <stdio.h>

#define LAS __attribute__((address_space(3)))
typedef unsigned short bf16_t;
typedef short bf16x8 __attribute__((ext_vector_type(8)));
typedef float f32x2 __attribute__((ext_vector_type(2)));
typedef float f32x4 __attribute__((ext_vector_type(4)));
typedef float f32x16 __attribute__((ext_vector_type(16)));
typedef unsigned u32x2 __attribute__((ext_vector_type(2)));
typedef unsigned u32x4 __attribute__((ext_vector_type(4)));
typedef __bf16 bfv2 __attribute__((ext_vector_type(2)));
typedef unsigned u32x6 __attribute__((ext_vector_type(6)));
typedef float f32x32 __attribute__((ext_vector_type(32)));

constexpr int L_ = 16384, D_ = 2048, DSSM = 1024, DATT = 1024, DIN = 3608, DIN_PAD = 3840;
constexpr int NADA = 12288;
constexpr float LOG2E = 1.4426950408889634f;
constexpr float QSCALE = 0.08838834764831845f * 1.4426950408889634f;
constexpr int TBN = 800;
constexpr int NTHREADS = 512;
constexpr int LDS_BYTES = 163840;

constexpr size_t al256(size_t x) { return (x + 255) & ~(size_t)255; }
constexpr size_t WS_CTL   = 0;                                  constexpr size_t CTL_BYTES = 65536;
constexpr size_t WS_CONDP = WS_CTL + CTL_BYTES;
constexpr size_t WS_COND  = WS_CONDP + 32 * 12288 * 4;
constexpr size_t WS_TB    = WS_COND + 12288 * 4;
constexpr size_t WS_BPE   = al256(WS_TB + 8 * TBN * 4);
constexpr size_t WS_S5P   = al256(WS_BPE + 2 * 256 * 4);
constexpr size_t WS_S5F   = WS_S5P + 2 * 64 * 64 * 2 * 4;
constexpr size_t WS_S5MT  = WS_S5F + 64 * 4 * 128 * 4;
constexpr size_t WS_S5WE  = WS_S5MT + (size_t)64 * 256 * 256 * 2;
constexpr size_t WS_S5WC  = WS_S5WE + (size_t)64 * 128 * 256 * 2;
constexpr size_t WS_WIN   = WS_S5WC + (size_t)64 * 256 * 128 * 2;
constexpr size_t WS_WGLU  = WS_WIN + (size_t)DIN_PAD * 2048 * 2;
constexpr size_t WS_WOUT  = WS_WGLU + (size_t)1024 * 1024 * 2;
constexpr size_t WS_WQ    = WS_WOUT + (size_t)2048 * 2048 * 2;
constexpr size_t WS_W1    = WS_WQ + (size_t)2048 * 2048 * 2;
constexpr size_t WS_W2    = WS_W1 + (size_t)2 * 256 * 4096 * 2;
constexpr size_t WS_PK    = WS_W2 + (size_t)2 * 128 * 256 * 2;
constexpr size_t WS_PU    = WS_PK + (size_t)2 * 128 * 128 * 2;
constexpr size_t WS_PV    = WS_PU + (size_t)16384 * 1024;
constexpr size_t WS_PSC   = WS_PV + (size_t)16384 * 1024;
constexpr size_t WS_BPEP  = WS_PSC + (size_t)2 * 16384 * 4;
constexpr size_t WS_H     = WS_BPEP + (size_t)32 * 2 * 256 * 4;
constexpr size_t WS_US    = WS_H + (size_t)16384 * 2048 * 2;
constexpr size_t WS_Q     = WS_US + (size_t)16384 * 1024 * 2;
constexpr size_t WS_QP    = WS_US;
constexpr size_t WS_KROW  = WS_Q + (size_t)16384 * 1024 * 2;
constexpr size_t WS_VROW  = WS_KROW + (size_t)6 * 16384 * 128 * 2;
constexpr size_t WS_VT    = WS_VROW + (size_t)2 * 16384 * 128 * 2 + 8192;
constexpr size_t WS_GATE  = WS_VT + (size_t)4 * 128 * 16384 * 2;
constexpr size_t WS_SLAB  = WS_GATE + (size_t)16384 * 24 * 4;
constexpr size_t WS_KC    = WS_SLAB + (size_t)2 * 16 * 2048 * 256 * 4;
constexpr size_t WS_VCT   = WS_KC + (size_t)2 * 1024 * 128 * 2;
constexpr size_t WS_Z     = WS_VCT + (size_t)2 * 128 * 1024 * 2;
constexpr size_t WS_YSSM  = WS_Z + (size_t)16384 * 1024 * 2;
constexpr size_t WS_YATT  = WS_YSSM + (size_t)16384 * 1024 * 2;
constexpr size_t WS_X1    = WS_Z;
constexpr size_t WS_END   = WS_YATT + (size_t)16384 * 1024 * 2;
static_assert(WS_END < (size_t)530 * 1024 * 1024, "workspace map too large");

struct Args { const float* in[33]; float* out; unsigned char* ws; int ph_lo, ph_hi; };

__device__ __forceinline__ unsigned cvt_pk_bf16(float lo, float hi) { bfv2 v; v[0] = (__bf16)lo; v[1] = (__bf16)hi; return __builtin_bit_cast(unsigned, v); }
__device__ __forceinline__ bf16_t f2bf(float f) { return (bf16_t)(cvt_pk_bf16(f, 0.f) & 0xffffu); }
__device__ __forceinline__ float bf2f(unsigned b) { return __uint_as_float(b << 16); }
__device__ __forceinline__ float bflo(unsigned w) { return __uint_as_float(w << 16); }
__device__ __forceinline__ float bfhi(unsigned w) { return __uint_as_float(w & 0xffff0000u); }
__device__ __forceinline__ float fexp2(float x) { return __builtin_amdgcn_exp2f(x); }
__device__ __forceinline__ float frcp(float x) { return __builtin_amdgcn_rcpf(x); }
__device__ __forceinline__ float sigmoidf_(float x) { return frcp(1.f + fexp2(-LOG2E * x)); }
__device__ __forceinline__ float gelu_tanh(float x) {
    const float u = x * (1.f + 0.044715f * x * x);
    return x * frcp(1.f + fexp2(-2.f * 0.7978845608028654f * LOG2E * u));
}
__device__ __forceinline__ float shfl_xor_f(float v, int m) { return __shfl_xor(v, m, 64); }
__device__ __forceinline__ float wave_sum(float v) {
#pragma unroll
    for (int m = 32; m >= 1; m >>= 1) v += __shfl_xor(v, m, 64);
    return v;
}
__device__ __forceinline__ float wave_max(float v) {
#pragma unroll
    for (int m = 32; m >= 1; m >>= 1) v = fmaxf(v, __shfl_xor(v, m, 64));
    return v;
}
template <int CTRL> __device__ __forceinline__ float dpp_f(float x) { return __int_as_float(__builtin_amdgcn_update_dpp(0, __float_as_int(x), CTRL, 0xf, 0xf, false)); }
__device__ __forceinline__ float wave_max_bcast(float v) {
    v = fmaxf(v, dpp_f<0xB1>(v)); v = fmaxf(v, dpp_f<0x4E>(v)); v = fmaxf(v, dpp_f<0x141>(v)); v = fmaxf(v, dpp_f<0x140>(v));
    v = fmaxf(v, __int_as_float(__builtin_amdgcn_update_dpp(__float_as_int(v), __float_as_int(v), 0x142, 0xa, 0xf, false)));
    v = fmaxf(v, __int_as_float(__builtin_amdgcn_update_dpp(__float_as_int(v), __float_as_int(v), 0x143, 0xc, 0xf, false)));
    return __int_as_float(__builtin_amdgcn_readlane(__float_as_int(v), 63));
}
__device__ __forceinline__ unsigned wave_umax_bcast(unsigned v) {
#define UDPP_(x, ctrl, rm) (unsigned)__builtin_amdgcn_update_dpp((int)(x), (int)(x), ctrl, rm, 0xf, false)
    v = max(v, UDPP_(v, 0xB1, 0xf)); v = max(v, UDPP_(v, 0x4E, 0xf)); v = max(v, UDPP_(v, 0x141, 0xf)); v = max(v, UDPP_(v, 0x140, 0xf));
    v = max(v, UDPP_(v, 0x142, 0xa)); v = max(v, UDPP_(v, 0x143, 0xc));
#undef UDPP_
    return (unsigned)__builtin_amdgcn_readlane((int)v, 63);
}
__device__ __forceinline__ float quad_sum(float x) { x += dpp_f<0xB1>(x); x += dpp_f<0x4E>(x); return x; }
template <int SEL> __device__ __forceinline__ f32x2 fp4_unpk(unsigned w) { return __builtin_amdgcn_cvt_scalef32_pk_f32_fp4(w, 1.0f, SEL); }
template <int SEL> __device__ __forceinline__ unsigned fp4_pk(unsigned w, float a, float b) { return __builtin_amdgcn_cvt_scalef32_pk_fp4_f32(w, a, b, 1.0f, SEL); }
__device__ __forceinline__ f32x4 mfma16(bf16x8 a, bf16x8 b, f32x4 c) { return __builtin_amdgcn_mfma_f32_16x16x32_bf16(a, b, c, 0, 0, 0); }
__device__ __forceinline__ f32x16 mfma32(bf16x8 a, bf16x8 b, f32x16 c) { return __builtin_amdgcn_mfma_f32_32x32x16_bf16(a, b, c, 0, 0, 0); }
#define XB_TMO      128
#define XB_XCNT(j)  (256  + 64 * (j))
#define XB_XSUB(j)  (1280 + 64 * (j))
#define XB_XGEN(j)  (2304 + 64 * (j))
#define XB_TOP      3328
#define XB_TOPGEN   3392
#define XCD_BAR_WORDS 3456
#define XB_SPIN_CAP (1u << 18)

__device__ __forceinline__ unsigned xb_ld(unsigned* p)              { return __hip_atomic_load(p, __ATOMIC_RELAXED, __HIP_MEMORY_SCOPE_AGENT); }
__device__ __forceinline__ unsigned xb_add(unsigned* p, unsigned v) { return __hip_atomic_fetch_add(p, v, __ATOMIC_RELAXED, __HIP_MEMORY_SCOPE_AGENT); }
__device__ __forceinline__ unsigned xb_xcc_id() { return (unsigned)__builtin_amdgcn_s_getreg((3 << 11) | 20) & 0xFu; }
#define XB_SPIN(cond, bar) do { unsigned _sp = 0; while (cond) { __builtin_amdgcn_s_sleep(1); \
    if ((++_sp & 255u) == 0u) { if (xb_ld(&(bar)[XB_TMO])) break; if (_sp > XB_SPIN_CAP) { atomicAdd(&(bar)[XB_TMO], 1u); break; } } } } while (0)

struct XcdBarrier {
    unsigned* bar; unsigned x;
    volatile LAS unsigned* st;
};
__device__ __forceinline__ XcdBarrier xcd_barrier_post(unsigned* bar, volatile LAS unsigned* st) {
    XcdBarrier b; b.bar = bar; b.x = xb_xcc_id(); b.st = st;
    if (threadIdx.x == 0) (void)xb_add(&bar[XB_XCNT(b.x)], 1u);
    return b;
}
__device__ __forceinline__ void xcd_barrier_complete(unsigned* bar, unsigned x, unsigned& nloc, unsigned& nx) {
    const unsigned G = gridDim.x * gridDim.y * gridDim.z;
    unsigned sum, cnt, mine, sp = 0u;
    for (;;) {
        sum = 0u; cnt = 0u; mine = 0u;
#pragma unroll
        for (unsigned j = 0; j < 16; ++j) { const unsigned c = xb_ld(&bar[XB_XCNT(j)]); sum += c; cnt += (c > 0u) ? 1u : 0u; mine = (j == x) ? c : mine; }
        if (sum == G) break;
        __builtin_amdgcn_s_sleep(1);
        if ((++sp & 255u) == 0u) { if (xb_ld(&bar[XB_TMO])) break; if (sp > XB_SPIN_CAP) { atomicAdd(&bar[XB_TMO], 1u); break; } }
    }
    nloc = mine > 0u ? mine : 1u; nx = cnt > 0u ? cnt : 1u;
}
__device__ __forceinline__ void xcd_barrier(const XcdBarrier& b) {
    asm volatile("s_waitcnt vmcnt(0)" ::: "memory");
    __syncthreads();
    if (threadIdx.x == 0) {
        unsigned* bar = b.bar;
        __builtin_amdgcn_s_waitcnt(0);
        unsigned nloc = b.st[0], nx = b.st[1];
        if (nloc == 0u) { xcd_barrier_complete(bar, b.x, nloc, nx); b.st[0] = nloc; b.st[1] = nx; }
        const unsigned old = xb_add(&bar[XB_XSUB(b.x)], 1u);
        const unsigned gen = old / nloc;
        if (old + 1u == (gen + 1u) * nloc) {
            __builtin_amdgcn_fence(__ATOMIC_RELEASE, "agent");
            asm volatile("s_waitcnt vmcnt(0)" ::: "memory");
            const unsigned og = xb_add(&bar[XB_TOP], 1u);
            const unsigned tg = og / nx;
            if (og + 1u == (tg + 1u) * nx) xb_add(&bar[XB_TOPGEN], 1u);
            else XB_SPIN(xb_ld(&bar[XB_TOPGEN]) == tg, bar);
            __builtin_amdgcn_fence(__ATOMIC_ACQUIRE, "agent");
            xb_add(&bar[XB_XGEN(b.x)], 1u);
            asm volatile("s_waitcnt vmcnt(0)" ::: "memory");
        } else {
            XB_SPIN(xb_ld(&bar[XB_XGEN(b.x)]) == gen, bar);
            __builtin_amdgcn_fence(__ATOMIC_ACQUIRE, "agent");
            asm volatile("s_waitcnt vmcnt(0)" ::: "memory");
        }
    }
    __syncthreads();
}

namespace pg8 {
constexpr int BM = 256, BK = 64, HALF = 128, HTB = HALF * BK * 2, STAGE_BYTES = 8 * HTB, NXCD = 8, WGM = 8;
__host__ __device__ __forceinline__ int lds_byte(int r, int c) { const int st = (r >> 4) * 2 + (c >> 5), rr = r & 15, cc = c & 31, ob = rr * 64 + cc * 2; return st * 1024 + (ob ^ (((ob >> 9) & 1) << 5)); }
__host__ __device__ __forceinline__ void stage_rc(int b, int& R, int& C) { const int st = b / 1024, sb = b % 1024, swz = sb ^ (((sb >> 9) & 1) << 5); R = (st >> 1) * 16 + swz / 64; C = (st & 1) * 32 + (swz % 64) / 2; }
__host__ __device__ __forceinline__ int perm32(int rho) { const int n = rho >> 4, i = rho & 15; return 8 * (i >> 2) + 4 * n + (i & 3); }

struct Unit { int pm, pn, z; };
struct StaticOrder {
    const bf16_t* A; const bf16_t* Bt; int lda, ldb, K;
    int nM, nN, nwg, G, c, pm0;
    __device__ void init(const bf16_t* A_, const bf16_t* Bt_, int lda_, int ldb_, int K_, int M, int N, int G_, int c_, int pm0_ = 0) { A = A_; Bt = Bt_; lda = lda_; ldb = ldb_; K = K_; nM = M / BM; nN = N / BM; nwg = nM * nN; G = G_; c = c_; pm0 = pm0_; }
    __device__ bool next(int i, Unit& u) const {
        const long Lx = (long)i * G + c; if (Lx >= nwg) return false;
        int wgid = (int)Lx; { const int q = nwg / NXCD, r = nwg % NXCD, xcd = wgid % NXCD, off = wgid / NXCD; wgid = (xcd < r ? xcd * (q + 1) : r * (q + 1) + (xcd - r) * q) + off; }
        const int nig = WGM * nN, gid = wgid / nig, fm = gid * WGM, gsz = (nM - fm) < WGM ? (nM - fm) : WGM;
        u.pm = pm0 + fm + ((wgid % nig) % gsz); u.pn = (wgid % nig) / gsz; u.z = 0; return true;
    }
    __device__ __forceinline__ const char* a_base(const Unit& u) const { return (const char*)(A + (size_t)u.pm * BM * lda); }
    __device__ __forceinline__ const char* b_base(const Unit& u) const { return (const char*)(Bt + (size_t)u.pn * BM * ldb); }
};

template <class Epi, class Sched>
__device__ __forceinline__ void gemm_phase(LAS unsigned char* lds, const Sched& S, const Epi& E) {
    const int tid = threadIdx.x, wid = __builtin_amdgcn_readfirstlane(tid >> 6), lane = tid & 63, wr = wid >> 2, wc = wid & 3, fr = lane & 15, fq = lane >> 4;
    const int K = S.K, nt = K / BK, lda = S.lda, ldb = S.ldb;
    unsigned voffA[2], voffB[2];
#pragma unroll
    for (int i = 0; i < 2; ++i) { int R, C; stage_rc(tid * 16 + i * 8192, R, C); const int Rb = Epi::PERM ? ((R & ~31) + perm32(R & 31)) : R;
        voffA[i] = (unsigned)(R * lda + C) * 2u; voffB[i] = (unsigned)(Rb * ldb + C) * 2u; }
    const size_t kstep = (size_t)(BK * 2);
    const size_t hstepA = (size_t)HALF * lda * 2, hstepB = (size_t)HALF * ldb * 2;
    const unsigned ldsw = (unsigned)wid * 1024u;
    const int aoff = lds_byte(wr * 64 + fr, fq * 8), boff = lds_byte(wc * 32 + fr, fq * 8);
#define PG8_SA(b, h) (((b) * 2 + (h)) * HTB)
#define PG8_SB(b, h) ((4 + (b) * 2 + (h)) * HTB)
#define PG8_STAGE(bufoff, gbase, voff) do { _Pragma("unroll") for (int _i = 0; _i < 2; ++_i) \
        __builtin_amdgcn_global_load_lds((const unsigned*)((const char*)(gbase) + (voff)[_i]), (LAS unsigned*)(lds + (bufoff) + ldsw + _i * 8192), 16, 0, 0); } while (0)
#define PG8_LDA(dst, b, h) do { _Pragma("unroll") for (int m = 0; m < 4; ++m) _Pragma("unroll") for (int k = 0; k < 2; ++k) dst[m][k] = *(const LAS bf16x8*)(lds + PG8_SA(b, h) + aoff + m * 2048 + k * 1024); } while (0)
#define PG8_LDB(dst, b, h) do { _Pragma("unroll") for (int n = 0; n < 2; ++n) _Pragma("unroll") for (int k = 0; k < 2; ++k) dst[n][k] = *(const LAS bf16x8*)(lds + PG8_SB(b, h) + boff + n * 2048 + k * 1024); } while (0)
#define PG8_MMA(ai, bj, At, Bt) do { __builtin_amdgcn_s_setprio(1); _Pragma("unroll") for (int m = 0; m < 4; ++m) _Pragma("unroll") for (int n = 0; n < 2; ++n) _Pragma("unroll") for (int k = 0; k < 2; ++k) \
        acc[ai][bj][m][n] = __builtin_amdgcn_mfma_f32_16x16x32_bf16(Bt[n][k], At[m][k], acc[ai][bj][m][n], 0, 0, 0); __builtin_amdgcn_s_setprio(0); } while (0)
#define PG8_WAIT_V(n) asm volatile("s_waitcnt vmcnt(" #n ")" ::: "memory")
#define PG8_WAIT_L(n) asm volatile("s_waitcnt lgkmcnt(" #n ")" ::: "memory")
#define PG8_BAR __builtin_amdgcn_s_barrier()
#define PG8_SCHED __builtin_amdgcn_sched_barrier(0)
    Unit cur, nxt; int ui = 0;
    if (!S.next(0, cur)) return;
    f32x4 acc[2][2][4][2];
#pragma unroll
    for (int a = 0; a < 2; ++a)
#pragma unroll
        for (int b = 0; b < 2; ++b)
#pragma unroll
            for (int m = 0; m < 4; ++m)
#pragma unroll
                for (int n = 0; n < 2; ++n) acc[a][b][m][n] = (f32x4){0.f, 0.f, 0.f, 0.f};
    bf16x8 At[4][2], B0[2][2], B1[2][2];
    const char* cA = S.a_base(cur); const char* cB = S.b_base(cur);
    PG8_STAGE(PG8_SB(0, 0), cB, voffB); PG8_STAGE(PG8_SA(0, 0), cA, voffA); PG8_STAGE(PG8_SB(0, 1), cB + hstepB, voffB); PG8_STAGE(PG8_SA(0, 1), cA + hstepA, voffA);
    if (wr == 1) PG8_BAR;
    PG8_WAIT_V(4); PG8_BAR;
    PG8_STAGE(PG8_SB(1, 0), cB + kstep, voffB); PG8_STAGE(PG8_SA(1, 0), cA + kstep, voffA); PG8_STAGE(PG8_SB(1, 1), cB + hstepB + kstep, voffB);
    PG8_WAIT_V(6); PG8_BAR;
    for (;;) {
        const bool has_next = S.next(ui + 1, nxt);
        const char* nA = has_next ? S.a_base(nxt) : cA; const char* nB = has_next ? S.b_base(nxt) : cB;
        for (int t = 0; t < nt; t += 2) {
            const bool last = (t == nt - 2);
            const char* a1 = cA + (size_t)(t + 1) * kstep;
            const char* a2 = last ? nA : cA + (size_t)(t + 2) * kstep; const char* b2 = last ? nB : cB + (size_t)(t + 2) * kstep;
            const char* a3 = a2 + kstep; const char* b3 = b2 + kstep;
            PG8_LDB(B0, 0, 0); PG8_SCHED; PG8_LDA(At, 0, 0); PG8_STAGE(PG8_SA(1, 1), a1 + hstepA, voffA);
            PG8_WAIT_L(8); PG8_BAR; PG8_WAIT_L(0); PG8_MMA(0, 0, At, B0); PG8_BAR; PG8_SCHED;
            PG8_LDB(B1, 0, 1); PG8_STAGE(PG8_SB(0, 0), b2, voffB);
            PG8_BAR; PG8_WAIT_L(0); PG8_MMA(0, 1, At, B1); PG8_BAR;
            PG8_LDA(At, 0, 1); PG8_STAGE(PG8_SA(0, 0), a2, voffA);
            PG8_BAR; PG8_WAIT_L(0); PG8_MMA(1, 0, At, B0); PG8_BAR; PG8_SCHED;
            PG8_STAGE(PG8_SB(0, 1), b2 + hstepB, voffB);
            PG8_WAIT_V(6); PG8_BAR; PG8_MMA(1, 1, At, B1); PG8_BAR;
            PG8_LDB(B0, 1, 0); PG8_SCHED; PG8_LDA(At, 1, 0); PG8_STAGE(PG8_SA(0, 1), a2 + hstepA, voffA);
            PG8_WAIT_L(8); PG8_BAR; PG8_WAIT_L(0); PG8_MMA(0, 0, At, B0); PG8_BAR; PG8_SCHED;
            PG8_LDB(B1, 1, 1); PG8_STAGE(PG8_SB(1, 0), b3, voffB);
            PG8_BAR; PG8_WAIT_L(0); PG8_MMA(0, 1, At, B1); PG8_BAR;
            PG8_LDA(At, 1, 1); PG8_STAGE(PG8_SA(1, 0), a3, voffA);
            PG8_BAR; PG8_WAIT_L(0); PG8_MMA(1, 0, At, B0); PG8_BAR; PG8_SCHED;
            PG8_STAGE(PG8_SB(1, 1), b3 + hstepB, voffB);
            PG8_WAIT_V(6); PG8_BAR; PG8_MMA(1, 1, At, B1); PG8_BAR;
        }
        E(acc, cur, wr, wc, fr, fq);
        if (!has_next) break;
#pragma unroll
        for (int a = 0; a < 2; ++a)
#pragma unroll
            for (int b = 0; b < 2; ++b)
#pragma unroll
                for (int m = 0; m < 4; ++m)
#pragma unroll
                    for (int n = 0; n < 2; ++n) acc[a][b][m][n] = (f32x4){0.f, 0.f, 0.f, 0.f};
        cur = nxt; cA = nA; cB = nB; ++ui;
    }
    PG8_WAIT_V(0);
    if (wr == 0) PG8_BAR;
    PG8_BAR;
#undef PG8_SA
#undef PG8_SB
#undef PG8_STAGE
#undef PG8_LDA
#undef PG8_LDB
#undef PG8_MMA
#undef PG8_WAIT_V
#undef PG8_WAIT_L
#undef PG8_BAR
#undef PG8_SCHED
}
}
using pg8::Unit;
__device__ __forceinline__ u32x4 pack8(const f32x4& v0, const f32x4& v1) {
    u32x4 o; o[0] = cvt_pk_bf16(v0[0], v0[1]); o[1] = cvt_pk_bf16(v0[2], v0[3]); o[2] = cvt_pk_bf16(v1[0], v1[1]); o[3] = cvt_pk_bf16(v1[2], v1[3]); return o;
}
struct EpiWin {
    static constexpr bool PERM = true;
    bf16_t* US; bf16_t* Q; bf16_t* KROW; bf16_t* VROW; bf16_t* VT; float* GATE;
    __device__ __forceinline__ void operator()(const f32x4 (&acc)[2][2][4][2], const Unit& u, int wr, int wc, int fr, int fq) const {
        const int row0 = u.pm * 256 + wr * 64 + fr; const int pn = u.pn;
#pragma unroll
        for (int ai = 0; ai < 2; ++ai)
#pragma unroll
            for (int m = 0; m < 4; ++m) {
                const int row = row0 + ai * 128 + m * 16;
#pragma unroll
                for (int bj = 0; bj < 2; ++bj) {
                    const f32x4 v0 = acc[ai][bj][m][0], v1 = acc[ai][bj][m][1];
                    const int cin = bj * 128 + wc * 32 + 8 * fq;
                    if (pn < 4) { *(u32x4*)(US + (size_t)row * 1024 + pn * 256 + cin) = pack8(v0, v1); }
                    else if (pn < 8) { *(u32x4*)(Q + (size_t)row * 1024 + (pn - 4) * 256 + cin) = pack8(v0 * QSCALE, v1 * QSCALE); }
                    else if (pn < 14) {
                        const int kvi = pn - 8, branch = kvi >> 1, kvsel = kvi & 1, g = bj, d0 = wc * 32 + 8 * fq;
                        if (kvsel == 0) { *(u32x4*)(KROW + ((size_t)(branch * 2 + g) * L_ + row) * 128 + d0) = pack8(v0, v1); }
                        else if (branch == 0) { *(u32x4*)(VROW + ((size_t)g * L_ + row) * 128 + d0) = pack8(v0, v1); }
                        else {
                            const int prow = ((row & ~12) | ((row & 4) << 1) | ((row & 8) >> 1));
                            bf16_t* vt = VT + ((size_t)((branch - 1) * 2 + g) * 128 + d0) * L_ + prow;
#pragma unroll
                            for (int e = 0; e < 4; ++e) { vt[(size_t)e * L_] = f2bf(v0[e]); vt[(size_t)(e + 4) * L_] = f2bf(v1[e]); }
                        }
                    } else {
                        if (cin < 24) {
                            float* gp = GATE + (size_t)row * 24 + cin;
                            f32x4 s0, s1;
#pragma unroll
                            for (int e = 0; e < 4; ++e) { s0[e] = sigmoidf_(v0[e]); s1[e] = sigmoidf_(v1[e]); }
                            *(f32x4*)gp = s0; *(f32x4*)(gp + 4) = s1;
                        }
                    }
                }
            }
    }
};
struct EpiGlu {
    static constexpr bool PERM = true;
    const bf16_t* Z; const float* bglu; bf16_t* Y;
    __device__ __forceinline__ void operator()(const f32x4 (&acc)[2][2][4][2], const Unit& u, int wr, int wc, int fr, int fq) const {
        const int row0 = u.pm * 256 + wr * 64 + fr;
#pragma unroll
        for (int bj = 0; bj < 2; ++bj) {
            const int col = u.pn * 256 + bj * 128 + wc * 32 + 8 * fq;
            const f32x4 b0 = *(const f32x4*)(bglu + col), b1 = *(const f32x4*)(bglu + col + 4);
#pragma unroll
            for (int ai = 0; ai < 2; ++ai)
#pragma unroll
                for (int m = 0; m < 4; ++m) {
                    const int row = row0 + ai * 128 + m * 16;
                    const u32x4 zz = *(const u32x4*)(Z + (size_t)row * 1024 + col);
                    const f32x4 v0 = acc[ai][bj][m][0] + b0, v1 = acc[ai][bj][m][1] + b1;
                    f32x4 o0, o1;
                    o0[0] = bflo(zz[0]) * sigmoidf_(v0[0]); o0[1] = bfhi(zz[0]) * sigmoidf_(v0[1]); o0[2] = bflo(zz[1]) * sigmoidf_(v0[2]); o0[3] = bfhi(zz[1]) * sigmoidf_(v0[3]);
                    o1[0] = bflo(zz[2]) * sigmoidf_(v1[0]); o1[1] = bfhi(zz[2]) * sigmoidf_(v1[1]); o1[2] = bflo(zz[3]) * sigmoidf_(v1[2]); o1[3] = bfhi(zz[3]) * sigmoidf_(v1[3]);
                    *(u32x4*)(Y + (size_t)row * 1024 + col) = pack8(o0, o1);
                }
        }
    }
};
struct EpiWout {
    static constexpr bool PERM = true;
    const float* X; const float* g1; bf16_t* X1;
    __device__ __forceinline__ void operator()(const f32x4 (&acc)[2][2][4][2], const Unit& u, int wr, int wc, int fr, int fq) const {
        const int row0 = u.pm * 256 + wr * 64 + fr, col0 = u.pn * 256 + wc * 32 + 8 * fq;
#pragma unroll
        for (int bj = 0; bj < 2; ++bj) {
            const int col = col0 + bj * 128;
            const f32x4 g0 = *(const f32x4*)(g1 + col), g4 = *(const f32x4*)(g1 + col + 4);
#pragma unroll
            for (int ai = 0; ai < 2; ++ai)
#pragma unroll
                for (int m = 0; m < 4; ++m) {
                    const size_t off = (size_t)(row0 + ai * 128 + m * 16) * 2048 + col;
                    const f32x4 x0 = *(const f32x4*)(X + off), x4 = *(const f32x4*)(X + off + 4);
                    *(u32x4*)(X1 + off) = pack8(x0 + g0 * acc[ai][bj][m][0], x4 + g4 * acc[ai][bj][m][1]);
                }
        }
    }
};
struct EpiBf16 {
    static constexpr bool PERM = true;
    bf16_t* O; int ldc;
    __device__ __forceinline__ void operator()(const f32x4 (&acc)[2][2][4][2], const Unit& u, int wr, int wc, int fr, int fq) const {
        const int row0 = u.pm * 256 + wr * 64 + fr, col0 = u.pn * 256 + wc * 32 + 8 * fq;
#pragma unroll
        for (int ai = 0; ai < 2; ++ai)
#pragma unroll
            for (int m = 0; m < 4; ++m)
#pragma unroll
                for (int bj = 0; bj < 2; ++bj)
                    *(u32x4*)(O + (size_t)(row0 + ai * 128 + m * 16) * ldc + col0 + bj * 128) = pack8(acc[ai][bj][m][0], acc[ai][bj][m][1]);
    }
};
struct EpiSlab {
    static constexpr bool PERM = false;
    float* SL;
    __device__ __forceinline__ void operator()(const f32x4 (&acc)[2][2][4][2], const Unit& u, int wr, int wc, int fr, int fq) const {
        float* base = SL + (size_t)u.z * 2048 * 256;
        const int row0 = u.pm * 256 + wr * 64 + fr, col0 = wc * 32 + 4 * fq;
#pragma unroll
        for (int ai = 0; ai < 2; ++ai)
#pragma unroll
            for (int m = 0; m < 4; ++m)
#pragma unroll
                for (int bj = 0; bj < 2; ++bj)
#pragma unroll
                    for (int n = 0; n < 2; ++n)
                        *(f32x4*)(base + (size_t)(row0 + ai * 128 + m * 16) * 256 + col0 + bj * 128 + n * 16) = acc[ai][bj][m][n];
    }
};
struct CmpOrder {
    const bf16_t* KROW; const bf16_t* VROW; const bf16_t* W1; int lda, ldb, K; int G, c;
    __device__ bool next(int i, Unit& u) const {
        const int x = i * G + c; if (x >= 256) return false;
        const int kvsel = x >> 7, pm = (x & 127) >> 4, ks = x & 15; u.pm = pm; u.pn = 0; u.z = kvsel * 16 + ks; return true;
    }
    __device__ __forceinline__ const char* a_base(const Unit& u) const { return (const char*)(((u.z >> 4) ? VROW : KROW) + (size_t)u.pm * 256 * 2048 + (u.z & 15) * 256); }
    __device__ __forceinline__ const char* b_base(const Unit& u) const { return (const char*)(W1 + (size_t)(u.z >> 4) * 256 * 4096 + (u.z & 15) * 256); }
};
struct Ctx { int bid, nb, tid, wave, lane; LAS unsigned char* lds; };

__device__ __forceinline__ void p0_cond(const Args& a, const Ctx& c) {
    const float* cv = a.in[1]; const float* w = a.in[2]; float* condp = (float*)(a.ws + WS_CONDP);
    for (int u = c.bid * 8 + c.wave; u < 1536; u += c.nb * 8) {
        const int cc = u % 48, kc = u / 48;
        const float* wp = w + (size_t)(kc * 64) * NADA + cc * 256 + c.lane * 4;
        f32x4 acc = {0.f, 0.f, 0.f, 0.f};
#pragma unroll 16
        for (int k = 0; k < 64; ++k) { const float x = cv[kc * 64 + k]; const float s = x / (1.f + __expf(-x)); acc += s * *(const f32x4*)(wp + (size_t)k * NADA); }
        *(f32x4*)(condp + (size_t)kc * NADA + cc * 256 + c.lane * 4) = acc;
    }
}
__device__ __forceinline__ void conv_T(const float* src, int K, int N, bf16_t* dst, int Npad, const Ctx& c) {
    LAS float* tile = (LAS float*)c.lds;
    const int nkt = K / 64, ntiles = nkt * (Npad / 64);
    const int r = c.tid >> 4, c4 = c.tid & 15;
    f32x4 v[2];
#define CONVT_LD(tix_) do { const int nt_ = (tix_) / nkt, kt_ = (tix_) % nkt, n_ = nt_ * 64 + 4 * c4; _Pragma("unroll") for (int i = 0; i < 2; ++i) { const int k_ = kt_ * 64 + r + 32 * i; v[i] = (f32x4){0.f, 0.f, 0.f, 0.f}; if (n_ < N) v[i] = *(const f32x4*)(src + (size_t)k_ * N + n_); } } while (0)
    if (c.bid < ntiles) CONVT_LD(c.bid);
    for (int tix = c.bid; tix < ntiles; tix += c.nb) {
        const int nt = tix / nkt, kt = tix % nkt;
#pragma unroll
        for (int i = 0; i < 2; ++i) { LAS float* tp = tile + (r + 32 * i) * 65 + 4 * c4; tp[0] = v[i][0]; tp[1] = v[i][1]; tp[2] = v[i][2]; tp[3] = v[i][3]; }
        __syncthreads();
        if (tix + c.nb < ntiles) CONVT_LD(tix + c.nb);
        { const int n = c.tid >> 3, kq = c.tid & 7; float w[8];
#pragma unroll
          for (int j = 0; j < 8; ++j) w[j] = tile[(kq * 8 + j) * 65 + n];
          u32x4 o; o[0] = cvt_pk_bf16(w[0], w[1]); o[1] = cvt_pk_bf16(w[2], w[3]); o[2] = cvt_pk_bf16(w[4], w[5]); o[3] = cvt_pk_bf16(w[6], w[7]);
          *(u32x4*)(dst + (size_t)(nt * 64 + n) * K + kt * 64 + kq * 8) = o; }
        __syncthreads();
    }
#undef CONVT_LD
}
__device__ __forceinline__ void conv_fp4rows(const float* src, unsigned char* dst4, float* scl, int rows, const Ctx& c) {
    const int stride = c.nb * 8;
    int row = c.bid * 8 + c.wave;
    f32x4 v[8], w[8];
    if (row < rows) {
#pragma unroll
        for (int j = 0; j < 8; ++j) v[j] = *(const f32x4*)(src + (size_t)row * 2048 + c.lane * 32 + j * 4);
    }
    for (; row < rows; row += stride) {
        const int nrow = row + stride;
        if (nrow < rows) {
#pragma unroll
            for (int j = 0; j < 8; ++j) w[j] = *(const f32x4*)(src + (size_t)nrow * 2048 + c.lane * 32 + j * 4);
        }
        float mx = 0.f;
#pragma unroll
        for (int j = 0; j < 8; ++j) mx = fmaxf(mx, fmaxf(fmaxf(fabsf(v[j][0]), fabsf(v[j][1])), fmaxf(fabsf(v[j][2]), fabsf(v[j][3]))));
        mx = wave_max(mx);
        const float s = mx > 0.f ? 6.f / mx : 1.f;
        if (c.lane == 0) scl[row] = mx > 0.f ? mx * (1.f / 6.f) : 1.f;
        u32x4 pk = {0u, 0u, 0u, 0u};
#pragma unroll
        for (int d = 0; d < 4; ++d) {
            unsigned wq = 0u;
            wq = fp4_pk<0>(wq, v[2 * d][0] * s, v[2 * d][1] * s); wq = fp4_pk<1>(wq, v[2 * d][2] * s, v[2 * d][3] * s);
            wq = fp4_pk<2>(wq, v[2 * d + 1][0] * s, v[2 * d + 1][1] * s); wq = fp4_pk<3>(wq, v[2 * d + 1][2] * s, v[2 * d + 1][3] * s);
            pk[d] = wq;
        }
        *(u32x4*)(dst4 + (size_t)row * 1024 + c.lane * 16) = pk;
#pragma unroll
        for (int j = 0; j < 8; ++j) v[j] = w[j];
    }
}
__device__ __forceinline__ void conv_E(const float* src, bf16_t* dst, size_t n8, const Ctx& c) {
    const size_t stride = (size_t)c.nb * NTHREADS;
    for (size_t i = (size_t)c.bid * NTHREADS + c.tid; i < n8; i += stride) {
        const f32x4 x = *(const f32x4*)(src + i * 8), y = *(const f32x4*)(src + i * 8 + 4);
        *(u32x4*)(dst + i * 8) = pack8(x, y);
    }
}
__device__ __forceinline__ int t5_bucket(int n) {
    if (n < 16) return n;
    const float scaled = logf((float)n / 16.f) / logf(64.f);
    const int large = 16 + (int)(scaled * 16.f);
    return large < 31 ? large : 31;
}
__device__ __forceinline__ void p0_tb(const Args& a, const Ctx& c) {
    float* tb = (float*)(a.ws + WS_TB); const float* rb = a.in[26];
    for (int i = c.bid * NTHREADS + c.tid; i < 8 * TBN; i += c.nb * NTHREADS) { const int head = i / TBN, dist = i % TBN; tb[i] = rb[t5_bucket(dist) * 8 + head] * LOG2E; }
}
__device__ __forceinline__ void p0_bpe(const Args& a, const Ctx& c, int part) {
    const int n = c.tid & 255, kv = c.tid >> 8;
    const float* pe = a.in[kv ? 23 : 20]; const float* w1 = a.in[kv ? 24 : 21]; float* bpep = (float*)(a.ws + WS_BPEP);
    float s = 0.f;
#pragma unroll 16
    for (int k = part * 128; k < part * 128 + 128; ++k) s += pe[k] * w1[(size_t)k * 256 + n];
    bpep[(part * 2 + kv) * 256 + n] = s;
}
__device__ __forceinline__ void p0_s5(const Args& a, const Ctx& c, int g, int part) {
    LAS float* ar = (LAS float*)c.lds;
    LAS float* ai = ar + 17 * 64;
    LAS float* bbr = ai + 17 * 64;
    LAS float* bbi = bbr + 1024;
    LAS float* cr = bbi + 1024;
    LAS float* ci = cr + 1024;
    LAS float* kd = ci + 1024;
    const int tid = c.tid;
    if (tid < 64) {
        const int p = tid; const float dt = expf(a.in[12][g]); const float lr = a.in[10][g * 64 + p], li = a.in[11][g * 64 + p];
        for (int d = 0; d <= 16; ++d) { const float mag = expf(lr * dt * (float)d), ang = li * dt * (float)d; ar[d * 64 + p] = mag * cosf(ang); ai[d * 64 + p] = mag * sinf(ang); }
        const float nr = ar[64 + p] - 1.f, ni = ai[64 + p], den = lr * lr + li * li;
        const float wre = (nr * lr + ni * li) / den, wim = (ni * lr - nr * li) / den;
        for (int h = 0; h < 16; ++h) { const float br = a.in[13][(g * 64 + p) * 16 + h], bi = a.in[14][(g * 64 + p) * 16 + h]; bbr[p * 16 + h] = wre * br - wim * bi; bbi[p * 16 + h] = wre * bi + wim * br; }
        if (part == 0) {
        float* s5p = (float*)(a.ws + WS_S5P);
        float xr = ar[16 * 64 + p], xi = ai[16 * 64 + p];
        s5p[(g * 64 + p) * 2] = xr; s5p[(g * 64 + p) * 2 + 1] = xi;
        for (int s = 0; s < 8; ++s) { const float tr = xr * xr - xi * xi, ti = 2.f * xr * xi; xr = tr; xi = ti; }
        s5p[64 * 64 * 2 + (g * 64 + p) * 2] = xr; s5p[64 * 64 * 2 + (g * 64 + p) * 2 + 1] = xi;
        }
    }
    for (int e = tid; e < 1024; e += NTHREADS) { cr[e] = a.in[15][g * 1024 + e]; ci[e] = a.in[16][g * 1024 + e]; }
    __syncthreads();
    for (int e = tid; e < 1024 * (part + 1); e += NTHREADS) {
        const int d = e >> 8, h1 = (e >> 4) & 15, h = e & 15; float s = 0.f;
        for (int p = 0; p < 64; ++p) { const float Cr = cr[h1 * 64 + p], Ci = ci[h1 * 64 + p], Ar = ar[d * 64 + p], Ai = ai[d * 64 + p];
            const float Gr = Cr * Ar - Ci * Ai, Gi = Cr * Ai + Ci * Ar; s += Gr * bbr[p * 16 + h] - Gi * bbi[p * 16 + h]; }
        if (d == 0 && h1 == h) s += a.in[17][g * 16 + h];
        kd[e] = s;
    }
    __syncthreads();
    bf16_t* MT = (bf16_t*)(a.ws + WS_S5MT) + (size_t)g * 65536;
    bf16_t* WE = (bf16_t*)(a.ws + WS_S5WE) + (size_t)g * 32768;
    bf16_t* WC = (bf16_t*)(a.ws + WS_S5WC) + (size_t)g * 32768;
    for (int e = 16384 * part + tid; e < 16384 * (part + 1); e += NTHREADS) { const int n = e >> 8, k = e & 255, j = n >> 4, h1 = n & 15, i = k >> 4, h = k & 15;
        MT[e] = f2bf(i <= j ? kd[(j - i) * 256 + h1 * 16 + h] : 0.f); }
    for (int e = 8192 * part + tid; e < 8192 * (part + 1); e += NTHREADS) { const int n = e >> 8, k = e & 255, cc = n >> 6, p = n & 63, i = k >> 4, h = k & 15;
        const float Ar = ar[(15 - i) * 64 + p], Ai = ai[(15 - i) * 64 + p], Br = bbr[p * 16 + h], Bi = bbi[p * 16 + h];
        WE[e] = f2bf(cc ? (Ar * Bi + Ai * Br) : (Ar * Br - Ai * Bi)); }
    for (int e = 8192 * part + tid; e < 8192 * (part + 1); e += NTHREADS) { const int n = e >> 7, k = e & 127, j = n >> 4, h1 = n & 15, cc = k >> 6, p = k & 63;
        const float Cr = cr[h1 * 64 + p], Ci = ci[h1 * 64 + p], Ar = ar[(j + 1) * 64 + p], Ai = ai[(j + 1) * 64 + p];
        WC[e] = f2bf(cc ? -(Cr * Ai + Ci * Ar) : (Cr * Ar - Ci * Ai)); }
    __syncthreads();
}
__device__ __forceinline__ void p0_prologue(const Args& a, const Ctx& c) {
    for (int u = c.bid; u < 256; u += c.nb) p0_s5(a, c, u >> 2, u & 3);
    for (int u = 0; u < 32; ++u) if (c.bid == (8 * u + 7) % c.nb) p0_bpe(a, c, u);
    p0_tb(a, c);
    p0_cond(a, c);
    conv_T(a.in[6], 2048, DIN, (bf16_t*)(a.ws + WS_WIN), DIN_PAD, c);
    conv_T(a.in[18], 1024, 1024, (bf16_t*)(a.ws + WS_WGLU), 1024, c);
    conv_T(a.in[7], 2048, 2048, (bf16_t*)(a.ws + WS_WOUT), 2048, c);
    conv_T(a.in[27], 2048, 2048, (bf16_t*)(a.ws + WS_WQ), 2048, c);
    conv_T(a.in[21], 4096, 256, (bf16_t*)(a.ws + WS_W1), 256, c);
    conv_T(a.in[24], 4096, 256, (bf16_t*)(a.ws + WS_W1) + 256 * 4096, 256, c);
    conv_T(a.in[22], 256, 128, (bf16_t*)(a.ws + WS_W2), 128, c);
    conv_T(a.in[25], 256, 128, (bf16_t*)(a.ws + WS_W2) + 128 * 256, 128, c);
    conv_E(a.in[28], (bf16_t*)(a.ws + WS_PK), 128 * 128 / 8, c);
    conv_E(a.in[29], (bf16_t*)(a.ws + WS_PK) + 128 * 128, 128 * 128 / 8, c);
    conv_fp4rows(a.in[30], a.ws + WS_PU, (float*)(a.ws + WS_PSC), 16384, c);
    conv_fp4rows(a.in[31], a.ws + WS_PV, (float*)(a.ws + WS_PSC) + 16384, 16384, c);
}

__device__ __forceinline__ void norm_rows(const float* X, bf16_t* O, LAS const float* Ab, LAS const float* Bb, const Ctx& c, int row0 = 0, int nrows = L_) {
    for (int t = row0 + c.bid * 8 + c.wave; t < row0 + nrows; t += c.nb * 8) {
        const float* xr = X + (size_t)t * 2048 + c.lane * 4;
        f32x4 v[8]; float ss = 0.f;
#pragma unroll
        for (int j = 0; j < 8; ++j) { v[j] = *(const f32x4*)(xr + j * 256); ss += v[j][0] * v[j][0] + v[j][1] * v[j][1] + v[j][2] * v[j][2] + v[j][3] * v[j][3]; }
        ss = wave_sum(ss);
        const float rstd = rsqrtf(ss * (1.f / 2048.f) + 1e-6f);
#pragma unroll
        for (int j = 0; j < 8; ++j) {
            const int col = j * 256 + c.lane * 4;
            const f32x4 A = *(const LAS f32x4*)(Ab + col), B = *(const LAS f32x4*)(Bb + col);
            const f32x4 o = v[j] * rstd * A + B;
            u32x2 w; w[0] = cvt_pk_bf16(o[0], o[1]); w[1] = cvt_pk_bf16(o[2], o[3]);
            *(u32x2*)(O + (size_t)t * 2048 + col) = w;
        }
    }
}
__device__ __forceinline__ void norm_rows_bf16(const bf16_t* X, bf16_t* O, LAS const float* Ab, LAS const float* Bb, const Ctx& c, int row0, int nrows) {
    for (int t = row0 + c.bid * 8 + c.wave; t < row0 + nrows; t += c.nb * 8) {
        const bf16_t* xr = X + (size_t)t * 2048 + c.lane * 8;
        u32x4 w[4]; float ss = 0.f;
#pragma unroll
        for (int j = 0; j < 4; ++j) { w[j] = *(const u32x4*)(xr + j * 512);
#pragma unroll
            for (int e = 0; e < 4; ++e) { const float a0 = bflo(w[j][e]), a1 = bfhi(w[j][e]); ss += a0 * a0 + a1 * a1; } }
        ss = wave_sum(ss);
        const float rstd = rsqrtf(ss * (1.f / 2048.f) + 1e-6f);
#pragma unroll
        for (int j = 0; j < 4; ++j) {
            const int col = j * 512 + c.lane * 8;
            const f32x4 A0 = *(const LAS f32x4*)(Ab + col), A1 = *(const LAS f32x4*)(Ab + col + 4), B0 = *(const LAS f32x4*)(Bb + col), B1 = *(const LAS f32x4*)(Bb + col + 4);
            f32x4 o0, o1;
#pragma unroll
            for (int e = 0; e < 2; ++e) { o0[2 * e] = bflo(w[j][e]) * rstd * A0[2 * e] + B0[2 * e]; o0[2 * e + 1] = bfhi(w[j][e]) * rstd * A0[2 * e + 1] + B0[2 * e + 1];
                o1[2 * e] = bflo(w[j][2 + e]) * rstd * A1[2 * e] + B1[2 * e]; o1[2 * e + 1] = bfhi(w[j][2 + e]) * rstd * A1[2 * e + 1] + B1[2 * e + 1]; }
            *(u32x4*)(O + (size_t)t * 2048 + col) = pack8(o0, o1);
        }
    }
}
__device__ __forceinline__ float cond_from_partials(const float* condp, const float* b_ada, int j) {
    float s = b_ada[j];
#pragma unroll 8
    for (int k = 0; k < 32; ++k) s += condp[(size_t)k * NADA + j];
    return s;
}
__device__ __forceinline__ void p1_hnorm(const Args& a, const Ctx& c) {
    const float* condp = (const float*)(a.ws + WS_CONDP); float* cond = (float*)(a.ws + WS_COND);
    for (int j = c.bid * NTHREADS + c.tid; j < NADA; j += c.nb * NTHREADS) cond[j] = cond_from_partials(condp, a.in[3], j);
    LAS float* Ab = (LAS float*)c.lds; LAS float* Bb = Ab + 2048;
    for (int col = c.tid; col < 2048; col += NTHREADS) {
        Ab[col] = a.in[4][col] * (1.f + cond_from_partials(condp, a.in[3], 2048 + col)); Bb[col] = cond_from_partials(condp, a.in[3], col); }
    __syncthreads();
    norm_rows(a.in[0], (bf16_t*)(a.ws + WS_H), Ab, Bb, c);
}
__device__ __forceinline__ void p8_h2norm(const Args& a, const Ctx& c, int row0, int nrows) {
    const float* cond = (const float*)(a.ws + WS_COND);
    LAS float* Ab = (LAS float*)c.lds; LAS float* Bb = Ab + 2048;
    for (int col = c.tid; col < 2048; col += NTHREADS) { Ab[col] = a.in[5][col] * (1.f + cond[4 * 2048 + col]); Bb[col] = cond[3 * 2048 + col]; }
    __syncthreads();
    norm_rows_bf16((const bf16_t*)(a.ws + WS_X1), (bf16_t*)(a.ws + WS_H), Ab, Bb, c, row0, nrows);
}
__device__ __forceinline__ void p6_mixnorm(const Args& a, const Ctx& c) {
    const bf16_t* YS = (const bf16_t*)(a.ws + WS_YSSM); const bf16_t* YA = (const bf16_t*)(a.ws + WS_YATT); bf16_t* O = (bf16_t*)(a.ws + WS_H);
    for (int t = c.bid * 8 + c.wave; t < L_; t += c.nb * 8) {
#pragma unroll
        for (int part = 0; part < 2; ++part) {
            const bf16_t* src = (part ? YA : YS) + (size_t)t * 1024 + c.lane * 8; const float* beta = a.in[part ? 9 : 8];
            u32x4 w[2]; float f[16]; float ss = 0.f;
#pragma unroll
            for (int j = 0; j < 2; ++j) { w[j] = *(const u32x4*)(src + j * 512);
#pragma unroll
                for (int e = 0; e < 4; ++e) { f[j * 8 + 2 * e] = bflo(w[j][e]); f[j * 8 + 2 * e + 1] = bfhi(w[j][e]); } }
#pragma unroll
            for (int e = 0; e < 16; ++e) ss += f[e] * f[e];
            ss = wave_sum(ss);
            const float rstd = rsqrtf(ss * (1.f / 1024.f) + 1e-6f);
#pragma unroll
            for (int j = 0; j < 2; ++j) { const int col = j * 512 + c.lane * 8; const f32x4 b0 = *(const f32x4*)(beta + col), b1 = *(const f32x4*)(beta + col + 4);
                f32x4 o0, o1;
#pragma unroll
                for (int e = 0; e < 4; ++e) { o0[e] = f[j * 8 + e] * rstd * b0[e]; o1[e] = f[j * 8 + 4 + e] * rstd * b1[e]; }
                *(u32x4*)(O + (size_t)t * 2048 + part * 1024 + col) = pack8(o0, o1); }
        }
    }
}
constexpr int S5_US = 0, S5_ES = 33792, S5_SS = 67584, S5_TS = 84992;
template <int PASS>
__device__ __forceinline__ void s5_item(const Args& a, const Ctx& c, int g, int seg) {
    LAS unsigned char* lds = c.lds;
    int tid = c.tid; asm volatile("" : "+v"(tid));
    const int wave = c.wave, lane = tid & 63, r = lane & 15, q = lane >> 4;
    const bf16_t* U = (const bf16_t*)(a.ws + WS_US);
    const bf16_t* MT = (const bf16_t*)(a.ws + WS_S5MT) + (size_t)g * 65536;
    const bf16_t* WE = (const bf16_t*)(a.ws + WS_S5WE) + (size_t)g * 32768;
    const bf16_t* WC = (const bf16_t*)(a.ws + WS_S5WC) + (size_t)g * 32768;
    const float* s5p = (const float*)(a.ws + WS_S5P);
    float* F = (float*)(a.ws + WS_S5F) + (size_t)g * 4 * 128;
    bf16_t* Z = (bf16_t*)(a.ws + WS_Z);
    bf16x8 bE[8];
#pragma unroll
    for (int ks = 0; ks < 8; ++ks) bE[ks] = *(const bf16x8*)(WE + (size_t)(16 * wave + r) * 256 + 32 * ks + 8 * q);
    bf16x8 bM[2][8], bC[2][4];
    if (PASS == 1) {
#pragma unroll
        for (int nt = 0; nt < 2; ++nt)
#pragma unroll
            for (int ks = 0; ks < 4; ++ks) bC[nt][ks] = *(const bf16x8*)(WC + (size_t)(16 * (2 * wave + nt) + r) * 128 + 32 * ks + 8 * q);
#pragma unroll
        for (int nt = 0; nt < 2; ++nt)
#pragma unroll
            for (int ks = 0; ks < 8; ++ks) bM[nt][ks] = *(const bf16x8*)(MT + (size_t)(16 * (2 * wave + nt) + r) * 256 + 32 * ks + 8 * q);
    }
    float sr = 0.f, si = 0.f;
    const float a16r = s5p[(g * 64 + lane) * 2], a16i = s5p[(g * 64 + lane) * 2 + 1];
    float a128r = a16r, a128i = a16i;
#pragma unroll
    for (int s = 0; s < 3; ++s) { const float tr = a128r * a128r - a128i * a128i, ti = 2.f * a128r * a128i; a128r = tr; a128i = ti; }
    if (PASS == 1) { const float br = s5p[8192 + (g * 64 + lane) * 2], bi = s5p[8192 + (g * 64 + lane) * 2 + 1];
        for (int s = 0; s < seg; ++s) { const float fr_ = F[s * 128 + lane], fi_ = F[s * 128 + 64 + lane]; const float nr = br * sr - bi * si + fr_, ni = br * si + bi * sr + fi_; sr = nr; si = ni; } }
    for (int sb = 0; sb < 4; ++sb) {
        const int tok0 = seg * 4096 + sb * 1024;
#pragma unroll
        for (int i = 0; i < 4; ++i) { const int ch = tid + NTHREADS * i, token = ch >> 1, half = ch & 1;
            const u32x4 v = *(const u32x4*)(U + (size_t)(tok0 + token) * 1024 + g * 16 + half * 8);
            *(LAS u32x4*)(lds + S5_US + (token >> 4) * 528 + ((token & 15) * 16 + half * 8) * 2) = v; }
        __syncthreads();
#pragma unroll
        for (int m = 0; m < 4; ++m) {
            f32x4 acc = {0.f, 0.f, 0.f, 0.f};
#pragma unroll
            for (int ks = 0; ks < 8; ++ks) { const bf16x8 A = *(const LAS bf16x8*)(lds + S5_US + (16 * m + r) * 528 + (32 * ks + 8 * q) * 2); acc = mfma16(A, bE[ks], acc); }
#pragma unroll
            for (int i = 0; i < 4; ++i) *(LAS float*)(lds + S5_ES + ((16 * m + 4 * q + i) * 132 + 16 * wave + r) * 4) = acc[i];
        }
        __syncthreads();
        {
            float lr[8], li[8];
            float xr = 0.f, xi = 0.f;
#pragma unroll
            for (int k = 0; k < 8; ++k) {
                lr[k] = xr; li[k] = xi;
                const float er = *(const LAS float*)(lds + S5_ES + ((8 * wave + k) * 132 + lane) * 4), ei = *(const LAS float*)(lds + S5_ES + ((8 * wave + k) * 132 + 64 + lane) * 4);
                const float nr = a16r * xr - a16i * xi + er, ni = a16r * xi + a16i * xr + ei; xr = nr; xi = ni;
            }
            __builtin_amdgcn_sched_barrier(0);
            *(LAS float*)(lds + S5_TS + (wave * 128 + lane) * 4) = xr; *(LAS float*)(lds + S5_TS + (wave * 128 + 64 + lane) * 4) = xi;
            __syncthreads();
            __builtin_amdgcn_sched_barrier(0);
            float cr = sr, ci = si, mr = sr, mi = si;
#pragma unroll
            for (int w2 = 0; w2 < 8; ++w2) {
                if (w2 == wave) { mr = cr; mi = ci; }
                const float tr = *(const LAS float*)(lds + S5_TS + (w2 * 128 + lane) * 4), ti = *(const LAS float*)(lds + S5_TS + (w2 * 128 + 64 + lane) * 4);
                const float nr = a128r * cr - a128i * ci + tr, ni = a128r * ci + a128i * cr + ti; cr = nr; ci = ni;
            }
            sr = cr; si = ci;
            __builtin_amdgcn_sched_barrier(0);
            if (PASS == 1) {
                float pr = mr, pi = mi;
#pragma unroll
                for (int k = 0; k < 8; ++k) {
                    *(LAS bf16_t*)(lds + S5_SS + ((8 * wave + k) * 136 + lane) * 2) = f2bf(lr[k] + pr); *(LAS bf16_t*)(lds + S5_SS + ((8 * wave + k) * 136 + 64 + lane) * 2) = f2bf(li[k] + pi);
                    const float nr = a16r * pr - a16i * pi, ni = a16r * pi + a16i * pr; pr = nr; pi = ni;
                }
            }
        }
        __syncthreads();
        if (PASS == 1) {
#pragma unroll
            for (int nt = 0; nt < 2; ++nt) {
                const int j = 2 * wave + nt;
                f32x4 acc[4];
#pragma unroll
                for (int m = 0; m < 4; ++m) acc[m] = (f32x4){0.f, 0.f, 0.f, 0.f};
#pragma unroll
                for (int ks = 0; ks < 8; ++ks) {
                    __builtin_amdgcn_sched_barrier(0);
#pragma unroll
                    for (int m = 0; m < 4; ++m) { const bf16x8 A = *(const LAS bf16x8*)(lds + S5_US + (16 * m + r) * 528 + (32 * ks + 8 * q) * 2); acc[m] = mfma16(A, bM[nt][ks], acc[m]); }
                }
#pragma unroll
                for (int ks = 0; ks < 4; ++ks) {
                    __builtin_amdgcn_sched_barrier(0);
#pragma unroll
                    for (int m = 0; m < 4; ++m) { const bf16x8 A = *(const LAS bf16x8*)(lds + S5_SS + (16 * m + r) * 272 + (32 * ks + 8 * q) * 2); acc[m] = mfma16(A, bC[nt][ks], acc[m]); }
                }
                int lz = lane; asm volatile("" : "+v"(lz));
                const int rz = lz & 15, qz = lz >> 4;
#pragma unroll
                for (int m = 0; m < 4; ++m)
#pragma unroll
                    for (int i = 0; i < 4; ++i) { const int ch = 16 * m + 4 * qz + i; Z[(size_t)(tok0 + 16 * ch + j) * 1024 + g * 16 + rz] = f2bf(gelu_tanh(acc[m][i])); }
            }
            __syncthreads();
        }
    }
    if (PASS == 0 && wave == 0) { F[seg * 128 + lane] = sr; F[seg * 128 + 64 + lane] = si; }
}

__device__ __forceinline__ void cmp_finish_item(const Args& a, const Ctx& c, int kvsel, int rt) {
    LAS unsigned char* lds = c.lds;
    const int tid = c.tid, wave = c.wave, lane = c.lane, r = lane & 15, q = lane >> 4;
    const float* SL = (const float*)(a.ws + WS_SLAB) + (size_t)kvsel * 16 * 2048 * 256;
    const float* bpep = (const float*)(a.ws + WS_BPEP) + kvsel * 256;
    const bf16_t* W2 = (const bf16_t*)(a.ws + WS_W2) + kvsel * 128 * 256;
    bf16x8 B[8];
#pragma unroll
    for (int ks = 0; ks < 8; ++ks) B[ks] = *(const bf16x8*)(W2 + (size_t)(16 * wave + r) * 256 + 32 * ks + 8 * q);
    for (int e = tid; e < 16 * 64; e += NTHREADS) {
        const int row = e >> 6, c4 = (e & 63) * 4;
        f32x4 s = {0.f, 0.f, 0.f, 0.f};
#pragma unroll 8
        for (int pt = 0; pt < 32; ++pt) s += *(const f32x4*)(bpep + pt * 512 + c4);
#pragma unroll
        for (int ks = 0; ks < 16; ++ks) s += *(const f32x4*)(SL + ((size_t)ks * 2048 + rt * 16 + row) * 256 + c4);
        u32x2 w; w[0] = cvt_pk_bf16(gelu_tanh(s[0]), gelu_tanh(s[1])); w[1] = cvt_pk_bf16(gelu_tanh(s[2]), gelu_tanh(s[3]));
        *(LAS u32x2*)(lds + row * 528 + c4 * 2) = w;
    }
    __syncthreads();
    f32x4 acc = {0.f, 0.f, 0.f, 0.f};
#pragma unroll
    for (int ks = 0; ks < 8; ++ks) { const bf16x8 A = *(const LAS bf16x8*)(lds + r * 528 + (32 * ks + 8 * q) * 2); acc = mfma16(A, B[ks], acc); }
#pragma unroll
    for (int i = 0; i < 4; ++i) {
        const int row = rt * 16 + 4 * q + i, gi = row >> 10, ci = row & 1023, n = 16 * wave + r;
        const bf16_t v = (ci == 1023) ? (bf16_t)0 : f2bf(acc[i]);
        if (kvsel == 0) ((bf16_t*)(a.ws + WS_KC))[((size_t)gi * 1024 + ci) * 128 + n] = v;
        else ((bf16_t*)(a.ws + WS_VCT))[((size_t)gi * 128 + n) * 1024 + ((ci & ~12) | ((ci & 4) << 1) | ((ci & 8) >> 1))] = v;
    }
    __syncthreads();
}
constexpr int AT_IMP = 65536, AT_TB = 131072, AT_BM = 143872, AT_WU = 145920, AT_END = 146176;
__device__ __forceinline__ int kswz(int r) { return ((r & 3) << 2) | ((r >> 2) & 3); }
__host__ __device__ __forceinline__ int vperm(int t) { return (t & ~12) | ((t & 4) << 1) | ((t & 8) >> 1); }
template <int KEYS> __device__ __forceinline__ int vsw(int d) { return KEYS == 128 ? kswz(d) : ((d >> 1) & 7); }
template <int KEYS, bool NEEDV>
__device__ __forceinline__ void stage_dma(const bf16_t* Kt, const bf16_t* Vt, int ldv, LAS unsigned char* kb, LAS unsigned char* vb, int wave, int lane) {
    constexpr int NP = KEYS / 32;
#pragma unroll
    for (int i = 0; i < NP; ++i) { const int pc = NP * wave + i, row = 4 * pc + (lane >> 4), ch = (lane & 15) ^ kswz(row);
        __builtin_amdgcn_global_load_lds((const unsigned*)(Kt + row * 128 + ch * 8), (LAS unsigned*)(kb + pc * 1024), 16, 0, 0); }
    if (NEEDV) {
#pragma unroll
        for (int i = 0; i < NP; ++i) {
            const int pc = NP * wave + i;
            if (KEYS == 128) { const int d = 4 * pc + (lane >> 4), ch = (lane & 15) ^ kswz(d);
                __builtin_amdgcn_global_load_lds((const unsigned*)(Vt + (size_t)d * ldv + 8 * ch), (LAS unsigned*)(vb + pc * 1024), 16, 0, 0); }
            else { const int d = 8 * pc + (lane >> 3), ch = (lane & 7) ^ ((d >> 1) & 7);
                __builtin_amdgcn_global_load_lds((const unsigned*)(Vt + (size_t)d * ldv + 8 * ch), (LAS unsigned*)(vb + pc * 1024), 16, 0, 0); }
        }
    }
}
__device__ __forceinline__ float xhalf_max(float x) { auto rr = __builtin_amdgcn_permlane32_swap(__float_as_uint(x), __float_as_uint(x), false, false); return fmaxf(__uint_as_float(rr[0]), __uint_as_float(rr[1])); }
__device__ __forceinline__ float xhalf_sum(float x) { auto rr = __builtin_amdgcn_permlane32_swap(__float_as_uint(x), __float_as_uint(x), false, false); return __uint_as_float(rr[0]) + __uint_as_float(rr[1]); }
template <int BR>
__device__ __forceinline__ float tile_prep(int MODE, f32x16& S, LAS const float* tb, float cb, int base, bool selbit) {
    float mx = -INFINITY;
    if (MODE == 1) {
#pragma unroll
        for (int r = 0; r < 16; ++r) mx = fmaxf(mx, S[r]);
        mx = (BR == 2 && !selbit) ? -INFINITY : mx + cb;
    } else {
        const bool nomask = (MODE == 2);
        float bv[16];
#pragma unroll
        for (int r = 0; r < 16; ++r) { const int cr = (r & 3) + 8 * (r >> 2); const int dist = (BR <= 1) ? base - 16 * cr : base - cr; bv[r] = tb[min(max(dist, 0), TBN - 1)]; }
        __builtin_amdgcn_sched_barrier(0);
#pragma unroll
        for (int r = 0; r < 16; ++r) {
            const int cr = (r & 3) + 8 * (r >> 2);
            const int dist = (BR <= 1) ? base - 16 * cr : base - cr;
            float v = S[r] + bv[r];
            bool valid;
            if (BR <= 1) valid = dist >= 0; else if (BR == 2) valid = selbit && dist >= 0; else valid = nomask || (unsigned)dist < 512u;
            v = valid ? v : -INFINITY;
            S[r] = v; mx = fmaxf(mx, v);
        }
    }
    return mx;
}
template <int BR, bool PEND>
__device__ __forceinline__ float tile_decide(int MODE, float mx, float cb, bool selbit, f32x16 (&O)[4], float& m, float& l, u32x4& pa, u32x4& pb) {
    if (BR == 1) { const float mu = (m == -INFINITY) ? 0.f : m; return (MODE == 1) ? mu - cb : mu; }
    mx = xhalf_max(mx);
    const float mn = fmaxf(m, mx), mu = (mn == -INFINITY) ? 0.f : mn;
    if (__any(mn > m)) {
        const float alpha = fexp2(m - mu);
        l *= alpha;
        if (BR >= 2) {
#pragma unroll
            for (int dt = 0; dt < 4; ++dt)
#pragma unroll
                for (int r = 0; r < 16; ++r) O[dt][r] *= alpha;
            if (PEND) {
#pragma unroll
                for (int e = 0; e < 4; ++e) { pa[e] = cvt_pk_bf16(bflo(pa[e]) * alpha, bfhi(pa[e]) * alpha); pb[e] = cvt_pk_bf16(bflo(pb[e]) * alpha, bfhi(pb[e]) * alpha); }
            }
        }
    }
    m = mn;
    if (MODE == 1) return (BR == 2 && !selbit) ? INFINITY : mu - cb;
    return mu;
}
template <int BR, int KEYS>
__device__ __forceinline__ void attn_tile(int MODE, LAS const unsigned char* kb, LAS const unsigned char* vb, int cb0, LAS const float* tb, int key0, int t, int lane,
                                          const bf16x8 (&qf)[8], f32x16 (&O)[4], float& m, float& l, float inv_l, bool selbit, LAS float* imp_row) {
    asm volatile("" : "+v"(lane));
    constexpr int ROWB = 2 * KEYS;
    const int r31 = lane & 31, h = lane >> 5;
    const int gh = kswz(r31) ^ h, vh = vsw<KEYS>(r31) ^ h;
    float cb = 0.f;
    if (MODE == 1) cb = tb[TBN - 1];
    const int base0 = (BR <= 1) ? t - 31 - 16 * (key0 + 4 * h) : t - (key0 + 4 * h);
    const int base1 = (BR <= 1) ? base0 - 16 * 32 : base0 - 32;
    LAS const unsigned char* k0 = kb + r31 * 256;
    f32x16 S0, S1;
    bf16x8 kf[8];
#pragma unroll
    for (int ks = 0; ks < 8; ++ks) kf[ks] = *(const LAS bf16x8*)(k0 + 16 * ((2 * ks) ^ gh));
#pragma unroll
    for (int r = 0; r < 16; ++r) { S0[r] = 0.f; S1[r] = 0.f; }
    __builtin_amdgcn_sched_barrier(0);
#pragma unroll
    for (int ks = 0; ks < 8; ++ks) S0 = mfma32(kf[ks], qf[ks], S0);
    __builtin_amdgcn_sched_barrier(0);
#pragma unroll
    for (int ks = 0; ks < 8; ++ks) kf[ks] = *(const LAS bf16x8*)(k0 + 8192 + 16 * ((2 * ks) ^ gh));
    const float mx0 = tile_prep<BR>(MODE, S0, tb, cb, base0, selbit);
    u32x4 pk0a = {0u, 0u, 0u, 0u}, pk0b = {0u, 0u, 0u, 0u}, pk1a, pk1b;
    const float me0 = tile_decide<BR, false>(MODE, mx0, cb, selbit, O, m, l, pk0a, pk0b);
    __builtin_amdgcn_sched_barrier(0);
    {
#pragma unroll
        for (int ks = 0; ks < 8; ++ks) S1 = mfma32(kf[ks], qf[ks], S1);
        float ps = 0.f;
#pragma unroll
        for (int r = 0; r < 16; ++r) { float p = fexp2(S0[r] - me0); if (BR == 1) p *= inv_l; S0[r] = p; ps += p; }
        if (BR != 1) l += ps;
        if (BR >= 1) {
#pragma unroll
            for (int e = 0; e < 4; ++e) { pk0a[e] = cvt_pk_bf16(S0[2 * e], S0[2 * e + 1]); pk0b[e] = cvt_pk_bf16(S0[8 + 2 * e], S0[8 + 2 * e + 1]); }
        }
#pragma unroll
        for (int i = 0; i < 8; ++i) { __builtin_amdgcn_sched_group_barrier(0x008, 1, 0); __builtin_amdgcn_sched_group_barrier(0x002, 8, 0); }
    }
    __builtin_amdgcn_sched_barrier(0);
    if (BR == 1) {
#pragma unroll
        for (int rg = 0; rg < 4; ++rg) {
            float A = 2.f * (S0[4 * rg] + S0[4 * rg + 1] + S0[4 * rg + 2]) + S0[4 * rg + 3], B = S0[4 * rg + 3];
            A = quad_sum(A); B = quad_sum(B);
            const int jj = (key0 >> 2) + 2 * rg + h;
            if ((lane & 3) == 0) { __hip_atomic_fetch_add(imp_row + jj, A, __ATOMIC_RELAXED, __HIP_MEMORY_SCOPE_WORKGROUP);
                if (jj + 1 < 256) __hip_atomic_fetch_add(imp_row + jj + 1, B, __ATOMIC_RELAXED, __HIP_MEMORY_SCOPE_WORKGROUP); }
        }
    }
    bf16x8 av[8];
    if (BR >= 1) {
#pragma unroll
        for (int s = 0; s < 2; ++s)
#pragma unroll
            for (int dt = 0; dt < 4; ++dt) av[s * 4 + dt] = *(const LAS bf16x8*)(vb + (32 * dt + r31) * ROWB + 16 * ((cb0 + 2 * s) ^ vh));
    }
    const float mx1 = tile_prep<BR>(MODE, S1, tb, cb, base1, selbit);
    const float me1 = tile_decide<BR, true>(MODE, mx1, cb, selbit, O, m, l, pk0a, pk0b);
    __builtin_amdgcn_sched_barrier(0);
    {
        if (BR >= 1) {
#pragma unroll
            for (int dt = 0; dt < 4; ++dt) O[dt] = mfma32(av[dt], __builtin_bit_cast(bf16x8, pk0a), O[dt]);
#pragma unroll
            for (int dt = 0; dt < 4; ++dt) O[dt] = mfma32(av[4 + dt], __builtin_bit_cast(bf16x8, pk0b), O[dt]);
        }
        float ps = 0.f;
#pragma unroll
        for (int r = 0; r < 16; ++r) { float p = fexp2(S1[r] - me1); if (BR == 1) p *= inv_l; S1[r] = p; ps += p; }
        if (BR != 1) l += ps;
        if (BR >= 1) {
#pragma unroll
            for (int e = 0; e < 4; ++e) { pk1a[e] = cvt_pk_bf16(S1[2 * e], S1[2 * e + 1]); pk1b[e] = cvt_pk_bf16(S1[8 + 2 * e], S1[8 + 2 * e + 1]); }
#pragma unroll
            for (int i = 0; i < 8; ++i) { __builtin_amdgcn_sched_group_barrier(0x008, 1, 0); __builtin_amdgcn_sched_group_barrier(0x002, 8, 0); }
        }
    }
    __builtin_amdgcn_sched_barrier(0);
    if (BR == 1) {
#pragma unroll
        for (int rg = 0; rg < 4; ++rg) {
            float A = 2.f * (S1[4 * rg] + S1[4 * rg + 1] + S1[4 * rg + 2]) + S1[4 * rg + 3], B = S1[4 * rg + 3];
            A = quad_sum(A); B = quad_sum(B);
            const int jj = ((key0 + 32) >> 2) + 2 * rg + h;
            if ((lane & 3) == 0) { __hip_atomic_fetch_add(imp_row + jj, A, __ATOMIC_RELAXED, __HIP_MEMORY_SCOPE_WORKGROUP);
                if (jj + 1 < 256) __hip_atomic_fetch_add(imp_row + jj + 1, B, __ATOMIC_RELAXED, __HIP_MEMORY_SCOPE_WORKGROUP); }
        }
    }
    if (BR >= 1) {
#pragma unroll
        for (int s = 0; s < 2; ++s)
#pragma unroll
            for (int dt = 0; dt < 4; ++dt) av[s * 4 + dt] = *(const LAS bf16x8*)(vb + (32 * dt + r31) * ROWB + 16 * ((cb0 + 4 + 2 * s) ^ vh));
        __builtin_amdgcn_sched_barrier(0);
#pragma unroll
        for (int dt = 0; dt < 4; ++dt) O[dt] = mfma32(av[dt], __builtin_bit_cast(bf16x8, pk1a), O[dt]);
#pragma unroll
        for (int dt = 0; dt < 4; ++dt) O[dt] = mfma32(av[4 + dt], __builtin_bit_cast(bf16x8, pk1b), O[dt]);
    }
}
template <int BR, int KEYS>
__device__ __forceinline__ void run_branch(const Ctx& c, const bf16_t* Kb, const bf16_t* Vtb, int ldv, int lo, int hi, LAS const float* tb, int t, int t0,
                                           const bf16x8 (&qf)[8], f32x16 (&O)[4], float& m, float& l, float inv_l, int tl, LAS float* imp_row) {
    constexpr bool NEEDV = (BR != 0);
    constexpr int BPS = KEYS / 64, KSTG = KEYS * 256, VSTG = 128 * 2 * KEYS, VB0 = 2 * KSTG;
    LAS unsigned char* lds = c.lds;
    int lz = c.lane; asm volatile("" : "+v"(lz));
    const int nst = (hi - lo + BPS - 1) / BPS;
#define STG_BLK(i) ((lo + BPS * (i) + BPS - 1 < hi) ? lo + BPS * (i) : hi - BPS)
    asm volatile("s_waitcnt vmcnt(0)" ::: "memory");
    { const int b0 = (BPS == 2 && hi - lo < 2) ? lo : STG_BLK(0);
      stage_dma<KEYS, NEEDV>(Kb + (size_t)b0 * 64 * 128, Vtb + (size_t)b0 * 64, ldv, lds, lds + VB0, c.wave, lz); }
    asm volatile("s_waitcnt vmcnt(0)" ::: "memory");
    __syncthreads();
    const int qt = t0 >> 6;
    for (int i = 0; i < nst; ++i) {
        const int buf = i & 1;
        if (i + 1 < nst) { int lz2 = lz; asm volatile("" : "+v"(lz2));
            const int b1 = STG_BLK(i + 1);
            stage_dma<KEYS, NEEDV>(Kb + (size_t)b1 * 64 * 128, Vtb + (size_t)b1 * 64, ldv, lds + (buf ^ 1) * KSTG, lds + VB0 + (buf ^ 1) * VSTG, c.wave, lz2); }
        const int sb = (BPS == 2 && hi - lo < 2) ? lo : STG_BLK(i);
#pragma unroll
        for (int q = 0; q < BPS; ++q) {
            const int j = lo + BPS * i + q;
            if (j < hi) {
                bool selbit = true, wave_on = true;
                if (BR == 2) {
                    const unsigned w = *(const LAS unsigned*)(lds + AT_BM + (tl * 8 + (j >> 5)) * 4);
                    selbit = (w >> (j & 31)) & 1u;
                    const unsigned wu = *(const LAS unsigned*)(lds + AT_WU + (c.wave * 8 + (j >> 5)) * 4);
                    wave_on = (wu >> (j & 31)) & 1u;
                }
                if (wave_on) {
                    int mode = 0;
                    if (BR <= 1) mode = (1024 * j + 1829 <= t0) ? 1 : 0;
                    else if (BR == 2) mode = (64 * j + 853 <= t0) ? 1 : 0;
                    else mode = (j >= qt - 7 && j <= qt - 1) ? 2 : 0;
                    const int slot = j - sb;
                    attn_tile<BR, KEYS>(mode, lds + buf * KSTG + slot * 16384, lds + VB0 + buf * VSTG, 8 * slot, tb, j * 64, t, c.lane, qf, O, m, l, inv_l, selbit, imp_row);
                }
            }
        }
        asm volatile("s_waitcnt vmcnt(0)" ::: "memory");
        __syncthreads();
    }
#undef STG_BLK
}
__device__ __forceinline__ void attn_item(const Args& a, const Ctx& c_, int qt, int g) {
    Ctx c = c_; { int tz = c_.tid; asm volatile("" : "+v"(tz)); c.tid = tz; c.lane = tz & 63; }
    LAS unsigned char* lds = c.lds;
    const int tid = c.tid, wave = c.wave, lane = c.lane, r31 = lane & 31, h = lane >> 5, hl = lane & 3;
    const int t0 = qt * 64, tl = 8 * wave + (r31 >> 2), t = t0 + tl, head = g * 4 + hl;
    const bf16_t* Qb = (const bf16_t*)(a.ws + WS_Q);
    const bf16_t* KROW = (const bf16_t*)(a.ws + WS_KROW);
    const bf16_t* VT = (const bf16_t*)(a.ws + WS_VT);
    const float* GATE = (const float*)(a.ws + WS_GATE);
    { const float* tbg = (const float*)(a.ws + WS_TB) + g * 4 * TBN;
      for (int i = tid; i < 4 * TBN; i += NTHREADS) *(LAS float*)(lds + AT_TB + i * 4) = tbg[i];
      for (int i = tid; i < 64 * 256; i += NTHREADS) *(LAS float*)(lds + AT_IMP + i * 4) = 0.f; }
    bf16x8 qf[8];
#pragma unroll
    for (int ks = 0; ks < 8; ++ks) qf[ks] = *(const bf16x8*)(Qb + (size_t)t * 1024 + head * 128 + 16 * ks + 8 * h);
    LAS const float* tb = (LAS const float*)(lds + AT_TB) + hl * TBN;
    LAS float* imp_row = (LAS float*)(lds + AT_IMP) + tl * 256;
    bf16_t* Y = (bf16_t*)(a.ws + WS_YATT) + (size_t)t * 1024 + head * 128 + 4 * h;
    f32x16 O[4];
#pragma unroll
    for (int dt = 0; dt < 4; ++dt)
#pragma unroll
        for (int r = 0; r < 16; ++r) O[dt][r] = 0.f;
    __syncthreads();
    { const int ntile = (t0 / 16 + 3 + 63) / 64;
      const bf16_t* KC = (const bf16_t*)(a.ws + WS_KC) + (size_t)g * 1024 * 128; const bf16_t* VCT = (const bf16_t*)(a.ws + WS_VCT) + (size_t)g * 128 * 1024;
      float m = -INFINITY, l = 0.f;
#if defined(PROBE_CMP)
      run_branch<0, 64>(c, KC, VCT, 1024, 0, ntile, tb, t, t0, qf, O, m, l, 0.f, tl, imp_row);
      asm volatile("" :: "v"(m), "v"(l));
      m = -INFINITY; l = 0.f;
#endif
      run_branch<0, 64>(c, KC, VCT, 1024, 0, ntile, tb, t, t0, qf, O, m, l, 0.f, tl, imp_row);
      const float lt = xhalf_sum(l), inv = lt > 0.f ? 1.f / lt : 0.f;
      run_branch<1, 64>(c, KC, VCT, 1024, 0, ntile, tb, t, t0, qf, O, m, l, inv, tl, imp_row);
      const float gc = GATE[(size_t)t * 24 + head];
#pragma unroll
      for (int dt = 0; dt < 4; ++dt)
#pragma unroll
          for (int rg = 0; rg < 4; ++rg) {
              u32x2 w; w[0] = cvt_pk_bf16(gc * O[dt][4 * rg], gc * O[dt][4 * rg + 1]); w[1] = cvt_pk_bf16(gc * O[dt][4 * rg + 2], gc * O[dt][4 * rg + 3]);
              *(u32x2*)(Y + 32 * dt + 8 * rg) = w;
#pragma unroll
              for (int e = 0; e < 4; ++e) O[dt][4 * rg + e] = 0.f;
          }
    }
    {
        const int ncand = qt - 2 > 0 ? qt - 2 : 0;
        unsigned v[8][4], selm[8];
#pragma unroll
        for (int i = 0; i < 8; ++i) {
            LAS const float* row = (LAS const float*)(lds + AT_IMP) + (8 * wave + i) * 256;
            selm[i] = 0u;
#pragma unroll
            for (int k = 0; k < 4; ++k) { const int j = lane + 64 * k; const bool cand = (j >= 1 && j <= qt - 2);
                v[i][k] = cand ? ((__float_as_uint(row[j]) & ~0xFFu) | (unsigned)(255 - j)) : 0u; if (ncand <= 13 && cand) selm[i] |= 1u << k; }
        }
        if (ncand > 13) {
            for (int it = 0; it < 13; ++it) {
#pragma unroll
                for (int i = 0; i < 8; ++i) {
                    const unsigned mx = wave_umax_bcast(max(max(v[i][0], v[i][1]), max(v[i][2], v[i][3])));
#pragma unroll
                    for (int k = 0; k < 4; ++k) if (v[i][k] == mx) { v[i][k] = 0u; selm[i] |= 1u << k; }
                }
            }
        }
        unsigned wu[8];
#pragma unroll
        for (int k = 0; k < 8; ++k) wu[k] = 0u;
#pragma unroll
        for (int i = 0; i < 8; ++i)
#pragma unroll
            for (int k = 0; k < 4; ++k) {
                const int j = lane + 64 * k; const bool forced = (j == 0) || (j == qt) || (j == qt - 1);
                const unsigned long long mk = __ballot(((selm[i] >> k) & 1u) || forced);
                const unsigned lo = (unsigned)mk, hi = (unsigned)(mk >> 32);
                if (lane == 0) { *(LAS unsigned*)(lds + AT_BM + ((8 * wave + i) * 8 + 2 * k) * 4) = lo; *(LAS unsigned*)(lds + AT_BM + ((8 * wave + i) * 8 + 2 * k + 1) * 4) = hi; }
                wu[2 * k] |= lo; wu[2 * k + 1] |= hi;
            }
        if (lane == 0) {
#pragma unroll
            for (int k = 0; k < 8; ++k) *(LAS unsigned*)(lds + AT_WU + (wave * 8 + k) * 4) = wu[k];
        }
    }
    __syncthreads();
#if defined(PROBE_SEL)
    { float m = -INFINITY, l = 0.f;
      run_branch<2, 128>(c, KROW + (size_t)(2 + g) * L_ * 128, VT + (size_t)g * 128 * L_, L_, 0, qt + 1, tb, t, t0, qf, O, m, l, 0.f, tl, imp_row);
      asm volatile("" :: "v"(O[0]), "v"(O[1]), "v"(O[2]), "v"(O[3]), "v"(m), "v"(l));
#pragma unroll
      for (int dt = 0; dt < 4; ++dt)
#pragma unroll
          for (int r = 0; r < 16; ++r) O[dt][r] = 0.f; }
#endif
    { float m = -INFINITY, l = 0.f;
      run_branch<2, 128>(c, KROW + (size_t)(2 + g) * L_ * 128, VT + (size_t)g * 128 * L_, L_, 0, qt + 1, tb, t, t0, qf, O, m, l, 0.f, tl, imp_row);
      const float gs = GATE[(size_t)t * 24 + 8 + head];
      const float lt = xhalf_sum(l), sc = gs * (lt > 0.f ? 1.f / lt : 0.f);
#pragma unroll
      for (int dt = 0; dt < 4; ++dt)
#pragma unroll
          for (int rg = 0; rg < 4; ++rg) {
              const u32x2 w0 = *(const u32x2*)(Y + 32 * dt + 8 * rg);
              u32x2 w; w[0] = cvt_pk_bf16(bflo(w0[0]) + sc * O[dt][4 * rg], bfhi(w0[0]) + sc * O[dt][4 * rg + 1]); w[1] = cvt_pk_bf16(bflo(w0[1]) + sc * O[dt][4 * rg + 2], bfhi(w0[1]) + sc * O[dt][4 * rg + 3]);
              *(u32x2*)(Y + 32 * dt + 8 * rg) = w;
#pragma unroll
              for (int e = 0; e < 4; ++e) O[dt][4 * rg + e] = 0.f;
          }
    }
#if defined(PROBE_WIN)
    { float m = -INFINITY, l = 0.f;
      const int lo = qt - 8 > 0 ? qt - 8 : 0;
      run_branch<3, 128>(c, KROW + (size_t)(4 + g) * L_ * 128, VT + (size_t)(2 + g) * 128 * L_, L_, lo, qt + 1, tb, t, t0, qf, O, m, l, 0.f, tl, imp_row);
      asm volatile("" :: "v"(O[0]), "v"(O[1]), "v"(O[2]), "v"(O[3]), "v"(m), "v"(l));
#pragma unroll
      for (int dt = 0; dt < 4; ++dt)
#pragma unroll
          for (int r = 0; r < 16; ++r) O[dt][r] = 0.f; }
#endif
    { float m = -INFINITY, l = 0.f;
      const int lo = qt - 8 > 0 ? qt - 8 : 0;
      run_branch<3, 128>(c, KROW + (size_t)(4 + g) * L_ * 128, VT + (size_t)(2 + g) * 128 * L_, L_, lo, qt + 1, tb, t, t0, qf, O, m, l, 0.f, tl, imp_row);
      const float gw = GATE[(size_t)t * 24 + 16 + head];
      const float lt = xhalf_sum(l), sc = gw * (lt > 0.f ? 1.f / lt : 0.f);
#pragma unroll
      for (int dt = 0; dt < 4; ++dt)
#pragma unroll
          for (int rg = 0; rg < 4; ++rg) {
              const u32x2 w0 = *(const u32x2*)(Y + 32 * dt + 8 * rg);
              u32x2 w; w[0] = cvt_pk_bf16(bflo(w0[0]) + sc * O[dt][4 * rg], bfhi(w0[0]) + sc * O[dt][4 * rg + 1]); w[1] = cvt_pk_bf16(bflo(w0[1]) + sc * O[dt][4 * rg + 2], bfhi(w0[1]) + sc * O[dt][4 * rg + 3]);
              *(u32x2*)(Y + 32 * dt + 8 * rg) = w;
          }
    }
    __syncthreads();
}
#ifndef PEER_ALPHA
#define PEER_ALPHA 1.0f
#endif
constexpr int PE_SC = 0, PE_LV = 65536, PE_LI = 73728, PE_PK = 81920, PE_EX = 147456, PE_GT = 151552, PE_SU = 155648, PE_END = 159744;
constexpr int PE_SLOT = 2048, PE_NSLOT = 8, PE_RINGW = PE_SLOT * 9;
static_assert(8 * PE_RINGW <= PE_EX && PE_END <= LDS_BYTES - 16, "PEER LDS map");
__device__ __forceinline__ float wave_sum_bcast(float v) {
    v += dpp_f<0xB1>(v); v += dpp_f<0x4E>(v); v += dpp_f<0x141>(v); v += dpp_f<0x140>(v);
    v += __int_as_float(__builtin_amdgcn_update_dpp(0, __float_as_int(v), 0x142, 0xa, 0xf, false));
    v += __int_as_float(__builtin_amdgcn_update_dpp(0, __float_as_int(v), 0x143, 0xc, 0xf, false));
    return __int_as_float(__builtin_amdgcn_readlane(__float_as_int(v), 63));
}
__device__ __forceinline__ unsigned mono_key(float v) { const unsigned b = __float_as_uint(v); return b ^ ((b >> 31) ? 0xFFFFFFFFu : 0x80000000u); }
template <int CTRL>
__device__ __forceinline__ void quad_merge16(unsigned (&t)[16]) {
    unsigned o[16];
#pragma unroll
    for (int i = 0; i < 16; ++i) o[i] = (unsigned)__builtin_amdgcn_update_dpp(0, (int)t[15 - i], CTRL, 0xf, 0xf, false);
#pragma unroll
    for (int i = 0; i < 16; ++i) t[i] = max(t[i], o[i]);
#pragma unroll
    for (int st = 8; st >= 1; st >>= 1)
#pragma unroll
        for (int i = 0; i < 16; ++i) if ((i & st) == 0) { const unsigned hi = max(t[i], t[i + st]), lo = min(t[i], t[i + st]); t[i] = hi; t[i + st] = lo; }
}
__device__ __forceinline__ int pair_a(int p) { return p < 16 ? 0 : p < 24 ? 1 : p < 29 ? 2 : p < 33 ? 3 : p < 36 ? 4 : p < 38 ? 5 : p < 40 ? 6 : p < 42 ? 7 : p - 34; }
__device__ __forceinline__ int pair_b(int p) { return p < 16 ? p : p < 24 ? p - 16 : p < 29 ? p - 24 : p < 33 ? p - 29 : p < 36 ? p - 33 : p < 38 ? p - 36 : p < 40 ? p - 38 : p < 42 ? p - 40 : 0; }
template <bool DRY>
__device__ __forceinline__ void peer_step(const Args& a, const Ctx& c_, int t0) {
    Ctx c = c_; { int tz = c_.tid; asm volatile("" : "+v"(tz)); c.tid = tz; c.lane = tz & 63; }
    LAS unsigned char* lds = c.lds;
    const int tid = c.tid, wave = c.wave, lane = c.lane, r = lane & 15, q = lane >> 4;
    const bf16_t* QP = (const bf16_t*)(a.ws + WS_QP); const bf16_t* PK = (const bf16_t*)(a.ws + WS_PK);
    const unsigned char* PU = a.ws + WS_PU; const unsigned char* PV = a.ws + WS_PV; const float* psc = (const float*)(a.ws + WS_PSC);
    const bf16_t* HB = (const bf16_t*)(a.ws + WS_H);
    const int t = t0 + wave;
    u32x4 hraw[4]; u32x2 xw[8];
#pragma unroll
    for (int k = 0; k < 4; ++k) hraw[k] = *(const u32x4*)(HB + (size_t)t * 2048 + lane * 32 + k * 8);
#pragma unroll
    for (int k = 0; k < 8; ++k) xw[k] = *(const u32x2*)((const bf16_t*)(a.ws + WS_X1) + (size_t)t * 2048 + lane * 32 + k * 4);
    {
#pragma unroll
        for (int i = 0; i < 8; ++i) { const int pc = 8 * wave + i, row = 4 * pc + (lane >> 4), ch = (lane & 15) ^ kswz(row);
            __builtin_amdgcn_global_load_lds((const unsigned*)(PK + (size_t)row * 128 + ch * 8), (LAS unsigned*)(lds + PE_PK + pc * 1024), 16, 0, 0); }
        const int hh = wave;
        bf16x8 aF[2][4];
#pragma unroll
        for (int cc = 0; cc < 2; ++cc)
#pragma unroll
            for (int ks = 0; ks < 4; ++ks) aF[cc][ks] = *(const bf16x8*)(QP + (size_t)(t0 + (r & 7)) * 2048 + hh * 256 + cc * 128 + 32 * ks + 8 * q);
        asm volatile("s_waitcnt vmcnt(0)" ::: "memory");
        __syncthreads();
        const int ksw = kswz(r);
#pragma unroll
        for (int cc = 0; cc < 2; ++cc)
#pragma unroll 2
            for (int nt = 0; nt < 8; ++nt) {
                f32x4 acc = {0.f, 0.f, 0.f, 0.f};
#pragma unroll
                for (int ks = 0; ks < 4; ++ks) { const bf16x8 B = *(const LAS bf16x8*)(lds + PE_PK + (cc * 128 + 16 * nt + r) * 256 + 16 * ((4 * ks + q) ^ ksw)); acc = mfma16(aF[cc][ks], B, acc); }
                if (q < 2) {
#pragma unroll
                    for (int i = 0; i < 4; ++i) { const int task = (4 * q + i) * 16 + hh * 2 + cc; *(LAS float*)(lds + PE_SC + (task * 128 + ((16 * nt + r + task) & 127)) * 4) = acc[i]; }
                }
            }
    }
    __syncthreads();
    {
        const int task = tid >> 2, part = tid & 3;
        LAS const float* sc = (LAS const float*)(lds + PE_SC) + task * 128;
        float vals[32];
#pragma unroll
        for (int k = 0; k < 32; ++k) vals[k] = sc[(32 * part + k + task) & 127];
        unsigned top[16];
#pragma unroll
        for (int e = 0; e < 16; ++e) top[e] = 0u;
#pragma unroll
        for (int k = 0; k < 32; ++k) {
            unsigned key = (mono_key(vals[k]) & ~0x7Fu) | (unsigned)(127 - (32 * part + k));
#pragma unroll
            for (int e = 0; e < 16; ++e) { const unsigned hi = max(top[e], key); key = min(top[e], key); top[e] = hi; }
        }
        quad_merge16<0xB1>(top);
        quad_merge16<0x4E>(top);
        if (part == 0) {
#pragma unroll
            for (int e = 0; e < 16; ++e) { const int idx = 127 - (int)(top[e] & 0x7Fu); *(LAS float*)(lds + PE_LV + (task * 16 + e) * 4) = sc[(idx + task) & 127]; *(LAS int*)(lds + PE_LI + (task * 16 + e) * 4) = idx; }
        }
    }
    __syncthreads();
    if (tid < 256) {
        const int task = tid >> 2, part = tid & 3, tok = task >> 3, hh = task & 7, t1 = tok * 16 + hh * 2, t2 = t1 + 1;
        LAS const float* lv1 = (LAS const float*)(lds + PE_LV) + t1 * 16; LAS const float* lv2 = (LAS const float*)(lds + PE_LV) + t2 * 16;
        unsigned top[16];
#pragma unroll
        for (int e = 0; e < 16; ++e) top[e] = 0u;
        for (int p = part; p < 50; p += 4) {
            const int aa = pair_a(p), bb = pair_b(p);
            unsigned key = (mono_key(lv1[aa] + lv2[bb]) & ~0xFFu) | (unsigned)(255 - (aa * 16 + bb));
#pragma unroll
            for (int e = 0; e < 16; ++e) { const unsigned hi = max(top[e], key); key = min(top[e], key); top[e] = hi; }
        }
        quad_merge16<0xB1>(top);
        quad_merge16<0x4E>(top);
        if (part == 0) {
            LAS const int* li1 = (LAS const int*)(lds + PE_LI) + t1 * 16; LAS const int* li2 = (LAS const int*)(lds + PE_LI) + t2 * 16;
            float sv[16]; int ex[16]; float mx = -INFINITY;
#pragma unroll
            for (int e = 0; e < 16; ++e) {
                const int id = 255 - (int)(top[e] & 0xFFu), aa = id >> 4, bb = id & 15;
                sv[e] = lv1[aa] + lv2[bb]; ex[e] = li1[aa] * 128 + li2[bb]; mx = fmaxf(mx, sv[e]);
            }
            float sum = 0.f;
#pragma unroll
            for (int e = 0; e < 16; ++e) { sv[e] = fexp2((sv[e] - mx) * LOG2E); sum += sv[e]; }
            const float inv = 1.f / sum;
#pragma unroll
            for (int e = 0; e < 16; ++e) { *(LAS int*)(lds + PE_EX + (tok * 128 + hh * 16 + e) * 4) = ex[e];
                *(LAS float*)(lds + PE_GT + (tok * 128 + hh * 16 + e) * 4) = sv[e] * inv * psc[16384 + ex[e]];
                *(LAS float*)(lds + PE_SU + (tok * 128 + hh * 16 + e) * 4) = psc[ex[e]]; }
        }
    }
    __syncthreads();
    float hp[32];
#pragma unroll
    for (int k = 0; k < 4; ++k)
#pragma unroll
        for (int e = 0; e < 4; ++e) { hp[k * 8 + 2 * e] = bflo(hraw[k][e]); hp[k * 8 + 2 * e + 1] = bfhi(hraw[k][e]); }
    float acc[32];
#pragma unroll
    for (int e = 0; e < 32; ++e) acc[e] = 0.f;
    asm volatile("s_waitcnt vmcnt(0)" ::: "memory");
    {
        LAS const int* exl = (LAS const int*)(lds + PE_EX) + wave * 128; LAS const float* gtl = (LAS const float*)(lds + PE_GT) + wave * 128;
        LAS const float* sul = (LAS const float*)(lds + PE_SU) + wave * 128;
        LAS unsigned char* ring = lds + wave * PE_RINGW;
#define ROW_ISSUE(SL, IDX) do { const int ex_ = __builtin_amdgcn_readfirstlane(exl[IDX]); \
            LAS unsigned char* sl_ = ring + (SL) * PE_SLOT; \
            __builtin_amdgcn_global_load_lds((const unsigned*)(PU + (size_t)ex_ * 1024 + lane * 16), (LAS unsigned*)sl_, 16, 0, 0); \
            __builtin_amdgcn_global_load_lds((const unsigned*)(PV + (size_t)ex_ * 1024 + lane * 16), (LAS unsigned*)(sl_ + 1024), 16, 0, 0); \
            } while (0)
#define UDOT(UW, D0, D1) do { _Pragma("unroll") for (int dw = 0; dw < 4; ++dw) { const f32x2 f0_ = fp4_unpk<0>(UW[dw]), f1_ = fp4_unpk<1>(UW[dw]), f2_ = fp4_unpk<2>(UW[dw]), f3_ = fp4_unpk<3>(UW[dw]); \
                D0 += f0_[0] * hp[8 * dw] + f1_[0] * hp[8 * dw + 2] + f2_[0] * hp[8 * dw + 4] + f3_[0] * hp[8 * dw + 6]; \
                D1 += f0_[1] * hp[8 * dw + 1] + f1_[1] * hp[8 * dw + 3] + f2_[1] * hp[8 * dw + 5] + f3_[1] * hp[8 * dw + 7]; } } while (0)
#define VACC(VW, WG) do { _Pragma("unroll") for (int dw = 0; dw < 4; ++dw) { const f32x2 f0_ = fp4_unpk<0>(VW[dw]), f1_ = fp4_unpk<1>(VW[dw]), f2_ = fp4_unpk<2>(VW[dw]), f3_ = fp4_unpk<3>(VW[dw]); \
                acc[8 * dw] += WG * f0_[0]; acc[8 * dw + 1] += WG * f0_[1]; acc[8 * dw + 2] += WG * f1_[0]; acc[8 * dw + 3] += WG * f1_[1]; \
                acc[8 * dw + 4] += WG * f2_[0]; acc[8 * dw + 5] += WG * f2_[1]; acc[8 * dw + 6] += WG * f3_[0]; acc[8 * dw + 7] += WG * f3_[1]; } } while (0)
#define PAIR_APPLY(SA, SB, IDX) do { LAS const unsigned char* pa_ = ring + (SA) * PE_SLOT + lane * 16; LAS const unsigned char* pb_ = ring + (SB) * PE_SLOT + lane * 16; \
            const u32x4 ua_ = *(const LAS u32x4*)pa_, ub_ = *(const LAS u32x4*)pb_, va_ = *(const LAS u32x4*)(pa_ + 1024), vb_ = *(const LAS u32x4*)(pb_ + 1024); \
            float a0_ = 0.f, a1_ = 0.f, b0_ = 0.f, b1_ = 0.f; \
            UDOT(ua_, a0_, a1_); UDOT(ub_, b0_, b1_); \
            const float da_ = wave_sum_bcast(a0_ + a1_) * sul[IDX], db_ = wave_sum_bcast(b0_ + b1_) * sul[(IDX) + 1]; \
            const float wa_ = gtl[IDX] * gelu_tanh(da_), wb_ = gtl[(IDX) + 1] * gelu_tanh(db_); \
            VACC(va_, wa_); VACC(vb_, wb_); \
            asm volatile("s_waitcnt lgkmcnt(0)" ::: "memory"); } while (0)
#define DMA_WAIT(N) asm volatile("s_waitcnt vmcnt(" #N ")" ::: "memory")
        ROW_ISSUE(0, 0); ROW_ISSUE(1, 1); ROW_ISSUE(2, 2); ROW_ISSUE(3, 3); ROW_ISSUE(4, 4); ROW_ISSUE(5, 5); ROW_ISSUE(6, 6); ROW_ISSUE(7, 7);
#pragma unroll 1
        for (int e = 0; e < 128; e += 8) {
            const bool more = e + 8 < 128;
            DMA_WAIT(12); PAIR_APPLY(0, 1, e);     if (more) { ROW_ISSUE(0, e + 8);  ROW_ISSUE(1, e + 9); }
            if (more) DMA_WAIT(12); else DMA_WAIT(0);
            PAIR_APPLY(2, 3, e + 2); if (more) { ROW_ISSUE(2, e + 10); ROW_ISSUE(3, e + 11); }
            if (more) DMA_WAIT(12);
            PAIR_APPLY(4, 5, e + 4); if (more) { ROW_ISSUE(4, e + 12); ROW_ISSUE(5, e + 13); }
            if (more) DMA_WAIT(12);
            PAIR_APPLY(6, 7, e + 6); if (more) { ROW_ISSUE(6, e + 14); ROW_ISSUE(7, e + 15); }
        }
#undef ROW_ISSUE
#undef PAIR_APPLY
#undef UDOT
#undef VACC
#undef DMA_WAIT
    }
    {
        float* xo = a.out + (size_t)t * 2048; const float* g2 = (const float*)(a.ws + WS_COND) + 5 * 2048; const float* fg = a.in[32];
        f32x4 gvv[8], fvv[8];
#pragma unroll
        for (int k = 0; k < 8; ++k) { const int col = lane * 32 + k * 4; gvv[k] = *(const f32x4*)(g2 + col); fvv[k] = *(const f32x4*)(fg + col); }
        float ss = 0.f;
#pragma unroll
        for (int k = 0; k < 8; ++k) {
            const float x1[4] = {bflo(xw[k][0]), bfhi(xw[k][0]), bflo(xw[k][1]), bfhi(xw[k][1])};
#pragma unroll
            for (int e = 0; e < 4; ++e) { const float x2 = x1[e] + PEER_ALPHA * gvv[k][e] * acc[k * 4 + e]; acc[k * 4 + e] = x2; ss += x2 * x2; }
        }
        ss = wave_sum_bcast(ss);
        const float rstd = rsqrtf(ss * (1.f / 2048.f) + 1e-6f);
#pragma unroll
        for (int k = 0; k < 8; ++k) {
            const int col = lane * 32 + k * 4;
            f32x4 o;
#pragma unroll
            for (int e = 0; e < 4; ++e) o[e] = acc[k * 4 + e] * rstd * fvv[k][e];
            if (!DRY || rstd == 123.456f) *(f32x4*)(xo + col) = o;
        }
    }
    __syncthreads();
}
constexpr int NPHASE = 14;
#ifndef DBG
#define DBG 0
#endif
__device__ __forceinline__ void dbg_final_norm(const Args& a, const Ctx& c, const float* src) {
    for (int t = c.bid * 8 + c.wave; t < L_; t += c.nb * 8) {
        const float* xr = src + (size_t)t * 2048 + c.lane * 4; float* o = a.out + (size_t)t * 2048 + c.lane * 4;
        f32x4 v[8]; float ss = 0.f;
#pragma unroll
        for (int j = 0; j < 8; ++j) { v[j] = *(const f32x4*)(xr + j * 256); ss += v[j][0] * v[j][0] + v[j][1] * v[j][1] + v[j][2] * v[j][2] + v[j][3] * v[j][3]; }
        ss = wave_sum(ss);
        const float rstd = rsqrtf(ss * (1.f / 2048.f) + 1e-6f);
#pragma unroll
        for (int j = 0; j < 8; ++j) { const f32x4 g = *(const f32x4*)(a.in[32] + j * 256 + c.lane * 4); *(f32x4*)(o + j * 256) = v[j] * rstd * g; }
    }
}

extern __shared__ __attribute__((aligned(16))) unsigned char smem[];

__global__ void __launch_bounds__(512, 2) fwd(Args a) {
    LAS unsigned char* lds = (LAS unsigned char*)smem;
    Ctx c; c.bid = blockIdx.x; c.nb = gridDim.x; c.tid = threadIdx.x; c.wave = __builtin_amdgcn_readfirstlane(threadIdx.x >> 6); c.lane = threadIdx.x & 63; c.lds = lds;
    volatile LAS unsigned* xbw = (volatile LAS unsigned*)(lds + LDS_BYTES - 16);
    if (c.tid < 4) xbw[c.tid] = 0u;
    __syncthreads();
    const int lo = a.ph_lo, hi = a.ph_hi;
    const bool multi = (hi - lo) > 1;
    XcdBarrier bar; bar.bar = (unsigned*)(a.ws + WS_CTL); bar.x = 0; bar.st = xbw;
    if (multi) bar = xcd_barrier_post((unsigned*)(a.ws + WS_CTL), xbw);
#ifndef PHASE_MASK
#define PHASE_MASK 0xFFFF
#endif
#if DBG == 1
#undef PHASE_MASK
#define PHASE_MASK 0x403
#elif DBG == 2 || DBG == 4 || DBG == 5
#undef PHASE_MASK
#define PHASE_MASK 0x4FF
#endif
#define IN(k) (((PHASE_MASK >> (k)) & 1) && lo <= (k) && (k) < hi)
#define REFRESH() do { int tz_ = threadIdx.x; asm volatile("" : "+v"(tz_)); c.tid = tz_; c.lane = tz_ & 63; c.wave = __builtin_amdgcn_readfirstlane(tz_ >> 6); } while (0)
#define SEAM(k) do { if (IN(k) && IN((k) + 1)) xcd_barrier(bar); } while (0)
#ifndef DUP
#define DUP -1
#endif
#define REP(k) for (int rep_ = 0; rep_ < ((DUP == (k)) ? 2 : 1); ++rep_)
#define DUP2(k, ...) do { __VA_ARGS__; if (DUP == (k)) { __syncthreads(); __VA_ARGS__; } } while (0)

    if (IN(0)) REP(0) { REFRESH(); p0_prologue(a, c); }
    SEAM(0);
    if (IN(1)) { REFRESH(); DUP2(1, p1_hnorm(a, c)); }
    SEAM(1);
    if (IN(2)) { REFRESH();
        pg8::StaticOrder S; S.init((const bf16_t*)(a.ws + WS_H), (const bf16_t*)(a.ws + WS_WIN), 2048, 2048, 2048, L_, DIN_PAD, c.nb, c.bid);
        EpiWin E{(bf16_t*)(a.ws + WS_US), (bf16_t*)(a.ws + WS_Q), (bf16_t*)(a.ws + WS_KROW), (bf16_t*)(a.ws + WS_VROW), (bf16_t*)(a.ws + WS_VT), (float*)(a.ws + WS_GATE)};
        DUP2(2, pg8::gemm_phase<EpiWin, pg8::StaticOrder>(lds, S, E));
    }
    SEAM(2);
    if (IN(3)) { REFRESH();
        DUP2(31, for (int it = c.bid; it < 256; it += c.nb) s5_item<0>(a, c, it >> 2, it & 3));
        __syncthreads();
        CmpOrder S{(const bf16_t*)(a.ws + WS_KROW), (const bf16_t*)(a.ws + WS_VROW), (const bf16_t*)(a.ws + WS_W1), 2048, 4096, 256, c.nb, c.bid};
        EpiSlab E{(float*)(a.ws + WS_SLAB)};
        DUP2(32, pg8::gemm_phase<EpiSlab, CmpOrder>(lds, S, E));
    }
    SEAM(3);
    if (IN(4)) { REFRESH();
        DUP2(41, for (int it = c.bid; it < 256; it += c.nb) cmp_finish_item(a, c, it >> 7, it & 127));
        DUP2(42, for (int it = c.bid; it < 256; it += c.nb) s5_item<1>(a, c, it >> 2, it & 3));
    }
    SEAM(4);
    if (IN(5)) { REFRESH();
#if DBG == 5
        for (size_t i = (size_t)c.bid * NTHREADS + c.tid; i < (size_t)L_ * 1024 / 8; i += (size_t)c.nb * NTHREADS) *(u32x4*)((bf16_t*)(a.ws + WS_YSSM) + i * 8) = (u32x4){0u, 0u, 0u, 0u};
#else
        {
            pg8::StaticOrder S; S.init((const bf16_t*)(a.ws + WS_Z), (const bf16_t*)(a.ws + WS_WGLU), 1024, 1024, 1024, L_, 1024, c.nb, c.bid);
            EpiGlu E{(const bf16_t*)(a.ws + WS_Z), a.in[19], (bf16_t*)(a.ws + WS_YSSM)};
            DUP2(55, pg8::gemm_phase<EpiGlu, pg8::StaticOrder>(lds, S, E));
        }
#endif
        __syncthreads();
        REP(5)
#if DBG == 4
        for (size_t i = (size_t)c.bid * NTHREADS + c.tid; i < (size_t)L_ * 1024 / 8; i += (size_t)c.nb * NTHREADS) *(u32x4*)((bf16_t*)(a.ws + WS_YATT) + i * 8) = (u32x4){0u, 0u, 0u, 0u};
#else
        {
            unsigned* qhead = (unsigned*)(a.ws + WS_CTL) + 8192;
            volatile LAS unsigned* slot = (volatile LAS unsigned*)(lds + LDS_BYTES - 32);
            for (;;) {
                if (c.tid == 0) *slot = __hip_atomic_fetch_add(qhead, 1u, __ATOMIC_RELAXED, __HIP_MEMORY_SCOPE_AGENT);
                __syncthreads();
                const unsigned q = *slot;
                __syncthreads();
                if (q >= 512u) break;
                attn_item(a, c, 255 - (int)(q >> 1), (int)(q & 1));
            }
        }
#endif
    }
    SEAM(5);
    if (IN(6)) { REFRESH(); DUP2(6, p6_mixnorm(a, c)); }
    SEAM(6);
#define WOUT_GEMM(PM0) do { pg8::StaticOrder S; S.init((const bf16_t*)(a.ws + WS_H), (const bf16_t*)(a.ws + WS_WOUT), 2048, 2048, 2048, L_ / 2, 2048, c.nb, c.bid, PM0); \
        EpiWout E{a.in[0], (const float*)(a.ws + WS_COND) + 2 * 2048, (bf16_t*)(a.ws + WS_X1)}; pg8::gemm_phase<EpiWout, pg8::StaticOrder>(lds, S, E); __syncthreads(); } while (0)
#define WQ_GEMM(PM0) do { pg8::StaticOrder S; S.init((const bf16_t*)(a.ws + WS_H), (const bf16_t*)(a.ws + WS_WQ), 2048, 2048, 2048, L_ / 2, 2048, c.nb, c.bid, PM0); \
        EpiBf16 E{(bf16_t*)(a.ws + WS_QP), 2048}; pg8::gemm_phase<EpiBf16, pg8::StaticOrder>(lds, S, E); __syncthreads(); } while (0)
#define PEER_STEPS(FIRST, COUNT) do { for (int s_ = (FIRST) + c.bid; s_ < (FIRST) + (COUNT); s_ += c.nb) peer_step<false>(a, c, s_ * 8); } while (0)
    if (IN(7)) { REFRESH(); WOUT_GEMM(0); }
    SEAM(7);
    if (IN(8)) { REFRESH(); p8_h2norm(a, c, 0, L_ / 2); }
    SEAM(8);
    if (IN(9)) { REFRESH(); WQ_GEMM(0); }
    SEAM(9);
    if (IN(10)) { REFRESH();
        if ((c.bid >> 3) & 1) PEER_STEPS(0, 512);
        WOUT_GEMM(32);
        if (!((c.bid >> 3) & 1)) PEER_STEPS(0, 512); }
    SEAM(10);
    if (IN(11)) { REFRESH(); p8_h2norm(a, c, L_ / 2, L_ / 2); }
    SEAM(11);
    if (IN(12)) { REFRESH();
        if ((c.bid >> 3) & 1) PEER_STEPS(512, 512);
        WQ_GEMM(32);
        if (!((c.bid >> 3) & 1)) PEER_STEPS(512, 512); }
    SEAM(12);
    if (IN(13)) { REFRESH(); PEER_STEPS(1024, 1024); }
#undef WOUT_GEMM
#undef WQ_GEMM
#undef PEER_STEPS
#undef IN
#undef SEAM
}

#ifndef N_LAUNCHES
#define N_LAUNCHES 1
#endif
extern "C" void kernel_launch(void* const* d_in, const int* in_sizes, int n_in, void* d_out, int out_size, void* d_ws, size_t ws_size, hipStream_t stream) {
    static int grid = 0;
    if (grid == 0) {
        if (n_in != 33 || out_size != L_ * D_ || ws_size < WS_END) { fprintf(stderr, "kernel_launch: unexpected shapes (n_in %d, out %d, ws %zu < %zu); nothing launched\n", n_in, out_size, ws_size, (size_t)WS_END); grid = -1; return; }
        int dev = 0, cus = 0, per_cu = 0;
        if (hipGetDevice(&dev) != hipSuccess || hipDeviceGetAttribute(&cus, hipDeviceAttributeMultiprocessorCount, dev) != hipSuccess) { grid = -1; return; }
        if (hipFuncSetAttribute((const void*)fwd, hipFuncAttributeMaxDynamicSharedMemorySize, LDS_BYTES) != hipSuccess) { fprintf(stderr, "kernel_launch: hipFuncSetAttribute failed\n"); grid = -1; return; }
        if (hipOccupancyMaxActiveBlocksPerMultiprocessor(&per_cu, (const void*)fwd, NTHREADS, LDS_BYTES) != hipSuccess || per_cu < 1) { fprintf(stderr, "kernel_launch: occupancy query says %d\n", per_cu); (void)hipGetLastError(); grid = -1; return; }
        grid = cus;
    }
    if (grid < 0) return;
    (void)hipMemsetAsync((char*)d_ws + WS_CTL, 0, CTL_BYTES, stream);
    Args a{};
    for (int i = 0; i < 33; ++i) a.in[i] = (const float*)d_in[i];
    a.out = (float*)d_out; a.ws = (unsigned char*)d_ws;
    if (N_LAUNCHES == 1) { a.ph_lo = 0; a.ph_hi = NPHASE; hipLaunchKernelGGL(fwd, dim3(grid), dim3(NTHREADS), LDS_BYTES, stream, a); }
    else for (int p = 0; p < NPHASE; ++p) { a.ph_lo = p; a.ph_hi = p + 1; hipLaunchKernelGGL(fwd, dim3(grid), dim3(NTHREADS), LDS_BYTES, stream, a); }
}
```

```cpp
#include <hip/hip_runtime.h>
#include <stdint.h>
#include <stdio.h>

#define LAS __attribute__((address_space(3)))
typedef unsigned short bf16_t;
typedef short bf16x8 __attribute__((ext_vector_type(8)));
typedef float f32x2 __attribute__((ext_vector_type(2)));
typedef float f32x4 __attribute__((ext_vector_type(4)));
typedef float f32x16 __attribute__((ext_vector_type(16)));
typedef unsigned u32x2 __attribute__((ext_vector_type(2)));
typedef unsigned u32x4 __attribute__((ext_vector_type(4)));
typedef __bf16 bfv2 __attribute__((ext_vector_type(2)));
typedef unsigned u32x6 __attribute__((ext_vector_type(6)));
typedef float f32x32 __attribute__((ext_vector_type(32)));

constexpr int L_ = 16384, D_ = 2048, DSSM = 1024, DATT = 1024, DIN = 3608, DIN_PAD = 3840;
constexpr int NADA = 12288;
constexpr float LOG2E = 1.4426950408889634f;
constexpr float QSCALE = 0.08838834764831845f * 1.4426950408889634f;
constexpr int TBN = 800;
constexpr int NTHREADS = 512;
constexpr int LDS_BYTES = 163840;

constexpr size_t al256(size_t x) { return (x + 255) & ~(size_t)255; }
constexpr size_t WS_CTL   = 0;                                  constexpr size_t CTL_BYTES = 65536;
constexpr size_t WS_CONDP = WS_CTL + CTL_BYTES;
constexpr size_t WS_COND  = WS_CONDP + 32 * 12288 * 4;
constexpr size_t WS_TB    = WS_COND + 12288 * 4;
constexpr size_t WS_BPE   = al256(WS_TB + 8 * TBN * 4);
constexpr size_t WS_S5P   = al256(WS_BPE + 2 * 256 * 4);
constexpr size_t WS_S5F   = WS_S5P + 2 * 64 * 64 * 2 * 4;
constexpr size_t WS_S5MT  = WS_S5F + 64 * 4 * 128 * 4;
constexpr size_t WS_S5WE  = WS_S5MT + (size_t)64 * 256 * 256 * 2;
constexpr size_t WS_S5WC  = WS_S5WE + (size_t)64 * 128 * 256 * 2;
constexpr size_t WS_WIN   = WS_S5WC + (size_t)64 * 256 * 128 * 2;
constexpr size_t WS_WGLU  = WS_WIN + (size_t)DIN_PAD * 2048 * 2;
constexpr size_t WS_WOUT  = WS_WGLU + (size_t)1024 * 1024 * 2;
constexpr size_t WS_WQ    = WS_WOUT + (size_t)2048 * 2048 * 2;
constexpr size_t WS_W1    = WS_WQ + (size_t)2048 * 2048 * 2;
constexpr size_t WS_W2    = WS_W1 + (size_t)2 * 256 * 4096 * 2;
constexpr size_t WS_PK    = WS_W2 + (size_t)2 * 128 * 256 * 2;
constexpr size_t WS_PU    = WS_PK + (size_t)2 * 128 * 128 * 2;
constexpr size_t WS_PV    = WS_PU + (size_t)16384 * 1024;
constexpr size_t WS_PSC   = WS_PV + (size_t)16384 * 1024;
constexpr size_t WS_BPEP  = WS_PSC + (size_t)4 * 16384 * 4;
constexpr size_t WS_H     = WS_BPEP + (size_t)32 * 2 * 256 * 4;
constexpr size_t WS_US    = WS_H + (size_t)16384 * 2048 * 2;
constexpr size_t WS_Q     = WS_US + (size_t)16384 * 1024 * 2;
constexpr size_t WS_QP    = WS_US;
constexpr size_t WS_KROW  = WS_Q + (size_t)16384 * 1024 * 2;
constexpr size_t WS_VROW  = WS_KROW + (size_t)6 * 16384 * 128 * 2;
constexpr size_t WS_VT    = WS_VROW + (size_t)2 * 16384 * 128 * 2 + 8192;
constexpr size_t WS_GATE  = WS_VT + (size_t)4 * 128 * 16384 * 2;
constexpr size_t WS_SLAB  = WS_GATE + (size_t)16384 * 24 * 4;
constexpr size_t WS_KC    = WS_SLAB + (size_t)2 * 16 * 2048 * 256 * 4;
constexpr size_t WS_VCT   = WS_KC + (size_t)2 * 1024 * 128 * 2;
constexpr size_t WS_Z     = WS_VCT + (size_t)2 * 128 * 1024 * 2;
constexpr size_t WS_YSSM  = WS_Z + (size_t)16384 * 1024 * 2;
constexpr size_t WS_YATT  = WS_YSSM + (size_t)16384 * 1024 * 2;
constexpr size_t WS_H2    = WS_SLAB;
constexpr size_t WS_X1    = WS_Z;
constexpr size_t WS_ST2P  = WS_YATT + (size_t)16384 * 1024 * 2;
constexpr size_t WS_RSTD2 = WS_ST2P + (size_t)16384 * 32 * 4;
constexpr size_t WS_F2    = WS_RSTD2 + (size_t)16384 * 4;
constexpr size_t WS_CQ    = WS_F2 + 2048 * 4;
constexpr size_t WS_END   = WS_CQ + 2048 * 4;
static_assert(WS_END < (size_t)530 * 1024 * 1024, "workspace map too large");

struct Args { const float* in[33]; float* out; unsigned char* ws; int ph_lo, ph_hi; };

__device__ __forceinline__ unsigned cvt_pk_bf16(float lo, float hi) { bfv2 v; v[0] = (__bf16)lo; v[1] = (__bf16)hi; return __builtin_bit_cast(unsigned, v); }
__device__ __forceinline__ bf16_t f2bf(float f) { return (bf16_t)(cvt_pk_bf16(f, 0.f) & 0xffffu); }
__device__ __forceinline__ float bf2f(unsigned b) { return __uint_as_float(b << 16); }
__device__ __forceinline__ float bflo(unsigned w) { return __uint_as_float(w << 16); }
__device__ __forceinline__ float bfhi(unsigned w) { return __uint_as_float(w & 0xffff0000u); }
__device__ __forceinline__ float fexp2(float x) { return __builtin_amdgcn_exp2f(x); }
__device__ __forceinline__ float frcp(float x) { return __builtin_amdgcn_rcpf(x); }
__device__ __forceinline__ float sigmoidf_(float x) { return frcp(1.f + fexp2(-LOG2E * x)); }
__device__ __forceinline__ float gelu_tanh(float x) {
    const float u = x * (1.f + 0.044715f * x * x);
    return x * frcp(1.f + fexp2(-2.f * 0.7978845608028654f * LOG2E * u));
}
__device__ __forceinline__ float shfl_xor_f(float v, int m) { return __shfl_xor(v, m, 64); }
__device__ __forceinline__ float wave_sum(float v) {
#pragma unroll
    for (int m = 32; m >= 1; m >>= 1) v += __shfl_xor(v, m, 64);
    return v;
}
__device__ __forceinline__ float wave_max(float v) {
#pragma unroll
    for (int m = 32; m >= 1; m >>= 1) v = fmaxf(v, __shfl_xor(v, m, 64));
    return v;
}
template <int CTRL> __device__ __forceinline__ float dpp_f(float x) { return __int_as_float(__builtin_amdgcn_update_dpp(0, __float_as_int(x), CTRL, 0xf, 0xf, false)); }
__device__ __forceinline__ float wave_max_bcast(float v) {
    v = fmaxf(v, dpp_f<0xB1>(v)); v = fmaxf(v, dpp_f<0x4E>(v)); v = fmaxf(v, dpp_f<0x141>(v)); v = fmaxf(v, dpp_f<0x140>(v));
    v = fmaxf(v, __int_as_float(__builtin_amdgcn_update_dpp(__float_as_int(v), __float_as_int(v), 0x142, 0xa, 0xf, false)));
    v = fmaxf(v, __int_as_float(__builtin_amdgcn_update_dpp(__float_as_int(v), __float_as_int(v), 0x143, 0xc, 0xf, false)));
    return __int_as_float(__builtin_amdgcn_readlane(__float_as_int(v), 63));
}
__device__ __forceinline__ unsigned wave_umax_bcast(unsigned v) {
#define UDPP_(x, ctrl, rm) (unsigned)__builtin_amdgcn_update_dpp((int)(x), (int)(x), ctrl, rm, 0xf, false)
    v = max(v, UDPP_(v, 0xB1, 0xf)); v = max(v, UDPP_(v, 0x4E, 0xf)); v = max(v, UDPP_(v, 0x141, 0xf)); v = max(v, UDPP_(v, 0x140, 0xf));
    v = max(v, UDPP_(v, 0x142, 0xa)); v = max(v, UDPP_(v, 0x143, 0xc));
#undef UDPP_
    return (unsigned)__builtin_amdgcn_readlane((int)v, 63);
}
__device__ __forceinline__ float quad_sum(float x) { x += dpp_f<0xB1>(x); x += dpp_f<0x4E>(x); return x; }
template <int SEL> __device__ __forceinline__ f32x2 fp4_unpk(unsigned w) { return __builtin_amdgcn_cvt_scalef32_pk_f32_fp4(w, 1.0f, SEL); }
template <int SEL> __device__ __forceinline__ unsigned fp4_pk(unsigned w, float a, float b) { return __builtin_amdgcn_cvt_scalef32_pk_fp4_f32(w, a, b, 1.0f, SEL); }
__device__ __forceinline__ f32x4 mfma16(bf16x8 a, bf16x8 b, f32x4 c) { return __builtin_amdgcn_mfma_f32_16x16x32_bf16(a, b, c, 0, 0, 0); }
__device__ __forceinline__ f32x16 mfma32(bf16x8 a, bf16x8 b, f32x16 c) { return __builtin_amdgcn_mfma_f32_32x32x16_bf16(a, b, c, 0, 0, 0); }
#define XB_TMO      128
#define XB_XCNT(j)  (256  + 64 * (j))
#define XB_XSUB(j)  (1280 + 64 * (j))
#define XB_XGEN(j)  (2304 + 64 * (j))
#define XB_TOP      3328
#define XB_TOPGEN   3392
#define XCD_BAR_WORDS 3456
#define XB_SPIN_CAP (1u << 18)

__device__ __forceinline__ unsigned xb_ld(unsigned* p)              { return __hip_atomic_load(p, __ATOMIC_RELAXED, __HIP_MEMORY_SCOPE_AGENT); }
__device__ __forceinline__ unsigned xb_add(unsigned* p, unsigned v) { return __hip_atomic_fetch_add(p, v, __ATOMIC_RELAXED, __HIP_MEMORY_SCOPE_AGENT); }
__device__ __forceinline__ unsigned xb_xcc_id() { return (unsigned)__builtin_amdgcn_s_getreg((3 << 11) | 20) & 0xFu; }
#define XB_SPIN(cond, bar) do { unsigned _sp = 0; while (cond) { __builtin_amdgcn_s_sleep(1); \
    if ((++_sp & 255u) == 0u) { if (xb_ld(&(bar)[XB_TMO])) break; if (_sp > XB_SPIN_CAP) { atomicAdd(&(bar)[XB_TMO], 1u); break; } } } } while (0)

struct XcdBarrier {
    unsigned* bar; unsigned x;
    volatile LAS unsigned* st;
};
__device__ __forceinline__ XcdBarrier xcd_barrier_post(unsigned* bar, volatile LAS unsigned* st) {
    XcdBarrier b; b.bar = bar; b.x = xb_xcc_id(); b.st = st;
    if (threadIdx.x == 0) (void)xb_add(&bar[XB_XCNT(b.x)], 1u);
    return b;
}
__device__ __forceinline__ void xcd_barrier_complete(unsigned* bar, unsigned x, unsigned& nloc, unsigned& nx) {
    const unsigned G = gridDim.x * gridDim.y * gridDim.z;
    unsigned sum, cnt, mine, sp = 0u;
    for (;;) {
        sum = 0u; cnt = 0u; mine = 0u;
#pragma unroll
        for (unsigned j = 0; j < 16; ++j) { const unsigned c = xb_ld(&bar[XB_XCNT(j)]); sum += c; cnt += (c > 0u) ? 1u : 0u; mine = (j == x) ? c : mine; }
        if (sum == G) break;
        __builtin_amdgcn_s_sleep(1);
        if ((++sp & 255u) == 0u) { if (xb_ld(&bar[XB_TMO])) break; if (sp > XB_SPIN_CAP) { atomicAdd(&bar[XB_TMO], 1u); break; } }
    }
    nloc = mine > 0u ? mine : 1u; nx = cnt > 0u ? cnt : 1u;
}
__device__ __forceinline__ void xcd_barrier(const XcdBarrier& b) {
    asm volatile("s_waitcnt vmcnt(0)" ::: "memory");
    __syncthreads();
    if (threadIdx.x == 0) {
        unsigned* bar = b.bar;
        __builtin_amdgcn_s_waitcnt(0);
        unsigned nloc = b.st[0], nx = b.st[1];
        if (nloc == 0u) { xcd_barrier_complete(bar, b.x, nloc, nx); b.st[0] = nloc; b.st[1] = nx; }
        const unsigned old = xb_add(&bar[XB_XSUB(b.x)], 1u);
        const unsigned gen = old / nloc;
        if (old + 1u == (gen + 1u) * nloc) {
            __builtin_amdgcn_fence(__ATOMIC_RELEASE, "agent");
            asm volatile("s_waitcnt vmcnt(0)" ::: "memory");
            const unsigned og = xb_add(&bar[XB_TOP], 1u);
            const unsigned tg = og / nx;
            if (og + 1u == (tg + 1u) * nx) xb_add(&bar[XB_TOPGEN], 1u);
            else XB_SPIN(xb_ld(&bar[XB_TOPGEN]) == tg, bar);
            __builtin_amdgcn_fence(__ATOMIC_ACQUIRE, "agent");
            xb_add(&bar[XB_XGEN(b.x)], 1u);
            asm volatile("s_waitcnt vmcnt(0)" ::: "memory");
        } else {
            XB_SPIN(xb_ld(&bar[XB_XGEN(b.x)]) == gen, bar);
            __builtin_amdgcn_fence(__ATOMIC_ACQUIRE, "agent");
            asm volatile("s_waitcnt vmcnt(0)" ::: "memory");
        }
    }
    __syncthreads();
}

namespace pg8 {
constexpr int BM = 256, BK = 64, HALF = 128, HTB = HALF * BK * 2, STAGE_BYTES = 8 * HTB, NXCD = 8, WGM = 8;
__host__ __device__ __forceinline__ int lds_byte(int r, int c) { const int st = (r >> 4) * 2 + (c >> 5), rr = r & 15, cc = c & 31, ob = rr * 64 + cc * 2; return st * 1024 + (ob ^ (((ob >> 9) & 1) << 5)); }
__host__ __device__ __forceinline__ void stage_rc(int b, int& R, int& C) { const int st = b / 1024, sb = b % 1024, swz = sb ^ (((sb >> 9) & 1) << 5); R = (st >> 1) * 16 + swz / 64; C = (st & 1) * 32 + (swz % 64) / 2; }
__host__ __device__ __forceinline__ int perm32(int rho) { const int n = rho >> 4, i = rho & 15; return 8 * (i >> 2) + 4 * n + (i & 3); }

struct Unit { int pm, pn, z; };
struct StaticOrder {
    const bf16_t* A; const bf16_t* Bt; int lda, ldb, K;
    int nM, nN, nwg, G, c, pm0;
    __device__ void init(const bf16_t* A_, const bf16_t* Bt_, int lda_, int ldb_, int K_, int M, int N, int G_, int c_, int pm0_ = 0) { A = A_; Bt = Bt_; lda = lda_; ldb = ldb_; K = K_; nM = M / BM; nN = N / BM; nwg = nM * nN; G = G_; c = c_; pm0 = pm0_; }
    __device__ bool next(int i, Unit& u) const {
        const long Lx = (long)i * G + c; if (Lx >= nwg) return false;
        int wgid = (int)Lx; { const int q = nwg / NXCD, r = nwg % NXCD, xcd = wgid % NXCD, off = wgid / NXCD; wgid = (xcd < r ? xcd * (q + 1) : r * (q + 1) + (xcd - r) * q) + off; }
        const int nig = WGM * nN, gid = wgid / nig, fm = gid * WGM, gsz = (nM - fm) < WGM ? (nM - fm) : WGM;
        u.pm = pm0 + fm + ((wgid % nig) % gsz); u.pn = (wgid % nig) / gsz; u.z = 0; return true;
    }
    __device__ __forceinline__ const char* a_base(const Unit& u) const { return (const char*)(A + (size_t)u.pm * BM * lda); }
    __device__ __forceinline__ const char* b_base(const Unit& u) const { return (const char*)(Bt + (size_t)u.pn * BM * ldb); }
};

template <class Epi, class Sched>
__device__ __forceinline__ void gemm_phase(LAS unsigned char* lds, const Sched& S, const Epi& E) {
    const int tid = threadIdx.x, wid = __builtin_amdgcn_readfirstlane(tid >> 6), lane = tid & 63, wr = wid >> 2, wc = wid & 3, fr = lane & 15, fq = lane >> 4;
    const int K = S.K, nt = K / BK, lda = S.lda, ldb = S.ldb;
    unsigned voffA[2], voffB[2];
#pragma unroll
    for (int i = 0; i < 2; ++i) { int R, C; stage_rc(tid * 16 + i * 8192, R, C); const int Rb = Epi::PERM ? ((R & ~31) + perm32(R & 31)) : R;
        voffA[i] = (unsigned)(R * lda + C) * 2u; voffB[i] = (unsigned)(Rb * ldb + C) * 2u; }
    const size_t kstep = (size_t)(BK * 2);
    const size_t hstepA = (size_t)HALF * lda * 2, hstepB = (size_t)HALF * ldb * 2;
    const unsigned ldsw = (unsigned)wid * 1024u;
    const int aoff = lds_byte(wr * 64 + fr, fq * 8), boff = lds_byte(wc * 32 + fr, fq * 8);
#define PG8_SA(b, h) (((b) * 2 + (h)) * HTB)
#define PG8_SB(b, h) ((4 + (b) * 2 + (h)) * HTB)
#define PG8_STAGE(bufoff, gbase, voff) do { _Pragma("unroll") for (int _i = 0; _i < 2; ++_i) \
        __builtin_amdgcn_global_load_lds((const unsigned*)((const char*)(gbase) + (voff)[_i]), (LAS unsigned*)(lds + (bufoff) + ldsw + _i * 8192), 16, 0, 0); } while (0)
#define PG8_LDA(dst, b, h) do { _Pragma("unroll") for (int m = 0; m < 4; ++m) _Pragma("unroll") for (int k = 0; k < 2; ++k) dst[m][k] = *(const LAS bf16x8*)(lds + PG8_SA(b, h) + aoff + m * 2048 + k * 1024); } while (0)
#define PG8_LDB(dst, b, h) do { _Pragma("unroll") for (int n = 0; n < 2; ++n) _Pragma("unroll") for (int k = 0; k < 2; ++k) dst[n][k] = *(const LAS bf16x8*)(lds + PG8_SB(b, h) + boff + n * 2048 + k * 1024); } while (0)
#define PG8_MMA(ai, bj, At, Bt) do { __builtin_amdgcn_s_setprio(1); _Pragma("unroll") for (int m = 0; m < 4; ++m) _Pragma("unroll") for (int n = 0; n < 2; ++n) _Pragma("unroll") for (int k = 0; k < 2; ++k) \
        acc[ai][bj][m][n] = __builtin_amdgcn_mfma_f32_16x16x32_bf16(Bt[n][k], At[m][k], acc[ai][bj][m][n], 0, 0, 0); __builtin_amdgcn_s_setprio(0); } while (0)
#define PG8_WAIT_V(n) asm volatile("s_waitcnt vmcnt(" #n ")" ::: "memory")
#define PG8_WAIT_L(n) asm volatile("s_waitcnt lgkmcnt(" #n ")" ::: "memory")
#define PG8_BAR __builtin_amdgcn_s_barrier()
#define PG8_SCHED __builtin_amdgcn_sched_barrier(0)
    Unit cur, nxt; int ui = 0;
    if (!S.next(0, cur)) return;
    f32x4 acc[2][2][4][2];
#pragma unroll
    for (int a = 0; a < 2; ++a)
#pragma unroll
        for (int b = 0; b < 2; ++b)
#pragma unroll
            for (int m = 0; m < 4; ++m)
#pragma unroll
                for (int n = 0; n < 2; ++n) acc[a][b][m][n] = (f32x4){0.f, 0.f, 0.f, 0.f};
    bf16x8 At[4][2], B0[2][2], B1[2][2];
    const char* cA = S.a_base(cur); const char* cB = S.b_base(cur);
    PG8_STAGE(PG8_SB(0, 0), cB, voffB); PG8_STAGE(PG8_SA(0, 0), cA, voffA); PG8_STAGE(PG8_SB(0, 1), cB + hstepB, voffB); PG8_STAGE(PG8_SA(0, 1), cA + hstepA, voffA);
    if (wr == 1) PG8_BAR;
    PG8_WAIT_V(4); PG8_BAR;
    PG8_STAGE(PG8_SB(1, 0), cB + kstep, voffB); PG8_STAGE(PG8_SA(1, 0), cA + kstep, voffA); PG8_STAGE(PG8_SB(1, 1), cB + hstepB + kstep, voffB);
    PG8_WAIT_V(6); PG8_BAR;
    for (;;) {
        const bool has_next = S.next(ui + 1, nxt);
        const char* nA = has_next ? S.a_base(nxt) : cA; const char* nB = has_next ? S.b_base(nxt) : cB;
        for (int t = 0; t < nt; t += 2) {
            const bool last = (t == nt - 2);
            const char* a1 = cA + (size_t)(t + 1) * kstep;
            const char* a2 = last ? nA : cA + (size_t)(t + 2) * kstep; const char* b2 = last ? nB : cB + (size_t)(t + 2) * kstep;
            const char* a3 = a2 + kstep; const char* b3 = b2 + kstep;
            PG8_LDB(B0, 0, 0); PG8_SCHED; PG8_LDA(At, 0, 0); PG8_STAGE(PG8_SA(1, 1), a1 + hstepA, voffA);
            PG8_WAIT_L(8); PG8_BAR; PG8_WAIT_L(0); PG8_MMA(0, 0, At, B0); PG8_BAR; PG8_SCHED;
            PG8_LDB(B1, 0, 1); PG8_STAGE(PG8_SB(0, 0), b2, voffB);
            PG8_BAR; PG8_WAIT_L(0); PG8_MMA(0, 1, At, B1); PG8_BAR;
            PG8_LDA(At, 0, 1); PG8_STAGE(PG8_SA(0, 0), a2, voffA);
            PG8_BAR; PG8_WAIT_L(0); PG8_MMA(1, 0, At, B0); PG8_BAR; PG8_SCHED;
            PG8_STAGE(PG8_SB(0, 1), b2 + hstepB, voffB);
            PG8_WAIT_V(6); PG8_BAR; PG8_MMA(1, 1, At, B1); PG8_BAR;
            PG8_LDB(B0, 1, 0); PG8_SCHED; PG8_LDA(At, 1, 0); PG8_STAGE(PG8_SA(0, 1), a2 + hstepA, voffA);
            PG8_WAIT_L(8); PG8_BAR; PG8_WAIT_L(0); PG8_MMA(0, 0, At, B0); PG8_BAR; PG8_SCHED;
            PG8_LDB(B1, 1, 1); PG8_STAGE(PG8_SB(1, 0), b3, voffB);
            PG8_BAR; PG8_WAIT_L(0); PG8_MMA(0, 1, At, B1); PG8_BAR;
            PG8_LDA(At, 1, 1); PG8_STAGE(PG8_SA(1, 0), a3, voffA);
            PG8_BAR; PG8_WAIT_L(0); PG8_MMA(1, 0, At, B0); PG8_BAR; PG8_SCHED;
            PG8_STAGE(PG8_SB(1, 1), b3 + hstepB, voffB);
            PG8_WAIT_V(6); PG8_BAR; PG8_MMA(1, 1, At, B1); PG8_BAR;
        }
        E(acc, cur, wr, wc, fr, fq);
        if (!has_next) break;
#pragma unroll
        for (int a = 0; a < 2; ++a)
#pragma unroll
            for (int b = 0; b < 2; ++b)
#pragma unroll
                for (int m = 0; m < 4; ++m)
#pragma unroll
                    for (int n = 0; n < 2; ++n) acc[a][b][m][n] = (f32x4){0.f, 0.f, 0.f, 0.f};
        cur = nxt; cA = nA; cB = nB; ++ui;
    }
    PG8_WAIT_V(0);
    if (wr == 0) PG8_BAR;
    PG8_BAR;
#undef PG8_SA
#undef PG8_SB
#undef PG8_STAGE
#undef PG8_LDA
#undef PG8_LDB
#undef PG8_MMA
#undef PG8_WAIT_V
#undef PG8_WAIT_L
#undef PG8_BAR
#undef PG8_SCHED
}
}
using pg8::Unit;
__device__ __forceinline__ u32x4 pack8(const f32x4& v0, const f32x4& v1) {
    u32x4 o; o[0] = cvt_pk_bf16(v0[0], v0[1]); o[1] = cvt_pk_bf16(v0[2], v0[3]); o[2] = cvt_pk_bf16(v1[0], v1[1]); o[3] = cvt_pk_bf16(v1[2], v1[3]); return o;
}
struct EpiWin {
    static constexpr bool PERM = true;
    bf16_t* US; bf16_t* Q; bf16_t* KROW; bf16_t* VROW; bf16_t* VT; float* GATE;
    __device__ __forceinline__ void operator()(const f32x4 (&acc)[2][2][4][2], const Unit& u, int wr, int wc, int fr, int fq) const {
        const int row0 = u.pm * 256 + wr * 64 + fr; const int pn = u.pn;
#pragma unroll
        for (int ai = 0; ai < 2; ++ai)
#pragma unroll
            for (int m = 0; m < 4; ++m) {
                const int row = row0 + ai * 128 + m * 16;
#pragma unroll
                for (int bj = 0; bj < 2; ++bj) {
                    const f32x4 v0 = acc[ai][bj][m][0], v1 = acc[ai][bj][m][1];
                    const int cin = bj * 128 + wc * 32 + 8 * fq;
                    if (pn < 4) { *(u32x4*)(US + (size_t)row * 1024 + pn * 256 + cin) = pack8(v0, v1); }
                    else if (pn < 8) { *(u32x4*)(Q + (size_t)row * 1024 + (pn - 4) * 256 + cin) = pack8(v0 * QSCALE, v1 * QSCALE); }
                    else if (pn < 14) {
                        const int kvi = pn - 8, branch = kvi >> 1, kvsel = kvi & 1, g = bj, d0 = wc * 32 + 8 * fq;
                        if (kvsel == 0) { *(u32x4*)(KROW + ((size_t)(branch * 2 + g) * L_ + row) * 128 + d0) = pack8(v0, v1); }
                        else if (branch == 0) { *(u32x4*)(VROW + ((size_t)g * L_ + row) * 128 + d0) = pack8(v0, v1); }
                        else {
                            const int prow = ((row & ~12) | ((row & 4) << 1) | ((row & 8) >> 1));
                            bf16_t* vt = VT + ((size_t)((branch - 1) * 2 + g) * 128 + d0) * L_ + prow;
#pragma unroll
                            for (int e = 0; e < 4; ++e) { vt[(size_t)e * L_] = f2bf(v0[e]); vt[(size_t)(e + 4) * L_] = f2bf(v1[e]); }
                        }
                    } else {
                        if (cin < 24) {
                            float* gp = GATE + (size_t)row * 24 + cin;
                            f32x4 s0, s1;
#pragma unroll
                            for (int e = 0; e < 4; ++e) { s0[e] = sigmoidf_(v0[e]); s1[e] = sigmoidf_(v1[e]); }
                            *(f32x4*)gp = s0; *(f32x4*)(gp + 4) = s1;
                        }
                    }
                }
            }
    }
};
struct EpiGlu {
    static constexpr bool PERM = true;
    const bf16_t* Z; const float* bglu; bf16_t* Y;
    __device__ __forceinline__ void operator()(const f32x4 (&acc)[2][2][4][2], const Unit& u, int wr, int wc, int fr, int fq) const {
        const int row0 = u.pm * 256 + wr * 64 + fr;
#pragma unroll
        for (int bj = 0; bj < 2; ++bj) {
            const int col = u.pn * 256 + bj * 128 + wc * 32 + 8 * fq;
            const f32x4 b0 = *(const f32x4*)(bglu + col), b1 = *(const f32x4*)(bglu + col + 4);
#pragma unroll
            for (int ai = 0; ai < 2; ++ai)
#pragma unroll
                for (int m = 0; m < 4; ++m) {
                    const int row = row0 + ai * 128 + m * 16;
                    const u32x4 zz = *(const u32x4*)(Z + (size_t)row * 1024 + col);
                    const f32x4 v0 = acc[ai][bj][m][0] + b0, v1 = acc[ai][bj][m][1] + b1;
                    f32x4 o0, o1;
                    o0[0] = bflo(zz[0]) * sigmoidf_(v0[0]); o0[1] = bfhi(zz[0]) * sigmoidf_(v0[1]); o0[2] = bflo(zz[1]) * sigmoidf_(v0[2]); o0[3] = bfhi(zz[1]) * sigmoidf_(v0[3]);
                    o1[0] = bflo(zz[2]) * sigmoidf_(v1[0]); o1[1] = bfhi(zz[2]) * sigmoidf_(v1[1]); o1[2] = bflo(zz[3]) * sigmoidf_(v1[2]); o1[3] = bfhi(zz[3]) * sigmoidf_(v1[3]);
                    *(u32x4*)(Y + (size_t)row * 1024 + col) = pack8(o0, o1);
                }
        }
    }
};
struct EpiWout {
    static constexpr bool PERM = true;
    const float* X; const float* g1; const float* f2; bf16_t* X1; bf16_t* A2; float* st2p;
    __device__ __forceinline__ void operator()(const f32x4 (&acc)[2][2][4][2], const Unit& u, int wr, int wc, int fr, int fq) const {
        const int row0 = u.pm * 256 + wr * 64 + fr, col0 = u.pn * 256 + wc * 32 + 8 * fq;
        float ss[2][4];
#pragma unroll
        for (int ai = 0; ai < 2; ++ai)
#pragma unroll
            for (int m = 0; m < 4; ++m) ss[ai][m] = 0.f;
#pragma unroll
        for (int bj = 0; bj < 2; ++bj) {
            const int col = col0 + bj * 128;
            const f32x4 g0 = *(const f32x4*)(g1 + col), g4 = *(const f32x4*)(g1 + col + 4), f0 = *(const f32x4*)(f2 + col), f4 = *(const f32x4*)(f2 + col + 4);
#pragma unroll
            for (int ai = 0; ai < 2; ++ai)
#pragma unroll
                for (int m = 0; m < 4; ++m) {
                    const size_t off = (size_t)(row0 + ai * 128 + m * 16) * 2048 + col;
                    const f32x4 x0 = *(const f32x4*)(X + off), x4 = *(const f32x4*)(X + off + 4);
                    const f32x4 v0 = x0 + g0 * acc[ai][bj][m][0], v1 = x4 + g4 * acc[ai][bj][m][1];
                    *(u32x4*)(X1 + off) = pack8(v0, v1);
                    *(u32x4*)(A2 + off) = pack8(v0 * f0, v1 * f4);
                    ss[ai][m] += (v0[0] * v0[0] + v0[1] * v0[1]) + (v0[2] * v0[2] + v0[3] * v0[3]) + (v1[0] * v1[0] + v1[1] * v1[1]) + (v1[2] * v1[2] + v1[3] * v1[3]);
                }
        }
#pragma unroll
        for (int ai = 0; ai < 2; ++ai)
#pragma unroll
            for (int m = 0; m < 4; ++m) {
                float s = ss[ai][m];
                s += __shfl_xor(s, 16); s += __shfl_xor(s, 32);
                if (fq == 0) st2p[(size_t)(row0 + ai * 128 + m * 16) * 32 + u.pn * 4 + wc] = s;
            }
    }
};
struct EpiQ {
    static constexpr bool PERM = true;
    bf16_t* O; const float* rstd2; const float* cq;
    __device__ __forceinline__ void operator()(const f32x4 (&acc)[2][2][4][2], const Unit& u, int wr, int wc, int fr, int fq) const {
        const int row0 = u.pm * 256 + wr * 64 + fr, col0 = u.pn * 256 + wc * 32 + 8 * fq;
        float rs[2][4];
#pragma unroll
        for (int ai = 0; ai < 2; ++ai)
#pragma unroll
            for (int m = 0; m < 4; ++m) rs[ai][m] = rstd2[row0 + ai * 128 + m * 16];
#pragma unroll
        for (int bj = 0; bj < 2; ++bj) {
            const int col = col0 + bj * 128;
            const f32x4 c0 = *(const f32x4*)(cq + col), c4 = *(const f32x4*)(cq + col + 4);
#pragma unroll
            for (int ai = 0; ai < 2; ++ai)
#pragma unroll
                for (int m = 0; m < 4; ++m)
                    *(u32x4*)(O + (size_t)(row0 + ai * 128 + m * 16) * 2048 + col) = pack8(acc[ai][bj][m][0] * rs[ai][m] + c0, acc[ai][bj][m][1] * rs[ai][m] + c4);
        }
    }
};
template <class Sched>
__device__ __forceinline__ void rstd2_prepass(const Sched& S, const float* st2p, float* rstd2, int tid) {
    Unit u;
    for (int i = 0; S.next(i, u); ++i)
        if (tid < 256) {
            const int row = u.pm * 256 + tid; const f32x4* p = (const f32x4*)(st2p + (size_t)row * 32);
            float s = 0.f;
#pragma unroll
            for (int k = 0; k < 8; ++k) { const f32x4 v = p[k]; s += (v[0] + v[1]) + (v[2] + v[3]); }
            rstd2[row] = rsqrtf(s * (1.f / 2048.f) + 1e-6f);
        }
    __syncthreads();
}
struct EpiSlab {
    static constexpr bool PERM = false;
    float* SL;
    __device__ __forceinline__ void operator()(const f32x4 (&acc)[2][2][4][2], const Unit& u, int wr, int wc, int fr, int fq) const {
        float* base = SL + (size_t)u.z * 2048 * 256;
        const int row0 = u.pm * 256 + wr * 64 + fr, col0 = wc * 32 + 4 * fq;
#pragma unroll
        for (int ai = 0; ai < 2; ++ai)
#pragma unroll
            for (int m = 0; m < 4; ++m)
#pragma unroll
                for (int bj = 0; bj < 2; ++bj)
#pragma unroll
                    for (int n = 0; n < 2; ++n)
                        *(f32x4*)(base + (size_t)(row0 + ai * 128 + m * 16) * 256 + col0 + bj * 128 + n * 16) = acc[ai][bj][m][n];
    }
};
struct CmpOrder {
    const bf16_t* KROW; const bf16_t* VROW; const bf16_t* W1; int lda, ldb, K; int G, c;
    __device__ bool next(int i, Unit& u) const {
        const int x = i * G + c; if (x >= 256) return false;
        const int kvsel = x >> 7, pm = (x & 127) >> 4, ks = x & 15; u.pm = pm; u.pn = 0; u.z = kvsel * 16 + ks; return true;
    }
    __device__ __forceinline__ const char* a_base(const Unit& u) const { return (const char*)(((u.z >> 4) ? VROW : KROW) + (size_t)u.pm * 256 * 2048 + (u.z & 15) * 256); }
    __device__ __forceinline__ const char* b_base(const Unit& u) const { return (const char*)(W1 + (size_t)(u.z >> 4) * 256 * 4096 + (u.z & 15) * 256); }
};
struct Ctx { int bid, nb, tid, wave, lane; LAS unsigned char* lds; };

__device__ __forceinline__ void p0_cond(const Args& a, const Ctx& c) {
    const float* cv = a.in[1]; const float* w = a.in[2]; float* condp = (float*)(a.ws + WS_CONDP);
    for (int u = c.bid * 8 + c.wave; u < 1536; u += c.nb * 8) {
        const int cc = u % 48, kc = u / 48;
        const float* wp = w + (size_t)(kc * 64) * NADA + cc * 256 + c.lane * 4;
        f32x4 acc = {0.f, 0.f, 0.f, 0.f};
#pragma unroll 16
        for (int k = 0; k < 64; ++k) { const float x = cv[kc * 64 + k]; const float s = x / (1.f + __expf(-x)); acc += s * *(const f32x4*)(wp + (size_t)k * NADA); }
        *(f32x4*)(condp + (size_t)kc * NADA + cc * 256 + c.lane * 4) = acc;
    }
}
__device__ __forceinline__ void conv_T(const float* src, int K, int N, bf16_t* dst, int Npad, const Ctx& c) {
    LAS float* tile = (LAS float*)c.lds;
    const int nkt = K / 64, ntiles = nkt * (Npad / 64);
    const int r = c.tid >> 4, c4 = c.tid & 15;
    f32x4 v[2];
#define CONVT_LD(tix_) do { const int nt_ = (tix_) / nkt, kt_ = (tix_) % nkt, n_ = nt_ * 64 + 4 * c4; _Pragma("unroll") for (int i = 0; i < 2; ++i) { const int k_ = kt_ * 64 + r + 32 * i; v[i] = (f32x4){0.f, 0.f, 0.f, 0.f}; if (n_ < N) v[i] = *(const f32x4*)(src + (size_t)k_ * N + n_); } } while (0)
    if (c.bid < ntiles) CONVT_LD(c.bid);
    for (int tix = c.bid; tix < ntiles; tix += c.nb) {
        const int nt = tix / nkt, kt = tix % nkt;
#pragma unroll
        for (int i = 0; i < 2; ++i) { LAS float* tp = tile + (r + 32 * i) * 65 + 4 * c4; tp[0] = v[i][0]; tp[1] = v[i][1]; tp[2] = v[i][2]; tp[3] = v[i][3]; }
        __syncthreads();
        if (tix + c.nb < ntiles) CONVT_LD(tix + c.nb);
        { const int n = c.tid >> 3, kq = c.tid & 7; float w[8];
#pragma unroll
          for (int j = 0; j < 8; ++j) w[j] = tile[(kq * 8 + j) * 65 + n];
          u32x4 o; o[0] = cvt_pk_bf16(w[0], w[1]); o[1] = cvt_pk_bf16(w[2], w[3]); o[2] = cvt_pk_bf16(w[4], w[5]); o[3] = cvt_pk_bf16(w[6], w[7]);
          *(u32x4*)(dst + (size_t)(nt * 64 + n) * K + kt * 64 + kq * 8) = o; }
        __syncthreads();
    }
#undef CONVT_LD
}
__device__ __forceinline__ void conv_fp4rows(const float* src, unsigned char* dst4, float* scl, int rows, const Ctx& c) {
    const int stride = c.nb * 8;
    int row = c.bid * 8 + c.wave;
    f32x4 v[8], w[8];
    if (row < rows) {
#pragma unroll
        for (int j = 0; j < 8; ++j) v[j] = *(const f32x4*)(src + (size_t)row * 2048 + c.lane * 32 + j * 4);
    }
    for (; row < rows; row += stride) {
        const int nrow = row + stride;
        if (nrow < rows) {
#pragma unroll
            for (int j = 0; j < 8; ++j) w[j] = *(const f32x4*)(src + (size_t)nrow * 2048 + c.lane * 32 + j * 4);
        }
        float mx = 0.f;
#pragma unroll
        for (int j = 0; j < 8; ++j) mx = fmaxf(mx, fmaxf(fmaxf(fabsf(v[j][0]), fabsf(v[j][1])), fmaxf(fabsf(v[j][2]), fabsf(v[j][3]))));
        mx = wave_max(mx);
        const float s = mx > 0.f ? 6.f / mx : 1.f;
        if (c.lane == 0) scl[(size_t)row * 4] = mx > 0.f ? mx * (1.f / 6.f) : 1.f;
        u32x4 pk = {0u, 0u, 0u, 0u};
#pragma unroll
        for (int d = 0; d < 4; ++d) {
            unsigned wq = 0u;
            wq = fp4_pk<0>(wq, v[2 * d][0] * s, v[2 * d][1] * s); wq = fp4_pk<1>(wq, v[2 * d][2] * s, v[2 * d][3] * s);
            wq = fp4_pk<2>(wq, v[2 * d + 1][0] * s, v[2 * d + 1][1] * s); wq = fp4_pk<3>(wq, v[2 * d + 1][2] * s, v[2 * d + 1][3] * s);
            pk[d] = wq;
        }
        *(u32x4*)(dst4 + (size_t)row * 1024 + c.lane * 16) = pk;
#pragma unroll
        for (int j = 0; j < 8; ++j) v[j] = w[j];
    }
}
__device__ __forceinline__ void conv_E(const float* src, bf16_t* dst, size_t n8, const Ctx& c) {
    const size_t stride = (size_t)c.nb * NTHREADS;
    for (size_t i = (size_t)c.bid * NTHREADS + c.tid; i < n8; i += stride) {
        const f32x4 x = *(const f32x4*)(src + i * 8), y = *(const f32x4*)(src + i * 8 + 4);
        *(u32x4*)(dst + i * 8) = pack8(x, y);
    }
}
__device__ __forceinline__ int t5_bucket(int n) {
    if (n < 16) return n;
    const float scaled = logf((float)n / 16.f) / logf(64.f);
    const int large = 16 + (int)(scaled * 16.f);
    return large < 31 ? large : 31;
}
__device__ __forceinline__ void p0_tb(const Args& a, const Ctx& c) {
    float* tb = (float*)(a.ws + WS_TB); const float* rb = a.in[26];
    for (int i = c.bid * NTHREADS + c.tid; i < 8 * TBN; i += c.nb * NTHREADS) { const int head = i / TBN, dist = i % TBN; tb[i] = rb[t5_bucket(dist) * 8 + head] * LOG2E; }
}
__device__ __forceinline__ void p0_bpe(const Args& a, const Ctx& c, int part) {
    const int n = c.tid & 255, kv = c.tid >> 8;
    const float* pe = a.in[kv ? 23 : 20]; const float* w1 = a.in[kv ? 24 : 21]; float* bpep = (float*)(a.ws + WS_BPEP);
    float s = 0.f;
#pragma unroll 16
    for (int k = part * 128; k < part * 128 + 128; ++k) s += pe[k] * w1[(size_t)k * 256 + n];
    bpep[(part * 2 + kv) * 256 + n] = s;
}
__device__ __forceinline__ void p0_s5(const Args& a, const Ctx& c, int g, int part) {
    LAS float* ar = (LAS float*)c.lds;
    LAS float* ai = ar + 17 * 64;
    LAS float* bbr = ai + 17 * 64;
    LAS float* bbi = bbr + 1024;
    LAS float* cr = bbi + 1024;
    LAS float* ci = cr + 1024;
    LAS float* kd = ci + 1024;
    const int tid = c.tid;
    if (tid < 64) {
        const int p = tid; const float dt = expf(a.in[12][g]); const float lr = a.in[10][g * 64 + p], li = a.in[11][g * 64 + p];
        for (int d = 0; d <= 16; ++d) { const float mag = expf(lr * dt * (float)d), ang = li * dt * (float)d; ar[d * 64 + p] = mag * cosf(ang); ai[d * 64 + p] = mag * sinf(ang); }
        const float nr = ar[64 + p] - 1.f, ni = ai[64 + p], den = lr * lr + li * li;
        const float wre = (nr * lr + ni * li) / den, wim = (ni * lr - nr * li) / den;
        for (int h = 0; h < 16; ++h) { const float br = a.in[13][(g * 64 + p) * 16 + h], bi = a.in[14][(g * 64 + p) * 16 + h]; bbr[p * 16 + h] = wre * br - wim * bi; bbi[p * 16 + h] = wre * bi + wim * br; }
        if (part == 0) {
        float* s5p = (float*)(a.ws + WS_S5P);
        float xr = ar[16 * 64 + p], xi = ai[16 * 64 + p];
        s5p[(g * 64 + p) * 2] = xr; s5p[(g * 64 + p) * 2 + 1] = xi;
        for (int s = 0; s < 8; ++s) { const float tr = xr * xr - xi * xi, ti = 2.f * xr * xi; xr = tr; xi = ti; }
        s5p[64 * 64 * 2 + (g * 64 + p) * 2] = xr; s5p[64 * 64 * 2 + (g * 64 + p) * 2 + 1] = xi;
        }
    }
    for (int e = tid; e < 1024; e += NTHREADS) { cr[e] = a.in[15][g * 1024 + e]; ci[e] = a.in[16][g * 1024 + e]; }
    __syncthreads();
    for (int e = tid; e < 1024 * (part + 1); e += NTHREADS) {
        const int d = e >> 8, h1 = (e >> 4) & 15, h = e & 15; float s = 0.f;
        for (int p = 0; p < 64; ++p) { const float Cr = cr[h1 * 64 + p], Ci = ci[h1 * 64 + p], Ar = ar[d * 64 + p], Ai = ai[d * 64 + p];
            const float Gr = Cr * Ar - Ci * Ai, Gi = Cr * Ai + Ci * Ar; s += Gr * bbr[p * 16 + h] - Gi * bbi[p * 16 + h]; }
        if (d == 0 && h1 == h) s += a.in[17][g * 16 + h];
        kd[e] = s;
    }
    __syncthreads();
    bf16_t* MT = (bf16_t*)(a.ws + WS_S5MT) + (size_t)g * 65536;
    bf16_t* WE = (bf16_t*)(a.ws + WS_S5WE) + (size_t)g * 32768;
    bf16_t* WC = (bf16_t*)(a.ws + WS_S5WC) + (size_t)g * 32768;
    for (int e = 16384 * part + tid; e < 16384 * (part + 1); e += NTHREADS) { const int n = e >> 8, k = e & 255, j = n >> 4, h1 = n & 15, i = k >> 4, h = k & 15;
        MT[e] = f2bf(i <= j ? kd[(j - i) * 256 + h1 * 16 + h] : 0.f); }
    for (int e = 8192 * part + tid; e < 8192 * (part + 1); e += NTHREADS) { const int n = e >> 8, k = e & 255, cc = n >> 6, p = n & 63, i = k >> 4, h = k & 15;
        const float Ar = ar[(15 - i) * 64 + p], Ai = ai[(15 - i) * 64 + p], Br = bbr[p * 16 + h], Bi = bbi[p * 16 + h];
        WE[e] = f2bf(cc ? (Ar * Bi + Ai * Br) : (Ar * Br - Ai * Bi)); }
    for (int e = 8192 * part + tid; e < 8192 * (part + 1); e += NTHREADS) { const int n = e >> 7, k = e & 127, j = n >> 4, h1 = n & 15, cc = k >> 6, p = k & 63;
        const float Cr = cr[h1 * 64 + p], Ci = ci[h1 * 64 + p], Ar = ar[(j + 1) * 64 + p], Ai = ai[(j + 1) * 64 + p];
        WC[e] = f2bf(cc ? -(Cr * Ai + Ci * Ar) : (Cr * Ar - Ci * Ai)); }
    __syncthreads();
}
__device__ __forceinline__ void p0_prologue(const Args& a, const Ctx& c) {
    for (int u = c.bid; u < 256; u += c.nb) p0_s5(a, c, u >> 2, u & 3);
    for (int u = 0; u < 32; ++u) if (c.bid == (8 * u + 7) % c.nb) p0_bpe(a, c, u);
    p0_tb(a, c);
    p0_cond(a, c);
    conv_T(a.in[6], 2048, DIN, (bf16_t*)(a.ws + WS_WIN), DIN_PAD, c);
    conv_T(a.in[18], 1024, 1024, (bf16_t*)(a.ws + WS_WGLU), 1024, c);
    conv_T(a.in[7], 2048, 2048, (bf16_t*)(a.ws + WS_WOUT), 2048, c);
    conv_T(a.in[27], 2048, 2048, (bf16_t*)(a.ws + WS_WQ), 2048, c);
    conv_T(a.in[21], 4096, 256, (bf16_t*)(a.ws + WS_W1), 256, c);
    conv_T(a.in[24], 4096, 256, (bf16_t*)(a.ws + WS_W1) + 256 * 4096, 256, c);
    conv_T(a.in[22], 256, 128, (bf16_t*)(a.ws + WS_W2), 128, c);
    conv_T(a.in[25], 256, 128, (bf16_t*)(a.ws + WS_W2) + 128 * 256, 128, c);
    conv_E(a.in[28], (bf16_t*)(a.ws + WS_PK), 128 * 128 / 8, c);
    conv_E(a.in[29], (bf16_t*)(a.ws + WS_PK) + 128 * 128, 128 * 128 / 8, c);
    conv_fp4rows(a.in[30], a.ws + WS_PU, (float*)(a.ws + WS_PSC), 16384, c);
    conv_fp4rows(a.in[31], a.ws + WS_PV, (float*)(a.ws + WS_PSC) + 2, 16384, c);
}

__device__ __forceinline__ void norm_rows(const float* X, bf16_t* O, LAS const float* Ab, LAS const float* Bb, const Ctx& c, int row0 = 0, int nrows = L_) {
    for (int t = row0 + c.bid * 8 + c.wave; t < row0 + nrows; t += c.nb * 8) {
        const float* xr = X + (size_t)t * 2048 + c.lane * 4;
        f32x4 v[8]; float ss = 0.f;
#pragma unroll
        for (int j = 0; j < 8; ++j) { v[j] = *(const f32x4*)(xr + j * 256); ss += v[j][0] * v[j][0] + v[j][1] * v[j][1] + v[j][2] * v[j][2] + v[j][3] * v[j][3]; }
        ss = wave_sum(ss);
        const float rstd = rsqrtf(ss * (1.f / 2048.f) + 1e-6f);
#pragma unroll
        for (int j = 0; j < 8; ++j) {
            const int col = j * 256 + c.lane * 4;
            const f32x4 A = *(const LAS f32x4*)(Ab + col), B = *(const LAS f32x4*)(Bb + col);
            const f32x4 o = v[j] * rstd * A + B;
            u32x2 w; w[0] = cvt_pk_bf16(o[0], o[1]); w[1] = cvt_pk_bf16(o[2], o[3]);
            *(u32x2*)(O + (size_t)t * 2048 + col) = w;
        }
    }
}
__device__ __forceinline__ void norm_rows_bf16(const bf16_t* X, bf16_t* O, LAS const float* Ab, LAS const float* Bb, const Ctx& c, int row0, int nrows) {
    for (int t = row0 + c.bid * 8 + c.wave; t < row0 + nrows; t += c.nb * 8) {
        const bf16_t* xr = X + (size_t)t * 2048 + c.lane * 8;
        u32x4 w[4]; float ss = 0.f;
#pragma unroll
        for (int j = 0; j < 4; ++j) { w[j] = *(const u32x4*)(xr + j * 512);
#pragma unroll
            for (int e = 0; e < 4; ++e) { const float a0 = bflo(w[j][e]), a1 = bfhi(w[j][e]); ss += a0 * a0 + a1 * a1; } }
        ss = wave_sum(ss);
        const float rstd = rsqrtf(ss * (1.f / 2048.f) + 1e-6f);
#pragma unroll
        for (int j = 0; j < 4; ++j) {
            const int col = j * 512 + c.lane * 8;
            const f32x4 A0 = *(const LAS f32x4*)(Ab + col), A1 = *(const LAS f32x4*)(Ab + col + 4), B0 = *(const LAS f32x4*)(Bb + col), B1 = *(const LAS f32x4*)(Bb + col + 4);
            f32x4 o0, o1;
#pragma unroll
            for (int e = 0; e < 2; ++e) { o0[2 * e] = bflo(w[j][e]) * rstd * A0[2 * e] + B0[2 * e]; o0[2 * e + 1] = bfhi(w[j][e]) * rstd * A0[2 * e + 1] + B0[2 * e + 1];
                o1[2 * e] = bflo(w[j][2 + e]) * rstd * A1[2 * e] + B1[2 * e]; o1[2 * e + 1] = bfhi(w[j][2 + e]) * rstd * A1[2 * e + 1] + B1[2 * e + 1]; }
            *(u32x4*)(O + (size_t)t * 2048 + col) = pack8(o0, o1);
        }
    }
}
__device__ __forceinline__ float cond_from_partials(const float* condp, const float* b_ada, int j) {
    float s = b_ada[j];
#pragma unroll 8
    for (int k = 0; k < 32; ++k) s += condp[(size_t)k * NADA + j];
    return s;
}
__device__ __forceinline__ void p1_hnorm(const Args& a, const Ctx& c) {
    const float* condp = (const float*)(a.ws + WS_CONDP); float* cond = (float*)(a.ws + WS_COND);
    for (int j = c.bid * NTHREADS + c.tid; j < NADA; j += c.nb * NTHREADS) cond[j] = cond_from_partials(condp, a.in[3], j);
    { float* F2 = (float*)(a.ws + WS_F2);
      for (int j = c.bid * NTHREADS + c.tid; j < 2048; j += c.nb * NTHREADS) F2[j] = a.in[5][j] * (1.f + cond_from_partials(condp, a.in[3], 4 * 2048 + j)); }
    LAS float* Ab = (LAS float*)c.lds; LAS float* Bb = Ab + 2048;
    for (int col = c.tid; col < 2048; col += NTHREADS) {
        Ab[col] = a.in[4][col] * (1.f + cond_from_partials(condp, a.in[3], 2048 + col)); Bb[col] = cond_from_partials(condp, a.in[3], col); }
    __syncthreads();
    norm_rows(a.in[0], (bf16_t*)(a.ws + WS_H), Ab, Bb, c);
}
__device__ __forceinline__ void p_cqce(const Args& a, const Ctx& c) {
    const float* sh2 = (const float*)(a.ws + WS_COND) + 3 * 2048;
    float s[32];
#pragma unroll
    for (int k = 0; k < 8; ++k) { const f32x4 v = *(const f32x4*)(sh2 + c.lane * 32 + k * 4); s[4 * k] = v[0]; s[4 * k + 1] = v[1]; s[4 * k + 2] = v[2]; s[4 * k + 3] = v[3]; }
    const bf16_t* WQ = (const bf16_t*)(a.ws + WS_WQ); float* cq = (float*)(a.ws + WS_CQ);
    for (int n = c.bid * 8 + c.wave; n < 2048; n += c.nb * 8) {
        u32x4 w[4];
#pragma unroll
        for (int k = 0; k < 4; ++k) w[k] = *(const u32x4*)(WQ + (size_t)n * 2048 + c.lane * 32 + k * 8);
        float d = 0.f;
#pragma unroll
        for (int k = 0; k < 4; ++k)
#pragma unroll
            for (int e = 0; e < 4; ++e) d += bflo(w[k][e]) * s[k * 8 + 2 * e] + bfhi(w[k][e]) * s[k * 8 + 2 * e + 1];
        d = wave_sum(d);
        if (c.lane == 0) cq[n] = d;
    }
    const unsigned char* PU = a.ws + WS_PU; float* psc = (float*)(a.ws + WS_PSC);
    for (int e0 = (c.bid * 8 + c.wave) * 4; e0 < 16384; e0 += c.nb * 8 * 4) {
        u32x4 uw[4];
#pragma unroll
        for (int i = 0; i < 4; ++i) uw[i] = *(const u32x4*)(PU + (size_t)(e0 + i) * 1024 + c.lane * 16);
#pragma unroll
        for (int i = 0; i < 4; ++i) {
            float d0 = 0.f, d1 = 0.f;
#pragma unroll
            for (int dw = 0; dw < 4; ++dw) { const f32x2 f0 = fp4_unpk<0>(uw[i][dw]), f1 = fp4_unpk<1>(uw[i][dw]), f2 = fp4_unpk<2>(uw[i][dw]), f3 = fp4_unpk<3>(uw[i][dw]);
                d0 += f0[0] * s[8 * dw] + f1[0] * s[8 * dw + 2] + f2[0] * s[8 * dw + 4] + f3[0] * s[8 * dw + 6];
                d1 += f0[1] * s[8 * dw + 1] + f1[1] * s[8 * dw + 3] + f2[1] * s[8 * dw + 5] + f3[1] * s[8 * dw + 7]; }
            const float d = wave_sum(d0 + d1);
            if (c.lane == 0) psc[(size_t)(e0 + i) * 4 + 1] = psc[(size_t)(e0 + i) * 4] * d;
        }
    }
}
__device__ __forceinline__ void p6_mixnorm(const Args& a, const Ctx& c) {
    const bf16_t* YS = (const bf16_t*)(a.ws + WS_YSSM); const bf16_t* YA = (const bf16_t*)(a.ws + WS_YATT); bf16_t* O = (bf16_t*)(a.ws + WS_H);
    for (int t = c.bid * 8 + c.wave; t < L_; t += c.nb * 8) {
#pragma unroll
        for (int part = 0; part < 2; ++part) {
            const bf16_t* src = (part ? YA : YS) + (size_t)t * 1024 + c.lane * 8; const float* beta = a.in[part ? 9 : 8];
            u32x4 w[2]; float f[16]; float ss = 0.f;
#pragma unroll
            for (int j = 0; j < 2; ++j) { w[j] = *(const u32x4*)(src + j * 512);
#pragma unroll
                for (int e = 0; e < 4; ++e) { f[j * 8 + 2 * e] = bflo(w[j][e]); f[j * 8 + 2 * e + 1] = bfhi(w[j][e]); } }
#pragma unroll
            for (int e = 0; e < 16; ++e) ss += f[e] * f[e];
            ss = wave_sum(ss);
            const float rstd = rsqrtf(ss * (1.f / 1024.f) + 1e-6f);
#pragma unroll
            for (int j = 0; j < 2; ++j) { const int col = j * 512 + c.lane * 8; const f32x4 b0 = *(const f32x4*)(beta + col), b1 = *(const f32x4*)(beta + col + 4);
                f32x4 o0, o1;
#pragma unroll
                for (int e = 0; e < 4; ++e) { o0[e] = f[j * 8 + e] * rstd * b0[e]; o1[e] = f[j * 8 + 4 + e] * rstd * b1[e]; }
                *(u32x4*)(O + (size_t)t * 2048 + part * 1024 + col) = pack8(o0, o1); }
        }
    }
}
constexpr int S5_US = 0, S5_ES = 33792, S5_SS = 67584, S5_TS = 84992;
template <int PASS>
__device__ __forceinline__ void s5_item(const Args& a, const Ctx& c, int g, int seg) {
    LAS unsigned char* lds = c.lds;
    int tid = c.tid; asm volatile("" : "+v"(tid));
    const int wave = c.wave, lane = tid & 63, r = lane & 15, q = lane >> 4;
    const bf16_t* U = (const bf16_t*)(a.ws + WS_US);
    const bf16_t* MT = (const bf16_t*)(a.ws + WS_S5MT) + (size_t)g * 65536;
    const bf16_t* WE = (const bf16_t*)(a.ws + WS_S5WE) + (size_t)g * 32768;
    const bf16_t* WC = (const bf16_t*)(a.ws + WS_S5WC) + (size_t)g * 32768;
    const float* s5p = (const float*)(a.ws + WS_S5P);
    float* F = (float*)(a.ws + WS_S5F) + (size_t)g * 4 * 128;
    bf16_t* Z = (bf16_t*)(a.ws + WS_Z);
    bf16x8 bE[8];
#pragma unroll
    for (int ks = 0; ks < 8; ++ks) bE[ks] = *(const bf16x8*)(WE + (size_t)(16 * wave + r) * 256 + 32 * ks + 8 * q);
    bf16x8 bM[2][8], bC[2][4];
    if (PASS == 1) {
#pragma unroll
        for (int nt = 0; nt < 2; ++nt)
#pragma unroll
            for (int ks = 0; ks < 4; ++ks) bC[nt][ks] = *(const bf16x8*)(WC + (size_t)(16 * (2 * wave + nt) + r) * 128 + 32 * ks + 8 * q);
#pragma unroll
        for (int nt = 0; nt < 2; ++nt)
#pragma unroll
            for (int ks = 0; ks < 8; ++ks) bM[nt][ks] = *(const bf16x8*)(MT + (size_t)(16 * (2 * wave + nt) + r) * 256 + 32 * ks + 8 * q);
    }
    float sr = 0.f, si = 0.f;
    const float a16r = s5p[(g * 64 + lane) * 2], a16i = s5p[(g * 64 + lane) * 2 + 1];
    float a128r = a16r, a128i = a16i;
#pragma unroll
    for (int s = 0; s < 3; ++s) { const float tr = a128r * a128r - a128i * a128i, ti = 2.f * a128r * a128i; a128r = tr; a128i = ti; }
    if (PASS == 1) { const float br = s5p[8192 + (g * 64 + lane) * 2], bi = s5p[8192 + (g * 64 + lane) * 2 + 1];
        for (int s = 0; s < seg; ++s) { const float fr_ = F[s * 128 + lane], fi_ = F[s * 128 + 64 + lane]; const float nr = br * sr - bi * si + fr_, ni = br * si + bi * sr + fi_; sr = nr; si = ni; } }
    for (int sb = 0; sb < 4; ++sb) {
        const int tok0 = seg * 4096 + sb * 1024;
#pragma unroll
        for (int i = 0; i < 4; ++i) { const int ch = tid + NTHREADS * i, token = ch >> 1, half = ch & 1;
            const u32x4 v = *(const u32x4*)(U + (size_t)(tok0 + token) * 1024 + g * 16 + half * 8);
            *(LAS u32x4*)(lds + S5_US + (token >> 4) * 528 + ((token & 15) * 16 + half * 8) * 2) = v; }
        __syncthreads();
#pragma unroll
        for (int m = 0; m < 4; ++m) {
            f32x4 acc = {0.f, 0.f, 0.f, 0.f};
#pragma unroll
            for (int ks = 0; ks < 8; ++ks) { const bf16x8 A = *(const LAS bf16x8*)(lds + S5_US + (16 * m + r) * 528 + (32 * ks + 8 * q) * 2); acc = mfma16(A, bE[ks], acc); }
#pragma unroll
            for (int i = 0; i < 4; ++i) *(LAS float*)(lds + S5_ES + ((16 * m + 4 * q + i) * 132 + 16 * wave + r) * 4) = acc[i];
        }
        __syncthreads();
        {
            float lr[8], li[8];
            float xr = 0.f, xi = 0.f;
#pragma unroll
            for (int k = 0; k < 8; ++k) {
                lr[k] = xr; li[k] = xi;
                const float er = *(const LAS float*)(lds + S5_ES + ((8 * wave + k) * 132 + lane) * 4), ei = *(const LAS float*)(lds + S5_ES + ((8 * wave + k) * 132 + 64 + lane) * 4);
                const float nr = a16r * xr - a16i * xi + er, ni = a16r * xi + a16i * xr + ei; xr = nr; xi = ni;
            }
            __builtin_amdgcn_sched_barrier(0);
            *(LAS float*)(lds + S5_TS + (wave * 128 + lane) * 4) = xr; *(LAS float*)(lds + S5_TS + (wave * 128 + 64 + lane) * 4) = xi;
            __syncthreads();
            __builtin_amdgcn_sched_barrier(0);
            float cr = sr, ci = si, mr = sr, mi = si;
#pragma unroll
            for (int w2 = 0; w2 < 8; ++w2) {
                if (w2 == wave) { mr = cr; mi = ci; }
                const float tr = *(const LAS float*)(lds + S5_TS + (w2 * 128 + lane) * 4), ti = *(const LAS float*)(lds + S5_TS + (w2 * 128 + 64 + lane) * 4);
                const float nr = a128r * cr - a128i * ci + tr, ni = a128r * ci + a128i * cr + ti; cr = nr; ci = ni;
            }
            sr = cr; si = ci;
            __builtin_amdgcn_sched_barrier(0);
            if (PASS == 1) {
                float pr = mr, pi = mi;
#pragma unroll
                for (int k = 0; k < 8; ++k) {
                    *(LAS bf16_t*)(lds + S5_SS + ((8 * wave + k) * 136 + lane) * 2) = f2bf(lr[k] + pr); *(LAS bf16_t*)(lds + S5_SS + ((8 * wave + k) * 136 + 64 + lane) * 2) = f2bf(li[k] + pi);
                    const float nr = a16r * pr - a16i * pi, ni = a16r * pi + a16i * pr; pr = nr; pi = ni;
                }
            }
        }
        __syncthreads();
        if (PASS == 1) {
#pragma unroll
            for (int nt = 0; nt < 2; ++nt) {
                const int j = 2 * wave + nt;
                f32x4 acc[4];
#pragma unroll
                for (int m = 0; m < 4; ++m) acc[m] = (f32x4){0.f, 0.f, 0.f, 0.f};
#pragma unroll
                for (int ks = 0; ks < 8; ++ks) {
                    __builtin_amdgcn_sched_barrier(0);
#pragma unroll
                    for (int m = 0; m < 4; ++m) { const bf16x8 A = *(const LAS bf16x8*)(lds + S5_US + (16 * m + r) * 528 + (32 * ks + 8 * q) * 2); acc[m] = mfma16(A, bM[nt][ks], acc[m]); }
                }
#pragma unroll
                for (int ks = 0; ks < 4; ++ks) {
                    __builtin_amdgcn_sched_barrier(0);
#pragma unroll
                    for (int m = 0; m < 4; ++m) { const bf16x8 A = *(const LAS bf16x8*)(lds + S5_SS + (16 * m + r) * 272 + (32 * ks + 8 * q) * 2); acc[m] = mfma16(A, bC[nt][ks], acc[m]); }
                }
                int lz = lane; asm volatile("" : "+v"(lz));
                const int rz = lz & 15, qz = lz >> 4;
#pragma unroll
                for (int m = 0; m < 4; ++m)
#pragma unroll
                    for (int i = 0; i < 4; ++i) { const int ch = 16 * m + 4 * qz + i; Z[(size_t)(tok0 + 16 * ch + j) * 1024 + g * 16 + rz] = f2bf(gelu_tanh(acc[m][i])); }
            }
            __syncthreads();
        }
    }
    if (PASS == 0 && wave == 0) { F[seg * 128 + lane] = sr; F[seg * 128 + 64 + lane] = si; }
}

__device__ __forceinline__ void cmp_finish_item(const Args& a, const Ctx& c, int kvsel, int rt) {
    LAS unsigned char* lds = c.lds;
    const int tid = c.tid, wave = c.wave, lane = c.lane, r = lane & 15, q = lane >> 4;
    const float* SL = (const float*)(a.ws + WS_SLAB) + (size_t)kvsel * 16 * 2048 * 256;
    const float* bpep = (const float*)(a.ws + WS_BPEP) + kvsel * 256;
    const bf16_t* W2 = (const bf16_t*)(a.ws + WS_W2) + kvsel * 128 * 256;
    bf16x8 B[8];
#pragma unroll
    for (int ks = 0; ks < 8; ++ks) B[ks] = *(const bf16x8*)(W2 + (size_t)(16 * wave + r) * 256 + 32 * ks + 8 * q);
    for (int e = tid; e < 16 * 64; e += NTHREADS) {
        const int row = e >> 6, c4 = (e & 63) * 4;
        f32x4 s = {0.f, 0.f, 0.f, 0.f};
#pragma unroll 8
        for (int pt = 0; pt < 32; ++pt) s += *(const f32x4*)(bpep + pt * 512 + c4);
#pragma unroll
        for (int ks = 0; ks < 16; ++ks) s += *(const f32x4*)(SL + ((size_t)ks * 2048 + rt * 16 + row) * 256 + c4);
        u32x2 w; w[0] = cvt_pk_bf16(gelu_tanh(s[0]), gelu_tanh(s[1])); w[1] = cvt_pk_bf16(gelu_tanh(s[2]), gelu_tanh(s[3]));
        *(LAS u32x2*)(lds + row * 528 + c4 * 2) = w;
    }
    __syncthreads();
    f32x4 acc = {0.f, 0.f, 0.f, 0.f};
#pragma unroll
    for (int ks = 0; ks < 8; ++ks) { const bf16x8 A = *(const LAS bf16x8*)(lds + r * 528 + (32 * ks + 8 * q) * 2); acc = mfma16(A, B[ks], acc); }
#pragma unroll
    for (int i = 0; i < 4; ++i) {
        const int row = rt * 16 + 4 * q + i, gi = row >> 10, ci = row & 1023, n = 16 * wave + r;
        const bf16_t v = (ci == 1023) ? (bf16_t)0 : f2bf(acc[i]);
        if (kvsel == 0) ((bf16_t*)(a.ws + WS_KC))[((size_t)gi * 1024 + ci) * 128 + n] = v;
        else ((bf16_t*)(a.ws + WS_VCT))[((size_t)gi * 128 + n) * 1024 + ((ci & ~12) | ((ci & 4) << 1) | ((ci & 8) >> 1))] = v;
    }
    __syncthreads();
}
constexpr int AT_IMP = 65536, AT_TB = 131072, AT_BM = 143872, AT_WU = 145920, AT_END = 146176;
__device__ __forceinline__ int kswz(int r) { return ((r & 3) << 2) | ((r >> 2) & 3); }
__host__ __device__ __forceinline__ int vperm(int t) { return (t & ~12) | ((t & 4) << 1) | ((t & 8) >> 1); }
template <int KEYS> __device__ __forceinline__ int vsw(int d) { return KEYS == 128 ? kswz(d) : ((d >> 1) & 7); }
template <int KEYS, bool NEEDV>
__device__ __forceinline__ void stage_dma(const bf16_t* Kt, const bf16_t* Vt, int ldv, LAS unsigned char* kb, LAS unsigned char* vb, int wave, int lane) {
    constexpr int NP = KEYS / 32;
#pragma unroll
    for (int i = 0; i < NP; ++i) { const int pc = NP * wave + i, row = 4 * pc + (lane >> 4), ch = (lane & 15) ^ kswz(row);
        __builtin_amdgcn_global_load_lds((const unsigned*)(Kt + row * 128 + ch * 8), (LAS unsigned*)(kb + pc * 1024), 16, 0, 0); }
    if (NEEDV) {
#pragma unroll
        for (int i = 0; i < NP; ++i) {
            const int pc = NP * wave + i;
            if (KEYS == 128) { const int d = 4 * pc + (lane >> 4), ch = (lane & 15) ^ kswz(d);
                __builtin_amdgcn_global_load_lds((const unsigned*)(Vt + (size_t)d * ldv + 8 * ch), (LAS unsigned*)(vb + pc * 1024), 16, 0, 0); }
            else { const int d = 8 * pc + (lane >> 3), ch = (lane & 7) ^ ((d >> 1) & 7);
                __builtin_amdgcn_global_load_lds((const unsigned*)(Vt + (size_t)d * ldv + 8 * ch), (LAS unsigned*)(vb + pc * 1024), 16, 0, 0); }
        }
    }
}
__device__ __forceinline__ float xhalf_max(float x) { auto rr = __builtin_amdgcn_permlane32_swap(__float_as_uint(x), __float_as_uint(x), false, false); return fmaxf(__uint_as_float(rr[0]), __uint_as_float(rr[1])); }
__device__ __forceinline__ float xhalf_sum(float x) { auto rr = __builtin_amdgcn_permlane32_swap(__float_as_uint(x), __float_as_uint(x), false, false); return __uint_as_float(rr[0]) + __uint_as_float(rr[1]); }
template <int BR>
__device__ __forceinline__ float tile_prep(int MODE, f32x16& S, LAS const float* tb, float cb, int base, bool selbit) {
    float mx = -INFINITY;
    if (MODE == 1) {
#pragma unroll
        for (int r = 0; r < 16; ++r) mx = fmaxf(mx, S[r]);
        mx = (BR == 2 && !selbit) ? -INFINITY : mx + cb;
    } else {
        const bool nomask = (MODE == 2);
        float bv[16];
#pragma unroll
        for (int r = 0; r < 16; ++r) { const int cr = (r & 3) + 8 * (r >> 2); const int dist = (BR <= 1) ? base - 16 * cr : base - cr; bv[r] = tb[min(max(dist, 0), TBN - 1)]; }
        __builtin_amdgcn_sched_barrier(0);
#pragma unroll
        for (int r = 0; r < 16; ++r) {
            const int cr = (r & 3) + 8 * (r >> 2);
            const int dist = (BR <= 1) ? base - 16 * cr : base - cr;
            float v = S[r] + bv[r];
            bool valid;
            if (BR <= 1) valid = dist >= 0; else if (BR == 2) valid = selbit && dist >= 0; else valid = nomask || (unsigned)dist < 512u;
            v = valid ? v : -INFINITY;
            S[r] = v; mx = fmaxf(mx, v);
        }
    }
    return mx;
}
template <int BR, bool PEND>
__device__ __forceinline__ float tile_decide(int MODE, float mx, float cb, bool selbit, f32x16 (&O)[4], float& m, float& l, u32x4& pa, u32x4& pb) {
    if (BR == 1) { const float mu = (m == -INFINITY) ? 0.f : m; return (MODE == 1) ? mu - cb : mu; }
    mx = xhalf_max(mx);
    const float mn = fmaxf(m, mx), mu = (mn == -INFINITY) ? 0.f : mn;
    if (__any(mn > m)) {
        const float alpha = fexp2(m - mu);
        l *= alpha;
        if (BR >= 2) {
#pragma unroll
            for (int dt = 0; dt < 4; ++dt)
#pragma unroll
                for (int r = 0; r < 16; ++r) O[dt][r] *= alpha;
            if (PEND) {
#pragma unroll
                for (int e = 0; e < 4; ++e) { pa[e] = cvt_pk_bf16(bflo(pa[e]) * alpha, bfhi(pa[e]) * alpha); pb[e] = cvt_pk_bf16(bflo(pb[e]) * alpha, bfhi(pb[e]) * alpha); }
            }
        }
    }
    m = mn;
    if (MODE == 1) return (BR == 2 && !selbit) ? INFINITY : mu - cb;
    return mu;
}
template <int BR, int KEYS>
__device__ __forceinline__ void attn_tile(int MODE, LAS const unsigned char* kb, LAS const unsigned char* vb, int cb0, LAS const float* tb, int key0, int t, int lane,
                                          const bf16x8 (&qf)[8], f32x16 (&O)[4], float& m, float& l, float inv_l, bool selbit, LAS float* imp_row) {
    asm volatile("" : "+v"(lane));
    constexpr int ROWB = 2 * KEYS;
    const int r31 = lane & 31, h = lane >> 5;
    const int gh = kswz(r31) ^ h, vh = vsw<KEYS>(r31) ^ h;
    float cb = 0.f;
    if (MODE == 1) cb = tb[TBN - 1];
    const int base0 = (BR <= 1) ? t - 31 - 16 * (key0 + 4 * h) : t - (key0 + 4 * h);
    const int base1 = (BR <= 1) ? base0 - 16 * 32 : base0 - 32;
    LAS const unsigned char* k0 = kb + r31 * 256;
    f32x16 S0, S1;
    bf16x8 kf[8];
#pragma unroll
    for (int ks = 0; ks < 8; ++ks) kf[ks] = *(const LAS bf16x8*)(k0 + 16 * ((2 * ks) ^ gh));
#pragma unroll
    for (int r = 0; r < 16; ++r) { S0[r] = 0.f; S1[r] = 0.f; }
    __builtin_amdgcn_sched_barrier(0);
#pragma unroll
    for (int ks = 0; ks < 8; ++ks) S0 = mfma32(kf[ks], qf[ks], S0);
    __builtin_amdgcn_sched_barrier(0);
#pragma unroll
    for (int ks = 0; ks < 8; ++ks) kf[ks] = *(const LAS bf16x8*)(k0 + 8192 + 16 * ((2 * ks) ^ gh));
    const float mx0 = tile_prep<BR>(MODE, S0, tb, cb, base0, selbit);
    u32x4 pk0a = {0u, 0u, 0u, 0u}, pk0b = {0u, 0u, 0u, 0u}, pk1a, pk1b;
    const float me0 = tile_decide<BR, false>(MODE, mx0, cb, selbit, O, m, l, pk0a, pk0b);
    __builtin_amdgcn_sched_barrier(0);
    {
#pragma unroll
        for (int ks = 0; ks < 8; ++ks) S1 = mfma32(kf[ks], qf[ks], S1);
        float ps = 0.f;
#pragma unroll
        for (int r = 0; r < 16; ++r) { float p = fexp2(S0[r] - me0); if (BR == 1) p *= inv_l; S0[r] = p; ps += p; }
        if (BR != 1) l += ps;
        if (BR >= 1) {
#pragma unroll
            for (int e = 0; e < 4; ++e) { pk0a[e] = cvt_pk_bf16(S0[2 * e], S0[2 * e + 1]); pk0b[e] = cvt_pk_bf16(S0[8 + 2 * e], S0[8 + 2 * e + 1]); }
        }
#pragma unroll
        for (int i = 0; i < 8; ++i) { __builtin_amdgcn_sched_group_barrier(0x008, 1, 0); __builtin_amdgcn_sched_group_barrier(0x002, 8, 0); }
    }
    __builtin_amdgcn_sched_barrier(0);
    if (BR == 1) {
#pragma unroll
        for (int rg = 0; rg < 4; ++rg) {
            float A = 2.f * (S0[4 * rg] + S0[4 * rg + 1] + S0[4 * rg + 2]) + S0[4 * rg + 3], B = S0[4 * rg + 3];
            A = quad_sum(A); B = quad_sum(B);
            const int jj = (key0 >> 2) + 2 * rg + h;
            if ((lane & 3) == 0) { __hip_atomic_fetch_add(imp_row + jj, A, __ATOMIC_RELAXED, __HIP_MEMORY_SCOPE_WORKGROUP);
                if (jj + 1 < 256) __hip_atomic_fetch_add(imp_row + jj + 1, B, __ATOMIC_RELAXED, __HIP_MEMORY_SCOPE_WORKGROUP); }
        }
    }
    bf16x8 av[8];
    if (BR >= 1) {
#pragma unroll
        for (int s = 0; s < 2; ++s)
#pragma unroll
            for (int dt = 0; dt < 4; ++dt) av[s * 4 + dt] = *(const LAS bf16x8*)(vb + (32 * dt + r31) * ROWB + 16 * ((cb0 + 2 * s) ^ vh));
    }
    const float mx1 = tile_prep<BR>(MODE, S1, tb, cb, base1, selbit);
    const float me1 = tile_decide<BR, true>(MODE, mx1, cb, selbit, O, m, l, pk0a, pk0b);
    __builtin_amdgcn_sched_barrier(0);
    {
        if (BR >= 1) {
#pragma unroll
            for (int dt = 0; dt < 4; ++dt) O[dt] = mfma32(av[dt], __builtin_bit_cast(bf16x8, pk0a), O[dt]);
#pragma unroll
            for (int dt = 0; dt < 4; ++dt) O[dt] = mfma32(av[4 + dt], __builtin_bit_cast(bf16x8, pk0b), O[dt]);
        }
        float ps = 0.f;
#pragma unroll
        for (int r = 0; r < 16; ++r) { float p = fexp2(S1[r] - me1); if (BR == 1) p *= inv_l; S1[r] = p; ps += p; }
        if (BR != 1) l += ps;
        if (BR >= 1) {
#pragma unroll
            for (int e = 0; e < 4; ++e) { pk1a[e] = cvt_pk_bf16(S1[2 * e], S1[2 * e + 1]); pk1b[e] = cvt_pk_bf16(S1[8 + 2 * e], S1[8 + 2 * e + 1]); }
#pragma unroll
            for (int i = 0; i < 8; ++i) { __builtin_amdgcn_sched_group_barrier(0x008, 1, 0); __builtin_amdgcn_sched_group_barrier(0x002, 8, 0); }
        }
    }
    __builtin_amdgcn_sched_barrier(0);
    if (BR == 1) {
#pragma unroll
        for (int rg = 0; rg < 4; ++rg) {
            float A = 2.f * (S1[4 * rg] + S1[4 * rg + 1] + S1[4 * rg + 2]) + S1[4 * rg + 3], B = S1[4 * rg + 3];
            A = quad_sum(A); B = quad_sum(B);
            const int jj = ((key0 + 32) >> 2) + 2 * rg + h;
            if ((lane & 3) == 0) { __hip_atomic_fetch_add(imp_row + jj, A, __ATOMIC_RELAXED, __HIP_MEMORY_SCOPE_WORKGROUP);
                if (jj + 1 < 256) __hip_atomic_fetch_add(imp_row + jj + 1, B, __ATOMIC_RELAXED, __HIP_MEMORY_SCOPE_WORKGROUP); }
        }
    }
    if (BR >= 1) {
#pragma unroll
        for (int s = 0; s < 2; ++s)
#pragma unroll
            for (int dt = 0; dt < 4; ++dt) av[s * 4 + dt] = *(const LAS bf16x8*)(vb + (32 * dt + r31) * ROWB + 16 * ((cb0 + 4 + 2 * s) ^ vh));
        __builtin_amdgcn_sched_barrier(0);
#pragma unroll
        for (int dt = 0; dt < 4; ++dt) O[dt] = mfma32(av[dt], __builtin_bit_cast(bf16x8, pk1a), O[dt]);
#pragma unroll
        for (int dt = 0; dt < 4; ++dt) O[dt] = mfma32(av[4 + dt], __builtin_bit_cast(bf16x8, pk1b), O[dt]);
    }
}
template <int BR, int KEYS>
__device__ __forceinline__ void run_branch(const Ctx& c, const bf16_t* Kb, const bf16_t* Vtb, int ldv, int lo, int hi, LAS const float* tb, int t, int t0,
                                           const bf16x8 (&qf)[8], f32x16 (&O)[4], float& m, float& l, float inv_l, int tl, LAS float* imp_row) {
    constexpr bool NEEDV = (BR != 0);
    constexpr int BPS = KEYS / 64, KSTG = KEYS * 256, VSTG = 128 * 2 * KEYS, VB0 = 2 * KSTG;
    LAS unsigned char* lds = c.lds;
    int lz = c.lane; asm volatile("" : "+v"(lz));
    const int nst = (hi - lo + BPS - 1) / BPS;
#define STG_BLK(i) ((lo + BPS * (i) + BPS - 1 < hi) ? lo + BPS * (i) : hi - BPS)
    asm volatile("s_waitcnt vmcnt(0)" ::: "memory");
    { const int b0 = (BPS == 2 && hi - lo < 2) ? lo : STG_BLK(0);
      stage_dma<KEYS, NEEDV>(Kb + (size_t)b0 * 64 * 128, Vtb + (size_t)b0 * 64, ldv, lds, lds + VB0, c.wave, lz); }
    asm volatile("s_waitcnt vmcnt(0)" ::: "memory");
    __syncthreads();
    const int qt = t0 >> 6;
    for (int i = 0; i < nst; ++i) {
        const int buf = i & 1;
        if (i + 1 < nst) { int lz2 = lz; asm volatile("" : "+v"(lz2));
            const int b1 = STG_BLK(i + 1);
            stage_dma<KEYS, NEEDV>(Kb + (size_t)b1 * 64 * 128, Vtb + (size_t)b1 * 64, ldv, lds + (buf ^ 1) * KSTG, lds + VB0 + (buf ^ 1) * VSTG, c.wave, lz2); }
        const int sb = (BPS == 2 && hi - lo < 2) ? lo : STG_BLK(i);
#pragma unroll
        for (int q = 0; q < BPS; ++q) {
            const int j = lo + BPS * i + q;
            if (j < hi) {
                bool selbit = true, wave_on = true;
                if (BR == 2) {
                    const unsigned w = *(const LAS unsigned*)(lds + AT_BM + (tl * 8 + (j >> 5)) * 4);
                    selbit = (w >> (j & 31)) & 1u;
                    const unsigned wu = *(const LAS unsigned*)(lds + AT_WU + (c.wave * 8 + (j >> 5)) * 4);
                    wave_on = (wu >> (j & 31)) & 1u;
                }
                if (wave_on) {
                    int mode = 0;
                    if (BR <= 1) mode = (1024 * j + 1829 <= t0) ? 1 : 0;
                    else if (BR == 2) mode = (64 * j + 853 <= t0) ? 1 : 0;
                    else mode = (j >= qt - 7 && j <= qt - 1) ? 2 : 0;
                    const int slot = j - sb;
                    attn_tile<BR, KEYS>(mode, lds + buf * KSTG + slot * 16384, lds + VB0 + buf * VSTG, 8 * slot, tb, j * 64, t, c.lane, qf, O, m, l, inv_l, selbit, imp_row);
                }
            }
        }
        asm volatile("s_waitcnt vmcnt(0)" ::: "memory");
        __syncthreads();
    }
#undef STG_BLK
}
__device__ __forceinline__ void attn_item(const Args& a, const Ctx& c_, int qt, int g) {
    Ctx c = c_; { int tz = c_.tid; asm volatile("" : "+v"(tz)); c.tid = tz; c.lane = tz & 63; }
    LAS unsigned char* lds = c.lds;
    const int tid = c.tid, wave = c.wave, lane = c.lane, r31 = lane & 31, h = lane >> 5, hl = lane & 3;
    const int t0 = qt * 64, tl = 8 * wave + (r31 >> 2), t = t0 + tl, head = g * 4 + hl;
    const bf16_t* Qb = (const bf16_t*)(a.ws + WS_Q);
    const bf16_t* KROW = (const bf16_t*)(a.ws + WS_KROW);
    const bf16_t* VT = (const bf16_t*)(a.ws + WS_VT);
    const float* GATE = (const float*)(a.ws + WS_GATE);
    { const float* tbg = (const float*)(a.ws + WS_TB) + g * 4 * TBN;
      for (int i = tid; i < 4 * TBN; i += NTHREADS) *(LAS float*)(lds + AT_TB + i * 4) = tbg[i];
      for (int i = tid; i < 64 * 256; i += NTHREADS) *(LAS float*)(lds + AT_IMP + i * 4) = 0.f; }
    bf16x8 qf[8];
#pragma unroll
    for (int ks = 0; ks < 8; ++ks) qf[ks] = *(const bf16x8*)(Qb + (size_t)t * 1024 + head * 128 + 16 * ks + 8 * h);
    LAS const float* tb = (LAS const float*)(lds + AT_TB) + hl * TBN;
    LAS float* imp_row = (LAS float*)(lds + AT_IMP) + tl * 256;
    bf16_t* Y = (bf16_t*)(a.ws + WS_YATT) + (size_t)t * 1024 + head * 128 + 4 * h;
    f32x16 O[4];
#pragma unroll
    for (int dt = 0; dt < 4; ++dt)
#pragma unroll
        for (int r = 0; r < 16; ++r) O[dt][r] = 0.f;
    __syncthreads();
    { const int ntile = (t0 / 16 + 3 + 63) / 64;
      const bf16_t* KC = (const bf16_t*)(a.ws + WS_KC) + (size_t)g * 1024 * 128; const bf16_t* VCT = (const bf16_t*)(a.ws + WS_VCT) + (size_t)g * 128 * 1024;
      float m = -INFINITY, l = 0.f;
#if defined(PROBE_CMP)
      run_branch<0, 64>(c, KC, VCT, 1024, 0, ntile, tb, t, t0, qf, O, m, l, 0.f, tl, imp_row);
      asm volatile("" :: "v"(m), "v"(l));
      m = -INFINITY; l = 0.f;
#endif
      run_branch<0, 64>(c, KC, VCT, 1024, 0, ntile, tb, t, t0, qf, O, m, l, 0.f, tl, imp_row);
      const float lt = xhalf_sum(l), inv = lt > 0.f ? 1.f / lt : 0.f;
      run_branch<1, 64>(c, KC, VCT, 1024, 0, ntile, tb, t, t0, qf, O, m, l, inv, tl, imp_row);
      const float gc = GATE[(size_t)t * 24 + head];
#pragma unroll
      for (int dt = 0; dt < 4; ++dt)
#pragma unroll
          for (int rg = 0; rg < 4; ++rg) {
              u32x2 w; w[0] = cvt_pk_bf16(gc * O[dt][4 * rg], gc * O[dt][4 * rg + 1]); w[1] = cvt_pk_bf16(gc * O[dt][4 * rg + 2], gc * O[dt][4 * rg + 3]);
              *(u32x2*)(Y + 32 * dt + 8 * rg) = w;
#pragma unroll
              for (int e = 0; e < 4; ++e) O[dt][4 * rg + e] = 0.f;
          }
    }
    {
        const int ncand = qt - 2 > 0 ? qt - 2 : 0;
        unsigned v[8][4], selm[8];
#pragma unroll
        for (int i = 0; i < 8; ++i) {
            LAS const float* row = (LAS const float*)(lds + AT_IMP) + (8 * wave + i) * 256;
            selm[i] = 0u;
#pragma unroll
            for (int k = 0; k < 4; ++k) { const int j = lane + 64 * k; const bool cand = (j >= 1 && j <= qt - 2);
                v[i][k] = cand ? ((__float_as_uint(row[j]) & ~0xFFu) | (unsigned)(255 - j)) : 0u; if (ncand <= 13 && cand) selm[i] |= 1u << k; }
        }
        if (ncand > 13) {
            for (int it = 0; it < 13; ++it) {
#pragma unroll
                for (int i = 0; i < 8; ++i) {
                    const unsigned mx = wave_umax_bcast(max(max(v[i][0], v[i][1]), max(v[i][2], v[i][3])));
#pragma unroll
                    for (int k = 0; k < 4; ++k) if (v[i][k] == mx) { v[i][k] = 0u; selm[i] |= 1u << k; }
                }
            }
        }
        unsigned wu[8];
#pragma unroll
        for (int k = 0; k < 8; ++k) wu[k] = 0u;
#pragma unroll
        for (int i = 0; i < 8; ++i)
#pragma unroll
            for (int k = 0; k < 4; ++k) {
                const int j = lane + 64 * k; const bool forced = (j == 0) || (j == qt) || (j == qt - 1);
                const unsigned long long mk = __ballot(((selm[i] >> k) & 1u) || forced);
                const unsigned lo = (unsigned)mk, hi = (unsigned)(mk >> 32);
                if (lane == 0) { *(LAS unsigned*)(lds + AT_BM + ((8 * wave + i) * 8 + 2 * k) * 4) = lo; *(LAS unsigned*)(lds + AT_BM + ((8 * wave + i) * 8 + 2 * k + 1) * 4) = hi; }
                wu[2 * k] |= lo; wu[2 * k + 1] |= hi;
            }
        if (lane == 0) {
#pragma unroll
            for (int k = 0; k < 8; ++k) *(LAS unsigned*)(lds + AT_WU + (wave * 8 + k) * 4) = wu[k];
        }
    }
    __syncthreads();
#if defined(PROBE_SEL)
    { float m = -INFINITY, l = 0.f;
      run_branch<2, 128>(c, KROW + (size_t)(2 + g) * L_ * 128, VT + (size_t)g * 128 * L_, L_, 0, qt + 1, tb, t, t0, qf, O, m, l, 0.f, tl, imp_row);
      asm volatile("" :: "v"(O[0]), "v"(O[1]), "v"(O[2]), "v"(O[3]), "v"(m), "v"(l));
#pragma unroll
      for (int dt = 0; dt < 4; ++dt)
#pragma unroll
          for (int r = 0; r < 16; ++r) O[dt][r] = 0.f; }
#endif
    { float m = -INFINITY, l = 0.f;
      run_branch<2, 128>(c, KROW + (size_t)(2 + g) * L_ * 128, VT + (size_t)g * 128 * L_, L_, 0, qt + 1, tb, t, t0, qf, O, m, l, 0.f, tl, imp_row);
      const float gs = GATE[(size_t)t * 24 + 8 + head];
      const float lt = xhalf_sum(l), sc = gs * (lt > 0.f ? 1.f / lt : 0.f);
#pragma unroll
      for (int dt = 0; dt < 4; ++dt)
#pragma unroll
          for (int rg = 0; rg < 4; ++rg) {
              const u32x2 w0 = *(const u32x2*)(Y + 32 * dt + 8 * rg);
              u32x2 w; w[0] = cvt_pk_bf16(bflo(w0[0]) + sc * O[dt][4 * rg], bfhi(w0[0]) + sc * O[dt][4 * rg + 1]); w[1] = cvt_pk_bf16(bflo(w0[1]) + sc * O[dt][4 * rg + 2], bfhi(w0[1]) + sc * O[dt][4 * rg + 3]);
              *(u32x2*)(Y + 32 * dt + 8 * rg) = w;
#pragma unroll
              for (int e = 0; e < 4; ++e) O[dt][4 * rg + e] = 0.f;
          }
    }
#if defined(PROBE_WIN)
    { float m = -INFINITY, l = 0.f;
      const int lo = qt - 8 > 0 ? qt - 8 : 0;
      run_branch<3, 128>(c, KROW + (size_t)(4 + g) * L_ * 128, VT + (size_t)(2 + g) * 128 * L_, L_, lo, qt + 1, tb, t, t0, qf, O, m, l, 0.f, tl, imp_row);
      asm volatile("" :: "v"(O[0]), "v"(O[1]), "v"(O[2]), "v"(O[3]), "v"(m), "v"(l));
#pragma unroll
      for (int dt = 0; dt < 4; ++dt)
#pragma unroll
          for (int r = 0; r < 16; ++r) O[dt][r] = 0.f; }
#endif
    { float m = -INFINITY, l = 0.f;
      const int lo = qt - 8 > 0 ? qt - 8 : 0;
      run_branch<3, 128>(c, KROW + (size_t)(4 + g) * L_ * 128, VT + (size_t)(2 + g) * 128 * L_, L_, lo, qt + 1, tb, t, t0, qf, O, m, l, 0.f, tl, imp_row);
      const float gw = GATE[(size_t)t * 24 + 16 + head];
      const float lt = xhalf_sum(l), sc = gw * (lt > 0.f ? 1.f / lt : 0.f);
#pragma unroll
      for (int dt = 0; dt < 4; ++dt)
#pragma unroll
          for (int rg = 0; rg < 4; ++rg) {
              const u32x2 w0 = *(const u32x2*)(Y + 32 * dt + 8 * rg);
              u32x2 w; w[0] = cvt_pk_bf16(bflo(w0[0]) + sc * O[dt][4 * rg], bfhi(w0[0]) + sc * O[dt][4 * rg + 1]); w[1] = cvt_pk_bf16(bflo(w0[1]) + sc * O[dt][4 * rg + 2], bfhi(w0[1]) + sc * O[dt][4 * rg + 3]);
              *(u32x2*)(Y + 32 * dt + 8 * rg) = w;
          }
    }
    __syncthreads();
}
#ifndef PEER_ALPHA
#define PEER_ALPHA 1.0f
#endif
constexpr int PE_SC = 0, PE_LV = 65536, PE_LI = 73728, PE_PK = 81920, PE_EX = 147456, PE_GT = 149504, PE_SU = 153600, PE_CE = 157696, PE_END = 161792;
constexpr int PE_SLOT = 2048, PE_NSLOT = 8, PE_RINGW = PE_SLOT * 9;
static_assert(8 * PE_RINGW <= PE_EX && PE_END <= LDS_BYTES - 32, "PEER LDS map");
__device__ __forceinline__ float wave_sum_bcast(float v) {
    v += dpp_f<0xB1>(v); v += dpp_f<0x4E>(v); v += dpp_f<0x141>(v); v += dpp_f<0x140>(v);
    v += __int_as_float(__builtin_amdgcn_update_dpp(0, __float_as_int(v), 0x142, 0xa, 0xf, false));
    v += __int_as_float(__builtin_amdgcn_update_dpp(0, __float_as_int(v), 0x143, 0xc, 0xf, false));
    return __int_as_float(__builtin_amdgcn_readlane(__float_as_int(v), 63));
}
__device__ __forceinline__ unsigned mono_key(float v) { const unsigned b = __float_as_uint(v); return b ^ ((b >> 31) ? 0xFFFFFFFFu : 0x80000000u); }
template <int CTRL>
__device__ __forceinline__ void quad_merge16(unsigned (&t)[16]) {
    unsigned o[16];
#pragma unroll
    for (int i = 0; i < 16; ++i) o[i] = (unsigned)__builtin_amdgcn_update_dpp(0, (int)t[15 - i], CTRL, 0xf, 0xf, false);
#pragma unroll
    for (int i = 0; i < 16; ++i) t[i] = max(t[i], o[i]);
#pragma unroll
    for (int st = 8; st >= 1; st >>= 1)
#pragma unroll
        for (int i = 0; i < 16; ++i) if ((i & st) == 0) { const unsigned hi = max(t[i], t[i + st]), lo = min(t[i], t[i + st]); t[i] = hi; t[i + st] = lo; }
}
__device__ __forceinline__ int pair_a(int p) { return p < 16 ? 0 : p < 24 ? 1 : p < 29 ? 2 : p < 33 ? 3 : p < 36 ? 4 : p < 38 ? 5 : p < 40 ? 6 : p < 42 ? 7 : p - 34; }
__device__ __forceinline__ int pair_b(int p) { return p < 16 ? p : p < 24 ? p - 16 : p < 29 ? p - 24 : p < 33 ? p - 29 : p < 36 ? p - 33 : p < 38 ? p - 36 : p < 40 ? p - 38 : p < 42 ? p - 40 : 0; }
template <bool DRY>
__device__ __forceinline__ void peer_step(const Args& a, const Ctx& c_, int t0) {
    Ctx c = c_; { int tz = c_.tid; asm volatile("" : "+v"(tz)); c.tid = tz; c.lane = tz & 63; }
    LAS unsigned char* lds = c.lds;
    const int tid = c.tid, wave = c.wave, lane = c.lane, r = lane & 15, q = lane >> 4;
    const bf16_t* QP = (const bf16_t*)(a.ws + WS_QP); const bf16_t* PK = (const bf16_t*)(a.ws + WS_PK);
    const unsigned char* PU = a.ws + WS_PU; const unsigned char* PV = a.ws + WS_PV; const float* psc = (const float*)(a.ws + WS_PSC);
    const bf16_t* HB = (const bf16_t*)(a.ws + WS_H2);
    const int t = t0 + wave;
    u32x4 hraw[4]; u32x2 xw[8];
#pragma unroll
    for (int k = 0; k < 4; ++k) hraw[k] = *(const u32x4*)(HB + (size_t)t * 2048 + lane * 32 + k * 8);
#pragma unroll
    for (int k = 0; k < 8; ++k) xw[k] = *(const u32x2*)((const bf16_t*)(a.ws + WS_X1) + (size_t)t * 2048 + lane * 32 + k * 4);
    const float r2 = ((const float*)(a.ws + WS_RSTD2))[t0 + ((tid >> 5) & 7)];
    {
#pragma unroll
        for (int i = 0; i < 8; ++i) { const int pc = 8 * wave + i, row = 4 * pc + (lane >> 4), ch = (lane & 15) ^ kswz(row);
            __builtin_amdgcn_global_load_lds((const unsigned*)(PK + (size_t)row * 128 + ch * 8), (LAS unsigned*)(lds + PE_PK + pc * 1024), 16, 0, 0); }
        const int hh = wave;
        bf16x8 aF[2][4];
#pragma unroll
        for (int cc = 0; cc < 2; ++cc)
#pragma unroll
            for (int ks = 0; ks < 4; ++ks) aF[cc][ks] = *(const bf16x8*)(QP + (size_t)(t0 + (r & 7)) * 2048 + hh * 256 + cc * 128 + 32 * ks + 8 * q);
        asm volatile("s_waitcnt vmcnt(0)" ::: "memory");
        __syncthreads();
        const int ksw = kswz(r);
#pragma unroll
        for (int cc = 0; cc < 2; ++cc)
#pragma unroll 2
            for (int nt = 0; nt < 8; ++nt) {
                f32x4 acc = {0.f, 0.f, 0.f, 0.f};
#pragma unroll
                for (int ks = 0; ks < 4; ++ks) { const bf16x8 B = *(const LAS bf16x8*)(lds + PE_PK + (cc * 128 + 16 * nt + r) * 256 + 16 * ((4 * ks + q) ^ ksw)); acc = mfma16(aF[cc][ks], B, acc); }
                if (q < 2) {
#pragma unroll
                    for (int i = 0; i < 4; ++i) { const int task = (4 * q + i) * 16 + hh * 2 + cc; *(LAS float*)(lds + PE_SC + (task * 128 + ((16 * nt + r + task) & 127)) * 4) = acc[i]; }
                }
            }
    }
    __syncthreads();
    {
        const int task = tid >> 2, part = tid & 3;
        LAS const float* sc = (LAS const float*)(lds + PE_SC) + task * 128;
        float vals[32];
#pragma unroll
        for (int k = 0; k < 32; ++k) vals[k] = sc[(32 * part + k + task) & 127];
        unsigned top[16];
#pragma unroll
        for (int e = 0; e < 16; ++e) top[e] = 0u;
#pragma unroll
        for (int k = 0; k < 32; ++k) {
            unsigned key = (mono_key(vals[k]) & ~0x7Fu) | (unsigned)(127 - (32 * part + k));
#pragma unroll
            for (int e = 0; e < 16; ++e) { const unsigned hi = max(top[e], key); key = min(top[e], key); top[e] = hi; }
        }
        quad_merge16<0xB1>(top);
        quad_merge16<0x4E>(top);
        if (part == 0) {
#pragma unroll
            for (int e = 0; e < 16; ++e) { const int idx = 127 - (int)(top[e] & 0x7Fu); *(LAS float*)(lds + PE_LV + (task * 16 + e) * 4) = sc[(idx + task) & 127]; *(LAS int*)(lds + PE_LI + (task * 16 + e) * 4) = idx; }
        }
    }
    __syncthreads();
    if (tid < 256) {
        const int task = tid >> 2, part = tid & 3, tok = task >> 3, hh = task & 7, t1 = tok * 16 + hh * 2, t2 = t1 + 1;
        LAS const float* lv1 = (LAS const float*)(lds + PE_LV) + t1 * 16; LAS const float* lv2 = (LAS const float*)(lds + PE_LV) + t2 * 16;
        unsigned top[16];
#pragma unroll
        for (int e = 0; e < 16; ++e) top[e] = 0u;
        for (int p = part; p < 50; p += 4) {
            const int aa = pair_a(p), bb = pair_b(p);
            unsigned key = (mono_key(lv1[aa] + lv2[bb]) & ~0xFFu) | (unsigned)(255 - (aa * 16 + bb));
#pragma unroll
            for (int e = 0; e < 16; ++e) { const unsigned hi = max(top[e], key); key = min(top[e], key); top[e] = hi; }
        }
        quad_merge16<0xB1>(top);
        quad_merge16<0x4E>(top);
        if (part == 0) {
            LAS const int* li1 = (LAS const int*)(lds + PE_LI) + t1 * 16; LAS const int* li2 = (LAS const int*)(lds + PE_LI) + t2 * 16;
            float sv[16]; int ex[16]; float mx = -INFINITY;
#pragma unroll
            for (int e = 0; e < 16; ++e) {
                const int id = 255 - (int)(top[e] & 0xFFu), aa = id >> 4, bb = id & 15;
                sv[e] = lv1[aa] + lv2[bb]; ex[e] = li1[aa] * 128 + li2[bb]; mx = fmaxf(mx, sv[e]);
            }
            float sum = 0.f;
#pragma unroll
            for (int e = 0; e < 16; ++e) { sv[e] = fexp2((sv[e] - mx) * LOG2E); sum += sv[e]; }
            const float inv = 1.f / sum;
#pragma unroll
            for (int e = 0; e < 16; ++e) *(LAS unsigned short*)(lds + PE_EX + (tok * 128 + hh * 16 + e) * 2) = (unsigned short)ex[e];
            f32x4 rec[16];
#pragma unroll
            for (int e = 0; e < 16; ++e) rec[e] = *(const f32x4*)(psc + (size_t)ex[e] * 4);
            __builtin_amdgcn_sched_barrier(0);
#pragma unroll
            for (int e = 0; e < 16; ++e) asm volatile("" :: "v"(rec[e]));
#pragma unroll
            for (int e = 0; e < 16; ++e) {
                *(LAS float*)(lds + PE_GT + (tok * 128 + hh * 16 + e) * 4) = sv[e] * inv * rec[e][2];
                *(LAS float*)(lds + PE_SU + (tok * 128 + hh * 16 + e) * 4) = rec[e][0] * r2;
                *(LAS float*)(lds + PE_CE + (tok * 128 + hh * 16 + e) * 4) = rec[e][1]; }
        }
    }
    __syncthreads();
    f32x2 hp[16];
#pragma unroll
    for (int k = 0; k < 4; ++k)
#pragma unroll
        for (int e = 0; e < 4; ++e) { hp[k * 4 + e][0] = bflo(hraw[k][e]); hp[k * 4 + e][1] = bfhi(hraw[k][e]); }
    f32x2 acc[16];
#pragma unroll
    for (int e = 0; e < 16; ++e) acc[e] = (f32x2){0.f, 0.f};
    asm volatile("s_waitcnt vmcnt(0)" ::: "memory");
    {
        LAS const unsigned short* exl = (LAS const unsigned short*)(lds + PE_EX) + wave * 128; LAS const float* gtl = (LAS const float*)(lds + PE_GT) + wave * 128;
        LAS const float* sul = (LAS const float*)(lds + PE_SU) + wave * 128; LAS const float* cel = (LAS const float*)(lds + PE_CE) + wave * 128;
        LAS unsigned char* ring = lds + wave * PE_RINGW;
#define ROW_ISSUE(SL, IDX) do { const int ex_ = __builtin_amdgcn_readfirstlane((int)exl[IDX]); \
            LAS unsigned char* sl_ = ring + (SL) * PE_SLOT; \
            __builtin_amdgcn_global_load_lds((const unsigned*)(PU + (size_t)ex_ * 1024 + lane * 16), (LAS unsigned*)sl_, 16, 0, 0); \
            __builtin_amdgcn_global_load_lds((const unsigned*)(PV + (size_t)ex_ * 1024 + lane * 16), (LAS unsigned*)(sl_ + 1024), 16, 0, 0); \
            } while (0)
#define UDOT(UW, D0, D1, D2, D3) do { _Pragma("unroll") for (int dw = 0; dw < 4; ++dw) { const f32x2 f0_ = fp4_unpk<0>(UW[dw]), f1_ = fp4_unpk<1>(UW[dw]), f2_ = fp4_unpk<2>(UW[dw]), f3_ = fp4_unpk<3>(UW[dw]); \
                D0 += f0_ * hp[4 * dw]; D1 += f1_ * hp[4 * dw + 1]; D2 += f2_ * hp[4 * dw + 2]; D3 += f3_ * hp[4 * dw + 3]; } } while (0)
#define VACC(VW, WG) do { _Pragma("unroll") for (int dw = 0; dw < 4; ++dw) { const f32x2 f0_ = fp4_unpk<0>(VW[dw]), f1_ = fp4_unpk<1>(VW[dw]), f2_ = fp4_unpk<2>(VW[dw]), f3_ = fp4_unpk<3>(VW[dw]); \
                acc[4 * dw] += WG * f0_; acc[4 * dw + 1] += WG * f1_; acc[4 * dw + 2] += WG * f2_; acc[4 * dw + 3] += WG * f3_; } } while (0)
#define PAIR_APPLY(SA, SB, IDX) do { LAS const unsigned char* pa_ = ring + (SA) * PE_SLOT + lane * 16; LAS const unsigned char* pb_ = ring + (SB) * PE_SLOT + lane * 16; \
            const u32x4 ua_ = *(const LAS u32x4*)pa_, ub_ = *(const LAS u32x4*)pb_, va_ = *(const LAS u32x4*)(pa_ + 1024), vb_ = *(const LAS u32x4*)(pb_ + 1024); \
            f32x2 a0_ = {0.f, 0.f}, a1_ = {0.f, 0.f}, a2_ = {0.f, 0.f}, a3_ = {0.f, 0.f}, b0_ = {0.f, 0.f}, b1_ = {0.f, 0.f}, b2_ = {0.f, 0.f}, b3_ = {0.f, 0.f}; \
            UDOT(ua_, a0_, a1_, a2_, a3_); UDOT(ub_, b0_, b1_, b2_, b3_); \
            const f32x2 as_ = (a0_ + a1_) + (a2_ + a3_), bs_ = (b0_ + b1_) + (b2_ + b3_); \
            const float da_ = wave_sum_bcast(as_[0] + as_[1]) * sul[IDX] + cel[IDX], db_ = wave_sum_bcast(bs_[0] + bs_[1]) * sul[(IDX) + 1] + cel[(IDX) + 1]; \
            const float wa_ = gtl[IDX] * gelu_tanh(da_), wb_ = gtl[(IDX) + 1] * gelu_tanh(db_); \
            VACC(va_, wa_); VACC(vb_, wb_); \
            asm volatile("s_waitcnt lgkmcnt(0)" ::: "memory"); } while (0)
#define DMA_WAIT(N) asm volatile("s_waitcnt vmcnt(" #N ")" ::: "memory")
        ROW_ISSUE(0, 0); ROW_ISSUE(1, 1); ROW_ISSUE(2, 2); ROW_ISSUE(3, 3); ROW_ISSUE(4, 4); ROW_ISSUE(5, 5); ROW_ISSUE(6, 6); ROW_ISSUE(7, 7);
#pragma unroll 1
        for (int e = 0; e < 128; e += 8) {
            const bool more = e + 8 < 128;
            DMA_WAIT(12); PAIR_APPLY(0, 1, e);     if (more) { ROW_ISSUE(0, e + 8);  ROW_ISSUE(1, e + 9); }
            if (more) DMA_WAIT(12); else DMA_WAIT(0);
            PAIR_APPLY(2, 3, e + 2); if (more) { ROW_ISSUE(2, e + 10); ROW_ISSUE(3, e + 11); }
            if (more) DMA_WAIT(12);
            PAIR_APPLY(4, 5, e + 4); if (more) { ROW_ISSUE(4, e + 12); ROW_ISSUE(5, e + 13); }
            if (more) DMA_WAIT(12);
            PAIR_APPLY(6, 7, e + 6); if (more) { ROW_ISSUE(6, e + 14); ROW_ISSUE(7, e + 15); }
        }
#undef ROW_ISSUE
#undef PAIR_APPLY
#undef UDOT
#undef VACC
#undef DMA_WAIT
    }
    {
        float* xo = a.out + (size_t)t * 2048; const float* g2 = (const float*)(a.ws + WS_COND) + 5 * 2048; const float* fg = a.in[32];
        f32x4 gvv[8], fvv[8];
#pragma unroll
        for (int k = 0; k < 8; ++k) { const int col = lane * 32 + k * 4; gvv[k] = *(const f32x4*)(g2 + col); fvv[k] = *(const f32x4*)(fg + col); }
        float ss = 0.f;
#pragma unroll
        for (int k = 0; k < 8; ++k) {
            const float x1[4] = {bflo(xw[k][0]), bfhi(xw[k][0]), bflo(xw[k][1]), bfhi(xw[k][1])};
#pragma unroll
            for (int e = 0; e < 4; ++e) { const float x2 = x1[e] + PEER_ALPHA * gvv[k][e] * acc[k * 2 + (e >> 1)][e & 1]; acc[k * 2 + (e >> 1)][e & 1] = x2; ss += x2 * x2; }
        }
        ss = wave_sum_bcast(ss);
        const float rstd = rsqrtf(ss * (1.f / 2048.f) + 1e-6f);
#pragma unroll
        for (int k = 0; k < 8; ++k) {
            const int col = lane * 32 + k * 4;
            f32x4 o;
#pragma unroll
            for (int e = 0; e < 4; ++e) o[e] = acc[k * 2 + (e >> 1)][e & 1] * rstd * fvv[k][e];
            if (!DRY || rstd == 123.456f) *(f32x4*)(xo + col) = o;
        }
    }
    __syncthreads();
}
constexpr int NPHASE = 12;
#ifndef DBG
#define DBG 0
#endif
__device__ __forceinline__ void dbg_final_norm(const Args& a, const Ctx& c, const float* src) {
    for (int t = c.bid * 8 + c.wave; t < L_; t += c.nb * 8) {
        const float* xr = src + (size_t)t * 2048 + c.lane * 4; float* o = a.out + (size_t)t * 2048 + c.lane * 4;
        f32x4 v[8]; float ss = 0.f;
#pragma unroll
        for (int j = 0; j < 8; ++j) { v[j] = *(const f32x4*)(xr + j * 256); ss += v[j][0] * v[j][0] + v[j][1] * v[j][1] + v[j][2] * v[j][2] + v[j][3] * v[j][3]; }
        ss = wave_sum(ss);
        const float rstd = rsqrtf(ss * (1.f / 2048.f) + 1e-6f);
#pragma unroll
        for (int j = 0; j < 8; ++j) { const f32x4 g = *(const f32x4*)(a.in[32] + j * 256 + c.lane * 4); *(f32x4*)(o + j * 256) = v[j] * rstd * g; }
    }
}

extern __shared__ __attribute__((aligned(16))) unsigned char smem[];

__global__ void __launch_bounds__(512, 2) fwd(Args a) {
    LAS unsigned char* lds = (LAS unsigned char*)smem;
    Ctx c; c.bid = blockIdx.x; c.nb = gridDim.x; c.tid = threadIdx.x; c.wave = __builtin_amdgcn_readfirstlane(threadIdx.x >> 6); c.lane = threadIdx.x & 63; c.lds = lds;
    volatile LAS unsigned* xbw = (volatile LAS unsigned*)(lds + LDS_BYTES - 16);
    if (c.tid < 4) xbw[c.tid] = 0u;
    __syncthreads();
    const int lo = a.ph_lo, hi = a.ph_hi;
    const bool multi = (hi - lo) > 1;
    XcdBarrier bar; bar.bar = (unsigned*)(a.ws + WS_CTL); bar.x = 0; bar.st = xbw;
    if (multi) bar = xcd_barrier_post((unsigned*)(a.ws + WS_CTL), xbw);
#ifndef PHASE_MASK
#define PHASE_MASK 0xFFFF
#endif
#if DBG == 1
#undef PHASE_MASK
#define PHASE_MASK 0x403
#elif DBG == 2 || DBG == 4 || DBG == 5
#undef PHASE_MASK
#define PHASE_MASK 0x4FF
#endif
#define IN(k) (((PHASE_MASK >> (k)) & 1) && lo <= (k) && (k) < hi)
#define REFRESH() do { int tz_ = threadIdx.x; asm volatile("" : "+v"(tz_)); c.tid = tz_; c.lane = tz_ & 63; c.wave = __builtin_amdgcn_readfirstlane(tz_ >> 6); } while (0)
#define SEAM(k) do { if (IN(k) && IN((k) + 1)) xcd_barrier(bar); } while (0)
#ifndef DUP
#define DUP -1
#endif
#define REP(k) for (int rep_ = 0; rep_ < ((DUP == (k)) ? 2 : 1); ++rep_)
#define DUP2(k, ...) do { __VA_ARGS__; if (DUP == (k)) { __syncthreads(); __VA_ARGS__; } } while (0)

    if (IN(0)) REP(0) { REFRESH(); p0_prologue(a, c); }
    SEAM(0);
    if (IN(1)) { REFRESH(); DUP2(1, p1_hnorm(a, c)); }
    SEAM(1);
    if (IN(2)) { REFRESH();
        pg8::StaticOrder S; S.init((const bf16_t*)(a.ws + WS_H), (const bf16_t*)(a.ws + WS_WIN), 2048, 2048, 2048, L_, DIN_PAD, c.nb, c.bid);
        EpiWin E{(bf16_t*)(a.ws + WS_US), (bf16_t*)(a.ws + WS_Q), (bf16_t*)(a.ws + WS_KROW), (bf16_t*)(a.ws + WS_VROW), (bf16_t*)(a.ws + WS_VT), (float*)(a.ws + WS_GATE)};
        DUP2(2, pg8::gemm_phase<EpiWin, pg8::StaticOrder>(lds, S, E));
    }
    SEAM(2);
    if (IN(3)) { REFRESH();
        DUP2(31, for (int it = c.bid; it < 256; it += c.nb) s5_item<0>(a, c, it >> 2, it & 3));
        __syncthreads();
        CmpOrder S{(const bf16_t*)(a.ws + WS_KROW), (const bf16_t*)(a.ws + WS_VROW), (const bf16_t*)(a.ws + WS_W1), 2048, 4096, 256, c.nb, c.bid};
        EpiSlab E{(float*)(a.ws + WS_SLAB)};
        DUP2(32, pg8::gemm_phase<EpiSlab, CmpOrder>(lds, S, E));
    }
    SEAM(3);
    if (IN(4)) { REFRESH();
        DUP2(41, for (int it = c.bid; it < 256; it += c.nb) cmp_finish_item(a, c, it >> 7, it & 127));
        DUP2(42, for (int it = c.bid; it < 256; it += c.nb) s5_item<1>(a, c, it >> 2, it & 3));
    }
    SEAM(4);
    if (IN(5)) { REFRESH();
#if DBG == 5
        for (size_t i = (size_t)c.bid * NTHREADS + c.tid; i < (size_t)L_ * 1024 / 8; i += (size_t)c.nb * NTHREADS) *(u32x4*)((bf16_t*)(a.ws + WS_YSSM) + i * 8) = (u32x4){0u, 0u, 0u, 0u};
#else
        {
            pg8::StaticOrder S; S.init((const bf16_t*)(a.ws + WS_Z), (const bf16_t*)(a.ws + WS_WGLU), 1024, 1024, 1024, L_, 1024, c.nb, c.bid);
            EpiGlu E{(const bf16_t*)(a.ws + WS_Z), a.in[19], (bf16_t*)(a.ws + WS_YSSM)};
            DUP2(55, pg8::gemm_phase<EpiGlu, pg8::StaticOrder>(lds, S, E));
        }
#endif
        __syncthreads();
        REP(5)
#if DBG == 4
        for (size_t i = (size_t)c.bid * NTHREADS + c.tid; i < (size_t)L_ * 1024 / 8; i += (size_t)c.nb * NTHREADS) *(u32x4*)((bf16_t*)(a.ws + WS_YATT) + i * 8) = (u32x4){0u, 0u, 0u, 0u};
#else
        {
            unsigned* qhead = (unsigned*)(a.ws + WS_CTL) + 8192;
            volatile LAS unsigned* slot = (volatile LAS unsigned*)(lds + LDS_BYTES - 32);
            for (;;) {
                if (c.tid == 0) *slot = __hip_atomic_fetch_add(qhead, 1u, __ATOMIC_RELAXED, __HIP_MEMORY_SCOPE_AGENT);
                __syncthreads();
                const unsigned q = *slot;
                __syncthreads();
                if (q >= 512u) break;
                attn_item(a, c, 255 - (int)(q >> 1), (int)(q & 1));
            }
        }
#endif
    }
    SEAM(5);
    if (IN(6)) { REFRESH(); DUP2(6, p6_mixnorm(a, c)); }
    SEAM(6);
#define WOUT_GEMM(PM0) do { pg8::StaticOrder S; S.init((const bf16_t*)(a.ws + WS_H), (const bf16_t*)(a.ws + WS_WOUT), 2048, 2048, 2048, L_ / 2, 2048, c.nb, c.bid, PM0); \
        EpiWout E{a.in[0], (const float*)(a.ws + WS_COND) + 2 * 2048, (const float*)(a.ws + WS_F2), (bf16_t*)(a.ws + WS_X1), (bf16_t*)(a.ws + WS_H2), (float*)(a.ws + WS_ST2P)}; \
        pg8::gemm_phase<EpiWout, pg8::StaticOrder>(lds, S, E); __syncthreads(); } while (0)
#define WQ_GEMM(PM0) do { pg8::StaticOrder S; S.init((const bf16_t*)(a.ws + WS_H2), (const bf16_t*)(a.ws + WS_WQ), 2048, 2048, 2048, L_ / 2, 2048, c.nb, c.bid, PM0); \
        rstd2_prepass(S, (const float*)(a.ws + WS_ST2P), (float*)(a.ws + WS_RSTD2), c.tid); \
        EpiQ E{(bf16_t*)(a.ws + WS_QP), (const float*)(a.ws + WS_RSTD2), (const float*)(a.ws + WS_CQ)}; pg8::gemm_phase<EpiQ, pg8::StaticOrder>(lds, S, E); __syncthreads(); } while (0)
#define PEER_STEPS(FIRST, COUNT) do { for (int s_ = (FIRST) + c.bid; s_ < (FIRST) + (COUNT); s_ += c.nb) peer_step<false>(a, c, s_ * 8); } while (0)
    if (IN(7)) { REFRESH(); DUP2(7, p_cqce(a, c)); DUP2(71, WOUT_GEMM(0)); }
    SEAM(7);
    if (IN(8)) { REFRESH(); DUP2(8, WQ_GEMM(0)); }
    SEAM(8);
    if (IN(9)) { REFRESH();
        if ((c.bid >> 3) & 1) PEER_STEPS(0, 512);
        WOUT_GEMM(32);
        if (!((c.bid >> 3) & 1)) PEER_STEPS(0, 512); }
    SEAM(9);
    if (IN(10)) { REFRESH();
        if ((c.bid >> 3) & 1) PEER_STEPS(512, 512);
        WQ_GEMM(32);
        if (!((c.bid >> 3) & 1)) PEER_STEPS(512, 512); }
    SEAM(10);
    if (IN(11)) { REFRESH(); DUP2(11, PEER_STEPS(1024, 1024)); }
#undef WOUT_GEMM
#undef WQ_GEMM
#undef PEER_STEPS
#undef IN
#undef SEAM
}

#ifndef N_LAUNCHES
#define N_LAUNCHES 1
#endif
extern "C" void kernel_launch(void* const* d_in, const int* in_sizes, int n_in, void* d_out, int out_size, void* d_ws, size_t ws_size, hipStream_t stream) {
    static int grid = 0;
    if (grid == 0) {
        if (n_in != 33 || out_size != L_ * D_ || ws_size < WS_END) { fprintf(stderr, "kernel_launch: unexpected shapes (n_in %d, out %d, ws %zu < %zu); nothing launched\n", n_in, out_size, ws_size, (size_t)WS_END); grid = -1; return; }
        int dev = 0, cus = 0, per_cu = 0;
        if (hipGetDevice(&dev) != hipSuccess || hipDeviceGetAttribute(&cus, hipDeviceAttributeMultiprocessorCount, dev) != hipSuccess) { grid = -1; return; }
        if (hipFuncSetAttribute((const void*)fwd, hipFuncAttributeMaxDynamicSharedMemorySize, LDS_BYTES) != hipSuccess) { fprintf(stderr, "kernel_launch: hipFuncSetAttribute failed\n"); grid = -1; return; }
        if (hipOccupancyMaxActiveBlocksPerMultiprocessor(&per_cu, (const void*)fwd, NTHREADS, LDS_BYTES) != hipSuccess || per_cu < 1) { fprintf(stderr, "kernel_launch: occupancy query says %d\n", per_cu); (void)hipGetLastError(); grid = -1; return; }
        grid = cus;
    }
    if (grid < 0) return;
    (void)hipMemsetAsync((char*)d_ws + WS_CTL, 0, CTL_BYTES, stream);
    Args a{};
    for (int i = 0; i < 33; ++i) a.in[i] = (const float*)d_in[i];
    a.out = (float*)d_out; a.ws = (unsigned char*)d_ws;
    if (N_LAUNCHES == 1) { a.ph_lo = 0; a.ph_hi = NPHASE; hipLaunchKernelGGL(fwd, dim3(grid), dim3(NTHREADS), LDS_BYTES, stream, a); }
    else for (int p = 0; p < NPHASE; ++p) { a.ph_lo = p; a.ph_hi = p + 1; hipLaunchKernelGGL(fwd, dim3(grid), dim3(NTHREADS), LDS_BYTES, stream, a); }
}
```

```cpp
#include <hip/hip_runtime.h>
#include <stdint.h>
#include <stdio.h>

#define LAS __attribute__((address_space(3)))
typedef unsigned short bf16_t;
typedef short bf16x8 __attribute__((ext_vector_type(8)));
typedef float f32x2 __attribute__((ext_vector_type(2)));
typedef float f32x4 __attribute__((ext_vector_type(4)));
typedef float f32x16 __attribute__((ext_vector_type(16)));
typedef unsigned u32x2 __attribute__((ext_vector_type(2)));
typedef unsigned u32x4 __attribute__((ext_vector_type(4)));
typedef __bf16 bfv2 __attribute__((ext_vector_type(2)));
typedef unsigned u32x6 __attribute__((ext_vector_type(6)));
typedef float f32x32 __attribute__((ext_vector_type(32)));

constexpr int L_ = 16384, D_ = 2048, DSSM = 1024, DATT = 1024, DIN = 3608, DIN_PAD = 3840;
constexpr int NADA = 12288;
constexpr float LOG2E = 1.4426950408889634f;
constexpr float QSCALE = 0.08838834764831845f * 1.4426950408889634f;
constexpr int TBN = 800;
constexpr int NTHREADS = 512;
constexpr int LDS_BYTES = 163840;

constexpr size_t al256(size_t x) { return (x + 255) & ~(size_t)255; }
constexpr size_t WS_CTL   = 0;                                  constexpr size_t CTL_BYTES = 65536;
constexpr size_t WS_CONDP = WS_CTL + CTL_BYTES;
constexpr size_t WS_COND  = WS_CONDP + 32 * 12288 * 4;
constexpr size_t WS_TB    = WS_COND + 12288 * 4;
constexpr size_t WS_BPE   = al256(WS_TB + 8 * TBN * 4);
constexpr size_t WS_S5P   = al256(WS_BPE + 2 * 256 * 4);
constexpr size_t WS_S5F   = WS_S5P + 2 * 64 * 64 * 2 * 4;
constexpr size_t WS_S5MT  = WS_S5F + 64 * 4 * 128 * 4;
constexpr size_t WS_S5WE  = WS_S5MT + (size_t)64 * 256 * 256 * 2;
constexpr size_t WS_S5WC  = WS_S5WE + (size_t)64 * 128 * 256 * 2;
constexpr size_t WS_WIN   = WS_S5WC + (size_t)64 * 256 * 128 * 2;
constexpr size_t WS_WGLU  = WS_WIN + (size_t)DIN_PAD * 2048 * 2;
constexpr size_t WS_WOUT  = WS_WGLU + (size_t)1024 * 1024 * 2;
constexpr size_t WS_WQ    = WS_WOUT + (size_t)2048 * 2048 * 2;
constexpr size_t WS_W1    = WS_WQ + (size_t)2048 * 2048 * 2;
constexpr size_t WS_W2    = WS_W1 + (size_t)2 * 256 * 4096 * 2;
constexpr size_t WS_PK    = WS_W2 + (size_t)2 * 128 * 256 * 2;
constexpr size_t WS_PU    = WS_PK + (size_t)2 * 128 * 128 * 2;
constexpr size_t WS_PV    = WS_PU + (size_t)16384 * 1024;
constexpr size_t WS_PSC   = WS_PV + (size_t)16384 * 1024;
constexpr size_t WS_BPEP  = WS_PSC + (size_t)4 * 16384 * 4;
constexpr size_t WS_H     = WS_BPEP + (size_t)32 * 2 * 256 * 4;
constexpr size_t WS_US    = WS_H + (size_t)16384 * 2048 * 2;
constexpr size_t WS_Q     = WS_US + (size_t)16384 * 1024 * 2;
constexpr size_t WS_QP    = WS_US;
constexpr size_t WS_KROW  = WS_Q + (size_t)16384 * 1024 * 2;
constexpr size_t WS_VROW  = WS_KROW + (size_t)6 * 16384 * 128 * 2;
constexpr size_t WS_VT    = WS_VROW + (size_t)2 * 16384 * 128 * 2 + 8192;
constexpr size_t WS_GATE  = WS_VT + (size_t)4 * 128 * 16384 * 2;
constexpr size_t WS_SLAB  = WS_GATE + (size_t)16384 * 24 * 4;
constexpr size_t WS_KC    = WS_SLAB + (size_t)2 * 16 * 2048 * 256 * 4;
constexpr size_t WS_VCT   = WS_KC + (size_t)2 * 1024 * 128 * 2;
constexpr size_t WS_Z     = WS_VCT + (size_t)2 * 128 * 1024 * 2;
constexpr size_t WS_YSSM  = WS_Z + (size_t)16384 * 1024 * 2;
constexpr size_t WS_YATT  = WS_YSSM + (size_t)16384 * 1024 * 2;
constexpr size_t WS_H2    = WS_SLAB;
constexpr size_t WS_Y2    = WS_YSSM;
constexpr size_t WS_X1    = WS_H;
constexpr size_t WS_ST2P  = WS_YATT + (size_t)16384 * 1024 * 2;
constexpr size_t WS_RSTD2 = WS_ST2P + (size_t)16384 * 32 * 4;
constexpr size_t WS_F2    = WS_RSTD2 + (size_t)16384 * 4;
constexpr size_t WS_CQ    = WS_F2 + 2048 * 4;
constexpr size_t WS_STSP  = WS_CQ + 2048 * 4;
constexpr size_t WS_STAP  = WS_STSP + (size_t)16384 * 16 * 4;
constexpr size_t WS_RSA   = WS_STAP + (size_t)16384 * 2 * 4;
constexpr size_t WS_END   = WS_RSA + (size_t)16384 * 2 * 4;
static_assert(WS_END < (size_t)530 * 1024 * 1024, "workspace map too large");

struct Args { const float* in[33]; float* out; unsigned char* ws; int ph_lo, ph_hi; };

__device__ __forceinline__ unsigned cvt_pk_bf16(float lo, float hi) { bfv2 v; v[0] = (__bf16)lo; v[1] = (__bf16)hi; return __builtin_bit_cast(unsigned, v); }
__device__ __forceinline__ bf16_t f2bf(float f) { return (bf16_t)(cvt_pk_bf16(f, 0.f) & 0xffffu); }
__device__ __forceinline__ float bf2f(unsigned b) { return __uint_as_float(b << 16); }
__device__ __forceinline__ float bflo(unsigned w) { return __uint_as_float(w << 16); }
__device__ __forceinline__ float bfhi(unsigned w) { return __uint_as_float(w & 0xffff0000u); }
__device__ __forceinline__ float fexp2(float x) { return __builtin_amdgcn_exp2f(x); }
__device__ __forceinline__ float frcp(float x) { return __builtin_amdgcn_rcpf(x); }
__device__ __forceinline__ float sigmoidf_(float x) { return frcp(1.f + fexp2(-LOG2E * x)); }
__device__ __forceinline__ float gelu_tanh(float x) {
    const float u = x * (1.f + 0.044715f * x * x);
    return x * frcp(1.f + fexp2(-2.f * 0.7978845608028654f * LOG2E * u));
}
__device__ __forceinline__ float shfl_xor_f(float v, int m) { return __shfl_xor(v, m, 64); }
__device__ __forceinline__ float wave_sum(float v) {
#pragma unroll
    for (int m = 32; m >= 1; m >>= 1) v += __shfl_xor(v, m, 64);
    return v;
}
__device__ __forceinline__ float wave_max(float v) {
#pragma unroll
    for (int m = 32; m >= 1; m >>= 1) v = fmaxf(v, __shfl_xor(v, m, 64));
    return v;
}
template <int CTRL> __device__ __forceinline__ float dpp_f(float x) { return __int_as_float(__builtin_amdgcn_update_dpp(0, __float_as_int(x), CTRL, 0xf, 0xf, false)); }
__device__ __forceinline__ float wave_max_bcast(float v) {
    v = fmaxf(v, dpp_f<0xB1>(v)); v = fmaxf(v, dpp_f<0x4E>(v)); v = fmaxf(v, dpp_f<0x141>(v)); v = fmaxf(v, dpp_f<0x140>(v));
    v = fmaxf(v, __int_as_float(__builtin_amdgcn_update_dpp(__float_as_int(v), __float_as_int(v), 0x142, 0xa, 0xf, false)));
    v = fmaxf(v, __int_as_float(__builtin_amdgcn_update_dpp(__float_as_int(v), __float_as_int(v), 0x143, 0xc, 0xf, false)));
    return __int_as_float(__builtin_amdgcn_readlane(__float_as_int(v), 63));
}
__device__ __forceinline__ unsigned wave_umax_bcast(unsigned v) {
#define UDPP_(x, ctrl, rm) (unsigned)__builtin_amdgcn_update_dpp((int)(x), (int)(x), ctrl, rm, 0xf, false)
    v = max(v, UDPP_(v, 0xB1, 0xf)); v = max(v, UDPP_(v, 0x4E, 0xf)); v = max(v, UDPP_(v, 0x141, 0xf)); v = max(v, UDPP_(v, 0x140, 0xf));
    v = max(v, UDPP_(v, 0x142, 0xa)); v = max(v, UDPP_(v, 0x143, 0xc));
#undef UDPP_
    return (unsigned)__builtin_amdgcn_readlane((int)v, 63);
}
__device__ __forceinline__ float quad_sum(float x) { x += dpp_f<0xB1>(x); x += dpp_f<0x4E>(x); return x; }
template <int SEL> __device__ __forceinline__ f32x2 fp4_unpk(unsigned w) { return __builtin_amdgcn_cvt_scalef32_pk_f32_fp4(w, 1.0f, SEL); }
template <int SEL> __device__ __forceinline__ unsigned fp4_pk(unsigned w, float a, float b) { return __builtin_amdgcn_cvt_scalef32_pk_fp4_f32(w, a, b, 1.0f, SEL); }
__device__ __forceinline__ f32x4 mfma16(bf16x8 a, bf16x8 b, f32x4 c) { return __builtin_amdgcn_mfma_f32_16x16x32_bf16(a, b, c, 0, 0, 0); }
__device__ __forceinline__ f32x16 mfma32(bf16x8 a, bf16x8 b, f32x16 c) { return __builtin_amdgcn_mfma_f32_32x32x16_bf16(a, b, c, 0, 0, 0); }
#define XB_TMO      128
#define XB_XCNT(j)  (256  + 64 * (j))
#define XB_XSUB(j)  (1280 + 64 * (j))
#define XB_XGEN(j)  (2304 + 64 * (j))
#define XB_TOP      3328
#define XB_TOPGEN   3392
#define XCD_BAR_WORDS 3456
#define XB_SPIN_CAP (1u << 18)

__device__ __forceinline__ unsigned xb_ld(unsigned* p)              { return __hip_atomic_load(p, __ATOMIC_RELAXED, __HIP_MEMORY_SCOPE_AGENT); }
__device__ __forceinline__ unsigned xb_add(unsigned* p, unsigned v) { return __hip_atomic_fetch_add(p, v, __ATOMIC_RELAXED, __HIP_MEMORY_SCOPE_AGENT); }
__device__ __forceinline__ unsigned xb_xcc_id() { return (unsigned)__builtin_amdgcn_s_getreg((3 << 11) | 20) & 0xFu; }
#define XB_SPIN(cond, bar) do { unsigned _sp = 0; while (cond) { __builtin_amdgcn_s_sleep(1); \
    if ((++_sp & 255u) == 0u) { if (xb_ld(&(bar)[XB_TMO])) break; if (_sp > XB_SPIN_CAP) { atomicAdd(&(bar)[XB_TMO], 1u); break; } } } } while (0)

struct XcdBarrier {
    unsigned* bar; unsigned x;
    volatile LAS unsigned* st;
};
__device__ __forceinline__ XcdBarrier xcd_barrier_post(unsigned* bar, volatile LAS unsigned* st) {
    XcdBarrier b; b.bar = bar; b.x = xb_xcc_id(); b.st = st;
    if (threadIdx.x == 0) (void)xb_add(&bar[XB_XCNT(b.x)], 1u);
    return b;
}
__device__ __forceinline__ void xcd_barrier_complete(unsigned* bar, unsigned x, unsigned& nloc, unsigned& nx) {
    const unsigned G = gridDim.x * gridDim.y * gridDim.z;
    unsigned sum, cnt, mine, sp = 0u;
    for (;;) {
        sum = 0u; cnt = 0u; mine = 0u;
#pragma unroll
        for (unsigned j = 0; j < 16; ++j) { const unsigned c = xb_ld(&bar[XB_XCNT(j)]); sum += c; cnt += (c > 0u) ? 1u : 0u; mine = (j == x) ? c : mine; }
        if (sum == G) break;
        __builtin_amdgcn_s_sleep(1);
        if ((++sp & 255u) == 0u) { if (xb_ld(&bar[XB_TMO])) break; if (sp > XB_SPIN_CAP) { atomicAdd(&bar[XB_TMO], 1u); break; } }
    }
    nloc = mine > 0u ? mine : 1u; nx = cnt > 0u ? cnt : 1u;
}
__device__ __forceinline__ void xcd_barrier(const XcdBarrier& b) {
    asm volatile("s_waitcnt vmcnt(0)" ::: "memory");
    __syncthreads();
    if (threadIdx.x == 0) {
        unsigned* bar = b.bar;
        __builtin_amdgcn_s_waitcnt(0);
        unsigned nloc = b.st[0], nx = b.st[1];
        if (nloc == 0u) { xcd_barrier_complete(bar, b.x, nloc, nx); b.st[0] = nloc; b.st[1] = nx; }
        const unsigned old = xb_add(&bar[XB_XSUB(b.x)], 1u);
        const unsigned gen = old / nloc;
        if (old + 1u == (gen + 1u) * nloc) {
            __builtin_amdgcn_fence(__ATOMIC_RELEASE, "agent");
            asm volatile("s_waitcnt vmcnt(0)" ::: "memory");
            const unsigned og = xb_add(&bar[XB_TOP], 1u);
            const unsigned tg = og / nx;
            if (og + 1u == (tg + 1u) * nx) xb_add(&bar[XB_TOPGEN], 1u);
            else XB_SPIN(xb_ld(&bar[XB_TOPGEN]) == tg, bar);
            __builtin_amdgcn_fence(__ATOMIC_ACQUIRE, "agent");
            xb_add(&bar[XB_XGEN(b.x)], 1u);
            asm volatile("s_waitcnt vmcnt(0)" ::: "memory");
        } else {
            XB_SPIN(xb_ld(&bar[XB_XGEN(b.x)]) == gen, bar);
            __builtin_amdgcn_fence(__ATOMIC_ACQUIRE, "agent");
            asm volatile("s_waitcnt vmcnt(0)" ::: "memory");
        }
    }
    __syncthreads();
}

namespace pg8 {
constexpr int BM = 256, BK = 64, HALF = 128, HTB = HALF * BK * 2, STAGE_BYTES = 8 * HTB, NXCD = 8, WGM = 8;
__host__ __device__ __forceinline__ int lds_byte(int r, int c) { const int st = (r >> 4) * 2 + (c >> 5), rr = r & 15, cc = c & 31, ob = rr * 64 + cc * 2; return st * 1024 + (ob ^ (((ob >> 9) & 1) << 5)); }
__host__ __device__ __forceinline__ void stage_rc(int b, int& R, int& C) { const int st = b / 1024, sb = b % 1024, swz = sb ^ (((sb >> 9) & 1) << 5); R = (st >> 1) * 16 + swz / 64; C = (st & 1) * 32 + (swz % 64) / 2; }
__host__ __device__ __forceinline__ int perm32(int rho) { const int n = rho >> 4, i = rho & 15; return 8 * (i >> 2) + 4 * n + (i & 3); }

struct Unit { int pm, pn, z; };
struct StaticOrder {
    const bf16_t* A; const bf16_t* Bt; int lda, ldb, K;
    int nM, nN, nwg, G, c, pm0;
    __device__ void init(const bf16_t* A_, const bf16_t* Bt_, int lda_, int ldb_, int K_, int M, int N, int G_, int c_, int pm0_ = 0) { A = A_; Bt = Bt_; lda = lda_; ldb = ldb_; K = K_; nM = M / BM; nN = N / BM; nwg = nM * nN; G = G_; c = c_; pm0 = pm0_; }
    __device__ bool next(int i, Unit& u) const {
        const long Lx = (long)i * G + c; if (Lx >= nwg) return false;
        int wgid = (int)Lx; { const int q = nwg / NXCD, r = nwg % NXCD, xcd = wgid % NXCD, off = wgid / NXCD; wgid = (xcd < r ? xcd * (q + 1) : r * (q + 1) + (xcd - r) * q) + off; }
        const int nig = WGM * nN, gid = wgid / nig, fm = gid * WGM, gsz = (nM - fm) < WGM ? (nM - fm) : WGM;
        u.pm = pm0 + fm + ((wgid % nig) % gsz); u.pn = (wgid % nig) / gsz; u.z = 0; return true;
    }
    __device__ __forceinline__ const char* a_base(const Unit& u) const { return (const char*)(A + (size_t)u.pm * BM * lda); }
    __device__ __forceinline__ const char* b_base(const Unit& u) const { return (const char*)(Bt + (size_t)u.pn * BM * ldb); }
};

template <class Epi, class Sched>
__device__ __forceinline__ void gemm_phase(LAS unsigned char* lds, const Sched& S, const Epi& E) {
    const int tid = threadIdx.x, wid = __builtin_amdgcn_readfirstlane(tid >> 6), lane = tid & 63, wr = wid >> 2, wc = wid & 3, fr = lane & 15, fq = lane >> 4;
    const int K = S.K, nt = K / BK, lda = S.lda, ldb = S.ldb;
    unsigned voffA[2], voffB[2];
#pragma unroll
    for (int i = 0; i < 2; ++i) { int R, C; stage_rc(tid * 16 + i * 8192, R, C); const int Rb = Epi::PERM ? ((R & ~31) + perm32(R & 31)) : R;
        voffA[i] = (unsigned)(R * lda + C) * 2u; voffB[i] = (unsigned)(Rb * ldb + C) * 2u; }
    const size_t kstep = (size_t)(BK * 2);
    const size_t hstepA = (size_t)HALF * lda * 2, hstepB = (size_t)HALF * ldb * 2;
    const unsigned ldsw = (unsigned)wid * 1024u;
    const int aoff = lds_byte(wr * 64 + fr, fq * 8), boff = lds_byte(wc * 32 + fr, fq * 8);
#define PG8_SA(b, h) (((b) * 2 + (h)) * HTB)
#define PG8_SB(b, h) ((4 + (b) * 2 + (h)) * HTB)
#define PG8_STAGE(bufoff, gbase, voff) do { _Pragma("unroll") for (int _i = 0; _i < 2; ++_i) \
        __builtin_amdgcn_global_load_lds((const unsigned*)((const char*)(gbase) + (voff)[_i]), (LAS unsigned*)(lds + (bufoff) + ldsw + _i * 8192), 16, 0, 0); } while (0)
#define PG8_LDA(dst, b, h) do { _Pragma("unroll") for (int m = 0; m < 4; ++m) _Pragma("unroll") for (int k = 0; k < 2; ++k) dst[m][k] = *(const LAS bf16x8*)(lds + PG8_SA(b, h) + aoff + m * 2048 + k * 1024); } while (0)
#define PG8_LDB(dst, b, h) do { _Pragma("unroll") for (int n = 0; n < 2; ++n) _Pragma("unroll") for (int k = 0; k < 2; ++k) dst[n][k] = *(const LAS bf16x8*)(lds + PG8_SB(b, h) + boff + n * 2048 + k * 1024); } while (0)
#define PG8_MMA(ai, bj, At, Bt) do { __builtin_amdgcn_s_setprio(1); _Pragma("unroll") for (int m = 0; m < 4; ++m) _Pragma("unroll") for (int n = 0; n < 2; ++n) _Pragma("unroll") for (int k = 0; k < 2; ++k) \
        acc[ai][bj][m][n] = __builtin_amdgcn_mfma_f32_16x16x32_bf16(Bt[n][k], At[m][k], acc[ai][bj][m][n], 0, 0, 0); __builtin_amdgcn_s_setprio(0); } while (0)
#define PG8_WAIT_V(n) asm volatile("s_waitcnt vmcnt(" #n ")" ::: "memory")
#define PG8_WAIT_L(n) asm volatile("s_waitcnt lgkmcnt(" #n ")" ::: "memory")
#define PG8_BAR __builtin_amdgcn_s_barrier()
#define PG8_SCHED __builtin_amdgcn_sched_barrier(0)
    Unit cur, nxt; int ui = 0;
    if (!S.next(0, cur)) return;
    f32x4 acc[2][2][4][2];
#pragma unroll
    for (int a = 0; a < 2; ++a)
#pragma unroll
        for (int b = 0; b < 2; ++b)
#pragma unroll
            for (int m = 0; m < 4; ++m)
#pragma unroll
                for (int n = 0; n < 2; ++n) acc[a][b][m][n] = (f32x4){0.f, 0.f, 0.f, 0.f};
    bf16x8 At[4][2], B0[2][2], B1[2][2];
    const char* cA = S.a_base(cur); const char* cB = S.b_base(cur);
    PG8_STAGE(PG8_SB(0, 0), cB, voffB); PG8_STAGE(PG8_SA(0, 0), cA, voffA); PG8_STAGE(PG8_SB(0, 1), cB + hstepB, voffB); PG8_STAGE(PG8_SA(0, 1), cA + hstepA, voffA);
    if (wr == 1) PG8_BAR;
    PG8_WAIT_V(4); PG8_BAR;
    PG8_STAGE(PG8_SB(1, 0), cB + kstep, voffB); PG8_STAGE(PG8_SA(1, 0), cA + kstep, voffA); PG8_STAGE(PG8_SB(1, 1), cB + hstepB + kstep, voffB);
    PG8_WAIT_V(6); PG8_BAR;
    for (;;) {
        const bool has_next = S.next(ui + 1, nxt);
        const char* nA = has_next ? S.a_base(nxt) : cA; const char* nB = has_next ? S.b_base(nxt) : cB;
        for (int t = 0; t < nt; t += 2) {
            if constexpr (Epi::MIDK) { if (t == (nt >> 1)) E.midk(acc, cur, wr, fr); }
            const bool last = (t == nt - 2);
            const char* a1 = cA + (size_t)(t + 1) * kstep;
            const char* a2 = last ? nA : cA + (size_t)(t + 2) * kstep; const char* b2 = last ? nB : cB + (size_t)(t + 2) * kstep;
            const char* a3 = a2 + kstep; const char* b3 = b2 + kstep;
            PG8_LDB(B0, 0, 0); PG8_SCHED; PG8_LDA(At, 0, 0); PG8_STAGE(PG8_SA(1, 1), a1 + hstepA, voffA);
            PG8_WAIT_L(8); PG8_BAR; PG8_WAIT_L(0); PG8_MMA(0, 0, At, B0); PG8_BAR; PG8_SCHED;
            PG8_LDB(B1, 0, 1); PG8_STAGE(PG8_SB(0, 0), b2, voffB);
            PG8_BAR; PG8_WAIT_L(0); PG8_MMA(0, 1, At, B1); PG8_BAR;
            PG8_LDA(At, 0, 1); PG8_STAGE(PG8_SA(0, 0), a2, voffA);
            PG8_BAR; PG8_WAIT_L(0); PG8_MMA(1, 0, At, B0); PG8_BAR; PG8_SCHED;
            PG8_STAGE(PG8_SB(0, 1), b2 + hstepB, voffB);
            PG8_WAIT_V(6); PG8_BAR; PG8_MMA(1, 1, At, B1); PG8_BAR;
            PG8_LDB(B0, 1, 0); PG8_SCHED; PG8_LDA(At, 1, 0); PG8_STAGE(PG8_SA(0, 1), a2 + hstepA, voffA);
            PG8_WAIT_L(8); PG8_BAR; PG8_WAIT_L(0); PG8_MMA(0, 0, At, B0); PG8_BAR; PG8_SCHED;
            PG8_LDB(B1, 1, 1); PG8_STAGE(PG8_SB(1, 0), b3, voffB);
            PG8_BAR; PG8_WAIT_L(0); PG8_MMA(0, 1, At, B1); PG8_BAR;
            PG8_LDA(At, 1, 1); PG8_STAGE(PG8_SA(1, 0), a3, voffA);
            PG8_BAR; PG8_WAIT_L(0); PG8_MMA(1, 0, At, B0); PG8_BAR; PG8_SCHED;
            PG8_STAGE(PG8_SB(1, 1), b3 + hstepB, voffB);
            PG8_WAIT_V(6); PG8_BAR; PG8_MMA(1, 1, At, B1); PG8_BAR;
        }
        E(acc, cur, wr, wc, fr, fq);
        if (!has_next) break;
#pragma unroll
        for (int a = 0; a < 2; ++a)
#pragma unroll
            for (int b = 0; b < 2; ++b)
#pragma unroll
                for (int m = 0; m < 4; ++m)
#pragma unroll
                    for (int n = 0; n < 2; ++n) acc[a][b][m][n] = (f32x4){0.f, 0.f, 0.f, 0.f};
        cur = nxt; cA = nA; cB = nB; ++ui;
    }
    PG8_WAIT_V(0);
    if (wr == 0) PG8_BAR;
    PG8_BAR;
#undef PG8_SA
#undef PG8_SB
#undef PG8_STAGE
#undef PG8_LDA
#undef PG8_LDB
#undef PG8_MMA
#undef PG8_WAIT_V
#undef PG8_WAIT_L
#undef PG8_BAR
#undef PG8_SCHED
}
}
using pg8::Unit;
__device__ __forceinline__ u32x4 pack8(const f32x4& v0, const f32x4& v1) {
    u32x4 o; o[0] = cvt_pk_bf16(v0[0], v0[1]); o[1] = cvt_pk_bf16(v0[2], v0[3]); o[2] = cvt_pk_bf16(v1[0], v1[1]); o[3] = cvt_pk_bf16(v1[2], v1[3]); return o;
}
struct EpiWin {
    static constexpr bool PERM = true; static constexpr bool MIDK = false;
    bf16_t* US; bf16_t* Q; bf16_t* KROW; bf16_t* VROW; bf16_t* VT; float* GATE;
    __device__ __forceinline__ void operator()(const f32x4 (&acc)[2][2][4][2], const Unit& u, int wr, int wc, int fr, int fq) const {
        const int row0 = u.pm * 256 + wr * 64 + fr; const int pn = u.pn;
#pragma unroll
        for (int ai = 0; ai < 2; ++ai)
#pragma unroll
            for (int m = 0; m < 4; ++m) {
                const int row = row0 + ai * 128 + m * 16;
#pragma unroll
                for (int bj = 0; bj < 2; ++bj) {
                    const f32x4 v0 = acc[ai][bj][m][0], v1 = acc[ai][bj][m][1];
                    const int cin = bj * 128 + wc * 32 + 8 * fq;
                    if (pn < 4) { *(u32x4*)(US + (size_t)row * 1024 + pn * 256 + cin) = pack8(v0, v1); }
                    else if (pn < 8) { *(u32x4*)(Q + (size_t)row * 1024 + (pn - 4) * 256 + cin) = pack8(v0 * QSCALE, v1 * QSCALE); }
                    else if (pn < 14) {
                        const int kvi = pn - 8, branch = kvi >> 1, kvsel = kvi & 1, g = bj, d0 = wc * 32 + 8 * fq;
                        if (kvsel == 0) { *(u32x4*)(KROW + ((size_t)(branch * 2 + g) * L_ + row) * 128 + d0) = pack8(v0, v1); }
                        else if (branch == 0) { *(u32x4*)(VROW + ((size_t)g * L_ + row) * 128 + d0) = pack8(v0, v1); }
                        else {
                            const int prow = ((row & ~12) | ((row & 4) << 1) | ((row & 8) >> 1));
                            bf16_t* vt = VT + ((size_t)((branch - 1) * 2 + g) * 128 + d0) * L_ + prow;
#pragma unroll
                            for (int e = 0; e < 4; ++e) { vt[(size_t)e * L_] = f2bf(v0[e]); vt[(size_t)(e + 4) * L_] = f2bf(v1[e]); }
                        }
                    } else {
                        if (cin < 24) {
                            float* gp = GATE + (size_t)row * 24 + cin;
                            f32x4 s0, s1;
#pragma unroll
                            for (int e = 0; e < 4; ++e) { s0[e] = sigmoidf_(v0[e]); s1[e] = sigmoidf_(v1[e]); }
                            *(f32x4*)gp = s0; *(f32x4*)(gp + 4) = s1;
                        }
                    }
                }
            }
    }
};
struct EpiGlu {
    static constexpr bool PERM = true; static constexpr bool MIDK = false;
    const bf16_t* Z; const float* bglu; bf16_t* Y; float* stsp;
    __device__ __forceinline__ void operator()(const f32x4 (&acc)[2][2][4][2], const Unit& u, int wr, int wc, int fr, int fq) const {
        const int row0 = u.pm * 256 + wr * 64 + fr;
        float ss[2][4];
#pragma unroll
        for (int ai = 0; ai < 2; ++ai)
#pragma unroll
            for (int m = 0; m < 4; ++m) ss[ai][m] = 0.f;
#pragma unroll
        for (int bj = 0; bj < 2; ++bj) {
            const int col = u.pn * 256 + bj * 128 + wc * 32 + 8 * fq;
            const f32x4 b0 = *(const f32x4*)(bglu + col), b1 = *(const f32x4*)(bglu + col + 4);
#pragma unroll
            for (int ai = 0; ai < 2; ++ai)
#pragma unroll
                for (int m = 0; m < 4; ++m) {
                    const int row = row0 + ai * 128 + m * 16;
                    const u32x4 zz = *(const u32x4*)(Z + (size_t)row * 1024 + col);
                    const f32x4 v0 = acc[ai][bj][m][0] + b0, v1 = acc[ai][bj][m][1] + b1;
                    f32x4 o0, o1;
                    o0[0] = bflo(zz[0]) * sigmoidf_(v0[0]); o0[1] = bfhi(zz[0]) * sigmoidf_(v0[1]); o0[2] = bflo(zz[1]) * sigmoidf_(v0[2]); o0[3] = bfhi(zz[1]) * sigmoidf_(v0[3]);
                    o1[0] = bflo(zz[2]) * sigmoidf_(v1[0]); o1[1] = bfhi(zz[2]) * sigmoidf_(v1[1]); o1[2] = bflo(zz[3]) * sigmoidf_(v1[2]); o1[3] = bfhi(zz[3]) * sigmoidf_(v1[3]);
                    *(u32x4*)(Y + (size_t)row * 2048 + col) = pack8(o0, o1);
                    ss[ai][m] += (o0[0] * o0[0] + o0[1] * o0[1]) + (o0[2] * o0[2] + o0[3] * o0[3]) + (o1[0] * o1[0] + o1[1] * o1[1]) + (o1[2] * o1[2] + o1[3] * o1[3]);
                }
        }
#pragma unroll
        for (int ai = 0; ai < 2; ++ai)
#pragma unroll
            for (int m = 0; m < 4; ++m) {
                float s = ss[ai][m];
                s += __shfl_xor(s, 16); s += __shfl_xor(s, 32);
                if (fq == 0) stsp[(size_t)(row0 + ai * 128 + m * 16) * 16 + u.pn * 4 + wc] = s;
            }
    }
};
struct EpiWout {
    static constexpr bool PERM = true; static constexpr bool MIDK = true;
    const float* X; const float* g1; const float* f2; bf16_t* X1; bf16_t* A2; float* st2p; const float* rsa;
    __device__ __forceinline__ void midk(f32x4 (&acc)[2][2][4][2], const Unit& u, int, int) const {
        int tz = threadIdx.x; asm volatile("" : "+v"(tz));
        const int row0 = u.pm * 256 + ((tz >> 8) & 1) * 64 + (tz & 15);
#pragma unroll
        for (int ai = 0; ai < 2; ++ai)
#pragma unroll
            for (int m = 0; m < 4; ++m) {
                const float r = rsa[(size_t)(row0 + ai * 128 + m * 16) * 2];
#pragma unroll
                for (int bj = 0; bj < 2; ++bj)
#pragma unroll
                    for (int n = 0; n < 2; ++n) acc[ai][bj][m][n] *= r;
            }
    }
    __device__ __forceinline__ void operator()(const f32x4 (&acc)[2][2][4][2], const Unit& u, int, int, int, int) const {
        int tz = threadIdx.x; asm volatile("" : "+v"(tz));
        const int wr = (tz >> 8) & 1, wc = (tz >> 6) & 3, fr = tz & 15, fq = (tz >> 4) & 3;
        const int row0 = u.pm * 256 + wr * 64 + fr, col0 = u.pn * 256 + wc * 32 + 8 * fq;
        float ss[2][4], ra[2][4];
#pragma unroll
        for (int ai = 0; ai < 2; ++ai)
#pragma unroll
            for (int m = 0; m < 4; ++m) { ss[ai][m] = 0.f; ra[ai][m] = rsa[(size_t)(row0 + ai * 128 + m * 16) * 2 + 1]; }
#pragma unroll
        for (int bj = 0; bj < 2; ++bj) {
            const int col = col0 + bj * 128;
            const f32x4 g0 = *(const f32x4*)(g1 + col), g4 = *(const f32x4*)(g1 + col + 4), f0 = *(const f32x4*)(f2 + col), f4 = *(const f32x4*)(f2 + col + 4);
#pragma unroll
            for (int ai = 0; ai < 2; ++ai)
#pragma unroll
                for (int m = 0; m < 4; ++m) {
                    const size_t off = (size_t)(row0 + ai * 128 + m * 16) * 2048 + col;
                    const f32x4 x0 = *(const f32x4*)(X + off), x4 = *(const f32x4*)(X + off + 4);
                    const f32x4 v0 = x0 + g0 * (acc[ai][bj][m][0] * ra[ai][m]), v1 = x4 + g4 * (acc[ai][bj][m][1] * ra[ai][m]);
                    *(u32x4*)(X1 + off) = pack8(v0, v1);
                    *(u32x4*)(A2 + off) = pack8(v0 * f0, v1 * f4);
                    ss[ai][m] += (v0[0] * v0[0] + v0[1] * v0[1]) + (v0[2] * v0[2] + v0[3] * v0[3]) + (v1[0] * v1[0] + v1[1] * v1[1]) + (v1[2] * v1[2] + v1[3] * v1[3]);
                }
        }
#pragma unroll
        for (int ai = 0; ai < 2; ++ai)
#pragma unroll
            for (int m = 0; m < 4; ++m) {
                float s = ss[ai][m];
                s += __shfl_xor(s, 16); s += __shfl_xor(s, 32);
                if (fq == 0) st2p[(size_t)(row0 + ai * 128 + m * 16) * 32 + u.pn * 4 + wc] = s;
            }
    }
};
struct EpiQ {
    static constexpr bool PERM = true; static constexpr bool MIDK = false;
    bf16_t* O; const float* rstd2; const float* cq;
    __device__ __forceinline__ void operator()(const f32x4 (&acc)[2][2][4][2], const Unit& u, int wr, int wc, int fr, int fq) const {
        const int row0 = u.pm * 256 + wr * 64 + fr, col0 = u.pn * 256 + wc * 32 + 8 * fq;
        float rs[2][4];
#pragma unroll
        for (int ai = 0; ai < 2; ++ai)
#pragma unroll
            for (int m = 0; m < 4; ++m) rs[ai][m] = rstd2[row0 + ai * 128 + m * 16];
#pragma unroll
        for (int bj = 0; bj < 2; ++bj) {
            const int col = col0 + bj * 128;
            const f32x4 c0 = *(const f32x4*)(cq + col), c4 = *(const f32x4*)(cq + col + 4);
#pragma unroll
            for (int ai = 0; ai < 2; ++ai)
#pragma unroll
                for (int m = 0; m < 4; ++m)
                    *(u32x4*)(O + (size_t)(row0 + ai * 128 + m * 16) * 2048 + col) = pack8(acc[ai][bj][m][0] * rs[ai][m] + c0, acc[ai][bj][m][1] * rs[ai][m] + c4);
        }
    }
};
template <class Sched>
__device__ __forceinline__ void rstd2_prepass(const Sched& S, const float* st2p, float* rstd2, int tid) {
    Unit u;
    for (int i = 0; S.next(i, u); ++i)
        if (tid < 256) {
            const int row = u.pm * 256 + tid; const f32x4* p = (const f32x4*)(st2p + (size_t)row * 32);
            float s = 0.f;
#pragma unroll
            for (int k = 0; k < 8; ++k) { const f32x4 v = p[k]; s += (v[0] + v[1]) + (v[2] + v[3]); }
            rstd2[row] = rsqrtf(s * (1.f / 2048.f) + 1e-6f);
        }
    __syncthreads();
}
struct EpiSlab {
    static constexpr bool PERM = false; static constexpr bool MIDK = false;
    float* SL;
    __device__ __forceinline__ void operator()(const f32x4 (&acc)[2][2][4][2], const Unit& u, int wr, int wc, int fr, int fq) const {
        float* base = SL + (size_t)u.z * 2048 * 256;
        const int row0 = u.pm * 256 + wr * 64 + fr, col0 = wc * 32 + 4 * fq;
#pragma unroll
        for (int ai = 0; ai < 2; ++ai)
#pragma unroll
            for (int m = 0; m < 4; ++m)
#pragma unroll
                for (int bj = 0; bj < 2; ++bj)
#pragma unroll
                    for (int n = 0; n < 2; ++n)
                        *(f32x4*)(base + (size_t)(row0 + ai * 128 + m * 16) * 256 + col0 + bj * 128 + n * 16) = acc[ai][bj][m][n];
    }
};
struct CmpOrder {
    const bf16_t* KROW; const bf16_t* VROW; const bf16_t* W1; int lda, ldb, K; int G, c;
    __device__ bool next(int i, Unit& u) const {
        const int x = i * G + c; if (x >= 256) return false;
        const int kvsel = x >> 7, pm = (x & 127) >> 4, ks = x & 15; u.pm = pm; u.pn = 0; u.z = kvsel * 16 + ks; return true;
    }
    __device__ __forceinline__ const char* a_base(const Unit& u) const { return (const char*)(((u.z >> 4) ? VROW : KROW) + (size_t)u.pm * 256 * 2048 + (u.z & 15) * 256); }
    __device__ __forceinline__ const char* b_base(const Unit& u) const { return (const char*)(W1 + (size_t)(u.z >> 4) * 256 * 4096 + (u.z & 15) * 256); }
};
template <class Sched>
__device__ __forceinline__ void rsa_prepass(const Sched& S, const float* stsp, const float* stap, float* rsa, int tid) {
    Unit u;
    for (int i = 0; S.next(i, u); ++i)
        if (tid < 256) {
            const int row = u.pm * 256 + tid; const f32x4* p = (const f32x4*)(stsp + (size_t)row * 16);
            float s = 0.f;
#pragma unroll
            for (int k = 0; k < 4; ++k) { const f32x4 v = p[k]; s += (v[0] + v[1]) + (v[2] + v[3]); }
            const f32x2 q = *(const f32x2*)(stap + (size_t)row * 2);
            const float rs = rsqrtf(s * (1.f / 1024.f) + 1e-6f), ra = rsqrtf((q[0] + q[1]) * (1.f / 1024.f) + 1e-6f);
            f32x2 o; o[0] = rs / ra; o[1] = ra;
            *(f32x2*)(rsa + (size_t)row * 2) = o;
        }
    __syncthreads();
}
struct Ctx { int bid, nb, tid, wave, lane; LAS unsigned char* lds; };

__device__ __forceinline__ void p0_cond(const Args& a, const Ctx& c) {
    const float* cv = a.in[1]; const float* w = a.in[2]; float* condp = (float*)(a.ws + WS_CONDP);
    for (int u = c.bid * 8 + c.wave; u < 1536; u += c.nb * 8) {
        const int cc = u % 48, kc = u / 48;
        const float* wp = w + (size_t)(kc * 64) * NADA + cc * 256 + c.lane * 4;
        f32x4 acc = {0.f, 0.f, 0.f, 0.f};
#pragma unroll 16
        for (int k = 0; k < 64; ++k) { const float x = cv[kc * 64 + k]; const float s = x / (1.f + __expf(-x)); acc += s * *(const f32x4*)(wp + (size_t)k * NADA); }
        *(f32x4*)(condp + (size_t)kc * NADA + cc * 256 + c.lane * 4) = acc;
    }
}
__device__ __forceinline__ void conv_T(const float* src, int K, int N, bf16_t* dst, int Npad, const Ctx& c, const float* ks0 = nullptr, const float* ks1 = nullptr) {
    LAS float* tile = (LAS float*)c.lds;
    const int nkt = K / 64, ntiles = nkt * (Npad / 64);
    const int r = c.tid >> 4, c4 = c.tid & 15;
    f32x4 v[2]; float sc[2] = {1.f, 1.f};
#define CONVT_LD(tix_) do { const int nt_ = (tix_) / nkt, kt_ = (tix_) % nkt, n_ = nt_ * 64 + 4 * c4; _Pragma("unroll") for (int i = 0; i < 2; ++i) { const int k_ = kt_ * 64 + r + 32 * i; v[i] = (f32x4){0.f, 0.f, 0.f, 0.f}; if (n_ < N) v[i] = *(const f32x4*)(src + (size_t)k_ * N + n_); if (ks0) sc[i] = k_ < 1024 ? ks0[k_] : ks1[k_ - 1024]; } } while (0)
    if (c.bid < ntiles) CONVT_LD(c.bid);
    for (int tix = c.bid; tix < ntiles; tix += c.nb) {
        const int nt = tix / nkt, kt = tix % nkt;
#pragma unroll
        for (int i = 0; i < 2; ++i) { LAS float* tp = tile + (r + 32 * i) * 65 + 4 * c4; tp[0] = v[i][0] * sc[i]; tp[1] = v[i][1] * sc[i]; tp[2] = v[i][2] * sc[i]; tp[3] = v[i][3] * sc[i]; }
        __syncthreads();
        if (tix + c.nb < ntiles) CONVT_LD(tix + c.nb);
        { const int n = c.tid >> 3, kq = c.tid & 7; float w[8];
#pragma unroll
          for (int j = 0; j < 8; ++j) w[j] = tile[(kq * 8 + j) * 65 + n];
          u32x4 o; o[0] = cvt_pk_bf16(w[0], w[1]); o[1] = cvt_pk_bf16(w[2], w[3]); o[2] = cvt_pk_bf16(w[4], w[5]); o[3] = cvt_pk_bf16(w[6], w[7]);
          *(u32x4*)(dst + (size_t)(nt * 64 + n) * K + kt * 64 + kq * 8) = o; }
        __syncthreads();
    }
#undef CONVT_LD
}
__device__ __forceinline__ void conv_fp4rows(const float* src, unsigned char* dst4, float* scl, int rows, const Ctx& c) {
    const int stride = c.nb * 8;
    int row = c.bid * 8 + c.wave;
    f32x4 v[8], w[8];
    if (row < rows) {
#pragma unroll
        for (int j = 0; j < 8; ++j) v[j] = *(const f32x4*)(src + (size_t)row * 2048 + c.lane * 32 + j * 4);
    }
    for (; row < rows; row += stride) {
        const int nrow = row + stride;
        if (nrow < rows) {
#pragma unroll
            for (int j = 0; j < 8; ++j) w[j] = *(const f32x4*)(src + (size_t)nrow * 2048 + c.lane * 32 + j * 4);
        }
        float mx = 0.f;
#pragma unroll
        for (int j = 0; j < 8; ++j) mx = fmaxf(mx, fmaxf(fmaxf(fabsf(v[j][0]), fabsf(v[j][1])), fmaxf(fabsf(v[j][2]), fabsf(v[j][3]))));
        mx = wave_max(mx);
        const float s = mx > 0.f ? 6.f / mx : 1.f;
        if (c.lane == 0) scl[(size_t)row * 4] = mx > 0.f ? mx * (1.f / 6.f) : 1.f;
        u32x4 pk = {0u, 0u, 0u, 0u};
#pragma unroll
        for (int d = 0; d < 4; ++d) {
            unsigned wq = 0u;
            wq = fp4_pk<0>(wq, v[2 * d][0] * s, v[2 * d][1] * s); wq = fp4_pk<1>(wq, v[2 * d][2] * s, v[2 * d][3] * s);
            wq = fp4_pk<2>(wq, v[2 * d + 1][0] * s, v[2 * d + 1][1] * s); wq = fp4_pk<3>(wq, v[2 * d + 1][2] * s, v[2 * d + 1][3] * s);
            pk[d] = wq;
        }
        *(u32x4*)(dst4 + (size_t)row * 1024 + c.lane * 16) = pk;
#pragma unroll
        for (int j = 0; j < 8; ++j) v[j] = w[j];
    }
}
__device__ __forceinline__ void conv_E(const float* src, bf16_t* dst, size_t n8, const Ctx& c) {
    const size_t stride = (size_t)c.nb * NTHREADS;
    for (size_t i = (size_t)c.bid * NTHREADS + c.tid; i < n8; i += stride) {
        const f32x4 x = *(const f32x4*)(src + i * 8), y = *(const f32x4*)(src + i * 8 + 4);
        *(u32x4*)(dst + i * 8) = pack8(x, y);
    }
}
__device__ __forceinline__ int t5_bucket(int n) {
    if (n < 16) return n;
    const float scaled = logf((float)n / 16.f) / logf(64.f);
    const int large = 16 + (int)(scaled * 16.f);
    return large < 31 ? large : 31;
}
__device__ __forceinline__ void p0_tb(const Args& a, const Ctx& c) {
    float* tb = (float*)(a.ws + WS_TB); const float* rb = a.in[26];
    for (int i = c.bid * NTHREADS + c.tid; i < 8 * TBN; i += c.nb * NTHREADS) { const int head = i / TBN, dist = i % TBN; tb[i] = rb[t5_bucket(dist) * 8 + head] * LOG2E; }
}
__device__ __forceinline__ void p0_bpe(const Args& a, const Ctx& c, int part) {
    const int n = c.tid & 255, kv = c.tid >> 8;
    const float* pe = a.in[kv ? 23 : 20]; const float* w1 = a.in[kv ? 24 : 21]; float* bpep = (float*)(a.ws + WS_BPEP);
    float s = 0.f;
#pragma unroll 16
    for (int k = part * 128; k < part * 128 + 128; ++k) s += pe[k] * w1[(size_t)k * 256 + n];
    bpep[(part * 2 + kv) * 256 + n] = s;
}
__device__ __forceinline__ void p0_s5(const Args& a, const Ctx& c, int g, int part) {
    LAS float* ar = (LAS float*)c.lds;
    LAS float* ai = ar + 17 * 64;
    LAS float* bbr = ai + 17 * 64;
    LAS float* bbi = bbr + 1024;
    LAS float* cr = bbi + 1024;
    LAS float* ci = cr + 1024;
    LAS float* kd = ci + 1024;
    const int tid = c.tid;
    if (tid < 64) {
        const int p = tid; const float dt = expf(a.in[12][g]); const float lr = a.in[10][g * 64 + p], li = a.in[11][g * 64 + p];
        for (int d = 0; d <= 16; ++d) { const float mag = expf(lr * dt * (float)d), ang = li * dt * (float)d; ar[d * 64 + p] = mag * cosf(ang); ai[d * 64 + p] = mag * sinf(ang); }
        const float nr = ar[64 + p] - 1.f, ni = ai[64 + p], den = lr * lr + li * li;
        const float wre = (nr * lr + ni * li) / den, wim = (ni * lr - nr * li) / den;
        for (int h = 0; h < 16; ++h) { const float br = a.in[13][(g * 64 + p) * 16 + h], bi = a.in[14][(g * 64 + p) * 16 + h]; bbr[p * 16 + h] = wre * br - wim * bi; bbi[p * 16 + h] = wre * bi + wim * br; }
        if (part == 0) {
        float* s5p = (float*)(a.ws + WS_S5P);
        float xr = ar[16 * 64 + p], xi = ai[16 * 64 + p];
        s5p[(g * 64 + p) * 2] = xr; s5p[(g * 64 + p) * 2 + 1] = xi;
        for (int s = 0; s < 8; ++s) { const float tr = xr * xr - xi * xi, ti = 2.f * xr * xi; xr = tr; xi = ti; }
        s5p[64 * 64 * 2 + (g * 64 + p) * 2] = xr; s5p[64 * 64 * 2 + (g * 64 + p) * 2 + 1] = xi;
        }
    }
    for (int e = tid; e < 1024; e += NTHREADS) { cr[e] = a.in[15][g * 1024 + e]; ci[e] = a.in[16][g * 1024 + e]; }
    __syncthreads();
    for (int e = tid; e < 1024 * (part + 1); e += NTHREADS) {
        const int d = e >> 8, h1 = (e >> 4) & 15, h = e & 15; float s = 0.f;
        for (int p = 0; p < 64; ++p) { const float Cr = cr[h1 * 64 + p], Ci = ci[h1 * 64 + p], Ar = ar[d * 64 + p], Ai = ai[d * 64 + p];
            const float Gr = Cr * Ar - Ci * Ai, Gi = Cr * Ai + Ci * Ar; s += Gr * bbr[p * 16 + h] - Gi * bbi[p * 16 + h]; }
        if (d == 0 && h1 == h) s += a.in[17][g * 16 + h];
        kd[e] = s;
    }
    __syncthreads();
    bf16_t* MT = (bf16_t*)(a.ws + WS_S5MT) + (size_t)g * 65536;
    bf16_t* WE = (bf16_t*)(a.ws + WS_S5WE) + (size_t)g * 32768;
    bf16_t* WC = (bf16_t*)(a.ws + WS_S5WC) + (size_t)g * 32768;
    for (int e = 16384 * part + tid; e < 16384 * (part + 1); e += NTHREADS) { const int n = e >> 8, k = e & 255, j = n >> 4, h1 = n & 15, i = k >> 4, h = k & 15;
        MT[e] = f2bf(i <= j ? kd[(j - i) * 256 + h1 * 16 + h] : 0.f); }
    for (int e = 8192 * part + tid; e < 8192 * (part + 1); e += NTHREADS) { const int n = e >> 8, k = e & 255, cc = n >> 6, p = n & 63, i = k >> 4, h = k & 15;
        const float Ar = ar[(15 - i) * 64 + p], Ai = ai[(15 - i) * 64 + p], Br = bbr[p * 16 + h], Bi = bbi[p * 16 + h];
        WE[e] = f2bf(cc ? (Ar * Bi + Ai * Br) : (Ar * Br - Ai * Bi)); }
    for (int e = 8192 * part + tid; e < 8192 * (part + 1); e += NTHREADS) { const int n = e >> 7, k = e & 127, j = n >> 4, h1 = n & 15, cc = k >> 6, p = k & 63;
        const float Cr = cr[h1 * 64 + p], Ci = ci[h1 * 64 + p], Ar = ar[(j + 1) * 64 + p], Ai = ai[(j + 1) * 64 + p];
        WC[e] = f2bf(cc ? -(Cr * Ai + Ci * Ar) : (Cr * Ar - Ci * Ai)); }
    __syncthreads();
}
__device__ __forceinline__ void p0_prologue(const Args& a, const Ctx& c) {
    for (int u = c.bid; u < 256; u += c.nb) p0_s5(a, c, u >> 2, u & 3);
    for (int u = 0; u < 32; ++u) if (c.bid == (8 * u + 7) % c.nb) p0_bpe(a, c, u);
    p0_tb(a, c);
    p0_cond(a, c);
    conv_T(a.in[6], 2048, DIN, (bf16_t*)(a.ws + WS_WIN), DIN_PAD, c);
    conv_T(a.in[18], 1024, 1024, (bf16_t*)(a.ws + WS_WGLU), 1024, c);
    conv_T(a.in[7], 2048, 2048, (bf16_t*)(a.ws + WS_WOUT), 2048, c, a.in[8], a.in[9]);
    conv_T(a.in[27], 2048, 2048, (bf16_t*)(a.ws + WS_WQ), 2048, c);
    conv_T(a.in[21], 4096, 256, (bf16_t*)(a.ws + WS_W1), 256, c);
    conv_T(a.in[24], 4096, 256, (bf16_t*)(a.ws + WS_W1) + 256 * 4096, 256, c);
    conv_T(a.in[22], 256, 128, (bf16_t*)(a.ws + WS_W2), 128, c);
    conv_T(a.in[25], 256, 128, (bf16_t*)(a.ws + WS_W2) + 128 * 256, 128, c);
    conv_E(a.in[28], (bf16_t*)(a.ws + WS_PK), 128 * 128 / 8, c);
    conv_E(a.in[29], (bf16_t*)(a.ws + WS_PK) + 128 * 128, 128 * 128 / 8, c);
    conv_fp4rows(a.in[30], a.ws + WS_PU, (float*)(a.ws + WS_PSC), 16384, c);
    conv_fp4rows(a.in[31], a.ws + WS_PV, (float*)(a.ws + WS_PSC) + 2, 16384, c);
}

__device__ __forceinline__ void norm_rows(const float* X, bf16_t* O, LAS const float* Ab, LAS const float* Bb, const Ctx& c, int row0 = 0, int nrows = L_) {
    for (int t = row0 + c.bid * 8 + c.wave; t < row0 + nrows; t += c.nb * 8) {
        const float* xr = X + (size_t)t * 2048 + c.lane * 4;
        f32x4 v[8]; float ss = 0.f;
#pragma unroll
        for (int j = 0; j < 8; ++j) { v[j] = *(const f32x4*)(xr + j * 256); ss += v[j][0] * v[j][0] + v[j][1] * v[j][1] + v[j][2] * v[j][2] + v[j][3] * v[j][3]; }
        ss = wave_sum(ss);
        const float rstd = rsqrtf(ss * (1.f / 2048.f) + 1e-6f);
#pragma unroll
        for (int j = 0; j < 8; ++j) {
            const int col = j * 256 + c.lane * 4;
            const f32x4 A = *(const LAS f32x4*)(Ab + col), B = *(const LAS f32x4*)(Bb + col);
            const f32x4 o = v[j] * rstd * A + B;
            u32x2 w; w[0] = cvt_pk_bf16(o[0], o[1]); w[1] = cvt_pk_bf16(o[2], o[3]);
            *(u32x2*)(O + (size_t)t * 2048 + col) = w;
        }
    }
}
__device__ __forceinline__ void norm_rows_bf16(const bf16_t* X, bf16_t* O, LAS const float* Ab, LAS const float* Bb, const Ctx& c, int row0, int nrows) {
    for (int t = row0 + c.bid * 8 + c.wave; t < row0 + nrows; t += c.nb * 8) {
        const bf16_t* xr = X + (size_t)t * 2048 + c.lane * 8;
        u32x4 w[4]; float ss = 0.f;
#pragma unroll
        for (int j = 0; j < 4; ++j) { w[j] = *(const u32x4*)(xr + j * 512);
#pragma unroll
            for (int e = 0; e < 4; ++e) { const float a0 = bflo(w[j][e]), a1 = bfhi(w[j][e]); ss += a0 * a0 + a1 * a1; } }
        ss = wave_sum(ss);
        const float rstd = rsqrtf(ss * (1.f / 2048.f) + 1e-6f);
#pragma unroll
        for (int j = 0; j < 4; ++j) {
            const int col = j * 512 + c.lane * 8;
            const f32x4 A0 = *(const LAS f32x4*)(Ab + col), A1 = *(const LAS f32x4*)(Ab + col + 4), B0 = *(const LAS f32x4*)(Bb + col), B1 = *(const LAS f32x4*)(Bb + col + 4);
            f32x4 o0, o1;
#pragma unroll
            for (int e = 0; e < 2; ++e) { o0[2 * e] = bflo(w[j][e]) * rstd * A0[2 * e] + B0[2 * e]; o0[2 * e + 1] = bfhi(w[j][e]) * rstd * A0[2 * e + 1] + B0[2 * e + 1];
                o1[2 * e] = bflo(w[j][2 + e]) * rstd * A1[2 * e] + B1[2 * e]; o1[2 * e + 1] = bfhi(w[j][2 + e]) * rstd * A1[2 * e + 1] + B1[2 * e + 1]; }
            *(u32x4*)(O + (size_t)t * 2048 + col) = pack8(o0, o1);
        }
    }
}
__device__ __forceinline__ float cond_from_partials(const float* condp, const float* b_ada, int j) {
    float s = b_ada[j];
#pragma unroll 8
    for (int k = 0; k < 32; ++k) s += condp[(size_t)k * NADA + j];
    return s;
}
__device__ __forceinline__ void p1_hnorm(const Args& a, const Ctx& c) {
    const float* condp = (const float*)(a.ws + WS_CONDP); float* cond = (float*)(a.ws + WS_COND);
    for (int j = c.bid * NTHREADS + c.tid; j < NADA; j += c.nb * NTHREADS) cond[j] = cond_from_partials(condp, a.in[3], j);
    { float* F2 = (float*)(a.ws + WS_F2);
      for (int j = c.bid * NTHREADS + c.tid; j < 2048; j += c.nb * NTHREADS) F2[j] = a.in[5][j] * (1.f + cond_from_partials(condp, a.in[3], 4 * 2048 + j)); }
    LAS float* Ab = (LAS float*)c.lds; LAS float* Bb = Ab + 2048;
    for (int col = c.tid; col < 2048; col += NTHREADS) {
        Ab[col] = a.in[4][col] * (1.f + cond_from_partials(condp, a.in[3], 2048 + col)); Bb[col] = cond_from_partials(condp, a.in[3], col); }
    __syncthreads();
    norm_rows(a.in[0], (bf16_t*)(a.ws + WS_H), Ab, Bb, c);
}
__device__ __forceinline__ void p_cqce(const Args& a, const Ctx& c) {
    const float* sh2 = (const float*)(a.ws + WS_COND) + 3 * 2048;
    float s[32];
#pragma unroll
    for (int k = 0; k < 8; ++k) { const f32x4 v = *(const f32x4*)(sh2 + c.lane * 32 + k * 4); s[4 * k] = v[0]; s[4 * k + 1] = v[1]; s[4 * k + 2] = v[2]; s[4 * k + 3] = v[3]; }
    const bf16_t* WQ = (const bf16_t*)(a.ws + WS_WQ); float* cq = (float*)(a.ws + WS_CQ);
    for (int n = c.bid * 8 + c.wave; n < 2048; n += c.nb * 8) {
        u32x4 w[4];
#pragma unroll
        for (int k = 0; k < 4; ++k) w[k] = *(const u32x4*)(WQ + (size_t)n * 2048 + c.lane * 32 + k * 8);
        float d = 0.f;
#pragma unroll
        for (int k = 0; k < 4; ++k)
#pragma unroll
            for (int e = 0; e < 4; ++e) d += bflo(w[k][e]) * s[k * 8 + 2 * e] + bfhi(w[k][e]) * s[k * 8 + 2 * e + 1];
        d = wave_sum(d);
        if (c.lane == 0) cq[n] = d;
    }
    const unsigned char* PU = a.ws + WS_PU; float* psc = (float*)(a.ws + WS_PSC);
    for (int e0 = (c.bid * 8 + c.wave) * 4; e0 < 16384; e0 += c.nb * 8 * 4) {
        u32x4 uw[4];
#pragma unroll
        for (int i = 0; i < 4; ++i) uw[i] = *(const u32x4*)(PU + (size_t)(e0 + i) * 1024 + c.lane * 16);
#pragma unroll
        for (int i = 0; i < 4; ++i) {
            float d0 = 0.f, d1 = 0.f;
#pragma unroll
            for (int dw = 0; dw < 4; ++dw) { const f32x2 f0 = fp4_unpk<0>(uw[i][dw]), f1 = fp4_unpk<1>(uw[i][dw]), f2 = fp4_unpk<2>(uw[i][dw]), f3 = fp4_unpk<3>(uw[i][dw]);
                d0 += f0[0] * s[8 * dw] + f1[0] * s[8 * dw + 2] + f2[0] * s[8 * dw + 4] + f3[0] * s[8 * dw + 6];
                d1 += f0[1] * s[8 * dw + 1] + f1[1] * s[8 * dw + 3] + f2[1] * s[8 * dw + 5] + f3[1] * s[8 * dw + 7]; }
            const float d = wave_sum(d0 + d1);
            if (c.lane == 0) psc[(size_t)(e0 + i) * 4 + 1] = psc[(size_t)(e0 + i) * 4] * d;
        }
    }
}
constexpr int S5_US = 0, S5_ES = 33792, S5_SS = 67584, S5_TS = 84992;
template <int PASS>
__device__ __forceinline__ void s5_item(const Args& a, const Ctx& c, int g, int seg) {
    LAS unsigned char* lds = c.lds;
    int tid = c.tid; asm volatile("" : "+v"(tid));
    const int wave = c.wave, lane = tid & 63, r = lane & 15, q = lane >> 4;
    const bf16_t* U = (const bf16_t*)(a.ws + WS_US);
    const bf16_t* MT = (const bf16_t*)(a.ws + WS_S5MT) + (size_t)g * 65536;
    const bf16_t* WE = (const bf16_t*)(a.ws + WS_S5WE) + (size_t)g * 32768;
    const bf16_t* WC = (const bf16_t*)(a.ws + WS_S5WC) + (size_t)g * 32768;
    const float* s5p = (const float*)(a.ws + WS_S5P);
    float* F = (float*)(a.ws + WS_S5F) + (size_t)g * 4 * 128;
    bf16_t* Z = (bf16_t*)(a.ws + WS_Z);
    bf16x8 bE[8];
#pragma unroll
    for (int ks = 0; ks < 8; ++ks) bE[ks] = *(const bf16x8*)(WE + (size_t)(16 * wave + r) * 256 + 32 * ks + 8 * q);
    bf16x8 bM[2][8], bC[2][4];
    if (PASS == 1) {
#pragma unroll
        for (int nt = 0; nt < 2; ++nt)
#pragma unroll
            for (int ks = 0; ks < 4; ++ks) bC[nt][ks] = *(const bf16x8*)(WC + (size_t)(16 * (2 * wave + nt) + r) * 128 + 32 * ks + 8 * q);
#pragma unroll
        for (int nt = 0; nt < 2; ++nt)
#pragma unroll
            for (int ks = 0; ks < 8; ++ks) bM[nt][ks] = *(const bf16x8*)(MT + (size_t)(16 * (2 * wave + nt) + r) * 256 + 32 * ks + 8 * q);
    }
    float sr = 0.f, si = 0.f;
    const float a16r = s5p[(g * 64 + lane) * 2], a16i = s5p[(g * 64 + lane) * 2 + 1];
    float a128r = a16r, a128i = a16i;
#pragma unroll
    for (int s = 0; s < 3; ++s) { const float tr = a128r * a128r - a128i * a128i, ti = 2.f * a128r * a128i; a128r = tr; a128i = ti; }
    if (PASS == 1) { const float br = s5p[8192 + (g * 64 + lane) * 2], bi = s5p[8192 + (g * 64 + lane) * 2 + 1];
        for (int s = 0; s < seg; ++s) { const float fr_ = F[s * 128 + lane], fi_ = F[s * 128 + 64 + lane]; const float nr = br * sr - bi * si + fr_, ni = br * si + bi * sr + fi_; sr = nr; si = ni; } }
    for (int sb = 0; sb < 4; ++sb) {
        const int tok0 = seg * 4096 + sb * 1024;
#pragma unroll
        for (int i = 0; i < 4; ++i) { const int ch = tid + NTHREADS * i, token = ch >> 1, half = ch & 1;
            const u32x4 v = *(const u32x4*)(U + (size_t)(tok0 + token) * 1024 + g * 16 + half * 8);
            *(LAS u32x4*)(lds + S5_US + (token >> 4) * 528 + ((token & 15) * 16 + half * 8) * 2) = v; }
        __syncthreads();
#pragma unroll
        for (int m = 0; m < 4; ++m) {
            f32x4 acc = {0.f, 0.f, 0.f, 0.f};
#pragma unroll
            for (int ks = 0; ks < 8; ++ks) { const bf16x8 A = *(const LAS bf16x8*)(lds + S5_US + (16 * m + r) * 528 + (32 * ks + 8 * q) * 2); acc = mfma16(A, bE[ks], acc); }
#pragma unroll
            for (int i = 0; i < 4; ++i) *(LAS float*)(lds + S5_ES + ((16 * m + 4 * q + i) * 132 + 16 * wave + r) * 4) = acc[i];
        }
        __syncthreads();
        {
            float lr[8], li[8];
            float xr = 0.f, xi = 0.f;
#pragma unroll
            for (int k = 0; k < 8; ++k) {
                lr[k] = xr; li[k] = xi;
                const float er = *(const LAS float*)(lds + S5_ES + ((8 * wave + k) * 132 + lane) * 4), ei = *(const LAS float*)(lds + S5_ES + ((8 * wave + k) * 132 + 64 + lane) * 4);
                const float nr = a16r * xr - a16i * xi + er, ni = a16r * xi + a16i * xr + ei; xr = nr; xi = ni;
            }
            __builtin_amdgcn_sched_barrier(0);
            *(LAS float*)(lds + S5_TS + (wave * 128 + lane) * 4) = xr; *(LAS float*)(lds + S5_TS + (wave * 128 + 64 + lane) * 4) = xi;
            __syncthreads();
            __builtin_amdgcn_sched_barrier(0);
            float cr = sr, ci = si, mr = sr, mi = si;
#pragma unroll
            for (int w2 = 0; w2 < 8; ++w2) {
                if (w2 == wave) { mr = cr; mi = ci; }
                const float tr = *(const LAS float*)(lds + S5_TS + (w2 * 128 + lane) * 4), ti = *(const LAS float*)(lds + S5_TS + (w2 * 128 + 64 + lane) * 4);
                const float nr = a128r * cr - a128i * ci + tr, ni = a128r * ci + a128i * cr + ti; cr = nr; ci = ni;
            }
            sr = cr; si = ci;
            __builtin_amdgcn_sched_barrier(0);
            if (PASS == 1) {
                float pr = mr, pi = mi;
#pragma unroll
                for (int k = 0; k < 8; ++k) {
                    *(LAS bf16_t*)(lds + S5_SS + ((8 * wave + k) * 136 + lane) * 2) = f2bf(lr[k] + pr); *(LAS bf16_t*)(lds + S5_SS + ((8 * wave + k) * 136 + 64 + lane) * 2) = f2bf(li[k] + pi);
                    const float nr = a16r * pr - a16i * pi, ni = a16r * pi + a16i * pr; pr = nr; pi = ni;
                }
            }
        }
        __syncthreads();
        if (PASS == 1) {
#pragma unroll
            for (int nt = 0; nt < 2; ++nt) {
                const int j = 2 * wave + nt;
                f32x4 acc[4];
#pragma unroll
                for (int m = 0; m < 4; ++m) acc[m] = (f32x4){0.f, 0.f, 0.f, 0.f};
#pragma unroll
                for (int ks = 0; ks < 8; ++ks) {
                    __builtin_amdgcn_sched_barrier(0);
#pragma unroll
                    for (int m = 0; m < 4; ++m) { const bf16x8 A = *(const LAS bf16x8*)(lds + S5_US + (16 * m + r) * 528 + (32 * ks + 8 * q) * 2); acc[m] = mfma16(A, bM[nt][ks], acc[m]); }
                }
#pragma unroll
                for (int ks = 0; ks < 4; ++ks) {
                    __builtin_amdgcn_sched_barrier(0);
#pragma unroll
                    for (int m = 0; m < 4; ++m) { const bf16x8 A = *(const LAS bf16x8*)(lds + S5_SS + (16 * m + r) * 272 + (32 * ks + 8 * q) * 2); acc[m] = mfma16(A, bC[nt][ks], acc[m]); }
                }
                int lz = lane; asm volatile("" : "+v"(lz));
                const int rz = lz & 15, qz = lz >> 4;
#pragma unroll
                for (int m = 0; m < 4; ++m)
#pragma unroll
                    for (int i = 0; i < 4; ++i) { const int ch = 16 * m + 4 * qz + i; Z[(size_t)(tok0 + 16 * ch + j) * 1024 + g * 16 + rz] = f2bf(gelu_tanh(acc[m][i])); }
            }
            __syncthreads();
        }
    }
    if (PASS == 0 && wave == 0) { F[seg * 128 + lane] = sr; F[seg * 128 + 64 + lane] = si; }
}

__device__ __forceinline__ void cmp_finish_item(const Args& a, const Ctx& c, int kvsel, int rt) {
    LAS unsigned char* lds = c.lds;
    const int tid = c.tid, wave = c.wave, lane = c.lane, r = lane & 15, q = lane >> 4;
    const float* SL = (const float*)(a.ws + WS_SLAB) + (size_t)kvsel * 16 * 2048 * 256;
    const float* bpep = (const float*)(a.ws + WS_BPEP) + kvsel * 256;
    const bf16_t* W2 = (const bf16_t*)(a.ws + WS_W2) + kvsel * 128 * 256;
    bf16x8 B[8];
#pragma unroll
    for (int ks = 0; ks < 8; ++ks) B[ks] = *(const bf16x8*)(W2 + (size_t)(16 * wave + r) * 256 + 32 * ks + 8 * q);
    for (int e = tid; e < 16 * 64; e += NTHREADS) {
        const int row = e >> 6, c4 = (e & 63) * 4;
        f32x4 s = {0.f, 0.f, 0.f, 0.f};
#pragma unroll 8
        for (int pt = 0; pt < 32; ++pt) s += *(const f32x4*)(bpep + pt * 512 + c4);
#pragma unroll
        for (int ks = 0; ks < 16; ++ks) s += *(const f32x4*)(SL + ((size_t)ks * 2048 + rt * 16 + row) * 256 + c4);
        u32x2 w; w[0] = cvt_pk_bf16(gelu_tanh(s[0]), gelu_tanh(s[1])); w[1] = cvt_pk_bf16(gelu_tanh(s[2]), gelu_tanh(s[3]));
        *(LAS u32x2*)(lds + row * 528 + c4 * 2) = w;
    }
    __syncthreads();
    f32x4 acc = {0.f, 0.f, 0.f, 0.f};
#pragma unroll
    for (int ks = 0; ks < 8; ++ks) { const bf16x8 A = *(const LAS bf16x8*)(lds + r * 528 + (32 * ks + 8 * q) * 2); acc = mfma16(A, B[ks], acc); }
#pragma unroll
    for (int i = 0; i < 4; ++i) {
        const int row = rt * 16 + 4 * q + i, gi = row >> 10, ci = row & 1023, n = 16 * wave + r;
        const bf16_t v = (ci == 1023) ? (bf16_t)0 : f2bf(acc[i]);
        if (kvsel == 0) ((bf16_t*)(a.ws + WS_KC))[((size_t)gi * 1024 + ci) * 128 + n] = v;
        else ((bf16_t*)(a.ws + WS_VCT))[((size_t)gi * 128 + n) * 1024 + ((ci & ~12) | ((ci & 4) << 1) | ((ci & 8) >> 1))] = v;
    }
    __syncthreads();
}
constexpr int AT_IMP = 65536, AT_TB = 131072, AT_BM = 143872, AT_WU = 145920, AT_END = 146176;
__device__ __forceinline__ int kswz(int r) { return ((r & 3) << 2) | ((r >> 2) & 3); }
__host__ __device__ __forceinline__ int vperm(int t) { return (t & ~12) | ((t & 4) << 1) | ((t & 8) >> 1); }
template <int KEYS> __device__ __forceinline__ int vsw(int d) { return KEYS == 128 ? kswz(d) : ((d >> 1) & 7); }
template <int KEYS, bool NEEDV>
__device__ __forceinline__ void stage_dma(const bf16_t* Kt, const bf16_t* Vt, int ldv, LAS unsigned char* kb, LAS unsigned char* vb, int wave, int lane) {
    constexpr int NP = KEYS / 32;
#pragma unroll
    for (int i = 0; i < NP; ++i) { const int pc = NP * wave + i, row = 4 * pc + (lane >> 4), ch = (lane & 15) ^ kswz(row);
        __builtin_amdgcn_global_load_lds((const unsigned*)(Kt + row * 128 + ch * 8), (LAS unsigned*)(kb + pc * 1024), 16, 0, 0); }
    if (NEEDV) {
#pragma unroll
        for (int i = 0; i < NP; ++i) {
            const int pc = NP * wave + i;
            if (KEYS == 128) { const int d = 4 * pc + (lane >> 4), ch = (lane & 15) ^ kswz(d);
                __builtin_amdgcn_global_load_lds((const unsigned*)(Vt + (size_t)d * ldv + 8 * ch), (LAS unsigned*)(vb + pc * 1024), 16, 0, 0); }
            else { const int d = 8 * pc + (lane >> 3), ch = (lane & 7) ^ ((d >> 1) & 7);
                __builtin_amdgcn_global_load_lds((const unsigned*)(Vt + (size_t)d * ldv + 8 * ch), (LAS unsigned*)(vb + pc * 1024), 16, 0, 0); }
        }
    }
}
__device__ __forceinline__ float xhalf_max(float x) { auto rr = __builtin_amdgcn_permlane32_swap(__float_as_uint(x), __float_as_uint(x), false, false); return fmaxf(__uint_as_float(rr[0]), __uint_as_float(rr[1])); }
__device__ __forceinline__ float xhalf_sum(float x) { auto rr = __builtin_amdgcn_permlane32_swap(__float_as_uint(x), __float_as_uint(x), false, false); return __uint_as_float(rr[0]) + __uint_as_float(rr[1]); }
template <int BR>
__device__ __forceinline__ float tile_prep(int MODE, f32x16& S, LAS const float* tb, float cb, int base, bool selbit) {
    float mx = -INFINITY;
    if (MODE == 1) {
#pragma unroll
        for (int r = 0; r < 16; ++r) mx = fmaxf(mx, S[r]);
        mx = (BR == 2 && !selbit) ? -INFINITY : mx + cb;
    } else {
        const bool nomask = (MODE == 2);
        float bv[16];
#pragma unroll
        for (int r = 0; r < 16; ++r) { const int cr = (r & 3) + 8 * (r >> 2); const int dist = (BR <= 1) ? base - 16 * cr : base - cr; bv[r] = tb[min(max(dist, 0), TBN - 1)]; }
        __builtin_amdgcn_sched_barrier(0);
#pragma unroll
        for (int r = 0; r < 16; ++r) {
            const int cr = (r & 3) + 8 * (r >> 2);
            const int dist = (BR <= 1) ? base - 16 * cr : base - cr;
            float v = S[r] + bv[r];
            bool valid;
            if (BR <= 1) valid = dist >= 0; else if (BR == 2) valid = selbit && dist >= 0; else valid = nomask || (unsigned)dist < 512u;
            v = valid ? v : -INFINITY;
            S[r] = v; mx = fmaxf(mx, v);
        }
    }
    return mx;
}
template <int BR, bool PEND>
__device__ __forceinline__ float tile_decide(int MODE, float mx, float cb, bool selbit, f32x16 (&O)[4], float& m, float& l, u32x4& pa, u32x4& pb) {
    if (BR == 1) { const float mu = (m == -INFINITY) ? 0.f : m; return (MODE == 1) ? mu - cb : mu; }
    mx = xhalf_max(mx);
    const float mn = fmaxf(m, mx), mu = (mn == -INFINITY) ? 0.f : mn;
    if (__any(mn > m)) {
        const float alpha = fexp2(m - mu);
        l *= alpha;
        if (BR >= 2) {
#pragma unroll
            for (int dt = 0; dt < 4; ++dt)
#pragma unroll
                for (int r = 0; r < 16; ++r) O[dt][r] *= alpha;
            if (PEND) {
#pragma unroll
                for (int e = 0; e < 4; ++e) { pa[e] = cvt_pk_bf16(bflo(pa[e]) * alpha, bfhi(pa[e]) * alpha); pb[e] = cvt_pk_bf16(bflo(pb[e]) * alpha, bfhi(pb[e]) * alpha); }
            }
        }
    }
    m = mn;
    if (MODE == 1) return (BR == 2 && !selbit) ? INFINITY : mu - cb;
    return mu;
}
template <int BR, int KEYS>
__device__ __forceinline__ void attn_tile(int MODE, LAS const unsigned char* kb, LAS const unsigned char* vb, int cb0, LAS const float* tb, int key0, int t, int lane,
                                          const bf16x8 (&qf)[8], f32x16 (&O)[4], float& m, float& l, float inv_l, bool selbit, LAS float* imp_row) {
    asm volatile("" : "+v"(lane));
    constexpr int ROWB = 2 * KEYS;
    const int r31 = lane & 31, h = lane >> 5;
    const int gh = kswz(r31) ^ h, vh = vsw<KEYS>(r31) ^ h;
    float cb = 0.f;
    if (MODE == 1) cb = tb[TBN - 1];
    const int base0 = (BR <= 1) ? t - 31 - 16 * (key0 + 4 * h) : t - (key0 + 4 * h);
    const int base1 = (BR <= 1) ? base0 - 16 * 32 : base0 - 32;
    LAS const unsigned char* k0 = kb + r31 * 256;
    f32x16 S0, S1;
    bf16x8 kf[8];
#pragma unroll
    for (int ks = 0; ks < 8; ++ks) kf[ks] = *(const LAS bf16x8*)(k0 + 16 * ((2 * ks) ^ gh));
#pragma unroll
    for (int r = 0; r < 16; ++r) { S0[r] = 0.f; S1[r] = 0.f; }
    __builtin_amdgcn_sched_barrier(0);
#pragma unroll
    for (int ks = 0; ks < 8; ++ks) S0 = mfma32(kf[ks], qf[ks], S0);
    __builtin_amdgcn_sched_barrier(0);
#pragma unroll
    for (int ks = 0; ks < 8; ++ks) kf[ks] = *(const LAS bf16x8*)(k0 + 8192 + 16 * ((2 * ks) ^ gh));
    const float mx0 = tile_prep<BR>(MODE, S0, tb, cb, base0, selbit);
    u32x4 pk0a = {0u, 0u, 0u, 0u}, pk0b = {0u, 0u, 0u, 0u}, pk1a, pk1b;
    const float me0 = tile_decide<BR, false>(MODE, mx0, cb, selbit, O, m, l, pk0a, pk0b);
    __builtin_amdgcn_sched_barrier(0);
    {
#pragma unroll
        for (int ks = 0; ks < 8; ++ks) S1 = mfma32(kf[ks], qf[ks], S1);
        float ps = 0.f;
#pragma unroll
        for (int r = 0; r < 16; ++r) { float p = fexp2(S0[r] - me0); if (BR == 1) p *= inv_l; S0[r] = p; ps += p; }
        if (BR != 1) l += ps;
        if (BR >= 1) {
#pragma unroll
            for (int e = 0; e < 4; ++e) { pk0a[e] = cvt_pk_bf16(S0[2 * e], S0[2 * e + 1]); pk0b[e] = cvt_pk_bf16(S0[8 + 2 * e], S0[8 + 2 * e + 1]); }
        }
#pragma unroll
        for (int i = 0; i < 8; ++i) { __builtin_amdgcn_sched_group_barrier(0x008, 1, 0); __builtin_amdgcn_sched_group_barrier(0x002, 8, 0); }
    }
    __builtin_amdgcn_sched_barrier(0);
    if (BR == 1) {
#pragma unroll
        for (int rg = 0; rg < 4; ++rg) {
            float A = 2.f * (S0[4 * rg] + S0[4 * rg + 1] + S0[4 * rg + 2]) + S0[4 * rg + 3], B = S0[4 * rg + 3];
            A = quad_sum(A); B = quad_sum(B);
            const int jj = (key0 >> 2) + 2 * rg + h;
            if ((lane & 3) == 0) { __hip_atomic_fetch_add(imp_row + jj, A, __ATOMIC_RELAXED, __HIP_MEMORY_SCOPE_WORKGROUP);
                if (jj + 1 < 256) __hip_atomic_fetch_add(imp_row + jj + 1, B, __ATOMIC_RELAXED, __HIP_MEMORY_SCOPE_WORKGROUP); }
        }
    }
    bf16x8 av[8];
    if (BR >= 1) {
#pragma unroll
        for (int s = 0; s < 2; ++s)
#pragma unroll
            for (int dt = 0; dt < 4; ++dt) av[s * 4 + dt] = *(const LAS bf16x8*)(vb + (32 * dt + r31) * ROWB + 16 * ((cb0 + 2 * s) ^ vh));
    }
    const float mx1 = tile_prep<BR>(MODE, S1, tb, cb, base1, selbit);
    const float me1 = tile_decide<BR, true>(MODE, mx1, cb, selbit, O, m, l, pk0a, pk0b);
    __builtin_amdgcn_sched_barrier(0);
    {
        if (BR >= 1) {
#pragma unroll
            for (int dt = 0; dt < 4; ++dt) O[dt] = mfma32(av[dt], __builtin_bit_cast(bf16x8, pk0a), O[dt]);
#pragma unroll
            for (int dt = 0; dt < 4; ++dt) O[dt] = mfma32(av[4 + dt], __builtin_bit_cast(bf16x8, pk0b), O[dt]);
        }
        float ps = 0.f;
#pragma unroll
        for (int r = 0; r < 16; ++r) { float p = fexp2(S1[r] - me1); if (BR == 1) p *= inv_l; S1[r] = p; ps += p; }
        if (BR != 1) l += ps;
        if (BR >= 1) {
#pragma unroll
            for (int e = 0; e < 4; ++e) { pk1a[e] = cvt_pk_bf16(S1[2 * e], S1[2 * e + 1]); pk1b[e] = cvt_pk_bf16(S1[8 + 2 * e], S1[8 + 2 * e + 1]); }
#pragma unroll
            for (int i = 0; i < 8; ++i) { __builtin_amdgcn_sched_group_barrier(0x008, 1, 0); __builtin_amdgcn_sched_group_barrier(0x002, 8, 0); }
        }
    }
    __builtin_amdgcn_sched_barrier(0);
    if (BR == 1) {
#pragma unroll
        for (int rg = 0; rg < 4; ++rg) {
            float A = 2.f * (S1[4 * rg] + S1[4 * rg + 1] + S1[4 * rg + 2]) + S1[4 * rg + 3], B = S1[4 * rg + 3];
            A = quad_sum(A); B = quad_sum(B);
            const int jj = ((key0 + 32) >> 2) + 2 * rg + h;
            if ((lane & 3) == 0) { __hip_atomic_fetch_add(imp_row + jj, A, __ATOMIC_RELAXED, __HIP_MEMORY_SCOPE_WORKGROUP);
                if (jj + 1 < 256) __hip_atomic_fetch_add(imp_row + jj + 1, B, __ATOMIC_RELAXED, __HIP_MEMORY_SCOPE_WORKGROUP); }
        }
    }
    if (BR >= 1) {
#pragma unroll
        for (int s = 0; s < 2; ++s)
#pragma unroll
            for (int dt = 0; dt < 4; ++dt) av[s * 4 + dt] = *(const LAS bf16x8*)(vb + (32 * dt + r31) * ROWB + 16 * ((cb0 + 4 + 2 * s) ^ vh));
        __builtin_amdgcn_sched_barrier(0);
#pragma unroll
        for (int dt = 0; dt < 4; ++dt) O[dt] = mfma32(av[dt], __builtin_bit_cast(bf16x8, pk1a), O[dt]);
#pragma unroll
        for (int dt = 0; dt < 4; ++dt) O[dt] = mfma32(av[4 + dt], __builtin_bit_cast(bf16x8, pk1b), O[dt]);
    }
}
template <int BR, int KEYS>
__device__ __forceinline__ void run_branch(const Ctx& c, const bf16_t* Kb, const bf16_t* Vtb, int ldv, int lo, int hi, LAS const float* tb, int t, int t0,
                                           const bf16x8 (&qf)[8], f32x16 (&O)[4], float& m, float& l, float inv_l, int tl, LAS float* imp_row) {
    constexpr bool NEEDV = (BR != 0);
    constexpr int BPS = KEYS / 64, KSTG = KEYS * 256, VSTG = 128 * 2 * KEYS, VB0 = 2 * KSTG;
    LAS unsigned char* lds = c.lds;
    int lz = c.lane; asm volatile("" : "+v"(lz));
    const int nst = (hi - lo + BPS - 1) / BPS;
#define STG_BLK(i) ((lo + BPS * (i) + BPS - 1 < hi) ? lo + BPS * (i) : hi - BPS)
    asm volatile("s_waitcnt vmcnt(0)" ::: "memory");
    { const int b0 = (BPS == 2 && hi - lo < 2) ? lo : STG_BLK(0);
      stage_dma<KEYS, NEEDV>(Kb + (size_t)b0 * 64 * 128, Vtb + (size_t)b0 * 64, ldv, lds, lds + VB0, c.wave, lz); }
    asm volatile("s_waitcnt vmcnt(0)" ::: "memory");
    __syncthreads();
    const int qt = t0 >> 6;
    for (int i = 0; i < nst; ++i) {
        const int buf = i & 1;
        if (i + 1 < nst) { int lz2 = lz; asm volatile("" : "+v"(lz2));
            const int b1 = STG_BLK(i + 1);
            stage_dma<KEYS, NEEDV>(Kb + (size_t)b1 * 64 * 128, Vtb + (size_t)b1 * 64, ldv, lds + (buf ^ 1) * KSTG, lds + VB0 + (buf ^ 1) * VSTG, c.wave, lz2); }
        const int sb = (BPS == 2 && hi - lo < 2) ? lo : STG_BLK(i);
#pragma unroll
        for (int q = 0; q < BPS; ++q) {
            const int j = lo + BPS * i + q;
            if (j < hi) {
                bool selbit = true, wave_on = true;
                if (BR == 2) {
                    const unsigned w = *(const LAS unsigned*)(lds + AT_BM + (tl * 8 + (j >> 5)) * 4);
                    selbit = (w >> (j & 31)) & 1u;
                    const unsigned wu = *(const LAS unsigned*)(lds + AT_WU + (c.wave * 8 + (j >> 5)) * 4);
                    wave_on = (wu >> (j & 31)) & 1u;
                }
                if (wave_on) {
                    int mode = 0;
                    if (BR <= 1) mode = (1024 * j + 1829 <= t0) ? 1 : 0;
                    else if (BR == 2) mode = (64 * j + 853 <= t0) ? 1 : 0;
                    else mode = (j >= qt - 7 && j <= qt - 1) ? 2 : 0;
                    const int slot = j - sb;
                    attn_tile<BR, KEYS>(mode, lds + buf * KSTG + slot * 16384, lds + VB0 + buf * VSTG, 8 * slot, tb, j * 64, t, c.lane, qf, O, m, l, inv_l, selbit, imp_row);
                }
            }
        }
        asm volatile("s_waitcnt vmcnt(0)" ::: "memory");
        __syncthreads();
    }
#undef STG_BLK
}
__device__ __forceinline__ void attn_item(const Args& a, const Ctx& c_, int qt, int g) {
    Ctx c = c_; { int tz = c_.tid; asm volatile("" : "+v"(tz)); c.tid = tz; c.lane = tz & 63; }
    LAS unsigned char* lds = c.lds;
    const int tid = c.tid, wave = c.wave, lane = c.lane, r31 = lane & 31, h = lane >> 5, hl = lane & 3;
    const int t0 = qt * 64, tl = 8 * wave + (r31 >> 2), t = t0 + tl, head = g * 4 + hl;
    const bf16_t* Qb = (const bf16_t*)(a.ws + WS_Q);
    const bf16_t* KROW = (const bf16_t*)(a.ws + WS_KROW);
    const bf16_t* VT = (const bf16_t*)(a.ws + WS_VT);
    const float* GATE = (const float*)(a.ws + WS_GATE);
    { const float* tbg = (const float*)(a.ws + WS_TB) + g * 4 * TBN;
      for (int i = tid; i < 4 * TBN; i += NTHREADS) *(LAS float*)(lds + AT_TB + i * 4) = tbg[i];
      for (int i = tid; i < 64 * 256; i += NTHREADS) *(LAS float*)(lds + AT_IMP + i * 4) = 0.f; }
    bf16x8 qf[8];
#pragma unroll
    for (int ks = 0; ks < 8; ++ks) qf[ks] = *(const bf16x8*)(Qb + (size_t)t * 1024 + head * 128 + 16 * ks + 8 * h);
    LAS const float* tb = (LAS const float*)(lds + AT_TB) + hl * TBN;
    LAS float* imp_row = (LAS float*)(lds + AT_IMP) + tl * 256;
    bf16_t* Y = (bf16_t*)(a.ws + WS_Y2) + (size_t)t * 2048 + 1024 + head * 128 + 4 * h;
    f32x16 O[4];
#pragma unroll
    for (int dt = 0; dt < 4; ++dt)
#pragma unroll
        for (int r = 0; r < 16; ++r) O[dt][r] = 0.f;
    __syncthreads();
    { const int ntile = (t0 / 16 + 3 + 63) / 64;
      const bf16_t* KC = (const bf16_t*)(a.ws + WS_KC) + (size_t)g * 1024 * 128; const bf16_t* VCT = (const bf16_t*)(a.ws + WS_VCT) + (size_t)g * 128 * 1024;
      float m = -INFINITY, l = 0.f;
#if defined(PROBE_CMP)
      run_branch<0, 64>(c, KC, VCT, 1024, 0, ntile, tb, t, t0, qf, O, m, l, 0.f, tl, imp_row);
      asm volatile("" :: "v"(m), "v"(l));
      m = -INFINITY; l = 0.f;
#endif
      run_branch<0, 64>(c, KC, VCT, 1024, 0, ntile, tb, t, t0, qf, O, m, l, 0.f, tl, imp_row);
      const float lt = xhalf_sum(l), inv = lt > 0.f ? 1.f / lt : 0.f;
      run_branch<1, 64>(c, KC, VCT, 1024, 0, ntile, tb, t, t0, qf, O, m, l, inv, tl, imp_row);
      const float gc = GATE[(size_t)t * 24 + head];
#pragma unroll
      for (int dt = 0; dt < 4; ++dt)
#pragma unroll
          for (int rg = 0; rg < 4; ++rg) {
              u32x2 w; w[0] = cvt_pk_bf16(gc * O[dt][4 * rg], gc * O[dt][4 * rg + 1]); w[1] = cvt_pk_bf16(gc * O[dt][4 * rg + 2], gc * O[dt][4 * rg + 3]);
              *(u32x2*)(Y + 32 * dt + 8 * rg) = w;
#pragma unroll
              for (int e = 0; e < 4; ++e) O[dt][4 * rg + e] = 0.f;
          }
    }
    {
        const int ncand = qt - 2 > 0 ? qt - 2 : 0;
        unsigned v[8][4], selm[8];
#pragma unroll
        for (int i = 0; i < 8; ++i) {
            LAS const float* row = (LAS const float*)(lds + AT_IMP) + (8 * wave + i) * 256;
            selm[i] = 0u;
#pragma unroll
            for (int k = 0; k < 4; ++k) { const int j = lane + 64 * k; const bool cand = (j >= 1 && j <= qt - 2);
                v[i][k] = cand ? ((__float_as_uint(row[j]) & ~0xFFu) | (unsigned)(255 - j)) : 0u; if (ncand <= 13 && cand) selm[i] |= 1u << k; }
        }
        if (ncand > 13) {
            for (int it = 0; it < 13; ++it) {
#pragma unroll
                for (int i = 0; i < 8; ++i) {
                    const unsigned mx = wave_umax_bcast(max(max(v[i][0], v[i][1]), max(v[i][2], v[i][3])));
#pragma unroll
                    for (int k = 0; k < 4; ++k) if (v[i][k] == mx) { v[i][k] = 0u; selm[i] |= 1u << k; }
                }
            }
        }
        unsigned wu[8];
#pragma unroll
        for (int k = 0; k < 8; ++k) wu[k] = 0u;
#pragma unroll
        for (int i = 0; i < 8; ++i)
#pragma unroll
            for (int k = 0; k < 4; ++k) {
                const int j = lane + 64 * k; const bool forced = (j == 0) || (j == qt) || (j == qt - 1);
                const unsigned long long mk = __ballot(((selm[i] >> k) & 1u) || forced);
                const unsigned lo = (unsigned)mk, hi = (unsigned)(mk >> 32);
                if (lane == 0) { *(LAS unsigned*)(lds + AT_BM + ((8 * wave + i) * 8 + 2 * k) * 4) = lo; *(LAS unsigned*)(lds + AT_BM + ((8 * wave + i) * 8 + 2 * k + 1) * 4) = hi; }
                wu[2 * k] |= lo; wu[2 * k + 1] |= hi;
            }
        if (lane == 0) {
#pragma unroll
            for (int k = 0; k < 8; ++k) *(LAS unsigned*)(lds + AT_WU + (wave * 8 + k) * 4) = wu[k];
        }
    }
    __syncthreads();
#if defined(PROBE_SEL)
    { float m = -INFINITY, l = 0.f;
      run_branch<2, 128>(c, KROW + (size_t)(2 + g) * L_ * 128, VT + (size_t)g * 128 * L_, L_, 0, qt + 1, tb, t, t0, qf, O, m, l, 0.f, tl, imp_row);
      asm volatile("" :: "v"(O[0]), "v"(O[1]), "v"(O[2]), "v"(O[3]), "v"(m), "v"(l));
#pragma unroll
      for (int dt = 0; dt < 4; ++dt)
#pragma unroll
          for (int r = 0; r < 16; ++r) O[dt][r] = 0.f; }
#endif
    { float m = -INFINITY, l = 0.f;
      run_branch<2, 128>(c, KROW + (size_t)(2 + g) * L_ * 128, VT + (size_t)g * 128 * L_, L_, 0, qt + 1, tb, t, t0, qf, O, m, l, 0.f, tl, imp_row);
      const float gs = GATE[(size_t)t * 24 + 8 + head];
      const float lt = xhalf_sum(l), sc = gs * (lt > 0.f ? 1.f / lt : 0.f);
#pragma unroll
      for (int dt = 0; dt < 4; ++dt)
#pragma unroll
          for (int rg = 0; rg < 4; ++rg) {
              const u32x2 w0 = *(const u32x2*)(Y + 32 * dt + 8 * rg);
              u32x2 w; w[0] = cvt_pk_bf16(bflo(w0[0]) + sc * O[dt][4 * rg], bfhi(w0[0]) + sc * O[dt][4 * rg + 1]); w[1] = cvt_pk_bf16(bflo(w0[1]) + sc * O[dt][4 * rg + 2], bfhi(w0[1]) + sc * O[dt][4 * rg + 3]);
              *(u32x2*)(Y + 32 * dt + 8 * rg) = w;
#pragma unroll
              for (int e = 0; e < 4; ++e) O[dt][4 * rg + e] = 0.f;
          }
    }
#if defined(PROBE_WIN)
    { float m = -INFINITY, l = 0.f;
      const int lo = qt - 8 > 0 ? qt - 8 : 0;
      run_branch<3, 128>(c, KROW + (size_t)(4 + g) * L_ * 128, VT + (size_t)(2 + g) * 128 * L_, L_, lo, qt + 1, tb, t, t0, qf, O, m, l, 0.f, tl, imp_row);
      asm volatile("" :: "v"(O[0]), "v"(O[1]), "v"(O[2]), "v"(O[3]), "v"(m), "v"(l));
#pragma unroll
      for (int dt = 0; dt < 4; ++dt)
#pragma unroll
          for (int r = 0; r < 16; ++r) O[dt][r] = 0.f; }
#endif
    { float m = -INFINITY, l = 0.f;
      const int lo = qt - 8 > 0 ? qt - 8 : 0;
      run_branch<3, 128>(c, KROW + (size_t)(4 + g) * L_ * 128, VT + (size_t)(2 + g) * 128 * L_, L_, lo, qt + 1, tb, t, t0, qf, O, m, l, 0.f, tl, imp_row);
      const float gw = GATE[(size_t)t * 24 + 16 + head];
      const float lt = xhalf_sum(l), sc = gw * (lt > 0.f ? 1.f / lt : 0.f);
      float ss = 0.f;
#pragma unroll
      for (int dt = 0; dt < 4; ++dt)
#pragma unroll
          for (int rg = 0; rg < 4; ++rg) {
              const u32x2 w0 = *(const u32x2*)(Y + 32 * dt + 8 * rg);
              const float y0 = bflo(w0[0]) + sc * O[dt][4 * rg], y1 = bfhi(w0[0]) + sc * O[dt][4 * rg + 1], y2 = bflo(w0[1]) + sc * O[dt][4 * rg + 2], y3 = bfhi(w0[1]) + sc * O[dt][4 * rg + 3];
              u32x2 w; w[0] = cvt_pk_bf16(y0, y1); w[1] = cvt_pk_bf16(y2, y3);
              *(u32x2*)(Y + 32 * dt + 8 * rg) = w;
              ss += (y0 * y0 + y1 * y1) + (y2 * y2 + y3 * y3);
          }
      ss = quad_sum(xhalf_sum(ss));
      if (hl == 0 && h == 0) ((float*)(a.ws + WS_STAP))[(size_t)t * 2 + g] = ss;
    }
    __syncthreads();
}
#ifndef PEER_ALPHA
#define PEER_ALPHA 1.0f
#endif
constexpr int PE_SC = 0, PE_LV = 65536, PE_LI = 73728, PE_PK = 81920, PE_EX = 147456, PE_GT = 149504, PE_SU = 153600, PE_CE = 157696, PE_END = 161792;
constexpr int PE_SLOT = 2048, PE_NSLOT = 8, PE_RINGW = PE_SLOT * 9;
static_assert(8 * PE_RINGW <= PE_EX && PE_END <= LDS_BYTES - 32, "PEER LDS map");
__device__ __forceinline__ float wave_sum_bcast(float v) {
    v += dpp_f<0xB1>(v); v += dpp_f<0x4E>(v); v += dpp_f<0x141>(v); v += dpp_f<0x140>(v);
    v += __int_as_float(__builtin_amdgcn_update_dpp(0, __float_as_int(v), 0x142, 0xa, 0xf, false));
    v += __int_as_float(__builtin_amdgcn_update_dpp(0, __float_as_int(v), 0x143, 0xc, 0xf, false));
    return __int_as_float(__builtin_amdgcn_readlane(__float_as_int(v), 63));
}
__device__ __forceinline__ unsigned mono_key(float v) { const unsigned b = __float_as_uint(v); return b ^ ((b >> 31) ? 0xFFFFFFFFu : 0x80000000u); }
template <int CTRL>
__device__ __forceinline__ void quad_merge16(unsigned (&t)[16]) {
    unsigned o[16];
#pragma unroll
    for (int i = 0; i < 16; ++i) o[i] = (unsigned)__builtin_amdgcn_update_dpp(0, (int)t[15 - i], CTRL, 0xf, 0xf, false);
#pragma unroll
    for (int i = 0; i < 16; ++i) t[i] = max(t[i], o[i]);
#pragma unroll
    for (int st = 8; st >= 1; st >>= 1)
#pragma unroll
        for (int i = 0; i < 16; ++i) if ((i & st) == 0) { const unsigned hi = max(t[i], t[i + st]), lo = min(t[i], t[i + st]); t[i] = hi; t[i + st] = lo; }
}
__device__ __forceinline__ int pair_a(int p) { return p < 16 ? 0 : p < 24 ? 1 : p < 29 ? 2 : p < 33 ? 3 : p < 36 ? 4 : p < 38 ? 5 : p < 40 ? 6 : p < 42 ? 7 : p - 34; }
__device__ __forceinline__ int pair_b(int p) { return p < 16 ? p : p < 24 ? p - 16 : p < 29 ? p - 24 : p < 33 ? p - 29 : p < 36 ? p - 33 : p < 38 ? p - 36 : p < 40 ? p - 38 : p < 42 ? p - 40 : 0; }
template <bool DRY>
__device__ __forceinline__ void peer_step(const Args& a, const Ctx& c_, int t0) {
    Ctx c = c_; { int tz = c_.tid; asm volatile("" : "+v"(tz)); c.tid = tz; c.lane = tz & 63; }
    LAS unsigned char* lds = c.lds;
    const int tid = c.tid, wave = c.wave, lane = c.lane, r = lane & 15, q = lane >> 4;
    const bf16_t* QP = (const bf16_t*)(a.ws + WS_QP); const bf16_t* PK = (const bf16_t*)(a.ws + WS_PK);
    const unsigned char* PU = a.ws + WS_PU; const unsigned char* PV = a.ws + WS_PV; const float* psc = (const float*)(a.ws + WS_PSC);
    const bf16_t* HB = (const bf16_t*)(a.ws + WS_H2);
    const int t = t0 + wave;
    u32x4 hraw[4]; u32x2 xw[8];
#pragma unroll
    for (int k = 0; k < 4; ++k) hraw[k] = *(const u32x4*)(HB + (size_t)t * 2048 + lane * 32 + k * 8);
#pragma unroll
    for (int k = 0; k < 8; ++k) xw[k] = *(const u32x2*)((const bf16_t*)(a.ws + WS_X1) + (size_t)t * 2048 + lane * 32 + k * 4);
    const float r2 = ((const float*)(a.ws + WS_RSTD2))[t0 + ((tid >> 5) & 7)];
    {
#pragma unroll
        for (int i = 0; i < 8; ++i) { const int pc = 8 * wave + i, row = 4 * pc + (lane >> 4), ch = (lane & 15) ^ kswz(row);
            __builtin_amdgcn_global_load_lds((const unsigned*)(PK + (size_t)row * 128 + ch * 8), (LAS unsigned*)(lds + PE_PK + pc * 1024), 16, 0, 0); }
        const int hh = wave;
        bf16x8 aF[2][4];
#pragma unroll
        for (int cc = 0; cc < 2; ++cc)
#pragma unroll
            for (int ks = 0; ks < 4; ++ks) aF[cc][ks] = *(const bf16x8*)(QP + (size_t)(t0 + (r & 7)) * 2048 + hh * 256 + cc * 128 + 32 * ks + 8 * q);
        asm volatile("s_waitcnt vmcnt(0)" ::: "memory");
        __syncthreads();
        const int ksw = kswz(r);
#pragma unroll
        for (int cc = 0; cc < 2; ++cc)
#pragma unroll 2
            for (int nt = 0; nt < 8; ++nt) {
                f32x4 acc = {0.f, 0.f, 0.f, 0.f};
#pragma unroll
                for (int ks = 0; ks < 4; ++ks) { const bf16x8 B = *(const LAS bf16x8*)(lds + PE_PK + (cc * 128 + 16 * nt + r) * 256 + 16 * ((4 * ks + q) ^ ksw)); acc = mfma16(aF[cc][ks], B, acc); }
                if (q < 2) {
#pragma unroll
                    for (int i = 0; i < 4; ++i) { const int task = (4 * q + i) * 16 + hh * 2 + cc; *(LAS float*)(lds + PE_SC + (task * 128 + ((16 * nt + r + task) & 127)) * 4) = acc[i]; }
                }
            }
    }
    __syncthreads();
    {
        const int task = tid >> 2, part = tid & 3;
        LAS const float* sc = (LAS const float*)(lds + PE_SC) + task * 128;
        float vals[32];
#pragma unroll
        for (int k = 0; k < 32; ++k) vals[k] = sc[(32 * part + k + task) & 127];
        unsigned top[16];
#pragma unroll
        for (int e = 0; e < 16; ++e) top[e] = 0u;
#pragma unroll
        for (int k = 0; k < 32; ++k) {
            unsigned key = (mono_key(vals[k]) & ~0x7Fu) | (unsigned)(127 - (32 * part + k));
#pragma unroll
            for (int e = 0; e < 16; ++e) { const unsigned hi = max(top[e], key); key = min(top[e], key); top[e] = hi; }
        }
        quad_merge16<0xB1>(top);
        quad_merge16<0x4E>(top);
        if (part == 0) {
#pragma unroll
            for (int e = 0; e < 16; ++e) { const int idx = 127 - (int)(top[e] & 0x7Fu); *(LAS float*)(lds + PE_LV + (task * 16 + e) * 4) = sc[(idx + task) & 127]; *(LAS int*)(lds + PE_LI + (task * 16 + e) * 4) = idx; }
        }
    }
    __syncthreads();
    if (tid < 256) {
        const int task = tid >> 2, part = tid & 3, tok = task >> 3, hh = task & 7, t1 = tok * 16 + hh * 2, t2 = t1 + 1;
        LAS const float* lv1 = (LAS const float*)(lds + PE_LV) + t1 * 16; LAS const float* lv2 = (LAS const float*)(lds + PE_LV) + t2 * 16;
        unsigned top[16];
#pragma unroll
        for (int e = 0; e < 16; ++e) top[e] = 0u;
        for (int p = part; p < 50; p += 4) {
            const int aa = pair_a(p), bb = pair_b(p);
            unsigned key = (mono_key(lv1[aa] + lv2[bb]) & ~0xFFu) | (unsigned)(255 - (aa * 16 + bb));
#pragma unroll
            for (int e = 0; e < 16; ++e) { const unsigned hi = max(top[e], key); key = min(top[e], key); top[e] = hi; }
        }
        quad_merge16<0xB1>(top);
        quad_merge16<0x4E>(top);
        if (part == 0) {
            LAS const int* li1 = (LAS const int*)(lds + PE_LI) + t1 * 16; LAS const int* li2 = (LAS const int*)(lds + PE_LI) + t2 * 16;
            float sv[16]; int ex[16]; float mx = -INFINITY;
#pragma unroll
            for (int e = 0; e < 16; ++e) {
                const int id = 255 - (int)(top[e] & 0xFFu), aa = id >> 4, bb = id & 15;
                sv[e] = lv1[aa] + lv2[bb]; ex[e] = li1[aa] * 128 + li2[bb]; mx = fmaxf(mx, sv[e]);
            }
            float sum = 0.f;
#pragma unroll
            for (int e = 0; e < 16; ++e) { sv[e] = fexp2((sv[e] - mx) * LOG2E); sum += sv[e]; }
            const float inv = 1.f / sum;
#pragma unroll
            for (int e = 0; e < 16; ++e) *(LAS unsigned short*)(lds + PE_EX + (tok * 128 + hh * 16 + e) * 2) = (unsigned short)ex[e];
            f32x4 rec[16];
#pragma unroll
            for (int e = 0; e < 16; ++e) rec[e] = *(const f32x4*)(psc + (size_t)ex[e] * 4);
            __builtin_amdgcn_sched_barrier(0);
#pragma unroll
            for (int e = 0; e < 16; ++e) asm volatile("" :: "v"(rec[e]));
#pragma unroll
            for (int e = 0; e < 16; ++e) {
                *(LAS float*)(lds + PE_GT + (tok * 128 + hh * 16 + e) * 4) = sv[e] * inv * rec[e][2];
                *(LAS float*)(lds + PE_SU + (tok * 128 + hh * 16 + e) * 4) = rec[e][0] * r2;
                *(LAS float*)(lds + PE_CE + (tok * 128 + hh * 16 + e) * 4) = rec[e][1]; }
        }
    }
    __syncthreads();
    f32x2 hp[16];
#pragma unroll
    for (int k = 0; k < 4; ++k)
#pragma unroll
        for (int e = 0; e < 4; ++e) { hp[k * 4 + e][0] = bflo(hraw[k][e]); hp[k * 4 + e][1] = bfhi(hraw[k][e]); }
    f32x2 acc[16];
#pragma unroll
    for (int e = 0; e < 16; ++e) acc[e] = (f32x2){0.f, 0.f};
    asm volatile("s_waitcnt vmcnt(0)" ::: "memory");
    {
        LAS const unsigned short* exl = (LAS const unsigned short*)(lds + PE_EX) + wave * 128; LAS const float* gtl = (LAS const float*)(lds + PE_GT) + wave * 128;
        LAS const float* sul = (LAS const float*)(lds + PE_SU) + wave * 128; LAS const float* cel = (LAS const float*)(lds + PE_CE) + wave * 128;
        LAS unsigned char* ring = lds + wave * PE_RINGW;
#define ROW_ISSUE(SL, IDX) do { const int ex_ = __builtin_amdgcn_readfirstlane((int)exl[IDX]); \
            LAS unsigned char* sl_ = ring + (SL) * PE_SLOT; \
            __builtin_amdgcn_global_load_lds((const unsigned*)(PU + (size_t)ex_ * 1024 + lane * 16), (LAS unsigned*)sl_, 16, 0, 0); \
            __builtin_amdgcn_global_load_lds((const unsigned*)(PV + (size_t)ex_ * 1024 + lane * 16), (LAS unsigned*)(sl_ + 1024), 16, 0, 0); \
            } while (0)
#define UDOT(UW, D0, D1, D2, D3) do { _Pragma("unroll") for (int dw = 0; dw < 4; ++dw) { const f32x2 f0_ = fp4_unpk<0>(UW[dw]), f1_ = fp4_unpk<1>(UW[dw]), f2_ = fp4_unpk<2>(UW[dw]), f3_ = fp4_unpk<3>(UW[dw]); \
                D0 += f0_ * hp[4 * dw]; D1 += f1_ * hp[4 * dw + 1]; D2 += f2_ * hp[4 * dw + 2]; D3 += f3_ * hp[4 * dw + 3]; } } while (0)
#define VACC(VW, WG) do { _Pragma("unroll") for (int dw = 0; dw < 4; ++dw) { const f32x2 f0_ = fp4_unpk<0>(VW[dw]), f1_ = fp4_unpk<1>(VW[dw]), f2_ = fp4_unpk<2>(VW[dw]), f3_ = fp4_unpk<3>(VW[dw]); \
                acc[4 * dw] += WG * f0_; acc[4 * dw + 1] += WG * f1_; acc[4 * dw + 2] += WG * f2_; acc[4 * dw + 3] += WG * f3_; } } while (0)
#define PAIR_APPLY(SA, SB, IDX) do { LAS const unsigned char* pa_ = ring + (SA) * PE_SLOT + lane * 16; LAS const unsigned char* pb_ = ring + (SB) * PE_SLOT + lane * 16; \
            const u32x4 ua_ = *(const LAS u32x4*)pa_, ub_ = *(const LAS u32x4*)pb_, va_ = *(const LAS u32x4*)(pa_ + 1024), vb_ = *(const LAS u32x4*)(pb_ + 1024); \
            f32x2 a0_ = {0.f, 0.f}, a1_ = {0.f, 0.f}, a2_ = {0.f, 0.f}, a3_ = {0.f, 0.f}, b0_ = {0.f, 0.f}, b1_ = {0.f, 0.f}, b2_ = {0.f, 0.f}, b3_ = {0.f, 0.f}; \
            UDOT(ua_, a0_, a1_, a2_, a3_); UDOT(ub_, b0_, b1_, b2_, b3_); \
            const f32x2 as_ = (a0_ + a1_) + (a2_ + a3_), bs_ = (b0_ + b1_) + (b2_ + b3_); \
            const float da_ = wave_sum_bcast(as_[0] + as_[1]) * sul[IDX] + cel[IDX], db_ = wave_sum_bcast(bs_[0] + bs_[1]) * sul[(IDX) + 1] + cel[(IDX) + 1]; \
            const float wa_ = gtl[IDX] * gelu_tanh(da_), wb_ = gtl[(IDX) + 1] * gelu_tanh(db_); \
            VACC(va_, wa_); VACC(vb_, wb_); \
            asm volatile("s_waitcnt lgkmcnt(0)" ::: "memory"); } while (0)
#define DMA_WAIT(N) asm volatile("s_waitcnt vmcnt(" #N ")" ::: "memory")
        ROW_ISSUE(0, 0); ROW_ISSUE(1, 1); ROW_ISSUE(2, 2); ROW_ISSUE(3, 3); ROW_ISSUE(4, 4); ROW_ISSUE(5, 5); ROW_ISSUE(6, 6); ROW_ISSUE(7, 7);
#pragma unroll 1
        for (int e = 0; e < 128; e += 8) {
            const bool more = e + 8 < 128;
            DMA_WAIT(12); PAIR_APPLY(0, 1, e);     if (more) { ROW_ISSUE(0, e + 8);  ROW_ISSUE(1, e + 9); }
            if (more) DMA_WAIT(12); else DMA_WAIT(0);
            PAIR_APPLY(2, 3, e + 2); if (more) { ROW_ISSUE(2, e + 10); ROW_ISSUE(3, e + 11); }
            if (more) DMA_WAIT(12);
            PAIR_APPLY(4, 5, e + 4); if (more) { ROW_ISSUE(4, e + 12); ROW_ISSUE(5, e + 13); }
            if (more) DMA_WAIT(12);
            PAIR_APPLY(6, 7, e + 6); if (more) { ROW_ISSUE(6, e + 14); ROW_ISSUE(7, e + 15); }
        }
#undef ROW_ISSUE
#undef PAIR_APPLY
#undef UDOT
#undef VACC
#undef DMA_WAIT
    }
    {
        float* xo = a.out + (size_t)t * 2048; const float* g2 = (const float*)(a.ws + WS_COND) + 5 * 2048; const float* fg = a.in[32];
        f32x4 gvv[8], fvv[8];
#pragma unroll
        for (int k = 0; k < 8; ++k) { const int col = lane * 32 + k * 4; gvv[k] = *(const f32x4*)(g2 + col); fvv[k] = *(const f32x4*)(fg + col); }
        float ss = 0.f;
#pragma unroll
        for (int k = 0; k < 8; ++k) {
            const float x1[4] = {bflo(xw[k][0]), bfhi(xw[k][0]), bflo(xw[k][1]), bfhi(xw[k][1])};
#pragma unroll
            for (int e = 0; e < 4; ++e) { const float x2 = x1[e] + PEER_ALPHA * gvv[k][e] * acc[k * 2 + (e >> 1)][e & 1]; acc[k * 2 + (e >> 1)][e & 1] = x2; ss += x2 * x2; }
        }
        ss = wave_sum_bcast(ss);
        const float rstd = rsqrtf(ss * (1.f / 2048.f) + 1e-6f);
#pragma unroll
        for (int k = 0; k < 8; ++k) {
            const int col = lane * 32 + k * 4;
            f32x4 o;
#pragma unroll
            for (int e = 0; e < 4; ++e) o[e] = acc[k * 2 + (e >> 1)][e & 1] * rstd * fvv[k][e];
            if (!DRY || rstd == 123.456f) *(f32x4*)(xo + col) = o;
        }
    }
    __syncthreads();
}
constexpr int NPHASE = 11;
#ifndef DBG
#define DBG 0
#endif
__device__ __forceinline__ void dbg_final_norm(const Args& a, const Ctx& c, const float* src) {
    for (int t = c.bid * 8 + c.wave; t < L_; t += c.nb * 8) {
        const float* xr = src + (size_t)t * 2048 + c.lane * 4; float* o = a.out + (size_t)t * 2048 + c.lane * 4;
        f32x4 v[8]; float ss = 0.f;
#pragma unroll
        for (int j = 0; j < 8; ++j) { v[j] = *(const f32x4*)(xr + j * 256); ss += v[j][0] * v[j][0] + v[j][1] * v[j][1] + v[j][2] * v[j][2] + v[j][3] * v[j][3]; }
        ss = wave_sum(ss);
        const float rstd = rsqrtf(ss * (1.f / 2048.f) + 1e-6f);
#pragma unroll
        for (int j = 0; j < 8; ++j) { const f32x4 g = *(const f32x4*)(a.in[32] + j * 256 + c.lane * 4); *(f32x4*)(o + j * 256) = v[j] * rstd * g; }
    }
}

extern __shared__ __attribute__((aligned(16))) unsigned char smem[];

__global__ void __launch_bounds__(512, 2) fwd(Args a) {
    LAS unsigned char* lds = (LAS unsigned char*)smem;
    Ctx c; c.bid = blockIdx.x; c.nb = gridDim.x; c.tid = threadIdx.x; c.wave = __builtin_amdgcn_readfirstlane(threadIdx.x >> 6); c.lane = threadIdx.x & 63; c.lds = lds;
    volatile LAS unsigned* xbw = (volatile LAS unsigned*)(lds + LDS_BYTES - 16);
    if (c.tid < 4) xbw[c.tid] = 0u;
    __syncthreads();
    const int lo = a.ph_lo, hi = a.ph_hi;
    const bool multi = (hi - lo) > 1;
    XcdBarrier bar; bar.bar = (unsigned*)(a.ws + WS_CTL); bar.x = 0; bar.st = xbw;
    if (multi) bar = xcd_barrier_post((unsigned*)(a.ws + WS_CTL), xbw);
#ifndef PHASE_MASK
#define PHASE_MASK 0xFFFF
#endif
#if DBG == 1
#undef PHASE_MASK
#define PHASE_MASK 0x403
#elif DBG == 2 || DBG == 4 || DBG == 5
#undef PHASE_MASK
#define PHASE_MASK 0x4FF
#endif
#define IN(k) (((PHASE_MASK >> (k)) & 1) && lo <= (k) && (k) < hi)
#define REFRESH() do { int tz_ = threadIdx.x; asm volatile("" : "+v"(tz_)); c.tid = tz_; c.lane = tz_ & 63; c.wave = __builtin_amdgcn_readfirstlane(tz_ >> 6); } while (0)
#define SEAM(k) do { if (IN(k) && IN((k) + 1)) xcd_barrier(bar); } while (0)
#ifndef DUP
#define DUP -1
#endif
#define REP(k) for (int rep_ = 0; rep_ < ((DUP == (k)) ? 2 : 1); ++rep_)
#define DUP2(k, ...) do { __VA_ARGS__; if (DUP == (k)) { __syncthreads(); __VA_ARGS__; } } while (0)

    if (IN(0)) REP(0) { REFRESH(); p0_prologue(a, c); }
    SEAM(0);
    if (IN(1)) { REFRESH(); DUP2(1, p1_hnorm(a, c)); }
    SEAM(1);
    if (IN(2)) { REFRESH();
        pg8::StaticOrder S; S.init((const bf16_t*)(a.ws + WS_H), (const bf16_t*)(a.ws + WS_WIN), 2048, 2048, 2048, L_, DIN_PAD, c.nb, c.bid);
        EpiWin E{(bf16_t*)(a.ws + WS_US), (bf16_t*)(a.ws + WS_Q), (bf16_t*)(a.ws + WS_KROW), (bf16_t*)(a.ws + WS_VROW), (bf16_t*)(a.ws + WS_VT), (float*)(a.ws + WS_GATE)};
        DUP2(2, pg8::gemm_phase<EpiWin, pg8::StaticOrder>(lds, S, E));
    }
    SEAM(2);
    if (IN(3)) { REFRESH();
        DUP2(31, for (int it = c.bid; it < 256; it += c.nb) s5_item<0>(a, c, it >> 2, it & 3));
        __syncthreads();
        CmpOrder S{(const bf16_t*)(a.ws + WS_KROW), (const bf16_t*)(a.ws + WS_VROW), (const bf16_t*)(a.ws + WS_W1), 2048, 4096, 256, c.nb, c.bid};
        EpiSlab E{(float*)(a.ws + WS_SLAB)};
        DUP2(32, pg8::gemm_phase<EpiSlab, CmpOrder>(lds, S, E));
    }
    SEAM(3);
    if (IN(4)) { REFRESH();
        DUP2(41, for (int it = c.bid; it < 256; it += c.nb) cmp_finish_item(a, c, it >> 7, it & 127));
        DUP2(42, for (int it = c.bid; it < 256; it += c.nb) s5_item<1>(a, c, it >> 2, it & 3));
    }
    SEAM(4);
    if (IN(5)) { REFRESH();
#if DBG == 5
        for (size_t i = (size_t)c.bid * NTHREADS + c.tid; i < (size_t)L_ * 1024 / 8; i += (size_t)c.nb * NTHREADS) *(u32x4*)((bf16_t*)(a.ws + WS_YSSM) + i * 8) = (u32x4){0u, 0u, 0u, 0u};
#else
        {
            pg8::StaticOrder S; S.init((const bf16_t*)(a.ws + WS_Z), (const bf16_t*)(a.ws + WS_WGLU), 1024, 1024, 1024, L_, 1024, c.nb, c.bid);
            EpiGlu E{(const bf16_t*)(a.ws + WS_Z), a.in[19], (bf16_t*)(a.ws + WS_Y2), (float*)(a.ws + WS_STSP)};
            DUP2(55, pg8::gemm_phase<EpiGlu, pg8::StaticOrder>(lds, S, E));
        }
#endif
        __syncthreads();
        REP(5)
#if DBG == 4
        for (size_t i = (size_t)c.bid * NTHREADS + c.tid; i < (size_t)L_ * 1024 / 8; i += (size_t)c.nb * NTHREADS) *(u32x4*)((bf16_t*)(a.ws + WS_YATT) + i * 8) = (u32x4){0u, 0u, 0u, 0u};
#else
        {
            unsigned* qhead = (unsigned*)(a.ws + WS_CTL) + 8192;
            volatile LAS unsigned* slot = (volatile LAS unsigned*)(lds + LDS_BYTES - 32);
            for (;;) {
                if (c.tid == 0) *slot = __hip_atomic_fetch_add(qhead, 1u, __ATOMIC_RELAXED, __HIP_MEMORY_SCOPE_AGENT);
                __syncthreads();
                const unsigned q = *slot;
                __syncthreads();
                if (q >= 512u) break;
                attn_item(a, c, 255 - (int)(q >> 1), (int)(q & 1));
            }
        }
#endif
    }
    SEAM(5);
#define WOUT_GEMM(PM0) do { pg8::StaticOrder S; S.init((const bf16_t*)(a.ws + WS_Y2), (const bf16_t*)(a.ws + WS_WOUT), 2048, 2048, 2048, L_ / 2, 2048, c.nb, c.bid, PM0); \
        rsa_prepass(S, (const float*)(a.ws + WS_STSP), (const float*)(a.ws + WS_STAP), (float*)(a.ws + WS_RSA), c.tid); \
        EpiWout E{a.in[0], (const float*)(a.ws + WS_COND) + 2 * 2048, (const float*)(a.ws + WS_F2), (bf16_t*)(a.ws + WS_X1), (bf16_t*)(a.ws + WS_H2), (float*)(a.ws + WS_ST2P), (const float*)(a.ws + WS_RSA)}; \
        pg8::gemm_phase<EpiWout, pg8::StaticOrder>(lds, S, E); __syncthreads(); } while (0)
#define WQ_GEMM(PM0) do { pg8::StaticOrder S; S.init((const bf16_t*)(a.ws + WS_H2), (const bf16_t*)(a.ws + WS_WQ), 2048, 2048, 2048, L_ / 2, 2048, c.nb, c.bid, PM0); \
        rstd2_prepass(S, (const float*)(a.ws + WS_ST2P), (float*)(a.ws + WS_RSTD2), c.tid); \
        EpiQ E{(bf16_t*)(a.ws + WS_QP), (const float*)(a.ws + WS_RSTD2), (const float*)(a.ws + WS_CQ)}; pg8::gemm_phase<EpiQ, pg8::StaticOrder>(lds, S, E); __syncthreads(); } while (0)
#define PEER_STEPS(FIRST, COUNT) do { for (int s_ = (FIRST) + c.bid; s_ < (FIRST) + (COUNT); s_ += c.nb) peer_step<false>(a, c, s_ * 8); } while (0)
    if (IN(6)) { REFRESH(); DUP2(7, p_cqce(a, c)); DUP2(71, WOUT_GEMM(0)); }
    SEAM(6);
    if (IN(7)) { REFRESH(); DUP2(8, WQ_GEMM(0)); }
    SEAM(7);
    if (IN(8)) { REFRESH();
        if ((c.bid >> 3) & 1) PEER_STEPS(0, 512);
        WOUT_GEMM(32);
        if (!((c.bid >> 3) & 1)) PEER_STEPS(0, 512); }
    SEAM(8);
    if (IN(9)) { REFRESH();
        if ((c.bid >> 3) & 1) PEER_STEPS(512, 512);
        WQ_GEMM(32);
        if (!((c.bid >> 3) & 1)) PEER_STEPS(512, 512); }
    SEAM(9);
    if (IN(10)) { REFRESH(); DUP2(11, PEER_STEPS(1024, 1024)); }
#undef WOUT_GEMM
#undef WQ_GEMM
#undef PEER_STEPS
#undef IN
#undef SEAM
}

#ifndef N_LAUNCHES
#define N_LAUNCHES 1
#endif
extern "C" void kernel_launch(void* const* d_in, const int* in_sizes, int n_in, void* d_out, int out_size, void* d_ws, size_t ws_size, hipStream_t stream) {
    static int grid = 0;
    if (grid == 0) {
        if (n_in != 33 || out_size != L_ * D_ || ws_size < WS_END) { fprintf(stderr, "kernel_launch: unexpected shapes (n_in %d, out %d, ws %zu < %zu); nothing launched\n", n_in, out_size, ws_size, (size_t)WS_END); grid = -1; return; }
        int dev = 0, cus = 0, per_cu = 0;
        if (hipGetDevice(&dev) != hipSuccess || hipDeviceGetAttribute(&cus, hipDeviceAttributeMultiprocessorCount, dev) != hipSuccess) { grid = -1; return; }
        if (hipFuncSetAttribute((const void*)fwd, hipFuncAttributeMaxDynamicSharedMemorySize, LDS_BYTES) != hipSuccess) { fprintf(stderr, "kernel_launch: hipFuncSetAttribute failed\n"); grid = -1; return; }
        if (hipOccupancyMaxActiveBlocksPerMultiprocessor(&per_cu, (const void*)fwd, NTHREADS, LDS_BYTES) != hipSuccess || per_cu < 1) { fprintf(stderr, "kernel_launch: occupancy query says %d\n", per_cu); (void)hipGetLastError(); grid = -1; return; }
        grid = cus;
    }
    if (grid < 0) return;
    (void)hipMemsetAsync((char*)d_ws + WS_CTL, 0, CTL_BYTES, stream);
    Args a{};
    for (int i = 0; i < 33; ++i) a.in[i] = (const float*)d_in[i];
    a.out = (float*)d_out; a.ws = (unsigned char*)d_ws;
    if (N_LAUNCHES == 1) { a.ph_lo = 0; a.ph_hi = NPHASE; hipLaunchKernelGGL(fwd, dim3(grid), dim3(NTHREADS), LDS_BYTES, stream, a); }
    else for (int p = 0; p < NPHASE; ++p) { a.ph_lo = p; a.ph_hi = p + 1; hipLaunchKernelGGL(fwd, dim3(grid), dim3(NTHREADS), LDS_BYTES, stream, a); }
}
```

```cpp
#include <hip/hip_runtime.h>
#include <stdint.h>
#include <stdio.h>

#define LAS __attribute__((address_space(3)))
typedef unsigned short bf16_t;
typedef short bf16x8 __attribute__((ext_vector_type(8)));
typedef float f32x2 __attribute__((ext_vector_type(2)));
typedef float f32x4 __attribute__((ext_vector_type(4)));
typedef float f32x16 __attribute__((ext_vector_type(16)));
typedef unsigned u32x2 __attribute__((ext_vector_type(2)));
typedef unsigned u32x4 __attribute__((ext_vector_type(4)));
typedef __bf16 bfv2 __attribute__((ext_vector_type(2)));
typedef unsigned u32x6 __attribute__((ext_vector_type(6)));
typedef float f32x32 __attribute__((ext_vector_type(32)));

constexpr int L_ = 16384, D_ = 2048, DSSM = 1024, DATT = 1024, DIN = 3608, DIN_PAD = 3840;
constexpr int NADA = 12288;
constexpr float LOG2E = 1.4426950408889634f;
constexpr float QSCALE = 0.08838834764831845f * 1.4426950408889634f;
constexpr int TBN = 800;
constexpr int NTHREADS = 512;
constexpr int LDS_BYTES = 163840;

constexpr size_t al256(size_t x) { return (x + 255) & ~(size_t)255; }
constexpr size_t WS_CTL   = 0;                                  constexpr size_t CTL_BYTES = 65536;
constexpr size_t WS_CONDP = WS_CTL + CTL_BYTES;
constexpr size_t WS_COND  = WS_CONDP + 32 * 12288 * 4;
constexpr size_t WS_TB    = WS_COND + 12288 * 4;
constexpr size_t WS_BPE   = al256(WS_TB + 8 * TBN * 4);
constexpr size_t WS_S5P   = al256(WS_BPE + 2 * 256 * 4);
constexpr size_t WS_S5F   = WS_S5P + 2 * 64 * 64 * 2 * 4;
constexpr size_t WS_S5MT  = WS_S5F + 64 * 4 * 128 * 4;
constexpr size_t WS_S5WE  = WS_S5MT + (size_t)64 * 256 * 256 * 2;
constexpr size_t WS_S5WC  = WS_S5WE + (size_t)64 * 128 * 256 * 2;
constexpr size_t WS_WIN   = WS_S5WC + (size_t)64 * 256 * 128 * 2;
constexpr size_t WS_WGLU  = WS_WIN + (size_t)DIN_PAD * 2048 * 2;
constexpr size_t WS_WOUT  = WS_WGLU + (size_t)1024 * 1024 * 2;
constexpr size_t WS_WQ    = WS_WOUT + (size_t)2048 * 2048 * 2;
constexpr size_t WS_W1    = WS_WQ + (size_t)2048 * 2048 * 2;
constexpr size_t WS_W2    = WS_W1 + (size_t)2 * 256 * 4096 * 2;
constexpr size_t WS_PK    = WS_W2 + (size_t)2 * 128 * 256 * 2;
constexpr size_t WS_PU    = WS_PK + (size_t)2 * 128 * 128 * 2;
constexpr size_t WS_PV    = WS_PU + (size_t)16384 * 1024;
constexpr size_t WS_PSC   = WS_PV + (size_t)16384 * 1024;
constexpr size_t WS_BPEP  = WS_PSC + (size_t)4 * 16384 * 4;
constexpr size_t WS_H     = WS_BPEP + (size_t)32 * 2 * 256 * 4;
constexpr size_t WS_US    = WS_H + (size_t)16384 * 2048 * 2;
constexpr size_t WS_Q     = WS_US + (size_t)16384 * 1024 * 2;
constexpr size_t WS_QP    = WS_US;
constexpr size_t WS_KROW  = WS_Q + (size_t)16384 * 1024 * 2;
constexpr size_t WS_VROW  = WS_KROW + (size_t)6 * 16384 * 128 * 2;
constexpr size_t WS_VT    = WS_VROW + (size_t)2 * 16384 * 128 * 2 + 8192;
constexpr size_t WS_GATE  = WS_VT + (size_t)4 * 128 * 16384 * 2;
constexpr size_t WS_SLAB  = WS_GATE + (size_t)16384 * 24 * 4;
constexpr size_t WS_KC    = WS_SLAB + (size_t)2 * 16 * 2048 * 256 * 4;
constexpr size_t WS_VCT   = WS_KC + (size_t)2 * 1024 * 128 * 2;
constexpr size_t WS_Z     = WS_VCT + (size_t)2 * 128 * 1024 * 2;
constexpr size_t WS_YSSM  = WS_Z + (size_t)16384 * 1024 * 2;
constexpr size_t WS_YATT  = WS_YSSM + (size_t)16384 * 1024 * 2;
constexpr size_t WS_H2    = WS_SLAB;
constexpr size_t WS_Y2    = WS_YSSM;
constexpr size_t WS_X1    = WS_H;
constexpr size_t WS_ST2P  = WS_YATT + (size_t)16384 * 1024 * 2;
constexpr size_t WS_RSTD2 = WS_ST2P + (size_t)16384 * 32 * 4;
constexpr size_t WS_F2    = WS_RSTD2 + (size_t)16384 * 4;
constexpr size_t WS_CQ    = WS_F2 + 2048 * 4;
constexpr size_t WS_STSP  = WS_CQ + 2048 * 4;
constexpr size_t WS_STAP  = WS_STSP + (size_t)16384 * 16 * 4;
constexpr size_t WS_RSA   = WS_STAP + (size_t)16384 * 2 * 4;
constexpr size_t WS_END   = WS_RSA + (size_t)16384 * 2 * 4;
static_assert(WS_END < (size_t)530 * 1024 * 1024, "workspace map too large");

struct Args { const float* in[33]; float* out; unsigned char* ws; int ph_lo, ph_hi; };

__device__ __forceinline__ unsigned cvt_pk_bf16(float lo, float hi) { bfv2 v; v[0] = (__bf16)lo; v[1] = (__bf16)hi; return __builtin_bit_cast(unsigned, v); }
__device__ __forceinline__ bf16_t f2bf(float f) { return (bf16_t)(cvt_pk_bf16(f, 0.f) & 0xffffu); }
__device__ __forceinline__ float bf2f(unsigned b) { return __uint_as_float(b << 16); }
__device__ __forceinline__ float bflo(unsigned w) { return __uint_as_float(w << 16); }
__device__ __forceinline__ float bfhi(unsigned w) { return __uint_as_float(w & 0xffff0000u); }
__device__ __forceinline__ float fexp2(float x) { return __builtin_amdgcn_exp2f(x); }
__device__ __forceinline__ float frcp(float x) { return __builtin_amdgcn_rcpf(x); }
__device__ __forceinline__ float sigmoidf_(float x) { return frcp(1.f + fexp2(-LOG2E * x)); }
__device__ __forceinline__ float gelu_tanh(float x) {
    const float u = x * (1.f + 0.044715f * x * x);
    return x * frcp(1.f + fexp2(-2.f * 0.7978845608028654f * LOG2E * u));
}
__device__ __forceinline__ float shfl_xor_f(float v, int m) { return __shfl_xor(v, m, 64); }
__device__ __forceinline__ float wave_sum(float v) {
#pragma unroll
    for (int m = 32; m >= 1; m >>= 1) v += __shfl_xor(v, m, 64);
    return v;
}
__device__ __forceinline__ float wave_max(float v) {
#pragma unroll
    for (int m = 32; m >= 1; m >>= 1) v = fmaxf(v, __shfl_xor(v, m, 64));
    return v;
}
template <int CTRL> __device__ __forceinline__ float dpp_f(float x) { return __int_as_float(__builtin_amdgcn_update_dpp(0, __float_as_int(x), CTRL, 0xf, 0xf, false)); }
__device__ __forceinline__ float wave_max_bcast(float v) {
    v = fmaxf(v, dpp_f<0xB1>(v)); v = fmaxf(v, dpp_f<0x4E>(v)); v = fmaxf(v, dpp_f<0x141>(v)); v = fmaxf(v, dpp_f<0x140>(v));
    v = fmaxf(v, __int_as_float(__builtin_amdgcn_update_dpp(__float_as_int(v), __float_as_int(v), 0x142, 0xa, 0xf, false)));
    v = fmaxf(v, __int_as_float(__builtin_amdgcn_update_dpp(__float_as_int(v), __float_as_int(v), 0x143, 0xc, 0xf, false)));
    return __int_as_float(__builtin_amdgcn_readlane(__float_as_int(v), 63));
}
__device__ __forceinline__ unsigned wave_umax_bcast(unsigned v) {
#define UDPP_(x, ctrl, rm) (unsigned)__builtin_amdgcn_update_dpp((int)(x), (int)(x), ctrl, rm, 0xf, false)
    v = max(v, UDPP_(v, 0xB1, 0xf)); v = max(v, UDPP_(v, 0x4E, 0xf)); v = max(v, UDPP_(v, 0x141, 0xf)); v = max(v, UDPP_(v, 0x140, 0xf));
    v = max(v, UDPP_(v, 0x142, 0xa)); v = max(v, UDPP_(v, 0x143, 0xc));
#undef UDPP_
    return (unsigned)__builtin_amdgcn_readlane((int)v, 63);
}
__device__ __forceinline__ float quad_sum(float x) { x += dpp_f<0xB1>(x); x += dpp_f<0x4E>(x); return x; }
template <int SEL> __device__ __forceinline__ f32x2 fp4_unpk(unsigned w) { return __builtin_amdgcn_cvt_scalef32_pk_f32_fp4(w, 1.0f, SEL); }
template <int SEL> __device__ __forceinline__ unsigned fp4_pk(unsigned w, float a, float b) { return __builtin_amdgcn_cvt_scalef32_pk_fp4_f32(w, a, b, 1.0f, SEL); }
__device__ __forceinline__ f32x4 mfma16(bf16x8 a, bf16x8 b, f32x4 c) { return __builtin_amdgcn_mfma_f32_16x16x32_bf16(a, b, c, 0, 0, 0); }
__device__ __forceinline__ f32x16 mfma32(bf16x8 a, bf16x8 b, f32x16 c) { return __builtin_amdgcn_mfma_f32_32x32x16_bf16(a, b, c, 0, 0, 0); }
#define XB_TMO      128
#define XB_XCNT(j)  (256  + 64 * (j))
#define XB_XSUB(j)  (1280 + 64 * (j))
#define XB_XGEN(j)  (2304 + 64 * (j))
#define XB_TOP      3328
#define XB_TOPGEN   3392
#define XCD_BAR_WORDS 3456
#define XB_SPIN_CAP (1u << 18)

__device__ __forceinline__ unsigned xb_ld(unsigned* p)              { return __hip_atomic_load(p, __ATOMIC_RELAXED, __HIP_MEMORY_SCOPE_AGENT); }
__device__ __forceinline__ unsigned xb_add(unsigned* p, unsigned v) { return __hip_atomic_fetch_add(p, v, __ATOMIC_RELAXED, __HIP_MEMORY_SCOPE_AGENT); }
__device__ __forceinline__ unsigned xb_xcc_id() { return (unsigned)__builtin_amdgcn_s_getreg((3 << 11) | 20) & 0xFu; }
#define XB_SPIN(cond, bar) do { unsigned _sp = 0; while (cond) { __builtin_amdgcn_s_sleep(1); \
    if ((++_sp & 255u) == 0u) { if (xb_ld(&(bar)[XB_TMO])) break; if (_sp > XB_SPIN_CAP) { atomicAdd(&(bar)[XB_TMO], 1u); break; } } } } while (0)

struct XcdBarrier {
    unsigned* bar; unsigned x;
    volatile LAS unsigned* st;
};
__device__ __forceinline__ XcdBarrier xcd_barrier_post(unsigned* bar, volatile LAS unsigned* st) {
    XcdBarrier b; b.bar = bar; b.x = xb_xcc_id(); b.st = st;
    if (threadIdx.x == 0) (void)xb_add(&bar[XB_XCNT(b.x)], 1u);
    return b;
}
__device__ __forceinline__ void xcd_barrier_complete(unsigned* bar, unsigned x, unsigned& nloc, unsigned& nx) {
    const unsigned G = gridDim.x * gridDim.y * gridDim.z;
    unsigned sum, cnt, mine, sp = 0u;
    for (;;) {
        sum = 0u; cnt = 0u; mine = 0u;
#pragma unroll
        for (unsigned j = 0; j < 16; ++j) { const unsigned c = xb_ld(&bar[XB_XCNT(j)]); sum += c; cnt += (c > 0u) ? 1u : 0u; mine = (j == x) ? c : mine; }
        if (sum == G) break;
        __builtin_amdgcn_s_sleep(1);
        if ((++sp & 255u) == 0u) { if (xb_ld(&bar[XB_TMO])) break; if (sp > XB_SPIN_CAP) { atomicAdd(&bar[XB_TMO], 1u); break; } }
    }
    nloc = mine > 0u ? mine : 1u; nx = cnt > 0u ? cnt : 1u;
}
__device__ __forceinline__ void xcd_barrier(const XcdBarrier& b) {
    asm volatile("s_waitcnt vmcnt(0)" ::: "memory");
    __syncthreads();
    if (threadIdx.x == 0) {
        unsigned* bar = b.bar;
        __builtin_amdgcn_s_waitcnt(0);
        unsigned nloc = b.st[0], nx = b.st[1];
        if (nloc == 0u) { xcd_barrier_complete(bar, b.x, nloc, nx); b.st[0] = nloc; b.st[1] = nx; }
        const unsigned old = xb_add(&bar[XB_XSUB(b.x)], 1u);
        const unsigned gen = old / nloc;
        if (old + 1u == (gen + 1u) * nloc) {
            __builtin_amdgcn_fence(__ATOMIC_RELEASE, "agent");
            asm volatile("s_waitcnt vmcnt(0)" ::: "memory");
            const unsigned og = xb_add(&bar[XB_TOP], 1u);
            const unsigned tg = og / nx;
            if (og + 1u == (tg + 1u) * nx) xb_add(&bar[XB_TOPGEN], 1u);
            else XB_SPIN(xb_ld(&bar[XB_TOPGEN]) == tg, bar);
            __builtin_amdgcn_fence(__ATOMIC_ACQUIRE, "agent");
            xb_add(&bar[XB_XGEN(b.x)], 1u);
            asm volatile("s_waitcnt vmcnt(0)" ::: "memory");
        } else {
            XB_SPIN(xb_ld(&bar[XB_XGEN(b.x)]) == gen, bar);
            __builtin_amdgcn_fence(__ATOMIC_ACQUIRE, "agent");
            asm volatile("s_waitcnt vmcnt(0)" ::: "memory");
        }
    }
    __syncthreads();
}

namespace pg8 {
constexpr int BM = 256, BK = 64, HALF = 128, HTB = HALF * BK * 2, STAGE_BYTES = 8 * HTB, NXCD = 8, WGM = 8;
__host__ __device__ __forceinline__ int lds_byte(int r, int c) { const int st = (r >> 4) * 2 + (c >> 5), rr = r & 15, cc = c & 31, ob = rr * 64 + cc * 2; return st * 1024 + (ob ^ (((ob >> 9) & 1) << 5)); }
__host__ __device__ __forceinline__ void stage_rc(int b, int& R, int& C) { const int st = b / 1024, sb = b % 1024, swz = sb ^ (((sb >> 9) & 1) << 5); R = (st >> 1) * 16 + swz / 64; C = (st & 1) * 32 + (swz % 64) / 2; }
__host__ __device__ __forceinline__ int perm32(int rho) { const int n = rho >> 4, i = rho & 15; return 8 * (i >> 2) + 4 * n + (i & 3); }

struct Unit { int pm, pn, z; };
struct StaticOrder {
    const bf16_t* A; const bf16_t* Bt; int lda, ldb, K;
    int nM, nN, nwg, G, c, pm0;
    __device__ void init(const bf16_t* A_, const bf16_t* Bt_, int lda_, int ldb_, int K_, int M, int N, int G_, int c_, int pm0_ = 0) { A = A_; Bt = Bt_; lda = lda_; ldb = ldb_; K = K_; nM = M / BM; nN = N / BM; nwg = nM * nN; G = G_; c = c_; pm0 = pm0_; }
    __device__ bool next(int i, Unit& u) const {
        const long Lx = (long)i * G + c; if (Lx >= nwg) return false;
        int wgid = (int)Lx; { const int q = nwg / NXCD, r = nwg % NXCD, xcd = wgid % NXCD, off = wgid / NXCD; wgid = (xcd < r ? xcd * (q + 1) : r * (q + 1) + (xcd - r) * q) + off; }
        const int nig = WGM * nN, gid = wgid / nig, fm = gid * WGM, gsz = (nM - fm) < WGM ? (nM - fm) : WGM;
        u.pm = pm0 + fm + ((wgid % nig) % gsz); u.pn = (wgid % nig) / gsz; u.z = 0; return true;
    }
    __device__ __forceinline__ const char* a_base(const Unit& u) const { return (const char*)(A + (size_t)u.pm * BM * lda); }
    __device__ __forceinline__ const char* b_base(const Unit& u) const { return (const char*)(Bt + (size_t)u.pn * BM * ldb); }
};

template <class Epi, class Sched>
__device__ __forceinline__ void gemm_phase(LAS unsigned char* lds, const Sched& S, const Epi& E) {
    const int tid = threadIdx.x, wid = __builtin_amdgcn_readfirstlane(tid >> 6), lane = tid & 63, wr = wid >> 2, wc = wid & 3, fr = lane & 15, fq = lane >> 4;
    const int K = S.K, nt = K / BK, lda = S.lda, ldb = S.ldb;
    unsigned voffA[2], voffB[2];
#pragma unroll
    for (int i = 0; i < 2; ++i) { int R, C; stage_rc(tid * 16 + i * 8192, R, C); const int Rb = Epi::PERM ? ((R & ~31) + perm32(R & 31)) : R;
        voffA[i] = (unsigned)(R * lda + C) * 2u; voffB[i] = (unsigned)(Rb * ldb + C) * 2u; }
    const size_t kstep = (size_t)(BK * 2);
    const size_t hstepA = (size_t)HALF * lda * 2, hstepB = (size_t)HALF * ldb * 2;
    const unsigned ldsw = (unsigned)wid * 1024u;
    const int aoff = lds_byte(wr * 64 + fr, fq * 8), boff = lds_byte(wc * 32 + fr, fq * 8);
#define PG8_SA(b, h) (((b) * 2 + (h)) * HTB)
#define PG8_SB(b, h) ((4 + (b) * 2 + (h)) * HTB)
#define PG8_STAGE(bufoff, gbase, voff) do { _Pragma("unroll") for (int _i = 0; _i < 2; ++_i) \
        __builtin_amdgcn_global_load_lds((const unsigned*)((const char*)(gbase) + (voff)[_i]), (LAS unsigned*)(lds + (bufoff) + ldsw + _i * 8192), 16, 0, 0); } while (0)
#define PG8_LDA(dst, b, h) do { _Pragma("unroll") for (int m = 0; m < 4; ++m) _Pragma("unroll") for (int k = 0; k < 2; ++k) dst[m][k] = *(const LAS bf16x8*)(lds + PG8_SA(b, h) + aoff + m * 2048 + k * 1024); } while (0)
#define PG8_LDB(dst, b, h) do { _Pragma("unroll") for (int n = 0; n < 2; ++n) _Pragma("unroll") for (int k = 0; k < 2; ++k) dst[n][k] = *(const LAS bf16x8*)(lds + PG8_SB(b, h) + boff + n * 2048 + k * 1024); } while (0)
#define PG8_MMA(ai, bj, At, Bt) do { __builtin_amdgcn_s_setprio(1); _Pragma("unroll") for (int m = 0; m < 4; ++m) _Pragma("unroll") for (int n = 0; n < 2; ++n) _Pragma("unroll") for (int k = 0; k < 2; ++k) \
        acc[ai][bj][m][n] = __builtin_amdgcn_mfma_f32_16x16x32_bf16(Bt[n][k], At[m][k], acc[ai][bj][m][n], 0, 0, 0); __builtin_amdgcn_s_setprio(0); } while (0)
#define PG8_WAIT_V(n) asm volatile("s_waitcnt vmcnt(" #n ")" ::: "memory")
#define PG8_WAIT_L(n) asm volatile("s_waitcnt lgkmcnt(" #n ")" ::: "memory")
#define PG8_BAR __builtin_amdgcn_s_barrier()
#define PG8_SCHED __builtin_amdgcn_sched_barrier(0)
    Unit cur, nxt; int ui = 0;
    if (!S.next(0, cur)) return;
    f32x4 acc[2][2][4][2];
#pragma unroll
    for (int a = 0; a < 2; ++a)
#pragma unroll
        for (int b = 0; b < 2; ++b)
#pragma unroll
            for (int m = 0; m < 4; ++m)
#pragma unroll
                for (int n = 0; n < 2; ++n) acc[a][b][m][n] = (f32x4){0.f, 0.f, 0.f, 0.f};
    bf16x8 At[4][2], B0[2][2], B1[2][2];
    const char* cA = S.a_base(cur); const char* cB = S.b_base(cur);
    PG8_STAGE(PG8_SB(0, 0), cB, voffB); PG8_STAGE(PG8_SA(0, 0), cA, voffA); PG8_STAGE(PG8_SB(0, 1), cB + hstepB, voffB); PG8_STAGE(PG8_SA(0, 1), cA + hstepA, voffA);
    if (wr == 1) PG8_BAR;
    PG8_WAIT_V(4); PG8_BAR;
    PG8_STAGE(PG8_SB(1, 0), cB + kstep, voffB); PG8_STAGE(PG8_SA(1, 0), cA + kstep, voffA); PG8_STAGE(PG8_SB(1, 1), cB + hstepB + kstep, voffB);
    PG8_WAIT_V(6); PG8_BAR;
    for (;;) {
        const bool has_next = S.next(ui + 1, nxt);
        const char* nA = has_next ? S.a_base(nxt) : cA; const char* nB = has_next ? S.b_base(nxt) : cB;
        for (int t = 0; t < nt; t += 2) {
            if constexpr (Epi::MIDK) { if (t == (nt >> 1)) E.midk(acc, cur, wr, fr); }
            const bool last = (t == nt - 2);
            const char* a1 = cA + (size_t)(t + 1) * kstep;
            const char* a2 = last ? nA : cA + (size_t)(t + 2) * kstep; const char* b2 = last ? nB : cB + (size_t)(t + 2) * kstep;
            const char* a3 = a2 + kstep; const char* b3 = b2 + kstep;
            PG8_LDB(B0, 0, 0); PG8_SCHED; PG8_LDA(At, 0, 0); PG8_STAGE(PG8_SA(1, 1), a1 + hstepA, voffA);
            PG8_WAIT_L(8); PG8_BAR; PG8_WAIT_L(0); PG8_MMA(0, 0, At, B0); PG8_BAR; PG8_SCHED;
            PG8_LDB(B1, 0, 1); PG8_STAGE(PG8_SB(0, 0), b2, voffB);
            PG8_BAR; PG8_WAIT_L(0); PG8_MMA(0, 1, At, B1); PG8_BAR;
            PG8_LDA(At, 0, 1); PG8_STAGE(PG8_SA(0, 0), a2, voffA);
            PG8_BAR; PG8_WAIT_L(0); PG8_MMA(1, 0, At, B0); PG8_BAR; PG8_SCHED;
            PG8_STAGE(PG8_SB(0, 1), b2 + hstepB, voffB);
            PG8_WAIT_V(6); PG8_BAR; PG8_MMA(1, 1, At, B1); PG8_BAR;
            PG8_LDB(B0, 1, 0); PG8_SCHED; PG8_LDA(At, 1, 0); PG8_STAGE(PG8_SA(0, 1), a2 + hstepA, voffA);
            PG8_WAIT_L(8); PG8_BAR; PG8_WAIT_L(0); PG8_MMA(0, 0, At, B0); PG8_BAR; PG8_SCHED;
            PG8_LDB(B1, 1, 1); PG8_STAGE(PG8_SB(1, 0), b3, voffB);
            PG8_BAR; PG8_WAIT_L(0); PG8_MMA(0, 1, At, B1); PG8_BAR;
            PG8_LDA(At, 1, 1); PG8_STAGE(PG8_SA(1, 0), a3, voffA);
            PG8_BAR; PG8_WAIT_L(0); PG8_MMA(1, 0, At, B0); PG8_BAR; PG8_SCHED;
            PG8_STAGE(PG8_SB(1, 1), b3 + hstepB, voffB);
            PG8_WAIT_V(6); PG8_BAR; PG8_MMA(1, 1, At, B1); PG8_BAR;
        }
        E(acc, cur, wr, wc, fr, fq);
        if (!has_next) break;
#pragma unroll
        for (int a = 0; a < 2; ++a)
#pragma unroll
            for (int b = 0; b < 2; ++b)
#pragma unroll
                for (int m = 0; m < 4; ++m)
#pragma unroll
                    for (int n = 0; n < 2; ++n) acc[a][b][m][n] = (f32x4){0.f, 0.f, 0.f, 0.f};
        cur = nxt; cA = nA; cB = nB; ++ui;
    }
    PG8_WAIT_V(0);
    if (wr == 0) PG8_BAR;
    PG8_BAR;
#undef PG8_SA
#undef PG8_SB
#undef PG8_STAGE
#undef PG8_LDA
#undef PG8_LDB
#undef PG8_MMA
#undef PG8_WAIT_V
#undef PG8_WAIT_L
#undef PG8_BAR
#undef PG8_SCHED
}
}
using pg8::Unit;
__device__ __forceinline__ u32x4 pack8(const f32x4& v0, const f32x4& v1) {
    u32x4 o; o[0] = cvt_pk_bf16(v0[0], v0[1]); o[1] = cvt_pk_bf16(v0[2], v0[3]); o[2] = cvt_pk_bf16(v1[0], v1[1]); o[3] = cvt_pk_bf16(v1[2], v1[3]); return o;
}
struct EpiWin {
    static constexpr bool PERM = true; static constexpr bool MIDK = false;
    bf16_t* US; bf16_t* Q; bf16_t* KROW; bf16_t* VROW; bf16_t* VT; float* GATE;
    __device__ __forceinline__ void operator()(const f32x4 (&acc)[2][2][4][2], const Unit& u, int wr, int wc, int fr, int fq) const {
        const int row0 = u.pm * 256 + wr * 64 + fr; const int pn = u.pn;
#pragma unroll
        for (int ai = 0; ai < 2; ++ai)
#pragma unroll
            for (int m = 0; m < 4; ++m) {
                const int row = row0 + ai * 128 + m * 16;
#pragma unroll
                for (int bj = 0; bj < 2; ++bj) {
                    const f32x4 v0 = acc[ai][bj][m][0], v1 = acc[ai][bj][m][1];
                    const int cin = bj * 128 + wc * 32 + 8 * fq;
                    if (pn < 4) { *(u32x4*)(US + (size_t)row * 1024 + pn * 256 + cin) = pack8(v0, v1); }
                    else if (pn < 8) { *(u32x4*)(Q + (size_t)row * 1024 + (pn - 4) * 256 + cin) = pack8(v0 * QSCALE, v1 * QSCALE); }
                    else if (pn < 14) {
                        const int kvi = pn - 8, branch = kvi >> 1, kvsel = kvi & 1, g = bj, d0 = wc * 32 + 8 * fq;
                        if (kvsel == 0) { *(u32x4*)(KROW + ((size_t)(branch * 2 + g) * L_ + row) * 128 + d0) = pack8(v0, v1); }
                        else if (branch == 0) { *(u32x4*)(VROW + ((size_t)g * L_ + row) * 128 + d0) = pack8(v0, v1); }
                        else {
                            const int prow = ((row & ~12) | ((row & 4) << 1) | ((row & 8) >> 1));
                            bf16_t* vt = VT + ((size_t)((branch - 1) * 2 + g) * 128 + d0) * L_ + prow;
#pragma unroll
                            for (int e = 0; e < 4; ++e) { vt[(size_t)e * L_] = f2bf(v0[e]); vt[(size_t)(e + 4) * L_] = f2bf(v1[e]); }
                        }
                    } else {
                        if (cin < 24) {
                            float* gp = GATE + (size_t)row * 24 + cin;
                            f32x4 s0, s1;
#pragma unroll
                            for (int e = 0; e < 4; ++e) { s0[e] = sigmoidf_(v0[e]); s1[e] = sigmoidf_(v1[e]); }
                            *(f32x4*)gp = s0; *(f32x4*)(gp + 4) = s1;
                        }
                    }
                }
            }
    }
};
struct EpiGlu {
    static constexpr bool PERM = true; static constexpr bool MIDK = false;
    const bf16_t* Z; const float* bglu; bf16_t* Y; float* stsp;
    __device__ __forceinline__ void operator()(const f32x4 (&acc)[2][2][4][2], const Unit& u, int wr, int wc, int fr, int fq) const {
        const int row0 = u.pm * 256 + wr * 64 + fr;
        float ss[2][4];
#pragma unroll
        for (int ai = 0; ai < 2; ++ai)
#pragma unroll
            for (int m = 0; m < 4; ++m) ss[ai][m] = 0.f;
#pragma unroll
        for (int bj = 0; bj < 2; ++bj) {
            const int col = u.pn * 256 + bj * 128 + wc * 32 + 8 * fq;
            const f32x4 b0 = *(const f32x4*)(bglu + col), b1 = *(const f32x4*)(bglu + col + 4);
#pragma unroll
            for (int ai = 0; ai < 2; ++ai)
#pragma unroll
                for (int m = 0; m < 4; ++m) {
                    const int row = row0 + ai * 128 + m * 16;
                    const u32x4 zz = *(const u32x4*)(Z + (size_t)row * 1024 + col);
                    const f32x4 v0 = acc[ai][bj][m][0] + b0, v1 = acc[ai][bj][m][1] + b1;
                    f32x4 o0, o1;
                    o0[0] = bflo(zz[0]) * sigmoidf_(v0[0]); o0[1] = bfhi(zz[0]) * sigmoidf_(v0[1]); o0[2] = bflo(zz[1]) * sigmoidf_(v0[2]); o0[3] = bfhi(zz[1]) * sigmoidf_(v0[3]);
                    o1[0] = bflo(zz[2]) * sigmoidf_(v1[0]); o1[1] = bfhi(zz[2]) * sigmoidf_(v1[1]); o1[2] = bflo(zz[3]) * sigmoidf_(v1[2]); o1[3] = bfhi(zz[3]) * sigmoidf_(v1[3]);
                    *(u32x4*)(Y + (size_t)row * 2048 + col) = pack8(o0, o1);
                    ss[ai][m] += (o0[0] * o0[0] + o0[1] * o0[1]) + (o0[2] * o0[2] + o0[3] * o0[3]) + (o1[0] * o1[0] + o1[1] * o1[1]) + (o1[2] * o1[2] + o1[3] * o1[3]);
                }
        }
#pragma unroll
        for (int ai = 0; ai < 2; ++ai)
#pragma unroll
            for (int m = 0; m < 4; ++m) {
                float s = ss[ai][m];
                s += __shfl_xor(s, 16); s += __shfl_xor(s, 32);
                if (fq == 0) stsp[(size_t)(row0 + ai * 128 + m * 16) * 16 + u.pn * 4 + wc] = s;
            }
    }
};
struct EpiWout {
    static constexpr bool PERM = true; static constexpr bool MIDK = true;
    const float* X; const float* g1; const float* f2; bf16_t* X1; bf16_t* A2; float* st2p; const float* rsa;
    __device__ __forceinline__ void midk(f32x4 (&acc)[2][2][4][2], const Unit& u, int, int) const {
        int tz = threadIdx.x; asm volatile("" : "+v"(tz));
        const int row0 = u.pm * 256 + ((tz >> 8) & 1) * 64 + (tz & 15);
#pragma unroll
        for (int ai = 0; ai < 2; ++ai)
#pragma unroll
            for (int m = 0; m < 4; ++m) {
                const float r = rsa[(size_t)(row0 + ai * 128 + m * 16) * 2];
#pragma unroll
                for (int bj = 0; bj < 2; ++bj)
#pragma unroll
                    for (int n = 0; n < 2; ++n) acc[ai][bj][m][n] *= r;
            }
    }
    __device__ __forceinline__ void operator()(const f32x4 (&acc)[2][2][4][2], const Unit& u, int, int, int, int) const {
        int tz = threadIdx.x; asm volatile("" : "+v"(tz));
        const int wr = (tz >> 8) & 1, wc = (tz >> 6) & 3, fr = tz & 15, fq = (tz >> 4) & 3;
        const int row0 = u.pm * 256 + wr * 64 + fr, col0 = u.pn * 256 + wc * 32 + 8 * fq;
        float ss[2][4], ra[2][4];
#pragma unroll
        for (int ai = 0; ai < 2; ++ai)
#pragma unroll
            for (int m = 0; m < 4; ++m) { ss[ai][m] = 0.f; ra[ai][m] = rsa[(size_t)(row0 + ai * 128 + m * 16) * 2 + 1]; }
#pragma unroll
        for (int bj = 0; bj < 2; ++bj) {
            const int col = col0 + bj * 128;
            const f32x4 g0 = *(const f32x4*)(g1 + col), g4 = *(const f32x4*)(g1 + col + 4), f0 = *(const f32x4*)(f2 + col), f4 = *(const f32x4*)(f2 + col + 4);
#pragma unroll
            for (int ai = 0; ai < 2; ++ai)
#pragma unroll
                for (int m = 0; m < 4; ++m) {
                    const size_t off = (size_t)(row0 + ai * 128 + m * 16) * 2048 + col;
                    const f32x4 x0 = *(const f32x4*)(X + off), x4 = *(const f32x4*)(X + off + 4);
                    const f32x4 v0 = x0 + g0 * (acc[ai][bj][m][0] * ra[ai][m]), v1 = x4 + g4 * (acc[ai][bj][m][1] * ra[ai][m]);
                    *(u32x4*)(X1 + off) = pack8(v0, v1);
                    *(u32x4*)(A2 + off) = pack8(v0 * f0, v1 * f4);
                    ss[ai][m] += (v0[0] * v0[0] + v0[1] * v0[1]) + (v0[2] * v0[2] + v0[3] * v0[3]) + (v1[0] * v1[0] + v1[1] * v1[1]) + (v1[2] * v1[2] + v1[3] * v1[3]);
                }
        }
#pragma unroll
        for (int ai = 0; ai < 2; ++ai)
#pragma unroll
            for (int m = 0; m < 4; ++m) {
                float s = ss[ai][m];
                s += __shfl_xor(s, 16); s += __shfl_xor(s, 32);
                if (fq == 0) st2p[(size_t)(row0 + ai * 128 + m * 16) * 32 + u.pn * 4 + wc] = s;
            }
    }
};
struct EpiQ {
    static constexpr bool PERM = true; static constexpr bool MIDK = false;
    bf16_t* O; const float* rstd2; const float* cq;
    __device__ __forceinline__ void operator()(const f32x4 (&acc)[2][2][4][2], const Unit& u, int wr, int wc, int fr, int fq) const {
        const int row0 = u.pm * 256 + wr * 64 + fr, col0 = u.pn * 256 + wc * 32 + 8 * fq;
        float rs[2][4];
#pragma unroll
        for (int ai = 0; ai < 2; ++ai)
#pragma unroll
            for (int m = 0; m < 4; ++m) rs[ai][m] = rstd2[row0 + ai * 128 + m * 16];
#pragma unroll
        for (int bj = 0; bj < 2; ++bj) {
            const int col = col0 + bj * 128;
            const f32x4 c0 = *(const f32x4*)(cq + col), c4 = *(const f32x4*)(cq + col + 4);
#pragma unroll
            for (int ai = 0; ai < 2; ++ai)
#pragma unroll
                for (int m = 0; m < 4; ++m)
                    *(u32x4*)(O + (size_t)(row0 + ai * 128 + m * 16) * 2048 + col) = pack8(acc[ai][bj][m][0] * rs[ai][m] + c0, acc[ai][bj][m][1] * rs[ai][m] + c4);
        }
    }
};
template <class Sched>
__device__ __forceinline__ void rstd2_prepass(const Sched& S, const float* st2p, float* rstd2, int tid) {
    Unit u;
    for (int i = 0; S.next(i, u); ++i)
        if (tid < 256) {
            const int row = u.pm * 256 + tid; const f32x4* p = (const f32x4*)(st2p + (size_t)row * 32);
            float s = 0.f;
#pragma unroll
            for (int k = 0; k < 8; ++k) { const f32x4 v = p[k]; s += (v[0] + v[1]) + (v[2] + v[3]); }
            rstd2[row] = rsqrtf(s * (1.f / 2048.f) + 1e-6f);
        }
    __syncthreads();
}
struct EpiSlab {
    static constexpr bool PERM = false; static constexpr bool MIDK = false;
    float* SL;
    __device__ __forceinline__ void operator()(const f32x4 (&acc)[2][2][4][2], const Unit& u, int wr, int wc, int fr, int fq) const {
        float* base = SL + (size_t)u.z * 2048 * 256;
        const int row0 = u.pm * 256 + wr * 64 + fr, col0 = wc * 32 + 4 * fq;
#pragma unroll
        for (int ai = 0; ai < 2; ++ai)
#pragma unroll
            for (int m = 0; m < 4; ++m)
#pragma unroll
                for (int bj = 0; bj < 2; ++bj)
#pragma unroll
                    for (int n = 0; n < 2; ++n)
                        *(f32x4*)(base + (size_t)(row0 + ai * 128 + m * 16) * 256 + col0 + bj * 128 + n * 16) = acc[ai][bj][m][n];
    }
};
struct CmpOrder {
    const bf16_t* KROW; const bf16_t* VROW; const bf16_t* W1; int lda, ldb, K; int G, c;
    __device__ bool next(int i, Unit& u) const {
        const int x = i * G + c; if (x >= 256) return false;
        const int kvsel = x >> 7, pm = (x & 127) >> 4, ks = x & 15; u.pm = pm; u.pn = 0; u.z = kvsel * 16 + ks; return true;
    }
    __device__ __forceinline__ const char* a_base(const Unit& u) const { return (const char*)(((u.z >> 4) ? VROW : KROW) + (size_t)u.pm * 256 * 2048 + (u.z & 15) * 256); }
    __device__ __forceinline__ const char* b_base(const Unit& u) const { return (const char*)(W1 + (size_t)(u.z >> 4) * 256 * 4096 + (u.z & 15) * 256); }
};
template <class Sched>
__device__ __forceinline__ void rsa_prepass(const Sched& S, const float* stsp, const float* stap, float* rsa, int tid) {
    Unit u;
    for (int i = 0; S.next(i, u); ++i)
        if (tid < 256) {
            const int row = u.pm * 256 + tid; const f32x4* p = (const f32x4*)(stsp + (size_t)row * 16);
            float s = 0.f;
#pragma unroll
            for (int k = 0; k < 4; ++k) { const f32x4 v = p[k]; s += (v[0] + v[1]) + (v[2] + v[3]); }
            const f32x2 q = *(const f32x2*)(stap + (size_t)row * 2);
            const float rs = rsqrtf(s * (1.f / 1024.f) + 1e-6f), ra = rsqrtf((q[0] + q[1]) * (1.f / 1024.f) + 1e-6f);
            f32x2 o; o[0] = rs / ra; o[1] = ra;
            *(f32x2*)(rsa + (size_t)row * 2) = o;
        }
    __syncthreads();
}
struct Ctx { int bid, nb, tid, wave, lane; LAS unsigned char* lds; };

__device__ __forceinline__ void p0_cond(const Args& a, const Ctx& c) {
    const float* cv = a.in[1]; const float* w = a.in[2]; float* condp = (float*)(a.ws + WS_CONDP);
    for (int u = c.bid * 8 + c.wave; u < 1536; u += c.nb * 8) {
        const int cc = u % 48, kc = u / 48;
        const float* wp = w + (size_t)(kc * 64) * NADA + cc * 256 + c.lane * 4;
        f32x4 acc = {0.f, 0.f, 0.f, 0.f};
#pragma unroll 16
        for (int k = 0; k < 64; ++k) { const float x = cv[kc * 64 + k]; const float s = x / (1.f + __expf(-x)); acc += s * *(const f32x4*)(wp + (size_t)k * NADA); }
        *(f32x4*)(condp + (size_t)kc * NADA + cc * 256 + c.lane * 4) = acc;
    }
}
__device__ __forceinline__ void conv_T(const float* src, int K, int N, bf16_t* dst, int Npad, const Ctx& c, const float* ks0 = nullptr, const float* ks1 = nullptr) {
    LAS float* tile = (LAS float*)c.lds;
    const int nkt = K / 64, ntiles = nkt * (Npad / 64);
    const int r = c.tid >> 4, c4 = c.tid & 15;
    f32x4 v[2]; float sc[2] = {1.f, 1.f};
#define CONVT_LD(tix_) do { const int nt_ = (tix_) / nkt, kt_ = (tix_) % nkt, n_ = nt_ * 64 + 4 * c4; _Pragma("unroll") for (int i = 0; i < 2; ++i) { const int k_ = kt_ * 64 + r + 32 * i; v[i] = (f32x4){0.f, 0.f, 0.f, 0.f}; if (n_ < N) v[i] = *(const f32x4*)(src + (size_t)k_ * N + n_); if (ks0) sc[i] = k_ < 1024 ? ks0[k_] : ks1[k_ - 1024]; } } while (0)
    if (c.bid < ntiles) CONVT_LD(c.bid);
    for (int tix = c.bid; tix < ntiles; tix += c.nb) {
        const int nt = tix / nkt, kt = tix % nkt;
#pragma unroll
        for (int i = 0; i < 2; ++i) { LAS float* tp = tile + (r + 32 * i) * 65 + 4 * c4; tp[0] = v[i][0] * sc[i]; tp[1] = v[i][1] * sc[i]; tp[2] = v[i][2] * sc[i]; tp[3] = v[i][3] * sc[i]; }
        __syncthreads();
        if (tix + c.nb < ntiles) CONVT_LD(tix + c.nb);
        { const int n = c.tid >> 3, kq = c.tid & 7; float w[8];
#pragma unroll
          for (int j = 0; j < 8; ++j) w[j] = tile[(kq * 8 + j) * 65 + n];
          u32x4 o; o[0] = cvt_pk_bf16(w[0], w[1]); o[1] = cvt_pk_bf16(w[2], w[3]); o[2] = cvt_pk_bf16(w[4], w[5]); o[3] = cvt_pk_bf16(w[6], w[7]);
          *(u32x4*)(dst + (size_t)(nt * 64 + n) * K + kt * 64 + kq * 8) = o; }
        __syncthreads();
    }
#undef CONVT_LD
}
__device__ __forceinline__ void conv_fp4rows(const float* src, unsigned char* dst4, float* scl, int rows, const Ctx& c) {
    const int stride = c.nb * 8;
    f32x4 b0[8], b1[8], b2[8];
#define FP4R_LD(buf, r_) do { if ((r_) < rows) { _Pragma("unroll") for (int j = 0; j < 8; ++j) buf[j] = *(const f32x4*)(src + (size_t)(r_) * 2048 + c.lane * 32 + j * 4); } } while (0)
#define FP4R_DO(buf, r_) do { if ((r_) < rows) { \
        float mx = 0.f; \
        _Pragma("unroll") for (int j = 0; j < 8; ++j) mx = fmaxf(mx, fmaxf(fmaxf(fabsf(buf[j][0]), fabsf(buf[j][1])), fmaxf(fabsf(buf[j][2]), fabsf(buf[j][3])))); \
        mx = wave_max(mx); \
        const float s = mx > 0.f ? 6.f / mx : 1.f; \
        if (c.lane == 0) scl[(size_t)(r_) * 4] = mx > 0.f ? mx * (1.f / 6.f) : 1.f; \
        u32x4 pk = {0u, 0u, 0u, 0u}; \
        _Pragma("unroll") for (int d = 0; d < 4; ++d) {              \
            unsigned wq = 0u; \
            wq = fp4_pk<0>(wq, buf[2 * d][0] * s, buf[2 * d][1] * s); wq = fp4_pk<1>(wq, buf[2 * d][2] * s, buf[2 * d][3] * s); \
            wq = fp4_pk<2>(wq, buf[2 * d + 1][0] * s, buf[2 * d + 1][1] * s); wq = fp4_pk<3>(wq, buf[2 * d + 1][2] * s, buf[2 * d + 1][3] * s); \
            pk[d] = wq; } \
        *(u32x4*)(dst4 + (size_t)(r_) * 1024 + c.lane * 16) = pk; } } while (0)
    int row = c.bid * 8 + c.wave;
    FP4R_LD(b0, row); FP4R_LD(b1, row + stride);
    for (; row < rows; row += 3 * stride) {
        FP4R_LD(b2, row + 2 * stride); FP4R_DO(b0, row);
        FP4R_LD(b0, row + 3 * stride); FP4R_DO(b1, row + stride);
        FP4R_LD(b1, row + 4 * stride); FP4R_DO(b2, row + 2 * stride);
    }
#undef FP4R_LD
#undef FP4R_DO
}
__device__ __forceinline__ void conv_E(const float* src, bf16_t* dst, size_t n8, const Ctx& c) {
    const size_t stride = (size_t)c.nb * NTHREADS;
    for (size_t i = (size_t)c.bid * NTHREADS + c.tid; i < n8; i += stride) {
        const f32x4 x = *(const f32x4*)(src + i * 8), y = *(const f32x4*)(src + i * 8 + 4);
        *(u32x4*)(dst + i * 8) = pack8(x, y);
    }
}
__device__ __forceinline__ int t5_bucket(int n) {
    if (n < 16) return n;
    const float scaled = logf((float)n / 16.f) / logf(64.f);
    const int large = 16 + (int)(scaled * 16.f);
    return large < 31 ? large : 31;
}
__device__ __forceinline__ void p0_tb(const Args& a, const Ctx& c) {
    float* tb = (float*)(a.ws + WS_TB); const float* rb = a.in[26];
    for (int i = c.bid * NTHREADS + c.tid; i < 8 * TBN; i += c.nb * NTHREADS) { const int head = i / TBN, dist = i % TBN; tb[i] = rb[t5_bucket(dist) * 8 + head] * LOG2E; }
}
__device__ __forceinline__ void p0_bpe(const Args& a, const Ctx& c, int part) {
    const int n = c.tid & 255, kv = c.tid >> 8;
    const float* pe = a.in[kv ? 23 : 20]; const float* w1 = a.in[kv ? 24 : 21]; float* bpep = (float*)(a.ws + WS_BPEP);
    float s = 0.f;
#pragma unroll 16
    for (int k = part * 128; k < part * 128 + 128; ++k) s += pe[k] * w1[(size_t)k * 256 + n];
    bpep[(part * 2 + kv) * 256 + n] = s;
}
__device__ __forceinline__ void p0_s5(const Args& a, const Ctx& c, int g, int part) {
    LAS float* ar = (LAS float*)c.lds;
    LAS float* ai = ar + 17 * 64;
    LAS float* bbr = ai + 17 * 64;
    LAS float* bbi = bbr + 1024;
    LAS float* cr = bbi + 1024;
    LAS float* ci = cr + 1024;
    LAS float* kd = ci + 1024;
    const int tid = c.tid;
    if (tid < 64) {
        const int p = tid; const float dt = expf(a.in[12][g]); const float lr = a.in[10][g * 64 + p], li = a.in[11][g * 64 + p];
        for (int d = 0; d <= 16; ++d) { const float mag = expf(lr * dt * (float)d), ang = li * dt * (float)d; ar[d * 64 + p] = mag * cosf(ang); ai[d * 64 + p] = mag * sinf(ang); }
        const float nr = ar[64 + p] - 1.f, ni = ai[64 + p], den = lr * lr + li * li;
        const float wre = (nr * lr + ni * li) / den, wim = (ni * lr - nr * li) / den;
        for (int h = 0; h < 16; ++h) { const float br = a.in[13][(g * 64 + p) * 16 + h], bi = a.in[14][(g * 64 + p) * 16 + h]; bbr[p * 16 + h] = wre * br - wim * bi; bbi[p * 16 + h] = wre * bi + wim * br; }
        if (part == 0) {
        float* s5p = (float*)(a.ws + WS_S5P);
        float xr = ar[16 * 64 + p], xi = ai[16 * 64 + p];
        s5p[(g * 64 + p) * 2] = xr; s5p[(g * 64 + p) * 2 + 1] = xi;
        for (int s = 0; s < 8; ++s) { const float tr = xr * xr - xi * xi, ti = 2.f * xr * xi; xr = tr; xi = ti; }
        s5p[64 * 64 * 2 + (g * 64 + p) * 2] = xr; s5p[64 * 64 * 2 + (g * 64 + p) * 2 + 1] = xi;
        }
    }
    for (int e = tid; e < 1024; e += NTHREADS) { cr[e] = a.in[15][g * 1024 + e]; ci[e] = a.in[16][g * 1024 + e]; }
    __syncthreads();
    for (int e = tid; e < 1024 * (part + 1); e += NTHREADS) {
        const int d = e >> 8, h1 = (e >> 4) & 15, h = e & 15; float s = 0.f;
        for (int p = 0; p < 64; ++p) { const float Cr = cr[h1 * 64 + p], Ci = ci[h1 * 64 + p], Ar = ar[d * 64 + p], Ai = ai[d * 64 + p];
            const float Gr = Cr * Ar - Ci * Ai, Gi = Cr * Ai + Ci * Ar; s += Gr * bbr[p * 16 + h] - Gi * bbi[p * 16 + h]; }
        if (d == 0 && h1 == h) s += a.in[17][g * 16 + h];
        kd[e] = s;
    }
    __syncthreads();
    bf16_t* MT = (bf16_t*)(a.ws + WS_S5MT) + (size_t)g * 65536;
    bf16_t* WE = (bf16_t*)(a.ws + WS_S5WE) + (size_t)g * 32768;
    bf16_t* WC = (bf16_t*)(a.ws + WS_S5WC) + (size_t)g * 32768;
    for (int e = 16384 * part + tid; e < 16384 * (part + 1); e += NTHREADS) { const int n = e >> 8, k = e & 255, j = n >> 4, h1 = n & 15, i = k >> 4, h = k & 15;
        MT[e] = f2bf(i <= j ? kd[(j - i) * 256 + h1 * 16 + h] : 0.f); }
    for (int e = 8192 * part + tid; e < 8192 * (part + 1); e += NTHREADS) { const int n = e >> 8, k = e & 255, cc = n >> 6, p = n & 63, i = k >> 4, h = k & 15;
        const float Ar = ar[(15 - i) * 64 + p], Ai = ai[(15 - i) * 64 + p], Br = bbr[p * 16 + h], Bi = bbi[p * 16 + h];
        WE[e] = f2bf(cc ? (Ar * Bi + Ai * Br) : (Ar * Br - Ai * Bi)); }
    for (int e = 8192 * part + tid; e < 8192 * (part + 1); e += NTHREADS) { const int n = e >> 7, k = e & 127, j = n >> 4, h1 = n & 15, cc = k >> 6, p = k & 63;
        const float Cr = cr[h1 * 64 + p], Ci = ci[h1 * 64 + p], Ar = ar[(j + 1) * 64 + p], Ai = ai[(j + 1) * 64 + p];
        WC[e] = f2bf(cc ? -(Cr * Ai + Ci * Ar) : (Cr * Ar - Ci * Ai)); }
    __syncthreads();
}
__device__ __forceinline__ void p0_prologue(const Args& a, const Ctx& c) {
    for (int u = c.bid; u < 256; u += c.nb) p0_s5(a, c, u >> 2, u & 3);
    for (int u = 0; u < 32; ++u) if (c.bid == (8 * u + 7) % c.nb) p0_bpe(a, c, u);
    p0_tb(a, c);
    p0_cond(a, c);
    conv_T(a.in[6], 2048, DIN, (bf16_t*)(a.ws + WS_WIN), DIN_PAD, c);
    conv_T(a.in[18], 1024, 1024, (bf16_t*)(a.ws + WS_WGLU), 1024, c);
    conv_T(a.in[7], 2048, 2048, (bf16_t*)(a.ws + WS_WOUT), 2048, c, a.in[8], a.in[9]);
    conv_T(a.in[27], 2048, 2048, (bf16_t*)(a.ws + WS_WQ), 2048, c);
    conv_T(a.in[21], 4096, 256, (bf16_t*)(a.ws + WS_W1), 256, c);
    conv_T(a.in[24], 4096, 256, (bf16_t*)(a.ws + WS_W1) + 256 * 4096, 256, c);
    conv_T(a.in[22], 256, 128, (bf16_t*)(a.ws + WS_W2), 128, c);
    conv_T(a.in[25], 256, 128, (bf16_t*)(a.ws + WS_W2) + 128 * 256, 128, c);
    conv_E(a.in[28], (bf16_t*)(a.ws + WS_PK), 128 * 128 / 8, c);
    conv_E(a.in[29], (bf16_t*)(a.ws + WS_PK) + 128 * 128, 128 * 128 / 8, c);
    conv_fp4rows(a.in[30], a.ws + WS_PU, (float*)(a.ws + WS_PSC), 16384, c);
    conv_fp4rows(a.in[31], a.ws + WS_PV, (float*)(a.ws + WS_PSC) + 2, 16384, c);
}

__device__ __forceinline__ void norm_rows(const float* X, bf16_t* O, LAS const float* Ab, LAS const float* Bb, const Ctx& c, int row0 = 0, int nrows = L_) {
    for (int t = row0 + c.bid * 8 + c.wave; t < row0 + nrows; t += c.nb * 8) {
        const float* xr = X + (size_t)t * 2048 + c.lane * 4;
        f32x4 v[8]; float ss = 0.f;
#pragma unroll
        for (int j = 0; j < 8; ++j) { v[j] = *(const f32x4*)(xr + j * 256); ss += v[j][0] * v[j][0] + v[j][1] * v[j][1] + v[j][2] * v[j][2] + v[j][3] * v[j][3]; }
        ss = wave_sum(ss);
        const float rstd = rsqrtf(ss * (1.f / 2048.f) + 1e-6f);
#pragma unroll
        for (int j = 0; j < 8; ++j) {
            const int col = j * 256 + c.lane * 4;
            const f32x4 A = *(const LAS f32x4*)(Ab + col), B = *(const LAS f32x4*)(Bb + col);
            const f32x4 o = v[j] * rstd * A + B;
            u32x2 w; w[0] = cvt_pk_bf16(o[0], o[1]); w[1] = cvt_pk_bf16(o[2], o[3]);
            *(u32x2*)(O + (size_t)t * 2048 + col) = w;
        }
    }
}
__device__ __forceinline__ void norm_rows_bf16(const bf16_t* X, bf16_t* O, LAS const float* Ab, LAS const float* Bb, const Ctx& c, int row0, int nrows) {
    for (int t = row0 + c.bid * 8 + c.wave; t < row0 + nrows; t += c.nb * 8) {
        const bf16_t* xr = X + (size_t)t * 2048 + c.lane * 8;
        u32x4 w[4]; float ss = 0.f;
#pragma unroll
        for (int j = 0; j < 4; ++j) { w[j] = *(const u32x4*)(xr + j * 512);
#pragma unroll
            for (int e = 0; e < 4; ++e) { const float a0 = bflo(w[j][e]), a1 = bfhi(w[j][e]); ss += a0 * a0 + a1 * a1; } }
        ss = wave_sum(ss);
        const float rstd = rsqrtf(ss * (1.f / 2048.f) + 1e-6f);
#pragma unroll
        for (int j = 0; j < 4; ++j) {
            const int col = j * 512 + c.lane * 8;
            const f32x4 A0 = *(const LAS f32x4*)(Ab + col), A1 = *(const LAS f32x4*)(Ab + col + 4), B0 = *(const LAS f32x4*)(Bb + col), B1 = *(const LAS f32x4*)(Bb + col + 4);
            f32x4 o0, o1;
#pragma unroll
            for (int e = 0; e < 2; ++e) { o0[2 * e] = bflo(w[j][e]) * rstd * A0[2 * e] + B0[2 * e]; o0[2 * e + 1] = bfhi(w[j][e]) * rstd * A0[2 * e + 1] + B0[2 * e + 1];
                o1[2 * e] = bflo(w[j][2 + e]) * rstd * A1[2 * e] + B1[2 * e]; o1[2 * e + 1] = bfhi(w[j][2 + e]) * rstd * A1[2 * e + 1] + B1[2 * e + 1]; }
            *(u32x4*)(O + (size_t)t * 2048 + col) = pack8(o0, o1);
        }
    }
}
__device__ __forceinline__ float cond_from_partials(const float* condp, const float* b_ada, int j) {
    float s = b_ada[j];
#pragma unroll 8
    for (int k = 0; k < 32; ++k) s += condp[(size_t)k * NADA + j];
    return s;
}
__device__ __forceinline__ void p1_hnorm(const Args& a, const Ctx& c) {
    const float* condp = (const float*)(a.ws + WS_CONDP); float* cond = (float*)(a.ws + WS_COND);
    for (int j = c.bid * NTHREADS + c.tid; j < NADA; j += c.nb * NTHREADS) cond[j] = cond_from_partials(condp, a.in[3], j);
    { float* F2 = (float*)(a.ws + WS_F2);
      for (int j = c.bid * NTHREADS + c.tid; j < 2048; j += c.nb * NTHREADS) F2[j] = a.in[5][j] * (1.f + cond_from_partials(condp, a.in[3], 4 * 2048 + j)); }
    LAS float* Ab = (LAS float*)c.lds; LAS float* Bb = Ab + 2048;
    for (int col = c.tid; col < 2048; col += NTHREADS) {
        Ab[col] = a.in[4][col] * (1.f + cond_from_partials(condp, a.in[3], 2048 + col)); Bb[col] = cond_from_partials(condp, a.in[3], col); }
    __syncthreads();
    norm_rows(a.in[0], (bf16_t*)(a.ws + WS_H), Ab, Bb, c);
}
__device__ __forceinline__ void p_cqce(const Args& a, const Ctx& c) {
    const float* sh2 = (const float*)(a.ws + WS_COND) + 3 * 2048;
    float s[32];
#pragma unroll
    for (int k = 0; k < 8; ++k) { const f32x4 v = *(const f32x4*)(sh2 + c.lane * 32 + k * 4); s[4 * k] = v[0]; s[4 * k + 1] = v[1]; s[4 * k + 2] = v[2]; s[4 * k + 3] = v[3]; }
    const bf16_t* WQ = (const bf16_t*)(a.ws + WS_WQ); float* cq = (float*)(a.ws + WS_CQ);
    for (int n = c.bid * 8 + c.wave; n < 2048; n += c.nb * 8) {
        u32x4 w[4];
#pragma unroll
        for (int k = 0; k < 4; ++k) w[k] = *(const u32x4*)(WQ + (size_t)n * 2048 + c.lane * 32 + k * 8);
        float d = 0.f;
#pragma unroll
        for (int k = 0; k < 4; ++k)
#pragma unroll
            for (int e = 0; e < 4; ++e) d += bflo(w[k][e]) * s[k * 8 + 2 * e] + bfhi(w[k][e]) * s[k * 8 + 2 * e + 1];
        d = wave_sum(d);
        if (c.lane == 0) cq[n] = d;
    }
    const unsigned char* PU = a.ws + WS_PU; float* psc = (float*)(a.ws + WS_PSC);
    for (int e0 = (c.bid * 8 + c.wave) * 4; e0 < 16384; e0 += c.nb * 8 * 4) {
        u32x4 uw[4];
#pragma unroll
        for (int i = 0; i < 4; ++i) uw[i] = *(const u32x4*)(PU + (size_t)(e0 + i) * 1024 + c.lane * 16);
#pragma unroll
        for (int i = 0; i < 4; ++i) {
            float d0 = 0.f, d1 = 0.f;
#pragma unroll
            for (int dw = 0; dw < 4; ++dw) { const f32x2 f0 = fp4_unpk<0>(uw[i][dw]), f1 = fp4_unpk<1>(uw[i][dw]), f2 = fp4_unpk<2>(uw[i][dw]), f3 = fp4_unpk<3>(uw[i][dw]);
                d0 += f0[0] * s[8 * dw] + f1[0] * s[8 * dw + 2] + f2[0] * s[8 * dw + 4] + f3[0] * s[8 * dw + 6];
                d1 += f0[1] * s[8 * dw + 1] + f1[1] * s[8 * dw + 3] + f2[1] * s[8 * dw + 5] + f3[1] * s[8 * dw + 7]; }
            const float d = wave_sum(d0 + d1);
            if (c.lane == 0) psc[(size_t)(e0 + i) * 4 + 1] = psc[(size_t)(e0 + i) * 4] * d;
        }
    }
}
constexpr int S5_US = 0, S5_ES = 33792, S5_SS = 67584, S5_TS = 84992;
template <int PASS>
__device__ __forceinline__ void s5_item(const Args& a, const Ctx& c, int g, int seg) {
    LAS unsigned char* lds = c.lds;
    int tid = c.tid; asm volatile("" : "+v"(tid));
    const int wave = c.wave, lane = tid & 63, r = lane & 15, q = lane >> 4;
    const bf16_t* U = (const bf16_t*)(a.ws + WS_US);
    const bf16_t* MT = (const bf16_t*)(a.ws + WS_S5MT) + (size_t)g * 65536;
    const bf16_t* WE = (const bf16_t*)(a.ws + WS_S5WE) + (size_t)g * 32768;
    const bf16_t* WC = (const bf16_t*)(a.ws + WS_S5WC) + (size_t)g * 32768;
    const float* s5p = (const float*)(a.ws + WS_S5P);
    float* F = (float*)(a.ws + WS_S5F) + (size_t)g * 4 * 128;
    bf16_t* Z = (bf16_t*)(a.ws + WS_Z);
    bf16x8 bE[8];
#pragma unroll
    for (int ks = 0; ks < 8; ++ks) bE[ks] = *(const bf16x8*)(WE + (size_t)(16 * wave + r) * 256 + 32 * ks + 8 * q);
    bf16x8 bM[2][8], bC[2][4];
    if (PASS == 1) {
#pragma unroll
        for (int nt = 0; nt < 2; ++nt)
#pragma unroll
            for (int ks = 0; ks < 4; ++ks) bC[nt][ks] = *(const bf16x8*)(WC + (size_t)(16 * (2 * wave + nt) + r) * 128 + 32 * ks + 8 * q);
#pragma unroll
        for (int nt = 0; nt < 2; ++nt)
#pragma unroll
            for (int ks = 0; ks < 8; ++ks) bM[nt][ks] = *(const bf16x8*)(MT + (size_t)(16 * (2 * wave + nt) + r) * 256 + 32 * ks + 8 * q);
    }
    float sr = 0.f, si = 0.f;
    const float a16r = s5p[(g * 64 + lane) * 2], a16i = s5p[(g * 64 + lane) * 2 + 1];
    float a128r = a16r, a128i = a16i;
#pragma unroll
    for (int s = 0; s < 3; ++s) { const float tr = a128r * a128r - a128i * a128i, ti = 2.f * a128r * a128i; a128r = tr; a128i = ti; }
    if (PASS == 1) { const float br = s5p[8192 + (g * 64 + lane) * 2], bi = s5p[8192 + (g * 64 + lane) * 2 + 1];
        for (int s = 0; s < seg; ++s) { const float fr_ = F[s * 128 + lane], fi_ = F[s * 128 + 64 + lane]; const float nr = br * sr - bi * si + fr_, ni = br * si + bi * sr + fi_; sr = nr; si = ni; } }
    for (int sb = 0; sb < 4; ++sb) {
        const int tok0 = seg * 4096 + sb * 1024;
#pragma unroll
        for (int i = 0; i < 4; ++i) { const int ch = tid + NTHREADS * i, token = ch >> 1, half = ch & 1;
            const u32x4 v = *(const u32x4*)(U + (size_t)(tok0 + token) * 1024 + g * 16 + half * 8);
            *(LAS u32x4*)(lds + S5_US + (token >> 4) * 528 + ((token & 15) * 16 + half * 8) * 2) = v; }
        __syncthreads();
#pragma unroll
        for (int m = 0; m < 4; ++m) {
            f32x4 acc = {0.f, 0.f, 0.f, 0.f};
#pragma unroll
            for (int ks = 0; ks < 8; ++ks) { const bf16x8 A = *(const LAS bf16x8*)(lds + S5_US + (16 * m + r) * 528 + (32 * ks + 8 * q) * 2); acc = mfma16(A, bE[ks], acc); }
#pragma unroll
            for (int i = 0; i < 4; ++i) *(LAS float*)(lds + S5_ES + ((16 * m + 4 * q + i) * 132 + 16 * wave + r) * 4) = acc[i];
        }
        __syncthreads();
        {
            float lr[8], li[8];
            float xr = 0.f, xi = 0.f;
#pragma unroll
            for (int k = 0; k < 8; ++k) {
                lr[k] = xr; li[k] = xi;
                const float er = *(const LAS float*)(lds + S5_ES + ((8 * wave + k) * 132 + lane) * 4), ei = *(const LAS float*)(lds + S5_ES + ((8 * wave + k) * 132 + 64 + lane) * 4);
                const float nr = a16r * xr - a16i * xi + er, ni = a16r * xi + a16i * xr + ei; xr = nr; xi = ni;
            }
            __builtin_amdgcn_sched_barrier(0);
            *(LAS float*)(lds + S5_TS + (wave * 128 + lane) * 4) = xr; *(LAS float*)(lds + S5_TS + (wave * 128 + 64 + lane) * 4) = xi;
            __syncthreads();
            __builtin_amdgcn_sched_barrier(0);
            float cr = sr, ci = si, mr = sr, mi = si;
#pragma unroll
            for (int w2 = 0; w2 < 8; ++w2) {
                if (w2 == wave) { mr = cr; mi = ci; }
                const float tr = *(const LAS float*)(lds + S5_TS + (w2 * 128 + lane) * 4), ti = *(const LAS float*)(lds + S5_TS + (w2 * 128 + 64 + lane) * 4);
                const float nr = a128r * cr - a128i * ci + tr, ni = a128r * ci + a128i * cr + ti; cr = nr; ci = ni;
            }
            sr = cr; si = ci;
            __builtin_amdgcn_sched_barrier(0);
            if (PASS == 1) {
                float pr = mr, pi = mi;
#pragma unroll
                for (int k = 0; k < 8; ++k) {
                    *(LAS bf16_t*)(lds + S5_SS + ((8 * wave + k) * 136 + lane) * 2) = f2bf(lr[k] + pr); *(LAS bf16_t*)(lds + S5_SS + ((8 * wave + k) * 136 + 64 + lane) * 2) = f2bf(li[k] + pi);
                    const float nr = a16r * pr - a16i * pi, ni = a16r * pi + a16i * pr; pr = nr; pi = ni;
                }
            }
        }
        __syncthreads();
        if (PASS == 1) {
#pragma unroll
            for (int nt = 0; nt < 2; ++nt) {
                const int j = 2 * wave + nt;
                f32x4 acc[4];
#pragma unroll
                for (int m = 0; m < 4; ++m) acc[m] = (f32x4){0.f, 0.f, 0.f, 0.f};
#pragma unroll
                for (int ks = 0; ks < 8; ++ks) {
                    __builtin_amdgcn_sched_barrier(0);
#pragma unroll
                    for (int m = 0; m < 4; ++m) { const bf16x8 A = *(const LAS bf16x8*)(lds + S5_US + (16 * m + r) * 528 + (32 * ks + 8 * q) * 2); acc[m] = mfma16(A, bM[nt][ks], acc[m]); }
                }
#pragma unroll
                for (int ks = 0; ks < 4; ++ks) {
                    __builtin_amdgcn_sched_barrier(0);
#pragma unroll
                    for (int m = 0; m < 4; ++m) { const bf16x8 A = *(const LAS bf16x8*)(lds + S5_SS + (16 * m + r) * 272 + (32 * ks + 8 * q) * 2); acc[m] = mfma16(A, bC[nt][ks], acc[m]); }
                }
                int lz = lane; asm volatile("" : "+v"(lz));
                const int rz = lz & 15, qz = lz >> 4;
#pragma unroll
                for (int m = 0; m < 4; ++m)
#pragma unroll
                    for (int i = 0; i < 4; ++i) { const int ch = 16 * m + 4 * qz + i; Z[(size_t)(tok0 + 16 * ch + j) * 1024 + g * 16 + rz] = f2bf(gelu_tanh(acc[m][i])); }
            }
            __syncthreads();
        }
    }
    if (PASS == 0 && wave == 0) { F[seg * 128 + lane] = sr; F[seg * 128 + 64 + lane] = si; }
}

__device__ __forceinline__ void cmp_finish_item(const Args& a, const Ctx& c, int kvsel, int rt) {
    LAS unsigned char* lds = c.lds;
    const int tid = c.tid, wave = c.wave, lane = c.lane, r = lane & 15, q = lane >> 4;
    const float* SL = (const float*)(a.ws + WS_SLAB) + (size_t)kvsel * 16 * 2048 * 256;
    const float* bpep = (const float*)(a.ws + WS_BPEP) + kvsel * 256;
    const bf16_t* W2 = (const bf16_t*)(a.ws + WS_W2) + kvsel * 128 * 256;
    bf16x8 B[8];
#pragma unroll
    for (int ks = 0; ks < 8; ++ks) B[ks] = *(const bf16x8*)(W2 + (size_t)(16 * wave + r) * 256 + 32 * ks + 8 * q);
    for (int e = tid; e < 16 * 64; e += NTHREADS) {
        const int row = e >> 6, c4 = (e & 63) * 4;
        f32x4 s = {0.f, 0.f, 0.f, 0.f};
#pragma unroll 8
        for (int pt = 0; pt < 32; ++pt) s += *(const f32x4*)(bpep + pt * 512 + c4);
#pragma unroll
        for (int ks = 0; ks < 16; ++ks) s += *(const f32x4*)(SL + ((size_t)ks * 2048 + rt * 16 + row) * 256 + c4);
        u32x2 w; w[0] = cvt_pk_bf16(gelu_tanh(s[0]), gelu_tanh(s[1])); w[1] = cvt_pk_bf16(gelu_tanh(s[2]), gelu_tanh(s[3]));
        *(LAS u32x2*)(lds + row * 528 + c4 * 2) = w;
    }
    __syncthreads();
    f32x4 acc = {0.f, 0.f, 0.f, 0.f};
#pragma unroll
    for (int ks = 0; ks < 8; ++ks) { const bf16x8 A = *(const LAS bf16x8*)(lds + r * 528 + (32 * ks + 8 * q) * 2); acc = mfma16(A, B[ks], acc); }
#pragma unroll
    for (int i = 0; i < 4; ++i) {
        const int row = rt * 16 + 4 * q + i, gi = row >> 10, ci = row & 1023, n = 16 * wave + r;
        const bf16_t v = (ci == 1023) ? (bf16_t)0 : f2bf(acc[i]);
        if (kvsel == 0) ((bf16_t*)(a.ws + WS_KC))[((size_t)gi * 1024 + ci) * 128 + n] = v;
        else ((bf16_t*)(a.ws + WS_VCT))[((size_t)gi * 128 + n) * 1024 + ((ci & ~12) | ((ci & 4) << 1) | ((ci & 8) >> 1))] = v;
    }
    __syncthreads();
}
constexpr int AT_IMP = 65536, AT_TB = 131072, AT_BM = 143872, AT_WU = 145920, AT_END = 146176;
__device__ __forceinline__ int kswz(int r) { return ((r & 3) << 2) | ((r >> 2) & 3); }
__host__ __device__ __forceinline__ int vperm(int t) { return (t & ~12) | ((t & 4) << 1) | ((t & 8) >> 1); }
template <int KEYS> __device__ __forceinline__ int vsw(int d) { return KEYS == 128 ? kswz(d) : ((d >> 1) & 7); }
template <int KEYS, bool NEEDV>
__device__ __forceinline__ void stage_dma(const bf16_t* Kt, const bf16_t* Vt, int ldv, LAS unsigned char* kb, LAS unsigned char* vb, int wave, int lane) {
    constexpr int NP = KEYS / 32;
#pragma unroll
    for (int i = 0; i < NP; ++i) { const int pc = NP * wave + i, row = 4 * pc + (lane >> 4), ch = (lane & 15) ^ kswz(row);
        __builtin_amdgcn_global_load_lds((const unsigned*)(Kt + row * 128 + ch * 8), (LAS unsigned*)(kb + pc * 1024), 16, 0, 0); }
    if (NEEDV) {
#pragma unroll
        for (int i = 0; i < NP; ++i) {
            const int pc = NP * wave + i;
            if (KEYS == 128) { const int d = 4 * pc + (lane >> 4), ch = (lane & 15) ^ kswz(d);
                __builtin_amdgcn_global_load_lds((const unsigned*)(Vt + (size_t)d * ldv + 8 * ch), (LAS unsigned*)(vb + pc * 1024), 16, 0, 0); }
            else { const int d = 8 * pc + (lane >> 3), ch = (lane & 7) ^ ((d >> 1) & 7);
                __builtin_amdgcn_global_load_lds((const unsigned*)(Vt + (size_t)d * ldv + 8 * ch), (LAS unsigned*)(vb + pc * 1024), 16, 0, 0); }
        }
    }
}
__device__ __forceinline__ float xhalf_max(float x) { auto rr = __builtin_amdgcn_permlane32_swap(__float_as_uint(x), __float_as_uint(x), false, false); return fmaxf(__uint_as_float(rr[0]), __uint_as_float(rr[1])); }
__device__ __forceinline__ float xhalf_sum(float x) { auto rr = __builtin_amdgcn_permlane32_swap(__float_as_uint(x), __float_as_uint(x), false, false); return __uint_as_float(rr[0]) + __uint_as_float(rr[1]); }
template <int BR>
__device__ __forceinline__ float tile_prep(int MODE, f32x16& S, LAS const float* tb, float cb, int base, bool selbit) {
    float mx = -INFINITY;
    if (MODE == 1) {
#pragma unroll
        for (int r = 0; r < 16; ++r) mx = fmaxf(mx, S[r]);
        mx = (BR == 2 && !selbit) ? -INFINITY : mx + cb;
    } else {
        const bool nomask = (MODE == 2);
        float bv[16];
#pragma unroll
        for (int r = 0; r < 16; ++r) { const int cr = (r & 3) + 8 * (r >> 2); const int dist = (BR <= 1) ? base - 16 * cr : base - cr; bv[r] = tb[min(max(dist, 0), TBN - 1)]; }
        __builtin_amdgcn_sched_barrier(0);
#pragma unroll
        for (int r = 0; r < 16; ++r) {
            const int cr = (r & 3) + 8 * (r >> 2);
            const int dist = (BR <= 1) ? base - 16 * cr : base - cr;
            float v = S[r] + bv[r];
            bool valid;
            if (BR <= 1) valid = dist >= 0; else if (BR == 2) valid = selbit && dist >= 0; else valid = nomask || (unsigned)dist < 512u;
            v = valid ? v : -INFINITY;
            S[r] = v; mx = fmaxf(mx, v);
        }
    }
    return mx;
}
template <int BR, bool PEND>
__device__ __forceinline__ float tile_decide(int MODE, float mx, float cb, bool selbit, f32x16 (&O)[4], float& m, float& l, u32x4& pa, u32x4& pb) {
    if (BR == 1) { const float mu = (m == -INFINITY) ? 0.f : m; return (MODE == 1) ? mu - cb : mu; }
    mx = xhalf_max(mx);
    const float mn = fmaxf(m, mx), mu = (mn == -INFINITY) ? 0.f : mn;
    if (__any(mn > m)) {
        const float alpha = fexp2(m - mu);
        l *= alpha;
        if (BR >= 2) {
#pragma unroll
            for (int dt = 0; dt < 4; ++dt)
#pragma unroll
                for (int r = 0; r < 16; ++r) O[dt][r] *= alpha;
            if (PEND) {
#pragma unroll
                for (int e = 0; e < 4; ++e) { pa[e] = cvt_pk_bf16(bflo(pa[e]) * alpha, bfhi(pa[e]) * alpha); pb[e] = cvt_pk_bf16(bflo(pb[e]) * alpha, bfhi(pb[e]) * alpha); }
            }
        }
    }
    m = mn;
    if (MODE == 1) return (BR == 2 && !selbit) ? INFINITY : mu - cb;
    return mu;
}
template <int BR, int KEYS>
__device__ __forceinline__ void attn_tile(int MODE, LAS const unsigned char* kb, LAS const unsigned char* vb, int cb0, LAS const float* tb, int key0, int t, int lane,
                                          const bf16x8 (&qf)[8], f32x16 (&O)[4], float& m, float& l, float inv_l, bool selbit, LAS float* imp_row) {
    asm volatile("" : "+v"(lane));
    constexpr int ROWB = 2 * KEYS;
    const int r31 = lane & 31, h = lane >> 5;
    const int gh = kswz(r31) ^ h, vh = vsw<KEYS>(r31) ^ h;
    float cb = 0.f;
    if (MODE == 1) cb = tb[TBN - 1];
    const int base0 = (BR <= 1) ? t - 31 - 16 * (key0 + 4 * h) : t - (key0 + 4 * h);
    const int base1 = (BR <= 1) ? base0 - 16 * 32 : base0 - 32;
    LAS const unsigned char* k0 = kb + r31 * 256;
    f32x16 S0, S1;
    bf16x8 kf[8];
#pragma unroll
    for (int ks = 0; ks < 8; ++ks) kf[ks] = *(const LAS bf16x8*)(k0 + 16 * ((2 * ks) ^ gh));
#pragma unroll
    for (int r = 0; r < 16; ++r) { S0[r] = 0.f; S1[r] = 0.f; }
    __builtin_amdgcn_sched_barrier(0);
#pragma unroll
    for (int ks = 0; ks < 8; ++ks) S0 = mfma32(kf[ks], qf[ks], S0);
    __builtin_amdgcn_sched_barrier(0);
#pragma unroll
    for (int ks = 0; ks < 8; ++ks) kf[ks] = *(const LAS bf16x8*)(k0 + 8192 + 16 * ((2 * ks) ^ gh));
    const float mx0 = tile_prep<BR>(MODE, S0, tb, cb, base0, selbit);
    u32x4 pk0a = {0u, 0u, 0u, 0u}, pk0b = {0u, 0u, 0u, 0u}, pk1a, pk1b;
    const float me0 = tile_decide<BR, false>(MODE, mx0, cb, selbit, O, m, l, pk0a, pk0b);
    __builtin_amdgcn_sched_barrier(0);
    {
#pragma unroll
        for (int ks = 0; ks < 8; ++ks) S1 = mfma32(kf[ks], qf[ks], S1);
        float ps = 0.f;
#pragma unroll
        for (int r = 0; r < 16; ++r) { float p = fexp2(S0[r] - me0); if (BR == 1) p *= inv_l; S0[r] = p; ps += p; }
        if (BR != 1) l += ps;
        if (BR >= 1) {
#pragma unroll
            for (int e = 0; e < 4; ++e) { pk0a[e] = cvt_pk_bf16(S0[2 * e], S0[2 * e + 1]); pk0b[e] = cvt_pk_bf16(S0[8 + 2 * e], S0[8 + 2 * e + 1]); }
        }
#pragma unroll
        for (int i = 0; i < 8; ++i) { __builtin_amdgcn_sched_group_barrier(0x008, 1, 0); __builtin_amdgcn_sched_group_barrier(0x002, 8, 0); }
    }
    __builtin_amdgcn_sched_barrier(0);
    if (BR == 1) {
#pragma unroll
        for (int rg = 0; rg < 4; ++rg) {
            float A = 2.f * (S0[4 * rg] + S0[4 * rg + 1] + S0[4 * rg + 2]) + S0[4 * rg + 3], B = S0[4 * rg + 3];
            A = quad_sum(A); B = quad_sum(B);
            const int jj = (key0 >> 2) + 2 * rg + h;
            if ((lane & 3) == 0) { __hip_atomic_fetch_add(imp_row + jj, A, __ATOMIC_RELAXED, __HIP_MEMORY_SCOPE_WORKGROUP);
                if (jj + 1 < 256) __hip_atomic_fetch_add(imp_row + jj + 1, B, __ATOMIC_RELAXED, __HIP_MEMORY_SCOPE_WORKGROUP); }
        }
    }
    bf16x8 av[8];
    if (BR >= 1) {
#pragma unroll
        for (int s = 0; s < 2; ++s)
#pragma unroll
            for (int dt = 0; dt < 4; ++dt) av[s * 4 + dt] = *(const LAS bf16x8*)(vb + (32 * dt + r31) * ROWB + 16 * ((cb0 + 2 * s) ^ vh));
    }
    const float mx1 = tile_prep<BR>(MODE, S1, tb, cb, base1, selbit);
    const float me1 = tile_decide<BR, true>(MODE, mx1, cb, selbit, O, m, l, pk0a, pk0b);
    __builtin_amdgcn_sched_barrier(0);
    {
        if (BR >= 1) {
#pragma unroll
            for (int dt = 0; dt < 4; ++dt) O[dt] = mfma32(av[dt], __builtin_bit_cast(bf16x8, pk0a), O[dt]);
#pragma unroll
            for (int dt = 0; dt < 4; ++dt) O[dt] = mfma32(av[4 + dt], __builtin_bit_cast(bf16x8, pk0b), O[dt]);
        }
        float ps = 0.f;
#pragma unroll
        for (int r = 0; r < 16; ++r) { float p = fexp2(S1[r] - me1); if (BR == 1) p *= inv_l; S1[r] = p; ps += p; }
        if (BR != 1) l += ps;
        if (BR >= 1) {
#pragma unroll
            for (int e = 0; e < 4; ++e) { pk1a[e] = cvt_pk_bf16(S1[2 * e], S1[2 * e + 1]); pk1b[e] = cvt_pk_bf16(S1[8 + 2 * e], S1[8 + 2 * e + 1]); }
#pragma unroll
            for (int i = 0; i < 8; ++i) { __builtin_amdgcn_sched_group_barrier(0x008, 1, 0); __builtin_amdgcn_sched_group_barrier(0x002, 8, 0); }
        }
    }
    __builtin_amdgcn_sched_barrier(0);
    if (BR == 1) {
#pragma unroll
        for (int rg = 0; rg < 4; ++rg) {
            float A = 2.f * (S1[4 * rg] + S1[4 * rg + 1] + S1[4 * rg + 2]) + S1[4 * rg + 3], B = S1[4 * rg + 3];
            A = quad_sum(A); B = quad_sum(B);
            const int jj = ((key0 + 32) >> 2) + 2 * rg + h;
            if ((lane & 3) == 0) { __hip_atomic_fetch_add(imp_row + jj, A, __ATOMIC_RELAXED, __HIP_MEMORY_SCOPE_WORKGROUP);
                if (jj + 1 < 256) __hip_atomic_fetch_add(imp_row + jj + 1, B, __ATOMIC_RELAXED, __HIP_MEMORY_SCOPE_WORKGROUP); }
        }
    }
    if (BR >= 1) {
#pragma unroll
        for (int s = 0; s < 2; ++s)
#pragma unroll
            for (int dt = 0; dt < 4; ++dt) av[s * 4 + dt] = *(const LAS bf16x8*)(vb + (32 * dt + r31) * ROWB + 16 * ((cb0 + 4 + 2 * s) ^ vh));
        __builtin_amdgcn_sched_barrier(0);
#pragma unroll
        for (int dt = 0; dt < 4; ++dt) O[dt] = mfma32(av[dt], __builtin_bit_cast(bf16x8, pk1a), O[dt]);
#pragma unroll
        for (int dt = 0; dt < 4; ++dt) O[dt] = mfma32(av[4 + dt], __builtin_bit_cast(bf16x8, pk1b), O[dt]);
    }
}
template <int BR, int KEYS>
__device__ __forceinline__ void run_branch(const Ctx& c, const bf16_t* Kb, const bf16_t* Vtb, int ldv, int lo, int hi, LAS const float* tb, int t, int t0,
                                           const bf16x8 (&qf)[8], f32x16 (&O)[4], float& m, float& l, float inv_l, int tl, LAS float* imp_row) {
    constexpr bool NEEDV = (BR != 0);
    constexpr int BPS = KEYS / 64, KSTG = KEYS * 256, VSTG = 128 * 2 * KEYS, VB0 = 2 * KSTG;
    LAS unsigned char* lds = c.lds;
    int lz = c.lane; asm volatile("" : "+v"(lz));
    const int nst = (hi - lo + BPS - 1) / BPS;
#define STG_BLK(i) ((lo + BPS * (i) + BPS - 1 < hi) ? lo + BPS * (i) : hi - BPS)
    asm volatile("s_waitcnt vmcnt(0)" ::: "memory");
    { const int b0 = (BPS == 2 && hi - lo < 2) ? lo : STG_BLK(0);
      stage_dma<KEYS, NEEDV>(Kb + (size_t)b0 * 64 * 128, Vtb + (size_t)b0 * 64, ldv, lds, lds + VB0, c.wave, lz); }
    asm volatile("s_waitcnt vmcnt(0)" ::: "memory");
    __syncthreads();
    const int qt = t0 >> 6;
    for (int i = 0; i < nst; ++i) {
        const int buf = i & 1;
        if (i + 1 < nst) { int lz2 = lz; asm volatile("" : "+v"(lz2));
            const int b1 = STG_BLK(i + 1);
            stage_dma<KEYS, NEEDV>(Kb + (size_t)b1 * 64 * 128, Vtb + (size_t)b1 * 64, ldv, lds + (buf ^ 1) * KSTG, lds + VB0 + (buf ^ 1) * VSTG, c.wave, lz2); }
        const int sb = (BPS == 2 && hi - lo < 2) ? lo : STG_BLK(i);
#pragma unroll
        for (int q = 0; q < BPS; ++q) {
            const int j = lo + BPS * i + q;
            if (j < hi) {
                bool selbit = true, wave_on = true;
                if (BR == 2) {
                    const unsigned w = *(const LAS unsigned*)(lds + AT_BM + (tl * 8 + (j >> 5)) * 4);
                    selbit = (w >> (j & 31)) & 1u;
                    const unsigned wu = *(const LAS unsigned*)(lds + AT_WU + (c.wave * 8 + (j >> 5)) * 4);
                    wave_on = (wu >> (j & 31)) & 1u;
                }
                if (wave_on) {
                    int mode = 0;
                    if (BR <= 1) mode = (1024 * j + 1829 <= t0) ? 1 : 0;
                    else if (BR == 2) mode = (64 * j + 853 <= t0) ? 1 : 0;
                    else mode = (j >= qt - 7 && j <= qt - 1) ? 2 : 0;
                    const int slot = j - sb;
                    attn_tile<BR, KEYS>(mode, lds + buf * KSTG + slot * 16384, lds + VB0 + buf * VSTG, 8 * slot, tb, j * 64, t, c.lane, qf, O, m, l, inv_l, selbit, imp_row);
                }
            }
        }
        asm volatile("s_waitcnt vmcnt(0)" ::: "memory");
        __syncthreads();
    }
#undef STG_BLK
}
__device__ __forceinline__ void attn_item(const Args& a, const Ctx& c_, int qt, int g) {
    Ctx c = c_; { int tz = c_.tid; asm volatile("" : "+v"(tz)); c.tid = tz; c.lane = tz & 63; }
    LAS unsigned char* lds = c.lds;
    const int tid = c.tid, wave = c.wave, lane = c.lane, r31 = lane & 31, h = lane >> 5, hl = lane & 3;
    const int t0 = qt * 64, tl = 8 * wave + (r31 >> 2), t = t0 + tl, head = g * 4 + hl;
    const bf16_t* Qb = (const bf16_t*)(a.ws + WS_Q);
    const bf16_t* KROW = (const bf16_t*)(a.ws + WS_KROW);
    const bf16_t* VT = (const bf16_t*)(a.ws + WS_VT);
    const float* GATE = (const float*)(a.ws + WS_GATE);
    { const float* tbg = (const float*)(a.ws + WS_TB) + g * 4 * TBN;
      for (int i = tid; i < 4 * TBN; i += NTHREADS) *(LAS float*)(lds + AT_TB + i * 4) = tbg[i];
      for (int i = tid; i < 64 * 256; i += NTHREADS) *(LAS float*)(lds + AT_IMP + i * 4) = 0.f; }
    bf16x8 qf[8];
#pragma unroll
    for (int ks = 0; ks < 8; ++ks) qf[ks] = *(const bf16x8*)(Qb + (size_t)t * 1024 + head * 128 + 16 * ks + 8 * h);
    LAS const float* tb = (LAS const float*)(lds + AT_TB) + hl * TBN;
    LAS float* imp_row = (LAS float*)(lds + AT_IMP) + tl * 256;
    bf16_t* Y = (bf16_t*)(a.ws + WS_Y2) + (size_t)t * 2048 + 1024 + head * 128 + 4 * h;
    f32x16 O[4];
#pragma unroll
    for (int dt = 0; dt < 4; ++dt)
#pragma unroll
        for (int r = 0; r < 16; ++r) O[dt][r] = 0.f;
    __syncthreads();
    { const int ntile = (t0 / 16 + 3 + 63) / 64;
      const bf16_t* KC = (const bf16_t*)(a.ws + WS_KC) + (size_t)g * 1024 * 128; const bf16_t* VCT = (const bf16_t*)(a.ws + WS_VCT) + (size_t)g * 128 * 1024;
      float m = -INFINITY, l = 0.f;
#if defined(PROBE_CMP)
      run_branch<0, 64>(c, KC, VCT, 1024, 0, ntile, tb, t, t0, qf, O, m, l, 0.f, tl, imp_row);
      asm volatile("" :: "v"(m), "v"(l));
      m = -INFINITY; l = 0.f;
#endif
      run_branch<0, 64>(c, KC, VCT, 1024, 0, ntile, tb, t, t0, qf, O, m, l, 0.f, tl, imp_row);
      const float lt = xhalf_sum(l), inv = lt > 0.f ? 1.f / lt : 0.f;
      run_branch<1, 64>(c, KC, VCT, 1024, 0, ntile, tb, t, t0, qf, O, m, l, inv, tl, imp_row);
      const float gc = GATE[(size_t)t * 24 + head];
#pragma unroll
      for (int dt = 0; dt < 4; ++dt)
#pragma unroll
          for (int rg = 0; rg < 4; ++rg) {
              u32x2 w; w[0] = cvt_pk_bf16(gc * O[dt][4 * rg], gc * O[dt][4 * rg + 1]); w[1] = cvt_pk_bf16(gc * O[dt][4 * rg + 2], gc * O[dt][4 * rg + 3]);
              *(u32x2*)(Y + 32 * dt + 8 * rg) = w;
#pragma unroll
              for (int e = 0; e < 4; ++e) O[dt][4 * rg + e] = 0.f;
          }
    }
    {
        const int ncand = qt - 2 > 0 ? qt - 2 : 0;
        unsigned v[8][4], selm[8];
#pragma unroll
        for (int i = 0; i < 8; ++i) {
            LAS const float* row = (LAS const float*)(lds + AT_IMP) + (8 * wave + i) * 256;
            selm[i] = 0u;
#pragma unroll
            for (int k = 0; k < 4; ++k) { const int j = lane + 64 * k; const bool cand = (j >= 1 && j <= qt - 2);
                v[i][k] = cand ? ((__float_as_uint(row[j]) & ~0xFFu) | (unsigned)(255 - j)) : 0u; if (ncand <= 13 && cand) selm[i] |= 1u << k; }
        }
        if (ncand > 13) {
            for (int it = 0; it < 13; ++it) {
#pragma unroll
                for (int i = 0; i < 8; ++i) {
                    const unsigned mx = wave_umax_bcast(max(max(v[i][0], v[i][1]), max(v[i][2], v[i][3])));
#pragma unroll
                    for (int k = 0; k < 4; ++k) if (v[i][k] == mx) { v[i][k] = 0u; selm[i] |= 1u << k; }
                }
            }
        }
        unsigned wu[8];
#pragma unroll
        for (int k = 0; k < 8; ++k) wu[k] = 0u;
#pragma unroll
        for (int i = 0; i < 8; ++i)
#pragma unroll
            for (int k = 0; k < 4; ++k) {
                const int j = lane + 64 * k; const bool forced = (j == 0) || (j == qt) || (j == qt - 1);
                const unsigned long long mk = __ballot(((selm[i] >> k) & 1u) || forced);
                const unsigned lo = (unsigned)mk, hi = (unsigned)(mk >> 32);
                if (lane == 0) { *(LAS unsigned*)(lds + AT_BM + ((8 * wave + i) * 8 + 2 * k) * 4) = lo; *(LAS unsigned*)(lds + AT_BM + ((8 * wave + i) * 8 + 2 * k + 1) * 4) = hi; }
                wu[2 * k] |= lo; wu[2 * k + 1] |= hi;
            }
        if (lane == 0) {
#pragma unroll
            for (int k = 0; k < 8; ++k) *(LAS unsigned*)(lds + AT_WU + (wave * 8 + k) * 4) = wu[k];
        }
    }
    __syncthreads();
#if defined(PROBE_SEL)
    { float m = -INFINITY, l = 0.f;
      run_branch<2, 128>(c, KROW + (size_t)(2 + g) * L_ * 128, VT + (size_t)g * 128 * L_, L_, 0, qt + 1, tb, t, t0, qf, O, m, l, 0.f, tl, imp_row);
      asm volatile("" :: "v"(O[0]), "v"(O[1]), "v"(O[2]), "v"(O[3]), "v"(m), "v"(l));
#pragma unroll
      for (int dt = 0; dt < 4; ++dt)
#pragma unroll
          for (int r = 0; r < 16; ++r) O[dt][r] = 0.f; }
#endif
    { float m = -INFINITY, l = 0.f;
      run_branch<2, 128>(c, KROW + (size_t)(2 + g) * L_ * 128, VT + (size_t)g * 128 * L_, L_, 0, qt + 1, tb, t, t0, qf, O, m, l, 0.f, tl, imp_row);
      const float gs = GATE[(size_t)t * 24 + 8 + head];
      const float lt = xhalf_sum(l), sc = gs * (lt > 0.f ? 1.f / lt : 0.f);
#pragma unroll
      for (int dt = 0; dt < 4; ++dt)
#pragma unroll
          for (int rg = 0; rg < 4; ++rg) {
              const u32x2 w0 = *(const u32x2*)(Y + 32 * dt + 8 * rg);
              u32x2 w; w[0] = cvt_pk_bf16(bflo(w0[0]) + sc * O[dt][4 * rg], bfhi(w0[0]) + sc * O[dt][4 * rg + 1]); w[1] = cvt_pk_bf16(bflo(w0[1]) + sc * O[dt][4 * rg + 2], bfhi(w0[1]) + sc * O[dt][4 * rg + 3]);
              *(u32x2*)(Y + 32 * dt + 8 * rg) = w;
#pragma unroll
              for (int e = 0; e < 4; ++e) O[dt][4 * rg + e] = 0.f;
          }
    }
#if defined(PROBE_WIN)
    { float m = -INFINITY, l = 0.f;
      const int lo = qt - 8 > 0 ? qt - 8 : 0;
      run_branch<3, 128>(c, KROW + (size_t)(4 + g) * L_ * 128, VT + (size_t)(2 + g) * 128 * L_, L_, lo, qt + 1, tb, t, t0, qf, O, m, l, 0.f, tl, imp_row);
      asm volatile("" :: "v"(O[0]), "v"(O[1]), "v"(O[2]), "v"(O[3]), "v"(m), "v"(l));
#pragma unroll
      for (int dt = 0; dt < 4; ++dt)
#pragma unroll
          for (int r = 0; r < 16; ++r) O[dt][r] = 0.f; }
#endif
    { float m = -INFINITY, l = 0.f;
      const int lo = qt - 8 > 0 ? qt - 8 : 0;
      run_branch<3, 128>(c, KROW + (size_t)(4 + g) * L_ * 128, VT + (size_t)(2 + g) * 128 * L_, L_, lo, qt + 1, tb, t, t0, qf, O, m, l, 0.f, tl, imp_row);
      const float gw = GATE[(size_t)t * 24 + 16 + head];
      const float lt = xhalf_sum(l), sc = gw * (lt > 0.f ? 1.f / lt : 0.f);
      float ss = 0.f;
#pragma unroll
      for (int dt = 0; dt < 4; ++dt)
#pragma unroll
          for (int rg = 0; rg < 4; ++rg) {
              const u32x2 w0 = *(const u32x2*)(Y + 32 * dt + 8 * rg);
              const float y0 = bflo(w0[0]) + sc * O[dt][4 * rg], y1 = bfhi(w0[0]) + sc * O[dt][4 * rg + 1], y2 = bflo(w0[1]) + sc * O[dt][4 * rg + 2], y3 = bfhi(w0[1]) + sc * O[dt][4 * rg + 3];
              u32x2 w; w[0] = cvt_pk_bf16(y0, y1); w[1] = cvt_pk_bf16(y2, y3);
              *(u32x2*)(Y + 32 * dt + 8 * rg) = w;
              ss += (y0 * y0 + y1 * y1) + (y2 * y2 + y3 * y3);
          }
      ss = quad_sum(xhalf_sum(ss));
      if (hl == 0 && h == 0) ((float*)(a.ws + WS_STAP))[(size_t)t * 2 + g] = ss;
    }
    __syncthreads();
}
#ifndef PEER_ALPHA
#define PEER_ALPHA 1.0f
#endif
constexpr int PE_SC = 0, PE_LV = 65536, PE_LI = 73728, PE_PK = 81920, PE_EX = 147456, PE_GT = 149504, PE_SU = 153600, PE_CE = 157696, PE_END = 161792;
constexpr int PE_SLOT = 2048, PE_NSLOT = 8, PE_RINGW = PE_SLOT * 9;
static_assert(8 * PE_RINGW <= PE_EX && PE_END <= LDS_BYTES - 32, "PEER LDS map");
__device__ __forceinline__ float pair_wave_sum(float a, float b, bool odd) {
    a += dpp_f<0xB1>(a); b += dpp_f<0xB1>(b);
    float c = odd ? b : a;
    c += dpp_f<0x4E>(c); c += dpp_f<0x124>(c); c += dpp_f<0x128>(c);
    { const auto r = __builtin_amdgcn_permlane16_swap(__float_as_uint(c), __float_as_uint(c), false, false); c = __uint_as_float(r[0]) + __uint_as_float(r[1]); }
    { const auto r = __builtin_amdgcn_permlane32_swap(__float_as_uint(c), __float_as_uint(c), false, false); c = __uint_as_float(r[0]) + __uint_as_float(r[1]); }
    return c;
}
__device__ __forceinline__ float wave_sum_bcast(float v) {
    v += dpp_f<0xB1>(v); v += dpp_f<0x4E>(v); v += dpp_f<0x141>(v); v += dpp_f<0x140>(v);
    v += __int_as_float(__builtin_amdgcn_update_dpp(0, __float_as_int(v), 0x142, 0xa, 0xf, false));
    v += __int_as_float(__builtin_amdgcn_update_dpp(0, __float_as_int(v), 0x143, 0xc, 0xf, false));
    return __int_as_float(__builtin_amdgcn_readlane(__float_as_int(v), 63));
}
__device__ __forceinline__ unsigned mono_key(float v) { const unsigned b = __float_as_uint(v); return b ^ ((b >> 31) ? 0xFFFFFFFFu : 0x80000000u); }
template <int CTRL>
__device__ __forceinline__ void quad_merge16(unsigned (&t)[16]) {
    unsigned o[16];
#pragma unroll
    for (int i = 0; i < 16; ++i) o[i] = (unsigned)__builtin_amdgcn_update_dpp(0, (int)t[15 - i], CTRL, 0xf, 0xf, false);
#pragma unroll
    for (int i = 0; i < 16; ++i) t[i] = max(t[i], o[i]);
#pragma unroll
    for (int st = 8; st >= 1; st >>= 1)
#pragma unroll
        for (int i = 0; i < 16; ++i) if ((i & st) == 0) { const unsigned hi = max(t[i], t[i + st]), lo = min(t[i], t[i + st]); t[i] = hi; t[i + st] = lo; }
}
__device__ __forceinline__ int pair_a(int p) { return p < 16 ? 0 : p < 24 ? 1 : p < 29 ? 2 : p < 33 ? 3 : p < 36 ? 4 : p < 38 ? 5 : p < 40 ? 6 : p < 42 ? 7 : p - 34; }
__device__ __forceinline__ int pair_b(int p) { return p < 16 ? p : p < 24 ? p - 16 : p < 29 ? p - 24 : p < 33 ? p - 29 : p < 36 ? p - 33 : p < 38 ? p - 36 : p < 40 ? p - 38 : p < 42 ? p - 40 : 0; }
template <bool DRY>
__device__ __forceinline__ void peer_step(const Args& a, const Ctx& c_, int t0) {
    Ctx c = c_; { int tz = c_.tid; asm volatile("" : "+v"(tz)); c.tid = tz; c.lane = tz & 63; }
    LAS unsigned char* lds = c.lds;
    const int tid = c.tid, wave = c.wave, lane = c.lane, r = lane & 15, q = lane >> 4;
    const bf16_t* QP = (const bf16_t*)(a.ws + WS_QP); const bf16_t* PK = (const bf16_t*)(a.ws + WS_PK);
    const unsigned char* PU = a.ws + WS_PU; const unsigned char* PV = a.ws + WS_PV; const float* psc = (const float*)(a.ws + WS_PSC);
    const bf16_t* HB = (const bf16_t*)(a.ws + WS_H2);
    const int t = t0 + wave;
    u32x4 hraw[4]; u32x2 xw[8];
#pragma unroll
    for (int k = 0; k < 4; ++k) hraw[k] = *(const u32x4*)(HB + (size_t)t * 2048 + lane * 32 + k * 8);
#pragma unroll
    for (int k = 0; k < 8; ++k) xw[k] = *(const u32x2*)((const bf16_t*)(a.ws + WS_X1) + (size_t)t * 2048 + lane * 32 + k * 4);
    const float r2 = ((const float*)(a.ws + WS_RSTD2))[t0 + ((tid >> 5) & 7)];
    {
#pragma unroll
        for (int i = 0; i < 8; ++i) { const int pc = 8 * wave + i, row = 4 * pc + (lane >> 4), ch = (lane & 15) ^ kswz(row);
            __builtin_amdgcn_global_load_lds((const unsigned*)(PK + (size_t)row * 128 + ch * 8), (LAS unsigned*)(lds + PE_PK + pc * 1024), 16, 0, 0); }
        const int hh = wave;
        bf16x8 aF[2][4];
#pragma unroll
        for (int cc = 0; cc < 2; ++cc)
#pragma unroll
            for (int ks = 0; ks < 4; ++ks) aF[cc][ks] = *(const bf16x8*)(QP + (size_t)(t0 + (r & 7)) * 2048 + hh * 256 + cc * 128 + 32 * ks + 8 * q);
        asm volatile("s_waitcnt vmcnt(0)" ::: "memory");
        __syncthreads();
        const int ksw = kswz(r);
#pragma unroll
        for (int cc = 0; cc < 2; ++cc)
#pragma unroll 2
            for (int nt = 0; nt < 8; ++nt) {
                f32x4 acc = {0.f, 0.f, 0.f, 0.f};
#pragma unroll
                for (int ks = 0; ks < 4; ++ks) { const bf16x8 B = *(const LAS bf16x8*)(lds + PE_PK + (cc * 128 + 16 * nt + r) * 256 + 16 * ((4 * ks + q) ^ ksw)); acc = mfma16(aF[cc][ks], B, acc); }
                if (q < 2) {
#pragma unroll
                    for (int i = 0; i < 4; ++i) { const int task = (4 * q + i) * 16 + hh * 2 + cc; *(LAS float*)(lds + PE_SC + (task * 128 + ((16 * nt + r + task) & 127)) * 4) = acc[i]; }
                }
            }
    }
    __syncthreads();
    {
        const int task = tid >> 2, part = tid & 3;
        LAS const float* sc = (LAS const float*)(lds + PE_SC) + task * 128;
        float vals[32];
#pragma unroll
        for (int k = 0; k < 32; ++k) vals[k] = sc[(32 * part + k + task) & 127];
        unsigned top[16];
#pragma unroll
        for (int e = 0; e < 16; ++e) top[e] = 0u;
#pragma unroll
        for (int k = 0; k < 32; ++k) {
            unsigned key = (mono_key(vals[k]) & ~0x7Fu) | (unsigned)(127 - (32 * part + k));
#pragma unroll
            for (int e = 0; e < 16; ++e) { const unsigned hi = max(top[e], key); key = min(top[e], key); top[e] = hi; }
        }
        quad_merge16<0xB1>(top);
        quad_merge16<0x4E>(top);
        if (part == 0) {
#pragma unroll
            for (int e = 0; e < 16; ++e) { const int idx = 127 - (int)(top[e] & 0x7Fu); *(LAS float*)(lds + PE_LV + (task * 16 + e) * 4) = sc[(idx + task) & 127]; *(LAS int*)(lds + PE_LI + (task * 16 + e) * 4) = idx; }
        }
    }
    __syncthreads();
    if (tid < 256) {
        const int task = tid >> 2, part = tid & 3, tok = task >> 3, hh = task & 7, t1 = tok * 16 + hh * 2, t2 = t1 + 1;
        LAS const float* lv1 = (LAS const float*)(lds + PE_LV) + t1 * 16; LAS const float* lv2 = (LAS const float*)(lds + PE_LV) + t2 * 16;
        unsigned top[16];
#pragma unroll
        for (int e = 0; e < 16; ++e) top[e] = 0u;
        for (int p = part; p < 50; p += 4) {
            const int aa = pair_a(p), bb = pair_b(p);
            unsigned key = (mono_key(lv1[aa] + lv2[bb]) & ~0xFFu) | (unsigned)(255 - (aa * 16 + bb));
#pragma unroll
            for (int e = 0; e < 16; ++e) { const unsigned hi = max(top[e], key); key = min(top[e], key); top[e] = hi; }
        }
        quad_merge16<0xB1>(top);
        quad_merge16<0x4E>(top);
        if (part == 0) {
            LAS const int* li1 = (LAS const int*)(lds + PE_LI) + t1 * 16; LAS const int* li2 = (LAS const int*)(lds + PE_LI) + t2 * 16;
            float sv[16]; int ex[16]; float mx = -INFINITY;
#pragma unroll
            for (int e = 0; e < 16; ++e) {
                const int id = 255 - (int)(top[e] & 0xFFu), aa = id >> 4, bb = id & 15;
                sv[e] = lv1[aa] + lv2[bb]; ex[e] = li1[aa] * 128 + li2[bb]; mx = fmaxf(mx, sv[e]);
            }
            float sum = 0.f;
#pragma unroll
            for (int e = 0; e < 16; ++e) { sv[e] = fexp2((sv[e] - mx) * LOG2E); sum += sv[e]; }
            const float inv = 1.f / sum;
#pragma unroll
            for (int e = 0; e < 16; ++e) *(LAS unsigned short*)(lds + PE_EX + (tok * 128 + hh * 16 + e) * 2) = (unsigned short)ex[e];
            f32x4 rec[16];
#pragma unroll
            for (int e = 0; e < 16; ++e) rec[e] = *(const f32x4*)(psc + (size_t)ex[e] * 4);
            __builtin_amdgcn_sched_barrier(0);
#pragma unroll
            for (int e = 0; e < 16; ++e) asm volatile("" :: "v"(rec[e]));
#pragma unroll
            for (int e = 0; e < 16; ++e) {
                *(LAS float*)(lds + PE_GT + (tok * 128 + hh * 16 + e) * 4) = sv[e] * inv * rec[e][2];
                *(LAS float*)(lds + PE_SU + (tok * 128 + hh * 16 + e) * 4) = rec[e][0] * r2;
                *(LAS float*)(lds + PE_CE + (tok * 128 + hh * 16 + e) * 4) = rec[e][1]; }
        }
    }
    __syncthreads();
    f32x2 hp[16];
#pragma unroll
    for (int k = 0; k < 4; ++k)
#pragma unroll
        for (int e = 0; e < 4; ++e) { hp[k * 4 + e][0] = bflo(hraw[k][e]); hp[k * 4 + e][1] = bfhi(hraw[k][e]); }
    f32x2 acc[16];
#pragma unroll
    for (int e = 0; e < 16; ++e) acc[e] = (f32x2){0.f, 0.f};
    asm volatile("s_waitcnt vmcnt(0)" ::: "memory");
    {
        int lo_ = wave * 512 + (lane & 1) * 4; asm volatile("" : "+v"(lo_));
        LAS const float* gtl = (LAS const float*)(lds + PE_GT + lo_); LAS const float* sul = (LAS const float*)(lds + PE_SU + lo_); LAS const float* cel = (LAS const float*)(lds + PE_CE + lo_);
        int xo_ = wave * 256; asm volatile("" : "+v"(xo_));
        LAS const unsigned short* exl = (LAS const unsigned short*)(lds + PE_EX + xo_);
        const bool odd = lane & 1;
        LAS unsigned char* ring = lds + wave * PE_RINGW;
#define ISSUE_U(SL, IDX) do { const int ex_ = __builtin_amdgcn_readfirstlane((int)exl[IDX]); \
            __builtin_amdgcn_global_load_lds((const unsigned*)(PU + (size_t)ex_ * 1024 + lane * 16), (LAS unsigned*)(ring + (SL) * PE_SLOT), 16, 0, 0); } while (0)
#define ISSUE_V(SL, IDX) do { const int ex_ = __builtin_amdgcn_readfirstlane((int)exl[IDX]); \
            __builtin_amdgcn_global_load_lds((const unsigned*)(PV + (size_t)ex_ * 1024 + lane * 16), (LAS unsigned*)(ring + (SL) * PE_SLOT + 1024), 16, 0, 0); } while (0)
#define UDOT(UW, D0, D1, D2, D3) do { _Pragma("unroll") for (int dw = 0; dw < 4; ++dw) { const f32x2 f0_ = fp4_unpk<0>(UW[dw]), f1_ = fp4_unpk<1>(UW[dw]), f2_ = fp4_unpk<2>(UW[dw]), f3_ = fp4_unpk<3>(UW[dw]); \
                D0 += f0_ * hp[4 * dw]; D1 += f1_ * hp[4 * dw + 1]; D2 += f2_ * hp[4 * dw + 2]; D3 += f3_ * hp[4 * dw + 3]; } } while (0)
#define VACC(VW, WG) do { _Pragma("unroll") for (int dw = 0; dw < 4; ++dw) { const f32x2 f0_ = fp4_unpk<0>(VW[dw]), f1_ = fp4_unpk<1>(VW[dw]), f2_ = fp4_unpk<2>(VW[dw]), f3_ = fp4_unpk<3>(VW[dw]); \
                acc[4 * dw] += WG * f0_; acc[4 * dw + 1] += WG * f1_; acc[4 * dw + 2] += WG * f2_; acc[4 * dw + 3] += WG * f3_; } } while (0)
#define STAGE_A(SA, SB, PA, PB) do { const u32x4 ua_ = *(const LAS u32x4*)(ring + (SA) * PE_SLOT + lane * 16), ub_ = *(const LAS u32x4*)(ring + (SB) * PE_SLOT + lane * 16); \
            f32x2 a0_ = {0.f, 0.f}, a1_ = {0.f, 0.f}, a2_ = {0.f, 0.f}, a3_ = {0.f, 0.f}, b0_ = {0.f, 0.f}, b1_ = {0.f, 0.f}, b2_ = {0.f, 0.f}, b3_ = {0.f, 0.f}; \
            if (!DRY) { UDOT(ua_, a0_, a1_, a2_, a3_); UDOT(ub_, b0_, b1_, b2_, b3_); } else { a0_[0] = __uint_as_float((ua_[0] ^ ua_[1] ^ ua_[2] ^ ua_[3]) & 0x3f800000u); b0_[0] = __uint_as_float((ub_[0] ^ ub_[1] ^ ub_[2] ^ ub_[3]) & 0x3f800000u); } \
            const f32x2 as_ = (a0_ + a1_) + (a2_ + a3_), bs_ = (b0_ + b1_) + (b2_ + b3_); PA = as_[0] + as_[1]; PB = bs_[0] + bs_[1]; } while (0)
#define STAGE_B(IDX, PA, PB, WA, WB) do { const float cs_ = pair_wave_sum(PA, PB, odd);                           \
            const float wl_ = gtl[IDX] * gelu_tanh(cs_ * sul[IDX] + cel[IDX]);                            \
            WA = dpp_f<0xA0>(wl_); WB = dpp_f<0xF5>(wl_); } while (0)
#define STAGE_C(SA, SB, WA, WB) do { const u32x4 va_ = *(const LAS u32x4*)(ring + (SA) * PE_SLOT + 1024 + lane * 16), vb_ = *(const LAS u32x4*)(ring + (SB) * PE_SLOT + 1024 + lane * 16); \
            VACC(va_, WA); VACC(vb_, WB); } while (0)
#define DMA_WAIT(N) asm volatile("s_waitcnt vmcnt(" #N ")" ::: "memory")
#define LDS_DONE() asm volatile("s_waitcnt lgkmcnt(0)" ::: "memory")
#define PAIR_ITER(P, NS, DOA, UW, DOU, VW, DOV) do { float na_ = 0.f, nb_ = 0.f, wa_, wb_; \
            if (DOA) { DMA_WAIT(UW); STAGE_A(NS, (NS) + 1, na_, nb_); } \
            STAGE_B(e + 2 * (P), pa, pb, wa_, wb_); \
            LDS_DONE(); \
            if (DOU) { ISSUE_U(NS, e + 2 * (P) + 10); ISSUE_U((NS) + 1, e + 2 * (P) + 11); } \
            DMA_WAIT(VW); STAGE_C(2 * (P), 2 * (P) + 1, wa_, wb_); \
            LDS_DONE(); \
            if (DOV) { ISSUE_V(2 * (P), e + 2 * (P) + 8); ISSUE_V(2 * (P) + 1, e + 2 * (P) + 9); } \
            pa = na_; pb = nb_; } while (0)
        float pa, pb;
        ISSUE_U(0, 0); ISSUE_U(1, 1); ISSUE_U(2, 2); ISSUE_U(3, 3); ISSUE_V(0, 0); ISSUE_V(1, 1); ISSUE_U(4, 4); ISSUE_U(5, 5); ISSUE_V(2, 2); ISSUE_V(3, 3);
        ISSUE_U(6, 6); ISSUE_U(7, 7); ISSUE_V(4, 4); ISSUE_V(5, 5);
        DMA_WAIT(12); STAGE_A(0, 1, pa, pb); LDS_DONE();
        ISSUE_U(0, 8); ISSUE_U(1, 9); ISSUE_V(6, 6); ISSUE_V(7, 7);
#pragma unroll 1
        for (int tr = 0; tr < 14; ++tr) {
            const int e = tr * 8;
            PAIR_ITER(0, 2, true, 14, true, 14, true);
            PAIR_ITER(1, 4, true, 14, true, 14, true);
            PAIR_ITER(2, 6, true, 14, true, 14, true);
            PAIR_ITER(3, 0, true, 14, true, 14, true);
        }
        { const int e = 14 * 8;
            PAIR_ITER(0, 2, true, 14, true, 14, true);
            PAIR_ITER(1, 4, true, 14, true, 14, true);
            PAIR_ITER(2, 6, true, 14, true, 14, true);
            PAIR_ITER(3, 0, true, 14, false, 12, true); }
        { const int e = 15 * 8;
            PAIR_ITER(0, 2, true, 12, false, 10, false);
            PAIR_ITER(1, 4, true, 8, false, 6, false);
            PAIR_ITER(2, 6, true, 4, false, 2, false);
            PAIR_ITER(3, 0, false, 0, false, 0, false); }
#undef ISSUE_U
#undef ISSUE_V
#undef STAGE_A
#undef STAGE_B
#undef STAGE_C
#undef LDS_DONE
#undef PAIR_ITER
#undef UDOT
#undef VACC
#undef DMA_WAIT
    }
    {
        float* xo = a.out + (size_t)t * 2048; const float* g2 = (const float*)(a.ws + WS_COND) + 5 * 2048; const float* fg = a.in[32];
        f32x4 gvv[8], fvv[8];
#pragma unroll
        for (int k = 0; k < 8; ++k) { const int col = lane * 32 + k * 4; gvv[k] = *(const f32x4*)(g2 + col); fvv[k] = *(const f32x4*)(fg + col); }
        float ss = 0.f;
#pragma unroll
        for (int k = 0; k < 8; ++k) {
            const float x1[4] = {bflo(xw[k][0]), bfhi(xw[k][0]), bflo(xw[k][1]), bfhi(xw[k][1])};
#pragma unroll
            for (int e = 0; e < 4; ++e) { const float x2 = x1[e] + PEER_ALPHA * gvv[k][e] * acc[k * 2 + (e >> 1)][e & 1]; acc[k * 2 + (e >> 1)][e & 1] = x2; ss += x2 * x2; }
        }
        ss = wave_sum_bcast(ss);
        const float rstd = rsqrtf(ss * (1.f / 2048.f) + 1e-6f);
#pragma unroll
        for (int k = 0; k < 8; ++k) {
            const int col = lane * 32 + k * 4;
            f32x4 o;
#pragma unroll
            for (int e = 0; e < 4; ++e) o[e] = acc[k * 2 + (e >> 1)][e & 1] * rstd * fvv[k][e];
            if (!DRY || rstd == 123.456f) *(f32x4*)(xo + col) = o;
        }
    }
    __syncthreads();
}
constexpr int NPHASE = 11;
#ifndef DBG
#define DBG 0
#endif
__device__ __forceinline__ void dbg_final_norm(const Args& a, const Ctx& c, const float* src) {
    for (int t = c.bid * 8 + c.wave; t < L_; t += c.nb * 8) {
        const float* xr = src + (size_t)t * 2048 + c.lane * 4; float* o = a.out + (size_t)t * 2048 + c.lane * 4;
        f32x4 v[8]; float ss = 0.f;
#pragma unroll
        for (int j = 0; j < 8; ++j) { v[j] = *(const f32x4*)(xr + j * 256); ss += v[j][0] * v[j][0] + v[j][1] * v[j][1] + v[j][2] * v[j][2] + v[j][3] * v[j][3]; }
        ss = wave_sum(ss);
        const float rstd = rsqrtf(ss * (1.f / 2048.f) + 1e-6f);
#pragma unroll
        for (int j = 0; j < 8; ++j) { const f32x4 g = *(const f32x4*)(a.in[32] + j * 256 + c.lane * 4); *(f32x4*)(o + j * 256) = v[j] * rstd * g; }
    }
}

extern __shared__ __attribute__((aligned(16))) unsigned char smem[];

__global__ void __launch_bounds__(512, 2) fwd(Args a) {
    LAS unsigned char* lds = (LAS unsigned char*)smem;
    Ctx c; c.bid = blockIdx.x; c.nb = gridDim.x; c.tid = threadIdx.x; c.wave = __builtin_amdgcn_readfirstlane(threadIdx.x >> 6); c.lane = threadIdx.x & 63; c.lds = lds;
    volatile LAS unsigned* xbw = (volatile LAS unsigned*)(lds + LDS_BYTES - 16);
    if (c.tid < 4) xbw[c.tid] = 0u;
    __syncthreads();
    const int lo = a.ph_lo, hi = a.ph_hi;
    const bool multi = (hi - lo) > 1;
    XcdBarrier bar; bar.bar = (unsigned*)(a.ws + WS_CTL); bar.x = 0; bar.st = xbw;
    if (multi) bar = xcd_barrier_post((unsigned*)(a.ws + WS_CTL), xbw);
#ifndef PHASE_MASK
#define PHASE_MASK 0xFFFF
#endif
#if DBG == 1
#undef PHASE_MASK
#define PHASE_MASK 0x403
#elif DBG == 2 || DBG == 4 || DBG == 5
#undef PHASE_MASK
#define PHASE_MASK 0x4FF
#endif
#define IN(k) (((PHASE_MASK >> (k)) & 1) && lo <= (k) && (k) < hi)
#define REFRESH() do { int tz_ = threadIdx.x; asm volatile("" : "+v"(tz_)); c.tid = tz_; c.lane = tz_ & 63; c.wave = __builtin_amdgcn_readfirstlane(tz_ >> 6); } while (0)
#define SEAM(k) do { if (IN(k) && IN((k) + 1)) xcd_barrier(bar); } while (0)
#ifndef DUP
#define DUP -1
#endif
#define REP(k) for (int rep_ = 0; rep_ < ((DUP == (k)) ? 2 : 1); ++rep_)
#define DUP2(k, ...) do { __VA_ARGS__; if (DUP == (k)) { __syncthreads(); __VA_ARGS__; } } while (0)

    if (IN(0)) REP(0) { REFRESH(); p0_prologue(a, c); }
    SEAM(0);
    if (IN(1)) { REFRESH(); DUP2(1, p1_hnorm(a, c)); }
    SEAM(1);
    if (IN(2)) { REFRESH();
        pg8::StaticOrder S; S.init((const bf16_t*)(a.ws + WS_H), (const bf16_t*)(a.ws + WS_WIN), 2048, 2048, 2048, L_, DIN_PAD, c.nb, c.bid);
        EpiWin E{(bf16_t*)(a.ws + WS_US), (bf16_t*)(a.ws + WS_Q), (bf16_t*)(a.ws + WS_KROW), (bf16_t*)(a.ws + WS_VROW), (bf16_t*)(a.ws + WS_VT), (float*)(a.ws + WS_GATE)};
        DUP2(2, pg8::gemm_phase<EpiWin, pg8::StaticOrder>(lds, S, E));
    }
    SEAM(2);
    if (IN(3)) { REFRESH();
        DUP2(31, for (int it = c.bid; it < 256; it += c.nb) s5_item<0>(a, c, it >> 2, it & 3));
        __syncthreads();
        CmpOrder S{(const bf16_t*)(a.ws + WS_KROW), (const bf16_t*)(a.ws + WS_VROW), (const bf16_t*)(a.ws + WS_W1), 2048, 4096, 256, c.nb, c.bid};
        EpiSlab E{(float*)(a.ws + WS_SLAB)};
        DUP2(32, pg8::gemm_phase<EpiSlab, CmpOrder>(lds, S, E));
    }
    SEAM(3);
    if (IN(4)) { REFRESH();
        DUP2(41, for (int it = c.bid; it < 256; it += c.nb) cmp_finish_item(a, c, it >> 7, it & 127));
        DUP2(42, for (int it = c.bid; it < 256; it += c.nb) s5_item<1>(a, c, it >> 2, it & 3));
    }
    SEAM(4);
    if (IN(5)) { REFRESH();
#if DBG == 5
        for (size_t i = (size_t)c.bid * NTHREADS + c.tid; i < (size_t)L_ * 1024 / 8; i += (size_t)c.nb * NTHREADS) *(u32x4*)((bf16_t*)(a.ws + WS_YSSM) + i * 8) = (u32x4){0u, 0u, 0u, 0u};
#else
        {
            pg8::StaticOrder S; S.init((const bf16_t*)(a.ws + WS_Z), (const bf16_t*)(a.ws + WS_WGLU), 1024, 1024, 1024, L_, 1024, c.nb, c.bid);
            EpiGlu E{(const bf16_t*)(a.ws + WS_Z), a.in[19], (bf16_t*)(a.ws + WS_Y2), (float*)(a.ws + WS_STSP)};
            DUP2(55, pg8::gemm_phase<EpiGlu, pg8::StaticOrder>(lds, S, E));
        }
#endif
        __syncthreads();
        REP(5)
#if DBG == 4
        for (size_t i = (size_t)c.bid * NTHREADS + c.tid; i < (size_t)L_ * 1024 / 8; i += (size_t)c.nb * NTHREADS) *(u32x4*)((bf16_t*)(a.ws + WS_YATT) + i * 8) = (u32x4){0u, 0u, 0u, 0u};
#else
        {
            unsigned* qhead = (unsigned*)(a.ws + WS_CTL) + 8192;
            volatile LAS unsigned* slot = (volatile LAS unsigned*)(lds + LDS_BYTES - 32);
            for (;;) {
                if (c.tid == 0) *slot = __hip_atomic_fetch_add(qhead, 1u, __ATOMIC_RELAXED, __HIP_MEMORY_SCOPE_AGENT);
                __syncthreads();
                const unsigned q = *slot;
                __syncthreads();
                if (q >= 512u) break;
                attn_item(a, c, 255 - (int)(q >> 1), (int)(q & 1));
            }
        }
#endif
    }
    SEAM(5);
#define WOUT_GEMM(PM0) do { pg8::StaticOrder S; S.init((const bf16_t*)(a.ws + WS_Y2), (const bf16_t*)(a.ws + WS_WOUT), 2048, 2048, 2048, L_ / 2, 2048, c.nb, c.bid, PM0); \
        rsa_prepass(S, (const float*)(a.ws + WS_STSP), (const float*)(a.ws + WS_STAP), (float*)(a.ws + WS_RSA), c.tid); \
        EpiWout E{a.in[0], (const float*)(a.ws + WS_COND) + 2 * 2048, (const float*)(a.ws + WS_F2), (bf16_t*)(a.ws + WS_X1), (bf16_t*)(a.ws + WS_H2), (float*)(a.ws + WS_ST2P), (const float*)(a.ws + WS_RSA)}; \
        pg8::gemm_phase<EpiWout, pg8::StaticOrder>(lds, S, E); __syncthreads(); } while (0)
#define WQ_GEMM(PM0) do { pg8::StaticOrder S; S.init((const bf16_t*)(a.ws + WS_H2), (const bf16_t*)(a.ws + WS_WQ), 2048, 2048, 2048, L_ / 2, 2048, c.nb, c.bid, PM0); \
        rstd2_prepass(S, (const float*)(a.ws + WS_ST2P), (float*)(a.ws + WS_RSTD2), c.tid); \
        EpiQ E{(bf16_t*)(a.ws + WS_QP), (const float*)(a.ws + WS_RSTD2), (const float*)(a.ws + WS_CQ)}; pg8::gemm_phase<EpiQ, pg8::StaticOrder>(lds, S, E); __syncthreads(); } while (0)
#define PEER_STEPS(FIRST, COUNT) do { for (int s_ = (FIRST) + c.bid; s_ < (FIRST) + (COUNT); s_ += c.nb) peer_step<false>(a, c, s_ * 8); } while (0)
    if (IN(6)) { REFRESH(); DUP2(7, p_cqce(a, c)); DUP2(71, WOUT_GEMM(0)); }
    SEAM(6);
    if (IN(7)) { REFRESH(); DUP2(8, WQ_GEMM(0)); }
    SEAM(7);
    if (IN(8)) { REFRESH();
        if ((c.bid >> 3) & 1) PEER_STEPS(0, 512);
        WOUT_GEMM(32);
        if (!((c.bid >> 3) & 1)) PEER_STEPS(0, 512); }
    SEAM(8);
    if (IN(9)) { REFRESH();
        if ((c.bid >> 3) & 1) PEER_STEPS(512, 512);
        WQ_GEMM(32);
        if (!((c.bid >> 3) & 1)) PEER_STEPS(512, 512); }
    SEAM(9);
#if defined(PROBE_DRY)
    if (IN(10)) { REFRESH(); for (int s_ = 1024 + c.bid; s_ < 2048; s_ += c.nb) peer_step<true>(a, c, s_ * 8); __syncthreads(); PEER_STEPS(1024, 1024); }
#else
    if (IN(10)) { REFRESH(); DUP2(11, PEER_STEPS(1024, 1024)); }
#endif
#undef WOUT_GEMM
#undef WQ_GEMM
#undef PEER_STEPS
#undef IN
#undef SEAM
}

#ifndef N_LAUNCHES
#define N_LAUNCHES 1
#endif
extern "C" void kernel_launch(void* const* d_in, const int* in_sizes, int n_in, void* d_out, int out_size, void* d_ws, size_t ws_size, hipStream_t stream) {
    static int grid = 0;
    if (grid == 0) {
        if (n_in != 33 || out_size != L_ * D_ || ws_size < WS_END) { fprintf(stderr, "kernel_launch: unexpected shapes (n_in %d, out %d, ws %zu < %zu); nothing launched\n", n_in, out_size, ws_size, (size_t)WS_END); grid = -1; return; }
        int dev = 0, cus = 0, per_cu = 0;
        if (hipGetDevice(&dev) != hipSuccess || hipDeviceGetAttribute(&cus, hipDeviceAttributeMultiprocessorCount, dev) != hipSuccess) { grid = -1; return; }
        if (hipFuncSetAttribute((const void*)fwd, hipFuncAttributeMaxDynamicSharedMemorySize, LDS_BYTES) != hipSuccess) { fprintf(stderr, "kernel_launch: hipFuncSetAttribute failed\n"); grid = -1; return; }
        if (hipOccupancyMaxActiveBlocksPerMultiprocessor(&per_cu, (const void*)fwd, NTHREADS, LDS_BYTES) != hipSuccess || per_cu < 1) { fprintf(stderr, "kernel_launch: occupancy query says %d\n", per_cu); (void)hipGetLastError(); grid = -1; return; }
        grid = cus;
    }
    if (grid < 0) return;
    (void)hipMemsetAsync((char*)d_ws + WS_CTL, 0, CTL_BYTES, stream);
    Args a{};
    for (int i = 0; i < 33; ++i) a.in[i] = (const float*)d_in[i];
    a.out = (float*)d_out; a.ws = (unsigned char*)d_ws;
    if (N_LAUNCHES == 1) { a.ph_lo = 0; a.ph_hi = NPHASE; hipLaunchKernelGGL(fwd, dim3(grid), dim3(NTHREADS), LDS_BYTES, stream, a); }
    else for (int p = 0; p < NPHASE; ++p) { a.ph_lo = p; a.ph_hi = p + 1; hipLaunchKernelGGL(fwd, dim3(grid), dim3(NTHREADS), LDS_BYTES, stream, a); }
}
```

```cpp
#include <hip/hip_runtime.h>
#include <stdint.h>
#include <stdio.h>

#define LAS __attribute__((address_space(3)))
typedef unsigned short bf16_t;
typedef short bf16x8 __attribute__((ext_vector_type(8)));
typedef float f32x2 __attribute__((ext_vector_type(2)));
typedef float f32x4 __attribute__((ext_vector_type(4)));
typedef float f32x16 __attribute__((ext_vector_type(16)));
typedef unsigned u32x2 __attribute__((ext_vector_type(2)));
typedef unsigned u32x4 __attribute__((ext_vector_type(4)));
typedef __bf16 bfv2 __attribute__((ext_vector_type(2)));
typedef unsigned u32x6 __attribute__((ext_vector_type(6)));
typedef float f32x32 __attribute__((ext_vector_type(32)));

constexpr int L_ = 16384, D_ = 2048, DSSM = 1024, DATT = 1024, DIN = 3608, DIN_PAD = 3840;
constexpr int NADA = 12288;
constexpr float LOG2E = 1.4426950408889634f;
constexpr float QSCALE = 0.08838834764831845f * 1.4426950408889634f;
constexpr int TBN = 800;
constexpr int NTHREADS = 512;
constexpr int LDS_BYTES = 163840;

constexpr size_t al256(size_t x) { return (x + 255) & ~(size_t)255; }
constexpr size_t WS_CTL   = 0;                                  constexpr size_t CTL_BYTES = 65536;
constexpr size_t WS_CONDP = WS_CTL + CTL_BYTES;
constexpr size_t WS_COND  = WS_CONDP + 32 * 12288 * 4;
constexpr size_t WS_TB    = WS_COND + 12288 * 4;
constexpr size_t WS_BPE   = al256(WS_TB + 8 * TBN * 4);
constexpr size_t WS_S5P   = al256(WS_BPE + 2 * 256 * 4);
constexpr size_t WS_S5F   = WS_S5P + 2 * 64 * 64 * 2 * 4;
constexpr size_t WS_S5MT  = WS_S5F + 64 * 4 * 128 * 4;
constexpr size_t WS_S5WE  = WS_S5MT + (size_t)64 * 256 * 256 * 2;
constexpr size_t WS_S5WC  = WS_S5WE + (size_t)64 * 128 * 256 * 2;
constexpr size_t WS_WIN   = WS_S5WC + (size_t)64 * 256 * 128 * 2;
constexpr size_t WS_WGLU  = WS_WIN + (size_t)DIN_PAD * 2048 * 2;
constexpr size_t WS_WOUT  = WS_WGLU + (size_t)1024 * 1024 * 2;
constexpr size_t WS_WQ    = WS_WOUT + (size_t)2048 * 2048 * 2;
constexpr size_t WS_W1    = WS_WQ + (size_t)2048 * 2048 * 2;
constexpr size_t WS_W2    = WS_W1 + (size_t)2 * 256 * 4096 * 2;
constexpr size_t WS_PK    = WS_W2 + (size_t)2 * 128 * 256 * 2;
constexpr size_t WS_PU    = WS_PK + (size_t)2 * 128 * 128 * 2;
constexpr size_t WS_PV    = WS_PU + (size_t)16384 * 1024;
constexpr size_t WS_PSC   = WS_PV + (size_t)16384 * 1024;
constexpr size_t WS_BPEP  = WS_PSC + (size_t)4 * 16384 * 4;
constexpr size_t WS_H     = WS_BPEP + (size_t)32 * 2 * 256 * 4;
constexpr size_t WS_US    = WS_H + (size_t)16384 * 2048 * 2;
constexpr size_t WS_Q     = WS_US + (size_t)16384 * 1024 * 2;
constexpr size_t WS_QP    = WS_US;
constexpr size_t WS_KROW  = WS_Q + (size_t)16384 * 1024 * 2;
constexpr size_t WS_VROW  = WS_KROW + (size_t)6 * 16384 * 128 * 2;
constexpr size_t WS_VT    = WS_VROW + (size_t)2 * 16384 * 128 * 2 + 8192;
constexpr size_t WS_GATE  = WS_VT + (size_t)4 * 128 * 16384 * 2;
constexpr size_t WS_SLAB  = WS_GATE + (size_t)16384 * 24 * 4;
constexpr size_t WS_KC    = WS_SLAB + (size_t)2 * 16 * 2048 * 256 * 4;
constexpr size_t WS_VCT   = WS_KC + (size_t)2 * 1024 * 128 * 2;
constexpr size_t WS_Z     = WS_VCT + (size_t)2 * 128 * 1024 * 2;
constexpr size_t WS_YSSM  = WS_Z + (size_t)16384 * 1024 * 2;
constexpr size_t WS_YATT  = WS_YSSM + (size_t)16384 * 1024 * 2;
constexpr size_t WS_H2    = WS_SLAB;
constexpr size_t WS_Y2    = WS_YSSM;
constexpr size_t WS_X1    = WS_H;
constexpr size_t WS_ST2P  = WS_YATT + (size_t)16384 * 1024 * 2;
constexpr size_t WS_RSTD2 = WS_ST2P + (size_t)16384 * 32 * 4;
constexpr size_t WS_F2    = WS_RSTD2 + (size_t)16384 * 4;
constexpr size_t WS_CQ    = WS_F2 + 2048 * 4;
constexpr size_t WS_STSP  = WS_CQ + 2048 * 4;
constexpr size_t WS_STAP  = WS_STSP + (size_t)16384 * 16 * 4;
constexpr size_t WS_RSA   = WS_STAP + (size_t)16384 * 2 * 4;
constexpr size_t WS_END   = WS_RSA + (size_t)16384 * 2 * 4;
static_assert(WS_END < (size_t)530 * 1024 * 1024, "workspace map too large");

struct Args { const float* in[33]; float* out; unsigned char* ws; int ph_lo, ph_hi; };

__device__ __forceinline__ unsigned cvt_pk_bf16(float lo, float hi) { bfv2 v; v[0] = (__bf16)lo; v[1] = (__bf16)hi; return __builtin_bit_cast(unsigned, v); }
__device__ __forceinline__ bf16_t f2bf(float f) { return (bf16_t)(cvt_pk_bf16(f, 0.f) & 0xffffu); }
__device__ __forceinline__ float bf2f(unsigned b) { return __uint_as_float(b << 16); }
__device__ __forceinline__ float bflo(unsigned w) { return __uint_as_float(w << 16); }
__device__ __forceinline__ float bfhi(unsigned w) { return __uint_as_float(w & 0xffff0000u); }
__device__ __forceinline__ float fexp2(float x) { return __builtin_amdgcn_exp2f(x); }
__device__ __forceinline__ float frcp(float x) { return __builtin_amdgcn_rcpf(x); }
__device__ __forceinline__ float sigmoidf_(float x) { return frcp(1.f + fexp2(-LOG2E * x)); }
__device__ __forceinline__ float gelu_tanh(float x) {
    const float u = x * (1.f + 0.044715f * x * x);
    return x * frcp(1.f + fexp2(-2.f * 0.7978845608028654f * LOG2E * u));
}
__device__ __forceinline__ float shfl_xor_f(float v, int m) { return __shfl_xor(v, m, 64); }
__device__ __forceinline__ float wave_sum(float v) {
#pragma unroll
    for (int m = 32; m >= 1; m >>= 1) v += __shfl_xor(v, m, 64);
    return v;
}
__device__ __forceinline__ float wave_max(float v) {
#pragma unroll
    for (int m = 32; m >= 1; m >>= 1) v = fmaxf(v, __shfl_xor(v, m, 64));
    return v;
}
template <int CTRL> __device__ __forceinline__ float dpp_f(float x) { return __int_as_float(__builtin_amdgcn_update_dpp(0, __float_as_int(x), CTRL, 0xf, 0xf, false)); }
__device__ __forceinline__ float wave_max_bcast(float v) {
    v = fmaxf(v, dpp_f<0xB1>(v)); v = fmaxf(v, dpp_f<0x4E>(v)); v = fmaxf(v, dpp_f<0x141>(v)); v = fmaxf(v, dpp_f<0x140>(v));
    v = fmaxf(v, __int_as_float(__builtin_amdgcn_update_dpp(__float_as_int(v), __float_as_int(v), 0x142, 0xa, 0xf, false)));
    v = fmaxf(v, __int_as_float(__builtin_amdgcn_update_dpp(__float_as_int(v), __float_as_int(v), 0x143, 0xc, 0xf, false)));
    return __int_as_float(__builtin_amdgcn_readlane(__float_as_int(v), 63));
}
__device__ __forceinline__ unsigned wave_umax_bcast(unsigned v) {
#define UDPP_(x, ctrl, rm) (unsigned)__builtin_amdgcn_update_dpp((int)(x), (int)(x), ctrl, rm, 0xf, false)
    v = max(v, UDPP_(v, 0xB1, 0xf)); v = max(v, UDPP_(v, 0x4E, 0xf)); v = max(v, UDPP_(v, 0x141, 0xf)); v = max(v, UDPP_(v, 0x140, 0xf));
    v = max(v, UDPP_(v, 0x142, 0xa)); v = max(v, UDPP_(v, 0x143, 0xc));
#undef UDPP_
    return (unsigned)__builtin_amdgcn_readlane((int)v, 63);
}
__device__ __forceinline__ float quad_sum(float x) { x += dpp_f<0xB1>(x); x += dpp_f<0x4E>(x); return x; }
template <int SEL> __device__ __forceinline__ f32x2 fp4_unpk(unsigned w) { return __builtin_amdgcn_cvt_scalef32_pk_f32_fp4(w, 1.0f, SEL); }
template <int SEL> __device__ __forceinline__ unsigned fp4_pk(unsigned w, float a, float b) { return __builtin_amdgcn_cvt_scalef32_pk_fp4_f32(w, a, b, 1.0f, SEL); }
__device__ __forceinline__ f32x4 mfma16(bf16x8 a, bf16x8 b, f32x4 c) { return __builtin_amdgcn_mfma_f32_16x16x32_bf16(a, b, c, 0, 0, 0); }
__device__ __forceinline__ f32x16 mfma32(bf16x8 a, bf16x8 b, f32x16 c) { return __builtin_amdgcn_mfma_f32_32x32x16_bf16(a, b, c, 0, 0, 0); }
#define XB_TMO      128
#define XB_XCNT(j)  (256  + 64 * (j))
#define XB_XSUB(j)  (1280 + 64 * (j))
#define XB_XGEN(j)  (2304 + 64 * (j))
#define XB_TOP      3328
#define XB_TOPGEN   3392
#define XCD_BAR_WORDS 3456
#define XB_SPIN_CAP (1u << 18)

__device__ __forceinline__ unsigned xb_ld(unsigned* p)              { return __hip_atomic_load(p, __ATOMIC_RELAXED, __HIP_MEMORY_SCOPE_AGENT); }
__device__ __forceinline__ unsigned xb_add(unsigned* p, unsigned v) { return __hip_atomic_fetch_add(p, v, __ATOMIC_RELAXED, __HIP_MEMORY_SCOPE_AGENT); }
__device__ __forceinline__ unsigned xb_xcc_id() { return (unsigned)__builtin_amdgcn_s_getreg((3 << 11) | 20) & 0xFu; }
#define XB_SPIN(cond, bar) do { unsigned _sp = 0; while (cond) { __builtin_amdgcn_s_sleep(1); \
    if ((++_sp & 255u) == 0u) { if (xb_ld(&(bar)[XB_TMO])) break; if (_sp > XB_SPIN_CAP) { atomicAdd(&(bar)[XB_TMO], 1u); break; } } } } while (0)

struct XcdBarrier {
    unsigned* bar; unsigned x;
    volatile LAS unsigned* st;
};
__device__ __forceinline__ XcdBarrier xcd_barrier_post(unsigned* bar, volatile LAS unsigned* st) {
    XcdBarrier b; b.bar = bar; b.x = xb_xcc_id(); b.st = st;
    if (threadIdx.x == 0) (void)xb_add(&bar[XB_XCNT(b.x)], 1u);
    return b;
}
__device__ __forceinline__ void xcd_barrier_complete(unsigned* bar, unsigned x, unsigned& nloc, unsigned& nx) {
    const unsigned G = gridDim.x * gridDim.y * gridDim.z;
    unsigned sum, cnt, mine, sp = 0u;
    for (;;) {
        sum = 0u; cnt = 0u; mine = 0u;
#pragma unroll
        for (unsigned j = 0; j < 16; ++j) { const unsigned c = xb_ld(&bar[XB_XCNT(j)]); sum += c; cnt += (c > 0u) ? 1u : 0u; mine = (j == x) ? c : mine; }
        if (sum == G) break;
        __builtin_amdgcn_s_sleep(1);
        if ((++sp & 255u) == 0u) { if (xb_ld(&bar[XB_TMO])) break; if (sp > XB_SPIN_CAP) { atomicAdd(&bar[XB_TMO], 1u); break; } }
    }
    nloc = mine > 0u ? mine : 1u; nx = cnt > 0u ? cnt : 1u;
}
__device__ __forceinline__ void xcd_barrier(const XcdBarrier& b) {
    asm volatile("s_waitcnt vmcnt(0)" ::: "memory");
    __syncthreads();
    if (threadIdx.x == 0) {
        unsigned* bar = b.bar;
        __builtin_amdgcn_s_waitcnt(0);
        unsigned nloc = b.st[0], nx = b.st[1];
        if (nloc == 0u) { xcd_barrier_complete(bar, b.x, nloc, nx); b.st[0] = nloc; b.st[1] = nx; }
        const unsigned old = xb_add(&bar[XB_XSUB(b.x)], 1u);
        const unsigned gen = old / nloc;
        if (old + 1u == (gen + 1u) * nloc) {
            __builtin_amdgcn_fence(__ATOMIC_RELEASE, "agent");
            asm volatile("s_waitcnt vmcnt(0)" ::: "memory");
            const unsigned og = xb_add(&bar[XB_TOP], 1u);
            const unsigned tg = og / nx;
            if (og + 1u == (tg + 1u) * nx) xb_add(&bar[XB_TOPGEN], 1u);
            else XB_SPIN(xb_ld(&bar[XB_TOPGEN]) == tg, bar);
            __builtin_amdgcn_fence(__ATOMIC_ACQUIRE, "agent");
            xb_add(&bar[XB_XGEN(b.x)], 1u);
            asm volatile("s_waitcnt vmcnt(0)" ::: "memory");
        } else {
            XB_SPIN(xb_ld(&bar[XB_XGEN(b.x)]) == gen, bar);
            __builtin_amdgcn_fence(__ATOMIC_ACQUIRE, "agent");
            asm volatile("s_waitcnt vmcnt(0)" ::: "memory");
        }
    }
    __syncthreads();
}

namespace pg8 {
constexpr int BM = 256, BK = 64, HALF = 128, HTB = HALF * BK * 2, STAGE_BYTES = 8 * HTB, NXCD = 8, WGM = 8;
__host__ __device__ __forceinline__ int lds_byte(int r, int c) { const int st = (r >> 4) * 2 + (c >> 5), rr = r & 15, cc = c & 31, ob = rr * 64 + cc * 2; return st * 1024 + (ob ^ (((ob >> 9) & 1) << 5)); }
__host__ __device__ __forceinline__ void stage_rc(int b, int& R, int& C) { const int st = b / 1024, sb = b % 1024, swz = sb ^ (((sb >> 9) & 1) << 5); R = (st >> 1) * 16 + swz / 64; C = (st & 1) * 32 + (swz % 64) / 2; }
__host__ __device__ __forceinline__ int perm32(int rho) { const int n = rho >> 4, i = rho & 15; return 8 * (i >> 2) + 4 * n + (i & 3); }

struct Unit { int pm, pn, z; };
struct StaticOrder {
    const bf16_t* A; const bf16_t* Bt; int lda, ldb, K;
    int nM, nN, nwg, G, c, pm0;
    __device__ void init(const bf16_t* A_, const bf16_t* Bt_, int lda_, int ldb_, int K_, int M, int N, int G_, int c_, int pm0_ = 0) { A = A_; Bt = Bt_; lda = lda_; ldb = ldb_; K = K_; nM = M / BM; nN = N / BM; nwg = nM * nN; G = G_; c = c_; pm0 = pm0_; }
    __device__ bool next(int i, Unit& u) const {
        const long Lx = (long)i * G + c; if (Lx >= nwg) return false;
        int wgid = (int)Lx; { const int q = nwg / NXCD, r = nwg % NXCD, xcd = wgid % NXCD, off = wgid / NXCD; wgid = (xcd < r ? xcd * (q + 1) : r * (q + 1) + (xcd - r) * q) + off; }
        const int nig = WGM * nN, gid = wgid / nig, fm = gid * WGM, gsz = (nM - fm) < WGM ? (nM - fm) : WGM;
        u.pm = pm0 + fm + ((wgid % nig) % gsz); u.pn = (wgid % nig) / gsz; u.z = 0; return true;
    }
    __device__ __forceinline__ const char* a_base(const Unit& u) const { return (const char*)(A + (size_t)u.pm * BM * lda); }
    __device__ __forceinline__ const char* b_base(const Unit& u) const { return (const char*)(Bt + (size_t)u.pn * BM * ldb); }
};

template <class Epi, class Sched>
__device__ __forceinline__ void gemm_phase(LAS unsigned char* lds, const Sched& S, const Epi& E) {
    const int tid = threadIdx.x, wid = __builtin_amdgcn_readfirstlane(tid >> 6), lane = tid & 63, wr = wid >> 2, wc = wid & 3, fr = lane & 15, fq = lane >> 4;
    const int K = S.K, nt = K / BK, lda = S.lda, ldb = S.ldb;
    unsigned voffA[2], voffB[2];
#pragma unroll
    for (int i = 0; i < 2; ++i) { int R, C; stage_rc(tid * 16 + i * 8192, R, C); const int Rb = Epi::PERM ? ((R & ~31) + perm32(R & 31)) : R;
        voffA[i] = (unsigned)(R * lda + C) * 2u; voffB[i] = (unsigned)(Rb * ldb + C) * 2u; }
    const size_t kstep = (size_t)(BK * 2);
    const size_t hstepA = (size_t)HALF * lda * 2, hstepB = (size_t)HALF * ldb * 2;
    const unsigned ldsw = (unsigned)wid * 1024u;
    const int aoff = lds_byte(wr * 64 + fr, fq * 8), boff = lds_byte(wc * 32 + fr, fq * 8);
#define PG8_SA(b, h) (((b) * 2 + (h)) * HTB)
#define PG8_SB(b, h) ((4 + (b) * 2 + (h)) * HTB)
#define PG8_STAGE(bufoff, gbase, voff) do { _Pragma("unroll") for (int _i = 0; _i < 2; ++_i) \
        __builtin_amdgcn_global_load_lds((const unsigned*)((const char*)(gbase) + (voff)[_i]), (LAS unsigned*)(lds + (bufoff) + ldsw + _i * 8192), 16, 0, 0); } while (0)
#define PG8_LDA(dst, b, h) do { _Pragma("unroll") for (int m = 0; m < 4; ++m) _Pragma("unroll") for (int k = 0; k < 2; ++k) dst[m][k] = *(const LAS bf16x8*)(lds + PG8_SA(b, h) + aoff + m * 2048 + k * 1024); } while (0)
#define PG8_LDB(dst, b, h) do { _Pragma("unroll") for (int n = 0; n < 2; ++n) _Pragma("unroll") for (int k = 0; k < 2; ++k) dst[n][k] = *(const LAS bf16x8*)(lds + PG8_SB(b, h) + boff + n * 2048 + k * 1024); } while (0)
#define PG8_MMA(ai, bj, At, Bt) do { __builtin_amdgcn_s_setprio(1); _Pragma("unroll") for (int m = 0; m < 4; ++m) _Pragma("unroll") for (int n = 0; n < 2; ++n) _Pragma("unroll") for (int k = 0; k < 2; ++k) \
        acc[ai][bj][m][n] = __builtin_amdgcn_mfma_f32_16x16x32_bf16(Bt[n][k], At[m][k], acc[ai][bj][m][n], 0, 0, 0); __builtin_amdgcn_s_setprio(0); } while (0)
#define PG8_WAIT_V(n) asm volatile("s_waitcnt vmcnt(" #n ")" ::: "memory")
#define PG8_WAIT_L(n) asm volatile("s_waitcnt lgkmcnt(" #n ")" ::: "memory")
#define PG8_BAR __builtin_amdgcn_s_barrier()
#define PG8_SCHED __builtin_amdgcn_sched_barrier(0)
    Unit cur, nxt; int ui = 0;
    if (!S.next(0, cur)) return;
    f32x4 acc[2][2][4][2];
#pragma unroll
    for (int a = 0; a < 2; ++a)
#pragma unroll
        for (int b = 0; b < 2; ++b)
#pragma unroll
            for (int m = 0; m < 4; ++m)
#pragma unroll
                for (int n = 0; n < 2; ++n) acc[a][b][m][n] = (f32x4){0.f, 0.f, 0.f, 0.f};
    bf16x8 At[4][2], B0[2][2], B1[2][2];
    const char* cA = S.a_base(cur); const char* cB = S.b_base(cur);
    PG8_STAGE(PG8_SB(0, 0), cB, voffB); PG8_STAGE(PG8_SA(0, 0), cA, voffA); PG8_STAGE(PG8_SB(0, 1), cB + hstepB, voffB); PG8_STAGE(PG8_SA(0, 1), cA + hstepA, voffA);
    if (wr == 1) PG8_BAR;
    PG8_WAIT_V(4); PG8_BAR;
    PG8_STAGE(PG8_SB(1, 0), cB + kstep, voffB); PG8_STAGE(PG8_SA(1, 0), cA + kstep, voffA); PG8_STAGE(PG8_SB(1, 1), cB + hstepB + kstep, voffB);
    PG8_WAIT_V(6); PG8_BAR;
    for (;;) {
        const bool has_next = S.next(ui + 1, nxt);
        const char* nA = has_next ? S.a_base(nxt) : cA; const char* nB = has_next ? S.b_base(nxt) : cB;
        for (int t = 0; t < nt; t += 2) {
            if constexpr (Epi::MIDK) { if (t == (nt >> 1)) E.midk(acc, cur, wr, fr); }
            const bool last = (t == nt - 2);
            const char* a1 = cA + (size_t)(t + 1) * kstep;
            const char* a2 = last ? nA : cA + (size_t)(t + 2) * kstep; const char* b2 = last ? nB : cB + (size_t)(t + 2) * kstep;
            const char* a3 = a2 + kstep; const char* b3 = b2 + kstep;
            PG8_LDB(B0, 0, 0); PG8_SCHED; PG8_LDA(At, 0, 0); PG8_STAGE(PG8_SA(1, 1), a1 + hstepA, voffA);
            PG8_WAIT_L(8); PG8_BAR; PG8_WAIT_L(0); PG8_MMA(0, 0, At, B0); PG8_BAR; PG8_SCHED;
            PG8_LDB(B1, 0, 1); PG8_STAGE(PG8_SB(0, 0), b2, voffB);
            PG8_BAR; PG8_WAIT_L(0); PG8_MMA(0, 1, At, B1); PG8_BAR;
            PG8_LDA(At, 0, 1); PG8_STAGE(PG8_SA(0, 0), a2, voffA);
            PG8_BAR; PG8_WAIT_L(0); PG8_MMA(1, 0, At, B0); PG8_BAR; PG8_SCHED;
            PG8_STAGE(PG8_SB(0, 1), b2 + hstepB, voffB);
            PG8_WAIT_V(6); PG8_BAR; PG8_MMA(1, 1, At, B1); PG8_BAR;
            PG8_LDB(B0, 1, 0); PG8_SCHED; PG8_LDA(At, 1, 0); PG8_STAGE(PG8_SA(0, 1), a2 + hstepA, voffA);
            PG8_WAIT_L(8); PG8_BAR; PG8_WAIT_L(0); PG8_MMA(0, 0, At, B0); PG8_BAR; PG8_SCHED;
            PG8_LDB(B1, 1, 1); PG8_STAGE(PG8_SB(1, 0), b3, voffB);
            PG8_BAR; PG8_WAIT_L(0); PG8_MMA(0, 1, At, B1); PG8_BAR;
            PG8_LDA(At, 1, 1); PG8_STAGE(PG8_SA(1, 0), a3, voffA);
            PG8_BAR; PG8_WAIT_L(0); PG8_MMA(1, 0, At, B0); PG8_BAR; PG8_SCHED;
            PG8_STAGE(PG8_SB(1, 1), b3 + hstepB, voffB);
            PG8_WAIT_V(6); PG8_BAR; PG8_MMA(1, 1, At, B1); PG8_BAR;
        }
        E(acc, cur, wr, wc, fr, fq);
        if (!has_next) break;
#pragma unroll
        for (int a = 0; a < 2; ++a)
#pragma unroll
            for (int b = 0; b < 2; ++b)
#pragma unroll
                for (int m = 0; m < 4; ++m)
#pragma unroll
                    for (int n = 0; n < 2; ++n) acc[a][b][m][n] = (f32x4){0.f, 0.f, 0.f, 0.f};
        cur = nxt; cA = nA; cB = nB; ++ui;
    }
    PG8_WAIT_V(0);
    if (wr == 0) PG8_BAR;
    PG8_BAR;
#undef PG8_SA
#undef PG8_SB
#undef PG8_STAGE
#undef PG8_LDA
#undef PG8_LDB
#undef PG8_MMA
#undef PG8_WAIT_V
#undef PG8_WAIT_L
#undef PG8_BAR
#undef PG8_SCHED
}
}
using pg8::Unit;
__device__ __forceinline__ u32x4 pack8(const f32x4& v0, const f32x4& v1) {
    u32x4 o; o[0] = cvt_pk_bf16(v0[0], v0[1]); o[1] = cvt_pk_bf16(v0[2], v0[3]); o[2] = cvt_pk_bf16(v1[0], v1[1]); o[3] = cvt_pk_bf16(v1[2], v1[3]); return o;
}
struct EpiWin {
    static constexpr bool PERM = true; static constexpr bool MIDK = false;
    bf16_t* US; bf16_t* Q; bf16_t* KROW; bf16_t* VROW; bf16_t* VT; float* GATE;
    __device__ __forceinline__ void operator()(const f32x4 (&acc)[2][2][4][2], const Unit& u, int wr, int wc, int fr, int fq) const {
        const int row0 = u.pm * 256 + wr * 64 + fr; const int pn = u.pn;
#pragma unroll
        for (int ai = 0; ai < 2; ++ai)
#pragma unroll
            for (int m = 0; m < 4; ++m) {
                const int row = row0 + ai * 128 + m * 16;
#pragma unroll
                for (int bj = 0; bj < 2; ++bj) {
                    const f32x4 v0 = acc[ai][bj][m][0], v1 = acc[ai][bj][m][1];
                    const int cin = bj * 128 + wc * 32 + 8 * fq;
                    if (pn < 4) { *(u32x4*)(US + (size_t)row * 1024 + pn * 256 + cin) = pack8(v0, v1); }
                    else if (pn < 8) { *(u32x4*)(Q + (size_t)row * 1024 + (pn - 4) * 256 + cin) = pack8(v0 * QSCALE, v1 * QSCALE); }
                    else if (pn < 14) {
                        const int kvi = pn - 8, branch = kvi >> 1, kvsel = kvi & 1, g = bj, d0 = wc * 32 + 8 * fq;
                        if (kvsel == 0) { *(u32x4*)(KROW + ((size_t)(branch * 2 + g) * L_ + row) * 128 + d0) = pack8(v0, v1); }
                        else if (branch == 0) { *(u32x4*)(VROW + ((size_t)g * L_ + row) * 128 + d0) = pack8(v0, v1); }
                        else {
                            const int prow = ((row & ~12) | ((row & 4) << 1) | ((row & 8) >> 1));
                            bf16_t* vt = VT + ((size_t)((branch - 1) * 2 + g) * 128 + d0) * L_ + prow;
#pragma unroll
                            for (int e = 0; e < 4; ++e) { vt[(size_t)e * L_] = f2bf(v0[e]); vt[(size_t)(e + 4) * L_] = f2bf(v1[e]); }
                        }
                    } else {
                        if (cin < 24) {
                            float* gp = GATE + (size_t)row * 24 + cin;
                            f32x4 s0, s1;
#pragma unroll
                            for (int e = 0; e < 4; ++e) { s0[e] = sigmoidf_(v0[e]); s1[e] = sigmoidf_(v1[e]); }
                            *(f32x4*)gp = s0; *(f32x4*)(gp + 4) = s1;
                        }
                    }
                }
            }
    }
};
struct EpiGlu {
    static constexpr bool PERM = true; static constexpr bool MIDK = false;
    const bf16_t* Z; const float* bglu; bf16_t* Y; float* stsp;
    __device__ __forceinline__ void operator()(const f32x4 (&acc)[2][2][4][2], const Unit& u, int wr, int wc, int fr, int fq) const {
        const int row0 = u.pm * 256 + wr * 64 + fr;
        float ss[2][4];
#pragma unroll
        for (int ai = 0; ai < 2; ++ai)
#pragma unroll
            for (int m = 0; m < 4; ++m) ss[ai][m] = 0.f;
#pragma unroll
        for (int bj = 0; bj < 2; ++bj) {
            const int col = u.pn * 256 + bj * 128 + wc * 32 + 8 * fq;
            const f32x4 b0 = *(const f32x4*)(bglu + col), b1 = *(const f32x4*)(bglu + col + 4);
#pragma unroll
            for (int ai = 0; ai < 2; ++ai)
#pragma unroll
                for (int m = 0; m < 4; ++m) {
                    const int row = row0 + ai * 128 + m * 16;
                    const u32x4 zz = *(const u32x4*)(Z + (size_t)row * 1024 + col);
                    const f32x4 v0 = acc[ai][bj][m][0] + b0, v1 = acc[ai][bj][m][1] + b1;
                    f32x4 o0, o1;
                    o0[0] = bflo(zz[0]) * sigmoidf_(v0[0]); o0[1] = bfhi(zz[0]) * sigmoidf_(v0[1]); o0[2] = bflo(zz[1]) * sigmoidf_(v0[2]); o0[3] = bfhi(zz[1]) * sigmoidf_(v0[3]);
                    o1[0] = bflo(zz[2]) * sigmoidf_(v1[0]); o1[1] = bfhi(zz[2]) * sigmoidf_(v1[1]); o1[2] = bflo(zz[3]) * sigmoidf_(v1[2]); o1[3] = bfhi(zz[3]) * sigmoidf_(v1[3]);
                    *(u32x4*)(Y + (size_t)row * 2048 + col) = pack8(o0, o1);
                    ss[ai][m] += (o0[0] * o0[0] + o0[1] * o0[1]) + (o0[2] * o0[2] + o0[3] * o0[3]) + (o1[0] * o1[0] + o1[1] * o1[1]) + (o1[2] * o1[2] + o1[3] * o1[3]);
                }
        }
#pragma unroll
        for (int ai = 0; ai < 2; ++ai)
#pragma unroll
            for (int m = 0; m < 4; ++m) {
                float s = ss[ai][m];
                s += __shfl_xor(s, 16); s += __shfl_xor(s, 32);
                if (fq == 0) stsp[(size_t)(row0 + ai * 128 + m * 16) * 16 + u.pn * 4 + wc] = s;
            }
    }
};
struct EpiWout {
    static constexpr bool PERM = true; static constexpr bool MIDK = true;
    const float* X; const float* g1; const float* f2; bf16_t* X1; bf16_t* A2; float* st2p; const float* rsa;
    __device__ __forceinline__ void midk(f32x4 (&acc)[2][2][4][2], const Unit& u, int, int) const {
        int tz = threadIdx.x; asm volatile("" : "+v"(tz));
        const int row0 = u.pm * 256 + ((tz >> 8) & 1) * 64 + (tz & 15);
#pragma unroll
        for (int ai = 0; ai < 2; ++ai)
#pragma unroll
            for (int m = 0; m < 4; ++m) {
                const float r = rsa[(size_t)(row0 + ai * 128 + m * 16) * 2];
#pragma unroll
                for (int bj = 0; bj < 2; ++bj)
#pragma unroll
                    for (int n = 0; n < 2; ++n) acc[ai][bj][m][n] *= r;
            }
    }
    __device__ __forceinline__ void operator()(const f32x4 (&acc)[2][2][4][2], const Unit& u, int, int, int, int) const {
        int tz = threadIdx.x; asm volatile("" : "+v"(tz));
        const int wr = (tz >> 8) & 1, wc = (tz >> 6) & 3, fr = tz & 15, fq = (tz >> 4) & 3;
        const int row0 = u.pm * 256 + wr * 64 + fr, col0 = u.pn * 256 + wc * 32 + 8 * fq;
        float ss[2][4], ra[2][4];
#pragma unroll
        for (int ai = 0; ai < 2; ++ai)
#pragma unroll
            for (int m = 0; m < 4; ++m) { ss[ai][m] = 0.f; ra[ai][m] = rsa[(size_t)(row0 + ai * 128 + m * 16) * 2 + 1]; }
#pragma unroll
        for (int bj = 0; bj < 2; ++bj) {
            const int col = col0 + bj * 128;
            const f32x4 g0 = *(const f32x4*)(g1 + col), g4 = *(const f32x4*)(g1 + col + 4), f0 = *(const f32x4*)(f2 + col), f4 = *(const f32x4*)(f2 + col + 4);
#pragma unroll
            for (int ai = 0; ai < 2; ++ai)
#pragma unroll
                for (int m = 0; m < 4; ++m) {
                    const size_t off = (size_t)(row0 + ai * 128 + m * 16) * 2048 + col;
                    const f32x4 x0 = *(const f32x4*)(X + off), x4 = *(const f32x4*)(X + off + 4);
                    const f32x4 v0 = x0 + g0 * (acc[ai][bj][m][0] * ra[ai][m]), v1 = x4 + g4 * (acc[ai][bj][m][1] * ra[ai][m]);
                    *(u32x4*)(X1 + off) = pack8(v0, v1);
                    *(u32x4*)(A2 + off) = pack8(v0 * f0, v1 * f4);
                    ss[ai][m] += (v0[0] * v0[0] + v0[1] * v0[1]) + (v0[2] * v0[2] + v0[3] * v0[3]) + (v1[0] * v1[0] + v1[1] * v1[1]) + (v1[2] * v1[2] + v1[3] * v1[3]);
                }
        }
#pragma unroll
        for (int ai = 0; ai < 2; ++ai)
#pragma unroll
            for (int m = 0; m < 4; ++m) {
                float s = ss[ai][m];
                s += __shfl_xor(s, 16); s += __shfl_xor(s, 32);
                if (fq == 0) st2p[(size_t)(row0 + ai * 128 + m * 16) * 32 + u.pn * 4 + wc] = s;
            }
    }
};
struct EpiQ {
    static constexpr bool PERM = true; static constexpr bool MIDK = false;
    bf16_t* O; const float* rstd2; const float* cq;
    __device__ __forceinline__ void operator()(const f32x4 (&acc)[2][2][4][2], const Unit& u, int wr, int wc, int fr, int fq) const {
        const int row0 = u.pm * 256 + wr * 64 + fr, col0 = u.pn * 256 + wc * 32 + 8 * fq;
        float rs[2][4];
#pragma unroll
        for (int ai = 0; ai < 2; ++ai)
#pragma unroll
            for (int m = 0; m < 4; ++m) rs[ai][m] = rstd2[row0 + ai * 128 + m * 16];
#pragma unroll
        for (int bj = 0; bj < 2; ++bj) {
            const int col = col0 + bj * 128;
            const f32x4 c0 = *(const f32x4*)(cq + col), c4 = *(const f32x4*)(cq + col + 4);
#pragma unroll
            for (int ai = 0; ai < 2; ++ai)
#pragma unroll
                for (int m = 0; m < 4; ++m)
                    *(u32x4*)(O + (size_t)(row0 + ai * 128 + m * 16) * 2048 + col) = pack8(acc[ai][bj][m][0] * rs[ai][m] + c0, acc[ai][bj][m][1] * rs[ai][m] + c4);
        }
    }
};
template <class Sched>
__device__ __forceinline__ void rstd2_prepass(const Sched& S, const float* st2p, float* rstd2, int tid) {
    Unit u;
    for (int i = 0; S.next(i, u); ++i)
        if (tid < 256) {
            const int row = u.pm * 256 + tid; const f32x4* p = (const f32x4*)(st2p + (size_t)row * 32);
            float s = 0.f;
#pragma unroll
            for (int k = 0; k < 8; ++k) { const f32x4 v = p[k]; s += (v[0] + v[1]) + (v[2] + v[3]); }
            rstd2[row] = rsqrtf(s * (1.f / 2048.f) + 1e-6f);
        }
    __syncthreads();
}
struct EpiSlab {
    static constexpr bool PERM = false; static constexpr bool MIDK = false;
    float* SL;
    __device__ __forceinline__ void operator()(const f32x4 (&acc)[2][2][4][2], const Unit& u, int wr, int wc, int fr, int fq) const {
        float* base = SL + (size_t)u.z * 2048 * 256;
        const int row0 = u.pm * 256 + wr * 64 + fr, col0 = wc * 32 + 4 * fq;
#pragma unroll
        for (int ai = 0; ai < 2; ++ai)
#pragma unroll
            for (int m = 0; m < 4; ++m)
#pragma unroll
                for (int bj = 0; bj < 2; ++bj)
#pragma unroll
                    for (int n = 0; n < 2; ++n)
                        *(f32x4*)(base + (size_t)(row0 + ai * 128 + m * 16) * 256 + col0 + bj * 128 + n * 16) = acc[ai][bj][m][n];
    }
};
struct CmpOrder {
    const bf16_t* KROW; const bf16_t* VROW; const bf16_t* W1; int lda, ldb, K; int G, c;
    __device__ bool next(int i, Unit& u) const {
        const int x = i * G + c; if (x >= 256) return false;
        const int kvsel = x >> 7, pm = (x & 127) >> 4, ks = x & 15; u.pm = pm; u.pn = 0; u.z = kvsel * 16 + ks; return true;
    }
    __device__ __forceinline__ const char* a_base(const Unit& u) const { return (const char*)(((u.z >> 4) ? VROW : KROW) + (size_t)u.pm * 256 * 2048 + (u.z & 15) * 256); }
    __device__ __forceinline__ const char* b_base(const Unit& u) const { return (const char*)(W1 + (size_t)(u.z >> 4) * 256 * 4096 + (u.z & 15) * 256); }
};
template <class Sched>
__device__ __forceinline__ void rsa_prepass(const Sched& S, const float* stsp, const float* stap, float* rsa, int tid) {
    Unit u;
    for (int i = 0; S.next(i, u); ++i)
        if (tid < 256) {
            const int row = u.pm * 256 + tid; const f32x4* p = (const f32x4*)(stsp + (size_t)row * 16);
            float s = 0.f;
#pragma unroll
            for (int k = 0; k < 4; ++k) { const f32x4 v = p[k]; s += (v[0] + v[1]) + (v[2] + v[3]); }
            const f32x2 q = *(const f32x2*)(stap + (size_t)row * 2);
            const float rs = rsqrtf(s * (1.f / 1024.f) + 1e-6f), ra = rsqrtf((q[0] + q[1]) * (1.f / 1024.f) + 1e-6f);
            f32x2 o; o[0] = rs / ra; o[1] = ra;
            *(f32x2*)(rsa + (size_t)row * 2) = o;
        }
    __syncthreads();
}
struct Ctx { int bid, nb, tid, wave, lane; LAS unsigned char* lds; };

__device__ __forceinline__ void p0_cond(const Args& a, const Ctx& c) {
    const float* cv = a.in[1]; const float* w = a.in[2]; float* condp = (float*)(a.ws + WS_CONDP);
    for (int u = c.bid * 8 + c.wave; u < 1536; u += c.nb * 8) {
        const int cc = u % 48, kc = u / 48;
        const float* wp = w + (size_t)(kc * 64) * NADA + cc * 256 + c.lane * 4;
        f32x4 acc = {0.f, 0.f, 0.f, 0.f};
#pragma unroll 16
        for (int k = 0; k < 64; ++k) { const float x = cv[kc * 64 + k]; const float s = x / (1.f + __expf(-x)); acc += s * *(const f32x4*)(wp + (size_t)k * NADA); }
        *(f32x4*)(condp + (size_t)kc * NADA + cc * 256 + c.lane * 4) = acc;
    }
}
struct TDesc { const float* src; bf16_t* dst; const float* ks0; const float* ks1; int K, N, nkt, nt, kt; };
__device__ __forceinline__ TDesc conv_decode(const Args& a, int tix) {
    TDesc d; d.ks0 = nullptr; d.ks1 = nullptr; int local;
    if (tix < 1920) { local = tix; d.src = a.in[6]; d.dst = (bf16_t*)(a.ws + WS_WIN); d.K = 2048; d.N = DIN; }
    else if (tix < 2176) { local = tix - 1920; d.src = a.in[18]; d.dst = (bf16_t*)(a.ws + WS_WGLU); d.K = 1024; d.N = 1024; }
    else if (tix < 3200) { local = tix - 2176; d.src = a.in[7]; d.dst = (bf16_t*)(a.ws + WS_WOUT); d.K = 2048; d.N = 2048; d.ks0 = a.in[8]; d.ks1 = a.in[9]; }
    else if (tix < 4224) { local = tix - 3200; d.src = a.in[27]; d.dst = (bf16_t*)(a.ws + WS_WQ); d.K = 2048; d.N = 2048; }
    else if (tix < 4480) { local = tix - 4224; d.src = a.in[21]; d.dst = (bf16_t*)(a.ws + WS_W1); d.K = 4096; d.N = 256; }
    else if (tix < 4736) { local = tix - 4480; d.src = a.in[24]; d.dst = (bf16_t*)(a.ws + WS_W1) + 256 * 4096; d.K = 4096; d.N = 256; }
    else if (tix < 4744) { local = tix - 4736; d.src = a.in[22]; d.dst = (bf16_t*)(a.ws + WS_W2); d.K = 256; d.N = 128; }
    else { local = tix - 4744; d.src = a.in[25]; d.dst = (bf16_t*)(a.ws + WS_W2) + 128 * 256; d.K = 256; d.N = 128; }
    d.nkt = d.K / 64; d.nt = local / d.nkt; d.kt = local % d.nkt;
    return d;
}
constexpr int CONV_TILES = 4752;
__device__ __forceinline__ void conv_T_all(const Args& a, const Ctx& c) {
    LAS float* tile = (LAS float*)c.lds;
    const int r = c.tid >> 4, c4 = c.tid & 15;
    f32x4 b0[2], b1[2], b2[2]; float s0[2] = {1.f, 1.f}, s1[2] = {1.f, 1.f}, s2[2] = {1.f, 1.f};
#define CONVT_LD(buf, sc, tix_) do { if ((tix_) < CONV_TILES) { const TDesc d_ = conv_decode(a, (tix_)); const int n_ = d_.nt * 64 + 4 * c4; \
        _Pragma("unroll") for (int i = 0; i < 2; ++i) { const int k_ = d_.kt * 64 + r + 32 * i; buf[i] = (f32x4){0.f, 0.f, 0.f, 0.f}; if (n_ < d_.N) buf[i] = *(const f32x4*)(d_.src + (size_t)k_ * d_.N + n_); \
            sc[i] = 1.f; if (d_.ks0) sc[i] = k_ < 1024 ? d_.ks0[k_] : d_.ks1[k_ - 1024]; } } } while (0)
#define CONVT_DO(buf, sc, tix_) do { if ((tix_) < CONV_TILES) { const TDesc d_ = conv_decode(a, (tix_)); \
        _Pragma("unroll") for (int i = 0; i < 2; ++i) { LAS float* tp = tile + (r + 32 * i) * 65 + 4 * c4; tp[0] = buf[i][0] * sc[i]; tp[1] = buf[i][1] * sc[i]; tp[2] = buf[i][2] * sc[i]; tp[3] = buf[i][3] * sc[i]; } \
        __syncthreads(); \
        { const int n = c.tid >> 3, kq = c.tid & 7; float w[8]; \
          _Pragma("unroll") for (int j = 0; j < 8; ++j) w[j] = tile[(kq * 8 + j) * 65 + n]; \
          u32x4 o; o[0] = cvt_pk_bf16(w[0], w[1]); o[1] = cvt_pk_bf16(w[2], w[3]); o[2] = cvt_pk_bf16(w[4], w[5]); o[3] = cvt_pk_bf16(w[6], w[7]); \
          *(u32x4*)(d_.dst + (size_t)(d_.nt * 64 + n) * d_.K + d_.kt * 64 + kq * 8) = o; } \
        __syncthreads(); } } while (0)
    int tix = c.bid;
    CONVT_LD(b0, s0, tix); CONVT_LD(b1, s1, tix + c.nb);
    for (; tix < CONV_TILES; tix += 3 * c.nb) {
        CONVT_LD(b2, s2, tix + 2 * c.nb); CONVT_DO(b0, s0, tix);
        CONVT_LD(b0, s0, tix + 3 * c.nb); CONVT_DO(b1, s1, tix + c.nb);
        CONVT_LD(b1, s1, tix + 4 * c.nb); CONVT_DO(b2, s2, tix + 2 * c.nb);
    }
#undef CONVT_LD
#undef CONVT_DO
}
__device__ __forceinline__ void conv_fp4rows(const float* src, unsigned char* dst4, float* scl, int rows, const Ctx& c) {
    const int stride = c.nb * 8;
    f32x4 b0[8], b1[8], b2[8];
#define FP4R_LD(buf, r_) do { if ((r_) < rows) { _Pragma("unroll") for (int j = 0; j < 8; ++j) buf[j] = *(const f32x4*)(src + (size_t)(r_) * 2048 + c.lane * 32 + j * 4); } } while (0)
#define FP4R_DO(buf, r_) do { if ((r_) < rows) { \
        float mx = 0.f; \
        _Pragma("unroll") for (int j = 0; j < 8; ++j) mx = fmaxf(mx, fmaxf(fmaxf(fabsf(buf[j][0]), fabsf(buf[j][1])), fmaxf(fabsf(buf[j][2]), fabsf(buf[j][3])))); \
        mx = wave_max(mx); \
        const float s = mx > 0.f ? 6.f / mx : 1.f; \
        if (c.lane == 0) scl[(size_t)(r_) * 4] = mx > 0.f ? mx * (1.f / 6.f) : 1.f; \
        u32x4 pk = {0u, 0u, 0u, 0u}; \
        _Pragma("unroll") for (int d = 0; d < 4; ++d) {              \
            unsigned wq = 0u; \
            wq = fp4_pk<0>(wq, buf[2 * d][0] * s, buf[2 * d][1] * s); wq = fp4_pk<1>(wq, buf[2 * d][2] * s, buf[2 * d][3] * s); \
            wq = fp4_pk<2>(wq, buf[2 * d + 1][0] * s, buf[2 * d + 1][1] * s); wq = fp4_pk<3>(wq, buf[2 * d + 1][2] * s, buf[2 * d + 1][3] * s); \
            pk[d] = wq; } \
        *(u32x4*)(dst4 + (size_t)(r_) * 1024 + c.lane * 16) = pk; } } while (0)
    int row = c.bid * 8 + c.wave;
    FP4R_LD(b0, row); FP4R_LD(b1, row + stride);
    for (; row < rows; row += 3 * stride) {
        FP4R_LD(b2, row + 2 * stride); FP4R_DO(b0, row);
        FP4R_LD(b0, row + 3 * stride); FP4R_DO(b1, row + stride);
        FP4R_LD(b1, row + 4 * stride); FP4R_DO(b2, row + 2 * stride);
    }
#undef FP4R_LD
#undef FP4R_DO
}
__device__ __forceinline__ void conv_E(const float* src, bf16_t* dst, size_t n8, const Ctx& c) {
    const size_t stride = (size_t)c.nb * NTHREADS;
    for (size_t i = (size_t)c.bid * NTHREADS + c.tid; i < n8; i += stride) {
        const f32x4 x = *(const f32x4*)(src + i * 8), y = *(const f32x4*)(src + i * 8 + 4);
        *(u32x4*)(dst + i * 8) = pack8(x, y);
    }
}
__device__ __forceinline__ int t5_bucket(int n) {
    if (n < 16) return n;
    const float scaled = logf((float)n / 16.f) / logf(64.f);
    const int large = 16 + (int)(scaled * 16.f);
    return large < 31 ? large : 31;
}
__device__ __forceinline__ void p0_tb(const Args& a, const Ctx& c) {
    float* tb = (float*)(a.ws + WS_TB); const float* rb = a.in[26];
    for (int i = c.bid * NTHREADS + c.tid; i < 8 * TBN; i += c.nb * NTHREADS) { const int head = i / TBN, dist = i % TBN; tb[i] = rb[t5_bucket(dist) * 8 + head] * LOG2E; }
}
__device__ __forceinline__ void p0_bpe(const Args& a, const Ctx& c, int part) {
    const int n = c.tid & 255, kv = c.tid >> 8;
    const float* pe = a.in[kv ? 23 : 20]; const float* w1 = a.in[kv ? 24 : 21]; float* bpep = (float*)(a.ws + WS_BPEP);
    float s = 0.f;
#pragma unroll 16
    for (int k = part * 128; k < part * 128 + 128; ++k) s += pe[k] * w1[(size_t)k * 256 + n];
    bpep[(part * 2 + kv) * 256 + n] = s;
}
__device__ __forceinline__ void p0_s5(const Args& a, const Ctx& c, int g, int part) {
    LAS float* ar = (LAS float*)c.lds;
    LAS float* ai = ar + 17 * 64;
    LAS float* bbr = ai + 17 * 64;
    LAS float* bbi = bbr + 1024;
    LAS float* cr = bbi + 1024;
    LAS float* ci = cr + 1024;
    LAS float* kd = ci + 1024;
    const int tid = c.tid;
    if (tid < 64) {
        const int p = tid; const float dt = expf(a.in[12][g]); const float lr = a.in[10][g * 64 + p], li = a.in[11][g * 64 + p];
        for (int d = 0; d <= 16; ++d) { const float mag = expf(lr * dt * (float)d), ang = li * dt * (float)d; ar[d * 64 + p] = mag * cosf(ang); ai[d * 64 + p] = mag * sinf(ang); }
        const float nr = ar[64 + p] - 1.f, ni = ai[64 + p], den = lr * lr + li * li;
        const float wre = (nr * lr + ni * li) / den, wim = (ni * lr - nr * li) / den;
        for (int h = 0; h < 16; ++h) { const float br = a.in[13][(g * 64 + p) * 16 + h], bi = a.in[14][(g * 64 + p) * 16 + h]; bbr[p * 16 + h] = wre * br - wim * bi; bbi[p * 16 + h] = wre * bi + wim * br; }
        if (part == 0) {
        float* s5p = (float*)(a.ws + WS_S5P);
        float xr = ar[16 * 64 + p], xi = ai[16 * 64 + p];
        s5p[(g * 64 + p) * 2] = xr; s5p[(g * 64 + p) * 2 + 1] = xi;
        for (int s = 0; s < 8; ++s) { const float tr = xr * xr - xi * xi, ti = 2.f * xr * xi; xr = tr; xi = ti; }
        s5p[64 * 64 * 2 + (g * 64 + p) * 2] = xr; s5p[64 * 64 * 2 + (g * 64 + p) * 2 + 1] = xi;
        }
    }
    for (int e = tid; e < 1024; e += NTHREADS) { cr[e] = a.in[15][g * 1024 + e]; ci[e] = a.in[16][g * 1024 + e]; }
    __syncthreads();
    for (int e = tid; e < 1024 * (part + 1); e += NTHREADS) {
        const int d = e >> 8, h1 = (e >> 4) & 15, h = e & 15; float s = 0.f;
        for (int p = 0; p < 64; ++p) { const float Cr = cr[h1 * 64 + p], Ci = ci[h1 * 64 + p], Ar = ar[d * 64 + p], Ai = ai[d * 64 + p];
            const float Gr = Cr * Ar - Ci * Ai, Gi = Cr * Ai + Ci * Ar; s += Gr * bbr[p * 16 + h] - Gi * bbi[p * 16 + h]; }
        if (d == 0 && h1 == h) s += a.in[17][g * 16 + h];
        kd[e] = s;
    }
    __syncthreads();
    bf16_t* MT = (bf16_t*)(a.ws + WS_S5MT) + (size_t)g * 65536;
    bf16_t* WE = (bf16_t*)(a.ws + WS_S5WE) + (size_t)g * 32768;
    bf16_t* WC = (bf16_t*)(a.ws + WS_S5WC) + (size_t)g * 32768;
    for (int e = 16384 * part + tid; e < 16384 * (part + 1); e += NTHREADS) { const int n = e >> 8, k = e & 255, j = n >> 4, h1 = n & 15, i = k >> 4, h = k & 15;
        MT[e] = f2bf(i <= j ? kd[(j - i) * 256 + h1 * 16 + h] : 0.f); }
    for (int e = 8192 * part + tid; e < 8192 * (part + 1); e += NTHREADS) { const int n = e >> 8, k = e & 255, cc = n >> 6, p = n & 63, i = k >> 4, h = k & 15;
        const float Ar = ar[(15 - i) * 64 + p], Ai = ai[(15 - i) * 64 + p], Br = bbr[p * 16 + h], Bi = bbi[p * 16 + h];
        WE[e] = f2bf(cc ? (Ar * Bi + Ai * Br) : (Ar * Br - Ai * Bi)); }
    for (int e = 8192 * part + tid; e < 8192 * (part + 1); e += NTHREADS) { const int n = e >> 7, k = e & 127, j = n >> 4, h1 = n & 15, cc = k >> 6, p = k & 63;
        const float Cr = cr[h1 * 64 + p], Ci = ci[h1 * 64 + p], Ar = ar[(j + 1) * 64 + p], Ai = ai[(j + 1) * 64 + p];
        WC[e] = f2bf(cc ? -(Cr * Ai + Ci * Ar) : (Cr * Ar - Ci * Ai)); }
    __syncthreads();
}
__device__ __forceinline__ void p0_prologue(const Args& a, const Ctx& c) {
    for (int u = c.bid; u < 256; u += c.nb) p0_s5(a, c, u >> 2, u & 3);
    for (int u = 0; u < 32; ++u) if (c.bid == (8 * u + 7) % c.nb) p0_bpe(a, c, u);
    p0_tb(a, c);
    p0_cond(a, c);
    conv_T_all(a, c);
    conv_E(a.in[28], (bf16_t*)(a.ws + WS_PK), 128 * 128 / 8, c);
    conv_E(a.in[29], (bf16_t*)(a.ws + WS_PK) + 128 * 128, 128 * 128 / 8, c);
    conv_fp4rows(a.in[30], a.ws + WS_PU, (float*)(a.ws + WS_PSC), 16384, c);
    conv_fp4rows(a.in[31], a.ws + WS_PV, (float*)(a.ws + WS_PSC) + 2, 16384, c);
}

__device__ __forceinline__ void norm_rows(const float* X, bf16_t* O, LAS const float* Ab, LAS const float* Bb, const Ctx& c, int row0 = 0, int nrows = L_) {
    for (int t = row0 + c.bid * 8 + c.wave; t < row0 + nrows; t += c.nb * 8) {
        const float* xr = X + (size_t)t * 2048 + c.lane * 4;
        f32x4 v[8]; float ss = 0.f;
#pragma unroll
        for (int j = 0; j < 8; ++j) { v[j] = *(const f32x4*)(xr + j * 256); ss += v[j][0] * v[j][0] + v[j][1] * v[j][1] + v[j][2] * v[j][2] + v[j][3] * v[j][3]; }
        ss = wave_sum(ss);
        const float rstd = rsqrtf(ss * (1.f / 2048.f) + 1e-6f);
#pragma unroll
        for (int j = 0; j < 8; ++j) {
            const int col = j * 256 + c.lane * 4;
            const f32x4 A = *(const LAS f32x4*)(Ab + col), B = *(const LAS f32x4*)(Bb + col);
            const f32x4 o = v[j] * rstd * A + B;
            u32x2 w; w[0] = cvt_pk_bf16(o[0], o[1]); w[1] = cvt_pk_bf16(o[2], o[3]);
            *(u32x2*)(O + (size_t)t * 2048 + col) = w;
        }
    }
}
__device__ __forceinline__ void norm_rows_bf16(const bf16_t* X, bf16_t* O, LAS const float* Ab, LAS const float* Bb, const Ctx& c, int row0, int nrows) {
    for (int t = row0 + c.bid * 8 + c.wave; t < row0 + nrows; t += c.nb * 8) {
        const bf16_t* xr = X + (size_t)t * 2048 + c.lane * 8;
        u32x4 w[4]; float ss = 0.f;
#pragma unroll
        for (int j = 0; j < 4; ++j) { w[j] = *(const u32x4*)(xr + j * 512);
#pragma unroll
            for (int e = 0; e < 4; ++e) { const float a0 = bflo(w[j][e]), a1 = bfhi(w[j][e]); ss += a0 * a0 + a1 * a1; } }
        ss = wave_sum(ss);
        const float rstd = rsqrtf(ss * (1.f / 2048.f) + 1e-6f);
#pragma unroll
        for (int j = 0; j < 4; ++j) {
            const int col = j * 512 + c.lane * 8;
            const f32x4 A0 = *(const LAS f32x4*)(Ab + col), A1 = *(const LAS f32x4*)(Ab + col + 4), B0 = *(const LAS f32x4*)(Bb + col), B1 = *(const LAS f32x4*)(Bb + col + 4);
            f32x4 o0, o1;
#pragma unroll
            for (int e = 0; e < 2; ++e) { o0[2 * e] = bflo(w[j][e]) * rstd * A0[2 * e] + B0[2 * e]; o0[2 * e + 1] = bfhi(w[j][e]) * rstd * A0[2 * e + 1] + B0[2 * e + 1];
                o1[2 * e] = bflo(w[j][2 + e]) * rstd * A1[2 * e] + B1[2 * e]; o1[2 * e + 1] = bfhi(w[j][2 + e]) * rstd * A1[2 * e + 1] + B1[2 * e + 1]; }
            *(u32x4*)(O + (size_t)t * 2048 + col) = pack8(o0, o1);
        }
    }
}
__device__ __forceinline__ float cond_from_partials(const float* condp, const float* b_ada, int j) {
    float s = b_ada[j];
#pragma unroll 8
    for (int k = 0; k < 32; ++k) s += condp[(size_t)k * NADA + j];
    return s;
}
__device__ __forceinline__ void p1_hnorm(const Args& a, const Ctx& c) {
    const float* condp = (const float*)(a.ws + WS_CONDP); float* cond = (float*)(a.ws + WS_COND);
    for (int j = c.bid * NTHREADS + c.tid; j < NADA; j += c.nb * NTHREADS) cond[j] = cond_from_partials(condp, a.in[3], j);
    { float* F2 = (float*)(a.ws + WS_F2);
      for (int j = c.bid * NTHREADS + c.tid; j < 2048; j += c.nb * NTHREADS) F2[j] = a.in[5][j] * (1.f + cond_from_partials(condp, a.in[3], 4 * 2048 + j)); }
    LAS float* Ab = (LAS float*)c.lds; LAS float* Bb = Ab + 2048;
    for (int col = c.tid; col < 2048; col += NTHREADS) {
        Ab[col] = a.in[4][col] * (1.f + cond_from_partials(condp, a.in[3], 2048 + col)); Bb[col] = cond_from_partials(condp, a.in[3], col); }
    __syncthreads();
    norm_rows(a.in[0], (bf16_t*)(a.ws + WS_H), Ab, Bb, c);
}
__device__ __forceinline__ void p_cqce(const Args& a, const Ctx& c) {
    const float* sh2 = (const float*)(a.ws + WS_COND) + 3 * 2048;
    float s[32];
#pragma unroll
    for (int k = 0; k < 8; ++k) { const f32x4 v = *(const f32x4*)(sh2 + c.lane * 32 + k * 4); s[4 * k] = v[0]; s[4 * k + 1] = v[1]; s[4 * k + 2] = v[2]; s[4 * k + 3] = v[3]; }
    const bf16_t* WQ = (const bf16_t*)(a.ws + WS_WQ); float* cq = (float*)(a.ws + WS_CQ);
    for (int n = c.bid * 8 + c.wave; n < 2048; n += c.nb * 8) {
        u32x4 w[4];
#pragma unroll
        for (int k = 0; k < 4; ++k) w[k] = *(const u32x4*)(WQ + (size_t)n * 2048 + c.lane * 32 + k * 8);
        float d = 0.f;
#pragma unroll
        for (int k = 0; k < 4; ++k)
#pragma unroll
            for (int e = 0; e < 4; ++e) d += bflo(w[k][e]) * s[k * 8 + 2 * e] + bfhi(w[k][e]) * s[k * 8 + 2 * e + 1];
        d = wave_sum(d);
        if (c.lane == 0) cq[n] = d;
    }
    const unsigned char* PU = a.ws + WS_PU; float* psc = (float*)(a.ws + WS_PSC);
    for (int e0 = (c.bid * 8 + c.wave) * 4; e0 < 16384; e0 += c.nb * 8 * 4) {
        u32x4 uw[4];
#pragma unroll
        for (int i = 0; i < 4; ++i) uw[i] = *(const u32x4*)(PU + (size_t)(e0 + i) * 1024 + c.lane * 16);
#pragma unroll
        for (int i = 0; i < 4; ++i) {
            float d0 = 0.f, d1 = 0.f;
#pragma unroll
            for (int dw = 0; dw < 4; ++dw) { const f32x2 f0 = fp4_unpk<0>(uw[i][dw]), f1 = fp4_unpk<1>(uw[i][dw]), f2 = fp4_unpk<2>(uw[i][dw]), f3 = fp4_unpk<3>(uw[i][dw]);
                d0 += f0[0] * s[8 * dw] + f1[0] * s[8 * dw + 2] + f2[0] * s[8 * dw + 4] + f3[0] * s[8 * dw + 6];
                d1 += f0[1] * s[8 * dw + 1] + f1[1] * s[8 * dw + 3] + f2[1] * s[8 * dw + 5] + f3[1] * s[8 * dw + 7]; }
            const float d = wave_sum(d0 + d1);
            if (c.lane == 0) psc[(size_t)(e0 + i) * 4 + 1] = psc[(size_t)(e0 + i) * 4] * d;
        }
    }
}
constexpr int S5_US = 0, S5_ES = 33792, S5_SS = 67584, S5_TS = 84992;
template <int PASS>
__device__ __forceinline__ void s5_item(const Args& a, const Ctx& c, int g, int seg) {
    LAS unsigned char* lds = c.lds;
    int tid = c.tid; asm volatile("" : "+v"(tid));
    const int wave = c.wave, lane = tid & 63, r = lane & 15, q = lane >> 4;
    const bf16_t* U = (const bf16_t*)(a.ws + WS_US);
    const bf16_t* MT = (const bf16_t*)(a.ws + WS_S5MT) + (size_t)g * 65536;
    const bf16_t* WE = (const bf16_t*)(a.ws + WS_S5WE) + (size_t)g * 32768;
    const bf16_t* WC = (const bf16_t*)(a.ws + WS_S5WC) + (size_t)g * 32768;
    const float* s5p = (const float*)(a.ws + WS_S5P);
    float* F = (float*)(a.ws + WS_S5F) + (size_t)g * 4 * 128;
    bf16_t* Z = (bf16_t*)(a.ws + WS_Z);
    bf16x8 bE[8];
#pragma unroll
    for (int ks = 0; ks < 8; ++ks) bE[ks] = *(const bf16x8*)(WE + (size_t)(16 * wave + r) * 256 + 32 * ks + 8 * q);
    bf16x8 bM[2][8], bC[2][4];
    if (PASS == 1) {
#pragma unroll
        for (int nt = 0; nt < 2; ++nt)
#pragma unroll
            for (int ks = 0; ks < 4; ++ks) bC[nt][ks] = *(const bf16x8*)(WC + (size_t)(16 * (2 * wave + nt) + r) * 128 + 32 * ks + 8 * q);
#pragma unroll
        for (int nt = 0; nt < 2; ++nt)
#pragma unroll
            for (int ks = 0; ks < 8; ++ks) bM[nt][ks] = *(const bf16x8*)(MT + (size_t)(16 * (2 * wave + nt) + r) * 256 + 32 * ks + 8 * q);
    }
    float sr = 0.f, si = 0.f;
    const float a16r = s5p[(g * 64 + lane) * 2], a16i = s5p[(g * 64 + lane) * 2 + 1];
    float a128r = a16r, a128i = a16i;
#pragma unroll
    for (int s = 0; s < 3; ++s) { const float tr = a128r * a128r - a128i * a128i, ti = 2.f * a128r * a128i; a128r = tr; a128i = ti; }
    if (PASS == 1) { const float br = s5p[8192 + (g * 64 + lane) * 2], bi = s5p[8192 + (g * 64 + lane) * 2 + 1];
        for (int s = 0; s < seg; ++s) { const float fr_ = F[s * 128 + lane], fi_ = F[s * 128 + 64 + lane]; const float nr = br * sr - bi * si + fr_, ni = br * si + bi * sr + fi_; sr = nr; si = ni; } }
    for (int sb = 0; sb < 4; ++sb) {
        const int tok0 = seg * 4096 + sb * 1024;
#pragma unroll
        for (int i = 0; i < 4; ++i) { const int ch = tid + NTHREADS * i, token = ch >> 1, half = ch & 1;
            const u32x4 v = *(const u32x4*)(U + (size_t)(tok0 + token) * 1024 + g * 16 + half * 8);
            *(LAS u32x4*)(lds + S5_US + (token >> 4) * 528 + ((token & 15) * 16 + half * 8) * 2) = v; }
        __syncthreads();
#pragma unroll
        for (int m = 0; m < 4; ++m) {
            f32x4 acc = {0.f, 0.f, 0.f, 0.f};
#pragma unroll
            for (int ks = 0; ks < 8; ++ks) { const bf16x8 A = *(const LAS bf16x8*)(lds + S5_US + (16 * m + r) * 528 + (32 * ks + 8 * q) * 2); acc = mfma16(A, bE[ks], acc); }
#pragma unroll
            for (int i = 0; i < 4; ++i) *(LAS float*)(lds + S5_ES + ((16 * m + 4 * q + i) * 132 + 16 * wave + r) * 4) = acc[i];
        }
        __syncthreads();
        {
            float lr[8], li[8];
            float xr = 0.f, xi = 0.f;
#pragma unroll
            for (int k = 0; k < 8; ++k) {
                lr[k] = xr; li[k] = xi;
                const float er = *(const LAS float*)(lds + S5_ES + ((8 * wave + k) * 132 + lane) * 4), ei = *(const LAS float*)(lds + S5_ES + ((8 * wave + k) * 132 + 64 + lane) * 4);
                const float nr = a16r * xr - a16i * xi + er, ni = a16r * xi + a16i * xr + ei; xr = nr; xi = ni;
            }
            __builtin_amdgcn_sched_barrier(0);
            *(LAS float*)(lds + S5_TS + (wave * 128 + lane) * 4) = xr; *(LAS float*)(lds + S5_TS + (wave * 128 + 64 + lane) * 4) = xi;
            __syncthreads();
            __builtin_amdgcn_sched_barrier(0);
            float cr = sr, ci = si, mr = sr, mi = si;
#pragma unroll
            for (int w2 = 0; w2 < 8; ++w2) {
                if (w2 == wave) { mr = cr; mi = ci; }
                const float tr = *(const LAS float*)(lds + S5_TS + (w2 * 128 + lane) * 4), ti = *(const LAS float*)(lds + S5_TS + (w2 * 128 + 64 + lane) * 4);
                const float nr = a128r * cr - a128i * ci + tr, ni = a128r * ci + a128i * cr + ti; cr = nr; ci = ni;
            }
            sr = cr; si = ci;
            __builtin_amdgcn_sched_barrier(0);
            if (PASS == 1) {
                float pr = mr, pi = mi;
#pragma unroll
                for (int k = 0; k < 8; ++k) {
                    *(LAS bf16_t*)(lds + S5_SS + ((8 * wave + k) * 136 + lane) * 2) = f2bf(lr[k] + pr); *(LAS bf16_t*)(lds + S5_SS + ((8 * wave + k) * 136 + 64 + lane) * 2) = f2bf(li[k] + pi);
                    const float nr = a16r * pr - a16i * pi, ni = a16r * pi + a16i * pr; pr = nr; pi = ni;
                }
            }
        }
        __syncthreads();
        if (PASS == 1) {
#pragma unroll
            for (int nt = 0; nt < 2; ++nt) {
                const int j = 2 * wave + nt;
                f32x4 acc[4];
#pragma unroll
                for (int m = 0; m < 4; ++m) acc[m] = (f32x4){0.f, 0.f, 0.f, 0.f};
#pragma unroll
                for (int ks = 0; ks < 8; ++ks) {
                    __builtin_amdgcn_sched_barrier(0);
#pragma unroll
                    for (int m = 0; m < 4; ++m) { const bf16x8 A = *(const LAS bf16x8*)(lds + S5_US + (16 * m + r) * 528 + (32 * ks + 8 * q) * 2); acc[m] = mfma16(A, bM[nt][ks], acc[m]); }
                }
#pragma unroll
                for (int ks = 0; ks < 4; ++ks) {
                    __builtin_amdgcn_sched_barrier(0);
#pragma unroll
                    for (int m = 0; m < 4; ++m) { const bf16x8 A = *(const LAS bf16x8*)(lds + S5_SS + (16 * m + r) * 272 + (32 * ks + 8 * q) * 2); acc[m] = mfma16(A, bC[nt][ks], acc[m]); }
                }
                int lz = lane; asm volatile("" : "+v"(lz));
                const int rz = lz & 15, qz = lz >> 4;
#pragma unroll
                for (int m = 0; m < 4; ++m)
#pragma unroll
                    for (int i = 0; i < 4; ++i) { const int ch = 16 * m + 4 * qz + i; Z[(size_t)(tok0 + 16 * ch + j) * 1024 + g * 16 + rz] = f2bf(gelu_tanh(acc[m][i])); }
            }
            __syncthreads();
        }
    }
    if (PASS == 0 && wave == 0) { F[seg * 128 + lane] = sr; F[seg * 128 + 64 + lane] = si; }
}

__device__ __forceinline__ void cmp_finish_item(const Args& a, const Ctx& c, int kvsel, int rt) {
    LAS unsigned char* lds = c.lds;
    const int tid = c.tid, wave = c.wave, lane = c.lane, r = lane & 15, q = lane >> 4;
    const float* SL = (const float*)(a.ws + WS_SLAB) + (size_t)kvsel * 16 * 2048 * 256;
    const float* bpep = (const float*)(a.ws + WS_BPEP) + kvsel * 256;
    const bf16_t* W2 = (const bf16_t*)(a.ws + WS_W2) + kvsel * 128 * 256;
    bf16x8 B[8];
#pragma unroll
    for (int ks = 0; ks < 8; ++ks) B[ks] = *(const bf16x8*)(W2 + (size_t)(16 * wave + r) * 256 + 32 * ks + 8 * q);
    for (int e = tid; e < 16 * 64; e += NTHREADS) {
        const int row = e >> 6, c4 = (e & 63) * 4;
        f32x4 s = {0.f, 0.f, 0.f, 0.f};
#pragma unroll 8
        for (int pt = 0; pt < 32; ++pt) s += *(const f32x4*)(bpep + pt * 512 + c4);
#pragma unroll
        for (int ks = 0; ks < 16; ++ks) s += *(const f32x4*)(SL + ((size_t)ks * 2048 + rt * 16 + row) * 256 + c4);
        u32x2 w; w[0] = cvt_pk_bf16(gelu_tanh(s[0]), gelu_tanh(s[1])); w[1] = cvt_pk_bf16(gelu_tanh(s[2]), gelu_tanh(s[3]));
        *(LAS u32x2*)(lds + row * 528 + c4 * 2) = w;
    }
    __syncthreads();
    f32x4 acc = {0.f, 0.f, 0.f, 0.f};
#pragma unroll
    for (int ks = 0; ks < 8; ++ks) { const bf16x8 A = *(const LAS bf16x8*)(lds + r * 528 + (32 * ks + 8 * q) * 2); acc = mfma16(A, B[ks], acc); }
#pragma unroll
    for (int i = 0; i < 4; ++i) {
        const int row = rt * 16 + 4 * q + i, gi = row >> 10, ci = row & 1023, n = 16 * wave + r;
        const bf16_t v = (ci == 1023) ? (bf16_t)0 : f2bf(acc[i]);
        if (kvsel == 0) ((bf16_t*)(a.ws + WS_KC))[((size_t)gi * 1024 + ci) * 128 + n] = v;
        else ((bf16_t*)(a.ws + WS_VCT))[((size_t)gi * 128 + n) * 1024 + ((ci & ~12) | ((ci & 4) << 1) | ((ci & 8) >> 1))] = v;
    }
    __syncthreads();
}
constexpr int AT_IMP = 65536, AT_TB = 131072, AT_BM = 143872, AT_WU = 145920, AT_END = 146176;
__device__ __forceinline__ int kswz(int r) { return ((r & 3) << 2) | ((r >> 2) & 3); }
__host__ __device__ __forceinline__ int vperm(int t) { return (t & ~12) | ((t & 4) << 1) | ((t & 8) >> 1); }
template <int KEYS> __device__ __forceinline__ int vsw(int d) { return KEYS == 128 ? kswz(d) : ((d >> 1) & 7); }
template <int KEYS, bool NEEDV>
__device__ __forceinline__ void stage_dma(const bf16_t* Kt, const bf16_t* Vt, int ldv, LAS unsigned char* kb, LAS unsigned char* vb, int wave, int lane) {
    constexpr int NP = KEYS / 32;
#pragma unroll
    for (int i = 0; i < NP; ++i) { const int pc = NP * wave + i, row = 4 * pc + (lane >> 4), ch = (lane & 15) ^ kswz(row);
        __builtin_amdgcn_global_load_lds((const unsigned*)(Kt + row * 128 + ch * 8), (LAS unsigned*)(kb + pc * 1024), 16, 0, 0); }
    if (NEEDV) {
#pragma unroll
        for (int i = 0; i < NP; ++i) {
            const int pc = NP * wave + i;
            if (KEYS == 128) { const int d = 4 * pc + (lane >> 4), ch = (lane & 15) ^ kswz(d);
                __builtin_amdgcn_global_load_lds((const unsigned*)(Vt + (size_t)d * ldv + 8 * ch), (LAS unsigned*)(vb + pc * 1024), 16, 0, 0); }
            else { const int d = 8 * pc + (lane >> 3), ch = (lane & 7) ^ ((d >> 1) & 7);
                __builtin_amdgcn_global_load_lds((const unsigned*)(Vt + (size_t)d * ldv + 8 * ch), (LAS unsigned*)(vb + pc * 1024), 16, 0, 0); }
        }
    }
}
__device__ __forceinline__ float xhalf_max(float x) { auto rr = __builtin_amdgcn_permlane32_swap(__float_as_uint(x), __float_as_uint(x), false, false); return fmaxf(__uint_as_float(rr[0]), __uint_as_float(rr[1])); }
__device__ __forceinline__ float xhalf_sum(float x) { auto rr = __builtin_amdgcn_permlane32_swap(__float_as_uint(x), __float_as_uint(x), false, false); return __uint_as_float(rr[0]) + __uint_as_float(rr[1]); }
template <int BR>
__device__ __forceinline__ float tile_prep(int MODE, f32x16& S, LAS const float* tb, float cb, int base, bool selbit) {
    float mx = -INFINITY;
    if (MODE == 1) {
#pragma unroll
        for (int r = 0; r < 16; ++r) mx = fmaxf(mx, S[r]);
        mx = (BR == 2 && !selbit) ? -INFINITY : mx + cb;
    } else {
        const bool nomask = (MODE == 2);
        float bv[16];
#pragma unroll
        for (int r = 0; r < 16; ++r) { const int cr = (r & 3) + 8 * (r >> 2); const int dist = (BR <= 1) ? base - 16 * cr : base - cr; bv[r] = tb[min(max(dist, 0), TBN - 1)]; }
        __builtin_amdgcn_sched_barrier(0);
#pragma unroll
        for (int r = 0; r < 16; ++r) {
            const int cr = (r & 3) + 8 * (r >> 2);
            const int dist = (BR <= 1) ? base - 16 * cr : base - cr;
            float v = S[r] + bv[r];
            bool valid;
            if (BR <= 1) valid = dist >= 0; else if (BR == 2) valid = selbit && dist >= 0; else valid = nomask || (unsigned)dist < 512u;
            v = valid ? v : -INFINITY;
            S[r] = v; mx = fmaxf(mx, v);
        }
    }
    return mx;
}
template <int BR, bool PEND>
__device__ __forceinline__ float tile_decide(int MODE, float mx, float cb, bool selbit, f32x16 (&O)[4], float& m, float& l, u32x4& pa, u32x4& pb) {
    if (BR == 1) { const float mu = (m == -INFINITY) ? 0.f : m; return (MODE == 1) ? mu - cb : mu; }
    mx = xhalf_max(mx);
    const float mn = fmaxf(m, mx), mu = (mn == -INFINITY) ? 0.f : mn;
    if (__any(mn > m)) {
        const float alpha = fexp2(m - mu);
        l *= alpha;
        if (BR >= 2) {
#pragma unroll
            for (int dt = 0; dt < 4; ++dt)
#pragma unroll
                for (int r = 0; r < 16; ++r) O[dt][r] *= alpha;
            if (PEND) {
#pragma unroll
                for (int e = 0; e < 4; ++e) { pa[e] = cvt_pk_bf16(bflo(pa[e]) * alpha, bfhi(pa[e]) * alpha); pb[e] = cvt_pk_bf16(bflo(pb[e]) * alpha, bfhi(pb[e]) * alpha); }
            }
        }
    }
    m = mn;
    if (MODE == 1) return (BR == 2 && !selbit) ? INFINITY : mu - cb;
    return mu;
}
template <int BR, int KEYS>
__device__ __forceinline__ void attn_tile(int MODE, LAS const unsigned char* kb, LAS const unsigned char* vb, int cb0, LAS const float* tb, int key0, int t, int lane,
                                          const bf16x8 (&qf)[8], f32x16 (&O)[4], float& m, float& l, float inv_l, bool selbit, LAS float* imp_row) {
    asm volatile("" : "+v"(lane));
    constexpr int ROWB = 2 * KEYS;
    const int r31 = lane & 31, h = lane >> 5;
    const int gh = kswz(r31) ^ h, vh = vsw<KEYS>(r31) ^ h;
    float cb = 0.f;
    if (MODE == 1) cb = tb[TBN - 1];
    const int base0 = (BR <= 1) ? t - 31 - 16 * (key0 + 4 * h) : t - (key0 + 4 * h);
    const int base1 = (BR <= 1) ? base0 - 16 * 32 : base0 - 32;
    LAS const unsigned char* k0 = kb + r31 * 256;
    f32x16 S0, S1;
    bf16x8 kf[8];
#pragma unroll
    for (int ks = 0; ks < 8; ++ks) kf[ks] = *(const LAS bf16x8*)(k0 + 16 * ((2 * ks) ^ gh));
#pragma unroll
    for (int r = 0; r < 16; ++r) { S0[r] = 0.f; S1[r] = 0.f; }
    __builtin_amdgcn_sched_barrier(0);
#pragma unroll
    for (int ks = 0; ks < 8; ++ks) S0 = mfma32(kf[ks], qf[ks], S0);
    __builtin_amdgcn_sched_barrier(0);
#pragma unroll
    for (int ks = 0; ks < 8; ++ks) kf[ks] = *(const LAS bf16x8*)(k0 + 8192 + 16 * ((2 * ks) ^ gh));
    const float mx0 = tile_prep<BR>(MODE, S0, tb, cb, base0, selbit);
    u32x4 pk0a = {0u, 0u, 0u, 0u}, pk0b = {0u, 0u, 0u, 0u}, pk1a, pk1b;
    const float me0 = tile_decide<BR, false>(MODE, mx0, cb, selbit, O, m, l, pk0a, pk0b);
    __builtin_amdgcn_sched_barrier(0);
    {
#pragma unroll
        for (int ks = 0; ks < 8; ++ks) S1 = mfma32(kf[ks], qf[ks], S1);
        float ps = 0.f;
#pragma unroll
        for (int r = 0; r < 16; ++r) { float p = fexp2(S0[r] - me0); if (BR == 1) p *= inv_l; S0[r] = p; ps += p; }
        if (BR != 1) l += ps;
        if (BR >= 1) {
#pragma unroll
            for (int e = 0; e < 4; ++e) { pk0a[e] = cvt_pk_bf16(S0[2 * e], S0[2 * e + 1]); pk0b[e] = cvt_pk_bf16(S0[8 + 2 * e], S0[8 + 2 * e + 1]); }
        }
#pragma unroll
        for (int i = 0; i < 8; ++i) { __builtin_amdgcn_sched_group_barrier(0x008, 1, 0); __builtin_amdgcn_sched_group_barrier(0x002, 8, 0); }
    }
    __builtin_amdgcn_sched_barrier(0);
    if (BR == 1) {
#pragma unroll
        for (int rg = 0; rg < 4; ++rg) {
            float A = 2.f * (S0[4 * rg] + S0[4 * rg + 1] + S0[4 * rg + 2]) + S0[4 * rg + 3], B = S0[4 * rg + 3];
            A = quad_sum(A); B = quad_sum(B);
            const int jj = (key0 >> 2) + 2 * rg + h;
            if ((lane & 3) == 0) { __hip_atomic_fetch_add(imp_row + jj, A, __ATOMIC_RELAXED, __HIP_MEMORY_SCOPE_WORKGROUP);
                if (jj + 1 < 256) __hip_atomic_fetch_add(imp_row + jj + 1, B, __ATOMIC_RELAXED, __HIP_MEMORY_SCOPE_WORKGROUP); }
        }
    }
    bf16x8 av[8];
    if (BR >= 1) {
#pragma unroll
        for (int s = 0; s < 2; ++s)
#pragma unroll
            for (int dt = 0; dt < 4; ++dt) av[s * 4 + dt] = *(const LAS bf16x8*)(vb + (32 * dt + r31) * ROWB + 16 * ((cb0 + 2 * s) ^ vh));
    }
    const float mx1 = tile_prep<BR>(MODE, S1, tb, cb, base1, selbit);
    const float me1 = tile_decide<BR, true>(MODE, mx1, cb, selbit, O, m, l, pk0a, pk0b);
    __builtin_amdgcn_sched_barrier(0);
    {
        if (BR >= 1) {
#pragma unroll
            for (int dt = 0; dt < 4; ++dt) O[dt] = mfma32(av[dt], __builtin_bit_cast(bf16x8, pk0a), O[dt]);
#pragma unroll
            for (int dt = 0; dt < 4; ++dt) O[dt] = mfma32(av[4 + dt], __builtin_bit_cast(bf16x8, pk0b), O[dt]);
        }
        float ps = 0.f;
#pragma unroll
        for (int r = 0; r < 16; ++r) { float p = fexp2(S1[r] - me1); if (BR == 1) p *= inv_l; S1[r] = p; ps += p; }
        if (BR != 1) l += ps;
        if (BR >= 1) {
#pragma unroll
            for (int e = 0; e < 4; ++e) { pk1a[e] = cvt_pk_bf16(S1[2 * e], S1[2 * e + 1]); pk1b[e] = cvt_pk_bf16(S1[8 + 2 * e], S1[8 + 2 * e + 1]); }
#pragma unroll
            for (int i = 0; i < 8; ++i) { __builtin_amdgcn_sched_group_barrier(0x008, 1, 0); __builtin_amdgcn_sched_group_barrier(0x002, 8, 0); }
        }
    }
    __builtin_amdgcn_sched_barrier(0);
    if (BR == 1) {
#pragma unroll
        for (int rg = 0; rg < 4; ++rg) {
            float A = 2.f * (S1[4 * rg] + S1[4 * rg + 1] + S1[4 * rg + 2]) + S1[4 * rg + 3], B = S1[4 * rg + 3];
            A = quad_sum(A); B = quad_sum(B);
            const int jj = ((key0 + 32) >> 2) + 2 * rg + h;
            if ((lane & 3) == 0) { __hip_atomic_fetch_add(imp_row + jj, A, __ATOMIC_RELAXED, __HIP_MEMORY_SCOPE_WORKGROUP);
                if (jj + 1 < 256) __hip_atomic_fetch_add(imp_row + jj + 1, B, __ATOMIC_RELAXED, __HIP_MEMORY_SCOPE_WORKGROUP); }
        }
    }
    if (BR >= 1) {
#pragma unroll
        for (int s = 0; s < 2; ++s)
#pragma unroll
            for (int dt = 0; dt < 4; ++dt) av[s * 4 + dt] = *(const LAS bf16x8*)(vb + (32 * dt + r31) * ROWB + 16 * ((cb0 + 4 + 2 * s) ^ vh));
        __builtin_amdgcn_sched_barrier(0);
#pragma unroll
        for (int dt = 0; dt < 4; ++dt) O[dt] = mfma32(av[dt], __builtin_bit_cast(bf16x8, pk1a), O[dt]);
#pragma unroll
        for (int dt = 0; dt < 4; ++dt) O[dt] = mfma32(av[4 + dt], __builtin_bit_cast(bf16x8, pk1b), O[dt]);
    }
}
template <int BR, int KEYS>
__device__ __forceinline__ void run_branch(const Ctx& c, const bf16_t* Kb, const bf16_t* Vtb, int ldv, int lo, int hi, LAS const float* tb, int t, int t0,
                                           const bf16x8 (&qf)[8], f32x16 (&O)[4], float& m, float& l, float inv_l, int tl, LAS float* imp_row) {
    constexpr bool NEEDV = (BR != 0);
    constexpr int BPS = KEYS / 64, KSTG = KEYS * 256, VSTG = 128 * 2 * KEYS, VB0 = 2 * KSTG;
    LAS unsigned char* lds = c.lds;
    int lz = c.lane; asm volatile("" : "+v"(lz));
    const int nst = (hi - lo + BPS - 1) / BPS;
#define STG_BLK(i) ((lo + BPS * (i) + BPS - 1 < hi) ? lo + BPS * (i) : hi - BPS)
    asm volatile("s_waitcnt vmcnt(0)" ::: "memory");
    { const int b0 = (BPS == 2 && hi - lo < 2) ? lo : STG_BLK(0);
      stage_dma<KEYS, NEEDV>(Kb + (size_t)b0 * 64 * 128, Vtb + (size_t)b0 * 64, ldv, lds, lds + VB0, c.wave, lz); }
    asm volatile("s_waitcnt vmcnt(0)" ::: "memory");
    __syncthreads();
    const int qt = t0 >> 6;
    for (int i = 0; i < nst; ++i) {
        const int buf = i & 1;
        if (i + 1 < nst) { int lz2 = lz; asm volatile("" : "+v"(lz2));
            const int b1 = STG_BLK(i + 1);
            stage_dma<KEYS, NEEDV>(Kb + (size_t)b1 * 64 * 128, Vtb + (size_t)b1 * 64, ldv, lds + (buf ^ 1) * KSTG, lds + VB0 + (buf ^ 1) * VSTG, c.wave, lz2); }
        const int sb = (BPS == 2 && hi - lo < 2) ? lo : STG_BLK(i);
#pragma unroll
        for (int q = 0; q < BPS; ++q) {
            const int j = lo + BPS * i + q;
            if (j < hi) {
                bool selbit = true, wave_on = true;
                if (BR == 2) {
                    const unsigned w = *(const LAS unsigned*)(lds + AT_BM + (tl * 8 + (j >> 5)) * 4);
                    selbit = (w >> (j & 31)) & 1u;
                    const unsigned wu = *(const LAS unsigned*)(lds + AT_WU + (c.wave * 8 + (j >> 5)) * 4);
                    wave_on = (wu >> (j & 31)) & 1u;
                }
                if (wave_on) {
                    int mode = 0;
                    if (BR <= 1) mode = (1024 * j + 1829 <= t0) ? 1 : 0;
                    else if (BR == 2) mode = (64 * j + 853 <= t0) ? 1 : 0;
                    else mode = (j >= qt - 7 && j <= qt - 1) ? 2 : 0;
                    const int slot = j - sb;
                    attn_tile<BR, KEYS>(mode, lds + buf * KSTG + slot * 16384, lds + VB0 + buf * VSTG, 8 * slot, tb, j * 64, t, c.lane, qf, O, m, l, inv_l, selbit, imp_row);
                }
            }
        }
        asm volatile("s_waitcnt vmcnt(0)" ::: "memory");
        __syncthreads();
    }
#undef STG_BLK
}
__device__ __forceinline__ void attn_item(const Args& a, const Ctx& c_, int qt, int g) {
    Ctx c = c_; { int tz = c_.tid; asm volatile("" : "+v"(tz)); c.tid = tz; c.lane = tz & 63; }
    LAS unsigned char* lds = c.lds;
    const int tid = c.tid, wave = c.wave, lane = c.lane, r31 = lane & 31, h = lane >> 5, hl = lane & 3;
    const int t0 = qt * 64, tl = 8 * wave + (r31 >> 2), t = t0 + tl, head = g * 4 + hl;
    const bf16_t* Qb = (const bf16_t*)(a.ws + WS_Q);
    const bf16_t* KROW = (const bf16_t*)(a.ws + WS_KROW);
    const bf16_t* VT = (const bf16_t*)(a.ws + WS_VT);
    const float* GATE = (const float*)(a.ws + WS_GATE);
    { const float* tbg = (const float*)(a.ws + WS_TB) + g * 4 * TBN;
      for (int i = tid; i < 4 * TBN; i += NTHREADS) *(LAS float*)(lds + AT_TB + i * 4) = tbg[i];
      for (int i = tid; i < 64 * 256; i += NTHREADS) *(LAS float*)(lds + AT_IMP + i * 4) = 0.f; }
    bf16x8 qf[8];
#pragma unroll
    for (int ks = 0; ks < 8; ++ks) qf[ks] = *(const bf16x8*)(Qb + (size_t)t * 1024 + head * 128 + 16 * ks + 8 * h);
    LAS const float* tb = (LAS const float*)(lds + AT_TB) + hl * TBN;
    LAS float* imp_row = (LAS float*)(lds + AT_IMP) + tl * 256;
    bf16_t* Y = (bf16_t*)(a.ws + WS_Y2) + (size_t)t * 2048 + 1024 + head * 128 + 4 * h;
    f32x16 O[4];
#pragma unroll
    for (int dt = 0; dt < 4; ++dt)
#pragma unroll
        for (int r = 0; r < 16; ++r) O[dt][r] = 0.f;
    __syncthreads();
    { const int ntile = (t0 / 16 + 3 + 63) / 64;
      const bf16_t* KC = (const bf16_t*)(a.ws + WS_KC) + (size_t)g * 1024 * 128; const bf16_t* VCT = (const bf16_t*)(a.ws + WS_VCT) + (size_t)g * 128 * 1024;
      float m = -INFINITY, l = 0.f;
#if defined(PROBE_CMP)
      run_branch<0, 64>(c, KC, VCT, 1024, 0, ntile, tb, t, t0, qf, O, m, l, 0.f, tl, imp_row);
      asm volatile("" :: "v"(m), "v"(l));
      m = -INFINITY; l = 0.f;
#endif
      run_branch<0, 64>(c, KC, VCT, 1024, 0, ntile, tb, t, t0, qf, O, m, l, 0.f, tl, imp_row);
      const float lt = xhalf_sum(l), inv = lt > 0.f ? 1.f / lt : 0.f;
      run_branch<1, 64>(c, KC, VCT, 1024, 0, ntile, tb, t, t0, qf, O, m, l, inv, tl, imp_row);
      const float gc = GATE[(size_t)t * 24 + head];
#pragma unroll
      for (int dt = 0; dt < 4; ++dt)
#pragma unroll
          for (int rg = 0; rg < 4; ++rg) {
              u32x2 w; w[0] = cvt_pk_bf16(gc * O[dt][4 * rg], gc * O[dt][4 * rg + 1]); w[1] = cvt_pk_bf16(gc * O[dt][4 * rg + 2], gc * O[dt][4 * rg + 3]);
              *(u32x2*)(Y + 32 * dt + 8 * rg) = w;
#pragma unroll
              for (int e = 0; e < 4; ++e) O[dt][4 * rg + e] = 0.f;
          }
    }
    {
        const int ncand = qt - 2 > 0 ? qt - 2 : 0;
        unsigned v[8][4], selm[8];
#pragma unroll
        for (int i = 0; i < 8; ++i) {
            LAS const float* row = (LAS const float*)(lds + AT_IMP) + (8 * wave + i) * 256;
            selm[i] = 0u;
#pragma unroll
            for (int k = 0; k < 4; ++k) { const int j = lane + 64 * k; const bool cand = (j >= 1 && j <= qt - 2);
                v[i][k] = cand ? ((__float_as_uint(row[j]) & ~0xFFu) | (unsigned)(255 - j)) : 0u; if (ncand <= 13 && cand) selm[i] |= 1u << k; }
        }
        if (ncand > 13) {
            for (int it = 0; it < 13; ++it) {
#pragma unroll
                for (int i = 0; i < 8; ++i) {
                    const unsigned mx = wave_umax_bcast(max(max(v[i][0], v[i][1]), max(v[i][2], v[i][3])));
#pragma unroll
                    for (int k = 0; k < 4; ++k) if (v[i][k] == mx) { v[i][k] = 0u; selm[i] |= 1u << k; }
                }
            }
        }
        unsigned wu[8];
#pragma unroll
        for (int k = 0; k < 8; ++k) wu[k] = 0u;
#pragma unroll
        for (int i = 0; i < 8; ++i)
#pragma unroll
            for (int k = 0; k < 4; ++k) {
                const int j = lane + 64 * k; const bool forced = (j == 0) || (j == qt) || (j == qt - 1);
                const unsigned long long mk = __ballot(((selm[i] >> k) & 1u) || forced);
                const unsigned lo = (unsigned)mk, hi = (unsigned)(mk >> 32);
                if (lane == 0) { *(LAS unsigned*)(lds + AT_BM + ((8 * wave + i) * 8 + 2 * k) * 4) = lo; *(LAS unsigned*)(lds + AT_BM + ((8 * wave + i) * 8 + 2 * k + 1) * 4) = hi; }
                wu[2 * k] |= lo; wu[2 * k + 1] |= hi;
            }
        if (lane == 0) {
#pragma unroll
            for (int k = 0; k < 8; ++k) *(LAS unsigned*)(lds + AT_WU + (wave * 8 + k) * 4) = wu[k];
        }
    }
    __syncthreads();
#if defined(PROBE_SEL)
    { float m = -INFINITY, l = 0.f;
      run_branch<2, 128>(c, KROW + (size_t)(2 + g) * L_ * 128, VT + (size_t)g * 128 * L_, L_, 0, qt + 1, tb, t, t0, qf, O, m, l, 0.f, tl, imp_row);
      asm volatile("" :: "v"(O[0]), "v"(O[1]), "v"(O[2]), "v"(O[3]), "v"(m), "v"(l));
#pragma unroll
      for (int dt = 0; dt < 4; ++dt)
#pragma unroll
          for (int r = 0; r < 16; ++r) O[dt][r] = 0.f; }
#endif
    { float m = -INFINITY, l = 0.f;
      run_branch<2, 128>(c, KROW + (size_t)(2 + g) * L_ * 128, VT + (size_t)g * 128 * L_, L_, 0, qt + 1, tb, t, t0, qf, O, m, l, 0.f, tl, imp_row);
      const float gs = GATE[(size_t)t * 24 + 8 + head];
      const float lt = xhalf_sum(l), sc = gs * (lt > 0.f ? 1.f / lt : 0.f);
#pragma unroll
      for (int dt = 0; dt < 4; ++dt)
#pragma unroll
          for (int rg = 0; rg < 4; ++rg) {
              const u32x2 w0 = *(const u32x2*)(Y + 32 * dt + 8 * rg);
              u32x2 w; w[0] = cvt_pk_bf16(bflo(w0[0]) + sc * O[dt][4 * rg], bfhi(w0[0]) + sc * O[dt][4 * rg + 1]); w[1] = cvt_pk_bf16(bflo(w0[1]) + sc * O[dt][4 * rg + 2], bfhi(w0[1]) + sc * O[dt][4 * rg + 3]);
              *(u32x2*)(Y + 32 * dt + 8 * rg) = w;
#pragma unroll
              for (int e = 0; e < 4; ++e) O[dt][4 * rg + e] = 0.f;
          }
    }
#if defined(PROBE_WIN)
    { float m = -INFINITY, l = 0.f;
      const int lo = qt - 8 > 0 ? qt - 8 : 0;
      run_branch<3, 128>(c, KROW + (size_t)(4 + g) * L_ * 128, VT + (size_t)(2 + g) * 128 * L_, L_, lo, qt + 1, tb, t, t0, qf, O, m, l, 0.f, tl, imp_row);
      asm volatile("" :: "v"(O[0]), "v"(O[1]), "v"(O[2]), "v"(O[3]), "v"(m), "v"(l));
#pragma unroll
      for (int dt = 0; dt < 4; ++dt)
#pragma unroll
          for (int r = 0; r < 16; ++r) O[dt][r] = 0.f; }
#endif
    { float m = -INFINITY, l = 0.f;
      const int lo = qt - 8 > 0 ? qt - 8 : 0;
      run_branch<3, 128>(c, KROW + (size_t)(4 + g) * L_ * 128, VT + (size_t)(2 + g) * 128 * L_, L_, lo, qt + 1, tb, t, t0, qf, O, m, l, 0.f, tl, imp_row);
      const float gw = GATE[(size_t)t * 24 + 16 + head];
      const float lt = xhalf_sum(l), sc = gw * (lt > 0.f ? 1.f / lt : 0.f);
      float ss = 0.f;
#pragma unroll
      for (int dt = 0; dt < 4; ++dt)
#pragma unroll
          for (int rg = 0; rg < 4; ++rg) {
              const u32x2 w0 = *(const u32x2*)(Y + 32 * dt + 8 * rg);
              const float y0 = bflo(w0[0]) + sc * O[dt][4 * rg], y1 = bfhi(w0[0]) + sc * O[dt][4 * rg + 1], y2 = bflo(w0[1]) + sc * O[dt][4 * rg + 2], y3 = bfhi(w0[1]) + sc * O[dt][4 * rg + 3];
              u32x2 w; w[0] = cvt_pk_bf16(y0, y1); w[1] = cvt_pk_bf16(y2, y3);
              *(u32x2*)(Y + 32 * dt + 8 * rg) = w;
              ss += (y0 * y0 + y1 * y1) + (y2 * y2 + y3 * y3);
          }
      ss = quad_sum(xhalf_sum(ss));
      if (hl == 0 && h == 0) ((float*)(a.ws + WS_STAP))[(size_t)t * 2 + g] = ss;
    }
    __syncthreads();
}
#ifndef PEER_ALPHA
#define PEER_ALPHA 1.0f
#endif
constexpr int PE_SC = 0, PE_LV = 65536, PE_LI = 73728, PE_PK = 81920, PE_EX = 147456, PE_GT = 149504, PE_SU = 153600, PE_CE = 157696, PE_END = 161792;
constexpr int PE_SLOT = 2048, PE_NSLOT = 8, PE_RINGW = PE_SLOT * 9;
static_assert(8 * PE_RINGW <= PE_EX && PE_END <= LDS_BYTES - 32, "PEER LDS map");
__device__ __forceinline__ float pair_wave_sum(float a, float b, bool odd) {
    a += dpp_f<0xB1>(a); b += dpp_f<0xB1>(b);
    float c = odd ? b : a;
    c += dpp_f<0x4E>(c); c += dpp_f<0x124>(c); c += dpp_f<0x128>(c);
    { const auto r = __builtin_amdgcn_permlane16_swap(__float_as_uint(c), __float_as_uint(c), false, false); c = __uint_as_float(r[0]) + __uint_as_float(r[1]); }
    { const auto r = __builtin_amdgcn_permlane32_swap(__float_as_uint(c), __float_as_uint(c), false, false); c = __uint_as_float(r[0]) + __uint_as_float(r[1]); }
    return c;
}
__device__ __forceinline__ float wave_sum_bcast(float v) {
    v += dpp_f<0xB1>(v); v += dpp_f<0x4E>(v); v += dpp_f<0x141>(v); v += dpp_f<0x140>(v);
    v += __int_as_float(__builtin_amdgcn_update_dpp(0, __float_as_int(v), 0x142, 0xa, 0xf, false));
    v += __int_as_float(__builtin_amdgcn_update_dpp(0, __float_as_int(v), 0x143, 0xc, 0xf, false));
    return __int_as_float(__builtin_amdgcn_readlane(__float_as_int(v), 63));
}
__device__ __forceinline__ unsigned mono_key(float v) { const unsigned b = __float_as_uint(v); return b ^ ((b >> 31) ? 0xFFFFFFFFu : 0x80000000u); }
template <int CTRL>
__device__ __forceinline__ void quad_merge16(unsigned (&t)[16]) {
    unsigned o[16];
#pragma unroll
    for (int i = 0; i < 16; ++i) o[i] = (unsigned)__builtin_amdgcn_update_dpp(0, (int)t[15 - i], CTRL, 0xf, 0xf, false);
#pragma unroll
    for (int i = 0; i < 16; ++i) t[i] = max(t[i], o[i]);
#pragma unroll
    for (int st = 8; st >= 1; st >>= 1)
#pragma unroll
        for (int i = 0; i < 16; ++i) if ((i & st) == 0) { const unsigned hi = max(t[i], t[i + st]), lo = min(t[i], t[i + st]); t[i] = hi; t[i + st] = lo; }
}
__device__ __forceinline__ void sort16_desc(unsigned (&t)[16]) {
#pragma unroll
    for (int k = 2; k <= 16; k <<= 1)
#pragma unroll
        for (int j = k >> 1; j > 0; j >>= 1)
#pragma unroll
            for (int i = 0; i < 16; ++i) { const int l = i ^ j; if (l > i) { const bool desc = ((i & k) == 0); const unsigned hi = max(t[i], t[l]), lo = min(t[i], t[l]); t[i] = desc ? hi : lo; t[l] = desc ? lo : hi; } }
}
__device__ __forceinline__ void bitonic_merge16_desc(unsigned (&t)[16]) {
#pragma unroll
    for (int st = 8; st >= 1; st >>= 1)
#pragma unroll
        for (int i = 0; i < 16; ++i) if ((i & st) == 0) { const unsigned hi = max(t[i], t[i + st]), lo = min(t[i], t[i + st]); t[i] = hi; t[i + st] = lo; }
}
__device__ __forceinline__ int pair_a(int p) { return p < 16 ? 0 : p < 24 ? 1 : p < 29 ? 2 : p < 33 ? 3 : p < 36 ? 4 : p < 38 ? 5 : p < 40 ? 6 : p < 42 ? 7 : p - 34; }
__device__ __forceinline__ int pair_b(int p) { return p < 16 ? p : p < 24 ? p - 16 : p < 29 ? p - 24 : p < 33 ? p - 29 : p < 36 ? p - 33 : p < 38 ? p - 36 : p < 40 ? p - 38 : p < 42 ? p - 40 : 0; }
template <bool DRY>
__device__ __forceinline__ void peer_step(const Args& a, const Ctx& c_, int t0) {
    Ctx c = c_; { int tz = c_.tid; asm volatile("" : "+v"(tz)); c.tid = tz; c.lane = tz & 63; }
    LAS unsigned char* lds = c.lds;
    const int tid = c.tid, wave = c.wave, lane = c.lane, r = lane & 15, q = lane >> 4;
    const bf16_t* QP = (const bf16_t*)(a.ws + WS_QP); const bf16_t* PK = (const bf16_t*)(a.ws + WS_PK);
    const unsigned char* PU = a.ws + WS_PU; const unsigned char* PV = a.ws + WS_PV; const float* psc = (const float*)(a.ws + WS_PSC);
    const bf16_t* HB = (const bf16_t*)(a.ws + WS_H2);
    const int t = t0 + wave;
    u32x4 hraw[4]; u32x2 xw[8];
#pragma unroll
    for (int k = 0; k < 4; ++k) hraw[k] = *(const u32x4*)(HB + (size_t)t * 2048 + lane * 32 + k * 8);
#pragma unroll
    for (int k = 0; k < 8; ++k) xw[k] = *(const u32x2*)((const bf16_t*)(a.ws + WS_X1) + (size_t)t * 2048 + lane * 32 + k * 4);
    const float r2 = ((const float*)(a.ws + WS_RSTD2))[t0 + ((tid >> 5) & 7)];
    {
#pragma unroll
        for (int i = 0; i < 8; ++i) { const int pc = 8 * wave + i, row = 4 * pc + (lane >> 4), ch = (lane & 15) ^ kswz(row);
            __builtin_amdgcn_global_load_lds((const unsigned*)(PK + (size_t)row * 128 + ch * 8), (LAS unsigned*)(lds + PE_PK + pc * 1024), 16, 0, 0); }
        const int hh = wave;
        bf16x8 aF[2][4];
#pragma unroll
        for (int cc = 0; cc < 2; ++cc)
#pragma unroll
            for (int ks = 0; ks < 4; ++ks) aF[cc][ks] = *(const bf16x8*)(QP + (size_t)(t0 + (r & 7)) * 2048 + hh * 256 + cc * 128 + 32 * ks + 8 * q);
        asm volatile("s_waitcnt vmcnt(0)" ::: "memory");
        __syncthreads();
        const int ksw = kswz(r);
#pragma unroll
        for (int cc = 0; cc < 2; ++cc)
#pragma unroll 2
            for (int nt = 0; nt < 8; ++nt) {
                f32x4 acc = {0.f, 0.f, 0.f, 0.f};
#pragma unroll
                for (int ks = 0; ks < 4; ++ks) { const bf16x8 B = *(const LAS bf16x8*)(lds + PE_PK + (cc * 128 + 16 * nt + r) * 256 + 16 * ((4 * ks + q) ^ ksw)); acc = mfma16(aF[cc][ks], B, acc); }
                if (q < 2) {
#pragma unroll
                    for (int i = 0; i < 4; ++i) { const int task = (4 * q + i) * 16 + hh * 2 + cc; *(LAS float*)(lds + PE_SC + (task * 128 + ((16 * nt + r + task) & 127)) * 4) = acc[i]; }
                }
            }
    }
    __syncthreads();
    {
        const int task = tid >> 2, part = tid & 3;
        LAS const float* sc = (LAS const float*)(lds + PE_SC) + task * 128;
        float vals[32];
#pragma unroll
        for (int k = 0; k < 32; ++k) vals[k] = sc[(32 * part + k + task) & 127];
        unsigned top[16], tb[16];
#pragma unroll
        for (int k = 0; k < 16; ++k) { top[k] = (mono_key(vals[k]) & ~0x7Fu) | (unsigned)(127 - (32 * part + k)); tb[k] = (mono_key(vals[16 + k]) & ~0x7Fu) | (unsigned)(127 - (32 * part + 16 + k)); }
        sort16_desc(top); sort16_desc(tb);
#pragma unroll
        for (int i = 0; i < 16; ++i) top[i] = max(top[i], tb[15 - i]);
        bitonic_merge16_desc(top);
        quad_merge16<0xB1>(top);
        quad_merge16<0x4E>(top);
        if (part == 0) {
#pragma unroll
            for (int e = 0; e < 16; ++e) { const int idx = 127 - (int)(top[e] & 0x7Fu); *(LAS float*)(lds + PE_LV + (task * 16 + e) * 4) = sc[(idx + task) & 127]; *(LAS int*)(lds + PE_LI + (task * 16 + e) * 4) = idx; }
        }
    }
    __syncthreads();
    if (tid < 256) {
        const int task = tid >> 2, part = tid & 3, tok = task >> 3, hh = task & 7, t1 = tok * 16 + hh * 2, t2 = t1 + 1;
        LAS const float* lv1 = (LAS const float*)(lds + PE_LV) + t1 * 16; LAS const float* lv2 = (LAS const float*)(lds + PE_LV) + t2 * 16;
        unsigned top[16];
#pragma unroll
        for (int i = 0; i < 16; ++i) {
            const int p = part + 4 * i;
            top[i] = 0u;
            if (i < 13 && p < 50) { const int aa = pair_a(p), bb = pair_b(p); top[i] = (mono_key(lv1[aa] + lv2[bb]) & ~0xFFu) | (unsigned)(255 - (aa * 16 + bb)); }
        }
        sort16_desc(top);
        quad_merge16<0xB1>(top);
        quad_merge16<0x4E>(top);
        if (part == 0) {
            LAS const int* li1 = (LAS const int*)(lds + PE_LI) + t1 * 16; LAS const int* li2 = (LAS const int*)(lds + PE_LI) + t2 * 16;
            float sv[16]; int ex[16]; float mx = -INFINITY;
#pragma unroll
            for (int e = 0; e < 16; ++e) {
                const int id = 255 - (int)(top[e] & 0xFFu), aa = id >> 4, bb = id & 15;
                sv[e] = lv1[aa] + lv2[bb]; ex[e] = li1[aa] * 128 + li2[bb]; mx = fmaxf(mx, sv[e]);
            }
            float sum = 0.f;
#pragma unroll
            for (int e = 0; e < 16; ++e) { sv[e] = fexp2((sv[e] - mx) * LOG2E); sum += sv[e]; }
            const float inv = 1.f / sum;
#pragma unroll
            for (int e = 0; e < 16; ++e) *(LAS unsigned short*)(lds + PE_EX + (tok * 128 + hh * 16 + e) * 2) = (unsigned short)ex[e];
            f32x4 rec[16];
#pragma unroll
            for (int e = 0; e < 16; ++e) rec[e] = *(const f32x4*)(psc + (size_t)ex[e] * 4);
            __builtin_amdgcn_sched_barrier(0);
#pragma unroll
            for (int e = 0; e < 16; ++e) asm volatile("" :: "v"(rec[e]));
#pragma unroll
            for (int e = 0; e < 16; ++e) {
                *(LAS float*)(lds + PE_GT + (tok * 128 + hh * 16 + e) * 4) = sv[e] * inv * rec[e][2];
                *(LAS float*)(lds + PE_SU + (tok * 128 + hh * 16 + e) * 4) = rec[e][0] * r2;
                *(LAS float*)(lds + PE_CE + (tok * 128 + hh * 16 + e) * 4) = rec[e][1]; }
        }
    }
    __syncthreads();
    f32x2 hp[16];
#pragma unroll
    for (int k = 0; k < 4; ++k)
#pragma unroll
        for (int e = 0; e < 4; ++e) { hp[k * 4 + e][0] = bflo(hraw[k][e]); hp[k * 4 + e][1] = bfhi(hraw[k][e]); }
    f32x2 acc[16];
#pragma unroll
    for (int e = 0; e < 16; ++e) acc[e] = (f32x2){0.f, 0.f};
    asm volatile("s_waitcnt vmcnt(0)" ::: "memory");
    f32x4 gvv[8], fvv[8];
    {
        int lo_ = wave * 512 + (lane & 1) * 4; asm volatile("" : "+v"(lo_));
        LAS const float* gtl = (LAS const float*)(lds + PE_GT + lo_); LAS const float* sul = (LAS const float*)(lds + PE_SU + lo_); LAS const float* cel = (LAS const float*)(lds + PE_CE + lo_);
        int xo_ = wave * 256; asm volatile("" : "+v"(xo_));
        LAS const unsigned short* exl = (LAS const unsigned short*)(lds + PE_EX + xo_);
        const bool odd = lane & 1;
        LAS unsigned char* ring = lds + wave * PE_RINGW;
#define ISSUE_U(SL, IDX) do { const int ex_ = __builtin_amdgcn_readfirstlane((int)exl[IDX]); \
            __builtin_amdgcn_global_load_lds((const unsigned*)(PU + (size_t)ex_ * 1024 + lane * 16), (LAS unsigned*)(ring + (SL) * PE_SLOT), 16, 0, 0); } while (0)
#define ISSUE_V(SL, IDX) do { const int ex_ = __builtin_amdgcn_readfirstlane((int)exl[IDX]); \
            __builtin_amdgcn_global_load_lds((const unsigned*)(PV + (size_t)ex_ * 1024 + lane * 16), (LAS unsigned*)(ring + (SL) * PE_SLOT + 1024), 16, 0, 0); } while (0)
#define UDOT(UW, D0, D1, D2, D3) do { _Pragma("unroll") for (int dw = 0; dw < 4; ++dw) { const f32x2 f0_ = fp4_unpk<0>(UW[dw]), f1_ = fp4_unpk<1>(UW[dw]), f2_ = fp4_unpk<2>(UW[dw]), f3_ = fp4_unpk<3>(UW[dw]); \
                D0 += f0_ * hp[4 * dw]; D1 += f1_ * hp[4 * dw + 1]; D2 += f2_ * hp[4 * dw + 2]; D3 += f3_ * hp[4 * dw + 3]; } } while (0)
#define VACC(VW, WG) do { _Pragma("unroll") for (int dw = 0; dw < 4; ++dw) { const f32x2 f0_ = fp4_unpk<0>(VW[dw]), f1_ = fp4_unpk<1>(VW[dw]), f2_ = fp4_unpk<2>(VW[dw]), f3_ = fp4_unpk<3>(VW[dw]); \
                acc[4 * dw] += WG * f0_; acc[4 * dw + 1] += WG * f1_; acc[4 * dw + 2] += WG * f2_; acc[4 * dw + 3] += WG * f3_; } } while (0)
#define STAGE_A(SA, SB, PA, PB) do { const u32x4 ua_ = *(const LAS u32x4*)(ring + (SA) * PE_SLOT + lane * 16), ub_ = *(const LAS u32x4*)(ring + (SB) * PE_SLOT + lane * 16); \
            f32x2 a0_ = {0.f, 0.f}, a1_ = {0.f, 0.f}, a2_ = {0.f, 0.f}, a3_ = {0.f, 0.f}, b0_ = {0.f, 0.f}, b1_ = {0.f, 0.f}, b2_ = {0.f, 0.f}, b3_ = {0.f, 0.f}; \
            UDOT(ua_, a0_, a1_, a2_, a3_); UDOT(ub_, b0_, b1_, b2_, b3_); \
            const f32x2 as_ = (a0_ + a1_) + (a2_ + a3_), bs_ = (b0_ + b1_) + (b2_ + b3_); PA = as_[0] + as_[1]; PB = bs_[0] + bs_[1]; } while (0)
#define STAGE_B(IDX, PA, PB, WA, WB) do { const float cs_ = pair_wave_sum(PA, PB, odd);                           \
            const float wl_ = gtl[IDX] * gelu_tanh(cs_ * sul[IDX] + cel[IDX]);                            \
            WA = dpp_f<0xA0>(wl_); WB = dpp_f<0xF5>(wl_); } while (0)
#define STAGE_C(SA, SB, WA, WB) do { const u32x4 va_ = *(const LAS u32x4*)(ring + (SA) * PE_SLOT + 1024 + lane * 16), vb_ = *(const LAS u32x4*)(ring + (SB) * PE_SLOT + 1024 + lane * 16); \
            VACC(va_, WA); VACC(vb_, WB); } while (0)
#define DMA_WAIT(N) asm volatile("s_waitcnt vmcnt(" #N ")" ::: "memory")
#define LDS_DONE() asm volatile("s_waitcnt lgkmcnt(0)" ::: "memory")
#define PAIR_ITER(P, NS, DOA, UW, DOU, VW, DOV) do { float na_ = 0.f, nb_ = 0.f, wa_, wb_; \
            if (DOA) { DMA_WAIT(UW); STAGE_A(NS, (NS) + 1, na_, nb_); } \
            STAGE_B(e + 2 * (P), pa, pb, wa_, wb_); \
            LDS_DONE(); \
            if (DOU) { ISSUE_U(NS, e + 2 * (P) + 10); ISSUE_U((NS) + 1, e + 2 * (P) + 11); } \
            DMA_WAIT(VW); STAGE_C(2 * (P), 2 * (P) + 1, wa_, wb_); \
            LDS_DONE(); \
            if (DOV) { ISSUE_V(2 * (P), e + 2 * (P) + 8); ISSUE_V(2 * (P) + 1, e + 2 * (P) + 9); } \
            pa = na_; pb = nb_; } while (0)
        float pa, pb;
        if (!DRY) {
        ISSUE_U(0, 0); ISSUE_U(1, 1); ISSUE_U(2, 2); ISSUE_U(3, 3); ISSUE_V(0, 0); ISSUE_V(1, 1); ISSUE_U(4, 4); ISSUE_U(5, 5); ISSUE_V(2, 2); ISSUE_V(3, 3);
        ISSUE_U(6, 6); ISSUE_U(7, 7); ISSUE_V(4, 4); ISSUE_V(5, 5);
        DMA_WAIT(12); STAGE_A(0, 1, pa, pb); LDS_DONE();
        ISSUE_U(0, 8); ISSUE_U(1, 9); ISSUE_V(6, 6); ISSUE_V(7, 7);
#pragma unroll 1
        for (int tr = 0; tr < 14; ++tr) {
            const int e = tr * 8;
            PAIR_ITER(0, 2, true, 14, true, 14, true);
            PAIR_ITER(1, 4, true, 14, true, 14, true);
            PAIR_ITER(2, 6, true, 14, true, 14, true);
            PAIR_ITER(3, 0, true, 14, true, 14, true);
        }
        { const int e = 14 * 8;
            PAIR_ITER(0, 2, true, 14, true, 14, true);
            PAIR_ITER(1, 4, true, 14, true, 14, true);
            PAIR_ITER(2, 6, true, 14, true, 14, true);
            PAIR_ITER(3, 0, true, 14, false, 12, true); }
        { const float* g2 = (const float*)(a.ws + WS_COND) + 5 * 2048; const float* fg = a.in[32];
#pragma unroll
          for (int k = 0; k < 8; ++k) { const int col = lane * 32 + k * 4; gvv[k] = *(const f32x4*)(g2 + col); fvv[k] = *(const f32x4*)(fg + col); } }
        { const int e = 15 * 8;
            PAIR_ITER(0, 2, true, 28, false, 26, false);
            PAIR_ITER(1, 4, true, 24, false, 22, false);
            PAIR_ITER(2, 6, true, 20, false, 18, false);
            PAIR_ITER(3, 0, false, 0, false, 16, false); }
        }
#undef ISSUE_U
#undef ISSUE_V
#undef STAGE_A
#undef STAGE_B
#undef STAGE_C
#undef LDS_DONE
#undef PAIR_ITER
#undef UDOT
#undef VACC
#undef DMA_WAIT
    }
    {
        float* xo = a.out + (size_t)t * 2048;
        float ss = 0.f;
#pragma unroll
        for (int k = 0; k < 8; ++k) {
            const float x1[4] = {bflo(xw[k][0]), bfhi(xw[k][0]), bflo(xw[k][1]), bfhi(xw[k][1])};
#pragma unroll
            for (int e = 0; e < 4; ++e) { const float x2 = x1[e] + PEER_ALPHA * gvv[k][e] * acc[k * 2 + (e >> 1)][e & 1]; acc[k * 2 + (e >> 1)][e & 1] = x2; ss += x2 * x2; }
        }
        ss = wave_sum_bcast(ss);
        const float rstd = rsqrtf(ss * (1.f / 2048.f) + 1e-6f);
#pragma unroll
        for (int k = 0; k < 8; ++k) {
            const int col = lane * 32 + k * 4;
            f32x4 o;
#pragma unroll
            for (int e = 0; e < 4; ++e) o[e] = acc[k * 2 + (e >> 1)][e & 1] * rstd * fvv[k][e];
            if (!DRY || rstd == 123.456f) *(f32x4*)(xo + col) = o;
        }
    }
    __syncthreads();
}
constexpr int NPHASE = 11;
#ifndef DBG
#define DBG 0
#endif
__device__ __forceinline__ void dbg_final_norm(const Args& a, const Ctx& c, const float* src) {
    for (int t = c.bid * 8 + c.wave; t < L_; t += c.nb * 8) {
        const float* xr = src + (size_t)t * 2048 + c.lane * 4; float* o = a.out + (size_t)t * 2048 + c.lane * 4;
        f32x4 v[8]; float ss = 0.f;
#pragma unroll
        for (int j = 0; j < 8; ++j) { v[j] = *(const f32x4*)(xr + j * 256); ss += v[j][0] * v[j][0] + v[j][1] * v[j][1] + v[j][2] * v[j][2] + v[j][3] * v[j][3]; }
        ss = wave_sum(ss);
        const float rstd = rsqrtf(ss * (1.f / 2048.f) + 1e-6f);
#pragma unroll
        for (int j = 0; j < 8; ++j) { const f32x4 g = *(const f32x4*)(a.in[32] + j * 256 + c.lane * 4); *(f32x4*)(o + j * 256) = v[j] * rstd * g; }
    }
}

extern __shared__ __attribute__((aligned(16))) unsigned char smem[];

__global__ void __launch_bounds__(512, 2) fwd(Args a) {
    LAS unsigned char* lds = (LAS unsigned char*)smem;
    Ctx c; c.bid = blockIdx.x; c.nb = gridDim.x; c.tid = threadIdx.x; c.wave = __builtin_amdgcn_readfirstlane(threadIdx.x >> 6); c.lane = threadIdx.x & 63; c.lds = lds;
    volatile LAS unsigned* xbw = (volatile LAS unsigned*)(lds + LDS_BYTES - 16);
    if (c.tid < 4) xbw[c.tid] = 0u;
    __syncthreads();
    const int lo = a.ph_lo, hi = a.ph_hi;
    const bool multi = (hi - lo) > 1;
    XcdBarrier bar; bar.bar = (unsigned*)(a.ws + WS_CTL); bar.x = 0; bar.st = xbw;
    if (multi) bar = xcd_barrier_post((unsigned*)(a.ws + WS_CTL), xbw);
#ifndef PHASE_MASK
#define PHASE_MASK 0xFFFF
#endif
#if DBG == 1
#undef PHASE_MASK
#define PHASE_MASK 0x403
#elif DBG == 2 || DBG == 4 || DBG == 5
#undef PHASE_MASK
#define PHASE_MASK 0x4FF
#endif
#define IN(k) (((PHASE_MASK >> (k)) & 1) && lo <= (k) && (k) < hi)
#define REFRESH() do { int tz_ = threadIdx.x; asm volatile("" : "+v"(tz_)); c.tid = tz_; c.lane = tz_ & 63; c.wave = __builtin_amdgcn_readfirstlane(tz_ >> 6); } while (0)
#define SEAM(k) do { if (IN(k) && IN((k) + 1)) xcd_barrier(bar); } while (0)
#ifndef DUP
#define DUP -1
#endif
#define REP(k) for (int rep_ = 0; rep_ < ((DUP == (k)) ? 2 : 1); ++rep_)
#define DUP2(k, ...) do { __VA_ARGS__; if (DUP == (k)) { __syncthreads(); __VA_ARGS__; } } while (0)

    if (IN(0)) REP(0) { REFRESH(); p0_prologue(a, c); }
    SEAM(0);
    if (IN(1)) { REFRESH(); DUP2(1, p1_hnorm(a, c)); }
    SEAM(1);
    if (IN(2)) { REFRESH();
        pg8::StaticOrder S; S.init((const bf16_t*)(a.ws + WS_H), (const bf16_t*)(a.ws + WS_WIN), 2048, 2048, 2048, L_, DIN_PAD, c.nb, c.bid);
        EpiWin E{(bf16_t*)(a.ws + WS_US), (bf16_t*)(a.ws + WS_Q), (bf16_t*)(a.ws + WS_KROW), (bf16_t*)(a.ws + WS_VROW), (bf16_t*)(a.ws + WS_VT), (float*)(a.ws + WS_GATE)};
        DUP2(2, pg8::gemm_phase<EpiWin, pg8::StaticOrder>(lds, S, E));
    }
    SEAM(2);
    if (IN(3)) { REFRESH();
        DUP2(31, for (int it = c.bid; it < 256; it += c.nb) s5_item<0>(a, c, it >> 2, it & 3));
        __syncthreads();
        CmpOrder S{(const bf16_t*)(a.ws + WS_KROW), (const bf16_t*)(a.ws + WS_VROW), (const bf16_t*)(a.ws + WS_W1), 2048, 4096, 256, c.nb, c.bid};
        EpiSlab E{(float*)(a.ws + WS_SLAB)};
        DUP2(32, pg8::gemm_phase<EpiSlab, CmpOrder>(lds, S, E));
    }
    SEAM(3);
    if (IN(4)) { REFRESH();
        DUP2(41, for (int it = c.bid; it < 256; it += c.nb) cmp_finish_item(a, c, it >> 7, it & 127));
        DUP2(42, for (int it = c.bid; it < 256; it += c.nb) s5_item<1>(a, c, it >> 2, it & 3));
    }
    SEAM(4);
    if (IN(5)) { REFRESH();
#if DBG == 5
        for (size_t i = (size_t)c.bid * NTHREADS + c.tid; i < (size_t)L_ * 1024 / 8; i += (size_t)c.nb * NTHREADS) *(u32x4*)((bf16_t*)(a.ws + WS_YSSM) + i * 8) = (u32x4){0u, 0u, 0u, 0u};
#else
        {
            pg8::StaticOrder S; S.init((const bf16_t*)(a.ws + WS_Z), (const bf16_t*)(a.ws + WS_WGLU), 1024, 1024, 1024, L_, 1024, c.nb, c.bid);
            EpiGlu E{(const bf16_t*)(a.ws + WS_Z), a.in[19], (bf16_t*)(a.ws + WS_Y2), (float*)(a.ws + WS_STSP)};
            DUP2(55, pg8::gemm_phase<EpiGlu, pg8::StaticOrder>(lds, S, E));
        }
#endif
        __syncthreads();
        REP(5)
#if DBG == 4
        for (size_t i = (size_t)c.bid * NTHREADS + c.tid; i < (size_t)L_ * 1024 / 8; i += (size_t)c.nb * NTHREADS) *(u32x4*)((bf16_t*)(a.ws + WS_YATT) + i * 8) = (u32x4){0u, 0u, 0u, 0u};
#else
        {
            unsigned* qhead = (unsigned*)(a.ws + WS_CTL) + 8192;
            volatile LAS unsigned* slot = (volatile LAS unsigned*)(lds + LDS_BYTES - 32);
            for (;;) {
                if (c.tid == 0) *slot = __hip_atomic_fetch_add(qhead, 1u, __ATOMIC_RELAXED, __HIP_MEMORY_SCOPE_AGENT);
                __syncthreads();
                const unsigned q = *slot;
                __syncthreads();
                if (q >= 512u) break;
                attn_item(a, c, 255 - (int)(q >> 1), (int)(q & 1));
            }
        }
#endif
    }
    SEAM(5);
#define WOUT_GEMM(PM0) do { pg8::StaticOrder S; S.init((const bf16_t*)(a.ws + WS_Y2), (const bf16_t*)(a.ws + WS_WOUT), 2048, 2048, 2048, L_ / 2, 2048, c.nb, c.bid, PM0); \
        rsa_prepass(S, (const float*)(a.ws + WS_STSP), (const float*)(a.ws + WS_STAP), (float*)(a.ws + WS_RSA), c.tid); \
        EpiWout E{a.in[0], (const float*)(a.ws + WS_COND) + 2 * 2048, (const float*)(a.ws + WS_F2), (bf16_t*)(a.ws + WS_X1), (bf16_t*)(a.ws + WS_H2), (float*)(a.ws + WS_ST2P), (const float*)(a.ws + WS_RSA)}; \
        pg8::gemm_phase<EpiWout, pg8::StaticOrder>(lds, S, E); __syncthreads(); } while (0)
#define WQ_GEMM(PM0) do { pg8::StaticOrder S; S.init((const bf16_t*)(a.ws + WS_H2), (const bf16_t*)(a.ws + WS_WQ), 2048, 2048, 2048, L_ / 2, 2048, c.nb, c.bid, PM0); \
        rstd2_prepass(S, (const float*)(a.ws + WS_ST2P), (float*)(a.ws + WS_RSTD2), c.tid); \
        EpiQ E{(bf16_t*)(a.ws + WS_QP), (const float*)(a.ws + WS_RSTD2), (const float*)(a.ws + WS_CQ)}; pg8::gemm_phase<EpiQ, pg8::StaticOrder>(lds, S, E); __syncthreads(); } while (0)
#define PEER_STEPS(FIRST, COUNT) do { for (int s_ = (FIRST) + c.bid; s_ < (FIRST) + (COUNT); s_ += c.nb) peer_step<false>(a, c, s_ * 8); } while (0)
    if (IN(6)) { REFRESH(); DUP2(7, p_cqce(a, c)); DUP2(71, WOUT_GEMM(0)); }
    SEAM(6);
    if (IN(7)) { REFRESH(); DUP2(8, WQ_GEMM(0)); }
    SEAM(7);
    if (IN(8)) { REFRESH();
        if ((c.bid >> 3) & 1) PEER_STEPS(0, 512);
        WOUT_GEMM(32);
        if (!((c.bid >> 3) & 1)) PEER_STEPS(0, 512); }
    SEAM(8);
    if (IN(9)) { REFRESH();
        if ((c.bid >> 3) & 1) PEER_STEPS(512, 512);
        WQ_GEMM(32);
        if (!((c.bid >> 3) & 1)) PEER_STEPS(512, 512); }
    SEAM(9);
#if defined(PROBE_DRY)
    if (IN(10)) { REFRESH(); for (int s_ = 1024 + c.bid; s_ < 2048; s_ += c.nb) peer_step<true>(a, c, s_ * 8); __syncthreads(); PEER_STEPS(1024, 1024); }
#else
    if (IN(10)) { REFRESH(); DUP2(11, PEER_STEPS(1024, 1024)); }
#endif
#undef WOUT_GEMM
#undef WQ_GEMM
#undef PEER_STEPS
#undef IN
#undef SEAM
}

#ifndef N_LAUNCHES
#define N_LAUNCHES 1
#endif
extern "C" void kernel_launch(void* const* d_in, const int* in_sizes, int n_in, void* d_out, int out_size, void* d_ws, size_t ws_size, hipStream_t stream) {
    static int grid = 0;
    if (grid == 0) {
        if (n_in != 33 || out_size != L_ * D_ || ws_size < WS_END) { fprintf(stderr, "kernel_launch: unexpected shapes (n_in %d, out %d, ws %zu < %zu); nothing launched\n", n_in, out_size, ws_size, (size_t)WS_END); grid = -1; return; }
        int dev = 0, cus = 0, per_cu = 0;
        if (hipGetDevice(&dev) != hipSuccess || hipDeviceGetAttribute(&cus, hipDeviceAttributeMultiprocessorCount, dev) != hipSuccess) { grid = -1; return; }
        if (hipFuncSetAttribute((const void*)fwd, hipFuncAttributeMaxDynamicSharedMemorySize, LDS_BYTES) != hipSuccess) { fprintf(stderr, "kernel_launch: hipFuncSetAttribute failed\n"); grid = -1; return; }
        if (hipOccupancyMaxActiveBlocksPerMultiprocessor(&per_cu, (const void*)fwd, NTHREADS, LDS_BYTES) != hipSuccess || per_cu < 1) { fprintf(stderr, "kernel_launch: occupancy query says %d\n", per_cu); (void)hipGetLastError(); grid = -1; return; }
        grid = cus;
    }
    if (grid < 0) return;
    (void)hipMemsetAsync((char*)d_ws + WS_CTL, 0, CTL_BYTES, stream);
    Args a{};
    for (int i = 0; i < 33; ++i) a.in[i] = (const float*)d_in[i];
    a.out = (float*)d_out; a.ws = (unsigned char*)d_ws;
    if (N_LAUNCHES == 1) { a.ph_lo = 0; a.ph_hi = NPHASE; hipLaunchKernelGGL(fwd, dim3(grid), dim3(NTHREADS), LDS_BYTES, stream, a); }
    else for (int p = 0; p < NPHASE; ++p) { a.ph_lo = p; a.ph_hi = p + 1; hipLaunchKernelGGL(fwd, dim3(grid), dim3(NTHREADS), LDS_BYTES, stream, a); }
}
```

```cpp
#include <hip/hip_runtime.h>
#include <stdint.h>
#include <stdio.h>

#define LAS __attribute__((address_space(3)))
typedef unsigned short bf16_t;
typedef short bf16x8 __attribute__((ext_vector_type(8)));
typedef float f32x2 __attribute__((ext_vector_type(2)));
typedef float f32x4 __attribute__((ext_vector_type(4)));
typedef float f32x16 __attribute__((ext_vector_type(16)));
typedef unsigned u32x2 __attribute__((ext_vector_type(2)));
typedef unsigned u32x4 __attribute__((ext_vector_type(4)));
typedef __bf16 bfv2 __attribute__((ext_vector_type(2)));
typedef unsigned u32x6 __attribute__((ext_vector_type(6)));
typedef float f32x32 __attribute__((ext_vector_type(32)));

constexpr int L_ = 16384, D_ = 2048, DSSM = 1024, DATT = 1024, DIN = 3608, DIN_PAD = 3840;
constexpr int NADA = 12288;
constexpr float LOG2E = 1.4426950408889634f;
constexpr float QSCALE = 0.08838834764831845f * 1.4426950408889634f;
constexpr int TBN = 800;
constexpr int NTHREADS = 512;
constexpr int LDS_BYTES = 163840;

constexpr size_t al256(size_t x) { return (x + 255) & ~(size_t)255; }
constexpr size_t WS_CTL   = 0;                                  constexpr size_t CTL_BYTES = 65536;
constexpr size_t WS_CONDP = WS_CTL + CTL_BYTES;
constexpr size_t WS_COND  = WS_CONDP + 32 * 12288 * 4;
constexpr size_t WS_TB    = WS_COND + 12288 * 4;
constexpr size_t WS_BPE   = al256(WS_TB + 8 * TBN * 4);
constexpr size_t WS_S5P   = al256(WS_BPE + 2 * 256 * 4);
constexpr size_t WS_S5F   = WS_S5P + 2 * 64 * 64 * 2 * 4;
constexpr size_t WS_S5MT  = WS_S5F + 64 * 4 * 128 * 4;
constexpr size_t WS_S5WE  = WS_S5MT + (size_t)64 * 256 * 256 * 2;
constexpr size_t WS_S5WC  = WS_S5WE + (size_t)64 * 128 * 256 * 2;
constexpr size_t WS_WIN   = WS_S5WC + (size_t)64 * 256 * 128 * 2;
constexpr size_t WS_WGLU  = WS_WIN + (size_t)DIN_PAD * 2048 * 2;
constexpr size_t WS_WOUT  = WS_WGLU + (size_t)1024 * 1024 * 2;
constexpr size_t WS_WQ    = WS_WOUT + (size_t)2048 * 2048 * 2;
constexpr size_t WS_W1    = WS_WQ + (size_t)2048 * 2048 * 2;
constexpr size_t WS_W2    = WS_W1 + (size_t)2 * 256 * 4096 * 2;
constexpr size_t WS_PK    = WS_W2 + (size_t)2 * 128 * 256 * 2;
constexpr size_t WS_PU    = WS_PK + (size_t)2 * 128 * 128 * 2;
constexpr size_t WS_PV    = WS_PU + (size_t)16384 * 1024;
constexpr size_t WS_PSC   = WS_PV + (size_t)16384 * 1024;
constexpr size_t WS_BPEP  = WS_PSC + (size_t)4 * 16384 * 4;
constexpr size_t WS_H     = WS_BPEP + (size_t)32 * 2 * 256 * 4;
constexpr size_t WS_US    = WS_H + (size_t)16384 * 2048 * 2;
constexpr size_t WS_Q     = WS_US + (size_t)16384 * 1024 * 2;
constexpr size_t WS_QP    = WS_US;
constexpr size_t WS_KROW  = WS_Q + (size_t)16384 * 1024 * 2;
constexpr size_t WS_VROW  = WS_KROW + (size_t)6 * 16384 * 128 * 2;
constexpr size_t WS_VT    = WS_VROW + (size_t)2 * 16384 * 128 * 2 + 8192;
constexpr size_t WS_GATE  = WS_VT + (size_t)4 * 128 * 16384 * 2;
constexpr size_t WS_SLAB  = WS_GATE + (size_t)16384 * 24 * 4;
constexpr size_t WS_KC    = WS_SLAB + (size_t)2 * 16 * 2048 * 256 * 4;
constexpr size_t WS_VCT   = WS_KC + (size_t)2 * 1024 * 128 * 2;
constexpr size_t WS_Z     = WS_VCT + (size_t)2 * 128 * 1024 * 2;
constexpr size_t WS_YSSM  = WS_Z + (size_t)16384 * 1024 * 2;
constexpr size_t WS_YATT  = WS_YSSM + (size_t)16384 * 1024 * 2;
constexpr size_t WS_H2    = WS_SLAB;
constexpr size_t WS_Y2    = WS_YSSM;
constexpr size_t WS_X1    = WS_H;
constexpr size_t WS_ST2P  = WS_YATT + (size_t)16384 * 1024 * 2;
constexpr size_t WS_RSTD2 = WS_ST2P + (size_t)16384 * 32 * 4;
constexpr size_t WS_F2    = WS_RSTD2 + (size_t)16384 * 4;
constexpr size_t WS_CQ    = WS_F2 + 2048 * 4;
constexpr size_t WS_STSP  = WS_CQ + 2048 * 4;
constexpr size_t WS_STAP  = WS_STSP + (size_t)16384 * 16 * 4;
constexpr size_t WS_RSA   = WS_STAP + (size_t)16384 * 2 * 4;
constexpr size_t WS_END   = WS_RSA + (size_t)16384 * 2 * 4;
static_assert(WS_END < (size_t)530 * 1024 * 1024, "workspace map too large");

struct Args { const float* in[33]; float* out; unsigned char* ws; int ph_lo, ph_hi; };

__device__ __forceinline__ unsigned cvt_pk_bf16(float lo, float hi) { bfv2 v; v[0] = (__bf16)lo; v[1] = (__bf16)hi; return __builtin_bit_cast(unsigned, v); }
__device__ __forceinline__ bf16_t f2bf(float f) { return (bf16_t)(cvt_pk_bf16(f, 0.f) & 0xffffu); }
__device__ __forceinline__ float bf2f(unsigned b) { return __uint_as_float(b << 16); }
__device__ __forceinline__ float bflo(unsigned w) { return __uint_as_float(w << 16); }
__device__ __forceinline__ float bfhi(unsigned w) { return __uint_as_float(w & 0xffff0000u); }
__device__ __forceinline__ float fexp2(float x) { return __builtin_amdgcn_exp2f(x); }
__device__ __forceinline__ float frcp(float x) { return __builtin_amdgcn_rcpf(x); }
__device__ __forceinline__ float sigmoidf_(float x) { return frcp(1.f + fexp2(-LOG2E * x)); }
__device__ __forceinline__ float gelu_tanh(float x) {
    const float u = x * (1.f + 0.044715f * x * x);
    return x * frcp(1.f + fexp2(-2.f * 0.7978845608028654f * LOG2E * u));
}
__device__ __forceinline__ float shfl_xor_f(float v, int m) { return __shfl_xor(v, m, 64); }
__device__ __forceinline__ float wave_sum(float v) {
#pragma unroll
    for (int m = 32; m >= 1; m >>= 1) v += __shfl_xor(v, m, 64);
    return v;
}
__device__ __forceinline__ float wave_max(float v) {
#pragma unroll
    for (int m = 32; m >= 1; m >>= 1) v = fmaxf(v, __shfl_xor(v, m, 64));
    return v;
}
template <int CTRL> __device__ __forceinline__ float dpp_f(float x) { return __int_as_float(__builtin_amdgcn_update_dpp(0, __float_as_int(x), CTRL, 0xf, 0xf, false)); }
__device__ __forceinline__ float wave_max_bcast(float v) {
    v = fmaxf(v, dpp_f<0xB1>(v)); v = fmaxf(v, dpp_f<0x4E>(v)); v = fmaxf(v, dpp_f<0x141>(v)); v = fmaxf(v, dpp_f<0x140>(v));
    v = fmaxf(v, __int_as_float(__builtin_amdgcn_update_dpp(__float_as_int(v), __float_as_int(v), 0x142, 0xa, 0xf, false)));
    v = fmaxf(v, __int_as_float(__builtin_amdgcn_update_dpp(__float_as_int(v), __float_as_int(v), 0x143, 0xc, 0xf, false)));
    return __int_as_float(__builtin_amdgcn_readlane(__float_as_int(v), 63));
}
__device__ __forceinline__ unsigned wave_umax_bcast(unsigned v) {
#define UDPP_(x, ctrl, rm) (unsigned)__builtin_amdgcn_update_dpp((int)(x), (int)(x), ctrl, rm, 0xf, false)
    v = max(v, UDPP_(v, 0xB1, 0xf)); v = max(v, UDPP_(v, 0x4E, 0xf)); v = max(v, UDPP_(v, 0x141, 0xf)); v = max(v, UDPP_(v, 0x140, 0xf));
    v = max(v, UDPP_(v, 0x142, 0xa)); v = max(v, UDPP_(v, 0x143, 0xc));
#undef UDPP_
    return (unsigned)__builtin_amdgcn_readlane((int)v, 63);
}
__device__ __forceinline__ float quad_sum(float x) { x += dpp_f<0xB1>(x); x += dpp_f<0x4E>(x); return x; }
template <int SEL> __device__ __forceinline__ f32x2 fp4_unpk(unsigned w) { return __builtin_amdgcn_cvt_scalef32_pk_f32_fp4(w, 1.0f, SEL); }
template <int SEL> __device__ __forceinline__ unsigned fp4_pk(unsigned w, float a, float b) { return __builtin_amdgcn_cvt_scalef32_pk_fp4_f32(w, a, b, 1.0f, SEL); }
__device__ __forceinline__ f32x4 mfma16(bf16x8 a, bf16x8 b, f32x4 c) { return __builtin_amdgcn_mfma_f32_16x16x32_bf16(a, b, c, 0, 0, 0); }
__device__ __forceinline__ f32x16 mfma32(bf16x8 a, bf16x8 b, f32x16 c) { return __builtin_amdgcn_mfma_f32_32x32x16_bf16(a, b, c, 0, 0, 0); }
#define XB_TMO      128
#define XB_XCNT(j)  (256  + 64 * (j))
#define XB_XSUB(j)  (1280 + 64 * (j))
#define XB_XGEN(j)  (2304 + 64 * (j))
#define XB_TOP      3328
#define XB_TOPGEN   3392
#define XCD_BAR_WORDS 3456
#define XB_SPIN_CAP (1u << 18)

__device__ __forceinline__ unsigned xb_ld(unsigned* p)              { return __hip_atomic_load(p, __ATOMIC_RELAXED, __HIP_MEMORY_SCOPE_AGENT); }
__device__ __forceinline__ unsigned xb_add(unsigned* p, unsigned v) { return __hip_atomic_fetch_add(p, v, __ATOMIC_RELAXED, __HIP_MEMORY_SCOPE_AGENT); }
__device__ __forceinline__ unsigned xb_xcc_id() { return (unsigned)__builtin_amdgcn_s_getreg((3 << 11) | 20) & 0xFu; }
#define XB_SPIN(cond, bar) do { unsigned _sp = 0; while (cond) { __builtin_amdgcn_s_sleep(1); \
    if ((++_sp & 255u) == 0u) { if (xb_ld(&(bar)[XB_TMO])) break; if (_sp > XB_SPIN_CAP) { atomicAdd(&(bar)[XB_TMO], 1u); break; } } } } while (0)

struct XcdBarrier {
    unsigned* bar; unsigned x;
    volatile LAS unsigned* st;
};
__device__ __forceinline__ XcdBarrier xcd_barrier_post(unsigned* bar, volatile LAS unsigned* st) {
    XcdBarrier b; b.bar = bar; b.x = xb_xcc_id(); b.st = st;
    if (threadIdx.x == 0) (void)xb_add(&bar[XB_XCNT(b.x)], 1u);
    return b;
}
__device__ __forceinline__ void xcd_barrier_complete(unsigned* bar, unsigned x, unsigned& nloc, unsigned& nx) {
    const unsigned G = gridDim.x * gridDim.y * gridDim.z;
    unsigned sum, cnt, mine, sp = 0u;
    for (;;) {
        sum = 0u; cnt = 0u; mine = 0u;
#pragma unroll
        for (unsigned j = 0; j < 16; ++j) { const unsigned c = xb_ld(&bar[XB_XCNT(j)]); sum += c; cnt += (c > 0u) ? 1u : 0u; mine = (j == x) ? c : mine; }
        if (sum == G) break;
        __builtin_amdgcn_s_sleep(1);
        if ((++sp & 255u) == 0u) { if (xb_ld(&bar[XB_TMO])) break; if (sp > XB_SPIN_CAP) { atomicAdd(&bar[XB_TMO], 1u); break; } }
    }
    nloc = mine > 0u ? mine : 1u; nx = cnt > 0u ? cnt : 1u;
}
__device__ __forceinline__ void xcd_barrier(const XcdBarrier& b) {
    asm volatile("s_waitcnt vmcnt(0)" ::: "memory");
    __syncthreads();
    if (threadIdx.x == 0) {
        unsigned* bar = b.bar;
        __builtin_amdgcn_s_waitcnt(0);
        unsigned nloc = b.st[0], nx = b.st[1];
        if (nloc == 0u) { xcd_barrier_complete(bar, b.x, nloc, nx); b.st[0] = nloc; b.st[1] = nx; }
        const unsigned old = xb_add(&bar[XB_XSUB(b.x)], 1u);
        const unsigned gen = old / nloc;
        if (old + 1u == (gen + 1u) * nloc) {
            __builtin_amdgcn_fence(__ATOMIC_RELEASE, "agent");
            asm volatile("s_waitcnt vmcnt(0)" ::: "memory");
            const unsigned og = xb_add(&bar[XB_TOP], 1u);
            const unsigned tg = og / nx;
            if (og + 1u == (tg + 1u) * nx) xb_add(&bar[XB_TOPGEN], 1u);
            else XB_SPIN(xb_ld(&bar[XB_TOPGEN]) == tg, bar);
            __builtin_amdgcn_fence(__ATOMIC_ACQUIRE, "agent");
            xb_add(&bar[XB_XGEN(b.x)], 1u);
            asm volatile("s_waitcnt vmcnt(0)" ::: "memory");
        } else {
            XB_SPIN(xb_ld(&bar[XB_XGEN(b.x)]) == gen, bar);
            __builtin_amdgcn_fence(__ATOMIC_ACQUIRE, "agent");
            asm volatile("s_waitcnt vmcnt(0)" ::: "memory");
        }
    }
    __syncthreads();
}

namespace pg8 {
constexpr int BM = 256, BK = 64, HALF = 128, HTB = HALF * BK * 2, STAGE_BYTES = 8 * HTB, NXCD = 8, WGM = 8;
__host__ __device__ __forceinline__ int lds_byte(int r, int c) { const int st = (r >> 4) * 2 + (c >> 5), rr = r & 15, cc = c & 31, ob = rr * 64 + cc * 2; return st * 1024 + (ob ^ (((ob >> 9) & 1) << 5)); }
__host__ __device__ __forceinline__ void stage_rc(int b, int& R, int& C) { const int st = b / 1024, sb = b % 1024, swz = sb ^ (((sb >> 9) & 1) << 5); R = (st >> 1) * 16 + swz / 64; C = (st & 1) * 32 + (swz % 64) / 2; }
__host__ __device__ __forceinline__ int perm32(int rho) { const int n = rho >> 4, i = rho & 15; return 8 * (i >> 2) + 4 * n + (i & 3); }

struct Unit { int pm, pn, z; };
struct StaticOrder {
    const bf16_t* A; const bf16_t* Bt; int lda, ldb, K;
    int nM, nN, nwg, G, c, pm0;
    __device__ void init(const bf16_t* A_, const bf16_t* Bt_, int lda_, int ldb_, int K_, int M, int N, int G_, int c_, int pm0_ = 0) { A = A_; Bt = Bt_; lda = lda_; ldb = ldb_; K = K_; nM = M / BM; nN = N / BM; nwg = nM * nN; G = G_; c = c_; pm0 = pm0_; }
    __device__ bool next(int i, Unit& u) const {
        const long Lx = (long)i * G + c; if (Lx >= nwg) return false;
        int wgid = (int)Lx; { const int q = nwg / NXCD, r = nwg % NXCD, xcd = wgid % NXCD, off = wgid / NXCD; wgid = (xcd < r ? xcd * (q + 1) : r * (q + 1) + (xcd - r) * q) + off; }
        const int nig = WGM * nN, gid = wgid / nig, fm = gid * WGM, gsz = (nM - fm) < WGM ? (nM - fm) : WGM;
        u.pm = pm0 + fm + ((wgid % nig) % gsz); u.pn = (wgid % nig) / gsz; u.z = 0; return true;
    }
    __device__ __forceinline__ const char* a_base(const Unit& u) const { return (const char*)(A + (size_t)u.pm * BM * lda); }
    __device__ __forceinline__ const char* b_base(const Unit& u) const { return (const char*)(Bt + (size_t)u.pn * BM * ldb); }
};

template <class Epi, class Sched>
__device__ __forceinline__ void gemm_phase(LAS unsigned char* lds, const Sched& S, const Epi& E) {
    const int tid = threadIdx.x, wid = __builtin_amdgcn_readfirstlane(tid >> 6), lane = tid & 63, wr = wid >> 2, wc = wid & 3, fr = lane & 15, fq = lane >> 4;
    const int K = S.K, nt = K / BK, lda = S.lda, ldb = S.ldb;
    unsigned voffA[2], voffB[2];
#pragma unroll
    for (int i = 0; i < 2; ++i) { int R, C; stage_rc(tid * 16 + i * 8192, R, C); const int Rb = Epi::PERM ? ((R & ~31) + perm32(R & 31)) : R;
        voffA[i] = (unsigned)(R * lda + C) * 2u; voffB[i] = (unsigned)(Rb * ldb + C) * 2u; }
    const size_t kstep = (size_t)(BK * 2);
    const size_t hstepA = (size_t)HALF * lda * 2, hstepB = (size_t)HALF * ldb * 2;
    const unsigned ldsw = (unsigned)wid * 1024u;
    const int aoff = lds_byte(wr * 64 + fr, fq * 8), boff = lds_byte(wc * 32 + fr, fq * 8);
#define PG8_SA(b, h) (((b) * 2 + (h)) * HTB)
#define PG8_SB(b, h) ((4 + (b) * 2 + (h)) * HTB)
#define PG8_STAGE(bufoff, gbase, voff) do { _Pragma("unroll") for (int _i = 0; _i < 2; ++_i) \
        __builtin_amdgcn_global_load_lds((const unsigned*)((const char*)(gbase) + (voff)[_i]), (LAS unsigned*)(lds + (bufoff) + ldsw + _i * 8192), 16, 0, 0); } while (0)
#define PG8_LDA(dst, b, h) do { _Pragma("unroll") for (int m = 0; m < 4; ++m) _Pragma("unroll") for (int k = 0; k < 2; ++k) dst[m][k] = *(const LAS bf16x8*)(lds + PG8_SA(b, h) + aoff + m * 2048 + k * 1024); } while (0)
#define PG8_LDB(dst, b, h) do { _Pragma("unroll") for (int n = 0; n < 2; ++n) _Pragma("unroll") for (int k = 0; k < 2; ++k) dst[n][k] = *(const LAS bf16x8*)(lds + PG8_SB(b, h) + boff + n * 2048 + k * 1024); } while (0)
#define PG8_MMA(ai, bj, At, Bt) do { __builtin_amdgcn_s_setprio(1); _Pragma("unroll") for (int m = 0; m < 4; ++m) _Pragma("unroll") for (int n = 0; n < 2; ++n) _Pragma("unroll") for (int k = 0; k < 2; ++k) \
        acc[ai][bj][m][n] = __builtin_amdgcn_mfma_f32_16x16x32_bf16(Bt[n][k], At[m][k], acc[ai][bj][m][n], 0, 0, 0); __builtin_amdgcn_s_setprio(0); } while (0)
#define PG8_WAIT_V(n) asm volatile("s_waitcnt vmcnt(" #n ")" ::: "memory")
#define PG8_WAIT_L(n) asm volatile("s_waitcnt lgkmcnt(" #n ")" ::: "memory")
#define PG8_BAR __builtin_amdgcn_s_barrier()
#define PG8_SCHED __builtin_amdgcn_sched_barrier(0)
    Unit cur, nxt; int ui = 0;
    if (!S.next(0, cur)) return;
    f32x4 acc[2][2][4][2];
#pragma unroll
    for (int a = 0; a < 2; ++a)
#pragma unroll
        for (int b = 0; b < 2; ++b)
#pragma unroll
            for (int m = 0; m < 4; ++m)
#pragma unroll
                for (int n = 0; n < 2; ++n) acc[a][b][m][n] = (f32x4){0.f, 0.f, 0.f, 0.f};
    bf16x8 At[4][2], B0[2][2], B1[2][2];
    const char* cA = S.a_base(cur); const char* cB = S.b_base(cur);
    PG8_STAGE(PG8_SB(0, 0), cB, voffB); PG8_STAGE(PG8_SA(0, 0), cA, voffA); PG8_STAGE(PG8_SB(0, 1), cB + hstepB, voffB); PG8_STAGE(PG8_SA(0, 1), cA + hstepA, voffA);
    if (wr == 1) PG8_BAR;
    PG8_WAIT_V(4); PG8_BAR;
    PG8_STAGE(PG8_SB(1, 0), cB + kstep, voffB); PG8_STAGE(PG8_SA(1, 0), cA + kstep, voffA); PG8_STAGE(PG8_SB(1, 1), cB + hstepB + kstep, voffB);
    PG8_WAIT_V(6); PG8_BAR;
    for (;;) {
        const bool has_next = S.next(ui + 1, nxt);
        const char* nA = has_next ? S.a_base(nxt) : cA; const char* nB = has_next ? S.b_base(nxt) : cB;
        for (int t = 0; t < nt; t += 2) {
            if constexpr (Epi::MIDK) { if (t == (nt >> 1)) E.midk(acc, cur, wr, fr); }
            const bool last = (t == nt - 2);
            const char* a1 = cA + (size_t)(t + 1) * kstep;
            const char* a2 = last ? nA : cA + (size_t)(t + 2) * kstep; const char* b2 = last ? nB : cB + (size_t)(t + 2) * kstep;
            const char* a3 = a2 + kstep; const char* b3 = b2 + kstep;
            PG8_LDB(B0, 0, 0); PG8_SCHED; PG8_LDA(At, 0, 0); PG8_STAGE(PG8_SA(1, 1), a1 + hstepA, voffA);
            PG8_WAIT_L(8); PG8_BAR; PG8_WAIT_L(0); PG8_MMA(0, 0, At, B0); PG8_BAR; PG8_SCHED;
            PG8_LDB(B1, 0, 1); PG8_STAGE(PG8_SB(0, 0), b2, voffB);
            PG8_BAR; PG8_WAIT_L(0); PG8_MMA(0, 1, At, B1); PG8_BAR;
            PG8_LDA(At, 0, 1); PG8_STAGE(PG8_SA(0, 0), a2, voffA);
            PG8_BAR; PG8_WAIT_L(0); PG8_MMA(1, 0, At, B0); PG8_BAR; PG8_SCHED;
            PG8_STAGE(PG8_SB(0, 1), b2 + hstepB, voffB);
            PG8_WAIT_V(6); PG8_BAR; PG8_MMA(1, 1, At, B1); PG8_BAR;
            PG8_LDB(B0, 1, 0); PG8_SCHED; PG8_LDA(At, 1, 0); PG8_STAGE(PG8_SA(0, 1), a2 + hstepA, voffA);
            PG8_WAIT_L(8); PG8_BAR; PG8_WAIT_L(0); PG8_MMA(0, 0, At, B0); PG8_BAR; PG8_SCHED;
            PG8_LDB(B1, 1, 1); PG8_STAGE(PG8_SB(1, 0), b3, voffB);
            PG8_BAR; PG8_WAIT_L(0); PG8_MMA(0, 1, At, B1); PG8_BAR;
            PG8_LDA(At, 1, 1); PG8_STAGE(PG8_SA(1, 0), a3, voffA);
            PG8_BAR; PG8_WAIT_L(0); PG8_MMA(1, 0, At, B0); PG8_BAR; PG8_SCHED;
            PG8_STAGE(PG8_SB(1, 1), b3 + hstepB, voffB);
            PG8_WAIT_V(6); PG8_BAR; PG8_MMA(1, 1, At, B1); PG8_BAR;
        }
        E(acc, cur, wr, wc, fr, fq);
        if (!has_next) break;
#pragma unroll
        for (int a = 0; a < 2; ++a)
#pragma unroll
            for (int b = 0; b < 2; ++b)
#pragma unroll
                for (int m = 0; m < 4; ++m)
#pragma unroll
                    for (int n = 0; n < 2; ++n) acc[a][b][m][n] = (f32x4){0.f, 0.f, 0.f, 0.f};
        cur = nxt; cA = nA; cB = nB; ++ui;
    }
    PG8_WAIT_V(0);
    if (wr == 0) PG8_BAR;
    PG8_BAR;
#undef PG8_SA
#undef PG8_SB
#undef PG8_STAGE
#undef PG8_LDA
#undef PG8_LDB
#undef PG8_MMA
#undef PG8_WAIT_V
#undef PG8_WAIT_L
#undef PG8_BAR
#undef PG8_SCHED
}
}
using pg8::Unit;
__device__ __forceinline__ u32x4 pack8(const f32x4& v0, const f32x4& v1) {
    u32x4 o; o[0] = cvt_pk_bf16(v0[0], v0[1]); o[1] = cvt_pk_bf16(v0[2], v0[3]); o[2] = cvt_pk_bf16(v1[0], v1[1]); o[3] = cvt_pk_bf16(v1[2], v1[3]); return o;
}
struct EpiWin {
    static constexpr bool PERM = true; static constexpr bool MIDK = false;
    bf16_t* US; bf16_t* Q; bf16_t* KROW; bf16_t* VROW; bf16_t* VT; float* GATE;
    __device__ __forceinline__ void operator()(const f32x4 (&acc)[2][2][4][2], const Unit& u, int wr, int wc, int fr, int fq) const {
        const int row0 = u.pm * 256 + wr * 64 + fr; const int pn = u.pn;
#pragma unroll
        for (int ai = 0; ai < 2; ++ai)
#pragma unroll
            for (int m = 0; m < 4; ++m) {
                const int row = row0 + ai * 128 + m * 16;
#pragma unroll
                for (int bj = 0; bj < 2; ++bj) {
                    const f32x4 v0 = acc[ai][bj][m][0], v1 = acc[ai][bj][m][1];
                    const int cin = bj * 128 + wc * 32 + 8 * fq;
                    if (pn < 4) { *(u32x4*)(US + (size_t)row * 1024 + pn * 256 + cin) = pack8(v0, v1); }
                    else if (pn < 8) { *(u32x4*)(Q + (size_t)row * 1024 + (pn - 4) * 256 + cin) = pack8(v0 * QSCALE, v1 * QSCALE); }
                    else if (pn < 14) {
                        const int kvi = pn - 8, branch = kvi >> 1, kvsel = kvi & 1, g = bj, d0 = wc * 32 + 8 * fq;
                        if (kvsel == 0) { *(u32x4*)(KROW + ((size_t)(branch * 2 + g) * L_ + row) * 128 + d0) = pack8(v0, v1); }
                        else if (branch == 0) { *(u32x4*)(VROW + ((size_t)g * L_ + row) * 128 + d0) = pack8(v0, v1); }
                        else {
                            const int prow = ((row & ~12) | ((row & 4) << 1) | ((row & 8) >> 1));
                            bf16_t* vt = VT + ((size_t)((branch - 1) * 2 + g) * 128 + d0) * L_ + prow;
#pragma unroll
                            for (int e = 0; e < 4; ++e) { vt[(size_t)e * L_] = f2bf(v0[e]); vt[(size_t)(e + 4) * L_] = f2bf(v1[e]); }
                        }
                    } else {
                        if (cin < 24) {
                            float* gp = GATE + (size_t)row * 24 + cin;
                            f32x4 s0, s1;
#pragma unroll
                            for (int e = 0; e < 4; ++e) { s0[e] = sigmoidf_(v0[e]); s1[e] = sigmoidf_(v1[e]); }
                            *(f32x4*)gp = s0; *(f32x4*)(gp + 4) = s1;
                        }
                    }
                }
            }
    }
};
struct EpiGlu {
    static constexpr bool PERM = true; static constexpr bool MIDK = false;
    const bf16_t* Z; const float* bglu; bf16_t* Y; float* stsp;
    __device__ __forceinline__ void operator()(const f32x4 (&acc)[2][2][4][2], const Unit& u, int wr, int wc, int fr, int fq) const {
        const int row0 = u.pm * 256 + wr * 64 + fr;
        float ss[2][4];
#pragma unroll
        for (int ai = 0; ai < 2; ++ai)
#pragma unroll
            for (int m = 0; m < 4; ++m) ss[ai][m] = 0.f;
#pragma unroll
        for (int bj = 0; bj < 2; ++bj) {
            const int col = u.pn * 256 + bj * 128 + wc * 32 + 8 * fq;
            const f32x4 b0 = *(const f32x4*)(bglu + col), b1 = *(const f32x4*)(bglu + col + 4);
#pragma unroll
            for (int ai = 0; ai < 2; ++ai)
#pragma unroll
                for (int m = 0; m < 4; ++m) {
                    const int row = row0 + ai * 128 + m * 16;
                    const u32x4 zz = *(const u32x4*)(Z + (size_t)row * 1024 + col);
                    const f32x4 v0 = acc[ai][bj][m][0] + b0, v1 = acc[ai][bj][m][1] + b1;
                    f32x4 o0, o1;
                    o0[0] = bflo(zz[0]) * sigmoidf_(v0[0]); o0[1] = bfhi(zz[0]) * sigmoidf_(v0[1]); o0[2] = bflo(zz[1]) * sigmoidf_(v0[2]); o0[3] = bfhi(zz[1]) * sigmoidf_(v0[3]);
                    o1[0] = bflo(zz[2]) * sigmoidf_(v1[0]); o1[1] = bfhi(zz[2]) * sigmoidf_(v1[1]); o1[2] = bflo(zz[3]) * sigmoidf_(v1[2]); o1[3] = bfhi(zz[3]) * sigmoidf_(v1[3]);
                    *(u32x4*)(Y + (size_t)row * 2048 + col) = pack8(o0, o1);
                    ss[ai][m] += (o0[0] * o0[0] + o0[1] * o0[1]) + (o0[2] * o0[2] + o0[3] * o0[3]) + (o1[0] * o1[0] + o1[1] * o1[1]) + (o1[2] * o1[2] + o1[3] * o1[3]);
                }
        }
#pragma unroll
        for (int ai = 0; ai < 2; ++ai)
#pragma unroll
            for (int m = 0; m < 4; ++m) {
                float s = ss[ai][m];
                s += __shfl_xor(s, 16); s += __shfl_xor(s, 32);
                if (fq == 0) stsp[(size_t)(row0 + ai * 128 + m * 16) * 16 + u.pn * 4 + wc] = s;
            }
    }
};
struct EpiWout {
    static constexpr bool PERM = true; static constexpr bool MIDK = true;
    const float* X; const float* g1; const float* f2; bf16_t* X1; bf16_t* A2; float* st2p; const float* rsa;
    __device__ __forceinline__ void midk(f32x4 (&acc)[2][2][4][2], const Unit& u, int, int) const {
        int tz = threadIdx.x; asm volatile("" : "+v"(tz));
        const int row0 = u.pm * 256 + ((tz >> 8) & 1) * 64 + (tz & 15);
#pragma unroll
        for (int ai = 0; ai < 2; ++ai)
#pragma unroll
            for (int m = 0; m < 4; ++m) {
                const float r = rsa[(size_t)(row0 + ai * 128 + m * 16) * 2];
#pragma unroll
                for (int bj = 0; bj < 2; ++bj)
#pragma unroll
                    for (int n = 0; n < 2; ++n) acc[ai][bj][m][n] *= r;
            }
    }
    __device__ __forceinline__ void operator()(const f32x4 (&acc)[2][2][4][2], const Unit& u, int, int, int, int) const {
        int tz = threadIdx.x; asm volatile("" : "+v"(tz));
        const int wr = (tz >> 8) & 1, wc = (tz >> 6) & 3, fr = tz & 15, fq = (tz >> 4) & 3;
        const int row0 = u.pm * 256 + wr * 64 + fr, col0 = u.pn * 256 + wc * 32 + 8 * fq;
        float ss[2][4], ra[2][4];
#pragma unroll
        for (int ai = 0; ai < 2; ++ai)
#pragma unroll
            for (int m = 0; m < 4; ++m) { ss[ai][m] = 0.f; ra[ai][m] = rsa[(size_t)(row0 + ai * 128 + m * 16) * 2 + 1]; }
#pragma unroll
        for (int bj = 0; bj < 2; ++bj) {
            const int col = col0 + bj * 128;
            const f32x4 g0 = *(const f32x4*)(g1 + col), g4 = *(const f32x4*)(g1 + col + 4), f0 = *(const f32x4*)(f2 + col), f4 = *(const f32x4*)(f2 + col + 4);
#pragma unroll
            for (int ai = 0; ai < 2; ++ai)
#pragma unroll
                for (int m = 0; m < 4; ++m) {
                    const size_t off = (size_t)(row0 + ai * 128 + m * 16) * 2048 + col;
                    const f32x4 x0 = *(const f32x4*)(X + off), x4 = *(const f32x4*)(X + off + 4);
                    const f32x4 v0 = x0 + g0 * (acc[ai][bj][m][0] * ra[ai][m]), v1 = x4 + g4 * (acc[ai][bj][m][1] * ra[ai][m]);
                    *(u32x4*)(X1 + off) = pack8(v0, v1);
                    *(u32x4*)(A2 + off) = pack8(v0 * f0, v1 * f4);
                    ss[ai][m] += (v0[0] * v0[0] + v0[1] * v0[1]) + (v0[2] * v0[2] + v0[3] * v0[3]) + (v1[0] * v1[0] + v1[1] * v1[1]) + (v1[2] * v1[2] + v1[3] * v1[3]);
                }
        }
#pragma unroll
        for (int ai = 0; ai < 2; ++ai)
#pragma unroll
            for (int m = 0; m < 4; ++m) {
                float s = ss[ai][m];
                s += __shfl_xor(s, 16); s += __shfl_xor(s, 32);
                if (fq == 0) st2p[(size_t)(row0 + ai * 128 + m * 16) * 32 + u.pn * 4 + wc] = s;
            }
    }
};
struct EpiQ {
    static constexpr bool PERM = true; static constexpr bool MIDK = false;
    bf16_t* O; const float* rstd2; const float* cq;
    __device__ __forceinline__ void operator()(const f32x4 (&acc)[2][2][4][2], const Unit& u, int wr, int wc, int fr, int fq) const {
        const int row0 = u.pm * 256 + wr * 64 + fr, col0 = u.pn * 256 + wc * 32 + 8 * fq;
        float rs[2][4];
#pragma unroll
        for (int ai = 0; ai < 2; ++ai)
#pragma unroll
            for (int m = 0; m < 4; ++m) rs[ai][m] = rstd2[row0 + ai * 128 + m * 16];
#pragma unroll
        for (int bj = 0; bj < 2; ++bj) {
            const int col = col0 + bj * 128;
            const f32x4 c0 = *(const f32x4*)(cq + col), c4 = *(const f32x4*)(cq + col + 4);
#pragma unroll
            for (int ai = 0; ai < 2; ++ai)
#pragma unroll
                for (int m = 0; m < 4; ++m)
                    *(u32x4*)(O + (size_t)(row0 + ai * 128 + m * 16) * 2048 + col) = pack8(acc[ai][bj][m][0] * rs[ai][m] + c0, acc[ai][bj][m][1] * rs[ai][m] + c4);
        }
    }
};
template <class Sched>
__device__ __forceinline__ void rstd2_prepass(const Sched& S, const float* st2p, float* rstd2, int tid) {
    Unit u;
    for (int i = 0; S.next(i, u); ++i)
        if (tid < 256) {
            const int row = u.pm * 256 + tid; const f32x4* p = (const f32x4*)(st2p + (size_t)row * 32);
            float s = 0.f;
#pragma unroll
            for (int k = 0; k < 8; ++k) { const f32x4 v = p[k]; s += (v[0] + v[1]) + (v[2] + v[3]); }
            rstd2[row] = rsqrtf(s * (1.f / 2048.f) + 1e-6f);
        }
    __syncthreads();
}
struct EpiSlab {
    static constexpr bool PERM = false; static constexpr bool MIDK = false;
    float* SL;
    __device__ __forceinline__ void operator()(const f32x4 (&acc)[2][2][4][2], const Unit& u, int wr, int wc, int fr, int fq) const {
        float* base = SL + (size_t)u.z * 2048 * 256;
        const int row0 = u.pm * 256 + wr * 64 + fr, col0 = wc * 32 + 4 * fq;
#pragma unroll
        for (int ai = 0; ai < 2; ++ai)
#pragma unroll
            for (int m = 0; m < 4; ++m)
#pragma unroll
                for (int bj = 0; bj < 2; ++bj)
#pragma unroll
                    for (int n = 0; n < 2; ++n)
                        *(f32x4*)(base + (size_t)(row0 + ai * 128 + m * 16) * 256 + col0 + bj * 128 + n * 16) = acc[ai][bj][m][n];
    }
};
struct CmpOrder {
    const bf16_t* KROW; const bf16_t* VROW; const bf16_t* W1; int lda, ldb, K; int G, c;
    __device__ bool next(int i, Unit& u) const {
        const int x = i * G + c; if (x >= 256) return false;
        const int kvsel = x >> 7, pm = (x & 127) >> 4, ks = x & 15; u.pm = pm; u.pn = 0; u.z = kvsel * 16 + ks; return true;
    }
    __device__ __forceinline__ const char* a_base(const Unit& u) const { return (const char*)(((u.z >> 4) ? VROW : KROW) + (size_t)u.pm * 256 * 2048 + (u.z & 15) * 256); }
    __device__ __forceinline__ const char* b_base(const Unit& u) const { return (const char*)(W1 + (size_t)(u.z >> 4) * 256 * 4096 + (u.z & 15) * 256); }
};
template <class Sched>
__device__ __forceinline__ void rsa_prepass(const Sched& S, const float* stsp, const float* stap, float* rsa, int tid) {
    Unit u;
    for (int i = 0; S.next(i, u); ++i)
        if (tid < 256) {
            const int row = u.pm * 256 + tid; const f32x4* p = (const f32x4*)(stsp + (size_t)row * 16);
            float s = 0.f;
#pragma unroll
            for (int k = 0; k < 4; ++k) { const f32x4 v = p[k]; s += (v[0] + v[1]) + (v[2] + v[3]); }
            const f32x2 q = *(const f32x2*)(stap + (size_t)row * 2);
            const float rs = rsqrtf(s * (1.f / 1024.f) + 1e-6f), ra = rsqrtf((q[0] + q[1]) * (1.f / 1024.f) + 1e-6f);
            f32x2 o; o[0] = rs / ra; o[1] = ra;
            *(f32x2*)(rsa + (size_t)row * 2) = o;
        }
    __syncthreads();
}
struct Ctx { int bid, nb, tid, wave, lane; LAS unsigned char* lds; };

__device__ __forceinline__ void p0_cond(const Args& a, const Ctx& c) {
    const float* cv = a.in[1]; const float* w = a.in[2]; float* condp = (float*)(a.ws + WS_CONDP);
    for (int u = c.bid * 8 + c.wave; u < 1536; u += c.nb * 8) {
        const int cc = u % 48, kc = u / 48;
        const float* wp = w + (size_t)(kc * 64) * NADA + cc * 256 + c.lane * 4;
        f32x4 acc = {0.f, 0.f, 0.f, 0.f};
#pragma unroll 16
        for (int k = 0; k < 64; ++k) { const float x = cv[kc * 64 + k]; const float s = x / (1.f + __expf(-x)); acc += s * *(const f32x4*)(wp + (size_t)k * NADA); }
        *(f32x4*)(condp + (size_t)kc * NADA + cc * 256 + c.lane * 4) = acc;
    }
}
struct TDesc { const float* src; bf16_t* dst; const float* ks0; const float* ks1; int K, N, nkt, nt, kt; };
__device__ __forceinline__ TDesc conv_decode(const Args& a, int tix) {
    TDesc d; d.ks0 = nullptr; d.ks1 = nullptr; int local;
    if (tix < 1920) { local = tix; d.src = a.in[6]; d.dst = (bf16_t*)(a.ws + WS_WIN); d.K = 2048; d.N = DIN; }
    else if (tix < 2176) { local = tix - 1920; d.src = a.in[18]; d.dst = (bf16_t*)(a.ws + WS_WGLU); d.K = 1024; d.N = 1024; }
    else if (tix < 3200) { local = tix - 2176; d.src = a.in[7]; d.dst = (bf16_t*)(a.ws + WS_WOUT); d.K = 2048; d.N = 2048; d.ks0 = a.in[8]; d.ks1 = a.in[9]; }
    else if (tix < 4224) { local = tix - 3200; d.src = a.in[27]; d.dst = (bf16_t*)(a.ws + WS_WQ); d.K = 2048; d.N = 2048; }
    else if (tix < 4480) { local = tix - 4224; d.src = a.in[21]; d.dst = (bf16_t*)(a.ws + WS_W1); d.K = 4096; d.N = 256; }
    else if (tix < 4736) { local = tix - 4480; d.src = a.in[24]; d.dst = (bf16_t*)(a.ws + WS_W1) + 256 * 4096; d.K = 4096; d.N = 256; }
    else if (tix < 4744) { local = tix - 4736; d.src = a.in[22]; d.dst = (bf16_t*)(a.ws + WS_W2); d.K = 256; d.N = 128; }
    else { local = tix - 4744; d.src = a.in[25]; d.dst = (bf16_t*)(a.ws + WS_W2) + 128 * 256; d.K = 256; d.N = 128; }
    d.nkt = d.K / 64; d.nt = local / d.nkt; d.kt = local % d.nkt;
    return d;
}
constexpr int CONV_TILES = 4752;
__device__ __forceinline__ void conv_T_all(const Args& a, const Ctx& c) {
    LAS float* tile = (LAS float*)c.lds;
    const int r = c.tid >> 4, c4 = c.tid & 15;
    f32x4 b0[2], b1[2], b2[2]; float s0[2] = {1.f, 1.f}, s1[2] = {1.f, 1.f}, s2[2] = {1.f, 1.f};
#define CONVT_LD(buf, sc, tix_) do { if ((tix_) < CONV_TILES) { const TDesc d_ = conv_decode(a, (tix_)); const int n_ = d_.nt * 64 + 4 * c4; \
        _Pragma("unroll") for (int i = 0; i < 2; ++i) { const int k_ = d_.kt * 64 + r + 32 * i; buf[i] = (f32x4){0.f, 0.f, 0.f, 0.f}; if (n_ < d_.N) buf[i] = *(const f32x4*)(d_.src + (size_t)k_ * d_.N + n_); \
            sc[i] = 1.f; if (d_.ks0) sc[i] = k_ < 1024 ? d_.ks0[k_] : d_.ks1[k_ - 1024]; } } } while (0)
#define CONVT_DO(buf, sc, tix_) do { if ((tix_) < CONV_TILES) { const TDesc d_ = conv_decode(a, (tix_)); \
        _Pragma("unroll") for (int i = 0; i < 2; ++i) { LAS float* tp = tile + (r + 32 * i) * 65 + 4 * c4; tp[0] = buf[i][0] * sc[i]; tp[1] = buf[i][1] * sc[i]; tp[2] = buf[i][2] * sc[i]; tp[3] = buf[i][3] * sc[i]; } \
        __syncthreads(); \
        { const int n = c.tid >> 3, kq = c.tid & 7; float w[8]; \
          _Pragma("unroll") for (int j = 0; j < 8; ++j) w[j] = tile[(kq * 8 + j) * 65 + n]; \
          u32x4 o; o[0] = cvt_pk_bf16(w[0], w[1]); o[1] = cvt_pk_bf16(w[2], w[3]); o[2] = cvt_pk_bf16(w[4], w[5]); o[3] = cvt_pk_bf16(w[6], w[7]); \
          *(u32x4*)(d_.dst + (size_t)(d_.nt * 64 + n) * d_.K + d_.kt * 64 + kq * 8) = o; } \
        __syncthreads(); } } while (0)
    int tix = c.bid;
    CONVT_LD(b0, s0, tix); CONVT_LD(b1, s1, tix + c.nb);
    for (; tix < CONV_TILES; tix += 3 * c.nb) {
        CONVT_LD(b2, s2, tix + 2 * c.nb); CONVT_DO(b0, s0, tix);
        CONVT_LD(b0, s0, tix + 3 * c.nb); CONVT_DO(b1, s1, tix + c.nb);
        CONVT_LD(b1, s1, tix + 4 * c.nb); CONVT_DO(b2, s2, tix + 2 * c.nb);
    }
#undef CONVT_LD
#undef CONVT_DO
}
__device__ __forceinline__ void conv_fp4rows(const float* src, unsigned char* dst4, float* scl, int rows, const Ctx& c) {
    const int stride = c.nb * 8;
    f32x4 b0[8], b1[8], b2[8];
#define FP4R_LD(buf, r_) do { if ((r_) < rows) { _Pragma("unroll") for (int j = 0; j < 8; ++j) buf[j] = *(const f32x4*)(src + (size_t)(r_) * 2048 + 256 * j + c.lane * 4); } } while (0)
#define FP4R_DO(buf, r_) do { if ((r_) < rows) { \
        float mx = 0.f; \
        _Pragma("unroll") for (int j = 0; j < 8; ++j) mx = fmaxf(mx, fmaxf(fmaxf(fabsf(buf[j][0]), fabsf(buf[j][1])), fmaxf(fabsf(buf[j][2]), fabsf(buf[j][3])))); \
        mx = wave_max(mx); \
        const float s = mx > 0.f ? 6.f / mx : 1.f; \
        if (c.lane == 0) scl[(size_t)(r_) * 4] = mx > 0.f ? mx * (1.f / 6.f) : 1.f; \
        u32x4 pk = {0u, 0u, 0u, 0u}; \
        _Pragma("unroll") for (int d = 0; d < 4; ++d) {              \
            unsigned wq = 0u; \
            wq = fp4_pk<0>(wq, buf[2 * d][0] * s, buf[2 * d][1] * s); wq = fp4_pk<1>(wq, buf[2 * d][2] * s, buf[2 * d][3] * s); \
            wq = fp4_pk<2>(wq, buf[2 * d + 1][0] * s, buf[2 * d + 1][1] * s); wq = fp4_pk<3>(wq, buf[2 * d + 1][2] * s, buf[2 * d + 1][3] * s); \
            pk[d] = wq; } \
        *(u32x4*)(dst4 + (size_t)(r_) * 1024 + c.lane * 16) = pk; } } while (0)
    int row = c.bid * 8 + c.wave;
    FP4R_LD(b0, row); FP4R_LD(b1, row + stride);
    for (; row < rows; row += 3 * stride) {
        FP4R_LD(b2, row + 2 * stride); FP4R_DO(b0, row);
        FP4R_LD(b0, row + 3 * stride); FP4R_DO(b1, row + stride);
        FP4R_LD(b1, row + 4 * stride); FP4R_DO(b2, row + 2 * stride);
    }
#undef FP4R_LD
#undef FP4R_DO
}
__device__ __forceinline__ void conv_E(const float* src, bf16_t* dst, size_t n8, const Ctx& c) {
    const size_t stride = (size_t)c.nb * NTHREADS;
    for (size_t i = (size_t)c.bid * NTHREADS + c.tid; i < n8; i += stride) {
        const f32x4 x = *(const f32x4*)(src + i * 8), y = *(const f32x4*)(src + i * 8 + 4);
        *(u32x4*)(dst + i * 8) = pack8(x, y);
    }
}
__device__ __forceinline__ int t5_bucket(int n) {
    if (n < 16) return n;
    const float scaled = logf((float)n / 16.f) / logf(64.f);
    const int large = 16 + (int)(scaled * 16.f);
    return large < 31 ? large : 31;
}
__device__ __forceinline__ void p0_tb(const Args& a, const Ctx& c) {
    float* tb = (float*)(a.ws + WS_TB); const float* rb = a.in[26];
    for (int i = c.bid * NTHREADS + c.tid; i < 8 * TBN; i += c.nb * NTHREADS) { const int head = i / TBN, dist = i % TBN; tb[i] = rb[t5_bucket(dist) * 8 + head] * LOG2E; }
}
__device__ __forceinline__ void p0_bpe(const Args& a, const Ctx& c, int part) {
    const int n = c.tid & 255, kv = c.tid >> 8;
    const float* pe = a.in[kv ? 23 : 20]; const float* w1 = a.in[kv ? 24 : 21]; float* bpep = (float*)(a.ws + WS_BPEP);
    float s = 0.f;
#pragma unroll 16
    for (int k = part * 128; k < part * 128 + 128; ++k) s += pe[k] * w1[(size_t)k * 256 + n];
    bpep[(part * 2 + kv) * 256 + n] = s;
}
__device__ __forceinline__ void p0_s5(const Args& a, const Ctx& c, int g, int part) {
    LAS float* ar = (LAS float*)c.lds;
    LAS float* ai = ar + 17 * 64;
    LAS float* bbr = ai + 17 * 64;
    LAS float* bbi = bbr + 1024;
    LAS float* cr = bbi + 1024;
    LAS float* ci = cr + 1024;
    LAS float* kd = ci + 1024;
    const int tid = c.tid;
    if (tid < 64) {
        const int p = tid; const float dt = expf(a.in[12][g]); const float lr = a.in[10][g * 64 + p], li = a.in[11][g * 64 + p];
        for (int d = 0; d <= 16; ++d) { const float mag = expf(lr * dt * (float)d), ang = li * dt * (float)d; ar[d * 64 + p] = mag * cosf(ang); ai[d * 64 + p] = mag * sinf(ang); }
        const float nr = ar[64 + p] - 1.f, ni = ai[64 + p], den = lr * lr + li * li;
        const float wre = (nr * lr + ni * li) / den, wim = (ni * lr - nr * li) / den;
        for (int h = 0; h < 16; ++h) { const float br = a.in[13][(g * 64 + p) * 16 + h], bi = a.in[14][(g * 64 + p) * 16 + h]; bbr[p * 16 + h] = wre * br - wim * bi; bbi[p * 16 + h] = wre * bi + wim * br; }
        if (part == 0) {
        float* s5p = (float*)(a.ws + WS_S5P);
        float xr = ar[16 * 64 + p], xi = ai[16 * 64 + p];
        s5p[(g * 64 + p) * 2] = xr; s5p[(g * 64 + p) * 2 + 1] = xi;
        for (int s = 0; s < 8; ++s) { const float tr = xr * xr - xi * xi, ti = 2.f * xr * xi; xr = tr; xi = ti; }
        s5p[64 * 64 * 2 + (g * 64 + p) * 2] = xr; s5p[64 * 64 * 2 + (g * 64 + p) * 2 + 1] = xi;
        }
    }
    for (int e = tid; e < 1024; e += NTHREADS) { cr[e] = a.in[15][g * 1024 + e]; ci[e] = a.in[16][g * 1024 + e]; }
    __syncthreads();
    for (int e = tid; e < 1024 * (part + 1); e += NTHREADS) {
        const int d = e >> 8, h1 = (e >> 4) & 15, h = e & 15; float s = 0.f;
        for (int p = 0; p < 64; ++p) { const float Cr = cr[h1 * 64 + p], Ci = ci[h1 * 64 + p], Ar = ar[d * 64 + p], Ai = ai[d * 64 + p];
            const float Gr = Cr * Ar - Ci * Ai, Gi = Cr * Ai + Ci * Ar; s += Gr * bbr[p * 16 + h] - Gi * bbi[p * 16 + h]; }
        if (d == 0 && h1 == h) s += a.in[17][g * 16 + h];
        kd[e] = s;
    }
    __syncthreads();
    bf16_t* MT = (bf16_t*)(a.ws + WS_S5MT) + (size_t)g * 65536;
    bf16_t* WE = (bf16_t*)(a.ws + WS_S5WE) + (size_t)g * 32768;
    bf16_t* WC = (bf16_t*)(a.ws + WS_S5WC) + (size_t)g * 32768;
    for (int e = 16384 * part + tid; e < 16384 * (part + 1); e += NTHREADS) { const int n = e >> 8, k = e & 255, j = n >> 4, h1 = n & 15, i = k >> 4, h = k & 15;
        MT[e] = f2bf(i <= j ? kd[(j - i) * 256 + h1 * 16 + h] : 0.f); }
    for (int e = 8192 * part + tid; e < 8192 * (part + 1); e += NTHREADS) { const int n = e >> 8, k = e & 255, cc = n >> 6, p = n & 63, i = k >> 4, h = k & 15;
        const float Ar = ar[(15 - i) * 64 + p], Ai = ai[(15 - i) * 64 + p], Br = bbr[p * 16 + h], Bi = bbi[p * 16 + h];
        WE[e] = f2bf(cc ? (Ar * Bi + Ai * Br) : (Ar * Br - Ai * Bi)); }
    for (int e = 8192 * part + tid; e < 8192 * (part + 1); e += NTHREADS) { const int n = e >> 7, k = e & 127, j = n >> 4, h1 = n & 15, cc = k >> 6, p = k & 63;
        const float Cr = cr[h1 * 64 + p], Ci = ci[h1 * 64 + p], Ar = ar[(j + 1) * 64 + p], Ai = ai[(j + 1) * 64 + p];
        WC[e] = f2bf(cc ? -(Cr * Ai + Ci * Ar) : (Cr * Ar - Ci * Ai)); }
    __syncthreads();
}
__device__ __forceinline__ void p0_prologue(const Args& a, const Ctx& c) {
    for (int u = c.bid; u < 256; u += c.nb) p0_s5(a, c, u >> 2, u & 3);
    for (int u = 0; u < 32; ++u) if (c.bid == (8 * u + 7) % c.nb) p0_bpe(a, c, u);
    p0_tb(a, c);
    p0_cond(a, c);
    conv_T_all(a, c);
    conv_E(a.in[28], (bf16_t*)(a.ws + WS_PK), 128 * 128 / 8, c);
    conv_E(a.in[29], (bf16_t*)(a.ws + WS_PK) + 128 * 128, 128 * 128 / 8, c);
    conv_fp4rows(a.in[30], a.ws + WS_PU, (float*)(a.ws + WS_PSC), 16384, c);
    conv_fp4rows(a.in[31], a.ws + WS_PV, (float*)(a.ws + WS_PSC) + 2, 16384, c);
}

__device__ __forceinline__ void norm_rows(const float* X, bf16_t* O, LAS const float* Ab, LAS const float* Bb, const Ctx& c, int row0 = 0, int nrows = L_) {
    for (int t = row0 + c.bid * 8 + c.wave; t < row0 + nrows; t += c.nb * 8) {
        const float* xr = X + (size_t)t * 2048 + c.lane * 4;
        f32x4 v[8]; float ss = 0.f;
#pragma unroll
        for (int j = 0; j < 8; ++j) { v[j] = *(const f32x4*)(xr + j * 256); ss += v[j][0] * v[j][0] + v[j][1] * v[j][1] + v[j][2] * v[j][2] + v[j][3] * v[j][3]; }
        ss = wave_sum(ss);
        const float rstd = rsqrtf(ss * (1.f / 2048.f) + 1e-6f);
#pragma unroll
        for (int j = 0; j < 8; ++j) {
            const int col = j * 256 + c.lane * 4;
            const f32x4 A = *(const LAS f32x4*)(Ab + col), B = *(const LAS f32x4*)(Bb + col);
            const f32x4 o = v[j] * rstd * A + B;
            u32x2 w; w[0] = cvt_pk_bf16(o[0], o[1]); w[1] = cvt_pk_bf16(o[2], o[3]);
            *(u32x2*)(O + (size_t)t * 2048 + col) = w;
        }
    }
}
__device__ __forceinline__ void norm_rows_bf16(const bf16_t* X, bf16_t* O, LAS const float* Ab, LAS const float* Bb, const Ctx& c, int row0, int nrows) {
    for (int t = row0 + c.bid * 8 + c.wave; t < row0 + nrows; t += c.nb * 8) {
        const bf16_t* xr = X + (size_t)t * 2048 + c.lane * 8;
        u32x4 w[4]; float ss = 0.f;
#pragma unroll
        for (int j = 0; j < 4; ++j) { w[j] = *(const u32x4*)(xr + j * 512);
#pragma unroll
            for (int e = 0; e < 4; ++e) { const float a0 = bflo(w[j][e]), a1 = bfhi(w[j][e]); ss += a0 * a0 + a1 * a1; } }
        ss = wave_sum(ss);
        const float rstd = rsqrtf(ss * (1.f / 2048.f) + 1e-6f);
#pragma unroll
        for (int j = 0; j < 4; ++j) {
            const int col = j * 512 + c.lane * 8;
            const f32x4 A0 = *(const LAS f32x4*)(Ab + col), A1 = *(const LAS f32x4*)(Ab + col + 4), B0 = *(const LAS f32x4*)(Bb + col), B1 = *(const LAS f32x4*)(Bb + col + 4);
            f32x4 o0, o1;
#pragma unroll
            for (int e = 0; e < 2; ++e) { o0[2 * e] = bflo(w[j][e]) * rstd * A0[2 * e] + B0[2 * e]; o0[2 * e + 1] = bfhi(w[j][e]) * rstd * A0[2 * e + 1] + B0[2 * e + 1];
                o1[2 * e] = bflo(w[j][2 + e]) * rstd * A1[2 * e] + B1[2 * e]; o1[2 * e + 1] = bfhi(w[j][2 + e]) * rstd * A1[2 * e + 1] + B1[2 * e + 1]; }
            *(u32x4*)(O + (size_t)t * 2048 + col) = pack8(o0, o1);
        }
    }
}
__device__ __forceinline__ float cond_from_partials(const float* condp, const float* b_ada, int j) {
    float s = b_ada[j];
#pragma unroll 8
    for (int k = 0; k < 32; ++k) s += condp[(size_t)k * NADA + j];
    return s;
}
__device__ __forceinline__ void p1_hnorm(const Args& a, const Ctx& c) {
    const float* condp = (const float*)(a.ws + WS_CONDP); float* cond = (float*)(a.ws + WS_COND);
    for (int j = c.bid * NTHREADS + c.tid; j < NADA; j += c.nb * NTHREADS) cond[j] = cond_from_partials(condp, a.in[3], j);
    { float* F2 = (float*)(a.ws + WS_F2);
      for (int j = c.bid * NTHREADS + c.tid; j < 2048; j += c.nb * NTHREADS) F2[j] = a.in[5][j] * (1.f + cond_from_partials(condp, a.in[3], 4 * 2048 + j)); }
    LAS float* Ab = (LAS float*)c.lds; LAS float* Bb = Ab + 2048;
    for (int col = c.tid; col < 2048; col += NTHREADS) {
        Ab[col] = a.in[4][col] * (1.f + cond_from_partials(condp, a.in[3], 2048 + col)); Bb[col] = cond_from_partials(condp, a.in[3], col); }
    __syncthreads();
    norm_rows(a.in[0], (bf16_t*)(a.ws + WS_H), Ab, Bb, c);
}
__device__ __forceinline__ void p_cqce(const Args& a, const Ctx& c) {
    const float* sh2 = (const float*)(a.ws + WS_COND) + 3 * 2048;
    float s[32];
#pragma unroll
    for (int k = 0; k < 8; ++k) { const f32x4 v = *(const f32x4*)(sh2 + 256 * k + c.lane * 4); s[4 * k] = v[0]; s[4 * k + 1] = v[1]; s[4 * k + 2] = v[2]; s[4 * k + 3] = v[3]; }
    const bf16_t* WQ = (const bf16_t*)(a.ws + WS_WQ); float* cq = (float*)(a.ws + WS_CQ);
    for (int n = c.bid * 8 + c.wave; n < 2048; n += c.nb * 8) {
        u32x2 w[8];
#pragma unroll
        for (int k = 0; k < 8; ++k) w[k] = *(const u32x2*)(WQ + (size_t)n * 2048 + 256 * k + c.lane * 4);
        float d = 0.f;
#pragma unroll
        for (int k = 0; k < 8; ++k) d += (bflo(w[k][0]) * s[4 * k] + bfhi(w[k][0]) * s[4 * k + 1]) + (bflo(w[k][1]) * s[4 * k + 2] + bfhi(w[k][1]) * s[4 * k + 3]);
        d = wave_sum(d);
        if (c.lane == 0) cq[n] = d;
    }
    const unsigned char* PU = a.ws + WS_PU; float* psc = (float*)(a.ws + WS_PSC);
    for (int e0 = (c.bid * 8 + c.wave) * 4; e0 < 16384; e0 += c.nb * 8 * 4) {
        u32x4 uw[4];
#pragma unroll
        for (int i = 0; i < 4; ++i) uw[i] = *(const u32x4*)(PU + (size_t)(e0 + i) * 1024 + c.lane * 16);
#pragma unroll
        for (int i = 0; i < 4; ++i) {
            float d0 = 0.f, d1 = 0.f;
#pragma unroll
            for (int dw = 0; dw < 4; ++dw) { const f32x2 f0 = fp4_unpk<0>(uw[i][dw]), f1 = fp4_unpk<1>(uw[i][dw]), f2 = fp4_unpk<2>(uw[i][dw]), f3 = fp4_unpk<3>(uw[i][dw]);
                d0 += f0[0] * s[8 * dw] + f1[0] * s[8 * dw + 2] + f2[0] * s[8 * dw + 4] + f3[0] * s[8 * dw + 6];
                d1 += f0[1] * s[8 * dw + 1] + f1[1] * s[8 * dw + 3] + f2[1] * s[8 * dw + 5] + f3[1] * s[8 * dw + 7]; }
            const float d = wave_sum(d0 + d1);
            if (c.lane == 0) psc[(size_t)(e0 + i) * 4 + 1] = psc[(size_t)(e0 + i) * 4] * d;
        }
    }
}
constexpr int S5_US = 0, S5_ES = 33792, S5_SS = 67584, S5_TS = 84992;
template <int PASS>
__device__ __forceinline__ void s5_item(const Args& a, const Ctx& c, int g, int seg) {
    LAS unsigned char* lds = c.lds;
    int tid = c.tid; asm volatile("" : "+v"(tid));
    const int wave = c.wave, lane = tid & 63, r = lane & 15, q = lane >> 4;
    const bf16_t* U = (const bf16_t*)(a.ws + WS_US);
    const bf16_t* MT = (const bf16_t*)(a.ws + WS_S5MT) + (size_t)g * 65536;
    const bf16_t* WE = (const bf16_t*)(a.ws + WS_S5WE) + (size_t)g * 32768;
    const bf16_t* WC = (const bf16_t*)(a.ws + WS_S5WC) + (size_t)g * 32768;
    const float* s5p = (const float*)(a.ws + WS_S5P);
    float* F = (float*)(a.ws + WS_S5F) + (size_t)g * 4 * 128;
    bf16_t* Z = (bf16_t*)(a.ws + WS_Z);
    bf16x8 bE[8];
#pragma unroll
    for (int ks = 0; ks < 8; ++ks) bE[ks] = *(const bf16x8*)(WE + (size_t)(16 * wave + r) * 256 + 32 * ks + 8 * q);
    bf16x8 bM[2][8], bC[2][4];
    if (PASS == 1) {
#pragma unroll
        for (int nt = 0; nt < 2; ++nt)
#pragma unroll
            for (int ks = 0; ks < 4; ++ks) bC[nt][ks] = *(const bf16x8*)(WC + (size_t)(16 * (2 * wave + nt) + r) * 128 + 32 * ks + 8 * q);
#pragma unroll
        for (int nt = 0; nt < 2; ++nt)
#pragma unroll
            for (int ks = 0; ks < 8; ++ks) bM[nt][ks] = *(const bf16x8*)(MT + (size_t)(16 * (2 * wave + nt) + r) * 256 + 32 * ks + 8 * q);
    }
    float sr = 0.f, si = 0.f;
    const float a16r = s5p[(g * 64 + lane) * 2], a16i = s5p[(g * 64 + lane) * 2 + 1];
    float a128r = a16r, a128i = a16i;
#pragma unroll
    for (int s = 0; s < 3; ++s) { const float tr = a128r * a128r - a128i * a128i, ti = 2.f * a128r * a128i; a128r = tr; a128i = ti; }
    if (PASS == 1) { const float br = s5p[8192 + (g * 64 + lane) * 2], bi = s5p[8192 + (g * 64 + lane) * 2 + 1];
        for (int s = 0; s < seg; ++s) { const float fr_ = F[s * 128 + lane], fi_ = F[s * 128 + 64 + lane]; const float nr = br * sr - bi * si + fr_, ni = br * si + bi * sr + fi_; sr = nr; si = ni; } }
    for (int sb = 0; sb < 4; ++sb) {
        const int tok0 = seg * 4096 + sb * 1024;
#pragma unroll
        for (int i = 0; i < 4; ++i) { const int ch = tid + NTHREADS * i, token = ch >> 1, half = ch & 1;
            const u32x4 v = *(const u32x4*)(U + (size_t)(tok0 + token) * 1024 + g * 16 + half * 8);
            *(LAS u32x4*)(lds + S5_US + (token >> 4) * 528 + ((token & 15) * 16 + half * 8) * 2) = v; }
        __syncthreads();
#pragma unroll
        for (int m = 0; m < 4; ++m) {
            f32x4 acc = {0.f, 0.f, 0.f, 0.f};
#pragma unroll
            for (int ks = 0; ks < 8; ++ks) { const bf16x8 A = *(const LAS bf16x8*)(lds + S5_US + (16 * m + r) * 528 + (32 * ks + 8 * q) * 2); acc = mfma16(A, bE[ks], acc); }
#pragma unroll
            for (int i = 0; i < 4; ++i) *(LAS float*)(lds + S5_ES + ((16 * m + 4 * q + i) * 132 + 16 * wave + r) * 4) = acc[i];
        }
        __syncthreads();
        {
            float lr[8], li[8];
            float xr = 0.f, xi = 0.f;
#pragma unroll
            for (int k = 0; k < 8; ++k) {
                lr[k] = xr; li[k] = xi;
                const float er = *(const LAS float*)(lds + S5_ES + ((8 * wave + k) * 132 + lane) * 4), ei = *(const LAS float*)(lds + S5_ES + ((8 * wave + k) * 132 + 64 + lane) * 4);
                const float nr = a16r * xr - a16i * xi + er, ni = a16r * xi + a16i * xr + ei; xr = nr; xi = ni;
            }
            __builtin_amdgcn_sched_barrier(0);
            *(LAS float*)(lds + S5_TS + (wave * 128 + lane) * 4) = xr; *(LAS float*)(lds + S5_TS + (wave * 128 + 64 + lane) * 4) = xi;
            __syncthreads();
            __builtin_amdgcn_sched_barrier(0);
            float cr = sr, ci = si, mr = sr, mi = si;
#pragma unroll
            for (int w2 = 0; w2 < 8; ++w2) {
                if (w2 == wave) { mr = cr; mi = ci; }
                const float tr = *(const LAS float*)(lds + S5_TS + (w2 * 128 + lane) * 4), ti = *(const LAS float*)(lds + S5_TS + (w2 * 128 + 64 + lane) * 4);
                const float nr = a128r * cr - a128i * ci + tr, ni = a128r * ci + a128i * cr + ti; cr = nr; ci = ni;
            }
            sr = cr; si = ci;
            __builtin_amdgcn_sched_barrier(0);
            if (PASS == 1) {
                float pr = mr, pi = mi;
#pragma unroll
                for (int k = 0; k < 8; ++k) {
                    *(LAS bf16_t*)(lds + S5_SS + ((8 * wave + k) * 136 + lane) * 2) = f2bf(lr[k] + pr); *(LAS bf16_t*)(lds + S5_SS + ((8 * wave + k) * 136 + 64 + lane) * 2) = f2bf(li[k] + pi);
                    const float nr = a16r * pr - a16i * pi, ni = a16r * pi + a16i * pr; pr = nr; pi = ni;
                }
            }
        }
        __syncthreads();
        if (PASS == 1) {
#pragma unroll
            for (int nt = 0; nt < 2; ++nt) {
                const int j = 2 * wave + nt;
                f32x4 acc[4];
#pragma unroll
                for (int m = 0; m < 4; ++m) acc[m] = (f32x4){0.f, 0.f, 0.f, 0.f};
#pragma unroll
                for (int ks = 0; ks < 8; ++ks) {
                    __builtin_amdgcn_sched_barrier(0);
#pragma unroll
                    for (int m = 0; m < 4; ++m) { const bf16x8 A = *(const LAS bf16x8*)(lds + S5_US + (16 * m + r) * 528 + (32 * ks + 8 * q) * 2); acc[m] = mfma16(A, bM[nt][ks], acc[m]); }
                }
#pragma unroll
                for (int ks = 0; ks < 4; ++ks) {
                    __builtin_amdgcn_sched_barrier(0);
#pragma unroll
                    for (int m = 0; m < 4; ++m) { const bf16x8 A = *(const LAS bf16x8*)(lds + S5_SS + (16 * m + r) * 272 + (32 * ks + 8 * q) * 2); acc[m] = mfma16(A, bC[nt][ks], acc[m]); }
                }
                int lz = lane; asm volatile("" : "+v"(lz));
                const int rz = lz & 15, qz = lz >> 4;
#pragma unroll
                for (int m = 0; m < 4; ++m)
#pragma unroll
                    for (int i = 0; i < 4; ++i) { const int ch = 16 * m + 4 * qz + i; Z[(size_t)(tok0 + 16 * ch + j) * 1024 + g * 16 + rz] = f2bf(gelu_tanh(acc[m][i])); }
            }
            __syncthreads();
        }
    }
    if (PASS == 0 && wave == 0) { F[seg * 128 + lane] = sr; F[seg * 128 + 64 + lane] = si; }
}

__device__ __forceinline__ void cmp_finish_item(const Args& a, const Ctx& c, int kvsel, int rt) {
    LAS unsigned char* lds = c.lds;
    const int tid = c.tid, wave = c.wave, lane = c.lane, r = lane & 15, q = lane >> 4;
    const float* SL = (const float*)(a.ws + WS_SLAB) + (size_t)kvsel * 16 * 2048 * 256;
    const float* bpep = (const float*)(a.ws + WS_BPEP) + kvsel * 256;
    const bf16_t* W2 = (const bf16_t*)(a.ws + WS_W2) + kvsel * 128 * 256;
    bf16x8 B[8];
#pragma unroll
    for (int ks = 0; ks < 8; ++ks) B[ks] = *(const bf16x8*)(W2 + (size_t)(16 * wave + r) * 256 + 32 * ks + 8 * q);
    for (int e = tid; e < 16 * 64; e += NTHREADS) {
        const int row = e >> 6, c4 = (e & 63) * 4;
        f32x4 s = {0.f, 0.f, 0.f, 0.f};
#pragma unroll 8
        for (int pt = 0; pt < 32; ++pt) s += *(const f32x4*)(bpep + pt * 512 + c4);
#pragma unroll
        for (int ks = 0; ks < 16; ++ks) s += *(const f32x4*)(SL + ((size_t)ks * 2048 + rt * 16 + row) * 256 + c4);
        u32x2 w; w[0] = cvt_pk_bf16(gelu_tanh(s[0]), gelu_tanh(s[1])); w[1] = cvt_pk_bf16(gelu_tanh(s[2]), gelu_tanh(s[3]));
        *(LAS u32x2*)(lds + row * 528 + c4 * 2) = w;
    }
    __syncthreads();
    f32x4 acc = {0.f, 0.f, 0.f, 0.f};
#pragma unroll
    for (int ks = 0; ks < 8; ++ks) { const bf16x8 A = *(const LAS bf16x8*)(lds + r * 528 + (32 * ks + 8 * q) * 2); acc = mfma16(A, B[ks], acc); }
#pragma unroll
    for (int i = 0; i < 4; ++i) {
        const int row = rt * 16 + 4 * q + i, gi = row >> 10, ci = row & 1023, n = 16 * wave + r;
        const bf16_t v = (ci == 1023) ? (bf16_t)0 : f2bf(acc[i]);
        if (kvsel == 0) ((bf16_t*)(a.ws + WS_KC))[((size_t)gi * 1024 + ci) * 128 + n] = v;
        else ((bf16_t*)(a.ws + WS_VCT))[((size_t)gi * 128 + n) * 1024 + ((ci & ~12) | ((ci & 4) << 1) | ((ci & 8) >> 1))] = v;
    }
    __syncthreads();
}
constexpr int AT_IMP = 65536, AT_TB = 131072, AT_BM = 143872, AT_WU = 145920, AT_END = 146176;
__device__ __forceinline__ int kswz(int r) { return ((r & 3) << 2) | ((r >> 2) & 3); }
__host__ __device__ __forceinline__ int vperm(int t) { return (t & ~12) | ((t & 4) << 1) | ((t & 8) >> 1); }
template <int KEYS> __device__ __forceinline__ int vsw(int d) { return KEYS == 128 ? kswz(d) : ((d >> 1) & 7); }
template <int KEYS, bool NEEDV>
__device__ __forceinline__ void stage_dma(const bf16_t* Kt, const bf16_t* Vt, int ldv, LAS unsigned char* kb, LAS unsigned char* vb, int wave, int lane) {
    constexpr int NP = KEYS / 32;
#pragma unroll
    for (int i = 0; i < NP; ++i) { const int pc = NP * wave + i, row = 4 * pc + (lane >> 4), ch = (lane & 15) ^ kswz(row);
        __builtin_amdgcn_global_load_lds((const unsigned*)(Kt + row * 128 + ch * 8), (LAS unsigned*)(kb + pc * 1024), 16, 0, 0); }
    if (NEEDV) {
#pragma unroll
        for (int i = 0; i < NP; ++i) {
            const int pc = NP * wave + i;
            if (KEYS == 128) { const int d = 4 * pc + (lane >> 4), ch = (lane & 15) ^ kswz(d);
                __builtin_amdgcn_global_load_lds((const unsigned*)(Vt + (size_t)d * ldv + 8 * ch), (LAS unsigned*)(vb + pc * 1024), 16, 0, 0); }
            else { const int d = 8 * pc + (lane >> 3), ch = (lane & 7) ^ ((d >> 1) & 7);
                __builtin_amdgcn_global_load_lds((const unsigned*)(Vt + (size_t)d * ldv + 8 * ch), (LAS unsigned*)(vb + pc * 1024), 16, 0, 0); }
        }
    }
}
__device__ __forceinline__ float xhalf_max(float x) { auto rr = __builtin_amdgcn_permlane32_swap(__float_as_uint(x), __float_as_uint(x), false, false); return fmaxf(__uint_as_float(rr[0]), __uint_as_float(rr[1])); }
__device__ __forceinline__ float xhalf_sum(float x) { auto rr = __builtin_amdgcn_permlane32_swap(__float_as_uint(x), __float_as_uint(x), false, false); return __uint_as_float(rr[0]) + __uint_as_float(rr[1]); }
template <int BR>
__device__ __forceinline__ float tile_prep(int MODE, f32x16& S, LAS const float* tb, float cb, int base, bool selbit) {
    float mx = -INFINITY;
    if (MODE == 1) {
#pragma unroll
        for (int r = 0; r < 16; ++r) mx = fmaxf(mx, S[r]);
        mx = (BR == 2 && !selbit) ? -INFINITY : mx + cb;
    } else {
        const bool nomask = (MODE == 2);
        float bv[16];
#pragma unroll
        for (int r = 0; r < 16; ++r) { const int cr = (r & 3) + 8 * (r >> 2); const int dist = (BR <= 1) ? base - 16 * cr : base - cr; bv[r] = tb[min(max(dist, 0), TBN - 1)]; }
        __builtin_amdgcn_sched_barrier(0);
#pragma unroll
        for (int r = 0; r < 16; ++r) {
            const int cr = (r & 3) + 8 * (r >> 2);
            const int dist = (BR <= 1) ? base - 16 * cr : base - cr;
            float v = S[r] + bv[r];
            bool valid;
            if (BR <= 1) valid = dist >= 0; else if (BR == 2) valid = selbit && dist >= 0; else valid = nomask || (unsigned)dist < 512u;
            v = valid ? v : -INFINITY;
            S[r] = v; mx = fmaxf(mx, v);
        }
    }
    return mx;
}
template <int BR, bool PEND>
__device__ __forceinline__ float tile_decide(int MODE, float mx, float cb, bool selbit, f32x16 (&O)[4], float& m, float& l, u32x4& pa, u32x4& pb) {
    if (BR == 1) { const float mu = (m == -INFINITY) ? 0.f : m; return (MODE == 1) ? mu - cb : mu; }
    mx = xhalf_max(mx);
    const float mn = fmaxf(m, mx), mu = (mn == -INFINITY) ? 0.f : mn;
    if (__any(mn > m)) {
        const float alpha = fexp2(m - mu);
        l *= alpha;
        if (BR >= 2) {
#pragma unroll
            for (int dt = 0; dt < 4; ++dt)
#pragma unroll
                for (int r = 0; r < 16; ++r) O[dt][r] *= alpha;
            if (PEND) {
#pragma unroll
                for (int e = 0; e < 4; ++e) { pa[e] = cvt_pk_bf16(bflo(pa[e]) * alpha, bfhi(pa[e]) * alpha); pb[e] = cvt_pk_bf16(bflo(pb[e]) * alpha, bfhi(pb[e]) * alpha); }
            }
        }
    }
    m = mn;
    if (MODE == 1) return (BR == 2 && !selbit) ? INFINITY : mu - cb;
    return mu;
}
template <int BR, int KEYS>
__device__ __forceinline__ void attn_tile(int MODE, LAS const unsigned char* kb, LAS const unsigned char* vb, int cb0, LAS const float* tb, int key0, int t, int lane,
                                          const bf16x8 (&qf)[8], f32x16 (&O)[4], float& m, float& l, float inv_l, bool selbit, LAS float* imp_row) {
    asm volatile("" : "+v"(lane));
    constexpr int ROWB = 2 * KEYS;
    const int r31 = lane & 31, h = lane >> 5;
    const int gh = kswz(r31) ^ h, vh = vsw<KEYS>(r31) ^ h;
    float cb = 0.f;
    if (MODE == 1) cb = tb[TBN - 1];
    const int base0 = (BR <= 1) ? t - 31 - 16 * (key0 + 4 * h) : t - (key0 + 4 * h);
    const int base1 = (BR <= 1) ? base0 - 16 * 32 : base0 - 32;
    LAS const unsigned char* k0 = kb + r31 * 256;
    f32x16 S0, S1;
    bf16x8 kf[8];
#pragma unroll
    for (int ks = 0; ks < 8; ++ks) kf[ks] = *(const LAS bf16x8*)(k0 + 16 * ((2 * ks) ^ gh));
#pragma unroll
    for (int r = 0; r < 16; ++r) { S0[r] = 0.f; S1[r] = 0.f; }
    __builtin_amdgcn_sched_barrier(0);
#pragma unroll
    for (int ks = 0; ks < 8; ++ks) S0 = mfma32(kf[ks], qf[ks], S0);
    __builtin_amdgcn_sched_barrier(0);
#pragma unroll
    for (int ks = 0; ks < 8; ++ks) kf[ks] = *(const LAS bf16x8*)(k0 + 8192 + 16 * ((2 * ks) ^ gh));
    const float mx0 = tile_prep<BR>(MODE, S0, tb, cb, base0, selbit);
    u32x4 pk0a = {0u, 0u, 0u, 0u}, pk0b = {0u, 0u, 0u, 0u}, pk1a, pk1b;
    const float me0 = tile_decide<BR, false>(MODE, mx0, cb, selbit, O, m, l, pk0a, pk0b);
    __builtin_amdgcn_sched_barrier(0);
    {
#pragma unroll
        for (int ks = 0; ks < 8; ++ks) S1 = mfma32(kf[ks], qf[ks], S1);
        float ps = 0.f;
#pragma unroll
        for (int r = 0; r < 16; ++r) { float p = fexp2(S0[r] - me0); if (BR == 1) p *= inv_l; S0[r] = p; ps += p; }
        if (BR != 1) l += ps;
        if (BR >= 1) {
#pragma unroll
            for (int e = 0; e < 4; ++e) { pk0a[e] = cvt_pk_bf16(S0[2 * e], S0[2 * e + 1]); pk0b[e] = cvt_pk_bf16(S0[8 + 2 * e], S0[8 + 2 * e + 1]); }
        }
#pragma unroll
        for (int i = 0; i < 8; ++i) { __builtin_amdgcn_sched_group_barrier(0x008, 1, 0); __builtin_amdgcn_sched_group_barrier(0x002, 8, 0); }
    }
    __builtin_amdgcn_sched_barrier(0);
    if (BR == 1) {
#pragma unroll
        for (int rg = 0; rg < 4; ++rg) {
            float A = 2.f * (S0[4 * rg] + S0[4 * rg + 1] + S0[4 * rg + 2]) + S0[4 * rg + 3], B = S0[4 * rg + 3];
            A = quad_sum(A); B = quad_sum(B);
            const int jj = (key0 >> 2) + 2 * rg + h;
            if ((lane & 3) == 0) { __hip_atomic_fetch_add(imp_row + jj, A, __ATOMIC_RELAXED, __HIP_MEMORY_SCOPE_WORKGROUP);
                if (jj + 1 < 256) __hip_atomic_fetch_add(imp_row + jj + 1, B, __ATOMIC_RELAXED, __HIP_MEMORY_SCOPE_WORKGROUP); }
        }
    }
    bf16x8 av[8];
    if (BR >= 1) {
#pragma unroll
        for (int s = 0; s < 2; ++s)
#pragma unroll
            for (int dt = 0; dt < 4; ++dt) av[s * 4 + dt] = *(const LAS bf16x8*)(vb + (32 * dt + r31) * ROWB + 16 * ((cb0 + 2 * s) ^ vh));
    }
    const float mx1 = tile_prep<BR>(MODE, S1, tb, cb, base1, selbit);
    const float me1 = tile_decide<BR, true>(MODE, mx1, cb, selbit, O, m, l, pk0a, pk0b);
    __builtin_amdgcn_sched_barrier(0);
    {
        if (BR >= 1) {
#pragma unroll
            for (int dt = 0; dt < 4; ++dt) O[dt] = mfma32(av[dt], __builtin_bit_cast(bf16x8, pk0a), O[dt]);
#pragma unroll
            for (int dt = 0; dt < 4; ++dt) O[dt] = mfma32(av[4 + dt], __builtin_bit_cast(bf16x8, pk0b), O[dt]);
        }
        float ps = 0.f;
#pragma unroll
        for (int r = 0; r < 16; ++r) { float p = fexp2(S1[r] - me1); if (BR == 1) p *= inv_l; S1[r] = p; ps += p; }
        if (BR != 1) l += ps;
        if (BR >= 1) {
#pragma unroll
            for (int e = 0; e < 4; ++e) { pk1a[e] = cvt_pk_bf16(S1[2 * e], S1[2 * e + 1]); pk1b[e] = cvt_pk_bf16(S1[8 + 2 * e], S1[8 + 2 * e + 1]); }
#pragma unroll
            for (int i = 0; i < 8; ++i) { __builtin_amdgcn_sched_group_barrier(0x008, 1, 0); __builtin_amdgcn_sched_group_barrier(0x002, 8, 0); }
        }
    }
    __builtin_amdgcn_sched_barrier(0);
    if (BR == 1) {
#pragma unroll
        for (int rg = 0; rg < 4; ++rg) {
            float A = 2.f * (S1[4 * rg] + S1[4 * rg + 1] + S1[4 * rg + 2]) + S1[4 * rg + 3], B = S1[4 * rg + 3];
            A = quad_sum(A); B = quad_sum(B);
            const int jj = ((key0 + 32) >> 2) + 2 * rg + h;
            if ((lane & 3) == 0) { __hip_atomic_fetch_add(imp_row + jj, A, __ATOMIC_RELAXED, __HIP_MEMORY_SCOPE_WORKGROUP);
                if (jj + 1 < 256) __hip_atomic_fetch_add(imp_row + jj + 1, B, __ATOMIC_RELAXED, __HIP_MEMORY_SCOPE_WORKGROUP); }
        }
    }
    if (BR >= 1) {
#pragma unroll
        for (int s = 0; s < 2; ++s)
#pragma unroll
            for (int dt = 0; dt < 4; ++dt) av[s * 4 + dt] = *(const LAS bf16x8*)(vb + (32 * dt + r31) * ROWB + 16 * ((cb0 + 4 + 2 * s) ^ vh));
        __builtin_amdgcn_sched_barrier(0);
#pragma unroll
        for (int dt = 0; dt < 4; ++dt) O[dt] = mfma32(av[dt], __builtin_bit_cast(bf16x8, pk1a), O[dt]);
#pragma unroll
        for (int dt = 0; dt < 4; ++dt) O[dt] = mfma32(av[4 + dt], __builtin_bit_cast(bf16x8, pk1b), O[dt]);
    }
}
template <int BR, int KEYS>
__device__ __forceinline__ void run_branch(const Ctx& c, const bf16_t* Kb, const bf16_t* Vtb, int ldv, int lo, int hi, LAS const float* tb, int t, int t0,
                                           const bf16x8 (&qf)[8], f32x16 (&O)[4], float& m, float& l, float inv_l, int tl, LAS float* imp_row) {
    constexpr bool NEEDV = (BR != 0);
    constexpr int BPS = KEYS / 64, KSTG = KEYS * 256, VSTG = 128 * 2 * KEYS, VB0 = 2 * KSTG;
    LAS unsigned char* lds = c.lds;
    int lz = c.lane; asm volatile("" : "+v"(lz));
    const int nst = (hi - lo + BPS - 1) / BPS;
#define STG_BLK(i) ((lo + BPS * (i) + BPS - 1 < hi) ? lo + BPS * (i) : hi - BPS)
    asm volatile("s_waitcnt vmcnt(0)" ::: "memory");
    { const int b0 = (BPS == 2 && hi - lo < 2) ? lo : STG_BLK(0);
      stage_dma<KEYS, NEEDV>(Kb + (size_t)b0 * 64 * 128, Vtb + (size_t)b0 * 64, ldv, lds, lds + VB0, c.wave, lz); }
    asm volatile("s_waitcnt vmcnt(0)" ::: "memory");
    __syncthreads();
    const int qt = t0 >> 6;
    for (int i = 0; i < nst; ++i) {
        const int buf = i & 1;
        if (i + 1 < nst) { int lz2 = lz; asm volatile("" : "+v"(lz2));
            const int b1 = STG_BLK(i + 1);
            stage_dma<KEYS, NEEDV>(Kb + (size_t)b1 * 64 * 128, Vtb + (size_t)b1 * 64, ldv, lds + (buf ^ 1) * KSTG, lds + VB0 + (buf ^ 1) * VSTG, c.wave, lz2); }
        const int sb = (BPS == 2 && hi - lo < 2) ? lo : STG_BLK(i);
#pragma unroll
        for (int q = 0; q < BPS; ++q) {
            const int j = lo + BPS * i + q;
            if (j < hi) {
                bool selbit = true, wave_on = true;
                if (BR == 2) {
                    const unsigned w = *(const LAS unsigned*)(lds + AT_BM + (tl * 8 + (j >> 5)) * 4);
                    selbit = (w >> (j & 31)) & 1u;
                    const unsigned wu = *(const LAS unsigned*)(lds + AT_WU + (c.wave * 8 + (j >> 5)) * 4);
                    wave_on = (wu >> (j & 31)) & 1u;
                }
                if (wave_on) {
                    int mode = 0;
                    if (BR <= 1) mode = (1024 * j + 1829 <= t0) ? 1 : 0;
                    else if (BR == 2) mode = (64 * j + 853 <= t0) ? 1 : 0;
                    else mode = (j >= qt - 7 && j <= qt - 1) ? 2 : 0;
                    const int slot = j - sb;
                    attn_tile<BR, KEYS>(mode, lds + buf * KSTG + slot * 16384, lds + VB0 + buf * VSTG, 8 * slot, tb, j * 64, t, c.lane, qf, O, m, l, inv_l, selbit, imp_row);
                }
            }
        }
        asm volatile("s_waitcnt vmcnt(0)" ::: "memory");
        __syncthreads();
    }
#undef STG_BLK
}
__device__ __forceinline__ void attn_item(const Args& a, const Ctx& c_, int qt, int g) {
    Ctx c = c_; { int tz = c_.tid; asm volatile("" : "+v"(tz)); c.tid = tz; c.lane = tz & 63; }
    LAS unsigned char* lds = c.lds;
    const int tid = c.tid, wave = c.wave, lane = c.lane, r31 = lane & 31, h = lane >> 5, hl = lane & 3;
    const int t0 = qt * 64, tl = 8 * wave + (r31 >> 2), t = t0 + tl, head = g * 4 + hl;
    const bf16_t* Qb = (const bf16_t*)(a.ws + WS_Q);
    const bf16_t* KROW = (const bf16_t*)(a.ws + WS_KROW);
    const bf16_t* VT = (const bf16_t*)(a.ws + WS_VT);
    const float* GATE = (const float*)(a.ws + WS_GATE);
    { const float* tbg = (const float*)(a.ws + WS_TB) + g * 4 * TBN;
      for (int i = tid; i < 4 * TBN; i += NTHREADS) *(LAS float*)(lds + AT_TB + i * 4) = tbg[i];
      for (int i = tid; i < 64 * 256; i += NTHREADS) *(LAS float*)(lds + AT_IMP + i * 4) = 0.f; }
    bf16x8 qf[8];
#pragma unroll
    for (int ks = 0; ks < 8; ++ks) qf[ks] = *(const bf16x8*)(Qb + (size_t)t * 1024 + head * 128 + 16 * ks + 8 * h);
    LAS const float* tb = (LAS const float*)(lds + AT_TB) + hl * TBN;
    LAS float* imp_row = (LAS float*)(lds + AT_IMP) + tl * 256;
    bf16_t* Y = (bf16_t*)(a.ws + WS_Y2) + (size_t)t * 2048 + 1024 + head * 128 + 4 * h;
    f32x16 O[4];
#pragma unroll
    for (int dt = 0; dt < 4; ++dt)
#pragma unroll
        for (int r = 0; r < 16; ++r) O[dt][r] = 0.f;
    __syncthreads();
    { const int ntile = (t0 / 16 + 3 + 63) / 64;
      const bf16_t* KC = (const bf16_t*)(a.ws + WS_KC) + (size_t)g * 1024 * 128; const bf16_t* VCT = (const bf16_t*)(a.ws + WS_VCT) + (size_t)g * 128 * 1024;
      float m = -INFINITY, l = 0.f;
#if defined(PROBE_CMP)
      run_branch<0, 64>(c, KC, VCT, 1024, 0, ntile, tb, t, t0, qf, O, m, l, 0.f, tl, imp_row);
      asm volatile("" :: "v"(m), "v"(l));
      m = -INFINITY; l = 0.f;
#endif
      run_branch<0, 64>(c, KC, VCT, 1024, 0, ntile, tb, t, t0, qf, O, m, l, 0.f, tl, imp_row);
      const float lt = xhalf_sum(l), inv = lt > 0.f ? 1.f / lt : 0.f;
      run_branch<1, 64>(c, KC, VCT, 1024, 0, ntile, tb, t, t0, qf, O, m, l, inv, tl, imp_row);
      const float gc = GATE[(size_t)t * 24 + head];
#pragma unroll
      for (int dt = 0; dt < 4; ++dt)
#pragma unroll
          for (int rg = 0; rg < 4; ++rg) {
              u32x2 w; w[0] = cvt_pk_bf16(gc * O[dt][4 * rg], gc * O[dt][4 * rg + 1]); w[1] = cvt_pk_bf16(gc * O[dt][4 * rg + 2], gc * O[dt][4 * rg + 3]);
              *(u32x2*)(Y + 32 * dt + 8 * rg) = w;
#pragma unroll
              for (int e = 0; e < 4; ++e) O[dt][4 * rg + e] = 0.f;
          }
    }
    {
        const int ncand = qt - 2 > 0 ? qt - 2 : 0;
        unsigned v[8][4], selm[8];
#pragma unroll
        for (int i = 0; i < 8; ++i) {
            LAS const float* row = (LAS const float*)(lds + AT_IMP) + (8 * wave + i) * 256;
            selm[i] = 0u;
#pragma unroll
            for (int k = 0; k < 4; ++k) { const int j = lane + 64 * k; const bool cand = (j >= 1 && j <= qt - 2);
                v[i][k] = cand ? ((__float_as_uint(row[j]) & ~0xFFu) | (unsigned)(255 - j)) : 0u; if (ncand <= 13 && cand) selm[i] |= 1u << k; }
        }
        if (ncand > 13) {
            for (int it = 0; it < 13; ++it) {
#pragma unroll
                for (int i = 0; i < 8; ++i) {
                    const unsigned mx = wave_umax_bcast(max(max(v[i][0], v[i][1]), max(v[i][2], v[i][3])));
#pragma unroll
                    for (int k = 0; k < 4; ++k) if (v[i][k] == mx) { v[i][k] = 0u; selm[i] |= 1u << k; }
                }
            }
        }
        unsigned wu[8];
#pragma unroll
        for (int k = 0; k < 8; ++k) wu[k] = 0u;
#pragma unroll
        for (int i = 0; i < 8; ++i)
#pragma unroll
            for (int k = 0; k < 4; ++k) {
                const int j = lane + 64 * k; const bool forced = (j == 0) || (j == qt) || (j == qt - 1);
                const unsigned long long mk = __ballot(((selm[i] >> k) & 1u) || forced);
                const unsigned lo = (unsigned)mk, hi = (unsigned)(mk >> 32);
                if (lane == 0) { *(LAS unsigned*)(lds + AT_BM + ((8 * wave + i) * 8 + 2 * k) * 4) = lo; *(LAS unsigned*)(lds + AT_BM + ((8 * wave + i) * 8 + 2 * k + 1) * 4) = hi; }
                wu[2 * k] |= lo; wu[2 * k + 1] |= hi;
            }
        if (lane == 0) {
#pragma unroll
            for (int k = 0; k < 8; ++k) *(LAS unsigned*)(lds + AT_WU + (wave * 8 + k) * 4) = wu[k];
        }
    }
    __syncthreads();
#if defined(PROBE_SEL)
    { float m = -INFINITY, l = 0.f;
      run_branch<2, 128>(c, KROW + (size_t)(2 + g) * L_ * 128, VT + (size_t)g * 128 * L_, L_, 0, qt + 1, tb, t, t0, qf, O, m, l, 0.f, tl, imp_row);
      asm volatile("" :: "v"(O[0]), "v"(O[1]), "v"(O[2]), "v"(O[3]), "v"(m), "v"(l));
#pragma unroll
      for (int dt = 0; dt < 4; ++dt)
#pragma unroll
          for (int r = 0; r < 16; ++r) O[dt][r] = 0.f; }
#endif
    { float m = -INFINITY, l = 0.f;
      run_branch<2, 128>(c, KROW + (size_t)(2 + g) * L_ * 128, VT + (size_t)g * 128 * L_, L_, 0, qt + 1, tb, t, t0, qf, O, m, l, 0.f, tl, imp_row);
      const float gs = GATE[(size_t)t * 24 + 8 + head];
      const float lt = xhalf_sum(l), sc = gs * (lt > 0.f ? 1.f / lt : 0.f);
#pragma unroll
      for (int dt = 0; dt < 4; ++dt)
#pragma unroll
          for (int rg = 0; rg < 4; ++rg) {
              const u32x2 w0 = *(const u32x2*)(Y + 32 * dt + 8 * rg);
              u32x2 w; w[0] = cvt_pk_bf16(bflo(w0[0]) + sc * O[dt][4 * rg], bfhi(w0[0]) + sc * O[dt][4 * rg + 1]); w[1] = cvt_pk_bf16(bflo(w0[1]) + sc * O[dt][4 * rg + 2], bfhi(w0[1]) + sc * O[dt][4 * rg + 3]);
              *(u32x2*)(Y + 32 * dt + 8 * rg) = w;
#pragma unroll
              for (int e = 0; e < 4; ++e) O[dt][4 * rg + e] = 0.f;
          }
    }
#if defined(PROBE_WIN)
    { float m = -INFINITY, l = 0.f;
      const int lo = qt - 8 > 0 ? qt - 8 : 0;
      run_branch<3, 128>(c, KROW + (size_t)(4 + g) * L_ * 128, VT + (size_t)(2 + g) * 128 * L_, L_, lo, qt + 1, tb, t, t0, qf, O, m, l, 0.f, tl, imp_row);
      asm volatile("" :: "v"(O[0]), "v"(O[1]), "v"(O[2]), "v"(O[3]), "v"(m), "v"(l));
#pragma unroll
      for (int dt = 0; dt < 4; ++dt)
#pragma unroll
          for (int r = 0; r < 16; ++r) O[dt][r] = 0.f; }
#endif
    { float m = -INFINITY, l = 0.f;
      const int lo = qt - 8 > 0 ? qt - 8 : 0;
      run_branch<3, 128>(c, KROW + (size_t)(4 + g) * L_ * 128, VT + (size_t)(2 + g) * 128 * L_, L_, lo, qt + 1, tb, t, t0, qf, O, m, l, 0.f, tl, imp_row);
      const float gw = GATE[(size_t)t * 24 + 16 + head];
      const float lt = xhalf_sum(l), sc = gw * (lt > 0.f ? 1.f / lt : 0.f);
      float ss = 0.f;
#pragma unroll
      for (int dt = 0; dt < 4; ++dt)
#pragma unroll
          for (int rg = 0; rg < 4; ++rg) {
              const u32x2 w0 = *(const u32x2*)(Y + 32 * dt + 8 * rg);
              const float y0 = bflo(w0[0]) + sc * O[dt][4 * rg], y1 = bfhi(w0[0]) + sc * O[dt][4 * rg + 1], y2 = bflo(w0[1]) + sc * O[dt][4 * rg + 2], y3 = bfhi(w0[1]) + sc * O[dt][4 * rg + 3];
              u32x2 w; w[0] = cvt_pk_bf16(y0, y1); w[1] = cvt_pk_bf16(y2, y3);
              *(u32x2*)(Y + 32 * dt + 8 * rg) = w;
              ss += (y0 * y0 + y1 * y1) + (y2 * y2 + y3 * y3);
          }
      ss = quad_sum(xhalf_sum(ss));
      if (hl == 0 && h == 0) ((float*)(a.ws + WS_STAP))[(size_t)t * 2 + g] = ss;
    }
    __syncthreads();
}
#ifndef PEER_ALPHA
#define PEER_ALPHA 1.0f
#endif
constexpr int PE_SC = 0, PE_LV = 65536, PE_LI = 73728, PE_PK = 81920, PE_EX = 147456, PE_GT = 149504, PE_SU = 153600, PE_CE = 157696, PE_END = 161792;
constexpr int PE_SLOT = 2048, PE_NSLOT = 8, PE_RINGW = PE_SLOT * 9;
static_assert(8 * PE_RINGW <= PE_EX && PE_END <= LDS_BYTES - 32, "PEER LDS map");
__device__ __forceinline__ float pair_wave_sum(float a, float b, bool odd) {
    a += dpp_f<0xB1>(a); b += dpp_f<0xB1>(b);
    float c = odd ? b : a;
    c += dpp_f<0x4E>(c); c += dpp_f<0x124>(c); c += dpp_f<0x128>(c);
    { const auto r = __builtin_amdgcn_permlane16_swap(__float_as_uint(c), __float_as_uint(c), false, false); c = __uint_as_float(r[0]) + __uint_as_float(r[1]); }
    { const auto r = __builtin_amdgcn_permlane32_swap(__float_as_uint(c), __float_as_uint(c), false, false); c = __uint_as_float(r[0]) + __uint_as_float(r[1]); }
    return c;
}
__device__ __forceinline__ float wave_sum_bcast(float v) {
    v += dpp_f<0xB1>(v); v += dpp_f<0x4E>(v); v += dpp_f<0x141>(v); v += dpp_f<0x140>(v);
    v += __int_as_float(__builtin_amdgcn_update_dpp(0, __float_as_int(v), 0x142, 0xa, 0xf, false));
    v += __int_as_float(__builtin_amdgcn_update_dpp(0, __float_as_int(v), 0x143, 0xc, 0xf, false));
    return __int_as_float(__builtin_amdgcn_readlane(__float_as_int(v), 63));
}
__device__ __forceinline__ unsigned mono_key(float v) { const unsigned b = __float_as_uint(v); return b ^ ((b >> 31) ? 0xFFFFFFFFu : 0x80000000u); }
template <int CTRL>
__device__ __forceinline__ void quad_merge16(unsigned (&t)[16]) {
    unsigned o[16];
#pragma unroll
    for (int i = 0; i < 16; ++i) o[i] = (unsigned)__builtin_amdgcn_update_dpp(0, (int)t[15 - i], CTRL, 0xf, 0xf, false);
#pragma unroll
    for (int i = 0; i < 16; ++i) t[i] = max(t[i], o[i]);
#pragma unroll
    for (int st = 8; st >= 1; st >>= 1)
#pragma unroll
        for (int i = 0; i < 16; ++i) if ((i & st) == 0) { const unsigned hi = max(t[i], t[i + st]), lo = min(t[i], t[i + st]); t[i] = hi; t[i + st] = lo; }
}
__device__ __forceinline__ void sort16_desc(unsigned (&t)[16]) {
#pragma unroll
    for (int k = 2; k <= 16; k <<= 1)
#pragma unroll
        for (int j = k >> 1; j > 0; j >>= 1)
#pragma unroll
            for (int i = 0; i < 16; ++i) { const int l = i ^ j; if (l > i) { const bool desc = ((i & k) == 0); const unsigned hi = max(t[i], t[l]), lo = min(t[i], t[l]); t[i] = desc ? hi : lo; t[l] = desc ? lo : hi; } }
}
__device__ __forceinline__ void bitonic_merge16_desc(unsigned (&t)[16]) {
#pragma unroll
    for (int st = 8; st >= 1; st >>= 1)
#pragma unroll
        for (int i = 0; i < 16; ++i) if ((i & st) == 0) { const unsigned hi = max(t[i], t[i + st]), lo = min(t[i], t[i + st]); t[i] = hi; t[i + st] = lo; }
}
__device__ __forceinline__ int pair_a(int p) { return p < 16 ? 0 : p < 24 ? 1 : p < 29 ? 2 : p < 33 ? 3 : p < 36 ? 4 : p < 38 ? 5 : p < 40 ? 6 : p < 42 ? 7 : p - 34; }
__device__ __forceinline__ int pair_b(int p) { return p < 16 ? p : p < 24 ? p - 16 : p < 29 ? p - 24 : p < 33 ? p - 29 : p < 36 ? p - 33 : p < 38 ? p - 36 : p < 40 ? p - 38 : p < 42 ? p - 40 : 0; }
template <bool DRY>
__device__ __forceinline__ void peer_step(const Args& a, const Ctx& c_, int t0) {
    Ctx c = c_; { int tz = c_.tid; asm volatile("" : "+v"(tz)); c.tid = tz; c.lane = tz & 63; }
    LAS unsigned char* lds = c.lds;
    const int tid = c.tid, wave = c.wave, lane = c.lane, r = lane & 15, q = lane >> 4;
    const bf16_t* QP = (const bf16_t*)(a.ws + WS_QP); const bf16_t* PK = (const bf16_t*)(a.ws + WS_PK);
    const unsigned char* PU = a.ws + WS_PU; const unsigned char* PV = a.ws + WS_PV; const float* psc = (const float*)(a.ws + WS_PSC);
    const bf16_t* HB = (const bf16_t*)(a.ws + WS_H2);
    const int t = t0 + wave;
    u32x2 hraw[8], xw[8];
#pragma unroll
    for (int k = 0; k < 8; ++k) hraw[k] = *(const u32x2*)(HB + (size_t)t * 2048 + 256 * k + lane * 4);
#pragma unroll
    for (int k = 0; k < 8; ++k) xw[k] = *(const u32x2*)((const bf16_t*)(a.ws + WS_X1) + (size_t)t * 2048 + 256 * k + lane * 4);
    const float r2 = ((const float*)(a.ws + WS_RSTD2))[t0 + ((tid >> 5) & 7)];
    {
#pragma unroll
        for (int i = 0; i < 8; ++i) { const int pc = 8 * wave + i, row = 4 * pc + (lane >> 4), ch = (lane & 15) ^ kswz(row);
            __builtin_amdgcn_global_load_lds((const unsigned*)(PK + (size_t)row * 128 + ch * 8), (LAS unsigned*)(lds + PE_PK + pc * 1024), 16, 0, 0); }
        const int hh = wave;
        bf16x8 aF[2][4];
#pragma unroll
        for (int cc = 0; cc < 2; ++cc)
#pragma unroll
            for (int ks = 0; ks < 4; ++ks) aF[cc][ks] = *(const bf16x8*)(QP + (size_t)(t0 + (r & 7)) * 2048 + hh * 256 + cc * 128 + 32 * ks + 8 * q);
        asm volatile("s_waitcnt vmcnt(0)" ::: "memory");
        __syncthreads();
        const int ksw = kswz(r);
#pragma unroll
        for (int cc = 0; cc < 2; ++cc)
#pragma unroll 2
            for (int nt = 0; nt < 8; ++nt) {
                f32x4 acc = {0.f, 0.f, 0.f, 0.f};
#pragma unroll
                for (int ks = 0; ks < 4; ++ks) { const bf16x8 B = *(const LAS bf16x8*)(lds + PE_PK + (cc * 128 + 16 * nt + r) * 256 + 16 * ((4 * ks + q) ^ ksw)); acc = mfma16(aF[cc][ks], B, acc); }
                if (q < 2) {
#pragma unroll
                    for (int i = 0; i < 4; ++i) { const int task = (4 * q + i) * 16 + hh * 2 + cc; *(LAS float*)(lds + PE_SC + (task * 128 + ((16 * nt + r + task) & 127)) * 4) = acc[i]; }
                }
            }
    }
    __syncthreads();
    {
        const int task = tid >> 2, part = tid & 3;
        LAS const float* sc = (LAS const float*)(lds + PE_SC) + task * 128;
        float vals[32];
#pragma unroll
        for (int k = 0; k < 32; ++k) vals[k] = sc[(32 * part + k + task) & 127];
        unsigned top[16], tb[16];
#pragma unroll
        for (int k = 0; k < 16; ++k) { top[k] = (mono_key(vals[k]) & ~0x7Fu) | (unsigned)(127 - (32 * part + k)); tb[k] = (mono_key(vals[16 + k]) & ~0x7Fu) | (unsigned)(127 - (32 * part + 16 + k)); }
        sort16_desc(top); sort16_desc(tb);
#pragma unroll
        for (int i = 0; i < 16; ++i) top[i] = max(top[i], tb[15 - i]);
        bitonic_merge16_desc(top);
        quad_merge16<0xB1>(top);
        quad_merge16<0x4E>(top);
        if (part == 0) {
#pragma unroll
            for (int e = 0; e < 16; ++e) { const int idx = 127 - (int)(top[e] & 0x7Fu); *(LAS float*)(lds + PE_LV + (task * 16 + e) * 4) = sc[(idx + task) & 127]; *(LAS int*)(lds + PE_LI + (task * 16 + e) * 4) = idx; }
        }
    }
    __syncthreads();
    if (tid < 256) {
        const int task = tid >> 2, part = tid & 3, tok = task >> 3, hh = task & 7, t1 = tok * 16 + hh * 2, t2 = t1 + 1;
        LAS const float* lv1 = (LAS const float*)(lds + PE_LV) + t1 * 16; LAS const float* lv2 = (LAS const float*)(lds + PE_LV) + t2 * 16;
        unsigned top[16];
#pragma unroll
        for (int i = 0; i < 16; ++i) {
            const int p = part + 4 * i;
            top[i] = 0u;
            if (i < 13 && p < 50) { const int aa = pair_a(p), bb = pair_b(p); top[i] = (mono_key(lv1[aa] + lv2[bb]) & ~0xFFu) | (unsigned)(255 - (aa * 16 + bb)); }
        }
        sort16_desc(top);
        quad_merge16<0xB1>(top);
        quad_merge16<0x4E>(top);
        if (part == 0) {
            LAS const int* li1 = (LAS const int*)(lds + PE_LI) + t1 * 16; LAS const int* li2 = (LAS const int*)(lds + PE_LI) + t2 * 16;
            float sv[16]; int ex[16]; float mx = -INFINITY;
#pragma unroll
            for (int e = 0; e < 16; ++e) {
                const int id = 255 - (int)(top[e] & 0xFFu), aa = id >> 4, bb = id & 15;
                sv[e] = lv1[aa] + lv2[bb]; ex[e] = li1[aa] * 128 + li2[bb]; mx = fmaxf(mx, sv[e]);
            }
            float sum = 0.f;
#pragma unroll
            for (int e = 0; e < 16; ++e) { sv[e] = fexp2((sv[e] - mx) * LOG2E); sum += sv[e]; }
            const float inv = 1.f / sum;
#pragma unroll
            for (int e = 0; e < 16; ++e) *(LAS unsigned short*)(lds + PE_EX + (tok * 128 + hh * 16 + e) * 2) = (unsigned short)ex[e];
            f32x4 rec[16];
#pragma unroll
            for (int e = 0; e < 16; ++e) rec[e] = *(const f32x4*)(psc + (size_t)ex[e] * 4);
            __builtin_amdgcn_sched_barrier(0);
#pragma unroll
            for (int e = 0; e < 16; ++e) asm volatile("" :: "v"(rec[e]));
#pragma unroll
            for (int e = 0; e < 16; ++e) {
                *(LAS float*)(lds + PE_GT + (tok * 128 + hh * 16 + e) * 4) = sv[e] * inv * rec[e][2];
                *(LAS float*)(lds + PE_SU + (tok * 128 + hh * 16 + e) * 4) = rec[e][0] * r2;
                *(LAS float*)(lds + PE_CE + (tok * 128 + hh * 16 + e) * 4) = rec[e][1]; }
        }
    }
    __syncthreads();
    f32x2 hp[16];
#pragma unroll
    for (int k = 0; k < 8; ++k)
#pragma unroll
        for (int e = 0; e < 2; ++e) { hp[k * 2 + e][0] = bflo(hraw[k][e]); hp[k * 2 + e][1] = bfhi(hraw[k][e]); }
    f32x2 acc[16];
#pragma unroll
    for (int e = 0; e < 16; ++e) acc[e] = (f32x2){0.f, 0.f};
    asm volatile("s_waitcnt vmcnt(0)" ::: "memory");
    f32x4 gvv[8], fvv[8];
    {
        int lo_ = wave * 512 + (lane & 1) * 4; asm volatile("" : "+v"(lo_));
        LAS const float* gtl = (LAS const float*)(lds + PE_GT + lo_); LAS const float* sul = (LAS const float*)(lds + PE_SU + lo_); LAS const float* cel = (LAS const float*)(lds + PE_CE + lo_);
        int xo_ = wave * 256; asm volatile("" : "+v"(xo_));
        LAS const unsigned short* exl = (LAS const unsigned short*)(lds + PE_EX + xo_);
        const bool odd = lane & 1;
        LAS unsigned char* ring = lds + wave * PE_RINGW;
#define ISSUE_U(SL, IDX) do { const int ex_ = __builtin_amdgcn_readfirstlane((int)exl[IDX]); \
            __builtin_amdgcn_global_load_lds((const unsigned*)(PU + (size_t)ex_ * 1024 + lane * 16), (LAS unsigned*)(ring + (SL) * PE_SLOT), 16, 0, 0); } while (0)
#define ISSUE_V(SL, IDX) do { const int ex_ = __builtin_amdgcn_readfirstlane((int)exl[IDX]); \
            __builtin_amdgcn_global_load_lds((const unsigned*)(PV + (size_t)ex_ * 1024 + lane * 16), (LAS unsigned*)(ring + (SL) * PE_SLOT + 1024), 16, 0, 0); } while (0)
#define UDOT(UW, D0, D1, D2, D3) do { _Pragma("unroll") for (int dw = 0; dw < 4; ++dw) { const f32x2 f0_ = fp4_unpk<0>(UW[dw]), f1_ = fp4_unpk<1>(UW[dw]), f2_ = fp4_unpk<2>(UW[dw]), f3_ = fp4_unpk<3>(UW[dw]); \
                D0 += f0_ * hp[4 * dw]; D1 += f1_ * hp[4 * dw + 1]; D2 += f2_ * hp[4 * dw + 2]; D3 += f3_ * hp[4 * dw + 3]; } } while (0)
#define VACC(VW, WG) do { _Pragma("unroll") for (int dw = 0; dw < 4; ++dw) { const f32x2 f0_ = fp4_unpk<0>(VW[dw]), f1_ = fp4_unpk<1>(VW[dw]), f2_ = fp4_unpk<2>(VW[dw]), f3_ = fp4_unpk<3>(VW[dw]); \
                acc[4 * dw] += WG * f0_; acc[4 * dw + 1] += WG * f1_; acc[4 * dw + 2] += WG * f2_; acc[4 * dw + 3] += WG * f3_; } } while (0)
#define STAGE_A(SA, SB, PA, PB) do { const u32x4 ua_ = *(const LAS u32x4*)(ring + (SA) * PE_SLOT + lane * 16), ub_ = *(const LAS u32x4*)(ring + (SB) * PE_SLOT + lane * 16); \
            f32x2 a0_ = {0.f, 0.f}, a1_ = {0.f, 0.f}, a2_ = {0.f, 0.f}, a3_ = {0.f, 0.f}, b0_ = {0.f, 0.f}, b1_ = {0.f, 0.f}, b2_ = {0.f, 0.f}, b3_ = {0.f, 0.f}; \
            UDOT(ua_, a0_, a1_, a2_, a3_); UDOT(ub_, b0_, b1_, b2_, b3_); \
            const f32x2 as_ = (a0_ + a1_) + (a2_ + a3_), bs_ = (b0_ + b1_) + (b2_ + b3_); PA = as_[0] + as_[1]; PB = bs_[0] + bs_[1]; } while (0)
#define STAGE_B(IDX, PA, PB, WA, WB) do { const float cs_ = pair_wave_sum(PA, PB, odd);                           \
            const float wl_ = gtl[IDX] * gelu_tanh(cs_ * sul[IDX] + cel[IDX]);                            \
            WA = dpp_f<0xA0>(wl_); WB = dpp_f<0xF5>(wl_); } while (0)
#define STAGE_C(SA, SB, WA, WB) do { const u32x4 va_ = *(const LAS u32x4*)(ring + (SA) * PE_SLOT + 1024 + lane * 16), vb_ = *(const LAS u32x4*)(ring + (SB) * PE_SLOT + 1024 + lane * 16); \
            VACC(va_, WA); VACC(vb_, WB); } while (0)
#define DMA_WAIT(N) asm volatile("s_waitcnt vmcnt(" #N ")" ::: "memory")
#define LDS_DONE() asm volatile("s_waitcnt lgkmcnt(0)" ::: "memory")
#define PAIR_ITER(P, NS, DOA, UW, DOU, VW, DOV) do { float na_ = 0.f, nb_ = 0.f, wa_, wb_; \
            if (DOA) { DMA_WAIT(UW); STAGE_A(NS, (NS) + 1, na_, nb_); } \
            STAGE_B(e + 2 * (P), pa, pb, wa_, wb_); \
            LDS_DONE(); \
            if (DOU) { ISSUE_U(NS, e + 2 * (P) + 10); ISSUE_U((NS) + 1, e + 2 * (P) + 11); } \
            DMA_WAIT(VW); STAGE_C(2 * (P), 2 * (P) + 1, wa_, wb_); \
            LDS_DONE(); \
            if (DOV) { ISSUE_V(2 * (P), e + 2 * (P) + 8); ISSUE_V(2 * (P) + 1, e + 2 * (P) + 9); } \
            pa = na_; pb = nb_; } while (0)
        float pa, pb;
        if (!DRY) {
        ISSUE_U(0, 0); ISSUE_U(1, 1); ISSUE_U(2, 2); ISSUE_U(3, 3); ISSUE_V(0, 0); ISSUE_V(1, 1); ISSUE_U(4, 4); ISSUE_U(5, 5); ISSUE_V(2, 2); ISSUE_V(3, 3);
        ISSUE_U(6, 6); ISSUE_U(7, 7); ISSUE_V(4, 4); ISSUE_V(5, 5);
        DMA_WAIT(12); STAGE_A(0, 1, pa, pb); LDS_DONE();
        ISSUE_U(0, 8); ISSUE_U(1, 9); ISSUE_V(6, 6); ISSUE_V(7, 7);
#pragma unroll 1
        for (int tr = 0; tr < 14; ++tr) {
            const int e = tr * 8;
            PAIR_ITER(0, 2, true, 14, true, 14, true);
            PAIR_ITER(1, 4, true, 14, true, 14, true);
            PAIR_ITER(2, 6, true, 14, true, 14, true);
            PAIR_ITER(3, 0, true, 14, true, 14, true);
        }
        { const int e = 14 * 8;
            PAIR_ITER(0, 2, true, 14, true, 14, true);
            PAIR_ITER(1, 4, true, 14, true, 14, true);
            PAIR_ITER(2, 6, true, 14, true, 14, true);
            PAIR_ITER(3, 0, true, 14, false, 12, true); }
        { const float* g2 = (const float*)(a.ws + WS_COND) + 5 * 2048; const float* fg = a.in[32];
#pragma unroll
          for (int k = 0; k < 8; ++k) { const int col = 256 * k + lane * 4; gvv[k] = *(const f32x4*)(g2 + col); fvv[k] = *(const f32x4*)(fg + col); } }
        { const int e = 15 * 8;
            PAIR_ITER(0, 2, true, 28, false, 26, false);
            PAIR_ITER(1, 4, true, 24, false, 22, false);
            PAIR_ITER(2, 6, true, 20, false, 18, false);
            PAIR_ITER(3, 0, false, 0, false, 16, false); }
        }
#undef ISSUE_U
#undef ISSUE_V
#undef STAGE_A
#undef STAGE_B
#undef STAGE_C
#undef LDS_DONE
#undef PAIR_ITER
#undef UDOT
#undef VACC
#undef DMA_WAIT
    }
    {
        float* xo = a.out + (size_t)t * 2048;
        float ss = 0.f;
#pragma unroll
        for (int k = 0; k < 8; ++k) {
            const float x1[4] = {bflo(xw[k][0]), bfhi(xw[k][0]), bflo(xw[k][1]), bfhi(xw[k][1])};
#pragma unroll
            for (int e = 0; e < 4; ++e) { const float x2 = x1[e] + PEER_ALPHA * gvv[k][e] * acc[k * 2 + (e >> 1)][e & 1]; acc[k * 2 + (e >> 1)][e & 1] = x2; ss += x2 * x2; }
        }
        ss = wave_sum_bcast(ss);
        const float rstd = rsqrtf(ss * (1.f / 2048.f) + 1e-6f);
#pragma unroll
        for (int k = 0; k < 8; ++k) {
            const int col = 256 * k + lane * 4;
            f32x4 o;
#pragma unroll
            for (int e = 0; e < 4; ++e) o[e] = acc[k * 2 + (e >> 1)][e & 1] * rstd * fvv[k][e];
            if (!DRY || rstd == 123.456f) *(f32x4*)(xo + col) = o;
        }
    }
    __syncthreads();
}
constexpr int NPHASE = 11;
#ifndef DBG
#define DBG 0
#endif
__device__ __forceinline__ void dbg_final_norm(const Args& a, const Ctx& c, const float* src) {
    for (int t = c.bid * 8 + c.wave; t < L_; t += c.nb * 8) {
        const float* xr = src + (size_t)t * 2048 + c.lane * 4; float* o = a.out + (size_t)t * 2048 + c.lane * 4;
        f32x4 v[8]; float ss = 0.f;
#pragma unroll
        for (int j = 0; j < 8; ++j) { v[j] = *(const f32x4*)(xr + j * 256); ss += v[j][0] * v[j][0] + v[j][1] * v[j][1] + v[j][2] * v[j][2] + v[j][3] * v[j][3]; }
        ss = wave_sum(ss);
        const float rstd = rsqrtf(ss * (1.f / 2048.f) + 1e-6f);
#pragma unroll
        for (int j = 0; j < 8; ++j) { const f32x4 g = *(const f32x4*)(a.in[32] + j * 256 + c.lane * 4); *(f32x4*)(o + j * 256) = v[j] * rstd * g; }
    }
}

extern __shared__ __attribute__((aligned(16))) unsigned char smem[];

__global__ void __launch_bounds__(512, 2) fwd(Args a) {
    LAS unsigned char* lds = (LAS unsigned char*)smem;
    Ctx c; c.bid = blockIdx.x; c.nb = gridDim.x; c.tid = threadIdx.x; c.wave = __builtin_amdgcn_readfirstlane(threadIdx.x >> 6); c.lane = threadIdx.x & 63; c.lds = lds;
    volatile LAS unsigned* xbw = (volatile LAS unsigned*)(lds + LDS_BYTES - 16);
    if (c.tid < 4) xbw[c.tid] = 0u;
    __syncthreads();
    const int lo = a.ph_lo, hi = a.ph_hi;
    const bool multi = (hi - lo) > 1;
    XcdBarrier bar; bar.bar = (unsigned*)(a.ws + WS_CTL); bar.x = 0; bar.st = xbw;
    if (multi) bar = xcd_barrier_post((unsigned*)(a.ws + WS_CTL), xbw);
#ifndef PHASE_MASK
#define PHASE_MASK 0xFFFF
#endif
#if DBG == 1
#undef PHASE_MASK
#define PHASE_MASK 0x403
#elif DBG == 2 || DBG == 4 || DBG == 5
#undef PHASE_MASK
#define PHASE_MASK 0x4FF
#endif
#define IN(k) (((PHASE_MASK >> (k)) & 1) && lo <= (k) && (k) < hi)
#define REFRESH() do { int tz_ = threadIdx.x; asm volatile("" : "+v"(tz_)); c.tid = tz_; c.lane = tz_ & 63; c.wave = __builtin_amdgcn_readfirstlane(tz_ >> 6); } while (0)
#define SEAM(k) do { if (IN(k) && IN((k) + 1)) xcd_barrier(bar); } while (0)
#ifndef DUP
#define DUP -1
#endif
#define REP(k) for (int rep_ = 0; rep_ < ((DUP == (k)) ? 2 : 1); ++rep_)
#define DUP2(k, ...) do { __VA_ARGS__; if (DUP == (k)) { __syncthreads(); __VA_ARGS__; } } while (0)

    if (IN(0)) REP(0) { REFRESH(); p0_prologue(a, c); }
    SEAM(0);
    if (IN(1)) { REFRESH(); DUP2(1, p1_hnorm(a, c)); }
    SEAM(1);
    if (IN(2)) { REFRESH();
        pg8::StaticOrder S; S.init((const bf16_t*)(a.ws + WS_H), (const bf16_t*)(a.ws + WS_WIN), 2048, 2048, 2048, L_, DIN_PAD, c.nb, c.bid);
        EpiWin E{(bf16_t*)(a.ws + WS_US), (bf16_t*)(a.ws + WS_Q), (bf16_t*)(a.ws + WS_KROW), (bf16_t*)(a.ws + WS_VROW), (bf16_t*)(a.ws + WS_VT), (float*)(a.ws + WS_GATE)};
        DUP2(2, pg8::gemm_phase<EpiWin, pg8::StaticOrder>(lds, S, E));
    }
    SEAM(2);
    if (IN(3)) { REFRESH();
        DUP2(31, for (int it = c.bid; it < 256; it += c.nb) s5_item<0>(a, c, it >> 2, it & 3));
        __syncthreads();
        CmpOrder S{(const bf16_t*)(a.ws + WS_KROW), (const bf16_t*)(a.ws + WS_VROW), (const bf16_t*)(a.ws + WS_W1), 2048, 4096, 256, c.nb, c.bid};
        EpiSlab E{(float*)(a.ws + WS_SLAB)};
        DUP2(32, pg8::gemm_phase<EpiSlab, CmpOrder>(lds, S, E));
    }
    SEAM(3);
    if (IN(4)) { REFRESH();
        DUP2(41, for (int it = c.bid; it < 256; it += c.nb) cmp_finish_item(a, c, it >> 7, it & 127));
        DUP2(42, for (int it = c.bid; it < 256; it += c.nb) s5_item<1>(a, c, it >> 2, it & 3));
    }
    SEAM(4);
    if (IN(5)) { REFRESH();
#if DBG == 5
        for (size_t i = (size_t)c.bid * NTHREADS + c.tid; i < (size_t)L_ * 1024 / 8; i += (size_t)c.nb * NTHREADS) *(u32x4*)((bf16_t*)(a.ws + WS_YSSM) + i * 8) = (u32x4){0u, 0u, 0u, 0u};
#else
        {
            pg8::StaticOrder S; S.init((const bf16_t*)(a.ws + WS_Z), (const bf16_t*)(a.ws + WS_WGLU), 1024, 1024, 1024, L_, 1024, c.nb, c.bid);
            EpiGlu E{(const bf16_t*)(a.ws + WS_Z), a.in[19], (bf16_t*)(a.ws + WS_Y2), (float*)(a.ws + WS_STSP)};
            DUP2(55, pg8::gemm_phase<EpiGlu, pg8::StaticOrder>(lds, S, E));
        }
#endif
        __syncthreads();
        REP(5)
#if DBG == 4
        for (size_t i = (size_t)c.bid * NTHREADS + c.tid; i < (size_t)L_ * 1024 / 8; i += (size_t)c.nb * NTHREADS) *(u32x4*)((bf16_t*)(a.ws + WS_YATT) + i * 8) = (u32x4){0u, 0u, 0u, 0u};
#else
        {
            unsigned* qhead = (unsigned*)(a.ws + WS_CTL) + 8192;
            volatile LAS unsigned* slot = (volatile LAS unsigned*)(lds + LDS_BYTES - 32);
            for (;;) {
                if (c.tid == 0) *slot = __hip_atomic_fetch_add(qhead, 1u, __ATOMIC_RELAXED, __HIP_MEMORY_SCOPE_AGENT);
                __syncthreads();
                const unsigned q = *slot;
                __syncthreads();
                if (q >= 512u) break;
                attn_item(a, c, 255 - (int)(q >> 1), (int)(q & 1));
            }
        }
#endif
    }
    SEAM(5);
#define WOUT_GEMM(PM0) do { pg8::StaticOrder S; S.init((const bf16_t*)(a.ws + WS_Y2), (const bf16_t*)(a.ws + WS_WOUT), 2048, 2048, 2048, L_ / 2, 2048, c.nb, c.bid, PM0); \
        rsa_prepass(S, (const float*)(a.ws + WS_STSP), (const float*)(a.ws + WS_STAP), (float*)(a.ws + WS_RSA), c.tid); \
        EpiWout E{a.in[0], (const float*)(a.ws + WS_COND) + 2 * 2048, (const float*)(a.ws + WS_F2), (bf16_t*)(a.ws + WS_X1), (bf16_t*)(a.ws + WS_H2), (float*)(a.ws + WS_ST2P), (const float*)(a.ws + WS_RSA)}; \
        pg8::gemm_phase<EpiWout, pg8::StaticOrder>(lds, S, E); __syncthreads(); } while (0)
#define WQ_GEMM(PM0) do { pg8::StaticOrder S; S.init((const bf16_t*)(a.ws + WS_H2), (const bf16_t*)(a.ws + WS_WQ), 2048, 2048, 2048, L_ / 2, 2048, c.nb, c.bid, PM0); \
        rstd2_prepass(S, (const float*)(a.ws + WS_ST2P), (float*)(a.ws + WS_RSTD2), c.tid); \
        EpiQ E{(bf16_t*)(a.ws + WS_QP), (const float*)(a.ws + WS_RSTD2), (const float*)(a.ws + WS_CQ)}; pg8::gemm_phase<EpiQ, pg8::StaticOrder>(lds, S, E); __syncthreads(); } while (0)
#define PEER_STEPS(FIRST, COUNT) do { for (int s_ = (FIRST) + c.bid; s_ < (FIRST) + (COUNT); s_ += c.nb) peer_step<false>(a, c, s_ * 8); } while (0)
    if (IN(6)) { REFRESH(); DUP2(7, p_cqce(a, c)); DUP2(71, WOUT_GEMM(0)); }
    SEAM(6);
    if (IN(7)) { REFRESH(); DUP2(8, WQ_GEMM(0)); }
    SEAM(7);
    if (IN(8)) { REFRESH();
        if ((c.bid >> 3) & 1) PEER_STEPS(0, 512);
        WOUT_GEMM(32);
        if (!((c.bid >> 3) & 1)) PEER_STEPS(0, 512); }
    SEAM(8);
    if (IN(9)) { REFRESH();
        if ((c.bid >> 3) & 1) PEER_STEPS(512, 512);
        WQ_GEMM(32);
        if (!((c.bid >> 3) & 1)) PEER_STEPS(512, 512); }
    SEAM(9);
#if defined(PROBE_DRY)
    if (IN(10)) { REFRESH(); for (int s_ = 1024 + c.bid; s_ < 2048; s_ += c.nb) peer_step<true>(a, c, s_ * 8); __syncthreads(); PEER_STEPS(1024, 1024); }
#else
    if (IN(10)) { REFRESH(); DUP2(11, PEER_STEPS(1024, 1024)); }
#endif
#undef WOUT_GEMM
#undef WQ_GEMM
#undef PEER_STEPS
#undef IN
#undef SEAM
}

#ifndef N_LAUNCHES
#define N_LAUNCHES 1
#endif
extern "C" void kernel_launch(void* const* d_in, const int* in_sizes, int n_in, void* d_out, int out_size, void* d_ws, size_t ws_size, hipStream_t stream) {
    static int grid = 0;
    if (grid == 0) {
        if (n_in != 33 || out_size != L_ * D_ || ws_size < WS_END) { fprintf(stderr, "kernel_launch: unexpected shapes (n_in %d, out %d, ws %zu < %zu); nothing launched\n", n_in, out_size, ws_size, (size_t)WS_END); grid = -1; return; }
        int dev = 0, cus = 0, per_cu = 0;
        if (hipGetDevice(&dev) != hipSuccess || hipDeviceGetAttribute(&cus, hipDeviceAttributeMultiprocessorCount, dev) != hipSuccess) { grid = -1; return; }
        if (hipFuncSetAttribute((const void*)fwd, hipFuncAttributeMaxDynamicSharedMemorySize, LDS_BYTES) != hipSuccess) { fprintf(stderr, "kernel_launch: hipFuncSetAttribute failed\n"); grid = -1; return; }
        if (hipOccupancyMaxActiveBlocksPerMultiprocessor(&per_cu, (const void*)fwd, NTHREADS, LDS_BYTES) != hipSuccess || per_cu < 1) { fprintf(stderr, "kernel_launch: occupancy query says %d\n", per_cu); (void)hipGetLastError(); grid = -1; return; }
        grid = cus;
    }
    if (grid < 0) return;
    (void)hipMemsetAsync((char*)d_ws + WS_CTL, 0, CTL_BYTES, stream);
    Args a{};
    for (int i = 0; i < 33; ++i) a.in[i] = (const float*)d_in[i];
    a.out = (float*)d_out; a.ws = (unsigned char*)d_ws;
    if (N_LAUNCHES == 1) { a.ph_lo = 0; a.ph_hi = NPHASE; hipLaunchKernelGGL(fwd, dim3(grid), dim3(NTHREADS), LDS_BYTES, stream, a); }
    else for (int p = 0; p < NPHASE; ++p) { a.ph_lo = p; a.ph_hi = p + 1; hipLaunchKernelGGL(fwd, dim3(grid), dim3(NTHREADS), LDS_BYTES, stream, a); }
}
```

```cpp
#include <hip/hip_runtime.h>
#include <stdint.h>
#include <stdio.h>

#define LAS __attribute__((address_space(3)))
typedef unsigned short bf16_t;
typedef short bf16x8 __attribute__((ext_vector_type(8)));
typedef float f32x2 __attribute__((ext_vector_type(2)));
typedef float f32x4 __attribute__((ext_vector_type(4)));
typedef float f32x16 __attribute__((ext_vector_type(16)));
typedef unsigned u32x2 __attribute__((ext_vector_type(2)));
typedef unsigned u32x4 __attribute__((ext_vector_type(4)));
typedef __bf16 bfv2 __attribute__((ext_vector_type(2)));
typedef unsigned u32x6 __attribute__((ext_vector_type(6)));
typedef float f32x32 __attribute__((ext_vector_type(32)));

constexpr int L_ = 16384, D_ = 2048, DSSM = 1024, DATT = 1024, DIN = 3608, DIN_PAD = 3840;
constexpr int NADA = 12288;
constexpr float LOG2E = 1.4426950408889634f;
constexpr float QSCALE = 0.08838834764831845f * 1.4426950408889634f;
constexpr int TBN = 800;
constexpr int NTHREADS = 512;
constexpr int LDS_BYTES = 163840;

constexpr size_t al256(size_t x) { return (x + 255) & ~(size_t)255; }
constexpr size_t WS_CTL   = 0;                                  constexpr size_t CTL_BYTES = 65536;
constexpr size_t WS_CONDP = WS_CTL + CTL_BYTES;
constexpr size_t WS_COND  = WS_CONDP + 32 * 12288 * 4;
constexpr size_t WS_TB    = WS_COND + 12288 * 4;
constexpr size_t WS_BPE   = al256(WS_TB + 8 * TBN * 4);
constexpr size_t WS_S5P   = al256(WS_BPE + 2 * 256 * 4);
constexpr size_t WS_S5F   = WS_S5P + 2 * 64 * 64 * 2 * 4;
constexpr size_t WS_S5MT  = WS_S5F + 64 * 4 * 128 * 4;
constexpr size_t WS_S5WE  = WS_S5MT + (size_t)64 * 256 * 256 * 2;
constexpr size_t WS_S5WC  = WS_S5WE + (size_t)64 * 128 * 256 * 2;
constexpr size_t WS_WIN   = WS_S5WC + (size_t)64 * 256 * 128 * 2;
constexpr size_t WS_WGLU  = WS_WIN + (size_t)DIN_PAD * 2048 * 2;
constexpr size_t WS_WOUT  = WS_WGLU + (size_t)1024 * 1024 * 2;
constexpr size_t WS_WQ    = WS_WOUT + (size_t)2048 * 2048 * 2;
constexpr size_t WS_W1    = WS_WQ + (size_t)2048 * 2048 * 2;
constexpr size_t WS_W2    = WS_W1 + (size_t)2 * 256 * 4096 * 2;
constexpr size_t WS_PK    = WS_W2 + (size_t)2 * 128 * 256 * 2;
constexpr size_t WS_PU    = WS_PK + (size_t)2 * 128 * 128 * 2;
constexpr size_t WS_PV    = WS_PU + (size_t)16384 * 1024;
constexpr size_t WS_PSC   = WS_PV + (size_t)16384 * 1024;
constexpr size_t WS_BPEP  = WS_PSC + (size_t)4 * 16384 * 4;
constexpr size_t WS_H     = WS_BPEP + (size_t)32 * 2 * 256 * 4;
constexpr size_t WS_US    = WS_H + (size_t)16384 * 2048 * 2;
constexpr size_t WS_Q     = WS_US + (size_t)16384 * 1024 * 2;
constexpr size_t WS_QP    = WS_US;
constexpr size_t WS_KROW  = WS_Q + (size_t)16384 * 1024 * 2;
constexpr size_t WS_VROW  = WS_KROW + (size_t)6 * 16384 * 128 * 2;
constexpr size_t WS_VT    = WS_VROW + (size_t)2 * 16384 * 128 * 2 + 8192;
constexpr size_t WS_GATE  = WS_VT + (size_t)4 * 128 * 16384 * 2;
constexpr size_t WS_SLAB  = WS_GATE + (size_t)16384 * 24 * 4;
constexpr size_t WS_KC    = WS_SLAB + (size_t)2 * 16 * 2048 * 256 * 4;
constexpr size_t WS_VCT   = WS_KC + (size_t)2 * 1024 * 128 * 2;
constexpr size_t WS_Z     = WS_VCT + (size_t)2 * 128 * 1024 * 2;
constexpr size_t WS_YSSM  = WS_Z + (size_t)16384 * 1024 * 2;
constexpr size_t WS_YATT  = WS_YSSM + (size_t)16384 * 1024 * 2;
constexpr size_t WS_H2    = WS_SLAB;
constexpr size_t WS_Y2    = WS_YSSM;
constexpr size_t WS_X1    = WS_H;
constexpr size_t WS_ST2P  = WS_YATT + (size_t)16384 * 1024 * 2;
constexpr size_t WS_RSTD2 = WS_ST2P + (size_t)16384 * 32 * 4;
constexpr size_t WS_F2    = WS_RSTD2 + (size_t)16384 * 4;
constexpr size_t WS_CQ    = WS_F2 + 2048 * 4;
constexpr size_t WS_STSP  = WS_CQ + 2048 * 4;
constexpr size_t WS_STAP  = WS_STSP + (size_t)16384 * 16 * 4;
constexpr size_t WS_RSA   = WS_STAP + (size_t)16384 * 2 * 4;
constexpr size_t WS_END   = WS_RSA + (size_t)16384 * 2 * 4;
static_assert(WS_END < (size_t)530 * 1024 * 1024, "workspace map too large");

struct Args { const float* in[33]; float* out; unsigned char* ws; int ph_lo, ph_hi; };

__device__ __forceinline__ unsigned cvt_pk_bf16(float lo, float hi) { bfv2 v; v[0] = (__bf16)lo; v[1] = (__bf16)hi; return __builtin_bit_cast(unsigned, v); }
__device__ __forceinline__ bf16_t f2bf(float f) { return (bf16_t)(cvt_pk_bf16(f, 0.f) & 0xffffu); }
__device__ __forceinline__ float bf2f(unsigned b) { return __uint_as_float(b << 16); }
__device__ __forceinline__ float bflo(unsigned w) { return __uint_as_float(w << 16); }
__device__ __forceinline__ float bfhi(unsigned w) { return __uint_as_float(w & 0xffff0000u); }
__device__ __forceinline__ float fexp2(float x) { return __builtin_amdgcn_exp2f(x); }
__device__ __forceinline__ float frcp(float x) { return __builtin_amdgcn_rcpf(x); }
__device__ __forceinline__ float sigmoidf_(float x) { return frcp(1.f + fexp2(-LOG2E * x)); }
__device__ __forceinline__ float gelu_tanh(float x) {
    const float u = x * (1.f + 0.044715f * x * x);
    return x * frcp(1.f + fexp2(-2.f * 0.7978845608028654f * LOG2E * u));
}
__device__ __forceinline__ float shfl_xor_f(float v, int m) { return __shfl_xor(v, m, 64); }
__device__ __forceinline__ float wave_sum(float v) {
#pragma unroll
    for (int m = 32; m >= 1; m >>= 1) v += __shfl_xor(v, m, 64);
    return v;
}
__device__ __forceinline__ float wave_max(float v) {
#pragma unroll
    for (int m = 32; m >= 1; m >>= 1) v = fmaxf(v, __shfl_xor(v, m, 64));
    return v;
}
template <int CTRL> __device__ __forceinline__ float dpp_f(float x) { return __int_as_float(__builtin_amdgcn_update_dpp(0, __float_as_int(x), CTRL, 0xf, 0xf, false)); }
__device__ __forceinline__ float wave_max_bcast(float v) {
    v = fmaxf(v, dpp_f<0xB1>(v)); v = fmaxf(v, dpp_f<0x4E>(v)); v = fmaxf(v, dpp_f<0x141>(v)); v = fmaxf(v, dpp_f<0x140>(v));
    v = fmaxf(v, __int_as_float(__builtin_amdgcn_update_dpp(__float_as_int(v), __float_as_int(v), 0x142, 0xa, 0xf, false)));
    v = fmaxf(v, __int_as_float(__builtin_amdgcn_update_dpp(__float_as_int(v), __float_as_int(v), 0x143, 0xc, 0xf, false)));
    return __int_as_float(__builtin_amdgcn_readlane(__float_as_int(v), 63));
}
__device__ __forceinline__ unsigned wave_umax_bcast(unsigned v) {
#define UDPP_(x, ctrl, rm) (unsigned)__builtin_amdgcn_update_dpp((int)(x), (int)(x), ctrl, rm, 0xf, false)
    v = max(v, UDPP_(v, 0xB1, 0xf)); v = max(v, UDPP_(v, 0x4E, 0xf)); v = max(v, UDPP_(v, 0x141, 0xf)); v = max(v, UDPP_(v, 0x140, 0xf));
    v = max(v, UDPP_(v, 0x142, 0xa)); v = max(v, UDPP_(v, 0x143, 0xc));
#undef UDPP_
    return (unsigned)__builtin_amdgcn_readlane((int)v, 63);
}
__device__ __forceinline__ float quad_sum(float x) { x += dpp_f<0xB1>(x); x += dpp_f<0x4E>(x); return x; }
template <int SEL> __device__ __forceinline__ f32x2 fp4_unpk(unsigned w) { return __builtin_amdgcn_cvt_scalef32_pk_f32_fp4(w, 1.0f, SEL); }
template <int SEL> __device__ __forceinline__ unsigned fp4_pk(unsigned w, float a, float b) { return __builtin_amdgcn_cvt_scalef32_pk_fp4_f32(w, a, b, 1.0f, SEL); }
__device__ __forceinline__ f32x4 mfma16(bf16x8 a, bf16x8 b, f32x4 c) { return __builtin_amdgcn_mfma_f32_16x16x32_bf16(a, b, c, 0, 0, 0); }
__device__ __forceinline__ f32x16 mfma32(bf16x8 a, bf16x8 b, f32x16 c) { return __builtin_amdgcn_mfma_f32_32x32x16_bf16(a, b, c, 0, 0, 0); }
#define XB_TMO      128
#define XB_XCNT(j)  (256  + 64 * (j))
#define XB_XSUB(j)  (1280 + 64 * (j))
#define XB_XGEN(j)  (2304 + 64 * (j))
#define XB_TOP      3328
#define XB_TOPGEN   3392
#define XCD_BAR_WORDS 3456
#define XB_SPIN_CAP (1u << 18)

__device__ __forceinline__ unsigned xb_ld(unsigned* p)              { return __hip_atomic_load(p, __ATOMIC_RELAXED, __HIP_MEMORY_SCOPE_AGENT); }
__device__ __forceinline__ unsigned xb_add(unsigned* p, unsigned v) { return __hip_atomic_fetch_add(p, v, __ATOMIC_RELAXED, __HIP_MEMORY_SCOPE_AGENT); }
__device__ __forceinline__ unsigned xb_xcc_id() { return (unsigned)__builtin_amdgcn_s_getreg((3 << 11) | 20) & 0xFu; }
#define XB_SPIN(cond, bar) do { unsigned _sp = 0; while (cond) { __builtin_amdgcn_s_sleep(1); \
    if ((++_sp & 255u) == 0u) { if (xb_ld(&(bar)[XB_TMO])) break; if (_sp > XB_SPIN_CAP) { atomicAdd(&(bar)[XB_TMO], 1u); break; } } } } while (0)

struct XcdBarrier {
    unsigned* bar; unsigned x;
    volatile LAS unsigned* st;
};
__device__ __forceinline__ XcdBarrier xcd_barrier_post(unsigned* bar, volatile LAS unsigned* st) {
    XcdBarrier b; b.bar = bar; b.x = xb_xcc_id(); b.st = st;
    if (threadIdx.x == 0) (void)xb_add(&bar[XB_XCNT(b.x)], 1u);
    return b;
}
__device__ __forceinline__ void xcd_barrier_complete(unsigned* bar, unsigned x, unsigned& nloc, unsigned& nx) {
    const unsigned G = gridDim.x * gridDim.y * gridDim.z;
    unsigned sum, cnt, mine, sp = 0u;
    for (;;) {
        sum = 0u; cnt = 0u; mine = 0u;
#pragma unroll
        for (unsigned j = 0; j < 16; ++j) { const unsigned c = xb_ld(&bar[XB_XCNT(j)]); sum += c; cnt += (c > 0u) ? 1u : 0u; mine = (j == x) ? c : mine; }
        if (sum == G) break;
        __builtin_amdgcn_s_sleep(1);
        if ((++sp & 255u) == 0u) { if (xb_ld(&bar[XB_TMO])) break; if (sp > XB_SPIN_CAP) { atomicAdd(&bar[XB_TMO], 1u); break; } }
    }
    nloc = mine > 0u ? mine : 1u; nx = cnt > 0u ? cnt : 1u;
}
__device__ __forceinline__ void xcd_barrier(const XcdBarrier& b) {
    asm volatile("s_waitcnt vmcnt(0)" ::: "memory");
    __syncthreads();
    if (threadIdx.x == 0) {
        unsigned* bar = b.bar;
        __builtin_amdgcn_s_waitcnt(0);
        unsigned nloc = b.st[0], nx = b.st[1];
        if (nloc == 0u) { xcd_barrier_complete(bar, b.x, nloc, nx); b.st[0] = nloc; b.st[1] = nx; }
        const unsigned old = xb_add(&bar[XB_XSUB(b.x)], 1u);
        const unsigned gen = old / nloc;
        if (old + 1u == (gen + 1u) * nloc) {
            __builtin_amdgcn_fence(__ATOMIC_RELEASE, "agent");
            asm volatile("s_waitcnt vmcnt(0)" ::: "memory");
            const unsigned og = xb_add(&bar[XB_TOP], 1u);
            const unsigned tg = og / nx;
            if (og + 1u == (tg + 1u) * nx) xb_add(&bar[XB_TOPGEN], 1u);
            else XB_SPIN(xb_ld(&bar[XB_TOPGEN]) == tg, bar);
            __builtin_amdgcn_fence(__ATOMIC_ACQUIRE, "agent");
            xb_add(&bar[XB_XGEN(b.x)], 1u);
            asm volatile("s_waitcnt vmcnt(0)" ::: "memory");
        } else {
            XB_SPIN(xb_ld(&bar[XB_XGEN(b.x)]) == gen, bar);
            __builtin_amdgcn_fence(__ATOMIC_ACQUIRE, "agent");
            asm volatile("s_waitcnt vmcnt(0)" ::: "memory");
        }
    }
    __syncthreads();
}

namespace pg8 {
constexpr int BM = 256, BK = 64, HALF = 128, HTB = HALF * BK * 2, STAGE_BYTES = 8 * HTB, NXCD = 8, WGM = 8;
__host__ __device__ __forceinline__ int lds_byte(int r, int c) { const int st = (r >> 4) * 2 + (c >> 5), rr = r & 15, cc = c & 31, ob = rr * 64 + cc * 2; return st * 1024 + (ob ^ (((ob >> 9) & 1) << 5)); }
__host__ __device__ __forceinline__ void stage_rc(int b, int& R, int& C) { const int st = b / 1024, sb = b % 1024, swz = sb ^ (((sb >> 9) & 1) << 5); R = (st >> 1) * 16 + swz / 64; C = (st & 1) * 32 + (swz % 64) / 2; }
__host__ __device__ __forceinline__ int perm32(int rho) { const int n = rho >> 4, i = rho & 15; return 8 * (i >> 2) + 4 * n + (i & 3); }

struct Unit { int pm, pn, z; };
struct StaticOrder {
    const bf16_t* A; const bf16_t* Bt; int lda, ldb, K;
    int nM, nN, nwg, G, c, pm0;
    __device__ void init(const bf16_t* A_, const bf16_t* Bt_, int lda_, int ldb_, int K_, int M, int N, int G_, int c_, int pm0_ = 0) { A = A_; Bt = Bt_; lda = lda_; ldb = ldb_; K = K_; nM = M / BM; nN = N / BM; nwg = nM * nN; G = G_; c = c_; pm0 = pm0_; }
    __device__ bool next(int i, Unit& u) const {
        const long Lx = (long)i * G + c; if (Lx >= nwg) return false;
        int wgid = (int)Lx; { const int q = nwg / NXCD, r = nwg % NXCD, xcd = wgid % NXCD, off = wgid / NXCD; wgid = (xcd < r ? xcd * (q + 1) : r * (q + 1) + (xcd - r) * q) + off; }
        const int nig = WGM * nN, gid = wgid / nig, fm = gid * WGM, gsz = (nM - fm) < WGM ? (nM - fm) : WGM;
        u.pm = pm0 + fm + ((wgid % nig) % gsz); u.pn = (wgid % nig) / gsz; u.z = 0; return true;
    }
    __device__ __forceinline__ const char* a_base(const Unit& u) const { return (const char*)(A + (size_t)u.pm * BM * lda); }
    __device__ __forceinline__ const char* b_base(const Unit& u) const { return (const char*)(Bt + (size_t)u.pn * BM * ldb); }
};

template <class Epi, class Sched>
__device__ __forceinline__ void gemm_phase(LAS unsigned char* lds, const Sched& S, const Epi& E) {
    const int tid = threadIdx.x, wid = __builtin_amdgcn_readfirstlane(tid >> 6), lane = tid & 63, wr = wid >> 2, wc = wid & 3, fr = lane & 15, fq = lane >> 4;
    const int K = S.K, nt = K / BK, lda = S.lda, ldb = S.ldb;
    unsigned voffA[2], voffB[2];
#pragma unroll
    for (int i = 0; i < 2; ++i) { int R, C; stage_rc(tid * 16 + i * 8192, R, C); const int Rb = Epi::PERM ? ((R & ~31) + perm32(R & 31)) : R;
        voffA[i] = (unsigned)(R * lda + C) * 2u; voffB[i] = (unsigned)(Rb * ldb + C) * 2u; }
    const size_t kstep = (size_t)(BK * 2);
    const size_t hstepA = (size_t)HALF * lda * 2, hstepB = (size_t)HALF * ldb * 2;
    const unsigned ldsw = (unsigned)wid * 1024u;
    const int aoff = lds_byte(wr * 64 + fr, fq * 8), boff = lds_byte(wc * 32 + fr, fq * 8);
#define PG8_SA(b, h) (((b) * 2 + (h)) * HTB)
#define PG8_SB(b, h) ((4 + (b) * 2 + (h)) * HTB)
#define PG8_STAGE(bufoff, gbase, voff) do { _Pragma("unroll") for (int _i = 0; _i < 2; ++_i) \
        __builtin_amdgcn_global_load_lds((const unsigned*)((const char*)(gbase) + (voff)[_i]), (LAS unsigned*)(lds + (bufoff) + ldsw + _i * 8192), 16, 0, 0); } while (0)
#define PG8_LDA(dst, b, h) do { _Pragma("unroll") for (int m = 0; m < 4; ++m) _Pragma("unroll") for (int k = 0; k < 2; ++k) dst[m][k] = *(const LAS bf16x8*)(lds + PG8_SA(b, h) + aoff + m * 2048 + k * 1024); } while (0)
#define PG8_LDB(dst, b, h) do { _Pragma("unroll") for (int n = 0; n < 2; ++n) _Pragma("unroll") for (int k = 0; k < 2; ++k) dst[n][k] = *(const LAS bf16x8*)(lds + PG8_SB(b, h) + boff + n * 2048 + k * 1024); } while (0)
#define PG8_MMA(ai, bj, At, Bt) do { __builtin_amdgcn_s_setprio(1); _Pragma("unroll") for (int m = 0; m < 4; ++m) _Pragma("unroll") for (int n = 0; n < 2; ++n) _Pragma("unroll") for (int k = 0; k < 2; ++k) \
        acc[ai][bj][m][n] = __builtin_amdgcn_mfma_f32_16x16x32_bf16(Bt[n][k], At[m][k], acc[ai][bj][m][n], 0, 0, 0); __builtin_amdgcn_s_setprio(0); } while (0)
#define PG8_WAIT_V(n) asm volatile("s_waitcnt vmcnt(" #n ")" ::: "memory")
#define PG8_WAIT_L(n) asm volatile("s_waitcnt lgkmcnt(" #n ")" ::: "memory")
#define PG8_BAR __builtin_amdgcn_s_barrier()
#define PG8_SCHED __builtin_amdgcn_sched_barrier(0)
    Unit cur, nxt; int ui = 0;
    if (!S.next(0, cur)) return;
    f32x4 acc[2][2][4][2];
#pragma unroll
    for (int a = 0; a < 2; ++a)
#pragma unroll
        for (int b = 0; b < 2; ++b)
#pragma unroll
            for (int m = 0; m < 4; ++m)
#pragma unroll
                for (int n = 0; n < 2; ++n) acc[a][b][m][n] = (f32x4){0.f, 0.f, 0.f, 0.f};
    bf16x8 At[4][2], B0[2][2], B1[2][2];
    const char* cA = S.a_base(cur); const char* cB = S.b_base(cur);
    PG8_STAGE(PG8_SB(0, 0), cB, voffB); PG8_STAGE(PG8_SA(0, 0), cA, voffA); PG8_STAGE(PG8_SB(0, 1), cB + hstepB, voffB); PG8_STAGE(PG8_SA(0, 1), cA + hstepA, voffA);
    if (wr == 1) PG8_BAR;
    PG8_WAIT_V(4); PG8_BAR;
    PG8_STAGE(PG8_SB(1, 0), cB + kstep, voffB); PG8_STAGE(PG8_SA(1, 0), cA + kstep, voffA); PG8_STAGE(PG8_SB(1, 1), cB + hstepB + kstep, voffB);
    PG8_WAIT_V(6); PG8_BAR;
    for (;;) {
        const bool has_next = S.next(ui + 1, nxt);
        const char* nA = has_next ? S.a_base(nxt) : cA; const char* nB = has_next ? S.b_base(nxt) : cB;
        for (int t = 0; t < nt; t += 2) {
            if constexpr (Epi::MIDK) { if (t == (nt >> 1)) E.midk(acc, cur, wr, fr); }
            const bool last = (t == nt - 2);
            const char* a1 = cA + (size_t)(t + 1) * kstep;
            const char* a2 = last ? nA : cA + (size_t)(t + 2) * kstep; const char* b2 = last ? nB : cB + (size_t)(t + 2) * kstep;
            const char* a3 = a2 + kstep; const char* b3 = b2 + kstep;
            PG8_LDB(B0, 0, 0); PG8_SCHED; PG8_LDA(At, 0, 0); PG8_STAGE(PG8_SA(1, 1), a1 + hstepA, voffA);
            PG8_WAIT_L(8); PG8_BAR; PG8_WAIT_L(0); PG8_MMA(0, 0, At, B0); PG8_BAR; PG8_SCHED;
            PG8_LDB(B1, 0, 1); PG8_STAGE(PG8_SB(0, 0), b2, voffB);
            PG8_BAR; PG8_WAIT_L(0); PG8_MMA(0, 1, At, B1); PG8_BAR;
            PG8_LDA(At, 0, 1); PG8_STAGE(PG8_SA(0, 0), a2, voffA);
            PG8_BAR; PG8_WAIT_L(0); PG8_MMA(1, 0, At, B0); PG8_BAR; PG8_SCHED;
            PG8_STAGE(PG8_SB(0, 1), b2 + hstepB, voffB);
            PG8_WAIT_V(6); PG8_BAR; PG8_MMA(1, 1, At, B1); PG8_BAR;
            PG8_LDB(B0, 1, 0); PG8_SCHED; PG8_LDA(At, 1, 0); PG8_STAGE(PG8_SA(0, 1), a2 + hstepA, voffA);
            PG8_WAIT_L(8); PG8_BAR; PG8_WAIT_L(0); PG8_MMA(0, 0, At, B0); PG8_BAR; PG8_SCHED;
            PG8_LDB(B1, 1, 1); PG8_STAGE(PG8_SB(1, 0), b3, voffB);
            PG8_BAR; PG8_WAIT_L(0); PG8_MMA(0, 1, At, B1); PG8_BAR;
            PG8_LDA(At, 1, 1); PG8_STAGE(PG8_SA(1, 0), a3, voffA);
            PG8_BAR; PG8_WAIT_L(0); PG8_MMA(1, 0, At, B0); PG8_BAR; PG8_SCHED;
            PG8_STAGE(PG8_SB(1, 1), b3 + hstepB, voffB);
            PG8_WAIT_V(6); PG8_BAR; PG8_MMA(1, 1, At, B1); PG8_BAR;
        }
        E(acc, cur, wr, wc, fr, fq);
        if (!has_next) break;
#pragma unroll
        for (int a = 0; a < 2; ++a)
#pragma unroll
            for (int b = 0; b < 2; ++b)
#pragma unroll
                for (int m = 0; m < 4; ++m)
#pragma unroll
                    for (int n = 0; n < 2; ++n) acc[a][b][m][n] = (f32x4){0.f, 0.f, 0.f, 0.f};
        cur = nxt; cA = nA; cB = nB; ++ui;
    }
    PG8_WAIT_V(0);
    if (wr == 0) PG8_BAR;
    PG8_BAR;
#undef PG8_SA
#undef PG8_SB
#undef PG8_STAGE
#undef PG8_LDA
#undef PG8_LDB
#undef PG8_MMA
#undef PG8_WAIT_V
#undef PG8_WAIT_L
#undef PG8_BAR
#undef PG8_SCHED
}
}
using pg8::Unit;
__device__ __forceinline__ u32x4 pack8(const f32x4& v0, const f32x4& v1) {
    u32x4 o; o[0] = cvt_pk_bf16(v0[0], v0[1]); o[1] = cvt_pk_bf16(v0[2], v0[3]); o[2] = cvt_pk_bf16(v1[0], v1[1]); o[3] = cvt_pk_bf16(v1[2], v1[3]); return o;
}
struct EpiWin {
    static constexpr bool PERM = true; static constexpr bool MIDK = false;
    bf16_t* US; bf16_t* Q; bf16_t* KROW; bf16_t* VROW; bf16_t* VT; float* GATE;
    __device__ __forceinline__ void operator()(const f32x4 (&acc)[2][2][4][2], const Unit& u, int wr, int wc, int fr, int fq) const {
        const int row0 = u.pm * 256 + wr * 64 + fr; const int pn = u.pn;
#pragma unroll
        for (int ai = 0; ai < 2; ++ai)
#pragma unroll
            for (int m = 0; m < 4; ++m) {
                const int row = row0 + ai * 128 + m * 16;
#pragma unroll
                for (int bj = 0; bj < 2; ++bj) {
                    const f32x4 v0 = acc[ai][bj][m][0], v1 = acc[ai][bj][m][1];
                    const int cin = bj * 128 + wc * 32 + 8 * fq;
                    if (pn < 4) { *(u32x4*)(US + (size_t)row * 1024 + pn * 256 + cin) = pack8(v0, v1); }
                    else if (pn < 8) { *(u32x4*)(Q + (size_t)row * 1024 + (pn - 4) * 256 + cin) = pack8(v0 * QSCALE, v1 * QSCALE); }
                    else if (pn < 14) {
                        const int kvi = pn - 8, branch = kvi >> 1, kvsel = kvi & 1, g = bj, d0 = wc * 32 + 8 * fq;
                        if (kvsel == 0) { *(u32x4*)(KROW + ((size_t)(branch * 2 + g) * L_ + row) * 128 + d0) = pack8(v0, v1); }
                        else if (branch == 0) { *(u32x4*)(VROW + ((size_t)g * L_ + row) * 128 + d0) = pack8(v0, v1); }
                        else {
                            const int prow = ((row & ~12) | ((row & 4) << 1) | ((row & 8) >> 1));
                            bf16_t* vt = VT + ((size_t)((branch - 1) * 2 + g) * 128 + d0) * L_ + prow;
#pragma unroll
                            for (int e = 0; e < 4; ++e) { vt[(size_t)e * L_] = f2bf(v0[e]); vt[(size_t)(e + 4) * L_] = f2bf(v1[e]); }
                        }
                    } else {
                        if (cin < 24) {
                            float* gp = GATE + (size_t)row * 24 + cin;
                            f32x4 s0, s1;
#pragma unroll
                            for (int e = 0; e < 4; ++e) { s0[e] = sigmoidf_(v0[e]); s1[e] = sigmoidf_(v1[e]); }
                            *(f32x4*)gp = s0; *(f32x4*)(gp + 4) = s1;
                        }
                    }
                }
            }
    }
};
struct EpiGlu {
    static constexpr bool PERM = true; static constexpr bool MIDK = false;
    const bf16_t* Z; const float* bglu; bf16_t* Y; float* stsp;
    __device__ __forceinline__ void operator()(const f32x4 (&acc)[2][2][4][2], const Unit& u, int wr, int wc, int fr, int fq) const {
        const int row0 = u.pm * 256 + wr * 64 + fr;
        float ss[2][4];
#pragma unroll
        for (int ai = 0; ai < 2; ++ai)
#pragma unroll
            for (int m = 0; m < 4; ++m) ss[ai][m] = 0.f;
#pragma unroll
        for (int bj = 0; bj < 2; ++bj) {
            const int col = u.pn * 256 + bj * 128 + wc * 32 + 8 * fq;
            const f32x4 b0 = *(const f32x4*)(bglu + col), b1 = *(const f32x4*)(bglu + col + 4);
#pragma unroll
            for (int ai = 0; ai < 2; ++ai)
#pragma unroll
                for (int m = 0; m < 4; ++m) {
                    const int row = row0 + ai * 128 + m * 16;
                    const u32x4 zz = *(const u32x4*)(Z + (size_t)row * 1024 + col);
                    const f32x4 v0 = acc[ai][bj][m][0] + b0, v1 = acc[ai][bj][m][1] + b1;
                    f32x4 o0, o1;
                    o0[0] = bflo(zz[0]) * sigmoidf_(v0[0]); o0[1] = bfhi(zz[0]) * sigmoidf_(v0[1]); o0[2] = bflo(zz[1]) * sigmoidf_(v0[2]); o0[3] = bfhi(zz[1]) * sigmoidf_(v0[3]);
                    o1[0] = bflo(zz[2]) * sigmoidf_(v1[0]); o1[1] = bfhi(zz[2]) * sigmoidf_(v1[1]); o1[2] = bflo(zz[3]) * sigmoidf_(v1[2]); o1[3] = bfhi(zz[3]) * sigmoidf_(v1[3]);
                    *(u32x4*)(Y + (size_t)row * 2048 + col) = pack8(o0, o1);
                    ss[ai][m] += (o0[0] * o0[0] + o0[1] * o0[1]) + (o0[2] * o0[2] + o0[3] * o0[3]) + (o1[0] * o1[0] + o1[1] * o1[1]) + (o1[2] * o1[2] + o1[3] * o1[3]);
                }
        }
#pragma unroll
        for (int ai = 0; ai < 2; ++ai)
#pragma unroll
            for (int m = 0; m < 4; ++m) {
                float s = ss[ai][m];
                s += __shfl_xor(s, 16); s += __shfl_xor(s, 32);
                if (fq == 0) stsp[(size_t)(row0 + ai * 128 + m * 16) * 16 + u.pn * 4 + wc] = s;
            }
    }
};
struct EpiWout {
    static constexpr bool PERM = true; static constexpr bool MIDK = true;
    const float* X; const float* g1; const float* f2; bf16_t* X1; bf16_t* A2; float* st2p; const float* rsa;
    __device__ __forceinline__ void midk(f32x4 (&acc)[2][2][4][2], const Unit& u, int, int) const {
        int tz = threadIdx.x; asm volatile("" : "+v"(tz));
        const int row0 = u.pm * 256 + ((tz >> 8) & 1) * 64 + (tz & 15);
#pragma unroll
        for (int ai = 0; ai < 2; ++ai)
#pragma unroll
            for (int m = 0; m < 4; ++m) {
                const float r = rsa[(size_t)(row0 + ai * 128 + m * 16) * 2];
#pragma unroll
                for (int bj = 0; bj < 2; ++bj)
#pragma unroll
                    for (int n = 0; n < 2; ++n) acc[ai][bj][m][n] *= r;
            }
    }
    __device__ __forceinline__ void operator()(const f32x4 (&acc)[2][2][4][2], const Unit& u, int, int, int, int) const {
        int tz = threadIdx.x; asm volatile("" : "+v"(tz));
        const int wr = (tz >> 8) & 1, wc = (tz >> 6) & 3, fr = tz & 15, fq = (tz >> 4) & 3;
        const int row0 = u.pm * 256 + wr * 64 + fr, col0 = u.pn * 256 + wc * 32 + 8 * fq;
        float ss[2][4], ra[2][4];
#pragma unroll
        for (int ai = 0; ai < 2; ++ai)
#pragma unroll
            for (int m = 0; m < 4; ++m) { ss[ai][m] = 0.f; ra[ai][m] = rsa[(size_t)(row0 + ai * 128 + m * 16) * 2 + 1]; }
#pragma unroll
        for (int bj = 0; bj < 2; ++bj) {
            const int col = col0 + bj * 128;
            const f32x4 g0 = *(const f32x4*)(g1 + col), g4 = *(const f32x4*)(g1 + col + 4), f0 = *(const f32x4*)(f2 + col), f4 = *(const f32x4*)(f2 + col + 4);
#pragma unroll
            for (int ai = 0; ai < 2; ++ai)
#pragma unroll
                for (int m = 0; m < 4; ++m) {
                    const size_t off = (size_t)(row0 + ai * 128 + m * 16) * 2048 + col;
                    const f32x4 x0 = *(const f32x4*)(X + off), x4 = *(const f32x4*)(X + off + 4);
                    const f32x4 v0 = x0 + g0 * (acc[ai][bj][m][0] * ra[ai][m]), v1 = x4 + g4 * (acc[ai][bj][m][1] * ra[ai][m]);
                    *(u32x4*)(X1 + off) = pack8(v0, v1);
                    *(u32x4*)(A2 + off) = pack8(v0 * f0, v1 * f4);
                    ss[ai][m] += (v0[0] * v0[0] + v0[1] * v0[1]) + (v0[2] * v0[2] + v0[3] * v0[3]) + (v1[0] * v1[0] + v1[1] * v1[1]) + (v1[2] * v1[2] + v1[3] * v1[3]);
                }
        }
#pragma unroll
        for (int ai = 0; ai < 2; ++ai)
#pragma unroll
            for (int m = 0; m < 4; ++m) {
                float s = ss[ai][m];
                s += __shfl_xor(s, 16); s += __shfl_xor(s, 32);
                if (fq == 0) st2p[(size_t)(row0 + ai * 128 + m * 16) * 32 + u.pn * 4 + wc] = s;
            }
    }
};
struct EpiQ {
    static constexpr bool PERM = true; static constexpr bool MIDK = false;
    bf16_t* O; const float* rstd2; const float* cq;
    __device__ __forceinline__ void operator()(const f32x4 (&acc)[2][2][4][2], const Unit& u, int wr, int wc, int fr, int fq) const {
        const int row0 = u.pm * 256 + wr * 64 + fr, col0 = u.pn * 256 + wc * 32 + 8 * fq;
        float rs[2][4];
#pragma unroll
        for (int ai = 0; ai < 2; ++ai)
#pragma unroll
            for (int m = 0; m < 4; ++m) rs[ai][m] = rstd2[row0 + ai * 128 + m * 16];
#pragma unroll
        for (int bj = 0; bj < 2; ++bj) {
            const int col = col0 + bj * 128;
            const f32x4 c0 = *(const f32x4*)(cq + col), c4 = *(const f32x4*)(cq + col + 4);
#pragma unroll
            for (int ai = 0; ai < 2; ++ai)
#pragma unroll
                for (int m = 0; m < 4; ++m)
                    *(u32x4*)(O + (size_t)(row0 + ai * 128 + m * 16) * 2048 + col) = pack8(acc[ai][bj][m][0] * rs[ai][m] + c0, acc[ai][bj][m][1] * rs[ai][m] + c4);
        }
    }
};
template <class Sched>
__device__ __forceinline__ void rstd2_prepass(const Sched& S, const float* st2p, float* rstd2, int tid) {
    Unit u;
    for (int i = 0; S.next(i, u); ++i)
        if (tid < 256) {
            const int row = u.pm * 256 + tid; const f32x4* p = (const f32x4*)(st2p + (size_t)row * 32);
            float s = 0.f;
#pragma unroll
            for (int k = 0; k < 8; ++k) { const f32x4 v = p[k]; s += (v[0] + v[1]) + (v[2] + v[3]); }
            rstd2[row] = rsqrtf(s * (1.f / 2048.f) + 1e-6f);
        }
    __syncthreads();
}
struct EpiSlab {
    static constexpr bool PERM = false; static constexpr bool MIDK = false;
    float* SL;
    __device__ __forceinline__ void operator()(const f32x4 (&acc)[2][2][4][2], const Unit& u, int wr, int wc, int fr, int fq) const {
        float* base = SL + (size_t)u.z * 2048 * 256;
        const int row0 = u.pm * 256 + wr * 64 + fr, col0 = wc * 32 + 4 * fq;
#pragma unroll
        for (int ai = 0; ai < 2; ++ai)
#pragma unroll
            for (int m = 0; m < 4; ++m)
#pragma unroll
                for (int bj = 0; bj < 2; ++bj)
#pragma unroll
                    for (int n = 0; n < 2; ++n)
                        *(f32x4*)(base + (size_t)(row0 + ai * 128 + m * 16) * 256 + col0 + bj * 128 + n * 16) = acc[ai][bj][m][n];
    }
};
struct CmpOrder {
    const bf16_t* KROW; const bf16_t* VROW; const bf16_t* W1; int lda, ldb, K; int G, c;
    __device__ bool next(int i, Unit& u) const {
        const int x = i * G + c; if (x >= 256) return false;
        const int kvsel = x >> 7, pm = (x & 127) >> 4, ks = x & 15; u.pm = pm; u.pn = 0; u.z = kvsel * 16 + ks; return true;
    }
    __device__ __forceinline__ const char* a_base(const Unit& u) const { return (const char*)(((u.z >> 4) ? VROW : KROW) + (size_t)u.pm * 256 * 2048 + (u.z & 15) * 256); }
    __device__ __forceinline__ const char* b_base(const Unit& u) const { return (const char*)(W1 + (size_t)(u.z >> 4) * 256 * 4096 + (u.z & 15) * 256); }
};
template <class Sched>
__device__ __forceinline__ void rsa_prepass(const Sched& S, const float* stsp, const float* stap, float* rsa, int tid) {
    Unit u;
    for (int i = 0; S.next(i, u); ++i)
        if (tid < 256) {
            const int row = u.pm * 256 + tid; const f32x4* p = (const f32x4*)(stsp + (size_t)row * 16);
            float s = 0.f;
#pragma unroll
            for (int k = 0; k < 4; ++k) { const f32x4 v = p[k]; s += (v[0] + v[1]) + (v[2] + v[3]); }
            const f32x2 q = *(const f32x2*)(stap + (size_t)row * 2);
            const float rs = rsqrtf(s * (1.f / 1024.f) + 1e-6f), ra = rsqrtf((q[0] + q[1]) * (1.f / 1024.f) + 1e-6f);
            f32x2 o; o[0] = rs / ra; o[1] = ra;
            *(f32x2*)(rsa + (size_t)row * 2) = o;
        }
    __syncthreads();
}
struct Ctx { int bid, nb, tid, wave, lane; LAS unsigned char* lds; };

__device__ __forceinline__ void p0_cond(const Args& a, const Ctx& c) {
    const float* cv = a.in[1]; const float* w = a.in[2]; float* condp = (float*)(a.ws + WS_CONDP);
    for (int u = c.bid * 8 + c.wave; u < 1536; u += c.nb * 8) {
        const int cc = u % 48, kc = u / 48;
        const float* wp = w + (size_t)(kc * 64) * NADA + cc * 256 + c.lane * 4;
        f32x4 acc = {0.f, 0.f, 0.f, 0.f};
#pragma unroll 16
        for (int k = 0; k < 64; ++k) { const float x = cv[kc * 64 + k]; const float s = x / (1.f + __expf(-x)); acc += s * *(const f32x4*)(wp + (size_t)k * NADA); }
        *(f32x4*)(condp + (size_t)kc * NADA + cc * 256 + c.lane * 4) = acc;
    }
}
struct TDesc { const float* src; bf16_t* dst; const float* ks0; const float* ks1; int K, N, nkt, nt, kt; };
__device__ __forceinline__ TDesc conv_decode(const Args& a, int tix) {
    TDesc d; d.ks0 = nullptr; d.ks1 = nullptr; int local;
    if (tix < 1920) { local = tix; d.src = a.in[6]; d.dst = (bf16_t*)(a.ws + WS_WIN); d.K = 2048; d.N = DIN; }
    else if (tix < 2176) { local = tix - 1920; d.src = a.in[18]; d.dst = (bf16_t*)(a.ws + WS_WGLU); d.K = 1024; d.N = 1024; }
    else if (tix < 3200) { local = tix - 2176; d.src = a.in[7]; d.dst = (bf16_t*)(a.ws + WS_WOUT); d.K = 2048; d.N = 2048; d.ks0 = a.in[8]; d.ks1 = a.in[9]; }
    else if (tix < 4224) { local = tix - 3200; d.src = a.in[27]; d.dst = (bf16_t*)(a.ws + WS_WQ); d.K = 2048; d.N = 2048; }
    else if (tix < 4480) { local = tix - 4224; d.src = a.in[21]; d.dst = (bf16_t*)(a.ws + WS_W1); d.K = 4096; d.N = 256; }
    else if (tix < 4736) { local = tix - 4480; d.src = a.in[24]; d.dst = (bf16_t*)(a.ws + WS_W1) + 256 * 4096; d.K = 4096; d.N = 256; }
    else if (tix < 4744) { local = tix - 4736; d.src = a.in[22]; d.dst = (bf16_t*)(a.ws + WS_W2); d.K = 256; d.N = 128; }
    else { local = tix - 4744; d.src = a.in[25]; d.dst = (bf16_t*)(a.ws + WS_W2) + 128 * 256; d.K = 256; d.N = 128; }
    d.nkt = d.K / 64; d.nt = local / d.nkt; d.kt = local % d.nkt;
    return d;
}
constexpr int CONV_TILES = 4752;
__device__ __forceinline__ void conv_T_all(const Args& a, const Ctx& c) {
    LAS float* tile = (LAS float*)c.lds;
    const int r = c.tid >> 4, c4 = c.tid & 15;
    f32x4 b0[2], b1[2], b2[2]; float s0[2] = {1.f, 1.f}, s1[2] = {1.f, 1.f}, s2[2] = {1.f, 1.f};
#define CONVT_LD(buf, sc, tix_) do { if ((tix_) < CONV_TILES) { const TDesc d_ = conv_decode(a, (tix_)); const int n_ = d_.nt * 64 + 4 * c4; \
        _Pragma("unroll") for (int i = 0; i < 2; ++i) { const int k_ = d_.kt * 64 + r + 32 * i; buf[i] = (f32x4){0.f, 0.f, 0.f, 0.f}; if (n_ < d_.N) buf[i] = *(const f32x4*)(d_.src + (size_t)k_ * d_.N + n_); \
            sc[i] = 1.f; if (d_.ks0) sc[i] = k_ < 1024 ? d_.ks0[k_] : d_.ks1[k_ - 1024]; } } } while (0)
#define CONVT_DO(buf, sc, tix_) do { if ((tix_) < CONV_TILES) { const TDesc d_ = conv_decode(a, (tix_)); \
        _Pragma("unroll") for (int i = 0; i < 2; ++i) { LAS float* tp = tile + (r + 32 * i) * 65 + 4 * c4; tp[0] = buf[i][0] * sc[i]; tp[1] = buf[i][1] * sc[i]; tp[2] = buf[i][2] * sc[i]; tp[3] = buf[i][3] * sc[i]; } \
        __syncthreads(); \
        { const int n = c.tid >> 3, kq = c.tid & 7; float w[8]; \
          _Pragma("unroll") for (int j = 0; j < 8; ++j) w[j] = tile[(kq * 8 + j) * 65 + n]; \
          u32x4 o; o[0] = cvt_pk_bf16(w[0], w[1]); o[1] = cvt_pk_bf16(w[2], w[3]); o[2] = cvt_pk_bf16(w[4], w[5]); o[3] = cvt_pk_bf16(w[6], w[7]); \
          *(u32x4*)(d_.dst + (size_t)(d_.nt * 64 + n) * d_.K + d_.kt * 64 + kq * 8) = o; } \
        __syncthreads(); } } while (0)
    int tix = c.bid;
    CONVT_LD(b0, s0, tix); CONVT_LD(b1, s1, tix + c.nb);
    for (; tix < CONV_TILES; tix += 3 * c.nb) {
        CONVT_LD(b2, s2, tix + 2 * c.nb); CONVT_DO(b0, s0, tix);
        CONVT_LD(b0, s0, tix + 3 * c.nb); CONVT_DO(b1, s1, tix + c.nb);
        CONVT_LD(b1, s1, tix + 4 * c.nb); CONVT_DO(b2, s2, tix + 2 * c.nb);
    }
#undef CONVT_LD
#undef CONVT_DO
}
__device__ __forceinline__ void conv_fp4rows(const float* src, unsigned char* dst4, float* scl, int rows, const Ctx& c) {
    const int stride = c.nb * 8;
    f32x4 b0[8], b1[8], b2[8];
#define FP4R_LD(buf, r_) do { if ((r_) < rows) { _Pragma("unroll") for (int j = 0; j < 8; ++j) buf[j] = *(const f32x4*)(src + (size_t)(r_) * 2048 + 256 * j + c.lane * 4); } } while (0)
#define FP4R_DO(buf, r_) do { if ((r_) < rows) { \
        float mx = 0.f; \
        _Pragma("unroll") for (int j = 0; j < 8; ++j) mx = fmaxf(mx, fmaxf(fmaxf(fabsf(buf[j][0]), fabsf(buf[j][1])), fmaxf(fabsf(buf[j][2]), fabsf(buf[j][3])))); \
        mx = wave_max(mx); \
        const float s = mx > 0.f ? 6.f / mx : 1.f; \
        if (c.lane == 0) scl[(size_t)(r_) * 4] = mx > 0.f ? mx * (1.f / 6.f) : 1.f; \
        u32x4 pk = {0u, 0u, 0u, 0u}; \
        _Pragma("unroll") for (int d = 0; d < 4; ++d) {              \
            unsigned wq = 0u; \
            wq = fp4_pk<0>(wq, buf[2 * d][0] * s, buf[2 * d][1] * s); wq = fp4_pk<1>(wq, buf[2 * d][2] * s, buf[2 * d][3] * s); \
            wq = fp4_pk<2>(wq, buf[2 * d + 1][0] * s, buf[2 * d + 1][1] * s); wq = fp4_pk<3>(wq, buf[2 * d + 1][2] * s, buf[2 * d + 1][3] * s); \
            pk[d] = wq; } \
        *(u32x4*)(dst4 + (size_t)(r_) * 1024 + c.lane * 16) = pk; } } while (0)
    int row = c.bid * 8 + c.wave;
    FP4R_LD(b0, row); FP4R_LD(b1, row + stride);
    for (; row < rows; row += 3 * stride) {
        FP4R_LD(b2, row + 2 * stride); FP4R_DO(b0, row);
        FP4R_LD(b0, row + 3 * stride); FP4R_DO(b1, row + stride);
        FP4R_LD(b1, row + 4 * stride); FP4R_DO(b2, row + 2 * stride);
    }
#undef FP4R_LD
#undef FP4R_DO
}
__device__ __forceinline__ void conv_E(const float* src, bf16_t* dst, size_t n8, const Ctx& c) {
    const size_t stride = (size_t)c.nb * NTHREADS;
    for (size_t i = (size_t)c.bid * NTHREADS + c.tid; i < n8; i += stride) {
        const f32x4 x = *(const f32x4*)(src + i * 8), y = *(const f32x4*)(src + i * 8 + 4);
        *(u32x4*)(dst + i * 8) = pack8(x, y);
    }
}
__device__ __forceinline__ int t5_bucket(int n) {
    if (n < 16) return n;
    const float scaled = logf((float)n / 16.f) / logf(64.f);
    const int large = 16 + (int)(scaled * 16.f);
    return large < 31 ? large : 31;
}
__device__ __forceinline__ void p0_tb(const Args& a, const Ctx& c) {
    float* tb = (float*)(a.ws + WS_TB); const float* rb = a.in[26];
    for (int i = c.bid * NTHREADS + c.tid; i < 8 * TBN; i += c.nb * NTHREADS) { const int head = i / TBN, dist = i % TBN; tb[i] = rb[t5_bucket(dist) * 8 + head] * LOG2E; }
}
__device__ __forceinline__ void p0_bpe(const Args& a, const Ctx& c, int part) {
    const int n = c.tid & 255, kv = c.tid >> 8;
    const float* pe = a.in[kv ? 23 : 20]; const float* w1 = a.in[kv ? 24 : 21]; float* bpep = (float*)(a.ws + WS_BPEP);
    float s = 0.f;
#pragma unroll 16
    for (int k = part * 128; k < part * 128 + 128; ++k) s += pe[k] * w1[(size_t)k * 256 + n];
    bpep[(part * 2 + kv) * 256 + n] = s;
}
__device__ __forceinline__ void p0_s5(const Args& a, const Ctx& c, int g, int part) {
    LAS float* ar = (LAS float*)c.lds;
    LAS float* ai = ar + 17 * 64;
    LAS float* bbr = ai + 17 * 64;
    LAS float* bbi = bbr + 1024;
    LAS float* cr = bbi + 1024;
    LAS float* ci = cr + 1024;
    LAS float* kd = ci + 1024;
    const int tid = c.tid;
    if (tid < 64) {
        const int p = tid; const float dt = expf(a.in[12][g]); const float lr = a.in[10][g * 64 + p], li = a.in[11][g * 64 + p];
        for (int d = 0; d <= 16; ++d) { const float mag = expf(lr * dt * (float)d), ang = li * dt * (float)d; ar[d * 64 + p] = mag * cosf(ang); ai[d * 64 + p] = mag * sinf(ang); }
        const float nr = ar[64 + p] - 1.f, ni = ai[64 + p], den = lr * lr + li * li;
        const float wre = (nr * lr + ni * li) / den, wim = (ni * lr - nr * li) / den;
        for (int h = 0; h < 16; ++h) { const float br = a.in[13][(g * 64 + p) * 16 + h], bi = a.in[14][(g * 64 + p) * 16 + h]; bbr[p * 16 + h] = wre * br - wim * bi; bbi[p * 16 + h] = wre * bi + wim * br; }
        if (part == 0) {
        float* s5p = (float*)(a.ws + WS_S5P);
        float xr = ar[16 * 64 + p], xi = ai[16 * 64 + p];
        s5p[(g * 64 + p) * 2] = xr; s5p[(g * 64 + p) * 2 + 1] = xi;
        for (int s = 0; s < 8; ++s) { const float tr = xr * xr - xi * xi, ti = 2.f * xr * xi; xr = tr; xi = ti; }
        s5p[64 * 64 * 2 + (g * 64 + p) * 2] = xr; s5p[64 * 64 * 2 + (g * 64 + p) * 2 + 1] = xi;
        }
    }
    for (int e = tid; e < 1024; e += NTHREADS) { cr[e] = a.in[15][g * 1024 + e]; ci[e] = a.in[16][g * 1024 + e]; }
    __syncthreads();
    for (int e = tid; e < 1024 * (part + 1); e += NTHREADS) {
        const int d = e >> 8, h1 = (e >> 4) & 15, h = e & 15; float s = 0.f;
        for (int p = 0; p < 64; ++p) { const float Cr = cr[h1 * 64 + p], Ci = ci[h1 * 64 + p], Ar = ar[d * 64 + p], Ai = ai[d * 64 + p];
            const float Gr = Cr * Ar - Ci * Ai, Gi = Cr * Ai + Ci * Ar; s += Gr * bbr[p * 16 + h] - Gi * bbi[p * 16 + h]; }
        if (d == 0 && h1 == h) s += a.in[17][g * 16 + h];
        kd[e] = s;
    }
    __syncthreads();
    bf16_t* MT = (bf16_t*)(a.ws + WS_S5MT) + (size_t)g * 65536;
    bf16_t* WE = (bf16_t*)(a.ws + WS_S5WE) + (size_t)g * 32768;
    bf16_t* WC = (bf16_t*)(a.ws + WS_S5WC) + (size_t)g * 32768;
    for (int e = 16384 * part + tid; e < 16384 * (part + 1); e += NTHREADS) { const int n = e >> 8, k = e & 255, j = n >> 4, h1 = n & 15, i = k >> 4, h = k & 15;
        MT[e] = f2bf(i <= j ? kd[(j - i) * 256 + h1 * 16 + h] : 0.f); }
    for (int e = 8192 * part + tid; e < 8192 * (part + 1); e += NTHREADS) { const int n = e >> 8, k = e & 255, cc = n >> 6, p = n & 63, i = k >> 4, h = k & 15;
        const float Ar = ar[(15 - i) * 64 + p], Ai = ai[(15 - i) * 64 + p], Br = bbr[p * 16 + h], Bi = bbi[p * 16 + h];
        WE[e] = f2bf(cc ? (Ar * Bi + Ai * Br) : (Ar * Br - Ai * Bi)); }
    for (int e = 8192 * part + tid; e < 8192 * (part + 1); e += NTHREADS) { const int n = e >> 7, k = e & 127, j = n >> 4, h1 = n & 15, cc = k >> 6, p = k & 63;
        const float Cr = cr[h1 * 64 + p], Ci = ci[h1 * 64 + p], Ar = ar[(j + 1) * 64 + p], Ai = ai[(j + 1) * 64 + p];
        WC[e] = f2bf(cc ? -(Cr * Ai + Ci * Ar) : (Cr * Ar - Ci * Ai)); }
    __syncthreads();
}
__device__ __forceinline__ void p0_prologue(const Args& a, const Ctx& c) {
    for (int u = c.bid; u < 256; u += c.nb) p0_s5(a, c, u >> 2, u & 3);
    for (int u = 0; u < 32; ++u) if (c.bid == (8 * u + 7) % c.nb) p0_bpe(a, c, u);
    p0_tb(a, c);
    p0_cond(a, c);
    conv_T_all(a, c);
    conv_E(a.in[28], (bf16_t*)(a.ws + WS_PK), 128 * 128 / 8, c);
    conv_E(a.in[29], (bf16_t*)(a.ws + WS_PK) + 128 * 128, 128 * 128 / 8, c);
    conv_fp4rows(a.in[30], a.ws + WS_PU, (float*)(a.ws + WS_PSC), 16384, c);
}

__device__ __forceinline__ void norm_rows(const float* X, bf16_t* O, LAS const float* Ab, LAS const float* Bb, const Ctx& c, int row0 = 0, int nrows = L_) {
    for (int t = row0 + c.bid * 8 + c.wave; t < row0 + nrows; t += c.nb * 8) {
        const float* xr = X + (size_t)t * 2048 + c.lane * 4;
        f32x4 v[8]; float ss = 0.f;
#pragma unroll
        for (int j = 0; j < 8; ++j) { v[j] = *(const f32x4*)(xr + j * 256); ss += v[j][0] * v[j][0] + v[j][1] * v[j][1] + v[j][2] * v[j][2] + v[j][3] * v[j][3]; }
        ss = wave_sum(ss);
        const float rstd = rsqrtf(ss * (1.f / 2048.f) + 1e-6f);
#pragma unroll
        for (int j = 0; j < 8; ++j) {
            const int col = j * 256 + c.lane * 4;
            const f32x4 A = *(const LAS f32x4*)(Ab + col), B = *(const LAS f32x4*)(Bb + col);
            const f32x4 o = v[j] * rstd * A + B;
            u32x2 w; w[0] = cvt_pk_bf16(o[0], o[1]); w[1] = cvt_pk_bf16(o[2], o[3]);
            *(u32x2*)(O + (size_t)t * 2048 + col) = w;
        }
    }
}
__device__ __forceinline__ void norm_rows_bf16(const bf16_t* X, bf16_t* O, LAS const float* Ab, LAS const float* Bb, const Ctx& c, int row0, int nrows) {
    for (int t = row0 + c.bid * 8 + c.wave; t < row0 + nrows; t += c.nb * 8) {
        const bf16_t* xr = X + (size_t)t * 2048 + c.lane * 8;
        u32x4 w[4]; float ss = 0.f;
#pragma unroll
        for (int j = 0; j < 4; ++j) { w[j] = *(const u32x4*)(xr + j * 512);
#pragma unroll
            for (int e = 0; e < 4; ++e) { const float a0 = bflo(w[j][e]), a1 = bfhi(w[j][e]); ss += a0 * a0 + a1 * a1; } }
        ss = wave_sum(ss);
        const float rstd = rsqrtf(ss * (1.f / 2048.f) + 1e-6f);
#pragma unroll
        for (int j = 0; j < 4; ++j) {
            const int col = j * 512 + c.lane * 8;
            const f32x4 A0 = *(const LAS f32x4*)(Ab + col), A1 = *(const LAS f32x4*)(Ab + col + 4), B0 = *(const LAS f32x4*)(Bb + col), B1 = *(const LAS f32x4*)(Bb + col + 4);
            f32x4 o0, o1;
#pragma unroll
            for (int e = 0; e < 2; ++e) { o0[2 * e] = bflo(w[j][e]) * rstd * A0[2 * e] + B0[2 * e]; o0[2 * e + 1] = bfhi(w[j][e]) * rstd * A0[2 * e + 1] + B0[2 * e + 1];
                o1[2 * e] = bflo(w[j][2 + e]) * rstd * A1[2 * e] + B1[2 * e]; o1[2 * e + 1] = bfhi(w[j][2 + e]) * rstd * A1[2 * e + 1] + B1[2 * e + 1]; }
            *(u32x4*)(O + (size_t)t * 2048 + col) = pack8(o0, o1);
        }
    }
}
__device__ __forceinline__ float cond_from_partials(const float* condp, const float* b_ada, int j) {
    float s = b_ada[j];
#pragma unroll 8
    for (int k = 0; k < 32; ++k) s += condp[(size_t)k * NADA + j];
    return s;
}
__device__ __forceinline__ void p1_hnorm(const Args& a, const Ctx& c) {
    const float* condp = (const float*)(a.ws + WS_CONDP); float* cond = (float*)(a.ws + WS_COND);
    for (int j = c.bid * NTHREADS + c.tid; j < NADA; j += c.nb * NTHREADS) cond[j] = cond_from_partials(condp, a.in[3], j);
    { float* F2 = (float*)(a.ws + WS_F2);
      for (int j = c.bid * NTHREADS + c.tid; j < 2048; j += c.nb * NTHREADS) F2[j] = a.in[5][j] * (1.f + cond_from_partials(condp, a.in[3], 4 * 2048 + j)); }
    LAS float* Ab = (LAS float*)c.lds; LAS float* Bb = Ab + 2048;
    for (int col = c.tid; col < 2048; col += NTHREADS) {
        Ab[col] = a.in[4][col] * (1.f + cond_from_partials(condp, a.in[3], 2048 + col)); Bb[col] = cond_from_partials(condp, a.in[3], col); }
    __syncthreads();
    norm_rows(a.in[0], (bf16_t*)(a.ws + WS_H), Ab, Bb, c);
}
__device__ __forceinline__ void p_cqce(const Args& a, const Ctx& c) {
    const float* sh2 = (const float*)(a.ws + WS_COND) + 3 * 2048;
    float s[32];
#pragma unroll
    for (int k = 0; k < 8; ++k) { const f32x4 v = *(const f32x4*)(sh2 + 256 * k + c.lane * 4); s[4 * k] = v[0]; s[4 * k + 1] = v[1]; s[4 * k + 2] = v[2]; s[4 * k + 3] = v[3]; }
    const bf16_t* WQ = (const bf16_t*)(a.ws + WS_WQ); float* cq = (float*)(a.ws + WS_CQ);
    for (int n = c.bid * 8 + c.wave; n < 2048; n += c.nb * 8) {
        u32x2 w[8];
#pragma unroll
        for (int k = 0; k < 8; ++k) w[k] = *(const u32x2*)(WQ + (size_t)n * 2048 + 256 * k + c.lane * 4);
        float d = 0.f;
#pragma unroll
        for (int k = 0; k < 8; ++k) d += (bflo(w[k][0]) * s[4 * k] + bfhi(w[k][0]) * s[4 * k + 1]) + (bflo(w[k][1]) * s[4 * k + 2] + bfhi(w[k][1]) * s[4 * k + 3]);
        d = wave_sum(d);
        if (c.lane == 0) cq[n] = d;
    }
    const unsigned char* PU = a.ws + WS_PU; float* psc = (float*)(a.ws + WS_PSC);
    for (int e0 = (c.bid * 8 + c.wave) * 4; e0 < 16384; e0 += c.nb * 8 * 4) {
        u32x4 uw[4];
#pragma unroll
        for (int i = 0; i < 4; ++i) uw[i] = *(const u32x4*)(PU + (size_t)(e0 + i) * 1024 + c.lane * 16);
#pragma unroll
        for (int i = 0; i < 4; ++i) {
            float d0 = 0.f, d1 = 0.f;
#pragma unroll
            for (int dw = 0; dw < 4; ++dw) { const f32x2 f0 = fp4_unpk<0>(uw[i][dw]), f1 = fp4_unpk<1>(uw[i][dw]), f2 = fp4_unpk<2>(uw[i][dw]), f3 = fp4_unpk<3>(uw[i][dw]);
                d0 += f0[0] * s[8 * dw] + f1[0] * s[8 * dw + 2] + f2[0] * s[8 * dw + 4] + f3[0] * s[8 * dw + 6];
                d1 += f0[1] * s[8 * dw + 1] + f1[1] * s[8 * dw + 3] + f2[1] * s[8 * dw + 5] + f3[1] * s[8 * dw + 7]; }
            const float d = wave_sum(d0 + d1);
            if (c.lane == 0) psc[(size_t)(e0 + i) * 4 + 1] = psc[(size_t)(e0 + i) * 4] * d;
        }
    }
}
constexpr int S5_US = 0, S5_ES = 33792, S5_SS = 67584, S5_TS = 84992;
template <int PASS>
__device__ __forceinline__ void s5_item(const Args& a, const Ctx& c, int g, int seg) {
    LAS unsigned char* lds = c.lds;
    int tid = c.tid; asm volatile("" : "+v"(tid));
    const int wave = c.wave, lane = tid & 63, r = lane & 15, q = lane >> 4;
    const bf16_t* U = (const bf16_t*)(a.ws + WS_US);
    const bf16_t* MT = (const bf16_t*)(a.ws + WS_S5MT) + (size_t)g * 65536;
    const bf16_t* WE = (const bf16_t*)(a.ws + WS_S5WE) + (size_t)g * 32768;
    const bf16_t* WC = (const bf16_t*)(a.ws + WS_S5WC) + (size_t)g * 32768;
    const float* s5p = (const float*)(a.ws + WS_S5P);
    float* F = (float*)(a.ws + WS_S5F) + (size_t)g * 4 * 128;
    bf16_t* Z = (bf16_t*)(a.ws + WS_Z);
    bf16x8 bE[8];
#pragma unroll
    for (int ks = 0; ks < 8; ++ks) bE[ks] = *(const bf16x8*)(WE + (size_t)(16 * wave + r) * 256 + 32 * ks + 8 * q);
    bf16x8 bM[2][8], bC[2][4];
    if (PASS == 1) {
#pragma unroll
        for (int nt = 0; nt < 2; ++nt)
#pragma unroll
            for (int ks = 0; ks < 4; ++ks) bC[nt][ks] = *(const bf16x8*)(WC + (size_t)(16 * (2 * wave + nt) + r) * 128 + 32 * ks + 8 * q);
#pragma unroll
        for (int nt = 0; nt < 2; ++nt)
#pragma unroll
            for (int ks = 0; ks < 8; ++ks) bM[nt][ks] = *(const bf16x8*)(MT + (size_t)(16 * (2 * wave + nt) + r) * 256 + 32 * ks + 8 * q);
    }
    float sr = 0.f, si = 0.f;
    const float a16r = s5p[(g * 64 + lane) * 2], a16i = s5p[(g * 64 + lane) * 2 + 1];
    float a128r = a16r, a128i = a16i;
#pragma unroll
    for (int s = 0; s < 3; ++s) { const float tr = a128r * a128r - a128i * a128i, ti = 2.f * a128r * a128i; a128r = tr; a128i = ti; }
    if (PASS == 1) { const float br = s5p[8192 + (g * 64 + lane) * 2], bi = s5p[8192 + (g * 64 + lane) * 2 + 1];
        for (int s = 0; s < seg; ++s) { const float fr_ = F[s * 128 + lane], fi_ = F[s * 128 + 64 + lane]; const float nr = br * sr - bi * si + fr_, ni = br * si + bi * sr + fi_; sr = nr; si = ni; } }
    for (int sb = 0; sb < 4; ++sb) {
        const int tok0 = seg * 4096 + sb * 1024;
#pragma unroll
        for (int i = 0; i < 4; ++i) { const int ch = tid + NTHREADS * i, token = ch >> 1, half = ch & 1;
            const u32x4 v = *(const u32x4*)(U + (size_t)(tok0 + token) * 1024 + g * 16 + half * 8);
            *(LAS u32x4*)(lds + S5_US + (token >> 4) * 528 + ((token & 15) * 16 + half * 8) * 2) = v; }
        __syncthreads();
#pragma unroll
        for (int m = 0; m < 4; ++m) {
            f32x4 acc = {0.f, 0.f, 0.f, 0.f};
#pragma unroll
            for (int ks = 0; ks < 8; ++ks) { const bf16x8 A = *(const LAS bf16x8*)(lds + S5_US + (16 * m + r) * 528 + (32 * ks + 8 * q) * 2); acc = mfma16(A, bE[ks], acc); }
#pragma unroll
            for (int i = 0; i < 4; ++i) *(LAS float*)(lds + S5_ES + ((16 * m + 4 * q + i) * 132 + 16 * wave + r) * 4) = acc[i];
        }
        __syncthreads();
        {
            float lr[8], li[8];
            float xr = 0.f, xi = 0.f;
#pragma unroll
            for (int k = 0; k < 8; ++k) {
                lr[k] = xr; li[k] = xi;
                const float er = *(const LAS float*)(lds + S5_ES + ((8 * wave + k) * 132 + lane) * 4), ei = *(const LAS float*)(lds + S5_ES + ((8 * wave + k) * 132 + 64 + lane) * 4);
                const float nr = a16r * xr - a16i * xi + er, ni = a16r * xi + a16i * xr + ei; xr = nr; xi = ni;
            }
            __builtin_amdgcn_sched_barrier(0);
            *(LAS float*)(lds + S5_TS + (wave * 128 + lane) * 4) = xr; *(LAS float*)(lds + S5_TS + (wave * 128 + 64 + lane) * 4) = xi;
            __syncthreads();
            __builtin_amdgcn_sched_barrier(0);
            float cr = sr, ci = si, mr = sr, mi = si;
#pragma unroll
            for (int w2 = 0; w2 < 8; ++w2) {
                if (w2 == wave) { mr = cr; mi = ci; }
                const float tr = *(const LAS float*)(lds + S5_TS + (w2 * 128 + lane) * 4), ti = *(const LAS float*)(lds + S5_TS + (w2 * 128 + 64 + lane) * 4);
                const float nr = a128r * cr - a128i * ci + tr, ni = a128r * ci + a128i * cr + ti; cr = nr; ci = ni;
            }
            sr = cr; si = ci;
            __builtin_amdgcn_sched_barrier(0);
            if (PASS == 1) {
                float pr = mr, pi = mi;
#pragma unroll
                for (int k = 0; k < 8; ++k) {
                    *(LAS bf16_t*)(lds + S5_SS + ((8 * wave + k) * 136 + lane) * 2) = f2bf(lr[k] + pr); *(LAS bf16_t*)(lds + S5_SS + ((8 * wave + k) * 136 + 64 + lane) * 2) = f2bf(li[k] + pi);
                    const float nr = a16r * pr - a16i * pi, ni = a16r * pi + a16i * pr; pr = nr; pi = ni;
                }
            }
        }
        __syncthreads();
        if (PASS == 1) {
#pragma unroll
            for (int nt = 0; nt < 2; ++nt) {
                const int j = 2 * wave + nt;
                f32x4 acc[4];
#pragma unroll
                for (int m = 0; m < 4; ++m) acc[m] = (f32x4){0.f, 0.f, 0.f, 0.f};
#pragma unroll
                for (int ks = 0; ks < 8; ++ks) {
                    __builtin_amdgcn_sched_barrier(0);
#pragma unroll
                    for (int m = 0; m < 4; ++m) { const bf16x8 A = *(const LAS bf16x8*)(lds + S5_US + (16 * m + r) * 528 + (32 * ks + 8 * q) * 2); acc[m] = mfma16(A, bM[nt][ks], acc[m]); }
                }
#pragma unroll
                for (int ks = 0; ks < 4; ++ks) {
                    __builtin_amdgcn_sched_barrier(0);
#pragma unroll
                    for (int m = 0; m < 4; ++m) { const bf16x8 A = *(const LAS bf16x8*)(lds + S5_SS + (16 * m + r) * 272 + (32 * ks + 8 * q) * 2); acc[m] = mfma16(A, bC[nt][ks], acc[m]); }
                }
                int lz = lane; asm volatile("" : "+v"(lz));
                const int rz = lz & 15, qz = lz >> 4;
#pragma unroll
                for (int m = 0; m < 4; ++m)
#pragma unroll
                    for (int i = 0; i < 4; ++i) { const int ch = 16 * m + 4 * qz + i; Z[(size_t)(tok0 + 16 * ch + j) * 1024 + g * 16 + rz] = f2bf(gelu_tanh(acc[m][i])); }
            }
            __syncthreads();
        }
    }
    if (PASS == 0 && wave == 0) { F[seg * 128 + lane] = sr; F[seg * 128 + 64 + lane] = si; }
}

__device__ __forceinline__ void cmp_finish_item(const Args& a, const Ctx& c, int kvsel, int rt) {
    LAS unsigned char* lds = c.lds;
    const int tid = c.tid, wave = c.wave, lane = c.lane, r = lane & 15, q = lane >> 4;
    const float* SL = (const float*)(a.ws + WS_SLAB) + (size_t)kvsel * 16 * 2048 * 256;
    const float* bpep = (const float*)(a.ws + WS_BPEP) + kvsel * 256;
    const bf16_t* W2 = (const bf16_t*)(a.ws + WS_W2) + kvsel * 128 * 256;
    bf16x8 B[8];
#pragma unroll
    for (int ks = 0; ks < 8; ++ks) B[ks] = *(const bf16x8*)(W2 + (size_t)(16 * wave + r) * 256 + 32 * ks + 8 * q);
    for (int e = tid; e < 16 * 64; e += NTHREADS) {
        const int row = e >> 6, c4 = (e & 63) * 4;
        f32x4 s = {0.f, 0.f, 0.f, 0.f};
#pragma unroll 8
        for (int pt = 0; pt < 32; ++pt) s += *(const f32x4*)(bpep + pt * 512 + c4);
#pragma unroll
        for (int ks = 0; ks < 16; ++ks) s += *(const f32x4*)(SL + ((size_t)ks * 2048 + rt * 16 + row) * 256 + c4);
        u32x2 w; w[0] = cvt_pk_bf16(gelu_tanh(s[0]), gelu_tanh(s[1])); w[1] = cvt_pk_bf16(gelu_tanh(s[2]), gelu_tanh(s[3]));
        *(LAS u32x2*)(lds + row * 528 + c4 * 2) = w;
    }
    __syncthreads();
    f32x4 acc = {0.f, 0.f, 0.f, 0.f};
#pragma unroll
    for (int ks = 0; ks < 8; ++ks) { const bf16x8 A = *(const LAS bf16x8*)(lds + r * 528 + (32 * ks + 8 * q) * 2); acc = mfma16(A, B[ks], acc); }
#pragma unroll
    for (int i = 0; i < 4; ++i) {
        const int row = rt * 16 + 4 * q + i, gi = row >> 10, ci = row & 1023, n = 16 * wave + r;
        const bf16_t v = (ci == 1023) ? (bf16_t)0 : f2bf(acc[i]);
        if (kvsel == 0) ((bf16_t*)(a.ws + WS_KC))[((size_t)gi * 1024 + ci) * 128 + n] = v;
        else ((bf16_t*)(a.ws + WS_VCT))[((size_t)gi * 128 + n) * 1024 + ((ci & ~12) | ((ci & 4) << 1) | ((ci & 8) >> 1))] = v;
    }
    __syncthreads();
}
constexpr int AT_IMP = 65536, AT_TB = 131072, AT_BM = 143872, AT_WU = 145920, AT_END = 146176;
__device__ __forceinline__ int kswz(int r) { return ((r & 3) << 2) | ((r >> 2) & 3); }
__host__ __device__ __forceinline__ int vperm(int t) { return (t & ~12) | ((t & 4) << 1) | ((t & 8) >> 1); }
template <int KEYS> __device__ __forceinline__ int vsw(int d) { return KEYS == 128 ? kswz(d) : ((d >> 1) & 7); }
template <int KEYS, bool NEEDV>
__device__ __forceinline__ void stage_dma(const bf16_t* Kt, const bf16_t* Vt, int ldv, LAS unsigned char* kb, LAS unsigned char* vb, int wave, int lane) {
    constexpr int NP = KEYS / 32;
#pragma unroll
    for (int i = 0; i < NP; ++i) { const int pc = NP * wave + i, row = 4 * pc + (lane >> 4), ch = (lane & 15) ^ kswz(row);
        __builtin_amdgcn_global_load_lds((const unsigned*)(Kt + row * 128 + ch * 8), (LAS unsigned*)(kb + pc * 1024), 16, 0, 0); }
    if (NEEDV) {
#pragma unroll
        for (int i = 0; i < NP; ++i) {
            const int pc = NP * wave + i;
            if (KEYS == 128) { const int d = 4 * pc + (lane >> 4), ch = (lane & 15) ^ kswz(d);
                __builtin_amdgcn_global_load_lds((const unsigned*)(Vt + (size_t)d * ldv + 8 * ch), (LAS unsigned*)(vb + pc * 1024), 16, 0, 0); }
            else { const int d = 8 * pc + (lane >> 3), ch = (lane & 7) ^ ((d >> 1) & 7);
                __builtin_amdgcn_global_load_lds((const unsigned*)(Vt + (size_t)d * ldv + 8 * ch), (LAS unsigned*)(vb + pc * 1024), 16, 0, 0); }
        }
    }
}
__device__ __forceinline__ float xhalf_max(float x) { auto rr = __builtin_amdgcn_permlane32_swap(__float_as_uint(x), __float_as_uint(x), false, false); return fmaxf(__uint_as_float(rr[0]), __uint_as_float(rr[1])); }
__device__ __forceinline__ float xhalf_sum(float x) { auto rr = __builtin_amdgcn_permlane32_swap(__float_as_uint(x), __float_as_uint(x), false, false); return __uint_as_float(rr[0]) + __uint_as_float(rr[1]); }
template <int BR>
__device__ __forceinline__ float tile_prep(int MODE, f32x16& S, LAS const float* tb, float cb, int base, bool selbit) {
    float mx = -INFINITY;
    if (MODE == 1) {
#pragma unroll
        for (int r = 0; r < 16; ++r) mx = fmaxf(mx, S[r]);
        mx = (BR == 2 && !selbit) ? -INFINITY : mx + cb;
    } else {
        const bool nomask = (MODE == 2);
        float bv[16];
#pragma unroll
        for (int r = 0; r < 16; ++r) { const int cr = (r & 3) + 8 * (r >> 2); const int dist = (BR <= 1) ? base - 16 * cr : base - cr; bv[r] = tb[min(max(dist, 0), TBN - 1)]; }
        __builtin_amdgcn_sched_barrier(0);
#pragma unroll
        for (int r = 0; r < 16; ++r) {
            const int cr = (r & 3) + 8 * (r >> 2);
            const int dist = (BR <= 1) ? base - 16 * cr : base - cr;
            float v = S[r] + bv[r];
            bool valid;
            if (BR <= 1) valid = dist >= 0; else if (BR == 2) valid = selbit && dist >= 0; else valid = nomask || (unsigned)dist < 512u;
            v = valid ? v : -INFINITY;
            S[r] = v; mx = fmaxf(mx, v);
        }
    }
    return mx;
}
template <int BR, bool PEND>
__device__ __forceinline__ float tile_decide(int MODE, float mx, float cb, bool selbit, f32x16 (&O)[4], float& m, float& l, u32x4& pa, u32x4& pb) {
    if (BR == 1) { const float mu = (m == -INFINITY) ? 0.f : m; return (MODE == 1) ? mu - cb : mu; }
    mx = xhalf_max(mx);
    const float mn = fmaxf(m, mx), mu = (mn == -INFINITY) ? 0.f : mn;
    if (__any(mn > m)) {
        const float alpha = fexp2(m - mu);
        l *= alpha;
        if (BR >= 2) {
#pragma unroll
            for (int dt = 0; dt < 4; ++dt)
#pragma unroll
                for (int r = 0; r < 16; ++r) O[dt][r] *= alpha;
            if (PEND) {
#pragma unroll
                for (int e = 0; e < 4; ++e) { pa[e] = cvt_pk_bf16(bflo(pa[e]) * alpha, bfhi(pa[e]) * alpha); pb[e] = cvt_pk_bf16(bflo(pb[e]) * alpha, bfhi(pb[e]) * alpha); }
            }
        }
    }
    m = mn;
    if (MODE == 1) return (BR == 2 && !selbit) ? INFINITY : mu - cb;
    return mu;
}
template <int BR, int KEYS>
__device__ __forceinline__ void attn_tile(int MODE, LAS const unsigned char* kb, LAS const unsigned char* vb, int cb0, LAS const float* tb, int key0, int t, int lane,
                                          const bf16x8 (&qf)[8], f32x16 (&O)[4], float& m, float& l, float inv_l, bool selbit, LAS float* imp_row) {
    asm volatile("" : "+v"(lane));
    constexpr int ROWB = 2 * KEYS;
    const int r31 = lane & 31, h = lane >> 5;
    const int gh = kswz(r31) ^ h, vh = vsw<KEYS>(r31) ^ h;
    float cb = 0.f;
    if (MODE == 1) cb = tb[TBN - 1];
    const int base0 = (BR <= 1) ? t - 31 - 16 * (key0 + 4 * h) : t - (key0 + 4 * h);
    const int base1 = (BR <= 1) ? base0 - 16 * 32 : base0 - 32;
    LAS const unsigned char* k0 = kb + r31 * 256;
    f32x16 S0, S1;
    bf16x8 kf[8];
#pragma unroll
    for (int ks = 0; ks < 8; ++ks) kf[ks] = *(const LAS bf16x8*)(k0 + 16 * ((2 * ks) ^ gh));
#pragma unroll
    for (int r = 0; r < 16; ++r) { S0[r] = 0.f; S1[r] = 0.f; }
    __builtin_amdgcn_sched_barrier(0);
#pragma unroll
    for (int ks = 0; ks < 8; ++ks) S0 = mfma32(kf[ks], qf[ks], S0);
    __builtin_amdgcn_sched_barrier(0);
#pragma unroll
    for (int ks = 0; ks < 8; ++ks) kf[ks] = *(const LAS bf16x8*)(k0 + 8192 + 16 * ((2 * ks) ^ gh));
    const float mx0 = tile_prep<BR>(MODE, S0, tb, cb, base0, selbit);
    u32x4 pk0a = {0u, 0u, 0u, 0u}, pk0b = {0u, 0u, 0u, 0u}, pk1a, pk1b;
    const float me0 = tile_decide<BR, false>(MODE, mx0, cb, selbit, O, m, l, pk0a, pk0b);
    __builtin_amdgcn_sched_barrier(0);
    {
#pragma unroll
        for (int ks = 0; ks < 8; ++ks) S1 = mfma32(kf[ks], qf[ks], S1);
        float ps = 0.f;
#pragma unroll
        for (int r = 0; r < 16; ++r) { float p = fexp2(S0[r] - me0); if (BR == 1) p *= inv_l; S0[r] = p; ps += p; }
        if (BR != 1) l += ps;
        if (BR >= 1) {
#pragma unroll
            for (int e = 0; e < 4; ++e) { pk0a[e] = cvt_pk_bf16(S0[2 * e], S0[2 * e + 1]); pk0b[e] = cvt_pk_bf16(S0[8 + 2 * e], S0[8 + 2 * e + 1]); }
        }
#pragma unroll
        for (int i = 0; i < 8; ++i) { __builtin_amdgcn_sched_group_barrier(0x008, 1, 0); __builtin_amdgcn_sched_group_barrier(0x002, 8, 0); }
    }
    __builtin_amdgcn_sched_barrier(0);
    if (BR == 1) {
#pragma unroll
        for (int rg = 0; rg < 4; ++rg) {
            float A = 2.f * (S0[4 * rg] + S0[4 * rg + 1] + S0[4 * rg + 2]) + S0[4 * rg + 3], B = S0[4 * rg + 3];
            A = quad_sum(A); B = quad_sum(B);
            const int jj = (key0 >> 2) + 2 * rg + h;
            if ((lane & 3) == 0) { __hip_atomic_fetch_add(imp_row + jj, A, __ATOMIC_RELAXED, __HIP_MEMORY_SCOPE_WORKGROUP);
                if (jj + 1 < 256) __hip_atomic_fetch_add(imp_row + jj + 1, B, __ATOMIC_RELAXED, __HIP_MEMORY_SCOPE_WORKGROUP); }
        }
    }
    bf16x8 av[8];
    if (BR >= 1) {
#pragma unroll
        for (int s = 0; s < 2; ++s)
#pragma unroll
            for (int dt = 0; dt < 4; ++dt) av[s * 4 + dt] = *(const LAS bf16x8*)(vb + (32 * dt + r31) * ROWB + 16 * ((cb0 + 2 * s) ^ vh));
    }
    const float mx1 = tile_prep<BR>(MODE, S1, tb, cb, base1, selbit);
    const float me1 = tile_decide<BR, true>(MODE, mx1, cb, selbit, O, m, l, pk0a, pk0b);
    __builtin_amdgcn_sched_barrier(0);
    {
        if (BR >= 1) {
#pragma unroll
            for (int dt = 0; dt < 4; ++dt) O[dt] = mfma32(av[dt], __builtin_bit_cast(bf16x8, pk0a), O[dt]);
#pragma unroll
            for (int dt = 0; dt < 4; ++dt) O[dt] = mfma32(av[4 + dt], __builtin_bit_cast(bf16x8, pk0b), O[dt]);
        }
        float ps = 0.f;
#pragma unroll
        for (int r = 0; r < 16; ++r) { float p = fexp2(S1[r] - me1); if (BR == 1) p *= inv_l; S1[r] = p; ps += p; }
        if (BR != 1) l += ps;
        if (BR >= 1) {
#pragma unroll
            for (int e = 0; e < 4; ++e) { pk1a[e] = cvt_pk_bf16(S1[2 * e], S1[2 * e + 1]); pk1b[e] = cvt_pk_bf16(S1[8 + 2 * e], S1[8 + 2 * e + 1]); }
#pragma unroll
            for (int i = 0; i < 8; ++i) { __builtin_amdgcn_sched_group_barrier(0x008, 1, 0); __builtin_amdgcn_sched_group_barrier(0x002, 8, 0); }
        }
    }
    __builtin_amdgcn_sched_barrier(0);
    if (BR == 1) {
#pragma unroll
        for (int rg = 0; rg < 4; ++rg) {
            float A = 2.f * (S1[4 * rg] + S1[4 * rg + 1] + S1[4 * rg + 2]) + S1[4 * rg + 3], B = S1[4 * rg + 3];
            A = quad_sum(A); B = quad_sum(B);
            const int jj = ((key0 + 32) >> 2) + 2 * rg + h;
            if ((lane & 3) == 0) { __hip_atomic_fetch_add(imp_row + jj, A, __ATOMIC_RELAXED, __HIP_MEMORY_SCOPE_WORKGROUP);
                if (jj + 1 < 256) __hip_atomic_fetch_add(imp_row + jj + 1, B, __ATOMIC_RELAXED, __HIP_MEMORY_SCOPE_WORKGROUP); }
        }
    }
    if (BR >= 1) {
#pragma unroll
        for (int s = 0; s < 2; ++s)
#pragma unroll
            for (int dt = 0; dt < 4; ++dt) av[s * 4 + dt] = *(const LAS bf16x8*)(vb + (32 * dt + r31) * ROWB + 16 * ((cb0 + 4 + 2 * s) ^ vh));
        __builtin_amdgcn_sched_barrier(0);
#pragma unroll
        for (int dt = 0; dt < 4; ++dt) O[dt] = mfma32(av[dt], __builtin_bit_cast(bf16x8, pk1a), O[dt]);
#pragma unroll
        for (int dt = 0; dt < 4; ++dt) O[dt] = mfma32(av[4 + dt], __builtin_bit_cast(bf16x8, pk1b), O[dt]);
    }
}
template <int BR, int KEYS>
__device__ __forceinline__ void run_branch(const Ctx& c, const bf16_t* Kb, const bf16_t* Vtb, int ldv, int lo, int hi, LAS const float* tb, int t, int t0,
                                           const bf16x8 (&qf)[8], f32x16 (&O)[4], float& m, float& l, float inv_l, int tl, LAS float* imp_row) {
    constexpr bool NEEDV = (BR != 0);
    constexpr int BPS = KEYS / 64, KSTG = KEYS * 256, VSTG = 128 * 2 * KEYS, VB0 = 2 * KSTG;
    LAS unsigned char* lds = c.lds;
    int lz = c.lane; asm volatile("" : "+v"(lz));
    const int nst = (hi - lo + BPS - 1) / BPS;
#define STG_BLK(i) ((lo + BPS * (i) + BPS - 1 < hi) ? lo + BPS * (i) : hi - BPS)
    asm volatile("s_waitcnt vmcnt(0)" ::: "memory");
    { const int b0 = (BPS == 2 && hi - lo < 2) ? lo : STG_BLK(0);
      stage_dma<KEYS, NEEDV>(Kb + (size_t)b0 * 64 * 128, Vtb + (size_t)b0 * 64, ldv, lds, lds + VB0, c.wave, lz); }
    asm volatile("s_waitcnt vmcnt(0)" ::: "memory");
    __syncthreads();
    const int qt = t0 >> 6;
    for (int i = 0; i < nst; ++i) {
        const int buf = i & 1;
        if (i + 1 < nst) { int lz2 = lz; asm volatile("" : "+v"(lz2));
            const int b1 = STG_BLK(i + 1);
            stage_dma<KEYS, NEEDV>(Kb + (size_t)b1 * 64 * 128, Vtb + (size_t)b1 * 64, ldv, lds + (buf ^ 1) * KSTG, lds + VB0 + (buf ^ 1) * VSTG, c.wave, lz2); }
        const int sb = (BPS == 2 && hi - lo < 2) ? lo : STG_BLK(i);
#pragma unroll
        for (int q = 0; q < BPS; ++q) {
            const int j = lo + BPS * i + q;
            if (j < hi) {
                bool selbit = true, wave_on = true;
                if (BR == 2) {
                    const unsigned w = *(const LAS unsigned*)(lds + AT_BM + (tl * 8 + (j >> 5)) * 4);
                    selbit = (w >> (j & 31)) & 1u;
                    const unsigned wu = *(const LAS unsigned*)(lds + AT_WU + (c.wave * 8 + (j >> 5)) * 4);
                    wave_on = (wu >> (j & 31)) & 1u;
                }
                if (wave_on) {
                    int mode = 0;
                    if (BR <= 1) mode = (1024 * j + 1829 <= t0) ? 1 : 0;
                    else if (BR == 2) mode = (64 * j + 853 <= t0) ? 1 : 0;
                    else mode = (j >= qt - 7 && j <= qt - 1) ? 2 : 0;
                    const int slot = j - sb;
                    attn_tile<BR, KEYS>(mode, lds + buf * KSTG + slot * 16384, lds + VB0 + buf * VSTG, 8 * slot, tb, j * 64, t, c.lane, qf, O, m, l, inv_l, selbit, imp_row);
                }
            }
        }
        asm volatile("s_waitcnt vmcnt(0)" ::: "memory");
        __syncthreads();
    }
#undef STG_BLK
}
__device__ __forceinline__ void attn_item(const Args& a, const Ctx& c_, int qt, int g) {
    Ctx c = c_; { int tz = c_.tid; asm volatile("" : "+v"(tz)); c.tid = tz; c.lane = tz & 63; }
    LAS unsigned char* lds = c.lds;
    const int tid = c.tid, wave = c.wave, lane = c.lane, r31 = lane & 31, h = lane >> 5, hl = lane & 3;
    const int t0 = qt * 64, tl = 8 * wave + (r31 >> 2), t = t0 + tl, head = g * 4 + hl;
    const bf16_t* Qb = (const bf16_t*)(a.ws + WS_Q);
    const bf16_t* KROW = (const bf16_t*)(a.ws + WS_KROW);
    const bf16_t* VT = (const bf16_t*)(a.ws + WS_VT);
    const float* GATE = (const float*)(a.ws + WS_GATE);
    { const float* tbg = (const float*)(a.ws + WS_TB) + g * 4 * TBN;
      for (int i = tid; i < 4 * TBN; i += NTHREADS) *(LAS float*)(lds + AT_TB + i * 4) = tbg[i];
      for (int i = tid; i < 64 * 256; i += NTHREADS) *(LAS float*)(lds + AT_IMP + i * 4) = 0.f; }
    bf16x8 qf[8];
#pragma unroll
    for (int ks = 0; ks < 8; ++ks) qf[ks] = *(const bf16x8*)(Qb + (size_t)t * 1024 + head * 128 + 16 * ks + 8 * h);
    LAS const float* tb = (LAS const float*)(lds + AT_TB) + hl * TBN;
    LAS float* imp_row = (LAS float*)(lds + AT_IMP) + tl * 256;
    bf16_t* Y = (bf16_t*)(a.ws + WS_Y2) + (size_t)t * 2048 + 1024 + head * 128 + 4 * h;
    f32x16 O[4];
#pragma unroll
    for (int dt = 0; dt < 4; ++dt)
#pragma unroll
        for (int r = 0; r < 16; ++r) O[dt][r] = 0.f;
    __syncthreads();
    { const int ntile = (t0 / 16 + 3 + 63) / 64;
      const bf16_t* KC = (const bf16_t*)(a.ws + WS_KC) + (size_t)g * 1024 * 128; const bf16_t* VCT = (const bf16_t*)(a.ws + WS_VCT) + (size_t)g * 128 * 1024;
      float m = -INFINITY, l = 0.f;
#if defined(PROBE_CMP)
      run_branch<0, 64>(c, KC, VCT, 1024, 0, ntile, tb, t, t0, qf, O, m, l, 0.f, tl, imp_row);
      asm volatile("" :: "v"(m), "v"(l));
      m = -INFINITY; l = 0.f;
#endif
      run_branch<0, 64>(c, KC, VCT, 1024, 0, ntile, tb, t, t0, qf, O, m, l, 0.f, tl, imp_row);
      const float lt = xhalf_sum(l), inv = lt > 0.f ? 1.f / lt : 0.f;
      run_branch<1, 64>(c, KC, VCT, 1024, 0, ntile, tb, t, t0, qf, O, m, l, inv, tl, imp_row);
      const float gc = GATE[(size_t)t * 24 + head];
#pragma unroll
      for (int dt = 0; dt < 4; ++dt)
#pragma unroll
          for (int rg = 0; rg < 4; ++rg) {
              u32x2 w; w[0] = cvt_pk_bf16(gc * O[dt][4 * rg], gc * O[dt][4 * rg + 1]); w[1] = cvt_pk_bf16(gc * O[dt][4 * rg + 2], gc * O[dt][4 * rg + 3]);
              *(u32x2*)(Y + 32 * dt + 8 * rg) = w;
#pragma unroll
              for (int e = 0; e < 4; ++e) O[dt][4 * rg + e] = 0.f;
          }
    }
    {
        const int ncand = qt - 2 > 0 ? qt - 2 : 0;
        unsigned v[8][4], selm[8];
#pragma unroll
        for (int i = 0; i < 8; ++i) {
            LAS const float* row = (LAS const float*)(lds + AT_IMP) + (8 * wave + i) * 256;
            selm[i] = 0u;
#pragma unroll
            for (int k = 0; k < 4; ++k) { const int j = lane + 64 * k; const bool cand = (j >= 1 && j <= qt - 2);
                v[i][k] = cand ? ((__float_as_uint(row[j]) & ~0xFFu) | (unsigned)(255 - j)) : 0u; if (ncand <= 13 && cand) selm[i] |= 1u << k; }
        }
        if (ncand > 13) {
            for (int it = 0; it < 13; ++it) {
#pragma unroll
                for (int i = 0; i < 8; ++i) {
                    const unsigned mx = wave_umax_bcast(max(max(v[i][0], v[i][1]), max(v[i][2], v[i][3])));
#pragma unroll
                    for (int k = 0; k < 4; ++k) if (v[i][k] == mx) { v[i][k] = 0u; selm[i] |= 1u << k; }
                }
            }
        }
        unsigned wu[8];
#pragma unroll
        for (int k = 0; k < 8; ++k) wu[k] = 0u;
#pragma unroll
        for (int i = 0; i < 8; ++i)
#pragma unroll
            for (int k = 0; k < 4; ++k) {
                const int j = lane + 64 * k; const bool forced = (j == 0) || (j == qt) || (j == qt - 1);
                const unsigned long long mk = __ballot(((selm[i] >> k) & 1u) || forced);
                const unsigned lo = (unsigned)mk, hi = (unsigned)(mk >> 32);
                if (lane == 0) { *(LAS unsigned*)(lds + AT_BM + ((8 * wave + i) * 8 + 2 * k) * 4) = lo; *(LAS unsigned*)(lds + AT_BM + ((8 * wave + i) * 8 + 2 * k + 1) * 4) = hi; }
                wu[2 * k] |= lo; wu[2 * k + 1] |= hi;
            }
        if (lane == 0) {
#pragma unroll
            for (int k = 0; k < 8; ++k) *(LAS unsigned*)(lds + AT_WU + (wave * 8 + k) * 4) = wu[k];
        }
    }
    __syncthreads();
#if defined(PROBE_SEL)
    { float m = -INFINITY, l = 0.f;
      run_branch<2, 128>(c, KROW + (size_t)(2 + g) * L_ * 128, VT + (size_t)g * 128 * L_, L_, 0, qt + 1, tb, t, t0, qf, O, m, l, 0.f, tl, imp_row);
      asm volatile("" :: "v"(O[0]), "v"(O[1]), "v"(O[2]), "v"(O[3]), "v"(m), "v"(l));
#pragma unroll
      for (int dt = 0; dt < 4; ++dt)
#pragma unroll
          for (int r = 0; r < 16; ++r) O[dt][r] = 0.f; }
#endif
    { float m = -INFINITY, l = 0.f;
      run_branch<2, 128>(c, KROW + (size_t)(2 + g) * L_ * 128, VT + (size_t)g * 128 * L_, L_, 0, qt + 1, tb, t, t0, qf, O, m, l, 0.f, tl, imp_row);
      const float gs = GATE[(size_t)t * 24 + 8 + head];
      const float lt = xhalf_sum(l), sc = gs * (lt > 0.f ? 1.f / lt : 0.f);
#pragma unroll
      for (int dt = 0; dt < 4; ++dt)
#pragma unroll
          for (int rg = 0; rg < 4; ++rg) {
              const u32x2 w0 = *(const u32x2*)(Y + 32 * dt + 8 * rg);
              u32x2 w; w[0] = cvt_pk_bf16(bflo(w0[0]) + sc * O[dt][4 * rg], bfhi(w0[0]) + sc * O[dt][4 * rg + 1]); w[1] = cvt_pk_bf16(bflo(w0[1]) + sc * O[dt][4 * rg + 2], bfhi(w0[1]) + sc * O[dt][4 * rg + 3]);
              *(u32x2*)(Y + 32 * dt + 8 * rg) = w;
#pragma unroll
              for (int e = 0; e < 4; ++e) O[dt][4 * rg + e] = 0.f;
          }
    }
#if defined(PROBE_WIN)
    { float m = -INFINITY, l = 0.f;
      const int lo = qt - 8 > 0 ? qt - 8 : 0;
      run_branch<3, 128>(c, KROW + (size_t)(4 + g) * L_ * 128, VT + (size_t)(2 + g) * 128 * L_, L_, lo, qt + 1, tb, t, t0, qf, O, m, l, 0.f, tl, imp_row);
      asm volatile("" :: "v"(O[0]), "v"(O[1]), "v"(O[2]), "v"(O[3]), "v"(m), "v"(l));
#pragma unroll
      for (int dt = 0; dt < 4; ++dt)
#pragma unroll
          for (int r = 0; r < 16; ++r) O[dt][r] = 0.f; }
#endif
    { float m = -INFINITY, l = 0.f;
      const int lo = qt - 8 > 0 ? qt - 8 : 0;
      run_branch<3, 128>(c, KROW + (size_t)(4 + g) * L_ * 128, VT + (size_t)(2 + g) * 128 * L_, L_, lo, qt + 1, tb, t, t0, qf, O, m, l, 0.f, tl, imp_row);
      const float gw = GATE[(size_t)t * 24 + 16 + head];
      const float lt = xhalf_sum(l), sc = gw * (lt > 0.f ? 1.f / lt : 0.f);
      float ss = 0.f;
#pragma unroll
      for (int dt = 0; dt < 4; ++dt)
#pragma unroll
          for (int rg = 0; rg < 4; ++rg) {
              const u32x2 w0 = *(const u32x2*)(Y + 32 * dt + 8 * rg);
              const float y0 = bflo(w0[0]) + sc * O[dt][4 * rg], y1 = bfhi(w0[0]) + sc * O[dt][4 * rg + 1], y2 = bflo(w0[1]) + sc * O[dt][4 * rg + 2], y3 = bfhi(w0[1]) + sc * O[dt][4 * rg + 3];
              u32x2 w; w[0] = cvt_pk_bf16(y0, y1); w[1] = cvt_pk_bf16(y2, y3);
              *(u32x2*)(Y + 32 * dt + 8 * rg) = w;
              ss += (y0 * y0 + y1 * y1) + (y2 * y2 + y3 * y3);
          }
      ss = quad_sum(xhalf_sum(ss));
      if (hl == 0 && h == 0) ((float*)(a.ws + WS_STAP))[(size_t)t * 2 + g] = ss;
    }
    __syncthreads();
}
#ifndef PEER_ALPHA
#define PEER_ALPHA 1.0f
#endif
constexpr int PE_SC = 0, PE_LV = 65536, PE_LI = 73728, PE_PK = 81920, PE_EX = 147456, PE_GT = 149504, PE_SU = 153600, PE_CE = 157696, PE_END = 161792;
constexpr int PE_SLOT = 2048, PE_NSLOT = 8, PE_RINGW = PE_SLOT * 9;
static_assert(8 * PE_RINGW <= PE_EX && PE_END <= LDS_BYTES - 32, "PEER LDS map");
__device__ __forceinline__ float pair_wave_sum(float a, float b, bool odd) {
    a += dpp_f<0xB1>(a); b += dpp_f<0xB1>(b);
    float c = odd ? b : a;
    c += dpp_f<0x4E>(c); c += dpp_f<0x124>(c); c += dpp_f<0x128>(c);
    { const auto r = __builtin_amdgcn_permlane16_swap(__float_as_uint(c), __float_as_uint(c), false, false); c = __uint_as_float(r[0]) + __uint_as_float(r[1]); }
    { const auto r = __builtin_amdgcn_permlane32_swap(__float_as_uint(c), __float_as_uint(c), false, false); c = __uint_as_float(r[0]) + __uint_as_float(r[1]); }
    return c;
}
__device__ __forceinline__ float wave_sum_bcast(float v) {
    v += dpp_f<0xB1>(v); v += dpp_f<0x4E>(v); v += dpp_f<0x141>(v); v += dpp_f<0x140>(v);
    v += __int_as_float(__builtin_amdgcn_update_dpp(0, __float_as_int(v), 0x142, 0xa, 0xf, false));
    v += __int_as_float(__builtin_amdgcn_update_dpp(0, __float_as_int(v), 0x143, 0xc, 0xf, false));
    return __int_as_float(__builtin_amdgcn_readlane(__float_as_int(v), 63));
}
__device__ __forceinline__ unsigned mono_key(float v) { const unsigned b = __float_as_uint(v); return b ^ ((b >> 31) ? 0xFFFFFFFFu : 0x80000000u); }
template <int CTRL>
__device__ __forceinline__ void quad_merge16(unsigned (&t)[16]) {
    unsigned o[16];
#pragma unroll
    for (int i = 0; i < 16; ++i) o[i] = (unsigned)__builtin_amdgcn_update_dpp(0, (int)t[15 - i], CTRL, 0xf, 0xf, false);
#pragma unroll
    for (int i = 0; i < 16; ++i) t[i] = max(t[i], o[i]);
#pragma unroll
    for (int st = 8; st >= 1; st >>= 1)
#pragma unroll
        for (int i = 0; i < 16; ++i) if ((i & st) == 0) { const unsigned hi = max(t[i], t[i + st]), lo = min(t[i], t[i + st]); t[i] = hi; t[i + st] = lo; }
}
__device__ __forceinline__ void sort16_desc(unsigned (&t)[16]) {
#pragma unroll
    for (int k = 2; k <= 16; k <<= 1)
#pragma unroll
        for (int j = k >> 1; j > 0; j >>= 1)
#pragma unroll
            for (int i = 0; i < 16; ++i) { const int l = i ^ j; if (l > i) { const bool desc = ((i & k) == 0); const unsigned hi = max(t[i], t[l]), lo = min(t[i], t[l]); t[i] = desc ? hi : lo; t[l] = desc ? lo : hi; } }
}
__device__ __forceinline__ void bitonic_merge16_desc(unsigned (&t)[16]) {
#pragma unroll
    for (int st = 8; st >= 1; st >>= 1)
#pragma unroll
        for (int i = 0; i < 16; ++i) if ((i & st) == 0) { const unsigned hi = max(t[i], t[i + st]), lo = min(t[i], t[i + st]); t[i] = hi; t[i + st] = lo; }
}
__device__ __forceinline__ int pair_a(int p) { return p < 16 ? 0 : p < 24 ? 1 : p < 29 ? 2 : p < 33 ? 3 : p < 36 ? 4 : p < 38 ? 5 : p < 40 ? 6 : p < 42 ? 7 : p - 34; }
__device__ __forceinline__ int pair_b(int p) { return p < 16 ? p : p < 24 ? p - 16 : p < 29 ? p - 24 : p < 33 ? p - 29 : p < 36 ? p - 33 : p < 38 ? p - 36 : p < 40 ? p - 38 : p < 42 ? p - 40 : 0; }
template <bool DRY>
__device__ __forceinline__ void peer_step(const Args& a, const Ctx& c_, int t0) {
    Ctx c = c_; { int tz = c_.tid; asm volatile("" : "+v"(tz)); c.tid = tz; c.lane = tz & 63; }
    LAS unsigned char* lds = c.lds;
    const int tid = c.tid, wave = c.wave, lane = c.lane, r = lane & 15, q = lane >> 4;
    const bf16_t* QP = (const bf16_t*)(a.ws + WS_QP); const bf16_t* PK = (const bf16_t*)(a.ws + WS_PK);
    const unsigned char* PU = a.ws + WS_PU; const unsigned char* PV = a.ws + WS_PV; const float* psc = (const float*)(a.ws + WS_PSC);
    const bf16_t* HB = (const bf16_t*)(a.ws + WS_H2);
    const int t = t0 + wave;
    u32x2 hraw[8], xw[8];
#pragma unroll
    for (int k = 0; k < 8; ++k) hraw[k] = *(const u32x2*)(HB + (size_t)t * 2048 + 256 * k + lane * 4);
#pragma unroll
    for (int k = 0; k < 8; ++k) xw[k] = *(const u32x2*)((const bf16_t*)(a.ws + WS_X1) + (size_t)t * 2048 + 256 * k + lane * 4);
    const float r2 = ((const float*)(a.ws + WS_RSTD2))[t0 + ((tid >> 5) & 7)];
    {
#pragma unroll
        for (int i = 0; i < 8; ++i) { const int pc = 8 * wave + i, row = 4 * pc + (lane >> 4), ch = (lane & 15) ^ kswz(row);
            __builtin_amdgcn_global_load_lds((const unsigned*)(PK + (size_t)row * 128 + ch * 8), (LAS unsigned*)(lds + PE_PK + pc * 1024), 16, 0, 0); }
        const int hh = wave;
        bf16x8 aF[2][4];
#pragma unroll
        for (int cc = 0; cc < 2; ++cc)
#pragma unroll
            for (int ks = 0; ks < 4; ++ks) aF[cc][ks] = *(const bf16x8*)(QP + (size_t)(t0 + (r & 7)) * 2048 + hh * 256 + cc * 128 + 32 * ks + 8 * q);
        asm volatile("s_waitcnt vmcnt(0)" ::: "memory");
        __syncthreads();
        const int ksw = kswz(r);
#pragma unroll
        for (int cc = 0; cc < 2; ++cc)
#pragma unroll 2
            for (int nt = 0; nt < 8; ++nt) {
                f32x4 acc = {0.f, 0.f, 0.f, 0.f};
#pragma unroll
                for (int ks = 0; ks < 4; ++ks) { const bf16x8 B = *(const LAS bf16x8*)(lds + PE_PK + (cc * 128 + 16 * nt + r) * 256 + 16 * ((4 * ks + q) ^ ksw)); acc = mfma16(aF[cc][ks], B, acc); }
                if (q < 2) {
#pragma unroll
                    for (int i = 0; i < 4; ++i) { const int task = (4 * q + i) * 16 + hh * 2 + cc; *(LAS float*)(lds + PE_SC + (task * 128 + ((16 * nt + r + task) & 127)) * 4) = acc[i]; }
                }
            }
    }
    __syncthreads();
    {
        const int task = tid >> 2, part = tid & 3;
        LAS const float* sc = (LAS const float*)(lds + PE_SC) + task * 128;
        float vals[32];
#pragma unroll
        for (int k = 0; k < 32; ++k) vals[k] = sc[(32 * part + k + task) & 127];
        unsigned top[16], tb[16];
#pragma unroll
        for (int k = 0; k < 16; ++k) { top[k] = (mono_key(vals[k]) & ~0x7Fu) | (unsigned)(127 - (32 * part + k)); tb[k] = (mono_key(vals[16 + k]) & ~0x7Fu) | (unsigned)(127 - (32 * part + 16 + k)); }
        sort16_desc(top); sort16_desc(tb);
#pragma unroll
        for (int i = 0; i < 16; ++i) top[i] = max(top[i], tb[15 - i]);
        bitonic_merge16_desc(top);
        quad_merge16<0xB1>(top);
        quad_merge16<0x4E>(top);
        if (part == 0) {
#pragma unroll
            for (int e = 0; e < 16; ++e) { const int idx = 127 - (int)(top[e] & 0x7Fu); *(LAS float*)(lds + PE_LV + (task * 16 + e) * 4) = sc[(idx + task) & 127]; *(LAS int*)(lds + PE_LI + (task * 16 + e) * 4) = idx; }
        }
    }
    __syncthreads();
    if (tid < 256) {
        const int task = tid >> 2, part = tid & 3, tok = task >> 3, hh = task & 7, t1 = tok * 16 + hh * 2, t2 = t1 + 1;
        LAS const float* lv1 = (LAS const float*)(lds + PE_LV) + t1 * 16; LAS const float* lv2 = (LAS const float*)(lds + PE_LV) + t2 * 16;
        unsigned top[16];
#pragma unroll
        for (int i = 0; i < 16; ++i) {
            const int p = part + 4 * i;
            top[i] = 0u;
            if (i < 13 && p < 50) { const int aa = pair_a(p), bb = pair_b(p); top[i] = (mono_key(lv1[aa] + lv2[bb]) & ~0xFFu) | (unsigned)(255 - (aa * 16 + bb)); }
        }
        sort16_desc(top);
        quad_merge16<0xB1>(top);
        quad_merge16<0x4E>(top);
        if (part == 0) {
            LAS const int* li1 = (LAS const int*)(lds + PE_LI) + t1 * 16; LAS const int* li2 = (LAS const int*)(lds + PE_LI) + t2 * 16;
            float sv[16]; int ex[16]; float mx = -INFINITY;
#pragma unroll
            for (int e = 0; e < 16; ++e) {
                const int id = 255 - (int)(top[e] & 0xFFu), aa = id >> 4, bb = id & 15;
                sv[e] = lv1[aa] + lv2[bb]; ex[e] = li1[aa] * 128 + li2[bb]; mx = fmaxf(mx, sv[e]);
            }
            float sum = 0.f;
#pragma unroll
            for (int e = 0; e < 16; ++e) { sv[e] = fexp2((sv[e] - mx) * LOG2E); sum += sv[e]; }
            const float inv = 1.f / sum;
#pragma unroll
            for (int e = 0; e < 16; ++e) *(LAS unsigned short*)(lds + PE_EX + (tok * 128 + hh * 16 + e) * 2) = (unsigned short)ex[e];
            f32x4 rec[16];
#pragma unroll
            for (int e = 0; e < 16; ++e) rec[e] = *(const f32x4*)(psc + (size_t)ex[e] * 4);
            __builtin_amdgcn_sched_barrier(0);
#pragma unroll
            for (int e = 0; e < 16; ++e) asm volatile("" :: "v"(rec[e]));
#pragma unroll
            for (int e = 0; e < 16; ++e) {
                *(LAS float*)(lds + PE_GT + (tok * 128 + hh * 16 + e) * 4) = sv[e] * inv * rec[e][2];
                *(LAS float*)(lds + PE_SU + (tok * 128 + hh * 16 + e) * 4) = rec[e][0] * r2;
                *(LAS float*)(lds + PE_CE + (tok * 128 + hh * 16 + e) * 4) = rec[e][1]; }
        }
    }
    __syncthreads();
    f32x2 hp[16];
#pragma unroll
    for (int k = 0; k < 8; ++k)
#pragma unroll
        for (int e = 0; e < 2; ++e) { hp[k * 2 + e][0] = bflo(hraw[k][e]); hp[k * 2 + e][1] = bfhi(hraw[k][e]); }
    f32x2 acc[16];
#pragma unroll
    for (int e = 0; e < 16; ++e) acc[e] = (f32x2){0.f, 0.f};
    asm volatile("s_waitcnt vmcnt(0)" ::: "memory");
    f32x4 gvv[8], fvv[8];
    {
        int lo_ = wave * 512 + (lane & 1) * 4; asm volatile("" : "+v"(lo_));
        LAS const float* gtl = (LAS const float*)(lds + PE_GT + lo_); LAS const float* sul = (LAS const float*)(lds + PE_SU + lo_); LAS const float* cel = (LAS const float*)(lds + PE_CE + lo_);
        int xo_ = wave * 256; asm volatile("" : "+v"(xo_));
        LAS const unsigned short* exl = (LAS const unsigned short*)(lds + PE_EX + xo_);
        const bool odd = lane & 1;
        LAS unsigned char* ring = lds + wave * PE_RINGW;
#define ISSUE_U(SL, IDX) do { const int ex_ = __builtin_amdgcn_readfirstlane((int)exl[IDX]); \
            __builtin_amdgcn_global_load_lds((const unsigned*)(PU + (size_t)ex_ * 1024 + lane * 16), (LAS unsigned*)(ring + (SL) * PE_SLOT), 16, 0, 0); } while (0)
#define ISSUE_V(SL, IDX) do { const int ex_ = __builtin_amdgcn_readfirstlane((int)exl[IDX]); \
            __builtin_amdgcn_global_load_lds((const unsigned*)(PV + (size_t)ex_ * 1024 + lane * 16), (LAS unsigned*)(ring + (SL) * PE_SLOT + 1024), 16, 0, 0); } while (0)
#define UDOT(UW, D0, D1, D2, D3) do { _Pragma("unroll") for (int dw = 0; dw < 4; ++dw) { const f32x2 f0_ = fp4_unpk<0>(UW[dw]), f1_ = fp4_unpk<1>(UW[dw]), f2_ = fp4_unpk<2>(UW[dw]), f3_ = fp4_unpk<3>(UW[dw]); \
                D0 += f0_ * hp[4 * dw]; D1 += f1_ * hp[4 * dw + 1]; D2 += f2_ * hp[4 * dw + 2]; D3 += f3_ * hp[4 * dw + 3]; } } while (0)
#define VACC(VW, WG) do { _Pragma("unroll") for (int dw = 0; dw < 4; ++dw) { const f32x2 f0_ = fp4_unpk<0>(VW[dw]), f1_ = fp4_unpk<1>(VW[dw]), f2_ = fp4_unpk<2>(VW[dw]), f3_ = fp4_unpk<3>(VW[dw]); \
                acc[4 * dw] += WG * f0_; acc[4 * dw + 1] += WG * f1_; acc[4 * dw + 2] += WG * f2_; acc[4 * dw + 3] += WG * f3_; } } while (0)
#define STAGE_A(SA, SB, PA, PB) do { const u32x4 ua_ = *(const LAS u32x4*)(ring + (SA) * PE_SLOT + lane * 16), ub_ = *(const LAS u32x4*)(ring + (SB) * PE_SLOT + lane * 16); \
            f32x2 a0_ = {0.f, 0.f}, a1_ = {0.f, 0.f}, a2_ = {0.f, 0.f}, a3_ = {0.f, 0.f}, b0_ = {0.f, 0.f}, b1_ = {0.f, 0.f}, b2_ = {0.f, 0.f}, b3_ = {0.f, 0.f}; \
            UDOT(ua_, a0_, a1_, a2_, a3_); UDOT(ub_, b0_, b1_, b2_, b3_); \
            const f32x2 as_ = (a0_ + a1_) + (a2_ + a3_), bs_ = (b0_ + b1_) + (b2_ + b3_); PA = as_[0] + as_[1]; PB = bs_[0] + bs_[1]; } while (0)
#define STAGE_B(IDX, PA, PB, WA, WB) do { const float cs_ = pair_wave_sum(PA, PB, odd);                           \
            const float wl_ = gtl[IDX] * gelu_tanh(cs_ * sul[IDX] + cel[IDX]);                            \
            WA = dpp_f<0xA0>(wl_); WB = dpp_f<0xF5>(wl_); } while (0)
#define STAGE_C(SA, SB, WA, WB) do { const u32x4 va_ = *(const LAS u32x4*)(ring + (SA) * PE_SLOT + 1024 + lane * 16), vb_ = *(const LAS u32x4*)(ring + (SB) * PE_SLOT + 1024 + lane * 16); \
            VACC(va_, WA); VACC(vb_, WB); } while (0)
#define DMA_WAIT(N) asm volatile("s_waitcnt vmcnt(" #N ")" ::: "memory")
#define LDS_DONE() asm volatile("s_waitcnt lgkmcnt(0)" ::: "memory")
#define PAIR_ITER(P, NS, DOA, UW, DOU, VW, DOV) do { float na_ = 0.f, nb_ = 0.f, wa_, wb_; \
            if (DOA) { DMA_WAIT(UW); STAGE_A(NS, (NS) + 1, na_, nb_); } \
            STAGE_B(e + 2 * (P), pa, pb, wa_, wb_); \
            LDS_DONE(); \
            if (DOU) { ISSUE_U(NS, e + 2 * (P) + 10); ISSUE_U((NS) + 1, e + 2 * (P) + 11); } \
            DMA_WAIT(VW); STAGE_C(2 * (P), 2 * (P) + 1, wa_, wb_); \
            LDS_DONE(); \
            if (DOV) { ISSUE_V(2 * (P), e + 2 * (P) + 8); ISSUE_V(2 * (P) + 1, e + 2 * (P) + 9); } \
            pa = na_; pb = nb_; } while (0)
        float pa, pb;
        if (!DRY) {
        ISSUE_U(0, 0); ISSUE_U(1, 1); ISSUE_U(2, 2); ISSUE_U(3, 3); ISSUE_V(0, 0); ISSUE_V(1, 1); ISSUE_U(4, 4); ISSUE_U(5, 5); ISSUE_V(2, 2); ISSUE_V(3, 3);
        ISSUE_U(6, 6); ISSUE_U(7, 7); ISSUE_V(4, 4); ISSUE_V(5, 5);
        DMA_WAIT(12); STAGE_A(0, 1, pa, pb); LDS_DONE();
        ISSUE_U(0, 8); ISSUE_U(1, 9); ISSUE_V(6, 6); ISSUE_V(7, 7);
#pragma unroll 1
        for (int tr = 0; tr < 14; ++tr) {
            const int e = tr * 8;
            PAIR_ITER(0, 2, true, 14, true, 14, true);
            PAIR_ITER(1, 4, true, 14, true, 14, true);
            PAIR_ITER(2, 6, true, 14, true, 14, true);
            PAIR_ITER(3, 0, true, 14, true, 14, true);
        }
        { const int e = 14 * 8;
            PAIR_ITER(0, 2, true, 14, true, 14, true);
            PAIR_ITER(1, 4, true, 14, true, 14, true);
            PAIR_ITER(2, 6, true, 14, true, 14, true);
            PAIR_ITER(3, 0, true, 14, false, 12, true); }
        { const float* g2 = (const float*)(a.ws + WS_COND) + 5 * 2048; const float* fg = a.in[32];
#pragma unroll
          for (int k = 0; k < 8; ++k) { const int col = 256 * k + lane * 4; gvv[k] = *(const f32x4*)(g2 + col); fvv[k] = *(const f32x4*)(fg + col); } }
        { const int e = 15 * 8;
            PAIR_ITER(0, 2, true, 28, false, 26, false);
            PAIR_ITER(1, 4, true, 24, false, 22, false);
            PAIR_ITER(2, 6, true, 20, false, 18, false);
            PAIR_ITER(3, 0, false, 0, false, 16, false); }
        }
#undef ISSUE_U
#undef ISSUE_V
#undef STAGE_A
#undef STAGE_B
#undef STAGE_C
#undef LDS_DONE
#undef PAIR_ITER
#undef UDOT
#undef VACC
#undef DMA_WAIT
    }
    {
        float* xo = a.out + (size_t)t * 2048;
        float ss = 0.f;
#pragma unroll
        for (int k = 0; k < 8; ++k) {
            const float x1[4] = {bflo(xw[k][0]), bfhi(xw[k][0]), bflo(xw[k][1]), bfhi(xw[k][1])};
#pragma unroll
            for (int e = 0; e < 4; ++e) { const float x2 = x1[e] + PEER_ALPHA * gvv[k][e] * acc[k * 2 + (e >> 1)][e & 1]; acc[k * 2 + (e >> 1)][e & 1] = x2; ss += x2 * x2; }
        }
        ss = wave_sum_bcast(ss);
        const float rstd = rsqrtf(ss * (1.f / 2048.f) + 1e-6f);
#pragma unroll
        for (int k = 0; k < 8; ++k) {
            const int col = 256 * k + lane * 4;
            f32x4 o;
#pragma unroll
            for (int e = 0; e < 4; ++e) o[e] = acc[k * 2 + (e >> 1)][e & 1] * rstd * fvv[k][e];
            if (!DRY || rstd == 123.456f) *(f32x4*)(xo + col) = o;
        }
    }
    __syncthreads();
}
constexpr int NPHASE = 11;
#ifndef DBG
#define DBG 0
#endif
__device__ __forceinline__ void dbg_final_norm(const Args& a, const Ctx& c, const float* src) {
    for (int t = c.bid * 8 + c.wave; t < L_; t += c.nb * 8) {
        const float* xr = src + (size_t)t * 2048 + c.lane * 4; float* o = a.out + (size_t)t * 2048 + c.lane * 4;
        f32x4 v[8]; float ss = 0.f;
#pragma unroll
        for (int j = 0; j < 8; ++j) { v[j] = *(const f32x4*)(xr + j * 256); ss += v[j][0] * v[j][0] + v[j][1] * v[j][1] + v[j][2] * v[j][2] + v[j][3] * v[j][3]; }
        ss = wave_sum(ss);
        const float rstd = rsqrtf(ss * (1.f / 2048.f) + 1e-6f);
#pragma unroll
        for (int j = 0; j < 8; ++j) { const f32x4 g = *(const f32x4*)(a.in[32] + j * 256 + c.lane * 4); *(f32x4*)(o + j * 256) = v[j] * rstd * g; }
    }
}

extern __shared__ __attribute__((aligned(16))) unsigned char smem[];

__global__ void __launch_bounds__(512, 2) fwd(Args a) {
    LAS unsigned char* lds = (LAS unsigned char*)smem;
    Ctx c; c.bid = blockIdx.x; c.nb = gridDim.x; c.tid = threadIdx.x; c.wave = __builtin_amdgcn_readfirstlane(threadIdx.x >> 6); c.lane = threadIdx.x & 63; c.lds = lds;
    volatile LAS unsigned* xbw = (volatile LAS unsigned*)(lds + LDS_BYTES - 16);
    if (c.tid < 4) xbw[c.tid] = 0u;
    __syncthreads();
    const int lo = a.ph_lo, hi = a.ph_hi;
    const bool multi = (hi - lo) > 1;
    XcdBarrier bar; bar.bar = (unsigned*)(a.ws + WS_CTL); bar.x = 0; bar.st = xbw;
    if (multi) bar = xcd_barrier_post((unsigned*)(a.ws + WS_CTL), xbw);
#ifndef PHASE_MASK
#define PHASE_MASK 0xFFFF
#endif
#if DBG == 1
#undef PHASE_MASK
#define PHASE_MASK 0x403
#elif DBG == 2 || DBG == 4 || DBG == 5
#undef PHASE_MASK
#define PHASE_MASK 0x4FF
#endif
#define IN(k) (((PHASE_MASK >> (k)) & 1) && lo <= (k) && (k) < hi)
#define REFRESH() do { int tz_ = threadIdx.x; asm volatile("" : "+v"(tz_)); c.tid = tz_; c.lane = tz_ & 63; c.wave = __builtin_amdgcn_readfirstlane(tz_ >> 6); } while (0)
#define SEAM(k) do { if (IN(k) && IN((k) + 1)) xcd_barrier(bar); } while (0)
#ifndef DUP
#define DUP -1
#endif
#define REP(k) for (int rep_ = 0; rep_ < ((DUP == (k)) ? 2 : 1); ++rep_)
#define DUP2(k, ...) do { __VA_ARGS__; if (DUP == (k)) { __syncthreads(); __VA_ARGS__; } } while (0)

    if (IN(0)) REP(0) { REFRESH(); p0_prologue(a, c); }
    SEAM(0);
    if (IN(1)) { REFRESH(); DUP2(1, p1_hnorm(a, c)); }
    SEAM(1);
    if (IN(2)) { REFRESH();
        pg8::StaticOrder S; S.init((const bf16_t*)(a.ws + WS_H), (const bf16_t*)(a.ws + WS_WIN), 2048, 2048, 2048, L_, DIN_PAD, c.nb, c.bid);
        EpiWin E{(bf16_t*)(a.ws + WS_US), (bf16_t*)(a.ws + WS_Q), (bf16_t*)(a.ws + WS_KROW), (bf16_t*)(a.ws + WS_VROW), (bf16_t*)(a.ws + WS_VT), (float*)(a.ws + WS_GATE)};
        DUP2(2, pg8::gemm_phase<EpiWin, pg8::StaticOrder>(lds, S, E));
        { const int nfull = (L_ / 256) * (DIN_PAD / 256) % c.nb, first = nfull, cnt = c.nb - nfull;
          if (c.bid >= first) { Ctx c2 = c; c2.bid = c.bid - first; c2.nb = cnt;
              conv_fp4rows(a.in[31], a.ws + WS_PV, (float*)(a.ws + WS_PSC) + 2, 16384, c2); } }
    }
    SEAM(2);
    if (IN(3)) { REFRESH();
        DUP2(31, for (int it = c.bid; it < 256; it += c.nb) s5_item<0>(a, c, it >> 2, it & 3));
        __syncthreads();
        CmpOrder S{(const bf16_t*)(a.ws + WS_KROW), (const bf16_t*)(a.ws + WS_VROW), (const bf16_t*)(a.ws + WS_W1), 2048, 4096, 256, c.nb, c.bid};
        EpiSlab E{(float*)(a.ws + WS_SLAB)};
        DUP2(32, pg8::gemm_phase<EpiSlab, CmpOrder>(lds, S, E));
    }
    SEAM(3);
    if (IN(4)) { REFRESH();
        DUP2(41, for (int it = c.bid; it < 256; it += c.nb) cmp_finish_item(a, c, it >> 7, it & 127));
        DUP2(42, for (int it = c.bid; it < 256; it += c.nb) s5_item<1>(a, c, it >> 2, it & 3));
    }
    SEAM(4);
    if (IN(5)) { REFRESH();
#if DBG == 5
        for (size_t i = (size_t)c.bid * NTHREADS + c.tid; i < (size_t)L_ * 1024 / 8; i += (size_t)c.nb * NTHREADS) *(u32x4*)((bf16_t*)(a.ws + WS_YSSM) + i * 8) = (u32x4){0u, 0u, 0u, 0u};
#else
        {
            pg8::StaticOrder S; S.init((const bf16_t*)(a.ws + WS_Z), (const bf16_t*)(a.ws + WS_WGLU), 1024, 1024, 1024, L_, 1024, c.nb, c.bid);
            EpiGlu E{(const bf16_t*)(a.ws + WS_Z), a.in[19], (bf16_t*)(a.ws + WS_Y2), (float*)(a.ws + WS_STSP)};
            DUP2(55, pg8::gemm_phase<EpiGlu, pg8::StaticOrder>(lds, S, E));
        }
#endif
        __syncthreads();
        REP(5)
#if DBG == 4
        for (size_t i = (size_t)c.bid * NTHREADS + c.tid; i < (size_t)L_ * 1024 / 8; i += (size_t)c.nb * NTHREADS) *(u32x4*)((bf16_t*)(a.ws + WS_YATT) + i * 8) = (u32x4){0u, 0u, 0u, 0u};
#else
        {
            unsigned* qhead = (unsigned*)(a.ws + WS_CTL) + 8192;
            volatile LAS unsigned* slot = (volatile LAS unsigned*)(lds + LDS_BYTES - 32);
            for (;;) {
                if (c.tid == 0) *slot = __hip_atomic_fetch_add(qhead, 1u, __ATOMIC_RELAXED, __HIP_MEMORY_SCOPE_AGENT);
                __syncthreads();
                const unsigned q = *slot;
                __syncthreads();
                if (q >= 512u) break;
                attn_item(a, c, 255 - (int)(q >> 1), (int)(q & 1));
            }
        }
#endif
    }
    SEAM(5);
#define WOUT_GEMM(PM0) do { pg8::StaticOrder S; S.init((const bf16_t*)(a.ws + WS_Y2), (const bf16_t*)(a.ws + WS_WOUT), 2048, 2048, 2048, L_ / 2, 2048, c.nb, c.bid, PM0); \
        rsa_prepass(S, (const float*)(a.ws + WS_STSP), (const float*)(a.ws + WS_STAP), (float*)(a.ws + WS_RSA), c.tid); \
        EpiWout E{a.in[0], (const float*)(a.ws + WS_COND) + 2 * 2048, (const float*)(a.ws + WS_F2), (bf16_t*)(a.ws + WS_X1), (bf16_t*)(a.ws + WS_H2), (float*)(a.ws + WS_ST2P), (const float*)(a.ws + WS_RSA)}; \
        pg8::gemm_phase<EpiWout, pg8::StaticOrder>(lds, S, E); __syncthreads(); } while (0)
#define WQ_GEMM(PM0) do { pg8::StaticOrder S; S.init((const bf16_t*)(a.ws + WS_H2), (const bf16_t*)(a.ws + WS_WQ), 2048, 2048, 2048, L_ / 2, 2048, c.nb, c.bid, PM0); \
        rstd2_prepass(S, (const float*)(a.ws + WS_ST2P), (float*)(a.ws + WS_RSTD2), c.tid); \
        EpiQ E{(bf16_t*)(a.ws + WS_QP), (const float*)(a.ws + WS_RSTD2), (const float*)(a.ws + WS_CQ)}; pg8::gemm_phase<EpiQ, pg8::StaticOrder>(lds, S, E); __syncthreads(); } while (0)
#define PEER_STEPS(FIRST, COUNT) do { for (int s_ = (FIRST) + c.bid; s_ < (FIRST) + (COUNT); s_ += c.nb) peer_step<false>(a, c, s_ * 8); } while (0)
    if (IN(6)) { REFRESH(); DUP2(7, p_cqce(a, c)); DUP2(71, WOUT_GEMM(0)); }
    SEAM(6);
    if (IN(7)) { REFRESH(); DUP2(8, WQ_GEMM(0)); }
    SEAM(7);
    if (IN(8)) { REFRESH();
        if ((c.bid >> 3) & 1) PEER_STEPS(0, 512);
        WOUT_GEMM(32);
        if (!((c.bid >> 3) & 1)) PEER_STEPS(0, 512); }
    SEAM(8);
    if (IN(9)) { REFRESH();
        if ((c.bid >> 3) & 1) PEER_STEPS(512, 512);
        WQ_GEMM(32);
        if (!((c.bid >> 3) & 1)) PEER_STEPS(512, 512); }
    SEAM(9);
#if defined(PROBE_DRY)
    if (IN(10)) { REFRESH(); for (int s_ = 1024 + c.bid; s_ < 2048; s_ += c.nb) peer_step<true>(a, c, s_ * 8); __syncthreads(); PEER_STEPS(1024, 1024); }
#else
    if (IN(10)) { REFRESH(); DUP2(11, PEER_STEPS(1024, 1024)); }
#endif
#undef WOUT_GEMM
#undef WQ_GEMM
#undef PEER_STEPS
#undef IN
#undef SEAM
}

#ifndef N_LAUNCHES
#define N_LAUNCHES 1
#endif
extern "C" void kernel_launch(void* const* d_in, const int* in_sizes, int n_in, void* d_out, int out_size, void* d_ws, size_t ws_size, hipStream_t stream) {
    static int grid = 0;
    if (grid == 0) {
        if (n_in != 33 || out_size != L_ * D_ || ws_size < WS_END) { fprintf(stderr, "kernel_launch: unexpected shapes (n_in %d, out %d, ws %zu < %zu); nothing launched\n", n_in, out_size, ws_size, (size_t)WS_END); grid = -1; return; }
        int dev = 0, cus = 0, per_cu = 0;
        if (hipGetDevice(&dev) != hipSuccess || hipDeviceGetAttribute(&cus, hipDeviceAttributeMultiprocessorCount, dev) != hipSuccess) { grid = -1; return; }
        if (hipFuncSetAttribute((const void*)fwd, hipFuncAttributeMaxDynamicSharedMemorySize, LDS_BYTES) != hipSuccess) { fprintf(stderr, "kernel_launch: hipFuncSetAttribute failed\n"); grid = -1; return; }
        if (hipOccupancyMaxActiveBlocksPerMultiprocessor(&per_cu, (const void*)fwd, NTHREADS, LDS_BYTES) != hipSuccess || per_cu < 1) { fprintf(stderr, "kernel_launch: occupancy query says %d\n", per_cu); (void)hipGetLastError(); grid = -1; return; }
        grid = cus;
    }
    if (grid < 0) return;
    (void)hipMemsetAsync((char*)d_ws + WS_CTL, 0, CTL_BYTES, stream);
    Args a{};
    for (int i = 0; i < 33; ++i) a.in[i] = (const float*)d_in[i];
    a.out = (float*)d_out; a.ws = (unsigned char*)d_ws;
    if (N_LAUNCHES == 1) { a.ph_lo = 0; a.ph_hi = NPHASE; hipLaunchKernelGGL(fwd, dim3(grid), dim3(NTHREADS), LDS_BYTES, stream, a); }
    else for (int p = 0; p < NPHASE; ++p) { a.ph_lo = p; a.ph_hi = p + 1; hipLaunchKernelGGL(fwd, dim3(grid), dim3(NTHREADS), LDS_BYTES, stream, a); }
}
```

```cpp
#include <hip/hip_runtime.h>
#include <stdint.h>
#include <stdio.h>

#define LAS __attribute__((address_space(3)))
typedef unsigned short bf16_t;
typedef short bf16x8 __attribute__((ext_vector_type(8)));
typedef float f32x2 __attribute__((ext_vector_type(2)));
typedef float f32x4 __attribute__((ext_vector_type(4)));
typedef float f32x16 __attribute__((ext_vector_type(16)));
typedef unsigned u32x2 __attribute__((ext_vector_type(2)));
typedef unsigned u32x4 __attribute__((ext_vector_type(4)));
typedef __bf16 bfv2 __attribute__((ext_vector_type(2)));
typedef unsigned u32x6 __attribute__((ext_vector_type(6)));
typedef float f32x32 __attribute__((ext_vector_type(32)));

constexpr int L_ = 16384, D_ = 2048, DSSM = 1024, DATT = 1024, DIN = 3608, DIN_PAD = 3840;
constexpr int NADA = 12288;
constexpr float LOG2E = 1.4426950408889634f;
constexpr float QSCALE = 0.08838834764831845f * 1.4426950408889634f;
constexpr int TBN = 800;
constexpr int NTHREADS = 512;
constexpr int LDS_BYTES = 163840;

constexpr size_t al256(size_t x) { return (x + 255) & ~(size_t)255; }
constexpr size_t WS_CTL   = 0;                                  constexpr size_t CTL_BYTES = 65536;
constexpr size_t WS_CONDP = WS_CTL + CTL_BYTES;
constexpr size_t WS_COND  = WS_CONDP + 32 * 12288 * 4;
constexpr size_t WS_TB    = WS_COND + 12288 * 4;
constexpr size_t WS_BPE   = al256(WS_TB + 8 * TBN * 4);
constexpr size_t WS_S5P   = al256(WS_BPE + 2 * 256 * 4);
constexpr size_t WS_S5F   = WS_S5P + 2 * 64 * 64 * 2 * 4;
constexpr size_t WS_S5MT  = WS_S5F + 64 * 4 * 128 * 4;
constexpr size_t WS_S5WE  = WS_S5MT + (size_t)64 * 256 * 256 * 2;
constexpr size_t WS_S5WC  = WS_S5WE + (size_t)64 * 128 * 256 * 2;
constexpr size_t WS_WIN   = WS_S5WC + (size_t)64 * 256 * 128 * 2;
constexpr size_t WS_WGLU  = WS_WIN + (size_t)DIN_PAD * 2048 * 2;
constexpr size_t WS_WOUT  = WS_WGLU + (size_t)1024 * 1024 * 2;
constexpr size_t WS_WQ    = WS_WOUT + (size_t)2048 * 2048 * 2;
constexpr size_t WS_W1    = WS_WQ + (size_t)2048 * 2048 * 2;
constexpr size_t WS_W2    = WS_W1 + (size_t)2 * 256 * 4096 * 2;
constexpr size_t WS_PK    = WS_W2 + (size_t)2 * 128 * 256 * 2;
constexpr size_t WS_PU    = WS_PK + (size_t)2 * 128 * 128 * 2;
constexpr size_t WS_PV    = WS_PU + (size_t)16384 * 1024;
constexpr size_t WS_PSC   = WS_PV + (size_t)16384 * 1024;
constexpr size_t WS_BPEP  = WS_PSC + (size_t)4 * 16384 * 4;
constexpr size_t WS_H     = WS_BPEP + (size_t)32 * 2 * 256 * 4;
constexpr size_t WS_US    = WS_H + (size_t)16384 * 2048 * 2;
constexpr size_t WS_Q     = WS_US + (size_t)16384 * 1024 * 2;
constexpr size_t WS_QP    = WS_US;
constexpr size_t WS_KROW  = WS_Q + (size_t)16384 * 1024 * 2;
constexpr size_t WS_VROW  = WS_KROW + (size_t)6 * 16384 * 128 * 2;
constexpr size_t WS_VT    = WS_VROW + (size_t)2 * 16384 * 128 * 2 + 8192;
constexpr size_t WS_GATE  = WS_VT + (size_t)4 * 128 * 16384 * 2;
constexpr size_t WS_SLAB  = WS_GATE + (size_t)16384 * 24 * 4;
constexpr size_t WS_KC    = WS_SLAB + (size_t)2 * 16 * 2048 * 256 * 4;
constexpr size_t WS_VCT   = WS_KC + (size_t)2 * 1024 * 128 * 2;
constexpr size_t WS_Z     = WS_VCT + (size_t)2 * 128 * 1024 * 2;
constexpr size_t WS_YSSM  = WS_Z + (size_t)16384 * 1024 * 2;
constexpr size_t WS_YATT  = WS_YSSM + (size_t)16384 * 1024 * 2;
constexpr size_t WS_H2    = WS_SLAB;
constexpr size_t WS_Y2    = WS_YSSM;
constexpr size_t WS_X1    = WS_H;
constexpr size_t WS_ST2P  = WS_YATT + (size_t)16384 * 1024 * 2;
constexpr size_t WS_RSTD2 = WS_ST2P + (size_t)16384 * 32 * 4;
constexpr size_t WS_F2    = WS_RSTD2 + (size_t)16384 * 4;
constexpr size_t WS_CQ    = WS_F2 + 2048 * 4;
constexpr size_t WS_STSP  = WS_CQ + 2048 * 4;
constexpr size_t WS_STAP  = WS_STSP + (size_t)16384 * 16 * 4;
constexpr size_t WS_RSA   = WS_STAP + (size_t)16384 * 2 * 4;
constexpr size_t WS_END   = WS_RSA + (size_t)16384 * 2 * 4;
static_assert(WS_END < (size_t)530 * 1024 * 1024, "workspace map too large");

struct Args { const float* in[33]; float* out; unsigned char* ws; int ph_lo, ph_hi; };

__device__ __forceinline__ unsigned cvt_pk_bf16(float lo, float hi) { bfv2 v; v[0] = (__bf16)lo; v[1] = (__bf16)hi; return __builtin_bit_cast(unsigned, v); }
__device__ __forceinline__ bf16_t f2bf(float f) { return (bf16_t)(cvt_pk_bf16(f, 0.f) & 0xffffu); }
__device__ __forceinline__ float bf2f(unsigned b) { return __uint_as_float(b << 16); }
__device__ __forceinline__ float bflo(unsigned w) { return __uint_as_float(w << 16); }
__device__ __forceinline__ float bfhi(unsigned w) { return __uint_as_float(w & 0xffff0000u); }
__device__ __forceinline__ float fexp2(float x) { return __builtin_amdgcn_exp2f(x); }
__device__ __forceinline__ float frcp(float x) { return __builtin_amdgcn_rcpf(x); }
__device__ __forceinline__ float sigmoidf_(float x) { return frcp(1.f + fexp2(-LOG2E * x)); }
__device__ __forceinline__ float gelu_tanh(float x) {
    const float u = x * (1.f + 0.044715f * x * x);
    return x * frcp(1.f + fexp2(-2.f * 0.7978845608028654f * LOG2E * u));
}
__device__ __forceinline__ float shfl_xor_f(float v, int m) { return __shfl_xor(v, m, 64); }
__device__ __forceinline__ float wave_sum(float v) {
#pragma unroll
    for (int m = 32; m >= 1; m >>= 1) v += __shfl_xor(v, m, 64);
    return v;
}
__device__ __forceinline__ float wave_max(float v) {
#pragma unroll
    for (int m = 32; m >= 1; m >>= 1) v = fmaxf(v, __shfl_xor(v, m, 64));
    return v;
}
template <int CTRL> __device__ __forceinline__ float dpp_f(float x) { return __int_as_float(__builtin_amdgcn_update_dpp(0, __float_as_int(x), CTRL, 0xf, 0xf, false)); }
__device__ __forceinline__ float wave_max_bcast(float v) {
    v = fmaxf(v, dpp_f<0xB1>(v)); v = fmaxf(v, dpp_f<0x4E>(v)); v = fmaxf(v, dpp_f<0x141>(v)); v = fmaxf(v, dpp_f<0x140>(v));
    v = fmaxf(v, __int_as_float(__builtin_amdgcn_update_dpp(__float_as_int(v), __float_as_int(v), 0x142, 0xa, 0xf, false)));
    v = fmaxf(v, __int_as_float(__builtin_amdgcn_update_dpp(__float_as_int(v), __float_as_int(v), 0x143, 0xc, 0xf, false)));
    return __int_as_float(__builtin_amdgcn_readlane(__float_as_int(v), 63));
}
__device__ __forceinline__ unsigned wave_umax_bcast(unsigned v) {
#define UDPP_(x, ctrl, rm) (unsigned)__builtin_amdgcn_update_dpp((int)(x), (int)(x), ctrl, rm, 0xf, false)
    v = max(v, UDPP_(v, 0xB1, 0xf)); v = max(v, UDPP_(v, 0x4E, 0xf)); v = max(v, UDPP_(v, 0x141, 0xf)); v = max(v, UDPP_(v, 0x140, 0xf));
    v = max(v, UDPP_(v, 0x142, 0xa)); v = max(v, UDPP_(v, 0x143, 0xc));
#undef UDPP_
    return (unsigned)__builtin_amdgcn_readlane((int)v, 63);
}
__device__ __forceinline__ float quad_sum(float x) { x += dpp_f<0xB1>(x); x += dpp_f<0x4E>(x); return x; }
template <int SEL> __device__ __forceinline__ f32x2 fp4_unpk(unsigned w) { return __builtin_amdgcn_cvt_scalef32_pk_f32_fp4(w, 1.0f, SEL); }
template <int SEL> __device__ __forceinline__ unsigned fp4_pk(unsigned w, float a, float b) { return __builtin_amdgcn_cvt_scalef32_pk_fp4_f32(w, a, b, 1.0f, SEL); }
__device__ __forceinline__ f32x4 mfma16(bf16x8 a, bf16x8 b, f32x4 c) { return __builtin_amdgcn_mfma_f32_16x16x32_bf16(a, b, c, 0, 0, 0); }
__device__ __forceinline__ f32x16 mfma32(bf16x8 a, bf16x8 b, f32x16 c) { return __builtin_amdgcn_mfma_f32_32x32x16_bf16(a, b, c, 0, 0, 0); }
#define XB_TMO      128
#define XB_XCNT(j)  (256  + 64 * (j))
#define XB_XSUB(j)  (1280 + 64 * (j))
#define XB_XGEN(j)  (2304 + 64 * (j))
#define XB_TOP      3328
#define XB_TOPGEN   3392
#define XCD_BAR_WORDS 3456
#define XB_SPIN_CAP (1u << 18)

__device__ __forceinline__ unsigned xb_ld(unsigned* p)              { return __hip_atomic_load(p, __ATOMIC_RELAXED, __HIP_MEMORY_SCOPE_AGENT); }
__device__ __forceinline__ unsigned xb_add(unsigned* p, unsigned v) { return __hip_atomic_fetch_add(p, v, __ATOMIC_RELAXED, __HIP_MEMORY_SCOPE_AGENT); }
__device__ __forceinline__ unsigned xb_xcc_id() { return (unsigned)__builtin_amdgcn_s_getreg((3 << 11) | 20) & 0xFu; }
#define XB_SPIN(cond, bar) do { unsigned _sp = 0; while (cond) { __builtin_amdgcn_s_sleep(1); \
    if ((++_sp & 255u) == 0u) { if (xb_ld(&(bar)[XB_TMO])) break; if (_sp > XB_SPIN_CAP) { atomicAdd(&(bar)[XB_TMO], 1u); break; } } } } while (0)

struct XcdBarrier {
    unsigned* bar; unsigned x;
    volatile LAS unsigned* st;
};
__device__ __forceinline__ XcdBarrier xcd_barrier_post(unsigned* bar, volatile LAS unsigned* st) {
    XcdBarrier b; b.bar = bar; b.x = xb_xcc_id(); b.st = st;
    if (threadIdx.x == 0) (void)xb_add(&bar[XB_XCNT(b.x)], 1u);
    return b;
}
__device__ __forceinline__ void xcd_barrier_complete(unsigned* bar, unsigned x, unsigned& nloc, unsigned& nx) {
    const unsigned G = gridDim.x * gridDim.y * gridDim.z;
    unsigned sum, cnt, mine, sp = 0u;
    for (;;) {
        sum = 0u; cnt = 0u; mine = 0u;
#pragma unroll
        for (unsigned j = 0; j < 16; ++j) { const unsigned c = xb_ld(&bar[XB_XCNT(j)]); sum += c; cnt += (c > 0u) ? 1u : 0u; mine = (j == x) ? c : mine; }
        if (sum == G) break;
        __builtin_amdgcn_s_sleep(1);
        if ((++sp & 255u) == 0u) { if (xb_ld(&bar[XB_TMO])) break; if (sp > XB_SPIN_CAP) { atomicAdd(&bar[XB_TMO], 1u); break; } }
    }
    nloc = mine > 0u ? mine : 1u; nx = cnt > 0u ? cnt : 1u;
}
__device__ __forceinline__ void xcd_barrier(const XcdBarrier& b) {
    asm volatile("s_waitcnt vmcnt(0)" ::: "memory");
    __syncthreads();
    if (threadIdx.x == 0) {
        unsigned* bar = b.bar;
        __builtin_amdgcn_s_waitcnt(0);
        unsigned nloc = b.st[0], nx = b.st[1];
        if (nloc == 0u) { xcd_barrier_complete(bar, b.x, nloc, nx); b.st[0] = nloc; b.st[1] = nx; }
        const unsigned old = xb_add(&bar[XB_XSUB(b.x)], 1u);
        const unsigned gen = old / nloc;
        if (old + 1u == (gen + 1u) * nloc) {
            __builtin_amdgcn_fence(__ATOMIC_RELEASE, "agent");
            asm volatile("s_waitcnt vmcnt(0)" ::: "memory");
            const unsigned og = xb_add(&bar[XB_TOP], 1u);
            const unsigned tg = og / nx;
            if (og + 1u == (tg + 1u) * nx) xb_add(&bar[XB_TOPGEN], 1u);
            else XB_SPIN(xb_ld(&bar[XB_TOPGEN]) == tg, bar);
            __builtin_amdgcn_fence(__ATOMIC_ACQUIRE, "agent");
            xb_add(&bar[XB_XGEN(b.x)], 1u);
            asm volatile("s_waitcnt vmcnt(0)" ::: "memory");
        } else {
            XB_SPIN(xb_ld(&bar[XB_XGEN(b.x)]) == gen, bar);
            __builtin_amdgcn_fence(__ATOMIC_ACQUIRE, "agent");
            asm volatile("s_waitcnt vmcnt(0)" ::: "memory");
        }
    }
    __syncthreads();
}

namespace pg8 {
constexpr int BM = 256, BK = 64, HALF = 128, HTB = HALF * BK * 2, STAGE_BYTES = 8 * HTB, NXCD = 8, WGM = 8;
__host__ __device__ __forceinline__ int lds_byte(int r, int c) { const int st = (r >> 4) * 2 + (c >> 5), rr = r & 15, cc = c & 31, ob = rr * 64 + cc * 2; return st * 1024 + (ob ^ (((ob >> 9) & 1) << 5)); }
__host__ __device__ __forceinline__ void stage_rc(int b, int& R, int& C) { const int st = b / 1024, sb = b % 1024, swz = sb ^ (((sb >> 9) & 1) << 5); R = (st >> 1) * 16 + swz / 64; C = (st & 1) * 32 + (swz % 64) / 2; }
__host__ __device__ __forceinline__ int perm32(int rho) { const int n = rho >> 4, i = rho & 15; return 8 * (i >> 2) + 4 * n + (i & 3); }

struct Unit { int pm, pn, z; };
struct StaticOrder {
    const bf16_t* A; const bf16_t* Bt; int lda, ldb, K;
    int nM, nN, nwg, G, c, pm0;
    __device__ void init(const bf16_t* A_, const bf16_t* Bt_, int lda_, int ldb_, int K_, int M, int N, int G_, int c_, int pm0_ = 0) { A = A_; Bt = Bt_; lda = lda_; ldb = ldb_; K = K_; nM = M / BM; nN = N / BM; nwg = nM * nN; G = G_; c = c_; pm0 = pm0_; }
    __device__ bool next(int i, Unit& u) const {
        const long Lx = (long)i * G + c; if (Lx >= nwg) return false;
        int wgid = (int)Lx; { const int q = nwg / NXCD, r = nwg % NXCD, xcd = wgid % NXCD, off = wgid / NXCD; wgid = (xcd < r ? xcd * (q + 1) : r * (q + 1) + (xcd - r) * q) + off; }
        const int nig = WGM * nN, gid = wgid / nig, fm = gid * WGM, gsz = (nM - fm) < WGM ? (nM - fm) : WGM;
        u.pm = pm0 + fm + ((wgid % nig) % gsz); u.pn = (wgid % nig) / gsz; u.z = 0; return true;
    }
    __device__ __forceinline__ const char* a_base(const Unit& u) const { return (const char*)(A + (size_t)u.pm * BM * lda); }
    __device__ __forceinline__ const char* b_base(const Unit& u) const { return (const char*)(Bt + (size_t)u.pn * BM * ldb); }
};

template <class Epi, class Sched>
__device__ __forceinline__ void gemm_phase(LAS unsigned char* lds, const Sched& S, const Epi& E) {
    const int tid = threadIdx.x, wid = __builtin_amdgcn_readfirstlane(tid >> 6), lane = tid & 63, wr = wid >> 2, wc = wid & 3, fr = lane & 15, fq = lane >> 4;
    const int K = S.K, nt = K / BK, lda = S.lda, ldb = S.ldb;
    unsigned voffA[2], voffB[2];
#pragma unroll
    for (int i = 0; i < 2; ++i) { int R, C; stage_rc(tid * 16 + i * 8192, R, C); const int Rb = Epi::PERM ? ((R & ~31) + perm32(R & 31)) : R;
        voffA[i] = (unsigned)(R * lda + C) * 2u; voffB[i] = (unsigned)(Rb * ldb + C) * 2u; }
    const size_t kstep = (size_t)(BK * 2);
    const size_t hstepA = (size_t)HALF * lda * 2, hstepB = (size_t)HALF * ldb * 2;
    const unsigned ldsw = (unsigned)wid * 1024u;
    const int aoff = lds_byte(wr * 64 + fr, fq * 8), boff = lds_byte(wc * 32 + fr, fq * 8);
#define PG8_SA(b, h) (((b) * 2 + (h)) * HTB)
#define PG8_SB(b, h) ((4 + (b) * 2 + (h)) * HTB)
#define PG8_STAGE(bufoff, gbase, voff) do { _Pragma("unroll") for (int _i = 0; _i < 2; ++_i) \
        __builtin_amdgcn_global_load_lds((const unsigned*)((const char*)(gbase) + (voff)[_i]), (LAS unsigned*)(lds + (bufoff) + ldsw + _i * 8192), 16, 0, 0); } while (0)
#define PG8_LDA(dst, b, h) do { _Pragma("unroll") for (int m = 0; m < 4; ++m) _Pragma("unroll") for (int k = 0; k < 2; ++k) dst[m][k] = *(const LAS bf16x8*)(lds + PG8_SA(b, h) + aoff + m * 2048 + k * 1024); } while (0)
#define PG8_LDB(dst, b, h) do { _Pragma("unroll") for (int n = 0; n < 2; ++n) _Pragma("unroll") for (int k = 0; k < 2; ++k) dst[n][k] = *(const LAS bf16x8*)(lds + PG8_SB(b, h) + boff + n * 2048 + k * 1024); } while (0)
#define PG8_MMA(ai, bj, At, Bt) do { __builtin_amdgcn_s_setprio(1); _Pragma("unroll") for (int m = 0; m < 4; ++m) _Pragma("unroll") for (int n = 0; n < 2; ++n) _Pragma("unroll") for (int k = 0; k < 2; ++k) \
        acc[ai][bj][m][n] = __builtin_amdgcn_mfma_f32_16x16x32_bf16(Bt[n][k], At[m][k], acc[ai][bj][m][n], 0, 0, 0); __builtin_amdgcn_s_setprio(0); } while (0)
#define PG8_WAIT_V(n) asm volatile("s_waitcnt vmcnt(" #n ")" ::: "memory")
#define PG8_WAIT_L(n) asm volatile("s_waitcnt lgkmcnt(" #n ")" ::: "memory")
#define PG8_BAR __builtin_amdgcn_s_barrier()
#define PG8_SCHED __builtin_amdgcn_sched_barrier(0)
    Unit cur, nxt; int ui = 0;
    if (!S.next(0, cur)) return;
    f32x4 acc[2][2][4][2];
#pragma unroll
    for (int a = 0; a < 2; ++a)
#pragma unroll
        for (int b = 0; b < 2; ++b)
#pragma unroll
            for (int m = 0; m < 4; ++m)
#pragma unroll
                for (int n = 0; n < 2; ++n) acc[a][b][m][n] = (f32x4){0.f, 0.f, 0.f, 0.f};
    bf16x8 At[4][2], B0[2][2], B1[2][2];
    const char* cA = S.a_base(cur); const char* cB = S.b_base(cur);
    PG8_STAGE(PG8_SB(0, 0), cB, voffB); PG8_STAGE(PG8_SA(0, 0), cA, voffA); PG8_STAGE(PG8_SB(0, 1), cB + hstepB, voffB); PG8_STAGE(PG8_SA(0, 1), cA + hstepA, voffA);
    if (wr == 1) PG8_BAR;
    PG8_WAIT_V(4); PG8_BAR;
    PG8_STAGE(PG8_SB(1, 0), cB + kstep, voffB); PG8_STAGE(PG8_SA(1, 0), cA + kstep, voffA); PG8_STAGE(PG8_SB(1, 1), cB + hstepB + kstep, voffB);
    PG8_WAIT_V(6); PG8_BAR;
    for (;;) {
        const bool has_next = S.next(ui + 1, nxt);
        const char* nA = has_next ? S.a_base(nxt) : cA; const char* nB = has_next ? S.b_base(nxt) : cB;
        for (int t = 0; t < nt; t += 2) {
            if constexpr (Epi::MIDK) { if (t == (nt >> 1)) E.midk(acc, cur, wr, fr); }
            const bool last = (t == nt - 2);
            const char* a1 = cA + (size_t)(t + 1) * kstep;
            const char* a2 = last ? nA : cA + (size_t)(t + 2) * kstep; const char* b2 = last ? nB : cB + (size_t)(t + 2) * kstep;
            const char* a3 = a2 + kstep; const char* b3 = b2 + kstep;
            PG8_LDB(B0, 0, 0); PG8_SCHED; PG8_LDA(At, 0, 0); PG8_STAGE(PG8_SA(1, 1), a1 + hstepA, voffA);
            PG8_WAIT_L(8); PG8_BAR; PG8_WAIT_L(0); PG8_MMA(0, 0, At, B0); PG8_BAR; PG8_SCHED;
            PG8_LDB(B1, 0, 1); PG8_STAGE(PG8_SB(0, 0), b2, voffB);
            PG8_BAR; PG8_WAIT_L(0); PG8_MMA(0, 1, At, B1); PG8_BAR;
            PG8_LDA(At, 0, 1); PG8_STAGE(PG8_SA(0, 0), a2, voffA);
            PG8_BAR; PG8_WAIT_L(0); PG8_MMA(1, 0, At, B0); PG8_BAR; PG8_SCHED;
            PG8_STAGE(PG8_SB(0, 1), b2 + hstepB, voffB);
            PG8_WAIT_V(6); PG8_BAR; PG8_MMA(1, 1, At, B1); PG8_BAR;
            PG8_LDB(B0, 1, 0); PG8_SCHED; PG8_LDA(At, 1, 0); PG8_STAGE(PG8_SA(0, 1), a2 + hstepA, voffA);
            PG8_WAIT_L(8); PG8_BAR; PG8_WAIT_L(0); PG8_MMA(0, 0, At, B0); PG8_BAR; PG8_SCHED;
            PG8_LDB(B1, 1, 1); PG8_STAGE(PG8_SB(1, 0), b3, voffB);
            PG8_BAR; PG8_WAIT_L(0); PG8_MMA(0, 1, At, B1); PG8_BAR;
            PG8_LDA(At, 1, 1); PG8_STAGE(PG8_SA(1, 0), a3, voffA);
            PG8_BAR; PG8_WAIT_L(0); PG8_MMA(1, 0, At, B0); PG8_BAR; PG8_SCHED;
            PG8_STAGE(PG8_SB(1, 1), b3 + hstepB, voffB);
            PG8_WAIT_V(6); PG8_BAR; PG8_MMA(1, 1, At, B1); PG8_BAR;
        }
        E(acc, cur, wr, wc, fr, fq);
        if (!has_next) break;
#pragma unroll
        for (int a = 0; a < 2; ++a)
#pragma unroll
            for (int b = 0; b < 2; ++b)
#pragma unroll
                for (int m = 0; m < 4; ++m)
#pragma unroll
                    for (int n = 0; n < 2; ++n) acc[a][b][m][n] = (f32x4){0.f, 0.f, 0.f, 0.f};
        cur = nxt; cA = nA; cB = nB; ++ui;
    }
    PG8_WAIT_V(0);
    if (wr == 0) PG8_BAR;
    PG8_BAR;
#undef PG8_SA
#undef PG8_SB
#undef PG8_STAGE
#undef PG8_LDA
#undef PG8_LDB
#undef PG8_MMA
#undef PG8_WAIT_V
#undef PG8_WAIT_L
#undef PG8_BAR
#undef PG8_SCHED
}
}
using pg8::Unit;
__device__ __forceinline__ u32x4 pack8(const f32x4& v0, const f32x4& v1) {
    u32x4 o; o[0] = cvt_pk_bf16(v0[0], v0[1]); o[1] = cvt_pk_bf16(v0[2], v0[3]); o[2] = cvt_pk_bf16(v1[0], v1[1]); o[3] = cvt_pk_bf16(v1[2], v1[3]); return o;
}
struct EpiWin {
    static constexpr bool PERM = true; static constexpr bool MIDK = false;
    bf16_t* US; bf16_t* Q; bf16_t* KROW; bf16_t* VROW; bf16_t* VT; float* GATE;
    __device__ __forceinline__ void operator()(const f32x4 (&acc)[2][2][4][2], const Unit& u, int wr, int wc, int fr, int fq) const {
        const int row0 = u.pm * 256 + wr * 64 + fr; const int pn = u.pn;
#pragma unroll
        for (int ai = 0; ai < 2; ++ai)
#pragma unroll
            for (int m = 0; m < 4; ++m) {
                const int row = row0 + ai * 128 + m * 16;
#pragma unroll
                for (int bj = 0; bj < 2; ++bj) {
                    const f32x4 v0 = acc[ai][bj][m][0], v1 = acc[ai][bj][m][1];
                    const int cin = bj * 128 + wc * 32 + 8 * fq;
                    if (pn < 4) { *(u32x4*)(US + (size_t)row * 1024 + pn * 256 + cin) = pack8(v0, v1); }
                    else if (pn < 8) { *(u32x4*)(Q + (size_t)row * 1024 + (pn - 4) * 256 + cin) = pack8(v0 * QSCALE, v1 * QSCALE); }
                    else if (pn < 14) {
                        const int kvi = pn - 8, branch = kvi >> 1, kvsel = kvi & 1, g = bj, d0 = wc * 32 + 8 * fq;
                        if (kvsel == 0) { *(u32x4*)(KROW + ((size_t)(branch * 2 + g) * L_ + row) * 128 + d0) = pack8(v0, v1); }
                        else if (branch == 0) { *(u32x4*)(VROW + ((size_t)g * L_ + row) * 128 + d0) = pack8(v0, v1); }
                        else {
                            const int prow = ((row & ~12) | ((row & 4) << 1) | ((row & 8) >> 1));
                            bf16_t* vt = VT + ((size_t)((branch - 1) * 2 + g) * 128 + d0) * L_ + prow;
#pragma unroll
                            for (int e = 0; e < 4; ++e) { vt[(size_t)e * L_] = f2bf(v0[e]); vt[(size_t)(e + 4) * L_] = f2bf(v1[e]); }
                        }
                    } else {
                        if (cin < 24) {
                            float* gp = GATE + (size_t)row * 24 + cin;
                            f32x4 s0, s1;
#pragma unroll
                            for (int e = 0; e < 4; ++e) { s0[e] = sigmoidf_(v0[e]); s1[e] = sigmoidf_(v1[e]); }
                            *(f32x4*)gp = s0; *(f32x4*)(gp + 4) = s1;
                        }
                    }
                }
            }
    }
};
struct EpiGlu {
    static constexpr bool PERM = true; static constexpr bool MIDK = false;
    const bf16_t* Z; const float* bglu; bf16_t* Y; float* stsp;
    __device__ __forceinline__ void operator()(const f32x4 (&acc)[2][2][4][2], const Unit& u, int wr, int wc, int fr, int fq) const {
        const int row0 = u.pm * 256 + wr * 64 + fr;
        float ss[2][4];
#pragma unroll
        for (int ai = 0; ai < 2; ++ai)
#pragma unroll
            for (int m = 0; m < 4; ++m) ss[ai][m] = 0.f;
#pragma unroll
        for (int bj = 0; bj < 2; ++bj) {
            const int col = u.pn * 256 + bj * 128 + wc * 32 + 8 * fq;
            const f32x4 b0 = *(const f32x4*)(bglu + col), b1 = *(const f32x4*)(bglu + col + 4);
#pragma unroll
            for (int ai = 0; ai < 2; ++ai)
#pragma unroll
                for (int m = 0; m < 4; ++m) {
                    const int row = row0 + ai * 128 + m * 16;
                    const u32x4 zz = *(const u32x4*)(Z + (size_t)row * 1024 + col);
                    const f32x4 v0 = acc[ai][bj][m][0] + b0, v1 = acc[ai][bj][m][1] + b1;
                    f32x4 o0, o1;
                    o0[0] = bflo(zz[0]) * sigmoidf_(v0[0]); o0[1] = bfhi(zz[0]) * sigmoidf_(v0[1]); o0[2] = bflo(zz[1]) * sigmoidf_(v0[2]); o0[3] = bfhi(zz[1]) * sigmoidf_(v0[3]);
                    o1[0] = bflo(zz[2]) * sigmoidf_(v1[0]); o1[1] = bfhi(zz[2]) * sigmoidf_(v1[1]); o1[2] = bflo(zz[3]) * sigmoidf_(v1[2]); o1[3] = bfhi(zz[3]) * sigmoidf_(v1[3]);
                    *(u32x4*)(Y + (size_t)row * 2048 + col) = pack8(o0, o1);
                    ss[ai][m] += (o0[0] * o0[0] + o0[1] * o0[1]) + (o0[2] * o0[2] + o0[3] * o0[3]) + (o1[0] * o1[0] + o1[1] * o1[1]) + (o1[2] * o1[2] + o1[3] * o1[3]);
                }
        }
#pragma unroll
        for (int ai = 0; ai < 2; ++ai)
#pragma unroll
            for (int m = 0; m < 4; ++m) {
                float s = ss[ai][m];
                s += __shfl_xor(s, 16); s += __shfl_xor(s, 32);
                if (fq == 0) stsp[(size_t)(row0 + ai * 128 + m * 16) * 16 + u.pn * 4 + wc] = s;
            }
    }
};
struct EpiWout {
    static constexpr bool PERM = true; static constexpr bool MIDK = true;
    const float* X; const float* g1; const float* f2; bf16_t* X1; bf16_t* A2; float* st2p; const float* rsa;
    __device__ __forceinline__ void midk(f32x4 (&acc)[2][2][4][2], const Unit& u, int, int) const {
        int tz = threadIdx.x; asm volatile("" : "+v"(tz));
        const int row0 = u.pm * 256 + ((tz >> 8) & 1) * 64 + (tz & 15);
#pragma unroll
        for (int ai = 0; ai < 2; ++ai)
#pragma unroll
            for (int m = 0; m < 4; ++m) {
                const float r = rsa[(size_t)(row0 + ai * 128 + m * 16) * 2];
#pragma unroll
                for (int bj = 0; bj < 2; ++bj)
#pragma unroll
                    for (int n = 0; n < 2; ++n) acc[ai][bj][m][n] *= r;
            }
    }
    __device__ __forceinline__ void operator()(const f32x4 (&acc)[2][2][4][2], const Unit& u, int, int, int, int) const {
        int tz = threadIdx.x; asm volatile("" : "+v"(tz));
        const int wr = (tz >> 8) & 1, wc = (tz >> 6) & 3, fr = tz & 15, fq = (tz >> 4) & 3;
        const int row0 = u.pm * 256 + wr * 64 + fr, col0 = u.pn * 256 + wc * 32 + 8 * fq;
        float ss[2][4], ra[2][4];
#pragma unroll
        for (int ai = 0; ai < 2; ++ai)
#pragma unroll
            for (int m = 0; m < 4; ++m) { ss[ai][m] = 0.f; ra[ai][m] = rsa[(size_t)(row0 + ai * 128 + m * 16) * 2 + 1]; }
#pragma unroll
        for (int bj = 0; bj < 2; ++bj) {
            const int col = col0 + bj * 128;
            const f32x4 g0 = *(const f32x4*)(g1 + col), g4 = *(const f32x4*)(g1 + col + 4), f0 = *(const f32x4*)(f2 + col), f4 = *(const f32x4*)(f2 + col + 4);
#pragma unroll
            for (int ai = 0; ai < 2; ++ai)
#pragma unroll
                for (int m = 0; m < 4; ++m) {
                    const size_t off = (size_t)(row0 + ai * 128 + m * 16) * 2048 + col;
                    const f32x4 x0 = *(const f32x4*)(X + off), x4 = *(const f32x4*)(X + off + 4);
                    const f32x4 v0 = x0 + g0 * (acc[ai][bj][m][0] * ra[ai][m]), v1 = x4 + g4 * (acc[ai][bj][m][1] * ra[ai][m]);
                    *(u32x4*)(X1 + off) = pack8(v0, v1);
                    *(u32x4*)(A2 + off) = pack8(v0 * f0, v1 * f4);
                    ss[ai][m] += (v0[0] * v0[0] + v0[1] * v0[1]) + (v0[2] * v0[2] + v0[3] * v0[3]) + (v1[0] * v1[0] + v1[1] * v1[1]) + (v1[2] * v1[2] + v1[3] * v1[3]);
                }
        }
#pragma unroll
        for (int ai = 0; ai < 2; ++ai)
#pragma unroll
            for (int m = 0; m < 4; ++m) {
                float s = ss[ai][m];
                s += __shfl_xor(s, 16); s += __shfl_xor(s, 32);
                if (fq == 0) st2p[(size_t)(row0 + ai * 128 + m * 16) * 32 + u.pn * 4 + wc] = s;
            }
    }
};
struct EpiQ {
    static constexpr bool PERM = true; static constexpr bool MIDK = false;
    bf16_t* O; const float* rstd2; const float* cq;
    __device__ __forceinline__ void operator()(const f32x4 (&acc)[2][2][4][2], const Unit& u, int wr, int wc, int fr, int fq) const {
        const int row0 = u.pm * 256 + wr * 64 + fr, col0 = u.pn * 256 + wc * 32 + 8 * fq;
        float rs[2][4];
#pragma unroll
        for (int ai = 0; ai < 2; ++ai)
#pragma unroll
            for (int m = 0; m < 4; ++m) rs[ai][m] = rstd2[row0 + ai * 128 + m * 16];
#pragma unroll
        for (int bj = 0; bj < 2; ++bj) {
            const int col = col0 + bj * 128;
            const f32x4 c0 = *(const f32x4*)(cq + col), c4 = *(const f32x4*)(cq + col + 4);
#pragma unroll
            for (int ai = 0; ai < 2; ++ai)
#pragma unroll
                for (int m = 0; m < 4; ++m)
                    *(u32x4*)(O + (size_t)(row0 + ai * 128 + m * 16) * 2048 + col) = pack8(acc[ai][bj][m][0] * rs[ai][m] + c0, acc[ai][bj][m][1] * rs[ai][m] + c4);
        }
    }
};
template <class Sched>
__device__ __forceinline__ void rstd2_prepass(const Sched& S, const float* st2p, float* rstd2, int tid) {
    Unit u;
    for (int i = 0; S.next(i, u); ++i)
        if (tid < 256) {
            const int row = u.pm * 256 + tid; const f32x4* p = (const f32x4*)(st2p + (size_t)row * 32);
            float s = 0.f;
#pragma unroll
            for (int k = 0; k < 8; ++k) { const f32x4 v = p[k]; s += (v[0] + v[1]) + (v[2] + v[3]); }
            rstd2[row] = rsqrtf(s * (1.f / 2048.f) + 1e-6f);
        }
    __syncthreads();
}
struct EpiSlab {
    static constexpr bool PERM = false; static constexpr bool MIDK = false;
    float* SL;
    __device__ __forceinline__ void operator()(const f32x4 (&acc)[2][2][4][2], const Unit& u, int wr, int wc, int fr, int fq) const {
        float* base = SL + (size_t)u.z * 2048 * 256;
        const int row0 = u.pm * 256 + wr * 64 + fr, col0 = wc * 32 + 4 * fq;
#pragma unroll
        for (int ai = 0; ai < 2; ++ai)
#pragma unroll
            for (int m = 0; m < 4; ++m)
#pragma unroll
                for (int bj = 0; bj < 2; ++bj)
#pragma unroll
                    for (int n = 0; n < 2; ++n)
                        *(f32x4*)(base + (size_t)(row0 + ai * 128 + m * 16) * 256 + col0 + bj * 128 + n * 16) = acc[ai][bj][m][n];
    }
};
struct CmpOrder {
    const bf16_t* KROW; const bf16_t* VROW; const bf16_t* W1; int lda, ldb, K; int G, c;
    __device__ bool next(int i, Unit& u) const {
        const int x = i * G + c; if (x >= 256) return false;
        const int kvsel = x >> 7, pm = (x & 127) >> 4, ks = x & 15; u.pm = pm; u.pn = 0; u.z = kvsel * 16 + ks; return true;
    }
    __device__ __forceinline__ const char* a_base(const Unit& u) const { return (const char*)(((u.z >> 4) ? VROW : KROW) + (size_t)u.pm * 256 * 2048 + (u.z & 15) * 256); }
    __device__ __forceinline__ const char* b_base(const Unit& u) const { return (const char*)(W1 + (size_t)(u.z >> 4) * 256 * 4096 + (u.z & 15) * 256); }
};
template <class Sched>
__device__ __forceinline__ void rsa_prepass(const Sched& S, const float* stsp, const float* stap, float* rsa, int tid) {
    Unit u;
    for (int i = 0; S.next(i, u); ++i)
        if (tid < 256) {
            const int row = u.pm * 256 + tid; const f32x4* p = (const f32x4*)(stsp + (size_t)row * 16);
            float s = 0.f;
#pragma unroll
            for (int k = 0; k < 4; ++k) { const f32x4 v = p[k]; s += (v[0] + v[1]) + (v[2] + v[3]); }
            const f32x2 q = *(const f32x2*)(stap + (size_t)row * 2);
            const float rs = rsqrtf(s * (1.f / 1024.f) + 1e-6f), ra = rsqrtf((q[0] + q[1]) * (1.f / 1024.f) + 1e-6f);
            f32x2 o; o[0] = rs / ra; o[1] = ra;
            *(f32x2*)(rsa + (size_t)row * 2) = o;
        }
    __syncthreads();
}
struct Ctx { int bid, nb, tid, wave, lane; LAS unsigned char* lds; };

__device__ __forceinline__ void p0_cond(const Args& a, const Ctx& c) {
    const float* cv = a.in[1]; const float* w = a.in[2]; float* condp = (float*)(a.ws + WS_CONDP);
    for (int u = c.bid * 8 + c.wave; u < 1536; u += c.nb * 8) {
        const int cc = u % 48, kc = u / 48;
        const float* wp = w + (size_t)(kc * 64) * NADA + cc * 256 + c.lane * 4;
        f32x4 acc = {0.f, 0.f, 0.f, 0.f};
#pragma unroll 16
        for (int k = 0; k < 64; ++k) { const float x = cv[kc * 64 + k]; const float s = x / (1.f + __expf(-x)); acc += s * *(const f32x4*)(wp + (size_t)k * NADA); }
        *(f32x4*)(condp + (size_t)kc * NADA + cc * 256 + c.lane * 4) = acc;
    }
}
struct TDesc { const float* src; bf16_t* dst; const float* ks0; const float* ks1; int K, N, nkt, nt, kt; };
__device__ __forceinline__ TDesc conv_decode(const Args& a, int tix) {
    TDesc d; d.ks0 = nullptr; d.ks1 = nullptr; int local;
    if (tix < 1920) { local = tix; d.src = a.in[6]; d.dst = (bf16_t*)(a.ws + WS_WIN); d.K = 2048; d.N = DIN; }
    else if (tix < 2176) { local = tix - 1920; d.src = a.in[18]; d.dst = (bf16_t*)(a.ws + WS_WGLU); d.K = 1024; d.N = 1024; }
    else if (tix < 3200) { local = tix - 2176; d.src = a.in[7]; d.dst = (bf16_t*)(a.ws + WS_WOUT); d.K = 2048; d.N = 2048; d.ks0 = a.in[8]; d.ks1 = a.in[9]; }
    else if (tix < 4224) { local = tix - 3200; d.src = a.in[27]; d.dst = (bf16_t*)(a.ws + WS_WQ); d.K = 2048; d.N = 2048; }
    else if (tix < 4480) { local = tix - 4224; d.src = a.in[21]; d.dst = (bf16_t*)(a.ws + WS_W1); d.K = 4096; d.N = 256; }
    else if (tix < 4736) { local = tix - 4480; d.src = a.in[24]; d.dst = (bf16_t*)(a.ws + WS_W1) + 256 * 4096; d.K = 4096; d.N = 256; }
    else if (tix < 4744) { local = tix - 4736; d.src = a.in[22]; d.dst = (bf16_t*)(a.ws + WS_W2); d.K = 256; d.N = 128; }
    else { local = tix - 4744; d.src = a.in[25]; d.dst = (bf16_t*)(a.ws + WS_W2) + 128 * 256; d.K = 256; d.N = 128; }
    d.nkt = d.K / 64; d.nt = local / d.nkt; d.kt = local % d.nkt;
    return d;
}
constexpr int CONV_TILES = 4752;
__device__ __forceinline__ void conv_T_all(const Args& a, const Ctx& c) {
    LAS float* tile = (LAS float*)c.lds;
    const int r = c.tid >> 4, c4 = c.tid & 15;
    f32x4 b0[2], b1[2], b2[2]; float s0[2] = {1.f, 1.f}, s1[2] = {1.f, 1.f}, s2[2] = {1.f, 1.f};
#define CONVT_LD(buf, sc, tix_) do { if ((tix_) < CONV_TILES) { const TDesc d_ = conv_decode(a, (tix_)); const int n_ = d_.nt * 64 + 4 * c4; \
        _Pragma("unroll") for (int i = 0; i < 2; ++i) { const int k_ = d_.kt * 64 + r + 32 * i; buf[i] = (f32x4){0.f, 0.f, 0.f, 0.f}; if (n_ < d_.N) buf[i] = *(const f32x4*)(d_.src + (size_t)k_ * d_.N + n_); \
            sc[i] = 1.f; if (d_.ks0) sc[i] = k_ < 1024 ? d_.ks0[k_] : d_.ks1[k_ - 1024]; } } } while (0)
#define CONVT_DO(buf, sc, tix_) do { if ((tix_) < CONV_TILES) { const TDesc d_ = conv_decode(a, (tix_)); \
        _Pragma("unroll") for (int i = 0; i < 2; ++i) { LAS float* tp = tile + (r + 32 * i) * 65 + 4 * c4; tp[0] = buf[i][0] * sc[i]; tp[1] = buf[i][1] * sc[i]; tp[2] = buf[i][2] * sc[i]; tp[3] = buf[i][3] * sc[i]; } \
        __syncthreads(); \
        { const int n = c.tid >> 3, kq = c.tid & 7; float w[8]; \
          _Pragma("unroll") for (int j = 0; j < 8; ++j) w[j] = tile[(kq * 8 + j) * 65 + n]; \
          u32x4 o; o[0] = cvt_pk_bf16(w[0], w[1]); o[1] = cvt_pk_bf16(w[2], w[3]); o[2] = cvt_pk_bf16(w[4], w[5]); o[3] = cvt_pk_bf16(w[6], w[7]); \
          *(u32x4*)(d_.dst + (size_t)(d_.nt * 64 + n) * d_.K + d_.kt * 64 + kq * 8) = o; } \
        __syncthreads(); } } while (0)
    int tix = c.bid;
    CONVT_LD(b0, s0, tix); CONVT_LD(b1, s1, tix + c.nb);
    for (; tix < CONV_TILES; tix += 3 * c.nb) {
        CONVT_LD(b2, s2, tix + 2 * c.nb); CONVT_DO(b0, s0, tix);
        CONVT_LD(b0, s0, tix + 3 * c.nb); CONVT_DO(b1, s1, tix + c.nb);
        CONVT_LD(b1, s1, tix + 4 * c.nb); CONVT_DO(b2, s2, tix + 2 * c.nb);
    }
#undef CONVT_LD
#undef CONVT_DO
}
__device__ __forceinline__ void conv_fp4rows(const float* src, unsigned char* dst4, float* scl, int rows, const Ctx& c) {
    const int stride = c.nb * 8;
    f32x4 b0[8], b1[8], b2[8], b3[8], b4[8];
#define FP4R_LD(buf, r_) do { if ((r_) < rows) { _Pragma("unroll") for (int j = 0; j < 8; ++j) buf[j] = *(const f32x4*)(src + (size_t)(r_) * 2048 + 256 * j + c.lane * 4); } } while (0)
#define FP4R_DO(buf, r_) do { if ((r_) < rows) { \
        float mx = 0.f; \
        _Pragma("unroll") for (int j = 0; j < 8; ++j) mx = fmaxf(mx, fmaxf(fmaxf(fabsf(buf[j][0]), fabsf(buf[j][1])), fmaxf(fabsf(buf[j][2]), fabsf(buf[j][3])))); \
        mx = wave_max(mx); \
        const float s = mx > 0.f ? 6.f / mx : 1.f; \
        if (c.lane == 0) scl[(size_t)(r_) * 4] = mx > 0.f ? mx * (1.f / 6.f) : 1.f; \
        u32x4 pk = {0u, 0u, 0u, 0u}; \
        _Pragma("unroll") for (int d = 0; d < 4; ++d) {              \
            unsigned wq = 0u; \
            wq = fp4_pk<0>(wq, buf[2 * d][0] * s, buf[2 * d][1] * s); wq = fp4_pk<1>(wq, buf[2 * d][2] * s, buf[2 * d][3] * s); \
            wq = fp4_pk<2>(wq, buf[2 * d + 1][0] * s, buf[2 * d + 1][1] * s); wq = fp4_pk<3>(wq, buf[2 * d + 1][2] * s, buf[2 * d + 1][3] * s); \
            pk[d] = wq; } \
        *(u32x4*)(dst4 + (size_t)(r_) * 1024 + c.lane * 16) = pk; } } while (0)
    int row = c.bid * 8 + c.wave;
    FP4R_LD(b0, row); FP4R_LD(b1, row + stride); FP4R_LD(b2, row + 2 * stride); FP4R_LD(b3, row + 3 * stride);
    for (; row < rows; row += 5 * stride) {
        FP4R_LD(b4, row + 4 * stride); FP4R_DO(b0, row);
        FP4R_LD(b0, row + 5 * stride); FP4R_DO(b1, row + stride);
        FP4R_LD(b1, row + 6 * stride); FP4R_DO(b2, row + 2 * stride);
        FP4R_LD(b2, row + 7 * stride); FP4R_DO(b3, row + 3 * stride);
        FP4R_LD(b3, row + 8 * stride); FP4R_DO(b4, row + 4 * stride);
    }
#undef FP4R_LD
#undef FP4R_DO
}
__device__ __forceinline__ void conv_E(const float* src, bf16_t* dst, size_t n8, const Ctx& c) {
    const size_t stride = (size_t)c.nb * NTHREADS;
    for (size_t i = (size_t)c.bid * NTHREADS + c.tid; i < n8; i += stride) {
        const f32x4 x = *(const f32x4*)(src + i * 8), y = *(const f32x4*)(src + i * 8 + 4);
        *(u32x4*)(dst + i * 8) = pack8(x, y);
    }
}
__device__ __forceinline__ int t5_bucket(int n) {
    if (n < 16) return n;
    const float scaled = logf((float)n / 16.f) / logf(64.f);
    const int large = 16 + (int)(scaled * 16.f);
    return large < 31 ? large : 31;
}
__device__ __forceinline__ void p0_tb(const Args& a, const Ctx& c) {
    float* tb = (float*)(a.ws + WS_TB); const float* rb = a.in[26];
    for (int i = c.bid * NTHREADS + c.tid; i < 8 * TBN; i += c.nb * NTHREADS) { const int head = i / TBN, dist = i % TBN; tb[i] = rb[t5_bucket(dist) * 8 + head] * LOG2E; }
}
__device__ __forceinline__ void p0_bpe(const Args& a, const Ctx& c, int part) {
    const int n = c.tid & 255, kv = c.tid >> 8;
    const float* pe = a.in[kv ? 23 : 20]; const float* w1 = a.in[kv ? 24 : 21]; float* bpep = (float*)(a.ws + WS_BPEP);
    float s = 0.f;
#pragma unroll 16
    for (int k = part * 128; k < part * 128 + 128; ++k) s += pe[k] * w1[(size_t)k * 256 + n];
    bpep[(part * 2 + kv) * 256 + n] = s;
}
__device__ __forceinline__ void p0_s5(const Args& a, const Ctx& c, int g, int part) {
    LAS float* ar = (LAS float*)c.lds;
    LAS float* ai = ar + 17 * 64;
    LAS float* bbr = ai + 17 * 64;
    LAS float* bbi = bbr + 1024;
    LAS float* cr = bbi + 1024;
    LAS float* ci = cr + 1024;
    LAS float* kd = ci + 1024;
    const int tid = c.tid;
    if (tid < 64) {
        const int p = tid; const float dt = expf(a.in[12][g]); const float lr = a.in[10][g * 64 + p], li = a.in[11][g * 64 + p];
        for (int d = 0; d <= 16; ++d) { const float mag = expf(lr * dt * (float)d), ang = li * dt * (float)d; ar[d * 64 + p] = mag * cosf(ang); ai[d * 64 + p] = mag * sinf(ang); }
        const float nr = ar[64 + p] - 1.f, ni = ai[64 + p], den = lr * lr + li * li;
        const float wre = (nr * lr + ni * li) / den, wim = (ni * lr - nr * li) / den;
        for (int h = 0; h < 16; ++h) { const float br = a.in[13][(g * 64 + p) * 16 + h], bi = a.in[14][(g * 64 + p) * 16 + h]; bbr[p * 16 + h] = wre * br - wim * bi; bbi[p * 16 + h] = wre * bi + wim * br; }
        if (part == 0) {
        float* s5p = (float*)(a.ws + WS_S5P);
        float xr = ar[16 * 64 + p], xi = ai[16 * 64 + p];
        s5p[(g * 64 + p) * 2] = xr; s5p[(g * 64 + p) * 2 + 1] = xi;
        for (int s = 0; s < 8; ++s) { const float tr = xr * xr - xi * xi, ti = 2.f * xr * xi; xr = tr; xi = ti; }
        s5p[64 * 64 * 2 + (g * 64 + p) * 2] = xr; s5p[64 * 64 * 2 + (g * 64 + p) * 2 + 1] = xi;
        }
    }
    for (int e = tid; e < 1024; e += NTHREADS) { cr[e] = a.in[15][g * 1024 + e]; ci[e] = a.in[16][g * 1024 + e]; }
    __syncthreads();
    for (int e = tid; e < 1024 * (part + 1); e += NTHREADS) {
        const int d = e >> 8, h1 = (e >> 4) & 15, h = e & 15; float s = 0.f;
        for (int p = 0; p < 64; ++p) { const float Cr = cr[h1 * 64 + p], Ci = ci[h1 * 64 + p], Ar = ar[d * 64 + p], Ai = ai[d * 64 + p];
            const float Gr = Cr * Ar - Ci * Ai, Gi = Cr * Ai + Ci * Ar; s += Gr * bbr[p * 16 + h] - Gi * bbi[p * 16 + h]; }
        if (d == 0 && h1 == h) s += a.in[17][g * 16 + h];
        kd[e] = s;
    }
    __syncthreads();
    bf16_t* MT = (bf16_t*)(a.ws + WS_S5MT) + (size_t)g * 65536;
    bf16_t* WE = (bf16_t*)(a.ws + WS_S5WE) + (size_t)g * 32768;
    bf16_t* WC = (bf16_t*)(a.ws + WS_S5WC) + (size_t)g * 32768;
    for (int e = 16384 * part + tid; e < 16384 * (part + 1); e += NTHREADS) { const int n = e >> 8, k = e & 255, j = n >> 4, h1 = n & 15, i = k >> 4, h = k & 15;
        MT[e] = f2bf(i <= j ? kd[(j - i) * 256 + h1 * 16 + h] : 0.f); }
    for (int e = 8192 * part + tid; e < 8192 * (part + 1); e += NTHREADS) { const int n = e >> 8, k = e & 255, cc = n >> 6, p = n & 63, i = k >> 4, h = k & 15;
        const float Ar = ar[(15 - i) * 64 + p], Ai = ai[(15 - i) * 64 + p], Br = bbr[p * 16 + h], Bi = bbi[p * 16 + h];
        WE[e] = f2bf(cc ? (Ar * Bi + Ai * Br) : (Ar * Br - Ai * Bi)); }
    for (int e = 8192 * part + tid; e < 8192 * (part + 1); e += NTHREADS) { const int n = e >> 7, k = e & 127, j = n >> 4, h1 = n & 15, cc = k >> 6, p = k & 63;
        const float Cr = cr[h1 * 64 + p], Ci = ci[h1 * 64 + p], Ar = ar[(j + 1) * 64 + p], Ai = ai[(j + 1) * 64 + p];
        WC[e] = f2bf(cc ? -(Cr * Ai + Ci * Ar) : (Cr * Ar - Ci * Ai)); }
    __syncthreads();
}
__device__ __forceinline__ void p0_prologue(const Args& a, const Ctx& c) {
    for (int u = c.bid; u < 256; u += c.nb) p0_s5(a, c, u >> 2, u & 3);
    for (int u = 0; u < 32; ++u) if (c.bid == (8 * u + 7) % c.nb) p0_bpe(a, c, u);
    p0_tb(a, c);
    p0_cond(a, c);
    conv_T_all(a, c);
    conv_E(a.in[28], (bf16_t*)(a.ws + WS_PK), 128 * 128 / 8, c);
    conv_E(a.in[29], (bf16_t*)(a.ws + WS_PK) + 128 * 128, 128 * 128 / 8, c);
    conv_fp4rows(a.in[30], a.ws + WS_PU, (float*)(a.ws + WS_PSC), 16384, c);
}

__device__ __forceinline__ void norm_rows(const float* X, bf16_t* O, LAS const float* Ab, LAS const float* Bb, const Ctx& c, int row0 = 0, int nrows = L_) {
    for (int t = row0 + c.bid * 8 + c.wave; t < row0 + nrows; t += c.nb * 8) {
        const float* xr = X + (size_t)t * 2048 + c.lane * 4;
        f32x4 v[8]; float ss = 0.f;
#pragma unroll
        for (int j = 0; j < 8; ++j) { v[j] = *(const f32x4*)(xr + j * 256); ss += v[j][0] * v[j][0] + v[j][1] * v[j][1] + v[j][2] * v[j][2] + v[j][3] * v[j][3]; }
        ss = wave_sum(ss);
        const float rstd = rsqrtf(ss * (1.f / 2048.f) + 1e-6f);
#pragma unroll
        for (int j = 0; j < 8; ++j) {
            const int col = j * 256 + c.lane * 4;
            const f32x4 A = *(const LAS f32x4*)(Ab + col), B = *(const LAS f32x4*)(Bb + col);
            const f32x4 o = v[j] * rstd * A + B;
            u32x2 w; w[0] = cvt_pk_bf16(o[0], o[1]); w[1] = cvt_pk_bf16(o[2], o[3]);
            *(u32x2*)(O + (size_t)t * 2048 + col) = w;
        }
    }
}
__device__ __forceinline__ void norm_rows_bf16(const bf16_t* X, bf16_t* O, LAS const float* Ab, LAS const float* Bb, const Ctx& c, int row0, int nrows) {
    for (int t = row0 + c.bid * 8 + c.wave; t < row0 + nrows; t += c.nb * 8) {
        const bf16_t* xr = X + (size_t)t * 2048 + c.lane * 8;
        u32x4 w[4]; float ss = 0.f;
#pragma unroll
        for (int j = 0; j < 4; ++j) { w[j] = *(const u32x4*)(xr + j * 512);
#pragma unroll
            for (int e = 0; e < 4; ++e) { const float a0 = bflo(w[j][e]), a1 = bfhi(w[j][e]); ss += a0 * a0 + a1 * a1; } }
        ss = wave_sum(ss);
        const float rstd = rsqrtf(ss * (1.f / 2048.f) + 1e-6f);
#pragma unroll
        for (int j = 0; j < 4; ++j) {
            const int col = j * 512 + c.lane * 8;
            const f32x4 A0 = *(const LAS f32x4*)(Ab + col), A1 = *(const LAS f32x4*)(Ab + col + 4), B0 = *(const LAS f32x4*)(Bb + col), B1 = *(const LAS f32x4*)(Bb + col + 4);
            f32x4 o0, o1;
#pragma unroll
            for (int e = 0; e < 2; ++e) { o0[2 * e] = bflo(w[j][e]) * rstd * A0[2 * e] + B0[2 * e]; o0[2 * e + 1] = bfhi(w[j][e]) * rstd * A0[2 * e + 1] + B0[2 * e + 1];
                o1[2 * e] = bflo(w[j][2 + e]) * rstd * A1[2 * e] + B1[2 * e]; o1[2 * e + 1] = bfhi(w[j][2 + e]) * rstd * A1[2 * e + 1] + B1[2 * e + 1]; }
            *(u32x4*)(O + (size_t)t * 2048 + col) = pack8(o0, o1);
        }
    }
}
__device__ __forceinline__ float cond_from_partials(const float* condp, const float* b_ada, int j) {
    float s = b_ada[j];
#pragma unroll 8
    for (int k = 0; k < 32; ++k) s += condp[(size_t)k * NADA + j];
    return s;
}
__device__ __forceinline__ void p1_hnorm(const Args& a, const Ctx& c) {
    const float* condp = (const float*)(a.ws + WS_CONDP); float* cond = (float*)(a.ws + WS_COND);
    for (int j = c.bid * NTHREADS + c.tid; j < NADA; j += c.nb * NTHREADS) cond[j] = cond_from_partials(condp, a.in[3], j);
    { float* F2 = (float*)(a.ws + WS_F2);
      for (int j = c.bid * NTHREADS + c.tid; j < 2048; j += c.nb * NTHREADS) F2[j] = a.in[5][j] * (1.f + cond_from_partials(condp, a.in[3], 4 * 2048 + j)); }
    LAS float* Ab = (LAS float*)c.lds; LAS float* Bb = Ab + 2048;
    for (int col = c.tid; col < 2048; col += NTHREADS) {
        Ab[col] = a.in[4][col] * (1.f + cond_from_partials(condp, a.in[3], 2048 + col)); Bb[col] = cond_from_partials(condp, a.in[3], col); }
    __syncthreads();
    norm_rows(a.in[0], (bf16_t*)(a.ws + WS_H), Ab, Bb, c);
}
__device__ __forceinline__ void p_cqce(const Args& a, const Ctx& c) {
    const float* sh2 = (const float*)(a.ws + WS_COND) + 3 * 2048;
    float s[32];
#pragma unroll
    for (int k = 0; k < 8; ++k) { const f32x4 v = *(const f32x4*)(sh2 + 256 * k + c.lane * 4); s[4 * k] = v[0]; s[4 * k + 1] = v[1]; s[4 * k + 2] = v[2]; s[4 * k + 3] = v[3]; }
    const bf16_t* WQ = (const bf16_t*)(a.ws + WS_WQ); float* cq = (float*)(a.ws + WS_CQ);
    for (int n = c.bid * 8 + c.wave; n < 2048; n += c.nb * 8) {
        u32x2 w[8];
#pragma unroll
        for (int k = 0; k < 8; ++k) w[k] = *(const u32x2*)(WQ + (size_t)n * 2048 + 256 * k + c.lane * 4);
        float d = 0.f;
#pragma unroll
        for (int k = 0; k < 8; ++k) d += (bflo(w[k][0]) * s[4 * k] + bfhi(w[k][0]) * s[4 * k + 1]) + (bflo(w[k][1]) * s[4 * k + 2] + bfhi(w[k][1]) * s[4 * k + 3]);
        d = wave_sum(d);
        if (c.lane == 0) cq[n] = d;
    }
    const unsigned char* PU = a.ws + WS_PU; float* psc = (float*)(a.ws + WS_PSC);
    for (int e0 = (c.bid * 8 + c.wave) * 4; e0 < 16384; e0 += c.nb * 8 * 4) {
        u32x4 uw[4];
#pragma unroll
        for (int i = 0; i < 4; ++i) uw[i] = *(const u32x4*)(PU + (size_t)(e0 + i) * 1024 + c.lane * 16);
#pragma unroll
        for (int i = 0; i < 4; ++i) {
            float d0 = 0.f, d1 = 0.f;
#pragma unroll
            for (int dw = 0; dw < 4; ++dw) { const f32x2 f0 = fp4_unpk<0>(uw[i][dw]), f1 = fp4_unpk<1>(uw[i][dw]), f2 = fp4_unpk<2>(uw[i][dw]), f3 = fp4_unpk<3>(uw[i][dw]);
                d0 += f0[0] * s[8 * dw] + f1[0] * s[8 * dw + 2] + f2[0] * s[8 * dw + 4] + f3[0] * s[8 * dw + 6];
                d1 += f0[1] * s[8 * dw + 1] + f1[1] * s[8 * dw + 3] + f2[1] * s[8 * dw + 5] + f3[1] * s[8 * dw + 7]; }
            const float d = wave_sum(d0 + d1);
            if (c.lane == 0) psc[(size_t)(e0 + i) * 4 + 1] = psc[(size_t)(e0 + i) * 4] * d;
        }
    }
}
constexpr int S5_US = 0, S5_ES = 33792, S5_SS = 67584, S5_TS = 84992;
template <int PASS>
__device__ __forceinline__ void s5_item(const Args& a, const Ctx& c, int g, int seg) {
    LAS unsigned char* lds = c.lds;
    int tid = c.tid; asm volatile("" : "+v"(tid));
    const int wave = c.wave, lane = tid & 63, r = lane & 15, q = lane >> 4;
    const bf16_t* U = (const bf16_t*)(a.ws + WS_US);
    const bf16_t* MT = (const bf16_t*)(a.ws + WS_S5MT) + (size_t)g * 65536;
    const bf16_t* WE = (const bf16_t*)(a.ws + WS_S5WE) + (size_t)g * 32768;
    const bf16_t* WC = (const bf16_t*)(a.ws + WS_S5WC) + (size_t)g * 32768;
    const float* s5p = (const float*)(a.ws + WS_S5P);
    float* F = (float*)(a.ws + WS_S5F) + (size_t)g * 4 * 128;
    bf16_t* Z = (bf16_t*)(a.ws + WS_Z);
    bf16x8 bE[8];
#pragma unroll
    for (int ks = 0; ks < 8; ++ks) bE[ks] = *(const bf16x8*)(WE + (size_t)(16 * wave + r) * 256 + 32 * ks + 8 * q);
    bf16x8 bM[2][8], bC[2][4];
    if (PASS == 1) {
#pragma unroll
        for (int nt = 0; nt < 2; ++nt)
#pragma unroll
            for (int ks = 0; ks < 4; ++ks) bC[nt][ks] = *(const bf16x8*)(WC + (size_t)(16 * (2 * wave + nt) + r) * 128 + 32 * ks + 8 * q);
#pragma unroll
        for (int nt = 0; nt < 2; ++nt)
#pragma unroll
            for (int ks = 0; ks < 8; ++ks) bM[nt][ks] = *(const bf16x8*)(MT + (size_t)(16 * (2 * wave + nt) + r) * 256 + 32 * ks + 8 * q);
    }
    float sr = 0.f, si = 0.f;
    const float a16r = s5p[(g * 64 + lane) * 2], a16i = s5p[(g * 64 + lane) * 2 + 1];
    float a128r = a16r, a128i = a16i;
#pragma unroll
    for (int s = 0; s < 3; ++s) { const float tr = a128r * a128r - a128i * a128i, ti = 2.f * a128r * a128i; a128r = tr; a128i = ti; }
    if (PASS == 1) { const float br = s5p[8192 + (g * 64 + lane) * 2], bi = s5p[8192 + (g * 64 + lane) * 2 + 1];
        for (int s = 0; s < seg; ++s) { const float fr_ = F[s * 128 + lane], fi_ = F[s * 128 + 64 + lane]; const float nr = br * sr - bi * si + fr_, ni = br * si + bi * sr + fi_; sr = nr; si = ni; } }
    for (int sb = 0; sb < 4; ++sb) {
        const int tok0 = seg * 4096 + sb * 1024;
#pragma unroll
        for (int i = 0; i < 4; ++i) { const int ch = tid + NTHREADS * i, token = ch >> 1, half = ch & 1;
            const u32x4 v = *(const u32x4*)(U + (size_t)(tok0 + token) * 1024 + g * 16 + half * 8);
            *(LAS u32x4*)(lds + S5_US + (token >> 4) * 528 + ((token & 15) * 16 + half * 8) * 2) = v; }
        __syncthreads();
#pragma unroll
        for (int m = 0; m < 4; ++m) {
            f32x4 acc = {0.f, 0.f, 0.f, 0.f};
#pragma unroll
            for (int ks = 0; ks < 8; ++ks) { const bf16x8 A = *(const LAS bf16x8*)(lds + S5_US + (16 * m + r) * 528 + (32 * ks + 8 * q) * 2); acc = mfma16(A, bE[ks], acc); }
#pragma unroll
            for (int i = 0; i < 4; ++i) *(LAS float*)(lds + S5_ES + ((16 * m + 4 * q + i) * 132 + 16 * wave + r) * 4) = acc[i];
        }
        __syncthreads();
        {
            float lr[8], li[8];
            float xr = 0.f, xi = 0.f;
#pragma unroll
            for (int k = 0; k < 8; ++k) {
                lr[k] = xr; li[k] = xi;
                const float er = *(const LAS float*)(lds + S5_ES + ((8 * wave + k) * 132 + lane) * 4), ei = *(const LAS float*)(lds + S5_ES + ((8 * wave + k) * 132 + 64 + lane) * 4);
                const float nr = a16r * xr - a16i * xi + er, ni = a16r * xi + a16i * xr + ei; xr = nr; xi = ni;
            }
            __builtin_amdgcn_sched_barrier(0);
            *(LAS float*)(lds + S5_TS + (wave * 128 + lane) * 4) = xr; *(LAS float*)(lds + S5_TS + (wave * 128 + 64 + lane) * 4) = xi;
            __syncthreads();
            __builtin_amdgcn_sched_barrier(0);
            float cr = sr, ci = si, mr = sr, mi = si;
#pragma unroll
            for (int w2 = 0; w2 < 8; ++w2) {
                if (w2 == wave) { mr = cr; mi = ci; }
                const float tr = *(const LAS float*)(lds + S5_TS + (w2 * 128 + lane) * 4), ti = *(const LAS float*)(lds + S5_TS + (w2 * 128 + 64 + lane) * 4);
                const float nr = a128r * cr - a128i * ci + tr, ni = a128r * ci + a128i * cr + ti; cr = nr; ci = ni;
            }
            sr = cr; si = ci;
            __builtin_amdgcn_sched_barrier(0);
            if (PASS == 1) {
                float pr = mr, pi = mi;
#pragma unroll
                for (int k = 0; k < 8; ++k) {
                    *(LAS bf16_t*)(lds + S5_SS + ((8 * wave + k) * 136 + lane) * 2) = f2bf(lr[k] + pr); *(LAS bf16_t*)(lds + S5_SS + ((8 * wave + k) * 136 + 64 + lane) * 2) = f2bf(li[k] + pi);
                    const float nr = a16r * pr - a16i * pi, ni = a16r * pi + a16i * pr; pr = nr; pi = ni;
                }
            }
        }
        __syncthreads();
        if (PASS == 1) {
#pragma unroll
            for (int nt = 0; nt < 2; ++nt) {
                const int j = 2 * wave + nt;
                f32x4 acc[4];
#pragma unroll
                for (int m = 0; m < 4; ++m) acc[m] = (f32x4){0.f, 0.f, 0.f, 0.f};
#pragma unroll
                for (int ks = 0; ks < 8; ++ks) {
                    __builtin_amdgcn_sched_barrier(0);
#pragma unroll
                    for (int m = 0; m < 4; ++m) { const bf16x8 A = *(const LAS bf16x8*)(lds + S5_US + (16 * m + r) * 528 + (32 * ks + 8 * q) * 2); acc[m] = mfma16(A, bM[nt][ks], acc[m]); }
                }
#pragma unroll
                for (int ks = 0; ks < 4; ++ks) {
                    __builtin_amdgcn_sched_barrier(0);
#pragma unroll
                    for (int m = 0; m < 4; ++m) { const bf16x8 A = *(const LAS bf16x8*)(lds + S5_SS + (16 * m + r) * 272 + (32 * ks + 8 * q) * 2); acc[m] = mfma16(A, bC[nt][ks], acc[m]); }
                }
                int lz = lane; asm volatile("" : "+v"(lz));
                const int rz = lz & 15, qz = lz >> 4;
#pragma unroll
                for (int m = 0; m < 4; ++m)
#pragma unroll
                    for (int i = 0; i < 4; ++i) { const int ch = 16 * m + 4 * qz + i; Z[(size_t)(tok0 + 16 * ch + j) * 1024 + g * 16 + rz] = f2bf(gelu_tanh(acc[m][i])); }
            }
            __syncthreads();
        }
    }
    if (PASS == 0 && wave == 0) { F[seg * 128 + lane] = sr; F[seg * 128 + 64 + lane] = si; }
}

__device__ __forceinline__ void cmp_finish_item(const Args& a, const Ctx& c, int kvsel, int rt) {
    LAS unsigned char* lds = c.lds;
    const int tid = c.tid, wave = c.wave, lane = c.lane, r = lane & 15, q = lane >> 4;
    const float* SL = (const float*)(a.ws + WS_SLAB) + (size_t)kvsel * 16 * 2048 * 256;
    const float* bpep = (const float*)(a.ws + WS_BPEP) + kvsel * 256;
    const bf16_t* W2 = (const bf16_t*)(a.ws + WS_W2) + kvsel * 128 * 256;
    bf16x8 B[8];
#pragma unroll
    for (int ks = 0; ks < 8; ++ks) B[ks] = *(const bf16x8*)(W2 + (size_t)(16 * wave + r) * 256 + 32 * ks + 8 * q);
    for (int e = tid; e < 16 * 64; e += NTHREADS) {
        const int row = e >> 6, c4 = (e & 63) * 4;
        f32x4 s = {0.f, 0.f, 0.f, 0.f};
#pragma unroll 8
        for (int pt = 0; pt < 32; ++pt) s += *(const f32x4*)(bpep + pt * 512 + c4);
#pragma unroll
        for (int ks = 0; ks < 16; ++ks) s += *(const f32x4*)(SL + ((size_t)ks * 2048 + rt * 16 + row) * 256 + c4);
        u32x2 w; w[0] = cvt_pk_bf16(gelu_tanh(s[0]), gelu_tanh(s[1])); w[1] = cvt_pk_bf16(gelu_tanh(s[2]), gelu_tanh(s[3]));
        *(LAS u32x2*)(lds + row * 528 + c4 * 2) = w;
    }
    __syncthreads();
    f32x4 acc = {0.f, 0.f, 0.f, 0.f};
#pragma unroll
    for (int ks = 0; ks < 8; ++ks) { const bf16x8 A = *(const LAS bf16x8*)(lds + r * 528 + (32 * ks + 8 * q) * 2); acc = mfma16(A, B[ks], acc); }
#pragma unroll
    for (int i = 0; i < 4; ++i) {
        const int row = rt * 16 + 4 * q + i, gi = row >> 10, ci = row & 1023, n = 16 * wave + r;
        const bf16_t v = (ci == 1023) ? (bf16_t)0 : f2bf(acc[i]);
        if (kvsel == 0) ((bf16_t*)(a.ws + WS_KC))[((size_t)gi * 1024 + ci) * 128 + n] = v;
        else ((bf16_t*)(a.ws + WS_VCT))[((size_t)gi * 128 + n) * 1024 + ((ci & ~12) | ((ci & 4) << 1) | ((ci & 8) >> 1))] = v;
    }
    __syncthreads();
}
constexpr int AT_IMP = 65536, AT_TB = 131072, AT_BM = 143872, AT_WU = 145920, AT_END = 146176;
__device__ __forceinline__ int kswz(int r) { return ((r & 3) << 2) | ((r >> 2) & 3); }
__host__ __device__ __forceinline__ int vperm(int t) { return (t & ~12) | ((t & 4) << 1) | ((t & 8) >> 1); }
template <int KEYS> __device__ __forceinline__ int vsw(int d) { return KEYS == 128 ? kswz(d) : ((d >> 1) & 7); }
template <int KEYS, bool NEEDV>
__device__ __forceinline__ void stage_dma(const bf16_t* Kt, const bf16_t* Vt, int ldv, LAS unsigned char* kb, LAS unsigned char* vb, int wave, int lane) {
    constexpr int NP = KEYS / 32;
#pragma unroll
    for (int i = 0; i < NP; ++i) { const int pc = NP * wave + i, row = 4 * pc + (lane >> 4), ch = (lane & 15) ^ kswz(row);
        __builtin_amdgcn_global_load_lds((const unsigned*)(Kt + row * 128 + ch * 8), (LAS unsigned*)(kb + pc * 1024), 16, 0, 0); }
    if (NEEDV) {
#pragma unroll
        for (int i = 0; i < NP; ++i) {
            const int pc = NP * wave + i;
            if (KEYS == 128) { const int d = 4 * pc + (lane >> 4), ch = (lane & 15) ^ kswz(d);
                __builtin_amdgcn_global_load_lds((const unsigned*)(Vt + (size_t)d * ldv + 8 * ch), (LAS unsigned*)(vb + pc * 1024), 16, 0, 0); }
            else { const int d = 8 * pc + (lane >> 3), ch = (lane & 7) ^ ((d >> 1) & 7);
                __builtin_amdgcn_global_load_lds((const unsigned*)(Vt + (size_t)d * ldv + 8 * ch), (LAS unsigned*)(vb + pc * 1024), 16, 0, 0); }
        }
    }
}
__device__ __forceinline__ float xhalf_max(float x) { auto rr = __builtin_amdgcn_permlane32_swap(__float_as_uint(x), __float_as_uint(x), false, false); return fmaxf(__uint_as_float(rr[0]), __uint_as_float(rr[1])); }
__device__ __forceinline__ float xhalf_sum(float x) { auto rr = __builtin_amdgcn_permlane32_swap(__float_as_uint(x), __float_as_uint(x), false, false); return __uint_as_float(rr[0]) + __uint_as_float(rr[1]); }
template <int BR>
__device__ __forceinline__ float tile_prep(int MODE, f32x16& S, LAS const float* tb, float cb, int base, bool selbit) {
    float mx = -INFINITY;
    if (MODE == 1) {
#pragma unroll
        for (int r = 0; r < 16; ++r) mx = fmaxf(mx, S[r]);
        mx = (BR == 2 && !selbit) ? -INFINITY : mx + cb;
    } else {
        const bool nomask = (MODE == 2);
        float bv[16];
#pragma unroll
        for (int r = 0; r < 16; ++r) { const int cr = (r & 3) + 8 * (r >> 2); const int dist = (BR <= 1) ? base - 16 * cr : base - cr; bv[r] = tb[min(max(dist, 0), TBN - 1)]; }
        __builtin_amdgcn_sched_barrier(0);
#pragma unroll
        for (int r = 0; r < 16; ++r) {
            const int cr = (r & 3) + 8 * (r >> 2);
            const int dist = (BR <= 1) ? base - 16 * cr : base - cr;
            float v = S[r] + bv[r];
            bool valid;
            if (BR <= 1) valid = dist >= 0; else if (BR == 2) valid = selbit && dist >= 0; else valid = nomask || (unsigned)dist < 512u;
            v = valid ? v : -INFINITY;
            S[r] = v; mx = fmaxf(mx, v);
        }
    }
    return mx;
}
template <int BR, bool PEND>
__device__ __forceinline__ float tile_decide(int MODE, float mx, float cb, bool selbit, f32x16 (&O)[4], float& m, float& l, u32x4& pa, u32x4& pb) {
    if (BR == 1) { const float mu = (m == -INFINITY) ? 0.f : m; return (MODE == 1) ? mu - cb : mu; }
    mx = xhalf_max(mx);
    const float mn = fmaxf(m, mx), mu = (mn == -INFINITY) ? 0.f : mn;
    if (__any(mn > m)) {
        const float alpha = fexp2(m - mu);
        l *= alpha;
        if (BR >= 2) {
#pragma unroll
            for (int dt = 0; dt < 4; ++dt)
#pragma unroll
                for (int r = 0; r < 16; ++r) O[dt][r] *= alpha;
            if (PEND) {
#pragma unroll
                for (int e = 0; e < 4; ++e) { pa[e] = cvt_pk_bf16(bflo(pa[e]) * alpha, bfhi(pa[e]) * alpha); pb[e] = cvt_pk_bf16(bflo(pb[e]) * alpha, bfhi(pb[e]) * alpha); }
            }
        }
    }
    m = mn;
    if (MODE == 1) return (BR == 2 && !selbit) ? INFINITY : mu - cb;
    return mu;
}
template <int BR, int KEYS>
__device__ __forceinline__ void attn_tile(int MODE, LAS const unsigned char* kb, LAS const unsigned char* vb, int cb0, LAS const float* tb, int key0, int t, int lane,
                                          const bf16x8 (&qf)[8], f32x16 (&O)[4], float& m, float& l, float inv_l, bool selbit, LAS float* imp_row) {
    asm volatile("" : "+v"(lane));
    constexpr int ROWB = 2 * KEYS;
    const int r31 = lane & 31, h = lane >> 5;
    const int gh = kswz(r31) ^ h, vh = vsw<KEYS>(r31) ^ h;
    float cb = 0.f;
    if (MODE == 1) cb = tb[TBN - 1];
    const int base0 = (BR <= 1) ? t - 31 - 16 * (key0 + 4 * h) : t - (key0 + 4 * h);
    const int base1 = (BR <= 1) ? base0 - 16 * 32 : base0 - 32;
    LAS const unsigned char* k0 = kb + r31 * 256;
    f32x16 S0, S1;
    bf16x8 kf[8];
#pragma unroll
    for (int ks = 0; ks < 8; ++ks) kf[ks] = *(const LAS bf16x8*)(k0 + 16 * ((2 * ks) ^ gh));
#pragma unroll
    for (int r = 0; r < 16; ++r) { S0[r] = 0.f; S1[r] = 0.f; }
    __builtin_amdgcn_sched_barrier(0);
#pragma unroll
    for (int ks = 0; ks < 8; ++ks) S0 = mfma32(kf[ks], qf[ks], S0);
    __builtin_amdgcn_sched_barrier(0);
#pragma unroll
    for (int ks = 0; ks < 8; ++ks) kf[ks] = *(const LAS bf16x8*)(k0 + 8192 + 16 * ((2 * ks) ^ gh));
    const float mx0 = tile_prep<BR>(MODE, S0, tb, cb, base0, selbit);
    u32x4 pk0a = {0u, 0u, 0u, 0u}, pk0b = {0u, 0u, 0u, 0u}, pk1a, pk1b;
    const float me0 = tile_decide<BR, false>(MODE, mx0, cb, selbit, O, m, l, pk0a, pk0b);
    __builtin_amdgcn_sched_barrier(0);
    {
#pragma unroll
        for (int ks = 0; ks < 8; ++ks) S1 = mfma32(kf[ks], qf[ks], S1);
        float ps = 0.f;
#pragma unroll
        for (int r = 0; r < 16; ++r) { float p = fexp2(S0[r] - me0); if (BR == 1) p *= inv_l; S0[r] = p; ps += p; }
        if (BR != 1) l += ps;
        if (BR >= 1) {
#pragma unroll
            for (int e = 0; e < 4; ++e) { pk0a[e] = cvt_pk_bf16(S0[2 * e], S0[2 * e + 1]); pk0b[e] = cvt_pk_bf16(S0[8 + 2 * e], S0[8 + 2 * e + 1]); }
        }
#pragma unroll
        for (int i = 0; i < 8; ++i) { __builtin_amdgcn_sched_group_barrier(0x008, 1, 0); __builtin_amdgcn_sched_group_barrier(0x002, 8, 0); }
    }
    __builtin_amdgcn_sched_barrier(0);
    if (BR == 1) {
#pragma unroll
        for (int rg = 0; rg < 4; ++rg) {
            float A = 2.f * (S0[4 * rg] + S0[4 * rg + 1] + S0[4 * rg + 2]) + S0[4 * rg + 3], B = S0[4 * rg + 3];
            A = quad_sum(A); B = quad_sum(B);
            const int jj = (key0 >> 2) + 2 * rg + h;
            if ((lane & 3) == 0) { __hip_atomic_fetch_add(imp_row + jj, A, __ATOMIC_RELAXED, __HIP_MEMORY_SCOPE_WORKGROUP);
                if (jj + 1 < 256) __hip_atomic_fetch_add(imp_row + jj + 1, B, __ATOMIC_RELAXED, __HIP_MEMORY_SCOPE_WORKGROUP); }
        }
    }
    bf16x8 av[8];
    if (BR >= 1) {
#pragma unroll
        for (int s = 0; s < 2; ++s)
#pragma unroll
            for (int dt = 0; dt < 4; ++dt) av[s * 4 + dt] = *(const LAS bf16x8*)(vb + (32 * dt + r31) * ROWB + 16 * ((cb0 + 2 * s) ^ vh));
    }
    const float mx1 = tile_prep<BR>(MODE, S1, tb, cb, base1, selbit);
    const float me1 = tile_decide<BR, true>(MODE, mx1, cb, selbit, O, m, l, pk0a, pk0b);
    __builtin_amdgcn_sched_barrier(0);
    {
        if (BR >= 1) {
#pragma unroll
            for (int dt = 0; dt < 4; ++dt) O[dt] = mfma32(av[dt], __builtin_bit_cast(bf16x8, pk0a), O[dt]);
#pragma unroll
            for (int dt = 0; dt < 4; ++dt) O[dt] = mfma32(av[4 + dt], __builtin_bit_cast(bf16x8, pk0b), O[dt]);
        }
        float ps = 0.f;
#pragma unroll
        for (int r = 0; r < 16; ++r) { float p = fexp2(S1[r] - me1); if (BR == 1) p *= inv_l; S1[r] = p; ps += p; }
        if (BR != 1) l += ps;
        if (BR >= 1) {
#pragma unroll
            for (int e = 0; e < 4; ++e) { pk1a[e] = cvt_pk_bf16(S1[2 * e], S1[2 * e + 1]); pk1b[e] = cvt_pk_bf16(S1[8 + 2 * e], S1[8 + 2 * e + 1]); }
#pragma unroll
            for (int i = 0; i < 8; ++i) { __builtin_amdgcn_sched_group_barrier(0x008, 1, 0); __builtin_amdgcn_sched_group_barrier(0x002, 8, 0); }
        }
    }
    __builtin_amdgcn_sched_barrier(0);
    if (BR == 1) {
#pragma unroll
        for (int rg = 0; rg < 4; ++rg) {
            float A = 2.f * (S1[4 * rg] + S1[4 * rg + 1] + S1[4 * rg + 2]) + S1[4 * rg + 3], B = S1[4 * rg + 3];
            A = quad_sum(A); B = quad_sum(B);
            const int jj = ((key0 + 32) >> 2) + 2 * rg + h;
            if ((lane & 3) == 0) { __hip_atomic_fetch_add(imp_row + jj, A, __ATOMIC_RELAXED, __HIP_MEMORY_SCOPE_WORKGROUP);
                if (jj + 1 < 256) __hip_atomic_fetch_add(imp_row + jj + 1, B, __ATOMIC_RELAXED, __HIP_MEMORY_SCOPE_WORKGROUP); }
        }
    }
    if (BR >= 1) {
#pragma unroll
        for (int s = 0; s < 2; ++s)
#pragma unroll
            for (int dt = 0; dt < 4; ++dt) av[s * 4 + dt] = *(const LAS bf16x8*)(vb + (32 * dt + r31) * ROWB + 16 * ((cb0 + 4 + 2 * s) ^ vh));
        __builtin_amdgcn_sched_barrier(0);
#pragma unroll
        for (int dt = 0; dt < 4; ++dt) O[dt] = mfma32(av[dt], __builtin_bit_cast(bf16x8, pk1a), O[dt]);
#pragma unroll
        for (int dt = 0; dt < 4; ++dt) O[dt] = mfma32(av[4 + dt], __builtin_bit_cast(bf16x8, pk1b), O[dt]);
    }
}
template <int BR, int KEYS>
__device__ __forceinline__ void run_branch(const Ctx& c, const bf16_t* Kb, const bf16_t* Vtb, int ldv, int lo, int hi, LAS const float* tb, int t, int t0,
                                           const bf16x8 (&qf)[8], f32x16 (&O)[4], float& m, float& l, float inv_l, int tl, LAS float* imp_row) {
    constexpr bool NEEDV = (BR != 0);
    constexpr int BPS = KEYS / 64, KSTG = KEYS * 256, VSTG = 128 * 2 * KEYS, VB0 = 2 * KSTG;
    LAS unsigned char* lds = c.lds;
    int lz = c.lane; asm volatile("" : "+v"(lz));
    const int nst = (hi - lo + BPS - 1) / BPS;
#define STG_BLK(i) ((lo + BPS * (i) + BPS - 1 < hi) ? lo + BPS * (i) : hi - BPS)
    asm volatile("s_waitcnt vmcnt(0)" ::: "memory");
    { const int b0 = (BPS == 2 && hi - lo < 2) ? lo : STG_BLK(0);
      stage_dma<KEYS, NEEDV>(Kb + (size_t)b0 * 64 * 128, Vtb + (size_t)b0 * 64, ldv, lds, lds + VB0, c.wave, lz); }
    asm volatile("s_waitcnt vmcnt(0)" ::: "memory");
    __syncthreads();
    const int qt = t0 >> 6;
    for (int i = 0; i < nst; ++i) {
        const int buf = i & 1;
        if (i + 1 < nst) { int lz2 = lz; asm volatile("" : "+v"(lz2));
            const int b1 = STG_BLK(i + 1);
            stage_dma<KEYS, NEEDV>(Kb + (size_t)b1 * 64 * 128, Vtb + (size_t)b1 * 64, ldv, lds + (buf ^ 1) * KSTG, lds + VB0 + (buf ^ 1) * VSTG, c.wave, lz2); }
        const int sb = (BPS == 2 && hi - lo < 2) ? lo : STG_BLK(i);
#pragma unroll
        for (int q = 0; q < BPS; ++q) {
            const int j = lo + BPS * i + q;
            if (j < hi) {
                bool selbit = true, wave_on = true;
                if (BR == 2) {
                    const unsigned w = *(const LAS unsigned*)(lds + AT_BM + (tl * 8 + (j >> 5)) * 4);
                    selbit = (w >> (j & 31)) & 1u;
                    const unsigned wu = *(const LAS unsigned*)(lds + AT_WU + (c.wave * 8 + (j >> 5)) * 4);
                    wave_on = (wu >> (j & 31)) & 1u;
                }
                if (wave_on) {
                    int mode = 0;
                    if (BR <= 1) mode = (1024 * j + 1829 <= t0) ? 1 : 0;
                    else if (BR == 2) mode = (64 * j + 853 <= t0) ? 1 : 0;
                    else mode = (j >= qt - 7 && j <= qt - 1) ? 2 : 0;
                    const int slot = j - sb;
                    attn_tile<BR, KEYS>(mode, lds + buf * KSTG + slot * 16384, lds + VB0 + buf * VSTG, 8 * slot, tb, j * 64, t, c.lane, qf, O, m, l, inv_l, selbit, imp_row);
                }
            }
        }
        asm volatile("s_waitcnt vmcnt(0)" ::: "memory");
        __syncthreads();
    }
#undef STG_BLK
}
__device__ __forceinline__ void attn_item(const Args& a, const Ctx& c_, int qt, int g) {
    Ctx c = c_; { int tz = c_.tid; asm volatile("" : "+v"(tz)); c.tid = tz; c.lane = tz & 63; }
    LAS unsigned char* lds = c.lds;
    const int tid = c.tid, wave = c.wave, lane = c.lane, r31 = lane & 31, h = lane >> 5, hl = lane & 3;
    const int t0 = qt * 64, tl = 8 * wave + (r31 >> 2), t = t0 + tl, head = g * 4 + hl;
    const bf16_t* Qb = (const bf16_t*)(a.ws + WS_Q);
    const bf16_t* KROW = (const bf16_t*)(a.ws + WS_KROW);
    const bf16_t* VT = (const bf16_t*)(a.ws + WS_VT);
    const float* GATE = (const float*)(a.ws + WS_GATE);
    { const float* tbg = (const float*)(a.ws + WS_TB) + g * 4 * TBN;
      for (int i = tid; i < 4 * TBN; i += NTHREADS) *(LAS float*)(lds + AT_TB + i * 4) = tbg[i];
      for (int i = tid; i < 64 * 256; i += NTHREADS) *(LAS float*)(lds + AT_IMP + i * 4) = 0.f; }
    bf16x8 qf[8];
#pragma unroll
    for (int ks = 0; ks < 8; ++ks) qf[ks] = *(const bf16x8*)(Qb + (size_t)t * 1024 + head * 128 + 16 * ks + 8 * h);
    LAS const float* tb = (LAS const float*)(lds + AT_TB) + hl * TBN;
    LAS float* imp_row = (LAS float*)(lds + AT_IMP) + tl * 256;
    bf16_t* Y = (bf16_t*)(a.ws + WS_Y2) + (size_t)t * 2048 + 1024 + head * 128 + 4 * h;
    f32x16 O[4];
#pragma unroll
    for (int dt = 0; dt < 4; ++dt)
#pragma unroll
        for (int r = 0; r < 16; ++r) O[dt][r] = 0.f;
    __syncthreads();
    { const int ntile = (t0 / 16 + 3 + 63) / 64;
      const bf16_t* KC = (const bf16_t*)(a.ws + WS_KC) + (size_t)g * 1024 * 128; const bf16_t* VCT = (const bf16_t*)(a.ws + WS_VCT) + (size_t)g * 128 * 1024;
      float m = -INFINITY, l = 0.f;
#if defined(PROBE_CMP)
      run_branch<0, 64>(c, KC, VCT, 1024, 0, ntile, tb, t, t0, qf, O, m, l, 0.f, tl, imp_row);
      asm volatile("" :: "v"(m), "v"(l));
      m = -INFINITY; l = 0.f;
#endif
      run_branch<0, 64>(c, KC, VCT, 1024, 0, ntile, tb, t, t0, qf, O, m, l, 0.f, tl, imp_row);
      const float lt = xhalf_sum(l), inv = lt > 0.f ? 1.f / lt : 0.f;
      run_branch<1, 64>(c, KC, VCT, 1024, 0, ntile, tb, t, t0, qf, O, m, l, inv, tl, imp_row);
      const float gc = GATE[(size_t)t * 24 + head];
#pragma unroll
      for (int dt = 0; dt < 4; ++dt)
#pragma unroll
          for (int rg = 0; rg < 4; ++rg) {
              u32x2 w; w[0] = cvt_pk_bf16(gc * O[dt][4 * rg], gc * O[dt][4 * rg + 1]); w[1] = cvt_pk_bf16(gc * O[dt][4 * rg + 2], gc * O[dt][4 * rg + 3]);
              *(u32x2*)(Y + 32 * dt + 8 * rg) = w;
#pragma unroll
              for (int e = 0; e < 4; ++e) O[dt][4 * rg + e] = 0.f;
          }
    }
    {
        const int ncand = qt - 2 > 0 ? qt - 2 : 0;
        unsigned v[8][4], selm[8];
#pragma unroll
        for (int i = 0; i < 8; ++i) {
            LAS const float* row = (LAS const float*)(lds + AT_IMP) + (8 * wave + i) * 256;
            selm[i] = 0u;
#pragma unroll
            for (int k = 0; k < 4; ++k) { const int j = lane + 64 * k; const bool cand = (j >= 1 && j <= qt - 2);
                v[i][k] = cand ? ((__float_as_uint(row[j]) & ~0xFFu) | (unsigned)(255 - j)) : 0u; if (ncand <= 13 && cand) selm[i] |= 1u << k; }
        }
        if (ncand > 13) {
            for (int it = 0; it < 13; ++it) {
#pragma unroll
                for (int i = 0; i < 8; ++i) {
                    const unsigned mx = wave_umax_bcast(max(max(v[i][0], v[i][1]), max(v[i][2], v[i][3])));
#pragma unroll
                    for (int k = 0; k < 4; ++k) if (v[i][k] == mx) { v[i][k] = 0u; selm[i] |= 1u << k; }
                }
            }
        }
        unsigned wu[8];
#pragma unroll
        for (int k = 0; k < 8; ++k) wu[k] = 0u;
#pragma unroll
        for (int i = 0; i < 8; ++i)
#pragma unroll
            for (int k = 0; k < 4; ++k) {
                const int j = lane + 64 * k; const bool forced = (j == 0) || (j == qt) || (j == qt - 1);
                const unsigned long long mk = __ballot(((selm[i] >> k) & 1u) || forced);
                const unsigned lo = (unsigned)mk, hi = (unsigned)(mk >> 32);
                if (lane == 0) { *(LAS unsigned*)(lds + AT_BM + ((8 * wave + i) * 8 + 2 * k) * 4) = lo; *(LAS unsigned*)(lds + AT_BM + ((8 * wave + i) * 8 + 2 * k + 1) * 4) = hi; }
                wu[2 * k] |= lo; wu[2 * k + 1] |= hi;
            }
        if (lane == 0) {
#pragma unroll
            for (int k = 0; k < 8; ++k) *(LAS unsigned*)(lds + AT_WU + (wave * 8 + k) * 4) = wu[k];
        }
    }
    __syncthreads();
#if defined(PROBE_SEL)
    { float m = -INFINITY, l = 0.f;
      run_branch<2, 128>(c, KROW + (size_t)(2 + g) * L_ * 128, VT + (size_t)g * 128 * L_, L_, 0, qt + 1, tb, t, t0, qf, O, m, l, 0.f, tl, imp_row);
      asm volatile("" :: "v"(O[0]), "v"(O[1]), "v"(O[2]), "v"(O[3]), "v"(m), "v"(l));
#pragma unroll
      for (int dt = 0; dt < 4; ++dt)
#pragma unroll
          for (int r = 0; r < 16; ++r) O[dt][r] = 0.f; }
#endif
    { float m = -INFINITY, l = 0.f;
      run_branch<2, 128>(c, KROW + (size_t)(2 + g) * L_ * 128, VT + (size_t)g * 128 * L_, L_, 0, qt + 1, tb, t, t0, qf, O, m, l, 0.f, tl, imp_row);
      const float gs = GATE[(size_t)t * 24 + 8 + head];
      const float lt = xhalf_sum(l), sc = gs * (lt > 0.f ? 1.f / lt : 0.f);
#pragma unroll
      for (int dt = 0; dt < 4; ++dt)
#pragma unroll
          for (int rg = 0; rg < 4; ++rg) {
              const u32x2 w0 = *(const u32x2*)(Y + 32 * dt + 8 * rg);
              u32x2 w; w[0] = cvt_pk_bf16(bflo(w0[0]) + sc * O[dt][4 * rg], bfhi(w0[0]) + sc * O[dt][4 * rg + 1]); w[1] = cvt_pk_bf16(bflo(w0[1]) + sc * O[dt][4 * rg + 2], bfhi(w0[1]) + sc * O[dt][4 * rg + 3]);
              *(u32x2*)(Y + 32 * dt + 8 * rg) = w;
#pragma unroll
              for (int e = 0; e < 4; ++e) O[dt][4 * rg + e] = 0.f;
          }
    }
#if defined(PROBE_WIN)
    { float m = -INFINITY, l = 0.f;
      const int lo = qt - 8 > 0 ? qt - 8 : 0;
      run_branch<3, 128>(c, KROW + (size_t)(4 + g) * L_ * 128, VT + (size_t)(2 + g) * 128 * L_, L_, lo, qt + 1, tb, t, t0, qf, O, m, l, 0.f, tl, imp_row);
      asm volatile("" :: "v"(O[0]), "v"(O[1]), "v"(O[2]), "v"(O[3]), "v"(m), "v"(l));
#pragma unroll
      for (int dt = 0; dt < 4; ++dt)
#pragma unroll
          for (int r = 0; r < 16; ++r) O[dt][r] = 0.f; }
#endif
    { float m = -INFINITY, l = 0.f;
      const int lo = qt - 8 > 0 ? qt - 8 : 0;
      run_branch<3, 128>(c, KROW + (size_t)(4 + g) * L_ * 128, VT + (size_t)(2 + g) * 128 * L_, L_, lo, qt + 1, tb, t, t0, qf, O, m, l, 0.f, tl, imp_row);
      const float gw = GATE[(size_t)t * 24 + 16 + head];
      const float lt = xhalf_sum(l), sc = gw * (lt > 0.f ? 1.f / lt : 0.f);
      float ss = 0.f;
#pragma unroll
      for (int dt = 0; dt < 4; ++dt)
#pragma unroll
          for (int rg = 0; rg < 4; ++rg) {
              const u32x2 w0 = *(const u32x2*)(Y + 32 * dt + 8 * rg);
              const float y0 = bflo(w0[0]) + sc * O[dt][4 * rg], y1 = bfhi(w0[0]) + sc * O[dt][4 * rg + 1], y2 = bflo(w0[1]) + sc * O[dt][4 * rg + 2], y3 = bfhi(w0[1]) + sc * O[dt][4 * rg + 3];
              u32x2 w; w[0] = cvt_pk_bf16(y0, y1); w[1] = cvt_pk_bf16(y2, y3);
              *(u32x2*)(Y + 32 * dt + 8 * rg) = w;
              ss += (y0 * y0 + y1 * y1) + (y2 * y2 + y3 * y3);
          }
      ss = quad_sum(xhalf_sum(ss));
      if (hl == 0 && h == 0) ((float*)(a.ws + WS_STAP))[(size_t)t * 2 + g] = ss;
    }
    __syncthreads();
}
#ifndef PEER_ALPHA
#define PEER_ALPHA 1.0f
#endif
constexpr int PE_SC = 0, PE_LV = 65536, PE_LI = 73728, PE_PK = 81920, PE_EX = 147456, PE_GT = 149504, PE_SU = 153600, PE_CE = 157696, PE_END = 161792;
constexpr int PE_SLOT = 2048, PE_NSLOT = 8, PE_RINGW = PE_SLOT * 9;
static_assert(8 * PE_RINGW <= PE_EX && PE_END <= LDS_BYTES - 32, "PEER LDS map");
__device__ __forceinline__ float pair_wave_sum(float a, float b, bool odd) {
    a += dpp_f<0xB1>(a); b += dpp_f<0xB1>(b);
    float c = odd ? b : a;
    c += dpp_f<0x4E>(c); c += dpp_f<0x124>(c); c += dpp_f<0x128>(c);
    { const auto r = __builtin_amdgcn_permlane16_swap(__float_as_uint(c), __float_as_uint(c), false, false); c = __uint_as_float(r[0]) + __uint_as_float(r[1]); }
    { const auto r = __builtin_amdgcn_permlane32_swap(__float_as_uint(c), __float_as_uint(c), false, false); c = __uint_as_float(r[0]) + __uint_as_float(r[1]); }
    return c;
}
__device__ __forceinline__ float wave_sum_bcast(float v) {
    v += dpp_f<0xB1>(v); v += dpp_f<0x4E>(v); v += dpp_f<0x141>(v); v += dpp_f<0x140>(v);
    v += __int_as_float(__builtin_amdgcn_update_dpp(0, __float_as_int(v), 0x142, 0xa, 0xf, false));
    v += __int_as_float(__builtin_amdgcn_update_dpp(0, __float_as_int(v), 0x143, 0xc, 0xf, false));
    return __int_as_float(__builtin_amdgcn_readlane(__float_as_int(v), 63));
}
__device__ __forceinline__ unsigned mono_key(float v) { const unsigned b = __float_as_uint(v); return b ^ ((b >> 31) ? 0xFFFFFFFFu : 0x80000000u); }
template <int CTRL>
__device__ __forceinline__ void quad_merge16(unsigned (&t)[16]) {
    unsigned o[16];
#pragma unroll
    for (int i = 0; i < 16; ++i) o[i] = (unsigned)__builtin_amdgcn_update_dpp(0, (int)t[15 - i], CTRL, 0xf, 0xf, false);
#pragma unroll
    for (int i = 0; i < 16; ++i) t[i] = max(t[i], o[i]);
#pragma unroll
    for (int st = 8; st >= 1; st >>= 1)
#pragma unroll
        for (int i = 0; i < 16; ++i) if ((i & st) == 0) { const unsigned hi = max(t[i], t[i + st]), lo = min(t[i], t[i + st]); t[i] = hi; t[i + st] = lo; }
}
__device__ __forceinline__ void sort16_desc(unsigned (&t)[16]) {
#pragma unroll
    for (int k = 2; k <= 16; k <<= 1)
#pragma unroll
        for (int j = k >> 1; j > 0; j >>= 1)
#pragma unroll
            for (int i = 0; i < 16; ++i) { const int l = i ^ j; if (l > i) { const bool desc = ((i & k) == 0); const unsigned hi = max(t[i], t[l]), lo = min(t[i], t[l]); t[i] = desc ? hi : lo; t[l] = desc ? lo : hi; } }
}
__device__ __forceinline__ void bitonic_merge16_desc(unsigned (&t)[16]) {
#pragma unroll
    for (int st = 8; st >= 1; st >>= 1)
#pragma unroll
        for (int i = 0; i < 16; ++i) if ((i & st) == 0) { const unsigned hi = max(t[i], t[i + st]), lo = min(t[i], t[i + st]); t[i] = hi; t[i + st] = lo; }
}
__device__ __forceinline__ int pair_a(int p) { return p < 16 ? 0 : p < 24 ? 1 : p < 29 ? 2 : p < 33 ? 3 : p < 36 ? 4 : p < 38 ? 5 : p < 40 ? 6 : p < 42 ? 7 : p - 34; }
__device__ __forceinline__ int pair_b(int p) { return p < 16 ? p : p < 24 ? p - 16 : p < 29 ? p - 24 : p < 33 ? p - 29 : p < 36 ? p - 33 : p < 38 ? p - 36 : p < 40 ? p - 38 : p < 42 ? p - 40 : 0; }
template <bool DRY>
__device__ __forceinline__ void peer_step(const Args& a, const Ctx& c_, int t0) {
    Ctx c = c_; { int tz = c_.tid; asm volatile("" : "+v"(tz)); c.tid = tz; c.lane = tz & 63; }
    LAS unsigned char* lds = c.lds;
    const int tid = c.tid, wave = c.wave, lane = c.lane, r = lane & 15, q = lane >> 4;
    const bf16_t* QP = (const bf16_t*)(a.ws + WS_QP); const bf16_t* PK = (const bf16_t*)(a.ws + WS_PK);
    const unsigned char* PU = a.ws + WS_PU; const unsigned char* PV = a.ws + WS_PV; const float* psc = (const float*)(a.ws + WS_PSC);
    const bf16_t* HB = (const bf16_t*)(a.ws + WS_H2);
    const int t = t0 + wave;
    u32x2 hraw[8], xw[8];
#pragma unroll
    for (int k = 0; k < 8; ++k) hraw[k] = *(const u32x2*)(HB + (size_t)t * 2048 + 256 * k + lane * 4);
#pragma unroll
    for (int k = 0; k < 8; ++k) xw[k] = *(const u32x2*)((const bf16_t*)(a.ws + WS_X1) + (size_t)t * 2048 + 256 * k + lane * 4);
    const float r2 = ((const float*)(a.ws + WS_RSTD2))[t0 + ((tid >> 5) & 7)];
    {
#pragma unroll
        for (int i = 0; i < 8; ++i) { const int pc = 8 * wave + i, row = 4 * pc + (lane >> 4), ch = (lane & 15) ^ kswz(row);
            __builtin_amdgcn_global_load_lds((const unsigned*)(PK + (size_t)row * 128 + ch * 8), (LAS unsigned*)(lds + PE_PK + pc * 1024), 16, 0, 0); }
        const int hh = wave;
        bf16x8 aF[2][4];
#pragma unroll
        for (int cc = 0; cc < 2; ++cc)
#pragma unroll
            for (int ks = 0; ks < 4; ++ks) aF[cc][ks] = *(const bf16x8*)(QP + (size_t)(t0 + (r & 7)) * 2048 + hh * 256 + cc * 128 + 32 * ks + 8 * q);
        asm volatile("s_waitcnt vmcnt(0)" ::: "memory");
        __syncthreads();
        const int ksw = kswz(r);
#pragma unroll
        for (int cc = 0; cc < 2; ++cc)
#pragma unroll 2
            for (int nt = 0; nt < 8; ++nt) {
                f32x4 acc = {0.f, 0.f, 0.f, 0.f};
#pragma unroll
                for (int ks = 0; ks < 4; ++ks) { const bf16x8 B = *(const LAS bf16x8*)(lds + PE_PK + (cc * 128 + 16 * nt + r) * 256 + 16 * ((4 * ks + q) ^ ksw)); acc = mfma16(aF[cc][ks], B, acc); }
                if (q < 2) {
#pragma unroll
                    for (int i = 0; i < 4; ++i) { const int task = (4 * q + i) * 16 + hh * 2 + cc; *(LAS float*)(lds + PE_SC + (task * 128 + ((16 * nt + r + task) & 127)) * 4) = acc[i]; }
                }
            }
    }
    __syncthreads();
    {
        const int task = tid >> 2, part = tid & 3;
        LAS const float* sc = (LAS const float*)(lds + PE_SC) + task * 128;
        float vals[32];
#pragma unroll
        for (int k = 0; k < 32; ++k) vals[k] = sc[(32 * part + k + task) & 127];
        unsigned top[16], tb[16];
#pragma unroll
        for (int k = 0; k < 16; ++k) { top[k] = (mono_key(vals[k]) & ~0x7Fu) | (unsigned)(127 - (32 * part + k)); tb[k] = (mono_key(vals[16 + k]) & ~0x7Fu) | (unsigned)(127 - (32 * part + 16 + k)); }
        sort16_desc(top); sort16_desc(tb);
#pragma unroll
        for (int i = 0; i < 16; ++i) top[i] = max(top[i], tb[15 - i]);
        bitonic_merge16_desc(top);
        quad_merge16<0xB1>(top);
        quad_merge16<0x4E>(top);
        if (part == 0) {
#pragma unroll
            for (int e = 0; e < 16; ++e) { const int idx = 127 - (int)(top[e] & 0x7Fu); *(LAS float*)(lds + PE_LV + (task * 16 + e) * 4) = sc[(idx + task) & 127]; *(LAS int*)(lds + PE_LI + (task * 16 + e) * 4) = idx; }
        }
    }
    __syncthreads();
    if (tid < 256) {
        const int task = tid >> 2, part = tid & 3, tok = task >> 3, hh = task & 7, t1 = tok * 16 + hh * 2, t2 = t1 + 1;
        LAS const float* lv1 = (LAS const float*)(lds + PE_LV) + t1 * 16; LAS const float* lv2 = (LAS const float*)(lds + PE_LV) + t2 * 16;
        unsigned top[16];
#pragma unroll
        for (int i = 0; i < 16; ++i) {
            const int p = part + 4 * i;
            top[i] = 0u;
            if (i < 13 && p < 50) { const int aa = pair_a(p), bb = pair_b(p); top[i] = (mono_key(lv1[aa] + lv2[bb]) & ~0xFFu) | (unsigned)(255 - (aa * 16 + bb)); }
        }
        sort16_desc(top);
        quad_merge16<0xB1>(top);
        quad_merge16<0x4E>(top);
        if (part == 0) {
            LAS const int* li1 = (LAS const int*)(lds + PE_LI) + t1 * 16; LAS const int* li2 = (LAS const int*)(lds + PE_LI) + t2 * 16;
            float sv[16]; int ex[16]; float mx = -INFINITY;
#pragma unroll
            for (int e = 0; e < 16; ++e) {
                const int id = 255 - (int)(top[e] & 0xFFu), aa = id >> 4, bb = id & 15;
                sv[e] = lv1[aa] + lv2[bb]; ex[e] = li1[aa] * 128 + li2[bb]; mx = fmaxf(mx, sv[e]);
            }
            float sum = 0.f;
#pragma unroll
            for (int e = 0; e < 16; ++e) { sv[e] = fexp2((sv[e] - mx) * LOG2E); sum += sv[e]; }
            const float inv = 1.f / sum;
#pragma unroll
            for (int e = 0; e < 16; ++e) *(LAS unsigned short*)(lds + PE_EX + (tok * 128 + hh * 16 + e) * 2) = (unsigned short)ex[e];
            f32x4 rec[16];
#pragma unroll
            for (int e = 0; e < 16; ++e) rec[e] = *(const f32x4*)(psc + (size_t)ex[e] * 4);
            __builtin_amdgcn_sched_barrier(0);
#pragma unroll
            for (int e = 0; e < 16; ++e) asm volatile("" :: "v"(rec[e]));
#pragma unroll
            for (int e = 0; e < 16; ++e) {
                *(LAS float*)(lds + PE_GT + (tok * 128 + hh * 16 + e) * 4) = sv[e] * inv * rec[e][2];
                *(LAS float*)(lds + PE_SU + (tok * 128 + hh * 16 + e) * 4) = rec[e][0] * r2;
                *(LAS float*)(lds + PE_CE + (tok * 128 + hh * 16 + e) * 4) = rec[e][1]; }
        }
    }
    __syncthreads();
    f32x2 hp[16];
#pragma unroll
    for (int k = 0; k < 8; ++k)
#pragma unroll
        for (int e = 0; e < 2; ++e) { hp[k * 2 + e][0] = bflo(hraw[k][e]); hp[k * 2 + e][1] = bfhi(hraw[k][e]); }
    f32x2 acc[16];
#pragma unroll
    for (int e = 0; e < 16; ++e) acc[e] = (f32x2){0.f, 0.f};
    asm volatile("s_waitcnt vmcnt(0)" ::: "memory");
    f32x4 gvv[8], fvv[8];
    {
        int lo_ = wave * 512 + (lane & 1) * 4; asm volatile("" : "+v"(lo_));
        LAS const float* gtl = (LAS const float*)(lds + PE_GT + lo_); LAS const float* sul = (LAS const float*)(lds + PE_SU + lo_); LAS const float* cel = (LAS const float*)(lds + PE_CE + lo_);
        int xo_ = wave * 256; asm volatile("" : "+v"(xo_));
        LAS const unsigned short* exl = (LAS const unsigned short*)(lds + PE_EX + xo_);
        const bool odd = lane & 1;
        LAS unsigned char* ring = lds + wave * PE_RINGW;
#define ISSUE_U(SL, IDX) do { const int ex_ = __builtin_amdgcn_readfirstlane((int)exl[IDX]); \
            __builtin_amdgcn_global_load_lds((const unsigned*)(PU + (size_t)ex_ * 1024 + lane * 16), (LAS unsigned*)(ring + (SL) * PE_SLOT), 16, 0, 0); } while (0)
#define ISSUE_V(SL, IDX) do { const int ex_ = __builtin_amdgcn_readfirstlane((int)exl[IDX]); \
            __builtin_amdgcn_global_load_lds((const unsigned*)(PV + (size_t)ex_ * 1024 + lane * 16), (LAS unsigned*)(ring + (SL) * PE_SLOT + 1024), 16, 0, 0); } while (0)
#define UDOT(UW, D0, D1, D2, D3) do { _Pragma("unroll") for (int dw = 0; dw < 4; ++dw) { const f32x2 f0_ = fp4_unpk<0>(UW[dw]), f1_ = fp4_unpk<1>(UW[dw]), f2_ = fp4_unpk<2>(UW[dw]), f3_ = fp4_unpk<3>(UW[dw]); \
                D0 += f0_ * hp[4 * dw]; D1 += f1_ * hp[4 * dw + 1]; D2 += f2_ * hp[4 * dw + 2]; D3 += f3_ * hp[4 * dw + 3]; } } while (0)
#define VACC(VW, WG) do { _Pragma("unroll") for (int dw = 0; dw < 4; ++dw) { const f32x2 f0_ = fp4_unpk<0>(VW[dw]), f1_ = fp4_unpk<1>(VW[dw]), f2_ = fp4_unpk<2>(VW[dw]), f3_ = fp4_unpk<3>(VW[dw]); \
                acc[4 * dw] += WG * f0_; acc[4 * dw + 1] += WG * f1_; acc[4 * dw + 2] += WG * f2_; acc[4 * dw + 3] += WG * f3_; } } while (0)
#define STAGE_A(SA, SB, PA, PB) do { const u32x4 ua_ = *(const LAS u32x4*)(ring + (SA) * PE_SLOT + lane * 16), ub_ = *(const LAS u32x4*)(ring + (SB) * PE_SLOT + lane * 16); \
            f32x2 a0_ = {0.f, 0.f}, a1_ = {0.f, 0.f}, a2_ = {0.f, 0.f}, a3_ = {0.f, 0.f}, b0_ = {0.f, 0.f}, b1_ = {0.f, 0.f}, b2_ = {0.f, 0.f}, b3_ = {0.f, 0.f}; \
            UDOT(ua_, a0_, a1_, a2_, a3_); UDOT(ub_, b0_, b1_, b2_, b3_); \
            const f32x2 as_ = (a0_ + a1_) + (a2_ + a3_), bs_ = (b0_ + b1_) + (b2_ + b3_); PA = as_[0] + as_[1]; PB = bs_[0] + bs_[1]; } while (0)
#define STAGE_B(IDX, PA, PB, WA, WB) do { const float cs_ = pair_wave_sum(PA, PB, odd);                           \
            const float wl_ = gtl[IDX] * gelu_tanh(cs_ * sul[IDX] + cel[IDX]);                            \
            WA = dpp_f<0xA0>(wl_); WB = dpp_f<0xF5>(wl_); } while (0)
#define STAGE_C(SA, SB, WA, WB) do { const u32x4 va_ = *(const LAS u32x4*)(ring + (SA) * PE_SLOT + 1024 + lane * 16), vb_ = *(const LAS u32x4*)(ring + (SB) * PE_SLOT + 1024 + lane * 16); \
            VACC(va_, WA); VACC(vb_, WB); } while (0)
#define DMA_WAIT(N) asm volatile("s_waitcnt vmcnt(" #N ")" ::: "memory")
#define LDS_DONE() asm volatile("s_waitcnt lgkmcnt(0)" ::: "memory")
#define PAIR_ITER(P, NS, DOA, UW, DOU, VW, DOV) do { float na_ = 0.f, nb_ = 0.f, wa_, wb_; \
            if (DOA) { DMA_WAIT(UW); STAGE_A(NS, (NS) + 1, na_, nb_); } \
            STAGE_B(e + 2 * (P), pa, pb, wa_, wb_); \
            LDS_DONE(); \
            if (DOU) { ISSUE_U(NS, e + 2 * (P) + 10); ISSUE_U((NS) + 1, e + 2 * (P) + 11); } \
            DMA_WAIT(VW); STAGE_C(2 * (P), 2 * (P) + 1, wa_, wb_); \
            LDS_DONE(); \
            if (DOV) { ISSUE_V(2 * (P), e + 2 * (P) + 8); ISSUE_V(2 * (P) + 1, e + 2 * (P) + 9); } \
            pa = na_; pb = nb_; } while (0)
        float pa, pb;
        if (!DRY) {
        ISSUE_U(0, 0); ISSUE_U(1, 1); ISSUE_U(2, 2); ISSUE_U(3, 3); ISSUE_V(0, 0); ISSUE_V(1, 1); ISSUE_U(4, 4); ISSUE_U(5, 5); ISSUE_V(2, 2); ISSUE_V(3, 3);
        ISSUE_U(6, 6); ISSUE_U(7, 7); ISSUE_V(4, 4); ISSUE_V(5, 5);
        DMA_WAIT(12); STAGE_A(0, 1, pa, pb); LDS_DONE();
        ISSUE_U(0, 8); ISSUE_U(1, 9); ISSUE_V(6, 6); ISSUE_V(7, 7);
#pragma unroll 1
        for (int tr = 0; tr < 14; ++tr) {
            const int e = tr * 8;
            PAIR_ITER(0, 2, true, 14, true, 14, true);
            PAIR_ITER(1, 4, true, 14, true, 14, true);
            PAIR_ITER(2, 6, true, 14, true, 14, true);
            PAIR_ITER(3, 0, true, 14, true, 14, true);
        }
        { const int e = 14 * 8;
            PAIR_ITER(0, 2, true, 14, true, 14, true);
            PAIR_ITER(1, 4, true, 14, true, 14, true);
            PAIR_ITER(2, 6, true, 14, true, 14, true);
            PAIR_ITER(3, 0, true, 14, false, 12, true); }
        { const float* g2 = (const float*)(a.ws + WS_COND) + 5 * 2048; const float* fg = a.in[32];
#pragma unroll
          for (int k = 0; k < 8; ++k) { const int col = 256 * k + lane * 4; gvv[k] = *(const f32x4*)(g2 + col); fvv[k] = *(const f32x4*)(fg + col); } }
        { const int e = 15 * 8;
            PAIR_ITER(0, 2, true, 28, false, 26, false);
            PAIR_ITER(1, 4, true, 24, false, 22, false);
            PAIR_ITER(2, 6, true, 20, false, 18, false);
            PAIR_ITER(3, 0, false, 0, false, 16, false); }
        }
#undef ISSUE_U
#undef ISSUE_V
#undef STAGE_A
#undef STAGE_B
#undef STAGE_C
#undef LDS_DONE
#undef PAIR_ITER
#undef UDOT
#undef VACC
#undef DMA_WAIT
    }
    {
        float* xo = a.out + (size_t)t * 2048;
        float ss = 0.f;
#pragma unroll
        for (int k = 0; k < 8; ++k) {
            const float x1[4] = {bflo(xw[k][0]), bfhi(xw[k][0]), bflo(xw[k][1]), bfhi(xw[k][1])};
#pragma unroll
            for (int e = 0; e < 4; ++e) { const float x2 = x1[e] + PEER_ALPHA * gvv[k][e] * acc[k * 2 + (e >> 1)][e & 1]; acc[k * 2 + (e >> 1)][e & 1] = x2; ss += x2 * x2; }
        }
        ss = wave_sum_bcast(ss);
        const float rstd = rsqrtf(ss * (1.f / 2048.f) + 1e-6f);
#pragma unroll
        for (int k = 0; k < 8; ++k) {
            const int col = 256 * k + lane * 4;
            f32x4 o;
#pragma unroll
            for (int e = 0; e < 4; ++e) o[e] = acc[k * 2 + (e >> 1)][e & 1] * rstd * fvv[k][e];
            if (!DRY || rstd == 123.456f) *(f32x4*)(xo + col) = o;
        }
    }
    __syncthreads();
}
constexpr int NPHASE = 11;
#ifndef DBG
#define DBG 0
#endif
__device__ __forceinline__ void dbg_final_norm(const Args& a, const Ctx& c, const float* src) {
    for (int t = c.bid * 8 + c.wave; t < L_; t += c.nb * 8) {
        const float* xr = src + (size_t)t * 2048 + c.lane * 4; float* o = a.out + (size_t)t * 2048 + c.lane * 4;
        f32x4 v[8]; float ss = 0.f;
#pragma unroll
        for (int j = 0; j < 8; ++j) { v[j] = *(const f32x4*)(xr + j * 256); ss += v[j][0] * v[j][0] + v[j][1] * v[j][1] + v[j][2] * v[j][2] + v[j][3] * v[j][3]; }
        ss = wave_sum(ss);
        const float rstd = rsqrtf(ss * (1.f / 2048.f) + 1e-6f);
#pragma unroll
        for (int j = 0; j < 8; ++j) { const f32x4 g = *(const f32x4*)(a.in[32] + j * 256 + c.lane * 4); *(f32x4*)(o + j * 256) = v[j] * rstd * g; }
    }
}

extern __shared__ __attribute__((aligned(16))) unsigned char smem[];

__global__ void __launch_bounds__(512, 2) fwd(Args a) {
    LAS unsigned char* lds = (LAS unsigned char*)smem;
    Ctx c; c.bid = blockIdx.x; c.nb = gridDim.x; c.tid = threadIdx.x; c.wave = __builtin_amdgcn_readfirstlane(threadIdx.x >> 6); c.lane = threadIdx.x & 63; c.lds = lds;
    volatile LAS unsigned* xbw = (volatile LAS unsigned*)(lds + LDS_BYTES - 16);
    if (c.tid < 4) xbw[c.tid] = 0u;
    __syncthreads();
    const int lo = a.ph_lo, hi = a.ph_hi;
    const bool multi = (hi - lo) > 1;
    XcdBarrier bar; bar.bar = (unsigned*)(a.ws + WS_CTL); bar.x = 0; bar.st = xbw;
    if (multi) bar = xcd_barrier_post((unsigned*)(a.ws + WS_CTL), xbw);
#ifndef PHASE_MASK
#define PHASE_MASK 0xFFFF
#endif
#if DBG == 1
#undef PHASE_MASK
#define PHASE_MASK 0x403
#elif DBG == 2 || DBG == 4 || DBG == 5
#undef PHASE_MASK
#define PHASE_MASK 0x4FF
#endif
#define IN(k) (((PHASE_MASK >> (k)) & 1) && lo <= (k) && (k) < hi)
#define REFRESH() do { int tz_ = threadIdx.x; asm volatile("" : "+v"(tz_)); c.tid = tz_; c.lane = tz_ & 63; c.wave = __builtin_amdgcn_readfirstlane(tz_ >> 6); } while (0)
#define SEAM(k) do { if (IN(k) && IN((k) + 1)) xcd_barrier(bar); } while (0)
#ifndef DUP
#define DUP -1
#endif
#define REP(k) for (int rep_ = 0; rep_ < ((DUP == (k)) ? 2 : 1); ++rep_)
#define DUP2(k, ...) do { __VA_ARGS__; if (DUP == (k)) { __syncthreads(); __VA_ARGS__; } } while (0)

    if (IN(0)) REP(0) { REFRESH(); p0_prologue(a, c); }
    SEAM(0);
    if (IN(1)) { REFRESH(); DUP2(1, p1_hnorm(a, c)); }
    SEAM(1);
    if (IN(2)) { REFRESH();
        pg8::StaticOrder S; S.init((const bf16_t*)(a.ws + WS_H), (const bf16_t*)(a.ws + WS_WIN), 2048, 2048, 2048, L_, DIN_PAD, c.nb, c.bid);
        EpiWin E{(bf16_t*)(a.ws + WS_US), (bf16_t*)(a.ws + WS_Q), (bf16_t*)(a.ws + WS_KROW), (bf16_t*)(a.ws + WS_VROW), (bf16_t*)(a.ws + WS_VT), (float*)(a.ws + WS_GATE)};
        DUP2(2, pg8::gemm_phase<EpiWin, pg8::StaticOrder>(lds, S, E));
        { const int nfull = (L_ / 256) * (DIN_PAD / 256) % c.nb, first = nfull, cnt = c.nb - nfull;
          if (c.bid >= first) { Ctx c2 = c; c2.bid = c.bid - first; c2.nb = cnt;
              conv_fp4rows(a.in[31], a.ws + WS_PV, (float*)(a.ws + WS_PSC) + 2, 16384, c2); } }
    }
    SEAM(2);
    if (IN(3)) { REFRESH();
        DUP2(31, for (int it = c.bid; it < 256; it += c.nb) s5_item<0>(a, c, it >> 2, it & 3));
        __syncthreads();
        CmpOrder S{(const bf16_t*)(a.ws + WS_KROW), (const bf16_t*)(a.ws + WS_VROW), (const bf16_t*)(a.ws + WS_W1), 2048, 4096, 256, c.nb, c.bid};
        EpiSlab E{(float*)(a.ws + WS_SLAB)};
        DUP2(32, pg8::gemm_phase<EpiSlab, CmpOrder>(lds, S, E));
    }
    SEAM(3);
    if (IN(4)) { REFRESH();
        DUP2(41, for (int it = c.bid; it < 256; it += c.nb) cmp_finish_item(a, c, it >> 7, it & 127));
        DUP2(42, for (int it = c.bid; it < 256; it += c.nb) s5_item<1>(a, c, it >> 2, it & 3));
    }
    SEAM(4);
    if (IN(5)) { REFRESH();
#if DBG == 5
        for (size_t i = (size_t)c.bid * NTHREADS + c.tid; i < (size_t)L_ * 1024 / 8; i += (size_t)c.nb * NTHREADS) *(u32x4*)((bf16_t*)(a.ws + WS_YSSM) + i * 8) = (u32x4){0u, 0u, 0u, 0u};
#else
        {
            pg8::StaticOrder S; S.init((const bf16_t*)(a.ws + WS_Z), (const bf16_t*)(a.ws + WS_WGLU), 1024, 1024, 1024, L_, 1024, c.nb, c.bid);
            EpiGlu E{(const bf16_t*)(a.ws + WS_Z), a.in[19], (bf16_t*)(a.ws + WS_Y2), (float*)(a.ws + WS_STSP)};
            DUP2(55, pg8::gemm_phase<EpiGlu, pg8::StaticOrder>(lds, S, E));
        }
#endif
        __syncthreads();
        REP(5)
#if DBG == 4
        for (size_t i = (size_t)c.bid * NTHREADS + c.tid; i < (size_t)L_ * 1024 / 8; i += (size_t)c.nb * NTHREADS) *(u32x4*)((bf16_t*)(a.ws + WS_YATT) + i * 8) = (u32x4){0u, 0u, 0u, 0u};
#else
        {
            unsigned* qhead = (unsigned*)(a.ws + WS_CTL) + 8192;
            volatile LAS unsigned* slot = (volatile LAS unsigned*)(lds + LDS_BYTES - 32);
            for (;;) {
                if (c.tid == 0) *slot = __hip_atomic_fetch_add(qhead, 1u, __ATOMIC_RELAXED, __HIP_MEMORY_SCOPE_AGENT);
                __syncthreads();
                const unsigned q = *slot;
                __syncthreads();
                if (q >= 512u) break;
                attn_item(a, c, 255 - (int)(q >> 1), (int)(q & 1));
            }
        }
#endif
    }
    SEAM(5);
#define WOUT_GEMM(PM0) do { pg8::StaticOrder S; S.init((const bf16_t*)(a.ws + WS_Y2), (const bf16_t*)(a.ws + WS_WOUT), 2048, 2048, 2048, L_ / 2, 2048, c.nb, c.bid, PM0); \
        rsa_prepass(S, (const float*)(a.ws + WS_STSP), (const float*)(a.ws + WS_STAP), (float*)(a.ws + WS_RSA), c.tid); \
        EpiWout E{a.in[0], (const float*)(a.ws + WS_COND) + 2 * 2048, (const float*)(a.ws + WS_F2), (bf16_t*)(a.ws + WS_X1), (bf16_t*)(a.ws + WS_H2), (float*)(a.ws + WS_ST2P), (const float*)(a.ws + WS_RSA)}; \
        pg8::gemm_phase<EpiWout, pg8::StaticOrder>(lds, S, E); __syncthreads(); } while (0)
#define WQ_GEMM(PM0) do { pg8::StaticOrder S; S.init((const bf16_t*)(a.ws + WS_H2), (const bf16_t*)(a.ws + WS_WQ), 2048, 2048, 2048, L_ / 2, 2048, c.nb, c.bid, PM0); \
        rstd2_prepass(S, (const float*)(a.ws + WS_ST2P), (float*)(a.ws + WS_RSTD2), c.tid); \
        EpiQ E{(bf16_t*)(a.ws + WS_QP), (const float*)(a.ws + WS_RSTD2), (const float*)(a.ws + WS_CQ)}; pg8::gemm_phase<EpiQ, pg8::StaticOrder>(lds, S, E); __syncthreads(); } while (0)
#define PEER_STEPS(FIRST, COUNT) do { for (int s_ = (FIRST) + c.bid; s_ < (FIRST) + (COUNT); s_ += c.nb) peer_step<false>(a, c, s_ * 8); } while (0)
    if (IN(6)) { REFRESH(); DUP2(7, p_cqce(a, c)); DUP2(71, WOUT_GEMM(0)); }
    SEAM(6);
    if (IN(7)) { REFRESH(); DUP2(8, WQ_GEMM(0)); }
    SEAM(7);
    if (IN(8)) { REFRESH();
        if ((c.bid >> 3) & 1) PEER_STEPS(0, 512);
        WOUT_GEMM(32);
        if (!((c.bid >> 3) & 1)) PEER_STEPS(0, 512); }
    SEAM(8);
    if (IN(9)) { REFRESH();
        if ((c.bid >> 3) & 1) PEER_STEPS(512, 512);
        WQ_GEMM(32);
        if (!((c.bid >> 3) & 1)) PEER_STEPS(512, 512); }
    SEAM(9);
#if defined(PROBE_DRY)
    if (IN(10)) { REFRESH(); for (int s_ = 1024 + c.bid; s_ < 2048; s_ += c.nb) peer_step<true>(a, c, s_ * 8); __syncthreads(); PEER_STEPS(1024, 1024); }
#else
    if (IN(10)) { REFRESH(); DUP2(11, PEER_STEPS(1024, 1024)); }
#endif
#undef WOUT_GEMM
#undef WQ_GEMM
#undef PEER_STEPS
#undef IN
#undef SEAM
}

#ifndef N_LAUNCHES
#define N_LAUNCHES 1
#endif
extern "C" void kernel_launch(void* const* d_in, const int* in_sizes, int n_in, void* d_out, int out_size, void* d_ws, size_t ws_size, hipStream_t stream) {
    static int grid = 0;
    if (grid == 0) {
        if (n_in != 33 || out_size != L_ * D_ || ws_size < WS_END) { fprintf(stderr, "kernel_launch: unexpected shapes (n_in %d, out %d, ws %zu < %zu); nothing launched\n", n_in, out_size, ws_size, (size_t)WS_END); grid = -1; return; }
        int dev = 0, cus = 0, per_cu = 0;
        if (hipGetDevice(&dev) != hipSuccess || hipDeviceGetAttribute(&cus, hipDeviceAttributeMultiprocessorCount, dev) != hipSuccess) { grid = -1; return; }
        if (hipFuncSetAttribute((const void*)fwd, hipFuncAttributeMaxDynamicSharedMemorySize, LDS_BYTES) != hipSuccess) { fprintf(stderr, "kernel_launch: hipFuncSetAttribute failed\n"); grid = -1; return; }
        if (hipOccupancyMaxActiveBlocksPerMultiprocessor(&per_cu, (const void*)fwd, NTHREADS, LDS_BYTES) != hipSuccess || per_cu < 1) { fprintf(stderr, "kernel_launch: occupancy query says %d\n", per_cu); (void)hipGetLastError(); grid = -1; return; }
        grid = cus;
    }
    if (grid < 0) return;
    (void)hipMemsetAsync((char*)d_ws + WS_CTL, 0, CTL_BYTES, stream);
    Args a{};
    for (int i = 0; i < 33; ++i) a.in[i] = (const float*)d_in[i];
    a.out = (float*)d_out; a.ws = (unsigned char*)d_ws;
    if (N_LAUNCHES == 1) { a.ph_lo = 0; a.ph_hi = NPHASE; hipLaunchKernelGGL(fwd, dim3(grid), dim3(NTHREADS), LDS_BYTES, stream, a); }
    else for (int p = 0; p < NPHASE; ++p) { a.ph_lo = p; a.ph_hi = p + 1; hipLaunchKernelGGL(fwd, dim3(grid), dim3(NTHREADS), LDS_BYTES, stream, a); }
}
```

```cpp
#include <hip/hip_runtime.h>
#include <stdint.h>
#include <stdio.h>

#define LAS __attribute__((address_space(3)))
typedef unsigned short bf16_t;
typedef short bf16x8 __attribute__((ext_vector_type(8)));
typedef float f32x2 __attribute__((ext_vector_type(2)));
typedef float f32x4 __attribute__((ext_vector_type(4)));
typedef float f32x16 __attribute__((ext_vector_type(16)));
typedef unsigned u32x2 __attribute__((ext_vector_type(2)));
typedef unsigned u32x4 __attribute__((ext_vector_type(4)));
typedef __bf16 bfv2 __attribute__((ext_vector_type(2)));
typedef unsigned u32x6 __attribute__((ext_vector_type(6)));
typedef float f32x32 __attribute__((ext_vector_type(32)));

constexpr int L_ = 16384, D_ = 2048, DSSM = 1024, DATT = 1024, DIN = 3608, DIN_PAD = 3840;
constexpr int NADA = 12288;
constexpr float LOG2E = 1.4426950408889634f;
constexpr float QSCALE = 0.08838834764831845f * 1.4426950408889634f;
constexpr int TBN = 800;
constexpr int NTHREADS = 512;
constexpr int LDS_BYTES = 163840;

constexpr size_t al256(size_t x) { return (x + 255) & ~(size_t)255; }
constexpr size_t WS_CTL   = 0;                                  constexpr size_t CTL_BYTES = 65536;
constexpr size_t WS_CONDP = WS_CTL + CTL_BYTES;
constexpr size_t WS_COND  = WS_CONDP + 32 * 12288 * 4;
constexpr size_t WS_TB    = WS_COND + 12288 * 4;
constexpr size_t WS_BPE   = al256(WS_TB + 8 * TBN * 4);
constexpr size_t WS_S5P   = al256(WS_BPE + 2 * 256 * 4);
constexpr size_t WS_S5F   = WS_S5P + 2 * 64 * 64 * 2 * 4;
constexpr size_t WS_S5MT  = WS_S5F + 64 * 4 * 128 * 4;
constexpr size_t WS_S5WE  = WS_S5MT + (size_t)64 * 256 * 256 * 2;
constexpr size_t WS_S5WC  = WS_S5WE + (size_t)64 * 128 * 256 * 2;
constexpr size_t WS_WIN   = WS_S5WC + (size_t)64 * 256 * 128 * 2;
constexpr size_t WS_WGLU  = WS_WIN + (size_t)DIN_PAD * 2048 * 2;
constexpr size_t WS_WOUT  = WS_WGLU + (size_t)1024 * 1024 * 2;
constexpr size_t WS_WQ    = WS_WOUT + (size_t)2048 * 2048 * 2;
constexpr size_t WS_W1    = WS_WQ + (size_t)2048 * 2048 * 2;
constexpr size_t WS_W2    = WS_W1 + (size_t)2 * 256 * 4096 * 2;
constexpr size_t WS_PK    = WS_W2 + (size_t)2 * 128 * 256 * 2;
constexpr size_t WS_PU    = WS_PK + (size_t)2 * 128 * 128 * 2;
constexpr size_t WS_PV    = WS_PU + (size_t)16384 * 1024;
constexpr size_t WS_PSC   = WS_PV + (size_t)16384 * 1024;
constexpr size_t WS_BPEP  = WS_PSC + (size_t)4 * 16384 * 4;
constexpr size_t WS_H     = WS_BPEP + (size_t)32 * 2 * 256 * 4;
constexpr size_t WS_US    = WS_H + (size_t)16384 * 2048 * 2;
constexpr size_t WS_Q     = WS_US + (size_t)16384 * 1024 * 2;
constexpr size_t WS_QP    = WS_US;
constexpr size_t WS_KROW  = WS_Q + (size_t)16384 * 1024 * 2;
constexpr size_t WS_VROW  = WS_KROW + (size_t)6 * 16384 * 128 * 2;
constexpr size_t WS_VT    = WS_VROW + (size_t)2 * 16384 * 128 * 2 + 8192;
constexpr size_t WS_GATE  = WS_VT + (size_t)4 * 128 * 16384 * 2;
constexpr size_t WS_SLAB  = WS_GATE + (size_t)16384 * 24 * 4;
constexpr size_t WS_KC    = WS_SLAB + (size_t)2 * 16 * 2048 * 256 * 4;
constexpr size_t WS_VCT   = WS_KC + (size_t)2 * 1024 * 128 * 2;
constexpr size_t WS_Z     = WS_VCT + (size_t)2 * 128 * 1024 * 2;
constexpr size_t WS_YSSM  = WS_Z + (size_t)16384 * 1024 * 2;
constexpr size_t WS_YATT  = WS_YSSM + (size_t)16384 * 1024 * 2;
constexpr size_t WS_H2    = WS_SLAB;
constexpr size_t WS_RLV   = WS_Z;
constexpr size_t WS_RLI   = WS_Z + (size_t)16384 * 256 * 4;
constexpr size_t WS_Y2    = WS_YSSM;
constexpr size_t WS_X1    = WS_H;
constexpr size_t WS_ST2P  = WS_YATT + (size_t)16384 * 1024 * 2;
constexpr size_t WS_RSTD2 = WS_ST2P + (size_t)16384 * 32 * 4;
constexpr size_t WS_F2    = WS_RSTD2 + (size_t)16384 * 4;
constexpr size_t WS_CQ    = WS_F2 + 2048 * 4;
constexpr size_t WS_STSP  = WS_CQ + 2048 * 4;
constexpr size_t WS_STAP  = WS_STSP + (size_t)16384 * 16 * 4;
constexpr size_t WS_RSA   = WS_STAP + (size_t)16384 * 2 * 4;
constexpr size_t WS_END   = WS_RSA + (size_t)16384 * 2 * 4;
static_assert(WS_END < (size_t)530 * 1024 * 1024, "workspace map too large");

struct Args { const float* in[33]; float* out; unsigned char* ws; int ph_lo, ph_hi; };

__device__ __forceinline__ unsigned cvt_pk_bf16(float lo, float hi) { bfv2 v; v[0] = (__bf16)lo; v[1] = (__bf16)hi; return __builtin_bit_cast(unsigned, v); }
__device__ __forceinline__ bf16_t f2bf(float f) { return (bf16_t)(cvt_pk_bf16(f, 0.f) & 0xffffu); }
__device__ __forceinline__ float bf2f(unsigned b) { return __uint_as_float(b << 16); }
__device__ __forceinline__ float bflo(unsigned w) { return __uint_as_float(w << 16); }
__device__ __forceinline__ float bfhi(unsigned w) { return __uint_as_float(w & 0xffff0000u); }
__device__ __forceinline__ float fexp2(float x) { return __builtin_amdgcn_exp2f(x); }
__device__ __forceinline__ float frcp(float x) { return __builtin_amdgcn_rcpf(x); }
__device__ __forceinline__ float sigmoidf_(float x) { return frcp(1.f + fexp2(-LOG2E * x)); }
__device__ __forceinline__ float gelu_tanh(float x) {
    const float u = x * (1.f + 0.044715f * x * x);
    return x * frcp(1.f + fexp2(-2.f * 0.7978845608028654f * LOG2E * u));
}
__device__ __forceinline__ float shfl_xor_f(float v, int m) { return __shfl_xor(v, m, 64); }
__device__ __forceinline__ float wave_sum(float v) {
#pragma unroll
    for (int m = 32; m >= 1; m >>= 1) v += __shfl_xor(v, m, 64);
    return v;
}
__device__ __forceinline__ float wave_max(float v) {
#pragma unroll
    for (int m = 32; m >= 1; m >>= 1) v = fmaxf(v, __shfl_xor(v, m, 64));
    return v;
}
template <int CTRL> __device__ __forceinline__ float dpp_f(float x) { return __int_as_float(__builtin_amdgcn_update_dpp(0, __float_as_int(x), CTRL, 0xf, 0xf, false)); }
__device__ __forceinline__ float wave_max_bcast(float v) {
    v = fmaxf(v, dpp_f<0xB1>(v)); v = fmaxf(v, dpp_f<0x4E>(v)); v = fmaxf(v, dpp_f<0x141>(v)); v = fmaxf(v, dpp_f<0x140>(v));
    v = fmaxf(v, __int_as_float(__builtin_amdgcn_update_dpp(__float_as_int(v), __float_as_int(v), 0x142, 0xa, 0xf, false)));
    v = fmaxf(v, __int_as_float(__builtin_amdgcn_update_dpp(__float_as_int(v), __float_as_int(v), 0x143, 0xc, 0xf, false)));
    return __int_as_float(__builtin_amdgcn_readlane(__float_as_int(v), 63));
}
__device__ __forceinline__ unsigned wave_umax_bcast(unsigned v) {
#define UDPP_(x, ctrl, rm) (unsigned)__builtin_amdgcn_update_dpp((int)(x), (int)(x), ctrl, rm, 0xf, false)
    v = max(v, UDPP_(v, 0xB1, 0xf)); v = max(v, UDPP_(v, 0x4E, 0xf)); v = max(v, UDPP_(v, 0x141, 0xf)); v = max(v, UDPP_(v, 0x140, 0xf));
    v = max(v, UDPP_(v, 0x142, 0xa)); v = max(v, UDPP_(v, 0x143, 0xc));
#undef UDPP_
    return (unsigned)__builtin_amdgcn_readlane((int)v, 63);
}
__device__ __forceinline__ float quad_sum(float x) { x += dpp_f<0xB1>(x); x += dpp_f<0x4E>(x); return x; }
template <int SEL> __device__ __forceinline__ f32x2 fp4_unpk(unsigned w) { return __builtin_amdgcn_cvt_scalef32_pk_f32_fp4(w, 1.0f, SEL); }
template <int SEL> __device__ __forceinline__ unsigned fp4_pk(unsigned w, float a, float b) { return __builtin_amdgcn_cvt_scalef32_pk_fp4_f32(w, a, b, 1.0f, SEL); }
__device__ __forceinline__ f32x4 mfma16(bf16x8 a, bf16x8 b, f32x4 c) { return __builtin_amdgcn_mfma_f32_16x16x32_bf16(a, b, c, 0, 0, 0); }
__device__ __forceinline__ f32x16 mfma32(bf16x8 a, bf16x8 b, f32x16 c) { return __builtin_amdgcn_mfma_f32_32x32x16_bf16(a, b, c, 0, 0, 0); }
#define XB_TMO      128
#define XB_XCNT(j)  (256  + 64 * (j))
#define XB_XSUB(j)  (1280 + 64 * (j))
#define XB_XGEN(j)  (2304 + 64 * (j))
#define XB_TOP      3328
#define XB_TOPGEN   3392
#define XCD_BAR_WORDS 3456
#define XB_SPIN_CAP (1u << 18)

__device__ __forceinline__ unsigned xb_ld(unsigned* p)              { return __hip_atomic_load(p, __ATOMIC_RELAXED, __HIP_MEMORY_SCOPE_AGENT); }
__device__ __forceinline__ unsigned xb_add(unsigned* p, unsigned v) { return __hip_atomic_fetch_add(p, v, __ATOMIC_RELAXED, __HIP_MEMORY_SCOPE_AGENT); }
__device__ __forceinline__ unsigned xb_xcc_id() { return (unsigned)__builtin_amdgcn_s_getreg((3 << 11) | 20) & 0xFu; }
#define XB_SPIN(cond, bar) do { unsigned _sp = 0; while (cond) { __builtin_amdgcn_s_sleep(1); \
    if ((++_sp & 255u) == 0u) { if (xb_ld(&(bar)[XB_TMO])) break; if (_sp > XB_SPIN_CAP) { atomicAdd(&(bar)[XB_TMO], 1u); break; } } } } while (0)

struct XcdBarrier {
    unsigned* bar; unsigned x;
    volatile LAS unsigned* st;
};
__device__ __forceinline__ XcdBarrier xcd_barrier_post(unsigned* bar, volatile LAS unsigned* st) {
    XcdBarrier b; b.bar = bar; b.x = xb_xcc_id(); b.st = st;
    if (threadIdx.x == 0) (void)xb_add(&bar[XB_XCNT(b.x)], 1u);
    return b;
}
__device__ __forceinline__ void xcd_barrier_complete(unsigned* bar, unsigned x, unsigned& nloc, unsigned& nx) {
    const unsigned G = gridDim.x * gridDim.y * gridDim.z;
    unsigned sum, cnt, mine, sp = 0u;
    for (;;) {
        sum = 0u; cnt = 0u; mine = 0u;
#pragma unroll
        for (unsigned j = 0; j < 16; ++j) { const unsigned c = xb_ld(&bar[XB_XCNT(j)]); sum += c; cnt += (c > 0u) ? 1u : 0u; mine = (j == x) ? c : mine; }
        if (sum == G) break;
        __builtin_amdgcn_s_sleep(1);
        if ((++sp & 255u) == 0u) { if (xb_ld(&bar[XB_TMO])) break; if (sp > XB_SPIN_CAP) { atomicAdd(&bar[XB_TMO], 1u); break; } }
    }
    nloc = mine > 0u ? mine : 1u; nx = cnt > 0u ? cnt : 1u;
}
__device__ __forceinline__ void xcd_barrier(const XcdBarrier& b) {
    asm volatile("s_waitcnt vmcnt(0)" ::: "memory");
    __syncthreads();
    if (threadIdx.x == 0) {
        unsigned* bar = b.bar;
        __builtin_amdgcn_s_waitcnt(0);
        unsigned nloc = b.st[0], nx = b.st[1];
        if (nloc == 0u) { xcd_barrier_complete(bar, b.x, nloc, nx); b.st[0] = nloc; b.st[1] = nx; }
        const unsigned old = xb_add(&bar[XB_XSUB(b.x)], 1u);
        const unsigned gen = old / nloc;
        if (old + 1u == (gen + 1u) * nloc) {
            __builtin_amdgcn_fence(__ATOMIC_RELEASE, "agent");
            asm volatile("s_waitcnt vmcnt(0)" ::: "memory");
            const unsigned og = xb_add(&bar[XB_TOP], 1u);
            const unsigned tg = og / nx;
            if (og + 1u == (tg + 1u) * nx) xb_add(&bar[XB_TOPGEN], 1u);
            else XB_SPIN(xb_ld(&bar[XB_TOPGEN]) == tg, bar);
            __builtin_amdgcn_fence(__ATOMIC_ACQUIRE, "agent");
            xb_add(&bar[XB_XGEN(b.x)], 1u);
            asm volatile("s_waitcnt vmcnt(0)" ::: "memory");
        } else {
            XB_SPIN(xb_ld(&bar[XB_XGEN(b.x)]) == gen, bar);
            __builtin_amdgcn_fence(__ATOMIC_ACQUIRE, "agent");
            asm volatile("s_waitcnt vmcnt(0)" ::: "memory");
        }
    }
    __syncthreads();
}

namespace pg8 {
constexpr int BM = 256, BK = 64, HALF = 128, HTB = HALF * BK * 2, STAGE_BYTES = 8 * HTB, NXCD = 8, WGM = 8;
__host__ __device__ __forceinline__ int lds_byte(int r, int c) { const int st = (r >> 4) * 2 + (c >> 5), rr = r & 15, cc = c & 31, ob = rr * 64 + cc * 2; return st * 1024 + (ob ^ (((ob >> 9) & 1) << 5)); }
__host__ __device__ __forceinline__ void stage_rc(int b, int& R, int& C) { const int st = b / 1024, sb = b % 1024, swz = sb ^ (((sb >> 9) & 1) << 5); R = (st >> 1) * 16 + swz / 64; C = (st & 1) * 32 + (swz % 64) / 2; }
__host__ __device__ __forceinline__ int perm32(int rho) { const int n = rho >> 4, i = rho & 15; return 8 * (i >> 2) + 4 * n + (i & 3); }

struct Unit { int pm, pn, z; };
struct StaticOrder {
    const bf16_t* A; const bf16_t* Bt; int lda, ldb, K;
    int nM, nN, nwg, G, c, pm0;
    __device__ __forceinline__ void init(const bf16_t* A_, const bf16_t* Bt_, int lda_, int ldb_, int K_, int M, int N, int G_, int c_, int pm0_ = 0) { A = A_; Bt = Bt_; lda = lda_; ldb = ldb_; K = K_; nM = M / BM; nN = N / BM; nwg = nM * nN; G = G_; c = c_; pm0 = pm0_; }
    __device__ __forceinline__ bool next(int i, Unit& u) const {
        const long Lx = (long)i * G + c; if (Lx >= nwg) return false;
        int wgid = (int)Lx; { const int q = nwg / NXCD, r = nwg % NXCD, xcd = wgid % NXCD, off = wgid / NXCD; wgid = (xcd < r ? xcd * (q + 1) : r * (q + 1) + (xcd - r) * q) + off; }
        const int nig = WGM * nN, gid = wgid / nig, fm = gid * WGM, gsz = (nM - fm) < WGM ? (nM - fm) : WGM;
        u.pm = pm0 + fm + ((wgid % nig) % gsz); u.pn = (wgid % nig) / gsz; u.z = 0; return true;
    }
    __device__ __forceinline__ const char* a_base(const Unit& u) const { return (const char*)(A + (size_t)u.pm * BM * lda); }
    __device__ __forceinline__ const char* b_base(const Unit& u) const { return (const char*)(Bt + (size_t)u.pn * BM * ldb); }
};

template <class Epi, class Sched>
__device__ __forceinline__ void gemm_phase(LAS unsigned char* lds, const Sched& S, const Epi& E) {
    const int tid = threadIdx.x, wid = __builtin_amdgcn_readfirstlane(tid >> 6), lane = tid & 63, wr = wid >> 2, wc = wid & 3, fr = lane & 15, fq = lane >> 4;
    const int K = S.K, nt = K / BK, lda = S.lda, ldb = S.ldb;
    unsigned voffA[2], voffB[2];
#pragma unroll
    for (int i = 0; i < 2; ++i) { int R, C; stage_rc(tid * 16 + i * 8192, R, C); const int Rb = Epi::PERM ? ((R & ~31) + perm32(R & 31)) : R;
        voffA[i] = (unsigned)(R * lda + C) * 2u; voffB[i] = (unsigned)(Rb * ldb + C) * 2u; }
    const size_t kstep = (size_t)(BK * 2);
    const size_t hstepA = (size_t)HALF * lda * 2, hstepB = (size_t)HALF * ldb * 2;
    const unsigned ldsw = (unsigned)wid * 1024u;
    const int aoff = lds_byte(wr * 64 + fr, fq * 8), boff = lds_byte(wc * 32 + fr, fq * 8);
#define PG8_SA(b, h) (((b) * 2 + (h)) * HTB)
#define PG8_SB(b, h) ((4 + (b) * 2 + (h)) * HTB)
#define PG8_STAGE(bufoff, gbase, voff) do { _Pragma("unroll") for (int _i = 0; _i < 2; ++_i) \
        __builtin_amdgcn_global_load_lds((const unsigned*)((const char*)(gbase) + (voff)[_i]), (LAS unsigned*)(lds + (bufoff) + ldsw + _i * 8192), 16, 0, 0); } while (0)
#define PG8_LDA(dst, b, h) do { _Pragma("unroll") for (int m = 0; m < 4; ++m) _Pragma("unroll") for (int k = 0; k < 2; ++k) dst[m][k] = *(const LAS bf16x8*)(lds + PG8_SA(b, h) + aoff + m * 2048 + k * 1024); } while (0)
#define PG8_LDB(dst, b, h) do { _Pragma("unroll") for (int n = 0; n < 2; ++n) _Pragma("unroll") for (int k = 0; k < 2; ++k) dst[n][k] = *(const LAS bf16x8*)(lds + PG8_SB(b, h) + boff + n * 2048 + k * 1024); } while (0)
#define PG8_MMA(ai, bj, At, Bt) do { __builtin_amdgcn_s_setprio(1); _Pragma("unroll") for (int m = 0; m < 4; ++m) _Pragma("unroll") for (int n = 0; n < 2; ++n) _Pragma("unroll") for (int k = 0; k < 2; ++k) \
        acc[ai][bj][m][n] = __builtin_amdgcn_mfma_f32_16x16x32_bf16(Bt[n][k], At[m][k], acc[ai][bj][m][n], 0, 0, 0); __builtin_amdgcn_s_setprio(0); } while (0)
#define PG8_WAIT_V(n) asm volatile("s_waitcnt vmcnt(" #n ")" ::: "memory")
#define PG8_WAIT_L(n) asm volatile("s_waitcnt lgkmcnt(" #n ")" ::: "memory")
#define PG8_BAR __builtin_amdgcn_s_barrier()
#define PG8_SCHED __builtin_amdgcn_sched_barrier(0)
    Unit cur, nxt; int ui = 0;
    if (!S.next(0, cur)) return;
    f32x4 acc[2][2][4][2];
#pragma unroll
    for (int a = 0; a < 2; ++a)
#pragma unroll
        for (int b = 0; b < 2; ++b)
#pragma unroll
            for (int m = 0; m < 4; ++m)
#pragma unroll
                for (int n = 0; n < 2; ++n) acc[a][b][m][n] = (f32x4){0.f, 0.f, 0.f, 0.f};
    bf16x8 At[4][2], B0[2][2], B1[2][2];
    const char* cA = S.a_base(cur); const char* cB = S.b_base(cur);
    PG8_STAGE(PG8_SB(0, 0), cB, voffB); PG8_STAGE(PG8_SA(0, 0), cA, voffA); PG8_STAGE(PG8_SB(0, 1), cB + hstepB, voffB); PG8_STAGE(PG8_SA(0, 1), cA + hstepA, voffA);
    if (wr == 1) PG8_BAR;
    PG8_WAIT_V(4); PG8_BAR;
    PG8_STAGE(PG8_SB(1, 0), cB + kstep, voffB); PG8_STAGE(PG8_SA(1, 0), cA + kstep, voffA); PG8_STAGE(PG8_SB(1, 1), cB + hstepB + kstep, voffB);
    PG8_WAIT_V(6); PG8_BAR;
    for (;;) {
        const bool has_next = S.next(ui + 1, nxt);
        const char* nA = has_next ? S.a_base(nxt) : cA; const char* nB = has_next ? S.b_base(nxt) : cB;
        for (int t = 0; t < nt; t += 2) {
            if constexpr (Epi::MIDK) { if (t == (nt >> 1)) E.midk(acc, cur, wr, fr); }
            const bool last = (t == nt - 2);
            const char* a1 = cA + (size_t)(t + 1) * kstep;
            const char* a2 = last ? nA : cA + (size_t)(t + 2) * kstep; const char* b2 = last ? nB : cB + (size_t)(t + 2) * kstep;
            const char* a3 = a2 + kstep; const char* b3 = b2 + kstep;
            PG8_LDB(B0, 0, 0); PG8_SCHED; PG8_LDA(At, 0, 0); PG8_STAGE(PG8_SA(1, 1), a1 + hstepA, voffA);
            PG8_WAIT_L(8); PG8_BAR; PG8_WAIT_L(0); PG8_MMA(0, 0, At, B0); PG8_BAR; PG8_SCHED;
            PG8_LDB(B1, 0, 1); PG8_STAGE(PG8_SB(0, 0), b2, voffB);
            PG8_BAR; PG8_WAIT_L(0); PG8_MMA(0, 1, At, B1); PG8_BAR;
            PG8_LDA(At, 0, 1); PG8_STAGE(PG8_SA(0, 0), a2, voffA);
            PG8_BAR; PG8_WAIT_L(0); PG8_MMA(1, 0, At, B0); PG8_BAR; PG8_SCHED;
            PG8_STAGE(PG8_SB(0, 1), b2 + hstepB, voffB);
            PG8_WAIT_V(6); PG8_BAR; PG8_MMA(1, 1, At, B1); PG8_BAR;
            PG8_LDB(B0, 1, 0); PG8_SCHED; PG8_LDA(At, 1, 0); PG8_STAGE(PG8_SA(0, 1), a2 + hstepA, voffA);
            PG8_WAIT_L(8); PG8_BAR; PG8_WAIT_L(0); PG8_MMA(0, 0, At, B0); PG8_BAR; PG8_SCHED;
            PG8_LDB(B1, 1, 1); PG8_STAGE(PG8_SB(1, 0), b3, voffB);
            PG8_BAR; PG8_WAIT_L(0); PG8_MMA(0, 1, At, B1); PG8_BAR;
            PG8_LDA(At, 1, 1); PG8_STAGE(PG8_SA(1, 0), a3, voffA);
            PG8_BAR; PG8_WAIT_L(0); PG8_MMA(1, 0, At, B0); PG8_BAR; PG8_SCHED;
            PG8_STAGE(PG8_SB(1, 1), b3 + hstepB, voffB);
            PG8_WAIT_V(6); PG8_BAR; PG8_MMA(1, 1, At, B1); PG8_BAR;
        }
        E(acc, cur, wr, wc, fr, fq);
        if (!has_next) break;
#pragma unroll
        for (int a = 0; a < 2; ++a)
#pragma unroll
            for (int b = 0; b < 2; ++b)
#pragma unroll
                for (int m = 0; m < 4; ++m)
#pragma unroll
                    for (int n = 0; n < 2; ++n) acc[a][b][m][n] = (f32x4){0.f, 0.f, 0.f, 0.f};
        cur = nxt; cA = nA; cB = nB; ++ui;
    }
    PG8_WAIT_V(0);
    if (wr == 0) PG8_BAR;
    PG8_BAR;
#undef PG8_SA
#undef PG8_SB
#undef PG8_STAGE
#undef PG8_LDA
#undef PG8_LDB
#undef PG8_MMA
#undef PG8_WAIT_V
#undef PG8_WAIT_L
#undef PG8_BAR
#undef PG8_SCHED
}
}
using pg8::Unit;
__device__ __forceinline__ u32x4 pack8(const f32x4& v0, const f32x4& v1) {
    u32x4 o; o[0] = cvt_pk_bf16(v0[0], v0[1]); o[1] = cvt_pk_bf16(v0[2], v0[3]); o[2] = cvt_pk_bf16(v1[0], v1[1]); o[3] = cvt_pk_bf16(v1[2], v1[3]); return o;
}
struct EpiWin {
    static constexpr bool PERM = true; static constexpr bool MIDK = false;
    bf16_t* US; bf16_t* Q; bf16_t* KROW; bf16_t* VROW; bf16_t* VT; float* GATE;
    __device__ __forceinline__ void operator()(const f32x4 (&acc)[2][2][4][2], const Unit& u, int wr, int wc, int fr, int fq) const {
        const int row0 = u.pm * 256 + wr * 64 + fr; const int pn = u.pn;
#pragma unroll
        for (int ai = 0; ai < 2; ++ai)
#pragma unroll
            for (int m = 0; m < 4; ++m) {
                const int row = row0 + ai * 128 + m * 16;
#pragma unroll
                for (int bj = 0; bj < 2; ++bj) {
                    const f32x4 v0 = acc[ai][bj][m][0], v1 = acc[ai][bj][m][1];
                    const int cin = bj * 128 + wc * 32 + 8 * fq;
                    if (pn < 4) { *(u32x4*)(US + (size_t)row * 1024 + pn * 256 + cin) = pack8(v0, v1); }
                    else if (pn < 8) { *(u32x4*)(Q + (size_t)row * 1024 + (pn - 4) * 256 + cin) = pack8(v0 * QSCALE, v1 * QSCALE); }
                    else if (pn < 14) {
                        const int kvi = pn - 8, branch = kvi >> 1, kvsel = kvi & 1, g = bj, d0 = wc * 32 + 8 * fq;
                        if (kvsel == 0) { *(u32x4*)(KROW + ((size_t)(branch * 2 + g) * L_ + row) * 128 + d0) = pack8(v0, v1); }
                        else if (branch == 0) { *(u32x4*)(VROW + ((size_t)g * L_ + row) * 128 + d0) = pack8(v0, v1); }
                        else {
                            const int prow = ((row & ~12) | ((row & 4) << 1) | ((row & 8) >> 1));
                            bf16_t* vt = VT + ((size_t)((branch - 1) * 2 + g) * 128 + d0) * L_ + prow;
#pragma unroll
                            for (int e = 0; e < 4; ++e) { vt[(size_t)e * L_] = f2bf(v0[e]); vt[(size_t)(e + 4) * L_] = f2bf(v1[e]); }
                        }
                    } else {
                        if (cin < 24) {
                            float* gp = GATE + (size_t)row * 24 + cin;
                            f32x4 s0, s1;
#pragma unroll
                            for (int e = 0; e < 4; ++e) { s0[e] = sigmoidf_(v0[e]); s1[e] = sigmoidf_(v1[e]); }
                            *(f32x4*)gp = s0; *(f32x4*)(gp + 4) = s1;
                        }
                    }
                }
            }
    }
};
struct EpiGlu {
    static constexpr bool PERM = true; static constexpr bool MIDK = false;
    const bf16_t* Z; const float* bglu; bf16_t* Y; float* stsp;
    __device__ __forceinline__ void operator()(const f32x4 (&acc)[2][2][4][2], const Unit& u, int wr, int wc, int fr, int fq) const {
        const int row0 = u.pm * 256 + wr * 64 + fr;
        float ss[2][4];
#pragma unroll
        for (int ai = 0; ai < 2; ++ai)
#pragma unroll
            for (int m = 0; m < 4; ++m) ss[ai][m] = 0.f;
#pragma unroll
        for (int bj = 0; bj < 2; ++bj) {
            const int col = u.pn * 256 + bj * 128 + wc * 32 + 8 * fq;
            const f32x4 b0 = *(const f32x4*)(bglu + col), b1 = *(const f32x4*)(bglu + col + 4);
#pragma unroll
            for (int ai = 0; ai < 2; ++ai)
#pragma unroll
                for (int m = 0; m < 4; ++m) {
                    const int row = row0 + ai * 128 + m * 16;
                    const u32x4 zz = *(const u32x4*)(Z + (size_t)row * 1024 + col);
                    const f32x4 v0 = acc[ai][bj][m][0] + b0, v1 = acc[ai][bj][m][1] + b1;
                    f32x4 o0, o1;
                    o0[0] = bflo(zz[0]) * sigmoidf_(v0[0]); o0[1] = bfhi(zz[0]) * sigmoidf_(v0[1]); o0[2] = bflo(zz[1]) * sigmoidf_(v0[2]); o0[3] = bfhi(zz[1]) * sigmoidf_(v0[3]);
                    o1[0] = bflo(zz[2]) * sigmoidf_(v1[0]); o1[1] = bfhi(zz[2]) * sigmoidf_(v1[1]); o1[2] = bflo(zz[3]) * sigmoidf_(v1[2]); o1[3] = bfhi(zz[3]) * sigmoidf_(v1[3]);
                    *(u32x4*)(Y + (size_t)row * 2048 + col) = pack8(o0, o1);
                    ss[ai][m] += (o0[0] * o0[0] + o0[1] * o0[1]) + (o0[2] * o0[2] + o0[3] * o0[3]) + (o1[0] * o1[0] + o1[1] * o1[1]) + (o1[2] * o1[2] + o1[3] * o1[3]);
                }
        }
#pragma unroll
        for (int ai = 0; ai < 2; ++ai)
#pragma unroll
            for (int m = 0; m < 4; ++m) {
                float s = ss[ai][m];
                s += __shfl_xor(s, 16); s += __shfl_xor(s, 32);
                if (fq == 0) stsp[(size_t)(row0 + ai * 128 + m * 16) * 16 + u.pn * 4 + wc] = s;
            }
    }
};
struct EpiWout {
    static constexpr bool PERM = true; static constexpr bool MIDK = true;
    const float* X; const float* g1; const float* f2; bf16_t* X1; bf16_t* A2; float* st2p; const float* rsa;
    __device__ __forceinline__ void midk(f32x4 (&acc)[2][2][4][2], const Unit& u, int, int) const {
        int tz = threadIdx.x; asm volatile("" : "+v"(tz));
        const int row0 = u.pm * 256 + ((tz >> 8) & 1) * 64 + (tz & 15);
#pragma unroll
        for (int ai = 0; ai < 2; ++ai)
#pragma unroll
            for (int m = 0; m < 4; ++m) {
                const float r = rsa[(size_t)(row0 + ai * 128 + m * 16) * 2];
#pragma unroll
                for (int bj = 0; bj < 2; ++bj)
#pragma unroll
                    for (int n = 0; n < 2; ++n) acc[ai][bj][m][n] *= r;
            }
    }
    __device__ __forceinline__ void operator()(const f32x4 (&acc)[2][2][4][2], const Unit& u, int, int, int, int) const {
        int tz = threadIdx.x; asm volatile("" : "+v"(tz));
        const int wr = (tz >> 8) & 1, wc = (tz >> 6) & 3, fr = tz & 15, fq = (tz >> 4) & 3;
        const int row0 = u.pm * 256 + wr * 64 + fr, col0 = u.pn * 256 + wc * 32 + 8 * fq;
        float ss[2][4], ra[2][4];
#pragma unroll
        for (int ai = 0; ai < 2; ++ai)
#pragma unroll
            for (int m = 0; m < 4; ++m) { ss[ai][m] = 0.f; ra[ai][m] = rsa[(size_t)(row0 + ai * 128 + m * 16) * 2 + 1]; }
#pragma unroll
        for (int bj = 0; bj < 2; ++bj) {
            const int col = col0 + bj * 128;
            const f32x4 g0 = *(const f32x4*)(g1 + col), g4 = *(const f32x4*)(g1 + col + 4), f0 = *(const f32x4*)(f2 + col), f4 = *(const f32x4*)(f2 + col + 4);
#pragma unroll
            for (int ai = 0; ai < 2; ++ai)
#pragma unroll
                for (int m = 0; m < 4; ++m) {
                    const size_t off = (size_t)(row0 + ai * 128 + m * 16) * 2048 + col;
                    const f32x4 x0 = *(const f32x4*)(X + off), x4 = *(const f32x4*)(X + off + 4);
                    const f32x4 v0 = x0 + g0 * (acc[ai][bj][m][0] * ra[ai][m]), v1 = x4 + g4 * (acc[ai][bj][m][1] * ra[ai][m]);
                    *(u32x4*)(X1 + off) = pack8(v0, v1);
                    *(u32x4*)(A2 + off) = pack8(v0 * f0, v1 * f4);
                    ss[ai][m] += (v0[0] * v0[0] + v0[1] * v0[1]) + (v0[2] * v0[2] + v0[3] * v0[3]) + (v1[0] * v1[0] + v1[1] * v1[1]) + (v1[2] * v1[2] + v1[3] * v1[3]);
                }
        }
#pragma unroll
        for (int ai = 0; ai < 2; ++ai)
#pragma unroll
            for (int m = 0; m < 4; ++m) {
                float s = ss[ai][m];
                s += __shfl_xor(s, 16); s += __shfl_xor(s, 32);
                if (fq == 0) st2p[(size_t)(row0 + ai * 128 + m * 16) * 32 + u.pn * 4 + wc] = s;
            }
    }
};
struct EpiQ {
    static constexpr bool PERM = true; static constexpr bool MIDK = false;
    bf16_t* O; const float* rstd2; const float* cq;
    __device__ __forceinline__ void operator()(const f32x4 (&acc)[2][2][4][2], const Unit& u, int wr, int wc, int fr, int fq) const {
        const int row0 = u.pm * 256 + wr * 64 + fr, col0 = u.pn * 256 + wc * 32 + 8 * fq;
        float rs[2][4];
#pragma unroll
        for (int ai = 0; ai < 2; ++ai)
#pragma unroll
            for (int m = 0; m < 4; ++m) rs[ai][m] = rstd2[row0 + ai * 128 + m * 16];
#pragma unroll
        for (int bj = 0; bj < 2; ++bj) {
            const int col = col0 + bj * 128;
            const f32x4 c0 = *(const f32x4*)(cq + col), c4 = *(const f32x4*)(cq + col + 4);
#pragma unroll
            for (int ai = 0; ai < 2; ++ai)
#pragma unroll
                for (int m = 0; m < 4; ++m)
                    *(u32x4*)(O + (size_t)(row0 + ai * 128 + m * 16) * 2048 + col) = pack8(acc[ai][bj][m][0] * rs[ai][m] + c0, acc[ai][bj][m][1] * rs[ai][m] + c4);
        }
    }
};
template <class Sched>
__device__ __forceinline__ void rstd2_prepass(const Sched& S, const float* st2p, float* rstd2, int tid) {
    Unit u;
    for (int i = 0; S.next(i, u); ++i)
        if (tid < 256) {
            const int row = u.pm * 256 + tid; const f32x4* p = (const f32x4*)(st2p + (size_t)row * 32);
            float s = 0.f;
#pragma unroll
            for (int k = 0; k < 8; ++k) { const f32x4 v = p[k]; s += (v[0] + v[1]) + (v[2] + v[3]); }
            rstd2[row] = rsqrtf(s * (1.f / 2048.f) + 1e-6f);
        }
    __syncthreads();
}
struct EpiSlab {
    static constexpr bool PERM = false; static constexpr bool MIDK = false;
    float* SL;
    __device__ __forceinline__ void operator()(const f32x4 (&acc)[2][2][4][2], const Unit& u, int wr, int wc, int fr, int fq) const {
        float* base = SL + (size_t)u.z * 2048 * 256;
        const int row0 = u.pm * 256 + wr * 64 + fr, col0 = wc * 32 + 4 * fq;
#pragma unroll
        for (int ai = 0; ai < 2; ++ai)
#pragma unroll
            for (int m = 0; m < 4; ++m)
#pragma unroll
                for (int bj = 0; bj < 2; ++bj)
#pragma unroll
                    for (int n = 0; n < 2; ++n)
                        *(f32x4*)(base + (size_t)(row0 + ai * 128 + m * 16) * 256 + col0 + bj * 128 + n * 16) = acc[ai][bj][m][n];
    }
};
struct EpiSlab2 {
    static constexpr bool PERM = false; static constexpr bool MIDK = false;
    float* SL;
    __device__ __forceinline__ void operator()(const f32x4 (&acc)[2][2][4][2], const Unit& u, int wr, int wc, int fr, int fq) const {
        float* base = SL + (size_t)u.z * 2048 * 512 + u.pn * 256;
        const int row0 = u.pm * 256 + wr * 64 + fr, col0 = wc * 32 + 4 * fq;
#pragma unroll
        for (int ai = 0; ai < 2; ++ai)
#pragma unroll
            for (int m = 0; m < 4; ++m)
#pragma unroll
                for (int bj = 0; bj < 2; ++bj)
#pragma unroll
                    for (int n = 0; n < 2; ++n)
                        *(f32x4*)(base + (size_t)(row0 + ai * 128 + m * 16) * 512 + col0 + bj * 128 + n * 16) = acc[ai][bj][m][n];
    }
};
struct CmpOrder2 {
    const bf16_t* KROW; const bf16_t* VROW; const bf16_t* W1; int lda, ldb, K; int G, c;
    __device__ __forceinline__ bool next(int i, Unit& u) const {
        const int x = i * G + c; if (x >= 64) return false;
        u.z = (x >> 5) * 2 + (x & 1); u.pm = (x >> 2) & 7; u.pn = (x >> 1) & 1; return true;
    }
    __device__ __forceinline__ const char* a_base(const Unit& u) const { return (const char*)(((u.z >> 1) ? VROW : KROW) + (size_t)u.pm * 256 * 2048 + (u.z & 1) * 1024); }
    __device__ __forceinline__ const char* b_base(const Unit& u) const { return (const char*)(W1 + (size_t)(u.z >> 1) * 256 * 4096 + (size_t)u.pn * 2048 + (u.z & 1) * 1024); }
};
struct CmpOrder {
    const bf16_t* KROW; const bf16_t* VROW; const bf16_t* W1; int lda, ldb, K; int G, c;
    __device__ __forceinline__ bool next(int i, Unit& u) const {
        const int x = i * G + c; if (x >= 256) return false;
        const int kvsel = x >> 7, pm = (x & 127) >> 4, ks = x & 15; u.pm = pm; u.pn = 0; u.z = kvsel * 16 + ks; return true;
    }
    __device__ __forceinline__ const char* a_base(const Unit& u) const { return (const char*)(((u.z >> 4) ? VROW : KROW) + (size_t)u.pm * 256 * 2048 + (u.z & 15) * 256); }
    __device__ __forceinline__ const char* b_base(const Unit& u) const { return (const char*)(W1 + (size_t)(u.z >> 4) * 256 * 4096 + (u.z & 15) * 256); }
};
template <class Sched>
__device__ __forceinline__ void rsa_prepass(const Sched& S, const float* stsp, const float* stap, float* rsa, int tid) {
    Unit u;
    for (int i = 0; S.next(i, u); ++i)
        if (tid < 256) {
            const int row = u.pm * 256 + tid; const f32x4* p = (const f32x4*)(stsp + (size_t)row * 16);
            float s = 0.f;
#pragma unroll
            for (int k = 0; k < 4; ++k) { const f32x4 v = p[k]; s += (v[0] + v[1]) + (v[2] + v[3]); }
            const f32x2 q = *(const f32x2*)(stap + (size_t)row * 2);
            const float rs = rsqrtf(s * (1.f / 1024.f) + 1e-6f), ra = rsqrtf((q[0] + q[1]) * (1.f / 1024.f) + 1e-6f);
            f32x2 o; o[0] = rs / ra; o[1] = ra;
            *(f32x2*)(rsa + (size_t)row * 2) = o;
        }
    __syncthreads();
}
struct Ctx { int bid, nb, tid, wave, lane; LAS unsigned char* lds; };

__device__ __forceinline__ void p0_cond(const Args& a, const Ctx& c) {
    const float* cv = a.in[1]; const float* w = a.in[2]; float* condp = (float*)(a.ws + WS_CONDP);
    for (int u = c.bid * 8 + c.wave; u < 1536; u += c.nb * 8) {
        const int cc = u % 48, kc = u / 48;
        const float* wp = w + (size_t)(kc * 64) * NADA + cc * 256 + c.lane * 4;
        f32x4 acc = {0.f, 0.f, 0.f, 0.f};
#pragma unroll 16
        for (int k = 0; k < 64; ++k) { const float x = cv[kc * 64 + k]; const float s = x / (1.f + __expf(-x)); acc += s * *(const f32x4*)(wp + (size_t)k * NADA); }
        *(f32x4*)(condp + (size_t)kc * NADA + cc * 256 + c.lane * 4) = acc;
    }
}
struct TDesc { const float* src; bf16_t* dst; const float* ks0; const float* ks1; int K, N, nkt, nt, kt; };
__device__ __forceinline__ TDesc conv_decode(const Args& a, int tix) {
    TDesc d; d.ks0 = nullptr; d.ks1 = nullptr; int local;
    if (tix < 1920) { local = tix; d.src = a.in[6]; d.dst = (bf16_t*)(a.ws + WS_WIN); d.K = 2048; d.N = DIN; }
    else if (tix < 2176) { local = tix - 1920; d.src = a.in[18]; d.dst = (bf16_t*)(a.ws + WS_WGLU); d.K = 1024; d.N = 1024; }
    else if (tix < 3200) { local = tix - 2176; d.src = a.in[7]; d.dst = (bf16_t*)(a.ws + WS_WOUT); d.K = 2048; d.N = 2048; d.ks0 = a.in[8]; d.ks1 = a.in[9]; }
    else if (tix < 4224) { local = tix - 3200; d.src = a.in[27]; d.dst = (bf16_t*)(a.ws + WS_WQ); d.K = 2048; d.N = 2048; }
    else if (tix < 4480) { local = tix - 4224; d.src = a.in[21]; d.dst = (bf16_t*)(a.ws + WS_W1); d.K = 4096; d.N = 256; }
    else if (tix < 4736) { local = tix - 4480; d.src = a.in[24]; d.dst = (bf16_t*)(a.ws + WS_W1) + 256 * 4096; d.K = 4096; d.N = 256; }
    else if (tix < 4744) { local = tix - 4736; d.src = a.in[22]; d.dst = (bf16_t*)(a.ws + WS_W2); d.K = 256; d.N = 128; }
    else { local = tix - 4744; d.src = a.in[25]; d.dst = (bf16_t*)(a.ws + WS_W2) + 128 * 256; d.K = 256; d.N = 128; }
    d.nkt = d.K / 64; d.nt = local / d.nkt; d.kt = local % d.nkt;
    return d;
}
constexpr int CONV_TILES = 4752;
__device__ __forceinline__ void conv_T_all(const Args& a, const Ctx& c) {
    LAS float* tile = (LAS float*)c.lds;
    const int r = c.tid >> 4, c4 = c.tid & 15;
    f32x4 b0[2], b1[2], b2[2]; float s0[2] = {1.f, 1.f}, s1[2] = {1.f, 1.f}, s2[2] = {1.f, 1.f};
#define CONVT_LD(buf, sc, tix_) do { if ((tix_) < CONV_TILES) { const TDesc d_ = conv_decode(a, (tix_)); const int n_ = d_.nt * 64 + 4 * c4; \
        _Pragma("unroll") for (int i = 0; i < 2; ++i) { const int k_ = d_.kt * 64 + r + 32 * i; buf[i] = (f32x4){0.f, 0.f, 0.f, 0.f}; if (n_ < d_.N) buf[i] = *(const f32x4*)(d_.src + (size_t)k_ * d_.N + n_); \
            sc[i] = 1.f; if (d_.ks0) sc[i] = k_ < 1024 ? d_.ks0[k_] : d_.ks1[k_ - 1024]; } } } while (0)
#define CONVT_DO(buf, sc, tix_) do { if ((tix_) < CONV_TILES) { const TDesc d_ = conv_decode(a, (tix_)); \
        _Pragma("unroll") for (int i = 0; i < 2; ++i) { LAS float* tp = tile + (r + 32 * i) * 65 + 4 * c4; tp[0] = buf[i][0] * sc[i]; tp[1] = buf[i][1] * sc[i]; tp[2] = buf[i][2] * sc[i]; tp[3] = buf[i][3] * sc[i]; } \
        __syncthreads(); \
        { const int n = c.tid >> 3, kq = c.tid & 7; float w[8]; \
          _Pragma("unroll") for (int j = 0; j < 8; ++j) w[j] = tile[(kq * 8 + j) * 65 + n]; \
          u32x4 o; o[0] = cvt_pk_bf16(w[0], w[1]); o[1] = cvt_pk_bf16(w[2], w[3]); o[2] = cvt_pk_bf16(w[4], w[5]); o[3] = cvt_pk_bf16(w[6], w[7]); \
          *(u32x4*)(d_.dst + (size_t)(d_.nt * 64 + n) * d_.K + d_.kt * 64 + kq * 8) = o; } \
        __syncthreads(); } } while (0)
    int tix = c.bid;
    CONVT_LD(b0, s0, tix); CONVT_LD(b1, s1, tix + c.nb);
    for (; tix < CONV_TILES; tix += 3 * c.nb) {
        CONVT_LD(b2, s2, tix + 2 * c.nb); CONVT_DO(b0, s0, tix);
        CONVT_LD(b0, s0, tix + 3 * c.nb); CONVT_DO(b1, s1, tix + c.nb);
        CONVT_LD(b1, s1, tix + 4 * c.nb); CONVT_DO(b2, s2, tix + 2 * c.nb);
    }
#undef CONVT_LD
#undef CONVT_DO
}
__device__ __forceinline__ void conv_fp4rows(const float* src, unsigned char* dst4, float* scl, int rows, const Ctx& c) {
    const int stride = c.nb * 8;
    f32x4 b0[8], b1[8], b2[8], b3[8], b4[8];
#define FP4R_LD(buf, r_) do { if ((r_) < rows) { _Pragma("unroll") for (int j = 0; j < 8; ++j) buf[j] = *(const f32x4*)(src + (size_t)(r_) * 2048 + 256 * j + c.lane * 4); } } while (0)
#define FP4R_DO(buf, r_) do { if ((r_) < rows) { \
        float mx = 0.f; \
        _Pragma("unroll") for (int j = 0; j < 8; ++j) mx = fmaxf(mx, fmaxf(fmaxf(fabsf(buf[j][0]), fabsf(buf[j][1])), fmaxf(fabsf(buf[j][2]), fabsf(buf[j][3])))); \
        mx = wave_max(mx); \
        const float s = mx > 0.f ? 6.f / mx : 1.f; \
        if (c.lane == 0) scl[(size_t)(r_) * 4] = mx > 0.f ? mx * (1.f / 6.f) : 1.f; \
        u32x4 pk = {0u, 0u, 0u, 0u}; \
        _Pragma("unroll") for (int d = 0; d < 4; ++d) {              \
            unsigned wq = 0u; \
            wq = fp4_pk<0>(wq, buf[2 * d][0] * s, buf[2 * d][1] * s); wq = fp4_pk<1>(wq, buf[2 * d][2] * s, buf[2 * d][3] * s); \
            wq = fp4_pk<2>(wq, buf[2 * d + 1][0] * s, buf[2 * d + 1][1] * s); wq = fp4_pk<3>(wq, buf[2 * d + 1][2] * s, buf[2 * d + 1][3] * s); \
            pk[d] = wq; } \
        *(u32x4*)(dst4 + (size_t)(r_) * 1024 + c.lane * 16) = pk; } } while (0)
    int row = c.bid * 8 + c.wave;
    FP4R_LD(b0, row); FP4R_LD(b1, row + stride); FP4R_LD(b2, row + 2 * stride); FP4R_LD(b3, row + 3 * stride);
    for (; row < rows; row += 5 * stride) {
        FP4R_LD(b4, row + 4 * stride); FP4R_DO(b0, row);
        FP4R_LD(b0, row + 5 * stride); FP4R_DO(b1, row + stride);
        FP4R_LD(b1, row + 6 * stride); FP4R_DO(b2, row + 2 * stride);
        FP4R_LD(b2, row + 7 * stride); FP4R_DO(b3, row + 3 * stride);
        FP4R_LD(b3, row + 8 * stride); FP4R_DO(b4, row + 4 * stride);
    }
#undef FP4R_LD
#undef FP4R_DO
}
__device__ __forceinline__ void conv_E(const float* src, bf16_t* dst, size_t n8, const Ctx& c) {
    const size_t stride = (size_t)c.nb * NTHREADS;
    for (size_t i = (size_t)c.bid * NTHREADS + c.tid; i < n8; i += stride) {
        const f32x4 x = *(const f32x4*)(src + i * 8), y = *(const f32x4*)(src + i * 8 + 4);
        *(u32x4*)(dst + i * 8) = pack8(x, y);
    }
}
__device__ __forceinline__ int t5_bucket(int n) {
    if (n < 16) return n;
    const float scaled = logf((float)n / 16.f) / logf(64.f);
    const int large = 16 + (int)(scaled * 16.f);
    return large < 31 ? large : 31;
}
__device__ __forceinline__ void p0_tb(const Args& a, const Ctx& c) {
    float* tb = (float*)(a.ws + WS_TB); const float* rb = a.in[26];
    for (int i = c.bid * NTHREADS + c.tid; i < 8 * TBN; i += c.nb * NTHREADS) { const int head = i / TBN, dist = i % TBN; tb[i] = rb[t5_bucket(dist) * 8 + head] * LOG2E; }
}
__device__ __forceinline__ void p0_bpe(const Args& a, const Ctx& c, int part) {
    const int n = c.tid & 255, kv = c.tid >> 8;
    const float* pe = a.in[kv ? 23 : 20]; const float* w1 = a.in[kv ? 24 : 21]; float* bpep = (float*)(a.ws + WS_BPEP);
    float s = 0.f;
#pragma unroll 16
    for (int k = part * 128; k < part * 128 + 128; ++k) s += pe[k] * w1[(size_t)k * 256 + n];
    bpep[(part * 2 + kv) * 256 + n] = s;
}
__device__ __forceinline__ void p0_s5(const Args& a, const Ctx& c, int g, int part) {
    LAS float* ar = (LAS float*)c.lds;
    LAS float* ai = ar + 17 * 64;
    LAS float* bbr = ai + 17 * 64;
    LAS float* bbi = bbr + 1024;
    LAS float* cr = bbi + 1024;
    LAS float* ci = cr + 16 * 65;
    LAS float* kd = ci + 16 * 65;
    const int tid = c.tid;
    if (tid < 64) {
        const int p = tid; const float dt = expf(a.in[12][g]); const float lr = a.in[10][g * 64 + p], li = a.in[11][g * 64 + p];
        const float mag = expf(lr * dt), a1r = mag * cosf(li * dt), a1i = mag * sinf(li * dt);
        float xr = 1.f, xi = 0.f;
        for (int d = 0; d <= 16; ++d) { ar[d * 64 + p] = xr; ai[d * 64 + p] = xi; const float tr = xr * a1r - xi * a1i, ti = xr * a1i + xi * a1r; xr = tr; xi = ti; }
        const float nr = a1r - 1.f, ni = a1i, den = lr * lr + li * li;
        const float wre = (nr * lr + ni * li) / den, wim = (ni * lr - nr * li) / den;
        for (int h = 0; h < 16; ++h) { const float br = a.in[13][(g * 64 + p) * 16 + h], bi = a.in[14][(g * 64 + p) * 16 + h]; bbr[p * 16 + h] = wre * br - wim * bi; bbi[p * 16 + h] = wre * bi + wim * br; }
        if (part == 0) {
        float* s5p = (float*)(a.ws + WS_S5P);
        float yr = ar[16 * 64 + p], yi = ai[16 * 64 + p];
        s5p[(g * 64 + p) * 2] = yr; s5p[(g * 64 + p) * 2 + 1] = yi;
        for (int s = 0; s < 8; ++s) { const float tr = yr * yr - yi * yi, ti = 2.f * yr * yi; yr = tr; yi = ti; }
        s5p[64 * 64 * 2 + (g * 64 + p) * 2] = yr; s5p[64 * 64 * 2 + (g * 64 + p) * 2 + 1] = yi;
        }
    }
    for (int e = tid; e < 1024; e += NTHREADS) { cr[(e >> 6) * 65 + (e & 63)] = a.in[15][g * 1024 + e]; ci[(e >> 6) * 65 + (e & 63)] = a.in[16][g * 1024 + e]; }
    __syncthreads();
    for (int it = tid; it < (4 * part + 4) * 32; it += NTHREADS) {
        const int d = it >> 5, h1 = (it >> 1) & 15, hh = it & 1;
        f32x4 s0 = {0.f, 0.f, 0.f, 0.f}, s1 = {0.f, 0.f, 0.f, 0.f};
#pragma unroll 4
        for (int p = 0; p < 64; ++p) { const float Cr = cr[h1 * 65 + p], Ci = ci[h1 * 65 + p], Ar = ar[d * 64 + p], Ai = ai[d * 64 + p];
            const float Gr = Cr * Ar - Ci * Ai, Gi = Cr * Ai + Ci * Ar;
            const f32x4 b0 = *(const LAS f32x4*)(bbr + p * 16 + hh * 8), b1 = *(const LAS f32x4*)(bbr + p * 16 + hh * 8 + 4), c0 = *(const LAS f32x4*)(bbi + p * 16 + hh * 8), c1 = *(const LAS f32x4*)(bbi + p * 16 + hh * 8 + 4);
            s0 += Gr * b0 - Gi * c0; s1 += Gr * b1 - Gi * c1; }
#pragma unroll
        for (int j = 0; j < 4; ++j) { const int h = hh * 8 + j;
            kd[d * 256 + h1 * 16 + h] = s0[j] + ((d == 0 && h1 == h) ? a.in[17][g * 16 + h] : 0.f);
            kd[d * 256 + h1 * 16 + h + 4] = s1[j] + ((d == 0 && h1 == h + 4) ? a.in[17][g * 16 + h + 4] : 0.f); }
    }
    __syncthreads();
    bf16_t* MT = (bf16_t*)(a.ws + WS_S5MT) + (size_t)g * 65536;
    bf16_t* WE = (bf16_t*)(a.ws + WS_S5WE) + (size_t)g * 32768;
    bf16_t* WC = (bf16_t*)(a.ws + WS_S5WC) + (size_t)g * 32768;
    for (int e = 16384 * part + tid; e < 16384 * (part + 1); e += NTHREADS) { const int n = e >> 8, k = e & 255, j = n >> 4, h1 = n & 15, i = k >> 4, h = k & 15;
        MT[e] = f2bf(i <= j ? kd[(j - i) * 256 + h1 * 16 + h] : 0.f); }
    for (int e = 8192 * part + tid; e < 8192 * (part + 1); e += NTHREADS) { const int n = e >> 8, k = e & 255, cc = n >> 6, p = n & 63, i = k >> 4, h = k & 15;
        const float Ar = ar[(15 - i) * 64 + p], Ai = ai[(15 - i) * 64 + p], Br = bbr[p * 16 + h], Bi = bbi[p * 16 + h];
        WE[e] = f2bf(cc ? (Ar * Bi + Ai * Br) : (Ar * Br - Ai * Bi)); }
    for (int e = 8192 * part + tid; e < 8192 * (part + 1); e += NTHREADS) { const int n = e >> 7, k = e & 127, j = n >> 4, h1 = n & 15, cc = k >> 6, p = k & 63;
        const float Cr = cr[h1 * 65 + p], Ci = ci[h1 * 65 + p], Ar = ar[(j + 1) * 64 + p], Ai = ai[(j + 1) * 64 + p];
        WC[e] = f2bf(cc ? -(Cr * Ai + Ci * Ar) : (Cr * Ar - Ci * Ai)); }
    __syncthreads();
}
__device__ __forceinline__ void p0_prologue(const Args& a, const Ctx& c) {
    for (int u = 0; u < 32; ++u) if (c.bid == (8 * u + 7) % c.nb) p0_bpe(a, c, u);
    p0_tb(a, c);
    p0_cond(a, c);
}
__device__ __forceinline__ void p1_weights(const Args& a, const Ctx& c, bool s5_first) {
    if (s5_first) { for (int u = c.bid; u < 256; u += c.nb) p0_s5(a, c, u >> 2, u & 3); }
    else {
        conv_T_all(a, c);
        conv_E(a.in[28], (bf16_t*)(a.ws + WS_PK), 128 * 128 / 8, c);
        conv_E(a.in[29], (bf16_t*)(a.ws + WS_PK) + 128 * 128, 128 * 128 / 8, c);
    }
}

__device__ __forceinline__ void norm_rows(const float* X, bf16_t* O, LAS const float* Ab, LAS const float* Bb, const Ctx& c, int row0 = 0, int nrows = L_) {
    for (int t = row0 + c.bid * 8 + c.wave; t < row0 + nrows; t += c.nb * 8) {
        const float* xr = X + (size_t)t * 2048 + c.lane * 4;
        f32x4 v[8]; float ss = 0.f;
#pragma unroll
        for (int j = 0; j < 8; ++j) { v[j] = *(const f32x4*)(xr + j * 256); ss += v[j][0] * v[j][0] + v[j][1] * v[j][1] + v[j][2] * v[j][2] + v[j][3] * v[j][3]; }
        ss = wave_sum(ss);
        const float rstd = rsqrtf(ss * (1.f / 2048.f) + 1e-6f);
#pragma unroll
        for (int j = 0; j < 8; ++j) {
            const int col = j * 256 + c.lane * 4;
            const f32x4 A = *(const LAS f32x4*)(Ab + col), B = *(const LAS f32x4*)(Bb + col);
            const f32x4 o = v[j] * rstd * A + B;
            u32x2 w; w[0] = cvt_pk_bf16(o[0], o[1]); w[1] = cvt_pk_bf16(o[2], o[3]);
            *(u32x2*)(O + (size_t)t * 2048 + col) = w;
        }
    }
}
__device__ __forceinline__ void norm_rows_bf16(const bf16_t* X, bf16_t* O, LAS const float* Ab, LAS const float* Bb, const Ctx& c, int row0, int nrows) {
    for (int t = row0 + c.bid * 8 + c.wave; t < row0 + nrows; t += c.nb * 8) {
        const bf16_t* xr = X + (size_t)t * 2048 + c.lane * 8;
        u32x4 w[4]; float ss = 0.f;
#pragma unroll
        for (int j = 0; j < 4; ++j) { w[j] = *(const u32x4*)(xr + j * 512);
#pragma unroll
            for (int e = 0; e < 4; ++e) { const float a0 = bflo(w[j][e]), a1 = bfhi(w[j][e]); ss += a0 * a0 + a1 * a1; } }
        ss = wave_sum(ss);
        const float rstd = rsqrtf(ss * (1.f / 2048.f) + 1e-6f);
#pragma unroll
        for (int j = 0; j < 4; ++j) {
            const int col = j * 512 + c.lane * 8;
            const f32x4 A0 = *(const LAS f32x4*)(Ab + col), A1 = *(const LAS f32x4*)(Ab + col + 4), B0 = *(const LAS f32x4*)(Bb + col), B1 = *(const LAS f32x4*)(Bb + col + 4);
            f32x4 o0, o1;
#pragma unroll
            for (int e = 0; e < 2; ++e) { o0[2 * e] = bflo(w[j][e]) * rstd * A0[2 * e] + B0[2 * e]; o0[2 * e + 1] = bfhi(w[j][e]) * rstd * A0[2 * e + 1] + B0[2 * e + 1];
                o1[2 * e] = bflo(w[j][2 + e]) * rstd * A1[2 * e] + B1[2 * e]; o1[2 * e + 1] = bfhi(w[j][2 + e]) * rstd * A1[2 * e + 1] + B1[2 * e + 1]; }
            *(u32x4*)(O + (size_t)t * 2048 + col) = pack8(o0, o1);
        }
    }
}
__device__ __forceinline__ float cond_from_partials(const float* condp, const float* b_ada, int j) {
    float s = b_ada[j]; float v[32];
#pragma unroll
    for (int k = 0; k < 32; ++k) v[k] = condp[(size_t)k * NADA + j];
#pragma unroll
    for (int k = 0; k < 32; ++k) s += v[k];
    return s;
}
__device__ __forceinline__ void p1_hnorm(const Args& a, const Ctx& c) {
    const bool s5_late = (c.bid >> 3) & 1;
    if (!s5_late) p1_weights(a, c, true);
    p1_weights(a, c, false);
    __syncthreads();
    const float* condp = (const float*)(a.ws + WS_CONDP); float* cond = (float*)(a.ws + WS_COND);
    for (int j = c.bid * NTHREADS + c.tid; j < NADA; j += c.nb * NTHREADS) cond[j] = cond_from_partials(condp, a.in[3], j);
    { float* F2 = (float*)(a.ws + WS_F2);
      for (int j = c.bid * NTHREADS + c.tid; j < 2048; j += c.nb * NTHREADS) F2[j] = a.in[5][j] * (1.f + cond_from_partials(condp, a.in[3], 4 * 2048 + j)); }
    LAS float* Ab = (LAS float*)c.lds; LAS float* Bb = Ab + 2048;
    {
        const int col = 4 * c.tid;
        f32x4 sA = *(const f32x4*)(a.in[3] + 2048 + col), sB = *(const f32x4*)(a.in[3] + col);
#pragma unroll
        for (int hf = 0; hf < 2; ++hf) {
            f32x4 pa[16], pb[16];
#pragma unroll
            for (int k = 0; k < 16; ++k) { pa[k] = *(const f32x4*)(condp + (size_t)(16 * hf + k) * NADA + 2048 + col); pb[k] = *(const f32x4*)(condp + (size_t)(16 * hf + k) * NADA + col); }
#pragma unroll
            for (int k = 0; k < 16; ++k) { sA += pa[k]; sB += pb[k]; }
        }
        const f32x4 g = *(const f32x4*)(a.in[4] + col);
        *(LAS f32x4*)(Ab + col) = g * (1.f + sA); *(LAS f32x4*)(Bb + col) = sB;
    }
    __syncthreads();
    norm_rows(a.in[0], (bf16_t*)(a.ws + WS_H), Ab, Bb, c);
    if (s5_late) { __syncthreads(); p1_weights(a, c, true); }
}
__device__ __forceinline__ void p_cqce(const Args& a, const Ctx& c) {
    const float* sh2 = (const float*)(a.ws + WS_COND) + 3 * 2048;
    float s[32];
#pragma unroll
    for (int k = 0; k < 8; ++k) { const f32x4 v = *(const f32x4*)(sh2 + 256 * k + c.lane * 4); s[4 * k] = v[0]; s[4 * k + 1] = v[1]; s[4 * k + 2] = v[2]; s[4 * k + 3] = v[3]; }
    const bf16_t* WQ = (const bf16_t*)(a.ws + WS_WQ); float* cq = (float*)(a.ws + WS_CQ);
    for (int n = c.bid * 8 + c.wave; n < 2048; n += c.nb * 8) {
        u32x2 w[8];
#pragma unroll
        for (int k = 0; k < 8; ++k) w[k] = *(const u32x2*)(WQ + (size_t)n * 2048 + 256 * k + c.lane * 4);
        float d = 0.f;
#pragma unroll
        for (int k = 0; k < 8; ++k) d += (bflo(w[k][0]) * s[4 * k] + bfhi(w[k][0]) * s[4 * k + 1]) + (bflo(w[k][1]) * s[4 * k + 2] + bfhi(w[k][1]) * s[4 * k + 3]);
        d = wave_sum(d);
        if (c.lane == 0) cq[n] = d;
    }
    const unsigned char* PU = a.ws + WS_PU; float* psc = (float*)(a.ws + WS_PSC);
    for (int e0 = (c.bid * 8 + c.wave) * 4; e0 < 16384; e0 += c.nb * 8 * 4) {
        u32x4 uw[4];
#pragma unroll
        for (int i = 0; i < 4; ++i) uw[i] = *(const u32x4*)(PU + (size_t)(e0 + i) * 1024 + c.lane * 16);
#pragma unroll
        for (int i = 0; i < 4; ++i) {
            float d0 = 0.f, d1 = 0.f;
#pragma unroll
            for (int dw = 0; dw < 4; ++dw) { const f32x2 f0 = fp4_unpk<0>(uw[i][dw]), f1 = fp4_unpk<1>(uw[i][dw]), f2 = fp4_unpk<2>(uw[i][dw]), f3 = fp4_unpk<3>(uw[i][dw]);
                d0 += f0[0] * s[8 * dw] + f1[0] * s[8 * dw + 2] + f2[0] * s[8 * dw + 4] + f3[0] * s[8 * dw + 6];
                d1 += f0[1] * s[8 * dw + 1] + f1[1] * s[8 * dw + 3] + f2[1] * s[8 * dw + 5] + f3[1] * s[8 * dw + 7]; }
            const float d = wave_sum(d0 + d1);
            if (c.lane == 0) psc[(size_t)(e0 + i) * 4 + 1] = psc[(size_t)(e0 + i) * 4] * d;
        }
    }
}
constexpr int S5_US = 0, S5_ES = 33792, S5_SS = 67584, S5_TS = 84992;
template <int PASS>
__device__ __forceinline__ void s5_item(const Args& a, const Ctx& c, int g, int seg) {
    LAS unsigned char* lds = c.lds;
    int tid = c.tid; asm volatile("" : "+v"(tid));
    const int wave = c.wave, lane = tid & 63, r = lane & 15, q = lane >> 4;
    const bf16_t* U = (const bf16_t*)(a.ws + WS_US);
    const bf16_t* MT = (const bf16_t*)(a.ws + WS_S5MT) + (size_t)g * 65536;
    const bf16_t* WE = (const bf16_t*)(a.ws + WS_S5WE) + (size_t)g * 32768;
    const bf16_t* WC = (const bf16_t*)(a.ws + WS_S5WC) + (size_t)g * 32768;
    const float* s5p = (const float*)(a.ws + WS_S5P);
    float* F = (float*)(a.ws + WS_S5F) + (size_t)g * 4 * 128;
    bf16_t* Z = (bf16_t*)(a.ws + WS_Z);
    bf16x8 bE[8];
#pragma unroll
    for (int ks = 0; ks < 8; ++ks) bE[ks] = *(const bf16x8*)(WE + (size_t)(16 * wave + r) * 256 + 32 * ks + 8 * q);
    bf16x8 bM[2][8], bC[2][4];
    if (PASS == 1) {
#pragma unroll
        for (int nt = 0; nt < 2; ++nt)
#pragma unroll
            for (int ks = 0; ks < 4; ++ks) bC[nt][ks] = *(const bf16x8*)(WC + (size_t)(16 * (2 * wave + nt) + r) * 128 + 32 * ks + 8 * q);
#pragma unroll
        for (int nt = 0; nt < 2; ++nt)
#pragma unroll
            for (int ks = 0; ks < 8; ++ks) bM[nt][ks] = *(const bf16x8*)(MT + (size_t)(16 * (2 * wave + nt) + r) * 256 + 32 * ks + 8 * q);
    }
    float sr = 0.f, si = 0.f;
    const float a16r = s5p[(g * 64 + lane) * 2], a16i = s5p[(g * 64 + lane) * 2 + 1];
    float a128r = a16r, a128i = a16i;
#pragma unroll
    for (int s = 0; s < 3; ++s) { const float tr = a128r * a128r - a128i * a128i, ti = 2.f * a128r * a128i; a128r = tr; a128i = ti; }
    if (PASS == 1) { const float br = s5p[8192 + (g * 64 + lane) * 2], bi = s5p[8192 + (g * 64 + lane) * 2 + 1];
        float fr_[3], fi_[3];
#pragma unroll
        for (int s = 0; s < 3; ++s) { fr_[s] = (s < seg) ? F[s * 128 + lane] : 0.f; fi_[s] = (s < seg) ? F[s * 128 + 64 + lane] : 0.f; }
#pragma unroll
        for (int s = 0; s < 3; ++s) if (s < seg) { const float nr = br * sr - bi * si + fr_[s], ni = br * si + bi * sr + fi_[s]; sr = nr; si = ni; } }
    u32x4 un[4];
#pragma unroll
    for (int i = 0; i < 4; ++i) { const int ch = tid + NTHREADS * i, token = ch >> 1, half = ch & 1; un[i] = *(const u32x4*)(U + (size_t)(seg * 4096 + token) * 1024 + g * 16 + half * 8); }
    for (int sb = 0; sb < 4; ++sb) {
        const int tok0 = seg * 4096 + sb * 1024;
#pragma unroll
        for (int i = 0; i < 4; ++i) { const int ch = tid + NTHREADS * i, token = ch >> 1, half = ch & 1;
            *(LAS u32x4*)(lds + S5_US + (token >> 4) * 528 + ((token & 15) * 16 + half * 8) * 2) = un[i]; }
        __syncthreads();
        if (sb < 3) { int tz = tid; asm volatile("" : "+v"(tz));
#pragma unroll
            for (int i = 0; i < 4; ++i) { const int ch = tz + NTHREADS * i, token = ch >> 1, half = ch & 1; un[i] = *(const u32x4*)(U + (size_t)(tok0 + 1024 + token) * 1024 + g * 16 + half * 8); } }
#pragma unroll
        for (int m = 0; m < 4; ++m) {
            f32x4 acc = {0.f, 0.f, 0.f, 0.f};
#pragma unroll
            for (int ks = 0; ks < 8; ++ks) { const bf16x8 A = *(const LAS bf16x8*)(lds + S5_US + (16 * m + r) * 528 + (32 * ks + 8 * q) * 2); acc = mfma16(A, bE[ks], acc); }
#pragma unroll
            for (int i = 0; i < 4; ++i) *(LAS float*)(lds + S5_ES + ((16 * m + 4 * q + i) * 132 + 16 * wave + r) * 4) = acc[i];
        }
        __syncthreads();
        {
            float lr[8], li[8];
            float xr = 0.f, xi = 0.f;
#pragma unroll
            for (int k = 0; k < 8; ++k) {
                lr[k] = xr; li[k] = xi;
                const float er = *(const LAS float*)(lds + S5_ES + ((8 * wave + k) * 132 + lane) * 4), ei = *(const LAS float*)(lds + S5_ES + ((8 * wave + k) * 132 + 64 + lane) * 4);
                const float nr = a16r * xr - a16i * xi + er, ni = a16r * xi + a16i * xr + ei; xr = nr; xi = ni;
            }
            __builtin_amdgcn_sched_barrier(0);
            *(LAS float*)(lds + S5_TS + (wave * 128 + lane) * 4) = xr; *(LAS float*)(lds + S5_TS + (wave * 128 + 64 + lane) * 4) = xi;
            __syncthreads();
            __builtin_amdgcn_sched_barrier(0);
            float cr = sr, ci = si, mr = sr, mi = si;
#pragma unroll
            for (int w2 = 0; w2 < 8; ++w2) {
                if (w2 == wave) { mr = cr; mi = ci; }
                const float tr = *(const LAS float*)(lds + S5_TS + (w2 * 128 + lane) * 4), ti = *(const LAS float*)(lds + S5_TS + (w2 * 128 + 64 + lane) * 4);
                const float nr = a128r * cr - a128i * ci + tr, ni = a128r * ci + a128i * cr + ti; cr = nr; ci = ni;
            }
            sr = cr; si = ci;
            __builtin_amdgcn_sched_barrier(0);
            if (PASS == 1) {
                float pr = mr, pi = mi;
#pragma unroll
                for (int k = 0; k < 8; ++k) {
                    *(LAS bf16_t*)(lds + S5_SS + ((8 * wave + k) * 136 + lane) * 2) = f2bf(lr[k] + pr); *(LAS bf16_t*)(lds + S5_SS + ((8 * wave + k) * 136 + 64 + lane) * 2) = f2bf(li[k] + pi);
                    const float nr = a16r * pr - a16i * pi, ni = a16r * pi + a16i * pr; pr = nr; pi = ni;
                }
            }
        }
        __syncthreads();
        if (PASS == 1) {
#pragma unroll
            for (int nt = 0; nt < 2; ++nt) {
                const int j = 2 * wave + nt;
                f32x4 acc[4];
#pragma unroll
                for (int m = 0; m < 4; ++m) acc[m] = (f32x4){0.f, 0.f, 0.f, 0.f};
#pragma unroll
                for (int ks = 0; ks < 8; ++ks) {
                    __builtin_amdgcn_sched_barrier(0);
#pragma unroll
                    for (int m = 0; m < 4; ++m) { const bf16x8 A = *(const LAS bf16x8*)(lds + S5_US + (16 * m + r) * 528 + (32 * ks + 8 * q) * 2); acc[m] = mfma16(A, bM[nt][ks], acc[m]); }
                }
#pragma unroll
                for (int ks = 0; ks < 4; ++ks) {
                    __builtin_amdgcn_sched_barrier(0);
#pragma unroll
                    for (int m = 0; m < 4; ++m) { const bf16x8 A = *(const LAS bf16x8*)(lds + S5_SS + (16 * m + r) * 272 + (32 * ks + 8 * q) * 2); acc[m] = mfma16(A, bC[nt][ks], acc[m]); }
                }
                int lz = lane; asm volatile("" : "+v"(lz));
                const int rz = lz & 15, qz = lz >> 4;
#pragma unroll
                for (int m = 0; m < 4; ++m)
#pragma unroll
                    for (int i = 0; i < 4; ++i) { const int ch = 16 * m + 4 * qz + i, token = 16 * ch + j;
                        *(LAS bf16_t*)(lds + S5_ES + token * 32 + (token >> 6) * 32 + rz * 2) = f2bf(gelu_tanh(acc[m][i])); }
            }
            __syncthreads();
            { int tz = tid; asm volatile("" : "+v"(tz));
#pragma unroll
              for (int k = 0; k < 4; ++k) { const int p = tz + NTHREADS * k, token = p >> 1, half = p & 1;
                  const u32x4 v = *(const LAS u32x4*)(lds + S5_ES + token * 32 + (token >> 6) * 32 + half * 16);
                  *(u32x4*)(Z + (size_t)(tok0 + token) * 1024 + g * 16 + half * 8) = v; } }
            __syncthreads();
        }
    }
    if (PASS == 0 && wave == 0) { F[seg * 128 + lane] = sr; F[seg * 128 + 64 + lane] = si; }
}

__device__ __forceinline__ void cmp_finish_item(const Args& a, const Ctx& c, int kvsel, int rt) {
    LAS unsigned char* lds = c.lds;
    const int tid = c.tid, wave = c.wave, lane = c.lane, r = lane & 15, q = lane >> 4;
    const float* SL = (const float*)(a.ws + WS_SLAB) + (size_t)kvsel * 2 * 2048 * 512;
    const float* bpep = (const float*)(a.ws + WS_BPEP) + kvsel * 256;
    const bf16_t* W2 = (const bf16_t*)(a.ws + WS_W2) + kvsel * 128 * 256;
    bf16x8 B[8];
#pragma unroll
    for (int ks = 0; ks < 8; ++ks) B[ks] = *(const bf16x8*)(W2 + (size_t)(16 * wave + r) * 256 + 32 * ks + 8 * q);
    LAS float* bias = (LAS float*)(lds + 16 * 528);
    if (tid < 64) { f32x4 s = {0.f, 0.f, 0.f, 0.f};
#pragma unroll
        for (int hf = 0; hf < 2; ++hf) { f32x4 pv[16];
#pragma unroll
            for (int pt = 0; pt < 16; ++pt) pv[pt] = *(const f32x4*)(bpep + (16 * hf + pt) * 512 + tid * 4);
#pragma unroll
            for (int pt = 0; pt < 16; ++pt) s += pv[pt]; }
        *(LAS f32x4*)(bias + tid * 4) = s; }
    __syncthreads();
    for (int e = tid; e < 16 * 64; e += NTHREADS) {
        const int row = e >> 6, c4 = (e & 63) * 4;
        f32x4 s = *(const LAS f32x4*)(bias + c4);
#pragma unroll
        for (int ks = 0; ks < 2; ++ks) { const int gr = ks * 2048 + rt * 16 + row, gn = (rt * 16 + row + 1 < 2048 ? rt * 16 + row + 1 : 2047) + ks * 2048;
            s += *(const f32x4*)(SL + (size_t)gr * 512 + c4); s += *(const f32x4*)(SL + (size_t)gn * 512 + 256 + c4); }
        u32x2 w; w[0] = cvt_pk_bf16(gelu_tanh(s[0]), gelu_tanh(s[1])); w[1] = cvt_pk_bf16(gelu_tanh(s[2]), gelu_tanh(s[3]));
        *(LAS u32x2*)(lds + row * 528 + c4 * 2) = w;
    }
    __syncthreads();
    f32x4 acc = {0.f, 0.f, 0.f, 0.f};
#pragma unroll
    for (int ks = 0; ks < 8; ++ks) { const bf16x8 A = *(const LAS bf16x8*)(lds + r * 528 + (32 * ks + 8 * q) * 2); acc = mfma16(A, B[ks], acc); }
#pragma unroll
    for (int i = 0; i < 4; ++i) {
        const int row = rt * 16 + 4 * q + i, gi = row >> 10, ci = row & 1023, n = 16 * wave + r;
        const bf16_t v = (ci == 1023) ? (bf16_t)0 : f2bf(acc[i]);
        if (kvsel == 0) ((bf16_t*)(a.ws + WS_KC))[((size_t)gi * 1024 + ci) * 128 + n] = v;
        else ((bf16_t*)(a.ws + WS_VCT))[((size_t)gi * 128 + n) * 1024 + ((ci & ~12) | ((ci & 4) << 1) | ((ci & 8) >> 1))] = v;
    }
    __syncthreads();
}
constexpr int AT_IMP = 65536, AT_TB = 131072, AT_BM = 143872, AT_WU = 145920, AT_END = 146176;
__device__ __forceinline__ int kswz(int r) { return ((r & 3) << 2) | ((r >> 2) & 3); }
__host__ __device__ __forceinline__ int vperm(int t) { return (t & ~12) | ((t & 4) << 1) | ((t & 8) >> 1); }
template <int KEYS> __device__ __forceinline__ int vsw(int d) { return KEYS == 128 ? kswz(d) : ((d >> 1) & 7); }
template <int KEYS, bool NEEDV>
__device__ __forceinline__ void stage_dma(const bf16_t* Kt, const bf16_t* Vt, int ldv, LAS unsigned char* kb, LAS unsigned char* vb, int wave, int lane) {
    constexpr int NP = KEYS / 32;
#pragma unroll
    for (int i = 0; i < NP; ++i) { const int pc = NP * wave + i, row = 4 * pc + (lane >> 4), ch = (lane & 15) ^ kswz(row);
        __builtin_amdgcn_global_load_lds((const unsigned*)(Kt + row * 128 + ch * 8), (LAS unsigned*)(kb + pc * 1024), 16, 0, 0); }
    if (NEEDV) {
#pragma unroll
        for (int i = 0; i < NP; ++i) {
            const int pc = NP * wave + i;
            if (KEYS == 128) { const int d = 4 * pc + (lane >> 4), ch = (lane & 15) ^ kswz(d);
                __builtin_amdgcn_global_load_lds((const unsigned*)(Vt + (size_t)d * ldv + 8 * ch), (LAS unsigned*)(vb + pc * 1024), 16, 0, 0); }
            else { const int d = 8 * pc + (lane >> 3), ch = (lane & 7) ^ ((d >> 1) & 7);
                __builtin_amdgcn_global_load_lds((const unsigned*)(Vt + (size_t)d * ldv + 8 * ch), (LAS unsigned*)(vb + pc * 1024), 16, 0, 0); }
        }
    }
}
__device__ __forceinline__ float xhalf_max(float x) { auto rr = __builtin_amdgcn_permlane32_swap(__float_as_uint(x), __float_as_uint(x), false, false); return fmaxf(__uint_as_float(rr[0]), __uint_as_float(rr[1])); }
__device__ __forceinline__ float xhalf_sum(float x) { auto rr = __builtin_amdgcn_permlane32_swap(__float_as_uint(x), __float_as_uint(x), false, false); return __uint_as_float(rr[0]) + __uint_as_float(rr[1]); }
template <int BR>
__device__ __forceinline__ float tile_prep(int MODE, f32x16& S, LAS const float* tb, float cb, int base, bool selbit) {
    float mx = -INFINITY;
    if (MODE == 1) {
#pragma unroll
        for (int r = 0; r < 16; ++r) mx = fmaxf(mx, S[r]);
    } else {
        const bool nomask = (MODE == 2);
        float bv[16];
#pragma unroll
        for (int r = 0; r < 16; ++r) { const int cr = (r & 3) + 8 * (r >> 2); const int dist = (BR <= 1) ? base - 16 * cr : base - cr; bv[r] = tb[min(max(dist, 0), TBN - 1)]; }
        __builtin_amdgcn_sched_barrier(0);
#pragma unroll
        for (int r = 0; r < 16; ++r) {
            const int cr = (r & 3) + 8 * (r >> 2);
            const int dist = (BR <= 1) ? base - 16 * cr : base - cr;
            float v = S[r] + bv[r];
            bool valid;
            if (BR <= 1) valid = dist >= 0; else if (BR == 2) valid = selbit && dist >= 0; else valid = nomask || (unsigned)dist < 512u;
            v = valid ? v : -INFINITY;
            S[r] = v; mx = fmaxf(mx, v);
        }
    }
    return mx;
}
constexpr float RESCALE_T = 8.f;
template <int BR, bool PEND>
__device__ __forceinline__ float tile_decide(float mx, float pre, f32x16 (&O)[4], float& m, float& l, u32x4& pa, u32x4& pb) {
    if (BR == 1) return 0.f;
    mx = xhalf_max(mx) - pre;
    const bool first = (m == -INFINITY);
    const bool fin = mx > -INFINITY;
    const bool move = !first && (mx > RESCALE_T);
    const float delta = ((first && fin) || move) ? mx : 0.f;
    if (__any(move)) {
        const float alpha = move ? fexp2(-delta) : 1.f;
        l *= alpha;
        if (BR >= 2) {
#pragma unroll
            for (int dt = 0; dt < 4; ++dt)
#pragma unroll
                for (int r = 0; r < 16; ++r) O[dt][r] *= alpha;
            if (PEND) {
#pragma unroll
                for (int e = 0; e < 4; ++e) { pa[e] = cvt_pk_bf16(bflo(pa[e]) * alpha, bfhi(pa[e]) * alpha); pb[e] = cvt_pk_bf16(bflo(pb[e]) * alpha, bfhi(pb[e]) * alpha); }
            }
        }
    }
    if ((first && fin) || move) m = (first ? 0.f : m) + delta;
    return pre + delta;
}
template <int BR, int KEYS>
__device__ __forceinline__ void attn_tile(int MODE, LAS const unsigned char* kb, LAS const unsigned char* vb, int cb0, LAS const float* tb, int key0, int t, int lane,
                                          const bf16x8 (&qf)[8], f32x16 (&O)[4], float& m, float& l, float inv_l, bool selbit, LAS float* imp_row) {
    asm volatile("" : "+v"(lane));
    constexpr int ROWB = 2 * KEYS;
    const int r31 = lane & 31, h = lane >> 5;
    const int gh = kswz(r31) ^ h, vh = vsw<KEYS>(r31) ^ h;
    float cb = 0.f;
    if (MODE == 1) cb = tb[TBN - 1];
    const float mref = (m == -INFINITY) ? 0.f : m;
    float ini = -mref;
    if (MODE == 1) ini = (BR == 2 && !selbit) ? -INFINITY : cb - mref;
    const int base0 = (BR <= 1) ? t - 31 - 16 * (key0 + 4 * h) : t - (key0 + 4 * h);
    const int base1 = (BR <= 1) ? base0 - 16 * 32 : base0 - 32;
    LAS const unsigned char* k0 = kb + r31 * 256;
    f32x16 S0, S1;
    bf16x8 kf[8];
#pragma unroll
    for (int ks = 0; ks < 8; ++ks) kf[ks] = *(const LAS bf16x8*)(k0 + 16 * ((2 * ks) ^ gh));
#pragma unroll
    for (int r = 0; r < 16; ++r) { S0[r] = ini; S1[r] = ini; }
    __builtin_amdgcn_sched_barrier(0);
#pragma unroll
    for (int ks = 0; ks < 8; ++ks) S0 = mfma32(kf[ks], qf[ks], S0);
    __builtin_amdgcn_sched_barrier(0);
#pragma unroll
    for (int ks = 0; ks < 8; ++ks) kf[ks] = *(const LAS bf16x8*)(k0 + 8192 + 16 * ((2 * ks) ^ gh));
    const float mx0 = tile_prep<BR>(MODE, S0, tb, cb, base0, selbit);
    u32x4 pk0a = {0u, 0u, 0u, 0u}, pk0b = {0u, 0u, 0u, 0u}, pk1a, pk1b;
    const float me0 = tile_decide<BR, false>(mx0, 0.f, O, m, l, pk0a, pk0b);
    __builtin_amdgcn_sched_barrier(0);
    {
#pragma unroll
        for (int ks = 0; ks < 8; ++ks) S1 = mfma32(kf[ks], qf[ks], S1);
        float ps = 0.f;
        if (__any(me0 != 0.f)) {
#pragma unroll
            for (int r = 0; r < 16; ++r) S0[r] -= me0; }
#pragma unroll
        for (int r = 0; r < 16; ++r) { float p = fexp2(S0[r]); if (BR == 1) p *= inv_l; S0[r] = p; ps += p; }
        if (BR != 1) l += ps;
        if (BR >= 1) {
#pragma unroll
            for (int e = 0; e < 4; ++e) { pk0a[e] = cvt_pk_bf16(S0[2 * e], S0[2 * e + 1]); pk0b[e] = cvt_pk_bf16(S0[8 + 2 * e], S0[8 + 2 * e + 1]); }
        }
#pragma unroll
        for (int i = 0; i < 8; ++i) { __builtin_amdgcn_sched_group_barrier(0x008, 1, 0); __builtin_amdgcn_sched_group_barrier(0x002, 10, 0); }
    }
    __builtin_amdgcn_sched_barrier(0);
    if (BR == 1) {
#pragma unroll
        for (int rg = 0; rg < 4; ++rg) {
            float A = 2.f * (S0[4 * rg] + S0[4 * rg + 1] + S0[4 * rg + 2]) + S0[4 * rg + 3], B = S0[4 * rg + 3];
            A = quad_sum(A); B = quad_sum(B);
            const int jj = (key0 >> 2) + 2 * rg + h;
            if ((lane & 3) == 0) { __hip_atomic_fetch_add(imp_row + jj, A, __ATOMIC_RELAXED, __HIP_MEMORY_SCOPE_WORKGROUP);
                if (jj + 1 < 256) __hip_atomic_fetch_add(imp_row + jj + 1, B, __ATOMIC_RELAXED, __HIP_MEMORY_SCOPE_WORKGROUP); }
        }
    }
    bf16x8 av[8];
    if (BR >= 1) {
#pragma unroll
        for (int s = 0; s < 2; ++s)
#pragma unroll
            for (int dt = 0; dt < 4; ++dt) av[s * 4 + dt] = *(const LAS bf16x8*)(vb + (32 * dt + r31) * ROWB + 16 * ((cb0 + 2 * s) ^ vh));
    }
    const float mx1 = tile_prep<BR>(MODE, S1, tb, cb, base1, selbit);
    const float me1 = tile_decide<BR, true>(mx1, me0, O, m, l, pk0a, pk0b);
    __builtin_amdgcn_sched_barrier(0);
    {
        if (BR >= 1) {
#pragma unroll
            for (int dt = 0; dt < 4; ++dt) O[dt] = mfma32(av[dt], __builtin_bit_cast(bf16x8, pk0a), O[dt]);
#pragma unroll
            for (int dt = 0; dt < 4; ++dt) O[dt] = mfma32(av[4 + dt], __builtin_bit_cast(bf16x8, pk0b), O[dt]);
        }
        float ps = 0.f;
        if (__any(me1 != 0.f)) {
#pragma unroll
            for (int r = 0; r < 16; ++r) S1[r] -= me1; }
#pragma unroll
        for (int r = 0; r < 16; ++r) { float p = fexp2(S1[r]); if (BR == 1) p *= inv_l; S1[r] = p; ps += p; }
        if (BR != 1) l += ps;
        if (BR >= 1) {
#pragma unroll
            for (int e = 0; e < 4; ++e) { pk1a[e] = cvt_pk_bf16(S1[2 * e], S1[2 * e + 1]); pk1b[e] = cvt_pk_bf16(S1[8 + 2 * e], S1[8 + 2 * e + 1]); }
#pragma unroll
            for (int i = 0; i < 8; ++i) { __builtin_amdgcn_sched_group_barrier(0x008, 1, 0); __builtin_amdgcn_sched_group_barrier(0x002, 10, 0); }
        }
    }
    __builtin_amdgcn_sched_barrier(0);
    if (BR == 1) {
#pragma unroll
        for (int rg = 0; rg < 4; ++rg) {
            float A = 2.f * (S1[4 * rg] + S1[4 * rg + 1] + S1[4 * rg + 2]) + S1[4 * rg + 3], B = S1[4 * rg + 3];
            A = quad_sum(A); B = quad_sum(B);
            const int jj = ((key0 + 32) >> 2) + 2 * rg + h;
            if ((lane & 3) == 0) { __hip_atomic_fetch_add(imp_row + jj, A, __ATOMIC_RELAXED, __HIP_MEMORY_SCOPE_WORKGROUP);
                if (jj + 1 < 256) __hip_atomic_fetch_add(imp_row + jj + 1, B, __ATOMIC_RELAXED, __HIP_MEMORY_SCOPE_WORKGROUP); }
        }
    }
    if (BR >= 1) {
#pragma unroll
        for (int s = 0; s < 2; ++s)
#pragma unroll
            for (int dt = 0; dt < 4; ++dt) av[s * 4 + dt] = *(const LAS bf16x8*)(vb + (32 * dt + r31) * ROWB + 16 * ((cb0 + 4 + 2 * s) ^ vh));
        __builtin_amdgcn_sched_barrier(0);
#pragma unroll
        for (int dt = 0; dt < 4; ++dt) O[dt] = mfma32(av[dt], __builtin_bit_cast(bf16x8, pk1a), O[dt]);
#pragma unroll
        for (int dt = 0; dt < 4; ++dt) O[dt] = mfma32(av[4 + dt], __builtin_bit_cast(bf16x8, pk1b), O[dt]);
    }
}
template <int BR, int KEYS>
__device__ __forceinline__ void run_branch(const Ctx& c, const bf16_t* Kb, const bf16_t* Vtb, int ldv, int lo, int hi, LAS const float* tb, int t, int t0,
                                           const bf16x8 (&qf)[8], f32x16 (&O)[4], float& m, float& l, float inv_l, int tl, LAS float* imp_row) {
    constexpr bool NEEDV = (BR != 0);
    constexpr int BPS = KEYS / 64, KSTG = KEYS * 256, VSTG = 128 * 2 * KEYS, VB0 = 2 * KSTG;
    LAS unsigned char* lds = c.lds;
    int lz = c.lane; asm volatile("" : "+v"(lz));
    const int nst = (hi - lo + BPS - 1) / BPS;
#define STG_BLK(i) ((lo + BPS * (i) + BPS - 1 < hi) ? lo + BPS * (i) : hi - BPS)
    asm volatile("s_waitcnt vmcnt(0)" ::: "memory");
    { const int b0 = (BPS == 2 && hi - lo < 2) ? lo : STG_BLK(0);
      stage_dma<KEYS, NEEDV>(Kb + (size_t)b0 * 64 * 128, Vtb + (size_t)b0 * 64, ldv, lds, lds + VB0, c.wave, lz); }
    asm volatile("s_waitcnt vmcnt(0)" ::: "memory");
    __syncthreads();
    const int qt = t0 >> 6;
    for (int i = 0; i < nst; ++i) {
        const int buf = i & 1;
        if (i + 1 < nst) { int lz2 = lz; asm volatile("" : "+v"(lz2));
            const int b1 = STG_BLK(i + 1);
            stage_dma<KEYS, NEEDV>(Kb + (size_t)b1 * 64 * 128, Vtb + (size_t)b1 * 64, ldv, lds + (buf ^ 1) * KSTG, lds + VB0 + (buf ^ 1) * VSTG, c.wave, lz2); }
        const int sb = (BPS == 2 && hi - lo < 2) ? lo : STG_BLK(i);
#pragma unroll
        for (int q = 0; q < BPS; ++q) {
            const int j = lo + BPS * i + q;
            if (j < hi) {
                bool selbit = true, wave_on = true;
                if (BR == 2) {
                    const unsigned w = *(const LAS unsigned*)(lds + AT_BM + (tl * 8 + (j >> 5)) * 4);
                    selbit = (w >> (j & 31)) & 1u;
                    const unsigned wu = *(const LAS unsigned*)(lds + AT_WU + (c.wave * 8 + (j >> 5)) * 4);
                    wave_on = (wu >> (j & 31)) & 1u;
                }
                if (wave_on) {
                    int mode = 0;
                    if (BR <= 1) mode = (1024 * j + 1829 <= t0) ? 1 : 0;
                    else if (BR == 2) mode = (64 * j + 853 <= t0) ? 1 : 0;
                    else mode = (j >= qt - 7 && j <= qt - 1) ? 2 : 0;
                    const int slot = j - sb;
                    attn_tile<BR, KEYS>(mode, lds + buf * KSTG + slot * 16384, lds + VB0 + buf * VSTG, 8 * slot, tb, j * 64, t, c.lane, qf, O, m, l, inv_l, selbit, imp_row);
                }
            }
        }
        asm volatile("s_waitcnt vmcnt(0)" ::: "memory");
        __syncthreads();
    }
#undef STG_BLK
}
__device__ __forceinline__ void attn_item(const Args& a, const Ctx& c_, int qt, int g) {
    Ctx c = c_; { int tz = c_.tid; asm volatile("" : "+v"(tz)); c.tid = tz; c.lane = tz & 63; }
    LAS unsigned char* lds = c.lds;
    const int tid = c.tid, wave = c.wave, lane = c.lane, r31 = lane & 31, h = lane >> 5, hl = lane & 3;
    const int t0 = qt * 64, tl = 8 * wave + (r31 >> 2), t = t0 + tl, head = g * 4 + hl;
    const bf16_t* Qb = (const bf16_t*)(a.ws + WS_Q);
    const bf16_t* KROW = (const bf16_t*)(a.ws + WS_KROW);
    const bf16_t* VT = (const bf16_t*)(a.ws + WS_VT);
    const float* GATE = (const float*)(a.ws + WS_GATE);
    { const float* tbg = (const float*)(a.ws + WS_TB) + g * 4 * TBN;
      for (int i = tid; i < 4 * TBN; i += NTHREADS) *(LAS float*)(lds + AT_TB + i * 4) = tbg[i];
      for (int i = tid; i < 64 * 256; i += NTHREADS) *(LAS float*)(lds + AT_IMP + i * 4) = 0.f; }
    bf16x8 qf[8];
#pragma unroll
    for (int ks = 0; ks < 8; ++ks) qf[ks] = *(const bf16x8*)(Qb + (size_t)t * 1024 + head * 128 + 16 * ks + 8 * h);
    LAS const float* tb = (LAS const float*)(lds + AT_TB) + hl * TBN;
    LAS float* imp_row = (LAS float*)(lds + AT_IMP) + tl * 256;
    bf16_t* Y = (bf16_t*)(a.ws + WS_Y2) + (size_t)t * 2048 + 1024 + head * 128 + 4 * h;
    f32x16 O[4];
#pragma unroll
    for (int dt = 0; dt < 4; ++dt)
#pragma unroll
        for (int r = 0; r < 16; ++r) O[dt][r] = 0.f;
    __syncthreads();
    { const int ntile = (t0 / 16 + 3 + 63) / 64;
      const bf16_t* KC = (const bf16_t*)(a.ws + WS_KC) + (size_t)g * 1024 * 128; const bf16_t* VCT = (const bf16_t*)(a.ws + WS_VCT) + (size_t)g * 128 * 1024;
      float m = -INFINITY, l = 0.f;
#if defined(PROBE_CMP)
      run_branch<0, 64>(c, KC, VCT, 1024, 0, ntile, tb, t, t0, qf, O, m, l, 0.f, tl, imp_row);
      asm volatile("" :: "v"(m), "v"(l));
      m = -INFINITY; l = 0.f;
#endif
      run_branch<0, 64>(c, KC, VCT, 1024, 0, ntile, tb, t, t0, qf, O, m, l, 0.f, tl, imp_row);
      const float lt = xhalf_sum(l), inv = lt > 0.f ? 1.f / lt : 0.f;
      run_branch<1, 64>(c, KC, VCT, 1024, 0, ntile, tb, t, t0, qf, O, m, l, inv, tl, imp_row);
      const float gc = GATE[(size_t)t * 24 + head];
#pragma unroll
      for (int dt = 0; dt < 4; ++dt)
#pragma unroll
          for (int rg = 0; rg < 4; ++rg) {
              u32x2 w; w[0] = cvt_pk_bf16(gc * O[dt][4 * rg], gc * O[dt][4 * rg + 1]); w[1] = cvt_pk_bf16(gc * O[dt][4 * rg + 2], gc * O[dt][4 * rg + 3]);
              *(u32x2*)(Y + 32 * dt + 8 * rg) = w;
#pragma unroll
              for (int e = 0; e < 4; ++e) O[dt][4 * rg + e] = 0.f;
          }
    }
    {
        const int ncand = qt - 2 > 0 ? qt - 2 : 0;
        unsigned v[8][4], selm[8];
#pragma unroll
        for (int i = 0; i < 8; ++i) {
            LAS const float* row = (LAS const float*)(lds + AT_IMP) + (8 * wave + i) * 256;
            selm[i] = 0u;
#pragma unroll
            for (int k = 0; k < 4; ++k) { const int j = lane + 64 * k; const bool cand = (j >= 1 && j <= qt - 2);
                v[i][k] = cand ? ((__float_as_uint(row[j]) & ~0xFFu) | (unsigned)(255 - j)) : 0u; if (ncand <= 13 && cand) selm[i] |= 1u << k; }
        }
        if (ncand > 13) {
            for (int it = 0; it < 13; ++it) {
#pragma unroll
                for (int i = 0; i < 8; ++i) {
                    const unsigned mx = wave_umax_bcast(max(max(v[i][0], v[i][1]), max(v[i][2], v[i][3])));
#pragma unroll
                    for (int k = 0; k < 4; ++k) if (v[i][k] == mx) { v[i][k] = 0u; selm[i] |= 1u << k; }
                }
            }
        }
        unsigned wu[8];
#pragma unroll
        for (int k = 0; k < 8; ++k) wu[k] = 0u;
#pragma unroll
        for (int i = 0; i < 8; ++i)
#pragma unroll
            for (int k = 0; k < 4; ++k) {
                const int j = lane + 64 * k; const bool forced = (j == 0) || (j == qt) || (j == qt - 1);
                const unsigned long long mk = __ballot(((selm[i] >> k) & 1u) || forced);
                const unsigned lo = (unsigned)mk, hi = (unsigned)(mk >> 32);
                if (lane == 0) { *(LAS unsigned*)(lds + AT_BM + ((8 * wave + i) * 8 + 2 * k) * 4) = lo; *(LAS unsigned*)(lds + AT_BM + ((8 * wave + i) * 8 + 2 * k + 1) * 4) = hi; }
                wu[2 * k] |= lo; wu[2 * k + 1] |= hi;
            }
        if (lane == 0) {
#pragma unroll
            for (int k = 0; k < 8; ++k) *(LAS unsigned*)(lds + AT_WU + (wave * 8 + k) * 4) = wu[k];
        }
    }
    __syncthreads();
#if defined(PROBE_SEL)
    { float m = -INFINITY, l = 0.f;
      run_branch<2, 128>(c, KROW + (size_t)(2 + g) * L_ * 128, VT + (size_t)g * 128 * L_, L_, 0, qt + 1, tb, t, t0, qf, O, m, l, 0.f, tl, imp_row);
      asm volatile("" :: "v"(O[0]), "v"(O[1]), "v"(O[2]), "v"(O[3]), "v"(m), "v"(l));
#pragma unroll
      for (int dt = 0; dt < 4; ++dt)
#pragma unroll
          for (int r = 0; r < 16; ++r) O[dt][r] = 0.f; }
#endif
    { float m = -INFINITY, l = 0.f;
      run_branch<2, 128>(c, KROW + (size_t)(2 + g) * L_ * 128, VT + (size_t)g * 128 * L_, L_, 0, qt + 1, tb, t, t0, qf, O, m, l, 0.f, tl, imp_row);
      const float gs = GATE[(size_t)t * 24 + 8 + head];
      const float lt = xhalf_sum(l), sc = gs * (lt > 0.f ? 1.f / lt : 0.f);
#pragma unroll
      for (int dt = 0; dt < 4; ++dt)
#pragma unroll
          for (int rg = 0; rg < 4; ++rg) {
              const u32x2 w0 = *(const u32x2*)(Y + 32 * dt + 8 * rg);
              u32x2 w; w[0] = cvt_pk_bf16(bflo(w0[0]) + sc * O[dt][4 * rg], bfhi(w0[0]) + sc * O[dt][4 * rg + 1]); w[1] = cvt_pk_bf16(bflo(w0[1]) + sc * O[dt][4 * rg + 2], bfhi(w0[1]) + sc * O[dt][4 * rg + 3]);
              *(u32x2*)(Y + 32 * dt + 8 * rg) = w;
#pragma unroll
              for (int e = 0; e < 4; ++e) O[dt][4 * rg + e] = 0.f;
          }
    }
#if defined(PROBE_WIN)
    { float m = -INFINITY, l = 0.f;
      const int lo = qt - 8 > 0 ? qt - 8 : 0;
      run_branch<3, 128>(c, KROW + (size_t)(4 + g) * L_ * 128, VT + (size_t)(2 + g) * 128 * L_, L_, lo, qt + 1, tb, t, t0, qf, O, m, l, 0.f, tl, imp_row);
      asm volatile("" :: "v"(O[0]), "v"(O[1]), "v"(O[2]), "v"(O[3]), "v"(m), "v"(l));
#pragma unroll
      for (int dt = 0; dt < 4; ++dt)
#pragma unroll
          for (int r = 0; r < 16; ++r) O[dt][r] = 0.f; }
#endif
    { float m = -INFINITY, l = 0.f;
      const int lo = qt - 8 > 0 ? qt - 8 : 0;
      run_branch<3, 128>(c, KROW + (size_t)(4 + g) * L_ * 128, VT + (size_t)(2 + g) * 128 * L_, L_, lo, qt + 1, tb, t, t0, qf, O, m, l, 0.f, tl, imp_row);
      const float gw = GATE[(size_t)t * 24 + 16 + head];
      const float lt = xhalf_sum(l), sc = gw * (lt > 0.f ? 1.f / lt : 0.f);
      float ss = 0.f;
#pragma unroll
      for (int dt = 0; dt < 4; ++dt)
#pragma unroll
          for (int rg = 0; rg < 4; ++rg) {
              const u32x2 w0 = *(const u32x2*)(Y + 32 * dt + 8 * rg);
              const float y0 = bflo(w0[0]) + sc * O[dt][4 * rg], y1 = bfhi(w0[0]) + sc * O[dt][4 * rg + 1], y2 = bflo(w0[1]) + sc * O[dt][4 * rg + 2], y3 = bfhi(w0[1]) + sc * O[dt][4 * rg + 3];
              u32x2 w; w[0] = cvt_pk_bf16(y0, y1); w[1] = cvt_pk_bf16(y2, y3);
              *(u32x2*)(Y + 32 * dt + 8 * rg) = w;
              ss += (y0 * y0 + y1 * y1) + (y2 * y2 + y3 * y3);
          }
      ss = quad_sum(xhalf_sum(ss));
      if (hl == 0 && h == 0) ((float*)(a.ws + WS_STAP))[(size_t)t * 2 + g] = ss;
    }
    __syncthreads();
}
#ifndef PEER_ALPHA
#define PEER_ALPHA 1.0f
#endif
constexpr int PE_SC = 0, PE_PK = 65536, PE_LV = 131072, PE_LI = 139264, PE_EX = 147456, PE_GT = 149504, PE_SU = 153600, PE_CE = 157696, PE_END = 161792;
constexpr int PE_SLOT = 2048, PE_NSLOT = 8, PE_RINGW = PE_SLOT * 8;
static_assert(8 * PE_RINGW <= PE_LV && PE_END <= LDS_BYTES - 32, "PEER LDS map");
__device__ __forceinline__ float pair_wave_sum(float a, float b, bool odd) {
    a += dpp_f<0xB1>(a); b += dpp_f<0xB1>(b);
    float c = odd ? b : a;
    c += dpp_f<0x4E>(c); c += dpp_f<0x124>(c); c += dpp_f<0x128>(c);
    { const auto r = __builtin_amdgcn_permlane16_swap(__float_as_uint(c), __float_as_uint(c), false, false); c = __uint_as_float(r[0]) + __uint_as_float(r[1]); }
    { const auto r = __builtin_amdgcn_permlane32_swap(__float_as_uint(c), __float_as_uint(c), false, false); c = __uint_as_float(r[0]) + __uint_as_float(r[1]); }
    return c;
}
__device__ __forceinline__ float wave_sum_bcast(float v) {
    v += dpp_f<0xB1>(v); v += dpp_f<0x4E>(v); v += dpp_f<0x141>(v); v += dpp_f<0x140>(v);
    v += __int_as_float(__builtin_amdgcn_update_dpp(0, __float_as_int(v), 0x142, 0xa, 0xf, false));
    v += __int_as_float(__builtin_amdgcn_update_dpp(0, __float_as_int(v), 0x143, 0xc, 0xf, false));
    return __int_as_float(__builtin_amdgcn_readlane(__float_as_int(v), 63));
}
__device__ __forceinline__ unsigned mono_key(float v) { const unsigned b = __float_as_uint(v); return b ^ ((b >> 31) ? 0xFFFFFFFFu : 0x80000000u); }
template <int CTRL>
__device__ __forceinline__ void quad_merge16(unsigned (&t)[16]) {
    unsigned o[16];
#pragma unroll
    for (int i = 0; i < 16; ++i) o[i] = (unsigned)__builtin_amdgcn_update_dpp(0, (int)t[15 - i], CTRL, 0xf, 0xf, false);
#pragma unroll
    for (int i = 0; i < 16; ++i) t[i] = max(t[i], o[i]);
#pragma unroll
    for (int st = 8; st >= 1; st >>= 1)
#pragma unroll
        for (int i = 0; i < 16; ++i) if ((i & st) == 0) { const unsigned hi = max(t[i], t[i + st]), lo = min(t[i], t[i + st]); t[i] = hi; t[i + st] = lo; }
}
__device__ __forceinline__ void sort16_desc(unsigned (&t)[16]) {
#pragma unroll
    for (int k = 2; k <= 16; k <<= 1)
#pragma unroll
        for (int j = k >> 1; j > 0; j >>= 1)
#pragma unroll
            for (int i = 0; i < 16; ++i) { const int l = i ^ j; if (l > i) { const bool desc = ((i & k) == 0); const unsigned hi = max(t[i], t[l]), lo = min(t[i], t[l]); t[i] = desc ? hi : lo; t[l] = desc ? lo : hi; } }
}
__device__ __forceinline__ void bitonic_merge16_desc(unsigned (&t)[16]) {
#pragma unroll
    for (int st = 8; st >= 1; st >>= 1)
#pragma unroll
        for (int i = 0; i < 16; ++i) if ((i & st) == 0) { const unsigned hi = max(t[i], t[i + st]), lo = min(t[i], t[i + st]); t[i] = hi; t[i + st] = lo; }
}
__device__ __forceinline__ int pair_a(int p) { return p < 16 ? 0 : p < 24 ? 1 : p < 29 ? 2 : p < 33 ? 3 : p < 36 ? 4 : p < 38 ? 5 : p < 40 ? 6 : p < 42 ? 7 : p - 34; }
__device__ __forceinline__ int pair_b(int p) { return p < 16 ? p : p < 24 ? p - 16 : p < 29 ? p - 24 : p < 33 ? p - 29 : p < 36 ? p - 33 : p < 38 ? p - 36 : p < 40 ? p - 38 : p < 42 ? p - 40 : 0; }
template <class Sched>
__device__ __forceinline__ void route_units(const Args& a, const Ctx& c_, const Sched& S) {
    Ctx c = c_; { int tz = c_.tid; asm volatile("" : "+v"(tz)); c.tid = tz; c.lane = tz & 63; }
    LAS unsigned char* lds = c.lds;
    const int tid = c.tid, wave = c.wave, lane = c.lane, r = lane & 15, q = lane >> 4;
    const bf16_t* QP = (const bf16_t*)(a.ws + WS_QP); const bf16_t* PK = (const bf16_t*)(a.ws + WS_PK);
    float* RLV = (float*)(a.ws + WS_RLV); int* RLI = (int*)(a.ws + WS_RLI);
    Unit ucur, unxt;
    if (!S.next(0, ucur)) return;
    int pm = ucur.pm, h = ucur.pn;
#pragma unroll
    for (int i = 0; i < 8; ++i) { const int pc = 8 * wave + i, row = 4 * pc + (lane >> 4), ch = (lane & 15) ^ kswz(row);
        __builtin_amdgcn_global_load_lds((const unsigned*)(PK + (size_t)row * 128 + ch * 8), (LAS unsigned*)(lds + PE_PK + pc * 1024), 16, 0, 0); }
    bf16x8 aF[2][4];
#pragma unroll
    for (int cc = 0; cc < 2; ++cc)
#pragma unroll
        for (int ks = 0; ks < 4; ++ks) aF[cc][ks] = *(const bf16x8*)(QP + (size_t)(pm * 256 + 8 * wave + (r & 7)) * 2048 + h * 256 + cc * 128 + 32 * ks + 8 * q);
    for (int ui = 0;; ++ui) {
    const bool has_next = S.next(ui + 1, unxt);
    for (int p = 0; p < 4; ++p) {
        int lz = lane; asm volatile("" : "+v"(lz));
        const int rr = lz & 15, qq = lz >> 4;
        const int tb = pm * 256 + 64 * p;
        asm volatile("s_waitcnt vmcnt(0)" ::: "memory");
        __syncthreads();
        const int ksw = kswz(rr);
#pragma unroll
        for (int cc = 0; cc < 2; ++cc)
#pragma unroll 2
            for (int nt = 0; nt < 8; ++nt) {
                f32x4 acc = {0.f, 0.f, 0.f, 0.f};
#pragma unroll
                for (int ks = 0; ks < 4; ++ks) { const bf16x8 B = *(const LAS bf16x8*)(lds + PE_PK + (cc * 128 + 16 * nt + rr) * 256 + 16 * ((4 * ks + qq) ^ ksw)); acc = mfma16(aF[cc][ks], B, acc); }
                if (qq < 2) {
#pragma unroll
                    for (int i = 0; i < 4; ++i) { const int task = (8 * wave + 4 * qq + i) * 2 + cc; *(LAS float*)(lds + PE_SC + (task * 128 + ((16 * nt + rr + task) & 127)) * 4) = acc[i]; }
                }
            }
        if (p < 3 || has_next) {
            const int tn = (p < 3) ? tb + 64 : unxt.pm * 256, hn = (p < 3) ? h : unxt.pn;
#pragma unroll
            for (int cc = 0; cc < 2; ++cc)
#pragma unroll
                for (int ks = 0; ks < 4; ++ks) aF[cc][ks] = *(const bf16x8*)(QP + (size_t)(tn + 8 * wave + (rr & 7)) * 2048 + hn * 256 + cc * 128 + 32 * ks + 8 * qq);
        }
        __syncthreads();
        {
            const int task = tid >> 2, part = tid & 3;
            LAS const float* sc = (LAS const float*)(lds + PE_SC) + task * 128;
            float vals[32];
#pragma unroll
            for (int k = 0; k < 32; ++k) vals[k] = sc[(32 * part + k + task) & 127];
            unsigned top[16], tb2[16];
#pragma unroll
            for (int k = 0; k < 16; ++k) { top[k] = (mono_key(vals[k]) & ~0x7Fu) | (unsigned)(127 - (32 * part + k)); tb2[k] = (mono_key(vals[16 + k]) & ~0x7Fu) | (unsigned)(127 - (32 * part + 16 + k)); }
            sort16_desc(top); sort16_desc(tb2);
#pragma unroll
            for (int i = 0; i < 16; ++i) top[i] = max(top[i], tb2[15 - i]);
            bitonic_merge16_desc(top);
            quad_merge16<0xB1>(top);
            quad_merge16<0x4E>(top);
            if (part == 0) {
                const size_t base = (((size_t)(tb + (task >> 1)) * 8 + h) * 2 + (task & 1)) * 16;
#pragma unroll
                for (int e4 = 0; e4 < 4; ++e4) { f32x4 vv; u32x4 ii;
#pragma unroll
                    for (int e = 0; e < 4; ++e) { const int idx = 127 - (int)(top[4 * e4 + e] & 0x7Fu); vv[e] = sc[(idx + task) & 127]; ii[e] = (unsigned)idx; }
                    *(f32x4*)(RLV + base + 4 * e4) = vv; *(u32x4*)(RLI + base + 4 * e4) = ii; }
            }
        }
    }
    if (!has_next) break;
    pm = unxt.pm; h = unxt.pn;
    }
    __syncthreads();
}
template <bool DRY>
__device__ __forceinline__ void peer_step(const Args& a, const Ctx& c_, int t0, bool first, int t0_next) {
    Ctx c = c_; { int tz = c_.tid; asm volatile("" : "+v"(tz)); c.tid = tz; c.lane = tz & 63; }
    LAS unsigned char* lds = c.lds;
    const int tid = c.tid, wave = c.wave, lane = c.lane, r = lane & 15, q = lane >> 4;
    const bf16_t* QP = (const bf16_t*)(a.ws + WS_QP); const bf16_t* PK = (const bf16_t*)(a.ws + WS_PK);
    const unsigned char* PU = a.ws + WS_PU; const unsigned char* PV = a.ws + WS_PV; const float* psc = (const float*)(a.ws + WS_PSC);
    const bf16_t* HB = (const bf16_t*)(a.ws + WS_H2);
    const int t = t0 + wave;
    u32x2 hraw[8], xw[8];
#pragma unroll
    for (int k = 0; k < 8; ++k) hraw[k] = *(const u32x2*)(HB + (size_t)t * 2048 + 256 * k + lane * 4);
#pragma unroll
    for (int k = 0; k < 8; ++k) xw[k] = *(const u32x2*)((const bf16_t*)(a.ws + WS_X1) + (size_t)t * 2048 + 256 * k + lane * 4);
    const float r2 = ((const float*)(a.ws + WS_RSTD2))[t0 + ((tid >> 5) & 7)];
#define LIST_DMA(T0) do { const float* RLV_ = (const float*)(a.ws + WS_RLV); const int* RLI_ = (const int*)(a.ws + WS_RLI); \
        __builtin_amdgcn_global_load_lds((const unsigned*)(RLV_ + (size_t)(T0) * 256 + wave * 256 + lane * 4), (LAS unsigned*)(lds + PE_LV + wave * 1024), 16, 0, 0); \
        __builtin_amdgcn_global_load_lds((const unsigned*)(RLI_ + (size_t)(T0) * 256 + wave * 256 + lane * 4), (LAS unsigned*)(lds + PE_LI + wave * 1024), 16, 0, 0); } while (0)
    if (first) { LIST_DMA(t0); asm volatile("s_waitcnt vmcnt(0)" ::: "memory"); __syncthreads(); }
    if (tid < 256) {
        const int task = tid >> 2, part = tid & 3, tok = task >> 3, hh = task & 7, t1 = tok * 16 + hh * 2, t2 = t1 + 1;
        LAS const float* lv1 = (LAS const float*)(lds + PE_LV) + t1 * 16; LAS const float* lv2 = (LAS const float*)(lds + PE_LV) + t2 * 16;
        unsigned top[16];
#pragma unroll
        for (int i = 0; i < 16; ++i) {
            const int p = part + 4 * i;
            top[i] = 0u;
            if (i < 13 && p < 50) { const int aa = pair_a(p), bb = pair_b(p); top[i] = (mono_key(lv1[aa] + lv2[bb]) & ~0xFFu) | (unsigned)(255 - (aa * 16 + bb)); }
        }
        sort16_desc(top);
        quad_merge16<0xB1>(top);
        quad_merge16<0x4E>(top);
        if (part == 0) {
            LAS const int* li1 = (LAS const int*)(lds + PE_LI) + t1 * 16; LAS const int* li2 = (LAS const int*)(lds + PE_LI) + t2 * 16;
            float sv[16]; int ex[16]; float mx = -INFINITY;
#pragma unroll
            for (int e = 0; e < 16; ++e) {
                const int id = 255 - (int)(top[e] & 0xFFu), aa = id >> 4, bb = id & 15;
                sv[e] = lv1[aa] + lv2[bb]; ex[e] = li1[aa] * 128 + li2[bb]; mx = fmaxf(mx, sv[e]);
            }
            float sum = 0.f;
#pragma unroll
            for (int e = 0; e < 16; ++e) { sv[e] = fexp2((sv[e] - mx) * LOG2E); sum += sv[e]; }
            const float inv = 1.f / sum;
#pragma unroll
            for (int e = 0; e < 16; ++e) *(LAS unsigned short*)(lds + PE_EX + (tok * 128 + hh * 16 + e) * 2) = (unsigned short)ex[e];
            f32x4 rec[16];
#pragma unroll
            for (int e = 0; e < 16; ++e) rec[e] = *(const f32x4*)(psc + (size_t)ex[e] * 4);
            __builtin_amdgcn_sched_barrier(0);
#pragma unroll
            for (int e = 0; e < 16; ++e) asm volatile("" :: "v"(rec[e]));
#pragma unroll
            for (int e = 0; e < 16; ++e) {
                *(LAS float*)(lds + PE_GT + (tok * 128 + hh * 16 + e) * 4) = sv[e] * inv * rec[e][2];
                *(LAS float*)(lds + PE_SU + (tok * 128 + hh * 16 + e) * 4) = rec[e][0] * r2;
                *(LAS float*)(lds + PE_CE + (tok * 128 + hh * 16 + e) * 4) = rec[e][1]; }
        }
    }
    __syncthreads();
    f32x2 hp[16];
#pragma unroll
    for (int k = 0; k < 8; ++k)
#pragma unroll
        for (int e = 0; e < 2; ++e) { hp[k * 2 + e][0] = bflo(hraw[k][e]); hp[k * 2 + e][1] = bfhi(hraw[k][e]); }
    f32x2 acc[16];
#pragma unroll
    for (int e = 0; e < 16; ++e) acc[e] = (f32x2){0.f, 0.f};
    asm volatile("s_waitcnt vmcnt(0)" ::: "memory");
    if (t0_next >= 0) { int lz = lane; asm volatile("" : "+v"(lz)); const int lane = lz; LIST_DMA(t0_next); }
#undef LIST_DMA
    f32x4 gvv[8], fvv[8];
    {
        int lo_ = wave * 512 + (lane & 1) * 4; asm volatile("" : "+v"(lo_));
        LAS const float* gtl = (LAS const float*)(lds + PE_GT + lo_); LAS const float* sul = (LAS const float*)(lds + PE_SU + lo_); LAS const float* cel = (LAS const float*)(lds + PE_CE + lo_);
        int xo_ = wave * 256; asm volatile("" : "+v"(xo_));
        LAS const unsigned short* exl = (LAS const unsigned short*)(lds + PE_EX + xo_);
        const bool odd = lane & 1;
        LAS unsigned char* ring = lds + wave * PE_RINGW;
#define ISSUE_U(SL, IDX) do { const int ex_ = __builtin_amdgcn_readfirstlane((int)exl[IDX]); \
            __builtin_amdgcn_global_load_lds((const unsigned*)(PU + (size_t)ex_ * 1024 + lane * 16), (LAS unsigned*)(ring + (SL) * PE_SLOT), 16, 0, 0); } while (0)
#define ISSUE_V(SL, IDX) do { const int ex_ = __builtin_amdgcn_readfirstlane((int)exl[IDX]); \
            __builtin_amdgcn_global_load_lds((const unsigned*)(PV + (size_t)ex_ * 1024 + lane * 16), (LAS unsigned*)(ring + (SL) * PE_SLOT + 1024), 16, 0, 0); } while (0)
#define UDOT(UW, D0, D1, D2, D3) do { _Pragma("unroll") for (int dw = 0; dw < 4; ++dw) { const f32x2 f0_ = fp4_unpk<0>(UW[dw]), f1_ = fp4_unpk<1>(UW[dw]), f2_ = fp4_unpk<2>(UW[dw]), f3_ = fp4_unpk<3>(UW[dw]); \
                D0 += f0_ * hp[4 * dw]; D1 += f1_ * hp[4 * dw + 1]; D2 += f2_ * hp[4 * dw + 2]; D3 += f3_ * hp[4 * dw + 3]; } } while (0)
#define VACC(VW, WG) do { _Pragma("unroll") for (int dw = 0; dw < 4; ++dw) { const f32x2 f0_ = fp4_unpk<0>(VW[dw]), f1_ = fp4_unpk<1>(VW[dw]), f2_ = fp4_unpk<2>(VW[dw]), f3_ = fp4_unpk<3>(VW[dw]); \
                acc[4 * dw] += WG * f0_; acc[4 * dw + 1] += WG * f1_; acc[4 * dw + 2] += WG * f2_; acc[4 * dw + 3] += WG * f3_; } } while (0)
#define STAGE_A(SA, SB, PA, PB) do { const u32x4 ua_ = *(const LAS u32x4*)(ring + (SA) * PE_SLOT + lane * 16), ub_ = *(const LAS u32x4*)(ring + (SB) * PE_SLOT + lane * 16); \
            f32x2 a0_ = {0.f, 0.f}, a1_ = {0.f, 0.f}, a2_ = {0.f, 0.f}, a3_ = {0.f, 0.f}, b0_ = {0.f, 0.f}, b1_ = {0.f, 0.f}, b2_ = {0.f, 0.f}, b3_ = {0.f, 0.f}; \
            UDOT(ua_, a0_, a1_, a2_, a3_); UDOT(ub_, b0_, b1_, b2_, b3_); \
            const f32x2 as_ = (a0_ + a1_) + (a2_ + a3_), bs_ = (b0_ + b1_) + (b2_ + b3_); PA = as_[0] + as_[1]; PB = bs_[0] + bs_[1]; } while (0)
#define STAGE_B(IDX, PA, PB, WA, WB) do { const float cs_ = pair_wave_sum(PA, PB, odd);                           \
            const float wl_ = gtl[IDX] * gelu_tanh(cs_ * sul[IDX] + cel[IDX]);                            \
            WA = dpp_f<0xA0>(wl_); WB = dpp_f<0xF5>(wl_); } while (0)
#define STAGE_C(SA, SB, WA, WB) do { const u32x4 va_ = *(const LAS u32x4*)(ring + (SA) * PE_SLOT + 1024 + lane * 16), vb_ = *(const LAS u32x4*)(ring + (SB) * PE_SLOT + 1024 + lane * 16); \
            VACC(va_, WA); VACC(vb_, WB); } while (0)
#define DMA_WAIT(N) asm volatile("s_waitcnt vmcnt(" #N ")" ::: "memory")
#define LDS_DONE() asm volatile("s_waitcnt lgkmcnt(0)" ::: "memory")
#define PAIR_ITER(P, NS, DOA, UW, DOU, VW, DOV) do { float na_ = 0.f, nb_ = 0.f, wa_, wb_; \
            if (DOA) { DMA_WAIT(UW); STAGE_A(NS, (NS) + 1, na_, nb_); } \
            STAGE_B(e + 2 * (P), pa, pb, wa_, wb_); \
            LDS_DONE(); \
            if (DOU) { ISSUE_U(NS, e + 2 * (P) + 10); ISSUE_U((NS) + 1, e + 2 * (P) + 11); } \
            DMA_WAIT(VW); STAGE_C(2 * (P), 2 * (P) + 1, wa_, wb_); \
            LDS_DONE(); \
            if (DOV) { ISSUE_V(2 * (P), e + 2 * (P) + 8); ISSUE_V(2 * (P) + 1, e + 2 * (P) + 9); } \
            pa = na_; pb = nb_; } while (0)
        float pa, pb;
        if (!DRY) {
        ISSUE_U(0, 0); ISSUE_U(1, 1); ISSUE_U(2, 2); ISSUE_U(3, 3); ISSUE_V(0, 0); ISSUE_V(1, 1); ISSUE_U(4, 4); ISSUE_U(5, 5); ISSUE_V(2, 2); ISSUE_V(3, 3);
        ISSUE_U(6, 6); ISSUE_U(7, 7); ISSUE_V(4, 4); ISSUE_V(5, 5);
        DMA_WAIT(12); STAGE_A(0, 1, pa, pb); LDS_DONE();
        ISSUE_U(0, 8); ISSUE_U(1, 9); ISSUE_V(6, 6); ISSUE_V(7, 7);
#pragma unroll 1
        for (int tr = 0; tr < 14; ++tr) {
            const int e = tr * 8;
            PAIR_ITER(0, 2, true, 14, true, 14, true);
            PAIR_ITER(1, 4, true, 14, true, 14, true);
            PAIR_ITER(2, 6, true, 14, true, 14, true);
            PAIR_ITER(3, 0, true, 14, true, 14, true);
        }
        { const int e = 14 * 8;
            PAIR_ITER(0, 2, true, 14, true, 14, true);
            PAIR_ITER(1, 4, true, 14, true, 14, true);
            PAIR_ITER(2, 6, true, 14, true, 14, true);
            PAIR_ITER(3, 0, true, 14, false, 12, true); }
        { const float* g2 = (const float*)(a.ws + WS_COND) + 5 * 2048; const float* fg = a.in[32];
#pragma unroll
          for (int k = 0; k < 8; ++k) { const int col = 256 * k + lane * 4; gvv[k] = *(const f32x4*)(g2 + col); fvv[k] = *(const f32x4*)(fg + col); } }
        { const int e = 15 * 8;
            PAIR_ITER(0, 2, true, 28, false, 26, false);
            PAIR_ITER(1, 4, true, 24, false, 22, false);
            PAIR_ITER(2, 6, true, 20, false, 18, false);
            PAIR_ITER(3, 0, false, 0, false, 16, false); }
        }
#undef ISSUE_U
#undef ISSUE_V
#undef STAGE_A
#undef STAGE_B
#undef STAGE_C
#undef LDS_DONE
#undef PAIR_ITER
#undef UDOT
#undef VACC
#undef DMA_WAIT
    }
    {
        float* xo = a.out + (size_t)t * 2048;
        float ss = 0.f;
#pragma unroll
        for (int k = 0; k < 8; ++k) {
            const float x1[4] = {bflo(xw[k][0]), bfhi(xw[k][0]), bflo(xw[k][1]), bfhi(xw[k][1])};
#pragma unroll
            for (int e = 0; e < 4; ++e) { const float x2 = x1[e] + PEER_ALPHA * gvv[k][e] * acc[k * 2 + (e >> 1)][e & 1]; acc[k * 2 + (e >> 1)][e & 1] = x2; ss += x2 * x2; }
        }
        ss = wave_sum_bcast(ss);
        const float rstd = rsqrtf(ss * (1.f / 2048.f) + 1e-6f);
#pragma unroll
        for (int k = 0; k < 8; ++k) {
            const int col = 256 * k + lane * 4;
            f32x4 o;
#pragma unroll
            for (int e = 0; e < 4; ++e) o[e] = acc[k * 2 + (e >> 1)][e & 1] * rstd * fvv[k][e];
            if (!DRY || rstd == 123.456f) *(f32x4*)(xo + col) = o;
        }
    }
    __syncthreads();
}
constexpr int NPHASE = 9;
#ifndef DBG
#define DBG 0
#endif
__device__ __forceinline__ void dbg_final_norm(const Args& a, const Ctx& c, const float* src) {
    for (int t = c.bid * 8 + c.wave; t < L_; t += c.nb * 8) {
        const float* xr = src + (size_t)t * 2048 + c.lane * 4; float* o = a.out + (size_t)t * 2048 + c.lane * 4;
        f32x4 v[8]; float ss = 0.f;
#pragma unroll
        for (int j = 0; j < 8; ++j) { v[j] = *(const f32x4*)(xr + j * 256); ss += v[j][0] * v[j][0] + v[j][1] * v[j][1] + v[j][2] * v[j][2] + v[j][3] * v[j][3]; }
        ss = wave_sum(ss);
        const float rstd = rsqrtf(ss * (1.f / 2048.f) + 1e-6f);
#pragma unroll
        for (int j = 0; j < 8; ++j) { const f32x4 g = *(const f32x4*)(a.in[32] + j * 256 + c.lane * 4); *(f32x4*)(o + j * 256) = v[j] * rstd * g; }
    }
}

extern __shared__ __attribute__((aligned(16))) unsigned char smem[];

__global__ void __launch_bounds__(512, 2) fwd(Args a) {
    LAS unsigned char* lds = (LAS unsigned char*)smem;
    Ctx c; c.bid = blockIdx.x; c.nb = gridDim.x; c.tid = threadIdx.x; c.wave = __builtin_amdgcn_readfirstlane(threadIdx.x >> 6); c.lane = threadIdx.x & 63; c.lds = lds;
    volatile LAS unsigned* xbw = (volatile LAS unsigned*)(lds + LDS_BYTES - 16);
    if (c.tid < 4) xbw[c.tid] = 0u;
    __syncthreads();
    const int lo = a.ph_lo, hi = a.ph_hi;
    const bool multi = (hi - lo) > 1;
    XcdBarrier bar; bar.bar = (unsigned*)(a.ws + WS_CTL); bar.x = 0; bar.st = xbw;
    if (multi) bar = xcd_barrier_post((unsigned*)(a.ws + WS_CTL), xbw);
#ifndef PHASE_MASK
#define PHASE_MASK 0xFFFF
#endif
#if DBG == 1
#undef PHASE_MASK
#define PHASE_MASK 0x403
#elif DBG == 2 || DBG == 4 || DBG == 5
#undef PHASE_MASK
#define PHASE_MASK 0x4FF
#endif
#define IN(k) (((PHASE_MASK >> (k)) & 1) && lo <= (k) && (k) < hi)
#define REFRESH() do { int tz_ = threadIdx.x; asm volatile("" : "+v"(tz_)); c.tid = tz_; c.lane = tz_ & 63; c.wave = __builtin_amdgcn_readfirstlane(tz_ >> 6); } while (0)
#define SEAM(k) do { if (IN(k) && IN((k) + 1)) xcd_barrier(bar); } while (0)
#ifndef DUP
#define DUP -1
#endif
#define REP(k) for (int rep_ = 0; rep_ < ((DUP == (k)) ? 2 : 1); ++rep_)
#define DUP2(k, ...) do { __VA_ARGS__; if (DUP == (k)) { __syncthreads(); __VA_ARGS__; } } while (0)

    if (IN(0)) REP(0) { REFRESH(); p0_prologue(a, c); }
    SEAM(0);
    if (IN(1)) { REFRESH(); DUP2(1, p1_hnorm(a, c)); }
    SEAM(1);
    if (IN(2)) { REFRESH();
        pg8::StaticOrder S; S.init((const bf16_t*)(a.ws + WS_H), (const bf16_t*)(a.ws + WS_WIN), 2048, 2048, 2048, L_, DIN_PAD, c.nb, c.bid);
        EpiWin E{(bf16_t*)(a.ws + WS_US), (bf16_t*)(a.ws + WS_Q), (bf16_t*)(a.ws + WS_KROW), (bf16_t*)(a.ws + WS_VROW), (bf16_t*)(a.ws + WS_VT), (float*)(a.ws + WS_GATE)};
        DUP2(2, pg8::gemm_phase<EpiWin, pg8::StaticOrder>(lds, S, E));
        { const int nfull = (L_ / 256) * (DIN_PAD / 256) % c.nb, first = nfull, cnt = c.nb - nfull;
          if (c.bid >= first) { Ctx c2 = c; c2.bid = c.bid - first; c2.nb = cnt;
              conv_fp4rows(a.in[31], a.ws + WS_PV, (float*)(a.ws + WS_PSC) + 2, 16384, c2); } }
    }
    SEAM(2);
    if (IN(3)) { REFRESH();
        if (c.nb >= 224) {
            if (c.bid < 192) s5_item<0>(a, c, c.bid / 3, c.bid % 3);
            else {
                CmpOrder2 S{(const bf16_t*)(a.ws + WS_KROW), (const bf16_t*)(a.ws + WS_VROW), (const bf16_t*)(a.ws + WS_W1), 2048, 4096, 1024, c.nb - 192, c.bid - 192};
                EpiSlab2 E{(float*)(a.ws + WS_SLAB)};
                pg8::gemm_phase<EpiSlab2, CmpOrder2>(lds, S, E);
            }
        } else {
            for (int it = c.bid; it < 192; it += c.nb) s5_item<0>(a, c, it / 3, it % 3);
            __syncthreads();
            CmpOrder2 S{(const bf16_t*)(a.ws + WS_KROW), (const bf16_t*)(a.ws + WS_VROW), (const bf16_t*)(a.ws + WS_W1), 2048, 4096, 1024, c.nb, c.bid};
            EpiSlab2 E{(float*)(a.ws + WS_SLAB)};
            pg8::gemm_phase<EpiSlab2, CmpOrder2>(lds, S, E);
        }
    }
    SEAM(3);
    if (IN(4)) { REFRESH();
        DUP2(41, for (int it = c.bid; it < 256; it += c.nb) cmp_finish_item(a, c, it >> 7, it & 127));
        DUP2(42, for (int it = c.bid; it < 256; it += c.nb) s5_item<1>(a, c, it >> 2, it & 3));
    }
    SEAM(4);
    if (IN(5)) { REFRESH();
#if DBG == 5
        for (size_t i = (size_t)c.bid * NTHREADS + c.tid; i < (size_t)L_ * 1024 / 8; i += (size_t)c.nb * NTHREADS) *(u32x4*)((bf16_t*)(a.ws + WS_YSSM) + i * 8) = (u32x4){0u, 0u, 0u, 0u};
#else
        {
            pg8::StaticOrder S; S.init((const bf16_t*)(a.ws + WS_Z), (const bf16_t*)(a.ws + WS_WGLU), 1024, 1024, 1024, L_, 1024, c.nb, c.bid);
            EpiGlu E{(const bf16_t*)(a.ws + WS_Z), a.in[19], (bf16_t*)(a.ws + WS_Y2), (float*)(a.ws + WS_STSP)};
            DUP2(55, pg8::gemm_phase<EpiGlu, pg8::StaticOrder>(lds, S, E));
        }
#endif
        __syncthreads();
        if (c.nb >= 64 && c.bid >= c.nb - 32) { Ctx c2 = c; c2.bid = c.bid - (c.nb - 32); c2.nb = 32; conv_fp4rows(a.in[30], a.ws + WS_PU, (float*)(a.ws + WS_PSC), 16384, c2); }
        else if (c.nb < 64) conv_fp4rows(a.in[30], a.ws + WS_PU, (float*)(a.ws + WS_PSC), 16384, c);
        REP(5)
#if DBG == 4
        for (size_t i = (size_t)c.bid * NTHREADS + c.tid; i < (size_t)L_ * 1024 / 8; i += (size_t)c.nb * NTHREADS) *(u32x4*)((bf16_t*)(a.ws + WS_YATT) + i * 8) = (u32x4){0u, 0u, 0u, 0u};
#else
        {
            unsigned* qhead = (unsigned*)(a.ws + WS_CTL) + 8192;
            volatile LAS unsigned* slot = (volatile LAS unsigned*)(lds + LDS_BYTES - 32);
            for (;;) {
                if (c.tid == 0) *slot = __hip_atomic_fetch_add(qhead, 1u, __ATOMIC_RELAXED, __HIP_MEMORY_SCOPE_AGENT);
                __syncthreads();
                const unsigned q = *slot;
                __syncthreads();
                if (q >= 512u) break;
                attn_item(a, c, 255 - (int)(q >> 1), (int)(q & 1));
            }
        }
#endif
    }
    SEAM(5);
#define WOUT_GEMM(PM0) do { pg8::StaticOrder S; S.init((const bf16_t*)(a.ws + WS_Y2), (const bf16_t*)(a.ws + WS_WOUT), 2048, 2048, 2048, L_, 2048, c.nb, c.bid, PM0); \
        rsa_prepass(S, (const float*)(a.ws + WS_STSP), (const float*)(a.ws + WS_STAP), (float*)(a.ws + WS_RSA), c.tid); \
        EpiWout E{a.in[0], (const float*)(a.ws + WS_COND) + 2 * 2048, (const float*)(a.ws + WS_F2), (bf16_t*)(a.ws + WS_X1), (bf16_t*)(a.ws + WS_H2), (float*)(a.ws + WS_ST2P), (const float*)(a.ws + WS_RSA)}; \
        pg8::gemm_phase<EpiWout, pg8::StaticOrder>(lds, S, E); __syncthreads(); } while (0)
#define WQ_GEMM(PM0) do { pg8::StaticOrder S; S.init((const bf16_t*)(a.ws + WS_H2), (const bf16_t*)(a.ws + WS_WQ), 2048, 2048, 2048, L_, 2048, c.nb, c.bid, PM0); \
        rstd2_prepass(S, (const float*)(a.ws + WS_ST2P), (float*)(a.ws + WS_RSTD2), c.tid); \
        EpiQ E{(bf16_t*)(a.ws + WS_QP), (const float*)(a.ws + WS_RSTD2), (const float*)(a.ws + WS_CQ)}; pg8::gemm_phase<EpiQ, pg8::StaticOrder>(lds, S, E); __syncthreads(); \
        route_units(a, c, S); } while (0)
#define PEER_STEPS(FIRST, COUNT) do { for (int s_ = (FIRST) + c.bid; s_ < (FIRST) + (COUNT); s_ += c.nb) peer_step<false>(a, c, s_ * 8, s_ == (FIRST) + c.bid, (s_ + c.nb < (FIRST) + (COUNT)) ? (s_ + c.nb) * 8 : -1); } while (0)
    if (IN(6)) { REFRESH(); DUP2(7, p_cqce(a, c)); DUP2(71, WOUT_GEMM(0)); }
    SEAM(6);
    if (IN(7)) { REFRESH(); DUP2(8, WQ_GEMM(0)); }
    SEAM(7);
    if (IN(8)) { REFRESH(); PEER_STEPS(0, 2048); }
#undef WOUT_GEMM
#undef WQ_GEMM
#undef PEER_STEPS
#undef IN
#undef SEAM
}

#ifndef N_LAUNCHES
#define N_LAUNCHES 1
#endif
extern "C" void kernel_launch(void* const* d_in, const int* in_sizes, int n_in, void* d_out, int out_size, void* d_ws, size_t ws_size, hipStream_t stream) {
    static int grid = 0;
    if (grid == 0) {
        if (n_in != 33 || out_size != L_ * D_ || ws_size < WS_END) { fprintf(stderr, "kernel_launch: unexpected shapes (n_in %d, out %d, ws %zu < %zu); nothing launched\n", n_in, out_size, ws_size, (size_t)WS_END); grid = -1; return; }
        int dev = 0, cus = 0, per_cu = 0;
        if (hipGetDevice(&dev) != hipSuccess || hipDeviceGetAttribute(&cus, hipDeviceAttributeMultiprocessorCount, dev) != hipSuccess) { grid = -1; return; }
        if (hipFuncSetAttribute((const void*)fwd, hipFuncAttributeMaxDynamicSharedMemorySize, LDS_BYTES) != hipSuccess) { fprintf(stderr, "kernel_launch: hipFuncSetAttribute failed\n"); grid = -1; return; }
        if (hipOccupancyMaxActiveBlocksPerMultiprocessor(&per_cu, (const void*)fwd, NTHREADS, LDS_BYTES) != hipSuccess || per_cu < 1) { fprintf(stderr, "kernel_launch: occupancy query says %d\n", per_cu); (void)hipGetLastError(); grid = -1; return; }
        grid = cus;
    }
    if (grid < 0) return;
    (void)hipMemsetAsync((char*)d_ws + WS_CTL, 0, CTL_BYTES, stream);
    Args a{};
    for (int i = 0; i < 33; ++i) a.in[i] = (const float*)d_in[i];
    a.out = (float*)d_out; a.ws = (unsigned char*)d_ws;
    if (N_LAUNCHES == 1) { a.ph_lo = 0; a.ph_hi = NPHASE; hipLaunchKernelGGL(fwd, dim3(grid), dim3(NTHREADS), LDS_BYTES, stream, a); }
    else for (int p = 0; p < NPHASE; ++p) { a.ph_lo = p; a.ph_hi = p + 1; hipLaunchKernelGGL(fwd, dim3(grid), dim3(NTHREADS), LDS_BYTES, stream, a); }
}
```
